# Optimizing an MI355X kernel written in HIP

```python
import jax, jax.numpy as jnp
from jax import lax
import numpy as np

D_MODEL = 1024
BATCH = 4
SEQ = 8192
DEPTH = 1
DEC_BATCH = 128
DEC_SEQ = 1
PAST_LEN = 16384
PAGE_SIZE = 128

N_Q_HEADS = 8
N_KV_HEADS = 2
GROUP = N_Q_HEADS // N_KV_HEADS
HEAD_DIM = 64
WINDOW = 128
ATTN_Q_WIDTH = N_Q_HEADS * HEAD_DIM
KV_WIDTH = N_KV_HEADS * HEAD_DIM
N_GDN_HEADS = 4
GDN_DK = 128
GDN_DV = 128
GDN_QK_WIDTH = N_GDN_HEADS * GDN_DK
GDN_V_WIDTH = N_GDN_HEADS * GDN_DV
GDN_CONV_DIM = 2 * GDN_QK_WIDTH + GDN_V_WIDTH
CONV_WIDTH = 4
CHUNK = 64
MIX_WIDTH = ATTN_Q_WIDTH + GDN_V_WIDTH
IN_WIDTH = ATTN_Q_WIDTH + 2 * KV_WIDTH + 2 * GDN_QK_WIDTH + 2 * GDN_V_WIDTH + 2 * N_GDN_HEADS
D_FF = 2816
EPS = 1e-6

kernel_name = "hymba_swa_sink_alibi_gdn_macaron"


def _split_points():
    sizes = (ATTN_Q_WIDTH, KV_WIDTH, KV_WIDTH, GDN_QK_WIDTH, GDN_QK_WIDTH,
             GDN_V_WIDTH, GDN_V_WIDTH, N_GDN_HEADS, N_GDN_HEADS)
    pts, acc = [], 0
    for s in sizes[:-1]:
        acc += s
        pts.append(acc)
    return pts


def rmsnorm(x, g):
    xf = x.astype(jnp.float32)
    y = xf * lax.rsqrt(jnp.mean(xf * xf, axis=-1, keepdims=True) + EPS)
    return (y * g.astype(jnp.float32)).astype(x.dtype)


def l2norm(x):
    return x * lax.rsqrt(jnp.sum(x * x, axis=-1, keepdims=True) + EPS)


def swiglu(x, w_in, w_out):
    gate, up = jnp.split(x @ w_in, 2, axis=-1)
    return (jax.nn.silu(gate) * up) @ w_out


def alibi_slopes():
    h = jnp.arange(1, N_Q_HEADS + 1, dtype=jnp.float32)
    return jnp.exp2(-8.0 * h / N_Q_HEADS).reshape(N_KV_HEADS, GROUP)


def band_attention(q, k, v, dist, valid, sinks, slopes):
    s = jnp.einsum("...qhgd,...khd->...hgqk", q, k).astype(jnp.float32) * (HEAD_DIM ** -0.5)
    s = s - slopes[:, :, None, None] * dist[..., None, None, :, :].astype(jnp.float32)
    s = jnp.where(valid[..., None, None, :, :], s, -jnp.inf)
    sink = jnp.broadcast_to(sinks.astype(jnp.float32)[:, :, None, None], s.shape[:-1] + (1,))
    p = jax.nn.softmax(jnp.concatenate([s, sink], axis=-1), axis=-1)[..., :-1]
    return jnp.einsum("...hgqk,...khd->...qhgd", p.astype(v.dtype), v)


def swa_prompt(q, k, v, sinks, slopes):
    B, T, KV, G, HD = q.shape
    nb = T // WINDOW
    qb = q.reshape(B, nb, WINDOW, KV, G, HD)
    pad = jnp.zeros((B, WINDOW, KV, HD), k.dtype)

    def band(t):
        tp = jnp.concatenate([pad, t], axis=1).reshape(B, nb + 1, WINDOW, KV, HD)
        return jnp.concatenate([tp[:, :-1], tp[:, 1:]], axis=2)

    r = jnp.arange(WINDOW)[:, None]
    c = jnp.arange(2 * WINDOW)[None, :]
    dist = r - c + WINDOW
    blk = jnp.arange(nb)[:, None, None]
    valid = (dist >= 0) & (dist <= WINDOW) & (blk * WINDOW + c - WINDOW >= 0)
    o = band_attention(qb, band(k), band(v), dist, valid, sinks, slopes)
    return o.reshape(B, T, KV * G * HD)


def swa_sample(q, k_new, v_new, k_hist, v_hist, sinks, slopes):
    DB, T, KV, G, HD = q.shape
    wb = k_hist.shape[1]
    kk = jnp.concatenate([k_hist, k_new], axis=1)
    vv = jnp.concatenate([v_hist, v_new], axis=1)
    dist = jnp.arange(T)[:, None] - (jnp.arange(wb + T)[None, :] - wb)
    valid = (dist >= 0) & (dist <= WINDOW)
    o = band_attention(q, kk, vv, dist, valid, sinks, slopes)
    return o.reshape(DB, T, KV * G * HD), kk[:, -wb:], vv[:, -wb:]


def gdn_chunked(q, k, v, g, beta, S0):
    B, T, H, _ = q.shape
    dv = v.shape[-1]
    n = T // CHUNK

    def blk(t):
        return jnp.moveaxis(t.reshape((B, n, CHUNK, H) + t.shape[3:]), 3, 1)

    q, k, v, g, beta = blk(q), blk(k), blk(v), blk(g), blk(beta)
    gc = jnp.cumsum(g, axis=-1)
    idx = jnp.arange(CHUNK)
    tril = idx[:, None] >= idx[None, :]
    strict = idx[:, None] > idx[None, :]
    decay = jnp.exp(jnp.where(tril, gc[..., :, None] - gc[..., None, :], -jnp.inf))
    kk = jnp.einsum("bhnid,bhnjd->bhnij", k, k)
    A = jnp.where(strict, beta[..., None] * kk * decay, 0.0)
    eye = jnp.eye(CHUNK, dtype=A.dtype)
    Tm = lax.linalg.triangular_solve(eye + A, jnp.broadcast_to(eye, A.shape),
                                     left_side=True, lower=True, unit_diagonal=True)
    u = Tm @ (v * beta[..., None])
    w = Tm @ (k * (beta * jnp.exp(gc))[..., None])
    qk = jnp.where(tril, jnp.einsum("bhnid,bhnjd->bhnij", q, k) * decay, 0.0)
    q_dec = q * jnp.exp(gc)[..., None]
    k_dec = k * jnp.exp(gc[..., -1:] - gc)[..., None]
    g_last = jnp.exp(gc[..., -1])

    def step(S, xs):
        u_c, w_c, qk_c, qd_c, kd_c, gl_c = xs
        v_new = u_c - w_c @ S
        o = qd_c @ S + qk_c @ v_new
        S = S * gl_c[..., None, None] + jnp.swapaxes(kd_c, -1, -2) @ v_new
        return S, o

    xs = tuple(jnp.moveaxis(t, 2, 0) for t in (u, w, qk, q_dec, k_dec, g_last))
    S, o = lax.scan(step, S0, xs)
    o = jnp.moveaxis(jnp.moveaxis(o, 0, 2), 1, 3).reshape(B, T, H, dv)
    return o, S


def gdn_recurrent(q, k, v, g, beta, S0):
    def step(S, xs):
        q_t, k_t, v_t, g_t, b_t = xs
        S = S * jnp.exp(g_t)[..., None, None]
        kS = jnp.einsum("bhk,bhkv->bhv", k_t, S)
        S = S + jnp.einsum("bhk,bhv->bhkv", k_t, b_t[..., None] * (v_t - kS))
        return S, jnp.einsum("bhk,bhkv->bhv", q_t, S)

    xs = tuple(jnp.moveaxis(t, 1, 0) for t in (q, k, v, g, beta))
    S, o = lax.scan(step, S0, xs)
    return jnp.moveaxis(o, 0, 1), S


def token_mix(n, k_hist, v_hist, conv_hist, S0, w_in_mix, attn_sinks, conv_w,
              gdn_A_log, gdn_dt_bias, gdn_norm_g, w_out_mix):
    B, T, _ = n.shape
    aq, ak, av, gq, gk, gv, gz, gb, ga = jnp.split(n @ w_in_mix, _split_points(), axis=-1)
    slopes = alibi_slopes()
    sinks = attn_sinks.reshape(N_KV_HEADS, GROUP)
    q = aq.reshape(B, T, N_KV_HEADS, GROUP, HEAD_DIM)
    k = ak.reshape(B, T, N_KV_HEADS, HEAD_DIM)
    v = av.reshape(B, T, N_KV_HEADS, HEAD_DIM)
    if k_hist is None:
        attn_out = swa_prompt(q, k, v, sinks, slopes)
        wb = min(WINDOW, T)
        new_k, new_v = k[:, -wb:], v[:, -wb:]
        hist = jnp.zeros((B, CONV_WIDTH - 1, GDN_CONV_DIM), n.dtype)
    else:
        attn_out, new_k, new_v = swa_sample(q, k, v, k_hist, v_hist, sinks, slopes)
        hist = conv_hist
    xh = jnp.concatenate([hist, jnp.concatenate([gq, gk, gv], axis=-1)], axis=1)
    conv = conv_w[0] * xh[:, 0:T]
    for j in range(1, CONV_WIDTH):
        conv = conv + conv_w[j] * xh[:, j:j + T]
    new_conv = xh[:, -(CONV_WIDTH - 1):]
    act = jax.nn.silu(conv).astype(jnp.float32)
    cq, ck, cv = jnp.split(act, [GDN_QK_WIDTH, 2 * GDN_QK_WIDTH], axis=-1)
    dq = l2norm(cq.reshape(B, T, N_GDN_HEADS, GDN_DK)) * (GDN_DK ** -0.5)
    dk = l2norm(ck.reshape(B, T, N_GDN_HEADS, GDN_DK))
    dvv = cv.reshape(B, T, N_GDN_HEADS, GDN_DV)
    beta = jax.nn.sigmoid(gb.astype(jnp.float32))
    g = -jnp.exp(gdn_A_log.astype(jnp.float32)) * jax.nn.softplus(
        ga.astype(jnp.float32) + gdn_dt_bias.astype(jnp.float32))
    if S0 is None:
        o, new_S = gdn_chunked(dq, dk, dvv, g, beta,
                               jnp.zeros((B, N_GDN_HEADS, GDN_DK, GDN_DV), jnp.float32))
    else:
        o, new_S = gdn_recurrent(dq, dk, dvv, g, beta, S0.astype(jnp.float32))
    o = rmsnorm(o, gdn_norm_g) * jax.nn.silu(gz.astype(jnp.float32).reshape(B, T, N_GDN_HEADS, GDN_DV))
    gdn_out = o.reshape(B, T, GDN_V_WIDTH).astype(n.dtype)
    mix = jnp.concatenate([attn_out, gdn_out], axis=-1) @ w_out_mix
    return mix, new_k, new_v, new_conv, new_S.astype(n.dtype)


def decoder_layer(x, k_hist, v_hist, conv_hist, S0, ffn1_norm_g, ffn1_w_in, ffn1_w_out,
                  mix_norm_g, w_in_mix, attn_sinks, conv_w, gdn_A_log, gdn_dt_bias,
                  gdn_norm_g, w_out_mix, ffn2_norm_g, ffn2_w_in, ffn2_w_out):
    x = x + 0.5 * swiglu(rmsnorm(x, ffn1_norm_g), ffn1_w_in, ffn1_w_out)
    mix, new_k, new_v, new_conv, new_S = token_mix(
        rmsnorm(x, mix_norm_g), k_hist, v_hist, conv_hist, S0, w_in_mix, attn_sinks, conv_w,
        gdn_A_log, gdn_dt_bias, gdn_norm_g, w_out_mix)
    x = x + mix
    x = x + 0.5 * swiglu(rmsnorm(x, ffn2_norm_g), ffn2_w_in, ffn2_w_out)
    return x, new_k, new_v, new_conv, new_S


def setup_inputs(seed: int = 0) -> dict:
    key = jax.random.key(seed)
    ks = jax.random.split(key, 24)
    f32 = jnp.float32
    wb = min(WINDOW, PAST_LEN)
    nrm = lambda k, shape, scale: jax.random.normal(k, shape, f32) * scale
    gain = lambda k, shape: 1.0 + 0.02 * jax.random.normal(k, shape, f32)
    dt = jnp.exp(jax.random.uniform(ks[0], (DEPTH, N_GDN_HEADS), f32, np.log(1e-3), np.log(1e-1)))
    return {
        "x_prompt": nrm(ks[1], (BATCH, SEQ, D_MODEL), 1.0),
        "x_sample": nrm(ks[2], (DEC_BATCH, DEC_SEQ, D_MODEL), 1.0),
        "cache_attn_k": nrm(ks[3], (DEPTH, DEC_BATCH, wb, N_KV_HEADS, HEAD_DIM), 1.0),
        "cache_attn_v": nrm(ks[4], (DEPTH, DEC_BATCH, wb, N_KV_HEADS, HEAD_DIM), 1.0),
        "state_conv": nrm(ks[5], (DEPTH, DEC_BATCH, CONV_WIDTH - 1, GDN_CONV_DIM), 1.0),
        "state_gdn": nrm(ks[6], (DEPTH, DEC_BATCH, N_GDN_HEADS, GDN_DK, GDN_DV), GDN_DK ** -0.5),
        "ffn1_norm_g": gain(ks[7], (DEPTH, D_MODEL)),
        "ffn1_w_in": nrm(ks[8], (DEPTH, D_MODEL, 2 * D_FF), D_MODEL ** -0.5),
        "ffn1_w_out": nrm(ks[9], (DEPTH, D_FF, D_MODEL), D_FF ** -0.5),
        "mix_norm_g": gain(ks[10], (DEPTH, D_MODEL)),
        "w_in_mix": nrm(ks[11], (DEPTH, D_MODEL, IN_WIDTH), D_MODEL ** -0.5),
        "attn_sinks": nrm(ks[12], (DEPTH, N_Q_HEADS), 0.5),
        "conv_w": nrm(ks[13], (DEPTH, CONV_WIDTH, GDN_CONV_DIM), CONV_WIDTH ** -0.5),
        "gdn_A_log": jnp.log(jax.random.uniform(ks[14], (DEPTH, N_GDN_HEADS), f32, 1.0, 16.0)),
        "gdn_dt_bias": dt + jnp.log(-jnp.expm1(-dt)),
        "gdn_norm_g": gain(ks[15], (DEPTH, GDN_DV)),
        "w_out_mix": nrm(ks[16], (DEPTH, MIX_WIDTH, D_MODEL), MIX_WIDTH ** -0.5),
        "ffn2_norm_g": gain(ks[17], (DEPTH, D_MODEL)),
        "ffn2_w_in": nrm(ks[18], (DEPTH, D_MODEL, 2 * D_FF), D_MODEL ** -0.5),
        "ffn2_w_out": nrm(ks[19], (DEPTH, D_FF, D_MODEL), D_FF ** -0.5),
        "final_norm_g": gain(ks[20], (D_MODEL,)),
    }


def reference(x_prompt, x_sample, cache_attn_k, cache_attn_v, state_conv, state_gdn,
              ffn1_norm_g, ffn1_w_in, ffn1_w_out, mix_norm_g, w_in_mix, attn_sinks, conv_w,
              gdn_A_log, gdn_dt_bias, gdn_norm_g, w_out_mix, ffn2_norm_g, ffn2_w_in, ffn2_w_out,
              final_norm_g):
    xp, xs = x_prompt, x_sample
    kp_l, vp_l, cp_l, sp_l, ks_l, vs_l, cs_l, ss_l = [], [], [], [], [], [], [], []
    for l in range(DEPTH):
        lw = (ffn1_norm_g[l], ffn1_w_in[l], ffn1_w_out[l], mix_norm_g[l], w_in_mix[l],
              attn_sinks[l], conv_w[l], gdn_A_log[l], gdn_dt_bias[l], gdn_norm_g[l],
              w_out_mix[l], ffn2_norm_g[l], ffn2_w_in[l], ffn2_w_out[l])
        xp, kp, vp, cp, sp = decoder_layer(xp, None, None, None, None, *lw)
        xs, kss, vss, css, sss = decoder_layer(xs, cache_attn_k[l], cache_attn_v[l],
                                               state_conv[l], state_gdn[l], *lw)
        kp_l.append(kp); vp_l.append(vp); cp_l.append(cp); sp_l.append(sp)
        ks_l.append(kss); vs_l.append(vss); cs_l.append(css); ss_l.append(sss)
    y_prompt = rmsnorm(xp, final_norm_g)
    y_sample = rmsnorm(xs, final_norm_g)
    new_k_prompt = jnp.stack(kp_l)
    new_v_prompt = jnp.stack(vp_l)
    new_conv_prompt = jnp.stack(cp_l)
    new_gdn_prompt = jnp.stack(sp_l)
    new_k_sample = jnp.stack(ks_l)
    new_v_sample = jnp.stack(vs_l)
    new_conv_sample = jnp.stack(cs_l)
    new_gdn_sample = jnp.stack(ss_l)
    return (y_prompt, y_sample, new_k_prompt, new_v_prompt, new_conv_prompt, new_gdn_prompt,
            new_k_sample, new_v_sample, new_conv_sample, new_gdn_sample)
```

```cpp
#include <hip/hip_runtime.h>
#include <hip/hip_cooperative_groups.h>
#include <cstdio>
namespace cg = cooperative_groups;
namespace pg8 {
#define PG8_LAS __attribute__((address_space(3)))
typedef unsigned short bf16_t;
typedef short bf16x8 __attribute__((ext_vector_type(8)));
typedef float f32x4 __attribute__((ext_vector_type(4)));
typedef unsigned u32x4 __attribute__((ext_vector_type(4)));
constexpr int BM = 256, BK = 64, HALF = 128, HTB = HALF * BK * 2  , STAGE_BYTES = 8 * HTB, NXCD = 8, WGM = 8;

__host__ __device__ __forceinline__ int lds_byte(int r, int c) { const int st = (r >> 4) * 2 + (c >> 5), rr = r & 15, cc = c & 31, ob = rr * 64 + cc * 2; return st * 1024 + (ob ^ (((ob >> 9) & 1) << 5)); }
__host__ __device__ __forceinline__ void stage_rc(int b, int& R, int& C) { const int st = b / 1024, sb = b % 1024, swz = sb ^ (((sb >> 9) & 1) << 5); R = (st >> 1) * 16 + swz / 64; C = (st & 1) * 32 + (swz % 64) / 2; }
__host__ __device__ __forceinline__ int perm32(int rho) { const int n = rho >> 4, i = rho & 15; return 8 * (i >> 2) + 4 * n + (i & 3); }

struct Unit { int pm, pn; };
struct Gemm { const bf16_t* A; const bf16_t* Bt; int M, N, K, lda; };

struct StaticOrder {
    int nM, nN, nwg, G, c;
    __host__ __device__ void init(int M, int N, int G_, int c_) { nM = M / BM; nN = N / BM; nwg = nM * nN; G = G_; c = c_; }
    __host__ __device__ bool next(int i, Unit& u) const {
        const long L = (long)i * G + c; if (L >= nwg) return false;
        int wgid = (int)L; { const int q = nwg / NXCD, r = nwg % NXCD, xcd = wgid % NXCD, off = wgid / NXCD; wgid = (xcd < r ? xcd * (q + 1) : r * (q + 1) + (xcd - r) * q) + off; }
        const int nig = WGM * nN, gid = wgid / nig, fm = gid * WGM, gsz = (nM - fm) < WGM ? (nM - fm) : WGM;
        u.pm = fm + ((wgid % nig) % gsz); u.pn = (wgid % nig) / gsz; return true;
    }
    __device__ __forceinline__ void a_ready(const Unit&) const {}
    __device__ __forceinline__ void done(const Unit&) const {}
};
struct CountedOrder : StaticOrder {
    const unsigned* ready; unsigned need; unsigned* tmo;
    __device__ __forceinline__ void a_ready(const Unit& u) const {
        if (threadIdx.x < 64) {
            const unsigned long long t0 = __builtin_amdgcn_s_memrealtime(); unsigned polls = 0;
            while ((unsigned)__builtin_amdgcn_readfirstlane(__hip_atomic_load(ready + 64 * u.pm, __ATOMIC_RELAXED, __HIP_MEMORY_SCOPE_AGENT)) < need) {
                if ((++polls & 255u) == 0u && __builtin_amdgcn_readfirstlane(__hip_atomic_load(tmo, __ATOMIC_RELAXED, __HIP_MEMORY_SCOPE_AGENT)) != 0u) break;
                if (__builtin_amdgcn_s_memrealtime() - t0 > 2000000ull) {
                    if (threadIdx.x == 0) { unsigned expect = 0u; __hip_atomic_compare_exchange_strong(tmo + 1, &expect, 0x600u | (unsigned)(u.pm & 0xff), __ATOMIC_RELAXED, __ATOMIC_RELAXED, __HIP_MEMORY_SCOPE_AGENT); __hip_atomic_store(tmo, 1u, __ATOMIC_RELAXED, __HIP_MEMORY_SCOPE_AGENT); }
                    break; }
                __builtin_amdgcn_s_sleep(2); }
            __builtin_amdgcn_fence(__ATOMIC_ACQUIRE, "agent");
            asm volatile("s_waitcnt vmcnt(0)" ::: "memory");
        }
#if !defined(BROKEN_HOOK_NO_BARRIER)
        asm volatile("" ::: "memory"); __builtin_amdgcn_s_barrier(); asm volatile("" ::: "memory");
#endif
    }
};

__device__ __forceinline__ unsigned cvt_pk_bf16(float lo, float hi) { unsigned r; asm volatile("v_cvt_pk_bf16_f32 %0, %1, %2" : "=v"(r) : "v"(lo), "v"(hi)); return r; }
typedef float f32x2 __attribute__((ext_vector_type(2)));
__device__ __forceinline__ f32x2 gelu_pk(f32x2 v) {
    const f32x2 av = __builtin_elementwise_abs(v), d = av * 0.2316418882f + 1.0f;
    f32x2 t; t.x = __builtin_amdgcn_rcpf(d.x); t.y = __builtin_amdgcn_rcpf(d.y);
    f32x2 q = t * 0.5307027145f + (-0.7265760135f); q = q * t + 0.7107068705f; q = q * t + (-0.142248368f); q = q * t + 0.127414796f; q = q * t;
    const f32x2 s = (v * v) * (-0.72134752044f);
    f32x2 e; e.x = __builtin_amdgcn_exp2f(s.x); e.y = __builtin_amdgcn_exp2f(s.y);
    const f32x2 m = v * (q * e), r = v - m;
    f32x2 o; o.x = v.x < 0.f ? m.x : r.x; o.y = v.y < 0.f ? m.y : r.y; return o;
}

struct EpiF32 {
    static constexpr bool PERM = false, AFTER_DRAIN = false;
    float* C; int ldc; const float* bias;
    __device__ __forceinline__ void operator()(const f32x4 (&acc)[2][2][4][2], const Unit& u, int wr, int wc, int fr, int fq) const {
        const int row0 = u.pm * BM + wr * 64 + fr, col0 = u.pn * BM + wc * 32 + 4 * fq;
        f32x4 bv[2][2];
#pragma unroll
        for (int bj = 0; bj < 2; ++bj)
#pragma unroll
            for (int n = 0; n < 2; ++n) bv[bj][n] = bias ? *(const f32x4*)(bias + col0 + bj * HALF + n * 16) : (f32x4){0.f, 0.f, 0.f, 0.f};
#pragma unroll
        for (int ai = 0; ai < 2; ++ai)
#pragma unroll
            for (int m = 0; m < 4; ++m) { float* rowp = C + (size_t)(row0 + ai * HALF + m * 16) * ldc + col0;
#pragma unroll
                for (int bj = 0; bj < 2; ++bj)
#pragma unroll
                    for (int n = 0; n < 2; ++n) *(f32x4*)(rowp + bj * HALF + n * 16) = acc[ai][bj][m][n] + bv[bj][n]; }
    }
};
template <int ACT  > struct EpiBf16 {
    static constexpr bool PERM = true, AFTER_DRAIN = false;
    bf16_t* O; int ldc; const float* bias; int split_cols; size_t split_stride;
    __device__ __forceinline__ void operator()(const f32x4 (&acc)[2][2][4][2], const Unit& u, int wr, int wc, int fr, int fq) const {
        const int row0 = u.pm * BM + wr * 64 + fr; int colt = u.pn * BM; bf16_t* base = O;
        if (split_cols) { const int t = colt / split_cols; base += (size_t)t * split_stride; colt -= t * split_cols; }
        const int col0 = colt + wc * 32 + 8 * fq, bcol0 = u.pn * BM + wc * 32 + 8 * fq;
        f32x4 bv[2][2];
#pragma unroll
        for (int bj = 0; bj < 2; ++bj)
#pragma unroll
            for (int n = 0; n < 2; ++n) bv[bj][n] = bias ? *(const f32x4*)(bias + bcol0 + bj * HALF + 4 * n) : (f32x4){0.f, 0.f, 0.f, 0.f};
#pragma unroll
        for (int ai = 0; ai < 2; ++ai)
#pragma unroll
            for (int m = 0; m < 4; ++m) { bf16_t* rowp = base + (size_t)(row0 + ai * HALF + m * 16) * ldc + col0;
#pragma unroll
                for (int bj = 0; bj < 2; ++bj) { f32x4 v0 = acc[ai][bj][m][0] + bv[bj][0], v1 = acc[ai][bj][m][1] + bv[bj][1];
                    if (ACT == 1) { f32x2 a = gelu_pk((f32x2){v0[0], v0[1]}), b = gelu_pk((f32x2){v0[2], v0[3]}), c = gelu_pk((f32x2){v1[0], v1[1]}), d = gelu_pk((f32x2){v1[2], v1[3]});
                        v0 = (f32x4){a.x, a.y, b.x, b.y}; v1 = (f32x4){c.x, c.y, d.x, d.y}; }
                    if (ACT == 2) {
#pragma unroll
                        for (int j = 0; j < 4; ++j) { v0[j] = 0.5f * v0[j] * (1.0f + erff(v0[j] * 0.70710678f)); v1[j] = 0.5f * v1[j] * (1.0f + erff(v1[j] * 0.70710678f)); } }
                    u32x4 w; w.x = cvt_pk_bf16(v0[0], v0[1]); w.y = cvt_pk_bf16(v0[2], v0[3]); w.z = cvt_pk_bf16(v1[0], v1[1]); w.w = cvt_pk_bf16(v1[2], v1[3]);
                    *(u32x4*)(rowp + bj * HALF) = w; } }
    }
};

struct PanelStats {
    unsigned* xbuf;
    unsigned* cnt;
    unsigned* tmo;
    int ntn; float eps;
    unsigned code;
    __device__ __forceinline__ bool run(const f32x4 (&v)[2][2][4][2], const Unit& u, int wr, int wc, int fr, int fq, PG8_LAS unsigned char* lds, int wid, int lane) const {
        typedef float f32x2v __attribute__((ext_vector_type(2)));
        PG8_LAS f32x2v* P = (PG8_LAS f32x2v*)lds;
        PG8_LAS f32x2v* S = (PG8_LAS f32x2v*)(lds + 8192);
        PG8_LAS unsigned* flag = (PG8_LAS unsigned*)(lds + 8192 + 2048);
#pragma unroll
        for (int ai = 0; ai < 2; ++ai)
#pragma unroll
            for (int m = 0; m < 4; ++m) {
                float s = 0.f;
#pragma unroll
                for (int bj = 0; bj < 2; ++bj)
#pragma unroll
                    for (int n = 0; n < 2; ++n) { const f32x4 x = v[ai][bj][m][n]; s += (x[0] + x[1]) + (x[2] + x[3]); }
                s += __shfl_xor(s, 16); s += __shfl_xor(s, 32);
                const float mw = s * (1.0f / 64.0f); float q = 0.f;
#pragma unroll
                for (int bj = 0; bj < 2; ++bj)
#pragma unroll
                    for (int n = 0; n < 2; ++n) { const f32x4 d = v[ai][bj][m][n] - mw; q += (d[0] * d[0] + d[1] * d[1]) + (d[2] * d[2] + d[3] * d[3]); }
                q += __shfl_xor(q, 16); q += __shfl_xor(q, 32);
                if (fq == 0) P[(ai * HALF + wr * 64 + m * 16 + fr) * 4 + wc] = (f32x2v){mw, q};
            }
        asm volatile("s_waitcnt lgkmcnt(0)" ::: "memory"); __builtin_amdgcn_s_barrier(); asm volatile("" ::: "memory");
#if defined(BROKEN_NO_WAIT)
        if (blockIdx.x >= 64) { const long long t0 = clock64(); while (clock64() - t0 < 60000) __builtin_amdgcn_s_sleep(8); }
#endif
        const int row = wid * 32 + (lane & 31);
        if (lane < 32) {
            const f32x2v a = P[row * 4 + 0], b = P[row * 4 + 1], c = P[row * 4 + 2], d = P[row * 4 + 3];
            const float mt = (a.x + b.x + c.x + d.x) * 0.25f;
            const float da = a.x - mt, db = b.x - mt, dc = c.x - mt, dd = d.x - mt;
            const float m2 = (a.y + b.y) + (c.y + d.y) + 64.0f * ((da * da + db * db) + (dc * dc + dd * dd));
            unsigned long long* slot = (unsigned long long*)xbuf + ((size_t)(u.pm * BM + row) * 4 + u.pn);
            __hip_atomic_store(slot, ((unsigned long long)__float_as_uint(m2) << 32) | __float_as_uint(mt), __ATOMIC_RELAXED, __HIP_MEMORY_SCOPE_AGENT);
        }
        asm volatile("s_waitcnt vmcnt(0)" ::: "memory");
        if (lane == 0) __hip_atomic_fetch_add(cnt + 64 * u.pm, 1u, __ATOMIC_RELAXED, __HIP_MEMORY_SCOPE_AGENT);
        if (wid == 0) {
            bool dead = false; const unsigned long long t0 = __builtin_amdgcn_s_memrealtime(); const unsigned want = 8u * (unsigned)ntn;
            for (;;) {
#if defined(BROKEN_NO_WAIT)
                break;
#endif
                if ((unsigned)__builtin_amdgcn_readfirstlane(__hip_atomic_load(cnt + 64 * u.pm, __ATOMIC_RELAXED, __HIP_MEMORY_SCOPE_AGENT)) >= want) break;
                if (__builtin_amdgcn_s_memrealtime() - t0 > 2000000ull) {
                    if (lane == 0) { unsigned expect = 0u; __hip_atomic_compare_exchange_strong(tmo + 1, &expect, code | (unsigned)(u.pm & 0xff), __ATOMIC_RELAXED, __ATOMIC_RELAXED, __HIP_MEMORY_SCOPE_AGENT);
                                     __hip_atomic_store(tmo, 1u, __ATOMIC_RELAXED, __HIP_MEMORY_SCOPE_AGENT); }
                    dead = true; break; }
                __builtin_amdgcn_s_sleep(2);
            }
            __builtin_amdgcn_fence(__ATOMIC_ACQUIRE, "agent");
            if (lane == 0) flag[0] = dead ? 1u : 0u;
        }
        asm volatile("s_waitcnt vmcnt(0) lgkmcnt(0)" ::: "memory"); __builtin_amdgcn_s_barrier(); asm volatile("" ::: "memory");
        const bool bad = flag[0] != 0u;
        if (lane < 32) {
            const unsigned long long* slot = (const unsigned long long*)xbuf + (size_t)(u.pm * BM + row) * 4; float mt[4], m2[4]; float ms = 0.f;
#pragma unroll
            for (int t = 0; t < 4; ++t) { if (t < ntn) { const unsigned long long w = __hip_atomic_load(slot + t, __ATOMIC_RELAXED, __HIP_MEMORY_SCOPE_AGENT); mt[t] = __uint_as_float((unsigned)w); m2[t] = __uint_as_float((unsigned)(w >> 32)); } else { mt[t] = 0.f; m2[t] = 0.f; } ms += mt[t]; }
            const float mean = ms / (float)ntn; float q = 0.f;
#pragma unroll
            for (int t = 0; t < 4; ++t) if (t < ntn) { const float dm = mt[t] - mean; q += m2[t] + 256.0f * dm * dm; }
            S[row] = (f32x2v){mean, 1.0f / sqrtf(q / (256.0f * (float)ntn) + eps)};
        }
        asm volatile("s_waitcnt lgkmcnt(0)" ::: "memory"); __builtin_amdgcn_s_barrier(); asm volatile("" ::: "memory");
        return bad;
    }
};
struct EpiLnRes {
    static constexpr bool PERM = false, AFTER_DRAIN = true;
    const float* base; float* out; int ldc; const float* bias; PanelStats st; unsigned poison;
    __device__ __forceinline__ void refuse(size_t i0, size_t stride, int M, int N) const { const float q = __builtin_nanf(""); for (size_t i = i0; i < (size_t)M * N; i += stride) out[(i / N) * ldc + i % N] = q;
        if (i0 == 0) { unsigned expect = 0u; __hip_atomic_compare_exchange_strong(st.tmo + 1, &expect, 0x7f0u, __ATOMIC_RELAXED, __ATOMIC_RELAXED, __HIP_MEMORY_SCOPE_AGENT); __hip_atomic_store(st.tmo, 1u, __ATOMIC_RELAXED, __HIP_MEMORY_SCOPE_AGENT); } }
    __device__ __forceinline__ void fused(f32x4 (&acc)[2][2][4][2], const Unit& u, int wr, int wc, int fr, int fq, PG8_LAS unsigned char* lds, int wid, int lane) const {
        typedef float f32x2v __attribute__((ext_vector_type(2)));
        const PG8_LAS f32x2v* S = (const PG8_LAS f32x2v*)(lds + 8192);
        const int col0 = u.pn * BM + wc * 32 + 4 * fq;
#pragma unroll
        for (int bj = 0; bj < 2; ++bj)
#pragma unroll
            for (int n = 0; n < 2; ++n) { const f32x4 bv = bias ? *(const f32x4*)(bias + col0 + bj * HALF + n * 16) : (f32x4){0.f, 0.f, 0.f, 0.f};
#pragma unroll
                for (int ai = 0; ai < 2; ++ai)
#pragma unroll
                    for (int m = 0; m < 4; ++m) acc[ai][bj][m][n] += bv; }
        const bool bad = st.run(acc, u, wr, wc, fr, fq, lds, wid, lane) || poison != 0u;
        const float qnan = __builtin_nanf("");
#pragma unroll
        for (int ai = 0; ai < 2; ++ai)
#pragma unroll
            for (int m = 0; m < 4; ++m) { const int r = ai * HALF + wr * 64 + m * 16 + fr; const f32x2v sr = S[r]; const size_t off = (size_t)(u.pm * BM + r) * ldc + col0;
#pragma unroll
                for (int bj = 0; bj < 2; ++bj)
#pragma unroll
                    for (int n = 0; n < 2; ++n) { const f32x4 bs = *(const f32x4*)(base + off + bj * HALF + n * 16); f32x4 o = bs + (acc[ai][bj][m][n] - sr.x) * sr.y;
                        if (bad) o = (f32x4){qnan, qnan, qnan, qnan}; *(f32x4*)(out + off + bj * HALF + n * 16) = o; }
                asm volatile("" ::: "memory"); }
    }
};
struct EpiLnResLn {
    static constexpr bool PERM = false, AFTER_DRAIN = true;
    const float* base; float* out; bf16_t* xn; int ldc; const float* bias; PanelStats st1, st2; unsigned poison;
    __device__ __forceinline__ void refuse(size_t i0, size_t stride, int M, int N) const { const float q = __builtin_nanf(""); for (size_t i = i0; i < (size_t)M * N; i += stride) { const size_t o = (i / N) * ldc + i % N; out[o] = q; xn[o] = (bf16_t)0x7fc0u; }
        if (i0 == 0) { unsigned expect = 0u; __hip_atomic_compare_exchange_strong(st1.tmo + 1, &expect, 0x7f0u, __ATOMIC_RELAXED, __ATOMIC_RELAXED, __HIP_MEMORY_SCOPE_AGENT); __hip_atomic_store(st1.tmo, 1u, __ATOMIC_RELAXED, __HIP_MEMORY_SCOPE_AGENT); } }
    __device__ __forceinline__ void fused(f32x4 (&acc)[2][2][4][2], const Unit& u, int wr, int wc, int fr, int fq, PG8_LAS unsigned char* lds, int wid, int lane) const {
        typedef float f32x2v __attribute__((ext_vector_type(2))); typedef unsigned u32x2v __attribute__((ext_vector_type(2)));
        const PG8_LAS f32x2v* S = (const PG8_LAS f32x2v*)(lds + 8192);
        const int col0 = u.pn * BM + wc * 32 + 4 * fq;
#pragma unroll
        for (int bj = 0; bj < 2; ++bj)
#pragma unroll
            for (int n = 0; n < 2; ++n) { const f32x4 bv = bias ? *(const f32x4*)(bias + col0 + bj * HALF + n * 16) : (f32x4){0.f, 0.f, 0.f, 0.f};
#pragma unroll
                for (int ai = 0; ai < 2; ++ai)
#pragma unroll
                    for (int m = 0; m < 4; ++m) acc[ai][bj][m][n] += bv; }
        bool bad = st1.run(acc, u, wr, wc, fr, fq, lds, wid, lane) || poison != 0u;
        const float qnan = __builtin_nanf("");
#pragma unroll
        for (int ai = 0; ai < 2; ++ai)
#pragma unroll
            for (int m = 0; m < 4; ++m) { const int r = ai * HALF + wr * 64 + m * 16 + fr; const f32x2v sr = S[r]; const size_t off = (size_t)(u.pm * BM + r) * ldc + col0;
#pragma unroll
                for (int bj = 0; bj < 2; ++bj)
#pragma unroll
                    for (int n = 0; n < 2; ++n) { const f32x4 bs = *(const f32x4*)(base + off + bj * HALF + n * 16); acc[ai][bj][m][n] = bs + (acc[ai][bj][m][n] - sr.x) * sr.y; }
                asm volatile("" : "+v"(acc[ai][0][m][0]), "+v"(acc[ai][0][m][1]), "+v"(acc[ai][1][m][0]), "+v"(acc[ai][1][m][1]));
                if (m & 1) asm volatile("" ::: "memory"); }
        const bool bad1 = bad;
        bad = st2.run(acc, u, wr, wc, fr, fq, lds, wid, lane) || bad;
#pragma unroll
        for (int ai = 0; ai < 2; ++ai)
#pragma unroll
            for (int m = 0; m < 4; ++m) { const int r = ai * HALF + wr * 64 + m * 16 + fr; const f32x2v sr = S[r]; const size_t off = (size_t)(u.pm * BM + r) * ldc + col0;
#pragma unroll
                for (int bj = 0; bj < 2; ++bj)
#pragma unroll
                    for (int n = 0; n < 2; ++n) { const f32x4 x1 = acc[ai][bj][m][n]; *(f32x4*)(out + off + bj * HALF + n * 16) = bad1 ? (f32x4){qnan, qnan, qnan, qnan} : x1;
                        const f32x4 o = (x1 - sr.x) * sr.y; u32x2v w; w.x = cvt_pk_bf16(o[0], o[1]); w.y = cvt_pk_bf16(o[2], o[3]);
                        if (bad) { w.x = 0x7fc07fc0u; w.y = 0x7fc07fc0u; } *(u32x2v*)(xn + off + bj * HALF + n * 16) = w; }
                asm volatile("" ::: "memory"); }
    }
};

template <class Epi, class Sched, bool STAMP = false>
__device__ __forceinline__ void gemm_phase(PG8_LAS unsigned char* lds, const Gemm g, const Sched S, const Epi E, unsigned long long* stamps) {
    const int tid = threadIdx.x, wid = __builtin_amdgcn_readfirstlane(tid >> 6), lane = tid & 63, wr = wid >> 2, wc = wid & 3, fr = lane & 15, fq = lane >> 4;
    const int K = g.K, nt = K / BK;
    int ts_lo = 0, ts_hi = 0, nts = 0; const unsigned long long rt_entry = STAMP ? (unsigned long long)wall_clock64() : 0ull;
#define PG8_STAMP() do { if (STAMP && wid == 0 && nts < 64) { const unsigned long long _c = (unsigned long long)clock64(); \
        ts_lo = (lane == nts) ? (int)(unsigned)_c : ts_lo; ts_hi = (lane == nts) ? (int)(unsigned)(_c >> 32) : ts_hi; ++nts; } } while (0)
    PG8_STAMP();
    unsigned voffA[2], voffB[2];
#pragma unroll
    for (int i = 0; i < 2; ++i) { int R, C; stage_rc(tid * 16 + i * 8192, R, C); const int Rb = Epi::PERM ? ((R & ~31) + perm32(R & 31)) : R;
        voffA[i] = (unsigned)(R * g.lda + C) * 2u; voffB[i] = (unsigned)(Rb * K + C) * 2u; }
    const size_t kstep = (size_t)(BK * 2);
    const size_t hstep = (size_t)HALF * K * 2;
    const size_t tstep = 2 * hstep;
    const size_t hstepA = (size_t)HALF * g.lda * 2, tstepA = 2 * hstepA;
    const unsigned ldsw = (unsigned)wid * 1024u;
    const int aoff = lds_byte(wr * 64 + fr, fq * 8), boff = lds_byte(wc * 32 + fr, fq * 8);
#define PG8_SA(b, h) (((b) * 2 + (h)) * HTB)
#define PG8_SB(b, h) ((4 + (b) * 2 + (h)) * HTB)
#define PG8_STAGE(bufoff, gbase, voff) do { _Pragma("unroll") for (int _i = 0; _i < 2; ++_i) \
        __builtin_amdgcn_global_load_lds((const unsigned*)((const char*)(gbase) + (voff)[_i]), (PG8_LAS unsigned*)(lds + (bufoff) + ldsw + _i * 8192), 16, 0, 0); } while (0)
#define PG8_LDA(dst, b, h) do { _Pragma("unroll") for (int m = 0; m < 4; ++m) _Pragma("unroll") for (int k = 0; k < 2; ++k) dst[m][k] = *(const PG8_LAS bf16x8*)(lds + PG8_SA(b, h) + aoff + m * 2048 + k * 1024); } while (0)
#define PG8_LDB(dst, b, h) do { _Pragma("unroll") for (int n = 0; n < 2; ++n) _Pragma("unroll") for (int k = 0; k < 2; ++k) dst[n][k] = *(const PG8_LAS bf16x8*)(lds + PG8_SB(b, h) + boff + n * 2048 + k * 1024); } while (0)
#define PG8_MMA(ai, bj, At, Bt) do { __builtin_amdgcn_s_setprio(1); _Pragma("unroll") for (int m = 0; m < 4; ++m) _Pragma("unroll") for (int n = 0; n < 2; ++n) _Pragma("unroll") for (int k = 0; k < 2; ++k) \
        acc[ai][bj][m][n] = __builtin_amdgcn_mfma_f32_16x16x32_bf16(Bt[n][k], At[m][k], acc[ai][bj][m][n], 0, 0, 0); __builtin_amdgcn_s_setprio(0); } while (0)
#define PG8_WAIT_V(n) asm volatile("s_waitcnt vmcnt(" #n ")" ::: "memory")
#define PG8_WAIT_L(n) asm volatile("s_waitcnt lgkmcnt(" #n ")" ::: "memory")
#define PG8_BAR __builtin_amdgcn_s_barrier()
#define PG8_SCHED __builtin_amdgcn_sched_barrier(0)
    Unit cur, nxt; int ui = 0;
    if (!S.next(0, cur)) return;
    f32x4 acc[2][2][4][2];
#pragma unroll
    for (int a = 0; a < 2; ++a)
#pragma unroll
        for (int b = 0; b < 2; ++b)
#pragma unroll
            for (int m = 0; m < 4; ++m)
#pragma unroll
                for (int n = 0; n < 2; ++n) acc[a][b][m][n] = (f32x4){0.f, 0.f, 0.f, 0.f};
    bf16x8 At[4][2], B0[2][2], B1[2][2];
    const char* cA = (const char*)g.A + (size_t)cur.pm * tstepA; const char* cB = (const char*)g.Bt + (size_t)cur.pn * tstep;
    S.a_ready(cur);
    PG8_STAGE(PG8_SB(0, 0), cB, voffB); PG8_STAGE(PG8_SA(0, 0), cA, voffA); PG8_STAGE(PG8_SB(0, 1), cB + hstep, voffB); PG8_STAGE(PG8_SA(0, 1), cA + hstepA, voffA);
    if (wr == 1) PG8_BAR;
    PG8_WAIT_V(4); PG8_BAR;
    PG8_STAGE(PG8_SB(1, 0), cB + kstep, voffB); PG8_STAGE(PG8_SA(1, 0), cA + kstep, voffA); PG8_STAGE(PG8_SB(1, 1), cB + hstep + kstep, voffB);
    PG8_WAIT_V(6); PG8_BAR;
    PG8_STAMP();
    for (;;) {
        const bool has_next = S.next(ui + 1, nxt);
        const char* nA = has_next ? (const char*)g.A + (size_t)nxt.pm * tstepA : cA; const char* nB = has_next ? (const char*)g.Bt + (size_t)nxt.pn * tstep : cB;
        for (int t = 0; t < nt; t += 2) {
            const bool last = (t == nt - 2);
            const char* a1 = cA + (size_t)(t + 1) * kstep;
            const char* a2 = last ? nA : cA + (size_t)(t + 2) * kstep; const char* b2 = last ? nB : cB + (size_t)(t + 2) * kstep;
            const char* a3 = a2 + kstep; const char* b3 = b2 + kstep;
            if (last && has_next) S.a_ready(nxt);
            PG8_LDB(B0, 0, 0); PG8_SCHED; PG8_LDA(At, 0, 0); PG8_STAGE(PG8_SA(1, 1), a1 + hstepA, voffA);
            PG8_WAIT_L(8); PG8_BAR; PG8_WAIT_L(0); PG8_MMA(0, 0, At, B0); PG8_BAR; PG8_SCHED;
            PG8_LDB(B1, 0, 1); PG8_STAGE(PG8_SB(0, 0), b2, voffB);
            PG8_BAR; PG8_WAIT_L(0); PG8_MMA(0, 1, At, B1); PG8_BAR;
            PG8_LDA(At, 0, 1); PG8_STAGE(PG8_SA(0, 0), a2, voffA);
            PG8_BAR; PG8_WAIT_L(0); PG8_MMA(1, 0, At, B0); PG8_BAR; PG8_SCHED;
            PG8_STAGE(PG8_SB(0, 1), b2 + hstep, voffB);
            PG8_WAIT_V(6); PG8_BAR; PG8_MMA(1, 1, At, B1); PG8_BAR;
            PG8_LDB(B0, 1, 0); PG8_SCHED; PG8_LDA(At, 1, 0); PG8_STAGE(PG8_SA(0, 1), a2 + hstepA, voffA);
            PG8_WAIT_L(8); PG8_BAR; PG8_WAIT_L(0); PG8_MMA(0, 0, At, B0); PG8_BAR; PG8_SCHED;
            PG8_LDB(B1, 1, 1); PG8_STAGE(PG8_SB(1, 0), b3, voffB);
            PG8_BAR; PG8_WAIT_L(0); PG8_MMA(0, 1, At, B1); PG8_BAR;
            PG8_LDA(At, 1, 1); PG8_STAGE(PG8_SA(1, 0), a3, voffA);
            PG8_BAR; PG8_WAIT_L(0); PG8_MMA(1, 0, At, B0); PG8_BAR; PG8_SCHED;
            PG8_STAGE(PG8_SB(1, 1), b3 + hstep, voffB);
            PG8_WAIT_V(6); PG8_BAR; PG8_MMA(1, 1, At, B1); PG8_BAR;
        }
        PG8_STAMP();
        if constexpr (!Epi::AFTER_DRAIN) { E(acc, cur, wr, wc, fr, fq); S.done(cur); }
        PG8_STAMP();
        if (!has_next) break;
#pragma unroll
        for (int a = 0; a < 2; ++a)
#pragma unroll
            for (int b = 0; b < 2; ++b)
#pragma unroll
                for (int m = 0; m < 4; ++m)
#pragma unroll
                    for (int n = 0; n < 2; ++n) acc[a][b][m][n] = (f32x4){0.f, 0.f, 0.f, 0.f};
        cur = nxt; cA = nA; cB = nB; ++ui;
    }
    PG8_WAIT_V(0);
    if (wr == 0) PG8_BAR;
    PG8_BAR;
    if constexpr (Epi::AFTER_DRAIN) { E.fused(acc, cur, wr, wc, fr, fq, lds, wid, lane); S.done(cur); }
    PG8_STAMP();
    if (STAMP && wid == 0) { stamps[lane] = lane < nts ? (((unsigned long long)(unsigned)ts_hi << 32) | (unsigned)ts_lo) : 0ull;
        if (lane == 62) stamps[62] = rt_entry; if (lane == 63) stamps[63] = (unsigned long long)wall_clock64(); }
#undef PG8_STAMP
#undef PG8_SA
#undef PG8_SB
#undef PG8_STAGE
#undef PG8_LDA
#undef PG8_LDB
#undef PG8_MMA
#undef PG8_WAIT_V
#undef PG8_WAIT_L
#undef PG8_BAR
#undef PG8_SCHED
}
}

namespace mk {
#define LAS __attribute__((address_space(3)))
using pg8::bf16_t; using pg8::bf16x8; using pg8::f32x4; using pg8::u32x4;
typedef unsigned u32x2 __attribute__((ext_vector_type(2)));

constexpr int DM = 1024, SEQ = 8192, NBATCH = 4, MPR = NBATCH * SEQ, MSAMP = 128, MREAL = MPR + MSAMP, MPAD = 33024;
constexpr int DFF = 2816, PW = 2816, NINP = 3072, CONVC = 1536;
constexpr float EPS = 1e-6f;
constexpr int NSCAN = 64;
constexpr int LDS_BYTES = 147456;

constexpr size_t O_YP = 0, O_YS = 33554432, O_KP = 33685504, O_VP = 33751040, O_CP = 33816576, O_GP = 33835008,
                 O_KS = 34097152, O_VS = 36194304, O_CS = 38291456, O_GS = 38881280;
constexpr size_t MiB = 1u << 20;
constexpr size_t WS_CTL = 0, CTL_ZERO_BYTES = 1 * MiB;
constexpr size_t WS_W1IN = 1 * MiB, WS_W1OUT = 12 * MiB, WS_WINMIX = 18 * MiB, WS_WOUTMIX = 24 * MiB, WS_W2IN = 26 * MiB, WS_W2OUT = 37 * MiB;
constexpr size_t WS_GBA = 43 * MiB, WS_XN = 45 * MiB, WS_XN2 = 110 * MiB, WS_H = 175 * MiB, WS_GM = 353 * MiB, WS_GN = 417 * MiB;
constexpr size_t WS_GQ = 110 * MiB, WS_GO = 142 * MiB;
constexpr size_t WS_SSP1 = 481 * MiB, WS_SSP2 = 484 * MiB;
constexpr size_t WS_END = 487 * MiB;
constexpr size_t CTL_SS1 = 0, CTL_SS2 = 256 * 1024, CTL_GLAST = 768 * 1024;

struct Params { const float* in[21]; float* out; unsigned char* ws; };

typedef float f32x2v __attribute__((ext_vector_type(2)));
typedef __bf16 bf16x2v __attribute__((ext_vector_type(2)));
__device__ __forceinline__ unsigned cvt_pk(float lo, float hi) { const f32x2v v = {lo, hi}; const bf16x2v b = __builtin_convertvector(v, bf16x2v); return __builtin_bit_cast(unsigned, b); }
__device__ __forceinline__ bf16_t f2bf(float f) { return (bf16_t)(cvt_pk(f, 0.f) & 0xffffu); }
__device__ __forceinline__ float bf2f(bf16_t h) { return __uint_as_float(((unsigned)h) << 16); }
__device__ __forceinline__ float bflo(unsigned w) { return __uint_as_float(w << 16); }
__device__ __forceinline__ float bfhi(unsigned w) { return __uint_as_float(w & 0xffff0000u); }
__device__ __forceinline__ float silu(float x) { return x * __builtin_amdgcn_rcpf(1.0f + __expf(-x)); }
__device__ __forceinline__ float wave_sum(float v) {
#pragma unroll
    for (int o = 1; o < 64; o <<= 1) v += __shfl_xor(v, o);
    return v;
}
__device__ __forceinline__ float wave_max(float v) {
#pragma unroll
    for (int o = 1; o < 64; o <<= 1) v = fmaxf(v, __shfl_xor(v, o));
    return v;
}
__device__ __forceinline__ f32x4 mfma16(bf16x8 a, bf16x8 b, f32x4 c) { return __builtin_amdgcn_mfma_f32_16x16x32_bf16(a, b, c, 0, 0, 0); }

__device__ __forceinline__ float row_rstd(const float* ssp, int r) {
    if (r >= MREAL) return 0.f;
    const f32x4 a = *(const f32x4*)(ssp + (size_t)r * 16), b = *(const f32x4*)(ssp + (size_t)r * 16 + 4), c = *(const f32x4*)(ssp + (size_t)r * 16 + 8), d = *(const f32x4*)(ssp + (size_t)r * 16 + 12);
    const float s = (((a[0] + a[1]) + (a[2] + a[3])) + ((b[0] + b[1]) + (b[2] + b[3]))) + (((c[0] + c[1]) + (c[2] + c[3])) + ((d[0] + d[1]) + (d[2] + d[3])));
    return rsqrtf(s * (1.0f / DM) + EPS);
}
struct EpiSwiglu {
    static constexpr bool PERM = true, AFTER_DRAIN = false;
    bf16_t* H; const float* ss;
    __device__ __forceinline__ void operator()(const f32x4 (&acc)[2][2][4][2], const pg8::Unit& u, int wr, int wc, int fr, int fq) const {
        const int row0 = u.pm * 256 + wr * 64 + fr, col0 = u.pn * 128 + wc * 32 + 8 * fq;
#pragma unroll
        for (int ai = 0; ai < 2; ++ai)
#pragma unroll
            for (int m = 0; m < 4; ++m) {
                const int r = row0 + ai * 128 + m * 16;
                const float rs = ss ? row_rstd(ss, r) : 1.0f;
                float h[8];
#pragma unroll
                for (int n = 0; n < 2; ++n)
#pragma unroll
                    for (int j = 0; j < 4; ++j) h[n * 4 + j] = silu(acc[ai][0][m][n][j] * rs) * (acc[ai][1][m][n][j] * rs);
                u32x4 w; w.x = cvt_pk(h[0], h[1]); w.y = cvt_pk(h[2], h[3]); w.z = cvt_pk(h[4], h[5]); w.w = cvt_pk(h[6], h[7]);
                *(u32x4*)(H + (size_t)r * DFF + col0) = w;
            }
    }
};
template <bool RESB16, bool WF32, bool WB16, bool SUMSQ, bool HALF> struct EpiResid {
    static constexpr bool PERM = true, AFTER_DRAIN = false;
    const void* resP; const void* resS; float* Yo; bf16_t* XBo; float* sso;
    __device__ __forceinline__ void operator()(const f32x4 (&acc)[2][2][4][2], const pg8::Unit& u, int wr, int wc, int fr, int fq) const {
        const int row0 = u.pm * 256 + wr * 64 + fr, col0 = u.pn * 256 + wc * 32 + 8 * fq;
        const char* const rP = (const char*)resP; const char* const rS = (const char*)resS - (size_t)MPR * DM * (RESB16 ? 2 : 4);
        float* const Y = Yo; const float scale = HALF ? 0.5f : 1.0f; bf16_t* const XB = XBo; float* const ss = sso;
#pragma unroll
        for (int ai = 0; ai < 2; ++ai)
#pragma unroll
            for (int m = 0; m < 4; ++m) {
                const int r = row0 + ai * 128 + m * 16; float s = 0.f;
                if (r < MREAL) {
                    const char* rp = ((r < MPR) ? rP : rS) + (size_t)r * DM * (RESB16 ? 2 : 4);
#pragma unroll
                    for (int bj = 0; bj < 2; ++bj) {
                        const int c = col0 + bj * 128;
                        f32x4 r0, r1;
                        if (RESB16) { const u32x4 w = *(const u32x4*)(rp + (size_t)c * 2); r0 = (f32x4){bflo(w.x), bfhi(w.x), bflo(w.y), bfhi(w.y)}; r1 = (f32x4){bflo(w.z), bfhi(w.z), bflo(w.w), bfhi(w.w)}; }
                        else { r0 = *(const f32x4*)(rp + (size_t)c * 4); r1 = *(const f32x4*)(rp + (size_t)c * 4 + 16); }
                        const f32x4 v0 = r0 + acc[ai][bj][m][0] * scale, v1 = r1 + acc[ai][bj][m][1] * scale;
                        if (WF32) { *(f32x4*)(Y + (size_t)r * DM + c) = v0; *(f32x4*)(Y + (size_t)r * DM + c + 4) = v1; }
                        if (WB16) { u32x4 w; w.x = cvt_pk(v0[0], v0[1]); w.y = cvt_pk(v0[2], v0[3]); w.z = cvt_pk(v1[0], v1[1]); w.w = cvt_pk(v1[2], v1[3]);
                            *(u32x4*)(XB + (size_t)r * DM + c) = w; }
                        if (SUMSQ) s += (v0[0] * v0[0] + v0[1] * v0[1]) + (v0[2] * v0[2] + v0[3] * v0[3]) + (v1[0] * v1[0] + v1[1] * v1[1]) + (v1[2] * v1[2] + v1[3] * v1[3]);
                    }
                }
                if (SUMSQ) { s += __shfl_xor(s, 16); s += __shfl_xor(s, 32); if (fq == 0 && r < MREAL) ss[(size_t)r * 16 + u.pn * 4 + wc] = s; }
            }
    }
};
struct EpiInproj {
    static constexpr bool PERM = true, AFTER_DRAIN = false;
    bf16_t* P; float* gba; const float* ss;
    __device__ __forceinline__ void operator()(const f32x4 (&acc)[2][2][4][2], const pg8::Unit& u, int wr, int wc, int fr, int fq) const {
        const int row0 = u.pm * 256 + wr * 64 + fr, col0 = u.pn * 256 + wc * 32 + 8 * fq;
#pragma unroll
        for (int ai = 0; ai < 2; ++ai)
#pragma unroll
            for (int m = 0; m < 4; ++m) {
                const int r = row0 + ai * 128 + m * 16;
                const float rs = row_rstd(ss, r);
                if (u.pn < 11) {
#pragma unroll
                    for (int bj = 0; bj < 2; ++bj) { const f32x4 v0 = acc[ai][bj][m][0] * rs, v1 = acc[ai][bj][m][1] * rs;
                        u32x4 w; w.x = cvt_pk(v0[0], v0[1]); w.y = cvt_pk(v0[2], v0[3]); w.z = cvt_pk(v1[0], v1[1]); w.w = cvt_pk(v1[2], v1[3]);
                        *(u32x4*)(P + (size_t)r * PW + col0 + bj * 128) = w; }
                } else if (wc == 0 && fq == 0) {
                    *(f32x4*)(gba + (size_t)r * 8) = acc[ai][0][m][0] * rs; *(f32x4*)(gba + (size_t)r * 8 + 4) = acc[ai][0][m][1] * rs;
                }
            }
    }
};

__device__ __forceinline__ void transpose_item(const float* W, int K, int N, bf16_t* WT, int k0, int n0, int drow0, const float* gs, LAS float* scr, int lane) {
#pragma unroll 8
    for (int i = 0; i < 32; ++i) { const int kk = 2 * i + (lane >> 5), n = n0 + (lane & 31);
        float v = (n < N) ? W[(size_t)(k0 + kk) * N + n] : 0.f; if (gs) v *= gs[k0 + kk];
        scr[kk * 33 + (lane & 31)] = v; }
    asm volatile("s_waitcnt lgkmcnt(0)" ::: "memory");
    const int c = lane & 7;
#pragma unroll
    for (int j = 0; j < 4; ++j) { const int nn = (lane >> 3) + 8 * j; const LAS float* s = scr + (8 * c) * 33 + nn;
        u32x4 o; o.x = cvt_pk(s[0 * 33], s[1 * 33]); o.y = cvt_pk(s[2 * 33], s[3 * 33]); o.z = cvt_pk(s[4 * 33], s[5 * 33]); o.w = cvt_pk(s[6 * 33], s[7 * 33]);
        *(u32x4*)(WT + (size_t)(drow0 + nn) * K + k0 + 8 * c) = o; }
    asm volatile("s_waitcnt lgkmcnt(0)" ::: "memory");
}
__device__ __forceinline__ int map_ffin_row(int n0) { return n0 < DFF ? (n0 >> 7) * 256 + (n0 & 127) : ((n0 - DFF) >> 7) * 256 + 128 + ((n0 - DFF) & 127); }

__device__ __forceinline__ void p0_prologue(const Params& p, LAS unsigned char* lds, int vb, int G) {
    const int tid = threadIdx.x, lane = tid & 63, wid = tid >> 6;
    LAS float* scr = (LAS float*)(lds + wid * 16384);
    const int gw = vb * 8 + wid, NGW = G * 8;
    bf16_t* W1IN = (bf16_t*)(p.ws + WS_W1IN); bf16_t* W1OUT = (bf16_t*)(p.ws + WS_W1OUT); bf16_t* WINMIX = (bf16_t*)(p.ws + WS_WINMIX);
    bf16_t* WOUTMIX = (bf16_t*)(p.ws + WS_WOUTMIX); bf16_t* W2IN = (bf16_t*)(p.ws + WS_W2IN); bf16_t* W2OUT = (bf16_t*)(p.ws + WS_W2OUT);
    constexpr int I_FIN = 16 * 176, I_FOUT = 44 * 32, I_INMIX = 16 * 89, I_OUTMIX = 16 * 32;
    constexpr int NITEMS = 2 * I_FIN + 2 * I_FOUT + I_INMIX + I_OUTMIX;
    for (int it = gw; it < NITEMS; it += NGW) {
        int r = it;
        if (r < I_FIN) { const int kb = r / 176, nb = r % 176; transpose_item(p.in[7], DM, 2 * DFF, W1IN, kb * 64, nb * 32, map_ffin_row(nb * 32), nullptr, scr, lane); continue; } r -= I_FIN;
        if (r < I_FIN) { const int kb = r / 176, nb = r % 176; transpose_item(p.in[18], DM, 2 * DFF, W2IN, kb * 64, nb * 32, map_ffin_row(nb * 32), p.in[17], scr, lane); continue; } r -= I_FIN;
        if (r < I_FOUT) { const int kb = r / 32, nb = r % 32; transpose_item(p.in[8], DFF, DM, W1OUT, kb * 64, nb * 32, nb * 32, nullptr, scr, lane); continue; } r -= I_FOUT;
        if (r < I_FOUT) { const int kb = r / 32, nb = r % 32; transpose_item(p.in[19], DFF, DM, W2OUT, kb * 64, nb * 32, nb * 32, nullptr, scr, lane); continue; } r -= I_FOUT;
        if (r < I_INMIX) { const int kb = r / 89, nb = r % 89; transpose_item(p.in[10], DM, 2824, WINMIX, kb * 64, nb * 32, nb * 32, p.in[9], scr, lane); continue; } r -= I_INMIX;
        { const int kb = r / 32, nb = r % 32; transpose_item(p.in[16], DM, DM, WOUTMIX, kb * 64, nb * 32, nb * 32, nullptr, scr, lane); }
    }
    bf16_t* XN = (bf16_t*)(p.ws + WS_XN); const float* g1 = p.in[6];
    f32x4 gv[4];
#pragma unroll
    for (int j = 0; j < 4; ++j) gv[j] = *((const f32x4*)g1 + lane + 64 * j);
    for (int m = gw; m < MPAD; m += NGW) {
        unsigned long long* o8 = (unsigned long long*)(XN + (size_t)m * DM) + lane;
        if (m >= MREAL) {
#pragma unroll
            for (int j = 0; j < 4; ++j) o8[64 * j] = 0ull;
            continue; }
        const float* xrow = (m < MPR) ? p.in[0] + (size_t)m * DM : p.in[1] + (size_t)(m - MPR) * DM;
        const f32x4* xr = (const f32x4*)xrow + lane;
        f32x4 v[4]; float s = 0.f;
#pragma unroll
        for (int j = 0; j < 4; ++j) { v[j] = xr[64 * j]; s += (v[j][0] * v[j][0] + v[j][1] * v[j][1]) + (v[j][2] * v[j][2] + v[j][3] * v[j][3]); }
        const float rstd = rsqrtf(wave_sum(s) * (1.0f / DM) + EPS);
#pragma unroll
        for (int j = 0; j < 4; ++j) { const f32x4 y = v[j] * rstd * gv[j];
            o8[64 * j] = (unsigned long long)cvt_pk(y[0], y[1]) | ((unsigned long long)cvt_pk(y[2], y[3]) << 32); }
    }
}

__device__ __forceinline__ f32x4 tile_mm(const LAS bf16_t* X, int ldx, int mt, const LAS bf16_t* Y, int ldy, int nt, int nks, int fr, int fq) {
    f32x4 acc = (f32x4){0.f, 0.f, 0.f, 0.f};
    const LAS bf16_t* xp = X + (16 * mt + fr) * ldx + 8 * fq; const LAS bf16_t* yp = Y + (16 * nt + fr) * ldy + 8 * fq;
    for (int ks = 0; ks < nks; ++ks) acc = mfma16(*(const LAS bf16x8*)(xp + 32 * ks), *(const LAS bf16x8*)(yp + 32 * ks), acc);
    return acc;
}
constexpr int G1_QS = 0, G1_KS = 17408, G1_VBT = 34816, G1_KBT = 53248, G1_KDT = 71680, G1_UT = 90112, G1_WT = 108544, G1_QK = 126976, G1_TB = 136192, G1_GC = 145408, G1_BETA = 145664;

__device__ __forceinline__ void gdn_prep_unit(const Params& p, LAS unsigned char* lds, int unit) {
    const int tid = threadIdx.x, lane = tid & 63, wid = tid >> 6, fr = lane & 15, fq = lane >> 4;
    const int bh = unit >> 7, n = unit & 127, b = bh >> 2, h = bh & 3;
    const int tok0 = b * SEQ + n * 64;
    LAS bf16_t* Qs = (LAS bf16_t*)(lds + G1_QS); LAS bf16_t* Ks = (LAS bf16_t*)(lds + G1_KS); LAS bf16_t* VbT = (LAS bf16_t*)(lds + G1_VBT);
    LAS bf16_t* KbT = (LAS bf16_t*)(lds + G1_KBT); LAS bf16_t* KdT = (LAS bf16_t*)(lds + G1_KDT); LAS bf16_t* UT = (LAS bf16_t*)(lds + G1_UT);
    LAS bf16_t* WT = (LAS bf16_t*)(lds + G1_WT); LAS float* Af = (LAS float*)(lds + G1_WT); LAS bf16_t* QK = (LAS bf16_t*)(lds + G1_QK);
    LAS bf16_t* Tb = (LAS bf16_t*)(lds + G1_TB); LAS float* gcs = (LAS float*)(lds + G1_GC); LAS float* betas = (LAS float*)(lds + G1_BETA);
    const bf16_t* PB = (const bf16_t*)(p.ws + WS_H); const float* GBA = (const float*)(p.ws + WS_GBA);
    if (tid < 64) {
        const float* gb = GBA + (size_t)(tok0 + tid) * 8;
        const float bt = 1.0f / (1.0f + __expf(-gb[h]));
        const float x = gb[4 + h] + p.in[14][h]; const float sp = x > 20.f ? x : log1pf(__expf(x));
        float c = -__expf(p.in[13][h]) * sp;
#pragma unroll
        for (int o = 1; o < 64; o <<= 1) { const float t = __shfl_up(c, o); if (lane >= o) c += t; }
        gcs[tid] = c; betas[tid] = bt;
    }
    __syncthreads();
    const float gclast = gcs[63];
    const float* cw = p.in[12];
#pragma unroll 1
    for (int it = 0; it < 6; ++it) {
        const int item = tid + 512 * it, l16 = item & 15, row = item >> 4, which = row >> 6, t = row & 63;
        const int cch = which * 512 + h * 128 + l16 * 8;
        float a[8];
#pragma unroll
        for (int e = 0; e < 8; ++e) a[e] = 0.f;
#pragma unroll
        for (int j = 0; j < 4; ++j) {
            const int tt = n * 64 + t - 3 + j;
            if (tt >= 0) {
                const u32x4 xv = *(const u32x4*)(PB + (size_t)(b * SEQ + tt) * PW + 768 + cch);
                const f32x4 w0 = *(const f32x4*)(cw + j * CONVC + cch), w1 = *(const f32x4*)(cw + j * CONVC + cch + 4);
                a[0] += w0[0] * bflo(xv.x); a[1] += w0[1] * bfhi(xv.x); a[2] += w0[2] * bflo(xv.y); a[3] += w0[3] * bfhi(xv.y);
                a[4] += w1[0] * bflo(xv.z); a[5] += w1[1] * bfhi(xv.z); a[6] += w1[2] * bflo(xv.w); a[7] += w1[3] * bfhi(xv.w);
            }
        }
        float ss = 0.f;
#pragma unroll
        for (int e = 0; e < 8; ++e) { a[e] = silu(a[e]); ss += a[e] * a[e]; }
        ss += __shfl_xor(ss, 1); ss += __shfl_xor(ss, 2); ss += __shfl_xor(ss, 4); ss += __shfl_xor(ss, 8);
        const float gct = gcs[t], bt = betas[t];
        if (which == 0) {
            const float sc = rsqrtf(ss + EPS) * 0.08838834764831845f;
            u32x4 w; w.x = cvt_pk(a[0] * sc, a[1] * sc); w.y = cvt_pk(a[2] * sc, a[3] * sc); w.z = cvt_pk(a[4] * sc, a[5] * sc); w.w = cvt_pk(a[6] * sc, a[7] * sc);
            *(LAS u32x4*)(Qs + t * 136 + l16 * 8) = w;
        } else if (which == 1) {
            const float sc = rsqrtf(ss + EPS);
            u32x4 w; w.x = cvt_pk(a[0] * sc, a[1] * sc); w.y = cvt_pk(a[2] * sc, a[3] * sc); w.z = cvt_pk(a[4] * sc, a[5] * sc); w.w = cvt_pk(a[6] * sc, a[7] * sc);
            *(LAS u32x4*)(Ks + t * 136 + l16 * 8) = w;
            const float sb = sc * bt * __expf(gct), sd = sc * __expf(gclast - gct);
#pragma unroll
            for (int e = 0; e < 8; ++e) { KbT[(l16 * 8 + e) * 72 + t] = f2bf(a[e] * sb); KdT[(l16 * 8 + e) * 72 + t] = f2bf(a[e] * sd); }
        } else {
#pragma unroll
            for (int e = 0; e < 8; ++e) VbT[(l16 * 8 + e) * 72 + t] = f2bf(a[e] * bt);
        }
    }
    __syncthreads();
#pragma unroll 1
    for (int r = 0; r < 4; ++r) {
        const int job = wid + 8 * r, kind = job >> 4, tile = job & 15, it = tile >> 2, jt = tile & 3;
        if (kind == 0 && jt > it) continue;
        const f32x4 acc = tile_mm(Ks, 136, jt, kind ? Qs : Ks, 136, it, 4, fr, fq);
        const int i = 16 * it + fr; const float gci = gcs[i], bi = betas[i];
        float v[4];
#pragma unroll
        for (int e = 0; e < 4; ++e) { const int j = 16 * jt + 4 * fq + e; const bool ok = kind ? (i >= j) : (i > j);
            const float d = __expf(ok ? gci - gcs[j] : 0.f); v[e] = ok ? acc[e] * d * (kind ? 1.0f : bi) : 0.f; }
        if (kind == 0) *(LAS f32x4*)(Af + i * 68 + 16 * jt + 4 * fq) = (f32x4){v[0], v[1], v[2], v[3]};
        else { u32x2 w; w.x = cvt_pk(v[0], v[1]); w.y = cvt_pk(v[2], v[3]); *(LAS u32x2*)(QK + i * 72 + 16 * jt + 4 * fq) = w; }
    }
    __syncthreads();
    if (wid == 0) {
        float t[64];
#pragma unroll
        for (int i = 0; i < 64; ++i) {
            float a = (lane == i) ? 1.0f : 0.0f;
#pragma unroll
            for (int j4 = 0; j4 < (i + 3) / 4; ++j4) { const f32x4 av = *(const LAS f32x4*)(Af + i * 68 + 4 * j4);
#pragma unroll
                for (int e = 0; e < 4; ++e) if (4 * j4 + e < i) a -= av[e] * t[4 * j4 + e]; }
            t[i] = a;
            Tb[i * 72 + lane] = f2bf(a);
        }
    }
    __syncthreads();
#pragma unroll 1
    for (int r = 0; r < 8; ++r) {
        const int job = wid + 8 * r, kind = job >> 5, tile = job & 31, mt = tile >> 3, nt = tile & 7;
        const f32x4 acc = tile_mm(Tb, 72, mt, kind ? KbT : VbT, 72, nt, 2, fr, fq);
        u32x2 w; w.x = cvt_pk(acc[0], acc[1]); w.y = cvt_pk(acc[2], acc[3]);
        *(LAS u32x2*)((kind ? WT : UT) + (16 * nt + fr) * 72 + 16 * mt + 4 * fq) = w;
    }
    __syncthreads();
    bf16_t* GM = (bf16_t*)(p.ws + WS_GM) + (size_t)unit * 16384; bf16_t* GN = (bf16_t*)(p.ws + WS_GN) + (size_t)unit * 16384;
    bf16_t* GQ = (bf16_t*)(p.ws + WS_GQ) + (size_t)unit * 8192; bf16_t* GO = (bf16_t*)(p.ws + WS_GO) + (size_t)unit * 8192;
#pragma unroll 1
    for (int r = 0; r < 24; ++r) {
        const int job = wid + 8 * r;
        if (job < 64) { const int a = job >> 3, mt = job & 7;
            const f32x4 acc = tile_mm(WT, 72, a, KdT, 72, mt, 2, fr, fq);
            u32x2 w; w.x = cvt_pk(-acc[0], -acc[1]); w.y = cvt_pk(-acc[2], -acc[3]);
            *(u32x2*)(GM + ((mt * 4 + (a >> 1)) * 64 + lane) * 8 + (a & 1) * 4) = w;
        } else if (job < 128) { const int j = job - 64, mt = j >> 3, nt = j & 7;
            const f32x4 acc = tile_mm(KdT, 72, mt, UT, 72, nt, 2, fr, fq);
            u32x2 w; w.x = cvt_pk(acc[0], acc[1]); w.y = cvt_pk(acc[2], acc[3]);
            *(u32x2*)(GN + ((nt * 64 + lane) * 8 + mt) * 4) = w;
        } else if (job < 160) { const int j = job - 128, a = j >> 2, it = j & 3;
            const f32x4 acc = tile_mm(WT, 72, a, QK, 72, it, 2, fr, fq);
            const int i = 16 * it + fr; const float eg = __expf(gcs[i]);
            const u32x2 qv = *(const LAS u32x2*)(Qs + i * 136 + 16 * a + 4 * fq);
            u32x2 w; w.x = cvt_pk(bflo(qv.x) * eg - acc[0], bfhi(qv.x) * eg - acc[1]); w.y = cvt_pk(bflo(qv.y) * eg - acc[2], bfhi(qv.y) * eg - acc[3]);
            *(u32x2*)(GQ + ((it * 4 + (a >> 1)) * 64 + lane) * 8 + (a & 1) * 4) = w;
        } else { const int j = job - 160, mt = j >> 3, nt = j & 7;
            const f32x4 acc = tile_mm(QK, 72, mt, UT, 72, nt, 2, fr, fq);
            u32x2 w; w.x = cvt_pk(acc[0], acc[1]); w.y = cvt_pk(acc[2], acc[3]);
            *(u32x2*)(GO + ((nt * 64 + lane) * 4 + mt) * 4) = w;
        }
    }
    if (tid == 0) ((float*)(p.ws + WS_CTL + CTL_GLAST))[unit] = __expf(gclast);
    __syncthreads();
}

__device__ __forceinline__ void gdn_scan(const Params& p, LAS unsigned char* lds, int sb) {
    const int tid = threadIdx.x, lane = tid & 63, wid = tid >> 6, fr = lane & 15, fq = lane >> 4;
    const int bh = sb >> 2, sp = sb & 3, unit0 = bh * 128, sl = sp * 2 + wid;
    const u32x4* GMb = (const u32x4*)((const bf16_t*)(p.ws + WS_GM) + (size_t)unit0 * 16384);
    const u32x4* GQb = (const u32x4*)((const bf16_t*)(p.ws + WS_GQ) + (size_t)unit0 * 8192);
    const bf16_t* GNb = (const bf16_t*)(p.ws + WS_GN) + (size_t)unit0 * 16384;
    bf16_t* GOb = (bf16_t*)(p.ws + WS_GO) + (size_t)unit0 * 8192;
    const float* glast = (const float*)(p.ws + WS_CTL + CTL_GLAST) + unit0;
    u32x4 st[6];
#pragma unroll
    for (int c = 0; c < 2; ++c) {
#pragma unroll
        for (int i = 0; i < 6; ++i) { const int q = tid + 512 * i; st[i] = (q < 2048) ? GMb[(size_t)c * 2048 + q] : GQb[(size_t)c * 1024 + (q - 2048)]; }
#pragma unroll
        for (int i = 0; i < 6; ++i) { const int q = tid + 512 * i; *(LAS u32x4*)(lds + c * 49152 + q * 16) = st[i]; }
    }
    f32x4 S[8];
#pragma unroll
    for (int mt = 0; mt < 8; ++mt) S[mt] = (f32x4){0.f, 0.f, 0.f, 0.f};
    u32x4 nn[4]; u32x4 on[2];
    if (wid < 2) {
#pragma unroll
        for (int i = 0; i < 4; ++i) nn[i] = *(const u32x4*)(GNb + (size_t)(sl * 64 + lane) * 32 + i * 8);
#pragma unroll
        for (int i = 0; i < 2; ++i) on[i] = *(const u32x4*)(GOb + (size_t)(sl * 64 + lane) * 16 + i * 8);
    }
    __syncthreads();
#pragma unroll 1
    for (int c = 0; c < 128; ++c) {
        if (c + 2 < 128) {
#pragma unroll
            for (int i = 0; i < 6; ++i) { const int q = tid + 512 * i; st[i] = (q < 2048) ? GMb[(size_t)(c + 2) * 2048 + q] : GQb[(size_t)(c + 2) * 1024 + (q - 2048)]; }
        }
        if (wid < 2) {
            const float gl = glast[c];
            bf16x8 Sb[4];
#pragma unroll
            for (int ks = 0; ks < 4; ++ks) { u32x4 w; w.x = cvt_pk(S[2 * ks][0], S[2 * ks][1]); w.y = cvt_pk(S[2 * ks][2], S[2 * ks][3]);
                w.z = cvt_pk(S[2 * ks + 1][0], S[2 * ks + 1][1]); w.w = cvt_pk(S[2 * ks + 1][2], S[2 * ks + 1][3]); Sb[ks] = __builtin_bit_cast(bf16x8, w); }
            f32x4 aO[4];
#pragma unroll
            for (int mt = 0; mt < 8; ++mt) { const unsigned w0 = nn[mt >> 1][(mt & 1) * 2], w1 = nn[mt >> 1][(mt & 1) * 2 + 1];
                S[mt] = S[mt] * gl + (f32x4){bflo(w0), bfhi(w0), bflo(w1), bfhi(w1)}; }
#pragma unroll
            for (int mt = 0; mt < 4; ++mt) { const unsigned w0 = on[mt >> 1][(mt & 1) * 2], w1 = on[mt >> 1][(mt & 1) * 2 + 1];
                aO[mt] = (f32x4){bflo(w0), bfhi(w0), bflo(w1), bfhi(w1)}; }
            if (c + 1 < 128) {
#pragma unroll
                for (int i = 0; i < 4; ++i) nn[i] = *(const u32x4*)(GNb + (size_t)(c + 1) * 16384 + (size_t)(sl * 64 + lane) * 32 + i * 8);
#pragma unroll
                for (int i = 0; i < 2; ++i) on[i] = *(const u32x4*)(GOb + (size_t)(c + 1) * 8192 + (size_t)(sl * 64 + lane) * 16 + i * 8);
            }
            const LAS unsigned char* slot = lds + (c % 3) * 49152;
#pragma unroll
            for (int mt = 0; mt < 8; ++mt)
#pragma unroll
                for (int ks = 0; ks < 4; ++ks) S[mt] = mfma16(*(const LAS bf16x8*)(slot + ((mt * 4 + ks) * 64 + lane) * 16), Sb[ks], S[mt]);
#pragma unroll
            for (int mt = 0; mt < 4; ++mt)
#pragma unroll
                for (int ks = 0; ks < 4; ++ks) aO[mt] = mfma16(*(const LAS bf16x8*)(slot + 32768 + ((mt * 4 + ks) * 64 + lane) * 16), Sb[ks], aO[mt]);
            u32x4 o0, o1;
            o0.x = cvt_pk(aO[0][0], aO[0][1]); o0.y = cvt_pk(aO[0][2], aO[0][3]); o0.z = cvt_pk(aO[1][0], aO[1][1]); o0.w = cvt_pk(aO[1][2], aO[1][3]);
            o1.x = cvt_pk(aO[2][0], aO[2][1]); o1.y = cvt_pk(aO[2][2], aO[2][3]); o1.z = cvt_pk(aO[3][0], aO[3][1]); o1.w = cvt_pk(aO[3][2], aO[3][3]);
            bf16_t* op = GOb + (size_t)c * 8192 + (size_t)(sl * 64 + lane) * 16;
            *(u32x4*)op = o0; *(u32x4*)(op + 8) = o1;
        }
        if (c + 2 < 128) {
#pragma unroll
            for (int i = 0; i < 6; ++i) { const int q = tid + 512 * i; *(LAS u32x4*)(lds + ((c + 2) % 3) * 49152 + q * 16) = st[i]; }
        }
        __syncthreads();
    }
    if (wid < 2) {
        float* go = p.out + O_GP + (size_t)bh * 16384;
#pragma unroll
        for (int mt = 0; mt < 8; ++mt)
#pragma unroll
            for (int e = 0; e < 4; ++e) go[(16 * mt + 4 * fq + e) * 128 + sl * 16 + fr] = S[mt][e];
    }
}

__device__ __forceinline__ void gdn_gate_unit(const Params& p, int unit, int lane) {
    const int fr = lane & 15, fq = lane >> 4, bh = unit >> 7, n = unit & 127, b = bh >> 2, h = bh & 3, tok0 = b * SEQ + n * 64;
    const bf16_t* GO = (const bf16_t*)(p.ws + WS_GO) + (size_t)unit * 8192;
    bf16_t* PB = (bf16_t*)(p.ws + WS_H);
    float ssq[16];
#pragma unroll
    for (int k = 0; k < 16; ++k) ssq[k] = 0.f;
#pragma unroll 1
    for (int nt = 0; nt < 8; ++nt) {
        const u32x4 a0 = *(const u32x4*)(GO + (nt * 64 + lane) * 16), a1 = *(const u32x4*)(GO + (nt * 64 + lane) * 16 + 8);
#pragma unroll
        for (int k = 0; k < 4; ++k) { const float l0 = bflo(a0[k]), h0 = bfhi(a0[k]), l1 = bflo(a1[k]), h1 = bfhi(a1[k]);
            ssq[2 * k] += l0 * l0; ssq[2 * k + 1] += h0 * h0; ssq[8 + 2 * k] += l1 * l1; ssq[8 + 2 * k + 1] += h1 * h1; }
    }
#pragma unroll
    for (int k = 0; k < 16; ++k) { float s = ssq[k]; s += __shfl_xor(s, 1); s += __shfl_xor(s, 2); s += __shfl_xor(s, 4); s += __shfl_xor(s, 8); ssq[k] = rsqrtf(s * (1.0f / 128.0f) + EPS); }
    const float* gn = p.in[15];
#pragma unroll 1
    for (int nt = 0; nt < 8; ++nt) {
        const int dv = 16 * nt + fr; const float g = gn[dv];
        const u32x4 a0 = *(const u32x4*)(GO + (nt * 64 + lane) * 16), a1 = *(const u32x4*)(GO + (nt * 64 + lane) * 16 + 8);
        const bf16_t* gzp = PB + (size_t)(tok0 + 4 * fq) * PW + 2304 + h * 128 + dv; bf16_t* mp = PB + (size_t)(tok0 + 4 * fq) * PW + 512 + h * 128 + dv;
#pragma unroll
        for (int k = 0; k < 16; ++k) {
            const unsigned w = (k < 8) ? a0[(k >> 1) & 3] : a1[(k >> 1) & 3]; const float o = (k & 1) ? bfhi(w) : bflo(w);
            const int to = 16 * (k >> 2) + (k & 3);
            const float gz = bf2f(gzp[(size_t)to * PW]);
            mp[(size_t)to * PW] = f2bf(o * ssq[k] * g * silu(gz));
        }
    }
}

__device__ __forceinline__ void attn_unit(const Params& p, LAS unsigned char* lds, int unit) {
    const int tid = threadIdx.x, lane = tid & 63, wid = tid >> 6, fr = lane & 15, fq = lane >> 4;
    const int b = unit >> 7, blk = (unit >> 1) & 63, kvh = unit & 1;
    LAS bf16_t* Ks = (LAS bf16_t*)lds; LAS bf16_t* Vt = (LAS bf16_t*)(lds + 36864);
    bf16_t* PB = (bf16_t*)(p.ws + WS_H);
    __syncthreads();
#pragma unroll
    for (int i = 0; i < 4; ++i) {
        const int q = tid + 512 * i, row = q >> 3, ch = q & 7, tp = blk * 128 - 128 + row;
        u32x4 kv = (u32x4){0u, 0u, 0u, 0u}, vv = (u32x4){0u, 0u, 0u, 0u};
        if (tp >= 0) { const bf16_t* base = PB + (size_t)(b * SEQ + tp) * PW; kv = *(const u32x4*)(base + 512 + kvh * 64 + ch * 8); vv = *(const u32x4*)(base + 640 + kvh * 64 + ch * 8); }
        *(LAS u32x4*)(Ks + row * 72 + ch * 8) = kv;
#pragma unroll
        for (int e = 0; e < 4; ++e) { const unsigned w = vv[e]; Vt[(ch * 8 + 2 * e) * 264 + row] = (bf16_t)(w & 0xffffu); Vt[(ch * 8 + 2 * e + 1) * 264 + row] = (bf16_t)(w >> 16); }
    }
    __syncthreads();
    const int qtok = b * SEQ + blk * 128 + 16 * wid + fr;
#pragma unroll 1
    for (int g = 0; g < 4; ++g) {
        const int h = kvh * 4 + g; const float slope = exp2f(-(float)(h + 1)), sink = p.in[11][h];
        bf16x8 qf[2];
#pragma unroll
        for (int ks = 0; ks < 2; ++ks) qf[ks] = *(const bf16x8*)(PB + (size_t)qtok * PW + h * 64 + ks * 32 + 8 * fq);
        f32x4 s[10]; float mx = sink;
#pragma unroll
        for (int j = 0; j < 10; ++j) {
            const int ct = (wid + j) < 15 ? (wid + j) : 15;
            f32x4 acc = (f32x4){0.f, 0.f, 0.f, 0.f};
#pragma unroll
            for (int ks = 0; ks < 2; ++ks) acc = mfma16(*(const LAS bf16x8*)(Ks + (16 * ct + fr) * 72 + ks * 32 + 8 * fq), qf[ks], acc);
#pragma unroll
            for (int e = 0; e < 4; ++e) {
                const int c = 16 * (wid + j) + 4 * fq + e, dist = 16 * wid + fr - c + 128;
                const bool ok = (wid + j <= 15) && dist >= 0 && dist <= 128 && (blk * 128 + c - 128 >= 0);
                const float v = ok ? acc[e] * 0.125f - slope * (float)dist : -INFINITY;
                acc[e] = v; mx = fmaxf(mx, v);
            }
            s[j] = acc;
            asm volatile("" ::: "memory");
        }
        mx = fmaxf(mx, __shfl_xor(mx, 16)); mx = fmaxf(mx, __shfl_xor(mx, 32));
        float sum = 0.f;
#pragma unroll
        for (int j = 0; j < 10; ++j)
#pragma unroll
            for (int e = 0; e < 4; ++e) { const float pv = __expf(s[j][e] - mx); s[j][e] = pv; sum += pv; }
        sum += __shfl_xor(sum, 16); sum += __shfl_xor(sum, 32);
        sum += __expf(sink - mx);
        const float inv = 1.0f / sum;
        bf16x8 pb[5];
#pragma unroll
        for (int kk = 0; kk < 5; ++kk) { u32x4 w; w.x = cvt_pk(s[2 * kk][0] * inv, s[2 * kk][1] * inv); w.y = cvt_pk(s[2 * kk][2] * inv, s[2 * kk][3] * inv);
            w.z = cvt_pk(s[2 * kk + 1][0] * inv, s[2 * kk + 1][1] * inv); w.w = cvt_pk(s[2 * kk + 1][2] * inv, s[2 * kk + 1][3] * inv); pb[kk] = __builtin_bit_cast(bf16x8, w); }
#pragma unroll
        for (int dt = 0; dt < 4; ++dt) {
            f32x4 acc = (f32x4){0.f, 0.f, 0.f, 0.f};
#pragma unroll
            for (int kk = 0; kk < 5; ++kk) {
                const int c0 = (wid + 2 * kk) < 15 ? (wid + 2 * kk) : 15, c1 = (wid + 2 * kk + 1) < 15 ? (wid + 2 * kk + 1) : 15;
                const u32x2 lo = *(const LAS u32x2*)(Vt + (16 * dt + fr) * 264 + 16 * c0 + 4 * fq), hi = *(const LAS u32x2*)(Vt + (16 * dt + fr) * 264 + 16 * c1 + 4 * fq);
                const u32x4 a = (u32x4){lo.x, lo.y, hi.x, hi.y};
                acc = mfma16(__builtin_bit_cast(bf16x8, a), pb[kk], acc);
            }
            u32x2 w; w.x = cvt_pk(acc[0], acc[1]); w.y = cvt_pk(acc[2], acc[3]);
            *(u32x2*)(PB + (size_t)qtok * PW + h * 64 + 16 * dt + 4 * fq) = w;
            asm volatile("" ::: "memory");
        }
    }
}

__device__ __forceinline__ void sattn_unit(const Params& p, int su, int lane) {
    const int s = su >> 1, kvh = su & 1;
    bf16_t* PB = (bf16_t*)(p.ws + WS_H) + (size_t)(MPR + s) * PW;
    const float* ck = p.in[2] + (size_t)s * 128 * 128 + kvh * 64 + lane; const float* cv = p.in[3] + (size_t)s * 128 * 128 + kvh * 64 + lane;
    float* nk = p.out + O_KS + (size_t)s * 128 * 128 + kvh * 64 + lane; float* nv = p.out + O_VS + (size_t)s * 128 * 128 + kvh * 64 + lane;
    float q[4], slope[4], sink[4], sc[4][3];
#pragma unroll
    for (int g = 0; g < 4; ++g) { const int h = kvh * 4 + g; q[g] = bf2f(PB[h * 64 + lane]) * 0.125f; slope[g] = exp2f(-(float)(h + 1)); sink[g] = p.in[11][h]; }
    const float knew = bf2f(PB[512 + kvh * 64 + lane]), vnew = bf2f(PB[640 + kvh * 64 + lane]);
#pragma unroll
    for (int t = 0; t < 2; ++t) {
#pragma unroll 4
        for (int jj = 0; jj < 64; ++jj) {
            const int j = t * 64 + jj; const float kval = ck[(size_t)j * 128];
            if (j >= 1) nk[(size_t)(j - 1) * 128] = kval;
#pragma unroll
            for (int g = 0; g < 4; ++g) { const float d = wave_sum(q[g] * kval) - slope[g] * (float)(128 - j); if (lane == jj) sc[g][t] = d; }
        }
    }
    nk[(size_t)127 * 128] = knew;
    float o[4], inv[4], pl[4][3];
#pragma unroll
    for (int g = 0; g < 4; ++g) {
        sc[g][2] = wave_sum(q[g] * knew);
        const float mx = fmaxf(fmaxf(wave_max(fmaxf(sc[g][0], sc[g][1])), sc[g][2]), sink[g]);
        pl[g][0] = __expf(sc[g][0] - mx); pl[g][1] = __expf(sc[g][1] - mx); pl[g][2] = __expf(sc[g][2] - mx);
        inv[g] = 1.0f / (wave_sum(pl[g][0] + pl[g][1]) + pl[g][2] + __expf(sink[g] - mx));
        o[g] = pl[g][2] * vnew;
    }
#pragma unroll
    for (int t = 0; t < 2; ++t) {
#pragma unroll 4
        for (int jj = 0; jj < 64; ++jj) {
            const int j = t * 64 + jj; const float vval = cv[(size_t)j * 128];
            if (j >= 1) nv[(size_t)(j - 1) * 128] = vval;
#pragma unroll
            for (int g = 0; g < 4; ++g) o[g] += __shfl(pl[g][t], jj) * vval;
        }
    }
    nv[(size_t)127 * 128] = vnew;
#pragma unroll
    for (int g = 0; g < 4; ++g) PB[(kvh * 4 + g) * 64 + lane] = f2bf(o[g] * inv[g]);
}

__device__ __forceinline__ void sgdn_unit(const Params& p, LAS unsigned char* lds, int s) {
    const int tid = threadIdx.x, wid = tid >> 6, h = tid >> 7, dv = tid & 127;
    LAS float* qs = (LAS float*)lds; LAS float* ks = qs + 512; LAS float* red = ks + 512;
    bf16_t* PB = (bf16_t*)(p.ws + WS_H) + (size_t)(MPR + s) * PW; const float* GBA = (const float*)(p.ws + WS_GBA) + (size_t)(MPR + s) * 8;
    const float* cw = p.in[12]; const float* hc = p.in[4] + (size_t)s * 3 * CONVC; float* nc = p.out + O_CS + (size_t)s * 3 * CONVC;
    __syncthreads();
    float val[3];
#pragma unroll
    for (int i = 0; i < 3; ++i) {
        const int c = i * 512 + tid; const float x3 = bf2f(PB[768 + c]), h0 = hc[c], h1 = hc[CONVC + c], h2 = hc[2 * CONVC + c];
        val[i] = silu(cw[c] * h0 + cw[CONVC + c] * h1 + cw[2 * CONVC + c] * h2 + cw[3 * CONVC + c] * x3);
        nc[c] = h1; nc[CONVC + c] = h2; nc[2 * CONVC + c] = x3;
    }
    const float sq = wave_sum(val[0] * val[0]), sk = wave_sum(val[1] * val[1]);
    if ((tid & 63) == 0) { red[wid] = sq; red[8 + wid] = sk; }
    __syncthreads();
    const float ssq = red[2 * h] + red[2 * h + 1], ssk = red[8 + 2 * h] + red[8 + 2 * h + 1];
    qs[tid] = val[0] * rsqrtf(ssq + EPS) * 0.08838834764831845f; ks[tid] = val[1] * rsqrtf(ssk + EPS);
    __syncthreads();
    const float beta = 1.0f / (1.0f + __expf(-GBA[h]));
    const float x = GBA[4 + h] + p.in[14][h]; const float sp = x > 20.f ? x : log1pf(__expf(x));
    const float eg = __expf(-__expf(p.in[13][h]) * sp);
    const float* S0 = p.in[5] + ((size_t)(s * 4 + h) * 128) * 128 + dv; float* S1 = p.out + O_GS + ((size_t)(s * 4 + h) * 128) * 128 + dv;
    float kS = 0.f;
#pragma unroll 8
    for (int dk = 0; dk < 128; ++dk) kS += ks[h * 128 + dk] * S0[(size_t)dk * 128];
    const float delta = beta * (val[2] - eg * kS);
    float o = 0.f;
#pragma unroll 8
    for (int dk = 0; dk < 128; ++dk) { const float sv = eg * S0[(size_t)dk * 128] + ks[h * 128 + dk] * delta; S1[(size_t)dk * 128] = sv; o += qs[h * 128 + dk] * sv; }
    const float so = wave_sum(o * o);
    if ((tid & 63) == 0) red[16 + wid] = so;
    __syncthreads();
    const float tot = red[16 + 2 * h] + red[16 + 2 * h + 1];
    const float gz = bf2f(PB[2304 + tid]);
    PB[512 + tid] = f2bf(o * rsqrtf(tot * (1.0f / 128.0f) + EPS) * p.in[15][dv] * silu(gz));
}

__global__ void __launch_bounds__(512, 2) fwd_kernel(Params p, int ph_lo, int ph_hi) {
    extern __shared__ __attribute__((aligned(16))) unsigned char lds_raw[];
    LAS unsigned char* lds = (LAS unsigned char*)lds_raw;
    cg::grid_group grid = cg::this_grid();
    const int tid = threadIdx.x, lane = tid & 63, wid = tid >> 6, G = gridDim.x, bx = blockIdx.x;
    unsigned char* ws = p.ws;
    bf16_t* XN = (bf16_t*)(ws + WS_XN); bf16_t* XN2 = (bf16_t*)(ws + WS_XN2); bf16_t* HB = (bf16_t*)(ws + WS_H);
    float* SS1 = (float*)(ws + WS_SSP1); float* SS2 = (float*)(ws + WS_SSP2);
    float* Y = p.out; float* X2 = (float*)(ws + WS_GM); float* X3 = (float*)(ws + WS_XN);
#ifndef PHMASK
#define PHMASK 0x7ff
#endif
#define IN(k) (((PHMASK >> (k)) & 1) && ph_lo <= (k) && (k) < ph_hi)
#define SEAM(k) do { if (IN(k) && IN((k) + 1)) { __threadfence(); asm volatile("s_waitcnt vmcnt(0) lgkmcnt(0)" ::: "memory"); grid.sync(); } } while (0)

    if (IN(0)) p0_prologue(p, lds, bx, G);
    SEAM(0);
    if (IN(1)) {
        pg8::Gemm g{XN, (const bf16_t*)(ws + WS_W1IN), MPAD, 2 * DFF, DM, DM}; pg8::StaticOrder S; S.init(MPAD, 2 * DFF, G, bx);
        EpiSwiglu E{HB, nullptr}; pg8::gemm_phase<EpiSwiglu, pg8::StaticOrder>(lds, g, S, E, nullptr);
    }
    SEAM(1);
    if (IN(2)) {
        pg8::Gemm g{HB, (const bf16_t*)(ws + WS_W1OUT), MPAD, DM, DFF, DFF}; pg8::StaticOrder S; S.init(MPAD, DM, G, bx);
        EpiResid<false, false, true, true, true> E{p.in[0], p.in[1], nullptr, XN, SS1}; pg8::gemm_phase<EpiResid<false, false, true, true, true>, pg8::StaticOrder>(lds, g, S, E, nullptr);
    }
    SEAM(2);
    if (IN(3)) {
        pg8::Gemm g{XN, (const bf16_t*)(ws + WS_WINMIX), MPAD, NINP, DM, DM}; pg8::StaticOrder S; S.init(MPAD, NINP, G, bx);
        EpiInproj E{HB, (float*)(ws + WS_GBA), SS1}; pg8::gemm_phase<EpiInproj, pg8::StaticOrder>(lds, g, S, E, nullptr);
    }
    SEAM(3);
    if (IN(4)) {
        for (int u = bx; u < 2048; u += G) gdn_prep_unit(p, lds, u);
    }
    SEAM(4);
    if (IN(5)) {
#ifndef P5MASK
#define P5MASK 31
#endif
        if (bx < NSCAN) { if (P5MASK & 1) gdn_scan(p, lds, bx); }
        else {
            const int ab = bx - NSCAN, NAB = G - NSCAN;
            int it = ab;
#pragma unroll 1
            for (; it < 512; it += NAB) { if (P5MASK & 2) attn_unit(p, lds, it); }
#pragma unroll 1
            for (; it < 640; it += NAB) {
                if (wid < 2) sattn_unit(p, (it - 512) * 2 + wid, lane);
                sgdn_unit(p, lds, it - 512); }
            const bf16_t* PB = HB;
            for (int idx = ab * 512 + tid; idx < 149504; idx += NAB * 512) {
                if (idx < 131072) { const int w = idx >> 16, r = idx & 65535, b = r >> 14, j = (r >> 7) & 127, c = r & 127;
                    p.out[(w ? O_VP : O_KP) + r] = bf2f(PB[(size_t)(b * SEQ + SEQ - 128 + j) * PW + 512 + w * 128 + c]);
                } else { const int r = idx - 131072, b = r / (3 * CONVC), q = r % (3 * CONVC), rr = q / CONVC, c = q % CONVC;
                    p.out[O_CP + r] = bf2f(PB[(size_t)(b * SEQ + SEQ - 3 + rr) * PW + 768 + c]); }
            }
        }
    }
    SEAM(5);
    if (IN(6)) {
        for (int u = bx * 8 + wid; u < 2048; u += G * 8) gdn_gate_unit(p, u, lane);
    }
    SEAM(6);
#ifdef DBG_DUMP
    if (ph_lo == 11) {
        const float* src = (const float*)(ws + DBG_SRC);
        for (size_t i = (size_t)bx * 512 + tid; i < (size_t)MREAL * DM; i += (size_t)G * 512) Y[i] = (i < (size_t)MREAL * 8) ? ((const float*)(ws + WS_GBA))[i] : 0.f;
    }
#endif
    if (IN(7)) {
        pg8::Gemm g{HB, (const bf16_t*)(ws + WS_WOUTMIX), MPAD, DM, DM, PW}; pg8::StaticOrder S; S.init(MPAD, DM, G, bx);
        EpiResid<true, true, true, true, false> E{XN, XN + (size_t)MPR * DM, X2, XN2, SS2}; pg8::gemm_phase<EpiResid<true, true, true, true, false>, pg8::StaticOrder>(lds, g, S, E, nullptr);
    }
    SEAM(7);
    if (IN(8)) {
        pg8::Gemm g{XN2, (const bf16_t*)(ws + WS_W2IN), MPAD, 2 * DFF, DM, DM}; pg8::StaticOrder S; S.init(MPAD, 2 * DFF, G, bx);
        EpiSwiglu E{HB, SS2}; pg8::gemm_phase<EpiSwiglu, pg8::StaticOrder>(lds, g, S, E, nullptr);
    }
    SEAM(8);
    if (IN(9)) {
        pg8::Gemm g{HB, (const bf16_t*)(ws + WS_W2OUT), MPAD, DM, DFF, DFF}; pg8::StaticOrder S; S.init(MPAD, DM, G, bx);
        EpiResid<false, true, false, false, true> E{X2, X2 + (size_t)MPR * DM, X3, nullptr, nullptr}; pg8::gemm_phase<EpiResid<false, true, false, false, true>, pg8::StaticOrder>(lds, g, S, E, nullptr);
    }
    SEAM(9);
    if (IN(10)) {
        const float* gf = p.in[20]; f32x4 gv[4];
#pragma unroll
        for (int j = 0; j < 4; ++j) gv[j] = *((const f32x4*)gf + lane + 64 * j);
        for (int m = bx * 8 + wid; m < MREAL; m += G * 8) {
            const f32x4* xr = (const f32x4*)(X3 + (size_t)m * DM) + lane; f32x4* yr = (f32x4*)(Y + (size_t)m * DM) + lane; f32x4 v[4]; float s = 0.f;
#pragma unroll
            for (int j = 0; j < 4; ++j) { v[j] = xr[64 * j]; s += (v[j][0] * v[j][0] + v[j][1] * v[j][1]) + (v[j][2] * v[j][2] + v[j][3] * v[j][3]); }
            const float rstd = rsqrtf(wave_sum(s) * (1.0f / DM) + EPS);
#pragma unroll
            for (int j = 0; j < 4; ++j) yr[64 * j] = v[j] * rstd * gv[j];
        }
    }
#undef IN
#undef SEAM
}
}

#ifndef MK_N_LAUNCHES
#define MK_N_LAUNCHES 1
#endif
extern "C" void kernel_launch(void* const* d_in, const int* in_sizes, int n_in, void* d_out, int out_size, void* d_ws, size_t ws_size, hipStream_t stream) {
    static int grid = 0;
    if (grid == 0) {
        if (n_in != 21 || ws_size < mk::WS_END || out_size != 47269888) { fprintf(stderr, "kernel_launch: unexpected shapes (n_in %d, ws %zu, out %d)\n", n_in, ws_size, out_size); grid = -1; return; }
        int dev = 0, cus = 0, per_cu = 0;
        (void)hipGetDevice(&dev); (void)hipDeviceGetAttribute(&cus, hipDeviceAttributeMultiprocessorCount, dev);
        if (hipFuncSetAttribute((const void*)mk::fwd_kernel, hipFuncAttributeMaxDynamicSharedMemorySize, mk::LDS_BYTES) != hipSuccess) { fprintf(stderr, "kernel_launch: hipFuncSetAttribute failed\n"); grid = -1; return; }
        if (hipOccupancyMaxActiveBlocksPerMultiprocessor(&per_cu, (const void*)mk::fwd_kernel, 512, mk::LDS_BYTES) != hipSuccess || per_cu < 1) { fprintf(stderr, "kernel_launch: occupancy query failed (%d)\n", per_cu); per_cu = 1; }
        (void)hipGetLastError();
        grid = cus * per_cu;
        if (grid <= mk::NSCAN) { fprintf(stderr, "kernel_launch: grid %d too small\n", grid); grid = -1; return; }
    }
    if (grid < 0) return;
    mk::Params p{};
    for (int i = 0; i < 21; ++i) p.in[i] = (const float*)d_in[i];
    p.out = (float*)d_out; p.ws = (unsigned char*)d_ws;
#if MK_N_LAUNCHES == 1
    int lo = 0, hi = 11; void* args[] = {&p, &lo, &hi};
    hipError_t e = hipLaunchCooperativeKernel((const void*)mk::fwd_kernel, dim3(grid), dim3(512), args, mk::LDS_BYTES, stream);
    if (e != hipSuccess) fprintf(stderr, "kernel_launch: cooperative launch failed: %s (grid %d)\n", hipGetErrorString(e), grid);
#else
#ifndef MK_LAST
#define MK_LAST 11
#define DBG_C0 512
#define DBG_C1 1024
#endif
    for (int ph = 0; ph < MK_LAST; ++ph) { hipLaunchKernelGGL(mk::fwd_kernel, dim3(grid), dim3(512), mk::LDS_BYTES, stream, p, ph, ph + 1); }
#ifdef DBG_DUMP
    hipLaunchKernelGGL(mk::fwd_kernel, dim3(grid), dim3(512), mk::LDS_BYTES, stream, p, 11, 12);
#endif
#endif
}
```

```cpp
#include <hip/hip_runtime.h>
#include <hip/hip_cooperative_groups.h>
#include <cstdio>
namespace cg = cooperative_groups;
namespace pg8 {
#define PG8_LAS __attribute__((address_space(3)))
typedef unsigned short bf16_t;
typedef short bf16x8 __attribute__((ext_vector_type(8)));
typedef float f32x4 __attribute__((ext_vector_type(4)));
typedef unsigned u32x4 __attribute__((ext_vector_type(4)));
constexpr int BM = 256, BK = 64, HALF = 128, HTB = HALF * BK * 2  , STAGE_BYTES = 8 * HTB, NXCD = 8, WGM = 8;

__host__ __device__ __forceinline__ int lds_byte(int r, int c) { const int st = (r >> 4) * 2 + (c >> 5), rr = r & 15, cc = c & 31, ob = rr * 64 + cc * 2; return st * 1024 + (ob ^ (((ob >> 9) & 1) << 5)); }
__host__ __device__ __forceinline__ void stage_rc(int b, int& R, int& C) { const int st = b / 1024, sb = b % 1024, swz = sb ^ (((sb >> 9) & 1) << 5); R = (st >> 1) * 16 + swz / 64; C = (st & 1) * 32 + (swz % 64) / 2; }
__host__ __device__ __forceinline__ int perm32(int rho) { const int n = rho >> 4, i = rho & 15; return 8 * (i >> 2) + 4 * n + (i & 3); }

struct Unit { int pm, pn; };
struct Gemm { const bf16_t* A; const bf16_t* Bt; int M, N, K, lda; };

struct StaticOrder {
    int nM, nN, nwg, G, c;
    __host__ __device__ void init(int M, int N, int G_, int c_) { nM = M / BM; nN = N / BM; nwg = nM * nN; G = G_; c = c_; }
    __host__ __device__ bool next(int i, Unit& u) const {
        const long L = (long)i * G + c; if (L >= nwg) return false;
        int wgid = (int)L; { const int q = nwg / NXCD, r = nwg % NXCD, xcd = wgid % NXCD, off = wgid / NXCD; wgid = (xcd < r ? xcd * (q + 1) : r * (q + 1) + (xcd - r) * q) + off; }
        const int nig = WGM * nN, gid = wgid / nig, fm = gid * WGM, gsz = (nM - fm) < WGM ? (nM - fm) : WGM;
        u.pm = fm + ((wgid % nig) % gsz); u.pn = (wgid % nig) / gsz; return true;
    }
    __device__ __forceinline__ void a_ready(const Unit&) const {}
    __device__ __forceinline__ void done(const Unit&) const {}
};
struct CountedOrder : StaticOrder {
    const unsigned* ready; unsigned need; unsigned* tmo;
    __device__ __forceinline__ void a_ready(const Unit& u) const {
        if (threadIdx.x < 64) {
            const unsigned long long t0 = __builtin_amdgcn_s_memrealtime(); unsigned polls = 0;
            while ((unsigned)__builtin_amdgcn_readfirstlane(__hip_atomic_load(ready + 64 * u.pm, __ATOMIC_RELAXED, __HIP_MEMORY_SCOPE_AGENT)) < need) {
                if ((++polls & 255u) == 0u && __builtin_amdgcn_readfirstlane(__hip_atomic_load(tmo, __ATOMIC_RELAXED, __HIP_MEMORY_SCOPE_AGENT)) != 0u) break;
                if (__builtin_amdgcn_s_memrealtime() - t0 > 2000000ull) {
                    if (threadIdx.x == 0) { unsigned expect = 0u; __hip_atomic_compare_exchange_strong(tmo + 1, &expect, 0x600u | (unsigned)(u.pm & 0xff), __ATOMIC_RELAXED, __ATOMIC_RELAXED, __HIP_MEMORY_SCOPE_AGENT); __hip_atomic_store(tmo, 1u, __ATOMIC_RELAXED, __HIP_MEMORY_SCOPE_AGENT); }
                    break; }
                __builtin_amdgcn_s_sleep(2); }
            __builtin_amdgcn_fence(__ATOMIC_ACQUIRE, "agent");
            asm volatile("s_waitcnt vmcnt(0)" ::: "memory");
        }
#if !defined(BROKEN_HOOK_NO_BARRIER)
        asm volatile("" ::: "memory"); __builtin_amdgcn_s_barrier(); asm volatile("" ::: "memory");
#endif
    }
};

__device__ __forceinline__ unsigned cvt_pk_bf16(float lo, float hi) { unsigned r; asm volatile("v_cvt_pk_bf16_f32 %0, %1, %2" : "=v"(r) : "v"(lo), "v"(hi)); return r; }
typedef float f32x2 __attribute__((ext_vector_type(2)));
__device__ __forceinline__ f32x2 gelu_pk(f32x2 v) {
    const f32x2 av = __builtin_elementwise_abs(v), d = av * 0.2316418882f + 1.0f;
    f32x2 t; t.x = __builtin_amdgcn_rcpf(d.x); t.y = __builtin_amdgcn_rcpf(d.y);
    f32x2 q = t * 0.5307027145f + (-0.7265760135f); q = q * t + 0.7107068705f; q = q * t + (-0.142248368f); q = q * t + 0.127414796f; q = q * t;
    const f32x2 s = (v * v) * (-0.72134752044f);
    f32x2 e; e.x = __builtin_amdgcn_exp2f(s.x); e.y = __builtin_amdgcn_exp2f(s.y);
    const f32x2 m = v * (q * e), r = v - m;
    f32x2 o; o.x = v.x < 0.f ? m.x : r.x; o.y = v.y < 0.f ? m.y : r.y; return o;
}

struct EpiF32 {
    static constexpr bool PERM = false, AFTER_DRAIN = false;
    float* C; int ldc; const float* bias;
    __device__ __forceinline__ void operator()(const f32x4 (&acc)[2][2][4][2], const Unit& u, int wr, int wc, int fr, int fq) const {
        const int row0 = u.pm * BM + wr * 64 + fr, col0 = u.pn * BM + wc * 32 + 4 * fq;
        f32x4 bv[2][2];
#pragma unroll
        for (int bj = 0; bj < 2; ++bj)
#pragma unroll
            for (int n = 0; n < 2; ++n) bv[bj][n] = bias ? *(const f32x4*)(bias + col0 + bj * HALF + n * 16) : (f32x4){0.f, 0.f, 0.f, 0.f};
#pragma unroll
        for (int ai = 0; ai < 2; ++ai)
#pragma unroll
            for (int m = 0; m < 4; ++m) { float* rowp = C + (size_t)(row0 + ai * HALF + m * 16) * ldc + col0;
#pragma unroll
                for (int bj = 0; bj < 2; ++bj)
#pragma unroll
                    for (int n = 0; n < 2; ++n) *(f32x4*)(rowp + bj * HALF + n * 16) = acc[ai][bj][m][n] + bv[bj][n]; }
    }
};
template <int ACT  > struct EpiBf16 {
    static constexpr bool PERM = true, AFTER_DRAIN = false;
    bf16_t* O; int ldc; const float* bias; int split_cols; size_t split_stride;
    __device__ __forceinline__ void operator()(const f32x4 (&acc)[2][2][4][2], const Unit& u, int wr, int wc, int fr, int fq) const {
        const int row0 = u.pm * BM + wr * 64 + fr; int colt = u.pn * BM; bf16_t* base = O;
        if (split_cols) { const int t = colt / split_cols; base += (size_t)t * split_stride; colt -= t * split_cols; }
        const int col0 = colt + wc * 32 + 8 * fq, bcol0 = u.pn * BM + wc * 32 + 8 * fq;
        f32x4 bv[2][2];
#pragma unroll
        for (int bj = 0; bj < 2; ++bj)
#pragma unroll
            for (int n = 0; n < 2; ++n) bv[bj][n] = bias ? *(const f32x4*)(bias + bcol0 + bj * HALF + 4 * n) : (f32x4){0.f, 0.f, 0.f, 0.f};
#pragma unroll
        for (int ai = 0; ai < 2; ++ai)
#pragma unroll
            for (int m = 0; m < 4; ++m) { bf16_t* rowp = base + (size_t)(row0 + ai * HALF + m * 16) * ldc + col0;
#pragma unroll
                for (int bj = 0; bj < 2; ++bj) { f32x4 v0 = acc[ai][bj][m][0] + bv[bj][0], v1 = acc[ai][bj][m][1] + bv[bj][1];
                    if (ACT == 1) { f32x2 a = gelu_pk((f32x2){v0[0], v0[1]}), b = gelu_pk((f32x2){v0[2], v0[3]}), c = gelu_pk((f32x2){v1[0], v1[1]}), d = gelu_pk((f32x2){v1[2], v1[3]});
                        v0 = (f32x4){a.x, a.y, b.x, b.y}; v1 = (f32x4){c.x, c.y, d.x, d.y}; }
                    if (ACT == 2) {
#pragma unroll
                        for (int j = 0; j < 4; ++j) { v0[j] = 0.5f * v0[j] * (1.0f + erff(v0[j] * 0.70710678f)); v1[j] = 0.5f * v1[j] * (1.0f + erff(v1[j] * 0.70710678f)); } }
                    u32x4 w; w.x = cvt_pk_bf16(v0[0], v0[1]); w.y = cvt_pk_bf16(v0[2], v0[3]); w.z = cvt_pk_bf16(v1[0], v1[1]); w.w = cvt_pk_bf16(v1[2], v1[3]);
                    *(u32x4*)(rowp + bj * HALF) = w; } }
    }
};

struct PanelStats {
    unsigned* xbuf;
    unsigned* cnt;
    unsigned* tmo;
    int ntn; float eps;
    unsigned code;
    __device__ __forceinline__ bool run(const f32x4 (&v)[2][2][4][2], const Unit& u, int wr, int wc, int fr, int fq, PG8_LAS unsigned char* lds, int wid, int lane) const {
        typedef float f32x2v __attribute__((ext_vector_type(2)));
        PG8_LAS f32x2v* P = (PG8_LAS f32x2v*)lds;
        PG8_LAS f32x2v* S = (PG8_LAS f32x2v*)(lds + 8192);
        PG8_LAS unsigned* flag = (PG8_LAS unsigned*)(lds + 8192 + 2048);
#pragma unroll
        for (int ai = 0; ai < 2; ++ai)
#pragma unroll
            for (int m = 0; m < 4; ++m) {
                float s = 0.f;
#pragma unroll
                for (int bj = 0; bj < 2; ++bj)
#pragma unroll
                    for (int n = 0; n < 2; ++n) { const f32x4 x = v[ai][bj][m][n]; s += (x[0] + x[1]) + (x[2] + x[3]); }
                s += __shfl_xor(s, 16); s += __shfl_xor(s, 32);
                const float mw = s * (1.0f / 64.0f); float q = 0.f;
#pragma unroll
                for (int bj = 0; bj < 2; ++bj)
#pragma unroll
                    for (int n = 0; n < 2; ++n) { const f32x4 d = v[ai][bj][m][n] - mw; q += (d[0] * d[0] + d[1] * d[1]) + (d[2] * d[2] + d[3] * d[3]); }
                q += __shfl_xor(q, 16); q += __shfl_xor(q, 32);
                if (fq == 0) P[(ai * HALF + wr * 64 + m * 16 + fr) * 4 + wc] = (f32x2v){mw, q};
            }
        asm volatile("s_waitcnt lgkmcnt(0)" ::: "memory"); __builtin_amdgcn_s_barrier(); asm volatile("" ::: "memory");
#if defined(BROKEN_NO_WAIT)
        if (blockIdx.x >= 64) { const long long t0 = clock64(); while (clock64() - t0 < 60000) __builtin_amdgcn_s_sleep(8); }
#endif
        const int row = wid * 32 + (lane & 31);
        if (lane < 32) {
            const f32x2v a = P[row * 4 + 0], b = P[row * 4 + 1], c = P[row * 4 + 2], d = P[row * 4 + 3];
            const float mt = (a.x + b.x + c.x + d.x) * 0.25f;
            const float da = a.x - mt, db = b.x - mt, dc = c.x - mt, dd = d.x - mt;
            const float m2 = (a.y + b.y) + (c.y + d.y) + 64.0f * ((da * da + db * db) + (dc * dc + dd * dd));
            unsigned long long* slot = (unsigned long long*)xbuf + ((size_t)(u.pm * BM + row) * 4 + u.pn);
            __hip_atomic_store(slot, ((unsigned long long)__float_as_uint(m2) << 32) | __float_as_uint(mt), __ATOMIC_RELAXED, __HIP_MEMORY_SCOPE_AGENT);
        }
        asm volatile("s_waitcnt vmcnt(0)" ::: "memory");
        if (lane == 0) __hip_atomic_fetch_add(cnt + 64 * u.pm, 1u, __ATOMIC_RELAXED, __HIP_MEMORY_SCOPE_AGENT);
        if (wid == 0) {
            bool dead = false; const unsigned long long t0 = __builtin_amdgcn_s_memrealtime(); const unsigned want = 8u * (unsigned)ntn;
            for (;;) {
#if defined(BROKEN_NO_WAIT)
                break;
#endif
                if ((unsigned)__builtin_amdgcn_readfirstlane(__hip_atomic_load(cnt + 64 * u.pm, __ATOMIC_RELAXED, __HIP_MEMORY_SCOPE_AGENT)) >= want) break;
                if (__builtin_amdgcn_s_memrealtime() - t0 > 2000000ull) {
                    if (lane == 0) { unsigned expect = 0u; __hip_atomic_compare_exchange_strong(tmo + 1, &expect, code | (unsigned)(u.pm & 0xff), __ATOMIC_RELAXED, __ATOMIC_RELAXED, __HIP_MEMORY_SCOPE_AGENT);
                                     __hip_atomic_store(tmo, 1u, __ATOMIC_RELAXED, __HIP_MEMORY_SCOPE_AGENT); }
                    dead = true; break; }
                __builtin_amdgcn_s_sleep(2);
            }
            __builtin_amdgcn_fence(__ATOMIC_ACQUIRE, "agent");
            if (lane == 0) flag[0] = dead ? 1u : 0u;
        }
        asm volatile("s_waitcnt vmcnt(0) lgkmcnt(0)" ::: "memory"); __builtin_amdgcn_s_barrier(); asm volatile("" ::: "memory");
        const bool bad = flag[0] != 0u;
        if (lane < 32) {
            const unsigned long long* slot = (const unsigned long long*)xbuf + (size_t)(u.pm * BM + row) * 4; float mt[4], m2[4]; float ms = 0.f;
#pragma unroll
            for (int t = 0; t < 4; ++t) { if (t < ntn) { const unsigned long long w = __hip_atomic_load(slot + t, __ATOMIC_RELAXED, __HIP_MEMORY_SCOPE_AGENT); mt[t] = __uint_as_float((unsigned)w); m2[t] = __uint_as_float((unsigned)(w >> 32)); } else { mt[t] = 0.f; m2[t] = 0.f; } ms += mt[t]; }
            const float mean = ms / (float)ntn; float q = 0.f;
#pragma unroll
            for (int t = 0; t < 4; ++t) if (t < ntn) { const float dm = mt[t] - mean; q += m2[t] + 256.0f * dm * dm; }
            S[row] = (f32x2v){mean, 1.0f / sqrtf(q / (256.0f * (float)ntn) + eps)};
        }
        asm volatile("s_waitcnt lgkmcnt(0)" ::: "memory"); __builtin_amdgcn_s_barrier(); asm volatile("" ::: "memory");
        return bad;
    }
};
struct EpiLnRes {
    static constexpr bool PERM = false, AFTER_DRAIN = true;
    const float* base; float* out; int ldc; const float* bias; PanelStats st; unsigned poison;
    __device__ __forceinline__ void refuse(size_t i0, size_t stride, int M, int N) const { const float q = __builtin_nanf(""); for (size_t i = i0; i < (size_t)M * N; i += stride) out[(i / N) * ldc + i % N] = q;
        if (i0 == 0) { unsigned expect = 0u; __hip_atomic_compare_exchange_strong(st.tmo + 1, &expect, 0x7f0u, __ATOMIC_RELAXED, __ATOMIC_RELAXED, __HIP_MEMORY_SCOPE_AGENT); __hip_atomic_store(st.tmo, 1u, __ATOMIC_RELAXED, __HIP_MEMORY_SCOPE_AGENT); } }
    __device__ __forceinline__ void fused(f32x4 (&acc)[2][2][4][2], const Unit& u, int wr, int wc, int fr, int fq, PG8_LAS unsigned char* lds, int wid, int lane) const {
        typedef float f32x2v __attribute__((ext_vector_type(2)));
        const PG8_LAS f32x2v* S = (const PG8_LAS f32x2v*)(lds + 8192);
        const int col0 = u.pn * BM + wc * 32 + 4 * fq;
#pragma unroll
        for (int bj = 0; bj < 2; ++bj)
#pragma unroll
            for (int n = 0; n < 2; ++n) { const f32x4 bv = bias ? *(const f32x4*)(bias + col0 + bj * HALF + n * 16) : (f32x4){0.f, 0.f, 0.f, 0.f};
#pragma unroll
                for (int ai = 0; ai < 2; ++ai)
#pragma unroll
                    for (int m = 0; m < 4; ++m) acc[ai][bj][m][n] += bv; }
        const bool bad = st.run(acc, u, wr, wc, fr, fq, lds, wid, lane) || poison != 0u;
        const float qnan = __builtin_nanf("");
#pragma unroll
        for (int ai = 0; ai < 2; ++ai)
#pragma unroll
            for (int m = 0; m < 4; ++m) { const int r = ai * HALF + wr * 64 + m * 16 + fr; const f32x2v sr = S[r]; const size_t off = (size_t)(u.pm * BM + r) * ldc + col0;
#pragma unroll
                for (int bj = 0; bj < 2; ++bj)
#pragma unroll
                    for (int n = 0; n < 2; ++n) { const f32x4 bs = *(const f32x4*)(base + off + bj * HALF + n * 16); f32x4 o = bs + (acc[ai][bj][m][n] - sr.x) * sr.y;
                        if (bad) o = (f32x4){qnan, qnan, qnan, qnan}; *(f32x4*)(out + off + bj * HALF + n * 16) = o; }
                asm volatile("" ::: "memory"); }
    }
};
struct EpiLnResLn {
    static constexpr bool PERM = false, AFTER_DRAIN = true;
    const float* base; float* out; bf16_t* xn; int ldc; const float* bias; PanelStats st1, st2; unsigned poison;
    __device__ __forceinline__ void refuse(size_t i0, size_t stride, int M, int N) const { const float q = __builtin_nanf(""); for (size_t i = i0; i < (size_t)M * N; i += stride) { const size_t o = (i / N) * ldc + i % N; out[o] = q; xn[o] = (bf16_t)0x7fc0u; }
        if (i0 == 0) { unsigned expect = 0u; __hip_atomic_compare_exchange_strong(st1.tmo + 1, &expect, 0x7f0u, __ATOMIC_RELAXED, __ATOMIC_RELAXED, __HIP_MEMORY_SCOPE_AGENT); __hip_atomic_store(st1.tmo, 1u, __ATOMIC_RELAXED, __HIP_MEMORY_SCOPE_AGENT); } }
    __device__ __forceinline__ void fused(f32x4 (&acc)[2][2][4][2], const Unit& u, int wr, int wc, int fr, int fq, PG8_LAS unsigned char* lds, int wid, int lane) const {
        typedef float f32x2v __attribute__((ext_vector_type(2))); typedef unsigned u32x2v __attribute__((ext_vector_type(2)));
        const PG8_LAS f32x2v* S = (const PG8_LAS f32x2v*)(lds + 8192);
        const int col0 = u.pn * BM + wc * 32 + 4 * fq;
#pragma unroll
        for (int bj = 0; bj < 2; ++bj)
#pragma unroll
            for (int n = 0; n < 2; ++n) { const f32x4 bv = bias ? *(const f32x4*)(bias + col0 + bj * HALF + n * 16) : (f32x4){0.f, 0.f, 0.f, 0.f};
#pragma unroll
                for (int ai = 0; ai < 2; ++ai)
#pragma unroll
                    for (int m = 0; m < 4; ++m) acc[ai][bj][m][n] += bv; }
        bool bad = st1.run(acc, u, wr, wc, fr, fq, lds, wid, lane) || poison != 0u;
        const float qnan = __builtin_nanf("");
#pragma unroll
        for (int ai = 0; ai < 2; ++ai)
#pragma unroll
            for (int m = 0; m < 4; ++m) { const int r = ai * HALF + wr * 64 + m * 16 + fr; const f32x2v sr = S[r]; const size_t off = (size_t)(u.pm * BM + r) * ldc + col0;
#pragma unroll
                for (int bj = 0; bj < 2; ++bj)
#pragma unroll
                    for (int n = 0; n < 2; ++n) { const f32x4 bs = *(const f32x4*)(base + off + bj * HALF + n * 16); acc[ai][bj][m][n] = bs + (acc[ai][bj][m][n] - sr.x) * sr.y; }
                asm volatile("" : "+v"(acc[ai][0][m][0]), "+v"(acc[ai][0][m][1]), "+v"(acc[ai][1][m][0]), "+v"(acc[ai][1][m][1]));
                if (m & 1) asm volatile("" ::: "memory"); }
        const bool bad1 = bad;
        bad = st2.run(acc, u, wr, wc, fr, fq, lds, wid, lane) || bad;
#pragma unroll
        for (int ai = 0; ai < 2; ++ai)
#pragma unroll
            for (int m = 0; m < 4; ++m) { const int r = ai * HALF + wr * 64 + m * 16 + fr; const f32x2v sr = S[r]; const size_t off = (size_t)(u.pm * BM + r) * ldc + col0;
#pragma unroll
                for (int bj = 0; bj < 2; ++bj)
#pragma unroll
                    for (int n = 0; n < 2; ++n) { const f32x4 x1 = acc[ai][bj][m][n]; *(f32x4*)(out + off + bj * HALF + n * 16) = bad1 ? (f32x4){qnan, qnan, qnan, qnan} : x1;
                        const f32x4 o = (x1 - sr.x) * sr.y; u32x2v w; w.x = cvt_pk_bf16(o[0], o[1]); w.y = cvt_pk_bf16(o[2], o[3]);
                        if (bad) { w.x = 0x7fc07fc0u; w.y = 0x7fc07fc0u; } *(u32x2v*)(xn + off + bj * HALF + n * 16) = w; }
                asm volatile("" ::: "memory"); }
    }
};

template <class Epi, class Sched, bool STAMP = false>
__device__ __forceinline__ void gemm_phase(PG8_LAS unsigned char* lds, const Gemm g, const Sched S, const Epi E, unsigned long long* stamps) {
    const int tid = threadIdx.x, wid = __builtin_amdgcn_readfirstlane(tid >> 6), lane = tid & 63, wr = wid >> 2, wc = wid & 3, fr = lane & 15, fq = lane >> 4;
    const int K = g.K, nt = K / BK;
    int ts_lo = 0, ts_hi = 0, nts = 0; const unsigned long long rt_entry = STAMP ? (unsigned long long)wall_clock64() : 0ull;
#define PG8_STAMP() do { if (STAMP && wid == 0 && nts < 64) { const unsigned long long _c = (unsigned long long)clock64(); \
        ts_lo = (lane == nts) ? (int)(unsigned)_c : ts_lo; ts_hi = (lane == nts) ? (int)(unsigned)(_c >> 32) : ts_hi; ++nts; } } while (0)
    PG8_STAMP();
    unsigned voffA[2], voffB[2];
#pragma unroll
    for (int i = 0; i < 2; ++i) { int R, C; stage_rc(tid * 16 + i * 8192, R, C); const int Rb = Epi::PERM ? ((R & ~31) + perm32(R & 31)) : R;
        voffA[i] = (unsigned)(R * g.lda + C) * 2u; voffB[i] = (unsigned)(Rb * K + C) * 2u; }
    const size_t kstep = (size_t)(BK * 2);
    const size_t hstep = (size_t)HALF * K * 2;
    const size_t tstep = 2 * hstep;
    const size_t hstepA = (size_t)HALF * g.lda * 2, tstepA = 2 * hstepA;
    const unsigned ldsw = (unsigned)wid * 1024u;
    const int aoff = lds_byte(wr * 64 + fr, fq * 8), boff = lds_byte(wc * 32 + fr, fq * 8);
#define PG8_SA(b, h) (((b) * 2 + (h)) * HTB)
#define PG8_SB(b, h) ((4 + (b) * 2 + (h)) * HTB)
#define PG8_STAGE(bufoff, gbase, voff) do { _Pragma("unroll") for (int _i = 0; _i < 2; ++_i) \
        __builtin_amdgcn_global_load_lds((const unsigned*)((const char*)(gbase) + (voff)[_i]), (PG8_LAS unsigned*)(lds + (bufoff) + ldsw + _i * 8192), 16, 0, 0); } while (0)
#define PG8_LDA(dst, b, h) do { _Pragma("unroll") for (int m = 0; m < 4; ++m) _Pragma("unroll") for (int k = 0; k < 2; ++k) dst[m][k] = *(const PG8_LAS bf16x8*)(lds + PG8_SA(b, h) + aoff + m * 2048 + k * 1024); } while (0)
#define PG8_LDB(dst, b, h) do { _Pragma("unroll") for (int n = 0; n < 2; ++n) _Pragma("unroll") for (int k = 0; k < 2; ++k) dst[n][k] = *(const PG8_LAS bf16x8*)(lds + PG8_SB(b, h) + boff + n * 2048 + k * 1024); } while (0)
#define PG8_MMA(ai, bj, At, Bt) do { __builtin_amdgcn_s_setprio(1); _Pragma("unroll") for (int m = 0; m < 4; ++m) _Pragma("unroll") for (int n = 0; n < 2; ++n) _Pragma("unroll") for (int k = 0; k < 2; ++k) \
        acc[ai][bj][m][n] = __builtin_amdgcn_mfma_f32_16x16x32_bf16(Bt[n][k], At[m][k], acc[ai][bj][m][n], 0, 0, 0); __builtin_amdgcn_s_setprio(0); } while (0)
#define PG8_WAIT_V(n) asm volatile("s_waitcnt vmcnt(" #n ")" ::: "memory")
#define PG8_WAIT_L(n) asm volatile("s_waitcnt lgkmcnt(" #n ")" ::: "memory")
#define PG8_BAR __builtin_amdgcn_s_barrier()
#define PG8_SCHED __builtin_amdgcn_sched_barrier(0)
    Unit cur, nxt; int ui = 0;
    if (!S.next(0, cur)) return;
    f32x4 acc[2][2][4][2];
#pragma unroll
    for (int a = 0; a < 2; ++a)
#pragma unroll
        for (int b = 0; b < 2; ++b)
#pragma unroll
            for (int m = 0; m < 4; ++m)
#pragma unroll
                for (int n = 0; n < 2; ++n) acc[a][b][m][n] = (f32x4){0.f, 0.f, 0.f, 0.f};
    bf16x8 At[4][2], B0[2][2], B1[2][2];
    const char* cA = (const char*)g.A + (size_t)cur.pm * tstepA; const char* cB = (const char*)g.Bt + (size_t)cur.pn * tstep;
    S.a_ready(cur);
    PG8_STAGE(PG8_SB(0, 0), cB, voffB); PG8_STAGE(PG8_SA(0, 0), cA, voffA); PG8_STAGE(PG8_SB(0, 1), cB + hstep, voffB); PG8_STAGE(PG8_SA(0, 1), cA + hstepA, voffA);
    if (wr == 1) PG8_BAR;
    PG8_WAIT_V(4); PG8_BAR;
    PG8_STAGE(PG8_SB(1, 0), cB + kstep, voffB); PG8_STAGE(PG8_SA(1, 0), cA + kstep, voffA); PG8_STAGE(PG8_SB(1, 1), cB + hstep + kstep, voffB);
    PG8_WAIT_V(6); PG8_BAR;
    PG8_STAMP();
    for (;;) {
        const bool has_next = S.next(ui + 1, nxt);
        const char* nA = has_next ? (const char*)g.A + (size_t)nxt.pm * tstepA : cA; const char* nB = has_next ? (const char*)g.Bt + (size_t)nxt.pn * tstep : cB;
        for (int t = 0; t < nt; t += 2) {
            const bool last = (t == nt - 2);
            const char* a1 = cA + (size_t)(t + 1) * kstep;
            const char* a2 = last ? nA : cA + (size_t)(t + 2) * kstep; const char* b2 = last ? nB : cB + (size_t)(t + 2) * kstep;
            const char* a3 = a2 + kstep; const char* b3 = b2 + kstep;
            if (last && has_next) S.a_ready(nxt);
            PG8_LDB(B0, 0, 0); PG8_SCHED; PG8_LDA(At, 0, 0); PG8_STAGE(PG8_SA(1, 1), a1 + hstepA, voffA);
            PG8_WAIT_L(8); PG8_BAR; PG8_WAIT_L(0); PG8_MMA(0, 0, At, B0); PG8_BAR; PG8_SCHED;
            PG8_LDB(B1, 0, 1); PG8_STAGE(PG8_SB(0, 0), b2, voffB);
            PG8_BAR; PG8_WAIT_L(0); PG8_MMA(0, 1, At, B1); PG8_BAR;
            PG8_LDA(At, 0, 1); PG8_STAGE(PG8_SA(0, 0), a2, voffA);
            PG8_BAR; PG8_WAIT_L(0); PG8_MMA(1, 0, At, B0); PG8_BAR; PG8_SCHED;
            PG8_STAGE(PG8_SB(0, 1), b2 + hstep, voffB);
            PG8_WAIT_V(6); PG8_BAR; PG8_MMA(1, 1, At, B1); PG8_BAR;
            PG8_LDB(B0, 1, 0); PG8_SCHED; PG8_LDA(At, 1, 0); PG8_STAGE(PG8_SA(0, 1), a2 + hstepA, voffA);
            PG8_WAIT_L(8); PG8_BAR; PG8_WAIT_L(0); PG8_MMA(0, 0, At, B0); PG8_BAR; PG8_SCHED;
            PG8_LDB(B1, 1, 1); PG8_STAGE(PG8_SB(1, 0), b3, voffB);
            PG8_BAR; PG8_WAIT_L(0); PG8_MMA(0, 1, At, B1); PG8_BAR;
            PG8_LDA(At, 1, 1); PG8_STAGE(PG8_SA(1, 0), a3, voffA);
            PG8_BAR; PG8_WAIT_L(0); PG8_MMA(1, 0, At, B0); PG8_BAR; PG8_SCHED;
            PG8_STAGE(PG8_SB(1, 1), b3 + hstep, voffB);
            PG8_WAIT_V(6); PG8_BAR; PG8_MMA(1, 1, At, B1); PG8_BAR;
        }
        PG8_STAMP();
        if constexpr (!Epi::AFTER_DRAIN) { E(acc, cur, wr, wc, fr, fq); S.done(cur); }
        PG8_STAMP();
        if (!has_next) break;
#pragma unroll
        for (int a = 0; a < 2; ++a)
#pragma unroll
            for (int b = 0; b < 2; ++b)
#pragma unroll
                for (int m = 0; m < 4; ++m)
#pragma unroll
                    for (int n = 0; n < 2; ++n) acc[a][b][m][n] = (f32x4){0.f, 0.f, 0.f, 0.f};
        cur = nxt; cA = nA; cB = nB; ++ui;
    }
    PG8_WAIT_V(0);
    if (wr == 0) PG8_BAR;
    PG8_BAR;
    if constexpr (Epi::AFTER_DRAIN) { E.fused(acc, cur, wr, wc, fr, fq, lds, wid, lane); S.done(cur); }
    PG8_STAMP();
    if (STAMP && wid == 0) { stamps[lane] = lane < nts ? (((unsigned long long)(unsigned)ts_hi << 32) | (unsigned)ts_lo) : 0ull;
        if (lane == 62) stamps[62] = rt_entry; if (lane == 63) stamps[63] = (unsigned long long)wall_clock64(); }
#undef PG8_STAMP
#undef PG8_SA
#undef PG8_SB
#undef PG8_STAGE
#undef PG8_LDA
#undef PG8_LDB
#undef PG8_MMA
#undef PG8_WAIT_V
#undef PG8_WAIT_L
#undef PG8_BAR
#undef PG8_SCHED
}
}

namespace mk {
#define LAS __attribute__((address_space(3)))
using pg8::bf16_t; using pg8::bf16x8; using pg8::f32x4; using pg8::u32x4;
typedef unsigned u32x2 __attribute__((ext_vector_type(2)));

constexpr int DM = 1024, SEQ = 8192, NBATCH = 4, MPR = NBATCH * SEQ, MSAMP = 128, MREAL = MPR + MSAMP, MPAD = 33024;
constexpr int DFF = 2816, PW = 2816, NINP = 3072, CONVC = 1536;
constexpr float EPS = 1e-6f;
constexpr int NSCAN = 64;
constexpr int LDS_BYTES = 147456;

constexpr size_t O_YP = 0, O_YS = 33554432, O_KP = 33685504, O_VP = 33751040, O_CP = 33816576, O_GP = 33835008,
                 O_KS = 34097152, O_VS = 36194304, O_CS = 38291456, O_GS = 38881280;
constexpr size_t MiB = 1u << 20;
constexpr size_t WS_CTL = 0, CTL_ZERO_BYTES = 1 * MiB;
constexpr size_t WS_W1IN = 1 * MiB, WS_W1OUT = 12 * MiB, WS_WINMIX = 18 * MiB, WS_WOUTMIX = 24 * MiB, WS_W2IN = 26 * MiB, WS_W2OUT = 37 * MiB;
constexpr size_t WS_GBA = 43 * MiB, WS_XN = 45 * MiB, WS_XN2 = 110 * MiB, WS_H = 175 * MiB, WS_GM = 353 * MiB, WS_GN = 417 * MiB;
constexpr size_t WS_GQ = 110 * MiB, WS_GO = 142 * MiB;
constexpr size_t WS_SSP1 = 481 * MiB, WS_SSP2 = 484 * MiB;
constexpr size_t WS_END = 487 * MiB;
constexpr size_t CTL_SS1 = 0, CTL_SS2 = 256 * 1024, CTL_GLAST = 768 * 1024;

struct Params { const float* in[21]; float* out; unsigned char* ws; };

typedef float f32x2v __attribute__((ext_vector_type(2)));
typedef __bf16 bf16x2v __attribute__((ext_vector_type(2)));
__device__ __forceinline__ unsigned cvt_pk(float lo, float hi) { const f32x2v v = {lo, hi}; const bf16x2v b = __builtin_convertvector(v, bf16x2v); return __builtin_bit_cast(unsigned, b); }
__device__ __forceinline__ bf16_t f2bf(float f) { return (bf16_t)(cvt_pk(f, 0.f) & 0xffffu); }
__device__ __forceinline__ float bf2f(bf16_t h) { return __uint_as_float(((unsigned)h) << 16); }
__device__ __forceinline__ float bflo(unsigned w) { return __uint_as_float(w << 16); }
__device__ __forceinline__ float bfhi(unsigned w) { return __uint_as_float(w & 0xffff0000u); }
__device__ __forceinline__ float silu(float x) { return x * __builtin_amdgcn_rcpf(1.0f + __expf(-x)); }
__device__ __forceinline__ float wave_sum(float v) {
#pragma unroll
    for (int o = 1; o < 64; o <<= 1) v += __shfl_xor(v, o);
    return v;
}
__device__ __forceinline__ float wave_max(float v) {
#pragma unroll
    for (int o = 1; o < 64; o <<= 1) v = fmaxf(v, __shfl_xor(v, o));
    return v;
}
__device__ __forceinline__ f32x4 mfma16(bf16x8 a, bf16x8 b, f32x4 c) { return __builtin_amdgcn_mfma_f32_16x16x32_bf16(a, b, c, 0, 0, 0); }

__device__ __forceinline__ float row_rstd(const float* ssp, int r) {
    if (r >= MREAL) return 0.f;
    const f32x4 a = *(const f32x4*)(ssp + (size_t)r * 16), b = *(const f32x4*)(ssp + (size_t)r * 16 + 4), c = *(const f32x4*)(ssp + (size_t)r * 16 + 8), d = *(const f32x4*)(ssp + (size_t)r * 16 + 12);
    const float s = (((a[0] + a[1]) + (a[2] + a[3])) + ((b[0] + b[1]) + (b[2] + b[3]))) + (((c[0] + c[1]) + (c[2] + c[3])) + ((d[0] + d[1]) + (d[2] + d[3])));
    return rsqrtf(s * (1.0f / DM) + EPS);
}
struct EpiSwiglu {
    static constexpr bool PERM = true, AFTER_DRAIN = false;
    bf16_t* H; const float* ss;
    __device__ __forceinline__ void operator()(const f32x4 (&acc)[2][2][4][2], const pg8::Unit& u, int wr, int wc, int fr, int fq) const {
        const int row0 = u.pm * 256 + wr * 64 + fr, col0 = u.pn * 128 + wc * 32 + 8 * fq;
#pragma unroll
        for (int ai = 0; ai < 2; ++ai)
#pragma unroll
            for (int m = 0; m < 4; ++m) {
                const int r = row0 + ai * 128 + m * 16;
                const float rs = ss ? row_rstd(ss, r) : 1.0f;
                float h[8];
#pragma unroll
                for (int n = 0; n < 2; ++n)
#pragma unroll
                    for (int j = 0; j < 4; ++j) h[n * 4 + j] = silu(acc[ai][0][m][n][j] * rs) * (acc[ai][1][m][n][j] * rs);
                u32x4 w; w.x = cvt_pk(h[0], h[1]); w.y = cvt_pk(h[2], h[3]); w.z = cvt_pk(h[4], h[5]); w.w = cvt_pk(h[6], h[7]);
                *(u32x4*)(H + (size_t)r * DFF + col0) = w;
            }
    }
};
template <bool RESB16, bool WF32, bool WB16, bool SUMSQ, bool HALF> struct EpiResid {
    static constexpr bool PERM = true, AFTER_DRAIN = false;
    const void* resP; const void* resS; float* Yo; bf16_t* XBo; float* sso;
    __device__ __forceinline__ void operator()(const f32x4 (&acc)[2][2][4][2], const pg8::Unit& u, int wr, int wc, int fr, int fq) const {
        const int row0 = u.pm * 256 + wr * 64 + fr, col0 = u.pn * 256 + wc * 32 + 8 * fq;
        const char* const rP = (const char*)resP; const char* const rS = (const char*)resS - (size_t)MPR * DM * (RESB16 ? 2 : 4);
        float* const Y = Yo; const float scale = HALF ? 0.5f : 1.0f; bf16_t* const XB = XBo; float* const ss = sso;
#pragma unroll
        for (int ai = 0; ai < 2; ++ai)
#pragma unroll
            for (int m = 0; m < 4; ++m) {
                const int r = row0 + ai * 128 + m * 16; float s = 0.f;
                if (r < MREAL) {
                    const char* rp = ((r < MPR) ? rP : rS) + (size_t)r * DM * (RESB16 ? 2 : 4);
#pragma unroll
                    for (int bj = 0; bj < 2; ++bj) {
                        const int c = col0 + bj * 128;
                        f32x4 r0, r1;
                        if (RESB16) { const u32x4 w = *(const u32x4*)(rp + (size_t)c * 2); r0 = (f32x4){bflo(w.x), bfhi(w.x), bflo(w.y), bfhi(w.y)}; r1 = (f32x4){bflo(w.z), bfhi(w.z), bflo(w.w), bfhi(w.w)}; }
                        else { r0 = *(const f32x4*)(rp + (size_t)c * 4); r1 = *(const f32x4*)(rp + (size_t)c * 4 + 16); }
                        const f32x4 v0 = r0 + acc[ai][bj][m][0] * scale, v1 = r1 + acc[ai][bj][m][1] * scale;
                        if (WF32) { *(f32x4*)(Y + (size_t)r * DM + c) = v0; *(f32x4*)(Y + (size_t)r * DM + c + 4) = v1; }
                        if (WB16) { u32x4 w; w.x = cvt_pk(v0[0], v0[1]); w.y = cvt_pk(v0[2], v0[3]); w.z = cvt_pk(v1[0], v1[1]); w.w = cvt_pk(v1[2], v1[3]);
                            *(u32x4*)(XB + (size_t)r * DM + c) = w; }
                        if (SUMSQ) s += (v0[0] * v0[0] + v0[1] * v0[1]) + (v0[2] * v0[2] + v0[3] * v0[3]) + (v1[0] * v1[0] + v1[1] * v1[1]) + (v1[2] * v1[2] + v1[3] * v1[3]);
                    }
                }
                if (SUMSQ) { s += __shfl_xor(s, 16); s += __shfl_xor(s, 32); if (fq == 0 && r < MREAL) ss[(size_t)r * 16 + u.pn * 4 + wc] = s; }
            }
    }
};
struct EpiInproj {
    static constexpr bool PERM = true, AFTER_DRAIN = false;
    bf16_t* P; float* gba; const float* ss;
    __device__ __forceinline__ void operator()(const f32x4 (&acc)[2][2][4][2], const pg8::Unit& u, int wr, int wc, int fr, int fq) const {
        const int row0 = u.pm * 256 + wr * 64 + fr, col0 = u.pn * 256 + wc * 32 + 8 * fq;
#pragma unroll
        for (int ai = 0; ai < 2; ++ai)
#pragma unroll
            for (int m = 0; m < 4; ++m) {
                const int r = row0 + ai * 128 + m * 16;
                const float rs = row_rstd(ss, r);
                if (u.pn < 11) {
#pragma unroll
                    for (int bj = 0; bj < 2; ++bj) { const f32x4 v0 = acc[ai][bj][m][0] * rs, v1 = acc[ai][bj][m][1] * rs;
                        u32x4 w; w.x = cvt_pk(v0[0], v0[1]); w.y = cvt_pk(v0[2], v0[3]); w.z = cvt_pk(v1[0], v1[1]); w.w = cvt_pk(v1[2], v1[3]);
                        *(u32x4*)(P + (size_t)r * PW + col0 + bj * 128) = w; }
                } else if (wc == 0 && fq == 0) {
                    *(f32x4*)(gba + (size_t)r * 8) = acc[ai][0][m][0] * rs; *(f32x4*)(gba + (size_t)r * 8 + 4) = acc[ai][0][m][1] * rs;
                }
            }
    }
};

__device__ __forceinline__ void transpose_item(const float* W, int K, int N, bf16_t* WT, int k0, int n0, int drow0, const float* gs, LAS float* scr, int lane) {
#pragma unroll 8
    for (int i = 0; i < 32; ++i) { const int kk = 2 * i + (lane >> 5), n = n0 + (lane & 31);
        float v = (n < N) ? W[(size_t)(k0 + kk) * N + n] : 0.f; if (gs) v *= gs[k0 + kk];
        scr[kk * 33 + (lane & 31)] = v; }
    asm volatile("s_waitcnt lgkmcnt(0)" ::: "memory");
    const int c = lane & 7;
#pragma unroll
    for (int j = 0; j < 4; ++j) { const int nn = (lane >> 3) + 8 * j; const LAS float* s = scr + (8 * c) * 33 + nn;
        u32x4 o; o.x = cvt_pk(s[0 * 33], s[1 * 33]); o.y = cvt_pk(s[2 * 33], s[3 * 33]); o.z = cvt_pk(s[4 * 33], s[5 * 33]); o.w = cvt_pk(s[6 * 33], s[7 * 33]);
        *(u32x4*)(WT + (size_t)(drow0 + nn) * K + k0 + 8 * c) = o; }
    asm volatile("s_waitcnt lgkmcnt(0)" ::: "memory");
}
__device__ __forceinline__ int map_ffin_row(int n0) { return n0 < DFF ? (n0 >> 7) * 256 + (n0 & 127) : ((n0 - DFF) >> 7) * 256 + 128 + ((n0 - DFF) & 127); }

__device__ __forceinline__ void p0_prologue(const Params& p, LAS unsigned char* lds, int vb, int G) {
    const int tid = threadIdx.x, lane = tid & 63, wid = tid >> 6;
    LAS float* scr = (LAS float*)(lds + wid * 16384);
    const int gw = vb * 8 + wid, NGW = G * 8;
    bf16_t* W1IN = (bf16_t*)(p.ws + WS_W1IN); bf16_t* W1OUT = (bf16_t*)(p.ws + WS_W1OUT); bf16_t* WINMIX = (bf16_t*)(p.ws + WS_WINMIX);
    bf16_t* WOUTMIX = (bf16_t*)(p.ws + WS_WOUTMIX); bf16_t* W2IN = (bf16_t*)(p.ws + WS_W2IN); bf16_t* W2OUT = (bf16_t*)(p.ws + WS_W2OUT);
    constexpr int I_FIN = 16 * 176, I_FOUT = 44 * 32, I_INMIX = 16 * 89, I_OUTMIX = 16 * 32;
    constexpr int NITEMS = 2 * I_FIN + 2 * I_FOUT + I_INMIX + I_OUTMIX;
    for (int it = gw; it < NITEMS; it += NGW) {
        int r = it;
        if (r < I_FIN) { const int kb = r / 176, nb = r % 176; transpose_item(p.in[7], DM, 2 * DFF, W1IN, kb * 64, nb * 32, map_ffin_row(nb * 32), nullptr, scr, lane); continue; } r -= I_FIN;
        if (r < I_FIN) { const int kb = r / 176, nb = r % 176; transpose_item(p.in[18], DM, 2 * DFF, W2IN, kb * 64, nb * 32, map_ffin_row(nb * 32), p.in[17], scr, lane); continue; } r -= I_FIN;
        if (r < I_FOUT) { const int kb = r / 32, nb = r % 32; transpose_item(p.in[8], DFF, DM, W1OUT, kb * 64, nb * 32, nb * 32, nullptr, scr, lane); continue; } r -= I_FOUT;
        if (r < I_FOUT) { const int kb = r / 32, nb = r % 32; transpose_item(p.in[19], DFF, DM, W2OUT, kb * 64, nb * 32, nb * 32, nullptr, scr, lane); continue; } r -= I_FOUT;
        if (r < I_INMIX) { const int kb = r / 89, nb = r % 89; transpose_item(p.in[10], DM, 2824, WINMIX, kb * 64, nb * 32, nb * 32, p.in[9], scr, lane); continue; } r -= I_INMIX;
        { const int kb = r / 32, nb = r % 32; transpose_item(p.in[16], DM, DM, WOUTMIX, kb * 64, nb * 32, nb * 32, nullptr, scr, lane); }
    }
    bf16_t* XN = (bf16_t*)(p.ws + WS_XN); const float* g1 = p.in[6];
    f32x4 gv[4];
#pragma unroll
    for (int j = 0; j < 4; ++j) gv[j] = *((const f32x4*)g1 + lane + 64 * j);
    for (int m = gw; m < MPAD; m += NGW) {
        unsigned long long* o8 = (unsigned long long*)(XN + (size_t)m * DM) + lane;
        if (m >= MREAL) {
#pragma unroll
            for (int j = 0; j < 4; ++j) o8[64 * j] = 0ull;
            continue; }
        const float* xrow = (m < MPR) ? p.in[0] + (size_t)m * DM : p.in[1] + (size_t)(m - MPR) * DM;
        const f32x4* xr = (const f32x4*)xrow + lane;
        f32x4 v[4]; float s = 0.f;
#pragma unroll
        for (int j = 0; j < 4; ++j) { v[j] = xr[64 * j]; s += (v[j][0] * v[j][0] + v[j][1] * v[j][1]) + (v[j][2] * v[j][2] + v[j][3] * v[j][3]); }
        const float rstd = rsqrtf(wave_sum(s) * (1.0f / DM) + EPS);
#pragma unroll
        for (int j = 0; j < 4; ++j) { const f32x4 y = v[j] * rstd * gv[j];
            o8[64 * j] = (unsigned long long)cvt_pk(y[0], y[1]) | ((unsigned long long)cvt_pk(y[2], y[3]) << 32); }
    }
}

__device__ __forceinline__ f32x4 tile_mm(const LAS bf16_t* X, int ldx, int mt, const LAS bf16_t* Y, int ldy, int nt, int nks, int fr, int fq) {
    f32x4 acc = (f32x4){0.f, 0.f, 0.f, 0.f};
    const LAS bf16_t* xp = X + (16 * mt + fr) * ldx + 8 * fq; const LAS bf16_t* yp = Y + (16 * nt + fr) * ldy + 8 * fq;
    for (int ks = 0; ks < nks; ++ks) acc = mfma16(*(const LAS bf16x8*)(xp + 32 * ks), *(const LAS bf16x8*)(yp + 32 * ks), acc);
    return acc;
}
constexpr int G1_QS = 0, G1_KS = 17408, G1_VBT = 34816, G1_KBT = 53248, G1_KDT = 71680, G1_UT = 90112, G1_WT = 108544, G1_QK = 126976, G1_TB = 136192, G1_GC = 145408, G1_BETA = 145664;

__device__ __forceinline__ void gdn_prep_unit(const Params& p, LAS unsigned char* lds, int unit) {
    const int tid = threadIdx.x, lane = tid & 63, wid = tid >> 6, fr = lane & 15, fq = lane >> 4;
    const int bh = unit >> 7, n = unit & 127, b = bh >> 2, h = bh & 3;
    const int tok0 = b * SEQ + n * 64;
    LAS bf16_t* Qs = (LAS bf16_t*)(lds + G1_QS); LAS bf16_t* Ks = (LAS bf16_t*)(lds + G1_KS); LAS bf16_t* VbT = (LAS bf16_t*)(lds + G1_VBT);
    LAS bf16_t* KbT = (LAS bf16_t*)(lds + G1_KBT); LAS bf16_t* KdT = (LAS bf16_t*)(lds + G1_KDT); LAS bf16_t* UT = (LAS bf16_t*)(lds + G1_UT);
    LAS bf16_t* WT = (LAS bf16_t*)(lds + G1_WT); LAS float* Af = (LAS float*)(lds + G1_WT); LAS bf16_t* QK = (LAS bf16_t*)(lds + G1_QK);
    LAS bf16_t* Tb = (LAS bf16_t*)(lds + G1_TB); LAS float* gcs = (LAS float*)(lds + G1_GC); LAS float* betas = (LAS float*)(lds + G1_BETA);
    const bf16_t* PB = (const bf16_t*)(p.ws + WS_H); const float* GBA = (const float*)(p.ws + WS_GBA);
    if (tid < 64) {
        const float* gb = GBA + (size_t)(tok0 + tid) * 8;
        const float bt = 1.0f / (1.0f + __expf(-gb[h]));
        const float x = gb[4 + h] + p.in[14][h]; const float sp = x > 20.f ? x : log1pf(__expf(x));
        float c = -__expf(p.in[13][h]) * sp;
#pragma unroll
        for (int o = 1; o < 64; o <<= 1) { const float t = __shfl_up(c, o); if (lane >= o) c += t; }
        gcs[tid] = c; betas[tid] = bt;
    }
    __syncthreads();
    const float gclast = gcs[63];
    const float* cw = p.in[12];
#pragma unroll 1
    for (int it = 0; it < 6; ++it) {
        const int item = tid + 512 * it, l16 = item & 15, row = item >> 4, which = row >> 6, t = row & 63;
        const int cch = which * 512 + h * 128 + l16 * 8;
        float a[8];
#pragma unroll
        for (int e = 0; e < 8; ++e) a[e] = 0.f;
#pragma unroll
        for (int j = 0; j < 4; ++j) {
            const int tt = n * 64 + t - 3 + j;
            if (tt >= 0) {
                const u32x4 xv = *(const u32x4*)(PB + (size_t)(b * SEQ + tt) * PW + 768 + cch);
                const f32x4 w0 = *(const f32x4*)(cw + j * CONVC + cch), w1 = *(const f32x4*)(cw + j * CONVC + cch + 4);
                a[0] += w0[0] * bflo(xv.x); a[1] += w0[1] * bfhi(xv.x); a[2] += w0[2] * bflo(xv.y); a[3] += w0[3] * bfhi(xv.y);
                a[4] += w1[0] * bflo(xv.z); a[5] += w1[1] * bfhi(xv.z); a[6] += w1[2] * bflo(xv.w); a[7] += w1[3] * bfhi(xv.w);
            }
        }
        float ss = 0.f;
#pragma unroll
        for (int e = 0; e < 8; ++e) { a[e] = silu(a[e]); ss += a[e] * a[e]; }
        ss += __shfl_xor(ss, 1); ss += __shfl_xor(ss, 2); ss += __shfl_xor(ss, 4); ss += __shfl_xor(ss, 8);
        const float gct = gcs[t], bt = betas[t];
        if (which == 0) {
            const float sc = rsqrtf(ss + EPS) * 0.08838834764831845f;
            u32x4 w; w.x = cvt_pk(a[0] * sc, a[1] * sc); w.y = cvt_pk(a[2] * sc, a[3] * sc); w.z = cvt_pk(a[4] * sc, a[5] * sc); w.w = cvt_pk(a[6] * sc, a[7] * sc);
            *(LAS u32x4*)(Qs + t * 136 + l16 * 8) = w;
        } else if (which == 1) {
            const float sc = rsqrtf(ss + EPS);
            u32x4 w; w.x = cvt_pk(a[0] * sc, a[1] * sc); w.y = cvt_pk(a[2] * sc, a[3] * sc); w.z = cvt_pk(a[4] * sc, a[5] * sc); w.w = cvt_pk(a[6] * sc, a[7] * sc);
            *(LAS u32x4*)(Ks + t * 136 + l16 * 8) = w;
            const float sb = sc * bt * __expf(gct), sd = sc * __expf(gclast - gct);
#pragma unroll
            for (int e = 0; e < 8; ++e) { KbT[(l16 * 8 + e) * 72 + t] = f2bf(a[e] * sb); KdT[(l16 * 8 + e) * 72 + t] = f2bf(a[e] * sd); }
        } else {
#pragma unroll
            for (int e = 0; e < 8; ++e) VbT[(l16 * 8 + e) * 72 + t] = f2bf(a[e] * bt);
        }
    }
    __syncthreads();
#pragma unroll 1
    for (int r = 0; r < 4; ++r) {
        const int job = wid + 8 * r, kind = job >> 4, tile = job & 15, it = tile >> 2, jt = tile & 3;
        if (kind == 0 && jt > it) continue;
        const f32x4 acc = tile_mm(Ks, 136, jt, kind ? Qs : Ks, 136, it, 4, fr, fq);
        const int i = 16 * it + fr; const float gci = gcs[i], bi = betas[i];
        float v[4];
#pragma unroll
        for (int e = 0; e < 4; ++e) { const int j = 16 * jt + 4 * fq + e; const bool ok = kind ? (i >= j) : (i > j);
            const float d = __expf(ok ? gci - gcs[j] : 0.f); v[e] = ok ? acc[e] * d * (kind ? 1.0f : bi) : 0.f; }
        if (kind == 0) *(LAS f32x4*)(Af + i * 68 + 16 * jt + 4 * fq) = (f32x4){v[0], v[1], v[2], v[3]};
        else { u32x2 w; w.x = cvt_pk(v[0], v[1]); w.y = cvt_pk(v[2], v[3]); *(LAS u32x2*)(QK + i * 72 + 16 * jt + 4 * fq) = w; }
    }
    __syncthreads();
    if (wid == 0) {
        float t[64];
#pragma unroll
        for (int i = 0; i < 64; ++i) {
            float a = (lane == i) ? 1.0f : 0.0f;
#pragma unroll
            for (int j4 = 0; j4 < (i + 3) / 4; ++j4) { const f32x4 av = *(const LAS f32x4*)(Af + i * 68 + 4 * j4);
#pragma unroll
                for (int e = 0; e < 4; ++e) if (4 * j4 + e < i) a -= av[e] * t[4 * j4 + e]; }
            t[i] = a;
            Tb[i * 72 + lane] = f2bf(a);
        }
    }
    __syncthreads();
#pragma unroll 1
    for (int r = 0; r < 8; ++r) {
        const int job = wid + 8 * r, kind = job >> 5, tile = job & 31, mt = tile >> 3, nt = tile & 7;
        const f32x4 acc = tile_mm(Tb, 72, mt, kind ? KbT : VbT, 72, nt, 2, fr, fq);
        u32x2 w; w.x = cvt_pk(acc[0], acc[1]); w.y = cvt_pk(acc[2], acc[3]);
        *(LAS u32x2*)((kind ? WT : UT) + (16 * nt + fr) * 72 + 16 * mt + 4 * fq) = w;
    }
    __syncthreads();
    bf16_t* GM = (bf16_t*)(p.ws + WS_GM) + (size_t)unit * 16384; bf16_t* GN = (bf16_t*)(p.ws + WS_GN) + (size_t)unit * 16384;
    bf16_t* GQ = (bf16_t*)(p.ws + WS_GQ) + (size_t)unit * 8192; bf16_t* GO = (bf16_t*)(p.ws + WS_GO) + (size_t)unit * 8192;
#pragma unroll 1
    for (int r = 0; r < 24; ++r) {
        const int job = wid + 8 * r;
        if (job < 64) { const int a = job >> 3, mt = job & 7;
            const f32x4 acc = tile_mm(WT, 72, a, KdT, 72, mt, 2, fr, fq);
            u32x2 w; w.x = cvt_pk(-acc[0], -acc[1]); w.y = cvt_pk(-acc[2], -acc[3]);
            *(u32x2*)(GM + ((mt * 4 + (a >> 1)) * 64 + lane) * 8 + (a & 1) * 4) = w;
        } else if (job < 128) { const int j = job - 64, mt = j >> 3, nt = j & 7;
            const f32x4 acc = tile_mm(KdT, 72, mt, UT, 72, nt, 2, fr, fq);
            u32x2 w; w.x = cvt_pk(acc[0], acc[1]); w.y = cvt_pk(acc[2], acc[3]);
            *(u32x2*)(GN + ((nt * 64 + lane) * 8 + mt) * 4) = w;
        } else if (job < 160) { const int j = job - 128, a = j >> 2, it = j & 3;
            const f32x4 acc = tile_mm(WT, 72, a, QK, 72, it, 2, fr, fq);
            const int i = 16 * it + fr; const float eg = __expf(gcs[i]);
            const u32x2 qv = *(const LAS u32x2*)(Qs + i * 136 + 16 * a + 4 * fq);
            u32x2 w; w.x = cvt_pk(bflo(qv.x) * eg - acc[0], bfhi(qv.x) * eg - acc[1]); w.y = cvt_pk(bflo(qv.y) * eg - acc[2], bfhi(qv.y) * eg - acc[3]);
            *(u32x2*)(GQ + ((it * 4 + (a >> 1)) * 64 + lane) * 8 + (a & 1) * 4) = w;
        } else { const int j = job - 160, mt = j >> 3, nt = j & 7;
            const f32x4 acc = tile_mm(QK, 72, mt, UT, 72, nt, 2, fr, fq);
            u32x2 w; w.x = cvt_pk(acc[0], acc[1]); w.y = cvt_pk(acc[2], acc[3]);
            *(u32x2*)(GO + ((nt * 64 + lane) * 4 + mt) * 4) = w;
        }
    }
    if (tid == 0) ((float*)(p.ws + WS_CTL + CTL_GLAST))[unit] = __expf(gclast);
    __syncthreads();
}

__device__ __forceinline__ void gdn_scan(const Params& p, LAS unsigned char* lds, int sb) {
    const int tid = threadIdx.x, lane = tid & 63, wid = tid >> 6, fr = lane & 15, fq = lane >> 4;
    const int bh = sb >> 2, sp = sb & 3, unit0 = bh * 128, sl = sp * 2 + wid;
    const u32x4* GMb = (const u32x4*)((const bf16_t*)(p.ws + WS_GM) + (size_t)unit0 * 16384);
    const u32x4* GQb = (const u32x4*)((const bf16_t*)(p.ws + WS_GQ) + (size_t)unit0 * 8192);
    const bf16_t* GNb = (const bf16_t*)(p.ws + WS_GN) + (size_t)unit0 * 16384;
    bf16_t* GOb = (bf16_t*)(p.ws + WS_GO) + (size_t)unit0 * 8192;
    const float* glast = (const float*)(p.ws + WS_CTL + CTL_GLAST) + unit0;
    u32x4 st[6];
#pragma unroll
    for (int c = 0; c < 2; ++c) {
#pragma unroll
        for (int i = 0; i < 6; ++i) { const int q = tid + 512 * i; st[i] = (q < 2048) ? GMb[(size_t)c * 2048 + q] : GQb[(size_t)c * 1024 + (q - 2048)]; }
#pragma unroll
        for (int i = 0; i < 6; ++i) { const int q = tid + 512 * i; *(LAS u32x4*)(lds + c * 49152 + q * 16) = st[i]; }
    }
    f32x4 S[8];
#pragma unroll
    for (int mt = 0; mt < 8; ++mt) S[mt] = (f32x4){0.f, 0.f, 0.f, 0.f};
    u32x4 nn[4]; u32x4 on[2];
    if (wid < 2) {
#pragma unroll
        for (int i = 0; i < 4; ++i) nn[i] = *(const u32x4*)(GNb + (size_t)(sl * 64 + lane) * 32 + i * 8);
#pragma unroll
        for (int i = 0; i < 2; ++i) on[i] = *(const u32x4*)(GOb + (size_t)(sl * 64 + lane) * 16 + i * 8);
    }
    __syncthreads();
#pragma unroll 1
    for (int c = 0; c < 128; ++c) {
        if (c + 2 < 128) {
#pragma unroll
            for (int i = 0; i < 6; ++i) { const int q = tid + 512 * i; st[i] = (q < 2048) ? GMb[(size_t)(c + 2) * 2048 + q] : GQb[(size_t)(c + 2) * 1024 + (q - 2048)]; }
        }
        if (wid < 2) {
            const float gl = glast[c];
            bf16x8 Sb[4];
#pragma unroll
            for (int ks = 0; ks < 4; ++ks) { u32x4 w; w.x = cvt_pk(S[2 * ks][0], S[2 * ks][1]); w.y = cvt_pk(S[2 * ks][2], S[2 * ks][3]);
                w.z = cvt_pk(S[2 * ks + 1][0], S[2 * ks + 1][1]); w.w = cvt_pk(S[2 * ks + 1][2], S[2 * ks + 1][3]); Sb[ks] = __builtin_bit_cast(bf16x8, w); }
            f32x4 aO[4];
#pragma unroll
            for (int mt = 0; mt < 8; ++mt) { const unsigned w0 = nn[mt >> 1][(mt & 1) * 2], w1 = nn[mt >> 1][(mt & 1) * 2 + 1];
                S[mt] = S[mt] * gl + (f32x4){bflo(w0), bfhi(w0), bflo(w1), bfhi(w1)}; }
#pragma unroll
            for (int mt = 0; mt < 4; ++mt) { const unsigned w0 = on[mt >> 1][(mt & 1) * 2], w1 = on[mt >> 1][(mt & 1) * 2 + 1];
                aO[mt] = (f32x4){bflo(w0), bfhi(w0), bflo(w1), bfhi(w1)}; }
            if (c + 1 < 128) {
#pragma unroll
                for (int i = 0; i < 4; ++i) nn[i] = *(const u32x4*)(GNb + (size_t)(c + 1) * 16384 + (size_t)(sl * 64 + lane) * 32 + i * 8);
#pragma unroll
                for (int i = 0; i < 2; ++i) on[i] = *(const u32x4*)(GOb + (size_t)(c + 1) * 8192 + (size_t)(sl * 64 + lane) * 16 + i * 8);
            }
            const LAS unsigned char* slot = lds + (c % 3) * 49152;
#pragma unroll
            for (int mt = 0; mt < 8; ++mt)
#pragma unroll
                for (int ks = 0; ks < 4; ++ks) S[mt] = mfma16(*(const LAS bf16x8*)(slot + ((mt * 4 + ks) * 64 + lane) * 16), Sb[ks], S[mt]);
#pragma unroll
            for (int mt = 0; mt < 4; ++mt)
#pragma unroll
                for (int ks = 0; ks < 4; ++ks) aO[mt] = mfma16(*(const LAS bf16x8*)(slot + 32768 + ((mt * 4 + ks) * 64 + lane) * 16), Sb[ks], aO[mt]);
            u32x4 o0, o1;
            o0.x = cvt_pk(aO[0][0], aO[0][1]); o0.y = cvt_pk(aO[0][2], aO[0][3]); o0.z = cvt_pk(aO[1][0], aO[1][1]); o0.w = cvt_pk(aO[1][2], aO[1][3]);
            o1.x = cvt_pk(aO[2][0], aO[2][1]); o1.y = cvt_pk(aO[2][2], aO[2][3]); o1.z = cvt_pk(aO[3][0], aO[3][1]); o1.w = cvt_pk(aO[3][2], aO[3][3]);
            bf16_t* op = GOb + (size_t)c * 8192 + (size_t)(sl * 64 + lane) * 16;
            *(u32x4*)op = o0; *(u32x4*)(op + 8) = o1;
        }
        if (c + 2 < 128) {
#pragma unroll
            for (int i = 0; i < 6; ++i) { const int q = tid + 512 * i; *(LAS u32x4*)(lds + ((c + 2) % 3) * 49152 + q * 16) = st[i]; }
        }
        __syncthreads();
    }
    if (wid < 2) {
        float* go = p.out + O_GP + (size_t)bh * 16384;
#pragma unroll
        for (int mt = 0; mt < 8; ++mt)
#pragma unroll
            for (int e = 0; e < 4; ++e) go[(16 * mt + 4 * fq + e) * 128 + sl * 16 + fr] = S[mt][e];
    }
}

__device__ __forceinline__ void gdn_gate_unit(const Params& p, int unit, int lane) {
    const int fr = lane & 15, fq = lane >> 4, bh = unit >> 7, n = unit & 127, b = bh >> 2, h = bh & 3, tok0 = b * SEQ + n * 64;
    const bf16_t* GO = (const bf16_t*)(p.ws + WS_GO) + (size_t)unit * 8192;
    bf16_t* PB = (bf16_t*)(p.ws + WS_H);
    float ssq[16];
#pragma unroll
    for (int k = 0; k < 16; ++k) ssq[k] = 0.f;
#pragma unroll 1
    for (int nt = 0; nt < 8; ++nt) {
        const u32x4 a0 = *(const u32x4*)(GO + (nt * 64 + lane) * 16), a1 = *(const u32x4*)(GO + (nt * 64 + lane) * 16 + 8);
#pragma unroll
        for (int k = 0; k < 4; ++k) { const float l0 = bflo(a0[k]), h0 = bfhi(a0[k]), l1 = bflo(a1[k]), h1 = bfhi(a1[k]);
            ssq[2 * k] += l0 * l0; ssq[2 * k + 1] += h0 * h0; ssq[8 + 2 * k] += l1 * l1; ssq[8 + 2 * k + 1] += h1 * h1; }
    }
#pragma unroll
    for (int k = 0; k < 16; ++k) { float s = ssq[k]; s += __shfl_xor(s, 1); s += __shfl_xor(s, 2); s += __shfl_xor(s, 4); s += __shfl_xor(s, 8); ssq[k] = rsqrtf(s * (1.0f / 128.0f) + EPS); }
    const float* gn = p.in[15];
#pragma unroll 1
    for (int nt = 0; nt < 8; ++nt) {
        const int dv = 16 * nt + fr; const float g = gn[dv];
        const u32x4 a0 = *(const u32x4*)(GO + (nt * 64 + lane) * 16), a1 = *(const u32x4*)(GO + (nt * 64 + lane) * 16 + 8);
        const bf16_t* gzp = PB + (size_t)(tok0 + 4 * fq) * PW + 2304 + h * 128 + dv; bf16_t* mp = PB + (size_t)(tok0 + 4 * fq) * PW + 512 + h * 128 + dv;
#pragma unroll
        for (int k = 0; k < 16; ++k) {
            const unsigned w = (k < 8) ? a0[(k >> 1) & 3] : a1[(k >> 1) & 3]; const float o = (k & 1) ? bfhi(w) : bflo(w);
            const int to = 16 * (k >> 2) + (k & 3);
            const float gz = bf2f(gzp[(size_t)to * PW]);
            mp[(size_t)to * PW] = f2bf(o * ssq[k] * g * silu(gz));
        }
    }
}

__device__ __forceinline__ void attn_unit(const Params& p, LAS unsigned char* lds, int unit) {
    const int tid = threadIdx.x, lane = tid & 63, wid = tid >> 6, fr = lane & 15, fq = lane >> 4;
    const int b = unit >> 7, blk = (unit >> 1) & 63, kvh = unit & 1;
    LAS bf16_t* Ks = (LAS bf16_t*)lds; LAS bf16_t* Vt = (LAS bf16_t*)(lds + 36864);
    bf16_t* PB = (bf16_t*)(p.ws + WS_H);
    __syncthreads();
#pragma unroll
    for (int i = 0; i < 4; ++i) {
        const int q = tid + 512 * i, row = q >> 3, ch = q & 7, tp = blk * 128 - 128 + row;
        u32x4 kv = (u32x4){0u, 0u, 0u, 0u}, vv = (u32x4){0u, 0u, 0u, 0u};
        if (tp >= 0) { const bf16_t* base = PB + (size_t)(b * SEQ + tp) * PW; kv = *(const u32x4*)(base + 512 + kvh * 64 + ch * 8); vv = *(const u32x4*)(base + 640 + kvh * 64 + ch * 8); }
        *(LAS u32x4*)(Ks + row * 72 + ch * 8) = kv;
#pragma unroll
        for (int e = 0; e < 4; ++e) { const unsigned w = vv[e]; Vt[(ch * 8 + 2 * e) * 264 + row] = (bf16_t)(w & 0xffffu); Vt[(ch * 8 + 2 * e + 1) * 264 + row] = (bf16_t)(w >> 16); }
    }
    __syncthreads();
    const int qtok = b * SEQ + blk * 128 + 16 * wid + fr;
#pragma unroll 1
    for (int g = 0; g < 4; ++g) {
        const int h = kvh * 4 + g; const float slope = exp2f(-(float)(h + 1)), sink = p.in[11][h];
        bf16x8 qf[2];
#pragma unroll
        for (int ks = 0; ks < 2; ++ks) qf[ks] = *(const bf16x8*)(PB + (size_t)qtok * PW + h * 64 + ks * 32 + 8 * fq);
        f32x4 s[10]; float mx = sink;
#pragma unroll
        for (int j = 0; j < 10; ++j) {
            const int ct = (wid + j) < 15 ? (wid + j) : 15;
            f32x4 acc = (f32x4){0.f, 0.f, 0.f, 0.f};
#pragma unroll
            for (int ks = 0; ks < 2; ++ks) acc = mfma16(*(const LAS bf16x8*)(Ks + (16 * ct + fr) * 72 + ks * 32 + 8 * fq), qf[ks], acc);
#pragma unroll
            for (int e = 0; e < 4; ++e) {
                const int c = 16 * (wid + j) + 4 * fq + e, dist = 16 * wid + fr - c + 128;
                const bool ok = (wid + j <= 15) && dist >= 0 && dist <= 128 && (blk * 128 + c - 128 >= 0);
                const float v = ok ? acc[e] * 0.125f - slope * (float)dist : -INFINITY;
                acc[e] = v; mx = fmaxf(mx, v);
            }
            s[j] = acc;
            asm volatile("" ::: "memory");
        }
        mx = fmaxf(mx, __shfl_xor(mx, 16)); mx = fmaxf(mx, __shfl_xor(mx, 32));
        float sum = 0.f;
#pragma unroll
        for (int j = 0; j < 10; ++j)
#pragma unroll
            for (int e = 0; e < 4; ++e) { const float pv = __expf(s[j][e] - mx); s[j][e] = pv; sum += pv; }
        sum += __shfl_xor(sum, 16); sum += __shfl_xor(sum, 32);
        sum += __expf(sink - mx);
        const float inv = 1.0f / sum;
        bf16x8 pb[5];
#pragma unroll
        for (int kk = 0; kk < 5; ++kk) { u32x4 w; w.x = cvt_pk(s[2 * kk][0] * inv, s[2 * kk][1] * inv); w.y = cvt_pk(s[2 * kk][2] * inv, s[2 * kk][3] * inv);
            w.z = cvt_pk(s[2 * kk + 1][0] * inv, s[2 * kk + 1][1] * inv); w.w = cvt_pk(s[2 * kk + 1][2] * inv, s[2 * kk + 1][3] * inv); pb[kk] = __builtin_bit_cast(bf16x8, w); }
#pragma unroll
        for (int dt = 0; dt < 4; ++dt) {
            f32x4 acc = (f32x4){0.f, 0.f, 0.f, 0.f};
#pragma unroll
            for (int kk = 0; kk < 5; ++kk) {
                const int c0 = (wid + 2 * kk) < 15 ? (wid + 2 * kk) : 15, c1 = (wid + 2 * kk + 1) < 15 ? (wid + 2 * kk + 1) : 15;
                const u32x2 lo = *(const LAS u32x2*)(Vt + (16 * dt + fr) * 264 + 16 * c0 + 4 * fq), hi = *(const LAS u32x2*)(Vt + (16 * dt + fr) * 264 + 16 * c1 + 4 * fq);
                const u32x4 a = (u32x4){lo.x, lo.y, hi.x, hi.y};
                acc = mfma16(__builtin_bit_cast(bf16x8, a), pb[kk], acc);
            }
            u32x2 w; w.x = cvt_pk(acc[0], acc[1]); w.y = cvt_pk(acc[2], acc[3]);
            *(u32x2*)(PB + (size_t)qtok * PW + h * 64 + 16 * dt + 4 * fq) = w;
            asm volatile("" ::: "memory");
        }
    }
}

__device__ __forceinline__ void sattn_unit(const Params& p, int su, int lane) {
    const int s = su >> 1, kvh = su & 1;
    bf16_t* PB = (bf16_t*)(p.ws + WS_H) + (size_t)(MPR + s) * PW;
    const float* ck = p.in[2] + (size_t)s * 128 * 128 + kvh * 64 + lane; const float* cv = p.in[3] + (size_t)s * 128 * 128 + kvh * 64 + lane;
    float* nk = p.out + O_KS + (size_t)s * 128 * 128 + kvh * 64 + lane; float* nv = p.out + O_VS + (size_t)s * 128 * 128 + kvh * 64 + lane;
    float q[4], slope[4], sink[4], sc[4][3];
#pragma unroll
    for (int g = 0; g < 4; ++g) { const int h = kvh * 4 + g; q[g] = bf2f(PB[h * 64 + lane]) * 0.125f; slope[g] = exp2f(-(float)(h + 1)); sink[g] = p.in[11][h]; }
    const float knew = bf2f(PB[512 + kvh * 64 + lane]), vnew = bf2f(PB[640 + kvh * 64 + lane]);
#pragma unroll
    for (int t = 0; t < 2; ++t) {
#pragma unroll 4
        for (int jj = 0; jj < 64; ++jj) {
            const int j = t * 64 + jj; const float kval = ck[(size_t)j * 128];
            if (j >= 1) nk[(size_t)(j - 1) * 128] = kval;
#pragma unroll
            for (int g = 0; g < 4; ++g) { const float d = wave_sum(q[g] * kval) - slope[g] * (float)(128 - j); if (lane == jj) sc[g][t] = d; }
        }
    }
    nk[(size_t)127 * 128] = knew;
    float o[4], inv[4], pl[4][3];
#pragma unroll
    for (int g = 0; g < 4; ++g) {
        sc[g][2] = wave_sum(q[g] * knew);
        const float mx = fmaxf(fmaxf(wave_max(fmaxf(sc[g][0], sc[g][1])), sc[g][2]), sink[g]);
        pl[g][0] = __expf(sc[g][0] - mx); pl[g][1] = __expf(sc[g][1] - mx); pl[g][2] = __expf(sc[g][2] - mx);
        inv[g] = 1.0f / (wave_sum(pl[g][0] + pl[g][1]) + pl[g][2] + __expf(sink[g] - mx));
        o[g] = pl[g][2] * vnew;
    }
#pragma unroll
    for (int t = 0; t < 2; ++t) {
#pragma unroll 4
        for (int jj = 0; jj < 64; ++jj) {
            const int j = t * 64 + jj; const float vval = cv[(size_t)j * 128];
            if (j >= 1) nv[(size_t)(j - 1) * 128] = vval;
#pragma unroll
            for (int g = 0; g < 4; ++g) o[g] += __shfl(pl[g][t], jj) * vval;
        }
    }
    nv[(size_t)127 * 128] = vnew;
#pragma unroll
    for (int g = 0; g < 4; ++g) PB[(kvh * 4 + g) * 64 + lane] = f2bf(o[g] * inv[g]);
}

__device__ __forceinline__ void sgdn_unit(const Params& p, LAS unsigned char* lds, int s) {
    const int tid = threadIdx.x, wid = tid >> 6, h = tid >> 7, dv = tid & 127;
    LAS float* qs = (LAS float*)lds; LAS float* ks = qs + 512; LAS float* red = ks + 512;
    bf16_t* PB = (bf16_t*)(p.ws + WS_H) + (size_t)(MPR + s) * PW; const float* GBA = (const float*)(p.ws + WS_GBA) + (size_t)(MPR + s) * 8;
    const float* cw = p.in[12]; const float* hc = p.in[4] + (size_t)s * 3 * CONVC; float* nc = p.out + O_CS + (size_t)s * 3 * CONVC;
    __syncthreads();
    float val[3];
#pragma unroll
    for (int i = 0; i < 3; ++i) {
        const int c = i * 512 + tid; const float x3 = bf2f(PB[768 + c]), h0 = hc[c], h1 = hc[CONVC + c], h2 = hc[2 * CONVC + c];
        val[i] = silu(cw[c] * h0 + cw[CONVC + c] * h1 + cw[2 * CONVC + c] * h2 + cw[3 * CONVC + c] * x3);
        nc[c] = h1; nc[CONVC + c] = h2; nc[2 * CONVC + c] = x3;
    }
    const float sq = wave_sum(val[0] * val[0]), sk = wave_sum(val[1] * val[1]);
    if ((tid & 63) == 0) { red[wid] = sq; red[8 + wid] = sk; }
    __syncthreads();
    const float ssq = red[2 * h] + red[2 * h + 1], ssk = red[8 + 2 * h] + red[8 + 2 * h + 1];
    qs[tid] = val[0] * rsqrtf(ssq + EPS) * 0.08838834764831845f; ks[tid] = val[1] * rsqrtf(ssk + EPS);
    __syncthreads();
    const float beta = 1.0f / (1.0f + __expf(-GBA[h]));
    const float x = GBA[4 + h] + p.in[14][h]; const float sp = x > 20.f ? x : log1pf(__expf(x));
    const float eg = __expf(-__expf(p.in[13][h]) * sp);
    const float* S0 = p.in[5] + ((size_t)(s * 4 + h) * 128) * 128 + dv; float* S1 = p.out + O_GS + ((size_t)(s * 4 + h) * 128) * 128 + dv;
    float kS = 0.f;
#pragma unroll 8
    for (int dk = 0; dk < 128; ++dk) kS += ks[h * 128 + dk] * S0[(size_t)dk * 128];
    const float delta = beta * (val[2] - eg * kS);
    float o = 0.f;
#pragma unroll 8
    for (int dk = 0; dk < 128; ++dk) { const float sv = eg * S0[(size_t)dk * 128] + ks[h * 128 + dk] * delta; S1[(size_t)dk * 128] = sv; o += qs[h * 128 + dk] * sv; }
    const float so = wave_sum(o * o);
    if ((tid & 63) == 0) red[16 + wid] = so;
    __syncthreads();
    const float tot = red[16 + 2 * h] + red[16 + 2 * h + 1];
    const float gz = bf2f(PB[2304 + tid]);
    PB[512 + tid] = f2bf(o * rsqrtf(tot * (1.0f / 128.0f) + EPS) * p.in[15][dv] * silu(gz));
}

__global__ void __launch_bounds__(512, 2) fwd_kernel(Params p, int ph_lo, int ph_hi) {
    extern __shared__ __attribute__((aligned(16))) unsigned char lds_raw[];
    LAS unsigned char* lds = (LAS unsigned char*)lds_raw;
    cg::grid_group grid = cg::this_grid();
    const int tid = threadIdx.x, lane = tid & 63, wid = tid >> 6, G = gridDim.x, bx = blockIdx.x;
    unsigned char* ws = p.ws;
    bf16_t* XN = (bf16_t*)(ws + WS_XN); bf16_t* XN2 = (bf16_t*)(ws + WS_XN2); bf16_t* HB = (bf16_t*)(ws + WS_H);
    float* SS1 = (float*)(ws + WS_SSP1); float* SS2 = (float*)(ws + WS_SSP2);
    float* Y = p.out; float* X2 = (float*)(ws + WS_GM); float* X3 = (float*)(ws + WS_XN);
#ifndef PHMASK
#define PHMASK 0x7ff
#endif
#define IN(k) (((PHMASK >> (k)) & 1) && ph_lo <= (k) && (k) < ph_hi)
#define SEAM(k) do { if (IN(k) && IN((k) + 1)) { asm volatile("s_waitcnt vmcnt(0) lgkmcnt(0)" ::: "memory"); grid.sync(); }     } while (0)

    if (IN(0)) p0_prologue(p, lds, bx, G);
    SEAM(0);
    if (IN(1)) {
        pg8::Gemm g{XN, (const bf16_t*)(ws + WS_W1IN), MPAD, 2 * DFF, DM, DM}; pg8::StaticOrder S; S.init(MPAD, 2 * DFF, G, bx);
        EpiSwiglu E{HB, nullptr}; pg8::gemm_phase<EpiSwiglu, pg8::StaticOrder>(lds, g, S, E, nullptr);
    }
    SEAM(1);
    if (IN(2)) {
        pg8::Gemm g{HB, (const bf16_t*)(ws + WS_W1OUT), MPAD, DM, DFF, DFF}; pg8::StaticOrder S; S.init(MPAD, DM, G, bx);
        EpiResid<false, false, true, true, true> E{p.in[0], p.in[1], nullptr, XN, SS1}; pg8::gemm_phase<EpiResid<false, false, true, true, true>, pg8::StaticOrder>(lds, g, S, E, nullptr);
    }
    SEAM(2);
    if (IN(3)) {
        pg8::Gemm g{XN, (const bf16_t*)(ws + WS_WINMIX), MPAD, NINP, DM, DM}; pg8::StaticOrder S; S.init(MPAD, NINP, G, bx);
        EpiInproj E{HB, (float*)(ws + WS_GBA), SS1}; pg8::gemm_phase<EpiInproj, pg8::StaticOrder>(lds, g, S, E, nullptr);
    }
    SEAM(3);
    if (IN(4)) {
        for (int u = bx; u < 2048; u += G) gdn_prep_unit(p, lds, u);
    }
    SEAM(4);
    if (IN(5)) {
#ifndef P5MASK
#define P5MASK 31
#endif
        if (bx < NSCAN) { if (P5MASK & 1) gdn_scan(p, lds, bx); }
        else {
            const int ab = bx - NSCAN, NAB = G - NSCAN;
            int it = ab;
#pragma unroll 1
            for (; it < 512; it += NAB) { if (P5MASK & 2) attn_unit(p, lds, it); }
#pragma unroll 1
            for (; it < 640; it += NAB) {
                if (wid < 2) sattn_unit(p, (it - 512) * 2 + wid, lane);
                sgdn_unit(p, lds, it - 512); }
            const bf16_t* PB = HB;
            for (int idx = ab * 512 + tid; idx < 149504; idx += NAB * 512) {
                if (idx < 131072) { const int w = idx >> 16, r = idx & 65535, b = r >> 14, j = (r >> 7) & 127, c = r & 127;
                    p.out[(w ? O_VP : O_KP) + r] = bf2f(PB[(size_t)(b * SEQ + SEQ - 128 + j) * PW + 512 + w * 128 + c]);
                } else { const int r = idx - 131072, b = r / (3 * CONVC), q = r % (3 * CONVC), rr = q / CONVC, c = q % CONVC;
                    p.out[O_CP + r] = bf2f(PB[(size_t)(b * SEQ + SEQ - 3 + rr) * PW + 768 + c]); }
            }
        }
    }
    SEAM(5);
    if (IN(6)) {
        for (int u = bx * 8 + wid; u < 2048; u += G * 8) gdn_gate_unit(p, u, lane);
    }
    SEAM(6);
#ifdef DBG_DUMP
    if (ph_lo == 11) {
        const float* src = (const float*)(ws + DBG_SRC);
        for (size_t i = (size_t)bx * 512 + tid; i < (size_t)MREAL * DM; i += (size_t)G * 512) Y[i] = (i < (size_t)MREAL * 8) ? ((const float*)(ws + WS_GBA))[i] : 0.f;
    }
#endif
    if (IN(7)) {
        pg8::Gemm g{HB, (const bf16_t*)(ws + WS_WOUTMIX), MPAD, DM, DM, PW}; pg8::StaticOrder S; S.init(MPAD, DM, G, bx);
        EpiResid<true, true, true, true, false> E{XN, XN + (size_t)MPR * DM, X2, XN2, SS2}; pg8::gemm_phase<EpiResid<true, true, true, true, false>, pg8::StaticOrder>(lds, g, S, E, nullptr);
    }
    SEAM(7);
    if (IN(8)) {
        pg8::Gemm g{XN2, (const bf16_t*)(ws + WS_W2IN), MPAD, 2 * DFF, DM, DM}; pg8::StaticOrder S; S.init(MPAD, 2 * DFF, G, bx);
        EpiSwiglu E{HB, SS2}; pg8::gemm_phase<EpiSwiglu, pg8::StaticOrder>(lds, g, S, E, nullptr);
    }
    SEAM(8);
    if (IN(9)) {
        pg8::Gemm g{HB, (const bf16_t*)(ws + WS_W2OUT), MPAD, DM, DFF, DFF}; pg8::StaticOrder S; S.init(MPAD, DM, G, bx);
        EpiResid<false, true, false, false, true> E{X2, X2 + (size_t)MPR * DM, X3, nullptr, nullptr}; pg8::gemm_phase<EpiResid<false, true, false, false, true>, pg8::StaticOrder>(lds, g, S, E, nullptr);
    }
    SEAM(9);
    if (IN(10)) {
        const float* gf = p.in[20]; f32x4 gv[4];
#pragma unroll
        for (int j = 0; j < 4; ++j) gv[j] = *((const f32x4*)gf + lane + 64 * j);
        for (int m = bx * 8 + wid; m < MREAL; m += G * 8) {
            const f32x4* xr = (const f32x4*)(X3 + (size_t)m * DM) + lane; f32x4* yr = (f32x4*)(Y + (size_t)m * DM) + lane; f32x4 v[4]; float s = 0.f;
#pragma unroll
            for (int j = 0; j < 4; ++j) { v[j] = xr[64 * j]; s += (v[j][0] * v[j][0] + v[j][1] * v[j][1]) + (v[j][2] * v[j][2] + v[j][3] * v[j][3]); }
            const float rstd = rsqrtf(wave_sum(s) * (1.0f / DM) + EPS);
#pragma unroll
            for (int j = 0; j < 4; ++j) yr[64 * j] = v[j] * rstd * gv[j];
        }
    }
#undef IN
#undef SEAM
}
}

#ifndef MK_N_LAUNCHES
#define MK_N_LAUNCHES 1
#endif
extern "C" void kernel_launch(void* const* d_in, const int* in_sizes, int n_in, void* d_out, int out_size, void* d_ws, size_t ws_size, hipStream_t stream) {
    static int grid = 0;
    if (grid == 0) {
        if (n_in != 21 || ws_size < mk::WS_END || out_size != 47269888) { fprintf(stderr, "kernel_launch: unexpected shapes (n_in %d, ws %zu, out %d)\n", n_in, ws_size, out_size); grid = -1; return; }
        int dev = 0, cus = 0, per_cu = 0;
        (void)hipGetDevice(&dev); (void)hipDeviceGetAttribute(&cus, hipDeviceAttributeMultiprocessorCount, dev);
        if (hipFuncSetAttribute((const void*)mk::fwd_kernel, hipFuncAttributeMaxDynamicSharedMemorySize, mk::LDS_BYTES) != hipSuccess) { fprintf(stderr, "kernel_launch: hipFuncSetAttribute failed\n"); grid = -1; return; }
        if (hipOccupancyMaxActiveBlocksPerMultiprocessor(&per_cu, (const void*)mk::fwd_kernel, 512, mk::LDS_BYTES) != hipSuccess || per_cu < 1) { fprintf(stderr, "kernel_launch: occupancy query failed (%d)\n", per_cu); per_cu = 1; }
        (void)hipGetLastError();
        grid = cus * per_cu;
        if (grid <= mk::NSCAN) { fprintf(stderr, "kernel_launch: grid %d too small\n", grid); grid = -1; return; }
    }
    if (grid < 0) return;
    mk::Params p{};
    for (int i = 0; i < 21; ++i) p.in[i] = (const float*)d_in[i];
    p.out = (float*)d_out; p.ws = (unsigned char*)d_ws;
#if MK_N_LAUNCHES == 1
    int lo = 0, hi = 11; void* args[] = {&p, &lo, &hi};
    hipError_t e = hipLaunchCooperativeKernel((const void*)mk::fwd_kernel, dim3(grid), dim3(512), args, mk::LDS_BYTES, stream);
    if (e != hipSuccess) fprintf(stderr, "kernel_launch: cooperative launch failed: %s (grid %d)\n", hipGetErrorString(e), grid);
#else
#ifndef MK_LAST
#define MK_LAST 11
#ifndef MK_DOUBLE
#define MK_DOUBLE 0x10
#endif
#define DBG_C0 512
#define DBG_C1 1024
#endif
    for (int ph = 0; ph < MK_LAST; ++ph) { const int reps = ((MK_DOUBLE >> ph) & 1) ? 2 : 1; for (int r = 0; r < reps; ++r) hipLaunchKernelGGL(mk::fwd_kernel, dim3(grid), dim3(512), mk::LDS_BYTES, stream, p, ph, ph + 1); }
#ifdef DBG_DUMP
    hipLaunchKernelGGL(mk::fwd_kernel, dim3(grid), dim3(512), mk::LDS_BYTES, stream, p, 11, 12);
#endif
#endif
}
```

```cpp
#include <hip/hip_runtime.h>
#include <hip/hip_cooperative_groups.h>
#include <cstdio>
namespace cg = cooperative_groups;
namespace pg8 {
#define PG8_LAS __attribute__((address_space(3)))
typedef unsigned short bf16_t;
typedef short bf16x8 __attribute__((ext_vector_type(8)));
typedef float f32x4 __attribute__((ext_vector_type(4)));
typedef unsigned u32x4 __attribute__((ext_vector_type(4)));
constexpr int BM = 256, BK = 64, HALF = 128, HTB = HALF * BK * 2  , STAGE_BYTES = 8 * HTB, NXCD = 8, WGM = 8;

__host__ __device__ __forceinline__ int lds_byte(int r, int c) { const int st = (r >> 4) * 2 + (c >> 5), rr = r & 15, cc = c & 31, ob = rr * 64 + cc * 2; return st * 1024 + (ob ^ (((ob >> 9) & 1) << 5)); }
__host__ __device__ __forceinline__ void stage_rc(int b, int& R, int& C) { const int st = b / 1024, sb = b % 1024, swz = sb ^ (((sb >> 9) & 1) << 5); R = (st >> 1) * 16 + swz / 64; C = (st & 1) * 32 + (swz % 64) / 2; }
__host__ __device__ __forceinline__ int perm32(int rho) { const int n = rho >> 4, i = rho & 15; return 8 * (i >> 2) + 4 * n + (i & 3); }

struct Unit { int pm, pn; };
struct Gemm { const bf16_t* A; const bf16_t* Bt; int M, N, K, lda; };

struct StaticOrder {
    int nM, nN, nwg, G, c;
    __host__ __device__ void init(int M, int N, int G_, int c_) { nM = M / BM; nN = N / BM; nwg = nM * nN; G = G_; c = c_; }
    __host__ __device__ bool next(int i, Unit& u) const {
        const long L = (long)i * G + c; if (L >= nwg) return false;
        int wgid = (int)L; { const int q = nwg / NXCD, r = nwg % NXCD, xcd = wgid % NXCD, off = wgid / NXCD; wgid = (xcd < r ? xcd * (q + 1) : r * (q + 1) + (xcd - r) * q) + off; }
        const int nig = WGM * nN, gid = wgid / nig, fm = gid * WGM, gsz = (nM - fm) < WGM ? (nM - fm) : WGM;
        u.pm = fm + ((wgid % nig) % gsz); u.pn = (wgid % nig) / gsz; return true;
    }
    __device__ __forceinline__ void a_ready(const Unit&) const {}
    __device__ __forceinline__ void done(const Unit&) const {}
};
struct CountedOrder : StaticOrder {
    const unsigned* ready; unsigned need; unsigned* tmo;
    __device__ __forceinline__ void a_ready(const Unit& u) const {
        if (threadIdx.x < 64) {
            const unsigned long long t0 = __builtin_amdgcn_s_memrealtime(); unsigned polls = 0;
            while ((unsigned)__builtin_amdgcn_readfirstlane(__hip_atomic_load(ready + 64 * u.pm, __ATOMIC_RELAXED, __HIP_MEMORY_SCOPE_AGENT)) < need) {
                if ((++polls & 255u) == 0u && __builtin_amdgcn_readfirstlane(__hip_atomic_load(tmo, __ATOMIC_RELAXED, __HIP_MEMORY_SCOPE_AGENT)) != 0u) break;
                if (__builtin_amdgcn_s_memrealtime() - t0 > 2000000ull) {
                    if (threadIdx.x == 0) { unsigned expect = 0u; __hip_atomic_compare_exchange_strong(tmo + 1, &expect, 0x600u | (unsigned)(u.pm & 0xff), __ATOMIC_RELAXED, __ATOMIC_RELAXED, __HIP_MEMORY_SCOPE_AGENT); __hip_atomic_store(tmo, 1u, __ATOMIC_RELAXED, __HIP_MEMORY_SCOPE_AGENT); }
                    break; }
                __builtin_amdgcn_s_sleep(2); }
            __builtin_amdgcn_fence(__ATOMIC_ACQUIRE, "agent");
            asm volatile("s_waitcnt vmcnt(0)" ::: "memory");
        }
#if !defined(BROKEN_HOOK_NO_BARRIER)
        asm volatile("" ::: "memory"); __builtin_amdgcn_s_barrier(); asm volatile("" ::: "memory");
#endif
    }
};

__device__ __forceinline__ unsigned cvt_pk_bf16(float lo, float hi) { unsigned r; asm volatile("v_cvt_pk_bf16_f32 %0, %1, %2" : "=v"(r) : "v"(lo), "v"(hi)); return r; }
typedef float f32x2 __attribute__((ext_vector_type(2)));
__device__ __forceinline__ f32x2 gelu_pk(f32x2 v) {
    const f32x2 av = __builtin_elementwise_abs(v), d = av * 0.2316418882f + 1.0f;
    f32x2 t; t.x = __builtin_amdgcn_rcpf(d.x); t.y = __builtin_amdgcn_rcpf(d.y);
    f32x2 q = t * 0.5307027145f + (-0.7265760135f); q = q * t + 0.7107068705f; q = q * t + (-0.142248368f); q = q * t + 0.127414796f; q = q * t;
    const f32x2 s = (v * v) * (-0.72134752044f);
    f32x2 e; e.x = __builtin_amdgcn_exp2f(s.x); e.y = __builtin_amdgcn_exp2f(s.y);
    const f32x2 m = v * (q * e), r = v - m;
    f32x2 o; o.x = v.x < 0.f ? m.x : r.x; o.y = v.y < 0.f ? m.y : r.y; return o;
}

struct EpiF32 {
    static constexpr bool PERM = false, AFTER_DRAIN = false;
    float* C; int ldc; const float* bias;
    __device__ __forceinline__ void operator()(const f32x4 (&acc)[2][2][4][2], const Unit& u, int wr, int wc, int fr, int fq) const {
        const int row0 = u.pm * BM + wr * 64 + fr, col0 = u.pn * BM + wc * 32 + 4 * fq;
        f32x4 bv[2][2];
#pragma unroll
        for (int bj = 0; bj < 2; ++bj)
#pragma unroll
            for (int n = 0; n < 2; ++n) bv[bj][n] = bias ? *(const f32x4*)(bias + col0 + bj * HALF + n * 16) : (f32x4){0.f, 0.f, 0.f, 0.f};
#pragma unroll
        for (int ai = 0; ai < 2; ++ai)
#pragma unroll
            for (int m = 0; m < 4; ++m) { float* rowp = C + (size_t)(row0 + ai * HALF + m * 16) * ldc + col0;
#pragma unroll
                for (int bj = 0; bj < 2; ++bj)
#pragma unroll
                    for (int n = 0; n < 2; ++n) *(f32x4*)(rowp + bj * HALF + n * 16) = acc[ai][bj][m][n] + bv[bj][n]; }
    }
};
template <int ACT  > struct EpiBf16 {
    static constexpr bool PERM = true, AFTER_DRAIN = false;
    bf16_t* O; int ldc; const float* bias; int split_cols; size_t split_stride;
    __device__ __forceinline__ void operator()(const f32x4 (&acc)[2][2][4][2], const Unit& u, int wr, int wc, int fr, int fq) const {
        const int row0 = u.pm * BM + wr * 64 + fr; int colt = u.pn * BM; bf16_t* base = O;
        if (split_cols) { const int t = colt / split_cols; base += (size_t)t * split_stride; colt -= t * split_cols; }
        const int col0 = colt + wc * 32 + 8 * fq, bcol0 = u.pn * BM + wc * 32 + 8 * fq;
        f32x4 bv[2][2];
#pragma unroll
        for (int bj = 0; bj < 2; ++bj)
#pragma unroll
            for (int n = 0; n < 2; ++n) bv[bj][n] = bias ? *(const f32x4*)(bias + bcol0 + bj * HALF + 4 * n) : (f32x4){0.f, 0.f, 0.f, 0.f};
#pragma unroll
        for (int ai = 0; ai < 2; ++ai)
#pragma unroll
            for (int m = 0; m < 4; ++m) { bf16_t* rowp = base + (size_t)(row0 + ai * HALF + m * 16) * ldc + col0;
#pragma unroll
                for (int bj = 0; bj < 2; ++bj) { f32x4 v0 = acc[ai][bj][m][0] + bv[bj][0], v1 = acc[ai][bj][m][1] + bv[bj][1];
                    if (ACT == 1) { f32x2 a = gelu_pk((f32x2){v0[0], v0[1]}), b = gelu_pk((f32x2){v0[2], v0[3]}), c = gelu_pk((f32x2){v1[0], v1[1]}), d = gelu_pk((f32x2){v1[2], v1[3]});
                        v0 = (f32x4){a.x, a.y, b.x, b.y}; v1 = (f32x4){c.x, c.y, d.x, d.y}; }
                    if (ACT == 2) {
#pragma unroll
                        for (int j = 0; j < 4; ++j) { v0[j] = 0.5f * v0[j] * (1.0f + erff(v0[j] * 0.70710678f)); v1[j] = 0.5f * v1[j] * (1.0f + erff(v1[j] * 0.70710678f)); } }
                    u32x4 w; w.x = cvt_pk_bf16(v0[0], v0[1]); w.y = cvt_pk_bf16(v0[2], v0[3]); w.z = cvt_pk_bf16(v1[0], v1[1]); w.w = cvt_pk_bf16(v1[2], v1[3]);
                    *(u32x4*)(rowp + bj * HALF) = w; } }
    }
};

struct PanelStats {
    unsigned* xbuf;
    unsigned* cnt;
    unsigned* tmo;
    int ntn; float eps;
    unsigned code;
    __device__ __forceinline__ bool run(const f32x4 (&v)[2][2][4][2], const Unit& u, int wr, int wc, int fr, int fq, PG8_LAS unsigned char* lds, int wid, int lane) const {
        typedef float f32x2v __attribute__((ext_vector_type(2)));
        PG8_LAS f32x2v* P = (PG8_LAS f32x2v*)lds;
        PG8_LAS f32x2v* S = (PG8_LAS f32x2v*)(lds + 8192);
        PG8_LAS unsigned* flag = (PG8_LAS unsigned*)(lds + 8192 + 2048);
#pragma unroll
        for (int ai = 0; ai < 2; ++ai)
#pragma unroll
            for (int m = 0; m < 4; ++m) {
                float s = 0.f;
#pragma unroll
                for (int bj = 0; bj < 2; ++bj)
#pragma unroll
                    for (int n = 0; n < 2; ++n) { const f32x4 x = v[ai][bj][m][n]; s += (x[0] + x[1]) + (x[2] + x[3]); }
                s += __shfl_xor(s, 16); s += __shfl_xor(s, 32);
                const float mw = s * (1.0f / 64.0f); float q = 0.f;
#pragma unroll
                for (int bj = 0; bj < 2; ++bj)
#pragma unroll
                    for (int n = 0; n < 2; ++n) { const f32x4 d = v[ai][bj][m][n] - mw; q += (d[0] * d[0] + d[1] * d[1]) + (d[2] * d[2] + d[3] * d[3]); }
                q += __shfl_xor(q, 16); q += __shfl_xor(q, 32);
                if (fq == 0) P[(ai * HALF + wr * 64 + m * 16 + fr) * 4 + wc] = (f32x2v){mw, q};
            }
        asm volatile("s_waitcnt lgkmcnt(0)" ::: "memory"); __builtin_amdgcn_s_barrier(); asm volatile("" ::: "memory");
#if defined(BROKEN_NO_WAIT)
        if (blockIdx.x >= 64) { const long long t0 = clock64(); while (clock64() - t0 < 60000) __builtin_amdgcn_s_sleep(8); }
#endif
        const int row = wid * 32 + (lane & 31);
        if (lane < 32) {
            const f32x2v a = P[row * 4 + 0], b = P[row * 4 + 1], c = P[row * 4 + 2], d = P[row * 4 + 3];
            const float mt = (a.x + b.x + c.x + d.x) * 0.25f;
            const float da = a.x - mt, db = b.x - mt, dc = c.x - mt, dd = d.x - mt;
            const float m2 = (a.y + b.y) + (c.y + d.y) + 64.0f * ((da * da + db * db) + (dc * dc + dd * dd));
            unsigned long long* slot = (unsigned long long*)xbuf + ((size_t)(u.pm * BM + row) * 4 + u.pn);
            __hip_atomic_store(slot, ((unsigned long long)__float_as_uint(m2) << 32) | __float_as_uint(mt), __ATOMIC_RELAXED, __HIP_MEMORY_SCOPE_AGENT);
        }
        asm volatile("s_waitcnt vmcnt(0)" ::: "memory");
        if (lane == 0) __hip_atomic_fetch_add(cnt + 64 * u.pm, 1u, __ATOMIC_RELAXED, __HIP_MEMORY_SCOPE_AGENT);
        if (wid == 0) {
            bool dead = false; const unsigned long long t0 = __builtin_amdgcn_s_memrealtime(); const unsigned want = 8u * (unsigned)ntn;
            for (;;) {
#if defined(BROKEN_NO_WAIT)
                break;
#endif
                if ((unsigned)__builtin_amdgcn_readfirstlane(__hip_atomic_load(cnt + 64 * u.pm, __ATOMIC_RELAXED, __HIP_MEMORY_SCOPE_AGENT)) >= want) break;
                if (__builtin_amdgcn_s_memrealtime() - t0 > 2000000ull) {
                    if (lane == 0) { unsigned expect = 0u; __hip_atomic_compare_exchange_strong(tmo + 1, &expect, code | (unsigned)(u.pm & 0xff), __ATOMIC_RELAXED, __ATOMIC_RELAXED, __HIP_MEMORY_SCOPE_AGENT);
                                     __hip_atomic_store(tmo, 1u, __ATOMIC_RELAXED, __HIP_MEMORY_SCOPE_AGENT); }
                    dead = true; break; }
                __builtin_amdgcn_s_sleep(2);
            }
            __builtin_amdgcn_fence(__ATOMIC_ACQUIRE, "agent");
            if (lane == 0) flag[0] = dead ? 1u : 0u;
        }
        asm volatile("s_waitcnt vmcnt(0) lgkmcnt(0)" ::: "memory"); __builtin_amdgcn_s_barrier(); asm volatile("" ::: "memory");
        const bool bad = flag[0] != 0u;
        if (lane < 32) {
            const unsigned long long* slot = (const unsigned long long*)xbuf + (size_t)(u.pm * BM + row) * 4; float mt[4], m2[4]; float ms = 0.f;
#pragma unroll
            for (int t = 0; t < 4; ++t) { if (t < ntn) { const unsigned long long w = __hip_atomic_load(slot + t, __ATOMIC_RELAXED, __HIP_MEMORY_SCOPE_AGENT); mt[t] = __uint_as_float((unsigned)w); m2[t] = __uint_as_float((unsigned)(w >> 32)); } else { mt[t] = 0.f; m2[t] = 0.f; } ms += mt[t]; }
            const float mean = ms / (float)ntn; float q = 0.f;
#pragma unroll
            for (int t = 0; t < 4; ++t) if (t < ntn) { const float dm = mt[t] - mean; q += m2[t] + 256.0f * dm * dm; }
            S[row] = (f32x2v){mean, 1.0f / sqrtf(q / (256.0f * (float)ntn) + eps)};
        }
        asm volatile("s_waitcnt lgkmcnt(0)" ::: "memory"); __builtin_amdgcn_s_barrier(); asm volatile("" ::: "memory");
        return bad;
    }
};
struct EpiLnRes {
    static constexpr bool PERM = false, AFTER_DRAIN = true;
    const float* base; float* out; int ldc; const float* bias; PanelStats st; unsigned poison;
    __device__ __forceinline__ void refuse(size_t i0, size_t stride, int M, int N) const { const float q = __builtin_nanf(""); for (size_t i = i0; i < (size_t)M * N; i += stride) out[(i / N) * ldc + i % N] = q;
        if (i0 == 0) { unsigned expect = 0u; __hip_atomic_compare_exchange_strong(st.tmo + 1, &expect, 0x7f0u, __ATOMIC_RELAXED, __ATOMIC_RELAXED, __HIP_MEMORY_SCOPE_AGENT); __hip_atomic_store(st.tmo, 1u, __ATOMIC_RELAXED, __HIP_MEMORY_SCOPE_AGENT); } }
    __device__ __forceinline__ void fused(f32x4 (&acc)[2][2][4][2], const Unit& u, int wr, int wc, int fr, int fq, PG8_LAS unsigned char* lds, int wid, int lane) const {
        typedef float f32x2v __attribute__((ext_vector_type(2)));
        const PG8_LAS f32x2v* S = (const PG8_LAS f32x2v*)(lds + 8192);
        const int col0 = u.pn * BM + wc * 32 + 4 * fq;
#pragma unroll
        for (int bj = 0; bj < 2; ++bj)
#pragma unroll
            for (int n = 0; n < 2; ++n) { const f32x4 bv = bias ? *(const f32x4*)(bias + col0 + bj * HALF + n * 16) : (f32x4){0.f, 0.f, 0.f, 0.f};
#pragma unroll
                for (int ai = 0; ai < 2; ++ai)
#pragma unroll
                    for (int m = 0; m < 4; ++m) acc[ai][bj][m][n] += bv; }
        const bool bad = st.run(acc, u, wr, wc, fr, fq, lds, wid, lane) || poison != 0u;
        const float qnan = __builtin_nanf("");
#pragma unroll
        for (int ai = 0; ai < 2; ++ai)
#pragma unroll
            for (int m = 0; m < 4; ++m) { const int r = ai * HALF + wr * 64 + m * 16 + fr; const f32x2v sr = S[r]; const size_t off = (size_t)(u.pm * BM + r) * ldc + col0;
#pragma unroll
                for (int bj = 0; bj < 2; ++bj)
#pragma unroll
                    for (int n = 0; n < 2; ++n) { const f32x4 bs = *(const f32x4*)(base + off + bj * HALF + n * 16); f32x4 o = bs + (acc[ai][bj][m][n] - sr.x) * sr.y;
                        if (bad) o = (f32x4){qnan, qnan, qnan, qnan}; *(f32x4*)(out + off + bj * HALF + n * 16) = o; }
                asm volatile("" ::: "memory"); }
    }
};
struct EpiLnResLn {
    static constexpr bool PERM = false, AFTER_DRAIN = true;
    const float* base; float* out; bf16_t* xn; int ldc; const float* bias; PanelStats st1, st2; unsigned poison;
    __device__ __forceinline__ void refuse(size_t i0, size_t stride, int M, int N) const { const float q = __builtin_nanf(""); for (size_t i = i0; i < (size_t)M * N; i += stride) { const size_t o = (i / N) * ldc + i % N; out[o] = q; xn[o] = (bf16_t)0x7fc0u; }
        if (i0 == 0) { unsigned expect = 0u; __hip_atomic_compare_exchange_strong(st1.tmo + 1, &expect, 0x7f0u, __ATOMIC_RELAXED, __ATOMIC_RELAXED, __HIP_MEMORY_SCOPE_AGENT); __hip_atomic_store(st1.tmo, 1u, __ATOMIC_RELAXED, __HIP_MEMORY_SCOPE_AGENT); } }
    __device__ __forceinline__ void fused(f32x4 (&acc)[2][2][4][2], const Unit& u, int wr, int wc, int fr, int fq, PG8_LAS unsigned char* lds, int wid, int lane) const {
        typedef float f32x2v __attribute__((ext_vector_type(2))); typedef unsigned u32x2v __attribute__((ext_vector_type(2)));
        const PG8_LAS f32x2v* S = (const PG8_LAS f32x2v*)(lds + 8192);
        const int col0 = u.pn * BM + wc * 32 + 4 * fq;
#pragma unroll
        for (int bj = 0; bj < 2; ++bj)
#pragma unroll
            for (int n = 0; n < 2; ++n) { const f32x4 bv = bias ? *(const f32x4*)(bias + col0 + bj * HALF + n * 16) : (f32x4){0.f, 0.f, 0.f, 0.f};
#pragma unroll
                for (int ai = 0; ai < 2; ++ai)
#pragma unroll
                    for (int m = 0; m < 4; ++m) acc[ai][bj][m][n] += bv; }
        bool bad = st1.run(acc, u, wr, wc, fr, fq, lds, wid, lane) || poison != 0u;
        const float qnan = __builtin_nanf("");
#pragma unroll
        for (int ai = 0; ai < 2; ++ai)
#pragma unroll
            for (int m = 0; m < 4; ++m) { const int r = ai * HALF + wr * 64 + m * 16 + fr; const f32x2v sr = S[r]; const size_t off = (size_t)(u.pm * BM + r) * ldc + col0;
#pragma unroll
                for (int bj = 0; bj < 2; ++bj)
#pragma unroll
                    for (int n = 0; n < 2; ++n) { const f32x4 bs = *(const f32x4*)(base + off + bj * HALF + n * 16); acc[ai][bj][m][n] = bs + (acc[ai][bj][m][n] - sr.x) * sr.y; }
                asm volatile("" : "+v"(acc[ai][0][m][0]), "+v"(acc[ai][0][m][1]), "+v"(acc[ai][1][m][0]), "+v"(acc[ai][1][m][1]));
                if (m & 1) asm volatile("" ::: "memory"); }
        const bool bad1 = bad;
        bad = st2.run(acc, u, wr, wc, fr, fq, lds, wid, lane) || bad;
#pragma unroll
        for (int ai = 0; ai < 2; ++ai)
#pragma unroll
            for (int m = 0; m < 4; ++m) { const int r = ai * HALF + wr * 64 + m * 16 + fr; const f32x2v sr = S[r]; const size_t off = (size_t)(u.pm * BM + r) * ldc + col0;
#pragma unroll
                for (int bj = 0; bj < 2; ++bj)
#pragma unroll
                    for (int n = 0; n < 2; ++n) { const f32x4 x1 = acc[ai][bj][m][n]; *(f32x4*)(out + off + bj * HALF + n * 16) = bad1 ? (f32x4){qnan, qnan, qnan, qnan} : x1;
                        const f32x4 o = (x1 - sr.x) * sr.y; u32x2v w; w.x = cvt_pk_bf16(o[0], o[1]); w.y = cvt_pk_bf16(o[2], o[3]);
                        if (bad) { w.x = 0x7fc07fc0u; w.y = 0x7fc07fc0u; } *(u32x2v*)(xn + off + bj * HALF + n * 16) = w; }
                asm volatile("" ::: "memory"); }
    }
};

template <class Epi, class Sched, bool STAMP = false>
__device__ __forceinline__ void gemm_phase(PG8_LAS unsigned char* lds, const Gemm g, const Sched S, const Epi E, unsigned long long* stamps) {
    const int tid = threadIdx.x, wid = __builtin_amdgcn_readfirstlane(tid >> 6), lane = tid & 63, wr = wid >> 2, wc = wid & 3, fr = lane & 15, fq = lane >> 4;
    const int K = g.K, nt = K / BK;
    int ts_lo = 0, ts_hi = 0, nts = 0; const unsigned long long rt_entry = STAMP ? (unsigned long long)wall_clock64() : 0ull;
#define PG8_STAMP() do { if (STAMP && wid == 0 && nts < 64) { const unsigned long long _c = (unsigned long long)clock64(); \
        ts_lo = (lane == nts) ? (int)(unsigned)_c : ts_lo; ts_hi = (lane == nts) ? (int)(unsigned)(_c >> 32) : ts_hi; ++nts; } } while (0)
    PG8_STAMP();
    unsigned voffA[2], voffB[2];
#pragma unroll
    for (int i = 0; i < 2; ++i) { int R, C; stage_rc(tid * 16 + i * 8192, R, C); const int Rb = Epi::PERM ? ((R & ~31) + perm32(R & 31)) : R;
        voffA[i] = (unsigned)(R * g.lda + C) * 2u; voffB[i] = (unsigned)(Rb * K + C) * 2u; }
    const size_t kstep = (size_t)(BK * 2);
    const size_t hstep = (size_t)HALF * K * 2;
    const size_t tstep = 2 * hstep;
    const size_t hstepA = (size_t)HALF * g.lda * 2, tstepA = 2 * hstepA;
    const unsigned ldsw = (unsigned)wid * 1024u;
    const int aoff = lds_byte(wr * 64 + fr, fq * 8), boff = lds_byte(wc * 32 + fr, fq * 8);
#define PG8_SA(b, h) (((b) * 2 + (h)) * HTB)
#define PG8_SB(b, h) ((4 + (b) * 2 + (h)) * HTB)
#define PG8_STAGE(bufoff, gbase, voff) do { _Pragma("unroll") for (int _i = 0; _i < 2; ++_i) \
        __builtin_amdgcn_global_load_lds((const unsigned*)((const char*)(gbase) + (voff)[_i]), (PG8_LAS unsigned*)(lds + (bufoff) + ldsw + _i * 8192), 16, 0, 0); } while (0)
#define PG8_LDA(dst, b, h) do { _Pragma("unroll") for (int m = 0; m < 4; ++m) _Pragma("unroll") for (int k = 0; k < 2; ++k) dst[m][k] = *(const PG8_LAS bf16x8*)(lds + PG8_SA(b, h) + aoff + m * 2048 + k * 1024); } while (0)
#define PG8_LDB(dst, b, h) do { _Pragma("unroll") for (int n = 0; n < 2; ++n) _Pragma("unroll") for (int k = 0; k < 2; ++k) dst[n][k] = *(const PG8_LAS bf16x8*)(lds + PG8_SB(b, h) + boff + n * 2048 + k * 1024); } while (0)
#define PG8_MMA(ai, bj, At, Bt) do { __builtin_amdgcn_s_setprio(1); _Pragma("unroll") for (int m = 0; m < 4; ++m) _Pragma("unroll") for (int n = 0; n < 2; ++n) _Pragma("unroll") for (int k = 0; k < 2; ++k) \
        acc[ai][bj][m][n] = __builtin_amdgcn_mfma_f32_16x16x32_bf16(Bt[n][k], At[m][k], acc[ai][bj][m][n], 0, 0, 0); __builtin_amdgcn_s_setprio(0); } while (0)
#define PG8_WAIT_V(n) asm volatile("s_waitcnt vmcnt(" #n ")" ::: "memory")
#define PG8_WAIT_L(n) asm volatile("s_waitcnt lgkmcnt(" #n ")" ::: "memory")
#define PG8_BAR __builtin_amdgcn_s_barrier()
#define PG8_SCHED __builtin_amdgcn_sched_barrier(0)
    Unit cur, nxt; int ui = 0;
    if (!S.next(0, cur)) return;
    f32x4 acc[2][2][4][2];
#pragma unroll
    for (int a = 0; a < 2; ++a)
#pragma unroll
        for (int b = 0; b < 2; ++b)
#pragma unroll
            for (int m = 0; m < 4; ++m)
#pragma unroll
                for (int n = 0; n < 2; ++n) acc[a][b][m][n] = (f32x4){0.f, 0.f, 0.f, 0.f};
    bf16x8 At[4][2], B0[2][2], B1[2][2];
    const char* cA = (const char*)g.A + (size_t)cur.pm * tstepA; const char* cB = (const char*)g.Bt + (size_t)cur.pn * tstep;
    S.a_ready(cur);
    PG8_STAGE(PG8_SB(0, 0), cB, voffB); PG8_STAGE(PG8_SA(0, 0), cA, voffA); PG8_STAGE(PG8_SB(0, 1), cB + hstep, voffB); PG8_STAGE(PG8_SA(0, 1), cA + hstepA, voffA);
    if (wr == 1) PG8_BAR;
    PG8_WAIT_V(4); PG8_BAR;
    PG8_STAGE(PG8_SB(1, 0), cB + kstep, voffB); PG8_STAGE(PG8_SA(1, 0), cA + kstep, voffA); PG8_STAGE(PG8_SB(1, 1), cB + hstep + kstep, voffB);
    PG8_WAIT_V(6); PG8_BAR;
    PG8_STAMP();
    for (;;) {
        const bool has_next = S.next(ui + 1, nxt);
        const char* nA = has_next ? (const char*)g.A + (size_t)nxt.pm * tstepA : cA; const char* nB = has_next ? (const char*)g.Bt + (size_t)nxt.pn * tstep : cB;
        for (int t = 0; t < nt; t += 2) {
            const bool last = (t == nt - 2);
            const char* a1 = cA + (size_t)(t + 1) * kstep;
            const char* a2 = last ? nA : cA + (size_t)(t + 2) * kstep; const char* b2 = last ? nB : cB + (size_t)(t + 2) * kstep;
            const char* a3 = a2 + kstep; const char* b3 = b2 + kstep;
            if (last && has_next) S.a_ready(nxt);
            PG8_LDB(B0, 0, 0); PG8_SCHED; PG8_LDA(At, 0, 0); PG8_STAGE(PG8_SA(1, 1), a1 + hstepA, voffA);
            PG8_WAIT_L(8); PG8_BAR; PG8_WAIT_L(0); PG8_MMA(0, 0, At, B0); PG8_BAR; PG8_SCHED;
            PG8_LDB(B1, 0, 1); PG8_STAGE(PG8_SB(0, 0), b2, voffB);
            PG8_BAR; PG8_WAIT_L(0); PG8_MMA(0, 1, At, B1); PG8_BAR;
            PG8_LDA(At, 0, 1); PG8_STAGE(PG8_SA(0, 0), a2, voffA);
            PG8_BAR; PG8_WAIT_L(0); PG8_MMA(1, 0, At, B0); PG8_BAR; PG8_SCHED;
            PG8_STAGE(PG8_SB(0, 1), b2 + hstep, voffB);
            PG8_WAIT_V(6); PG8_BAR; PG8_MMA(1, 1, At, B1); PG8_BAR;
            PG8_LDB(B0, 1, 0); PG8_SCHED; PG8_LDA(At, 1, 0); PG8_STAGE(PG8_SA(0, 1), a2 + hstepA, voffA);
            PG8_WAIT_L(8); PG8_BAR; PG8_WAIT_L(0); PG8_MMA(0, 0, At, B0); PG8_BAR; PG8_SCHED;
            PG8_LDB(B1, 1, 1); PG8_STAGE(PG8_SB(1, 0), b3, voffB);
            PG8_BAR; PG8_WAIT_L(0); PG8_MMA(0, 1, At, B1); PG8_BAR;
            PG8_LDA(At, 1, 1); PG8_STAGE(PG8_SA(1, 0), a3, voffA);
            PG8_BAR; PG8_WAIT_L(0); PG8_MMA(1, 0, At, B0); PG8_BAR; PG8_SCHED;
            PG8_STAGE(PG8_SB(1, 1), b3 + hstep, voffB);
            PG8_WAIT_V(6); PG8_BAR; PG8_MMA(1, 1, At, B1); PG8_BAR;
        }
        PG8_STAMP();
        if constexpr (!Epi::AFTER_DRAIN) { E(acc, cur, wr, wc, fr, fq); S.done(cur); }
        PG8_STAMP();
        if (!has_next) break;
#pragma unroll
        for (int a = 0; a < 2; ++a)
#pragma unroll
            for (int b = 0; b < 2; ++b)
#pragma unroll
                for (int m = 0; m < 4; ++m)
#pragma unroll
                    for (int n = 0; n < 2; ++n) acc[a][b][m][n] = (f32x4){0.f, 0.f, 0.f, 0.f};
        cur = nxt; cA = nA; cB = nB; ++ui;
    }
    PG8_WAIT_V(0);
    if (wr == 0) PG8_BAR;
    PG8_BAR;
    if constexpr (Epi::AFTER_DRAIN) { E.fused(acc, cur, wr, wc, fr, fq, lds, wid, lane); S.done(cur); }
    PG8_STAMP();
    if (STAMP && wid == 0) { stamps[lane] = lane < nts ? (((unsigned long long)(unsigned)ts_hi << 32) | (unsigned)ts_lo) : 0ull;
        if (lane == 62) stamps[62] = rt_entry; if (lane == 63) stamps[63] = (unsigned long long)wall_clock64(); }
#undef PG8_STAMP
#undef PG8_SA
#undef PG8_SB
#undef PG8_STAGE
#undef PG8_LDA
#undef PG8_LDB
#undef PG8_MMA
#undef PG8_WAIT_V
#undef PG8_WAIT_L
#undef PG8_BAR
#undef PG8_SCHED
}
}

namespace mk {
#define LAS __attribute__((address_space(3)))
using pg8::bf16_t; using pg8::bf16x8; using pg8::f32x4; using pg8::u32x4;
typedef unsigned u32x2 __attribute__((ext_vector_type(2)));

constexpr int DM = 1024, SEQ = 8192, NBATCH = 4, MPR = NBATCH * SEQ, MSAMP = 128, MREAL = MPR + MSAMP, MPAD = 33024;
constexpr int DFF = 2816, PW = 2816, NINP = 3072, CONVC = 1536;
constexpr float EPS = 1e-6f;
constexpr int NSCAN = 64;
constexpr int LDS_PHASE_BYTES = 147456, LDS_BYTES = LDS_PHASE_BYTES + 256;

constexpr size_t O_YP = 0, O_YS = 33554432, O_KP = 33685504, O_VP = 33751040, O_CP = 33816576, O_GP = 33835008,
                 O_KS = 34097152, O_VS = 36194304, O_CS = 38291456, O_GS = 38881280;
constexpr size_t MiB = 1u << 20;
constexpr size_t WS_CTL = 0, CTL_ZERO_BYTES = 1 * MiB;
constexpr size_t WS_W1IN = 1 * MiB, WS_W1OUT = 12 * MiB, WS_WINMIX = 18 * MiB, WS_WOUTMIX = 24 * MiB, WS_W2IN = 26 * MiB, WS_W2OUT = 37 * MiB;
constexpr size_t WS_GBA = 43 * MiB, WS_XN = 45 * MiB, WS_XN2 = 110 * MiB, WS_H = 175 * MiB, WS_GM = 353 * MiB, WS_GN = 417 * MiB;
constexpr size_t WS_GQ = 110 * MiB, WS_GO = 142 * MiB;
constexpr size_t WS_SSP1 = 481 * MiB, WS_SSP2 = 484 * MiB;
constexpr size_t WS_END = 487 * MiB;
constexpr size_t CTL_BAR = 0, CTL_BAR_BYTES = 16384, CTL_GLAST = 768 * 1024;

struct Params { const float* in[21]; float* out; unsigned char* ws; };

typedef float f32x2v __attribute__((ext_vector_type(2)));
typedef __bf16 bf16x2v __attribute__((ext_vector_type(2)));
__device__ __forceinline__ unsigned cvt_pk(float lo, float hi) { const f32x2v v = {lo, hi}; const bf16x2v b = __builtin_convertvector(v, bf16x2v); return __builtin_bit_cast(unsigned, b); }
__device__ __forceinline__ bf16_t f2bf(float f) { return (bf16_t)(cvt_pk(f, 0.f) & 0xffffu); }
__device__ __forceinline__ float bf2f(bf16_t h) { return __uint_as_float(((unsigned)h) << 16); }
__device__ __forceinline__ float bflo(unsigned w) { return __uint_as_float(w << 16); }
__device__ __forceinline__ float bfhi(unsigned w) { return __uint_as_float(w & 0xffff0000u); }
__device__ __forceinline__ float silu(float x) { return x * __builtin_amdgcn_rcpf(1.0f + __expf(-x)); }
__device__ __forceinline__ float wave_sum(float v) {
#pragma unroll
    for (int o = 1; o < 64; o <<= 1) v += __shfl_xor(v, o);
    return v;
}
__device__ __forceinline__ float wave_max(float v) {
#pragma unroll
    for (int o = 1; o < 64; o <<= 1) v = fmaxf(v, __shfl_xor(v, o));
    return v;
}
__device__ __forceinline__ f32x4 mfma16(bf16x8 a, bf16x8 b, f32x4 c) { return __builtin_amdgcn_mfma_f32_16x16x32_bf16(a, b, c, 0, 0, 0); }

__device__ __forceinline__ float row_rstd(const float* ssp, int r) {
    if (r >= MREAL) return 0.f;
    const f32x4 a = *(const f32x4*)(ssp + (size_t)r * 16), b = *(const f32x4*)(ssp + (size_t)r * 16 + 4), c = *(const f32x4*)(ssp + (size_t)r * 16 + 8), d = *(const f32x4*)(ssp + (size_t)r * 16 + 12);
    const float s = (((a[0] + a[1]) + (a[2] + a[3])) + ((b[0] + b[1]) + (b[2] + b[3]))) + (((c[0] + c[1]) + (c[2] + c[3])) + ((d[0] + d[1]) + (d[2] + d[3])));
    return rsqrtf(s * (1.0f / DM) + EPS);
}
struct EpiSwiglu {
    static constexpr bool PERM = true, AFTER_DRAIN = false;
    bf16_t* H; const float* ss;
    __device__ __forceinline__ void operator()(const f32x4 (&acc)[2][2][4][2], const pg8::Unit& u, int wr, int wc, int fr, int fq) const {
        const int row0 = u.pm * 256 + wr * 64 + fr, col0 = u.pn * 128 + wc * 32 + 8 * fq;
#pragma unroll
        for (int ai = 0; ai < 2; ++ai)
#pragma unroll
            for (int m = 0; m < 4; ++m) {
                const int r = row0 + ai * 128 + m * 16;
                const float rs = ss ? row_rstd(ss, r) : 1.0f;
                float h[8];
#pragma unroll
                for (int n = 0; n < 2; ++n)
#pragma unroll
                    for (int j = 0; j < 4; ++j) h[n * 4 + j] = silu(acc[ai][0][m][n][j] * rs) * (acc[ai][1][m][n][j] * rs);
                u32x4 w; w.x = cvt_pk(h[0], h[1]); w.y = cvt_pk(h[2], h[3]); w.z = cvt_pk(h[4], h[5]); w.w = cvt_pk(h[6], h[7]);
                *(u32x4*)(H + (size_t)r * DFF + col0) = w;
            }
    }
};
template <bool RESB16, bool WF32, bool WB16, bool SUMSQ, bool HALF> struct EpiResid {
    static constexpr bool PERM = true, AFTER_DRAIN = false;
    const void* resP; const void* resS; float* Yo; bf16_t* XBo; float* sso;
    __device__ __forceinline__ void operator()(const f32x4 (&acc)[2][2][4][2], const pg8::Unit& u, int wr, int wc, int fr, int fq) const {
        const int row0 = u.pm * 256 + wr * 64 + fr, col0 = u.pn * 256 + wc * 32 + 8 * fq;
        const char* const rP = (const char*)resP; const char* const rS = (const char*)resS - (size_t)MPR * DM * (RESB16 ? 2 : 4);
        float* const Y = Yo; const float scale = HALF ? 0.5f : 1.0f; bf16_t* const XB = XBo; float* const ss = sso;
#pragma unroll
        for (int ai = 0; ai < 2; ++ai)
#pragma unroll
            for (int m = 0; m < 4; ++m) {
                const int r = row0 + ai * 128 + m * 16; float s = 0.f;
                if (r < MREAL) {
                    const char* rp = ((r < MPR) ? rP : rS) + (size_t)r * DM * (RESB16 ? 2 : 4);
#pragma unroll
                    for (int bj = 0; bj < 2; ++bj) {
                        const int c = col0 + bj * 128;
                        f32x4 r0, r1;
                        if (RESB16) { const u32x4 w = *(const u32x4*)(rp + (size_t)c * 2); r0 = (f32x4){bflo(w.x), bfhi(w.x), bflo(w.y), bfhi(w.y)}; r1 = (f32x4){bflo(w.z), bfhi(w.z), bflo(w.w), bfhi(w.w)}; }
                        else { r0 = *(const f32x4*)(rp + (size_t)c * 4); r1 = *(const f32x4*)(rp + (size_t)c * 4 + 16); }
                        const f32x4 v0 = r0 + acc[ai][bj][m][0] * scale, v1 = r1 + acc[ai][bj][m][1] * scale;
                        if (WF32) { *(f32x4*)(Y + (size_t)r * DM + c) = v0; *(f32x4*)(Y + (size_t)r * DM + c + 4) = v1; }
                        if (WB16) { u32x4 w; w.x = cvt_pk(v0[0], v0[1]); w.y = cvt_pk(v0[2], v0[3]); w.z = cvt_pk(v1[0], v1[1]); w.w = cvt_pk(v1[2], v1[3]);
                            *(u32x4*)(XB + (size_t)r * DM + c) = w; }
                        if (SUMSQ) s += (v0[0] * v0[0] + v0[1] * v0[1]) + (v0[2] * v0[2] + v0[3] * v0[3]) + (v1[0] * v1[0] + v1[1] * v1[1]) + (v1[2] * v1[2] + v1[3] * v1[3]);
                    }
                }
                if (SUMSQ) { s += __shfl_xor(s, 16); s += __shfl_xor(s, 32); if (fq == 0 && r < MREAL) ss[(size_t)r * 16 + u.pn * 4 + wc] = s; }
            }
    }
};
struct EpiInproj {
    static constexpr bool PERM = true, AFTER_DRAIN = false;
    bf16_t* P; float* gba; const float* ss;
    __device__ __forceinline__ void operator()(const f32x4 (&acc)[2][2][4][2], const pg8::Unit& u, int wr, int wc, int fr, int fq) const {
        const int row0 = u.pm * 256 + wr * 64 + fr, col0 = u.pn * 256 + wc * 32 + 8 * fq;
#pragma unroll
        for (int ai = 0; ai < 2; ++ai)
#pragma unroll
            for (int m = 0; m < 4; ++m) {
                const int r = row0 + ai * 128 + m * 16;
                const float rs = row_rstd(ss, r);
                if (u.pn < 11) {
#pragma unroll
                    for (int bj = 0; bj < 2; ++bj) { const f32x4 v0 = acc[ai][bj][m][0] * rs, v1 = acc[ai][bj][m][1] * rs;
                        u32x4 w; w.x = cvt_pk(v0[0], v0[1]); w.y = cvt_pk(v0[2], v0[3]); w.z = cvt_pk(v1[0], v1[1]); w.w = cvt_pk(v1[2], v1[3]);
                        *(u32x4*)(P + (size_t)r * PW + col0 + bj * 128) = w; }
                } else if (wc == 0 && fq == 0) {
                    *(f32x4*)(gba + (size_t)r * 8) = acc[ai][0][m][0] * rs; *(f32x4*)(gba + (size_t)r * 8 + 4) = acc[ai][0][m][1] * rs;
                }
            }
    }
};

__device__ __forceinline__ void transpose_item(const float* W, int K, int N, bf16_t* WT, int k0, int n0, int drow0, const float* gs, LAS float* scr, int lane) {
#pragma unroll 8
    for (int i = 0; i < 32; ++i) { const int kk = 2 * i + (lane >> 5), n = n0 + (lane & 31);
        float v = (n < N) ? W[(size_t)(k0 + kk) * N + n] : 0.f; if (gs) v *= gs[k0 + kk];
        scr[kk * 33 + (lane & 31)] = v; }
    asm volatile("s_waitcnt lgkmcnt(0)" ::: "memory");
    const int c = lane & 7;
#pragma unroll
    for (int j = 0; j < 4; ++j) { const int nn = (lane >> 3) + 8 * j; const LAS float* s = scr + (8 * c) * 33 + nn;
        u32x4 o; o.x = cvt_pk(s[0 * 33], s[1 * 33]); o.y = cvt_pk(s[2 * 33], s[3 * 33]); o.z = cvt_pk(s[4 * 33], s[5 * 33]); o.w = cvt_pk(s[6 * 33], s[7 * 33]);
        *(u32x4*)(WT + (size_t)(drow0 + nn) * K + k0 + 8 * c) = o; }
    asm volatile("s_waitcnt lgkmcnt(0)" ::: "memory");
}
__device__ __forceinline__ int map_ffin_row(int n0) { return n0 < DFF ? (n0 >> 7) * 256 + (n0 & 127) : ((n0 - DFF) >> 7) * 256 + 128 + ((n0 - DFF) & 127); }

__device__ __forceinline__ void p0_prologue(const Params& p, LAS unsigned char* lds, int vb, int G) {
    const int tid = threadIdx.x, lane = tid & 63, wid = tid >> 6;
    LAS float* scr = (LAS float*)(lds + wid * 16384);
    const int gw = vb * 8 + wid, NGW = G * 8;
    bf16_t* W1IN = (bf16_t*)(p.ws + WS_W1IN); bf16_t* W1OUT = (bf16_t*)(p.ws + WS_W1OUT); bf16_t* WINMIX = (bf16_t*)(p.ws + WS_WINMIX);
    bf16_t* WOUTMIX = (bf16_t*)(p.ws + WS_WOUTMIX); bf16_t* W2IN = (bf16_t*)(p.ws + WS_W2IN); bf16_t* W2OUT = (bf16_t*)(p.ws + WS_W2OUT);
    constexpr int I_FIN = 16 * 176, I_FOUT = 44 * 32, I_INMIX = 16 * 89, I_OUTMIX = 16 * 32;
    constexpr int NITEMS = 2 * I_FIN + 2 * I_FOUT + I_INMIX + I_OUTMIX;
    for (int it = gw; it < NITEMS; it += NGW) {
        int r = it;
        if (r < I_FIN) { const int kb = r / 176, nb = r % 176; transpose_item(p.in[7], DM, 2 * DFF, W1IN, kb * 64, nb * 32, map_ffin_row(nb * 32), nullptr, scr, lane); continue; } r -= I_FIN;
        if (r < I_FIN) { const int kb = r / 176, nb = r % 176; transpose_item(p.in[18], DM, 2 * DFF, W2IN, kb * 64, nb * 32, map_ffin_row(nb * 32), p.in[17], scr, lane); continue; } r -= I_FIN;
        if (r < I_FOUT) { const int kb = r / 32, nb = r % 32; transpose_item(p.in[8], DFF, DM, W1OUT, kb * 64, nb * 32, nb * 32, nullptr, scr, lane); continue; } r -= I_FOUT;
        if (r < I_FOUT) { const int kb = r / 32, nb = r % 32; transpose_item(p.in[19], DFF, DM, W2OUT, kb * 64, nb * 32, nb * 32, nullptr, scr, lane); continue; } r -= I_FOUT;
        if (r < I_INMIX) { const int kb = r / 89, nb = r % 89; transpose_item(p.in[10], DM, 2824, WINMIX, kb * 64, nb * 32, nb * 32, p.in[9], scr, lane); continue; } r -= I_INMIX;
        { const int kb = r / 32, nb = r % 32; transpose_item(p.in[16], DM, DM, WOUTMIX, kb * 64, nb * 32, nb * 32, nullptr, scr, lane); }
    }
    bf16_t* XN = (bf16_t*)(p.ws + WS_XN); const float* g1 = p.in[6];
    f32x4 gv[4];
#pragma unroll
    for (int j = 0; j < 4; ++j) gv[j] = *((const f32x4*)g1 + lane + 64 * j);
    for (int m = gw; m < MPAD; m += NGW) {
        unsigned long long* o8 = (unsigned long long*)(XN + (size_t)m * DM) + lane;
        if (m >= MREAL) {
#pragma unroll
            for (int j = 0; j < 4; ++j) o8[64 * j] = 0ull;
            continue; }
        const float* xrow = (m < MPR) ? p.in[0] + (size_t)m * DM : p.in[1] + (size_t)(m - MPR) * DM;
        const f32x4* xr = (const f32x4*)xrow + lane;
        f32x4 v[4]; float s = 0.f;
#pragma unroll
        for (int j = 0; j < 4; ++j) { v[j] = xr[64 * j]; s += (v[j][0] * v[j][0] + v[j][1] * v[j][1]) + (v[j][2] * v[j][2] + v[j][3] * v[j][3]); }
        const float rstd = rsqrtf(wave_sum(s) * (1.0f / DM) + EPS);
#pragma unroll
        for (int j = 0; j < 4; ++j) { const f32x4 y = v[j] * rstd * gv[j];
            o8[64 * j] = (unsigned long long)cvt_pk(y[0], y[1]) | ((unsigned long long)cvt_pk(y[2], y[3]) << 32); }
    }
}

__device__ __forceinline__ f32x4 tile_mm(const LAS bf16_t* X, int ldx, int mt, const LAS bf16_t* Y, int ldy, int nt, int nks, int fr, int fq) {
    f32x4 acc = (f32x4){0.f, 0.f, 0.f, 0.f};
    const LAS bf16_t* xp = X + (16 * mt + fr) * ldx + 8 * fq; const LAS bf16_t* yp = Y + (16 * nt + fr) * ldy + 8 * fq;
    for (int ks = 0; ks < nks; ++ks) acc = mfma16(*(const LAS bf16x8*)(xp + 32 * ks), *(const LAS bf16x8*)(yp + 32 * ks), acc);
    return acc;
}
constexpr int G1_QS = 0, G1_KS = 17408, G1_VBT = 34816, G1_KBT = 53248, G1_KDT = 71680, G1_UT = 90112, G1_WT = 108544, G1_QK = 126976, G1_TB = 136192, G1_GC = 145408, G1_BETA = 145664;

__device__ __forceinline__ void gdn_prep_unit(const Params& p, LAS unsigned char* lds, int unit) {
    const int tid = threadIdx.x, lane = tid & 63, wid = tid >> 6, fr = lane & 15, fq = lane >> 4;
    const int bh = unit >> 7, n = unit & 127, b = bh >> 2, h = bh & 3;
    const int tok0 = b * SEQ + n * 64;
    LAS bf16_t* Qs = (LAS bf16_t*)(lds + G1_QS); LAS bf16_t* Ks = (LAS bf16_t*)(lds + G1_KS); LAS bf16_t* VbT = (LAS bf16_t*)(lds + G1_VBT);
    LAS bf16_t* KbT = (LAS bf16_t*)(lds + G1_KBT); LAS bf16_t* KdT = (LAS bf16_t*)(lds + G1_KDT); LAS bf16_t* UT = (LAS bf16_t*)(lds + G1_UT);
    LAS bf16_t* WT = (LAS bf16_t*)(lds + G1_WT); LAS float* Af = (LAS float*)(lds + G1_WT); LAS bf16_t* QK = (LAS bf16_t*)(lds + G1_QK);
    LAS bf16_t* Tb = (LAS bf16_t*)(lds + G1_TB); LAS float* gcs = (LAS float*)(lds + G1_GC); LAS float* betas = (LAS float*)(lds + G1_BETA);
    const bf16_t* PB = (const bf16_t*)(p.ws + WS_H); const float* GBA = (const float*)(p.ws + WS_GBA);
    if (tid < 64) {
        const float* gb = GBA + (size_t)(tok0 + tid) * 8;
        const float bt = 1.0f / (1.0f + __expf(-gb[h]));
        const float x = gb[4 + h] + p.in[14][h]; const float sp = x > 20.f ? x : log1pf(__expf(x));
        float c = -__expf(p.in[13][h]) * sp;
#pragma unroll
        for (int o = 1; o < 64; o <<= 1) { const float t = __shfl_up(c, o); if (lane >= o) c += t; }
        gcs[tid] = c; betas[tid] = bt;
    }
    __syncthreads();
    const float gclast = gcs[63];
    const float* cw = p.in[12];
#pragma unroll 1
    for (int it = 0; it < 6; ++it) {
        const int item = tid + 512 * it, l16 = item & 15, row = item >> 4, which = row >> 6, t = row & 63;
        const int cch = which * 512 + h * 128 + l16 * 8;
        float a[8];
#pragma unroll
        for (int e = 0; e < 8; ++e) a[e] = 0.f;
#pragma unroll
        for (int j = 0; j < 4; ++j) {
            const int tt = n * 64 + t - 3 + j;
            if (tt >= 0) {
                const u32x4 xv = *(const u32x4*)(PB + (size_t)(b * SEQ + tt) * PW + 768 + cch);
                const f32x4 w0 = *(const f32x4*)(cw + j * CONVC + cch), w1 = *(const f32x4*)(cw + j * CONVC + cch + 4);
                a[0] += w0[0] * bflo(xv.x); a[1] += w0[1] * bfhi(xv.x); a[2] += w0[2] * bflo(xv.y); a[3] += w0[3] * bfhi(xv.y);
                a[4] += w1[0] * bflo(xv.z); a[5] += w1[1] * bfhi(xv.z); a[6] += w1[2] * bflo(xv.w); a[7] += w1[3] * bfhi(xv.w);
            }
        }
        float ss = 0.f;
#pragma unroll
        for (int e = 0; e < 8; ++e) { a[e] = silu(a[e]); ss += a[e] * a[e]; }
        ss += __shfl_xor(ss, 1); ss += __shfl_xor(ss, 2); ss += __shfl_xor(ss, 4); ss += __shfl_xor(ss, 8);
        const float gct = gcs[t], bt = betas[t];
        if (which == 0) {
            const float sc = rsqrtf(ss + EPS) * 0.08838834764831845f;
            u32x4 w; w.x = cvt_pk(a[0] * sc, a[1] * sc); w.y = cvt_pk(a[2] * sc, a[3] * sc); w.z = cvt_pk(a[4] * sc, a[5] * sc); w.w = cvt_pk(a[6] * sc, a[7] * sc);
            *(LAS u32x4*)(Qs + t * 136 + l16 * 8) = w;
        } else if (which == 1) {
            const float sc = rsqrtf(ss + EPS);
            u32x4 w; w.x = cvt_pk(a[0] * sc, a[1] * sc); w.y = cvt_pk(a[2] * sc, a[3] * sc); w.z = cvt_pk(a[4] * sc, a[5] * sc); w.w = cvt_pk(a[6] * sc, a[7] * sc);
            *(LAS u32x4*)(Ks + t * 136 + l16 * 8) = w;
            const float sb = sc * bt * __expf(gct), sd = sc * __expf(gclast - gct);
#pragma unroll
            for (int e = 0; e < 8; ++e) { KbT[(l16 * 8 + e) * 72 + t] = f2bf(a[e] * sb); KdT[(l16 * 8 + e) * 72 + t] = f2bf(a[e] * sd); }
        } else {
#pragma unroll
            for (int e = 0; e < 8; ++e) VbT[(l16 * 8 + e) * 72 + t] = f2bf(a[e] * bt);
        }
    }
    __syncthreads();
#pragma unroll 2
    for (int r = 0; r < 4; ++r) {
        const int job = wid + 8 * r, kind = job >> 4, tile = job & 15, it = tile >> 2, jt = tile & 3;
        if (kind == 0) {
            if (jt > it) continue;
            const f32x4 acc = tile_mm(Ks, 136, it, Ks, 136, jt, 4, fr, fq);
            const int j = 16 * jt + fr; const float gcj = gcs[j];
            float v[4];
#pragma unroll
            for (int e = 0; e < 4; ++e) { const int i = 16 * it + 4 * fq + e; const bool ok = i > j; v[e] = ok ? acc[e] * __expf(gcs[i] - gcj) * betas[i] : 0.f; }
            *(LAS f32x4*)(Af + j * 68 + 16 * it + 4 * fq) = (f32x4){v[0], v[1], v[2], v[3]};
        } else {
            const f32x4 acc = tile_mm(Ks, 136, jt, Qs, 136, it, 4, fr, fq);
            const int i = 16 * it + fr; const float gci = gcs[i];
            float v[4];
#pragma unroll
            for (int e = 0; e < 4; ++e) { const int j = 16 * jt + 4 * fq + e; const bool ok = i >= j; v[e] = ok ? acc[e] * __expf(gci - gcs[j]) : 0.f; }
            u32x2 w; w.x = cvt_pk(v[0], v[1]); w.y = cvt_pk(v[2], v[3]); *(LAS u32x2*)(QK + i * 72 + 16 * jt + 4 * fq) = w;
        }
    }
    __syncthreads();
    if (wid == 0) {
        f32x2v r2[32];
#pragma unroll
        for (int k = 0; k < 32; ++k) r2[k] = (f32x2v){(lane == 2 * k) ? 1.0f : 0.0f, (lane == 2 * k + 1) ? 1.0f : 0.0f};
#pragma unroll
        for (int j = 0; j < 64; ++j) {
            const float tj = (j & 1) ? r2[j >> 1][1] : r2[j >> 1][0];
            Tb[j * 72 + lane] = f2bf(tj);
            const f32x2v t2 = (f32x2v){tj, tj};
#pragma unroll
            for (int i4 = (j + 1) >> 2; i4 < 16; ++i4) {
                const f32x4 av = *(const LAS f32x4*)(Af + j * 68 + 4 * i4);
                if (4 * i4 + 1 > j) r2[2 * i4] -= (f32x2v){av[0], av[1]} * t2;
                if (4 * i4 + 3 > j) r2[2 * i4 + 1] -= (f32x2v){av[2], av[3]} * t2;
            }
        }
    }
    __syncthreads();
#pragma unroll 2
    for (int r = 0; r < 8; ++r) {
        const int job = wid + 8 * r, kind = job >> 5, tile = job & 31, mt = tile >> 3, nt = tile & 7;
        const f32x4 acc = tile_mm(Tb, 72, mt, kind ? KbT : VbT, 72, nt, 2, fr, fq);
        u32x2 w; w.x = cvt_pk(acc[0], acc[1]); w.y = cvt_pk(acc[2], acc[3]);
        *(LAS u32x2*)((kind ? WT : UT) + (16 * nt + fr) * 72 + 16 * mt + 4 * fq) = w;
    }
    __syncthreads();
    bf16_t* GM = (bf16_t*)(p.ws + WS_GM) + (size_t)unit * 16384; bf16_t* GN = (bf16_t*)(p.ws + WS_GN) + (size_t)unit * 16384;
    bf16_t* GQ = (bf16_t*)(p.ws + WS_GQ) + (size_t)unit * 8192; bf16_t* GO = (bf16_t*)(p.ws + WS_GO) + (size_t)unit * 8192;
#pragma unroll 2
    for (int r = 0; r < 24; ++r) {
        const int job = wid + 8 * r;
        if (job < 64) { const int a = job >> 3, mt = job & 7;
            const f32x4 acc = tile_mm(WT, 72, a, KdT, 72, mt, 2, fr, fq);
            u32x2 w; w.x = cvt_pk(-acc[0], -acc[1]); w.y = cvt_pk(-acc[2], -acc[3]);
            *(u32x2*)(GM + ((mt * 4 + (a >> 1)) * 64 + lane) * 8 + (a & 1) * 4) = w;
        } else if (job < 128) { const int j = job - 64, mt = j >> 3, nt = j & 7;
            const f32x4 acc = tile_mm(KdT, 72, mt, UT, 72, nt, 2, fr, fq);
            u32x2 w; w.x = cvt_pk(acc[0], acc[1]); w.y = cvt_pk(acc[2], acc[3]);
            *(u32x2*)(GN + ((nt * 64 + lane) * 8 + mt) * 4) = w;
        } else if (job < 160) { const int j = job - 128, a = j >> 2, it = j & 3;
            const f32x4 acc = tile_mm(WT, 72, a, QK, 72, it, 2, fr, fq);
            const int i = 16 * it + fr; const float eg = __expf(gcs[i]);
            const u32x2 qv = *(const LAS u32x2*)(Qs + i * 136 + 16 * a + 4 * fq);
            u32x2 w; w.x = cvt_pk(bflo(qv.x) * eg - acc[0], bfhi(qv.x) * eg - acc[1]); w.y = cvt_pk(bflo(qv.y) * eg - acc[2], bfhi(qv.y) * eg - acc[3]);
            *(u32x2*)(GQ + ((it * 4 + (a >> 1)) * 64 + lane) * 8 + (a & 1) * 4) = w;
        } else { const int j = job - 160, mt = j >> 3, nt = j & 7;
            const f32x4 acc = tile_mm(QK, 72, mt, UT, 72, nt, 2, fr, fq);
            u32x2 w; w.x = cvt_pk(acc[0], acc[1]); w.y = cvt_pk(acc[2], acc[3]);
            *(u32x2*)(GO + ((nt * 64 + lane) * 4 + mt) * 4) = w;
        }
    }
    if (tid == 0) ((float*)(p.ws + WS_CTL + CTL_GLAST))[unit] = __expf(gclast);
    __syncthreads();
}

__device__ __forceinline__ void gdn_scan(const Params& p, LAS unsigned char* lds, int sb) {
    const int tid = threadIdx.x, lane = tid & 63, wid = tid >> 6, fr = lane & 15, fq = lane >> 4;
    const int bh = sb >> 2, sp = sb & 3, unit0 = bh * 128, sl = sp * 2 + wid;
    const u32x4* GMb = (const u32x4*)((const bf16_t*)(p.ws + WS_GM) + (size_t)unit0 * 16384);
    const u32x4* GQb = (const u32x4*)((const bf16_t*)(p.ws + WS_GQ) + (size_t)unit0 * 8192);
    const bf16_t* GNb = (const bf16_t*)(p.ws + WS_GN) + (size_t)unit0 * 16384;
    bf16_t* GOb = (bf16_t*)(p.ws + WS_GO) + (size_t)unit0 * 8192;
    const float* glast = (const float*)(p.ws + WS_CTL + CTL_GLAST) + unit0;
    const int lw = wid - 2;
#define SCAN_DMA(cc) do { _Pragma("unroll") for (int k = 0; k < 8; ++k) { const int inst = lw * 8 + k; \
        const char* src = (inst < 32) ? (const char*)(GMb + (size_t)(cc) * 2048) + inst * 1024 : (const char*)(GQb + (size_t)(cc) * 1024) + (inst - 32) * 1024; \
        __builtin_amdgcn_global_load_lds((const unsigned*)(src + lane * 16), (LAS unsigned*)(lds + ((cc) % 3) * 49152 + inst * 1024), 16, 0, 0); } } while (0)
#define SCAN_LOADN(dn, dO, cc) do { _Pragma("unroll") for (int i = 0; i < 4; ++i) dn[i] = *(const u32x4*)(GNb + (size_t)(cc) * 16384 + (size_t)(sl * 64 + lane) * 32 + i * 8); \
        _Pragma("unroll") for (int i = 0; i < 2; ++i) dO[i] = *(const u32x4*)(GOb + (size_t)(cc) * 8192 + (size_t)(sl * 64 + lane) * 16 + i * 8); } while (0)
#define SCAN_STEP(c, nn, on, RELOAD) do { \
        const float gl = __shfl(((c) < 64) ? glr0 : glr1, (c) & 63); bf16x8 Sb[4]; \
        _Pragma("unroll") for (int ks = 0; ks < 4; ++ks) { u32x4 w; w.x = cvt_pk(S[2 * ks][0], S[2 * ks][1]); w.y = cvt_pk(S[2 * ks][2], S[2 * ks][3]); \
            w.z = cvt_pk(S[2 * ks + 1][0], S[2 * ks + 1][1]); w.w = cvt_pk(S[2 * ks + 1][2], S[2 * ks + 1][3]); Sb[ks] = __builtin_bit_cast(bf16x8, w); } \
        const LAS unsigned char* slot = lds + ((c) % 3) * 49152 + lane * 16; \
        bf16x8 fa[2][2][4];                                     \
        _Pragma("unroll") for (int ks = 0; ks < 4; ++ks) { fa[0][0][ks] = *(const LAS bf16x8*)(slot + (0 * 4 + ks) * 1024); fa[0][1][ks] = *(const LAS bf16x8*)(slot + (1 * 4 + ks) * 1024); } \
        _Pragma("unroll") for (int mt = 0; mt < 8; ++mt) { const unsigned w0 = nn[mt >> 1][(mt & 1) * 2], w1 = nn[mt >> 1][(mt & 1) * 2 + 1]; \
            S[mt] = S[mt] * gl + (f32x4){bflo(w0), bfhi(w0), bflo(w1), bfhi(w1)}; } \
        _Pragma("unroll") for (int mt = 0; mt < 4; ++mt) { const unsigned w0 = on[mt >> 1][(mt & 1) * 2], w1 = on[mt >> 1][(mt & 1) * 2 + 1]; \
            S[8 + mt] = (f32x4){bflo(w0), bfhi(w0), bflo(w1), bfhi(w1)}; } \
        RELOAD; \
        _Pragma("unroll") for (int pr = 0; pr < 6; ++pr) { \
            if (pr < 5) { _Pragma("unroll") for (int ks = 0; ks < 4; ++ks) { fa[(pr + 1) & 1][0][ks] = *(const LAS bf16x8*)(slot + ((2 * pr + 2) * 4 + ks) * 1024); fa[(pr + 1) & 1][1][ks] = *(const LAS bf16x8*)(slot + ((2 * pr + 3) * 4 + ks) * 1024); } } \
            _Pragma("unroll") for (int ks = 0; ks < 4; ++ks) { S[2 * pr] = mfma16(fa[pr & 1][0][ks], Sb[ks], S[2 * pr]); S[2 * pr + 1] = mfma16(fa[pr & 1][1][ks], Sb[ks], S[2 * pr + 1]); } } \
        u32x4 o0, o1; \
        o0.x = cvt_pk(S[8][0], S[8][1]); o0.y = cvt_pk(S[8][2], S[8][3]); o0.z = cvt_pk(S[9][0], S[9][1]); o0.w = cvt_pk(S[9][2], S[9][3]); \
        o1.x = cvt_pk(S[10][0], S[10][1]); o1.y = cvt_pk(S[10][2], S[10][3]); o1.z = cvt_pk(S[11][0], S[11][1]); o1.w = cvt_pk(S[11][2], S[11][3]); \
        bf16_t* op = GOb + (size_t)(c) * 8192 + (size_t)(sl * 64 + lane) * 16; \
        *(u32x4*)op = o0; *(u32x4*)(op + 8) = o1; } while (0)
    if (wid >= 2) { SCAN_DMA(0); SCAN_DMA(1); asm volatile("s_waitcnt vmcnt(0)" ::: "memory"); }
    f32x4 S[12];
#pragma unroll
    for (int mt = 0; mt < 12; ++mt) S[mt] = (f32x4){0.f, 0.f, 0.f, 0.f};
    const float glr0 = glast[lane], glr1 = glast[64 + lane];
    u32x4 nnA[4], onA[2], nnB[4], onB[2];
    if (wid < 2) { SCAN_LOADN(nnA, onA, 0); SCAN_LOADN(nnB, onB, 1); }
    asm volatile("s_waitcnt lgkmcnt(0)" ::: "memory"); __builtin_amdgcn_s_barrier(); asm volatile("" ::: "memory");
#pragma unroll 1
    for (int c = 0; c < 128; c += 2) {
        if (wid >= 2) { if (c + 2 < 128) SCAN_DMA(c + 2); }
        else { SCAN_STEP(c, nnA, onA, if (c + 2 < 128) SCAN_LOADN(nnA, onA, c + 2)); }
        if (wid >= 2) { if (c + 2 < 128) asm volatile("s_waitcnt vmcnt(8)" ::: "memory"); else asm volatile("s_waitcnt vmcnt(0)" ::: "memory"); }
        asm volatile("s_waitcnt lgkmcnt(0)" ::: "memory"); __builtin_amdgcn_s_barrier(); asm volatile("" ::: "memory");
        if (wid >= 2) { if (c + 3 < 128) SCAN_DMA(c + 3); }
        else { SCAN_STEP(c + 1, nnB, onB, if (c + 3 < 128) SCAN_LOADN(nnB, onB, c + 3)); }
        if (wid >= 2) { if (c + 3 < 128) asm volatile("s_waitcnt vmcnt(8)" ::: "memory"); else asm volatile("s_waitcnt vmcnt(0)" ::: "memory"); }
        asm volatile("s_waitcnt lgkmcnt(0)" ::: "memory"); __builtin_amdgcn_s_barrier(); asm volatile("" ::: "memory");
    }
#undef SCAN_DMA
#undef SCAN_LOADN
#undef SCAN_STEP
    __syncthreads();
    if (wid < 2) {
        float* go = p.out + O_GP + (size_t)bh * 16384;
#pragma unroll
        for (int mt = 0; mt < 8; ++mt)
#pragma unroll
            for (int e = 0; e < 4; ++e) go[(16 * mt + 4 * fq + e) * 128 + sl * 16 + fr] = S[mt][e];
    }
}

__device__ __forceinline__ void gdn_gate_unit(const Params& p, int unit, int lane) {
    const int fr = lane & 15, fq = lane >> 4, bh = unit >> 7, n = unit & 127, b = bh >> 2, h = bh & 3, tok0 = b * SEQ + n * 64;
    const bf16_t* GO = (const bf16_t*)(p.ws + WS_GO) + (size_t)unit * 8192;
    bf16_t* PB = (bf16_t*)(p.ws + WS_H);
    float ssq[16];
#pragma unroll
    for (int k = 0; k < 16; ++k) ssq[k] = 0.f;
#pragma unroll 1
    for (int nt = 0; nt < 8; ++nt) {
        const u32x4 a0 = *(const u32x4*)(GO + (nt * 64 + lane) * 16), a1 = *(const u32x4*)(GO + (nt * 64 + lane) * 16 + 8);
#pragma unroll
        for (int k = 0; k < 4; ++k) { const float l0 = bflo(a0[k]), h0 = bfhi(a0[k]), l1 = bflo(a1[k]), h1 = bfhi(a1[k]);
            ssq[2 * k] += l0 * l0; ssq[2 * k + 1] += h0 * h0; ssq[8 + 2 * k] += l1 * l1; ssq[8 + 2 * k + 1] += h1 * h1; }
    }
#pragma unroll
    for (int k = 0; k < 16; ++k) { float s = ssq[k]; s += __shfl_xor(s, 1); s += __shfl_xor(s, 2); s += __shfl_xor(s, 4); s += __shfl_xor(s, 8); ssq[k] = rsqrtf(s * (1.0f / 128.0f) + EPS); }
    const float* gn = p.in[15];
#pragma unroll 1
    for (int nt = 0; nt < 8; ++nt) {
        const int dv = 16 * nt + fr; const float g = gn[dv];
        const u32x4 a0 = *(const u32x4*)(GO + (nt * 64 + lane) * 16), a1 = *(const u32x4*)(GO + (nt * 64 + lane) * 16 + 8);
        const bf16_t* gzp = PB + (size_t)(tok0 + 4 * fq) * PW + 2304 + h * 128 + dv; bf16_t* mp = PB + (size_t)(tok0 + 4 * fq) * PW + 512 + h * 128 + dv;
#pragma unroll
        for (int k = 0; k < 16; ++k) {
            const unsigned w = (k < 8) ? a0[(k >> 1) & 3] : a1[(k >> 1) & 3]; const float o = (k & 1) ? bfhi(w) : bflo(w);
            const int to = 16 * (k >> 2) + (k & 3);
            const float gz = bf2f(gzp[(size_t)to * PW]);
            mp[(size_t)to * PW] = f2bf(o * ssq[k] * g * silu(gz));
        }
    }
}

__device__ __forceinline__ void attn_unit(const Params& p, LAS unsigned char* lds, int unit) {
    const int tid = threadIdx.x, lane = tid & 63, wid = tid >> 6, fr = lane & 15, fq = lane >> 4;
    const int b = unit >> 7, blk = (unit >> 1) & 63, kvh = unit & 1;
    LAS bf16_t* Ks = (LAS bf16_t*)lds; LAS bf16_t* Vt = (LAS bf16_t*)(lds + 36864);
    bf16_t* PB = (bf16_t*)(p.ws + WS_H);
    __syncthreads();
#pragma unroll
    for (int i = 0; i < 4; ++i) {
        const int q = tid + 512 * i, row = q >> 3, ch = q & 7, tp = blk * 128 - 128 + row;
        u32x4 kv = (u32x4){0u, 0u, 0u, 0u}, vv = (u32x4){0u, 0u, 0u, 0u};
        if (tp >= 0) { const bf16_t* base = PB + (size_t)(b * SEQ + tp) * PW; kv = *(const u32x4*)(base + 512 + kvh * 64 + ch * 8); vv = *(const u32x4*)(base + 640 + kvh * 64 + ch * 8); }
        *(LAS u32x4*)(Ks + row * 72 + ch * 8) = kv;
#pragma unroll
        for (int e = 0; e < 4; ++e) { const unsigned w = vv[e]; Vt[(ch * 8 + 2 * e) * 264 + row] = (bf16_t)(w & 0xffffu); Vt[(ch * 8 + 2 * e + 1) * 264 + row] = (bf16_t)(w >> 16); }
    }
    __syncthreads();
    const int qtok = b * SEQ + blk * 128 + 16 * wid + fr;
#pragma unroll 1
    for (int g = 0; g < 4; ++g) {
        const int h = kvh * 4 + g; const float slope = exp2f(-(float)(h + 1)), sink = p.in[11][h];
        bf16x8 qf[2];
#pragma unroll
        for (int ks = 0; ks < 2; ++ks) qf[ks] = *(const bf16x8*)(PB + (size_t)qtok * PW + h * 64 + ks * 32 + 8 * fq);
        f32x4 s[10]; float mx = sink;
#pragma unroll
        for (int j = 0; j < 10; ++j) {
            const int ct = (wid + j) < 15 ? (wid + j) : 15;
            f32x4 acc = (f32x4){0.f, 0.f, 0.f, 0.f};
#pragma unroll
            for (int ks = 0; ks < 2; ++ks) acc = mfma16(*(const LAS bf16x8*)(Ks + (16 * ct + fr) * 72 + ks * 32 + 8 * fq), qf[ks], acc);
#pragma unroll
            for (int e = 0; e < 4; ++e) {
                const int c = 16 * (wid + j) + 4 * fq + e, dist = 16 * wid + fr - c + 128;
                const bool ok = (wid + j <= 15) && dist >= 0 && dist <= 128 && (blk * 128 + c - 128 >= 0);
                const float v = ok ? acc[e] * 0.125f - slope * (float)dist : -INFINITY;
                acc[e] = v; mx = fmaxf(mx, v);
            }
            s[j] = acc;
            asm volatile("" ::: "memory");
        }
        mx = fmaxf(mx, __shfl_xor(mx, 16)); mx = fmaxf(mx, __shfl_xor(mx, 32));
        float sum = 0.f;
#pragma unroll
        for (int j = 0; j < 10; ++j)
#pragma unroll
            for (int e = 0; e < 4; ++e) { const float pv = __expf(s[j][e] - mx); s[j][e] = pv; sum += pv; }
        sum += __shfl_xor(sum, 16); sum += __shfl_xor(sum, 32);
        sum += __expf(sink - mx);
        const float inv = 1.0f / sum;
        bf16x8 pb[5];
#pragma unroll
        for (int kk = 0; kk < 5; ++kk) { u32x4 w; w.x = cvt_pk(s[2 * kk][0] * inv, s[2 * kk][1] * inv); w.y = cvt_pk(s[2 * kk][2] * inv, s[2 * kk][3] * inv);
            w.z = cvt_pk(s[2 * kk + 1][0] * inv, s[2 * kk + 1][1] * inv); w.w = cvt_pk(s[2 * kk + 1][2] * inv, s[2 * kk + 1][3] * inv); pb[kk] = __builtin_bit_cast(bf16x8, w); }
#pragma unroll
        for (int dt = 0; dt < 4; ++dt) {
            f32x4 acc = (f32x4){0.f, 0.f, 0.f, 0.f};
#pragma unroll
            for (int kk = 0; kk < 5; ++kk) {
                const int c0 = (wid + 2 * kk) < 15 ? (wid + 2 * kk) : 15, c1 = (wid + 2 * kk + 1) < 15 ? (wid + 2 * kk + 1) : 15;
                const u32x2 lo = *(const LAS u32x2*)(Vt + (16 * dt + fr) * 264 + 16 * c0 + 4 * fq), hi = *(const LAS u32x2*)(Vt + (16 * dt + fr) * 264 + 16 * c1 + 4 * fq);
                const u32x4 a = (u32x4){lo.x, lo.y, hi.x, hi.y};
                acc = mfma16(__builtin_bit_cast(bf16x8, a), pb[kk], acc);
            }
            u32x2 w; w.x = cvt_pk(acc[0], acc[1]); w.y = cvt_pk(acc[2], acc[3]);
            *(u32x2*)(PB + (size_t)qtok * PW + h * 64 + 16 * dt + 4 * fq) = w;
            asm volatile("" ::: "memory");
        }
    }
}

__device__ __forceinline__ void sattn_unit(const Params& p, int s, int h, int lane) {
    const int kvh = h >> 2; const bool wr = (h & 3) == 0;
    bf16_t* PB = (bf16_t*)(p.ws + WS_H) + (size_t)(MPR + s) * PW;
    const float* ck = p.in[2] + (size_t)s * 128 * 128 + kvh * 64 + lane; const float* cv = p.in[3] + (size_t)s * 128 * 128 + kvh * 64 + lane;
    float* nk = p.out + O_KS + (size_t)s * 128 * 128 + kvh * 64 + lane; float* nv = p.out + O_VS + (size_t)s * 128 * 128 + kvh * 64 + lane;
    const float q = bf2f(PB[h * 64 + lane]) * 0.125f, slope = exp2f(-(float)(h + 1)), sink = p.in[11][h];
    const float knew = bf2f(PB[512 + kvh * 64 + lane]), vnew = bf2f(PB[640 + kvh * 64 + lane]);
    float sc[3];
#pragma unroll
    for (int t = 0; t < 2; ++t) {
#pragma unroll 8
        for (int jj = 0; jj < 64; ++jj) {
            const int j = t * 64 + jj; const float kval = ck[(size_t)j * 128];
            if (wr && j >= 1) nk[(size_t)(j - 1) * 128] = kval;
            const float d = wave_sum(q * kval) - slope * (float)(128 - j); if (lane == jj) sc[t] = d;
        }
    }
    if (wr) nk[(size_t)127 * 128] = knew;
    sc[2] = wave_sum(q * knew);
    const float mx = fmaxf(fmaxf(wave_max(fmaxf(sc[0], sc[1])), sc[2]), sink);
    const float p0 = __expf(sc[0] - mx), p1 = __expf(sc[1] - mx), p2 = __expf(sc[2] - mx);
    const float inv = 1.0f / (wave_sum(p0 + p1) + p2 + __expf(sink - mx));
    float o = p2 * vnew;
#pragma unroll 8
    for (int jj = 0; jj < 64; ++jj) { const float vval = cv[(size_t)jj * 128]; if (wr && jj >= 1) nv[(size_t)(jj - 1) * 128] = vval; o += __shfl(p0, jj) * vval; }
#pragma unroll 8
    for (int jj = 0; jj < 64; ++jj) { const float vval = cv[(size_t)(64 + jj) * 128]; if (wr) nv[(size_t)(63 + jj) * 128] = vval; o += __shfl(p1, jj) * vval; }
    if (wr) nv[(size_t)127 * 128] = vnew;
    asm volatile("" ::: "memory");
    PB[h * 64 + lane] = f2bf(o * inv);
}

__device__ __forceinline__ void sgdn_unit(const Params& p, LAS unsigned char* lds, int s) {
    const int tid = threadIdx.x, wid = tid >> 6, h = tid >> 7, dv = tid & 127;
    LAS float* qs = (LAS float*)lds; LAS float* ks = qs + 512; LAS float* red = ks + 512;
    bf16_t* PB = (bf16_t*)(p.ws + WS_H) + (size_t)(MPR + s) * PW; const float* GBA = (const float*)(p.ws + WS_GBA) + (size_t)(MPR + s) * 8;
    const float* cw = p.in[12]; const float* hc = p.in[4] + (size_t)s * 3 * CONVC; float* nc = p.out + O_CS + (size_t)s * 3 * CONVC;
    __syncthreads();
    float val[3];
#pragma unroll
    for (int i = 0; i < 3; ++i) {
        const int c = i * 512 + tid; const float x3 = bf2f(PB[768 + c]), h0 = hc[c], h1 = hc[CONVC + c], h2 = hc[2 * CONVC + c];
        val[i] = silu(cw[c] * h0 + cw[CONVC + c] * h1 + cw[2 * CONVC + c] * h2 + cw[3 * CONVC + c] * x3);
        nc[c] = h1; nc[CONVC + c] = h2; nc[2 * CONVC + c] = x3;
    }
    const float sq = wave_sum(val[0] * val[0]), sk = wave_sum(val[1] * val[1]);
    if ((tid & 63) == 0) { red[wid] = sq; red[8 + wid] = sk; }
    __syncthreads();
    const float ssq = red[2 * h] + red[2 * h + 1], ssk = red[8 + 2 * h] + red[8 + 2 * h + 1];
    qs[tid] = val[0] * rsqrtf(ssq + EPS) * 0.08838834764831845f; ks[tid] = val[1] * rsqrtf(ssk + EPS);
    __syncthreads();
    const float beta = 1.0f / (1.0f + __expf(-GBA[h]));
    const float x = GBA[4 + h] + p.in[14][h]; const float sp = x > 20.f ? x : log1pf(__expf(x));
    const float eg = __expf(-__expf(p.in[13][h]) * sp);
    const float* S0 = p.in[5] + ((size_t)(s * 4 + h) * 128) * 128 + dv; float* S1 = p.out + O_GS + ((size_t)(s * 4 + h) * 128) * 128 + dv;
    float kS = 0.f;
#pragma unroll 1
    for (int hf = 0; hf < 4; ++hf) { float sv[32];
#pragma unroll
        for (int dk = 0; dk < 32; ++dk) sv[dk] = S0[(size_t)(hf * 32 + dk) * 128];
#pragma unroll
        for (int dk = 0; dk < 32; ++dk) kS += ks[h * 128 + hf * 32 + dk] * sv[dk]; }
    const float delta = beta * (val[2] - eg * kS);
    float o = 0.f;
#pragma unroll 1
    for (int hf = 0; hf < 4; ++hf) { float sv[32];
#pragma unroll
        for (int dk = 0; dk < 32; ++dk) sv[dk] = S0[(size_t)(hf * 32 + dk) * 128];
#pragma unroll
        for (int dk = 0; dk < 32; ++dk) { const float nvv = eg * sv[dk] + ks[h * 128 + hf * 32 + dk] * delta; S1[(size_t)(hf * 32 + dk) * 128] = nvv; o += qs[h * 128 + hf * 32 + dk] * nvv; } }
    const float so = wave_sum(o * o);
    if ((tid & 63) == 0) red[16 + wid] = so;
    __syncthreads();
    const float tot = red[16 + 2 * h] + red[16 + 2 * h + 1];
    const float gz = bf2f(PB[2304 + tid]);
    PB[512 + tid] = f2bf(o * rsqrtf(tot * (1.0f / 128.0f) + EPS) * p.in[15][dv] * silu(gz));
}

#define XB_TMO      128
#define XB_XCNT(j)  (256  + 64 * (j))
#define XB_XSUB(j)  (1280 + 64 * (j))
#define XB_XGEN(j)  (2304 + 64 * (j))
#define XB_TOP      3328
#define XB_TOPGEN   3392
#define XCD_BAR_WORDS 3456
#define XB_SPIN_CAP (1u << 18)

__device__ __forceinline__ unsigned xb_ld(unsigned* p)              { return __hip_atomic_load(p, __ATOMIC_RELAXED, __HIP_MEMORY_SCOPE_AGENT); }
__device__ __forceinline__ unsigned xb_add(unsigned* p, unsigned v) { return __hip_atomic_fetch_add(p, v, __ATOMIC_RELAXED, __HIP_MEMORY_SCOPE_AGENT); }
__device__ __forceinline__ unsigned xb_xcc_id() { return (unsigned)__builtin_amdgcn_s_getreg((3 << 11) | 20) & 0xFu; }
#define XB_SPIN(cond, bar) do { unsigned _sp = 0; while (cond) { __builtin_amdgcn_s_sleep(1); \
    if ((++_sp & 255u) == 0u) { if (xb_ld(&(bar)[XB_TMO])) break; if (_sp > XB_SPIN_CAP) { atomicAdd(&(bar)[XB_TMO], 1u); break; } } } } while (0)

struct XcdBarrier {
    unsigned* bar; unsigned x;
    volatile LAS unsigned* st;
};

__device__ __forceinline__ XcdBarrier xcd_barrier_post(unsigned* bar, volatile LAS unsigned* st) {
    XcdBarrier b; b.bar = bar; b.x = xb_xcc_id(); b.st = st;
    if (threadIdx.x == 0) (void)xb_add(&bar[XB_XCNT(b.x)], 1u);
    return b;
}
__device__ __forceinline__ void xcd_barrier_complete(unsigned* bar, unsigned x, unsigned& nloc, unsigned& nx) {
    const unsigned G = gridDim.x * gridDim.y * gridDim.z;
    unsigned sum, cnt, mine, sp = 0u;
    for (;;) {
        sum = 0u; cnt = 0u; mine = 0u;
#pragma unroll
        for (unsigned j = 0; j < 16; ++j) { const unsigned c = xb_ld(&bar[XB_XCNT(j)]); sum += c; cnt += (c > 0u) ? 1u : 0u; mine = (j == x) ? c : mine; }
        if (sum == G) break;
        __builtin_amdgcn_s_sleep(1);
        if ((++sp & 255u) == 0u) { if (xb_ld(&bar[XB_TMO])) break; if (sp > XB_SPIN_CAP) { atomicAdd(&bar[XB_TMO], 1u); break; } }
    }
    nloc = mine > 0u ? mine : 1u; nx = cnt > 0u ? cnt : 1u;
}

__device__ __forceinline__ void xcd_barrier(const XcdBarrier& b) {
    asm volatile("s_waitcnt vmcnt(0)" ::: "memory");
    __syncthreads();
    if (threadIdx.x == 0) {
        unsigned* bar = b.bar;
        __builtin_amdgcn_s_waitcnt(0);
        unsigned nloc = b.st[0], nx = b.st[1];
        if (nloc == 0u) { xcd_barrier_complete(bar, b.x, nloc, nx); b.st[0] = nloc; b.st[1] = nx; }
        const unsigned old = xb_add(&bar[XB_XSUB(b.x)], 1u);
        const unsigned gen = old / nloc;
        if (old + 1u == (gen + 1u) * nloc) {
            __builtin_amdgcn_fence(__ATOMIC_RELEASE, "agent");
            asm volatile("s_waitcnt vmcnt(0)" ::: "memory");
            const unsigned og = xb_add(&bar[XB_TOP], 1u);
            const unsigned tg = og / nx;
            if (og + 1u == (tg + 1u) * nx) xb_add(&bar[XB_TOPGEN], 1u);
            else XB_SPIN(xb_ld(&bar[XB_TOPGEN]) == tg, bar);
            __builtin_amdgcn_fence(__ATOMIC_ACQUIRE, "agent");
            xb_add(&bar[XB_XGEN(b.x)], 1u);
            asm volatile("s_waitcnt vmcnt(0)" ::: "memory");
        } else {
            XB_SPIN(xb_ld(&bar[XB_XGEN(b.x)]) == gen, bar);
            __builtin_amdgcn_fence(__ATOMIC_ACQUIRE, "agent");
            asm volatile("s_waitcnt vmcnt(0)" ::: "memory");
        }
    }
    __syncthreads();
}

__global__ void __launch_bounds__(512, 2) fwd_kernel(Params p, int ph_lo, int ph_hi) {
    extern __shared__ __attribute__((aligned(16))) unsigned char lds_raw[];
    LAS unsigned char* lds = (LAS unsigned char*)lds_raw;
    cg::grid_group grid = cg::this_grid();
    if (ph_lo < 0) grid.sync();
    volatile LAS unsigned* bst = (volatile LAS unsigned*)(lds + LDS_PHASE_BYTES);
    if (threadIdx.x < 2) bst[threadIdx.x] = 0u;
    __syncthreads();
    XcdBarrier xbar; xbar.bar = (unsigned*)(p.ws + WS_CTL + CTL_BAR); xbar.x = 0; xbar.st = bst;
    if (ph_hi - ph_lo > 1) xbar = xcd_barrier_post((unsigned*)(p.ws + WS_CTL + CTL_BAR), bst);
    const int tid = threadIdx.x, lane = tid & 63, wid = tid >> 6, G = gridDim.x, bx = blockIdx.x;
    unsigned char* ws = p.ws;
    bf16_t* XN = (bf16_t*)(ws + WS_XN); bf16_t* XN2 = (bf16_t*)(ws + WS_XN2); bf16_t* HB = (bf16_t*)(ws + WS_H);
    float* SS1 = (float*)(ws + WS_SSP1); float* SS2 = (float*)(ws + WS_SSP2);
    float* Y = p.out; float* X2 = (float*)(ws + WS_GM); float* X3 = (float*)(ws + WS_XN);
#ifndef PHMASK
#define PHMASK 0x7ff
#endif
#define IN(k) (((PHMASK >> (k)) & 1) && ph_lo <= (k) && (k) < ph_hi)
#define SEAM(k) do { if (IN(k) && IN((k) + 1)) { xcd_barrier(xbar); }     } while (0)

    if (IN(0)) p0_prologue(p, lds, bx, G);
    SEAM(0);
    if (IN(1)) {
        pg8::Gemm g{XN, (const bf16_t*)(ws + WS_W1IN), MPAD, 2 * DFF, DM, DM}; pg8::StaticOrder S; S.init(MPAD, 2 * DFF, G, bx);
        EpiSwiglu E{HB, nullptr}; pg8::gemm_phase<EpiSwiglu, pg8::StaticOrder>(lds, g, S, E, nullptr);
    }
    SEAM(1);
    if (IN(2)) {
        pg8::Gemm g{HB, (const bf16_t*)(ws + WS_W1OUT), MPAD, DM, DFF, DFF}; pg8::StaticOrder S; S.init(MPAD, DM, G, bx);
        EpiResid<false, false, true, true, true> E{p.in[0], p.in[1], nullptr, XN, SS1}; pg8::gemm_phase<EpiResid<false, false, true, true, true>, pg8::StaticOrder>(lds, g, S, E, nullptr);
    }
    SEAM(2);
    if (IN(3)) {
        pg8::Gemm g{XN, (const bf16_t*)(ws + WS_WINMIX), MPAD, NINP, DM, DM}; pg8::StaticOrder S; S.init(MPAD, NINP, G, bx);
        EpiInproj E{HB, (float*)(ws + WS_GBA), SS1}; pg8::gemm_phase<EpiInproj, pg8::StaticOrder>(lds, g, S, E, nullptr);
    }
    SEAM(3);
    if (IN(4)) {
        for (int u = bx; u < 2048; u += G) gdn_prep_unit(p, lds, u);
    }
    SEAM(4);
    if (IN(5)) {
        if (bx < NSCAN) gdn_scan(p, lds, bx);
        else {
            const int ab = bx - NSCAN, NAB = G - NSCAN;
            int it = ab;
#pragma unroll 1
            for (; it < 512; it += NAB) attn_unit(p, lds, it);
#pragma unroll 1
            for (; it < 640; it += NAB) {
                sattn_unit(p, it - 512, wid, lane);
                sgdn_unit(p, lds, it - 512); }
            const bf16_t* PB = HB;
            for (int idx = ab * 512 + tid; idx < 149504; idx += NAB * 512) {
                if (idx < 131072) { const int w = idx >> 16, r = idx & 65535, b = r >> 14, j = (r >> 7) & 127, c = r & 127;
                    p.out[(w ? O_VP : O_KP) + r] = bf2f(PB[(size_t)(b * SEQ + SEQ - 128 + j) * PW + 512 + w * 128 + c]);
                } else { const int r = idx - 131072, b = r / (3 * CONVC), q = r % (3 * CONVC), rr = q / CONVC, c = q % CONVC;
                    p.out[O_CP + r] = bf2f(PB[(size_t)(b * SEQ + SEQ - 3 + rr) * PW + 768 + c]); }
            }
        }
    }
    SEAM(5);
    if (IN(6)) {
        for (int u = bx * 8 + wid; u < 2048; u += G * 8) gdn_gate_unit(p, u, lane);
    }
    SEAM(6);
#ifdef DBG_DUMP
    if (ph_lo == 11) {
        const float* src = (const float*)(ws + DBG_SRC);
        for (size_t i = (size_t)bx * 512 + tid; i < (size_t)MREAL * DM; i += (size_t)G * 512) Y[i] = (i < (size_t)MREAL * 8) ? ((const float*)(ws + WS_GBA))[i] : 0.f;
    }
#endif
    if (IN(7)) {
        pg8::Gemm g{HB, (const bf16_t*)(ws + WS_WOUTMIX), MPAD, DM, DM, PW}; pg8::StaticOrder S; S.init(MPAD, DM, G, bx);
        EpiResid<true, true, true, true, false> E{XN, XN + (size_t)MPR * DM, X2, XN2, SS2}; pg8::gemm_phase<EpiResid<true, true, true, true, false>, pg8::StaticOrder>(lds, g, S, E, nullptr);
    }
    SEAM(7);
    if (IN(8)) {
        pg8::Gemm g{XN2, (const bf16_t*)(ws + WS_W2IN), MPAD, 2 * DFF, DM, DM}; pg8::StaticOrder S; S.init(MPAD, 2 * DFF, G, bx);
        EpiSwiglu E{HB, SS2}; pg8::gemm_phase<EpiSwiglu, pg8::StaticOrder>(lds, g, S, E, nullptr);
    }
    SEAM(8);
    if (IN(9)) {
        pg8::Gemm g{HB, (const bf16_t*)(ws + WS_W2OUT), MPAD, DM, DFF, DFF}; pg8::StaticOrder S; S.init(MPAD, DM, G, bx);
        EpiResid<false, true, false, false, true> E{X2, X2 + (size_t)MPR * DM, X3, nullptr, nullptr}; pg8::gemm_phase<EpiResid<false, true, false, false, true>, pg8::StaticOrder>(lds, g, S, E, nullptr);
    }
    SEAM(9);
    if (IN(10)) {
        const float* gf = p.in[20]; f32x4 gv[4];
#pragma unroll
        for (int j = 0; j < 4; ++j) gv[j] = *((const f32x4*)gf + lane + 64 * j);
        for (int m = bx * 8 + wid; m < MREAL; m += G * 8) {
            const f32x4* xr = (const f32x4*)(X3 + (size_t)m * DM) + lane; f32x4* yr = (f32x4*)(Y + (size_t)m * DM) + lane; f32x4 v[4]; float s = 0.f;
#pragma unroll
            for (int j = 0; j < 4; ++j) { v[j] = xr[64 * j]; s += (v[j][0] * v[j][0] + v[j][1] * v[j][1]) + (v[j][2] * v[j][2] + v[j][3] * v[j][3]); }
            const float rstd = rsqrtf(wave_sum(s) * (1.0f / DM) + EPS);
#pragma unroll
            for (int j = 0; j < 4; ++j) yr[64 * j] = v[j] * rstd * gv[j];
        }
    }
#undef IN
#undef SEAM
}
}

#ifndef MK_N_LAUNCHES
#define MK_N_LAUNCHES 1
#endif
extern "C" void kernel_launch(void* const* d_in, const int* in_sizes, int n_in, void* d_out, int out_size, void* d_ws, size_t ws_size, hipStream_t stream) {
    static int grid = 0;
    if (grid == 0) {
        if (n_in != 21 || ws_size < mk::WS_END || out_size != 47269888) { fprintf(stderr, "kernel_launch: unexpected shapes (n_in %d, ws %zu, out %d)\n", n_in, ws_size, out_size); grid = -1; return; }
        int dev = 0, cus = 0, per_cu = 0;
        (void)hipGetDevice(&dev); (void)hipDeviceGetAttribute(&cus, hipDeviceAttributeMultiprocessorCount, dev);
        if (hipFuncSetAttribute((const void*)mk::fwd_kernel, hipFuncAttributeMaxDynamicSharedMemorySize, mk::LDS_BYTES) != hipSuccess) { fprintf(stderr, "kernel_launch: hipFuncSetAttribute failed\n"); grid = -1; return; }
        if (hipOccupancyMaxActiveBlocksPerMultiprocessor(&per_cu, (const void*)mk::fwd_kernel, 512, mk::LDS_BYTES) != hipSuccess || per_cu < 1) { fprintf(stderr, "kernel_launch: occupancy query failed (%d)\n", per_cu); per_cu = 1; }
        (void)hipGetLastError();
        grid = cus * per_cu;
        if (grid <= mk::NSCAN) { fprintf(stderr, "kernel_launch: grid %d too small\n", grid); grid = -1; return; }
    }
    if (grid < 0) return;
    (void)hipMemsetAsync((char*)d_ws + mk::WS_CTL + mk::CTL_BAR, 0, mk::CTL_BAR_BYTES, stream);
    mk::Params p{};
    for (int i = 0; i < 21; ++i) p.in[i] = (const float*)d_in[i];
    p.out = (float*)d_out; p.ws = (unsigned char*)d_ws;
#if MK_N_LAUNCHES == 1
    int lo = 0, hi = 11; void* args[] = {&p, &lo, &hi};
    hipError_t e = hipLaunchCooperativeKernel((const void*)mk::fwd_kernel, dim3(grid), dim3(512), args, mk::LDS_BYTES, stream);
    if (e != hipSuccess) fprintf(stderr, "kernel_launch: cooperative launch failed: %s (grid %d)\n", hipGetErrorString(e), grid);
#else
#ifndef MK_LAST
#define MK_LAST 11
#ifndef MK_DOUBLE
#define MK_DOUBLE 0x10
#endif
#define DBG_C0 512
#define DBG_C1 1024
#endif
    for (int ph = 0; ph < MK_LAST; ++ph) { const int reps = ((MK_DOUBLE >> ph) & 1) ? 2 : 1; for (int r = 0; r < reps; ++r) hipLaunchKernelGGL(mk::fwd_kernel, dim3(grid), dim3(512), mk::LDS_BYTES, stream, p, ph, ph + 1); }
#ifdef DBG_DUMP
    hipLaunchKernelGGL(mk::fwd_kernel, dim3(grid), dim3(512), mk::LDS_BYTES, stream, p, 11, 12);
#endif
#endif
}
```

```cpp
#include <hip/hip_runtime.h>
#include <hip/hip_cooperative_groups.h>
#include <cstdio>
namespace cg = cooperative_groups;
namespace pg8 {
#define PG8_LAS __attribute__((address_space(3)))
typedef unsigned short bf16_t;
typedef short bf16x8 __attribute__((ext_vector_type(8)));
typedef float f32x4 __attribute__((ext_vector_type(4)));
typedef unsigned u32x4 __attribute__((ext_vector_type(4)));
constexpr int BM = 256, BK = 64, HALF = 128, HTB = HALF * BK * 2  , STAGE_BYTES = 8 * HTB, NXCD = 8, WGM = 8;

__host__ __device__ __forceinline__ int lds_byte(int r, int c) { const int st = (r >> 4) * 2 + (c >> 5), rr = r & 15, cc = c & 31, ob = rr * 64 + cc * 2; return st * 1024 + (ob ^ (((ob >> 9) & 1) << 5)); }
__host__ __device__ __forceinline__ void stage_rc(int b, int& R, int& C) { const int st = b / 1024, sb = b % 1024, swz = sb ^ (((sb >> 9) & 1) << 5); R = (st >> 1) * 16 + swz / 64; C = (st & 1) * 32 + (swz % 64) / 2; }
__host__ __device__ __forceinline__ int perm32(int rho) { const int n = rho >> 4, i = rho & 15; return 8 * (i >> 2) + 4 * n + (i & 3); }

struct Unit { int pm, pn; };
struct Gemm { const bf16_t* A; const bf16_t* Bt; int M, N, K, lda; };

struct StaticOrder {
    int nM, nN, nwg, G, c;
    __host__ __device__ void init(int M, int N, int G_, int c_) { nM = M / BM; nN = N / BM; nwg = nM * nN; G = G_; c = c_; }
    __host__ __device__ bool next(int i, Unit& u) const {
        const long L = (long)i * G + c; if (L >= nwg) return false;
        int wgid = (int)L; { const int q = nwg / NXCD, r = nwg % NXCD, xcd = wgid % NXCD, off = wgid / NXCD; wgid = (xcd < r ? xcd * (q + 1) : r * (q + 1) + (xcd - r) * q) + off; }
        const int nig = WGM * nN, gid = wgid / nig, fm = gid * WGM, gsz = (nM - fm) < WGM ? (nM - fm) : WGM;
        u.pm = fm + ((wgid % nig) % gsz); u.pn = (wgid % nig) / gsz; return true;
    }
    __device__ __forceinline__ void a_ready(const Unit&) const {}
    __device__ __forceinline__ void done(const Unit&) const {}
};
struct CountedOrder : StaticOrder {
    const unsigned* ready; unsigned need; unsigned* tmo;
    __device__ __forceinline__ void a_ready(const Unit& u) const {
        if (threadIdx.x < 64) {
            const unsigned long long t0 = __builtin_amdgcn_s_memrealtime(); unsigned polls = 0;
            while ((unsigned)__builtin_amdgcn_readfirstlane(__hip_atomic_load(ready + 64 * u.pm, __ATOMIC_RELAXED, __HIP_MEMORY_SCOPE_AGENT)) < need) {
                if ((++polls & 255u) == 0u && __builtin_amdgcn_readfirstlane(__hip_atomic_load(tmo, __ATOMIC_RELAXED, __HIP_MEMORY_SCOPE_AGENT)) != 0u) break;
                if (__builtin_amdgcn_s_memrealtime() - t0 > 2000000ull) {
                    if (threadIdx.x == 0) { unsigned expect = 0u; __hip_atomic_compare_exchange_strong(tmo + 1, &expect, 0x600u | (unsigned)(u.pm & 0xff), __ATOMIC_RELAXED, __ATOMIC_RELAXED, __HIP_MEMORY_SCOPE_AGENT); __hip_atomic_store(tmo, 1u, __ATOMIC_RELAXED, __HIP_MEMORY_SCOPE_AGENT); }
                    break; }
                __builtin_amdgcn_s_sleep(2); }
            __builtin_amdgcn_fence(__ATOMIC_ACQUIRE, "agent");
            asm volatile("s_waitcnt vmcnt(0)" ::: "memory");
        }
#if !defined(BROKEN_HOOK_NO_BARRIER)
        asm volatile("" ::: "memory"); __builtin_amdgcn_s_barrier(); asm volatile("" ::: "memory");
#endif
    }
};

__device__ __forceinline__ unsigned cvt_pk_bf16(float lo, float hi) { unsigned r; asm volatile("v_cvt_pk_bf16_f32 %0, %1, %2" : "=v"(r) : "v"(lo), "v"(hi)); return r; }
typedef float f32x2 __attribute__((ext_vector_type(2)));
__device__ __forceinline__ f32x2 gelu_pk(f32x2 v) {
    const f32x2 av = __builtin_elementwise_abs(v), d = av * 0.2316418882f + 1.0f;
    f32x2 t; t.x = __builtin_amdgcn_rcpf(d.x); t.y = __builtin_amdgcn_rcpf(d.y);
    f32x2 q = t * 0.5307027145f + (-0.7265760135f); q = q * t + 0.7107068705f; q = q * t + (-0.142248368f); q = q * t + 0.127414796f; q = q * t;
    const f32x2 s = (v * v) * (-0.72134752044f);
    f32x2 e; e.x = __builtin_amdgcn_exp2f(s.x); e.y = __builtin_amdgcn_exp2f(s.y);
    const f32x2 m = v * (q * e), r = v - m;
    f32x2 o; o.x = v.x < 0.f ? m.x : r.x; o.y = v.y < 0.f ? m.y : r.y; return o;
}

struct EpiF32 {
    static constexpr bool PERM = false, AFTER_DRAIN = false;
    float* C; int ldc; const float* bias;
    __device__ __forceinline__ void operator()(const f32x4 (&acc)[2][2][4][2], const Unit& u, int wr, int wc, int fr, int fq) const {
        const int row0 = u.pm * BM + wr * 64 + fr, col0 = u.pn * BM + wc * 32 + 4 * fq;
        f32x4 bv[2][2];
#pragma unroll
        for (int bj = 0; bj < 2; ++bj)
#pragma unroll
            for (int n = 0; n < 2; ++n) bv[bj][n] = bias ? *(const f32x4*)(bias + col0 + bj * HALF + n * 16) : (f32x4){0.f, 0.f, 0.f, 0.f};
#pragma unroll
        for (int ai = 0; ai < 2; ++ai)
#pragma unroll
            for (int m = 0; m < 4; ++m) { float* rowp = C + (size_t)(row0 + ai * HALF + m * 16) * ldc + col0;
#pragma unroll
                for (int bj = 0; bj < 2; ++bj)
#pragma unroll
                    for (int n = 0; n < 2; ++n) *(f32x4*)(rowp + bj * HALF + n * 16) = acc[ai][bj][m][n] + bv[bj][n]; }
    }
};
template <int ACT  > struct EpiBf16 {
    static constexpr bool PERM = true, AFTER_DRAIN = false;
    bf16_t* O; int ldc; const float* bias; int split_cols; size_t split_stride;
    __device__ __forceinline__ void operator()(const f32x4 (&acc)[2][2][4][2], const Unit& u, int wr, int wc, int fr, int fq) const {
        const int row0 = u.pm * BM + wr * 64 + fr; int colt = u.pn * BM; bf16_t* base = O;
        if (split_cols) { const int t = colt / split_cols; base += (size_t)t * split_stride; colt -= t * split_cols; }
        const int col0 = colt + wc * 32 + 8 * fq, bcol0 = u.pn * BM + wc * 32 + 8 * fq;
        f32x4 bv[2][2];
#pragma unroll
        for (int bj = 0; bj < 2; ++bj)
#pragma unroll
            for (int n = 0; n < 2; ++n) bv[bj][n] = bias ? *(const f32x4*)(bias + bcol0 + bj * HALF + 4 * n) : (f32x4){0.f, 0.f, 0.f, 0.f};
#pragma unroll
        for (int ai = 0; ai < 2; ++ai)
#pragma unroll
            for (int m = 0; m < 4; ++m) { bf16_t* rowp = base + (size_t)(row0 + ai * HALF + m * 16) * ldc + col0;
#pragma unroll
                for (int bj = 0; bj < 2; ++bj) { f32x4 v0 = acc[ai][bj][m][0] + bv[bj][0], v1 = acc[ai][bj][m][1] + bv[bj][1];
                    if (ACT == 1) { f32x2 a = gelu_pk((f32x2){v0[0], v0[1]}), b = gelu_pk((f32x2){v0[2], v0[3]}), c = gelu_pk((f32x2){v1[0], v1[1]}), d = gelu_pk((f32x2){v1[2], v1[3]});
                        v0 = (f32x4){a.x, a.y, b.x, b.y}; v1 = (f32x4){c.x, c.y, d.x, d.y}; }
                    if (ACT == 2) {
#pragma unroll
                        for (int j = 0; j < 4; ++j) { v0[j] = 0.5f * v0[j] * (1.0f + erff(v0[j] * 0.70710678f)); v1[j] = 0.5f * v1[j] * (1.0f + erff(v1[j] * 0.70710678f)); } }
                    u32x4 w; w.x = cvt_pk_bf16(v0[0], v0[1]); w.y = cvt_pk_bf16(v0[2], v0[3]); w.z = cvt_pk_bf16(v1[0], v1[1]); w.w = cvt_pk_bf16(v1[2], v1[3]);
                    *(u32x4*)(rowp + bj * HALF) = w; } }
    }
};

struct PanelStats {
    unsigned* xbuf;
    unsigned* cnt;
    unsigned* tmo;
    int ntn; float eps;
    unsigned code;
    __device__ __forceinline__ bool run(const f32x4 (&v)[2][2][4][2], const Unit& u, int wr, int wc, int fr, int fq, PG8_LAS unsigned char* lds, int wid, int lane) const {
        typedef float f32x2v __attribute__((ext_vector_type(2)));
        PG8_LAS f32x2v* P = (PG8_LAS f32x2v*)lds;
        PG8_LAS f32x2v* S = (PG8_LAS f32x2v*)(lds + 8192);
        PG8_LAS unsigned* flag = (PG8_LAS unsigned*)(lds + 8192 + 2048);
#pragma unroll
        for (int ai = 0; ai < 2; ++ai)
#pragma unroll
            for (int m = 0; m < 4; ++m) {
                float s = 0.f;
#pragma unroll
                for (int bj = 0; bj < 2; ++bj)
#pragma unroll
                    for (int n = 0; n < 2; ++n) { const f32x4 x = v[ai][bj][m][n]; s += (x[0] + x[1]) + (x[2] + x[3]); }
                s += __shfl_xor(s, 16); s += __shfl_xor(s, 32);
                const float mw = s * (1.0f / 64.0f); float q = 0.f;
#pragma unroll
                for (int bj = 0; bj < 2; ++bj)
#pragma unroll
                    for (int n = 0; n < 2; ++n) { const f32x4 d = v[ai][bj][m][n] - mw; q += (d[0] * d[0] + d[1] * d[1]) + (d[2] * d[2] + d[3] * d[3]); }
                q += __shfl_xor(q, 16); q += __shfl_xor(q, 32);
                if (fq == 0) P[(ai * HALF + wr * 64 + m * 16 + fr) * 4 + wc] = (f32x2v){mw, q};
            }
        asm volatile("s_waitcnt lgkmcnt(0)" ::: "memory"); __builtin_amdgcn_s_barrier(); asm volatile("" ::: "memory");
#if defined(BROKEN_NO_WAIT)
        if (blockIdx.x >= 64) { const long long t0 = clock64(); while (clock64() - t0 < 60000) __builtin_amdgcn_s_sleep(8); }
#endif
        const int row = wid * 32 + (lane & 31);
        if (lane < 32) {
            const f32x2v a = P[row * 4 + 0], b = P[row * 4 + 1], c = P[row * 4 + 2], d = P[row * 4 + 3];
            const float mt = (a.x + b.x + c.x + d.x) * 0.25f;
            const float da = a.x - mt, db = b.x - mt, dc = c.x - mt, dd = d.x - mt;
            const float m2 = (a.y + b.y) + (c.y + d.y) + 64.0f * ((da * da + db * db) + (dc * dc + dd * dd));
            unsigned long long* slot = (unsigned long long*)xbuf + ((size_t)(u.pm * BM + row) * 4 + u.pn);
            __hip_atomic_store(slot, ((unsigned long long)__float_as_uint(m2) << 32) | __float_as_uint(mt), __ATOMIC_RELAXED, __HIP_MEMORY_SCOPE_AGENT);
        }
        asm volatile("s_waitcnt vmcnt(0)" ::: "memory");
        if (lane == 0) __hip_atomic_fetch_add(cnt + 64 * u.pm, 1u, __ATOMIC_RELAXED, __HIP_MEMORY_SCOPE_AGENT);
        if (wid == 0) {
            bool dead = false; const unsigned long long t0 = __builtin_amdgcn_s_memrealtime(); const unsigned want = 8u * (unsigned)ntn;
            for (;;) {
#if defined(BROKEN_NO_WAIT)
                break;
#endif
                if ((unsigned)__builtin_amdgcn_readfirstlane(__hip_atomic_load(cnt + 64 * u.pm, __ATOMIC_RELAXED, __HIP_MEMORY_SCOPE_AGENT)) >= want) break;
                if (__builtin_amdgcn_s_memrealtime() - t0 > 2000000ull) {
                    if (lane == 0) { unsigned expect = 0u; __hip_atomic_compare_exchange_strong(tmo + 1, &expect, code | (unsigned)(u.pm & 0xff), __ATOMIC_RELAXED, __ATOMIC_RELAXED, __HIP_MEMORY_SCOPE_AGENT);
                                     __hip_atomic_store(tmo, 1u, __ATOMIC_RELAXED, __HIP_MEMORY_SCOPE_AGENT); }
                    dead = true; break; }
                __builtin_amdgcn_s_sleep(2);
            }
            __builtin_amdgcn_fence(__ATOMIC_ACQUIRE, "agent");
            if (lane == 0) flag[0] = dead ? 1u : 0u;
        }
        asm volatile("s_waitcnt vmcnt(0) lgkmcnt(0)" ::: "memory"); __builtin_amdgcn_s_barrier(); asm volatile("" ::: "memory");
        const bool bad = flag[0] != 0u;
        if (lane < 32) {
            const unsigned long long* slot = (const unsigned long long*)xbuf + (size_t)(u.pm * BM + row) * 4; float mt[4], m2[4]; float ms = 0.f;
#pragma unroll
            for (int t = 0; t < 4; ++t) { if (t < ntn) { const unsigned long long w = __hip_atomic_load(slot + t, __ATOMIC_RELAXED, __HIP_MEMORY_SCOPE_AGENT); mt[t] = __uint_as_float((unsigned)w); m2[t] = __uint_as_float((unsigned)(w >> 32)); } else { mt[t] = 0.f; m2[t] = 0.f; } ms += mt[t]; }
            const float mean = ms / (float)ntn; float q = 0.f;
#pragma unroll
            for (int t = 0; t < 4; ++t) if (t < ntn) { const float dm = mt[t] - mean; q += m2[t] + 256.0f * dm * dm; }
            S[row] = (f32x2v){mean, 1.0f / sqrtf(q / (256.0f * (float)ntn) + eps)};
        }
        asm volatile("s_waitcnt lgkmcnt(0)" ::: "memory"); __builtin_amdgcn_s_barrier(); asm volatile("" ::: "memory");
        return bad;
    }
};
struct EpiLnRes {
    static constexpr bool PERM = false, AFTER_DRAIN = true;
    const float* base; float* out; int ldc; const float* bias; PanelStats st; unsigned poison;
    __device__ __forceinline__ void refuse(size_t i0, size_t stride, int M, int N) const { const float q = __builtin_nanf(""); for (size_t i = i0; i < (size_t)M * N; i += stride) out[(i / N) * ldc + i % N] = q;
        if (i0 == 0) { unsigned expect = 0u; __hip_atomic_compare_exchange_strong(st.tmo + 1, &expect, 0x7f0u, __ATOMIC_RELAXED, __ATOMIC_RELAXED, __HIP_MEMORY_SCOPE_AGENT); __hip_atomic_store(st.tmo, 1u, __ATOMIC_RELAXED, __HIP_MEMORY_SCOPE_AGENT); } }
    __device__ __forceinline__ void fused(f32x4 (&acc)[2][2][4][2], const Unit& u, int wr, int wc, int fr, int fq, PG8_LAS unsigned char* lds, int wid, int lane) const {
        typedef float f32x2v __attribute__((ext_vector_type(2)));
        const PG8_LAS f32x2v* S = (const PG8_LAS f32x2v*)(lds + 8192);
        const int col0 = u.pn * BM + wc * 32 + 4 * fq;
#pragma unroll
        for (int bj = 0; bj < 2; ++bj)
#pragma unroll
            for (int n = 0; n < 2; ++n) { const f32x4 bv = bias ? *(const f32x4*)(bias + col0 + bj * HALF + n * 16) : (f32x4){0.f, 0.f, 0.f, 0.f};
#pragma unroll
                for (int ai = 0; ai < 2; ++ai)
#pragma unroll
                    for (int m = 0; m < 4; ++m) acc[ai][bj][m][n] += bv; }
        const bool bad = st.run(acc, u, wr, wc, fr, fq, lds, wid, lane) || poison != 0u;
        const float qnan = __builtin_nanf("");
#pragma unroll
        for (int ai = 0; ai < 2; ++ai)
#pragma unroll
            for (int m = 0; m < 4; ++m) { const int r = ai * HALF + wr * 64 + m * 16 + fr; const f32x2v sr = S[r]; const size_t off = (size_t)(u.pm * BM + r) * ldc + col0;
#pragma unroll
                for (int bj = 0; bj < 2; ++bj)
#pragma unroll
                    for (int n = 0; n < 2; ++n) { const f32x4 bs = *(const f32x4*)(base + off + bj * HALF + n * 16); f32x4 o = bs + (acc[ai][bj][m][n] - sr.x) * sr.y;
                        if (bad) o = (f32x4){qnan, qnan, qnan, qnan}; *(f32x4*)(out + off + bj * HALF + n * 16) = o; }
                asm volatile("" ::: "memory"); }
    }
};
struct EpiLnResLn {
    static constexpr bool PERM = false, AFTER_DRAIN = true;
    const float* base; float* out; bf16_t* xn; int ldc; const float* bias; PanelStats st1, st2; unsigned poison;
    __device__ __forceinline__ void refuse(size_t i0, size_t stride, int M, int N) const { const float q = __builtin_nanf(""); for (size_t i = i0; i < (size_t)M * N; i += stride) { const size_t o = (i / N) * ldc + i % N; out[o] = q; xn[o] = (bf16_t)0x7fc0u; }
        if (i0 == 0) { unsigned expect = 0u; __hip_atomic_compare_exchange_strong(st1.tmo + 1, &expect, 0x7f0u, __ATOMIC_RELAXED, __ATOMIC_RELAXED, __HIP_MEMORY_SCOPE_AGENT); __hip_atomic_store(st1.tmo, 1u, __ATOMIC_RELAXED, __HIP_MEMORY_SCOPE_AGENT); } }
    __device__ __forceinline__ void fused(f32x4 (&acc)[2][2][4][2], const Unit& u, int wr, int wc, int fr, int fq, PG8_LAS unsigned char* lds, int wid, int lane) const {
        typedef float f32x2v __attribute__((ext_vector_type(2))); typedef unsigned u32x2v __attribute__((ext_vector_type(2)));
        const PG8_LAS f32x2v* S = (const PG8_LAS f32x2v*)(lds + 8192);
        const int col0 = u.pn * BM + wc * 32 + 4 * fq;
#pragma unroll
        for (int bj = 0; bj < 2; ++bj)
#pragma unroll
            for (int n = 0; n < 2; ++n) { const f32x4 bv = bias ? *(const f32x4*)(bias + col0 + bj * HALF + n * 16) : (f32x4){0.f, 0.f, 0.f, 0.f};
#pragma unroll
                for (int ai = 0; ai < 2; ++ai)
#pragma unroll
                    for (int m = 0; m < 4; ++m) acc[ai][bj][m][n] += bv; }
        bool bad = st1.run(acc, u, wr, wc, fr, fq, lds, wid, lane) || poison != 0u;
        const float qnan = __builtin_nanf("");
#pragma unroll
        for (int ai = 0; ai < 2; ++ai)
#pragma unroll
            for (int m = 0; m < 4; ++m) { const int r = ai * HALF + wr * 64 + m * 16 + fr; const f32x2v sr = S[r]; const size_t off = (size_t)(u.pm * BM + r) * ldc + col0;
#pragma unroll
                for (int bj = 0; bj < 2; ++bj)
#pragma unroll
                    for (int n = 0; n < 2; ++n) { const f32x4 bs = *(const f32x4*)(base + off + bj * HALF + n * 16); acc[ai][bj][m][n] = bs + (acc[ai][bj][m][n] - sr.x) * sr.y; }
                asm volatile("" : "+v"(acc[ai][0][m][0]), "+v"(acc[ai][0][m][1]), "+v"(acc[ai][1][m][0]), "+v"(acc[ai][1][m][1]));
                if (m & 1) asm volatile("" ::: "memory"); }
        const bool bad1 = bad;
        bad = st2.run(acc, u, wr, wc, fr, fq, lds, wid, lane) || bad;
#pragma unroll
        for (int ai = 0; ai < 2; ++ai)
#pragma unroll
            for (int m = 0; m < 4; ++m) { const int r = ai * HALF + wr * 64 + m * 16 + fr; const f32x2v sr = S[r]; const size_t off = (size_t)(u.pm * BM + r) * ldc + col0;
#pragma unroll
                for (int bj = 0; bj < 2; ++bj)
#pragma unroll
                    for (int n = 0; n < 2; ++n) { const f32x4 x1 = acc[ai][bj][m][n]; *(f32x4*)(out + off + bj * HALF + n * 16) = bad1 ? (f32x4){qnan, qnan, qnan, qnan} : x1;
                        const f32x4 o = (x1 - sr.x) * sr.y; u32x2v w; w.x = cvt_pk_bf16(o[0], o[1]); w.y = cvt_pk_bf16(o[2], o[3]);
                        if (bad) { w.x = 0x7fc07fc0u; w.y = 0x7fc07fc0u; } *(u32x2v*)(xn + off + bj * HALF + n * 16) = w; }
                asm volatile("" ::: "memory"); }
    }
};

template <class Epi, class Sched, bool STAMP = false>
__device__ __forceinline__ void gemm_phase(PG8_LAS unsigned char* lds, const Gemm g, const Sched S, const Epi E, unsigned long long* stamps) {
    const int tid = threadIdx.x, wid = __builtin_amdgcn_readfirstlane(tid >> 6), lane = tid & 63, wr = wid >> 2, wc = wid & 3, fr = lane & 15, fq = lane >> 4;
    const int K = g.K, nt = K / BK;
    int ts_lo = 0, ts_hi = 0, nts = 0; const unsigned long long rt_entry = STAMP ? (unsigned long long)wall_clock64() : 0ull;
#define PG8_STAMP() do { if (STAMP && wid == 0 && nts < 64) { const unsigned long long _c = (unsigned long long)clock64(); \
        ts_lo = (lane == nts) ? (int)(unsigned)_c : ts_lo; ts_hi = (lane == nts) ? (int)(unsigned)(_c >> 32) : ts_hi; ++nts; } } while (0)
    PG8_STAMP();
    unsigned voffA[2], voffB[2];
#pragma unroll
    for (int i = 0; i < 2; ++i) { int R, C; stage_rc(tid * 16 + i * 8192, R, C); const int Rb = Epi::PERM ? ((R & ~31) + perm32(R & 31)) : R;
        voffA[i] = (unsigned)(R * g.lda + C) * 2u; voffB[i] = (unsigned)(Rb * K + C) * 2u; }
    const size_t kstep = (size_t)(BK * 2);
    const size_t hstep = (size_t)HALF * K * 2;
    const size_t tstep = 2 * hstep;
    const size_t hstepA = (size_t)HALF * g.lda * 2, tstepA = 2 * hstepA;
    const unsigned ldsw = (unsigned)wid * 1024u;
    const int aoff = lds_byte(wr * 64 + fr, fq * 8), boff = lds_byte(wc * 32 + fr, fq * 8);
#define PG8_SA(b, h) (((b) * 2 + (h)) * HTB)
#define PG8_SB(b, h) ((4 + (b) * 2 + (h)) * HTB)
#define PG8_STAGE(bufoff, gbase, voff) do { _Pragma("unroll") for (int _i = 0; _i < 2; ++_i) \
        __builtin_amdgcn_global_load_lds((const unsigned*)((const char*)(gbase) + (voff)[_i]), (PG8_LAS unsigned*)(lds + (bufoff) + ldsw + _i * 8192), 16, 0, 0); } while (0)
#define PG8_LDA(dst, b, h) do { _Pragma("unroll") for (int m = 0; m < 4; ++m) _Pragma("unroll") for (int k = 0; k < 2; ++k) dst[m][k] = *(const PG8_LAS bf16x8*)(lds + PG8_SA(b, h) + aoff + m * 2048 + k * 1024); } while (0)
#define PG8_LDB(dst, b, h) do { _Pragma("unroll") for (int n = 0; n < 2; ++n) _Pragma("unroll") for (int k = 0; k < 2; ++k) dst[n][k] = *(const PG8_LAS bf16x8*)(lds + PG8_SB(b, h) + boff + n * 2048 + k * 1024); } while (0)
#define PG8_MMA(ai, bj, At, Bt) do { __builtin_amdgcn_s_setprio(1); _Pragma("unroll") for (int m = 0; m < 4; ++m) _Pragma("unroll") for (int n = 0; n < 2; ++n) _Pragma("unroll") for (int k = 0; k < 2; ++k) \
        acc[ai][bj][m][n] = __builtin_amdgcn_mfma_f32_16x16x32_bf16(Bt[n][k], At[m][k], acc[ai][bj][m][n], 0, 0, 0); __builtin_amdgcn_s_setprio(0); } while (0)
#define PG8_WAIT_V(n) asm volatile("s_waitcnt vmcnt(" #n ")" ::: "memory")
#define PG8_WAIT_L(n) asm volatile("s_waitcnt lgkmcnt(" #n ")" ::: "memory")
#define PG8_BAR __builtin_amdgcn_s_barrier()
#define PG8_SCHED __builtin_amdgcn_sched_barrier(0)
    Unit cur, nxt; int ui = 0;
    if (!S.next(0, cur)) return;
    f32x4 acc[2][2][4][2];
#pragma unroll
    for (int a = 0; a < 2; ++a)
#pragma unroll
        for (int b = 0; b < 2; ++b)
#pragma unroll
            for (int m = 0; m < 4; ++m)
#pragma unroll
                for (int n = 0; n < 2; ++n) acc[a][b][m][n] = (f32x4){0.f, 0.f, 0.f, 0.f};
    bf16x8 At[4][2], B0[2][2], B1[2][2];
    const char* cA = (const char*)g.A + (size_t)cur.pm * tstepA; const char* cB = (const char*)g.Bt + (size_t)cur.pn * tstep;
    S.a_ready(cur);
    PG8_STAGE(PG8_SB(0, 0), cB, voffB); PG8_STAGE(PG8_SA(0, 0), cA, voffA); PG8_STAGE(PG8_SB(0, 1), cB + hstep, voffB); PG8_STAGE(PG8_SA(0, 1), cA + hstepA, voffA);
    if (wr == 1) PG8_BAR;
    PG8_WAIT_V(4); PG8_BAR;
    PG8_STAGE(PG8_SB(1, 0), cB + kstep, voffB); PG8_STAGE(PG8_SA(1, 0), cA + kstep, voffA); PG8_STAGE(PG8_SB(1, 1), cB + hstep + kstep, voffB);
    PG8_WAIT_V(6); PG8_BAR;
    PG8_STAMP();
    for (;;) {
        const bool has_next = S.next(ui + 1, nxt);
        const char* nA = has_next ? (const char*)g.A + (size_t)nxt.pm * tstepA : cA; const char* nB = has_next ? (const char*)g.Bt + (size_t)nxt.pn * tstep : cB;
        for (int t = 0; t < nt; t += 2) {
            const bool last = (t == nt - 2);
            const char* a1 = cA + (size_t)(t + 1) * kstep;
            const char* a2 = last ? nA : cA + (size_t)(t + 2) * kstep; const char* b2 = last ? nB : cB + (size_t)(t + 2) * kstep;
            const char* a3 = a2 + kstep; const char* b3 = b2 + kstep;
            if (last && has_next) S.a_ready(nxt);
            PG8_LDB(B0, 0, 0); PG8_SCHED; PG8_LDA(At, 0, 0); PG8_STAGE(PG8_SA(1, 1), a1 + hstepA, voffA);
            PG8_WAIT_L(8); PG8_BAR; PG8_WAIT_L(0); PG8_MMA(0, 0, At, B0); PG8_BAR; PG8_SCHED;
            PG8_LDB(B1, 0, 1); PG8_STAGE(PG8_SB(0, 0), b2, voffB);
            PG8_BAR; PG8_WAIT_L(0); PG8_MMA(0, 1, At, B1); PG8_BAR;
            PG8_LDA(At, 0, 1); PG8_STAGE(PG8_SA(0, 0), a2, voffA);
            PG8_BAR; PG8_WAIT_L(0); PG8_MMA(1, 0, At, B0); PG8_BAR; PG8_SCHED;
            PG8_STAGE(PG8_SB(0, 1), b2 + hstep, voffB);
            PG8_WAIT_V(6); PG8_BAR; PG8_MMA(1, 1, At, B1); PG8_BAR;
            PG8_LDB(B0, 1, 0); PG8_SCHED; PG8_LDA(At, 1, 0); PG8_STAGE(PG8_SA(0, 1), a2 + hstepA, voffA);
            PG8_WAIT_L(8); PG8_BAR; PG8_WAIT_L(0); PG8_MMA(0, 0, At, B0); PG8_BAR; PG8_SCHED;
            PG8_LDB(B1, 1, 1); PG8_STAGE(PG8_SB(1, 0), b3, voffB);
            PG8_BAR; PG8_WAIT_L(0); PG8_MMA(0, 1, At, B1); PG8_BAR;
            PG8_LDA(At, 1, 1); PG8_STAGE(PG8_SA(1, 0), a3, voffA);
            PG8_BAR; PG8_WAIT_L(0); PG8_MMA(1, 0, At, B0); PG8_BAR; PG8_SCHED;
            PG8_STAGE(PG8_SB(1, 1), b3 + hstep, voffB);
            PG8_WAIT_V(6); PG8_BAR; PG8_MMA(1, 1, At, B1); PG8_BAR;
        }
        PG8_STAMP();
        if constexpr (!Epi::AFTER_DRAIN) { E(acc, cur, wr, wc, fr, fq); S.done(cur); }
        PG8_STAMP();
        if (!has_next) break;
#pragma unroll
        for (int a = 0; a < 2; ++a)
#pragma unroll
            for (int b = 0; b < 2; ++b)
#pragma unroll
                for (int m = 0; m < 4; ++m)
#pragma unroll
                    for (int n = 0; n < 2; ++n) acc[a][b][m][n] = (f32x4){0.f, 0.f, 0.f, 0.f};
        cur = nxt; cA = nA; cB = nB; ++ui;
    }
    PG8_WAIT_V(0);
    if (wr == 0) PG8_BAR;
    PG8_BAR;
    if constexpr (Epi::AFTER_DRAIN) { E.fused(acc, cur, wr, wc, fr, fq, lds, wid, lane); S.done(cur); }
    PG8_STAMP();
    if (STAMP && wid == 0) { stamps[lane] = lane < nts ? (((unsigned long long)(unsigned)ts_hi << 32) | (unsigned)ts_lo) : 0ull;
        if (lane == 62) stamps[62] = rt_entry; if (lane == 63) stamps[63] = (unsigned long long)wall_clock64(); }
#undef PG8_STAMP
#undef PG8_SA
#undef PG8_SB
#undef PG8_STAGE
#undef PG8_LDA
#undef PG8_LDB
#undef PG8_MMA
#undef PG8_WAIT_V
#undef PG8_WAIT_L
#undef PG8_BAR
#undef PG8_SCHED
}
}

namespace mk {
#define LAS __attribute__((address_space(3)))
using pg8::bf16_t; using pg8::bf16x8; using pg8::f32x4; using pg8::u32x4;
typedef unsigned u32x2 __attribute__((ext_vector_type(2)));

constexpr int DM = 1024, SEQ = 8192, NBATCH = 4, MPR = NBATCH * SEQ, MSAMP = 128, MREAL = MPR + MSAMP, MPAD = 33024;
constexpr int DFF = 2816, PW = 2816, NINP = 3072, CONVC = 1536;
constexpr float EPS = 1e-6f;
constexpr int NSCAN = 64;
constexpr int LDS_PHASE_BYTES = 147456, LDS_BYTES = LDS_PHASE_BYTES + 256;

constexpr size_t O_YP = 0, O_YS = 33554432, O_KP = 33685504, O_VP = 33751040, O_CP = 33816576, O_GP = 33835008,
                 O_KS = 34097152, O_VS = 36194304, O_CS = 38291456, O_GS = 38881280;
constexpr size_t MiB = 1u << 20;
constexpr size_t WS_CTL = 0, CTL_ZERO_BYTES = 1 * MiB;
constexpr size_t WS_W1IN = 1 * MiB, WS_W1OUT = 12 * MiB, WS_WINMIX = 18 * MiB, WS_WOUTMIX = 24 * MiB, WS_W2IN = 26 * MiB, WS_W2OUT = 37 * MiB;
constexpr size_t WS_GBA = 43 * MiB, WS_XN = 45 * MiB, WS_XN2 = 110 * MiB, WS_H = 175 * MiB, WS_GM = 353 * MiB, WS_GN = 417 * MiB;
constexpr size_t WS_GQ = 110 * MiB, WS_GO = 142 * MiB;
constexpr size_t WS_SSP1 = 481 * MiB, WS_SSP2 = 484 * MiB;
constexpr size_t WS_END = 487 * MiB;
constexpr size_t CTL_BAR = 0, CTL_BAR_BYTES = 16384, CTL_GLAST = 768 * 1024;

struct Params { const float* in[21]; float* out; unsigned char* ws; };

typedef float f32x2v __attribute__((ext_vector_type(2)));
typedef __bf16 bf16x2v __attribute__((ext_vector_type(2)));
__device__ __forceinline__ unsigned cvt_pk(float lo, float hi) { const f32x2v v = {lo, hi}; const bf16x2v b = __builtin_convertvector(v, bf16x2v); return __builtin_bit_cast(unsigned, b); }
__device__ __forceinline__ bf16_t f2bf(float f) { return (bf16_t)(cvt_pk(f, 0.f) & 0xffffu); }
__device__ __forceinline__ float bf2f(bf16_t h) { return __uint_as_float(((unsigned)h) << 16); }
__device__ __forceinline__ float bflo(unsigned w) { return __uint_as_float(w << 16); }
__device__ __forceinline__ float bfhi(unsigned w) { return __uint_as_float(w & 0xffff0000u); }
__device__ __forceinline__ float silu(float x) { return x * __builtin_amdgcn_rcpf(1.0f + __expf(-x)); }
__device__ __forceinline__ float wave_sum(float v) {
#pragma unroll
    for (int o = 1; o < 64; o <<= 1) v += __shfl_xor(v, o);
    return v;
}
__device__ __forceinline__ float wave_max(float v) {
#pragma unroll
    for (int o = 1; o < 64; o <<= 1) v = fmaxf(v, __shfl_xor(v, o));
    return v;
}
__device__ __forceinline__ f32x4 mfma16(bf16x8 a, bf16x8 b, f32x4 c) { return __builtin_amdgcn_mfma_f32_16x16x32_bf16(a, b, c, 0, 0, 0); }

__device__ __forceinline__ float row_rstd(const float* ssp, int r) {
    if (r >= MREAL) return 0.f;
    const f32x4 a = *(const f32x4*)(ssp + (size_t)r * 16), b = *(const f32x4*)(ssp + (size_t)r * 16 + 4), c = *(const f32x4*)(ssp + (size_t)r * 16 + 8), d = *(const f32x4*)(ssp + (size_t)r * 16 + 12);
    const float s = (((a[0] + a[1]) + (a[2] + a[3])) + ((b[0] + b[1]) + (b[2] + b[3]))) + (((c[0] + c[1]) + (c[2] + c[3])) + ((d[0] + d[1]) + (d[2] + d[3])));
    return rsqrtf(s * (1.0f / DM) + EPS);
}
struct EpiSwiglu {
    static constexpr bool PERM = true, AFTER_DRAIN = false;
    bf16_t* H; const float* ss;
    __device__ __forceinline__ void operator()(const f32x4 (&acc)[2][2][4][2], const pg8::Unit& u, int wr, int wc, int fr, int fq) const {
        const int row0 = u.pm * 256 + wr * 64 + fr, col0 = u.pn * 128 + wc * 32 + 8 * fq;
#pragma unroll
        for (int ai = 0; ai < 2; ++ai)
#pragma unroll
            for (int m = 0; m < 4; ++m) {
                const int r = row0 + ai * 128 + m * 16;
                const float rs = ss ? row_rstd(ss, r) : 1.0f;
                float h[8];
#pragma unroll
                for (int n = 0; n < 2; ++n)
#pragma unroll
                    for (int j = 0; j < 4; ++j) h[n * 4 + j] = silu(acc[ai][0][m][n][j] * rs) * (acc[ai][1][m][n][j] * rs);
                u32x4 w; w.x = cvt_pk(h[0], h[1]); w.y = cvt_pk(h[2], h[3]); w.z = cvt_pk(h[4], h[5]); w.w = cvt_pk(h[6], h[7]);
                *(u32x4*)(H + (size_t)r * DFF + col0) = w;
            }
    }
};
template <bool RESB16, bool WF32, bool WB16, bool SUMSQ, bool HALF> struct EpiResid {
    static constexpr bool PERM = true, AFTER_DRAIN = false;
    const void* resP; const void* resS; float* Yo; bf16_t* XBo; float* sso;
    __device__ __forceinline__ void operator()(const f32x4 (&acc)[2][2][4][2], const pg8::Unit& u, int wr, int wc, int fr, int fq) const {
        const int row0 = u.pm * 256 + wr * 64 + fr, col0 = u.pn * 256 + wc * 32 + 8 * fq;
        const char* const rP = (const char*)resP; const char* const rS = (const char*)resS - (size_t)MPR * DM * (RESB16 ? 2 : 4);
        float* const Y = Yo; const float scale = HALF ? 0.5f : 1.0f; bf16_t* const XB = XBo; float* const ss = sso;
#pragma unroll
        for (int ai = 0; ai < 2; ++ai)
#pragma unroll
            for (int m = 0; m < 4; ++m) {
                const int r = row0 + ai * 128 + m * 16; float s = 0.f;
                if (r < MREAL) {
                    const char* rp = ((r < MPR) ? rP : rS) + (size_t)r * DM * (RESB16 ? 2 : 4);
#pragma unroll
                    for (int bj = 0; bj < 2; ++bj) {
                        const int c = col0 + bj * 128;
                        f32x4 r0, r1;
                        if (RESB16) { const u32x4 w = *(const u32x4*)(rp + (size_t)c * 2); r0 = (f32x4){bflo(w.x), bfhi(w.x), bflo(w.y), bfhi(w.y)}; r1 = (f32x4){bflo(w.z), bfhi(w.z), bflo(w.w), bfhi(w.w)}; }
                        else { r0 = *(const f32x4*)(rp + (size_t)c * 4); r1 = *(const f32x4*)(rp + (size_t)c * 4 + 16); }
                        const f32x4 v0 = r0 + acc[ai][bj][m][0] * scale, v1 = r1 + acc[ai][bj][m][1] * scale;
                        if (WF32) { *(f32x4*)(Y + (size_t)r * DM + c) = v0; *(f32x4*)(Y + (size_t)r * DM + c + 4) = v1; }
                        if (WB16) { u32x4 w; w.x = cvt_pk(v0[0], v0[1]); w.y = cvt_pk(v0[2], v0[3]); w.z = cvt_pk(v1[0], v1[1]); w.w = cvt_pk(v1[2], v1[3]);
                            *(u32x4*)(XB + (size_t)r * DM + c) = w; }
                        if (SUMSQ) s += (v0[0] * v0[0] + v0[1] * v0[1]) + (v0[2] * v0[2] + v0[3] * v0[3]) + (v1[0] * v1[0] + v1[1] * v1[1]) + (v1[2] * v1[2] + v1[3] * v1[3]);
                    }
                }
                if (SUMSQ) { s += __shfl_xor(s, 16); s += __shfl_xor(s, 32); if (fq == 0 && r < MREAL) ss[(size_t)r * 16 + u.pn * 4 + wc] = s; }
            }
    }
};
struct EpiInproj {
    static constexpr bool PERM = true, AFTER_DRAIN = false;
    bf16_t* P; float* gba; const float* ss;
    __device__ __forceinline__ void operator()(const f32x4 (&acc)[2][2][4][2], const pg8::Unit& u, int wr, int wc, int fr, int fq) const {
        const int row0 = u.pm * 256 + wr * 64 + fr, col0 = u.pn * 256 + wc * 32 + 8 * fq;
#pragma unroll
        for (int ai = 0; ai < 2; ++ai)
#pragma unroll
            for (int m = 0; m < 4; ++m) {
                const int r = row0 + ai * 128 + m * 16;
                const float rs = row_rstd(ss, r);
                if (u.pn < 11) {
#pragma unroll
                    for (int bj = 0; bj < 2; ++bj) { const f32x4 v0 = acc[ai][bj][m][0] * rs, v1 = acc[ai][bj][m][1] * rs;
                        u32x4 w; w.x = cvt_pk(v0[0], v0[1]); w.y = cvt_pk(v0[2], v0[3]); w.z = cvt_pk(v1[0], v1[1]); w.w = cvt_pk(v1[2], v1[3]);
                        *(u32x4*)(P + (size_t)r * PW + col0 + bj * 128) = w; }
                } else if (wc == 0 && fq == 0) {
                    *(f32x4*)(gba + (size_t)r * 8) = acc[ai][0][m][0] * rs; *(f32x4*)(gba + (size_t)r * 8 + 4) = acc[ai][0][m][1] * rs;
                }
            }
    }
};


template <int NT, bool SS>
__device__ __forceinline__ void skinny_mm(const bf16_t* A, int lda, const bf16_t* W, int K, int wrow0, int wrow1, int wid, int fr, int fq, f32x4 (&acc)[NT], float& ss) {
    const bf16_t* ap = A + (size_t)(16 * wid + fr) * lda + 8 * fq;
    const bf16_t* w0 = W + (size_t)(wrow0 + fr) * K + 8 * fq; const bf16_t* w1 = W + (size_t)(wrow1 + fr) * K + 8 * fq;
#pragma unroll
    for (int nt = 0; nt < NT; ++nt) acc[nt] = (f32x4){0.f, 0.f, 0.f, 0.f};
    float s = 0.f;
#pragma unroll 8
    for (int ks = 0; ks < K / 32; ++ks) {
        const bf16x8 a = *(const bf16x8*)(ap + 32 * ks);
        acc[0] = mfma16(*(const bf16x8*)(w0 + 32 * ks), a, acc[0]);
        if (NT == 2) acc[NT - 1] = mfma16(*(const bf16x8*)(w1 + 32 * ks), a, acc[NT - 1]);
        if (SS) { const u32x4 u = __builtin_bit_cast(u32x4, a);
#pragma unroll
            for (int k = 0; k < 4; ++k) { const float lo = bflo(u[k]), hi = bfhi(u[k]); s += lo * lo + hi * hi; } }
    }
    if (SS) { s += __shfl_xor(s, 16); s += __shfl_xor(s, 32); }
    ss = s;
}
template <bool SS> __device__ __forceinline__ void sk_ffn_in(const bf16_t* X, const bf16_t* Wt, bf16_t* H, int slab, int wid, int fr, int fq) {
    const int j0 = 16 * slab, wr0 = (j0 >> 7) * 256 + (j0 & 127);
    f32x4 acc[2]; float ss;
    skinny_mm<2, SS>(X + (size_t)MPR * DM, DM, Wt, DM, wr0, wr0 + 128, wid, fr, fq, acc, ss);
    const float rs = SS ? rsqrtf(ss * (1.0f / DM) + EPS) : 1.0f;
    float h[4];
#pragma unroll
    for (int e = 0; e < 4; ++e) h[e] = silu(acc[0][e] * rs) * (acc[1][e] * rs);
    u32x2 w; w.x = cvt_pk(h[0], h[1]); w.y = cvt_pk(h[2], h[3]);
    *(u32x2*)(H + (size_t)(MPR + 16 * wid + fr) * DFF + j0 + 4 * fq) = w;
}
template <bool OUTF32> __device__ __forceinline__ void sk_ffn_out(const bf16_t* Hb, const bf16_t* Wt, const float* resf, float* outf, bf16_t* outb, int slab, int wid, int fr, int fq) {
    f32x4 acc[1]; float ss;
    skinny_mm<1, false>(Hb + (size_t)MPR * DFF, DFF, Wt, DFF, 16 * slab, 0, wid, fr, fq, acc, ss);
    const int rl = 16 * wid + fr, c = 16 * slab + 4 * fq;
    const f32x4 v = *(const f32x4*)(resf + (size_t)rl * DM + c) + acc[0] * 0.5f;
    if (OUTF32) *(f32x4*)(outf + (size_t)rl * DM + c) = v;
    else { u32x2 w; w.x = cvt_pk(v[0], v[1]); w.y = cvt_pk(v[2], v[3]); *(u32x2*)(outb + (size_t)rl * DM + c) = w; }
}
__device__ __forceinline__ void sk_inproj(const bf16_t* X, const bf16_t* Wt, bf16_t* P, float* gba, int slab, int wid, int fr, int fq) {
    const int n0 = 32 * slab; f32x4 acc[2]; float ss;
    skinny_mm<2, true>(X + (size_t)MPR * DM, DM, Wt, DM, n0, n0 + 16, wid, fr, fq, acc, ss);
    const float rs = rsqrtf(ss * (1.0f / DM) + EPS); const int r = MPR + 16 * wid + fr;
    if (n0 < PW) {
#pragma unroll
        for (int nt = 0; nt < 2; ++nt) { const f32x4 v = acc[nt] * rs; u32x2 w; w.x = cvt_pk(v[0], v[1]); w.y = cvt_pk(v[2], v[3]); *(u32x2*)(P + (size_t)r * PW + n0 + 16 * nt + 4 * fq) = w; }
    } else if (fq < 2) *(f32x4*)(gba + (size_t)r * 8 + 4 * fq) = acc[0] * rs;
}
__device__ __forceinline__ void sk_outproj(const bf16_t* Pm, const bf16_t* Wt, const bf16_t* X1b, float* X2f, bf16_t* X2b, int slab, int wid, int fr, int fq) {
    const int n0 = 32 * slab; f32x4 acc[2]; float ss;
    skinny_mm<2, false>(Pm + (size_t)MPR * PW, PW, Wt, DM, n0, n0 + 16, wid, fr, fq, acc, ss);
    const int r = MPR + 16 * wid + fr;
#pragma unroll
    for (int nt = 0; nt < 2; ++nt) { const int c = n0 + 16 * nt + 4 * fq; const u32x2 xr = *(const u32x2*)(X1b + (size_t)r * DM + c);
        const f32x4 v = (f32x4){bflo(xr.x), bfhi(xr.x), bflo(xr.y), bfhi(xr.y)} + acc[nt];
        *(f32x4*)(X2f + (size_t)r * DM + c) = v; u32x2 w; w.x = cvt_pk(v[0], v[1]); w.y = cvt_pk(v[2], v[3]); *(u32x2*)(X2b + (size_t)r * DM + c) = w; }
}

__device__ __forceinline__ void transpose_item(const float* W, int K, int N, bf16_t* WT, int k0, int n0, int drow0, const float* gs, LAS float* scr, int lane) {
#pragma unroll 8
    for (int i = 0; i < 32; ++i) { const int kk = 2 * i + (lane >> 5), n = n0 + (lane & 31);
        float v = (n < N) ? W[(size_t)(k0 + kk) * N + n] : 0.f; if (gs) v *= gs[k0 + kk];
        scr[kk * 33 + (lane & 31)] = v; }
    asm volatile("s_waitcnt lgkmcnt(0)" ::: "memory");
    const int c = lane & 7;
#pragma unroll
    for (int j = 0; j < 4; ++j) { const int nn = (lane >> 3) + 8 * j; const LAS float* s = scr + (8 * c) * 33 + nn;
        u32x4 o; o.x = cvt_pk(s[0 * 33], s[1 * 33]); o.y = cvt_pk(s[2 * 33], s[3 * 33]); o.z = cvt_pk(s[4 * 33], s[5 * 33]); o.w = cvt_pk(s[6 * 33], s[7 * 33]);
        *(u32x4*)(WT + (size_t)(drow0 + nn) * K + k0 + 8 * c) = o; }
    asm volatile("s_waitcnt lgkmcnt(0)" ::: "memory");
}
__device__ __forceinline__ int map_ffin_row(int n0) { return n0 < DFF ? (n0 >> 7) * 256 + (n0 & 127) : ((n0 - DFF) >> 7) * 256 + 128 + ((n0 - DFF) & 127); }

__device__ __forceinline__ void p0_prologue(const Params& p, LAS unsigned char* lds, int vb, int G) {
    const int tid = threadIdx.x, lane = tid & 63, wid = tid >> 6;
    LAS float* scr = (LAS float*)(lds + wid * 16384);
    const int gw = vb * 8 + wid, NGW = G * 8;
    bf16_t* W1IN = (bf16_t*)(p.ws + WS_W1IN); bf16_t* W1OUT = (bf16_t*)(p.ws + WS_W1OUT); bf16_t* WINMIX = (bf16_t*)(p.ws + WS_WINMIX);
    bf16_t* WOUTMIX = (bf16_t*)(p.ws + WS_WOUTMIX); bf16_t* W2IN = (bf16_t*)(p.ws + WS_W2IN); bf16_t* W2OUT = (bf16_t*)(p.ws + WS_W2OUT);
    constexpr int I_FIN = 16 * 176, I_FOUT = 44 * 32, I_INMIX = 16 * 89, I_OUTMIX = 16 * 32;
    constexpr int NITEMS = 2 * I_FIN + 2 * I_FOUT + I_INMIX + I_OUTMIX;
    for (int it = gw; it < NITEMS; it += NGW) {
        int r = it;
        if (r < I_FIN) { const int kb = r / 176, nb = r % 176; transpose_item(p.in[7], DM, 2 * DFF, W1IN, kb * 64, nb * 32, map_ffin_row(nb * 32), nullptr, scr, lane); continue; } r -= I_FIN;
        if (r < I_FIN) { const int kb = r / 176, nb = r % 176; transpose_item(p.in[18], DM, 2 * DFF, W2IN, kb * 64, nb * 32, map_ffin_row(nb * 32), p.in[17], scr, lane); continue; } r -= I_FIN;
        if (r < I_FOUT) { const int kb = r / 32, nb = r % 32; transpose_item(p.in[8], DFF, DM, W1OUT, kb * 64, nb * 32, nb * 32, nullptr, scr, lane); continue; } r -= I_FOUT;
        if (r < I_FOUT) { const int kb = r / 32, nb = r % 32; transpose_item(p.in[19], DFF, DM, W2OUT, kb * 64, nb * 32, nb * 32, nullptr, scr, lane); continue; } r -= I_FOUT;
        if (r < I_INMIX) { const int kb = r / 89, nb = r % 89; transpose_item(p.in[10], DM, 2824, WINMIX, kb * 64, nb * 32, nb * 32, p.in[9], scr, lane); continue; } r -= I_INMIX;
        { const int kb = r / 32, nb = r % 32; transpose_item(p.in[16], DM, DM, WOUTMIX, kb * 64, nb * 32, nb * 32, nullptr, scr, lane); }
    }
    bf16_t* XN = (bf16_t*)(p.ws + WS_XN); const float* g1 = p.in[6];
    f32x4 gv[4];
#pragma unroll
    for (int j = 0; j < 4; ++j) gv[j] = *((const f32x4*)g1 + lane + 64 * j);
    for (int m = gw; m < MPAD; m += NGW) {
        unsigned long long* o8 = (unsigned long long*)(XN + (size_t)m * DM) + lane;
        if (m >= MREAL) {
#pragma unroll
            for (int j = 0; j < 4; ++j) o8[64 * j] = 0ull;
            continue; }
        const float* xrow = (m < MPR) ? p.in[0] + (size_t)m * DM : p.in[1] + (size_t)(m - MPR) * DM;
        const f32x4* xr = (const f32x4*)xrow + lane;
        f32x4 v[4]; float s = 0.f;
#pragma unroll
        for (int j = 0; j < 4; ++j) { v[j] = xr[64 * j]; s += (v[j][0] * v[j][0] + v[j][1] * v[j][1]) + (v[j][2] * v[j][2] + v[j][3] * v[j][3]); }
        const float rstd = rsqrtf(wave_sum(s) * (1.0f / DM) + EPS);
#pragma unroll
        for (int j = 0; j < 4; ++j) { const f32x4 y = v[j] * rstd * gv[j];
            o8[64 * j] = (unsigned long long)cvt_pk(y[0], y[1]) | ((unsigned long long)cvt_pk(y[2], y[3]) << 32); }
    }
}

__device__ __forceinline__ f32x4 tile_mm(const LAS bf16_t* X, int ldx, int mt, const LAS bf16_t* Y, int ldy, int nt, int nks, int fr, int fq) {
    f32x4 acc = (f32x4){0.f, 0.f, 0.f, 0.f};
    const LAS bf16_t* xp = X + (16 * mt + fr) * ldx + 8 * fq; const LAS bf16_t* yp = Y + (16 * nt + fr) * ldy + 8 * fq;
    for (int ks = 0; ks < nks; ++ks) acc = mfma16(*(const LAS bf16x8*)(xp + 32 * ks), *(const LAS bf16x8*)(yp + 32 * ks), acc);
    return acc;
}
constexpr int G1_QS = 0, G1_KS = 17408, G1_VBT = 34816, G1_KBT = 53248, G1_KDT = 71680, G1_UT = 90112, G1_WT = 108544, G1_QK = 126976, G1_TB = 136192, G1_GC = 145408, G1_BETA = 145664;

__device__ __forceinline__ void gdn_prep_unit(const Params& p, LAS unsigned char* lds, int unit) {
    const int tid = threadIdx.x, lane = tid & 63, wid = tid >> 6, fr = lane & 15, fq = lane >> 4;
    const int bh = unit >> 7, n = unit & 127, b = bh >> 2, h = bh & 3;
    const int tok0 = b * SEQ + n * 64;
    LAS bf16_t* Qs = (LAS bf16_t*)(lds + G1_QS); LAS bf16_t* Ks = (LAS bf16_t*)(lds + G1_KS); LAS bf16_t* VbT = (LAS bf16_t*)(lds + G1_VBT);
    LAS bf16_t* KbT = (LAS bf16_t*)(lds + G1_KBT); LAS bf16_t* KdT = (LAS bf16_t*)(lds + G1_KDT); LAS bf16_t* UT = (LAS bf16_t*)(lds + G1_UT);
    LAS bf16_t* WT = (LAS bf16_t*)(lds + G1_WT); LAS float* Af = (LAS float*)(lds + G1_WT); LAS bf16_t* QK = (LAS bf16_t*)(lds + G1_QK);
    LAS bf16_t* Tb = (LAS bf16_t*)(lds + G1_TB); LAS float* gcs = (LAS float*)(lds + G1_GC); LAS float* betas = (LAS float*)(lds + G1_BETA);
    const bf16_t* PB = (const bf16_t*)(p.ws + WS_H); const float* GBA = (const float*)(p.ws + WS_GBA);
    if (tid < 64) {
        const float* gb = GBA + (size_t)(tok0 + tid) * 8;
        const float bt = 1.0f / (1.0f + __expf(-gb[h]));
        const float x = gb[4 + h] + p.in[14][h]; const float sp = x > 20.f ? x : log1pf(__expf(x));
        float c = -__expf(p.in[13][h]) * sp;
#pragma unroll
        for (int o = 1; o < 64; o <<= 1) { const float t = __shfl_up(c, o); if (lane >= o) c += t; }
        gcs[tid] = c; betas[tid] = bt;
    }
    __syncthreads();
    const float gclast = gcs[63];
    const float* cw = p.in[12];
#pragma unroll 1
    for (int it = 0; it < 6; ++it) {
        const int item = tid + 512 * it, l16 = item & 15, row = item >> 4, which = row >> 6, t = row & 63;
        const int cch = which * 512 + h * 128 + l16 * 8;
        float a[8];
#pragma unroll
        for (int e = 0; e < 8; ++e) a[e] = 0.f;
#pragma unroll
        for (int j = 0; j < 4; ++j) {
            const int tt = n * 64 + t - 3 + j;
            if (tt >= 0) {
                const u32x4 xv = *(const u32x4*)(PB + (size_t)(b * SEQ + tt) * PW + 768 + cch);
                const f32x4 w0 = *(const f32x4*)(cw + j * CONVC + cch), w1 = *(const f32x4*)(cw + j * CONVC + cch + 4);
                a[0] += w0[0] * bflo(xv.x); a[1] += w0[1] * bfhi(xv.x); a[2] += w0[2] * bflo(xv.y); a[3] += w0[3] * bfhi(xv.y);
                a[4] += w1[0] * bflo(xv.z); a[5] += w1[1] * bfhi(xv.z); a[6] += w1[2] * bflo(xv.w); a[7] += w1[3] * bfhi(xv.w);
            }
        }
        float ss = 0.f;
#pragma unroll
        for (int e = 0; e < 8; ++e) { a[e] = silu(a[e]); ss += a[e] * a[e]; }
        ss += __shfl_xor(ss, 1); ss += __shfl_xor(ss, 2); ss += __shfl_xor(ss, 4); ss += __shfl_xor(ss, 8);
        const float gct = gcs[t], bt = betas[t];
        if (which == 0) {
            const float sc = rsqrtf(ss + EPS) * 0.08838834764831845f;
            u32x4 w; w.x = cvt_pk(a[0] * sc, a[1] * sc); w.y = cvt_pk(a[2] * sc, a[3] * sc); w.z = cvt_pk(a[4] * sc, a[5] * sc); w.w = cvt_pk(a[6] * sc, a[7] * sc);
            *(LAS u32x4*)(Qs + t * 136 + l16 * 8) = w;
        } else if (which == 1) {
            const float sc = rsqrtf(ss + EPS);
            u32x4 w; w.x = cvt_pk(a[0] * sc, a[1] * sc); w.y = cvt_pk(a[2] * sc, a[3] * sc); w.z = cvt_pk(a[4] * sc, a[5] * sc); w.w = cvt_pk(a[6] * sc, a[7] * sc);
            *(LAS u32x4*)(Ks + t * 136 + l16 * 8) = w;
            const float sb = sc * bt * __expf(gct), sd = sc * __expf(gclast - gct);
#pragma unroll
            for (int e = 0; e < 8; ++e) { KbT[(l16 * 8 + e) * 72 + t] = f2bf(a[e] * sb); KdT[(l16 * 8 + e) * 72 + t] = f2bf(a[e] * sd); }
        } else {
#pragma unroll
            for (int e = 0; e < 8; ++e) VbT[(l16 * 8 + e) * 72 + t] = f2bf(a[e] * bt);
        }
    }
    __syncthreads();
#pragma unroll 2
    for (int r = 0; r < 4; ++r) {
        const int job = wid + 8 * r, kind = job >> 4, tile = job & 15, it = tile >> 2, jt = tile & 3;
        if (kind == 0) {
            if (jt > it) continue;
            const f32x4 acc = tile_mm(Ks, 136, it, Ks, 136, jt, 4, fr, fq);
            const int j = 16 * jt + fr; const float gcj = gcs[j];
            float v[4];
#pragma unroll
            for (int e = 0; e < 4; ++e) { const int i = 16 * it + 4 * fq + e; const bool ok = i > j; v[e] = ok ? acc[e] * __expf(gcs[i] - gcj) * betas[i] : 0.f; }
            *(LAS f32x4*)(Af + j * 68 + 16 * it + 4 * fq) = (f32x4){v[0], v[1], v[2], v[3]};
        } else {
            const f32x4 acc = tile_mm(Ks, 136, jt, Qs, 136, it, 4, fr, fq);
            const int i = 16 * it + fr; const float gci = gcs[i];
            float v[4];
#pragma unroll
            for (int e = 0; e < 4; ++e) { const int j = 16 * jt + 4 * fq + e; const bool ok = i >= j; v[e] = ok ? acc[e] * __expf(gci - gcs[j]) : 0.f; }
            u32x2 w; w.x = cvt_pk(v[0], v[1]); w.y = cvt_pk(v[2], v[3]); *(LAS u32x2*)(QK + i * 72 + 16 * jt + 4 * fq) = w;
        }
    }
    __syncthreads();
    if (wid == 0) {
        f32x2v r2[32];
#pragma unroll
        for (int k = 0; k < 32; ++k) r2[k] = (f32x2v){(lane == 2 * k) ? 1.0f : 0.0f, (lane == 2 * k + 1) ? 1.0f : 0.0f};
#pragma unroll
        for (int j = 0; j < 64; ++j) {
            const float tj = (j & 1) ? r2[j >> 1][1] : r2[j >> 1][0];
            Tb[j * 72 + lane] = f2bf(tj);
            const f32x2v t2 = (f32x2v){tj, tj};
#pragma unroll
            for (int i4 = (j + 1) >> 2; i4 < 16; ++i4) {
                const f32x4 av = *(const LAS f32x4*)(Af + j * 68 + 4 * i4);
                if (4 * i4 + 1 > j) r2[2 * i4] -= (f32x2v){av[0], av[1]} * t2;
                if (4 * i4 + 3 > j) r2[2 * i4 + 1] -= (f32x2v){av[2], av[3]} * t2;
            }
        }
    }
    __syncthreads();
#pragma unroll 2
    for (int r = 0; r < 8; ++r) {
        const int job = wid + 8 * r, kind = job >> 5, tile = job & 31, mt = tile >> 3, nt = tile & 7;
        const f32x4 acc = tile_mm(Tb, 72, mt, kind ? KbT : VbT, 72, nt, 2, fr, fq);
        u32x2 w; w.x = cvt_pk(acc[0], acc[1]); w.y = cvt_pk(acc[2], acc[3]);
        *(LAS u32x2*)((kind ? WT : UT) + (16 * nt + fr) * 72 + 16 * mt + 4 * fq) = w;
    }
    __syncthreads();
    bf16_t* GM = (bf16_t*)(p.ws + WS_GM) + (size_t)unit * 16384; bf16_t* GN = (bf16_t*)(p.ws + WS_GN) + (size_t)unit * 16384;
    bf16_t* GQ = (bf16_t*)(p.ws + WS_GQ) + (size_t)unit * 8192; bf16_t* GO = (bf16_t*)(p.ws + WS_GO) + (size_t)unit * 8192;
#pragma unroll 2
    for (int r = 0; r < 24; ++r) {
        const int job = wid + 8 * r;
        if (job < 64) { const int a = job >> 3, mt = job & 7;
            const f32x4 acc = tile_mm(WT, 72, a, KdT, 72, mt, 2, fr, fq);
            u32x2 w; w.x = cvt_pk(-acc[0], -acc[1]); w.y = cvt_pk(-acc[2], -acc[3]);
            *(u32x2*)(GM + ((mt * 4 + (a >> 1)) * 64 + lane) * 8 + (a & 1) * 4) = w;
        } else if (job < 128) { const int j = job - 64, mt = j >> 3, nt = j & 7;
            const f32x4 acc = tile_mm(KdT, 72, mt, UT, 72, nt, 2, fr, fq);
            u32x2 w; w.x = cvt_pk(acc[0], acc[1]); w.y = cvt_pk(acc[2], acc[3]);
            *(u32x2*)(GN + ((nt * 64 + lane) * 8 + mt) * 4) = w;
        } else if (job < 160) { const int j = job - 128, a = j >> 2, it = j & 3;
            const f32x4 acc = tile_mm(WT, 72, a, QK, 72, it, 2, fr, fq);
            const int i = 16 * it + fr; const float eg = __expf(gcs[i]);
            const u32x2 qv = *(const LAS u32x2*)(Qs + i * 136 + 16 * a + 4 * fq);
            u32x2 w; w.x = cvt_pk(bflo(qv.x) * eg - acc[0], bfhi(qv.x) * eg - acc[1]); w.y = cvt_pk(bflo(qv.y) * eg - acc[2], bfhi(qv.y) * eg - acc[3]);
            *(u32x2*)(GQ + ((it * 4 + (a >> 1)) * 64 + lane) * 8 + (a & 1) * 4) = w;
        } else { const int j = job - 160, mt = j >> 3, nt = j & 7;
            const f32x4 acc = tile_mm(QK, 72, mt, UT, 72, nt, 2, fr, fq);
            u32x2 w; w.x = cvt_pk(acc[0], acc[1]); w.y = cvt_pk(acc[2], acc[3]);
            *(u32x2*)(GO + ((nt * 64 + lane) * 4 + mt) * 4) = w;
        }
    }
    if (tid == 0) ((float*)(p.ws + WS_CTL + CTL_GLAST))[unit] = __expf(gclast);
    __syncthreads();
}

__device__ __forceinline__ void gdn_scan(const Params& p, LAS unsigned char* lds, int sb) {
    const int tid = threadIdx.x, lane = tid & 63, wid = tid >> 6, fr = lane & 15, fq = lane >> 4;
    const int bh = sb >> 2, sp = sb & 3, unit0 = bh * 128, sl = sp * 2 + wid;
    const u32x4* GMb = (const u32x4*)((const bf16_t*)(p.ws + WS_GM) + (size_t)unit0 * 16384);
    const u32x4* GQb = (const u32x4*)((const bf16_t*)(p.ws + WS_GQ) + (size_t)unit0 * 8192);
    const bf16_t* GNb = (const bf16_t*)(p.ws + WS_GN) + (size_t)unit0 * 16384;
    bf16_t* GOb = (bf16_t*)(p.ws + WS_GO) + (size_t)unit0 * 8192;
    const float* glast = (const float*)(p.ws + WS_CTL + CTL_GLAST) + unit0;
    const bool loader = (wid >= 2 && wid < 6);
#define SCAN_DMA(cc) do { _Pragma("unroll") for (int k = 0; k < 8; ++k) { const int inst = (wid - 2) * 8 + k; \
        __builtin_amdgcn_global_load_lds((const unsigned*)((const char*)(GMb + (size_t)(cc) * 2048) + inst * 1024 + lane * 16), (LAS unsigned*)(lds + ((cc) & 3) * 32768 + inst * 1024), 16, 0, 0); } } while (0)
#define SCAN_LOADN(dn, cc) do { _Pragma("unroll") for (int i = 0; i < 4; ++i) dn[i] = *(const u32x4*)(GNb + (size_t)(cc) * 16384 + (size_t)(sl * 64 + lane) * 32 + i * 8); } while (0)
#define SCAN_STEP(c, nn, RELOAD) do { \
        const float gl = __shfl(((c) < 64) ? glr0 : glr1, (c) & 63); bf16x8 Sb[4]; \
        bf16_t* scp = (bf16_t*)GNb + (size_t)(c) * 16384 + (size_t)sl * 2048 + lane * 8; \
        _Pragma("unroll") for (int ks = 0; ks < 4; ++ks) { u32x4 w; w.x = cvt_pk(S[2 * ks][0], S[2 * ks][1]); w.y = cvt_pk(S[2 * ks][2], S[2 * ks][3]); \
            w.z = cvt_pk(S[2 * ks + 1][0], S[2 * ks + 1][1]); w.w = cvt_pk(S[2 * ks + 1][2], S[2 * ks + 1][3]); Sb[ks] = __builtin_bit_cast(bf16x8, w); } \
        const LAS unsigned char* slot = lds + ((c) & 3) * 32768 + lane * 16; \
        bf16x8 fa[2][2][4]; \
        _Pragma("unroll") for (int ks = 0; ks < 4; ++ks) { fa[0][0][ks] = *(const LAS bf16x8*)(slot + (0 * 4 + ks) * 1024); fa[0][1][ks] = *(const LAS bf16x8*)(slot + (1 * 4 + ks) * 1024); } \
        _Pragma("unroll") for (int mt = 0; mt < 8; ++mt) { const unsigned w0 = nn[mt >> 1][(mt & 1) * 2], w1 = nn[mt >> 1][(mt & 1) * 2 + 1]; \
            S[mt] = S[mt] * gl + (f32x4){bflo(w0), bfhi(w0), bflo(w1), bfhi(w1)}; } \
        _Pragma("unroll") for (int ks = 0; ks < 4; ++ks) *(u32x4*)(scp + ks * 512) = __builtin_bit_cast(u32x4, Sb[ks]);     \
        RELOAD; \
        _Pragma("unroll") for (int pr = 0; pr < 4; ++pr) { \
            if (pr < 3) { _Pragma("unroll") for (int ks = 0; ks < 4; ++ks) { fa[(pr + 1) & 1][0][ks] = *(const LAS bf16x8*)(slot + ((2 * pr + 2) * 4 + ks) * 1024); fa[(pr + 1) & 1][1][ks] = *(const LAS bf16x8*)(slot + ((2 * pr + 3) * 4 + ks) * 1024); } } \
            _Pragma("unroll") for (int ks = 0; ks < 4; ++ks) { S[2 * pr] = mfma16(fa[pr & 1][0][ks], Sb[ks], S[2 * pr]); S[2 * pr + 1] = mfma16(fa[pr & 1][1][ks], Sb[ks], S[2 * pr + 1]); } } \
        } while (0)
    if (loader) { SCAN_DMA(0); SCAN_DMA(1); SCAN_DMA(2); asm volatile("s_waitcnt vmcnt(0)" ::: "memory"); }
    f32x4 S[8];
#pragma unroll
    for (int mt = 0; mt < 8; ++mt) S[mt] = (f32x4){0.f, 0.f, 0.f, 0.f};
    const float glr0 = glast[lane], glr1 = glast[64 + lane];
    u32x4 nnA[4], nnB[4];
    if (wid < 2) { SCAN_LOADN(nnA, 0); SCAN_LOADN(nnB, 1); }
    asm volatile("s_waitcnt lgkmcnt(0)" ::: "memory"); __builtin_amdgcn_s_barrier(); asm volatile("" ::: "memory");
#pragma unroll 1
    for (int c = 0; c < 128; c += 2) {
        if (loader) { if (c + 3 < 128) { SCAN_DMA(c + 3); asm volatile("s_waitcnt vmcnt(16)" ::: "memory"); } else asm volatile("s_waitcnt vmcnt(0)" ::: "memory"); }
        else if (wid < 2) { SCAN_STEP(c, nnA, if (c + 2 < 128) SCAN_LOADN(nnA, c + 2)); }
        asm volatile("s_waitcnt lgkmcnt(0)" ::: "memory"); __builtin_amdgcn_s_barrier(); asm volatile("" ::: "memory");
        if (loader) { if (c + 4 < 128) { SCAN_DMA(c + 4); asm volatile("s_waitcnt vmcnt(16)" ::: "memory"); } else asm volatile("s_waitcnt vmcnt(0)" ::: "memory"); }
        else if (wid < 2) { SCAN_STEP(c + 1, nnB, if (c + 3 < 128) SCAN_LOADN(nnB, c + 3)); }
        asm volatile("s_waitcnt lgkmcnt(0)" ::: "memory"); __builtin_amdgcn_s_barrier(); asm volatile("" ::: "memory");
    }
#undef SCAN_DMA
#undef SCAN_LOADN
#undef SCAN_STEP
    __syncthreads();
    if (wid < 2) {
        float* go = p.out + O_GP + (size_t)bh * 16384;
#pragma unroll
        for (int mt = 0; mt < 8; ++mt)
#pragma unroll
            for (int e = 0; e < 4; ++e) go[(16 * mt + 4 * fq + e) * 128 + sl * 16 + fr] = S[mt][e];
    }
}

__device__ __forceinline__ void gdn_gate_unit(const Params& p, int unit, int lane) {
    const int fr = lane & 15, fq = lane >> 4, bh = unit >> 7, n = unit & 127, b = bh >> 2, h = bh & 3, tok0 = b * SEQ + n * 64;
    const bf16_t* GO = (const bf16_t*)(p.ws + WS_GO) + (size_t)unit * 8192;
    bf16_t* PB = (bf16_t*)(p.ws + WS_H);
    {
        bf16_t* GOw = (bf16_t*)(p.ws + WS_GO) + (size_t)unit * 8192;
        const bf16_t* GQ = (const bf16_t*)(p.ws + WS_GQ) + (size_t)unit * 8192; const bf16_t* SC = (const bf16_t*)(p.ws + WS_GN) + (size_t)unit * 16384;
        bf16x8 qa[4][4];
#pragma unroll
        for (int mt = 0; mt < 4; ++mt)
#pragma unroll
            for (int ks = 0; ks < 4; ++ks) qa[mt][ks] = *(const bf16x8*)(GQ + ((mt * 4 + ks) * 64 + lane) * 8);
#pragma unroll 2
        for (int nt = 0; nt < 8; ++nt) {
            bf16x8 sb[4];
#pragma unroll
            for (int ks = 0; ks < 4; ++ks) sb[ks] = *(const bf16x8*)(SC + nt * 2048 + (ks * 64 + lane) * 8);
            const u32x4 o0 = *(const u32x4*)(GOw + (nt * 64 + lane) * 16), o1 = *(const u32x4*)(GOw + (nt * 64 + lane) * 16 + 8);
            f32x4 acc[4];
            acc[0] = (f32x4){bflo(o0.x), bfhi(o0.x), bflo(o0.y), bfhi(o0.y)}; acc[1] = (f32x4){bflo(o0.z), bfhi(o0.z), bflo(o0.w), bfhi(o0.w)};
            acc[2] = (f32x4){bflo(o1.x), bfhi(o1.x), bflo(o1.y), bfhi(o1.y)}; acc[3] = (f32x4){bflo(o1.z), bfhi(o1.z), bflo(o1.w), bfhi(o1.w)};
#pragma unroll
            for (int ks = 0; ks < 4; ++ks)
#pragma unroll
                for (int mt = 0; mt < 4; ++mt) acc[mt] = mfma16(qa[mt][ks], sb[ks], acc[mt]);
            u32x4 w0, w1;
            w0.x = cvt_pk(acc[0][0], acc[0][1]); w0.y = cvt_pk(acc[0][2], acc[0][3]); w0.z = cvt_pk(acc[1][0], acc[1][1]); w0.w = cvt_pk(acc[1][2], acc[1][3]);
            w1.x = cvt_pk(acc[2][0], acc[2][1]); w1.y = cvt_pk(acc[2][2], acc[2][3]); w1.z = cvt_pk(acc[3][0], acc[3][1]); w1.w = cvt_pk(acc[3][2], acc[3][3]);
            *(u32x4*)(GOw + (nt * 64 + lane) * 16) = w0; *(u32x4*)(GOw + (nt * 64 + lane) * 16 + 8) = w1;
        }
        asm volatile("s_waitcnt vmcnt(0)" ::: "memory");
    }
    float ssq[16];
#pragma unroll
    for (int k = 0; k < 16; ++k) ssq[k] = 0.f;
#pragma unroll 1
    for (int nt = 0; nt < 8; ++nt) {
        const u32x4 a0 = *(const u32x4*)(GO + (nt * 64 + lane) * 16), a1 = *(const u32x4*)(GO + (nt * 64 + lane) * 16 + 8);
#pragma unroll
        for (int k = 0; k < 4; ++k) { const float l0 = bflo(a0[k]), h0 = bfhi(a0[k]), l1 = bflo(a1[k]), h1 = bfhi(a1[k]);
            ssq[2 * k] += l0 * l0; ssq[2 * k + 1] += h0 * h0; ssq[8 + 2 * k] += l1 * l1; ssq[8 + 2 * k + 1] += h1 * h1; }
    }
#pragma unroll
    for (int k = 0; k < 16; ++k) { float s = ssq[k]; s += __shfl_xor(s, 1); s += __shfl_xor(s, 2); s += __shfl_xor(s, 4); s += __shfl_xor(s, 8); ssq[k] = rsqrtf(s * (1.0f / 128.0f) + EPS); }
    const float* gn = p.in[15];
#pragma unroll 1
    for (int nt = 0; nt < 8; ++nt) {
        const int dv = 16 * nt + fr; const float g = gn[dv];
        const u32x4 a0 = *(const u32x4*)(GO + (nt * 64 + lane) * 16), a1 = *(const u32x4*)(GO + (nt * 64 + lane) * 16 + 8);
        const bf16_t* gzp = PB + (size_t)(tok0 + 4 * fq) * PW + 2304 + h * 128 + dv; bf16_t* mp = PB + (size_t)(tok0 + 4 * fq) * PW + 512 + h * 128 + dv;
#pragma unroll
        for (int k = 0; k < 16; ++k) {
            const unsigned w = (k < 8) ? a0[(k >> 1) & 3] : a1[(k >> 1) & 3]; const float o = (k & 1) ? bfhi(w) : bflo(w);
            const int to = 16 * (k >> 2) + (k & 3);
            const float gz = bf2f(gzp[(size_t)to * PW]);
            mp[(size_t)to * PW] = f2bf(o * ssq[k] * g * silu(gz));
        }
    }
}

__device__ __forceinline__ void attn_unit(const Params& p, LAS unsigned char* lds, int unit) {
    const int tid = threadIdx.x, lane = tid & 63, wid = tid >> 6, fr = lane & 15, fq = lane >> 4;
    const int b = unit >> 7, blk = (unit >> 1) & 63, kvh = unit & 1;
    LAS bf16_t* Ks = (LAS bf16_t*)lds; LAS bf16_t* Vt = (LAS bf16_t*)(lds + 36864);
    bf16_t* PB = (bf16_t*)(p.ws + WS_H);
    __syncthreads();
#pragma unroll
    for (int i = 0; i < 4; ++i) {
        const int q = tid + 512 * i, row = q >> 3, ch = q & 7, tp = blk * 128 - 128 + row;
        u32x4 kv = (u32x4){0u, 0u, 0u, 0u}, vv = (u32x4){0u, 0u, 0u, 0u};
        if (tp >= 0) { const bf16_t* base = PB + (size_t)(b * SEQ + tp) * PW; kv = *(const u32x4*)(base + 512 + kvh * 64 + ch * 8); vv = *(const u32x4*)(base + 640 + kvh * 64 + ch * 8); }
        *(LAS u32x4*)(Ks + row * 72 + ch * 8) = kv;
#pragma unroll
        for (int e = 0; e < 4; ++e) { const unsigned w = vv[e]; Vt[(ch * 8 + 2 * e) * 264 + row] = (bf16_t)(w & 0xffffu); Vt[(ch * 8 + 2 * e + 1) * 264 + row] = (bf16_t)(w >> 16); }
    }
    __syncthreads();
    const int qtok = b * SEQ + blk * 128 + 16 * wid + fr;
#pragma unroll 1
    for (int g = 0; g < 4; ++g) {
        const int h = kvh * 4 + g; const float slope = exp2f(-(float)(h + 1)), sink = p.in[11][h];
        bf16x8 qf[2];
#pragma unroll
        for (int ks = 0; ks < 2; ++ks) qf[ks] = *(const bf16x8*)(PB + (size_t)qtok * PW + h * 64 + ks * 32 + 8 * fq);
        f32x4 s[10]; float mx = sink;
#pragma unroll
        for (int j = 0; j < 10; ++j) {
            const int ct = (wid + j) < 15 ? (wid + j) : 15;
            f32x4 acc = (f32x4){0.f, 0.f, 0.f, 0.f};
#pragma unroll
            for (int ks = 0; ks < 2; ++ks) acc = mfma16(*(const LAS bf16x8*)(Ks + (16 * ct + fr) * 72 + ks * 32 + 8 * fq), qf[ks], acc);
#pragma unroll
            for (int e = 0; e < 4; ++e) {
                const int c = 16 * (wid + j) + 4 * fq + e, dist = 16 * wid + fr - c + 128;
                const bool ok = (wid + j <= 15) && dist >= 0 && dist <= 128 && (blk * 128 + c - 128 >= 0);
                const float v = ok ? acc[e] * 0.125f - slope * (float)dist : -INFINITY;
                acc[e] = v; mx = fmaxf(mx, v);
            }
            s[j] = acc;
            asm volatile("" ::: "memory");
        }
        mx = fmaxf(mx, __shfl_xor(mx, 16)); mx = fmaxf(mx, __shfl_xor(mx, 32));
        float sum = 0.f;
#pragma unroll
        for (int j = 0; j < 10; ++j)
#pragma unroll
            for (int e = 0; e < 4; ++e) { const float pv = __expf(s[j][e] - mx); s[j][e] = pv; sum += pv; }
        sum += __shfl_xor(sum, 16); sum += __shfl_xor(sum, 32);
        sum += __expf(sink - mx);
        const float inv = 1.0f / sum;
        bf16x8 pb[5];
#pragma unroll
        for (int kk = 0; kk < 5; ++kk) { u32x4 w; w.x = cvt_pk(s[2 * kk][0] * inv, s[2 * kk][1] * inv); w.y = cvt_pk(s[2 * kk][2] * inv, s[2 * kk][3] * inv);
            w.z = cvt_pk(s[2 * kk + 1][0] * inv, s[2 * kk + 1][1] * inv); w.w = cvt_pk(s[2 * kk + 1][2] * inv, s[2 * kk + 1][3] * inv); pb[kk] = __builtin_bit_cast(bf16x8, w); }
#pragma unroll
        for (int dt = 0; dt < 4; ++dt) {
            f32x4 acc = (f32x4){0.f, 0.f, 0.f, 0.f};
#pragma unroll
            for (int kk = 0; kk < 5; ++kk) {
                const int c0 = (wid + 2 * kk) < 15 ? (wid + 2 * kk) : 15, c1 = (wid + 2 * kk + 1) < 15 ? (wid + 2 * kk + 1) : 15;
                const u32x2 lo = *(const LAS u32x2*)(Vt + (16 * dt + fr) * 264 + 16 * c0 + 4 * fq), hi = *(const LAS u32x2*)(Vt + (16 * dt + fr) * 264 + 16 * c1 + 4 * fq);
                const u32x4 a = (u32x4){lo.x, lo.y, hi.x, hi.y};
                acc = mfma16(__builtin_bit_cast(bf16x8, a), pb[kk], acc);
            }
            u32x2 w; w.x = cvt_pk(acc[0], acc[1]); w.y = cvt_pk(acc[2], acc[3]);
            *(u32x2*)(PB + (size_t)qtok * PW + h * 64 + 16 * dt + 4 * fq) = w;
            asm volatile("" ::: "memory");
        }
    }
}

__device__ __forceinline__ void sattn_unit(const Params& p, int s, int h, int lane) {
    const int kvh = h >> 2; const bool wr = (h & 3) == 0;
    bf16_t* PB = (bf16_t*)(p.ws + WS_H) + (size_t)(MPR + s) * PW;
    const float* ck = p.in[2] + (size_t)s * 128 * 128 + kvh * 64 + lane; const float* cv = p.in[3] + (size_t)s * 128 * 128 + kvh * 64 + lane;
    float* nk = p.out + O_KS + (size_t)s * 128 * 128 + kvh * 64 + lane; float* nv = p.out + O_VS + (size_t)s * 128 * 128 + kvh * 64 + lane;
    const float q = bf2f(PB[h * 64 + lane]) * 0.125f, slope = exp2f(-(float)(h + 1)), sink = p.in[11][h];
    const float knew = bf2f(PB[512 + kvh * 64 + lane]), vnew = bf2f(PB[640 + kvh * 64 + lane]);
    float sc[3];
#pragma unroll
    for (int t = 0; t < 2; ++t) {
#pragma unroll 8
        for (int jj = 0; jj < 64; ++jj) {
            const int j = t * 64 + jj; const float kval = ck[(size_t)j * 128];
            if (wr && j >= 1) nk[(size_t)(j - 1) * 128] = kval;
            const float d = wave_sum(q * kval) - slope * (float)(128 - j); if (lane == jj) sc[t] = d;
        }
    }
    if (wr) nk[(size_t)127 * 128] = knew;
    sc[2] = wave_sum(q * knew);
    const float mx = fmaxf(fmaxf(wave_max(fmaxf(sc[0], sc[1])), sc[2]), sink);
    const float p0 = __expf(sc[0] - mx), p1 = __expf(sc[1] - mx), p2 = __expf(sc[2] - mx);
    const float inv = 1.0f / (wave_sum(p0 + p1) + p2 + __expf(sink - mx));
    float o = p2 * vnew;
#pragma unroll 8
    for (int jj = 0; jj < 64; ++jj) { const float vval = cv[(size_t)jj * 128]; if (wr && jj >= 1) nv[(size_t)(jj - 1) * 128] = vval; o += __shfl(p0, jj) * vval; }
#pragma unroll 8
    for (int jj = 0; jj < 64; ++jj) { const float vval = cv[(size_t)(64 + jj) * 128]; if (wr) nv[(size_t)(63 + jj) * 128] = vval; o += __shfl(p1, jj) * vval; }
    if (wr) nv[(size_t)127 * 128] = vnew;
    asm volatile("" ::: "memory");
    PB[h * 64 + lane] = f2bf(o * inv);
}

__device__ __forceinline__ void sgdn_unit(const Params& p, LAS unsigned char* lds, int s) {
    const int tid = threadIdx.x, wid = tid >> 6, h = tid >> 7, dv = tid & 127;
    LAS float* qs = (LAS float*)lds; LAS float* ks = qs + 512; LAS float* red = ks + 512;
    bf16_t* PB = (bf16_t*)(p.ws + WS_H) + (size_t)(MPR + s) * PW; const float* GBA = (const float*)(p.ws + WS_GBA) + (size_t)(MPR + s) * 8;
    const float* cw = p.in[12]; const float* hc = p.in[4] + (size_t)s * 3 * CONVC; float* nc = p.out + O_CS + (size_t)s * 3 * CONVC;
    __syncthreads();
    float val[3];
#pragma unroll
    for (int i = 0; i < 3; ++i) {
        const int c = i * 512 + tid; const float x3 = bf2f(PB[768 + c]), h0 = hc[c], h1 = hc[CONVC + c], h2 = hc[2 * CONVC + c];
        val[i] = silu(cw[c] * h0 + cw[CONVC + c] * h1 + cw[2 * CONVC + c] * h2 + cw[3 * CONVC + c] * x3);
        nc[c] = h1; nc[CONVC + c] = h2; nc[2 * CONVC + c] = x3;
    }
    const float sq = wave_sum(val[0] * val[0]), sk = wave_sum(val[1] * val[1]);
    if ((tid & 63) == 0) { red[wid] = sq; red[8 + wid] = sk; }
    __syncthreads();
    const float ssq = red[2 * h] + red[2 * h + 1], ssk = red[8 + 2 * h] + red[8 + 2 * h + 1];
    qs[tid] = val[0] * rsqrtf(ssq + EPS) * 0.08838834764831845f; ks[tid] = val[1] * rsqrtf(ssk + EPS);
    __syncthreads();
    const float beta = 1.0f / (1.0f + __expf(-GBA[h]));
    const float x = GBA[4 + h] + p.in[14][h]; const float sp = x > 20.f ? x : log1pf(__expf(x));
    const float eg = __expf(-__expf(p.in[13][h]) * sp);
    const float* S0 = p.in[5] + ((size_t)(s * 4 + h) * 128) * 128 + dv; float* S1 = p.out + O_GS + ((size_t)(s * 4 + h) * 128) * 128 + dv;
    float kS = 0.f;
#pragma unroll 1
    for (int hf = 0; hf < 4; ++hf) { float sv[32];
#pragma unroll
        for (int dk = 0; dk < 32; ++dk) sv[dk] = S0[(size_t)(hf * 32 + dk) * 128];
#pragma unroll
        for (int dk = 0; dk < 32; ++dk) kS += ks[h * 128 + hf * 32 + dk] * sv[dk]; }
    const float delta = beta * (val[2] - eg * kS);
    float o = 0.f;
#pragma unroll 1
    for (int hf = 0; hf < 4; ++hf) { float sv[32];
#pragma unroll
        for (int dk = 0; dk < 32; ++dk) sv[dk] = S0[(size_t)(hf * 32 + dk) * 128];
#pragma unroll
        for (int dk = 0; dk < 32; ++dk) { const float nvv = eg * sv[dk] + ks[h * 128 + hf * 32 + dk] * delta; S1[(size_t)(hf * 32 + dk) * 128] = nvv; o += qs[h * 128 + hf * 32 + dk] * nvv; } }
    const float so = wave_sum(o * o);
    if ((tid & 63) == 0) red[16 + wid] = so;
    __syncthreads();
    const float tot = red[16 + 2 * h] + red[16 + 2 * h + 1];
    const float gz = bf2f(PB[2304 + tid]);
    PB[512 + tid] = f2bf(o * rsqrtf(tot * (1.0f / 128.0f) + EPS) * p.in[15][dv] * silu(gz));
}

#define XB_TMO      128
#define XB_XCNT(j)  (256  + 64 * (j))
#define XB_XSUB(j)  (1280 + 64 * (j))
#define XB_XGEN(j)  (2304 + 64 * (j))
#define XB_TOP      3328
#define XB_TOPGEN   3392
#define XCD_BAR_WORDS 3456
#define XB_SPIN_CAP (1u << 18)

__device__ __forceinline__ unsigned xb_ld(unsigned* p)              { return __hip_atomic_load(p, __ATOMIC_RELAXED, __HIP_MEMORY_SCOPE_AGENT); }
__device__ __forceinline__ unsigned xb_add(unsigned* p, unsigned v) { return __hip_atomic_fetch_add(p, v, __ATOMIC_RELAXED, __HIP_MEMORY_SCOPE_AGENT); }
__device__ __forceinline__ unsigned xb_xcc_id() { return (unsigned)__builtin_amdgcn_s_getreg((3 << 11) | 20) & 0xFu; }
#define XB_SPIN(cond, bar) do { unsigned _sp = 0; while (cond) { __builtin_amdgcn_s_sleep(1); \
    if ((++_sp & 255u) == 0u) { if (xb_ld(&(bar)[XB_TMO])) break; if (_sp > XB_SPIN_CAP) { atomicAdd(&(bar)[XB_TMO], 1u); break; } } } } while (0)

struct XcdBarrier {
    unsigned* bar; unsigned x;
    volatile LAS unsigned* st;
};

__device__ __forceinline__ XcdBarrier xcd_barrier_post(unsigned* bar, volatile LAS unsigned* st) {
    XcdBarrier b; b.bar = bar; b.x = xb_xcc_id(); b.st = st;
    if (threadIdx.x == 0) (void)xb_add(&bar[XB_XCNT(b.x)], 1u);
    return b;
}
__device__ __forceinline__ void xcd_barrier_complete(unsigned* bar, unsigned x, unsigned& nloc, unsigned& nx) {
    const unsigned G = gridDim.x * gridDim.y * gridDim.z;
    unsigned sum, cnt, mine, sp = 0u;
    for (;;) {
        sum = 0u; cnt = 0u; mine = 0u;
#pragma unroll
        for (unsigned j = 0; j < 16; ++j) { const unsigned c = xb_ld(&bar[XB_XCNT(j)]); sum += c; cnt += (c > 0u) ? 1u : 0u; mine = (j == x) ? c : mine; }
        if (sum == G) break;
        __builtin_amdgcn_s_sleep(1);
        if ((++sp & 255u) == 0u) { if (xb_ld(&bar[XB_TMO])) break; if (sp > XB_SPIN_CAP) { atomicAdd(&bar[XB_TMO], 1u); break; } }
    }
    nloc = mine > 0u ? mine : 1u; nx = cnt > 0u ? cnt : 1u;
}

__device__ __forceinline__ void xcd_barrier(const XcdBarrier& b) {
    asm volatile("s_waitcnt vmcnt(0)" ::: "memory");
    __syncthreads();
    if (threadIdx.x == 0) {
        unsigned* bar = b.bar;
        __builtin_amdgcn_s_waitcnt(0);
        unsigned nloc = b.st[0], nx = b.st[1];
        if (nloc == 0u) { xcd_barrier_complete(bar, b.x, nloc, nx); b.st[0] = nloc; b.st[1] = nx; }
        const unsigned old = xb_add(&bar[XB_XSUB(b.x)], 1u);
        const unsigned gen = old / nloc;
        if (old + 1u == (gen + 1u) * nloc) {
            __builtin_amdgcn_fence(__ATOMIC_RELEASE, "agent");
            asm volatile("s_waitcnt vmcnt(0)" ::: "memory");
            const unsigned og = xb_add(&bar[XB_TOP], 1u);
            const unsigned tg = og / nx;
            if (og + 1u == (tg + 1u) * nx) xb_add(&bar[XB_TOPGEN], 1u);
            else XB_SPIN(xb_ld(&bar[XB_TOPGEN]) == tg, bar);
            __builtin_amdgcn_fence(__ATOMIC_ACQUIRE, "agent");
            xb_add(&bar[XB_XGEN(b.x)], 1u);
            asm volatile("s_waitcnt vmcnt(0)" ::: "memory");
        } else {
            XB_SPIN(xb_ld(&bar[XB_XGEN(b.x)]) == gen, bar);
            __builtin_amdgcn_fence(__ATOMIC_ACQUIRE, "agent");
            asm volatile("s_waitcnt vmcnt(0)" ::: "memory");
        }
    }
    __syncthreads();
}

__global__ void __launch_bounds__(512, 2) fwd_kernel(Params p, int ph_lo, int ph_hi) {
    extern __shared__ __attribute__((aligned(16))) unsigned char lds_raw[];
    LAS unsigned char* lds = (LAS unsigned char*)lds_raw;
    cg::grid_group grid = cg::this_grid();
    if (ph_lo < 0) grid.sync();
    volatile LAS unsigned* bst = (volatile LAS unsigned*)(lds + LDS_PHASE_BYTES);
    if (threadIdx.x < 2) bst[threadIdx.x] = 0u;
    __syncthreads();
    XcdBarrier xbar; xbar.bar = (unsigned*)(p.ws + WS_CTL + CTL_BAR); xbar.x = 0; xbar.st = bst;
    if (ph_hi - ph_lo > 1) xbar = xcd_barrier_post((unsigned*)(p.ws + WS_CTL + CTL_BAR), bst);
    const int tid = threadIdx.x, lane = tid & 63, wid = tid >> 6, G = gridDim.x, bx = blockIdx.x;
    unsigned char* ws = p.ws;
    bf16_t* XN = (bf16_t*)(ws + WS_XN); bf16_t* XN2 = (bf16_t*)(ws + WS_XN2); bf16_t* HB = (bf16_t*)(ws + WS_H);
    float* SS1 = (float*)(ws + WS_SSP1); float* SS2 = (float*)(ws + WS_SSP2);
    float* Y = p.out; float* X2 = (float*)(ws + WS_GM); float* X3 = (float*)(ws + WS_XN);
#ifndef PHMASK
#define PHMASK 0x7ff
#endif
#define IN(k) (((PHMASK >> (k)) & 1) && ph_lo <= (k) && (k) < ph_hi)
#define SEAM(k) do { if (IN(k) && IN((k) + 1)) { xcd_barrier(xbar); }     } while (0)

    if (IN(0)) p0_prologue(p, lds, bx, G);
    SEAM(0);
    if (IN(1)) {
        if (bx < 176) sk_ffn_in<false>(XN, (const bf16_t*)(ws + WS_W1IN), HB, bx, wid, lane & 15, lane >> 4);
        pg8::Gemm g{XN, (const bf16_t*)(ws + WS_W1IN), MPR, 2 * DFF, DM, DM}; pg8::StaticOrder S; S.init(MPR, 2 * DFF, G, bx);
        EpiSwiglu E{HB, nullptr}; pg8::gemm_phase<EpiSwiglu, pg8::StaticOrder>(lds, g, S, E, nullptr);
    }
    SEAM(1);
    if (IN(2)) {
        if (bx < 64) sk_ffn_out<false>(HB, (const bf16_t*)(ws + WS_W1OUT), p.in[1], nullptr, XN + (size_t)MPR * DM, bx, wid, lane & 15, lane >> 4);
        pg8::Gemm g{HB, (const bf16_t*)(ws + WS_W1OUT), MPR, DM, DFF, DFF}; pg8::StaticOrder S; S.init(MPR, DM, G, bx);
        EpiResid<false, false, true, true, true> E{p.in[0], p.in[1], nullptr, XN, SS1}; pg8::gemm_phase<EpiResid<false, false, true, true, true>, pg8::StaticOrder>(lds, g, S, E, nullptr);
    }
    SEAM(2);
    if (IN(3)) {
        if (bx < 89) sk_inproj(XN, (const bf16_t*)(ws + WS_WINMIX), HB, (float*)(ws + WS_GBA), bx, wid, lane & 15, lane >> 4);
        pg8::Gemm g{XN, (const bf16_t*)(ws + WS_WINMIX), MPR, NINP, DM, DM}; pg8::StaticOrder S; S.init(MPR, NINP, G, bx);
        EpiInproj E{HB, (float*)(ws + WS_GBA), SS1}; pg8::gemm_phase<EpiInproj, pg8::StaticOrder>(lds, g, S, E, nullptr);
    }
    SEAM(3);
    if (IN(4)) {
        for (int u = bx; u < 2048; u += G) gdn_prep_unit(p, lds, u);
    }
    SEAM(4);
    if (IN(5)) {
        if (bx < NSCAN) gdn_scan(p, lds, bx);
        else {
            const int ab = bx - NSCAN, NAB = G - NSCAN;
            int it = ab;
#pragma unroll 1
            for (; it < 512; it += NAB) attn_unit(p, lds, it);
#pragma unroll 1
            for (; it < 640; it += NAB) {
                sattn_unit(p, it - 512, wid, lane);
                sgdn_unit(p, lds, it - 512); }
            const bf16_t* PB = HB;
            for (int idx = ab * 512 + tid; idx < 149504; idx += NAB * 512) {
                if (idx < 131072) { const int w = idx >> 16, r = idx & 65535, b = r >> 14, j = (r >> 7) & 127, c = r & 127;
                    p.out[(w ? O_VP : O_KP) + r] = bf2f(PB[(size_t)(b * SEQ + SEQ - 128 + j) * PW + 512 + w * 128 + c]);
                } else { const int r = idx - 131072, b = r / (3 * CONVC), q = r % (3 * CONVC), rr = q / CONVC, c = q % CONVC;
                    p.out[O_CP + r] = bf2f(PB[(size_t)(b * SEQ + SEQ - 3 + rr) * PW + 768 + c]); }
            }
        }
    }
    SEAM(5);
    if (IN(6)) {
        for (int u = bx * 8 + wid; u < 2048; u += G * 8) gdn_gate_unit(p, u, lane);
    }
    SEAM(6);
#ifdef DBG_DUMP
    if (ph_lo == 11) {
        const float* src = (const float*)(ws + DBG_SRC);
        for (size_t i = (size_t)bx * 512 + tid; i < (size_t)MREAL * DM; i += (size_t)G * 512) Y[i] = (i < (size_t)MREAL * 8) ? ((const float*)(ws + WS_GBA))[i] : 0.f;
    }
#endif
    if (IN(7)) {
        if (bx < 32) sk_outproj(HB, (const bf16_t*)(ws + WS_WOUTMIX), XN, X2, XN2, bx, wid, lane & 15, lane >> 4);
        pg8::Gemm g{HB, (const bf16_t*)(ws + WS_WOUTMIX), MPR, DM, DM, PW}; pg8::StaticOrder S; S.init(MPR, DM, G, bx);
        EpiResid<true, true, true, true, false> E{XN, XN + (size_t)MPR * DM, X2, XN2, SS2}; pg8::gemm_phase<EpiResid<true, true, true, true, false>, pg8::StaticOrder>(lds, g, S, E, nullptr);
    }
    SEAM(7);
    if (IN(8)) {
        if (bx < 176) sk_ffn_in<true>(XN2, (const bf16_t*)(ws + WS_W2IN), HB, bx, wid, lane & 15, lane >> 4);
        pg8::Gemm g{XN2, (const bf16_t*)(ws + WS_W2IN), MPR, 2 * DFF, DM, DM}; pg8::StaticOrder S; S.init(MPR, 2 * DFF, G, bx);
        EpiSwiglu E{HB, SS2}; pg8::gemm_phase<EpiSwiglu, pg8::StaticOrder>(lds, g, S, E, nullptr);
    }
    SEAM(8);
    if (IN(9)) {
        if (bx < 64) sk_ffn_out<true>(HB, (const bf16_t*)(ws + WS_W2OUT), X2 + (size_t)MPR * DM, X3 + (size_t)MPR * DM, nullptr, bx, wid, lane & 15, lane >> 4);
        pg8::Gemm g{HB, (const bf16_t*)(ws + WS_W2OUT), MPR, DM, DFF, DFF}; pg8::StaticOrder S; S.init(MPR, DM, G, bx);
        EpiResid<false, true, false, false, true> E{X2, X2 + (size_t)MPR * DM, X3, nullptr, nullptr}; pg8::gemm_phase<EpiResid<false, true, false, false, true>, pg8::StaticOrder>(lds, g, S, E, nullptr);
    }
    SEAM(9);
    if (IN(10)) {
        const float* gf = p.in[20]; f32x4 gv[4];
#pragma unroll
        for (int j = 0; j < 4; ++j) gv[j] = *((const f32x4*)gf + lane + 64 * j);
        for (int m = bx * 8 + wid; m < MREAL; m += G * 8) {
            const f32x4* xr = (const f32x4*)(X3 + (size_t)m * DM) + lane; f32x4* yr = (f32x4*)(Y + (size_t)m * DM) + lane; f32x4 v[4]; float s = 0.f;
#pragma unroll
            for (int j = 0; j < 4; ++j) { v[j] = xr[64 * j]; s += (v[j][0] * v[j][0] + v[j][1] * v[j][1]) + (v[j][2] * v[j][2] + v[j][3] * v[j][3]); }
            const float rstd = rsqrtf(wave_sum(s) * (1.0f / DM) + EPS);
#pragma unroll
            for (int j = 0; j < 4; ++j) yr[64 * j] = v[j] * rstd * gv[j];
        }
    }
#undef IN
#undef SEAM
}
}

#ifndef MK_N_LAUNCHES
#define MK_N_LAUNCHES 1
#endif
extern "C" void kernel_launch(void* const* d_in, const int* in_sizes, int n_in, void* d_out, int out_size, void* d_ws, size_t ws_size, hipStream_t stream) {
    static int grid = 0;
    if (grid == 0) {
        if (n_in != 21 || ws_size < mk::WS_END || out_size != 47269888) { fprintf(stderr, "kernel_launch: unexpected shapes (n_in %d, ws %zu, out %d)\n", n_in, ws_size, out_size); grid = -1; return; }
        int dev = 0, cus = 0, per_cu = 0;
        (void)hipGetDevice(&dev); (void)hipDeviceGetAttribute(&cus, hipDeviceAttributeMultiprocessorCount, dev);
        if (hipFuncSetAttribute((const void*)mk::fwd_kernel, hipFuncAttributeMaxDynamicSharedMemorySize, mk::LDS_BYTES) != hipSuccess) { fprintf(stderr, "kernel_launch: hipFuncSetAttribute failed\n"); grid = -1; return; }
        if (hipOccupancyMaxActiveBlocksPerMultiprocessor(&per_cu, (const void*)mk::fwd_kernel, 512, mk::LDS_BYTES) != hipSuccess || per_cu < 1) { fprintf(stderr, "kernel_launch: occupancy query failed (%d)\n", per_cu); per_cu = 1; }
        (void)hipGetLastError();
        grid = cus * per_cu;
        if (grid <= mk::NSCAN) { fprintf(stderr, "kernel_launch: grid %d too small\n", grid); grid = -1; return; }
    }
    if (grid < 0) return;
    (void)hipMemsetAsync((char*)d_ws + mk::WS_CTL + mk::CTL_BAR, 0, mk::CTL_BAR_BYTES, stream);
    mk::Params p{};
    for (int i = 0; i < 21; ++i) p.in[i] = (const float*)d_in[i];
    p.out = (float*)d_out; p.ws = (unsigned char*)d_ws;
#if MK_N_LAUNCHES == 1
    int lo = 0, hi = 11; void* args[] = {&p, &lo, &hi};
    hipError_t e = hipLaunchCooperativeKernel((const void*)mk::fwd_kernel, dim3(grid), dim3(512), args, mk::LDS_BYTES, stream);
    if (e != hipSuccess) fprintf(stderr, "kernel_launch: cooperative launch failed: %s (grid %d)\n", hipGetErrorString(e), grid);
#else
#ifndef MK_LAST
#define MK_LAST 11
#ifndef MK_DOUBLE
#define MK_DOUBLE 0x0
#endif
#define DBG_C0 512
#define DBG_C1 1024
#endif
    for (int ph = 0; ph < MK_LAST; ++ph) { const int reps = ((MK_DOUBLE >> ph) & 1) ? 2 : 1; for (int r = 0; r < reps; ++r) hipLaunchKernelGGL(mk::fwd_kernel, dim3(grid), dim3(512), mk::LDS_BYTES, stream, p, ph, ph + 1); }
#ifdef DBG_DUMP
    hipLaunchKernelGGL(mk::fwd_kernel, dim3(grid), dim3(512), mk::LDS_BYTES, stream, p, 11, 12);
#endif
#endif
}
```

```cpp
#include <hip/hip_runtime.h>
#include <hip/hip_cooperative_groups.h>
#include <cstdio>
namespace cg = cooperative_groups;
namespace pg8 {
#define PG8_LAS __attribute__((address_space(3)))
typedef unsigned short bf16_t;
typedef short bf16x8 __attribute__((ext_vector_type(8)));
typedef float f32x4 __attribute__((ext_vector_type(4)));
typedef unsigned u32x4 __attribute__((ext_vector_type(4)));
constexpr int BM = 256, BK = 64, HALF = 128, HTB = HALF * BK * 2  , STAGE_BYTES = 8 * HTB, NXCD = 8, WGM = 8;

__host__ __device__ __forceinline__ int lds_byte(int r, int c) { const int st = (r >> 4) * 2 + (c >> 5), rr = r & 15, cc = c & 31, ob = rr * 64 + cc * 2; return st * 1024 + (ob ^ (((ob >> 9) & 1) << 5)); }
__host__ __device__ __forceinline__ void stage_rc(int b, int& R, int& C) { const int st = b / 1024, sb = b % 1024, swz = sb ^ (((sb >> 9) & 1) << 5); R = (st >> 1) * 16 + swz / 64; C = (st & 1) * 32 + (swz % 64) / 2; }
__host__ __device__ __forceinline__ int perm32(int rho) { const int n = rho >> 4, i = rho & 15; return 8 * (i >> 2) + 4 * n + (i & 3); }

struct Unit { int pm, pn; };
struct Gemm { const bf16_t* A; const bf16_t* Bt; int M, N, K, lda; };

struct StaticOrder {
    int nM, nN, nwg, G, c;
    __host__ __device__ void init(int M, int N, int G_, int c_) { nM = M / BM; nN = N / BM; nwg = nM * nN; G = G_; c = c_; }
    __host__ __device__ bool next(int i, Unit& u) const {
        const long L = (long)i * G + c; if (L >= nwg) return false;
        int wgid = (int)L; { const int q = nwg / NXCD, r = nwg % NXCD, xcd = wgid % NXCD, off = wgid / NXCD; wgid = (xcd < r ? xcd * (q + 1) : r * (q + 1) + (xcd - r) * q) + off; }
        const int nig = WGM * nN, gid = wgid / nig, fm = gid * WGM, gsz = (nM - fm) < WGM ? (nM - fm) : WGM;
        u.pm = fm + ((wgid % nig) % gsz); u.pn = (wgid % nig) / gsz; return true;
    }
    __device__ __forceinline__ void a_ready(const Unit&) const {}
    __device__ __forceinline__ void done(const Unit&) const {}
};
struct CountedOrder : StaticOrder {
    const unsigned* ready; unsigned need; unsigned* tmo;
    __device__ __forceinline__ void a_ready(const Unit& u) const {
        if (threadIdx.x < 64) {
            const unsigned long long t0 = __builtin_amdgcn_s_memrealtime(); unsigned polls = 0;
            while ((unsigned)__builtin_amdgcn_readfirstlane(__hip_atomic_load(ready + 64 * u.pm, __ATOMIC_RELAXED, __HIP_MEMORY_SCOPE_AGENT)) < need) {
                if ((++polls & 255u) == 0u && __builtin_amdgcn_readfirstlane(__hip_atomic_load(tmo, __ATOMIC_RELAXED, __HIP_MEMORY_SCOPE_AGENT)) != 0u) break;
                if (__builtin_amdgcn_s_memrealtime() - t0 > 2000000ull) {
                    if (threadIdx.x == 0) { unsigned expect = 0u; __hip_atomic_compare_exchange_strong(tmo + 1, &expect, 0x600u | (unsigned)(u.pm & 0xff), __ATOMIC_RELAXED, __ATOMIC_RELAXED, __HIP_MEMORY_SCOPE_AGENT); __hip_atomic_store(tmo, 1u, __ATOMIC_RELAXED, __HIP_MEMORY_SCOPE_AGENT); }
                    break; }
                __builtin_amdgcn_s_sleep(2); }
            __builtin_amdgcn_fence(__ATOMIC_ACQUIRE, "agent");
            asm volatile("s_waitcnt vmcnt(0)" ::: "memory");
        }
#if !defined(BROKEN_HOOK_NO_BARRIER)
        asm volatile("" ::: "memory"); __builtin_amdgcn_s_barrier(); asm volatile("" ::: "memory");
#endif
    }
};

__device__ __forceinline__ unsigned cvt_pk_bf16(float lo, float hi) { unsigned r; asm volatile("v_cvt_pk_bf16_f32 %0, %1, %2" : "=v"(r) : "v"(lo), "v"(hi)); return r; }
typedef float f32x2 __attribute__((ext_vector_type(2)));
__device__ __forceinline__ f32x2 gelu_pk(f32x2 v) {
    const f32x2 av = __builtin_elementwise_abs(v), d = av * 0.2316418882f + 1.0f;
    f32x2 t; t.x = __builtin_amdgcn_rcpf(d.x); t.y = __builtin_amdgcn_rcpf(d.y);
    f32x2 q = t * 0.5307027145f + (-0.7265760135f); q = q * t + 0.7107068705f; q = q * t + (-0.142248368f); q = q * t + 0.127414796f; q = q * t;
    const f32x2 s = (v * v) * (-0.72134752044f);
    f32x2 e; e.x = __builtin_amdgcn_exp2f(s.x); e.y = __builtin_amdgcn_exp2f(s.y);
    const f32x2 m = v * (q * e), r = v - m;
    f32x2 o; o.x = v.x < 0.f ? m.x : r.x; o.y = v.y < 0.f ? m.y : r.y; return o;
}

struct EpiF32 {
    static constexpr bool PERM = false, AFTER_DRAIN = false;
    float* C; int ldc; const float* bias;
    __device__ __forceinline__ void operator()(const f32x4 (&acc)[2][2][4][2], const Unit& u, int wr, int wc, int fr, int fq) const {
        const int row0 = u.pm * BM + wr * 64 + fr, col0 = u.pn * BM + wc * 32 + 4 * fq;
        f32x4 bv[2][2];
#pragma unroll
        for (int bj = 0; bj < 2; ++bj)
#pragma unroll
            for (int n = 0; n < 2; ++n) bv[bj][n] = bias ? *(const f32x4*)(bias + col0 + bj * HALF + n * 16) : (f32x4){0.f, 0.f, 0.f, 0.f};
#pragma unroll
        for (int ai = 0; ai < 2; ++ai)
#pragma unroll
            for (int m = 0; m < 4; ++m) { float* rowp = C + (size_t)(row0 + ai * HALF + m * 16) * ldc + col0;
#pragma unroll
                for (int bj = 0; bj < 2; ++bj)
#pragma unroll
                    for (int n = 0; n < 2; ++n) *(f32x4*)(rowp + bj * HALF + n * 16) = acc[ai][bj][m][n] + bv[bj][n]; }
    }
};
template <int ACT  > struct EpiBf16 {
    static constexpr bool PERM = true, AFTER_DRAIN = false;
    bf16_t* O; int ldc; const float* bias; int split_cols; size_t split_stride;
    __device__ __forceinline__ void operator()(const f32x4 (&acc)[2][2][4][2], const Unit& u, int wr, int wc, int fr, int fq) const {
        const int row0 = u.pm * BM + wr * 64 + fr; int colt = u.pn * BM; bf16_t* base = O;
        if (split_cols) { const int t = colt / split_cols; base += (size_t)t * split_stride; colt -= t * split_cols; }
        const int col0 = colt + wc * 32 + 8 * fq, bcol0 = u.pn * BM + wc * 32 + 8 * fq;
        f32x4 bv[2][2];
#pragma unroll
        for (int bj = 0; bj < 2; ++bj)
#pragma unroll
            for (int n = 0; n < 2; ++n) bv[bj][n] = bias ? *(const f32x4*)(bias + bcol0 + bj * HALF + 4 * n) : (f32x4){0.f, 0.f, 0.f, 0.f};
#pragma unroll
        for (int ai = 0; ai < 2; ++ai)
#pragma unroll
            for (int m = 0; m < 4; ++m) { bf16_t* rowp = base + (size_t)(row0 + ai * HALF + m * 16) * ldc + col0;
#pragma unroll
                for (int bj = 0; bj < 2; ++bj) { f32x4 v0 = acc[ai][bj][m][0] + bv[bj][0], v1 = acc[ai][bj][m][1] + bv[bj][1];
                    if (ACT == 1) { f32x2 a = gelu_pk((f32x2){v0[0], v0[1]}), b = gelu_pk((f32x2){v0[2], v0[3]}), c = gelu_pk((f32x2){v1[0], v1[1]}), d = gelu_pk((f32x2){v1[2], v1[3]});
                        v0 = (f32x4){a.x, a.y, b.x, b.y}; v1 = (f32x4){c.x, c.y, d.x, d.y}; }
                    if (ACT == 2) {
#pragma unroll
                        for (int j = 0; j < 4; ++j) { v0[j] = 0.5f * v0[j] * (1.0f + erff(v0[j] * 0.70710678f)); v1[j] = 0.5f * v1[j] * (1.0f + erff(v1[j] * 0.70710678f)); } }
                    u32x4 w; w.x = cvt_pk_bf16(v0[0], v0[1]); w.y = cvt_pk_bf16(v0[2], v0[3]); w.z = cvt_pk_bf16(v1[0], v1[1]); w.w = cvt_pk_bf16(v1[2], v1[3]);
                    *(u32x4*)(rowp + bj * HALF) = w; } }
    }
};

struct PanelStats {
    unsigned* xbuf;
    unsigned* cnt;
    unsigned* tmo;
    int ntn; float eps;
    unsigned code;
    __device__ __forceinline__ bool run(const f32x4 (&v)[2][2][4][2], const Unit& u, int wr, int wc, int fr, int fq, PG8_LAS unsigned char* lds, int wid, int lane) const {
        typedef float f32x2v __attribute__((ext_vector_type(2)));
        PG8_LAS f32x2v* P = (PG8_LAS f32x2v*)lds;
        PG8_LAS f32x2v* S = (PG8_LAS f32x2v*)(lds + 8192);
        PG8_LAS unsigned* flag = (PG8_LAS unsigned*)(lds + 8192 + 2048);
#pragma unroll
        for (int ai = 0; ai < 2; ++ai)
#pragma unroll
            for (int m = 0; m < 4; ++m) {
                float s = 0.f;
#pragma unroll
                for (int bj = 0; bj < 2; ++bj)
#pragma unroll
                    for (int n = 0; n < 2; ++n) { const f32x4 x = v[ai][bj][m][n]; s += (x[0] + x[1]) + (x[2] + x[3]); }
                s += __shfl_xor(s, 16); s += __shfl_xor(s, 32);
                const float mw = s * (1.0f / 64.0f); float q = 0.f;
#pragma unroll
                for (int bj = 0; bj < 2; ++bj)
#pragma unroll
                    for (int n = 0; n < 2; ++n) { const f32x4 d = v[ai][bj][m][n] - mw; q += (d[0] * d[0] + d[1] * d[1]) + (d[2] * d[2] + d[3] * d[3]); }
                q += __shfl_xor(q, 16); q += __shfl_xor(q, 32);
                if (fq == 0) P[(ai * HALF + wr * 64 + m * 16 + fr) * 4 + wc] = (f32x2v){mw, q};
            }
        asm volatile("s_waitcnt lgkmcnt(0)" ::: "memory"); __builtin_amdgcn_s_barrier(); asm volatile("" ::: "memory");
#if defined(BROKEN_NO_WAIT)
        if (blockIdx.x >= 64) { const long long t0 = clock64(); while (clock64() - t0 < 60000) __builtin_amdgcn_s_sleep(8); }
#endif
        const int row = wid * 32 + (lane & 31);
        if (lane < 32) {
            const f32x2v a = P[row * 4 + 0], b = P[row * 4 + 1], c = P[row * 4 + 2], d = P[row * 4 + 3];
            const float mt = (a.x + b.x + c.x + d.x) * 0.25f;
            const float da = a.x - mt, db = b.x - mt, dc = c.x - mt, dd = d.x - mt;
            const float m2 = (a.y + b.y) + (c.y + d.y) + 64.0f * ((da * da + db * db) + (dc * dc + dd * dd));
            unsigned long long* slot = (unsigned long long*)xbuf + ((size_t)(u.pm * BM + row) * 4 + u.pn);
            __hip_atomic_store(slot, ((unsigned long long)__float_as_uint(m2) << 32) | __float_as_uint(mt), __ATOMIC_RELAXED, __HIP_MEMORY_SCOPE_AGENT);
        }
        asm volatile("s_waitcnt vmcnt(0)" ::: "memory");
        if (lane == 0) __hip_atomic_fetch_add(cnt + 64 * u.pm, 1u, __ATOMIC_RELAXED, __HIP_MEMORY_SCOPE_AGENT);
        if (wid == 0) {
            bool dead = false; const unsigned long long t0 = __builtin_amdgcn_s_memrealtime(); const unsigned want = 8u * (unsigned)ntn;
            for (;;) {
#if defined(BROKEN_NO_WAIT)
                break;
#endif
                if ((unsigned)__builtin_amdgcn_readfirstlane(__hip_atomic_load(cnt + 64 * u.pm, __ATOMIC_RELAXED, __HIP_MEMORY_SCOPE_AGENT)) >= want) break;
                if (__builtin_amdgcn_s_memrealtime() - t0 > 2000000ull) {
                    if (lane == 0) { unsigned expect = 0u; __hip_atomic_compare_exchange_strong(tmo + 1, &expect, code | (unsigned)(u.pm & 0xff), __ATOMIC_RELAXED, __ATOMIC_RELAXED, __HIP_MEMORY_SCOPE_AGENT);
                                     __hip_atomic_store(tmo, 1u, __ATOMIC_RELAXED, __HIP_MEMORY_SCOPE_AGENT); }
                    dead = true; break; }
                __builtin_amdgcn_s_sleep(2);
            }
            __builtin_amdgcn_fence(__ATOMIC_ACQUIRE, "agent");
            if (lane == 0) flag[0] = dead ? 1u : 0u;
        }
        asm volatile("s_waitcnt vmcnt(0) lgkmcnt(0)" ::: "memory"); __builtin_amdgcn_s_barrier(); asm volatile("" ::: "memory");
        const bool bad = flag[0] != 0u;
        if (lane < 32) {
            const unsigned long long* slot = (const unsigned long long*)xbuf + (size_t)(u.pm * BM + row) * 4; float mt[4], m2[4]; float ms = 0.f;
#pragma unroll
            for (int t = 0; t < 4; ++t) { if (t < ntn) { const unsigned long long w = __hip_atomic_load(slot + t, __ATOMIC_RELAXED, __HIP_MEMORY_SCOPE_AGENT); mt[t] = __uint_as_float((unsigned)w); m2[t] = __uint_as_float((unsigned)(w >> 32)); } else { mt[t] = 0.f; m2[t] = 0.f; } ms += mt[t]; }
            const float mean = ms / (float)ntn; float q = 0.f;
#pragma unroll
            for (int t = 0; t < 4; ++t) if (t < ntn) { const float dm = mt[t] - mean; q += m2[t] + 256.0f * dm * dm; }
            S[row] = (f32x2v){mean, 1.0f / sqrtf(q / (256.0f * (float)ntn) + eps)};
        }
        asm volatile("s_waitcnt lgkmcnt(0)" ::: "memory"); __builtin_amdgcn_s_barrier(); asm volatile("" ::: "memory");
        return bad;
    }
};
struct EpiLnRes {
    static constexpr bool PERM = false, AFTER_DRAIN = true;
    const float* base; float* out; int ldc; const float* bias; PanelStats st; unsigned poison;
    __device__ __forceinline__ void refuse(size_t i0, size_t stride, int M, int N) const { const float q = __builtin_nanf(""); for (size_t i = i0; i < (size_t)M * N; i += stride) out[(i / N) * ldc + i % N] = q;
        if (i0 == 0) { unsigned expect = 0u; __hip_atomic_compare_exchange_strong(st.tmo + 1, &expect, 0x7f0u, __ATOMIC_RELAXED, __ATOMIC_RELAXED, __HIP_MEMORY_SCOPE_AGENT); __hip_atomic_store(st.tmo, 1u, __ATOMIC_RELAXED, __HIP_MEMORY_SCOPE_AGENT); } }
    __device__ __forceinline__ void fused(f32x4 (&acc)[2][2][4][2], const Unit& u, int wr, int wc, int fr, int fq, PG8_LAS unsigned char* lds, int wid, int lane) const {
        typedef float f32x2v __attribute__((ext_vector_type(2)));
        const PG8_LAS f32x2v* S = (const PG8_LAS f32x2v*)(lds + 8192);
        const int col0 = u.pn * BM + wc * 32 + 4 * fq;
#pragma unroll
        for (int bj = 0; bj < 2; ++bj)
#pragma unroll
            for (int n = 0; n < 2; ++n) { const f32x4 bv = bias ? *(const f32x4*)(bias + col0 + bj * HALF + n * 16) : (f32x4){0.f, 0.f, 0.f, 0.f};
#pragma unroll
                for (int ai = 0; ai < 2; ++ai)
#pragma unroll
                    for (int m = 0; m < 4; ++m) acc[ai][bj][m][n] += bv; }
        const bool bad = st.run(acc, u, wr, wc, fr, fq, lds, wid, lane) || poison != 0u;
        const float qnan = __builtin_nanf("");
#pragma unroll
        for (int ai = 0; ai < 2; ++ai)
#pragma unroll
            for (int m = 0; m < 4; ++m) { const int r = ai * HALF + wr * 64 + m * 16 + fr; const f32x2v sr = S[r]; const size_t off = (size_t)(u.pm * BM + r) * ldc + col0;
#pragma unroll
                for (int bj = 0; bj < 2; ++bj)
#pragma unroll
                    for (int n = 0; n < 2; ++n) { const f32x4 bs = *(const f32x4*)(base + off + bj * HALF + n * 16); f32x4 o = bs + (acc[ai][bj][m][n] - sr.x) * sr.y;
                        if (bad) o = (f32x4){qnan, qnan, qnan, qnan}; *(f32x4*)(out + off + bj * HALF + n * 16) = o; }
                asm volatile("" ::: "memory"); }
    }
};
struct EpiLnResLn {
    static constexpr bool PERM = false, AFTER_DRAIN = true;
    const float* base; float* out; bf16_t* xn; int ldc; const float* bias; PanelStats st1, st2; unsigned poison;
    __device__ __forceinline__ void refuse(size_t i0, size_t stride, int M, int N) const { const float q = __builtin_nanf(""); for (size_t i = i0; i < (size_t)M * N; i += stride) { const size_t o = (i / N) * ldc + i % N; out[o] = q; xn[o] = (bf16_t)0x7fc0u; }
        if (i0 == 0) { unsigned expect = 0u; __hip_atomic_compare_exchange_strong(st1.tmo + 1, &expect, 0x7f0u, __ATOMIC_RELAXED, __ATOMIC_RELAXED, __HIP_MEMORY_SCOPE_AGENT); __hip_atomic_store(st1.tmo, 1u, __ATOMIC_RELAXED, __HIP_MEMORY_SCOPE_AGENT); } }
    __device__ __forceinline__ void fused(f32x4 (&acc)[2][2][4][2], const Unit& u, int wr, int wc, int fr, int fq, PG8_LAS unsigned char* lds, int wid, int lane) const {
        typedef float f32x2v __attribute__((ext_vector_type(2))); typedef unsigned u32x2v __attribute__((ext_vector_type(2)));
        const PG8_LAS f32x2v* S = (const PG8_LAS f32x2v*)(lds + 8192);
        const int col0 = u.pn * BM + wc * 32 + 4 * fq;
#pragma unroll
        for (int bj = 0; bj < 2; ++bj)
#pragma unroll
            for (int n = 0; n < 2; ++n) { const f32x4 bv = bias ? *(const f32x4*)(bias + col0 + bj * HALF + n * 16) : (f32x4){0.f, 0.f, 0.f, 0.f};
#pragma unroll
                for (int ai = 0; ai < 2; ++ai)
#pragma unroll
                    for (int m = 0; m < 4; ++m) acc[ai][bj][m][n] += bv; }
        bool bad = st1.run(acc, u, wr, wc, fr, fq, lds, wid, lane) || poison != 0u;
        const float qnan = __builtin_nanf("");
#pragma unroll
        for (int ai = 0; ai < 2; ++ai)
#pragma unroll
            for (int m = 0; m < 4; ++m) { const int r = ai * HALF + wr * 64 + m * 16 + fr; const f32x2v sr = S[r]; const size_t off = (size_t)(u.pm * BM + r) * ldc + col0;
#pragma unroll
                for (int bj = 0; bj < 2; ++bj)
#pragma unroll
                    for (int n = 0; n < 2; ++n) { const f32x4 bs = *(const f32x4*)(base + off + bj * HALF + n * 16); acc[ai][bj][m][n] = bs + (acc[ai][bj][m][n] - sr.x) * sr.y; }
                asm volatile("" : "+v"(acc[ai][0][m][0]), "+v"(acc[ai][0][m][1]), "+v"(acc[ai][1][m][0]), "+v"(acc[ai][1][m][1]));
                if (m & 1) asm volatile("" ::: "memory"); }
        const bool bad1 = bad;
        bad = st2.run(acc, u, wr, wc, fr, fq, lds, wid, lane) || bad;
#pragma unroll
        for (int ai = 0; ai < 2; ++ai)
#pragma unroll
            for (int m = 0; m < 4; ++m) { const int r = ai * HALF + wr * 64 + m * 16 + fr; const f32x2v sr = S[r]; const size_t off = (size_t)(u.pm * BM + r) * ldc + col0;
#pragma unroll
                for (int bj = 0; bj < 2; ++bj)
#pragma unroll
                    for (int n = 0; n < 2; ++n) { const f32x4 x1 = acc[ai][bj][m][n]; *(f32x4*)(out + off + bj * HALF + n * 16) = bad1 ? (f32x4){qnan, qnan, qnan, qnan} : x1;
                        const f32x4 o = (x1 - sr.x) * sr.y; u32x2v w; w.x = cvt_pk_bf16(o[0], o[1]); w.y = cvt_pk_bf16(o[2], o[3]);
                        if (bad) { w.x = 0x7fc07fc0u; w.y = 0x7fc07fc0u; } *(u32x2v*)(xn + off + bj * HALF + n * 16) = w; }
                asm volatile("" ::: "memory"); }
    }
};

template <class Epi, class Sched, bool STAMP = false>
__device__ __forceinline__ void gemm_phase(PG8_LAS unsigned char* lds, const Gemm g, const Sched S, const Epi E, unsigned long long* stamps) {
    const int tid = threadIdx.x, wid = __builtin_amdgcn_readfirstlane(tid >> 6), lane = tid & 63, wr = wid >> 2, wc = wid & 3, fr = lane & 15, fq = lane >> 4;
    const int K = g.K, nt = K / BK;
    int ts_lo = 0, ts_hi = 0, nts = 0; const unsigned long long rt_entry = STAMP ? (unsigned long long)wall_clock64() : 0ull;
#define PG8_STAMP() do { if (STAMP && wid == 0 && nts < 64) { const unsigned long long _c = (unsigned long long)clock64(); \
        ts_lo = (lane == nts) ? (int)(unsigned)_c : ts_lo; ts_hi = (lane == nts) ? (int)(unsigned)(_c >> 32) : ts_hi; ++nts; } } while (0)
    PG8_STAMP();
    unsigned voffA[2], voffB[2];
#pragma unroll
    for (int i = 0; i < 2; ++i) { int R, C; stage_rc(tid * 16 + i * 8192, R, C); const int Rb = Epi::PERM ? ((R & ~31) + perm32(R & 31)) : R;
        voffA[i] = (unsigned)(R * g.lda + C) * 2u; voffB[i] = (unsigned)(Rb * K + C) * 2u; }
    const size_t kstep = (size_t)(BK * 2);
    const size_t hstep = (size_t)HALF * K * 2;
    const size_t tstep = 2 * hstep;
    const size_t hstepA = (size_t)HALF * g.lda * 2, tstepA = 2 * hstepA;
    const unsigned ldsw = (unsigned)wid * 1024u;
    const int aoff = lds_byte(wr * 64 + fr, fq * 8), boff = lds_byte(wc * 32 + fr, fq * 8);
#define PG8_SA(b, h) (((b) * 2 + (h)) * HTB)
#define PG8_SB(b, h) ((4 + (b) * 2 + (h)) * HTB)
#define PG8_STAGE(bufoff, gbase, voff) do { _Pragma("unroll") for (int _i = 0; _i < 2; ++_i) \
        __builtin_amdgcn_global_load_lds((const unsigned*)((const char*)(gbase) + (voff)[_i]), (PG8_LAS unsigned*)(lds + (bufoff) + ldsw + _i * 8192), 16, 0, 0); } while (0)
#define PG8_LDA(dst, b, h) do { _Pragma("unroll") for (int m = 0; m < 4; ++m) _Pragma("unroll") for (int k = 0; k < 2; ++k) dst[m][k] = *(const PG8_LAS bf16x8*)(lds + PG8_SA(b, h) + aoff + m * 2048 + k * 1024); } while (0)
#define PG8_LDB(dst, b, h) do { _Pragma("unroll") for (int n = 0; n < 2; ++n) _Pragma("unroll") for (int k = 0; k < 2; ++k) dst[n][k] = *(const PG8_LAS bf16x8*)(lds + PG8_SB(b, h) + boff + n * 2048 + k * 1024); } while (0)
#define PG8_MMA(ai, bj, At, Bt) do { __builtin_amdgcn_s_setprio(1); _Pragma("unroll") for (int m = 0; m < 4; ++m) _Pragma("unroll") for (int n = 0; n < 2; ++n) _Pragma("unroll") for (int k = 0; k < 2; ++k) \
        acc[ai][bj][m][n] = __builtin_amdgcn_mfma_f32_16x16x32_bf16(Bt[n][k], At[m][k], acc[ai][bj][m][n], 0, 0, 0); __builtin_amdgcn_s_setprio(0); } while (0)
#define PG8_WAIT_V(n) asm volatile("s_waitcnt vmcnt(" #n ")" ::: "memory")
#define PG8_WAIT_L(n) asm volatile("s_waitcnt lgkmcnt(" #n ")" ::: "memory")
#define PG8_BAR __builtin_amdgcn_s_barrier()
#define PG8_SCHED __builtin_amdgcn_sched_barrier(0)
    Unit cur, nxt; int ui = 0;
    if (!S.next(0, cur)) return;
    f32x4 acc[2][2][4][2];
#pragma unroll
    for (int a = 0; a < 2; ++a)
#pragma unroll
        for (int b = 0; b < 2; ++b)
#pragma unroll
            for (int m = 0; m < 4; ++m)
#pragma unroll
                for (int n = 0; n < 2; ++n) acc[a][b][m][n] = (f32x4){0.f, 0.f, 0.f, 0.f};
    bf16x8 At[4][2], B0[2][2], B1[2][2];
    const char* cA = (const char*)g.A + (size_t)cur.pm * tstepA; const char* cB = (const char*)g.Bt + (size_t)cur.pn * tstep;
    S.a_ready(cur);
    PG8_STAGE(PG8_SB(0, 0), cB, voffB); PG8_STAGE(PG8_SA(0, 0), cA, voffA); PG8_STAGE(PG8_SB(0, 1), cB + hstep, voffB); PG8_STAGE(PG8_SA(0, 1), cA + hstepA, voffA);
    if (wr == 1) PG8_BAR;
    PG8_WAIT_V(4); PG8_BAR;
    PG8_STAGE(PG8_SB(1, 0), cB + kstep, voffB); PG8_STAGE(PG8_SA(1, 0), cA + kstep, voffA); PG8_STAGE(PG8_SB(1, 1), cB + hstep + kstep, voffB);
    PG8_WAIT_V(6); PG8_BAR;
    PG8_STAMP();
    for (;;) {
        const bool has_next = S.next(ui + 1, nxt);
        const char* nA = has_next ? (const char*)g.A + (size_t)nxt.pm * tstepA : cA; const char* nB = has_next ? (const char*)g.Bt + (size_t)nxt.pn * tstep : cB;
        for (int t = 0; t < nt; t += 2) {
            const bool last = (t == nt - 2);
            const char* a1 = cA + (size_t)(t + 1) * kstep;
            const char* a2 = last ? nA : cA + (size_t)(t + 2) * kstep; const char* b2 = last ? nB : cB + (size_t)(t + 2) * kstep;
            const char* a3 = a2 + kstep; const char* b3 = b2 + kstep;
            if (last && has_next) S.a_ready(nxt);
            PG8_LDB(B0, 0, 0); PG8_SCHED; PG8_LDA(At, 0, 0); PG8_STAGE(PG8_SA(1, 1), a1 + hstepA, voffA);
            PG8_WAIT_L(8); PG8_BAR; PG8_WAIT_L(0); PG8_MMA(0, 0, At, B0); PG8_BAR; PG8_SCHED;
            PG8_LDB(B1, 0, 1); PG8_STAGE(PG8_SB(0, 0), b2, voffB);
            PG8_BAR; PG8_WAIT_L(0); PG8_MMA(0, 1, At, B1); PG8_BAR;
            PG8_LDA(At, 0, 1); PG8_STAGE(PG8_SA(0, 0), a2, voffA);
            PG8_BAR; PG8_WAIT_L(0); PG8_MMA(1, 0, At, B0); PG8_BAR; PG8_SCHED;
            PG8_STAGE(PG8_SB(0, 1), b2 + hstep, voffB);
            PG8_WAIT_V(6); PG8_BAR; PG8_MMA(1, 1, At, B1); PG8_BAR;
            PG8_LDB(B0, 1, 0); PG8_SCHED; PG8_LDA(At, 1, 0); PG8_STAGE(PG8_SA(0, 1), a2 + hstepA, voffA);
            PG8_WAIT_L(8); PG8_BAR; PG8_WAIT_L(0); PG8_MMA(0, 0, At, B0); PG8_BAR; PG8_SCHED;
            PG8_LDB(B1, 1, 1); PG8_STAGE(PG8_SB(1, 0), b3, voffB);
            PG8_BAR; PG8_WAIT_L(0); PG8_MMA(0, 1, At, B1); PG8_BAR;
            PG8_LDA(At, 1, 1); PG8_STAGE(PG8_SA(1, 0), a3, voffA);
            PG8_BAR; PG8_WAIT_L(0); PG8_MMA(1, 0, At, B0); PG8_BAR; PG8_SCHED;
            PG8_STAGE(PG8_SB(1, 1), b3 + hstep, voffB);
            PG8_WAIT_V(6); PG8_BAR; PG8_MMA(1, 1, At, B1); PG8_BAR;
        }
        PG8_STAMP();
        if constexpr (!Epi::AFTER_DRAIN) { E(acc, cur, wr, wc, fr, fq); S.done(cur); }
        PG8_STAMP();
        if (!has_next) break;
#pragma unroll
        for (int a = 0; a < 2; ++a)
#pragma unroll
            for (int b = 0; b < 2; ++b)
#pragma unroll
                for (int m = 0; m < 4; ++m)
#pragma unroll
                    for (int n = 0; n < 2; ++n) acc[a][b][m][n] = (f32x4){0.f, 0.f, 0.f, 0.f};
        cur = nxt; cA = nA; cB = nB; ++ui;
    }
    PG8_WAIT_V(0);
    if (wr == 0) PG8_BAR;
    PG8_BAR;
    if constexpr (Epi::AFTER_DRAIN) { E.fused(acc, cur, wr, wc, fr, fq, lds, wid, lane); S.done(cur); }
    PG8_STAMP();
    if (STAMP && wid == 0) { stamps[lane] = lane < nts ? (((unsigned long long)(unsigned)ts_hi << 32) | (unsigned)ts_lo) : 0ull;
        if (lane == 62) stamps[62] = rt_entry; if (lane == 63) stamps[63] = (unsigned long long)wall_clock64(); }
#undef PG8_STAMP
#undef PG8_SA
#undef PG8_SB
#undef PG8_STAGE
#undef PG8_LDA
#undef PG8_LDB
#undef PG8_MMA
#undef PG8_WAIT_V
#undef PG8_WAIT_L
#undef PG8_BAR
#undef PG8_SCHED
}
}

namespace mk {
#define LAS __attribute__((address_space(3)))
using pg8::bf16_t; using pg8::bf16x8; using pg8::f32x4; using pg8::u32x4;
typedef unsigned u32x2 __attribute__((ext_vector_type(2)));

constexpr int DM = 1024, SEQ = 8192, NBATCH = 4, MPR = NBATCH * SEQ, MSAMP = 128, MREAL = MPR + MSAMP, MPAD = 33024;
constexpr int DFF = 2816, PW = 2816, NINP = 3072, CONVC = 1536;
constexpr float EPS = 1e-6f;
#ifndef SCAN_CW
#define SCAN_CW 2
#endif
constexpr int CW = SCAN_CW, NSCAN = 128 / CW;
constexpr int LDS_PHASE_BYTES = 147456, LDS_BYTES = LDS_PHASE_BYTES + 256;

constexpr size_t O_YP = 0, O_YS = 33554432, O_KP = 33685504, O_VP = 33751040, O_CP = 33816576, O_GP = 33835008,
                 O_KS = 34097152, O_VS = 36194304, O_CS = 38291456, O_GS = 38881280;
constexpr size_t MiB = 1u << 20;
constexpr size_t WS_CTL = 0, CTL_ZERO_BYTES = 1 * MiB;
constexpr size_t WS_W1IN = 1 * MiB, WS_W1OUT = 12 * MiB, WS_WINMIX = 18 * MiB, WS_WOUTMIX = 24 * MiB, WS_W2IN = 26 * MiB, WS_W2OUT = 37 * MiB;
constexpr size_t WS_GBA = 43 * MiB, WS_XN = 45 * MiB, WS_XN2 = 110 * MiB, WS_H = 175 * MiB, WS_GM = 353 * MiB, WS_GN = 417 * MiB;
constexpr size_t WS_GQ = 110 * MiB, WS_GO = 142 * MiB;
constexpr size_t WS_SSP1 = 481 * MiB, WS_SSP2 = 484 * MiB;
constexpr size_t WS_END = 487 * MiB;
constexpr size_t CTL_BAR = 0, CTL_BAR_BYTES = 16384, CTL_GLAST = 768 * 1024;

struct Params { const float* in[21]; float* out; unsigned char* ws; };

typedef float f32x2v __attribute__((ext_vector_type(2)));
typedef __bf16 bf16x2v __attribute__((ext_vector_type(2)));
__device__ __forceinline__ unsigned cvt_pk(float lo, float hi) { const f32x2v v = {lo, hi}; const bf16x2v b = __builtin_convertvector(v, bf16x2v); return __builtin_bit_cast(unsigned, b); }
__device__ __forceinline__ bf16_t f2bf(float f) { return (bf16_t)(cvt_pk(f, 0.f) & 0xffffu); }
__device__ __forceinline__ float bf2f(bf16_t h) { return __uint_as_float(((unsigned)h) << 16); }
__device__ __forceinline__ float bflo(unsigned w) { return __uint_as_float(w << 16); }
__device__ __forceinline__ float bfhi(unsigned w) { return __uint_as_float(w & 0xffff0000u); }
__device__ __forceinline__ float silu(float x) { return x * __builtin_amdgcn_rcpf(1.0f + __expf(-x)); }
__device__ __forceinline__ float wave_sum(float v) {
#pragma unroll
    for (int o = 1; o < 64; o <<= 1) v += __shfl_xor(v, o);
    return v;
}
__device__ __forceinline__ float wave_max(float v) {
#pragma unroll
    for (int o = 1; o < 64; o <<= 1) v = fmaxf(v, __shfl_xor(v, o));
    return v;
}
__device__ __forceinline__ f32x4 mfma16(bf16x8 a, bf16x8 b, f32x4 c) { return __builtin_amdgcn_mfma_f32_16x16x32_bf16(a, b, c, 0, 0, 0); }

__device__ __forceinline__ float row_rstd(const float* ssp, int r) {
    if (r >= MREAL) return 0.f;
    const f32x4 a = *(const f32x4*)(ssp + (size_t)r * 16), b = *(const f32x4*)(ssp + (size_t)r * 16 + 4), c = *(const f32x4*)(ssp + (size_t)r * 16 + 8), d = *(const f32x4*)(ssp + (size_t)r * 16 + 12);
    const float s = (((a[0] + a[1]) + (a[2] + a[3])) + ((b[0] + b[1]) + (b[2] + b[3]))) + (((c[0] + c[1]) + (c[2] + c[3])) + ((d[0] + d[1]) + (d[2] + d[3])));
    return rsqrtf(s * (1.0f / DM) + EPS);
}
struct EpiSwiglu {
    static constexpr bool PERM = true, AFTER_DRAIN = false;
    bf16_t* H; const float* ss;
    __device__ __forceinline__ void operator()(const f32x4 (&acc)[2][2][4][2], const pg8::Unit& u, int wr, int wc, int fr, int fq) const {
        const int row0 = u.pm * 256 + wr * 64 + fr, col0 = u.pn * 128 + wc * 32 + 8 * fq;
#pragma unroll
        for (int ai = 0; ai < 2; ++ai)
#pragma unroll
            for (int m = 0; m < 4; ++m) {
                const int r = row0 + ai * 128 + m * 16;
                const float rs = ss ? row_rstd(ss, r) : 1.0f;
                float h[8];
#pragma unroll
                for (int n = 0; n < 2; ++n)
#pragma unroll
                    for (int j = 0; j < 4; ++j) h[n * 4 + j] = silu(acc[ai][0][m][n][j] * rs) * (acc[ai][1][m][n][j] * rs);
                u32x4 w; w.x = cvt_pk(h[0], h[1]); w.y = cvt_pk(h[2], h[3]); w.z = cvt_pk(h[4], h[5]); w.w = cvt_pk(h[6], h[7]);
                *(u32x4*)(H + (size_t)r * DFF + col0) = w;
            }
    }
};
template <bool RESB16, bool WF32, bool WB16, bool SUMSQ, bool HALF> struct EpiResid {
    static constexpr bool PERM = true, AFTER_DRAIN = false;
    const void* resP; const void* resS; float* Yo; bf16_t* XBo; float* sso;
    __device__ __forceinline__ void operator()(const f32x4 (&acc)[2][2][4][2], const pg8::Unit& u, int wr, int wc, int fr, int fq) const {
        const int row0 = u.pm * 256 + wr * 64 + fr, col0 = u.pn * 256 + wc * 32 + 8 * fq;
        const char* const rP = (const char*)resP; const char* const rS = (const char*)resS - (size_t)MPR * DM * (RESB16 ? 2 : 4);
        float* const Y = Yo; const float scale = HALF ? 0.5f : 1.0f; bf16_t* const XB = XBo; float* const ss = sso;
#pragma unroll
        for (int ai = 0; ai < 2; ++ai)
#pragma unroll
            for (int m = 0; m < 4; ++m) {
                const int r = row0 + ai * 128 + m * 16; float s = 0.f;
                if (r < MREAL) {
                    const char* rp = ((r < MPR) ? rP : rS) + (size_t)r * DM * (RESB16 ? 2 : 4);
#pragma unroll
                    for (int bj = 0; bj < 2; ++bj) {
                        const int c = col0 + bj * 128;
                        f32x4 r0, r1;
                        if (RESB16) { const u32x4 w = *(const u32x4*)(rp + (size_t)c * 2); r0 = (f32x4){bflo(w.x), bfhi(w.x), bflo(w.y), bfhi(w.y)}; r1 = (f32x4){bflo(w.z), bfhi(w.z), bflo(w.w), bfhi(w.w)}; }
                        else { r0 = *(const f32x4*)(rp + (size_t)c * 4); r1 = *(const f32x4*)(rp + (size_t)c * 4 + 16); }
                        const f32x4 v0 = r0 + acc[ai][bj][m][0] * scale, v1 = r1 + acc[ai][bj][m][1] * scale;
                        if (WF32) { *(f32x4*)(Y + (size_t)r * DM + c) = v0; *(f32x4*)(Y + (size_t)r * DM + c + 4) = v1; }
                        if (WB16) { u32x4 w; w.x = cvt_pk(v0[0], v0[1]); w.y = cvt_pk(v0[2], v0[3]); w.z = cvt_pk(v1[0], v1[1]); w.w = cvt_pk(v1[2], v1[3]);
                            *(u32x4*)(XB + (size_t)r * DM + c) = w; }
                        if (SUMSQ) s += (v0[0] * v0[0] + v0[1] * v0[1]) + (v0[2] * v0[2] + v0[3] * v0[3]) + (v1[0] * v1[0] + v1[1] * v1[1]) + (v1[2] * v1[2] + v1[3] * v1[3]);
                    }
                }
                if (SUMSQ) { s += __shfl_xor(s, 16); s += __shfl_xor(s, 32); if (fq == 0 && r < MREAL) ss[(size_t)r * 16 + u.pn * 4 + wc] = s; }
            }
    }
};
struct EpiInproj {
    static constexpr bool PERM = true, AFTER_DRAIN = false;
    bf16_t* P; float* gba; const float* ss;
    __device__ __forceinline__ void operator()(const f32x4 (&acc)[2][2][4][2], const pg8::Unit& u, int wr, int wc, int fr, int fq) const {
        const int row0 = u.pm * 256 + wr * 64 + fr, col0 = u.pn * 256 + wc * 32 + 8 * fq;
#pragma unroll
        for (int ai = 0; ai < 2; ++ai)
#pragma unroll
            for (int m = 0; m < 4; ++m) {
                const int r = row0 + ai * 128 + m * 16;
                const float rs = row_rstd(ss, r);
                if (u.pn < 11) {
#pragma unroll
                    for (int bj = 0; bj < 2; ++bj) { const f32x4 v0 = acc[ai][bj][m][0] * rs, v1 = acc[ai][bj][m][1] * rs;
                        u32x4 w; w.x = cvt_pk(v0[0], v0[1]); w.y = cvt_pk(v0[2], v0[3]); w.z = cvt_pk(v1[0], v1[1]); w.w = cvt_pk(v1[2], v1[3]);
                        *(u32x4*)(P + (size_t)r * PW + col0 + bj * 128) = w; }
                } else if (wc == 0 && fq == 0) {
                    *(f32x4*)(gba + (size_t)r * 8) = acc[ai][0][m][0] * rs; *(f32x4*)(gba + (size_t)r * 8 + 4) = acc[ai][0][m][1] * rs;
                }
            }
    }
};


template <int NT, bool SS>
__device__ __forceinline__ void skinny_mm(const bf16_t* A, int lda, const bf16_t* W, int K, int wrow0, int wrow1, int wid, int fr, int fq, f32x4 (&acc)[NT], float& ss) {
    const bf16_t* ap = A + (size_t)(16 * wid + fr) * lda + 8 * fq;
    const bf16_t* w0 = W + (size_t)(wrow0 + fr) * K + 8 * fq; const bf16_t* w1 = W + (size_t)(wrow1 + fr) * K + 8 * fq;
#pragma unroll
    for (int nt = 0; nt < NT; ++nt) acc[nt] = (f32x4){0.f, 0.f, 0.f, 0.f};
    float s = 0.f;
#pragma unroll 8
    for (int ks = 0; ks < K / 32; ++ks) {
        const bf16x8 a = *(const bf16x8*)(ap + 32 * ks);
        acc[0] = mfma16(*(const bf16x8*)(w0 + 32 * ks), a, acc[0]);
        if (NT == 2) acc[NT - 1] = mfma16(*(const bf16x8*)(w1 + 32 * ks), a, acc[NT - 1]);
        if (SS) { const u32x4 u = __builtin_bit_cast(u32x4, a);
#pragma unroll
            for (int k = 0; k < 4; ++k) { const float lo = bflo(u[k]), hi = bfhi(u[k]); s += lo * lo + hi * hi; } }
    }
    if (SS) { s += __shfl_xor(s, 16); s += __shfl_xor(s, 32); }
    ss = s;
}
template <bool SS> __device__ __forceinline__ void sk_ffn_in(const bf16_t* X, const bf16_t* Wt, bf16_t* H, int slab, int wid, int fr, int fq) {
    const int j0 = 16 * slab, wr0 = (j0 >> 7) * 256 + (j0 & 127);
    f32x4 acc[2]; float ss;
    skinny_mm<2, SS>(X + (size_t)MPR * DM, DM, Wt, DM, wr0, wr0 + 128, wid, fr, fq, acc, ss);
    const float rs = SS ? rsqrtf(ss * (1.0f / DM) + EPS) : 1.0f;
    float h[4];
#pragma unroll
    for (int e = 0; e < 4; ++e) h[e] = silu(acc[0][e] * rs) * (acc[1][e] * rs);
    u32x2 w; w.x = cvt_pk(h[0], h[1]); w.y = cvt_pk(h[2], h[3]);
    *(u32x2*)(H + (size_t)(MPR + 16 * wid + fr) * DFF + j0 + 4 * fq) = w;
}
template <bool OUTF32> __device__ __forceinline__ void sk_ffn_out(const bf16_t* Hb, const bf16_t* Wt, const float* resf, float* outf, bf16_t* outb, int slab, int wid, int fr, int fq) {
    f32x4 acc[1]; float ss;
    skinny_mm<1, false>(Hb + (size_t)MPR * DFF, DFF, Wt, DFF, 16 * slab, 0, wid, fr, fq, acc, ss);
    const int rl = 16 * wid + fr, c = 16 * slab + 4 * fq;
    const f32x4 v = *(const f32x4*)(resf + (size_t)rl * DM + c) + acc[0] * 0.5f;
    if (OUTF32) *(f32x4*)(outf + (size_t)rl * DM + c) = v;
    else { u32x2 w; w.x = cvt_pk(v[0], v[1]); w.y = cvt_pk(v[2], v[3]); *(u32x2*)(outb + (size_t)rl * DM + c) = w; }
}
__device__ __forceinline__ void sk_inproj(const bf16_t* X, const bf16_t* Wt, bf16_t* P, float* gba, int slab, int wid, int fr, int fq) {
    const int n0 = 32 * slab; f32x4 acc[2]; float ss;
    skinny_mm<2, true>(X + (size_t)MPR * DM, DM, Wt, DM, n0, n0 + 16, wid, fr, fq, acc, ss);
    const float rs = rsqrtf(ss * (1.0f / DM) + EPS); const int r = MPR + 16 * wid + fr;
    if (n0 < PW) {
#pragma unroll
        for (int nt = 0; nt < 2; ++nt) { const f32x4 v = acc[nt] * rs; u32x2 w; w.x = cvt_pk(v[0], v[1]); w.y = cvt_pk(v[2], v[3]); *(u32x2*)(P + (size_t)r * PW + n0 + 16 * nt + 4 * fq) = w; }
    } else if (fq < 2) *(f32x4*)(gba + (size_t)r * 8 + 4 * fq) = acc[0] * rs;
}
__device__ __forceinline__ void sk_outproj(const bf16_t* Pm, const bf16_t* Wt, const bf16_t* X1b, float* X2f, bf16_t* X2b, int slab, int wid, int fr, int fq) {
    const int n0 = 32 * slab; f32x4 acc[2]; float ss;
    skinny_mm<2, false>(Pm + (size_t)MPR * PW, PW, Wt, DM, n0, n0 + 16, wid, fr, fq, acc, ss);
    const int r = MPR + 16 * wid + fr;
#pragma unroll
    for (int nt = 0; nt < 2; ++nt) { const int c = n0 + 16 * nt + 4 * fq; const u32x2 xr = *(const u32x2*)(X1b + (size_t)r * DM + c);
        const f32x4 v = (f32x4){bflo(xr.x), bfhi(xr.x), bflo(xr.y), bfhi(xr.y)} + acc[nt];
        *(f32x4*)(X2f + (size_t)r * DM + c) = v; u32x2 w; w.x = cvt_pk(v[0], v[1]); w.y = cvt_pk(v[2], v[3]); *(u32x2*)(X2b + (size_t)r * DM + c) = w; }
}

__device__ __forceinline__ void transpose_item(const float* W, int K, int N, bf16_t* WT, int k0, int n0, int drow0, const float* gs, LAS float* scr, int lane) {
#pragma unroll 8
    for (int i = 0; i < 32; ++i) { const int kk = 2 * i + (lane >> 5), n = n0 + (lane & 31);
        float v = (n < N) ? W[(size_t)(k0 + kk) * N + n] : 0.f; if (gs) v *= gs[k0 + kk];
        scr[kk * 33 + (lane & 31)] = v; }
    asm volatile("s_waitcnt lgkmcnt(0)" ::: "memory");
    const int c = lane & 7;
#pragma unroll
    for (int j = 0; j < 4; ++j) { const int nn = (lane >> 3) + 8 * j; const LAS float* s = scr + (8 * c) * 33 + nn;
        u32x4 o; o.x = cvt_pk(s[0 * 33], s[1 * 33]); o.y = cvt_pk(s[2 * 33], s[3 * 33]); o.z = cvt_pk(s[4 * 33], s[5 * 33]); o.w = cvt_pk(s[6 * 33], s[7 * 33]);
        *(u32x4*)(WT + (size_t)(drow0 + nn) * K + k0 + 8 * c) = o; }
    asm volatile("s_waitcnt lgkmcnt(0)" ::: "memory");
}
__device__ __forceinline__ int map_ffin_row(int n0) { return n0 < DFF ? (n0 >> 7) * 256 + (n0 & 127) : ((n0 - DFF) >> 7) * 256 + 128 + ((n0 - DFF) & 127); }

__device__ __forceinline__ void p0_prologue(const Params& p, LAS unsigned char* lds, int vb, int G) {
    const int tid = threadIdx.x, lane = tid & 63, wid = tid >> 6;
    LAS float* scr = (LAS float*)(lds + wid * 16384);
    const int gw = vb * 8 + wid, NGW = G * 8;
    bf16_t* W1IN = (bf16_t*)(p.ws + WS_W1IN); bf16_t* W1OUT = (bf16_t*)(p.ws + WS_W1OUT); bf16_t* WINMIX = (bf16_t*)(p.ws + WS_WINMIX);
    bf16_t* WOUTMIX = (bf16_t*)(p.ws + WS_WOUTMIX); bf16_t* W2IN = (bf16_t*)(p.ws + WS_W2IN); bf16_t* W2OUT = (bf16_t*)(p.ws + WS_W2OUT);
    constexpr int I_FIN = 16 * 176, I_FOUT = 44 * 32, I_INMIX = 16 * 89, I_OUTMIX = 16 * 32;
    constexpr int NITEMS = 2 * I_FIN + 2 * I_FOUT + I_INMIX + I_OUTMIX;
    for (int it = gw; it < NITEMS; it += NGW) {
        int r = it;
        if (r < I_FIN) { const int kb = r / 176, nb = r % 176; transpose_item(p.in[7], DM, 2 * DFF, W1IN, kb * 64, nb * 32, map_ffin_row(nb * 32), nullptr, scr, lane); continue; } r -= I_FIN;
        if (r < I_FIN) { const int kb = r / 176, nb = r % 176; transpose_item(p.in[18], DM, 2 * DFF, W2IN, kb * 64, nb * 32, map_ffin_row(nb * 32), p.in[17], scr, lane); continue; } r -= I_FIN;
        if (r < I_FOUT) { const int kb = r / 32, nb = r % 32; transpose_item(p.in[8], DFF, DM, W1OUT, kb * 64, nb * 32, nb * 32, nullptr, scr, lane); continue; } r -= I_FOUT;
        if (r < I_FOUT) { const int kb = r / 32, nb = r % 32; transpose_item(p.in[19], DFF, DM, W2OUT, kb * 64, nb * 32, nb * 32, nullptr, scr, lane); continue; } r -= I_FOUT;
        if (r < I_INMIX) { const int kb = r / 89, nb = r % 89; transpose_item(p.in[10], DM, 2824, WINMIX, kb * 64, nb * 32, nb * 32, p.in[9], scr, lane); continue; } r -= I_INMIX;
        { const int kb = r / 32, nb = r % 32; transpose_item(p.in[16], DM, DM, WOUTMIX, kb * 64, nb * 32, nb * 32, nullptr, scr, lane); }
    }
    bf16_t* XN = (bf16_t*)(p.ws + WS_XN); const float* g1 = p.in[6];
    f32x4 gv[4];
#pragma unroll
    for (int j = 0; j < 4; ++j) gv[j] = *((const f32x4*)g1 + lane + 64 * j);
    for (int m = gw; m < MPAD; m += NGW) {
        unsigned long long* o8 = (unsigned long long*)(XN + (size_t)m * DM) + lane;
        if (m >= MREAL) {
#pragma unroll
            for (int j = 0; j < 4; ++j) o8[64 * j] = 0ull;
            continue; }
        const float* xrow = (m < MPR) ? p.in[0] + (size_t)m * DM : p.in[1] + (size_t)(m - MPR) * DM;
        const f32x4* xr = (const f32x4*)xrow + lane;
        f32x4 v[4]; float s = 0.f;
#pragma unroll
        for (int j = 0; j < 4; ++j) { v[j] = xr[64 * j]; s += (v[j][0] * v[j][0] + v[j][1] * v[j][1]) + (v[j][2] * v[j][2] + v[j][3] * v[j][3]); }
        const float rstd = rsqrtf(wave_sum(s) * (1.0f / DM) + EPS);
#pragma unroll
        for (int j = 0; j < 4; ++j) { const f32x4 y = v[j] * rstd * gv[j];
            o8[64 * j] = (unsigned long long)cvt_pk(y[0], y[1]) | ((unsigned long long)cvt_pk(y[2], y[3]) << 32); }
    }
}

__device__ __forceinline__ f32x4 tile_mm(const LAS bf16_t* X, int ldx, int mt, const LAS bf16_t* Y, int ldy, int nt, int nks, int fr, int fq) {
    f32x4 acc = (f32x4){0.f, 0.f, 0.f, 0.f};
    const LAS bf16_t* xp = X + (16 * mt + fr) * ldx + 8 * fq; const LAS bf16_t* yp = Y + (16 * nt + fr) * ldy + 8 * fq;
    for (int ks = 0; ks < nks; ++ks) acc = mfma16(*(const LAS bf16x8*)(xp + 32 * ks), *(const LAS bf16x8*)(yp + 32 * ks), acc);
    return acc;
}
constexpr int G1_QS = 0, G1_KS = 17408, G1_VBT = 34816, G1_KBT = 53248, G1_KDT = 71680, G1_UT = 90112, G1_WT = 108544, G1_QK = 126976, G1_TB = 136192, G1_GC = 145408, G1_BETA = 145664;

__device__ __forceinline__ void gdn_prep_unit(const Params& p, LAS unsigned char* lds, int unit) {
    const int tid = threadIdx.x, lane = tid & 63, wid = tid >> 6, fr = lane & 15, fq = lane >> 4;
    const int bh = unit >> 7, n = unit & 127, b = bh >> 2, h = bh & 3;
    const int tok0 = b * SEQ + n * 64;
    LAS bf16_t* Qs = (LAS bf16_t*)(lds + G1_QS); LAS bf16_t* Ks = (LAS bf16_t*)(lds + G1_KS); LAS bf16_t* VbT = (LAS bf16_t*)(lds + G1_VBT);
    LAS bf16_t* KbT = (LAS bf16_t*)(lds + G1_KBT); LAS bf16_t* KdT = (LAS bf16_t*)(lds + G1_KDT); LAS bf16_t* UT = (LAS bf16_t*)(lds + G1_UT);
    LAS bf16_t* WT = (LAS bf16_t*)(lds + G1_WT); LAS float* Af = (LAS float*)(lds + G1_WT); LAS bf16_t* QK = (LAS bf16_t*)(lds + G1_QK);
    LAS bf16_t* Tb = (LAS bf16_t*)(lds + G1_TB); LAS float* gcs = (LAS float*)(lds + G1_GC); LAS float* betas = (LAS float*)(lds + G1_BETA);
    const bf16_t* PB = (const bf16_t*)(p.ws + WS_H); const float* GBA = (const float*)(p.ws + WS_GBA);
    LAS unsigned char* raw = lds + G1_UT;
    for (int pc4 = wid; pc4 < 51; pc4 += 8) {
        int pc = pc4 * 4 + (lane >> 4); pc = pc < 200 ? pc : 200;
        const int r = pc / 3, seg = pc - 3 * r; int tt = n * 64 - 3 + r; tt = tt < 0 ? 0 : tt;
        __builtin_amdgcn_global_load_lds((const unsigned*)(PB + (size_t)(b * SEQ + tt) * PW + 768 + seg * 512 + h * 128 + (lane & 15) * 8), (LAS unsigned*)(raw + pc4 * 1024), 16, 0, 0);
    }
    if (tid < 64) {
        const float* gb = GBA + (size_t)(tok0 + tid) * 8;
        const float bt = 1.0f / (1.0f + __expf(-gb[h]));
        const float x = gb[4 + h] + p.in[14][h]; const float sp = x > 20.f ? x : log1pf(__expf(x));
        float c = -__expf(p.in[13][h]) * sp;
#pragma unroll
        for (int o = 1; o < 64; o <<= 1) { const float t = __shfl_up(c, o); if (lane >= o) c += t; }
        gcs[tid] = c; betas[tid] = bt;
    }
    asm volatile("s_waitcnt vmcnt(0)" ::: "memory");
    __syncthreads();
    const float gclast = gcs[63];
    const float* cw = p.in[12];
#pragma unroll 1
    for (int it = 0; it < 6; ++it) {
        const int item = tid + 512 * it, l16 = item & 15, row = item >> 4, which = row >> 6, t = row & 63;
        const int cch = which * 512 + h * 128 + l16 * 8;
        float a[8];
#pragma unroll
        for (int e = 0; e < 8; ++e) a[e] = 0.f;
#pragma unroll
        for (int j = 0; j < 4; ++j) {
            const int tt = n * 64 + t - 3 + j;
            if (tt >= 0) {
                const u32x4 xv = *(const LAS u32x4*)(raw + ((t + j) * 3 + which) * 256 + l16 * 16);
                const f32x4 w0 = *(const f32x4*)(cw + j * CONVC + cch), w1 = *(const f32x4*)(cw + j * CONVC + cch + 4);
                a[0] += w0[0] * bflo(xv.x); a[1] += w0[1] * bfhi(xv.x); a[2] += w0[2] * bflo(xv.y); a[3] += w0[3] * bfhi(xv.y);
                a[4] += w1[0] * bflo(xv.z); a[5] += w1[1] * bfhi(xv.z); a[6] += w1[2] * bflo(xv.w); a[7] += w1[3] * bfhi(xv.w);
            }
        }
        float ss = 0.f;
#pragma unroll
        for (int e = 0; e < 8; ++e) { a[e] = silu(a[e]); ss += a[e] * a[e]; }
        ss += __shfl_xor(ss, 1); ss += __shfl_xor(ss, 2); ss += __shfl_xor(ss, 4); ss += __shfl_xor(ss, 8);
        const float gct = gcs[t], bt = betas[t];
        if (which == 0) {
            const float sc = rsqrtf(ss + EPS) * 0.08838834764831845f;
            u32x4 w; w.x = cvt_pk(a[0] * sc, a[1] * sc); w.y = cvt_pk(a[2] * sc, a[3] * sc); w.z = cvt_pk(a[4] * sc, a[5] * sc); w.w = cvt_pk(a[6] * sc, a[7] * sc);
            *(LAS u32x4*)(Qs + t * 136 + l16 * 8) = w;
        } else if (which == 1) {
            const float sc = rsqrtf(ss + EPS);
            u32x4 w; w.x = cvt_pk(a[0] * sc, a[1] * sc); w.y = cvt_pk(a[2] * sc, a[3] * sc); w.z = cvt_pk(a[4] * sc, a[5] * sc); w.w = cvt_pk(a[6] * sc, a[7] * sc);
            *(LAS u32x4*)(Ks + t * 136 + l16 * 8) = w;
            const float sb = sc * bt * __expf(gct), sd = sc * __expf(gclast - gct);
#pragma unroll
            for (int e = 0; e < 8; ++e) { KbT[(l16 * 8 + e) * 72 + t] = f2bf(a[e] * sb); KdT[(l16 * 8 + e) * 72 + t] = f2bf(a[e] * sd); }
        } else {
#pragma unroll
            for (int e = 0; e < 8; ++e) VbT[(l16 * 8 + e) * 72 + t] = f2bf(a[e] * bt);
        }
    }
    __syncthreads();
#pragma unroll 2
    for (int r = 0; r < 4; ++r) {
        const int job = wid + 8 * r, kind = job >> 4, tile = job & 15, it = tile >> 2, jt = tile & 3;
        if (kind == 0) {
            if (jt > it) continue;
            const f32x4 acc = tile_mm(Ks, 136, it, Ks, 136, jt, 4, fr, fq);
            const int j = 16 * jt + fr; const float gcj = gcs[j];
            float v[4];
#pragma unroll
            for (int e = 0; e < 4; ++e) { const int i = 16 * it + 4 * fq + e; const bool ok = i > j; v[e] = ok ? acc[e] * __expf(gcs[i] - gcj) * betas[i] : 0.f; }
            *(LAS f32x4*)(Af + j * 68 + 16 * it + 4 * fq) = (f32x4){v[0], v[1], v[2], v[3]};
        } else {
            const f32x4 acc = tile_mm(Ks, 136, jt, Qs, 136, it, 4, fr, fq);
            const int i = 16 * it + fr; const float gci = gcs[i];
            float v[4];
#pragma unroll
            for (int e = 0; e < 4; ++e) { const int j = 16 * jt + 4 * fq + e; const bool ok = i >= j; v[e] = ok ? acc[e] * __expf(gci - gcs[j]) : 0.f; }
            u32x2 w; w.x = cvt_pk(v[0], v[1]); w.y = cvt_pk(v[2], v[3]); *(LAS u32x2*)(QK + i * 72 + 16 * jt + 4 * fq) = w;
        }
    }
    __syncthreads();
    if (wid == 0) {
        f32x2v r2[32];
#pragma unroll
        for (int k = 0; k < 32; ++k) r2[k] = (f32x2v){(lane == 2 * k) ? 1.0f : 0.0f, (lane == 2 * k + 1) ? 1.0f : 0.0f};
        const f32x4 a0 = *(const LAS f32x4*)(Af + 0);
        const f32x4 a1 = *(const LAS f32x4*)(Af + 4);
        const f32x4 a2 = *(const LAS f32x4*)(Af + 8);
        const f32x4 a3 = *(const LAS f32x4*)(Af + 12);
        const f32x4 a4 = *(const LAS f32x4*)(Af + 16);
        const float t0 = r2[0][0]; const f32x2v T0 = (f32x2v){t0, t0}; Tb[0 + lane] = f2bf(t0);
        r2[0] -= (f32x2v){a0[0], a0[1]} * T0; r2[1] -= (f32x2v){a0[2], a0[3]} * T0;
        const f32x4 a5 = *(const LAS f32x4*)(Af + 20);
        r2[2] -= (f32x2v){a1[0], a1[1]} * T0; r2[3] -= (f32x2v){a1[2], a1[3]} * T0;
        const f32x4 a6 = *(const LAS f32x4*)(Af + 24);
        r2[4] -= (f32x2v){a2[0], a2[1]} * T0; r2[5] -= (f32x2v){a2[2], a2[3]} * T0;
        const f32x4 a7 = *(const LAS f32x4*)(Af + 28);
        r2[6] -= (f32x2v){a3[0], a3[1]} * T0; r2[7] -= (f32x2v){a3[2], a3[3]} * T0;
        const f32x4 a8 = *(const LAS f32x4*)(Af + 32);
        r2[8] -= (f32x2v){a4[0], a4[1]} * T0; r2[9] -= (f32x2v){a4[2], a4[3]} * T0;
        const f32x4 a9 = *(const LAS f32x4*)(Af + 36);
        r2[10] -= (f32x2v){a5[0], a5[1]} * T0; r2[11] -= (f32x2v){a5[2], a5[3]} * T0;
        const f32x4 a10 = *(const LAS f32x4*)(Af + 40);
        r2[12] -= (f32x2v){a6[0], a6[1]} * T0; r2[13] -= (f32x2v){a6[2], a6[3]} * T0;
        const f32x4 a11 = *(const LAS f32x4*)(Af + 44);
        r2[14] -= (f32x2v){a7[0], a7[1]} * T0; r2[15] -= (f32x2v){a7[2], a7[3]} * T0;
        const f32x4 a12 = *(const LAS f32x4*)(Af + 48);
        r2[16] -= (f32x2v){a8[0], a8[1]} * T0; r2[17] -= (f32x2v){a8[2], a8[3]} * T0;
        const f32x4 a13 = *(const LAS f32x4*)(Af + 52);
        r2[18] -= (f32x2v){a9[0], a9[1]} * T0; r2[19] -= (f32x2v){a9[2], a9[3]} * T0;
        const f32x4 a14 = *(const LAS f32x4*)(Af + 56);
        r2[20] -= (f32x2v){a10[0], a10[1]} * T0; r2[21] -= (f32x2v){a10[2], a10[3]} * T0;
        const f32x4 a15 = *(const LAS f32x4*)(Af + 60);
        r2[22] -= (f32x2v){a11[0], a11[1]} * T0; r2[23] -= (f32x2v){a11[2], a11[3]} * T0;
        const f32x4 a16 = *(const LAS f32x4*)(Af + 68);
        r2[24] -= (f32x2v){a12[0], a12[1]} * T0; r2[25] -= (f32x2v){a12[2], a12[3]} * T0;
        const f32x4 a17 = *(const LAS f32x4*)(Af + 72);
        r2[26] -= (f32x2v){a13[0], a13[1]} * T0; r2[27] -= (f32x2v){a13[2], a13[3]} * T0;
        const f32x4 a18 = *(const LAS f32x4*)(Af + 76);
        r2[28] -= (f32x2v){a14[0], a14[1]} * T0; r2[29] -= (f32x2v){a14[2], a14[3]} * T0;
        const f32x4 a19 = *(const LAS f32x4*)(Af + 80);
        r2[30] -= (f32x2v){a15[0], a15[1]} * T0; r2[31] -= (f32x2v){a15[2], a15[3]} * T0;
        const f32x4 a20 = *(const LAS f32x4*)(Af + 84);
        const float t1 = r2[0][1]; const f32x2v T1 = (f32x2v){t1, t1}; Tb[72 + lane] = f2bf(t1);
        r2[1] -= (f32x2v){a16[2], a16[3]} * T1;
        const f32x4 a21 = *(const LAS f32x4*)(Af + 88);
        r2[2] -= (f32x2v){a17[0], a17[1]} * T1; r2[3] -= (f32x2v){a17[2], a17[3]} * T1;
        const f32x4 a22 = *(const LAS f32x4*)(Af + 92);
        r2[4] -= (f32x2v){a18[0], a18[1]} * T1; r2[5] -= (f32x2v){a18[2], a18[3]} * T1;
        const f32x4 a23 = *(const LAS f32x4*)(Af + 96);
        r2[6] -= (f32x2v){a19[0], a19[1]} * T1; r2[7] -= (f32x2v){a19[2], a19[3]} * T1;
        const f32x4 a24 = *(const LAS f32x4*)(Af + 100);
        r2[8] -= (f32x2v){a20[0], a20[1]} * T1; r2[9] -= (f32x2v){a20[2], a20[3]} * T1;
        const f32x4 a25 = *(const LAS f32x4*)(Af + 104);
        r2[10] -= (f32x2v){a21[0], a21[1]} * T1; r2[11] -= (f32x2v){a21[2], a21[3]} * T1;
        const f32x4 a26 = *(const LAS f32x4*)(Af + 108);
        r2[12] -= (f32x2v){a22[0], a22[1]} * T1; r2[13] -= (f32x2v){a22[2], a22[3]} * T1;
        const f32x4 a27 = *(const LAS f32x4*)(Af + 112);
        r2[14] -= (f32x2v){a23[0], a23[1]} * T1; r2[15] -= (f32x2v){a23[2], a23[3]} * T1;
        const f32x4 a28 = *(const LAS f32x4*)(Af + 116);
        r2[16] -= (f32x2v){a24[0], a24[1]} * T1; r2[17] -= (f32x2v){a24[2], a24[3]} * T1;
        const f32x4 a29 = *(const LAS f32x4*)(Af + 120);
        r2[18] -= (f32x2v){a25[0], a25[1]} * T1; r2[19] -= (f32x2v){a25[2], a25[3]} * T1;
        const f32x4 a30 = *(const LAS f32x4*)(Af + 124);
        r2[20] -= (f32x2v){a26[0], a26[1]} * T1; r2[21] -= (f32x2v){a26[2], a26[3]} * T1;
        const f32x4 a31 = *(const LAS f32x4*)(Af + 128);
        r2[22] -= (f32x2v){a27[0], a27[1]} * T1; r2[23] -= (f32x2v){a27[2], a27[3]} * T1;
        const f32x4 a32 = *(const LAS f32x4*)(Af + 136);
        r2[24] -= (f32x2v){a28[0], a28[1]} * T1; r2[25] -= (f32x2v){a28[2], a28[3]} * T1;
        const f32x4 a33 = *(const LAS f32x4*)(Af + 140);
        r2[26] -= (f32x2v){a29[0], a29[1]} * T1; r2[27] -= (f32x2v){a29[2], a29[3]} * T1;
        const f32x4 a34 = *(const LAS f32x4*)(Af + 144);
        r2[28] -= (f32x2v){a30[0], a30[1]} * T1; r2[29] -= (f32x2v){a30[2], a30[3]} * T1;
        const f32x4 a35 = *(const LAS f32x4*)(Af + 148);
        r2[30] -= (f32x2v){a31[0], a31[1]} * T1; r2[31] -= (f32x2v){a31[2], a31[3]} * T1;
        const f32x4 a36 = *(const LAS f32x4*)(Af + 152);
        const float t2 = r2[1][0]; const f32x2v T2 = (f32x2v){t2, t2}; Tb[144 + lane] = f2bf(t2);
        r2[1] -= (f32x2v){a32[2], a32[3]} * T2;
        const f32x4 a37 = *(const LAS f32x4*)(Af + 156);
        r2[2] -= (f32x2v){a33[0], a33[1]} * T2; r2[3] -= (f32x2v){a33[2], a33[3]} * T2;
        const f32x4 a38 = *(const LAS f32x4*)(Af + 160);
        r2[4] -= (f32x2v){a34[0], a34[1]} * T2; r2[5] -= (f32x2v){a34[2], a34[3]} * T2;
        const f32x4 a39 = *(const LAS f32x4*)(Af + 164);
        r2[6] -= (f32x2v){a35[0], a35[1]} * T2; r2[7] -= (f32x2v){a35[2], a35[3]} * T2;
        const f32x4 a40 = *(const LAS f32x4*)(Af + 168);
        r2[8] -= (f32x2v){a36[0], a36[1]} * T2; r2[9] -= (f32x2v){a36[2], a36[3]} * T2;
        const f32x4 a41 = *(const LAS f32x4*)(Af + 172);
        r2[10] -= (f32x2v){a37[0], a37[1]} * T2; r2[11] -= (f32x2v){a37[2], a37[3]} * T2;
        const f32x4 a42 = *(const LAS f32x4*)(Af + 176);
        r2[12] -= (f32x2v){a38[0], a38[1]} * T2; r2[13] -= (f32x2v){a38[2], a38[3]} * T2;
        const f32x4 a43 = *(const LAS f32x4*)(Af + 180);
        r2[14] -= (f32x2v){a39[0], a39[1]} * T2; r2[15] -= (f32x2v){a39[2], a39[3]} * T2;
        const f32x4 a44 = *(const LAS f32x4*)(Af + 184);
        r2[16] -= (f32x2v){a40[0], a40[1]} * T2; r2[17] -= (f32x2v){a40[2], a40[3]} * T2;
        const f32x4 a45 = *(const LAS f32x4*)(Af + 188);
        r2[18] -= (f32x2v){a41[0], a41[1]} * T2; r2[19] -= (f32x2v){a41[2], a41[3]} * T2;
        const f32x4 a46 = *(const LAS f32x4*)(Af + 192);
        r2[20] -= (f32x2v){a42[0], a42[1]} * T2; r2[21] -= (f32x2v){a42[2], a42[3]} * T2;
        const f32x4 a47 = *(const LAS f32x4*)(Af + 196);
        r2[22] -= (f32x2v){a43[0], a43[1]} * T2; r2[23] -= (f32x2v){a43[2], a43[3]} * T2;
        const f32x4 a48 = *(const LAS f32x4*)(Af + 208);
        r2[24] -= (f32x2v){a44[0], a44[1]} * T2; r2[25] -= (f32x2v){a44[2], a44[3]} * T2;
        const f32x4 a49 = *(const LAS f32x4*)(Af + 212);
        r2[26] -= (f32x2v){a45[0], a45[1]} * T2; r2[27] -= (f32x2v){a45[2], a45[3]} * T2;
        const f32x4 a50 = *(const LAS f32x4*)(Af + 216);
        r2[28] -= (f32x2v){a46[0], a46[1]} * T2; r2[29] -= (f32x2v){a46[2], a46[3]} * T2;
        const f32x4 a51 = *(const LAS f32x4*)(Af + 220);
        r2[30] -= (f32x2v){a47[0], a47[1]} * T2; r2[31] -= (f32x2v){a47[2], a47[3]} * T2;
        const f32x4 a52 = *(const LAS f32x4*)(Af + 224);
        const float t3 = r2[1][1]; const f32x2v T3 = (f32x2v){t3, t3}; Tb[216 + lane] = f2bf(t3);
        r2[2] -= (f32x2v){a48[0], a48[1]} * T3; r2[3] -= (f32x2v){a48[2], a48[3]} * T3;
        const f32x4 a53 = *(const LAS f32x4*)(Af + 228);
        r2[4] -= (f32x2v){a49[0], a49[1]} * T3; r2[5] -= (f32x2v){a49[2], a49[3]} * T3;
        const f32x4 a54 = *(const LAS f32x4*)(Af + 232);
        r2[6] -= (f32x2v){a50[0], a50[1]} * T3; r2[7] -= (f32x2v){a50[2], a50[3]} * T3;
        const f32x4 a55 = *(const LAS f32x4*)(Af + 236);
        r2[8] -= (f32x2v){a51[0], a51[1]} * T3; r2[9] -= (f32x2v){a51[2], a51[3]} * T3;
        const f32x4 a56 = *(const LAS f32x4*)(Af + 240);
        r2[10] -= (f32x2v){a52[0], a52[1]} * T3; r2[11] -= (f32x2v){a52[2], a52[3]} * T3;
        const f32x4 a57 = *(const LAS f32x4*)(Af + 244);
        r2[12] -= (f32x2v){a53[0], a53[1]} * T3; r2[13] -= (f32x2v){a53[2], a53[3]} * T3;
        const f32x4 a58 = *(const LAS f32x4*)(Af + 248);
        r2[14] -= (f32x2v){a54[0], a54[1]} * T3; r2[15] -= (f32x2v){a54[2], a54[3]} * T3;
        const f32x4 a59 = *(const LAS f32x4*)(Af + 252);
        r2[16] -= (f32x2v){a55[0], a55[1]} * T3; r2[17] -= (f32x2v){a55[2], a55[3]} * T3;
        const f32x4 a60 = *(const LAS f32x4*)(Af + 256);
        r2[18] -= (f32x2v){a56[0], a56[1]} * T3; r2[19] -= (f32x2v){a56[2], a56[3]} * T3;
        const f32x4 a61 = *(const LAS f32x4*)(Af + 260);
        r2[20] -= (f32x2v){a57[0], a57[1]} * T3; r2[21] -= (f32x2v){a57[2], a57[3]} * T3;
        const f32x4 a62 = *(const LAS f32x4*)(Af + 264);
        r2[22] -= (f32x2v){a58[0], a58[1]} * T3; r2[23] -= (f32x2v){a58[2], a58[3]} * T3;
        const f32x4 a63 = *(const LAS f32x4*)(Af + 276);
        r2[24] -= (f32x2v){a59[0], a59[1]} * T3; r2[25] -= (f32x2v){a59[2], a59[3]} * T3;
        const f32x4 a64 = *(const LAS f32x4*)(Af + 280);
        r2[26] -= (f32x2v){a60[0], a60[1]} * T3; r2[27] -= (f32x2v){a60[2], a60[3]} * T3;
        const f32x4 a65 = *(const LAS f32x4*)(Af + 284);
        r2[28] -= (f32x2v){a61[0], a61[1]} * T3; r2[29] -= (f32x2v){a61[2], a61[3]} * T3;
        const f32x4 a66 = *(const LAS f32x4*)(Af + 288);
        r2[30] -= (f32x2v){a62[0], a62[1]} * T3; r2[31] -= (f32x2v){a62[2], a62[3]} * T3;
        const f32x4 a67 = *(const LAS f32x4*)(Af + 292);
        const float t4 = r2[2][0]; const f32x2v T4 = (f32x2v){t4, t4}; Tb[288 + lane] = f2bf(t4);
        r2[2] -= (f32x2v){a63[0], a63[1]} * T4; r2[3] -= (f32x2v){a63[2], a63[3]} * T4;
        const f32x4 a68 = *(const LAS f32x4*)(Af + 296);
        r2[4] -= (f32x2v){a64[0], a64[1]} * T4; r2[5] -= (f32x2v){a64[2], a64[3]} * T4;
        const f32x4 a69 = *(const LAS f32x4*)(Af + 300);
        r2[6] -= (f32x2v){a65[0], a65[1]} * T4; r2[7] -= (f32x2v){a65[2], a65[3]} * T4;
        const f32x4 a70 = *(const LAS f32x4*)(Af + 304);
        r2[8] -= (f32x2v){a66[0], a66[1]} * T4; r2[9] -= (f32x2v){a66[2], a66[3]} * T4;
        const f32x4 a71 = *(const LAS f32x4*)(Af + 308);
        r2[10] -= (f32x2v){a67[0], a67[1]} * T4; r2[11] -= (f32x2v){a67[2], a67[3]} * T4;
        const f32x4 a72 = *(const LAS f32x4*)(Af + 312);
        r2[12] -= (f32x2v){a68[0], a68[1]} * T4; r2[13] -= (f32x2v){a68[2], a68[3]} * T4;
        const f32x4 a73 = *(const LAS f32x4*)(Af + 316);
        r2[14] -= (f32x2v){a69[0], a69[1]} * T4; r2[15] -= (f32x2v){a69[2], a69[3]} * T4;
        const f32x4 a74 = *(const LAS f32x4*)(Af + 320);
        r2[16] -= (f32x2v){a70[0], a70[1]} * T4; r2[17] -= (f32x2v){a70[2], a70[3]} * T4;
        const f32x4 a75 = *(const LAS f32x4*)(Af + 324);
        r2[18] -= (f32x2v){a71[0], a71[1]} * T4; r2[19] -= (f32x2v){a71[2], a71[3]} * T4;
        const f32x4 a76 = *(const LAS f32x4*)(Af + 328);
        r2[20] -= (f32x2v){a72[0], a72[1]} * T4; r2[21] -= (f32x2v){a72[2], a72[3]} * T4;
        const f32x4 a77 = *(const LAS f32x4*)(Af + 332);
        r2[22] -= (f32x2v){a73[0], a73[1]} * T4; r2[23] -= (f32x2v){a73[2], a73[3]} * T4;
        const f32x4 a78 = *(const LAS f32x4*)(Af + 344);
        r2[24] -= (f32x2v){a74[0], a74[1]} * T4; r2[25] -= (f32x2v){a74[2], a74[3]} * T4;
        const f32x4 a79 = *(const LAS f32x4*)(Af + 348);
        r2[26] -= (f32x2v){a75[0], a75[1]} * T4; r2[27] -= (f32x2v){a75[2], a75[3]} * T4;
        const f32x4 a80 = *(const LAS f32x4*)(Af + 352);
        r2[28] -= (f32x2v){a76[0], a76[1]} * T4; r2[29] -= (f32x2v){a76[2], a76[3]} * T4;
        const f32x4 a81 = *(const LAS f32x4*)(Af + 356);
        r2[30] -= (f32x2v){a77[0], a77[1]} * T4; r2[31] -= (f32x2v){a77[2], a77[3]} * T4;
        const f32x4 a82 = *(const LAS f32x4*)(Af + 360);
        const float t5 = r2[2][1]; const f32x2v T5 = (f32x2v){t5, t5}; Tb[360 + lane] = f2bf(t5);
        r2[3] -= (f32x2v){a78[2], a78[3]} * T5;
        const f32x4 a83 = *(const LAS f32x4*)(Af + 364);
        r2[4] -= (f32x2v){a79[0], a79[1]} * T5; r2[5] -= (f32x2v){a79[2], a79[3]} * T5;
        const f32x4 a84 = *(const LAS f32x4*)(Af + 368);
        r2[6] -= (f32x2v){a80[0], a80[1]} * T5; r2[7] -= (f32x2v){a80[2], a80[3]} * T5;
        const f32x4 a85 = *(const LAS f32x4*)(Af + 372);
        r2[8] -= (f32x2v){a81[0], a81[1]} * T5; r2[9] -= (f32x2v){a81[2], a81[3]} * T5;
        const f32x4 a86 = *(const LAS f32x4*)(Af + 376);
        r2[10] -= (f32x2v){a82[0], a82[1]} * T5; r2[11] -= (f32x2v){a82[2], a82[3]} * T5;
        const f32x4 a87 = *(const LAS f32x4*)(Af + 380);
        r2[12] -= (f32x2v){a83[0], a83[1]} * T5; r2[13] -= (f32x2v){a83[2], a83[3]} * T5;
        const f32x4 a88 = *(const LAS f32x4*)(Af + 384);
        r2[14] -= (f32x2v){a84[0], a84[1]} * T5; r2[15] -= (f32x2v){a84[2], a84[3]} * T5;
        const f32x4 a89 = *(const LAS f32x4*)(Af + 388);
        r2[16] -= (f32x2v){a85[0], a85[1]} * T5; r2[17] -= (f32x2v){a85[2], a85[3]} * T5;
        const f32x4 a90 = *(const LAS f32x4*)(Af + 392);
        r2[18] -= (f32x2v){a86[0], a86[1]} * T5; r2[19] -= (f32x2v){a86[2], a86[3]} * T5;
        const f32x4 a91 = *(const LAS f32x4*)(Af + 396);
        r2[20] -= (f32x2v){a87[0], a87[1]} * T5; r2[21] -= (f32x2v){a87[2], a87[3]} * T5;
        const f32x4 a92 = *(const LAS f32x4*)(Af + 400);
        r2[22] -= (f32x2v){a88[0], a88[1]} * T5; r2[23] -= (f32x2v){a88[2], a88[3]} * T5;
        const f32x4 a93 = *(const LAS f32x4*)(Af + 412);
        r2[24] -= (f32x2v){a89[0], a89[1]} * T5; r2[25] -= (f32x2v){a89[2], a89[3]} * T5;
        const f32x4 a94 = *(const LAS f32x4*)(Af + 416);
        r2[26] -= (f32x2v){a90[0], a90[1]} * T5; r2[27] -= (f32x2v){a90[2], a90[3]} * T5;
        const f32x4 a95 = *(const LAS f32x4*)(Af + 420);
        r2[28] -= (f32x2v){a91[0], a91[1]} * T5; r2[29] -= (f32x2v){a91[2], a91[3]} * T5;
        const f32x4 a96 = *(const LAS f32x4*)(Af + 424);
        r2[30] -= (f32x2v){a92[0], a92[1]} * T5; r2[31] -= (f32x2v){a92[2], a92[3]} * T5;
        const f32x4 a97 = *(const LAS f32x4*)(Af + 428);
        const float t6 = r2[3][0]; const f32x2v T6 = (f32x2v){t6, t6}; Tb[432 + lane] = f2bf(t6);
        r2[3] -= (f32x2v){a93[2], a93[3]} * T6;
        const f32x4 a98 = *(const LAS f32x4*)(Af + 432);
        r2[4] -= (f32x2v){a94[0], a94[1]} * T6; r2[5] -= (f32x2v){a94[2], a94[3]} * T6;
        const f32x4 a99 = *(const LAS f32x4*)(Af + 436);
        r2[6] -= (f32x2v){a95[0], a95[1]} * T6; r2[7] -= (f32x2v){a95[2], a95[3]} * T6;
        const f32x4 a100 = *(const LAS f32x4*)(Af + 440);
        r2[8] -= (f32x2v){a96[0], a96[1]} * T6; r2[9] -= (f32x2v){a96[2], a96[3]} * T6;
        const f32x4 a101 = *(const LAS f32x4*)(Af + 444);
        r2[10] -= (f32x2v){a97[0], a97[1]} * T6; r2[11] -= (f32x2v){a97[2], a97[3]} * T6;
        const f32x4 a102 = *(const LAS f32x4*)(Af + 448);
        r2[12] -= (f32x2v){a98[0], a98[1]} * T6; r2[13] -= (f32x2v){a98[2], a98[3]} * T6;
        const f32x4 a103 = *(const LAS f32x4*)(Af + 452);
        r2[14] -= (f32x2v){a99[0], a99[1]} * T6; r2[15] -= (f32x2v){a99[2], a99[3]} * T6;
        const f32x4 a104 = *(const LAS f32x4*)(Af + 456);
        r2[16] -= (f32x2v){a100[0], a100[1]} * T6; r2[17] -= (f32x2v){a100[2], a100[3]} * T6;
        const f32x4 a105 = *(const LAS f32x4*)(Af + 460);
        r2[18] -= (f32x2v){a101[0], a101[1]} * T6; r2[19] -= (f32x2v){a101[2], a101[3]} * T6;
        const f32x4 a106 = *(const LAS f32x4*)(Af + 464);
        r2[20] -= (f32x2v){a102[0], a102[1]} * T6; r2[21] -= (f32x2v){a102[2], a102[3]} * T6;
        const f32x4 a107 = *(const LAS f32x4*)(Af + 468);
        r2[22] -= (f32x2v){a103[0], a103[1]} * T6; r2[23] -= (f32x2v){a103[2], a103[3]} * T6;
        const f32x4 a108 = *(const LAS f32x4*)(Af + 484);
        r2[24] -= (f32x2v){a104[0], a104[1]} * T6; r2[25] -= (f32x2v){a104[2], a104[3]} * T6;
        const f32x4 a109 = *(const LAS f32x4*)(Af + 488);
        r2[26] -= (f32x2v){a105[0], a105[1]} * T6; r2[27] -= (f32x2v){a105[2], a105[3]} * T6;
        const f32x4 a110 = *(const LAS f32x4*)(Af + 492);
        r2[28] -= (f32x2v){a106[0], a106[1]} * T6; r2[29] -= (f32x2v){a106[2], a106[3]} * T6;
        const f32x4 a111 = *(const LAS f32x4*)(Af + 496);
        r2[30] -= (f32x2v){a107[0], a107[1]} * T6; r2[31] -= (f32x2v){a107[2], a107[3]} * T6;
        const f32x4 a112 = *(const LAS f32x4*)(Af + 500);
        const float t7 = r2[3][1]; const f32x2v T7 = (f32x2v){t7, t7}; Tb[504 + lane] = f2bf(t7);
        r2[4] -= (f32x2v){a108[0], a108[1]} * T7; r2[5] -= (f32x2v){a108[2], a108[3]} * T7;
        const f32x4 a113 = *(const LAS f32x4*)(Af + 504);
        r2[6] -= (f32x2v){a109[0], a109[1]} * T7; r2[7] -= (f32x2v){a109[2], a109[3]} * T7;
        const f32x4 a114 = *(const LAS f32x4*)(Af + 508);
        r2[8] -= (f32x2v){a110[0], a110[1]} * T7; r2[9] -= (f32x2v){a110[2], a110[3]} * T7;
        const f32x4 a115 = *(const LAS f32x4*)(Af + 512);
        r2[10] -= (f32x2v){a111[0], a111[1]} * T7; r2[11] -= (f32x2v){a111[2], a111[3]} * T7;
        const f32x4 a116 = *(const LAS f32x4*)(Af + 516);
        r2[12] -= (f32x2v){a112[0], a112[1]} * T7; r2[13] -= (f32x2v){a112[2], a112[3]} * T7;
        const f32x4 a117 = *(const LAS f32x4*)(Af + 520);
        r2[14] -= (f32x2v){a113[0], a113[1]} * T7; r2[15] -= (f32x2v){a113[2], a113[3]} * T7;
        const f32x4 a118 = *(const LAS f32x4*)(Af + 524);
        r2[16] -= (f32x2v){a114[0], a114[1]} * T7; r2[17] -= (f32x2v){a114[2], a114[3]} * T7;
        const f32x4 a119 = *(const LAS f32x4*)(Af + 528);
        r2[18] -= (f32x2v){a115[0], a115[1]} * T7; r2[19] -= (f32x2v){a115[2], a115[3]} * T7;
        const f32x4 a120 = *(const LAS f32x4*)(Af + 532);
        r2[20] -= (f32x2v){a116[0], a116[1]} * T7; r2[21] -= (f32x2v){a116[2], a116[3]} * T7;
        const f32x4 a121 = *(const LAS f32x4*)(Af + 536);
        r2[22] -= (f32x2v){a117[0], a117[1]} * T7; r2[23] -= (f32x2v){a117[2], a117[3]} * T7;
        const f32x4 a122 = *(const LAS f32x4*)(Af + 552);
        r2[24] -= (f32x2v){a118[0], a118[1]} * T7; r2[25] -= (f32x2v){a118[2], a118[3]} * T7;
        const f32x4 a123 = *(const LAS f32x4*)(Af + 556);
        r2[26] -= (f32x2v){a119[0], a119[1]} * T7; r2[27] -= (f32x2v){a119[2], a119[3]} * T7;
        const f32x4 a124 = *(const LAS f32x4*)(Af + 560);
        r2[28] -= (f32x2v){a120[0], a120[1]} * T7; r2[29] -= (f32x2v){a120[2], a120[3]} * T7;
        const f32x4 a125 = *(const LAS f32x4*)(Af + 564);
        r2[30] -= (f32x2v){a121[0], a121[1]} * T7; r2[31] -= (f32x2v){a121[2], a121[3]} * T7;
        const f32x4 a126 = *(const LAS f32x4*)(Af + 568);
        const float t8 = r2[4][0]; const f32x2v T8 = (f32x2v){t8, t8}; Tb[576 + lane] = f2bf(t8);
        r2[4] -= (f32x2v){a122[0], a122[1]} * T8; r2[5] -= (f32x2v){a122[2], a122[3]} * T8;
        const f32x4 a127 = *(const LAS f32x4*)(Af + 572);
        r2[6] -= (f32x2v){a123[0], a123[1]} * T8; r2[7] -= (f32x2v){a123[2], a123[3]} * T8;
        const f32x4 a128 = *(const LAS f32x4*)(Af + 576);
        r2[8] -= (f32x2v){a124[0], a124[1]} * T8; r2[9] -= (f32x2v){a124[2], a124[3]} * T8;
        const f32x4 a129 = *(const LAS f32x4*)(Af + 580);
        r2[10] -= (f32x2v){a125[0], a125[1]} * T8; r2[11] -= (f32x2v){a125[2], a125[3]} * T8;
        const f32x4 a130 = *(const LAS f32x4*)(Af + 584);
        r2[12] -= (f32x2v){a126[0], a126[1]} * T8; r2[13] -= (f32x2v){a126[2], a126[3]} * T8;
        const f32x4 a131 = *(const LAS f32x4*)(Af + 588);
        r2[14] -= (f32x2v){a127[0], a127[1]} * T8; r2[15] -= (f32x2v){a127[2], a127[3]} * T8;
        const f32x4 a132 = *(const LAS f32x4*)(Af + 592);
        r2[16] -= (f32x2v){a128[0], a128[1]} * T8; r2[17] -= (f32x2v){a128[2], a128[3]} * T8;
        const f32x4 a133 = *(const LAS f32x4*)(Af + 596);
        r2[18] -= (f32x2v){a129[0], a129[1]} * T8; r2[19] -= (f32x2v){a129[2], a129[3]} * T8;
        const f32x4 a134 = *(const LAS f32x4*)(Af + 600);
        r2[20] -= (f32x2v){a130[0], a130[1]} * T8; r2[21] -= (f32x2v){a130[2], a130[3]} * T8;
        const f32x4 a135 = *(const LAS f32x4*)(Af + 604);
        r2[22] -= (f32x2v){a131[0], a131[1]} * T8; r2[23] -= (f32x2v){a131[2], a131[3]} * T8;
        const f32x4 a136 = *(const LAS f32x4*)(Af + 620);
        r2[24] -= (f32x2v){a132[0], a132[1]} * T8; r2[25] -= (f32x2v){a132[2], a132[3]} * T8;
        const f32x4 a137 = *(const LAS f32x4*)(Af + 624);
        r2[26] -= (f32x2v){a133[0], a133[1]} * T8; r2[27] -= (f32x2v){a133[2], a133[3]} * T8;
        const f32x4 a138 = *(const LAS f32x4*)(Af + 628);
        r2[28] -= (f32x2v){a134[0], a134[1]} * T8; r2[29] -= (f32x2v){a134[2], a134[3]} * T8;
        const f32x4 a139 = *(const LAS f32x4*)(Af + 632);
        r2[30] -= (f32x2v){a135[0], a135[1]} * T8; r2[31] -= (f32x2v){a135[2], a135[3]} * T8;
        const f32x4 a140 = *(const LAS f32x4*)(Af + 636);
        const float t9 = r2[4][1]; const f32x2v T9 = (f32x2v){t9, t9}; Tb[648 + lane] = f2bf(t9);
        r2[5] -= (f32x2v){a136[2], a136[3]} * T9;
        const f32x4 a141 = *(const LAS f32x4*)(Af + 640);
        r2[6] -= (f32x2v){a137[0], a137[1]} * T9; r2[7] -= (f32x2v){a137[2], a137[3]} * T9;
        const f32x4 a142 = *(const LAS f32x4*)(Af + 644);
        r2[8] -= (f32x2v){a138[0], a138[1]} * T9; r2[9] -= (f32x2v){a138[2], a138[3]} * T9;
        const f32x4 a143 = *(const LAS f32x4*)(Af + 648);
        r2[10] -= (f32x2v){a139[0], a139[1]} * T9; r2[11] -= (f32x2v){a139[2], a139[3]} * T9;
        const f32x4 a144 = *(const LAS f32x4*)(Af + 652);
        r2[12] -= (f32x2v){a140[0], a140[1]} * T9; r2[13] -= (f32x2v){a140[2], a140[3]} * T9;
        const f32x4 a145 = *(const LAS f32x4*)(Af + 656);
        r2[14] -= (f32x2v){a141[0], a141[1]} * T9; r2[15] -= (f32x2v){a141[2], a141[3]} * T9;
        const f32x4 a146 = *(const LAS f32x4*)(Af + 660);
        r2[16] -= (f32x2v){a142[0], a142[1]} * T9; r2[17] -= (f32x2v){a142[2], a142[3]} * T9;
        const f32x4 a147 = *(const LAS f32x4*)(Af + 664);
        r2[18] -= (f32x2v){a143[0], a143[1]} * T9; r2[19] -= (f32x2v){a143[2], a143[3]} * T9;
        const f32x4 a148 = *(const LAS f32x4*)(Af + 668);
        r2[20] -= (f32x2v){a144[0], a144[1]} * T9; r2[21] -= (f32x2v){a144[2], a144[3]} * T9;
        const f32x4 a149 = *(const LAS f32x4*)(Af + 672);
        r2[22] -= (f32x2v){a145[0], a145[1]} * T9; r2[23] -= (f32x2v){a145[2], a145[3]} * T9;
        const f32x4 a150 = *(const LAS f32x4*)(Af + 688);
        r2[24] -= (f32x2v){a146[0], a146[1]} * T9; r2[25] -= (f32x2v){a146[2], a146[3]} * T9;
        const f32x4 a151 = *(const LAS f32x4*)(Af + 692);
        r2[26] -= (f32x2v){a147[0], a147[1]} * T9; r2[27] -= (f32x2v){a147[2], a147[3]} * T9;
        const f32x4 a152 = *(const LAS f32x4*)(Af + 696);
        r2[28] -= (f32x2v){a148[0], a148[1]} * T9; r2[29] -= (f32x2v){a148[2], a148[3]} * T9;
        const f32x4 a153 = *(const LAS f32x4*)(Af + 700);
        r2[30] -= (f32x2v){a149[0], a149[1]} * T9; r2[31] -= (f32x2v){a149[2], a149[3]} * T9;
        const f32x4 a154 = *(const LAS f32x4*)(Af + 704);
        const float t10 = r2[5][0]; const f32x2v T10 = (f32x2v){t10, t10}; Tb[720 + lane] = f2bf(t10);
        r2[5] -= (f32x2v){a150[2], a150[3]} * T10;
        const f32x4 a155 = *(const LAS f32x4*)(Af + 708);
        r2[6] -= (f32x2v){a151[0], a151[1]} * T10; r2[7] -= (f32x2v){a151[2], a151[3]} * T10;
        const f32x4 a156 = *(const LAS f32x4*)(Af + 712);
        r2[8] -= (f32x2v){a152[0], a152[1]} * T10; r2[9] -= (f32x2v){a152[2], a152[3]} * T10;
        const f32x4 a157 = *(const LAS f32x4*)(Af + 716);
        r2[10] -= (f32x2v){a153[0], a153[1]} * T10; r2[11] -= (f32x2v){a153[2], a153[3]} * T10;
        const f32x4 a158 = *(const LAS f32x4*)(Af + 720);
        r2[12] -= (f32x2v){a154[0], a154[1]} * T10; r2[13] -= (f32x2v){a154[2], a154[3]} * T10;
        const f32x4 a159 = *(const LAS f32x4*)(Af + 724);
        r2[14] -= (f32x2v){a155[0], a155[1]} * T10; r2[15] -= (f32x2v){a155[2], a155[3]} * T10;
        const f32x4 a160 = *(const LAS f32x4*)(Af + 728);
        r2[16] -= (f32x2v){a156[0], a156[1]} * T10; r2[17] -= (f32x2v){a156[2], a156[3]} * T10;
        const f32x4 a161 = *(const LAS f32x4*)(Af + 732);
        r2[18] -= (f32x2v){a157[0], a157[1]} * T10; r2[19] -= (f32x2v){a157[2], a157[3]} * T10;
        const f32x4 a162 = *(const LAS f32x4*)(Af + 736);
        r2[20] -= (f32x2v){a158[0], a158[1]} * T10; r2[21] -= (f32x2v){a158[2], a158[3]} * T10;
        const f32x4 a163 = *(const LAS f32x4*)(Af + 740);
        r2[22] -= (f32x2v){a159[0], a159[1]} * T10; r2[23] -= (f32x2v){a159[2], a159[3]} * T10;
        const f32x4 a164 = *(const LAS f32x4*)(Af + 760);
        r2[24] -= (f32x2v){a160[0], a160[1]} * T10; r2[25] -= (f32x2v){a160[2], a160[3]} * T10;
        const f32x4 a165 = *(const LAS f32x4*)(Af + 764);
        r2[26] -= (f32x2v){a161[0], a161[1]} * T10; r2[27] -= (f32x2v){a161[2], a161[3]} * T10;
        const f32x4 a166 = *(const LAS f32x4*)(Af + 768);
        r2[28] -= (f32x2v){a162[0], a162[1]} * T10; r2[29] -= (f32x2v){a162[2], a162[3]} * T10;
        const f32x4 a167 = *(const LAS f32x4*)(Af + 772);
        r2[30] -= (f32x2v){a163[0], a163[1]} * T10; r2[31] -= (f32x2v){a163[2], a163[3]} * T10;
        const f32x4 a168 = *(const LAS f32x4*)(Af + 776);
        const float t11 = r2[5][1]; const f32x2v T11 = (f32x2v){t11, t11}; Tb[792 + lane] = f2bf(t11);
        r2[6] -= (f32x2v){a164[0], a164[1]} * T11; r2[7] -= (f32x2v){a164[2], a164[3]} * T11;
        const f32x4 a169 = *(const LAS f32x4*)(Af + 780);
        r2[8] -= (f32x2v){a165[0], a165[1]} * T11; r2[9] -= (f32x2v){a165[2], a165[3]} * T11;
        const f32x4 a170 = *(const LAS f32x4*)(Af + 784);
        r2[10] -= (f32x2v){a166[0], a166[1]} * T11; r2[11] -= (f32x2v){a166[2], a166[3]} * T11;
        const f32x4 a171 = *(const LAS f32x4*)(Af + 788);
        r2[12] -= (f32x2v){a167[0], a167[1]} * T11; r2[13] -= (f32x2v){a167[2], a167[3]} * T11;
        const f32x4 a172 = *(const LAS f32x4*)(Af + 792);
        r2[14] -= (f32x2v){a168[0], a168[1]} * T11; r2[15] -= (f32x2v){a168[2], a168[3]} * T11;
        const f32x4 a173 = *(const LAS f32x4*)(Af + 796);
        r2[16] -= (f32x2v){a169[0], a169[1]} * T11; r2[17] -= (f32x2v){a169[2], a169[3]} * T11;
        const f32x4 a174 = *(const LAS f32x4*)(Af + 800);
        r2[18] -= (f32x2v){a170[0], a170[1]} * T11; r2[19] -= (f32x2v){a170[2], a170[3]} * T11;
        const f32x4 a175 = *(const LAS f32x4*)(Af + 804);
        r2[20] -= (f32x2v){a171[0], a171[1]} * T11; r2[21] -= (f32x2v){a171[2], a171[3]} * T11;
        const f32x4 a176 = *(const LAS f32x4*)(Af + 808);
        r2[22] -= (f32x2v){a172[0], a172[1]} * T11; r2[23] -= (f32x2v){a172[2], a172[3]} * T11;
        const f32x4 a177 = *(const LAS f32x4*)(Af + 828);
        r2[24] -= (f32x2v){a173[0], a173[1]} * T11; r2[25] -= (f32x2v){a173[2], a173[3]} * T11;
        const f32x4 a178 = *(const LAS f32x4*)(Af + 832);
        r2[26] -= (f32x2v){a174[0], a174[1]} * T11; r2[27] -= (f32x2v){a174[2], a174[3]} * T11;
        const f32x4 a179 = *(const LAS f32x4*)(Af + 836);
        r2[28] -= (f32x2v){a175[0], a175[1]} * T11; r2[29] -= (f32x2v){a175[2], a175[3]} * T11;
        const f32x4 a180 = *(const LAS f32x4*)(Af + 840);
        r2[30] -= (f32x2v){a176[0], a176[1]} * T11; r2[31] -= (f32x2v){a176[2], a176[3]} * T11;
        const f32x4 a181 = *(const LAS f32x4*)(Af + 844);
        const float t12 = r2[6][0]; const f32x2v T12 = (f32x2v){t12, t12}; Tb[864 + lane] = f2bf(t12);
        r2[6] -= (f32x2v){a177[0], a177[1]} * T12; r2[7] -= (f32x2v){a177[2], a177[3]} * T12;
        const f32x4 a182 = *(const LAS f32x4*)(Af + 848);
        r2[8] -= (f32x2v){a178[0], a178[1]} * T12; r2[9] -= (f32x2v){a178[2], a178[3]} * T12;
        const f32x4 a183 = *(const LAS f32x4*)(Af + 852);
        r2[10] -= (f32x2v){a179[0], a179[1]} * T12; r2[11] -= (f32x2v){a179[2], a179[3]} * T12;
        const f32x4 a184 = *(const LAS f32x4*)(Af + 856);
        r2[12] -= (f32x2v){a180[0], a180[1]} * T12; r2[13] -= (f32x2v){a180[2], a180[3]} * T12;
        const f32x4 a185 = *(const LAS f32x4*)(Af + 860);
        r2[14] -= (f32x2v){a181[0], a181[1]} * T12; r2[15] -= (f32x2v){a181[2], a181[3]} * T12;
        const f32x4 a186 = *(const LAS f32x4*)(Af + 864);
        r2[16] -= (f32x2v){a182[0], a182[1]} * T12; r2[17] -= (f32x2v){a182[2], a182[3]} * T12;
        const f32x4 a187 = *(const LAS f32x4*)(Af + 868);
        r2[18] -= (f32x2v){a183[0], a183[1]} * T12; r2[19] -= (f32x2v){a183[2], a183[3]} * T12;
        const f32x4 a188 = *(const LAS f32x4*)(Af + 872);
        r2[20] -= (f32x2v){a184[0], a184[1]} * T12; r2[21] -= (f32x2v){a184[2], a184[3]} * T12;
        const f32x4 a189 = *(const LAS f32x4*)(Af + 876);
        r2[22] -= (f32x2v){a185[0], a185[1]} * T12; r2[23] -= (f32x2v){a185[2], a185[3]} * T12;
        const f32x4 a190 = *(const LAS f32x4*)(Af + 896);
        r2[24] -= (f32x2v){a186[0], a186[1]} * T12; r2[25] -= (f32x2v){a186[2], a186[3]} * T12;
        const f32x4 a191 = *(const LAS f32x4*)(Af + 900);
        r2[26] -= (f32x2v){a187[0], a187[1]} * T12; r2[27] -= (f32x2v){a187[2], a187[3]} * T12;
        const f32x4 a192 = *(const LAS f32x4*)(Af + 904);
        r2[28] -= (f32x2v){a188[0], a188[1]} * T12; r2[29] -= (f32x2v){a188[2], a188[3]} * T12;
        const f32x4 a193 = *(const LAS f32x4*)(Af + 908);
        r2[30] -= (f32x2v){a189[0], a189[1]} * T12; r2[31] -= (f32x2v){a189[2], a189[3]} * T12;
        const f32x4 a194 = *(const LAS f32x4*)(Af + 912);
        const float t13 = r2[6][1]; const f32x2v T13 = (f32x2v){t13, t13}; Tb[936 + lane] = f2bf(t13);
        r2[7] -= (f32x2v){a190[2], a190[3]} * T13;
        const f32x4 a195 = *(const LAS f32x4*)(Af + 916);
        r2[8] -= (f32x2v){a191[0], a191[1]} * T13; r2[9] -= (f32x2v){a191[2], a191[3]} * T13;
        const f32x4 a196 = *(const LAS f32x4*)(Af + 920);
        r2[10] -= (f32x2v){a192[0], a192[1]} * T13; r2[11] -= (f32x2v){a192[2], a192[3]} * T13;
        const f32x4 a197 = *(const LAS f32x4*)(Af + 924);
        r2[12] -= (f32x2v){a193[0], a193[1]} * T13; r2[13] -= (f32x2v){a193[2], a193[3]} * T13;
        const f32x4 a198 = *(const LAS f32x4*)(Af + 928);
        r2[14] -= (f32x2v){a194[0], a194[1]} * T13; r2[15] -= (f32x2v){a194[2], a194[3]} * T13;
        const f32x4 a199 = *(const LAS f32x4*)(Af + 932);
        r2[16] -= (f32x2v){a195[0], a195[1]} * T13; r2[17] -= (f32x2v){a195[2], a195[3]} * T13;
        const f32x4 a200 = *(const LAS f32x4*)(Af + 936);
        r2[18] -= (f32x2v){a196[0], a196[1]} * T13; r2[19] -= (f32x2v){a196[2], a196[3]} * T13;
        const f32x4 a201 = *(const LAS f32x4*)(Af + 940);
        r2[20] -= (f32x2v){a197[0], a197[1]} * T13; r2[21] -= (f32x2v){a197[2], a197[3]} * T13;
        const f32x4 a202 = *(const LAS f32x4*)(Af + 944);
        r2[22] -= (f32x2v){a198[0], a198[1]} * T13; r2[23] -= (f32x2v){a198[2], a198[3]} * T13;
        const f32x4 a203 = *(const LAS f32x4*)(Af + 964);
        r2[24] -= (f32x2v){a199[0], a199[1]} * T13; r2[25] -= (f32x2v){a199[2], a199[3]} * T13;
        const f32x4 a204 = *(const LAS f32x4*)(Af + 968);
        r2[26] -= (f32x2v){a200[0], a200[1]} * T13; r2[27] -= (f32x2v){a200[2], a200[3]} * T13;
        const f32x4 a205 = *(const LAS f32x4*)(Af + 972);
        r2[28] -= (f32x2v){a201[0], a201[1]} * T13; r2[29] -= (f32x2v){a201[2], a201[3]} * T13;
        const f32x4 a206 = *(const LAS f32x4*)(Af + 976);
        r2[30] -= (f32x2v){a202[0], a202[1]} * T13; r2[31] -= (f32x2v){a202[2], a202[3]} * T13;
        const f32x4 a207 = *(const LAS f32x4*)(Af + 980);
        const float t14 = r2[7][0]; const f32x2v T14 = (f32x2v){t14, t14}; Tb[1008 + lane] = f2bf(t14);
        r2[7] -= (f32x2v){a203[2], a203[3]} * T14;
        const f32x4 a208 = *(const LAS f32x4*)(Af + 984);
        r2[8] -= (f32x2v){a204[0], a204[1]} * T14; r2[9] -= (f32x2v){a204[2], a204[3]} * T14;
        const f32x4 a209 = *(const LAS f32x4*)(Af + 988);
        r2[10] -= (f32x2v){a205[0], a205[1]} * T14; r2[11] -= (f32x2v){a205[2], a205[3]} * T14;
        const f32x4 a210 = *(const LAS f32x4*)(Af + 992);
        r2[12] -= (f32x2v){a206[0], a206[1]} * T14; r2[13] -= (f32x2v){a206[2], a206[3]} * T14;
        const f32x4 a211 = *(const LAS f32x4*)(Af + 996);
        r2[14] -= (f32x2v){a207[0], a207[1]} * T14; r2[15] -= (f32x2v){a207[2], a207[3]} * T14;
        const f32x4 a212 = *(const LAS f32x4*)(Af + 1000);
        r2[16] -= (f32x2v){a208[0], a208[1]} * T14; r2[17] -= (f32x2v){a208[2], a208[3]} * T14;
        const f32x4 a213 = *(const LAS f32x4*)(Af + 1004);
        r2[18] -= (f32x2v){a209[0], a209[1]} * T14; r2[19] -= (f32x2v){a209[2], a209[3]} * T14;
        const f32x4 a214 = *(const LAS f32x4*)(Af + 1008);
        r2[20] -= (f32x2v){a210[0], a210[1]} * T14; r2[21] -= (f32x2v){a210[2], a210[3]} * T14;
        const f32x4 a215 = *(const LAS f32x4*)(Af + 1012);
        r2[22] -= (f32x2v){a211[0], a211[1]} * T14; r2[23] -= (f32x2v){a211[2], a211[3]} * T14;
        const f32x4 a216 = *(const LAS f32x4*)(Af + 1036);
        r2[24] -= (f32x2v){a212[0], a212[1]} * T14; r2[25] -= (f32x2v){a212[2], a212[3]} * T14;
        const f32x4 a217 = *(const LAS f32x4*)(Af + 1040);
        r2[26] -= (f32x2v){a213[0], a213[1]} * T14; r2[27] -= (f32x2v){a213[2], a213[3]} * T14;
        const f32x4 a218 = *(const LAS f32x4*)(Af + 1044);
        r2[28] -= (f32x2v){a214[0], a214[1]} * T14; r2[29] -= (f32x2v){a214[2], a214[3]} * T14;
        const f32x4 a219 = *(const LAS f32x4*)(Af + 1048);
        r2[30] -= (f32x2v){a215[0], a215[1]} * T14; r2[31] -= (f32x2v){a215[2], a215[3]} * T14;
        const f32x4 a220 = *(const LAS f32x4*)(Af + 1052);
        const float t15 = r2[7][1]; const f32x2v T15 = (f32x2v){t15, t15}; Tb[1080 + lane] = f2bf(t15);
        r2[8] -= (f32x2v){a216[0], a216[1]} * T15; r2[9] -= (f32x2v){a216[2], a216[3]} * T15;
        const f32x4 a221 = *(const LAS f32x4*)(Af + 1056);
        r2[10] -= (f32x2v){a217[0], a217[1]} * T15; r2[11] -= (f32x2v){a217[2], a217[3]} * T15;
        const f32x4 a222 = *(const LAS f32x4*)(Af + 1060);
        r2[12] -= (f32x2v){a218[0], a218[1]} * T15; r2[13] -= (f32x2v){a218[2], a218[3]} * T15;
        const f32x4 a223 = *(const LAS f32x4*)(Af + 1064);
        r2[14] -= (f32x2v){a219[0], a219[1]} * T15; r2[15] -= (f32x2v){a219[2], a219[3]} * T15;
        const f32x4 a224 = *(const LAS f32x4*)(Af + 1068);
        r2[16] -= (f32x2v){a220[0], a220[1]} * T15; r2[17] -= (f32x2v){a220[2], a220[3]} * T15;
        const f32x4 a225 = *(const LAS f32x4*)(Af + 1072);
        r2[18] -= (f32x2v){a221[0], a221[1]} * T15; r2[19] -= (f32x2v){a221[2], a221[3]} * T15;
        const f32x4 a226 = *(const LAS f32x4*)(Af + 1076);
        r2[20] -= (f32x2v){a222[0], a222[1]} * T15; r2[21] -= (f32x2v){a222[2], a222[3]} * T15;
        const f32x4 a227 = *(const LAS f32x4*)(Af + 1080);
        r2[22] -= (f32x2v){a223[0], a223[1]} * T15; r2[23] -= (f32x2v){a223[2], a223[3]} * T15;
        const f32x4 a228 = *(const LAS f32x4*)(Af + 1104);
        r2[24] -= (f32x2v){a224[0], a224[1]} * T15; r2[25] -= (f32x2v){a224[2], a224[3]} * T15;
        const f32x4 a229 = *(const LAS f32x4*)(Af + 1108);
        r2[26] -= (f32x2v){a225[0], a225[1]} * T15; r2[27] -= (f32x2v){a225[2], a225[3]} * T15;
        const f32x4 a230 = *(const LAS f32x4*)(Af + 1112);
        r2[28] -= (f32x2v){a226[0], a226[1]} * T15; r2[29] -= (f32x2v){a226[2], a226[3]} * T15;
        const f32x4 a231 = *(const LAS f32x4*)(Af + 1116);
        r2[30] -= (f32x2v){a227[0], a227[1]} * T15; r2[31] -= (f32x2v){a227[2], a227[3]} * T15;
        const f32x4 a232 = *(const LAS f32x4*)(Af + 1120);
        const float t16 = r2[8][0]; const f32x2v T16 = (f32x2v){t16, t16}; Tb[1152 + lane] = f2bf(t16);
        r2[8] -= (f32x2v){a228[0], a228[1]} * T16; r2[9] -= (f32x2v){a228[2], a228[3]} * T16;
        const f32x4 a233 = *(const LAS f32x4*)(Af + 1124);
        r2[10] -= (f32x2v){a229[0], a229[1]} * T16; r2[11] -= (f32x2v){a229[2], a229[3]} * T16;
        const f32x4 a234 = *(const LAS f32x4*)(Af + 1128);
        r2[12] -= (f32x2v){a230[0], a230[1]} * T16; r2[13] -= (f32x2v){a230[2], a230[3]} * T16;
        const f32x4 a235 = *(const LAS f32x4*)(Af + 1132);
        r2[14] -= (f32x2v){a231[0], a231[1]} * T16; r2[15] -= (f32x2v){a231[2], a231[3]} * T16;
        const f32x4 a236 = *(const LAS f32x4*)(Af + 1136);
        r2[16] -= (f32x2v){a232[0], a232[1]} * T16; r2[17] -= (f32x2v){a232[2], a232[3]} * T16;
        const f32x4 a237 = *(const LAS f32x4*)(Af + 1140);
        r2[18] -= (f32x2v){a233[0], a233[1]} * T16; r2[19] -= (f32x2v){a233[2], a233[3]} * T16;
        const f32x4 a238 = *(const LAS f32x4*)(Af + 1144);
        r2[20] -= (f32x2v){a234[0], a234[1]} * T16; r2[21] -= (f32x2v){a234[2], a234[3]} * T16;
        const f32x4 a239 = *(const LAS f32x4*)(Af + 1148);
        r2[22] -= (f32x2v){a235[0], a235[1]} * T16; r2[23] -= (f32x2v){a235[2], a235[3]} * T16;
        const f32x4 a240 = *(const LAS f32x4*)(Af + 1172);
        r2[24] -= (f32x2v){a236[0], a236[1]} * T16; r2[25] -= (f32x2v){a236[2], a236[3]} * T16;
        const f32x4 a241 = *(const LAS f32x4*)(Af + 1176);
        r2[26] -= (f32x2v){a237[0], a237[1]} * T16; r2[27] -= (f32x2v){a237[2], a237[3]} * T16;
        const f32x4 a242 = *(const LAS f32x4*)(Af + 1180);
        r2[28] -= (f32x2v){a238[0], a238[1]} * T16; r2[29] -= (f32x2v){a238[2], a238[3]} * T16;
        const f32x4 a243 = *(const LAS f32x4*)(Af + 1184);
        r2[30] -= (f32x2v){a239[0], a239[1]} * T16; r2[31] -= (f32x2v){a239[2], a239[3]} * T16;
        const f32x4 a244 = *(const LAS f32x4*)(Af + 1188);
        const float t17 = r2[8][1]; const f32x2v T17 = (f32x2v){t17, t17}; Tb[1224 + lane] = f2bf(t17);
        r2[9] -= (f32x2v){a240[2], a240[3]} * T17;
        const f32x4 a245 = *(const LAS f32x4*)(Af + 1192);
        r2[10] -= (f32x2v){a241[0], a241[1]} * T17; r2[11] -= (f32x2v){a241[2], a241[3]} * T17;
        const f32x4 a246 = *(const LAS f32x4*)(Af + 1196);
        r2[12] -= (f32x2v){a242[0], a242[1]} * T17; r2[13] -= (f32x2v){a242[2], a242[3]} * T17;
        const f32x4 a247 = *(const LAS f32x4*)(Af + 1200);
        r2[14] -= (f32x2v){a243[0], a243[1]} * T17; r2[15] -= (f32x2v){a243[2], a243[3]} * T17;
        const f32x4 a248 = *(const LAS f32x4*)(Af + 1204);
        r2[16] -= (f32x2v){a244[0], a244[1]} * T17; r2[17] -= (f32x2v){a244[2], a244[3]} * T17;
        const f32x4 a249 = *(const LAS f32x4*)(Af + 1208);
        r2[18] -= (f32x2v){a245[0], a245[1]} * T17; r2[19] -= (f32x2v){a245[2], a245[3]} * T17;
        const f32x4 a250 = *(const LAS f32x4*)(Af + 1212);
        r2[20] -= (f32x2v){a246[0], a246[1]} * T17; r2[21] -= (f32x2v){a246[2], a246[3]} * T17;
        const f32x4 a251 = *(const LAS f32x4*)(Af + 1216);
        r2[22] -= (f32x2v){a247[0], a247[1]} * T17; r2[23] -= (f32x2v){a247[2], a247[3]} * T17;
        const f32x4 a252 = *(const LAS f32x4*)(Af + 1240);
        r2[24] -= (f32x2v){a248[0], a248[1]} * T17; r2[25] -= (f32x2v){a248[2], a248[3]} * T17;
        const f32x4 a253 = *(const LAS f32x4*)(Af + 1244);
        r2[26] -= (f32x2v){a249[0], a249[1]} * T17; r2[27] -= (f32x2v){a249[2], a249[3]} * T17;
        const f32x4 a254 = *(const LAS f32x4*)(Af + 1248);
        r2[28] -= (f32x2v){a250[0], a250[1]} * T17; r2[29] -= (f32x2v){a250[2], a250[3]} * T17;
        const f32x4 a255 = *(const LAS f32x4*)(Af + 1252);
        r2[30] -= (f32x2v){a251[0], a251[1]} * T17; r2[31] -= (f32x2v){a251[2], a251[3]} * T17;
        const f32x4 a256 = *(const LAS f32x4*)(Af + 1256);
        const float t18 = r2[9][0]; const f32x2v T18 = (f32x2v){t18, t18}; Tb[1296 + lane] = f2bf(t18);
        r2[9] -= (f32x2v){a252[2], a252[3]} * T18;
        const f32x4 a257 = *(const LAS f32x4*)(Af + 1260);
        r2[10] -= (f32x2v){a253[0], a253[1]} * T18; r2[11] -= (f32x2v){a253[2], a253[3]} * T18;
        const f32x4 a258 = *(const LAS f32x4*)(Af + 1264);
        r2[12] -= (f32x2v){a254[0], a254[1]} * T18; r2[13] -= (f32x2v){a254[2], a254[3]} * T18;
        const f32x4 a259 = *(const LAS f32x4*)(Af + 1268);
        r2[14] -= (f32x2v){a255[0], a255[1]} * T18; r2[15] -= (f32x2v){a255[2], a255[3]} * T18;
        const f32x4 a260 = *(const LAS f32x4*)(Af + 1272);
        r2[16] -= (f32x2v){a256[0], a256[1]} * T18; r2[17] -= (f32x2v){a256[2], a256[3]} * T18;
        const f32x4 a261 = *(const LAS f32x4*)(Af + 1276);
        r2[18] -= (f32x2v){a257[0], a257[1]} * T18; r2[19] -= (f32x2v){a257[2], a257[3]} * T18;
        const f32x4 a262 = *(const LAS f32x4*)(Af + 1280);
        r2[20] -= (f32x2v){a258[0], a258[1]} * T18; r2[21] -= (f32x2v){a258[2], a258[3]} * T18;
        const f32x4 a263 = *(const LAS f32x4*)(Af + 1284);
        r2[22] -= (f32x2v){a259[0], a259[1]} * T18; r2[23] -= (f32x2v){a259[2], a259[3]} * T18;
        const f32x4 a264 = *(const LAS f32x4*)(Af + 1312);
        r2[24] -= (f32x2v){a260[0], a260[1]} * T18; r2[25] -= (f32x2v){a260[2], a260[3]} * T18;
        const f32x4 a265 = *(const LAS f32x4*)(Af + 1316);
        r2[26] -= (f32x2v){a261[0], a261[1]} * T18; r2[27] -= (f32x2v){a261[2], a261[3]} * T18;
        const f32x4 a266 = *(const LAS f32x4*)(Af + 1320);
        r2[28] -= (f32x2v){a262[0], a262[1]} * T18; r2[29] -= (f32x2v){a262[2], a262[3]} * T18;
        const f32x4 a267 = *(const LAS f32x4*)(Af + 1324);
        r2[30] -= (f32x2v){a263[0], a263[1]} * T18; r2[31] -= (f32x2v){a263[2], a263[3]} * T18;
        const f32x4 a268 = *(const LAS f32x4*)(Af + 1328);
        const float t19 = r2[9][1]; const f32x2v T19 = (f32x2v){t19, t19}; Tb[1368 + lane] = f2bf(t19);
        r2[10] -= (f32x2v){a264[0], a264[1]} * T19; r2[11] -= (f32x2v){a264[2], a264[3]} * T19;
        const f32x4 a269 = *(const LAS f32x4*)(Af + 1332);
        r2[12] -= (f32x2v){a265[0], a265[1]} * T19; r2[13] -= (f32x2v){a265[2], a265[3]} * T19;
        const f32x4 a270 = *(const LAS f32x4*)(Af + 1336);
        r2[14] -= (f32x2v){a266[0], a266[1]} * T19; r2[15] -= (f32x2v){a266[2], a266[3]} * T19;
        const f32x4 a271 = *(const LAS f32x4*)(Af + 1340);
        r2[16] -= (f32x2v){a267[0], a267[1]} * T19; r2[17] -= (f32x2v){a267[2], a267[3]} * T19;
        const f32x4 a272 = *(const LAS f32x4*)(Af + 1344);
        r2[18] -= (f32x2v){a268[0], a268[1]} * T19; r2[19] -= (f32x2v){a268[2], a268[3]} * T19;
        const f32x4 a273 = *(const LAS f32x4*)(Af + 1348);
        r2[20] -= (f32x2v){a269[0], a269[1]} * T19; r2[21] -= (f32x2v){a269[2], a269[3]} * T19;
        const f32x4 a274 = *(const LAS f32x4*)(Af + 1352);
        r2[22] -= (f32x2v){a270[0], a270[1]} * T19; r2[23] -= (f32x2v){a270[2], a270[3]} * T19;
        const f32x4 a275 = *(const LAS f32x4*)(Af + 1380);
        r2[24] -= (f32x2v){a271[0], a271[1]} * T19; r2[25] -= (f32x2v){a271[2], a271[3]} * T19;
        const f32x4 a276 = *(const LAS f32x4*)(Af + 1384);
        r2[26] -= (f32x2v){a272[0], a272[1]} * T19; r2[27] -= (f32x2v){a272[2], a272[3]} * T19;
        const f32x4 a277 = *(const LAS f32x4*)(Af + 1388);
        r2[28] -= (f32x2v){a273[0], a273[1]} * T19; r2[29] -= (f32x2v){a273[2], a273[3]} * T19;
        const f32x4 a278 = *(const LAS f32x4*)(Af + 1392);
        r2[30] -= (f32x2v){a274[0], a274[1]} * T19; r2[31] -= (f32x2v){a274[2], a274[3]} * T19;
        const f32x4 a279 = *(const LAS f32x4*)(Af + 1396);
        const float t20 = r2[10][0]; const f32x2v T20 = (f32x2v){t20, t20}; Tb[1440 + lane] = f2bf(t20);
        r2[10] -= (f32x2v){a275[0], a275[1]} * T20; r2[11] -= (f32x2v){a275[2], a275[3]} * T20;
        const f32x4 a280 = *(const LAS f32x4*)(Af + 1400);
        r2[12] -= (f32x2v){a276[0], a276[1]} * T20; r2[13] -= (f32x2v){a276[2], a276[3]} * T20;
        const f32x4 a281 = *(const LAS f32x4*)(Af + 1404);
        r2[14] -= (f32x2v){a277[0], a277[1]} * T20; r2[15] -= (f32x2v){a277[2], a277[3]} * T20;
        const f32x4 a282 = *(const LAS f32x4*)(Af + 1408);
        r2[16] -= (f32x2v){a278[0], a278[1]} * T20; r2[17] -= (f32x2v){a278[2], a278[3]} * T20;
        const f32x4 a283 = *(const LAS f32x4*)(Af + 1412);
        r2[18] -= (f32x2v){a279[0], a279[1]} * T20; r2[19] -= (f32x2v){a279[2], a279[3]} * T20;
        const f32x4 a284 = *(const LAS f32x4*)(Af + 1416);
        r2[20] -= (f32x2v){a280[0], a280[1]} * T20; r2[21] -= (f32x2v){a280[2], a280[3]} * T20;
        const f32x4 a285 = *(const LAS f32x4*)(Af + 1420);
        r2[22] -= (f32x2v){a281[0], a281[1]} * T20; r2[23] -= (f32x2v){a281[2], a281[3]} * T20;
        const f32x4 a286 = *(const LAS f32x4*)(Af + 1448);
        r2[24] -= (f32x2v){a282[0], a282[1]} * T20; r2[25] -= (f32x2v){a282[2], a282[3]} * T20;
        const f32x4 a287 = *(const LAS f32x4*)(Af + 1452);
        r2[26] -= (f32x2v){a283[0], a283[1]} * T20; r2[27] -= (f32x2v){a283[2], a283[3]} * T20;
        const f32x4 a288 = *(const LAS f32x4*)(Af + 1456);
        r2[28] -= (f32x2v){a284[0], a284[1]} * T20; r2[29] -= (f32x2v){a284[2], a284[3]} * T20;
        const f32x4 a289 = *(const LAS f32x4*)(Af + 1460);
        r2[30] -= (f32x2v){a285[0], a285[1]} * T20; r2[31] -= (f32x2v){a285[2], a285[3]} * T20;
        const f32x4 a290 = *(const LAS f32x4*)(Af + 1464);
        const float t21 = r2[10][1]; const f32x2v T21 = (f32x2v){t21, t21}; Tb[1512 + lane] = f2bf(t21);
        r2[11] -= (f32x2v){a286[2], a286[3]} * T21;
        const f32x4 a291 = *(const LAS f32x4*)(Af + 1468);
        r2[12] -= (f32x2v){a287[0], a287[1]} * T21; r2[13] -= (f32x2v){a287[2], a287[3]} * T21;
        const f32x4 a292 = *(const LAS f32x4*)(Af + 1472);
        r2[14] -= (f32x2v){a288[0], a288[1]} * T21; r2[15] -= (f32x2v){a288[2], a288[3]} * T21;
        const f32x4 a293 = *(const LAS f32x4*)(Af + 1476);
        r2[16] -= (f32x2v){a289[0], a289[1]} * T21; r2[17] -= (f32x2v){a289[2], a289[3]} * T21;
        const f32x4 a294 = *(const LAS f32x4*)(Af + 1480);
        r2[18] -= (f32x2v){a290[0], a290[1]} * T21; r2[19] -= (f32x2v){a290[2], a290[3]} * T21;
        const f32x4 a295 = *(const LAS f32x4*)(Af + 1484);
        r2[20] -= (f32x2v){a291[0], a291[1]} * T21; r2[21] -= (f32x2v){a291[2], a291[3]} * T21;
        const f32x4 a296 = *(const LAS f32x4*)(Af + 1488);
        r2[22] -= (f32x2v){a292[0], a292[1]} * T21; r2[23] -= (f32x2v){a292[2], a292[3]} * T21;
        const f32x4 a297 = *(const LAS f32x4*)(Af + 1516);
        r2[24] -= (f32x2v){a293[0], a293[1]} * T21; r2[25] -= (f32x2v){a293[2], a293[3]} * T21;
        const f32x4 a298 = *(const LAS f32x4*)(Af + 1520);
        r2[26] -= (f32x2v){a294[0], a294[1]} * T21; r2[27] -= (f32x2v){a294[2], a294[3]} * T21;
        const f32x4 a299 = *(const LAS f32x4*)(Af + 1524);
        r2[28] -= (f32x2v){a295[0], a295[1]} * T21; r2[29] -= (f32x2v){a295[2], a295[3]} * T21;
        const f32x4 a300 = *(const LAS f32x4*)(Af + 1528);
        r2[30] -= (f32x2v){a296[0], a296[1]} * T21; r2[31] -= (f32x2v){a296[2], a296[3]} * T21;
        const f32x4 a301 = *(const LAS f32x4*)(Af + 1532);
        const float t22 = r2[11][0]; const f32x2v T22 = (f32x2v){t22, t22}; Tb[1584 + lane] = f2bf(t22);
        r2[11] -= (f32x2v){a297[2], a297[3]} * T22;
        const f32x4 a302 = *(const LAS f32x4*)(Af + 1536);
        r2[12] -= (f32x2v){a298[0], a298[1]} * T22; r2[13] -= (f32x2v){a298[2], a298[3]} * T22;
        const f32x4 a303 = *(const LAS f32x4*)(Af + 1540);
        r2[14] -= (f32x2v){a299[0], a299[1]} * T22; r2[15] -= (f32x2v){a299[2], a299[3]} * T22;
        const f32x4 a304 = *(const LAS f32x4*)(Af + 1544);
        r2[16] -= (f32x2v){a300[0], a300[1]} * T22; r2[17] -= (f32x2v){a300[2], a300[3]} * T22;
        const f32x4 a305 = *(const LAS f32x4*)(Af + 1548);
        r2[18] -= (f32x2v){a301[0], a301[1]} * T22; r2[19] -= (f32x2v){a301[2], a301[3]} * T22;
        const f32x4 a306 = *(const LAS f32x4*)(Af + 1552);
        r2[20] -= (f32x2v){a302[0], a302[1]} * T22; r2[21] -= (f32x2v){a302[2], a302[3]} * T22;
        const f32x4 a307 = *(const LAS f32x4*)(Af + 1556);
        r2[22] -= (f32x2v){a303[0], a303[1]} * T22; r2[23] -= (f32x2v){a303[2], a303[3]} * T22;
        const f32x4 a308 = *(const LAS f32x4*)(Af + 1588);
        r2[24] -= (f32x2v){a304[0], a304[1]} * T22; r2[25] -= (f32x2v){a304[2], a304[3]} * T22;
        const f32x4 a309 = *(const LAS f32x4*)(Af + 1592);
        r2[26] -= (f32x2v){a305[0], a305[1]} * T22; r2[27] -= (f32x2v){a305[2], a305[3]} * T22;
        const f32x4 a310 = *(const LAS f32x4*)(Af + 1596);
        r2[28] -= (f32x2v){a306[0], a306[1]} * T22; r2[29] -= (f32x2v){a306[2], a306[3]} * T22;
        const f32x4 a311 = *(const LAS f32x4*)(Af + 1600);
        r2[30] -= (f32x2v){a307[0], a307[1]} * T22; r2[31] -= (f32x2v){a307[2], a307[3]} * T22;
        const f32x4 a312 = *(const LAS f32x4*)(Af + 1604);
        const float t23 = r2[11][1]; const f32x2v T23 = (f32x2v){t23, t23}; Tb[1656 + lane] = f2bf(t23);
        r2[12] -= (f32x2v){a308[0], a308[1]} * T23; r2[13] -= (f32x2v){a308[2], a308[3]} * T23;
        const f32x4 a313 = *(const LAS f32x4*)(Af + 1608);
        r2[14] -= (f32x2v){a309[0], a309[1]} * T23; r2[15] -= (f32x2v){a309[2], a309[3]} * T23;
        const f32x4 a314 = *(const LAS f32x4*)(Af + 1612);
        r2[16] -= (f32x2v){a310[0], a310[1]} * T23; r2[17] -= (f32x2v){a310[2], a310[3]} * T23;
        const f32x4 a315 = *(const LAS f32x4*)(Af + 1616);
        r2[18] -= (f32x2v){a311[0], a311[1]} * T23; r2[19] -= (f32x2v){a311[2], a311[3]} * T23;
        const f32x4 a316 = *(const LAS f32x4*)(Af + 1620);
        r2[20] -= (f32x2v){a312[0], a312[1]} * T23; r2[21] -= (f32x2v){a312[2], a312[3]} * T23;
        const f32x4 a317 = *(const LAS f32x4*)(Af + 1624);
        r2[22] -= (f32x2v){a313[0], a313[1]} * T23; r2[23] -= (f32x2v){a313[2], a313[3]} * T23;
        const f32x4 a318 = *(const LAS f32x4*)(Af + 1656);
        r2[24] -= (f32x2v){a314[0], a314[1]} * T23; r2[25] -= (f32x2v){a314[2], a314[3]} * T23;
        const f32x4 a319 = *(const LAS f32x4*)(Af + 1660);
        r2[26] -= (f32x2v){a315[0], a315[1]} * T23; r2[27] -= (f32x2v){a315[2], a315[3]} * T23;
        const f32x4 a320 = *(const LAS f32x4*)(Af + 1664);
        r2[28] -= (f32x2v){a316[0], a316[1]} * T23; r2[29] -= (f32x2v){a316[2], a316[3]} * T23;
        const f32x4 a321 = *(const LAS f32x4*)(Af + 1668);
        r2[30] -= (f32x2v){a317[0], a317[1]} * T23; r2[31] -= (f32x2v){a317[2], a317[3]} * T23;
        const f32x4 a322 = *(const LAS f32x4*)(Af + 1672);
        const float t24 = r2[12][0]; const f32x2v T24 = (f32x2v){t24, t24}; Tb[1728 + lane] = f2bf(t24);
        r2[12] -= (f32x2v){a318[0], a318[1]} * T24; r2[13] -= (f32x2v){a318[2], a318[3]} * T24;
        const f32x4 a323 = *(const LAS f32x4*)(Af + 1676);
        r2[14] -= (f32x2v){a319[0], a319[1]} * T24; r2[15] -= (f32x2v){a319[2], a319[3]} * T24;
        const f32x4 a324 = *(const LAS f32x4*)(Af + 1680);
        r2[16] -= (f32x2v){a320[0], a320[1]} * T24; r2[17] -= (f32x2v){a320[2], a320[3]} * T24;
        const f32x4 a325 = *(const LAS f32x4*)(Af + 1684);
        r2[18] -= (f32x2v){a321[0], a321[1]} * T24; r2[19] -= (f32x2v){a321[2], a321[3]} * T24;
        const f32x4 a326 = *(const LAS f32x4*)(Af + 1688);
        r2[20] -= (f32x2v){a322[0], a322[1]} * T24; r2[21] -= (f32x2v){a322[2], a322[3]} * T24;
        const f32x4 a327 = *(const LAS f32x4*)(Af + 1692);
        r2[22] -= (f32x2v){a323[0], a323[1]} * T24; r2[23] -= (f32x2v){a323[2], a323[3]} * T24;
        const f32x4 a328 = *(const LAS f32x4*)(Af + 1724);
        r2[24] -= (f32x2v){a324[0], a324[1]} * T24; r2[25] -= (f32x2v){a324[2], a324[3]} * T24;
        const f32x4 a329 = *(const LAS f32x4*)(Af + 1728);
        r2[26] -= (f32x2v){a325[0], a325[1]} * T24; r2[27] -= (f32x2v){a325[2], a325[3]} * T24;
        const f32x4 a330 = *(const LAS f32x4*)(Af + 1732);
        r2[28] -= (f32x2v){a326[0], a326[1]} * T24; r2[29] -= (f32x2v){a326[2], a326[3]} * T24;
        const f32x4 a331 = *(const LAS f32x4*)(Af + 1736);
        r2[30] -= (f32x2v){a327[0], a327[1]} * T24; r2[31] -= (f32x2v){a327[2], a327[3]} * T24;
        const f32x4 a332 = *(const LAS f32x4*)(Af + 1740);
        const float t25 = r2[12][1]; const f32x2v T25 = (f32x2v){t25, t25}; Tb[1800 + lane] = f2bf(t25);
        r2[13] -= (f32x2v){a328[2], a328[3]} * T25;
        const f32x4 a333 = *(const LAS f32x4*)(Af + 1744);
        r2[14] -= (f32x2v){a329[0], a329[1]} * T25; r2[15] -= (f32x2v){a329[2], a329[3]} * T25;
        const f32x4 a334 = *(const LAS f32x4*)(Af + 1748);
        r2[16] -= (f32x2v){a330[0], a330[1]} * T25; r2[17] -= (f32x2v){a330[2], a330[3]} * T25;
        const f32x4 a335 = *(const LAS f32x4*)(Af + 1752);
        r2[18] -= (f32x2v){a331[0], a331[1]} * T25; r2[19] -= (f32x2v){a331[2], a331[3]} * T25;
        const f32x4 a336 = *(const LAS f32x4*)(Af + 1756);
        r2[20] -= (f32x2v){a332[0], a332[1]} * T25; r2[21] -= (f32x2v){a332[2], a332[3]} * T25;
        const f32x4 a337 = *(const LAS f32x4*)(Af + 1760);
        r2[22] -= (f32x2v){a333[0], a333[1]} * T25; r2[23] -= (f32x2v){a333[2], a333[3]} * T25;
        const f32x4 a338 = *(const LAS f32x4*)(Af + 1792);
        r2[24] -= (f32x2v){a334[0], a334[1]} * T25; r2[25] -= (f32x2v){a334[2], a334[3]} * T25;
        const f32x4 a339 = *(const LAS f32x4*)(Af + 1796);
        r2[26] -= (f32x2v){a335[0], a335[1]} * T25; r2[27] -= (f32x2v){a335[2], a335[3]} * T25;
        const f32x4 a340 = *(const LAS f32x4*)(Af + 1800);
        r2[28] -= (f32x2v){a336[0], a336[1]} * T25; r2[29] -= (f32x2v){a336[2], a336[3]} * T25;
        const f32x4 a341 = *(const LAS f32x4*)(Af + 1804);
        r2[30] -= (f32x2v){a337[0], a337[1]} * T25; r2[31] -= (f32x2v){a337[2], a337[3]} * T25;
        const f32x4 a342 = *(const LAS f32x4*)(Af + 1808);
        const float t26 = r2[13][0]; const f32x2v T26 = (f32x2v){t26, t26}; Tb[1872 + lane] = f2bf(t26);
        r2[13] -= (f32x2v){a338[2], a338[3]} * T26;
        const f32x4 a343 = *(const LAS f32x4*)(Af + 1812);
        r2[14] -= (f32x2v){a339[0], a339[1]} * T26; r2[15] -= (f32x2v){a339[2], a339[3]} * T26;
        const f32x4 a344 = *(const LAS f32x4*)(Af + 1816);
        r2[16] -= (f32x2v){a340[0], a340[1]} * T26; r2[17] -= (f32x2v){a340[2], a340[3]} * T26;
        const f32x4 a345 = *(const LAS f32x4*)(Af + 1820);
        r2[18] -= (f32x2v){a341[0], a341[1]} * T26; r2[19] -= (f32x2v){a341[2], a341[3]} * T26;
        const f32x4 a346 = *(const LAS f32x4*)(Af + 1824);
        r2[20] -= (f32x2v){a342[0], a342[1]} * T26; r2[21] -= (f32x2v){a342[2], a342[3]} * T26;
        const f32x4 a347 = *(const LAS f32x4*)(Af + 1828);
        r2[22] -= (f32x2v){a343[0], a343[1]} * T26; r2[23] -= (f32x2v){a343[2], a343[3]} * T26;
        const f32x4 a348 = *(const LAS f32x4*)(Af + 1864);
        r2[24] -= (f32x2v){a344[0], a344[1]} * T26; r2[25] -= (f32x2v){a344[2], a344[3]} * T26;
        const f32x4 a349 = *(const LAS f32x4*)(Af + 1868);
        r2[26] -= (f32x2v){a345[0], a345[1]} * T26; r2[27] -= (f32x2v){a345[2], a345[3]} * T26;
        const f32x4 a350 = *(const LAS f32x4*)(Af + 1872);
        r2[28] -= (f32x2v){a346[0], a346[1]} * T26; r2[29] -= (f32x2v){a346[2], a346[3]} * T26;
        const f32x4 a351 = *(const LAS f32x4*)(Af + 1876);
        r2[30] -= (f32x2v){a347[0], a347[1]} * T26; r2[31] -= (f32x2v){a347[2], a347[3]} * T26;
        const f32x4 a352 = *(const LAS f32x4*)(Af + 1880);
        const float t27 = r2[13][1]; const f32x2v T27 = (f32x2v){t27, t27}; Tb[1944 + lane] = f2bf(t27);
        r2[14] -= (f32x2v){a348[0], a348[1]} * T27; r2[15] -= (f32x2v){a348[2], a348[3]} * T27;
        const f32x4 a353 = *(const LAS f32x4*)(Af + 1884);
        r2[16] -= (f32x2v){a349[0], a349[1]} * T27; r2[17] -= (f32x2v){a349[2], a349[3]} * T27;
        const f32x4 a354 = *(const LAS f32x4*)(Af + 1888);
        r2[18] -= (f32x2v){a350[0], a350[1]} * T27; r2[19] -= (f32x2v){a350[2], a350[3]} * T27;
        const f32x4 a355 = *(const LAS f32x4*)(Af + 1892);
        r2[20] -= (f32x2v){a351[0], a351[1]} * T27; r2[21] -= (f32x2v){a351[2], a351[3]} * T27;
        const f32x4 a356 = *(const LAS f32x4*)(Af + 1896);
        r2[22] -= (f32x2v){a352[0], a352[1]} * T27; r2[23] -= (f32x2v){a352[2], a352[3]} * T27;
        const f32x4 a357 = *(const LAS f32x4*)(Af + 1932);
        r2[24] -= (f32x2v){a353[0], a353[1]} * T27; r2[25] -= (f32x2v){a353[2], a353[3]} * T27;
        const f32x4 a358 = *(const LAS f32x4*)(Af + 1936);
        r2[26] -= (f32x2v){a354[0], a354[1]} * T27; r2[27] -= (f32x2v){a354[2], a354[3]} * T27;
        const f32x4 a359 = *(const LAS f32x4*)(Af + 1940);
        r2[28] -= (f32x2v){a355[0], a355[1]} * T27; r2[29] -= (f32x2v){a355[2], a355[3]} * T27;
        const f32x4 a360 = *(const LAS f32x4*)(Af + 1944);
        r2[30] -= (f32x2v){a356[0], a356[1]} * T27; r2[31] -= (f32x2v){a356[2], a356[3]} * T27;
        const f32x4 a361 = *(const LAS f32x4*)(Af + 1948);
        const float t28 = r2[14][0]; const f32x2v T28 = (f32x2v){t28, t28}; Tb[2016 + lane] = f2bf(t28);
        r2[14] -= (f32x2v){a357[0], a357[1]} * T28; r2[15] -= (f32x2v){a357[2], a357[3]} * T28;
        const f32x4 a362 = *(const LAS f32x4*)(Af + 1952);
        r2[16] -= (f32x2v){a358[0], a358[1]} * T28; r2[17] -= (f32x2v){a358[2], a358[3]} * T28;
        const f32x4 a363 = *(const LAS f32x4*)(Af + 1956);
        r2[18] -= (f32x2v){a359[0], a359[1]} * T28; r2[19] -= (f32x2v){a359[2], a359[3]} * T28;
        const f32x4 a364 = *(const LAS f32x4*)(Af + 1960);
        r2[20] -= (f32x2v){a360[0], a360[1]} * T28; r2[21] -= (f32x2v){a360[2], a360[3]} * T28;
        const f32x4 a365 = *(const LAS f32x4*)(Af + 1964);
        r2[22] -= (f32x2v){a361[0], a361[1]} * T28; r2[23] -= (f32x2v){a361[2], a361[3]} * T28;
        const f32x4 a366 = *(const LAS f32x4*)(Af + 2000);
        r2[24] -= (f32x2v){a362[0], a362[1]} * T28; r2[25] -= (f32x2v){a362[2], a362[3]} * T28;
        const f32x4 a367 = *(const LAS f32x4*)(Af + 2004);
        r2[26] -= (f32x2v){a363[0], a363[1]} * T28; r2[27] -= (f32x2v){a363[2], a363[3]} * T28;
        const f32x4 a368 = *(const LAS f32x4*)(Af + 2008);
        r2[28] -= (f32x2v){a364[0], a364[1]} * T28; r2[29] -= (f32x2v){a364[2], a364[3]} * T28;
        const f32x4 a369 = *(const LAS f32x4*)(Af + 2012);
        r2[30] -= (f32x2v){a365[0], a365[1]} * T28; r2[31] -= (f32x2v){a365[2], a365[3]} * T28;
        const f32x4 a370 = *(const LAS f32x4*)(Af + 2016);
        const float t29 = r2[14][1]; const f32x2v T29 = (f32x2v){t29, t29}; Tb[2088 + lane] = f2bf(t29);
        r2[15] -= (f32x2v){a366[2], a366[3]} * T29;
        const f32x4 a371 = *(const LAS f32x4*)(Af + 2020);
        r2[16] -= (f32x2v){a367[0], a367[1]} * T29; r2[17] -= (f32x2v){a367[2], a367[3]} * T29;
        const f32x4 a372 = *(const LAS f32x4*)(Af + 2024);
        r2[18] -= (f32x2v){a368[0], a368[1]} * T29; r2[19] -= (f32x2v){a368[2], a368[3]} * T29;
        const f32x4 a373 = *(const LAS f32x4*)(Af + 2028);
        r2[20] -= (f32x2v){a369[0], a369[1]} * T29; r2[21] -= (f32x2v){a369[2], a369[3]} * T29;
        const f32x4 a374 = *(const LAS f32x4*)(Af + 2032);
        r2[22] -= (f32x2v){a370[0], a370[1]} * T29; r2[23] -= (f32x2v){a370[2], a370[3]} * T29;
        const f32x4 a375 = *(const LAS f32x4*)(Af + 2068);
        r2[24] -= (f32x2v){a371[0], a371[1]} * T29; r2[25] -= (f32x2v){a371[2], a371[3]} * T29;
        const f32x4 a376 = *(const LAS f32x4*)(Af + 2072);
        r2[26] -= (f32x2v){a372[0], a372[1]} * T29; r2[27] -= (f32x2v){a372[2], a372[3]} * T29;
        const f32x4 a377 = *(const LAS f32x4*)(Af + 2076);
        r2[28] -= (f32x2v){a373[0], a373[1]} * T29; r2[29] -= (f32x2v){a373[2], a373[3]} * T29;
        const f32x4 a378 = *(const LAS f32x4*)(Af + 2080);
        r2[30] -= (f32x2v){a374[0], a374[1]} * T29; r2[31] -= (f32x2v){a374[2], a374[3]} * T29;
        const f32x4 a379 = *(const LAS f32x4*)(Af + 2084);
        const float t30 = r2[15][0]; const f32x2v T30 = (f32x2v){t30, t30}; Tb[2160 + lane] = f2bf(t30);
        r2[15] -= (f32x2v){a375[2], a375[3]} * T30;
        const f32x4 a380 = *(const LAS f32x4*)(Af + 2088);
        r2[16] -= (f32x2v){a376[0], a376[1]} * T30; r2[17] -= (f32x2v){a376[2], a376[3]} * T30;
        const f32x4 a381 = *(const LAS f32x4*)(Af + 2092);
        r2[18] -= (f32x2v){a377[0], a377[1]} * T30; r2[19] -= (f32x2v){a377[2], a377[3]} * T30;
        const f32x4 a382 = *(const LAS f32x4*)(Af + 2096);
        r2[20] -= (f32x2v){a378[0], a378[1]} * T30; r2[21] -= (f32x2v){a378[2], a378[3]} * T30;
        const f32x4 a383 = *(const LAS f32x4*)(Af + 2100);
        r2[22] -= (f32x2v){a379[0], a379[1]} * T30; r2[23] -= (f32x2v){a379[2], a379[3]} * T30;
        const f32x4 a384 = *(const LAS f32x4*)(Af + 2140);
        r2[24] -= (f32x2v){a380[0], a380[1]} * T30; r2[25] -= (f32x2v){a380[2], a380[3]} * T30;
        const f32x4 a385 = *(const LAS f32x4*)(Af + 2144);
        r2[26] -= (f32x2v){a381[0], a381[1]} * T30; r2[27] -= (f32x2v){a381[2], a381[3]} * T30;
        const f32x4 a386 = *(const LAS f32x4*)(Af + 2148);
        r2[28] -= (f32x2v){a382[0], a382[1]} * T30; r2[29] -= (f32x2v){a382[2], a382[3]} * T30;
        const f32x4 a387 = *(const LAS f32x4*)(Af + 2152);
        r2[30] -= (f32x2v){a383[0], a383[1]} * T30; r2[31] -= (f32x2v){a383[2], a383[3]} * T30;
        const f32x4 a388 = *(const LAS f32x4*)(Af + 2156);
        const float t31 = r2[15][1]; const f32x2v T31 = (f32x2v){t31, t31}; Tb[2232 + lane] = f2bf(t31);
        r2[16] -= (f32x2v){a384[0], a384[1]} * T31; r2[17] -= (f32x2v){a384[2], a384[3]} * T31;
        const f32x4 a389 = *(const LAS f32x4*)(Af + 2160);
        r2[18] -= (f32x2v){a385[0], a385[1]} * T31; r2[19] -= (f32x2v){a385[2], a385[3]} * T31;
        const f32x4 a390 = *(const LAS f32x4*)(Af + 2164);
        r2[20] -= (f32x2v){a386[0], a386[1]} * T31; r2[21] -= (f32x2v){a386[2], a386[3]} * T31;
        const f32x4 a391 = *(const LAS f32x4*)(Af + 2168);
        r2[22] -= (f32x2v){a387[0], a387[1]} * T31; r2[23] -= (f32x2v){a387[2], a387[3]} * T31;
        const f32x4 a392 = *(const LAS f32x4*)(Af + 2208);
        r2[24] -= (f32x2v){a388[0], a388[1]} * T31; r2[25] -= (f32x2v){a388[2], a388[3]} * T31;
        const f32x4 a393 = *(const LAS f32x4*)(Af + 2212);
        r2[26] -= (f32x2v){a389[0], a389[1]} * T31; r2[27] -= (f32x2v){a389[2], a389[3]} * T31;
        const f32x4 a394 = *(const LAS f32x4*)(Af + 2216);
        r2[28] -= (f32x2v){a390[0], a390[1]} * T31; r2[29] -= (f32x2v){a390[2], a390[3]} * T31;
        const f32x4 a395 = *(const LAS f32x4*)(Af + 2220);
        r2[30] -= (f32x2v){a391[0], a391[1]} * T31; r2[31] -= (f32x2v){a391[2], a391[3]} * T31;
        const f32x4 a396 = *(const LAS f32x4*)(Af + 2224);
        const float t32 = r2[16][0]; const f32x2v T32 = (f32x2v){t32, t32}; Tb[2304 + lane] = f2bf(t32);
        r2[16] -= (f32x2v){a392[0], a392[1]} * T32; r2[17] -= (f32x2v){a392[2], a392[3]} * T32;
        const f32x4 a397 = *(const LAS f32x4*)(Af + 2228);
        r2[18] -= (f32x2v){a393[0], a393[1]} * T32; r2[19] -= (f32x2v){a393[2], a393[3]} * T32;
        const f32x4 a398 = *(const LAS f32x4*)(Af + 2232);
        r2[20] -= (f32x2v){a394[0], a394[1]} * T32; r2[21] -= (f32x2v){a394[2], a394[3]} * T32;
        const f32x4 a399 = *(const LAS f32x4*)(Af + 2236);
        r2[22] -= (f32x2v){a395[0], a395[1]} * T32; r2[23] -= (f32x2v){a395[2], a395[3]} * T32;
        const f32x4 a400 = *(const LAS f32x4*)(Af + 2276);
        r2[24] -= (f32x2v){a396[0], a396[1]} * T32; r2[25] -= (f32x2v){a396[2], a396[3]} * T32;
        const f32x4 a401 = *(const LAS f32x4*)(Af + 2280);
        r2[26] -= (f32x2v){a397[0], a397[1]} * T32; r2[27] -= (f32x2v){a397[2], a397[3]} * T32;
        const f32x4 a402 = *(const LAS f32x4*)(Af + 2284);
        r2[28] -= (f32x2v){a398[0], a398[1]} * T32; r2[29] -= (f32x2v){a398[2], a398[3]} * T32;
        const f32x4 a403 = *(const LAS f32x4*)(Af + 2288);
        r2[30] -= (f32x2v){a399[0], a399[1]} * T32; r2[31] -= (f32x2v){a399[2], a399[3]} * T32;
        const f32x4 a404 = *(const LAS f32x4*)(Af + 2292);
        const float t33 = r2[16][1]; const f32x2v T33 = (f32x2v){t33, t33}; Tb[2376 + lane] = f2bf(t33);
        r2[17] -= (f32x2v){a400[2], a400[3]} * T33;
        const f32x4 a405 = *(const LAS f32x4*)(Af + 2296);
        r2[18] -= (f32x2v){a401[0], a401[1]} * T33; r2[19] -= (f32x2v){a401[2], a401[3]} * T33;
        const f32x4 a406 = *(const LAS f32x4*)(Af + 2300);
        r2[20] -= (f32x2v){a402[0], a402[1]} * T33; r2[21] -= (f32x2v){a402[2], a402[3]} * T33;
        const f32x4 a407 = *(const LAS f32x4*)(Af + 2304);
        r2[22] -= (f32x2v){a403[0], a403[1]} * T33; r2[23] -= (f32x2v){a403[2], a403[3]} * T33;
        const f32x4 a408 = *(const LAS f32x4*)(Af + 2344);
        r2[24] -= (f32x2v){a404[0], a404[1]} * T33; r2[25] -= (f32x2v){a404[2], a404[3]} * T33;
        const f32x4 a409 = *(const LAS f32x4*)(Af + 2348);
        r2[26] -= (f32x2v){a405[0], a405[1]} * T33; r2[27] -= (f32x2v){a405[2], a405[3]} * T33;
        const f32x4 a410 = *(const LAS f32x4*)(Af + 2352);
        r2[28] -= (f32x2v){a406[0], a406[1]} * T33; r2[29] -= (f32x2v){a406[2], a406[3]} * T33;
        const f32x4 a411 = *(const LAS f32x4*)(Af + 2356);
        r2[30] -= (f32x2v){a407[0], a407[1]} * T33; r2[31] -= (f32x2v){a407[2], a407[3]} * T33;
        const f32x4 a412 = *(const LAS f32x4*)(Af + 2360);
        const float t34 = r2[17][0]; const f32x2v T34 = (f32x2v){t34, t34}; Tb[2448 + lane] = f2bf(t34);
        r2[17] -= (f32x2v){a408[2], a408[3]} * T34;
        const f32x4 a413 = *(const LAS f32x4*)(Af + 2364);
        r2[18] -= (f32x2v){a409[0], a409[1]} * T34; r2[19] -= (f32x2v){a409[2], a409[3]} * T34;
        const f32x4 a414 = *(const LAS f32x4*)(Af + 2368);
        r2[20] -= (f32x2v){a410[0], a410[1]} * T34; r2[21] -= (f32x2v){a410[2], a410[3]} * T34;
        const f32x4 a415 = *(const LAS f32x4*)(Af + 2372);
        r2[22] -= (f32x2v){a411[0], a411[1]} * T34; r2[23] -= (f32x2v){a411[2], a411[3]} * T34;
        const f32x4 a416 = *(const LAS f32x4*)(Af + 2416);
        r2[24] -= (f32x2v){a412[0], a412[1]} * T34; r2[25] -= (f32x2v){a412[2], a412[3]} * T34;
        const f32x4 a417 = *(const LAS f32x4*)(Af + 2420);
        r2[26] -= (f32x2v){a413[0], a413[1]} * T34; r2[27] -= (f32x2v){a413[2], a413[3]} * T34;
        const f32x4 a418 = *(const LAS f32x4*)(Af + 2424);
        r2[28] -= (f32x2v){a414[0], a414[1]} * T34; r2[29] -= (f32x2v){a414[2], a414[3]} * T34;
        const f32x4 a419 = *(const LAS f32x4*)(Af + 2428);
        r2[30] -= (f32x2v){a415[0], a415[1]} * T34; r2[31] -= (f32x2v){a415[2], a415[3]} * T34;
        const f32x4 a420 = *(const LAS f32x4*)(Af + 2432);
        const float t35 = r2[17][1]; const f32x2v T35 = (f32x2v){t35, t35}; Tb[2520 + lane] = f2bf(t35);
        r2[18] -= (f32x2v){a416[0], a416[1]} * T35; r2[19] -= (f32x2v){a416[2], a416[3]} * T35;
        const f32x4 a421 = *(const LAS f32x4*)(Af + 2436);
        r2[20] -= (f32x2v){a417[0], a417[1]} * T35; r2[21] -= (f32x2v){a417[2], a417[3]} * T35;
        const f32x4 a422 = *(const LAS f32x4*)(Af + 2440);
        r2[22] -= (f32x2v){a418[0], a418[1]} * T35; r2[23] -= (f32x2v){a418[2], a418[3]} * T35;
        const f32x4 a423 = *(const LAS f32x4*)(Af + 2484);
        r2[24] -= (f32x2v){a419[0], a419[1]} * T35; r2[25] -= (f32x2v){a419[2], a419[3]} * T35;
        const f32x4 a424 = *(const LAS f32x4*)(Af + 2488);
        r2[26] -= (f32x2v){a420[0], a420[1]} * T35; r2[27] -= (f32x2v){a420[2], a420[3]} * T35;
        const f32x4 a425 = *(const LAS f32x4*)(Af + 2492);
        r2[28] -= (f32x2v){a421[0], a421[1]} * T35; r2[29] -= (f32x2v){a421[2], a421[3]} * T35;
        const f32x4 a426 = *(const LAS f32x4*)(Af + 2496);
        r2[30] -= (f32x2v){a422[0], a422[1]} * T35; r2[31] -= (f32x2v){a422[2], a422[3]} * T35;
        const f32x4 a427 = *(const LAS f32x4*)(Af + 2500);
        const float t36 = r2[18][0]; const f32x2v T36 = (f32x2v){t36, t36}; Tb[2592 + lane] = f2bf(t36);
        r2[18] -= (f32x2v){a423[0], a423[1]} * T36; r2[19] -= (f32x2v){a423[2], a423[3]} * T36;
        const f32x4 a428 = *(const LAS f32x4*)(Af + 2504);
        r2[20] -= (f32x2v){a424[0], a424[1]} * T36; r2[21] -= (f32x2v){a424[2], a424[3]} * T36;
        const f32x4 a429 = *(const LAS f32x4*)(Af + 2508);
        r2[22] -= (f32x2v){a425[0], a425[1]} * T36; r2[23] -= (f32x2v){a425[2], a425[3]} * T36;
        const f32x4 a430 = *(const LAS f32x4*)(Af + 2552);
        r2[24] -= (f32x2v){a426[0], a426[1]} * T36; r2[25] -= (f32x2v){a426[2], a426[3]} * T36;
        const f32x4 a431 = *(const LAS f32x4*)(Af + 2556);
        r2[26] -= (f32x2v){a427[0], a427[1]} * T36; r2[27] -= (f32x2v){a427[2], a427[3]} * T36;
        const f32x4 a432 = *(const LAS f32x4*)(Af + 2560);
        r2[28] -= (f32x2v){a428[0], a428[1]} * T36; r2[29] -= (f32x2v){a428[2], a428[3]} * T36;
        const f32x4 a433 = *(const LAS f32x4*)(Af + 2564);
        r2[30] -= (f32x2v){a429[0], a429[1]} * T36; r2[31] -= (f32x2v){a429[2], a429[3]} * T36;
        const f32x4 a434 = *(const LAS f32x4*)(Af + 2568);
        const float t37 = r2[18][1]; const f32x2v T37 = (f32x2v){t37, t37}; Tb[2664 + lane] = f2bf(t37);
        r2[19] -= (f32x2v){a430[2], a430[3]} * T37;
        const f32x4 a435 = *(const LAS f32x4*)(Af + 2572);
        r2[20] -= (f32x2v){a431[0], a431[1]} * T37; r2[21] -= (f32x2v){a431[2], a431[3]} * T37;
        const f32x4 a436 = *(const LAS f32x4*)(Af + 2576);
        r2[22] -= (f32x2v){a432[0], a432[1]} * T37; r2[23] -= (f32x2v){a432[2], a432[3]} * T37;
        const f32x4 a437 = *(const LAS f32x4*)(Af + 2620);
        r2[24] -= (f32x2v){a433[0], a433[1]} * T37; r2[25] -= (f32x2v){a433[2], a433[3]} * T37;
        const f32x4 a438 = *(const LAS f32x4*)(Af + 2624);
        r2[26] -= (f32x2v){a434[0], a434[1]} * T37; r2[27] -= (f32x2v){a434[2], a434[3]} * T37;
        const f32x4 a439 = *(const LAS f32x4*)(Af + 2628);
        r2[28] -= (f32x2v){a435[0], a435[1]} * T37; r2[29] -= (f32x2v){a435[2], a435[3]} * T37;
        const f32x4 a440 = *(const LAS f32x4*)(Af + 2632);
        r2[30] -= (f32x2v){a436[0], a436[1]} * T37; r2[31] -= (f32x2v){a436[2], a436[3]} * T37;
        const f32x4 a441 = *(const LAS f32x4*)(Af + 2636);
        const float t38 = r2[19][0]; const f32x2v T38 = (f32x2v){t38, t38}; Tb[2736 + lane] = f2bf(t38);
        r2[19] -= (f32x2v){a437[2], a437[3]} * T38;
        const f32x4 a442 = *(const LAS f32x4*)(Af + 2640);
        r2[20] -= (f32x2v){a438[0], a438[1]} * T38; r2[21] -= (f32x2v){a438[2], a438[3]} * T38;
        const f32x4 a443 = *(const LAS f32x4*)(Af + 2644);
        r2[22] -= (f32x2v){a439[0], a439[1]} * T38; r2[23] -= (f32x2v){a439[2], a439[3]} * T38;
        const f32x4 a444 = *(const LAS f32x4*)(Af + 2692);
        r2[24] -= (f32x2v){a440[0], a440[1]} * T38; r2[25] -= (f32x2v){a440[2], a440[3]} * T38;
        const f32x4 a445 = *(const LAS f32x4*)(Af + 2696);
        r2[26] -= (f32x2v){a441[0], a441[1]} * T38; r2[27] -= (f32x2v){a441[2], a441[3]} * T38;
        const f32x4 a446 = *(const LAS f32x4*)(Af + 2700);
        r2[28] -= (f32x2v){a442[0], a442[1]} * T38; r2[29] -= (f32x2v){a442[2], a442[3]} * T38;
        const f32x4 a447 = *(const LAS f32x4*)(Af + 2704);
        r2[30] -= (f32x2v){a443[0], a443[1]} * T38; r2[31] -= (f32x2v){a443[2], a443[3]} * T38;
        const f32x4 a448 = *(const LAS f32x4*)(Af + 2708);
        const float t39 = r2[19][1]; const f32x2v T39 = (f32x2v){t39, t39}; Tb[2808 + lane] = f2bf(t39);
        r2[20] -= (f32x2v){a444[0], a444[1]} * T39; r2[21] -= (f32x2v){a444[2], a444[3]} * T39;
        const f32x4 a449 = *(const LAS f32x4*)(Af + 2712);
        r2[22] -= (f32x2v){a445[0], a445[1]} * T39; r2[23] -= (f32x2v){a445[2], a445[3]} * T39;
        const f32x4 a450 = *(const LAS f32x4*)(Af + 2760);
        r2[24] -= (f32x2v){a446[0], a446[1]} * T39; r2[25] -= (f32x2v){a446[2], a446[3]} * T39;
        const f32x4 a451 = *(const LAS f32x4*)(Af + 2764);
        r2[26] -= (f32x2v){a447[0], a447[1]} * T39; r2[27] -= (f32x2v){a447[2], a447[3]} * T39;
        const f32x4 a452 = *(const LAS f32x4*)(Af + 2768);
        r2[28] -= (f32x2v){a448[0], a448[1]} * T39; r2[29] -= (f32x2v){a448[2], a448[3]} * T39;
        const f32x4 a453 = *(const LAS f32x4*)(Af + 2772);
        r2[30] -= (f32x2v){a449[0], a449[1]} * T39; r2[31] -= (f32x2v){a449[2], a449[3]} * T39;
        const f32x4 a454 = *(const LAS f32x4*)(Af + 2776);
        const float t40 = r2[20][0]; const f32x2v T40 = (f32x2v){t40, t40}; Tb[2880 + lane] = f2bf(t40);
        r2[20] -= (f32x2v){a450[0], a450[1]} * T40; r2[21] -= (f32x2v){a450[2], a450[3]} * T40;
        const f32x4 a455 = *(const LAS f32x4*)(Af + 2780);
        r2[22] -= (f32x2v){a451[0], a451[1]} * T40; r2[23] -= (f32x2v){a451[2], a451[3]} * T40;
        const f32x4 a456 = *(const LAS f32x4*)(Af + 2828);
        r2[24] -= (f32x2v){a452[0], a452[1]} * T40; r2[25] -= (f32x2v){a452[2], a452[3]} * T40;
        const f32x4 a457 = *(const LAS f32x4*)(Af + 2832);
        r2[26] -= (f32x2v){a453[0], a453[1]} * T40; r2[27] -= (f32x2v){a453[2], a453[3]} * T40;
        const f32x4 a458 = *(const LAS f32x4*)(Af + 2836);
        r2[28] -= (f32x2v){a454[0], a454[1]} * T40; r2[29] -= (f32x2v){a454[2], a454[3]} * T40;
        const f32x4 a459 = *(const LAS f32x4*)(Af + 2840);
        r2[30] -= (f32x2v){a455[0], a455[1]} * T40; r2[31] -= (f32x2v){a455[2], a455[3]} * T40;
        const f32x4 a460 = *(const LAS f32x4*)(Af + 2844);
        const float t41 = r2[20][1]; const f32x2v T41 = (f32x2v){t41, t41}; Tb[2952 + lane] = f2bf(t41);
        r2[21] -= (f32x2v){a456[2], a456[3]} * T41;
        const f32x4 a461 = *(const LAS f32x4*)(Af + 2848);
        r2[22] -= (f32x2v){a457[0], a457[1]} * T41; r2[23] -= (f32x2v){a457[2], a457[3]} * T41;
        const f32x4 a462 = *(const LAS f32x4*)(Af + 2896);
        r2[24] -= (f32x2v){a458[0], a458[1]} * T41; r2[25] -= (f32x2v){a458[2], a458[3]} * T41;
        const f32x4 a463 = *(const LAS f32x4*)(Af + 2900);
        r2[26] -= (f32x2v){a459[0], a459[1]} * T41; r2[27] -= (f32x2v){a459[2], a459[3]} * T41;
        const f32x4 a464 = *(const LAS f32x4*)(Af + 2904);
        r2[28] -= (f32x2v){a460[0], a460[1]} * T41; r2[29] -= (f32x2v){a460[2], a460[3]} * T41;
        const f32x4 a465 = *(const LAS f32x4*)(Af + 2908);
        r2[30] -= (f32x2v){a461[0], a461[1]} * T41; r2[31] -= (f32x2v){a461[2], a461[3]} * T41;
        const f32x4 a466 = *(const LAS f32x4*)(Af + 2912);
        const float t42 = r2[21][0]; const f32x2v T42 = (f32x2v){t42, t42}; Tb[3024 + lane] = f2bf(t42);
        r2[21] -= (f32x2v){a462[2], a462[3]} * T42;
        const f32x4 a467 = *(const LAS f32x4*)(Af + 2916);
        r2[22] -= (f32x2v){a463[0], a463[1]} * T42; r2[23] -= (f32x2v){a463[2], a463[3]} * T42;
        const f32x4 a468 = *(const LAS f32x4*)(Af + 2968);
        r2[24] -= (f32x2v){a464[0], a464[1]} * T42; r2[25] -= (f32x2v){a464[2], a464[3]} * T42;
        const f32x4 a469 = *(const LAS f32x4*)(Af + 2972);
        r2[26] -= (f32x2v){a465[0], a465[1]} * T42; r2[27] -= (f32x2v){a465[2], a465[3]} * T42;
        const f32x4 a470 = *(const LAS f32x4*)(Af + 2976);
        r2[28] -= (f32x2v){a466[0], a466[1]} * T42; r2[29] -= (f32x2v){a466[2], a466[3]} * T42;
        const f32x4 a471 = *(const LAS f32x4*)(Af + 2980);
        r2[30] -= (f32x2v){a467[0], a467[1]} * T42; r2[31] -= (f32x2v){a467[2], a467[3]} * T42;
        const f32x4 a472 = *(const LAS f32x4*)(Af + 2984);
        const float t43 = r2[21][1]; const f32x2v T43 = (f32x2v){t43, t43}; Tb[3096 + lane] = f2bf(t43);
        r2[22] -= (f32x2v){a468[0], a468[1]} * T43; r2[23] -= (f32x2v){a468[2], a468[3]} * T43;
        const f32x4 a473 = *(const LAS f32x4*)(Af + 3036);
        r2[24] -= (f32x2v){a469[0], a469[1]} * T43; r2[25] -= (f32x2v){a469[2], a469[3]} * T43;
        const f32x4 a474 = *(const LAS f32x4*)(Af + 3040);
        r2[26] -= (f32x2v){a470[0], a470[1]} * T43; r2[27] -= (f32x2v){a470[2], a470[3]} * T43;
        const f32x4 a475 = *(const LAS f32x4*)(Af + 3044);
        r2[28] -= (f32x2v){a471[0], a471[1]} * T43; r2[29] -= (f32x2v){a471[2], a471[3]} * T43;
        const f32x4 a476 = *(const LAS f32x4*)(Af + 3048);
        r2[30] -= (f32x2v){a472[0], a472[1]} * T43; r2[31] -= (f32x2v){a472[2], a472[3]} * T43;
        const f32x4 a477 = *(const LAS f32x4*)(Af + 3052);
        const float t44 = r2[22][0]; const f32x2v T44 = (f32x2v){t44, t44}; Tb[3168 + lane] = f2bf(t44);
        r2[22] -= (f32x2v){a473[0], a473[1]} * T44; r2[23] -= (f32x2v){a473[2], a473[3]} * T44;
        const f32x4 a478 = *(const LAS f32x4*)(Af + 3104);
        r2[24] -= (f32x2v){a474[0], a474[1]} * T44; r2[25] -= (f32x2v){a474[2], a474[3]} * T44;
        const f32x4 a479 = *(const LAS f32x4*)(Af + 3108);
        r2[26] -= (f32x2v){a475[0], a475[1]} * T44; r2[27] -= (f32x2v){a475[2], a475[3]} * T44;
        const f32x4 a480 = *(const LAS f32x4*)(Af + 3112);
        r2[28] -= (f32x2v){a476[0], a476[1]} * T44; r2[29] -= (f32x2v){a476[2], a476[3]} * T44;
        const f32x4 a481 = *(const LAS f32x4*)(Af + 3116);
        r2[30] -= (f32x2v){a477[0], a477[1]} * T44; r2[31] -= (f32x2v){a477[2], a477[3]} * T44;
        const f32x4 a482 = *(const LAS f32x4*)(Af + 3120);
        const float t45 = r2[22][1]; const f32x2v T45 = (f32x2v){t45, t45}; Tb[3240 + lane] = f2bf(t45);
        r2[23] -= (f32x2v){a478[2], a478[3]} * T45;
        const f32x4 a483 = *(const LAS f32x4*)(Af + 3172);
        r2[24] -= (f32x2v){a479[0], a479[1]} * T45; r2[25] -= (f32x2v){a479[2], a479[3]} * T45;
        const f32x4 a484 = *(const LAS f32x4*)(Af + 3176);
        r2[26] -= (f32x2v){a480[0], a480[1]} * T45; r2[27] -= (f32x2v){a480[2], a480[3]} * T45;
        const f32x4 a485 = *(const LAS f32x4*)(Af + 3180);
        r2[28] -= (f32x2v){a481[0], a481[1]} * T45; r2[29] -= (f32x2v){a481[2], a481[3]} * T45;
        const f32x4 a486 = *(const LAS f32x4*)(Af + 3184);
        r2[30] -= (f32x2v){a482[0], a482[1]} * T45; r2[31] -= (f32x2v){a482[2], a482[3]} * T45;
        const f32x4 a487 = *(const LAS f32x4*)(Af + 3188);
        const float t46 = r2[23][0]; const f32x2v T46 = (f32x2v){t46, t46}; Tb[3312 + lane] = f2bf(t46);
        r2[23] -= (f32x2v){a483[2], a483[3]} * T46;
        const f32x4 a488 = *(const LAS f32x4*)(Af + 3244);
        r2[24] -= (f32x2v){a484[0], a484[1]} * T46; r2[25] -= (f32x2v){a484[2], a484[3]} * T46;
        const f32x4 a489 = *(const LAS f32x4*)(Af + 3248);
        r2[26] -= (f32x2v){a485[0], a485[1]} * T46; r2[27] -= (f32x2v){a485[2], a485[3]} * T46;
        const f32x4 a490 = *(const LAS f32x4*)(Af + 3252);
        r2[28] -= (f32x2v){a486[0], a486[1]} * T46; r2[29] -= (f32x2v){a486[2], a486[3]} * T46;
        const f32x4 a491 = *(const LAS f32x4*)(Af + 3256);
        r2[30] -= (f32x2v){a487[0], a487[1]} * T46; r2[31] -= (f32x2v){a487[2], a487[3]} * T46;
        const f32x4 a492 = *(const LAS f32x4*)(Af + 3312);
        const float t47 = r2[23][1]; const f32x2v T47 = (f32x2v){t47, t47}; Tb[3384 + lane] = f2bf(t47);
        r2[24] -= (f32x2v){a488[0], a488[1]} * T47; r2[25] -= (f32x2v){a488[2], a488[3]} * T47;
        const f32x4 a493 = *(const LAS f32x4*)(Af + 3316);
        r2[26] -= (f32x2v){a489[0], a489[1]} * T47; r2[27] -= (f32x2v){a489[2], a489[3]} * T47;
        const f32x4 a494 = *(const LAS f32x4*)(Af + 3320);
        r2[28] -= (f32x2v){a490[0], a490[1]} * T47; r2[29] -= (f32x2v){a490[2], a490[3]} * T47;
        const f32x4 a495 = *(const LAS f32x4*)(Af + 3324);
        r2[30] -= (f32x2v){a491[0], a491[1]} * T47; r2[31] -= (f32x2v){a491[2], a491[3]} * T47;
        const f32x4 a496 = *(const LAS f32x4*)(Af + 3380);
        const float t48 = r2[24][0]; const f32x2v T48 = (f32x2v){t48, t48}; Tb[3456 + lane] = f2bf(t48);
        r2[24] -= (f32x2v){a492[0], a492[1]} * T48; r2[25] -= (f32x2v){a492[2], a492[3]} * T48;
        const f32x4 a497 = *(const LAS f32x4*)(Af + 3384);
        r2[26] -= (f32x2v){a493[0], a493[1]} * T48; r2[27] -= (f32x2v){a493[2], a493[3]} * T48;
        const f32x4 a498 = *(const LAS f32x4*)(Af + 3388);
        r2[28] -= (f32x2v){a494[0], a494[1]} * T48; r2[29] -= (f32x2v){a494[2], a494[3]} * T48;
        const f32x4 a499 = *(const LAS f32x4*)(Af + 3392);
        r2[30] -= (f32x2v){a495[0], a495[1]} * T48; r2[31] -= (f32x2v){a495[2], a495[3]} * T48;
        const f32x4 a500 = *(const LAS f32x4*)(Af + 3448);
        const float t49 = r2[24][1]; const f32x2v T49 = (f32x2v){t49, t49}; Tb[3528 + lane] = f2bf(t49);
        r2[25] -= (f32x2v){a496[2], a496[3]} * T49;
        const f32x4 a501 = *(const LAS f32x4*)(Af + 3452);
        r2[26] -= (f32x2v){a497[0], a497[1]} * T49; r2[27] -= (f32x2v){a497[2], a497[3]} * T49;
        const f32x4 a502 = *(const LAS f32x4*)(Af + 3456);
        r2[28] -= (f32x2v){a498[0], a498[1]} * T49; r2[29] -= (f32x2v){a498[2], a498[3]} * T49;
        const f32x4 a503 = *(const LAS f32x4*)(Af + 3460);
        r2[30] -= (f32x2v){a499[0], a499[1]} * T49; r2[31] -= (f32x2v){a499[2], a499[3]} * T49;
        const f32x4 a504 = *(const LAS f32x4*)(Af + 3520);
        const float t50 = r2[25][0]; const f32x2v T50 = (f32x2v){t50, t50}; Tb[3600 + lane] = f2bf(t50);
        r2[25] -= (f32x2v){a500[2], a500[3]} * T50;
        const f32x4 a505 = *(const LAS f32x4*)(Af + 3524);
        r2[26] -= (f32x2v){a501[0], a501[1]} * T50; r2[27] -= (f32x2v){a501[2], a501[3]} * T50;
        const f32x4 a506 = *(const LAS f32x4*)(Af + 3528);
        r2[28] -= (f32x2v){a502[0], a502[1]} * T50; r2[29] -= (f32x2v){a502[2], a502[3]} * T50;
        const f32x4 a507 = *(const LAS f32x4*)(Af + 3588);
        r2[30] -= (f32x2v){a503[0], a503[1]} * T50; r2[31] -= (f32x2v){a503[2], a503[3]} * T50;
        const f32x4 a508 = *(const LAS f32x4*)(Af + 3592);
        const float t51 = r2[25][1]; const f32x2v T51 = (f32x2v){t51, t51}; Tb[3672 + lane] = f2bf(t51);
        r2[26] -= (f32x2v){a504[0], a504[1]} * T51; r2[27] -= (f32x2v){a504[2], a504[3]} * T51;
        const f32x4 a509 = *(const LAS f32x4*)(Af + 3596);
        r2[28] -= (f32x2v){a505[0], a505[1]} * T51; r2[29] -= (f32x2v){a505[2], a505[3]} * T51;
        const f32x4 a510 = *(const LAS f32x4*)(Af + 3656);
        r2[30] -= (f32x2v){a506[0], a506[1]} * T51; r2[31] -= (f32x2v){a506[2], a506[3]} * T51;
        const f32x4 a511 = *(const LAS f32x4*)(Af + 3660);
        const float t52 = r2[26][0]; const f32x2v T52 = (f32x2v){t52, t52}; Tb[3744 + lane] = f2bf(t52);
        r2[26] -= (f32x2v){a507[0], a507[1]} * T52; r2[27] -= (f32x2v){a507[2], a507[3]} * T52;
        const f32x4 a512 = *(const LAS f32x4*)(Af + 3664);
        r2[28] -= (f32x2v){a508[0], a508[1]} * T52; r2[29] -= (f32x2v){a508[2], a508[3]} * T52;
        const f32x4 a513 = *(const LAS f32x4*)(Af + 3724);
        r2[30] -= (f32x2v){a509[0], a509[1]} * T52; r2[31] -= (f32x2v){a509[2], a509[3]} * T52;
        const f32x4 a514 = *(const LAS f32x4*)(Af + 3728);
        const float t53 = r2[26][1]; const f32x2v T53 = (f32x2v){t53, t53}; Tb[3816 + lane] = f2bf(t53);
        r2[27] -= (f32x2v){a510[2], a510[3]} * T53;
        const f32x4 a515 = *(const LAS f32x4*)(Af + 3732);
        r2[28] -= (f32x2v){a511[0], a511[1]} * T53; r2[29] -= (f32x2v){a511[2], a511[3]} * T53;
        const f32x4 a516 = *(const LAS f32x4*)(Af + 3796);
        r2[30] -= (f32x2v){a512[0], a512[1]} * T53; r2[31] -= (f32x2v){a512[2], a512[3]} * T53;
        const f32x4 a517 = *(const LAS f32x4*)(Af + 3800);
        const float t54 = r2[27][0]; const f32x2v T54 = (f32x2v){t54, t54}; Tb[3888 + lane] = f2bf(t54);
        r2[27] -= (f32x2v){a513[2], a513[3]} * T54;
        const f32x4 a518 = *(const LAS f32x4*)(Af + 3864);
        r2[28] -= (f32x2v){a514[0], a514[1]} * T54; r2[29] -= (f32x2v){a514[2], a514[3]} * T54;
        const f32x4 a519 = *(const LAS f32x4*)(Af + 3868);
        r2[30] -= (f32x2v){a515[0], a515[1]} * T54; r2[31] -= (f32x2v){a515[2], a515[3]} * T54;
        const f32x4 a520 = *(const LAS f32x4*)(Af + 3932);
        const float t55 = r2[27][1]; const f32x2v T55 = (f32x2v){t55, t55}; Tb[3960 + lane] = f2bf(t55);
        r2[28] -= (f32x2v){a516[0], a516[1]} * T55; r2[29] -= (f32x2v){a516[2], a516[3]} * T55;
        const f32x4 a521 = *(const LAS f32x4*)(Af + 3936);
        r2[30] -= (f32x2v){a517[0], a517[1]} * T55; r2[31] -= (f32x2v){a517[2], a517[3]} * T55;
        const f32x4 a522 = *(const LAS f32x4*)(Af + 4000);
        const float t56 = r2[28][0]; const f32x2v T56 = (f32x2v){t56, t56}; Tb[4032 + lane] = f2bf(t56);
        r2[28] -= (f32x2v){a518[0], a518[1]} * T56; r2[29] -= (f32x2v){a518[2], a518[3]} * T56;
        const f32x4 a523 = *(const LAS f32x4*)(Af + 4004);
        r2[30] -= (f32x2v){a519[0], a519[1]} * T56; r2[31] -= (f32x2v){a519[2], a519[3]} * T56;
        const f32x4 a524 = *(const LAS f32x4*)(Af + 4072);
        const float t57 = r2[28][1]; const f32x2v T57 = (f32x2v){t57, t57}; Tb[4104 + lane] = f2bf(t57);
        r2[29] -= (f32x2v){a520[2], a520[3]} * T57;
        const f32x4 a525 = *(const LAS f32x4*)(Af + 4140);
        r2[30] -= (f32x2v){a521[0], a521[1]} * T57; r2[31] -= (f32x2v){a521[2], a521[3]} * T57;
        const f32x4 a526 = *(const LAS f32x4*)(Af + 4208);
        const float t58 = r2[29][0]; const f32x2v T58 = (f32x2v){t58, t58}; Tb[4176 + lane] = f2bf(t58);
        r2[29] -= (f32x2v){a522[2], a522[3]} * T58;
        const f32x4 a527 = *(const LAS f32x4*)(Af + 4276);
        r2[30] -= (f32x2v){a523[0], a523[1]} * T58; r2[31] -= (f32x2v){a523[2], a523[3]} * T58;
        const float t59 = r2[29][1]; const f32x2v T59 = (f32x2v){t59, t59}; Tb[4248 + lane] = f2bf(t59);
        r2[30] -= (f32x2v){a524[0], a524[1]} * T59; r2[31] -= (f32x2v){a524[2], a524[3]} * T59;
        const float t60 = r2[30][0]; const f32x2v T60 = (f32x2v){t60, t60}; Tb[4320 + lane] = f2bf(t60);
        r2[30] -= (f32x2v){a525[0], a525[1]} * T60; r2[31] -= (f32x2v){a525[2], a525[3]} * T60;
        const float t61 = r2[30][1]; const f32x2v T61 = (f32x2v){t61, t61}; Tb[4392 + lane] = f2bf(t61);
        r2[31] -= (f32x2v){a526[2], a526[3]} * T61;
        const float t62 = r2[31][0]; const f32x2v T62 = (f32x2v){t62, t62}; Tb[4464 + lane] = f2bf(t62);
        r2[31] -= (f32x2v){a527[2], a527[3]} * T62;
        Tb[4536 + lane] = f2bf(r2[31][1]);
    }
    __syncthreads();
#pragma unroll 2
    for (int r = 0; r < 8; ++r) {
        const int job = wid + 8 * r, kind = job >> 5, tile = job & 31, mt = tile >> 3, nt = tile & 7;
        const f32x4 acc = tile_mm(Tb, 72, mt, kind ? KbT : VbT, 72, nt, 2, fr, fq);
        u32x2 w; w.x = cvt_pk(acc[0], acc[1]); w.y = cvt_pk(acc[2], acc[3]);
        *(LAS u32x2*)((kind ? WT : UT) + (16 * nt + fr) * 72 + 16 * mt + 4 * fq) = w;
    }
    __syncthreads();
    bf16_t* GM = (bf16_t*)(p.ws + WS_GM) + (size_t)unit * 16384; bf16_t* GN = (bf16_t*)(p.ws + WS_GN) + (size_t)unit * 16384;
    bf16_t* GQ = (bf16_t*)(p.ws + WS_GQ) + (size_t)unit * 8192; bf16_t* GO = (bf16_t*)(p.ws + WS_GO) + (size_t)unit * 8192;
#pragma unroll 2
    for (int r = 0; r < 24; ++r) {
        const int job = wid + 8 * r;
        if (job < 64) { const int a = job >> 3, mt = job & 7;
            const f32x4 acc = tile_mm(WT, 72, a, KdT, 72, mt, 2, fr, fq);
            u32x2 w; w.x = cvt_pk(-acc[0], -acc[1]); w.y = cvt_pk(-acc[2], -acc[3]);
            *(u32x2*)(GM + ((mt * 4 + (a >> 1)) * 64 + lane) * 8 + (a & 1) * 4) = w;
        } else if (job < 128) { const int j = job - 64, mt = j >> 3, nt = j & 7;
            const f32x4 acc = tile_mm(KdT, 72, mt, UT, 72, nt, 2, fr, fq);
            u32x2 w; w.x = cvt_pk(acc[0], acc[1]); w.y = cvt_pk(acc[2], acc[3]);
            *(u32x2*)(GN + ((nt * 64 + lane) * 8 + mt) * 4) = w;
        } else if (job < 160) { const int j = job - 128, a = j >> 2, it = j & 3;
            const f32x4 acc = tile_mm(WT, 72, a, QK, 72, it, 2, fr, fq);
            const int i = 16 * it + fr; const float eg = __expf(gcs[i]);
            const u32x2 qv = *(const LAS u32x2*)(Qs + i * 136 + 16 * a + 4 * fq);
            u32x2 w; w.x = cvt_pk(bflo(qv.x) * eg - acc[0], bfhi(qv.x) * eg - acc[1]); w.y = cvt_pk(bflo(qv.y) * eg - acc[2], bfhi(qv.y) * eg - acc[3]);
            *(u32x2*)(GQ + ((it * 4 + (a >> 1)) * 64 + lane) * 8 + (a & 1) * 4) = w;
        } else { const int j = job - 160, mt = j >> 3, nt = j & 7;
            const f32x4 acc = tile_mm(QK, 72, mt, UT, 72, nt, 2, fr, fq);
            u32x2 w; w.x = cvt_pk(acc[0], acc[1]); w.y = cvt_pk(acc[2], acc[3]);
            *(u32x2*)(GO + ((nt * 64 + lane) * 4 + mt) * 4) = w;
        }
    }
    if (tid == 0) ((float*)(p.ws + WS_CTL + CTL_GLAST))[unit] = __expf(gclast);
    __syncthreads();
}

__device__ __forceinline__ void gdn_scan(const Params& p, LAS unsigned char* lds, int sb) {
    const int tid = threadIdx.x, lane = tid & 63, wid = tid >> 6, fr = lane & 15, fq = lane >> 4;
    const int bh = sb / (8 / CW), sp = sb % (8 / CW), unit0 = bh * 128, sl = sp * CW + wid;
    const u32x4* GMb = (const u32x4*)((const bf16_t*)(p.ws + WS_GM) + (size_t)unit0 * 16384);
    const u32x4* GQb = (const u32x4*)((const bf16_t*)(p.ws + WS_GQ) + (size_t)unit0 * 8192);
    const bf16_t* GNb = (const bf16_t*)(p.ws + WS_GN) + (size_t)unit0 * 16384;
    bf16_t* GOb = (bf16_t*)(p.ws + WS_GO) + (size_t)unit0 * 8192;
    const float* glast = (const float*)(p.ws + WS_CTL + CTL_GLAST) + unit0;
    const bool loader = (wid >= CW && wid < CW + 4);
#define SCAN_DMA(cc) do { _Pragma("unroll") for (int k = 0; k < 8; ++k) { const int inst = (wid - CW) * 8 + k; \
        __builtin_amdgcn_global_load_lds((const unsigned*)((const char*)(GMb + (size_t)(cc) * 2048) + inst * 1024 + lane * 16), (LAS unsigned*)(lds + ((cc) & 3) * 32768 + inst * 1024), 16, 0, 0); } } while (0)
#define SCAN_LOADN(dn, cc) do { _Pragma("unroll") for (int i = 0; i < 4; ++i) dn[i] = *(const u32x4*)(GNb + (size_t)(cc) * 16384 + (size_t)(sl * 64 + lane) * 32 + i * 8); } while (0)
#define SCAN_STEP(c, nn, RELOAD) do { \
        const float gl = __shfl(((c) < 64) ? glr0 : glr1, (c) & 63); bf16x8 Sb[4]; \
        bf16_t* scp = (bf16_t*)GNb + (size_t)(c) * 16384 + (size_t)sl * 2048 + lane * 8; \
        _Pragma("unroll") for (int ks = 0; ks < 4; ++ks) { u32x4 w; w.x = cvt_pk(S[2 * ks][0], S[2 * ks][1]); w.y = cvt_pk(S[2 * ks][2], S[2 * ks][3]); \
            w.z = cvt_pk(S[2 * ks + 1][0], S[2 * ks + 1][1]); w.w = cvt_pk(S[2 * ks + 1][2], S[2 * ks + 1][3]); Sb[ks] = __builtin_bit_cast(bf16x8, w); } \
        const LAS unsigned char* slot = lds + ((c) & 3) * 32768 + lane * 16; \
        bf16x8 fa[2][2][4]; \
        _Pragma("unroll") for (int ks = 0; ks < 4; ++ks) { fa[0][0][ks] = *(const LAS bf16x8*)(slot + (0 * 4 + ks) * 1024); fa[0][1][ks] = *(const LAS bf16x8*)(slot + (1 * 4 + ks) * 1024); } \
        _Pragma("unroll") for (int mt = 0; mt < 8; ++mt) { const unsigned w0 = nn[mt >> 1][(mt & 1) * 2], w1 = nn[mt >> 1][(mt & 1) * 2 + 1]; \
            S[mt] = S[mt] * gl + (f32x4){bflo(w0), bfhi(w0), bflo(w1), bfhi(w1)}; } \
        _Pragma("unroll") for (int ks = 0; ks < 4; ++ks) *(u32x4*)(scp + ks * 512) = __builtin_bit_cast(u32x4, Sb[ks]);     \
        RELOAD; \
        _Pragma("unroll") for (int pr = 0; pr < 4; ++pr) { \
            if (pr < 3) { _Pragma("unroll") for (int ks = 0; ks < 4; ++ks) { fa[(pr + 1) & 1][0][ks] = *(const LAS bf16x8*)(slot + ((2 * pr + 2) * 4 + ks) * 1024); fa[(pr + 1) & 1][1][ks] = *(const LAS bf16x8*)(slot + ((2 * pr + 3) * 4 + ks) * 1024); } } \
            _Pragma("unroll") for (int ks = 0; ks < 4; ++ks) { S[2 * pr] = mfma16(fa[pr & 1][0][ks], Sb[ks], S[2 * pr]); S[2 * pr + 1] = mfma16(fa[pr & 1][1][ks], Sb[ks], S[2 * pr + 1]); } } \
        } while (0)
    if (loader) { SCAN_DMA(0); SCAN_DMA(1); SCAN_DMA(2); asm volatile("s_waitcnt vmcnt(0)" ::: "memory"); }
    f32x4 S[8];
#pragma unroll
    for (int mt = 0; mt < 8; ++mt) S[mt] = (f32x4){0.f, 0.f, 0.f, 0.f};
    const float glr0 = glast[lane], glr1 = glast[64 + lane];
    u32x4 nnA[4], nnB[4];
    if (wid < CW) { SCAN_LOADN(nnA, 0); SCAN_LOADN(nnB, 1); }
    asm volatile("s_waitcnt lgkmcnt(0)" ::: "memory"); __builtin_amdgcn_s_barrier(); asm volatile("" ::: "memory");
#pragma unroll 1
    for (int c = 0; c < 128; c += 2) {
        if (loader) { if (c + 3 < 128) { SCAN_DMA(c + 3); asm volatile("s_waitcnt vmcnt(16)" ::: "memory"); } else asm volatile("s_waitcnt vmcnt(0)" ::: "memory"); }
        else if (wid < CW) { SCAN_STEP(c, nnA, if (c + 2 < 128) SCAN_LOADN(nnA, c + 2)); }
        asm volatile("s_waitcnt lgkmcnt(0)" ::: "memory"); __builtin_amdgcn_s_barrier(); asm volatile("" ::: "memory");
        if (loader) { if (c + 4 < 128) { SCAN_DMA(c + 4); asm volatile("s_waitcnt vmcnt(16)" ::: "memory"); } else asm volatile("s_waitcnt vmcnt(0)" ::: "memory"); }
        else if (wid < CW) { SCAN_STEP(c + 1, nnB, if (c + 3 < 128) SCAN_LOADN(nnB, c + 3)); }
        asm volatile("s_waitcnt lgkmcnt(0)" ::: "memory"); __builtin_amdgcn_s_barrier(); asm volatile("" ::: "memory");
    }
#undef SCAN_DMA
#undef SCAN_LOADN
#undef SCAN_STEP
    __syncthreads();
    if (wid < CW) {
        float* go = p.out + O_GP + (size_t)bh * 16384;
#pragma unroll
        for (int mt = 0; mt < 8; ++mt)
#pragma unroll
            for (int e = 0; e < 4; ++e) go[(16 * mt + 4 * fq + e) * 128 + sl * 16 + fr] = S[mt][e];
    }
}

__device__ __forceinline__ void gdn_gate_unit(const Params& p, int unit, int lane) {
    const int fr = lane & 15, fq = lane >> 4, bh = unit >> 7, n = unit & 127, b = bh >> 2, h = bh & 3, tok0 = b * SEQ + n * 64;
    const bf16_t* GO = (const bf16_t*)(p.ws + WS_GO) + (size_t)unit * 8192;
    bf16_t* PB = (bf16_t*)(p.ws + WS_H);
    {
        bf16_t* GOw = (bf16_t*)(p.ws + WS_GO) + (size_t)unit * 8192;
        const bf16_t* GQ = (const bf16_t*)(p.ws + WS_GQ) + (size_t)unit * 8192; const bf16_t* SC = (const bf16_t*)(p.ws + WS_GN) + (size_t)unit * 16384;
        bf16x8 qa[4][4];
#pragma unroll
        for (int mt = 0; mt < 4; ++mt)
#pragma unroll
            for (int ks = 0; ks < 4; ++ks) qa[mt][ks] = *(const bf16x8*)(GQ + ((mt * 4 + ks) * 64 + lane) * 8);
#pragma unroll 2
        for (int nt = 0; nt < 8; ++nt) {
            bf16x8 sb[4];
#pragma unroll
            for (int ks = 0; ks < 4; ++ks) sb[ks] = *(const bf16x8*)(SC + nt * 2048 + (ks * 64 + lane) * 8);
            const u32x4 o0 = *(const u32x4*)(GOw + (nt * 64 + lane) * 16), o1 = *(const u32x4*)(GOw + (nt * 64 + lane) * 16 + 8);
            f32x4 acc[4];
            acc[0] = (f32x4){bflo(o0.x), bfhi(o0.x), bflo(o0.y), bfhi(o0.y)}; acc[1] = (f32x4){bflo(o0.z), bfhi(o0.z), bflo(o0.w), bfhi(o0.w)};
            acc[2] = (f32x4){bflo(o1.x), bfhi(o1.x), bflo(o1.y), bfhi(o1.y)}; acc[3] = (f32x4){bflo(o1.z), bfhi(o1.z), bflo(o1.w), bfhi(o1.w)};
#pragma unroll
            for (int ks = 0; ks < 4; ++ks)
#pragma unroll
                for (int mt = 0; mt < 4; ++mt) acc[mt] = mfma16(qa[mt][ks], sb[ks], acc[mt]);
            u32x4 w0, w1;
            w0.x = cvt_pk(acc[0][0], acc[0][1]); w0.y = cvt_pk(acc[0][2], acc[0][3]); w0.z = cvt_pk(acc[1][0], acc[1][1]); w0.w = cvt_pk(acc[1][2], acc[1][3]);
            w1.x = cvt_pk(acc[2][0], acc[2][1]); w1.y = cvt_pk(acc[2][2], acc[2][3]); w1.z = cvt_pk(acc[3][0], acc[3][1]); w1.w = cvt_pk(acc[3][2], acc[3][3]);
            *(u32x4*)(GOw + (nt * 64 + lane) * 16) = w0; *(u32x4*)(GOw + (nt * 64 + lane) * 16 + 8) = w1;
        }
        asm volatile("s_waitcnt vmcnt(0)" ::: "memory");
    }
    float ssq[16];
#pragma unroll
    for (int k = 0; k < 16; ++k) ssq[k] = 0.f;
#pragma unroll 1
    for (int nt = 0; nt < 8; ++nt) {
        const u32x4 a0 = *(const u32x4*)(GO + (nt * 64 + lane) * 16), a1 = *(const u32x4*)(GO + (nt * 64 + lane) * 16 + 8);
#pragma unroll
        for (int k = 0; k < 4; ++k) { const float l0 = bflo(a0[k]), h0 = bfhi(a0[k]), l1 = bflo(a1[k]), h1 = bfhi(a1[k]);
            ssq[2 * k] += l0 * l0; ssq[2 * k + 1] += h0 * h0; ssq[8 + 2 * k] += l1 * l1; ssq[8 + 2 * k + 1] += h1 * h1; }
    }
#pragma unroll
    for (int k = 0; k < 16; ++k) { float s = ssq[k]; s += __shfl_xor(s, 1); s += __shfl_xor(s, 2); s += __shfl_xor(s, 4); s += __shfl_xor(s, 8); ssq[k] = rsqrtf(s * (1.0f / 128.0f) + EPS); }
    const float* gn = p.in[15];
#pragma unroll 1
    for (int nt = 0; nt < 8; ++nt) {
        const int dv = 16 * nt + fr; const float g = gn[dv];
        const u32x4 a0 = *(const u32x4*)(GO + (nt * 64 + lane) * 16), a1 = *(const u32x4*)(GO + (nt * 64 + lane) * 16 + 8);
        const bf16_t* gzp = PB + (size_t)(tok0 + 4 * fq) * PW + 2304 + h * 128 + dv; bf16_t* mp = PB + (size_t)(tok0 + 4 * fq) * PW + 512 + h * 128 + dv;
#pragma unroll
        for (int k = 0; k < 16; ++k) {
            const unsigned w = (k < 8) ? a0[(k >> 1) & 3] : a1[(k >> 1) & 3]; const float o = (k & 1) ? bfhi(w) : bflo(w);
            const int to = 16 * (k >> 2) + (k & 3);
            const float gz = bf2f(gzp[(size_t)to * PW]);
            mp[(size_t)to * PW] = f2bf(o * ssq[k] * g * silu(gz));
        }
    }
}

__device__ __forceinline__ void attn_unit(const Params& p, LAS unsigned char* lds, int unit) {
    const int tid = threadIdx.x, lane = tid & 63, wid = tid >> 6, fr = lane & 15, fq = lane >> 4;
    const int b = unit >> 7, blk = (unit >> 1) & 63, kvh = unit & 1;
    LAS bf16_t* Ks = (LAS bf16_t*)lds; LAS bf16_t* Vt = (LAS bf16_t*)(lds + 36864);
    bf16_t* PB = (bf16_t*)(p.ws + WS_H);
    __syncthreads();
#pragma unroll
    for (int i = 0; i < 4; ++i) {
        const int q = tid + 512 * i, row = q >> 3, ch = q & 7, tp = blk * 128 - 128 + row;
        u32x4 kv = (u32x4){0u, 0u, 0u, 0u}, vv = (u32x4){0u, 0u, 0u, 0u};
        if (tp >= 0) { const bf16_t* base = PB + (size_t)(b * SEQ + tp) * PW; kv = *(const u32x4*)(base + 512 + kvh * 64 + ch * 8); vv = *(const u32x4*)(base + 640 + kvh * 64 + ch * 8); }
        *(LAS u32x4*)(Ks + row * 72 + ch * 8) = kv;
#pragma unroll
        for (int e = 0; e < 4; ++e) { const unsigned w = vv[e]; Vt[(ch * 8 + 2 * e) * 264 + row] = (bf16_t)(w & 0xffffu); Vt[(ch * 8 + 2 * e + 1) * 264 + row] = (bf16_t)(w >> 16); }
    }
    __syncthreads();
    const int qtok = b * SEQ + blk * 128 + 16 * wid + fr;
#pragma unroll 1
    for (int g = 0; g < 4; ++g) {
        const int h = kvh * 4 + g; const float slope = exp2f(-(float)(h + 1)), sink = p.in[11][h];
        bf16x8 qf[2];
#pragma unroll
        for (int ks = 0; ks < 2; ++ks) qf[ks] = *(const bf16x8*)(PB + (size_t)qtok * PW + h * 64 + ks * 32 + 8 * fq);
        f32x4 s[10]; float mx = sink;
#pragma unroll
        for (int j = 0; j < 10; ++j) {
            const int ct = (wid + j) < 15 ? (wid + j) : 15;
            f32x4 acc = (f32x4){0.f, 0.f, 0.f, 0.f};
#pragma unroll
            for (int ks = 0; ks < 2; ++ks) acc = mfma16(*(const LAS bf16x8*)(Ks + (16 * ct + fr) * 72 + ks * 32 + 8 * fq), qf[ks], acc);
#pragma unroll
            for (int e = 0; e < 4; ++e) {
                const int c = 16 * (wid + j) + 4 * fq + e, dist = 16 * wid + fr - c + 128;
                const bool ok = (wid + j <= 15) && dist >= 0 && dist <= 128 && (blk * 128 + c - 128 >= 0);
                const float v = ok ? acc[e] * 0.125f - slope * (float)dist : -INFINITY;
                acc[e] = v; mx = fmaxf(mx, v);
            }
            s[j] = acc;
            asm volatile("" ::: "memory");
        }
        mx = fmaxf(mx, __shfl_xor(mx, 16)); mx = fmaxf(mx, __shfl_xor(mx, 32));
        float sum = 0.f;
#pragma unroll
        for (int j = 0; j < 10; ++j)
#pragma unroll
            for (int e = 0; e < 4; ++e) { const float pv = __expf(s[j][e] - mx); s[j][e] = pv; sum += pv; }
        sum += __shfl_xor(sum, 16); sum += __shfl_xor(sum, 32);
        sum += __expf(sink - mx);
        const float inv = 1.0f / sum;
        bf16x8 pb[5];
#pragma unroll
        for (int kk = 0; kk < 5; ++kk) { u32x4 w; w.x = cvt_pk(s[2 * kk][0] * inv, s[2 * kk][1] * inv); w.y = cvt_pk(s[2 * kk][2] * inv, s[2 * kk][3] * inv);
            w.z = cvt_pk(s[2 * kk + 1][0] * inv, s[2 * kk + 1][1] * inv); w.w = cvt_pk(s[2 * kk + 1][2] * inv, s[2 * kk + 1][3] * inv); pb[kk] = __builtin_bit_cast(bf16x8, w); }
#pragma unroll
        for (int dt = 0; dt < 4; ++dt) {
            f32x4 acc = (f32x4){0.f, 0.f, 0.f, 0.f};
#pragma unroll
            for (int kk = 0; kk < 5; ++kk) {
                const int c0 = (wid + 2 * kk) < 15 ? (wid + 2 * kk) : 15, c1 = (wid + 2 * kk + 1) < 15 ? (wid + 2 * kk + 1) : 15;
                const u32x2 lo = *(const LAS u32x2*)(Vt + (16 * dt + fr) * 264 + 16 * c0 + 4 * fq), hi = *(const LAS u32x2*)(Vt + (16 * dt + fr) * 264 + 16 * c1 + 4 * fq);
                const u32x4 a = (u32x4){lo.x, lo.y, hi.x, hi.y};
                acc = mfma16(__builtin_bit_cast(bf16x8, a), pb[kk], acc);
            }
            u32x2 w; w.x = cvt_pk(acc[0], acc[1]); w.y = cvt_pk(acc[2], acc[3]);
            *(u32x2*)(PB + (size_t)qtok * PW + h * 64 + 16 * dt + 4 * fq) = w;
            asm volatile("" ::: "memory");
        }
    }
}

__device__ __forceinline__ void sattn_unit(const Params& p, int s, int h, int lane) {
    const int kvh = h >> 2; const bool wr = (h & 3) == 0;
    bf16_t* PB = (bf16_t*)(p.ws + WS_H) + (size_t)(MPR + s) * PW;
    const float* ck = p.in[2] + (size_t)s * 128 * 128 + kvh * 64 + lane; const float* cv = p.in[3] + (size_t)s * 128 * 128 + kvh * 64 + lane;
    float* nk = p.out + O_KS + (size_t)s * 128 * 128 + kvh * 64 + lane; float* nv = p.out + O_VS + (size_t)s * 128 * 128 + kvh * 64 + lane;
    const float q = bf2f(PB[h * 64 + lane]) * 0.125f, slope = exp2f(-(float)(h + 1)), sink = p.in[11][h];
    const float knew = bf2f(PB[512 + kvh * 64 + lane]), vnew = bf2f(PB[640 + kvh * 64 + lane]);
    float sc[3];
#pragma unroll
    for (int t = 0; t < 2; ++t) {
#pragma unroll 8
        for (int jj = 0; jj < 64; ++jj) {
            const int j = t * 64 + jj; const float kval = ck[(size_t)j * 128];
            if (wr && j >= 1) nk[(size_t)(j - 1) * 128] = kval;
            const float d = wave_sum(q * kval) - slope * (float)(128 - j); if (lane == jj) sc[t] = d;
        }
    }
    if (wr) nk[(size_t)127 * 128] = knew;
    sc[2] = wave_sum(q * knew);
    const float mx = fmaxf(fmaxf(wave_max(fmaxf(sc[0], sc[1])), sc[2]), sink);
    const float p0 = __expf(sc[0] - mx), p1 = __expf(sc[1] - mx), p2 = __expf(sc[2] - mx);
    const float inv = 1.0f / (wave_sum(p0 + p1) + p2 + __expf(sink - mx));
    float o = p2 * vnew;
#pragma unroll 8
    for (int jj = 0; jj < 64; ++jj) { const float vval = cv[(size_t)jj * 128]; if (wr && jj >= 1) nv[(size_t)(jj - 1) * 128] = vval; o += __shfl(p0, jj) * vval; }
#pragma unroll 8
    for (int jj = 0; jj < 64; ++jj) { const float vval = cv[(size_t)(64 + jj) * 128]; if (wr) nv[(size_t)(63 + jj) * 128] = vval; o += __shfl(p1, jj) * vval; }
    if (wr) nv[(size_t)127 * 128] = vnew;
    asm volatile("" ::: "memory");
    PB[h * 64 + lane] = f2bf(o * inv);
}

__device__ __forceinline__ void sgdn_unit(const Params& p, LAS unsigned char* lds, int s) {
    const int tid = threadIdx.x, wid = tid >> 6, h = tid >> 7, dv = tid & 127;
    LAS float* qs = (LAS float*)lds; LAS float* ks = qs + 512; LAS float* red = ks + 512;
    bf16_t* PB = (bf16_t*)(p.ws + WS_H) + (size_t)(MPR + s) * PW; const float* GBA = (const float*)(p.ws + WS_GBA) + (size_t)(MPR + s) * 8;
    const float* cw = p.in[12]; const float* hc = p.in[4] + (size_t)s * 3 * CONVC; float* nc = p.out + O_CS + (size_t)s * 3 * CONVC;
    __syncthreads();
    float val[3];
#pragma unroll
    for (int i = 0; i < 3; ++i) {
        const int c = i * 512 + tid; const float x3 = bf2f(PB[768 + c]), h0 = hc[c], h1 = hc[CONVC + c], h2 = hc[2 * CONVC + c];
        val[i] = silu(cw[c] * h0 + cw[CONVC + c] * h1 + cw[2 * CONVC + c] * h2 + cw[3 * CONVC + c] * x3);
        nc[c] = h1; nc[CONVC + c] = h2; nc[2 * CONVC + c] = x3;
    }
    const float sq = wave_sum(val[0] * val[0]), sk = wave_sum(val[1] * val[1]);
    if ((tid & 63) == 0) { red[wid] = sq; red[8 + wid] = sk; }
    __syncthreads();
    const float ssq = red[2 * h] + red[2 * h + 1], ssk = red[8 + 2 * h] + red[8 + 2 * h + 1];
    qs[tid] = val[0] * rsqrtf(ssq + EPS) * 0.08838834764831845f; ks[tid] = val[1] * rsqrtf(ssk + EPS);
    __syncthreads();
    const float beta = 1.0f / (1.0f + __expf(-GBA[h]));
    const float x = GBA[4 + h] + p.in[14][h]; const float sp = x > 20.f ? x : log1pf(__expf(x));
    const float eg = __expf(-__expf(p.in[13][h]) * sp);
    const float* S0 = p.in[5] + ((size_t)(s * 4 + h) * 128) * 128 + dv; float* S1 = p.out + O_GS + ((size_t)(s * 4 + h) * 128) * 128 + dv;
    float kS = 0.f;
#pragma unroll 1
    for (int hf = 0; hf < 4; ++hf) { float sv[32];
#pragma unroll
        for (int dk = 0; dk < 32; ++dk) sv[dk] = S0[(size_t)(hf * 32 + dk) * 128];
#pragma unroll
        for (int dk = 0; dk < 32; ++dk) kS += ks[h * 128 + hf * 32 + dk] * sv[dk]; }
    const float delta = beta * (val[2] - eg * kS);
    float o = 0.f;
#pragma unroll 1
    for (int hf = 0; hf < 4; ++hf) { float sv[32];
#pragma unroll
        for (int dk = 0; dk < 32; ++dk) sv[dk] = S0[(size_t)(hf * 32 + dk) * 128];
#pragma unroll
        for (int dk = 0; dk < 32; ++dk) { const float nvv = eg * sv[dk] + ks[h * 128 + hf * 32 + dk] * delta; S1[(size_t)(hf * 32 + dk) * 128] = nvv; o += qs[h * 128 + hf * 32 + dk] * nvv; } }
    const float so = wave_sum(o * o);
    if ((tid & 63) == 0) red[16 + wid] = so;
    __syncthreads();
    const float tot = red[16 + 2 * h] + red[16 + 2 * h + 1];
    const float gz = bf2f(PB[2304 + tid]);
    PB[512 + tid] = f2bf(o * rsqrtf(tot * (1.0f / 128.0f) + EPS) * p.in[15][dv] * silu(gz));
}

#define XB_TMO      128
#define XB_XCNT(j)  (256  + 64 * (j))
#define XB_XSUB(j)  (1280 + 64 * (j))
#define XB_XGEN(j)  (2304 + 64 * (j))
#define XB_TOP      3328
#define XB_TOPGEN   3392
#define XCD_BAR_WORDS 3456
#define XB_SPIN_CAP (1u << 18)

__device__ __forceinline__ unsigned xb_ld(unsigned* p)              { return __hip_atomic_load(p, __ATOMIC_RELAXED, __HIP_MEMORY_SCOPE_AGENT); }
__device__ __forceinline__ unsigned xb_add(unsigned* p, unsigned v) { return __hip_atomic_fetch_add(p, v, __ATOMIC_RELAXED, __HIP_MEMORY_SCOPE_AGENT); }
__device__ __forceinline__ unsigned xb_xcc_id() { return (unsigned)__builtin_amdgcn_s_getreg((3 << 11) | 20) & 0xFu; }
#define XB_SPIN(cond, bar) do { unsigned _sp = 0; while (cond) { __builtin_amdgcn_s_sleep(1); \
    if ((++_sp & 255u) == 0u) { if (xb_ld(&(bar)[XB_TMO])) break; if (_sp > XB_SPIN_CAP) { atomicAdd(&(bar)[XB_TMO], 1u); break; } } } } while (0)

struct XcdBarrier {
    unsigned* bar; unsigned x;
    volatile LAS unsigned* st;
};

__device__ __forceinline__ XcdBarrier xcd_barrier_post(unsigned* bar, volatile LAS unsigned* st) {
    XcdBarrier b; b.bar = bar; b.x = xb_xcc_id(); b.st = st;
    if (threadIdx.x == 0) (void)xb_add(&bar[XB_XCNT(b.x)], 1u);
    return b;
}
__device__ __forceinline__ void xcd_barrier_complete(unsigned* bar, unsigned x, unsigned& nloc, unsigned& nx) {
    const unsigned G = gridDim.x * gridDim.y * gridDim.z;
    unsigned sum, cnt, mine, sp = 0u;
    for (;;) {
        sum = 0u; cnt = 0u; mine = 0u;
#pragma unroll
        for (unsigned j = 0; j < 16; ++j) { const unsigned c = xb_ld(&bar[XB_XCNT(j)]); sum += c; cnt += (c > 0u) ? 1u : 0u; mine = (j == x) ? c : mine; }
        if (sum == G) break;
        __builtin_amdgcn_s_sleep(1);
        if ((++sp & 255u) == 0u) { if (xb_ld(&bar[XB_TMO])) break; if (sp > XB_SPIN_CAP) { atomicAdd(&bar[XB_TMO], 1u); break; } }
    }
    nloc = mine > 0u ? mine : 1u; nx = cnt > 0u ? cnt : 1u;
}

__device__ __forceinline__ void xcd_barrier(const XcdBarrier& b) {
    asm volatile("s_waitcnt vmcnt(0)" ::: "memory");
    __syncthreads();
    if (threadIdx.x == 0) {
        unsigned* bar = b.bar;
        __builtin_amdgcn_s_waitcnt(0);
        unsigned nloc = b.st[0], nx = b.st[1];
        if (nloc == 0u) { xcd_barrier_complete(bar, b.x, nloc, nx); b.st[0] = nloc; b.st[1] = nx; }
        const unsigned old = xb_add(&bar[XB_XSUB(b.x)], 1u);
        const unsigned gen = old / nloc;
        if (old + 1u == (gen + 1u) * nloc) {
            __builtin_amdgcn_fence(__ATOMIC_RELEASE, "agent");
            asm volatile("s_waitcnt vmcnt(0)" ::: "memory");
            const unsigned og = xb_add(&bar[XB_TOP], 1u);
            const unsigned tg = og / nx;
            if (og + 1u == (tg + 1u) * nx) xb_add(&bar[XB_TOPGEN], 1u);
            else XB_SPIN(xb_ld(&bar[XB_TOPGEN]) == tg, bar);
            __builtin_amdgcn_fence(__ATOMIC_ACQUIRE, "agent");
            xb_add(&bar[XB_XGEN(b.x)], 1u);
            asm volatile("s_waitcnt vmcnt(0)" ::: "memory");
        } else {
            XB_SPIN(xb_ld(&bar[XB_XGEN(b.x)]) == gen, bar);
            __builtin_amdgcn_fence(__ATOMIC_ACQUIRE, "agent");
            asm volatile("s_waitcnt vmcnt(0)" ::: "memory");
        }
    }
    __syncthreads();
}

__global__ void __launch_bounds__(512, 2) fwd_kernel(Params p, int ph_lo, int ph_hi) {
    extern __shared__ __attribute__((aligned(16))) unsigned char lds_raw[];
    LAS unsigned char* lds = (LAS unsigned char*)lds_raw;
    cg::grid_group grid = cg::this_grid();
    if (ph_lo < 0) grid.sync();
    volatile LAS unsigned* bst = (volatile LAS unsigned*)(lds + LDS_PHASE_BYTES);
    if (threadIdx.x < 2) bst[threadIdx.x] = 0u;
    __syncthreads();
    XcdBarrier xbar; xbar.bar = (unsigned*)(p.ws + WS_CTL + CTL_BAR); xbar.x = 0; xbar.st = bst;
    if (ph_hi - ph_lo > 1) xbar = xcd_barrier_post((unsigned*)(p.ws + WS_CTL + CTL_BAR), bst);
    const int tid = threadIdx.x, lane = tid & 63, wid = tid >> 6, G = gridDim.x, bx = blockIdx.x;
    unsigned char* ws = p.ws;
    bf16_t* XN = (bf16_t*)(ws + WS_XN); bf16_t* XN2 = (bf16_t*)(ws + WS_XN2); bf16_t* HB = (bf16_t*)(ws + WS_H);
    float* SS1 = (float*)(ws + WS_SSP1); float* SS2 = (float*)(ws + WS_SSP2);
    float* Y = p.out; float* X2 = (float*)(ws + WS_GM); float* X3 = (float*)(ws + WS_XN);
#ifndef PHMASK
#define PHMASK 0x7ff
#endif
#define IN(k) (((PHMASK >> (k)) & 1) && ph_lo <= (k) && (k) < ph_hi)
#define SEAM(k) do { if (IN(k) && IN((k) + 1)) { xcd_barrier(xbar); }     } while (0)

    if (IN(0)) p0_prologue(p, lds, bx, G);
    SEAM(0);
    if (IN(1)) {
        if (bx < 176) sk_ffn_in<false>(XN, (const bf16_t*)(ws + WS_W1IN), HB, bx, wid, lane & 15, lane >> 4);
        pg8::Gemm g{XN, (const bf16_t*)(ws + WS_W1IN), MPR, 2 * DFF, DM, DM}; pg8::StaticOrder S; S.init(MPR, 2 * DFF, G, bx);
        EpiSwiglu E{HB, nullptr}; pg8::gemm_phase<EpiSwiglu, pg8::StaticOrder>(lds, g, S, E, nullptr);
    }
    SEAM(1);
    if (IN(2)) {
        if (bx < 64) sk_ffn_out<false>(HB, (const bf16_t*)(ws + WS_W1OUT), p.in[1], nullptr, XN + (size_t)MPR * DM, bx, wid, lane & 15, lane >> 4);
        pg8::Gemm g{HB, (const bf16_t*)(ws + WS_W1OUT), MPR, DM, DFF, DFF}; pg8::StaticOrder S; S.init(MPR, DM, G, bx);
        EpiResid<false, false, true, true, true> E{p.in[0], p.in[1], nullptr, XN, SS1}; pg8::gemm_phase<EpiResid<false, false, true, true, true>, pg8::StaticOrder>(lds, g, S, E, nullptr);
    }
    SEAM(2);
    if (IN(3)) {
        if (bx < 89) sk_inproj(XN, (const bf16_t*)(ws + WS_WINMIX), HB, (float*)(ws + WS_GBA), bx, wid, lane & 15, lane >> 4);
        pg8::Gemm g{XN, (const bf16_t*)(ws + WS_WINMIX), MPR, NINP, DM, DM}; pg8::StaticOrder S; S.init(MPR, NINP, G, bx);
        EpiInproj E{HB, (float*)(ws + WS_GBA), SS1}; pg8::gemm_phase<EpiInproj, pg8::StaticOrder>(lds, g, S, E, nullptr);
    }
    SEAM(3);
    if (IN(4)) {
        for (int u = bx; u < 2048; u += G) gdn_prep_unit(p, lds, u);
    }
    SEAM(4);
    if (IN(5)) {
        if (bx < NSCAN) gdn_scan(p, lds, bx);
        else {
            const int ab = bx - NSCAN, NAB = G - NSCAN;
            int it = ab;
#pragma unroll 1
            for (; it < 512; it += NAB) attn_unit(p, lds, it);
#pragma unroll 1
            for (; it < 640; it += NAB) {
                sattn_unit(p, it - 512, wid, lane);
                sgdn_unit(p, lds, it - 512); }
            const bf16_t* PB = HB;
            for (int idx = ab * 512 + tid; idx < 149504; idx += NAB * 512) {
                if (idx < 131072) { const int w = idx >> 16, r = idx & 65535, b = r >> 14, j = (r >> 7) & 127, c = r & 127;
                    p.out[(w ? O_VP : O_KP) + r] = bf2f(PB[(size_t)(b * SEQ + SEQ - 128 + j) * PW + 512 + w * 128 + c]);
                } else { const int r = idx - 131072, b = r / (3 * CONVC), q = r % (3 * CONVC), rr = q / CONVC, c = q % CONVC;
                    p.out[O_CP + r] = bf2f(PB[(size_t)(b * SEQ + SEQ - 3 + rr) * PW + 768 + c]); }
            }
        }
    }
    SEAM(5);
    if (IN(6)) {
        for (int u = bx * 8 + wid; u < 2048; u += G * 8) gdn_gate_unit(p, u, lane);
    }
    SEAM(6);
#ifdef DBG_DUMP
    if (ph_lo == 11) {
        const float* src = (const float*)(ws + DBG_SRC);
        for (size_t i = (size_t)bx * 512 + tid; i < (size_t)MREAL * DM; i += (size_t)G * 512) Y[i] = (i < (size_t)MREAL * 8) ? ((const float*)(ws + WS_GBA))[i] : 0.f;
    }
#endif
    if (IN(7)) {
        if (bx < 32) sk_outproj(HB, (const bf16_t*)(ws + WS_WOUTMIX), XN, X2, XN2, bx, wid, lane & 15, lane >> 4);
        pg8::Gemm g{HB, (const bf16_t*)(ws + WS_WOUTMIX), MPR, DM, DM, PW}; pg8::StaticOrder S; S.init(MPR, DM, G, bx);
        EpiResid<true, true, true, true, false> E{XN, XN + (size_t)MPR * DM, X2, XN2, SS2}; pg8::gemm_phase<EpiResid<true, true, true, true, false>, pg8::StaticOrder>(lds, g, S, E, nullptr);
    }
    SEAM(7);
    if (IN(8)) {
        if (bx < 176) sk_ffn_in<true>(XN2, (const bf16_t*)(ws + WS_W2IN), HB, bx, wid, lane & 15, lane >> 4);
        pg8::Gemm g{XN2, (const bf16_t*)(ws + WS_W2IN), MPR, 2 * DFF, DM, DM}; pg8::StaticOrder S; S.init(MPR, 2 * DFF, G, bx);
        EpiSwiglu E{HB, SS2}; pg8::gemm_phase<EpiSwiglu, pg8::StaticOrder>(lds, g, S, E, nullptr);
    }
    SEAM(8);
    if (IN(9)) {
        if (bx < 64) sk_ffn_out<true>(HB, (const bf16_t*)(ws + WS_W2OUT), X2 + (size_t)MPR * DM, X3 + (size_t)MPR * DM, nullptr, bx, wid, lane & 15, lane >> 4);
        pg8::Gemm g{HB, (const bf16_t*)(ws + WS_W2OUT), MPR, DM, DFF, DFF}; pg8::StaticOrder S; S.init(MPR, DM, G, bx);
        EpiResid<false, true, false, false, true> E{X2, X2 + (size_t)MPR * DM, X3, nullptr, nullptr}; pg8::gemm_phase<EpiResid<false, true, false, false, true>, pg8::StaticOrder>(lds, g, S, E, nullptr);
    }
    SEAM(9);
    if (IN(10)) {
        const float* gf = p.in[20]; f32x4 gv[4];
#pragma unroll
        for (int j = 0; j < 4; ++j) gv[j] = *((const f32x4*)gf + lane + 64 * j);
        for (int m = bx * 8 + wid; m < MREAL; m += G * 8) {
            const f32x4* xr = (const f32x4*)(X3 + (size_t)m * DM) + lane; f32x4* yr = (f32x4*)(Y + (size_t)m * DM) + lane; f32x4 v[4]; float s = 0.f;
#pragma unroll
            for (int j = 0; j < 4; ++j) { v[j] = xr[64 * j]; s += (v[j][0] * v[j][0] + v[j][1] * v[j][1]) + (v[j][2] * v[j][2] + v[j][3] * v[j][3]); }
            const float rstd = rsqrtf(wave_sum(s) * (1.0f / DM) + EPS);
#pragma unroll
            for (int j = 0; j < 4; ++j) yr[64 * j] = v[j] * rstd * gv[j];
        }
    }
#undef IN
#undef SEAM
}
}

#ifndef MK_N_LAUNCHES
#define MK_N_LAUNCHES 1
#endif
extern "C" void kernel_launch(void* const* d_in, const int* in_sizes, int n_in, void* d_out, int out_size, void* d_ws, size_t ws_size, hipStream_t stream) {
    static int grid = 0;
    if (grid == 0) {
        if (n_in != 21 || ws_size < mk::WS_END || out_size != 47269888) { fprintf(stderr, "kernel_launch: unexpected shapes (n_in %d, ws %zu, out %d)\n", n_in, ws_size, out_size); grid = -1; return; }
        int dev = 0, cus = 0, per_cu = 0;
        (void)hipGetDevice(&dev); (void)hipDeviceGetAttribute(&cus, hipDeviceAttributeMultiprocessorCount, dev);
        if (hipFuncSetAttribute((const void*)mk::fwd_kernel, hipFuncAttributeMaxDynamicSharedMemorySize, mk::LDS_BYTES) != hipSuccess) { fprintf(stderr, "kernel_launch: hipFuncSetAttribute failed\n"); grid = -1; return; }
        if (hipOccupancyMaxActiveBlocksPerMultiprocessor(&per_cu, (const void*)mk::fwd_kernel, 512, mk::LDS_BYTES) != hipSuccess || per_cu < 1) { fprintf(stderr, "kernel_launch: occupancy query failed (%d)\n", per_cu); per_cu = 1; }
        (void)hipGetLastError();
        grid = cus * per_cu;
        if (grid <= mk::NSCAN) { fprintf(stderr, "kernel_launch: grid %d too small\n", grid); grid = -1; return; }
    }
    if (grid < 0) return;
    (void)hipMemsetAsync((char*)d_ws + mk::WS_CTL + mk::CTL_BAR, 0, mk::CTL_BAR_BYTES, stream);
    mk::Params p{};
    for (int i = 0; i < 21; ++i) p.in[i] = (const float*)d_in[i];
    p.out = (float*)d_out; p.ws = (unsigned char*)d_ws;
#if MK_N_LAUNCHES == 1
    int lo = 0, hi = 11; void* args[] = {&p, &lo, &hi};
    hipError_t e = hipLaunchCooperativeKernel((const void*)mk::fwd_kernel, dim3(grid), dim3(512), args, mk::LDS_BYTES, stream);
    if (e != hipSuccess) fprintf(stderr, "kernel_launch: cooperative launch failed: %s (grid %d)\n", hipGetErrorString(e), grid);
#else
#ifndef MK_LAST
#define MK_LAST 11
#ifndef MK_DOUBLE
#define MK_DOUBLE 0x0
#endif
#define DBG_C0 512
#define DBG_C1 1024
#endif
    for (int ph = 0; ph < MK_LAST; ++ph) { const int reps = ((MK_DOUBLE >> ph) & 1) ? 2 : 1; for (int r = 0; r < reps; ++r) hipLaunchKernelGGL(mk::fwd_kernel, dim3(grid), dim3(512), mk::LDS_BYTES, stream, p, ph, ph + 1); }
#ifdef DBG_DUMP
    hipLaunchKernelGGL(mk::fwd_kernel, dim3(grid), dim3(512), mk::LDS_BYTES, stream, p, 11, 12);
#endif
#endif
}
```

```cpp
#include <hip/hip_runtime.h>
#include <hip/hip_cooperative_groups.h>
#include <cstdio>
namespace cg = cooperative_groups;
namespace pg8 {
#define PG8_LAS __attribute__((address_space(3)))
typedef unsigned short bf16_t;
typedef short bf16x8 __attribute__((ext_vector_type(8)));
typedef float f32x4 __attribute__((ext_vector_type(4)));
typedef unsigned u32x4 __attribute__((ext_vector_type(4)));
constexpr int BM = 256, BK = 64, HALF = 128, HTB = HALF * BK * 2  , STAGE_BYTES = 8 * HTB, NXCD = 8, WGM = 4;

__host__ __device__ __forceinline__ int lds_byte(int r, int c) { const int st = (r >> 4) * 2 + (c >> 5), rr = r & 15, cc = c & 31, ob = rr * 64 + cc * 2; return st * 1024 + (ob ^ (((ob >> 9) & 1) << 5)); }
__host__ __device__ __forceinline__ void stage_rc(int b, int& R, int& C) { const int st = b / 1024, sb = b % 1024, swz = sb ^ (((sb >> 9) & 1) << 5); R = (st >> 1) * 16 + swz / 64; C = (st & 1) * 32 + (swz % 64) / 2; }
__host__ __device__ __forceinline__ int perm32(int rho) { const int n = rho >> 4, i = rho & 15; return 8 * (i >> 2) + 4 * n + (i & 3); }

struct Unit { int pm, pn; };
struct Gemm { const bf16_t* A; const bf16_t* Bt; int M, N, K, lda; };

struct StaticOrder {
    int nM, nN, nwg, G, c;
    __host__ __device__ void init(int M, int N, int G_, int c_) { nM = M / BM; nN = N / BM; nwg = nM * nN; G = G_; c = c_; }
    __host__ __device__ bool next(int i, Unit& u) const {
        const long L = (long)i * G + c; if (L >= nwg) return false;
        int wgid = (int)L; { const int q = nwg / NXCD, r = nwg % NXCD, xcd = wgid % NXCD, off = wgid / NXCD; wgid = (xcd < r ? xcd * (q + 1) : r * (q + 1) + (xcd - r) * q) + off; }
        const int nig = WGM * nN, gid = wgid / nig, fm = gid * WGM, gsz = (nM - fm) < WGM ? (nM - fm) : WGM;
        u.pm = fm + ((wgid % nig) % gsz); u.pn = (wgid % nig) / gsz; return true;
    }
    __device__ __forceinline__ void a_ready(const Unit&) const {}
    __device__ __forceinline__ void done(const Unit&) const {}
};
struct CountedOrder : StaticOrder {
    const unsigned* ready; unsigned need; unsigned* tmo;
    __device__ __forceinline__ void a_ready(const Unit& u) const {
        if (threadIdx.x < 64) {
            const unsigned long long t0 = __builtin_amdgcn_s_memrealtime(); unsigned polls = 0;
            while ((unsigned)__builtin_amdgcn_readfirstlane(__hip_atomic_load(ready + 64 * u.pm, __ATOMIC_RELAXED, __HIP_MEMORY_SCOPE_AGENT)) < need) {
                if ((++polls & 255u) == 0u && __builtin_amdgcn_readfirstlane(__hip_atomic_load(tmo, __ATOMIC_RELAXED, __HIP_MEMORY_SCOPE_AGENT)) != 0u) break;
                if (__builtin_amdgcn_s_memrealtime() - t0 > 2000000ull) {
                    if (threadIdx.x == 0) { unsigned expect = 0u; __hip_atomic_compare_exchange_strong(tmo + 1, &expect, 0x600u | (unsigned)(u.pm & 0xff), __ATOMIC_RELAXED, __ATOMIC_RELAXED, __HIP_MEMORY_SCOPE_AGENT); __hip_atomic_store(tmo, 1u, __ATOMIC_RELAXED, __HIP_MEMORY_SCOPE_AGENT); }
                    break; }
                __builtin_amdgcn_s_sleep(2); }
            __builtin_amdgcn_fence(__ATOMIC_ACQUIRE, "agent");
            asm volatile("s_waitcnt vmcnt(0)" ::: "memory");
        }
#if !defined(BROKEN_HOOK_NO_BARRIER)
        asm volatile("" ::: "memory"); __builtin_amdgcn_s_barrier(); asm volatile("" ::: "memory");
#endif
    }
};

__device__ __forceinline__ unsigned cvt_pk_bf16(float lo, float hi) { unsigned r; asm volatile("v_cvt_pk_bf16_f32 %0, %1, %2" : "=v"(r) : "v"(lo), "v"(hi)); return r; }
typedef float f32x2 __attribute__((ext_vector_type(2)));
__device__ __forceinline__ f32x2 gelu_pk(f32x2 v) {
    const f32x2 av = __builtin_elementwise_abs(v), d = av * 0.2316418882f + 1.0f;
    f32x2 t; t.x = __builtin_amdgcn_rcpf(d.x); t.y = __builtin_amdgcn_rcpf(d.y);
    f32x2 q = t * 0.5307027145f + (-0.7265760135f); q = q * t + 0.7107068705f; q = q * t + (-0.142248368f); q = q * t + 0.127414796f; q = q * t;
    const f32x2 s = (v * v) * (-0.72134752044f);
    f32x2 e; e.x = __builtin_amdgcn_exp2f(s.x); e.y = __builtin_amdgcn_exp2f(s.y);
    const f32x2 m = v * (q * e), r = v - m;
    f32x2 o; o.x = v.x < 0.f ? m.x : r.x; o.y = v.y < 0.f ? m.y : r.y; return o;
}

struct EpiF32 {
    static constexpr bool PERM = false, AFTER_DRAIN = false;
    float* C; int ldc; const float* bias;
    __device__ __forceinline__ void operator()(const f32x4 (&acc)[2][2][4][2], const Unit& u, int wr, int wc, int fr, int fq) const {
        const int row0 = u.pm * BM + wr * 64 + fr, col0 = u.pn * BM + wc * 32 + 4 * fq;
        f32x4 bv[2][2];
#pragma unroll
        for (int bj = 0; bj < 2; ++bj)
#pragma unroll
            for (int n = 0; n < 2; ++n) bv[bj][n] = bias ? *(const f32x4*)(bias + col0 + bj * HALF + n * 16) : (f32x4){0.f, 0.f, 0.f, 0.f};
#pragma unroll
        for (int ai = 0; ai < 2; ++ai)
#pragma unroll
            for (int m = 0; m < 4; ++m) { float* rowp = C + (size_t)(row0 + ai * HALF + m * 16) * ldc + col0;
#pragma unroll
                for (int bj = 0; bj < 2; ++bj)
#pragma unroll
                    for (int n = 0; n < 2; ++n) *(f32x4*)(rowp + bj * HALF + n * 16) = acc[ai][bj][m][n] + bv[bj][n]; }
    }
};
template <int ACT  > struct EpiBf16 {
    static constexpr bool PERM = true, AFTER_DRAIN = false;
    bf16_t* O; int ldc; const float* bias; int split_cols; size_t split_stride;
    __device__ __forceinline__ void operator()(const f32x4 (&acc)[2][2][4][2], const Unit& u, int wr, int wc, int fr, int fq) const {
        const int row0 = u.pm * BM + wr * 64 + fr; int colt = u.pn * BM; bf16_t* base = O;
        if (split_cols) { const int t = colt / split_cols; base += (size_t)t * split_stride; colt -= t * split_cols; }
        const int col0 = colt + wc * 32 + 8 * fq, bcol0 = u.pn * BM + wc * 32 + 8 * fq;
        f32x4 bv[2][2];
#pragma unroll
        for (int bj = 0; bj < 2; ++bj)
#pragma unroll
            for (int n = 0; n < 2; ++n) bv[bj][n] = bias ? *(const f32x4*)(bias + bcol0 + bj * HALF + 4 * n) : (f32x4){0.f, 0.f, 0.f, 0.f};
#pragma unroll
        for (int ai = 0; ai < 2; ++ai)
#pragma unroll
            for (int m = 0; m < 4; ++m) { bf16_t* rowp = base + (size_t)(row0 + ai * HALF + m * 16) * ldc + col0;
#pragma unroll
                for (int bj = 0; bj < 2; ++bj) { f32x4 v0 = acc[ai][bj][m][0] + bv[bj][0], v1 = acc[ai][bj][m][1] + bv[bj][1];
                    if (ACT == 1) { f32x2 a = gelu_pk((f32x2){v0[0], v0[1]}), b = gelu_pk((f32x2){v0[2], v0[3]}), c = gelu_pk((f32x2){v1[0], v1[1]}), d = gelu_pk((f32x2){v1[2], v1[3]});
                        v0 = (f32x4){a.x, a.y, b.x, b.y}; v1 = (f32x4){c.x, c.y, d.x, d.y}; }
                    if (ACT == 2) {
#pragma unroll
                        for (int j = 0; j < 4; ++j) { v0[j] = 0.5f * v0[j] * (1.0f + erff(v0[j] * 0.70710678f)); v1[j] = 0.5f * v1[j] * (1.0f + erff(v1[j] * 0.70710678f)); } }
                    u32x4 w; w.x = cvt_pk_bf16(v0[0], v0[1]); w.y = cvt_pk_bf16(v0[2], v0[3]); w.z = cvt_pk_bf16(v1[0], v1[1]); w.w = cvt_pk_bf16(v1[2], v1[3]);
                    *(u32x4*)(rowp + bj * HALF) = w; } }
    }
};

struct PanelStats {
    unsigned* xbuf;
    unsigned* cnt;
    unsigned* tmo;
    int ntn; float eps;
    unsigned code;
    __device__ __forceinline__ bool run(const f32x4 (&v)[2][2][4][2], const Unit& u, int wr, int wc, int fr, int fq, PG8_LAS unsigned char* lds, int wid, int lane) const {
        typedef float f32x2v __attribute__((ext_vector_type(2)));
        PG8_LAS f32x2v* P = (PG8_LAS f32x2v*)lds;
        PG8_LAS f32x2v* S = (PG8_LAS f32x2v*)(lds + 8192);
        PG8_LAS unsigned* flag = (PG8_LAS unsigned*)(lds + 8192 + 2048);
#pragma unroll
        for (int ai = 0; ai < 2; ++ai)
#pragma unroll
            for (int m = 0; m < 4; ++m) {
                float s = 0.f;
#pragma unroll
                for (int bj = 0; bj < 2; ++bj)
#pragma unroll
                    for (int n = 0; n < 2; ++n) { const f32x4 x = v[ai][bj][m][n]; s += (x[0] + x[1]) + (x[2] + x[3]); }
                s += __shfl_xor(s, 16); s += __shfl_xor(s, 32);
                const float mw = s * (1.0f / 64.0f); float q = 0.f;
#pragma unroll
                for (int bj = 0; bj < 2; ++bj)
#pragma unroll
                    for (int n = 0; n < 2; ++n) { const f32x4 d = v[ai][bj][m][n] - mw; q += (d[0] * d[0] + d[1] * d[1]) + (d[2] * d[2] + d[3] * d[3]); }
                q += __shfl_xor(q, 16); q += __shfl_xor(q, 32);
                if (fq == 0) P[(ai * HALF + wr * 64 + m * 16 + fr) * 4 + wc] = (f32x2v){mw, q};
            }
        asm volatile("s_waitcnt lgkmcnt(0)" ::: "memory"); __builtin_amdgcn_s_barrier(); asm volatile("" ::: "memory");
#if defined(BROKEN_NO_WAIT)
        if (blockIdx.x >= 64) { const long long t0 = clock64(); while (clock64() - t0 < 60000) __builtin_amdgcn_s_sleep(8); }
#endif
        const int row = wid * 32 + (lane & 31);
        if (lane < 32) {
            const f32x2v a = P[row * 4 + 0], b = P[row * 4 + 1], c = P[row * 4 + 2], d = P[row * 4 + 3];
            const float mt = (a.x + b.x + c.x + d.x) * 0.25f;
            const float da = a.x - mt, db = b.x - mt, dc = c.x - mt, dd = d.x - mt;
            const float m2 = (a.y + b.y) + (c.y + d.y) + 64.0f * ((da * da + db * db) + (dc * dc + dd * dd));
            unsigned long long* slot = (unsigned long long*)xbuf + ((size_t)(u.pm * BM + row) * 4 + u.pn);
            __hip_atomic_store(slot, ((unsigned long long)__float_as_uint(m2) << 32) | __float_as_uint(mt), __ATOMIC_RELAXED, __HIP_MEMORY_SCOPE_AGENT);
        }
        asm volatile("s_waitcnt vmcnt(0)" ::: "memory");
        if (lane == 0) __hip_atomic_fetch_add(cnt + 64 * u.pm, 1u, __ATOMIC_RELAXED, __HIP_MEMORY_SCOPE_AGENT);
        if (wid == 0) {
            bool dead = false; const unsigned long long t0 = __builtin_amdgcn_s_memrealtime(); const unsigned want = 8u * (unsigned)ntn;
            for (;;) {
#if defined(BROKEN_NO_WAIT)
                break;
#endif
                if ((unsigned)__builtin_amdgcn_readfirstlane(__hip_atomic_load(cnt + 64 * u.pm, __ATOMIC_RELAXED, __HIP_MEMORY_SCOPE_AGENT)) >= want) break;
                if (__builtin_amdgcn_s_memrealtime() - t0 > 2000000ull) {
                    if (lane == 0) { unsigned expect = 0u; __hip_atomic_compare_exchange_strong(tmo + 1, &expect, code | (unsigned)(u.pm & 0xff), __ATOMIC_RELAXED, __ATOMIC_RELAXED, __HIP_MEMORY_SCOPE_AGENT);
                                     __hip_atomic_store(tmo, 1u, __ATOMIC_RELAXED, __HIP_MEMORY_SCOPE_AGENT); }
                    dead = true; break; }
                __builtin_amdgcn_s_sleep(2);
            }
            __builtin_amdgcn_fence(__ATOMIC_ACQUIRE, "agent");
            if (lane == 0) flag[0] = dead ? 1u : 0u;
        }
        asm volatile("s_waitcnt vmcnt(0) lgkmcnt(0)" ::: "memory"); __builtin_amdgcn_s_barrier(); asm volatile("" ::: "memory");
        const bool bad = flag[0] != 0u;
        if (lane < 32) {
            const unsigned long long* slot = (const unsigned long long*)xbuf + (size_t)(u.pm * BM + row) * 4; float mt[4], m2[4]; float ms = 0.f;
#pragma unroll
            for (int t = 0; t < 4; ++t) { if (t < ntn) { const unsigned long long w = __hip_atomic_load(slot + t, __ATOMIC_RELAXED, __HIP_MEMORY_SCOPE_AGENT); mt[t] = __uint_as_float((unsigned)w); m2[t] = __uint_as_float((unsigned)(w >> 32)); } else { mt[t] = 0.f; m2[t] = 0.f; } ms += mt[t]; }
            const float mean = ms / (float)ntn; float q = 0.f;
#pragma unroll
            for (int t = 0; t < 4; ++t) if (t < ntn) { const float dm = mt[t] - mean; q += m2[t] + 256.0f * dm * dm; }
            S[row] = (f32x2v){mean, 1.0f / sqrtf(q / (256.0f * (float)ntn) + eps)};
        }
        asm volatile("s_waitcnt lgkmcnt(0)" ::: "memory"); __builtin_amdgcn_s_barrier(); asm volatile("" ::: "memory");
        return bad;
    }
};
struct EpiLnRes {
    static constexpr bool PERM = false, AFTER_DRAIN = true;
    const float* base; float* out; int ldc; const float* bias; PanelStats st; unsigned poison;
    __device__ __forceinline__ void refuse(size_t i0, size_t stride, int M, int N) const { const float q = __builtin_nanf(""); for (size_t i = i0; i < (size_t)M * N; i += stride) out[(i / N) * ldc + i % N] = q;
        if (i0 == 0) { unsigned expect = 0u; __hip_atomic_compare_exchange_strong(st.tmo + 1, &expect, 0x7f0u, __ATOMIC_RELAXED, __ATOMIC_RELAXED, __HIP_MEMORY_SCOPE_AGENT); __hip_atomic_store(st.tmo, 1u, __ATOMIC_RELAXED, __HIP_MEMORY_SCOPE_AGENT); } }
    __device__ __forceinline__ void fused(f32x4 (&acc)[2][2][4][2], const Unit& u, int wr, int wc, int fr, int fq, PG8_LAS unsigned char* lds, int wid, int lane) const {
        typedef float f32x2v __attribute__((ext_vector_type(2)));
        const PG8_LAS f32x2v* S = (const PG8_LAS f32x2v*)(lds + 8192);
        const int col0 = u.pn * BM + wc * 32 + 4 * fq;
#pragma unroll
        for (int bj = 0; bj < 2; ++bj)
#pragma unroll
            for (int n = 0; n < 2; ++n) { const f32x4 bv = bias ? *(const f32x4*)(bias + col0 + bj * HALF + n * 16) : (f32x4){0.f, 0.f, 0.f, 0.f};
#pragma unroll
                for (int ai = 0; ai < 2; ++ai)
#pragma unroll
                    for (int m = 0; m < 4; ++m) acc[ai][bj][m][n] += bv; }
        const bool bad = st.run(acc, u, wr, wc, fr, fq, lds, wid, lane) || poison != 0u;
        const float qnan = __builtin_nanf("");
#pragma unroll
        for (int ai = 0; ai < 2; ++ai)
#pragma unroll
            for (int m = 0; m < 4; ++m) { const int r = ai * HALF + wr * 64 + m * 16 + fr; const f32x2v sr = S[r]; const size_t off = (size_t)(u.pm * BM + r) * ldc + col0;
#pragma unroll
                for (int bj = 0; bj < 2; ++bj)
#pragma unroll
                    for (int n = 0; n < 2; ++n) { const f32x4 bs = *(const f32x4*)(base + off + bj * HALF + n * 16); f32x4 o = bs + (acc[ai][bj][m][n] - sr.x) * sr.y;
                        if (bad) o = (f32x4){qnan, qnan, qnan, qnan}; *(f32x4*)(out + off + bj * HALF + n * 16) = o; }
                asm volatile("" ::: "memory"); }
    }
};
struct EpiLnResLn {
    static constexpr bool PERM = false, AFTER_DRAIN = true;
    const float* base; float* out; bf16_t* xn; int ldc; const float* bias; PanelStats st1, st2; unsigned poison;
    __device__ __forceinline__ void refuse(size_t i0, size_t stride, int M, int N) const { const float q = __builtin_nanf(""); for (size_t i = i0; i < (size_t)M * N; i += stride) { const size_t o = (i / N) * ldc + i % N; out[o] = q; xn[o] = (bf16_t)0x7fc0u; }
        if (i0 == 0) { unsigned expect = 0u; __hip_atomic_compare_exchange_strong(st1.tmo + 1, &expect, 0x7f0u, __ATOMIC_RELAXED, __ATOMIC_RELAXED, __HIP_MEMORY_SCOPE_AGENT); __hip_atomic_store(st1.tmo, 1u, __ATOMIC_RELAXED, __HIP_MEMORY_SCOPE_AGENT); } }
    __device__ __forceinline__ void fused(f32x4 (&acc)[2][2][4][2], const Unit& u, int wr, int wc, int fr, int fq, PG8_LAS unsigned char* lds, int wid, int lane) const {
        typedef float f32x2v __attribute__((ext_vector_type(2))); typedef unsigned u32x2v __attribute__((ext_vector_type(2)));
        const PG8_LAS f32x2v* S = (const PG8_LAS f32x2v*)(lds + 8192);
        const int col0 = u.pn * BM + wc * 32 + 4 * fq;
#pragma unroll
        for (int bj = 0; bj < 2; ++bj)
#pragma unroll
            for (int n = 0; n < 2; ++n) { const f32x4 bv = bias ? *(const f32x4*)(bias + col0 + bj * HALF + n * 16) : (f32x4){0.f, 0.f, 0.f, 0.f};
#pragma unroll
                for (int ai = 0; ai < 2; ++ai)
#pragma unroll
                    for (int m = 0; m < 4; ++m) acc[ai][bj][m][n] += bv; }
        bool bad = st1.run(acc, u, wr, wc, fr, fq, lds, wid, lane) || poison != 0u;
        const float qnan = __builtin_nanf("");
#pragma unroll
        for (int ai = 0; ai < 2; ++ai)
#pragma unroll
            for (int m = 0; m < 4; ++m) { const int r = ai * HALF + wr * 64 + m * 16 + fr; const f32x2v sr = S[r]; const size_t off = (size_t)(u.pm * BM + r) * ldc + col0;
#pragma unroll
                for (int bj = 0; bj < 2; ++bj)
#pragma unroll
                    for (int n = 0; n < 2; ++n) { const f32x4 bs = *(const f32x4*)(base + off + bj * HALF + n * 16); acc[ai][bj][m][n] = bs + (acc[ai][bj][m][n] - sr.x) * sr.y; }
                asm volatile("" : "+v"(acc[ai][0][m][0]), "+v"(acc[ai][0][m][1]), "+v"(acc[ai][1][m][0]), "+v"(acc[ai][1][m][1]));
                if (m & 1) asm volatile("" ::: "memory"); }
        const bool bad1 = bad;
        bad = st2.run(acc, u, wr, wc, fr, fq, lds, wid, lane) || bad;
#pragma unroll
        for (int ai = 0; ai < 2; ++ai)
#pragma unroll
            for (int m = 0; m < 4; ++m) { const int r = ai * HALF + wr * 64 + m * 16 + fr; const f32x2v sr = S[r]; const size_t off = (size_t)(u.pm * BM + r) * ldc + col0;
#pragma unroll
                for (int bj = 0; bj < 2; ++bj)
#pragma unroll
                    for (int n = 0; n < 2; ++n) { const f32x4 x1 = acc[ai][bj][m][n]; *(f32x4*)(out + off + bj * HALF + n * 16) = bad1 ? (f32x4){qnan, qnan, qnan, qnan} : x1;
                        const f32x4 o = (x1 - sr.x) * sr.y; u32x2v w; w.x = cvt_pk_bf16(o[0], o[1]); w.y = cvt_pk_bf16(o[2], o[3]);
                        if (bad) { w.x = 0x7fc07fc0u; w.y = 0x7fc07fc0u; } *(u32x2v*)(xn + off + bj * HALF + n * 16) = w; }
                asm volatile("" ::: "memory"); }
    }
};

template <class Epi, class Sched, bool STAMP = false>
__device__ __forceinline__ void gemm_phase(PG8_LAS unsigned char* lds, const Gemm g, const Sched S, const Epi E, unsigned long long* stamps) {
    const int tid = threadIdx.x, wid = __builtin_amdgcn_readfirstlane(tid >> 6), lane = tid & 63, wr = wid >> 2, wc = wid & 3, fr = lane & 15, fq = lane >> 4;
    const int K = g.K, nt = K / BK;
    int ts_lo = 0, ts_hi = 0, nts = 0; const unsigned long long rt_entry = STAMP ? (unsigned long long)wall_clock64() : 0ull;
#define PG8_STAMP() do { if (STAMP && wid == 0 && nts < 64) { const unsigned long long _c = (unsigned long long)clock64(); \
        ts_lo = (lane == nts) ? (int)(unsigned)_c : ts_lo; ts_hi = (lane == nts) ? (int)(unsigned)(_c >> 32) : ts_hi; ++nts; } } while (0)
    PG8_STAMP();
    unsigned voffA[2], voffB[2];
#pragma unroll
    for (int i = 0; i < 2; ++i) { int R, C; stage_rc(tid * 16 + i * 8192, R, C); const int Rb = Epi::PERM ? ((R & ~31) + perm32(R & 31)) : R;
        voffA[i] = (unsigned)(R * g.lda + C) * 2u; voffB[i] = (unsigned)(Rb * K + C) * 2u; }
    const size_t kstep = (size_t)(BK * 2);
    const size_t hstep = (size_t)HALF * K * 2;
    const size_t tstep = 2 * hstep;
    const size_t hstepA = (size_t)HALF * g.lda * 2, tstepA = 2 * hstepA;
    const unsigned ldsw = (unsigned)wid * 1024u;
    const int aoff = lds_byte(wr * 64 + fr, fq * 8), boff = lds_byte(wc * 32 + fr, fq * 8);
#define PG8_SA(b, h) (((b) * 2 + (h)) * HTB)
#define PG8_SB(b, h) ((4 + (b) * 2 + (h)) * HTB)
#define PG8_STAGE(bufoff, gbase, voff) do { _Pragma("unroll") for (int _i = 0; _i < 2; ++_i) \
        __builtin_amdgcn_global_load_lds((const unsigned*)((const char*)(gbase) + (voff)[_i]), (PG8_LAS unsigned*)(lds + (bufoff) + ldsw + _i * 8192), 16, 0, 0); } while (0)
#define PG8_LDA(dst, b, h) do { _Pragma("unroll") for (int m = 0; m < 4; ++m) _Pragma("unroll") for (int k = 0; k < 2; ++k) dst[m][k] = *(const PG8_LAS bf16x8*)(lds + PG8_SA(b, h) + aoff + m * 2048 + k * 1024); } while (0)
#define PG8_LDB(dst, b, h) do { _Pragma("unroll") for (int n = 0; n < 2; ++n) _Pragma("unroll") for (int k = 0; k < 2; ++k) dst[n][k] = *(const PG8_LAS bf16x8*)(lds + PG8_SB(b, h) + boff + n * 2048 + k * 1024); } while (0)
#define PG8_MMA(ai, bj, At, Bt) do { __builtin_amdgcn_s_setprio(1); _Pragma("unroll") for (int m = 0; m < 4; ++m) _Pragma("unroll") for (int n = 0; n < 2; ++n) _Pragma("unroll") for (int k = 0; k < 2; ++k) \
        acc[ai][bj][m][n] = __builtin_amdgcn_mfma_f32_16x16x32_bf16(Bt[n][k], At[m][k], acc[ai][bj][m][n], 0, 0, 0); __builtin_amdgcn_s_setprio(0); } while (0)
#define PG8_WAIT_V(n) asm volatile("s_waitcnt vmcnt(" #n ")" ::: "memory")
#define PG8_WAIT_L(n) asm volatile("s_waitcnt lgkmcnt(" #n ")" ::: "memory")
#define PG8_BAR __builtin_amdgcn_s_barrier()
#define PG8_SCHED __builtin_amdgcn_sched_barrier(0)
    Unit cur, nxt; int ui = 0;
    if (!S.next(0, cur)) return;
    f32x4 acc[2][2][4][2];
#pragma unroll
    for (int a = 0; a < 2; ++a)
#pragma unroll
        for (int b = 0; b < 2; ++b)
#pragma unroll
            for (int m = 0; m < 4; ++m)
#pragma unroll
                for (int n = 0; n < 2; ++n) acc[a][b][m][n] = (f32x4){0.f, 0.f, 0.f, 0.f};
    bf16x8 At[4][2], B0[2][2], B1[2][2];
    const char* cA = (const char*)g.A + (size_t)cur.pm * tstepA; const char* cB = (const char*)g.Bt + (size_t)cur.pn * tstep;
    S.a_ready(cur);
    PG8_STAGE(PG8_SB(0, 0), cB, voffB); PG8_STAGE(PG8_SA(0, 0), cA, voffA); PG8_STAGE(PG8_SB(0, 1), cB + hstep, voffB); PG8_STAGE(PG8_SA(0, 1), cA + hstepA, voffA);
    if (wr == 1) PG8_BAR;
    PG8_WAIT_V(4); PG8_BAR;
    PG8_STAGE(PG8_SB(1, 0), cB + kstep, voffB); PG8_STAGE(PG8_SA(1, 0), cA + kstep, voffA); PG8_STAGE(PG8_SB(1, 1), cB + hstep + kstep, voffB);
    PG8_WAIT_V(6); PG8_BAR;
    PG8_STAMP();
    for (;;) {
        const bool has_next = S.next(ui + 1, nxt);
        const char* nA = has_next ? (const char*)g.A + (size_t)nxt.pm * tstepA : cA; const char* nB = has_next ? (const char*)g.Bt + (size_t)nxt.pn * tstep : cB;
        for (int t = 0; t < nt; t += 2) {
            const bool last = (t == nt - 2);
            const char* a1 = cA + (size_t)(t + 1) * kstep;
            const char* a2 = last ? nA : cA + (size_t)(t + 2) * kstep; const char* b2 = last ? nB : cB + (size_t)(t + 2) * kstep;
            const char* a3 = a2 + kstep; const char* b3 = b2 + kstep;
            if (last && has_next) S.a_ready(nxt);
            PG8_LDB(B0, 0, 0); PG8_SCHED; PG8_LDA(At, 0, 0); PG8_STAGE(PG8_SA(1, 1), a1 + hstepA, voffA);
            PG8_WAIT_L(8); PG8_BAR; PG8_WAIT_L(0); PG8_MMA(0, 0, At, B0); PG8_BAR; PG8_SCHED;
            PG8_LDB(B1, 0, 1); PG8_STAGE(PG8_SB(0, 0), b2, voffB);
            PG8_BAR; PG8_WAIT_L(0); PG8_MMA(0, 1, At, B1); PG8_BAR;
            PG8_LDA(At, 0, 1); PG8_STAGE(PG8_SA(0, 0), a2, voffA);
            PG8_BAR; PG8_WAIT_L(0); PG8_MMA(1, 0, At, B0); PG8_BAR; PG8_SCHED;
            PG8_STAGE(PG8_SB(0, 1), b2 + hstep, voffB);
            PG8_WAIT_V(6); PG8_BAR; PG8_MMA(1, 1, At, B1); PG8_BAR;
            PG8_LDB(B0, 1, 0); PG8_SCHED; PG8_LDA(At, 1, 0); PG8_STAGE(PG8_SA(0, 1), a2 + hstepA, voffA);
            PG8_WAIT_L(8); PG8_BAR; PG8_WAIT_L(0); PG8_MMA(0, 0, At, B0); PG8_BAR; PG8_SCHED;
            PG8_LDB(B1, 1, 1); PG8_STAGE(PG8_SB(1, 0), b3, voffB);
            PG8_BAR; PG8_WAIT_L(0); PG8_MMA(0, 1, At, B1); PG8_BAR;
            PG8_LDA(At, 1, 1); PG8_STAGE(PG8_SA(1, 0), a3, voffA);
            PG8_BAR; PG8_WAIT_L(0); PG8_MMA(1, 0, At, B0); PG8_BAR; PG8_SCHED;
            PG8_STAGE(PG8_SB(1, 1), b3 + hstep, voffB);
            PG8_WAIT_V(6); PG8_BAR; PG8_MMA(1, 1, At, B1); PG8_BAR;
        }
        PG8_STAMP();
        if constexpr (!Epi::AFTER_DRAIN) { E(acc, cur, wr, wc, fr, fq); S.done(cur); }
        PG8_STAMP();
        if (!has_next) break;
#pragma unroll
        for (int a = 0; a < 2; ++a)
#pragma unroll
            for (int b = 0; b < 2; ++b)
#pragma unroll
                for (int m = 0; m < 4; ++m)
#pragma unroll
                    for (int n = 0; n < 2; ++n) acc[a][b][m][n] = (f32x4){0.f, 0.f, 0.f, 0.f};
        cur = nxt; cA = nA; cB = nB; ++ui;
    }
    PG8_WAIT_V(0);
    if (wr == 0) PG8_BAR;
    PG8_BAR;
    if constexpr (Epi::AFTER_DRAIN) { E.fused(acc, cur, wr, wc, fr, fq, lds, wid, lane); S.done(cur); }
    PG8_STAMP();
    if (STAMP && wid == 0) { stamps[lane] = lane < nts ? (((unsigned long long)(unsigned)ts_hi << 32) | (unsigned)ts_lo) : 0ull;
        if (lane == 62) stamps[62] = rt_entry; if (lane == 63) stamps[63] = (unsigned long long)wall_clock64(); }
#undef PG8_STAMP
#undef PG8_SA
#undef PG8_SB
#undef PG8_STAGE
#undef PG8_LDA
#undef PG8_LDB
#undef PG8_MMA
#undef PG8_WAIT_V
#undef PG8_WAIT_L
#undef PG8_BAR
#undef PG8_SCHED
}
}

namespace mk {
#define LAS __attribute__((address_space(3)))
using pg8::bf16_t; using pg8::bf16x8; using pg8::f32x4; using pg8::u32x4;
typedef unsigned u32x2 __attribute__((ext_vector_type(2)));

constexpr int DM = 1024, SEQ = 8192, NBATCH = 4, MPR = NBATCH * SEQ, MSAMP = 128, MREAL = MPR + MSAMP, MPAD = 33024;
constexpr int DFF = 2816, PW = 2816, NINP = 3072, CONVC = 1536;
constexpr float EPS = 1e-6f;
#ifndef SCAN_CW
#define SCAN_CW 2
#endif
constexpr int CW = SCAN_CW, NSCAN = 128 / CW;
constexpr int LDS_PHASE_BYTES = 147456, LDS_BYTES = LDS_PHASE_BYTES + 256;

constexpr size_t O_YP = 0, O_YS = 33554432, O_KP = 33685504, O_VP = 33751040, O_CP = 33816576, O_GP = 33835008,
                 O_KS = 34097152, O_VS = 36194304, O_CS = 38291456, O_GS = 38881280;
constexpr size_t MiB = 1u << 20;
constexpr size_t WS_CTL = 0, CTL_ZERO_BYTES = 1 * MiB;
constexpr size_t WS_W1IN = 1 * MiB, WS_W1OUT = 12 * MiB, WS_WINMIX = 18 * MiB, WS_WOUTMIX = 24 * MiB, WS_W2IN = 26 * MiB, WS_W2OUT = 37 * MiB;
constexpr size_t WS_GBA = 43 * MiB, WS_XN = 45 * MiB, WS_XN2 = 110 * MiB, WS_H = 175 * MiB, WS_GM = 353 * MiB, WS_GN = 417 * MiB;
constexpr size_t WS_GQ = 110 * MiB, WS_GO = 142 * MiB;
constexpr size_t WS_SSP1 = 481 * MiB, WS_SSP2 = 484 * MiB;
constexpr size_t WS_END = 487 * MiB;
constexpr size_t CTL_BAR = 0, CTL_BAR_BYTES = 16384, CTL_GLAST = 768 * 1024;

struct Params { const float* in[21]; float* out; unsigned char* ws; };

typedef float f32x2v __attribute__((ext_vector_type(2)));
typedef __bf16 bf16x2v __attribute__((ext_vector_type(2)));
__device__ __forceinline__ unsigned cvt_pk(float lo, float hi) { const f32x2v v = {lo, hi}; const bf16x2v b = __builtin_convertvector(v, bf16x2v); return __builtin_bit_cast(unsigned, b); }
__device__ __forceinline__ bf16_t f2bf(float f) { return (bf16_t)(cvt_pk(f, 0.f) & 0xffffu); }
__device__ __forceinline__ float bf2f(bf16_t h) { return __uint_as_float(((unsigned)h) << 16); }
__device__ __forceinline__ float bflo(unsigned w) { return __uint_as_float(w << 16); }
__device__ __forceinline__ float bfhi(unsigned w) { return __uint_as_float(w & 0xffff0000u); }
__device__ __forceinline__ float silu(float x) { return x * __builtin_amdgcn_rcpf(1.0f + __expf(-x)); }
__device__ __forceinline__ float wave_sum(float v) {
#pragma unroll
    for (int o = 1; o < 64; o <<= 1) v += __shfl_xor(v, o);
    return v;
}
__device__ __forceinline__ float wave_max(float v) {
#pragma unroll
    for (int o = 1; o < 64; o <<= 1) v = fmaxf(v, __shfl_xor(v, o));
    return v;
}
__device__ __forceinline__ f32x4 mfma16(bf16x8 a, bf16x8 b, f32x4 c) { return __builtin_amdgcn_mfma_f32_16x16x32_bf16(a, b, c, 0, 0, 0); }

__device__ __forceinline__ float row_rstd(const float* ssp, int r) {
    if (r >= MREAL) return 0.f;
    const f32x4 a = *(const f32x4*)(ssp + (size_t)r * 16), b = *(const f32x4*)(ssp + (size_t)r * 16 + 4), c = *(const f32x4*)(ssp + (size_t)r * 16 + 8), d = *(const f32x4*)(ssp + (size_t)r * 16 + 12);
    const float s = (((a[0] + a[1]) + (a[2] + a[3])) + ((b[0] + b[1]) + (b[2] + b[3]))) + (((c[0] + c[1]) + (c[2] + c[3])) + ((d[0] + d[1]) + (d[2] + d[3])));
    return rsqrtf(s * (1.0f / DM) + EPS);
}
struct EpiSwiglu {
    static constexpr bool PERM = true, AFTER_DRAIN = false;
    bf16_t* H; const float* ss;
    __device__ __forceinline__ void operator()(const f32x4 (&acc)[2][2][4][2], const pg8::Unit& u, int wr, int wc, int fr, int fq) const {
        const int row0 = u.pm * 256 + wr * 64 + fr, col0 = u.pn * 128 + wc * 32 + 8 * fq;
#pragma unroll
        for (int ai = 0; ai < 2; ++ai)
#pragma unroll
            for (int m = 0; m < 4; ++m) {
                const int r = row0 + ai * 128 + m * 16;
                const float rs = ss ? row_rstd(ss, r) : 1.0f;
                float h[8];
#pragma unroll
                for (int n = 0; n < 2; ++n)
#pragma unroll
                    for (int j = 0; j < 4; ++j) h[n * 4 + j] = silu(acc[ai][0][m][n][j] * rs) * (acc[ai][1][m][n][j] * rs);
                u32x4 w; w.x = cvt_pk(h[0], h[1]); w.y = cvt_pk(h[2], h[3]); w.z = cvt_pk(h[4], h[5]); w.w = cvt_pk(h[6], h[7]);
                *(u32x4*)(H + (size_t)r * DFF + col0) = w;
            }
    }
};
template <bool RESB16, bool WF32, bool WB16, bool SUMSQ, bool HALF> struct EpiResid {
    static constexpr bool PERM = true, AFTER_DRAIN = false;
    const void* resP; const void* resS; float* Yo; bf16_t* XBo; float* sso;
    __device__ __forceinline__ void operator()(const f32x4 (&acc)[2][2][4][2], const pg8::Unit& u, int wr, int wc, int fr, int fq) const {
        const int row0 = u.pm * 256 + wr * 64 + fr, col0 = u.pn * 256 + wc * 32 + 8 * fq;
        const char* const rP = (const char*)resP; const char* const rS = (const char*)resS - (size_t)MPR * DM * (RESB16 ? 2 : 4);
        float* const Y = Yo; const float scale = HALF ? 0.5f : 1.0f; bf16_t* const XB = XBo; float* const ss = sso;
#pragma unroll
        for (int ai = 0; ai < 2; ++ai)
#pragma unroll
            for (int m = 0; m < 4; ++m) {
                const int r = row0 + ai * 128 + m * 16; float s = 0.f;
                if (r < MREAL) {
                    const char* rp = ((r < MPR) ? rP : rS) + (size_t)r * DM * (RESB16 ? 2 : 4);
#pragma unroll
                    for (int bj = 0; bj < 2; ++bj) {
                        const int c = col0 + bj * 128;
                        f32x4 r0, r1;
                        if (RESB16) { const u32x4 w = *(const u32x4*)(rp + (size_t)c * 2); r0 = (f32x4){bflo(w.x), bfhi(w.x), bflo(w.y), bfhi(w.y)}; r1 = (f32x4){bflo(w.z), bfhi(w.z), bflo(w.w), bfhi(w.w)}; }
                        else { r0 = *(const f32x4*)(rp + (size_t)c * 4); r1 = *(const f32x4*)(rp + (size_t)c * 4 + 16); }
                        const f32x4 v0 = r0 + acc[ai][bj][m][0] * scale, v1 = r1 + acc[ai][bj][m][1] * scale;
                        if (WF32) { *(f32x4*)(Y + (size_t)r * DM + c) = v0; *(f32x4*)(Y + (size_t)r * DM + c + 4) = v1; }
                        if (WB16) { u32x4 w; w.x = cvt_pk(v0[0], v0[1]); w.y = cvt_pk(v0[2], v0[3]); w.z = cvt_pk(v1[0], v1[1]); w.w = cvt_pk(v1[2], v1[3]);
                            *(u32x4*)(XB + (size_t)r * DM + c) = w; }
                        if (SUMSQ) s += (v0[0] * v0[0] + v0[1] * v0[1]) + (v0[2] * v0[2] + v0[3] * v0[3]) + (v1[0] * v1[0] + v1[1] * v1[1]) + (v1[2] * v1[2] + v1[3] * v1[3]);
                    }
                }
                if (SUMSQ) { s += __shfl_xor(s, 16); s += __shfl_xor(s, 32); if (fq == 0 && r < MREAL) ss[(size_t)r * 16 + u.pn * 4 + wc] = s; }
            }
    }
};
struct EpiInproj {
    static constexpr bool PERM = true, AFTER_DRAIN = false;
    bf16_t* P; float* gba; const float* ss;
    __device__ __forceinline__ void operator()(const f32x4 (&acc)[2][2][4][2], const pg8::Unit& u, int wr, int wc, int fr, int fq) const {
        const int row0 = u.pm * 256 + wr * 64 + fr, col0 = u.pn * 256 + wc * 32 + 8 * fq;
#pragma unroll
        for (int ai = 0; ai < 2; ++ai)
#pragma unroll
            for (int m = 0; m < 4; ++m) {
                const int r = row0 + ai * 128 + m * 16;
                const float rs = row_rstd(ss, r);
                if (u.pn < 11) {
#pragma unroll
                    for (int bj = 0; bj < 2; ++bj) { const f32x4 v0 = acc[ai][bj][m][0] * rs, v1 = acc[ai][bj][m][1] * rs;
                        u32x4 w; w.x = cvt_pk(v0[0], v0[1]); w.y = cvt_pk(v0[2], v0[3]); w.z = cvt_pk(v1[0], v1[1]); w.w = cvt_pk(v1[2], v1[3]);
                        *(u32x4*)(P + (size_t)r * PW + col0 + bj * 128) = w; }
                } else if (wc == 0 && fq == 0) {
                    *(f32x4*)(gba + (size_t)r * 8) = acc[ai][0][m][0] * rs; *(f32x4*)(gba + (size_t)r * 8 + 4) = acc[ai][0][m][1] * rs;
                }
            }
    }
};


template <int NT, bool SS>
__device__ __forceinline__ void skinny_mm(const bf16_t* A, int lda, const bf16_t* W, int K, int wrow0, int wrow1, int wid, int fr, int fq, f32x4 (&acc)[NT], float& ss) {
    const bf16_t* ap = A + (size_t)(16 * wid + fr) * lda + 8 * fq;
    const bf16_t* w0 = W + (size_t)(wrow0 + fr) * K + 8 * fq; const bf16_t* w1 = W + (size_t)(wrow1 + fr) * K + 8 * fq;
#pragma unroll
    for (int nt = 0; nt < NT; ++nt) acc[nt] = (f32x4){0.f, 0.f, 0.f, 0.f};
    float s = 0.f;
#pragma unroll 8
    for (int ks = 0; ks < K / 32; ++ks) {
        const bf16x8 a = *(const bf16x8*)(ap + 32 * ks);
        acc[0] = mfma16(*(const bf16x8*)(w0 + 32 * ks), a, acc[0]);
        if (NT == 2) acc[NT - 1] = mfma16(*(const bf16x8*)(w1 + 32 * ks), a, acc[NT - 1]);
        if (SS) { const u32x4 u = __builtin_bit_cast(u32x4, a);
#pragma unroll
            for (int k = 0; k < 4; ++k) { const float lo = bflo(u[k]), hi = bfhi(u[k]); s += lo * lo + hi * hi; } }
    }
    if (SS) { s += __shfl_xor(s, 16); s += __shfl_xor(s, 32); }
    ss = s;
}
template <bool SS> __device__ __forceinline__ void sk_ffn_in(const bf16_t* X, const bf16_t* Wt, bf16_t* H, int slab, int wid, int fr, int fq) {
    const int j0 = 16 * slab, wr0 = (j0 >> 7) * 256 + (j0 & 127);
    f32x4 acc[2]; float ss;
    skinny_mm<2, SS>(X + (size_t)MPR * DM, DM, Wt, DM, wr0, wr0 + 128, wid, fr, fq, acc, ss);
    const float rs = SS ? rsqrtf(ss * (1.0f / DM) + EPS) : 1.0f;
    float h[4];
#pragma unroll
    for (int e = 0; e < 4; ++e) h[e] = silu(acc[0][e] * rs) * (acc[1][e] * rs);
    u32x2 w; w.x = cvt_pk(h[0], h[1]); w.y = cvt_pk(h[2], h[3]);
    *(u32x2*)(H + (size_t)(MPR + 16 * wid + fr) * DFF + j0 + 4 * fq) = w;
}
template <bool OUTF32> __device__ __forceinline__ void sk_ffn_out(const bf16_t* Hb, const bf16_t* Wt, const float* resf, float* outf, bf16_t* outb, int slab, int wid, int fr, int fq) {
    f32x4 acc[1]; float ss;
    skinny_mm<1, false>(Hb + (size_t)MPR * DFF, DFF, Wt, DFF, 16 * slab, 0, wid, fr, fq, acc, ss);
    const int rl = 16 * wid + fr, c = 16 * slab + 4 * fq;
    const f32x4 v = *(const f32x4*)(resf + (size_t)rl * DM + c) + acc[0] * 0.5f;
    if (OUTF32) *(f32x4*)(outf + (size_t)rl * DM + c) = v;
    else { u32x2 w; w.x = cvt_pk(v[0], v[1]); w.y = cvt_pk(v[2], v[3]); *(u32x2*)(outb + (size_t)rl * DM + c) = w; }
}
__device__ __forceinline__ void sk_inproj(const bf16_t* X, const bf16_t* Wt, bf16_t* P, float* gba, int slab, int wid, int fr, int fq) {
    const int n0 = 32 * slab; f32x4 acc[2]; float ss;
    skinny_mm<2, true>(X + (size_t)MPR * DM, DM, Wt, DM, n0, n0 + 16, wid, fr, fq, acc, ss);
    const float rs = rsqrtf(ss * (1.0f / DM) + EPS); const int r = MPR + 16 * wid + fr;
    if (n0 < PW) {
#pragma unroll
        for (int nt = 0; nt < 2; ++nt) { const f32x4 v = acc[nt] * rs; u32x2 w; w.x = cvt_pk(v[0], v[1]); w.y = cvt_pk(v[2], v[3]); *(u32x2*)(P + (size_t)r * PW + n0 + 16 * nt + 4 * fq) = w; }
    } else if (fq < 2) *(f32x4*)(gba + (size_t)r * 8 + 4 * fq) = acc[0] * rs;
}
__device__ __forceinline__ void sk_outproj(const bf16_t* Pm, const bf16_t* Wt, const bf16_t* X1b, float* X2f, bf16_t* X2b, int slab, int wid, int fr, int fq) {
    const int n0 = 32 * slab; f32x4 acc[2]; float ss;
    skinny_mm<2, false>(Pm + (size_t)MPR * PW, PW, Wt, DM, n0, n0 + 16, wid, fr, fq, acc, ss);
    const int r = MPR + 16 * wid + fr;
#pragma unroll
    for (int nt = 0; nt < 2; ++nt) { const int c = n0 + 16 * nt + 4 * fq; const u32x2 xr = *(const u32x2*)(X1b + (size_t)r * DM + c);
        const f32x4 v = (f32x4){bflo(xr.x), bfhi(xr.x), bflo(xr.y), bfhi(xr.y)} + acc[nt];
        *(f32x4*)(X2f + (size_t)r * DM + c) = v; u32x2 w; w.x = cvt_pk(v[0], v[1]); w.y = cvt_pk(v[2], v[3]); *(u32x2*)(X2b + (size_t)r * DM + c) = w; }
}

__device__ __forceinline__ void transpose_item(const float* W, int K, int N, bf16_t* WT, int k0, int n0, int drow0, const float* gs, LAS float* scr, int lane) {
    float wv[32];
#pragma unroll
    for (int i = 0; i < 32; ++i) { const int kk = 2 * i + (lane >> 5), n = n0 + (lane & 31); wv[i] = (n < N) ? W[(size_t)(k0 + kk) * N + n] : 0.f; }
#pragma unroll
    for (int i = 0; i < 32; ++i) { const int kk = 2 * i + (lane >> 5); float v = wv[i]; if (gs) v *= gs[k0 + kk]; scr[kk * 33 + (lane & 31)] = v; }
    asm volatile("s_waitcnt lgkmcnt(0)" ::: "memory");
    const int c = lane & 7;
#pragma unroll
    for (int j = 0; j < 4; ++j) { const int nn = (lane >> 3) + 8 * j; const LAS float* s = scr + (8 * c) * 33 + nn;
        u32x4 o; o.x = cvt_pk(s[0 * 33], s[1 * 33]); o.y = cvt_pk(s[2 * 33], s[3 * 33]); o.z = cvt_pk(s[4 * 33], s[5 * 33]); o.w = cvt_pk(s[6 * 33], s[7 * 33]);
        *(u32x4*)(WT + (size_t)(drow0 + nn) * K + k0 + 8 * c) = o; }
    asm volatile("s_waitcnt lgkmcnt(0)" ::: "memory");
}
__device__ __forceinline__ int map_ffin_row(int n0) { return n0 < DFF ? (n0 >> 7) * 256 + (n0 & 127) : ((n0 - DFF) >> 7) * 256 + 128 + ((n0 - DFF) & 127); }

__device__ __forceinline__ void p0_prologue(const Params& p, LAS unsigned char* lds, int vb, int G) {
    const int tid = threadIdx.x, lane = tid & 63, wid = tid >> 6;
    LAS float* scr = (LAS float*)(lds + wid * 16384);
    const int gw = vb * 8 + wid, NGW = G * 8;
    bf16_t* W1IN = (bf16_t*)(p.ws + WS_W1IN); bf16_t* W1OUT = (bf16_t*)(p.ws + WS_W1OUT); bf16_t* WINMIX = (bf16_t*)(p.ws + WS_WINMIX);
    bf16_t* WOUTMIX = (bf16_t*)(p.ws + WS_WOUTMIX); bf16_t* W2IN = (bf16_t*)(p.ws + WS_W2IN); bf16_t* W2OUT = (bf16_t*)(p.ws + WS_W2OUT);
    constexpr int I_FIN = 16 * 176, I_FOUT = 44 * 32, I_INMIX = 16 * 89, I_OUTMIX = 16 * 32;
    constexpr int NITEMS = 2 * I_FIN + 2 * I_FOUT + I_INMIX + I_OUTMIX;
    for (int it = gw; it < NITEMS; it += NGW) {
        int r = it;
        if (r < I_FIN) { const int kb = r / 176, nb = r % 176; transpose_item(p.in[7], DM, 2 * DFF, W1IN, kb * 64, nb * 32, map_ffin_row(nb * 32), nullptr, scr, lane); continue; } r -= I_FIN;
        if (r < I_FIN) { const int kb = r / 176, nb = r % 176; transpose_item(p.in[18], DM, 2 * DFF, W2IN, kb * 64, nb * 32, map_ffin_row(nb * 32), p.in[17], scr, lane); continue; } r -= I_FIN;
        if (r < I_FOUT) { const int kb = r / 32, nb = r % 32; transpose_item(p.in[8], DFF, DM, W1OUT, kb * 64, nb * 32, nb * 32, nullptr, scr, lane); continue; } r -= I_FOUT;
        if (r < I_FOUT) { const int kb = r / 32, nb = r % 32; transpose_item(p.in[19], DFF, DM, W2OUT, kb * 64, nb * 32, nb * 32, nullptr, scr, lane); continue; } r -= I_FOUT;
        if (r < I_INMIX) { const int kb = r / 89, nb = r % 89; transpose_item(p.in[10], DM, 2824, WINMIX, kb * 64, nb * 32, nb * 32, p.in[9], scr, lane); continue; } r -= I_INMIX;
        { const int kb = r / 32, nb = r % 32; transpose_item(p.in[16], DM, DM, WOUTMIX, kb * 64, nb * 32, nb * 32, nullptr, scr, lane); }
    }
    bf16_t* XN = (bf16_t*)(p.ws + WS_XN); const float* g1 = p.in[6];
    f32x4 gv[4];
#pragma unroll
    for (int j = 0; j < 4; ++j) gv[j] = *((const f32x4*)g1 + lane + 64 * j);
    {
        f32x4 v[4], vn[4];
        int m = gw;
        if (m < MREAL) { const f32x4* xr = (const f32x4*)((m < MPR) ? p.in[0] + (size_t)m * DM : p.in[1] + (size_t)(m - MPR) * DM) + lane;
#pragma unroll
            for (int j = 0; j < 4; ++j) v[j] = xr[64 * j]; }
        for (; m < MREAL; m += NGW) {
            const int mn = m + NGW;
            if (mn < MREAL) { const f32x4* xr = (const f32x4*)((mn < MPR) ? p.in[0] + (size_t)mn * DM : p.in[1] + (size_t)(mn - MPR) * DM) + lane;
#pragma unroll
                for (int j = 0; j < 4; ++j) vn[j] = xr[64 * j]; }
            float s = 0.f;
#pragma unroll
            for (int j = 0; j < 4; ++j) s += (v[j][0] * v[j][0] + v[j][1] * v[j][1]) + (v[j][2] * v[j][2] + v[j][3] * v[j][3]);
            const float rstd = rsqrtf(wave_sum(s) * (1.0f / DM) + EPS);
            unsigned long long* o8 = (unsigned long long*)(XN + (size_t)m * DM) + lane;
#pragma unroll
            for (int j = 0; j < 4; ++j) { const f32x4 y = v[j] * rstd * gv[j];
                o8[64 * j] = (unsigned long long)cvt_pk(y[0], y[1]) | ((unsigned long long)cvt_pk(y[2], y[3]) << 32); }
#pragma unroll
            for (int j = 0; j < 4; ++j) v[j] = vn[j];
        }
    }
}

__device__ __forceinline__ f32x4 tile_mm(const LAS bf16_t* X, int ldx, int mt, const LAS bf16_t* Y, int ldy, int nt, int nks, int fr, int fq) {
    f32x4 acc = (f32x4){0.f, 0.f, 0.f, 0.f};
    const LAS bf16_t* xp = X + (16 * mt + fr) * ldx + 8 * fq; const LAS bf16_t* yp = Y + (16 * nt + fr) * ldy + 8 * fq;
    for (int ks = 0; ks < nks; ++ks) acc = mfma16(*(const LAS bf16x8*)(xp + 32 * ks), *(const LAS bf16x8*)(yp + 32 * ks), acc);
    return acc;
}
constexpr int G1_QS = 0, G1_KS = 17408, G1_VBT = 34816, G1_KBT = 53248, G1_KDT = 71680, G1_UT = 90112, G1_WT = 108544, G1_QK = 126976, G1_TB = 136192, G1_GC = 145408, G1_BETA = 145664;

__device__ __forceinline__ void gdn_prep_unit(const Params& p, LAS unsigned char* lds, int unit) {
    const int tid = threadIdx.x, lane = tid & 63, wid = tid >> 6, fr = lane & 15, fq = lane >> 4;
    const int bh = unit >> 7, n = unit & 127, b = bh >> 2, h = bh & 3;
    const int tok0 = b * SEQ + n * 64;
    LAS bf16_t* Qs = (LAS bf16_t*)(lds + G1_QS); LAS bf16_t* Ks = (LAS bf16_t*)(lds + G1_KS); LAS bf16_t* VbT = (LAS bf16_t*)(lds + G1_VBT);
    LAS bf16_t* KbT = (LAS bf16_t*)(lds + G1_KBT); LAS bf16_t* KdT = (LAS bf16_t*)(lds + G1_KDT); LAS bf16_t* UT = (LAS bf16_t*)(lds + G1_UT);
    LAS bf16_t* WT = (LAS bf16_t*)(lds + G1_WT); LAS float* Af = (LAS float*)(lds + G1_WT); LAS bf16_t* QK = (LAS bf16_t*)(lds + G1_QK);
    LAS bf16_t* Tb = (LAS bf16_t*)(lds + G1_TB); LAS float* gcs = (LAS float*)(lds + G1_GC); LAS float* betas = (LAS float*)(lds + G1_BETA);
    const bf16_t* PB = (const bf16_t*)(p.ws + WS_H); const float* GBA = (const float*)(p.ws + WS_GBA);
    LAS unsigned char* raw = lds + G1_UT;
    for (int pc4 = wid; pc4 < 51; pc4 += 8) {
        int pc = pc4 * 4 + (lane >> 4); pc = pc < 200 ? pc : 200;
        const int r = pc / 3, seg = pc - 3 * r; int tt = n * 64 - 3 + r; tt = tt < 0 ? 0 : tt;
        __builtin_amdgcn_global_load_lds((const unsigned*)(PB + (size_t)(b * SEQ + tt) * PW + 768 + seg * 512 + h * 128 + (lane & 15) * 8), (LAS unsigned*)(raw + pc4 * 1024), 16, 0, 0);
    }
    if (tid < 64) {
        const float* gb = GBA + (size_t)(tok0 + tid) * 8;
        const float bt = 1.0f / (1.0f + __expf(-gb[h]));
        const float x = gb[4 + h] + p.in[14][h]; const float sp = x > 20.f ? x : log1pf(__expf(x));
        float c = -__expf(p.in[13][h]) * sp;
#pragma unroll
        for (int o = 1; o < 64; o <<= 1) { const float t = __shfl_up(c, o); if (lane >= o) c += t; }
        gcs[tid] = c; betas[tid] = bt;
    }
    asm volatile("s_waitcnt vmcnt(0)" ::: "memory");
    __syncthreads();
    const float gclast = gcs[63];
    const float* cw = p.in[12];
#pragma unroll 1
    for (int it = 0; it < 6; ++it) {
        const int item = tid + 512 * it, l16 = item & 15, row = item >> 4, which = row >> 6, t = row & 63;
        const int cch = which * 512 + h * 128 + l16 * 8;
        float a[8];
#pragma unroll
        for (int e = 0; e < 8; ++e) a[e] = 0.f;
#pragma unroll
        for (int j = 0; j < 4; ++j) {
            const int tt = n * 64 + t - 3 + j;
            if (tt >= 0) {
                const u32x4 xv = *(const LAS u32x4*)(raw + ((t + j) * 3 + which) * 256 + l16 * 16);
                const f32x4 w0 = *(const f32x4*)(cw + j * CONVC + cch), w1 = *(const f32x4*)(cw + j * CONVC + cch + 4);
                a[0] += w0[0] * bflo(xv.x); a[1] += w0[1] * bfhi(xv.x); a[2] += w0[2] * bflo(xv.y); a[3] += w0[3] * bfhi(xv.y);
                a[4] += w1[0] * bflo(xv.z); a[5] += w1[1] * bfhi(xv.z); a[6] += w1[2] * bflo(xv.w); a[7] += w1[3] * bfhi(xv.w);
            }
        }
        float ss = 0.f;
#pragma unroll
        for (int e = 0; e < 8; ++e) { a[e] = silu(a[e]); ss += a[e] * a[e]; }
        ss += __shfl_xor(ss, 1); ss += __shfl_xor(ss, 2); ss += __shfl_xor(ss, 4); ss += __shfl_xor(ss, 8);
        const float gct = gcs[t], bt = betas[t];
        if (which == 0) {
            const float sc = rsqrtf(ss + EPS) * 0.08838834764831845f;
            u32x4 w; w.x = cvt_pk(a[0] * sc, a[1] * sc); w.y = cvt_pk(a[2] * sc, a[3] * sc); w.z = cvt_pk(a[4] * sc, a[5] * sc); w.w = cvt_pk(a[6] * sc, a[7] * sc);
            *(LAS u32x4*)(Qs + t * 136 + l16 * 8) = w;
        } else if (which == 1) {
            const float sc = rsqrtf(ss + EPS);
            u32x4 w; w.x = cvt_pk(a[0] * sc, a[1] * sc); w.y = cvt_pk(a[2] * sc, a[3] * sc); w.z = cvt_pk(a[4] * sc, a[5] * sc); w.w = cvt_pk(a[6] * sc, a[7] * sc);
            *(LAS u32x4*)(Ks + t * 136 + l16 * 8) = w;
            const float sb = sc * bt * __expf(gct), sd = sc * __expf(gclast - gct);
#pragma unroll
            for (int e = 0; e < 8; ++e) { KbT[(l16 * 8 + e) * 72 + t] = f2bf(a[e] * sb); KdT[(l16 * 8 + e) * 72 + t] = f2bf(a[e] * sd); }
        } else {
#pragma unroll
            for (int e = 0; e < 8; ++e) VbT[(l16 * 8 + e) * 72 + t] = f2bf(a[e] * bt);
        }
    }
    __syncthreads();
#pragma unroll 2
    for (int r = 0; r < 4; ++r) {
        const int job = wid + 8 * r, kind = job >> 4, tile = job & 15, it = tile >> 2, jt = tile & 3;
        if (kind == 0) {
            if (jt > it) continue;
            const f32x4 acc = tile_mm(Ks, 136, it, Ks, 136, jt, 4, fr, fq);
            const int j = 16 * jt + fr; const float gcj = gcs[j];
            float v[4];
#pragma unroll
            for (int e = 0; e < 4; ++e) { const int i = 16 * it + 4 * fq + e; const bool ok = i > j; v[e] = ok ? acc[e] * __expf(gcs[i] - gcj) * betas[i] : 0.f; }
            *(LAS f32x4*)(Af + j * 68 + 16 * it + 4 * fq) = (f32x4){v[0], v[1], v[2], v[3]};
        } else {
            const f32x4 acc = tile_mm(Ks, 136, jt, Qs, 136, it, 4, fr, fq);
            const int i = 16 * it + fr; const float gci = gcs[i];
            float v[4];
#pragma unroll
            for (int e = 0; e < 4; ++e) { const int j = 16 * jt + 4 * fq + e; const bool ok = i >= j; v[e] = ok ? acc[e] * __expf(gci - gcs[j]) : 0.f; }
            u32x2 w; w.x = cvt_pk(v[0], v[1]); w.y = cvt_pk(v[2], v[3]); *(LAS u32x2*)(QK + i * 72 + 16 * jt + 4 * fq) = w;
        }
    }
    __syncthreads();
    if (wid == 0) {
        f32x2v r2[32];
#pragma unroll
        for (int k = 0; k < 32; ++k) r2[k] = (f32x2v){(lane == 2 * k) ? 1.0f : 0.0f, (lane == 2 * k + 1) ? 1.0f : 0.0f};
        const f32x4 a0 = *(const LAS f32x4*)(Af + 0);
        const f32x4 a1 = *(const LAS f32x4*)(Af + 4);
        const f32x4 a2 = *(const LAS f32x4*)(Af + 8);
        const f32x4 a3 = *(const LAS f32x4*)(Af + 12);
        const f32x4 a4 = *(const LAS f32x4*)(Af + 16);
        const float t0 = r2[0][0]; const f32x2v T0 = (f32x2v){t0, t0}; Tb[0 + lane] = f2bf(t0);
        r2[0] -= (f32x2v){a0[0], a0[1]} * T0; r2[1] -= (f32x2v){a0[2], a0[3]} * T0;
        const f32x4 a5 = *(const LAS f32x4*)(Af + 20);
        r2[2] -= (f32x2v){a1[0], a1[1]} * T0; r2[3] -= (f32x2v){a1[2], a1[3]} * T0;
        const f32x4 a6 = *(const LAS f32x4*)(Af + 24);
        r2[4] -= (f32x2v){a2[0], a2[1]} * T0; r2[5] -= (f32x2v){a2[2], a2[3]} * T0;
        const f32x4 a7 = *(const LAS f32x4*)(Af + 28);
        r2[6] -= (f32x2v){a3[0], a3[1]} * T0; r2[7] -= (f32x2v){a3[2], a3[3]} * T0;
        const f32x4 a8 = *(const LAS f32x4*)(Af + 32);
        r2[8] -= (f32x2v){a4[0], a4[1]} * T0; r2[9] -= (f32x2v){a4[2], a4[3]} * T0;
        const f32x4 a9 = *(const LAS f32x4*)(Af + 36);
        r2[10] -= (f32x2v){a5[0], a5[1]} * T0; r2[11] -= (f32x2v){a5[2], a5[3]} * T0;
        const f32x4 a10 = *(const LAS f32x4*)(Af + 40);
        r2[12] -= (f32x2v){a6[0], a6[1]} * T0; r2[13] -= (f32x2v){a6[2], a6[3]} * T0;
        const f32x4 a11 = *(const LAS f32x4*)(Af + 44);
        r2[14] -= (f32x2v){a7[0], a7[1]} * T0; r2[15] -= (f32x2v){a7[2], a7[3]} * T0;
        const f32x4 a12 = *(const LAS f32x4*)(Af + 48);
        r2[16] -= (f32x2v){a8[0], a8[1]} * T0; r2[17] -= (f32x2v){a8[2], a8[3]} * T0;
        const f32x4 a13 = *(const LAS f32x4*)(Af + 52);
        r2[18] -= (f32x2v){a9[0], a9[1]} * T0; r2[19] -= (f32x2v){a9[2], a9[3]} * T0;
        const f32x4 a14 = *(const LAS f32x4*)(Af + 56);
        r2[20] -= (f32x2v){a10[0], a10[1]} * T0; r2[21] -= (f32x2v){a10[2], a10[3]} * T0;
        const f32x4 a15 = *(const LAS f32x4*)(Af + 60);
        r2[22] -= (f32x2v){a11[0], a11[1]} * T0; r2[23] -= (f32x2v){a11[2], a11[3]} * T0;
        const f32x4 a16 = *(const LAS f32x4*)(Af + 68);
        r2[24] -= (f32x2v){a12[0], a12[1]} * T0; r2[25] -= (f32x2v){a12[2], a12[3]} * T0;
        const f32x4 a17 = *(const LAS f32x4*)(Af + 72);
        r2[26] -= (f32x2v){a13[0], a13[1]} * T0; r2[27] -= (f32x2v){a13[2], a13[3]} * T0;
        const f32x4 a18 = *(const LAS f32x4*)(Af + 76);
        r2[28] -= (f32x2v){a14[0], a14[1]} * T0; r2[29] -= (f32x2v){a14[2], a14[3]} * T0;
        const f32x4 a19 = *(const LAS f32x4*)(Af + 80);
        r2[30] -= (f32x2v){a15[0], a15[1]} * T0; r2[31] -= (f32x2v){a15[2], a15[3]} * T0;
        const f32x4 a20 = *(const LAS f32x4*)(Af + 84);
        const float t1 = r2[0][1]; const f32x2v T1 = (f32x2v){t1, t1}; Tb[72 + lane] = f2bf(t1);
        r2[1] -= (f32x2v){a16[2], a16[3]} * T1;
        const f32x4 a21 = *(const LAS f32x4*)(Af + 88);
        r2[2] -= (f32x2v){a17[0], a17[1]} * T1; r2[3] -= (f32x2v){a17[2], a17[3]} * T1;
        const f32x4 a22 = *(const LAS f32x4*)(Af + 92);
        r2[4] -= (f32x2v){a18[0], a18[1]} * T1; r2[5] -= (f32x2v){a18[2], a18[3]} * T1;
        const f32x4 a23 = *(const LAS f32x4*)(Af + 96);
        r2[6] -= (f32x2v){a19[0], a19[1]} * T1; r2[7] -= (f32x2v){a19[2], a19[3]} * T1;
        const f32x4 a24 = *(const LAS f32x4*)(Af + 100);
        r2[8] -= (f32x2v){a20[0], a20[1]} * T1; r2[9] -= (f32x2v){a20[2], a20[3]} * T1;
        const f32x4 a25 = *(const LAS f32x4*)(Af + 104);
        r2[10] -= (f32x2v){a21[0], a21[1]} * T1; r2[11] -= (f32x2v){a21[2], a21[3]} * T1;
        const f32x4 a26 = *(const LAS f32x4*)(Af + 108);
        r2[12] -= (f32x2v){a22[0], a22[1]} * T1; r2[13] -= (f32x2v){a22[2], a22[3]} * T1;
        const f32x4 a27 = *(const LAS f32x4*)(Af + 112);
        r2[14] -= (f32x2v){a23[0], a23[1]} * T1; r2[15] -= (f32x2v){a23[2], a23[3]} * T1;
        const f32x4 a28 = *(const LAS f32x4*)(Af + 116);
        r2[16] -= (f32x2v){a24[0], a24[1]} * T1; r2[17] -= (f32x2v){a24[2], a24[3]} * T1;
        const f32x4 a29 = *(const LAS f32x4*)(Af + 120);
        r2[18] -= (f32x2v){a25[0], a25[1]} * T1; r2[19] -= (f32x2v){a25[2], a25[3]} * T1;
        const f32x4 a30 = *(const LAS f32x4*)(Af + 124);
        r2[20] -= (f32x2v){a26[0], a26[1]} * T1; r2[21] -= (f32x2v){a26[2], a26[3]} * T1;
        const f32x4 a31 = *(const LAS f32x4*)(Af + 128);
        r2[22] -= (f32x2v){a27[0], a27[1]} * T1; r2[23] -= (f32x2v){a27[2], a27[3]} * T1;
        const f32x4 a32 = *(const LAS f32x4*)(Af + 136);
        r2[24] -= (f32x2v){a28[0], a28[1]} * T1; r2[25] -= (f32x2v){a28[2], a28[3]} * T1;
        const f32x4 a33 = *(const LAS f32x4*)(Af + 140);
        r2[26] -= (f32x2v){a29[0], a29[1]} * T1; r2[27] -= (f32x2v){a29[2], a29[3]} * T1;
        const f32x4 a34 = *(const LAS f32x4*)(Af + 144);
        r2[28] -= (f32x2v){a30[0], a30[1]} * T1; r2[29] -= (f32x2v){a30[2], a30[3]} * T1;
        const f32x4 a35 = *(const LAS f32x4*)(Af + 148);
        r2[30] -= (f32x2v){a31[0], a31[1]} * T1; r2[31] -= (f32x2v){a31[2], a31[3]} * T1;
        const f32x4 a36 = *(const LAS f32x4*)(Af + 152);
        const float t2 = r2[1][0]; const f32x2v T2 = (f32x2v){t2, t2}; Tb[144 + lane] = f2bf(t2);
        r2[1] -= (f32x2v){a32[2], a32[3]} * T2;
        const f32x4 a37 = *(const LAS f32x4*)(Af + 156);
        r2[2] -= (f32x2v){a33[0], a33[1]} * T2; r2[3] -= (f32x2v){a33[2], a33[3]} * T2;
        const f32x4 a38 = *(const LAS f32x4*)(Af + 160);
        r2[4] -= (f32x2v){a34[0], a34[1]} * T2; r2[5] -= (f32x2v){a34[2], a34[3]} * T2;
        const f32x4 a39 = *(const LAS f32x4*)(Af + 164);
        r2[6] -= (f32x2v){a35[0], a35[1]} * T2; r2[7] -= (f32x2v){a35[2], a35[3]} * T2;
        const f32x4 a40 = *(const LAS f32x4*)(Af + 168);
        r2[8] -= (f32x2v){a36[0], a36[1]} * T2; r2[9] -= (f32x2v){a36[2], a36[3]} * T2;
        const f32x4 a41 = *(const LAS f32x4*)(Af + 172);
        r2[10] -= (f32x2v){a37[0], a37[1]} * T2; r2[11] -= (f32x2v){a37[2], a37[3]} * T2;
        const f32x4 a42 = *(const LAS f32x4*)(Af + 176);
        r2[12] -= (f32x2v){a38[0], a38[1]} * T2; r2[13] -= (f32x2v){a38[2], a38[3]} * T2;
        const f32x4 a43 = *(const LAS f32x4*)(Af + 180);
        r2[14] -= (f32x2v){a39[0], a39[1]} * T2; r2[15] -= (f32x2v){a39[2], a39[3]} * T2;
        const f32x4 a44 = *(const LAS f32x4*)(Af + 184);
        r2[16] -= (f32x2v){a40[0], a40[1]} * T2; r2[17] -= (f32x2v){a40[2], a40[3]} * T2;
        const f32x4 a45 = *(const LAS f32x4*)(Af + 188);
        r2[18] -= (f32x2v){a41[0], a41[1]} * T2; r2[19] -= (f32x2v){a41[2], a41[3]} * T2;
        const f32x4 a46 = *(const LAS f32x4*)(Af + 192);
        r2[20] -= (f32x2v){a42[0], a42[1]} * T2; r2[21] -= (f32x2v){a42[2], a42[3]} * T2;
        const f32x4 a47 = *(const LAS f32x4*)(Af + 196);
        r2[22] -= (f32x2v){a43[0], a43[1]} * T2; r2[23] -= (f32x2v){a43[2], a43[3]} * T2;
        const f32x4 a48 = *(const LAS f32x4*)(Af + 208);
        r2[24] -= (f32x2v){a44[0], a44[1]} * T2; r2[25] -= (f32x2v){a44[2], a44[3]} * T2;
        const f32x4 a49 = *(const LAS f32x4*)(Af + 212);
        r2[26] -= (f32x2v){a45[0], a45[1]} * T2; r2[27] -= (f32x2v){a45[2], a45[3]} * T2;
        const f32x4 a50 = *(const LAS f32x4*)(Af + 216);
        r2[28] -= (f32x2v){a46[0], a46[1]} * T2; r2[29] -= (f32x2v){a46[2], a46[3]} * T2;
        const f32x4 a51 = *(const LAS f32x4*)(Af + 220);
        r2[30] -= (f32x2v){a47[0], a47[1]} * T2; r2[31] -= (f32x2v){a47[2], a47[3]} * T2;
        const f32x4 a52 = *(const LAS f32x4*)(Af + 224);
        const float t3 = r2[1][1]; const f32x2v T3 = (f32x2v){t3, t3}; Tb[216 + lane] = f2bf(t3);
        r2[2] -= (f32x2v){a48[0], a48[1]} * T3; r2[3] -= (f32x2v){a48[2], a48[3]} * T3;
        const f32x4 a53 = *(const LAS f32x4*)(Af + 228);
        r2[4] -= (f32x2v){a49[0], a49[1]} * T3; r2[5] -= (f32x2v){a49[2], a49[3]} * T3;
        const f32x4 a54 = *(const LAS f32x4*)(Af + 232);
        r2[6] -= (f32x2v){a50[0], a50[1]} * T3; r2[7] -= (f32x2v){a50[2], a50[3]} * T3;
        const f32x4 a55 = *(const LAS f32x4*)(Af + 236);
        r2[8] -= (f32x2v){a51[0], a51[1]} * T3; r2[9] -= (f32x2v){a51[2], a51[3]} * T3;
        const f32x4 a56 = *(const LAS f32x4*)(Af + 240);
        r2[10] -= (f32x2v){a52[0], a52[1]} * T3; r2[11] -= (f32x2v){a52[2], a52[3]} * T3;
        const f32x4 a57 = *(const LAS f32x4*)(Af + 244);
        r2[12] -= (f32x2v){a53[0], a53[1]} * T3; r2[13] -= (f32x2v){a53[2], a53[3]} * T3;
        const f32x4 a58 = *(const LAS f32x4*)(Af + 248);
        r2[14] -= (f32x2v){a54[0], a54[1]} * T3; r2[15] -= (f32x2v){a54[2], a54[3]} * T3;
        const f32x4 a59 = *(const LAS f32x4*)(Af + 252);
        r2[16] -= (f32x2v){a55[0], a55[1]} * T3; r2[17] -= (f32x2v){a55[2], a55[3]} * T3;
        const f32x4 a60 = *(const LAS f32x4*)(Af + 256);
        r2[18] -= (f32x2v){a56[0], a56[1]} * T3; r2[19] -= (f32x2v){a56[2], a56[3]} * T3;
        const f32x4 a61 = *(const LAS f32x4*)(Af + 260);
        r2[20] -= (f32x2v){a57[0], a57[1]} * T3; r2[21] -= (f32x2v){a57[2], a57[3]} * T3;
        const f32x4 a62 = *(const LAS f32x4*)(Af + 264);
        r2[22] -= (f32x2v){a58[0], a58[1]} * T3; r2[23] -= (f32x2v){a58[2], a58[3]} * T3;
        const f32x4 a63 = *(const LAS f32x4*)(Af + 276);
        r2[24] -= (f32x2v){a59[0], a59[1]} * T3; r2[25] -= (f32x2v){a59[2], a59[3]} * T3;
        const f32x4 a64 = *(const LAS f32x4*)(Af + 280);
        r2[26] -= (f32x2v){a60[0], a60[1]} * T3; r2[27] -= (f32x2v){a60[2], a60[3]} * T3;
        const f32x4 a65 = *(const LAS f32x4*)(Af + 284);
        r2[28] -= (f32x2v){a61[0], a61[1]} * T3; r2[29] -= (f32x2v){a61[2], a61[3]} * T3;
        const f32x4 a66 = *(const LAS f32x4*)(Af + 288);
        r2[30] -= (f32x2v){a62[0], a62[1]} * T3; r2[31] -= (f32x2v){a62[2], a62[3]} * T3;
        const f32x4 a67 = *(const LAS f32x4*)(Af + 292);
        const float t4 = r2[2][0]; const f32x2v T4 = (f32x2v){t4, t4}; Tb[288 + lane] = f2bf(t4);
        r2[2] -= (f32x2v){a63[0], a63[1]} * T4; r2[3] -= (f32x2v){a63[2], a63[3]} * T4;
        const f32x4 a68 = *(const LAS f32x4*)(Af + 296);
        r2[4] -= (f32x2v){a64[0], a64[1]} * T4; r2[5] -= (f32x2v){a64[2], a64[3]} * T4;
        const f32x4 a69 = *(const LAS f32x4*)(Af + 300);
        r2[6] -= (f32x2v){a65[0], a65[1]} * T4; r2[7] -= (f32x2v){a65[2], a65[3]} * T4;
        const f32x4 a70 = *(const LAS f32x4*)(Af + 304);
        r2[8] -= (f32x2v){a66[0], a66[1]} * T4; r2[9] -= (f32x2v){a66[2], a66[3]} * T4;
        const f32x4 a71 = *(const LAS f32x4*)(Af + 308);
        r2[10] -= (f32x2v){a67[0], a67[1]} * T4; r2[11] -= (f32x2v){a67[2], a67[3]} * T4;
        const f32x4 a72 = *(const LAS f32x4*)(Af + 312);
        r2[12] -= (f32x2v){a68[0], a68[1]} * T4; r2[13] -= (f32x2v){a68[2], a68[3]} * T4;
        const f32x4 a73 = *(const LAS f32x4*)(Af + 316);
        r2[14] -= (f32x2v){a69[0], a69[1]} * T4; r2[15] -= (f32x2v){a69[2], a69[3]} * T4;
        const f32x4 a74 = *(const LAS f32x4*)(Af + 320);
        r2[16] -= (f32x2v){a70[0], a70[1]} * T4; r2[17] -= (f32x2v){a70[2], a70[3]} * T4;
        const f32x4 a75 = *(const LAS f32x4*)(Af + 324);
        r2[18] -= (f32x2v){a71[0], a71[1]} * T4; r2[19] -= (f32x2v){a71[2], a71[3]} * T4;
        const f32x4 a76 = *(const LAS f32x4*)(Af + 328);
        r2[20] -= (f32x2v){a72[0], a72[1]} * T4; r2[21] -= (f32x2v){a72[2], a72[3]} * T4;
        const f32x4 a77 = *(const LAS f32x4*)(Af + 332);
        r2[22] -= (f32x2v){a73[0], a73[1]} * T4; r2[23] -= (f32x2v){a73[2], a73[3]} * T4;
        const f32x4 a78 = *(const LAS f32x4*)(Af + 344);
        r2[24] -= (f32x2v){a74[0], a74[1]} * T4; r2[25] -= (f32x2v){a74[2], a74[3]} * T4;
        const f32x4 a79 = *(const LAS f32x4*)(Af + 348);
        r2[26] -= (f32x2v){a75[0], a75[1]} * T4; r2[27] -= (f32x2v){a75[2], a75[3]} * T4;
        const f32x4 a80 = *(const LAS f32x4*)(Af + 352);
        r2[28] -= (f32x2v){a76[0], a76[1]} * T4; r2[29] -= (f32x2v){a76[2], a76[3]} * T4;
        const f32x4 a81 = *(const LAS f32x4*)(Af + 356);
        r2[30] -= (f32x2v){a77[0], a77[1]} * T4; r2[31] -= (f32x2v){a77[2], a77[3]} * T4;
        const f32x4 a82 = *(const LAS f32x4*)(Af + 360);
        const float t5 = r2[2][1]; const f32x2v T5 = (f32x2v){t5, t5}; Tb[360 + lane] = f2bf(t5);
        r2[3] -= (f32x2v){a78[2], a78[3]} * T5;
        const f32x4 a83 = *(const LAS f32x4*)(Af + 364);
        r2[4] -= (f32x2v){a79[0], a79[1]} * T5; r2[5] -= (f32x2v){a79[2], a79[3]} * T5;
        const f32x4 a84 = *(const LAS f32x4*)(Af + 368);
        r2[6] -= (f32x2v){a80[0], a80[1]} * T5; r2[7] -= (f32x2v){a80[2], a80[3]} * T5;
        const f32x4 a85 = *(const LAS f32x4*)(Af + 372);
        r2[8] -= (f32x2v){a81[0], a81[1]} * T5; r2[9] -= (f32x2v){a81[2], a81[3]} * T5;
        const f32x4 a86 = *(const LAS f32x4*)(Af + 376);
        r2[10] -= (f32x2v){a82[0], a82[1]} * T5; r2[11] -= (f32x2v){a82[2], a82[3]} * T5;
        const f32x4 a87 = *(const LAS f32x4*)(Af + 380);
        r2[12] -= (f32x2v){a83[0], a83[1]} * T5; r2[13] -= (f32x2v){a83[2], a83[3]} * T5;
        const f32x4 a88 = *(const LAS f32x4*)(Af + 384);
        r2[14] -= (f32x2v){a84[0], a84[1]} * T5; r2[15] -= (f32x2v){a84[2], a84[3]} * T5;
        const f32x4 a89 = *(const LAS f32x4*)(Af + 388);
        r2[16] -= (f32x2v){a85[0], a85[1]} * T5; r2[17] -= (f32x2v){a85[2], a85[3]} * T5;
        const f32x4 a90 = *(const LAS f32x4*)(Af + 392);
        r2[18] -= (f32x2v){a86[0], a86[1]} * T5; r2[19] -= (f32x2v){a86[2], a86[3]} * T5;
        const f32x4 a91 = *(const LAS f32x4*)(Af + 396);
        r2[20] -= (f32x2v){a87[0], a87[1]} * T5; r2[21] -= (f32x2v){a87[2], a87[3]} * T5;
        const f32x4 a92 = *(const LAS f32x4*)(Af + 400);
        r2[22] -= (f32x2v){a88[0], a88[1]} * T5; r2[23] -= (f32x2v){a88[2], a88[3]} * T5;
        const f32x4 a93 = *(const LAS f32x4*)(Af + 412);
        r2[24] -= (f32x2v){a89[0], a89[1]} * T5; r2[25] -= (f32x2v){a89[2], a89[3]} * T5;
        const f32x4 a94 = *(const LAS f32x4*)(Af + 416);
        r2[26] -= (f32x2v){a90[0], a90[1]} * T5; r2[27] -= (f32x2v){a90[2], a90[3]} * T5;
        const f32x4 a95 = *(const LAS f32x4*)(Af + 420);
        r2[28] -= (f32x2v){a91[0], a91[1]} * T5; r2[29] -= (f32x2v){a91[2], a91[3]} * T5;
        const f32x4 a96 = *(const LAS f32x4*)(Af + 424);
        r2[30] -= (f32x2v){a92[0], a92[1]} * T5; r2[31] -= (f32x2v){a92[2], a92[3]} * T5;
        const f32x4 a97 = *(const LAS f32x4*)(Af + 428);
        const float t6 = r2[3][0]; const f32x2v T6 = (f32x2v){t6, t6}; Tb[432 + lane] = f2bf(t6);
        r2[3] -= (f32x2v){a93[2], a93[3]} * T6;
        const f32x4 a98 = *(const LAS f32x4*)(Af + 432);
        r2[4] -= (f32x2v){a94[0], a94[1]} * T6; r2[5] -= (f32x2v){a94[2], a94[3]} * T6;
        const f32x4 a99 = *(const LAS f32x4*)(Af + 436);
        r2[6] -= (f32x2v){a95[0], a95[1]} * T6; r2[7] -= (f32x2v){a95[2], a95[3]} * T6;
        const f32x4 a100 = *(const LAS f32x4*)(Af + 440);
        r2[8] -= (f32x2v){a96[0], a96[1]} * T6; r2[9] -= (f32x2v){a96[2], a96[3]} * T6;
        const f32x4 a101 = *(const LAS f32x4*)(Af + 444);
        r2[10] -= (f32x2v){a97[0], a97[1]} * T6; r2[11] -= (f32x2v){a97[2], a97[3]} * T6;
        const f32x4 a102 = *(const LAS f32x4*)(Af + 448);
        r2[12] -= (f32x2v){a98[0], a98[1]} * T6; r2[13] -= (f32x2v){a98[2], a98[3]} * T6;
        const f32x4 a103 = *(const LAS f32x4*)(Af + 452);
        r2[14] -= (f32x2v){a99[0], a99[1]} * T6; r2[15] -= (f32x2v){a99[2], a99[3]} * T6;
        const f32x4 a104 = *(const LAS f32x4*)(Af + 456);
        r2[16] -= (f32x2v){a100[0], a100[1]} * T6; r2[17] -= (f32x2v){a100[2], a100[3]} * T6;
        const f32x4 a105 = *(const LAS f32x4*)(Af + 460);
        r2[18] -= (f32x2v){a101[0], a101[1]} * T6; r2[19] -= (f32x2v){a101[2], a101[3]} * T6;
        const f32x4 a106 = *(const LAS f32x4*)(Af + 464);
        r2[20] -= (f32x2v){a102[0], a102[1]} * T6; r2[21] -= (f32x2v){a102[2], a102[3]} * T6;
        const f32x4 a107 = *(const LAS f32x4*)(Af + 468);
        r2[22] -= (f32x2v){a103[0], a103[1]} * T6; r2[23] -= (f32x2v){a103[2], a103[3]} * T6;
        const f32x4 a108 = *(const LAS f32x4*)(Af + 484);
        r2[24] -= (f32x2v){a104[0], a104[1]} * T6; r2[25] -= (f32x2v){a104[2], a104[3]} * T6;
        const f32x4 a109 = *(const LAS f32x4*)(Af + 488);
        r2[26] -= (f32x2v){a105[0], a105[1]} * T6; r2[27] -= (f32x2v){a105[2], a105[3]} * T6;
        const f32x4 a110 = *(const LAS f32x4*)(Af + 492);
        r2[28] -= (f32x2v){a106[0], a106[1]} * T6; r2[29] -= (f32x2v){a106[2], a106[3]} * T6;
        const f32x4 a111 = *(const LAS f32x4*)(Af + 496);
        r2[30] -= (f32x2v){a107[0], a107[1]} * T6; r2[31] -= (f32x2v){a107[2], a107[3]} * T6;
        const f32x4 a112 = *(const LAS f32x4*)(Af + 500);
        const float t7 = r2[3][1]; const f32x2v T7 = (f32x2v){t7, t7}; Tb[504 + lane] = f2bf(t7);
        r2[4] -= (f32x2v){a108[0], a108[1]} * T7; r2[5] -= (f32x2v){a108[2], a108[3]} * T7;
        const f32x4 a113 = *(const LAS f32x4*)(Af + 504);
        r2[6] -= (f32x2v){a109[0], a109[1]} * T7; r2[7] -= (f32x2v){a109[2], a109[3]} * T7;
        const f32x4 a114 = *(const LAS f32x4*)(Af + 508);
        r2[8] -= (f32x2v){a110[0], a110[1]} * T7; r2[9] -= (f32x2v){a110[2], a110[3]} * T7;
        const f32x4 a115 = *(const LAS f32x4*)(Af + 512);
        r2[10] -= (f32x2v){a111[0], a111[1]} * T7; r2[11] -= (f32x2v){a111[2], a111[3]} * T7;
        const f32x4 a116 = *(const LAS f32x4*)(Af + 516);
        r2[12] -= (f32x2v){a112[0], a112[1]} * T7; r2[13] -= (f32x2v){a112[2], a112[3]} * T7;
        const f32x4 a117 = *(const LAS f32x4*)(Af + 520);
        r2[14] -= (f32x2v){a113[0], a113[1]} * T7; r2[15] -= (f32x2v){a113[2], a113[3]} * T7;
        const f32x4 a118 = *(const LAS f32x4*)(Af + 524);
        r2[16] -= (f32x2v){a114[0], a114[1]} * T7; r2[17] -= (f32x2v){a114[2], a114[3]} * T7;
        const f32x4 a119 = *(const LAS f32x4*)(Af + 528);
        r2[18] -= (f32x2v){a115[0], a115[1]} * T7; r2[19] -= (f32x2v){a115[2], a115[3]} * T7;
        const f32x4 a120 = *(const LAS f32x4*)(Af + 532);
        r2[20] -= (f32x2v){a116[0], a116[1]} * T7; r2[21] -= (f32x2v){a116[2], a116[3]} * T7;
        const f32x4 a121 = *(const LAS f32x4*)(Af + 536);
        r2[22] -= (f32x2v){a117[0], a117[1]} * T7; r2[23] -= (f32x2v){a117[2], a117[3]} * T7;
        const f32x4 a122 = *(const LAS f32x4*)(Af + 552);
        r2[24] -= (f32x2v){a118[0], a118[1]} * T7; r2[25] -= (f32x2v){a118[2], a118[3]} * T7;
        const f32x4 a123 = *(const LAS f32x4*)(Af + 556);
        r2[26] -= (f32x2v){a119[0], a119[1]} * T7; r2[27] -= (f32x2v){a119[2], a119[3]} * T7;
        const f32x4 a124 = *(const LAS f32x4*)(Af + 560);
        r2[28] -= (f32x2v){a120[0], a120[1]} * T7; r2[29] -= (f32x2v){a120[2], a120[3]} * T7;
        const f32x4 a125 = *(const LAS f32x4*)(Af + 564);
        r2[30] -= (f32x2v){a121[0], a121[1]} * T7; r2[31] -= (f32x2v){a121[2], a121[3]} * T7;
        const f32x4 a126 = *(const LAS f32x4*)(Af + 568);
        const float t8 = r2[4][0]; const f32x2v T8 = (f32x2v){t8, t8}; Tb[576 + lane] = f2bf(t8);
        r2[4] -= (f32x2v){a122[0], a122[1]} * T8; r2[5] -= (f32x2v){a122[2], a122[3]} * T8;
        const f32x4 a127 = *(const LAS f32x4*)(Af + 572);
        r2[6] -= (f32x2v){a123[0], a123[1]} * T8; r2[7] -= (f32x2v){a123[2], a123[3]} * T8;
        const f32x4 a128 = *(const LAS f32x4*)(Af + 576);
        r2[8] -= (f32x2v){a124[0], a124[1]} * T8; r2[9] -= (f32x2v){a124[2], a124[3]} * T8;
        const f32x4 a129 = *(const LAS f32x4*)(Af + 580);
        r2[10] -= (f32x2v){a125[0], a125[1]} * T8; r2[11] -= (f32x2v){a125[2], a125[3]} * T8;
        const f32x4 a130 = *(const LAS f32x4*)(Af + 584);
        r2[12] -= (f32x2v){a126[0], a126[1]} * T8; r2[13] -= (f32x2v){a126[2], a126[3]} * T8;
        const f32x4 a131 = *(const LAS f32x4*)(Af + 588);
        r2[14] -= (f32x2v){a127[0], a127[1]} * T8; r2[15] -= (f32x2v){a127[2], a127[3]} * T8;
        const f32x4 a132 = *(const LAS f32x4*)(Af + 592);
        r2[16] -= (f32x2v){a128[0], a128[1]} * T8; r2[17] -= (f32x2v){a128[2], a128[3]} * T8;
        const f32x4 a133 = *(const LAS f32x4*)(Af + 596);
        r2[18] -= (f32x2v){a129[0], a129[1]} * T8; r2[19] -= (f32x2v){a129[2], a129[3]} * T8;
        const f32x4 a134 = *(const LAS f32x4*)(Af + 600);
        r2[20] -= (f32x2v){a130[0], a130[1]} * T8; r2[21] -= (f32x2v){a130[2], a130[3]} * T8;
        const f32x4 a135 = *(const LAS f32x4*)(Af + 604);
        r2[22] -= (f32x2v){a131[0], a131[1]} * T8; r2[23] -= (f32x2v){a131[2], a131[3]} * T8;
        const f32x4 a136 = *(const LAS f32x4*)(Af + 620);
        r2[24] -= (f32x2v){a132[0], a132[1]} * T8; r2[25] -= (f32x2v){a132[2], a132[3]} * T8;
        const f32x4 a137 = *(const LAS f32x4*)(Af + 624);
        r2[26] -= (f32x2v){a133[0], a133[1]} * T8; r2[27] -= (f32x2v){a133[2], a133[3]} * T8;
        const f32x4 a138 = *(const LAS f32x4*)(Af + 628);
        r2[28] -= (f32x2v){a134[0], a134[1]} * T8; r2[29] -= (f32x2v){a134[2], a134[3]} * T8;
        const f32x4 a139 = *(const LAS f32x4*)(Af + 632);
        r2[30] -= (f32x2v){a135[0], a135[1]} * T8; r2[31] -= (f32x2v){a135[2], a135[3]} * T8;
        const f32x4 a140 = *(const LAS f32x4*)(Af + 636);
        const float t9 = r2[4][1]; const f32x2v T9 = (f32x2v){t9, t9}; Tb[648 + lane] = f2bf(t9);
        r2[5] -= (f32x2v){a136[2], a136[3]} * T9;
        const f32x4 a141 = *(const LAS f32x4*)(Af + 640);
        r2[6] -= (f32x2v){a137[0], a137[1]} * T9; r2[7] -= (f32x2v){a137[2], a137[3]} * T9;
        const f32x4 a142 = *(const LAS f32x4*)(Af + 644);
        r2[8] -= (f32x2v){a138[0], a138[1]} * T9; r2[9] -= (f32x2v){a138[2], a138[3]} * T9;
        const f32x4 a143 = *(const LAS f32x4*)(Af + 648);
        r2[10] -= (f32x2v){a139[0], a139[1]} * T9; r2[11] -= (f32x2v){a139[2], a139[3]} * T9;
        const f32x4 a144 = *(const LAS f32x4*)(Af + 652);
        r2[12] -= (f32x2v){a140[0], a140[1]} * T9; r2[13] -= (f32x2v){a140[2], a140[3]} * T9;
        const f32x4 a145 = *(const LAS f32x4*)(Af + 656);
        r2[14] -= (f32x2v){a141[0], a141[1]} * T9; r2[15] -= (f32x2v){a141[2], a141[3]} * T9;
        const f32x4 a146 = *(const LAS f32x4*)(Af + 660);
        r2[16] -= (f32x2v){a142[0], a142[1]} * T9; r2[17] -= (f32x2v){a142[2], a142[3]} * T9;
        const f32x4 a147 = *(const LAS f32x4*)(Af + 664);
        r2[18] -= (f32x2v){a143[0], a143[1]} * T9; r2[19] -= (f32x2v){a143[2], a143[3]} * T9;
        const f32x4 a148 = *(const LAS f32x4*)(Af + 668);
        r2[20] -= (f32x2v){a144[0], a144[1]} * T9; r2[21] -= (f32x2v){a144[2], a144[3]} * T9;
        const f32x4 a149 = *(const LAS f32x4*)(Af + 672);
        r2[22] -= (f32x2v){a145[0], a145[1]} * T9; r2[23] -= (f32x2v){a145[2], a145[3]} * T9;
        const f32x4 a150 = *(const LAS f32x4*)(Af + 688);
        r2[24] -= (f32x2v){a146[0], a146[1]} * T9; r2[25] -= (f32x2v){a146[2], a146[3]} * T9;
        const f32x4 a151 = *(const LAS f32x4*)(Af + 692);
        r2[26] -= (f32x2v){a147[0], a147[1]} * T9; r2[27] -= (f32x2v){a147[2], a147[3]} * T9;
        const f32x4 a152 = *(const LAS f32x4*)(Af + 696);
        r2[28] -= (f32x2v){a148[0], a148[1]} * T9; r2[29] -= (f32x2v){a148[2], a148[3]} * T9;
        const f32x4 a153 = *(const LAS f32x4*)(Af + 700);
        r2[30] -= (f32x2v){a149[0], a149[1]} * T9; r2[31] -= (f32x2v){a149[2], a149[3]} * T9;
        const f32x4 a154 = *(const LAS f32x4*)(Af + 704);
        const float t10 = r2[5][0]; const f32x2v T10 = (f32x2v){t10, t10}; Tb[720 + lane] = f2bf(t10);
        r2[5] -= (f32x2v){a150[2], a150[3]} * T10;
        const f32x4 a155 = *(const LAS f32x4*)(Af + 708);
        r2[6] -= (f32x2v){a151[0], a151[1]} * T10; r2[7] -= (f32x2v){a151[2], a151[3]} * T10;
        const f32x4 a156 = *(const LAS f32x4*)(Af + 712);
        r2[8] -= (f32x2v){a152[0], a152[1]} * T10; r2[9] -= (f32x2v){a152[2], a152[3]} * T10;
        const f32x4 a157 = *(const LAS f32x4*)(Af + 716);
        r2[10] -= (f32x2v){a153[0], a153[1]} * T10; r2[11] -= (f32x2v){a153[2], a153[3]} * T10;
        const f32x4 a158 = *(const LAS f32x4*)(Af + 720);
        r2[12] -= (f32x2v){a154[0], a154[1]} * T10; r2[13] -= (f32x2v){a154[2], a154[3]} * T10;
        const f32x4 a159 = *(const LAS f32x4*)(Af + 724);
        r2[14] -= (f32x2v){a155[0], a155[1]} * T10; r2[15] -= (f32x2v){a155[2], a155[3]} * T10;
        const f32x4 a160 = *(const LAS f32x4*)(Af + 728);
        r2[16] -= (f32x2v){a156[0], a156[1]} * T10; r2[17] -= (f32x2v){a156[2], a156[3]} * T10;
        const f32x4 a161 = *(const LAS f32x4*)(Af + 732);
        r2[18] -= (f32x2v){a157[0], a157[1]} * T10; r2[19] -= (f32x2v){a157[2], a157[3]} * T10;
        const f32x4 a162 = *(const LAS f32x4*)(Af + 736);
        r2[20] -= (f32x2v){a158[0], a158[1]} * T10; r2[21] -= (f32x2v){a158[2], a158[3]} * T10;
        const f32x4 a163 = *(const LAS f32x4*)(Af + 740);
        r2[22] -= (f32x2v){a159[0], a159[1]} * T10; r2[23] -= (f32x2v){a159[2], a159[3]} * T10;
        const f32x4 a164 = *(const LAS f32x4*)(Af + 760);
        r2[24] -= (f32x2v){a160[0], a160[1]} * T10; r2[25] -= (f32x2v){a160[2], a160[3]} * T10;
        const f32x4 a165 = *(const LAS f32x4*)(Af + 764);
        r2[26] -= (f32x2v){a161[0], a161[1]} * T10; r2[27] -= (f32x2v){a161[2], a161[3]} * T10;
        const f32x4 a166 = *(const LAS f32x4*)(Af + 768);
        r2[28] -= (f32x2v){a162[0], a162[1]} * T10; r2[29] -= (f32x2v){a162[2], a162[3]} * T10;
        const f32x4 a167 = *(const LAS f32x4*)(Af + 772);
        r2[30] -= (f32x2v){a163[0], a163[1]} * T10; r2[31] -= (f32x2v){a163[2], a163[3]} * T10;
        const f32x4 a168 = *(const LAS f32x4*)(Af + 776);
        const float t11 = r2[5][1]; const f32x2v T11 = (f32x2v){t11, t11}; Tb[792 + lane] = f2bf(t11);
        r2[6] -= (f32x2v){a164[0], a164[1]} * T11; r2[7] -= (f32x2v){a164[2], a164[3]} * T11;
        const f32x4 a169 = *(const LAS f32x4*)(Af + 780);
        r2[8] -= (f32x2v){a165[0], a165[1]} * T11; r2[9] -= (f32x2v){a165[2], a165[3]} * T11;
        const f32x4 a170 = *(const LAS f32x4*)(Af + 784);
        r2[10] -= (f32x2v){a166[0], a166[1]} * T11; r2[11] -= (f32x2v){a166[2], a166[3]} * T11;
        const f32x4 a171 = *(const LAS f32x4*)(Af + 788);
        r2[12] -= (f32x2v){a167[0], a167[1]} * T11; r2[13] -= (f32x2v){a167[2], a167[3]} * T11;
        const f32x4 a172 = *(const LAS f32x4*)(Af + 792);
        r2[14] -= (f32x2v){a168[0], a168[1]} * T11; r2[15] -= (f32x2v){a168[2], a168[3]} * T11;
        const f32x4 a173 = *(const LAS f32x4*)(Af + 796);
        r2[16] -= (f32x2v){a169[0], a169[1]} * T11; r2[17] -= (f32x2v){a169[2], a169[3]} * T11;
        const f32x4 a174 = *(const LAS f32x4*)(Af + 800);
        r2[18] -= (f32x2v){a170[0], a170[1]} * T11; r2[19] -= (f32x2v){a170[2], a170[3]} * T11;
        const f32x4 a175 = *(const LAS f32x4*)(Af + 804);
        r2[20] -= (f32x2v){a171[0], a171[1]} * T11; r2[21] -= (f32x2v){a171[2], a171[3]} * T11;
        const f32x4 a176 = *(const LAS f32x4*)(Af + 808);
        r2[22] -= (f32x2v){a172[0], a172[1]} * T11; r2[23] -= (f32x2v){a172[2], a172[3]} * T11;
        const f32x4 a177 = *(const LAS f32x4*)(Af + 828);
        r2[24] -= (f32x2v){a173[0], a173[1]} * T11; r2[25] -= (f32x2v){a173[2], a173[3]} * T11;
        const f32x4 a178 = *(const LAS f32x4*)(Af + 832);
        r2[26] -= (f32x2v){a174[0], a174[1]} * T11; r2[27] -= (f32x2v){a174[2], a174[3]} * T11;
        const f32x4 a179 = *(const LAS f32x4*)(Af + 836);
        r2[28] -= (f32x2v){a175[0], a175[1]} * T11; r2[29] -= (f32x2v){a175[2], a175[3]} * T11;
        const f32x4 a180 = *(const LAS f32x4*)(Af + 840);
        r2[30] -= (f32x2v){a176[0], a176[1]} * T11; r2[31] -= (f32x2v){a176[2], a176[3]} * T11;
        const f32x4 a181 = *(const LAS f32x4*)(Af + 844);
        const float t12 = r2[6][0]; const f32x2v T12 = (f32x2v){t12, t12}; Tb[864 + lane] = f2bf(t12);
        r2[6] -= (f32x2v){a177[0], a177[1]} * T12; r2[7] -= (f32x2v){a177[2], a177[3]} * T12;
        const f32x4 a182 = *(const LAS f32x4*)(Af + 848);
        r2[8] -= (f32x2v){a178[0], a178[1]} * T12; r2[9] -= (f32x2v){a178[2], a178[3]} * T12;
        const f32x4 a183 = *(const LAS f32x4*)(Af + 852);
        r2[10] -= (f32x2v){a179[0], a179[1]} * T12; r2[11] -= (f32x2v){a179[2], a179[3]} * T12;
        const f32x4 a184 = *(const LAS f32x4*)(Af + 856);
        r2[12] -= (f32x2v){a180[0], a180[1]} * T12; r2[13] -= (f32x2v){a180[2], a180[3]} * T12;
        const f32x4 a185 = *(const LAS f32x4*)(Af + 860);
        r2[14] -= (f32x2v){a181[0], a181[1]} * T12; r2[15] -= (f32x2v){a181[2], a181[3]} * T12;
        const f32x4 a186 = *(const LAS f32x4*)(Af + 864);
        r2[16] -= (f32x2v){a182[0], a182[1]} * T12; r2[17] -= (f32x2v){a182[2], a182[3]} * T12;
        const f32x4 a187 = *(const LAS f32x4*)(Af + 868);
        r2[18] -= (f32x2v){a183[0], a183[1]} * T12; r2[19] -= (f32x2v){a183[2], a183[3]} * T12;
        const f32x4 a188 = *(const LAS f32x4*)(Af + 872);
        r2[20] -= (f32x2v){a184[0], a184[1]} * T12; r2[21] -= (f32x2v){a184[2], a184[3]} * T12;
        const f32x4 a189 = *(const LAS f32x4*)(Af + 876);
        r2[22] -= (f32x2v){a185[0], a185[1]} * T12; r2[23] -= (f32x2v){a185[2], a185[3]} * T12;
        const f32x4 a190 = *(const LAS f32x4*)(Af + 896);
        r2[24] -= (f32x2v){a186[0], a186[1]} * T12; r2[25] -= (f32x2v){a186[2], a186[3]} * T12;
        const f32x4 a191 = *(const LAS f32x4*)(Af + 900);
        r2[26] -= (f32x2v){a187[0], a187[1]} * T12; r2[27] -= (f32x2v){a187[2], a187[3]} * T12;
        const f32x4 a192 = *(const LAS f32x4*)(Af + 904);
        r2[28] -= (f32x2v){a188[0], a188[1]} * T12; r2[29] -= (f32x2v){a188[2], a188[3]} * T12;
        const f32x4 a193 = *(const LAS f32x4*)(Af + 908);
        r2[30] -= (f32x2v){a189[0], a189[1]} * T12; r2[31] -= (f32x2v){a189[2], a189[3]} * T12;
        const f32x4 a194 = *(const LAS f32x4*)(Af + 912);
        const float t13 = r2[6][1]; const f32x2v T13 = (f32x2v){t13, t13}; Tb[936 + lane] = f2bf(t13);
        r2[7] -= (f32x2v){a190[2], a190[3]} * T13;
        const f32x4 a195 = *(const LAS f32x4*)(Af + 916);
        r2[8] -= (f32x2v){a191[0], a191[1]} * T13; r2[9] -= (f32x2v){a191[2], a191[3]} * T13;
        const f32x4 a196 = *(const LAS f32x4*)(Af + 920);
        r2[10] -= (f32x2v){a192[0], a192[1]} * T13; r2[11] -= (f32x2v){a192[2], a192[3]} * T13;
        const f32x4 a197 = *(const LAS f32x4*)(Af + 924);
        r2[12] -= (f32x2v){a193[0], a193[1]} * T13; r2[13] -= (f32x2v){a193[2], a193[3]} * T13;
        const f32x4 a198 = *(const LAS f32x4*)(Af + 928);
        r2[14] -= (f32x2v){a194[0], a194[1]} * T13; r2[15] -= (f32x2v){a194[2], a194[3]} * T13;
        const f32x4 a199 = *(const LAS f32x4*)(Af + 932);
        r2[16] -= (f32x2v){a195[0], a195[1]} * T13; r2[17] -= (f32x2v){a195[2], a195[3]} * T13;
        const f32x4 a200 = *(const LAS f32x4*)(Af + 936);
        r2[18] -= (f32x2v){a196[0], a196[1]} * T13; r2[19] -= (f32x2v){a196[2], a196[3]} * T13;
        const f32x4 a201 = *(const LAS f32x4*)(Af + 940);
        r2[20] -= (f32x2v){a197[0], a197[1]} * T13; r2[21] -= (f32x2v){a197[2], a197[3]} * T13;
        const f32x4 a202 = *(const LAS f32x4*)(Af + 944);
        r2[22] -= (f32x2v){a198[0], a198[1]} * T13; r2[23] -= (f32x2v){a198[2], a198[3]} * T13;
        const f32x4 a203 = *(const LAS f32x4*)(Af + 964);
        r2[24] -= (f32x2v){a199[0], a199[1]} * T13; r2[25] -= (f32x2v){a199[2], a199[3]} * T13;
        const f32x4 a204 = *(const LAS f32x4*)(Af + 968);
        r2[26] -= (f32x2v){a200[0], a200[1]} * T13; r2[27] -= (f32x2v){a200[2], a200[3]} * T13;
        const f32x4 a205 = *(const LAS f32x4*)(Af + 972);
        r2[28] -= (f32x2v){a201[0], a201[1]} * T13; r2[29] -= (f32x2v){a201[2], a201[3]} * T13;
        const f32x4 a206 = *(const LAS f32x4*)(Af + 976);
        r2[30] -= (f32x2v){a202[0], a202[1]} * T13; r2[31] -= (f32x2v){a202[2], a202[3]} * T13;
        const f32x4 a207 = *(const LAS f32x4*)(Af + 980);
        const float t14 = r2[7][0]; const f32x2v T14 = (f32x2v){t14, t14}; Tb[1008 + lane] = f2bf(t14);
        r2[7] -= (f32x2v){a203[2], a203[3]} * T14;
        const f32x4 a208 = *(const LAS f32x4*)(Af + 984);
        r2[8] -= (f32x2v){a204[0], a204[1]} * T14; r2[9] -= (f32x2v){a204[2], a204[3]} * T14;
        const f32x4 a209 = *(const LAS f32x4*)(Af + 988);
        r2[10] -= (f32x2v){a205[0], a205[1]} * T14; r2[11] -= (f32x2v){a205[2], a205[3]} * T14;
        const f32x4 a210 = *(const LAS f32x4*)(Af + 992);
        r2[12] -= (f32x2v){a206[0], a206[1]} * T14; r2[13] -= (f32x2v){a206[2], a206[3]} * T14;
        const f32x4 a211 = *(const LAS f32x4*)(Af + 996);
        r2[14] -= (f32x2v){a207[0], a207[1]} * T14; r2[15] -= (f32x2v){a207[2], a207[3]} * T14;
        const f32x4 a212 = *(const LAS f32x4*)(Af + 1000);
        r2[16] -= (f32x2v){a208[0], a208[1]} * T14; r2[17] -= (f32x2v){a208[2], a208[3]} * T14;
        const f32x4 a213 = *(const LAS f32x4*)(Af + 1004);
        r2[18] -= (f32x2v){a209[0], a209[1]} * T14; r2[19] -= (f32x2v){a209[2], a209[3]} * T14;
        const f32x4 a214 = *(const LAS f32x4*)(Af + 1008);
        r2[20] -= (f32x2v){a210[0], a210[1]} * T14; r2[21] -= (f32x2v){a210[2], a210[3]} * T14;
        const f32x4 a215 = *(const LAS f32x4*)(Af + 1012);
        r2[22] -= (f32x2v){a211[0], a211[1]} * T14; r2[23] -= (f32x2v){a211[2], a211[3]} * T14;
        const f32x4 a216 = *(const LAS f32x4*)(Af + 1036);
        r2[24] -= (f32x2v){a212[0], a212[1]} * T14; r2[25] -= (f32x2v){a212[2], a212[3]} * T14;
        const f32x4 a217 = *(const LAS f32x4*)(Af + 1040);
        r2[26] -= (f32x2v){a213[0], a213[1]} * T14; r2[27] -= (f32x2v){a213[2], a213[3]} * T14;
        const f32x4 a218 = *(const LAS f32x4*)(Af + 1044);
        r2[28] -= (f32x2v){a214[0], a214[1]} * T14; r2[29] -= (f32x2v){a214[2], a214[3]} * T14;
        const f32x4 a219 = *(const LAS f32x4*)(Af + 1048);
        r2[30] -= (f32x2v){a215[0], a215[1]} * T14; r2[31] -= (f32x2v){a215[2], a215[3]} * T14;
        const f32x4 a220 = *(const LAS f32x4*)(Af + 1052);
        const float t15 = r2[7][1]; const f32x2v T15 = (f32x2v){t15, t15}; Tb[1080 + lane] = f2bf(t15);
        r2[8] -= (f32x2v){a216[0], a216[1]} * T15; r2[9] -= (f32x2v){a216[2], a216[3]} * T15;
        const f32x4 a221 = *(const LAS f32x4*)(Af + 1056);
        r2[10] -= (f32x2v){a217[0], a217[1]} * T15; r2[11] -= (f32x2v){a217[2], a217[3]} * T15;
        const f32x4 a222 = *(const LAS f32x4*)(Af + 1060);
        r2[12] -= (f32x2v){a218[0], a218[1]} * T15; r2[13] -= (f32x2v){a218[2], a218[3]} * T15;
        const f32x4 a223 = *(const LAS f32x4*)(Af + 1064);
        r2[14] -= (f32x2v){a219[0], a219[1]} * T15; r2[15] -= (f32x2v){a219[2], a219[3]} * T15;
        const f32x4 a224 = *(const LAS f32x4*)(Af + 1068);
        r2[16] -= (f32x2v){a220[0], a220[1]} * T15; r2[17] -= (f32x2v){a220[2], a220[3]} * T15;
        const f32x4 a225 = *(const LAS f32x4*)(Af + 1072);
        r2[18] -= (f32x2v){a221[0], a221[1]} * T15; r2[19] -= (f32x2v){a221[2], a221[3]} * T15;
        const f32x4 a226 = *(const LAS f32x4*)(Af + 1076);
        r2[20] -= (f32x2v){a222[0], a222[1]} * T15; r2[21] -= (f32x2v){a222[2], a222[3]} * T15;
        const f32x4 a227 = *(const LAS f32x4*)(Af + 1080);
        r2[22] -= (f32x2v){a223[0], a223[1]} * T15; r2[23] -= (f32x2v){a223[2], a223[3]} * T15;
        const f32x4 a228 = *(const LAS f32x4*)(Af + 1104);
        r2[24] -= (f32x2v){a224[0], a224[1]} * T15; r2[25] -= (f32x2v){a224[2], a224[3]} * T15;
        const f32x4 a229 = *(const LAS f32x4*)(Af + 1108);
        r2[26] -= (f32x2v){a225[0], a225[1]} * T15; r2[27] -= (f32x2v){a225[2], a225[3]} * T15;
        const f32x4 a230 = *(const LAS f32x4*)(Af + 1112);
        r2[28] -= (f32x2v){a226[0], a226[1]} * T15; r2[29] -= (f32x2v){a226[2], a226[3]} * T15;
        const f32x4 a231 = *(const LAS f32x4*)(Af + 1116);
        r2[30] -= (f32x2v){a227[0], a227[1]} * T15; r2[31] -= (f32x2v){a227[2], a227[3]} * T15;
        const f32x4 a232 = *(const LAS f32x4*)(Af + 1120);
        const float t16 = r2[8][0]; const f32x2v T16 = (f32x2v){t16, t16}; Tb[1152 + lane] = f2bf(t16);
        r2[8] -= (f32x2v){a228[0], a228[1]} * T16; r2[9] -= (f32x2v){a228[2], a228[3]} * T16;
        const f32x4 a233 = *(const LAS f32x4*)(Af + 1124);
        r2[10] -= (f32x2v){a229[0], a229[1]} * T16; r2[11] -= (f32x2v){a229[2], a229[3]} * T16;
        const f32x4 a234 = *(const LAS f32x4*)(Af + 1128);
        r2[12] -= (f32x2v){a230[0], a230[1]} * T16; r2[13] -= (f32x2v){a230[2], a230[3]} * T16;
        const f32x4 a235 = *(const LAS f32x4*)(Af + 1132);
        r2[14] -= (f32x2v){a231[0], a231[1]} * T16; r2[15] -= (f32x2v){a231[2], a231[3]} * T16;
        const f32x4 a236 = *(const LAS f32x4*)(Af + 1136);
        r2[16] -= (f32x2v){a232[0], a232[1]} * T16; r2[17] -= (f32x2v){a232[2], a232[3]} * T16;
        const f32x4 a237 = *(const LAS f32x4*)(Af + 1140);
        r2[18] -= (f32x2v){a233[0], a233[1]} * T16; r2[19] -= (f32x2v){a233[2], a233[3]} * T16;
        const f32x4 a238 = *(const LAS f32x4*)(Af + 1144);
        r2[20] -= (f32x2v){a234[0], a234[1]} * T16; r2[21] -= (f32x2v){a234[2], a234[3]} * T16;
        const f32x4 a239 = *(const LAS f32x4*)(Af + 1148);
        r2[22] -= (f32x2v){a235[0], a235[1]} * T16; r2[23] -= (f32x2v){a235[2], a235[3]} * T16;
        const f32x4 a240 = *(const LAS f32x4*)(Af + 1172);
        r2[24] -= (f32x2v){a236[0], a236[1]} * T16; r2[25] -= (f32x2v){a236[2], a236[3]} * T16;
        const f32x4 a241 = *(const LAS f32x4*)(Af + 1176);
        r2[26] -= (f32x2v){a237[0], a237[1]} * T16; r2[27] -= (f32x2v){a237[2], a237[3]} * T16;
        const f32x4 a242 = *(const LAS f32x4*)(Af + 1180);
        r2[28] -= (f32x2v){a238[0], a238[1]} * T16; r2[29] -= (f32x2v){a238[2], a238[3]} * T16;
        const f32x4 a243 = *(const LAS f32x4*)(Af + 1184);
        r2[30] -= (f32x2v){a239[0], a239[1]} * T16; r2[31] -= (f32x2v){a239[2], a239[3]} * T16;
        const f32x4 a244 = *(const LAS f32x4*)(Af + 1188);
        const float t17 = r2[8][1]; const f32x2v T17 = (f32x2v){t17, t17}; Tb[1224 + lane] = f2bf(t17);
        r2[9] -= (f32x2v){a240[2], a240[3]} * T17;
        const f32x4 a245 = *(const LAS f32x4*)(Af + 1192);
        r2[10] -= (f32x2v){a241[0], a241[1]} * T17; r2[11] -= (f32x2v){a241[2], a241[3]} * T17;
        const f32x4 a246 = *(const LAS f32x4*)(Af + 1196);
        r2[12] -= (f32x2v){a242[0], a242[1]} * T17; r2[13] -= (f32x2v){a242[2], a242[3]} * T17;
        const f32x4 a247 = *(const LAS f32x4*)(Af + 1200);
        r2[14] -= (f32x2v){a243[0], a243[1]} * T17; r2[15] -= (f32x2v){a243[2], a243[3]} * T17;
        const f32x4 a248 = *(const LAS f32x4*)(Af + 1204);
        r2[16] -= (f32x2v){a244[0], a244[1]} * T17; r2[17] -= (f32x2v){a244[2], a244[3]} * T17;
        const f32x4 a249 = *(const LAS f32x4*)(Af + 1208);
        r2[18] -= (f32x2v){a245[0], a245[1]} * T17; r2[19] -= (f32x2v){a245[2], a245[3]} * T17;
        const f32x4 a250 = *(const LAS f32x4*)(Af + 1212);
        r2[20] -= (f32x2v){a246[0], a246[1]} * T17; r2[21] -= (f32x2v){a246[2], a246[3]} * T17;
        const f32x4 a251 = *(const LAS f32x4*)(Af + 1216);
        r2[22] -= (f32x2v){a247[0], a247[1]} * T17; r2[23] -= (f32x2v){a247[2], a247[3]} * T17;
        const f32x4 a252 = *(const LAS f32x4*)(Af + 1240);
        r2[24] -= (f32x2v){a248[0], a248[1]} * T17; r2[25] -= (f32x2v){a248[2], a248[3]} * T17;
        const f32x4 a253 = *(const LAS f32x4*)(Af + 1244);
        r2[26] -= (f32x2v){a249[0], a249[1]} * T17; r2[27] -= (f32x2v){a249[2], a249[3]} * T17;
        const f32x4 a254 = *(const LAS f32x4*)(Af + 1248);
        r2[28] -= (f32x2v){a250[0], a250[1]} * T17; r2[29] -= (f32x2v){a250[2], a250[3]} * T17;
        const f32x4 a255 = *(const LAS f32x4*)(Af + 1252);
        r2[30] -= (f32x2v){a251[0], a251[1]} * T17; r2[31] -= (f32x2v){a251[2], a251[3]} * T17;
        const f32x4 a256 = *(const LAS f32x4*)(Af + 1256);
        const float t18 = r2[9][0]; const f32x2v T18 = (f32x2v){t18, t18}; Tb[1296 + lane] = f2bf(t18);
        r2[9] -= (f32x2v){a252[2], a252[3]} * T18;
        const f32x4 a257 = *(const LAS f32x4*)(Af + 1260);
        r2[10] -= (f32x2v){a253[0], a253[1]} * T18; r2[11] -= (f32x2v){a253[2], a253[3]} * T18;
        const f32x4 a258 = *(const LAS f32x4*)(Af + 1264);
        r2[12] -= (f32x2v){a254[0], a254[1]} * T18; r2[13] -= (f32x2v){a254[2], a254[3]} * T18;
        const f32x4 a259 = *(const LAS f32x4*)(Af + 1268);
        r2[14] -= (f32x2v){a255[0], a255[1]} * T18; r2[15] -= (f32x2v){a255[2], a255[3]} * T18;
        const f32x4 a260 = *(const LAS f32x4*)(Af + 1272);
        r2[16] -= (f32x2v){a256[0], a256[1]} * T18; r2[17] -= (f32x2v){a256[2], a256[3]} * T18;
        const f32x4 a261 = *(const LAS f32x4*)(Af + 1276);
        r2[18] -= (f32x2v){a257[0], a257[1]} * T18; r2[19] -= (f32x2v){a257[2], a257[3]} * T18;
        const f32x4 a262 = *(const LAS f32x4*)(Af + 1280);
        r2[20] -= (f32x2v){a258[0], a258[1]} * T18; r2[21] -= (f32x2v){a258[2], a258[3]} * T18;
        const f32x4 a263 = *(const LAS f32x4*)(Af + 1284);
        r2[22] -= (f32x2v){a259[0], a259[1]} * T18; r2[23] -= (f32x2v){a259[2], a259[3]} * T18;
        const f32x4 a264 = *(const LAS f32x4*)(Af + 1312);
        r2[24] -= (f32x2v){a260[0], a260[1]} * T18; r2[25] -= (f32x2v){a260[2], a260[3]} * T18;
        const f32x4 a265 = *(const LAS f32x4*)(Af + 1316);
        r2[26] -= (f32x2v){a261[0], a261[1]} * T18; r2[27] -= (f32x2v){a261[2], a261[3]} * T18;
        const f32x4 a266 = *(const LAS f32x4*)(Af + 1320);
        r2[28] -= (f32x2v){a262[0], a262[1]} * T18; r2[29] -= (f32x2v){a262[2], a262[3]} * T18;
        const f32x4 a267 = *(const LAS f32x4*)(Af + 1324);
        r2[30] -= (f32x2v){a263[0], a263[1]} * T18; r2[31] -= (f32x2v){a263[2], a263[3]} * T18;
        const f32x4 a268 = *(const LAS f32x4*)(Af + 1328);
        const float t19 = r2[9][1]; const f32x2v T19 = (f32x2v){t19, t19}; Tb[1368 + lane] = f2bf(t19);
        r2[10] -= (f32x2v){a264[0], a264[1]} * T19; r2[11] -= (f32x2v){a264[2], a264[3]} * T19;
        const f32x4 a269 = *(const LAS f32x4*)(Af + 1332);
        r2[12] -= (f32x2v){a265[0], a265[1]} * T19; r2[13] -= (f32x2v){a265[2], a265[3]} * T19;
        const f32x4 a270 = *(const LAS f32x4*)(Af + 1336);
        r2[14] -= (f32x2v){a266[0], a266[1]} * T19; r2[15] -= (f32x2v){a266[2], a266[3]} * T19;
        const f32x4 a271 = *(const LAS f32x4*)(Af + 1340);
        r2[16] -= (f32x2v){a267[0], a267[1]} * T19; r2[17] -= (f32x2v){a267[2], a267[3]} * T19;
        const f32x4 a272 = *(const LAS f32x4*)(Af + 1344);
        r2[18] -= (f32x2v){a268[0], a268[1]} * T19; r2[19] -= (f32x2v){a268[2], a268[3]} * T19;
        const f32x4 a273 = *(const LAS f32x4*)(Af + 1348);
        r2[20] -= (f32x2v){a269[0], a269[1]} * T19; r2[21] -= (f32x2v){a269[2], a269[3]} * T19;
        const f32x4 a274 = *(const LAS f32x4*)(Af + 1352);
        r2[22] -= (f32x2v){a270[0], a270[1]} * T19; r2[23] -= (f32x2v){a270[2], a270[3]} * T19;
        const f32x4 a275 = *(const LAS f32x4*)(Af + 1380);
        r2[24] -= (f32x2v){a271[0], a271[1]} * T19; r2[25] -= (f32x2v){a271[2], a271[3]} * T19;
        const f32x4 a276 = *(const LAS f32x4*)(Af + 1384);
        r2[26] -= (f32x2v){a272[0], a272[1]} * T19; r2[27] -= (f32x2v){a272[2], a272[3]} * T19;
        const f32x4 a277 = *(const LAS f32x4*)(Af + 1388);
        r2[28] -= (f32x2v){a273[0], a273[1]} * T19; r2[29] -= (f32x2v){a273[2], a273[3]} * T19;
        const f32x4 a278 = *(const LAS f32x4*)(Af + 1392);
        r2[30] -= (f32x2v){a274[0], a274[1]} * T19; r2[31] -= (f32x2v){a274[2], a274[3]} * T19;
        const f32x4 a279 = *(const LAS f32x4*)(Af + 1396);
        const float t20 = r2[10][0]; const f32x2v T20 = (f32x2v){t20, t20}; Tb[1440 + lane] = f2bf(t20);
        r2[10] -= (f32x2v){a275[0], a275[1]} * T20; r2[11] -= (f32x2v){a275[2], a275[3]} * T20;
        const f32x4 a280 = *(const LAS f32x4*)(Af + 1400);
        r2[12] -= (f32x2v){a276[0], a276[1]} * T20; r2[13] -= (f32x2v){a276[2], a276[3]} * T20;
        const f32x4 a281 = *(const LAS f32x4*)(Af + 1404);
        r2[14] -= (f32x2v){a277[0], a277[1]} * T20; r2[15] -= (f32x2v){a277[2], a277[3]} * T20;
        const f32x4 a282 = *(const LAS f32x4*)(Af + 1408);
        r2[16] -= (f32x2v){a278[0], a278[1]} * T20; r2[17] -= (f32x2v){a278[2], a278[3]} * T20;
        const f32x4 a283 = *(const LAS f32x4*)(Af + 1412);
        r2[18] -= (f32x2v){a279[0], a279[1]} * T20; r2[19] -= (f32x2v){a279[2], a279[3]} * T20;
        const f32x4 a284 = *(const LAS f32x4*)(Af + 1416);
        r2[20] -= (f32x2v){a280[0], a280[1]} * T20; r2[21] -= (f32x2v){a280[2], a280[3]} * T20;
        const f32x4 a285 = *(const LAS f32x4*)(Af + 1420);
        r2[22] -= (f32x2v){a281[0], a281[1]} * T20; r2[23] -= (f32x2v){a281[2], a281[3]} * T20;
        const f32x4 a286 = *(const LAS f32x4*)(Af + 1448);
        r2[24] -= (f32x2v){a282[0], a282[1]} * T20; r2[25] -= (f32x2v){a282[2], a282[3]} * T20;
        const f32x4 a287 = *(const LAS f32x4*)(Af + 1452);
        r2[26] -= (f32x2v){a283[0], a283[1]} * T20; r2[27] -= (f32x2v){a283[2], a283[3]} * T20;
        const f32x4 a288 = *(const LAS f32x4*)(Af + 1456);
        r2[28] -= (f32x2v){a284[0], a284[1]} * T20; r2[29] -= (f32x2v){a284[2], a284[3]} * T20;
        const f32x4 a289 = *(const LAS f32x4*)(Af + 1460);
        r2[30] -= (f32x2v){a285[0], a285[1]} * T20; r2[31] -= (f32x2v){a285[2], a285[3]} * T20;
        const f32x4 a290 = *(const LAS f32x4*)(Af + 1464);
        const float t21 = r2[10][1]; const f32x2v T21 = (f32x2v){t21, t21}; Tb[1512 + lane] = f2bf(t21);
        r2[11] -= (f32x2v){a286[2], a286[3]} * T21;
        const f32x4 a291 = *(const LAS f32x4*)(Af + 1468);
        r2[12] -= (f32x2v){a287[0], a287[1]} * T21; r2[13] -= (f32x2v){a287[2], a287[3]} * T21;
        const f32x4 a292 = *(const LAS f32x4*)(Af + 1472);
        r2[14] -= (f32x2v){a288[0], a288[1]} * T21; r2[15] -= (f32x2v){a288[2], a288[3]} * T21;
        const f32x4 a293 = *(const LAS f32x4*)(Af + 1476);
        r2[16] -= (f32x2v){a289[0], a289[1]} * T21; r2[17] -= (f32x2v){a289[2], a289[3]} * T21;
        const f32x4 a294 = *(const LAS f32x4*)(Af + 1480);
        r2[18] -= (f32x2v){a290[0], a290[1]} * T21; r2[19] -= (f32x2v){a290[2], a290[3]} * T21;
        const f32x4 a295 = *(const LAS f32x4*)(Af + 1484);
        r2[20] -= (f32x2v){a291[0], a291[1]} * T21; r2[21] -= (f32x2v){a291[2], a291[3]} * T21;
        const f32x4 a296 = *(const LAS f32x4*)(Af + 1488);
        r2[22] -= (f32x2v){a292[0], a292[1]} * T21; r2[23] -= (f32x2v){a292[2], a292[3]} * T21;
        const f32x4 a297 = *(const LAS f32x4*)(Af + 1516);
        r2[24] -= (f32x2v){a293[0], a293[1]} * T21; r2[25] -= (f32x2v){a293[2], a293[3]} * T21;
        const f32x4 a298 = *(const LAS f32x4*)(Af + 1520);
        r2[26] -= (f32x2v){a294[0], a294[1]} * T21; r2[27] -= (f32x2v){a294[2], a294[3]} * T21;
        const f32x4 a299 = *(const LAS f32x4*)(Af + 1524);
        r2[28] -= (f32x2v){a295[0], a295[1]} * T21; r2[29] -= (f32x2v){a295[2], a295[3]} * T21;
        const f32x4 a300 = *(const LAS f32x4*)(Af + 1528);
        r2[30] -= (f32x2v){a296[0], a296[1]} * T21; r2[31] -= (f32x2v){a296[2], a296[3]} * T21;
        const f32x4 a301 = *(const LAS f32x4*)(Af + 1532);
        const float t22 = r2[11][0]; const f32x2v T22 = (f32x2v){t22, t22}; Tb[1584 + lane] = f2bf(t22);
        r2[11] -= (f32x2v){a297[2], a297[3]} * T22;
        const f32x4 a302 = *(const LAS f32x4*)(Af + 1536);
        r2[12] -= (f32x2v){a298[0], a298[1]} * T22; r2[13] -= (f32x2v){a298[2], a298[3]} * T22;
        const f32x4 a303 = *(const LAS f32x4*)(Af + 1540);
        r2[14] -= (f32x2v){a299[0], a299[1]} * T22; r2[15] -= (f32x2v){a299[2], a299[3]} * T22;
        const f32x4 a304 = *(const LAS f32x4*)(Af + 1544);
        r2[16] -= (f32x2v){a300[0], a300[1]} * T22; r2[17] -= (f32x2v){a300[2], a300[3]} * T22;
        const f32x4 a305 = *(const LAS f32x4*)(Af + 1548);
        r2[18] -= (f32x2v){a301[0], a301[1]} * T22; r2[19] -= (f32x2v){a301[2], a301[3]} * T22;
        const f32x4 a306 = *(const LAS f32x4*)(Af + 1552);
        r2[20] -= (f32x2v){a302[0], a302[1]} * T22; r2[21] -= (f32x2v){a302[2], a302[3]} * T22;
        const f32x4 a307 = *(const LAS f32x4*)(Af + 1556);
        r2[22] -= (f32x2v){a303[0], a303[1]} * T22; r2[23] -= (f32x2v){a303[2], a303[3]} * T22;
        const f32x4 a308 = *(const LAS f32x4*)(Af + 1588);
        r2[24] -= (f32x2v){a304[0], a304[1]} * T22; r2[25] -= (f32x2v){a304[2], a304[3]} * T22;
        const f32x4 a309 = *(const LAS f32x4*)(Af + 1592);
        r2[26] -= (f32x2v){a305[0], a305[1]} * T22; r2[27] -= (f32x2v){a305[2], a305[3]} * T22;
        const f32x4 a310 = *(const LAS f32x4*)(Af + 1596);
        r2[28] -= (f32x2v){a306[0], a306[1]} * T22; r2[29] -= (f32x2v){a306[2], a306[3]} * T22;
        const f32x4 a311 = *(const LAS f32x4*)(Af + 1600);
        r2[30] -= (f32x2v){a307[0], a307[1]} * T22; r2[31] -= (f32x2v){a307[2], a307[3]} * T22;
        const f32x4 a312 = *(const LAS f32x4*)(Af + 1604);
        const float t23 = r2[11][1]; const f32x2v T23 = (f32x2v){t23, t23}; Tb[1656 + lane] = f2bf(t23);
        r2[12] -= (f32x2v){a308[0], a308[1]} * T23; r2[13] -= (f32x2v){a308[2], a308[3]} * T23;
        const f32x4 a313 = *(const LAS f32x4*)(Af + 1608);
        r2[14] -= (f32x2v){a309[0], a309[1]} * T23; r2[15] -= (f32x2v){a309[2], a309[3]} * T23;
        const f32x4 a314 = *(const LAS f32x4*)(Af + 1612);
        r2[16] -= (f32x2v){a310[0], a310[1]} * T23; r2[17] -= (f32x2v){a310[2], a310[3]} * T23;
        const f32x4 a315 = *(const LAS f32x4*)(Af + 1616);
        r2[18] -= (f32x2v){a311[0], a311[1]} * T23; r2[19] -= (f32x2v){a311[2], a311[3]} * T23;
        const f32x4 a316 = *(const LAS f32x4*)(Af + 1620);
        r2[20] -= (f32x2v){a312[0], a312[1]} * T23; r2[21] -= (f32x2v){a312[2], a312[3]} * T23;
        const f32x4 a317 = *(const LAS f32x4*)(Af + 1624);
        r2[22] -= (f32x2v){a313[0], a313[1]} * T23; r2[23] -= (f32x2v){a313[2], a313[3]} * T23;
        const f32x4 a318 = *(const LAS f32x4*)(Af + 1656);
        r2[24] -= (f32x2v){a314[0], a314[1]} * T23; r2[25] -= (f32x2v){a314[2], a314[3]} * T23;
        const f32x4 a319 = *(const LAS f32x4*)(Af + 1660);
        r2[26] -= (f32x2v){a315[0], a315[1]} * T23; r2[27] -= (f32x2v){a315[2], a315[3]} * T23;
        const f32x4 a320 = *(const LAS f32x4*)(Af + 1664);
        r2[28] -= (f32x2v){a316[0], a316[1]} * T23; r2[29] -= (f32x2v){a316[2], a316[3]} * T23;
        const f32x4 a321 = *(const LAS f32x4*)(Af + 1668);
        r2[30] -= (f32x2v){a317[0], a317[1]} * T23; r2[31] -= (f32x2v){a317[2], a317[3]} * T23;
        const f32x4 a322 = *(const LAS f32x4*)(Af + 1672);
        const float t24 = r2[12][0]; const f32x2v T24 = (f32x2v){t24, t24}; Tb[1728 + lane] = f2bf(t24);
        r2[12] -= (f32x2v){a318[0], a318[1]} * T24; r2[13] -= (f32x2v){a318[2], a318[3]} * T24;
        const f32x4 a323 = *(const LAS f32x4*)(Af + 1676);
        r2[14] -= (f32x2v){a319[0], a319[1]} * T24; r2[15] -= (f32x2v){a319[2], a319[3]} * T24;
        const f32x4 a324 = *(const LAS f32x4*)(Af + 1680);
        r2[16] -= (f32x2v){a320[0], a320[1]} * T24; r2[17] -= (f32x2v){a320[2], a320[3]} * T24;
        const f32x4 a325 = *(const LAS f32x4*)(Af + 1684);
        r2[18] -= (f32x2v){a321[0], a321[1]} * T24; r2[19] -= (f32x2v){a321[2], a321[3]} * T24;
        const f32x4 a326 = *(const LAS f32x4*)(Af + 1688);
        r2[20] -= (f32x2v){a322[0], a322[1]} * T24; r2[21] -= (f32x2v){a322[2], a322[3]} * T24;
        const f32x4 a327 = *(const LAS f32x4*)(Af + 1692);
        r2[22] -= (f32x2v){a323[0], a323[1]} * T24; r2[23] -= (f32x2v){a323[2], a323[3]} * T24;
        const f32x4 a328 = *(const LAS f32x4*)(Af + 1724);
        r2[24] -= (f32x2v){a324[0], a324[1]} * T24; r2[25] -= (f32x2v){a324[2], a324[3]} * T24;
        const f32x4 a329 = *(const LAS f32x4*)(Af + 1728);
        r2[26] -= (f32x2v){a325[0], a325[1]} * T24; r2[27] -= (f32x2v){a325[2], a325[3]} * T24;
        const f32x4 a330 = *(const LAS f32x4*)(Af + 1732);
        r2[28] -= (f32x2v){a326[0], a326[1]} * T24; r2[29] -= (f32x2v){a326[2], a326[3]} * T24;
        const f32x4 a331 = *(const LAS f32x4*)(Af + 1736);
        r2[30] -= (f32x2v){a327[0], a327[1]} * T24; r2[31] -= (f32x2v){a327[2], a327[3]} * T24;
        const f32x4 a332 = *(const LAS f32x4*)(Af + 1740);
        const float t25 = r2[12][1]; const f32x2v T25 = (f32x2v){t25, t25}; Tb[1800 + lane] = f2bf(t25);
        r2[13] -= (f32x2v){a328[2], a328[3]} * T25;
        const f32x4 a333 = *(const LAS f32x4*)(Af + 1744);
        r2[14] -= (f32x2v){a329[0], a329[1]} * T25; r2[15] -= (f32x2v){a329[2], a329[3]} * T25;
        const f32x4 a334 = *(const LAS f32x4*)(Af + 1748);
        r2[16] -= (f32x2v){a330[0], a330[1]} * T25; r2[17] -= (f32x2v){a330[2], a330[3]} * T25;
        const f32x4 a335 = *(const LAS f32x4*)(Af + 1752);
        r2[18] -= (f32x2v){a331[0], a331[1]} * T25; r2[19] -= (f32x2v){a331[2], a331[3]} * T25;
        const f32x4 a336 = *(const LAS f32x4*)(Af + 1756);
        r2[20] -= (f32x2v){a332[0], a332[1]} * T25; r2[21] -= (f32x2v){a332[2], a332[3]} * T25;
        const f32x4 a337 = *(const LAS f32x4*)(Af + 1760);
        r2[22] -= (f32x2v){a333[0], a333[1]} * T25; r2[23] -= (f32x2v){a333[2], a333[3]} * T25;
        const f32x4 a338 = *(const LAS f32x4*)(Af + 1792);
        r2[24] -= (f32x2v){a334[0], a334[1]} * T25; r2[25] -= (f32x2v){a334[2], a334[3]} * T25;
        const f32x4 a339 = *(const LAS f32x4*)(Af + 1796);
        r2[26] -= (f32x2v){a335[0], a335[1]} * T25; r2[27] -= (f32x2v){a335[2], a335[3]} * T25;
        const f32x4 a340 = *(const LAS f32x4*)(Af + 1800);
        r2[28] -= (f32x2v){a336[0], a336[1]} * T25; r2[29] -= (f32x2v){a336[2], a336[3]} * T25;
        const f32x4 a341 = *(const LAS f32x4*)(Af + 1804);
        r2[30] -= (f32x2v){a337[0], a337[1]} * T25; r2[31] -= (f32x2v){a337[2], a337[3]} * T25;
        const f32x4 a342 = *(const LAS f32x4*)(Af + 1808);
        const float t26 = r2[13][0]; const f32x2v T26 = (f32x2v){t26, t26}; Tb[1872 + lane] = f2bf(t26);
        r2[13] -= (f32x2v){a338[2], a338[3]} * T26;
        const f32x4 a343 = *(const LAS f32x4*)(Af + 1812);
        r2[14] -= (f32x2v){a339[0], a339[1]} * T26; r2[15] -= (f32x2v){a339[2], a339[3]} * T26;
        const f32x4 a344 = *(const LAS f32x4*)(Af + 1816);
        r2[16] -= (f32x2v){a340[0], a340[1]} * T26; r2[17] -= (f32x2v){a340[2], a340[3]} * T26;
        const f32x4 a345 = *(const LAS f32x4*)(Af + 1820);
        r2[18] -= (f32x2v){a341[0], a341[1]} * T26; r2[19] -= (f32x2v){a341[2], a341[3]} * T26;
        const f32x4 a346 = *(const LAS f32x4*)(Af + 1824);
        r2[20] -= (f32x2v){a342[0], a342[1]} * T26; r2[21] -= (f32x2v){a342[2], a342[3]} * T26;
        const f32x4 a347 = *(const LAS f32x4*)(Af + 1828);
        r2[22] -= (f32x2v){a343[0], a343[1]} * T26; r2[23] -= (f32x2v){a343[2], a343[3]} * T26;
        const f32x4 a348 = *(const LAS f32x4*)(Af + 1864);
        r2[24] -= (f32x2v){a344[0], a344[1]} * T26; r2[25] -= (f32x2v){a344[2], a344[3]} * T26;
        const f32x4 a349 = *(const LAS f32x4*)(Af + 1868);
        r2[26] -= (f32x2v){a345[0], a345[1]} * T26; r2[27] -= (f32x2v){a345[2], a345[3]} * T26;
        const f32x4 a350 = *(const LAS f32x4*)(Af + 1872);
        r2[28] -= (f32x2v){a346[0], a346[1]} * T26; r2[29] -= (f32x2v){a346[2], a346[3]} * T26;
        const f32x4 a351 = *(const LAS f32x4*)(Af + 1876);
        r2[30] -= (f32x2v){a347[0], a347[1]} * T26; r2[31] -= (f32x2v){a347[2], a347[3]} * T26;
        const f32x4 a352 = *(const LAS f32x4*)(Af + 1880);
        const float t27 = r2[13][1]; const f32x2v T27 = (f32x2v){t27, t27}; Tb[1944 + lane] = f2bf(t27);
        r2[14] -= (f32x2v){a348[0], a348[1]} * T27; r2[15] -= (f32x2v){a348[2], a348[3]} * T27;
        const f32x4 a353 = *(const LAS f32x4*)(Af + 1884);
        r2[16] -= (f32x2v){a349[0], a349[1]} * T27; r2[17] -= (f32x2v){a349[2], a349[3]} * T27;
        const f32x4 a354 = *(const LAS f32x4*)(Af + 1888);
        r2[18] -= (f32x2v){a350[0], a350[1]} * T27; r2[19] -= (f32x2v){a350[2], a350[3]} * T27;
        const f32x4 a355 = *(const LAS f32x4*)(Af + 1892);
        r2[20] -= (f32x2v){a351[0], a351[1]} * T27; r2[21] -= (f32x2v){a351[2], a351[3]} * T27;
        const f32x4 a356 = *(const LAS f32x4*)(Af + 1896);
        r2[22] -= (f32x2v){a352[0], a352[1]} * T27; r2[23] -= (f32x2v){a352[2], a352[3]} * T27;
        const f32x4 a357 = *(const LAS f32x4*)(Af + 1932);
        r2[24] -= (f32x2v){a353[0], a353[1]} * T27; r2[25] -= (f32x2v){a353[2], a353[3]} * T27;
        const f32x4 a358 = *(const LAS f32x4*)(Af + 1936);
        r2[26] -= (f32x2v){a354[0], a354[1]} * T27; r2[27] -= (f32x2v){a354[2], a354[3]} * T27;
        const f32x4 a359 = *(const LAS f32x4*)(Af + 1940);
        r2[28] -= (f32x2v){a355[0], a355[1]} * T27; r2[29] -= (f32x2v){a355[2], a355[3]} * T27;
        const f32x4 a360 = *(const LAS f32x4*)(Af + 1944);
        r2[30] -= (f32x2v){a356[0], a356[1]} * T27; r2[31] -= (f32x2v){a356[2], a356[3]} * T27;
        const f32x4 a361 = *(const LAS f32x4*)(Af + 1948);
        const float t28 = r2[14][0]; const f32x2v T28 = (f32x2v){t28, t28}; Tb[2016 + lane] = f2bf(t28);
        r2[14] -= (f32x2v){a357[0], a357[1]} * T28; r2[15] -= (f32x2v){a357[2], a357[3]} * T28;
        const f32x4 a362 = *(const LAS f32x4*)(Af + 1952);
        r2[16] -= (f32x2v){a358[0], a358[1]} * T28; r2[17] -= (f32x2v){a358[2], a358[3]} * T28;
        const f32x4 a363 = *(const LAS f32x4*)(Af + 1956);
        r2[18] -= (f32x2v){a359[0], a359[1]} * T28; r2[19] -= (f32x2v){a359[2], a359[3]} * T28;
        const f32x4 a364 = *(const LAS f32x4*)(Af + 1960);
        r2[20] -= (f32x2v){a360[0], a360[1]} * T28; r2[21] -= (f32x2v){a360[2], a360[3]} * T28;
        const f32x4 a365 = *(const LAS f32x4*)(Af + 1964);
        r2[22] -= (f32x2v){a361[0], a361[1]} * T28; r2[23] -= (f32x2v){a361[2], a361[3]} * T28;
        const f32x4 a366 = *(const LAS f32x4*)(Af + 2000);
        r2[24] -= (f32x2v){a362[0], a362[1]} * T28; r2[25] -= (f32x2v){a362[2], a362[3]} * T28;
        const f32x4 a367 = *(const LAS f32x4*)(Af + 2004);
        r2[26] -= (f32x2v){a363[0], a363[1]} * T28; r2[27] -= (f32x2v){a363[2], a363[3]} * T28;
        const f32x4 a368 = *(const LAS f32x4*)(Af + 2008);
        r2[28] -= (f32x2v){a364[0], a364[1]} * T28; r2[29] -= (f32x2v){a364[2], a364[3]} * T28;
        const f32x4 a369 = *(const LAS f32x4*)(Af + 2012);
        r2[30] -= (f32x2v){a365[0], a365[1]} * T28; r2[31] -= (f32x2v){a365[2], a365[3]} * T28;
        const f32x4 a370 = *(const LAS f32x4*)(Af + 2016);
        const float t29 = r2[14][1]; const f32x2v T29 = (f32x2v){t29, t29}; Tb[2088 + lane] = f2bf(t29);
        r2[15] -= (f32x2v){a366[2], a366[3]} * T29;
        const f32x4 a371 = *(const LAS f32x4*)(Af + 2020);
        r2[16] -= (f32x2v){a367[0], a367[1]} * T29; r2[17] -= (f32x2v){a367[2], a367[3]} * T29;
        const f32x4 a372 = *(const LAS f32x4*)(Af + 2024);
        r2[18] -= (f32x2v){a368[0], a368[1]} * T29; r2[19] -= (f32x2v){a368[2], a368[3]} * T29;
        const f32x4 a373 = *(const LAS f32x4*)(Af + 2028);
        r2[20] -= (f32x2v){a369[0], a369[1]} * T29; r2[21] -= (f32x2v){a369[2], a369[3]} * T29;
        const f32x4 a374 = *(const LAS f32x4*)(Af + 2032);
        r2[22] -= (f32x2v){a370[0], a370[1]} * T29; r2[23] -= (f32x2v){a370[2], a370[3]} * T29;
        const f32x4 a375 = *(const LAS f32x4*)(Af + 2068);
        r2[24] -= (f32x2v){a371[0], a371[1]} * T29; r2[25] -= (f32x2v){a371[2], a371[3]} * T29;
        const f32x4 a376 = *(const LAS f32x4*)(Af + 2072);
        r2[26] -= (f32x2v){a372[0], a372[1]} * T29; r2[27] -= (f32x2v){a372[2], a372[3]} * T29;
        const f32x4 a377 = *(const LAS f32x4*)(Af + 2076);
        r2[28] -= (f32x2v){a373[0], a373[1]} * T29; r2[29] -= (f32x2v){a373[2], a373[3]} * T29;
        const f32x4 a378 = *(const LAS f32x4*)(Af + 2080);
        r2[30] -= (f32x2v){a374[0], a374[1]} * T29; r2[31] -= (f32x2v){a374[2], a374[3]} * T29;
        const f32x4 a379 = *(const LAS f32x4*)(Af + 2084);
        const float t30 = r2[15][0]; const f32x2v T30 = (f32x2v){t30, t30}; Tb[2160 + lane] = f2bf(t30);
        r2[15] -= (f32x2v){a375[2], a375[3]} * T30;
        const f32x4 a380 = *(const LAS f32x4*)(Af + 2088);
        r2[16] -= (f32x2v){a376[0], a376[1]} * T30; r2[17] -= (f32x2v){a376[2], a376[3]} * T30;
        const f32x4 a381 = *(const LAS f32x4*)(Af + 2092);
        r2[18] -= (f32x2v){a377[0], a377[1]} * T30; r2[19] -= (f32x2v){a377[2], a377[3]} * T30;
        const f32x4 a382 = *(const LAS f32x4*)(Af + 2096);
        r2[20] -= (f32x2v){a378[0], a378[1]} * T30; r2[21] -= (f32x2v){a378[2], a378[3]} * T30;
        const f32x4 a383 = *(const LAS f32x4*)(Af + 2100);
        r2[22] -= (f32x2v){a379[0], a379[1]} * T30; r2[23] -= (f32x2v){a379[2], a379[3]} * T30;
        const f32x4 a384 = *(const LAS f32x4*)(Af + 2140);
        r2[24] -= (f32x2v){a380[0], a380[1]} * T30; r2[25] -= (f32x2v){a380[2], a380[3]} * T30;
        const f32x4 a385 = *(const LAS f32x4*)(Af + 2144);
        r2[26] -= (f32x2v){a381[0], a381[1]} * T30; r2[27] -= (f32x2v){a381[2], a381[3]} * T30;
        const f32x4 a386 = *(const LAS f32x4*)(Af + 2148);
        r2[28] -= (f32x2v){a382[0], a382[1]} * T30; r2[29] -= (f32x2v){a382[2], a382[3]} * T30;
        const f32x4 a387 = *(const LAS f32x4*)(Af + 2152);
        r2[30] -= (f32x2v){a383[0], a383[1]} * T30; r2[31] -= (f32x2v){a383[2], a383[3]} * T30;
        const f32x4 a388 = *(const LAS f32x4*)(Af + 2156);
        const float t31 = r2[15][1]; const f32x2v T31 = (f32x2v){t31, t31}; Tb[2232 + lane] = f2bf(t31);
        r2[16] -= (f32x2v){a384[0], a384[1]} * T31; r2[17] -= (f32x2v){a384[2], a384[3]} * T31;
        const f32x4 a389 = *(const LAS f32x4*)(Af + 2160);
        r2[18] -= (f32x2v){a385[0], a385[1]} * T31; r2[19] -= (f32x2v){a385[2], a385[3]} * T31;
        const f32x4 a390 = *(const LAS f32x4*)(Af + 2164);
        r2[20] -= (f32x2v){a386[0], a386[1]} * T31; r2[21] -= (f32x2v){a386[2], a386[3]} * T31;
        const f32x4 a391 = *(const LAS f32x4*)(Af + 2168);
        r2[22] -= (f32x2v){a387[0], a387[1]} * T31; r2[23] -= (f32x2v){a387[2], a387[3]} * T31;
        const f32x4 a392 = *(const LAS f32x4*)(Af + 2208);
        r2[24] -= (f32x2v){a388[0], a388[1]} * T31; r2[25] -= (f32x2v){a388[2], a388[3]} * T31;
        const f32x4 a393 = *(const LAS f32x4*)(Af + 2212);
        r2[26] -= (f32x2v){a389[0], a389[1]} * T31; r2[27] -= (f32x2v){a389[2], a389[3]} * T31;
        const f32x4 a394 = *(const LAS f32x4*)(Af + 2216);
        r2[28] -= (f32x2v){a390[0], a390[1]} * T31; r2[29] -= (f32x2v){a390[2], a390[3]} * T31;
        const f32x4 a395 = *(const LAS f32x4*)(Af + 2220);
        r2[30] -= (f32x2v){a391[0], a391[1]} * T31; r2[31] -= (f32x2v){a391[2], a391[3]} * T31;
        const f32x4 a396 = *(const LAS f32x4*)(Af + 2224);
        const float t32 = r2[16][0]; const f32x2v T32 = (f32x2v){t32, t32}; Tb[2304 + lane] = f2bf(t32);
        r2[16] -= (f32x2v){a392[0], a392[1]} * T32; r2[17] -= (f32x2v){a392[2], a392[3]} * T32;
        const f32x4 a397 = *(const LAS f32x4*)(Af + 2228);
        r2[18] -= (f32x2v){a393[0], a393[1]} * T32; r2[19] -= (f32x2v){a393[2], a393[3]} * T32;
        const f32x4 a398 = *(const LAS f32x4*)(Af + 2232);
        r2[20] -= (f32x2v){a394[0], a394[1]} * T32; r2[21] -= (f32x2v){a394[2], a394[3]} * T32;
        const f32x4 a399 = *(const LAS f32x4*)(Af + 2236);
        r2[22] -= (f32x2v){a395[0], a395[1]} * T32; r2[23] -= (f32x2v){a395[2], a395[3]} * T32;
        const f32x4 a400 = *(const LAS f32x4*)(Af + 2276);
        r2[24] -= (f32x2v){a396[0], a396[1]} * T32; r2[25] -= (f32x2v){a396[2], a396[3]} * T32;
        const f32x4 a401 = *(const LAS f32x4*)(Af + 2280);
        r2[26] -= (f32x2v){a397[0], a397[1]} * T32; r2[27] -= (f32x2v){a397[2], a397[3]} * T32;
        const f32x4 a402 = *(const LAS f32x4*)(Af + 2284);
        r2[28] -= (f32x2v){a398[0], a398[1]} * T32; r2[29] -= (f32x2v){a398[2], a398[3]} * T32;
        const f32x4 a403 = *(const LAS f32x4*)(Af + 2288);
        r2[30] -= (f32x2v){a399[0], a399[1]} * T32; r2[31] -= (f32x2v){a399[2], a399[3]} * T32;
        const f32x4 a404 = *(const LAS f32x4*)(Af + 2292);
        const float t33 = r2[16][1]; const f32x2v T33 = (f32x2v){t33, t33}; Tb[2376 + lane] = f2bf(t33);
        r2[17] -= (f32x2v){a400[2], a400[3]} * T33;
        const f32x4 a405 = *(const LAS f32x4*)(Af + 2296);
        r2[18] -= (f32x2v){a401[0], a401[1]} * T33; r2[19] -= (f32x2v){a401[2], a401[3]} * T33;
        const f32x4 a406 = *(const LAS f32x4*)(Af + 2300);
        r2[20] -= (f32x2v){a402[0], a402[1]} * T33; r2[21] -= (f32x2v){a402[2], a402[3]} * T33;
        const f32x4 a407 = *(const LAS f32x4*)(Af + 2304);
        r2[22] -= (f32x2v){a403[0], a403[1]} * T33; r2[23] -= (f32x2v){a403[2], a403[3]} * T33;
        const f32x4 a408 = *(const LAS f32x4*)(Af + 2344);
        r2[24] -= (f32x2v){a404[0], a404[1]} * T33; r2[25] -= (f32x2v){a404[2], a404[3]} * T33;
        const f32x4 a409 = *(const LAS f32x4*)(Af + 2348);
        r2[26] -= (f32x2v){a405[0], a405[1]} * T33; r2[27] -= (f32x2v){a405[2], a405[3]} * T33;
        const f32x4 a410 = *(const LAS f32x4*)(Af + 2352);
        r2[28] -= (f32x2v){a406[0], a406[1]} * T33; r2[29] -= (f32x2v){a406[2], a406[3]} * T33;
        const f32x4 a411 = *(const LAS f32x4*)(Af + 2356);
        r2[30] -= (f32x2v){a407[0], a407[1]} * T33; r2[31] -= (f32x2v){a407[2], a407[3]} * T33;
        const f32x4 a412 = *(const LAS f32x4*)(Af + 2360);
        const float t34 = r2[17][0]; const f32x2v T34 = (f32x2v){t34, t34}; Tb[2448 + lane] = f2bf(t34);
        r2[17] -= (f32x2v){a408[2], a408[3]} * T34;
        const f32x4 a413 = *(const LAS f32x4*)(Af + 2364);
        r2[18] -= (f32x2v){a409[0], a409[1]} * T34; r2[19] -= (f32x2v){a409[2], a409[3]} * T34;
        const f32x4 a414 = *(const LAS f32x4*)(Af + 2368);
        r2[20] -= (f32x2v){a410[0], a410[1]} * T34; r2[21] -= (f32x2v){a410[2], a410[3]} * T34;
        const f32x4 a415 = *(const LAS f32x4*)(Af + 2372);
        r2[22] -= (f32x2v){a411[0], a411[1]} * T34; r2[23] -= (f32x2v){a411[2], a411[3]} * T34;
        const f32x4 a416 = *(const LAS f32x4*)(Af + 2416);
        r2[24] -= (f32x2v){a412[0], a412[1]} * T34; r2[25] -= (f32x2v){a412[2], a412[3]} * T34;
        const f32x4 a417 = *(const LAS f32x4*)(Af + 2420);
        r2[26] -= (f32x2v){a413[0], a413[1]} * T34; r2[27] -= (f32x2v){a413[2], a413[3]} * T34;
        const f32x4 a418 = *(const LAS f32x4*)(Af + 2424);
        r2[28] -= (f32x2v){a414[0], a414[1]} * T34; r2[29] -= (f32x2v){a414[2], a414[3]} * T34;
        const f32x4 a419 = *(const LAS f32x4*)(Af + 2428);
        r2[30] -= (f32x2v){a415[0], a415[1]} * T34; r2[31] -= (f32x2v){a415[2], a415[3]} * T34;
        const f32x4 a420 = *(const LAS f32x4*)(Af + 2432);
        const float t35 = r2[17][1]; const f32x2v T35 = (f32x2v){t35, t35}; Tb[2520 + lane] = f2bf(t35);
        r2[18] -= (f32x2v){a416[0], a416[1]} * T35; r2[19] -= (f32x2v){a416[2], a416[3]} * T35;
        const f32x4 a421 = *(const LAS f32x4*)(Af + 2436);
        r2[20] -= (f32x2v){a417[0], a417[1]} * T35; r2[21] -= (f32x2v){a417[2], a417[3]} * T35;
        const f32x4 a422 = *(const LAS f32x4*)(Af + 2440);
        r2[22] -= (f32x2v){a418[0], a418[1]} * T35; r2[23] -= (f32x2v){a418[2], a418[3]} * T35;
        const f32x4 a423 = *(const LAS f32x4*)(Af + 2484);
        r2[24] -= (f32x2v){a419[0], a419[1]} * T35; r2[25] -= (f32x2v){a419[2], a419[3]} * T35;
        const f32x4 a424 = *(const LAS f32x4*)(Af + 2488);
        r2[26] -= (f32x2v){a420[0], a420[1]} * T35; r2[27] -= (f32x2v){a420[2], a420[3]} * T35;
        const f32x4 a425 = *(const LAS f32x4*)(Af + 2492);
        r2[28] -= (f32x2v){a421[0], a421[1]} * T35; r2[29] -= (f32x2v){a421[2], a421[3]} * T35;
        const f32x4 a426 = *(const LAS f32x4*)(Af + 2496);
        r2[30] -= (f32x2v){a422[0], a422[1]} * T35; r2[31] -= (f32x2v){a422[2], a422[3]} * T35;
        const f32x4 a427 = *(const LAS f32x4*)(Af + 2500);
        const float t36 = r2[18][0]; const f32x2v T36 = (f32x2v){t36, t36}; Tb[2592 + lane] = f2bf(t36);
        r2[18] -= (f32x2v){a423[0], a423[1]} * T36; r2[19] -= (f32x2v){a423[2], a423[3]} * T36;
        const f32x4 a428 = *(const LAS f32x4*)(Af + 2504);
        r2[20] -= (f32x2v){a424[0], a424[1]} * T36; r2[21] -= (f32x2v){a424[2], a424[3]} * T36;
        const f32x4 a429 = *(const LAS f32x4*)(Af + 2508);
        r2[22] -= (f32x2v){a425[0], a425[1]} * T36; r2[23] -= (f32x2v){a425[2], a425[3]} * T36;
        const f32x4 a430 = *(const LAS f32x4*)(Af + 2552);
        r2[24] -= (f32x2v){a426[0], a426[1]} * T36; r2[25] -= (f32x2v){a426[2], a426[3]} * T36;
        const f32x4 a431 = *(const LAS f32x4*)(Af + 2556);
        r2[26] -= (f32x2v){a427[0], a427[1]} * T36; r2[27] -= (f32x2v){a427[2], a427[3]} * T36;
        const f32x4 a432 = *(const LAS f32x4*)(Af + 2560);
        r2[28] -= (f32x2v){a428[0], a428[1]} * T36; r2[29] -= (f32x2v){a428[2], a428[3]} * T36;
        const f32x4 a433 = *(const LAS f32x4*)(Af + 2564);
        r2[30] -= (f32x2v){a429[0], a429[1]} * T36; r2[31] -= (f32x2v){a429[2], a429[3]} * T36;
        const f32x4 a434 = *(const LAS f32x4*)(Af + 2568);
        const float t37 = r2[18][1]; const f32x2v T37 = (f32x2v){t37, t37}; Tb[2664 + lane] = f2bf(t37);
        r2[19] -= (f32x2v){a430[2], a430[3]} * T37;
        const f32x4 a435 = *(const LAS f32x4*)(Af + 2572);
        r2[20] -= (f32x2v){a431[0], a431[1]} * T37; r2[21] -= (f32x2v){a431[2], a431[3]} * T37;
        const f32x4 a436 = *(const LAS f32x4*)(Af + 2576);
        r2[22] -= (f32x2v){a432[0], a432[1]} * T37; r2[23] -= (f32x2v){a432[2], a432[3]} * T37;
        const f32x4 a437 = *(const LAS f32x4*)(Af + 2620);
        r2[24] -= (f32x2v){a433[0], a433[1]} * T37; r2[25] -= (f32x2v){a433[2], a433[3]} * T37;
        const f32x4 a438 = *(const LAS f32x4*)(Af + 2624);
        r2[26] -= (f32x2v){a434[0], a434[1]} * T37; r2[27] -= (f32x2v){a434[2], a434[3]} * T37;
        const f32x4 a439 = *(const LAS f32x4*)(Af + 2628);
        r2[28] -= (f32x2v){a435[0], a435[1]} * T37; r2[29] -= (f32x2v){a435[2], a435[3]} * T37;
        const f32x4 a440 = *(const LAS f32x4*)(Af + 2632);
        r2[30] -= (f32x2v){a436[0], a436[1]} * T37; r2[31] -= (f32x2v){a436[2], a436[3]} * T37;
        const f32x4 a441 = *(const LAS f32x4*)(Af + 2636);
        const float t38 = r2[19][0]; const f32x2v T38 = (f32x2v){t38, t38}; Tb[2736 + lane] = f2bf(t38);
        r2[19] -= (f32x2v){a437[2], a437[3]} * T38;
        const f32x4 a442 = *(const LAS f32x4*)(Af + 2640);
        r2[20] -= (f32x2v){a438[0], a438[1]} * T38; r2[21] -= (f32x2v){a438[2], a438[3]} * T38;
        const f32x4 a443 = *(const LAS f32x4*)(Af + 2644);
        r2[22] -= (f32x2v){a439[0], a439[1]} * T38; r2[23] -= (f32x2v){a439[2], a439[3]} * T38;
        const f32x4 a444 = *(const LAS f32x4*)(Af + 2692);
        r2[24] -= (f32x2v){a440[0], a440[1]} * T38; r2[25] -= (f32x2v){a440[2], a440[3]} * T38;
        const f32x4 a445 = *(const LAS f32x4*)(Af + 2696);
        r2[26] -= (f32x2v){a441[0], a441[1]} * T38; r2[27] -= (f32x2v){a441[2], a441[3]} * T38;
        const f32x4 a446 = *(const LAS f32x4*)(Af + 2700);
        r2[28] -= (f32x2v){a442[0], a442[1]} * T38; r2[29] -= (f32x2v){a442[2], a442[3]} * T38;
        const f32x4 a447 = *(const LAS f32x4*)(Af + 2704);
        r2[30] -= (f32x2v){a443[0], a443[1]} * T38; r2[31] -= (f32x2v){a443[2], a443[3]} * T38;
        const f32x4 a448 = *(const LAS f32x4*)(Af + 2708);
        const float t39 = r2[19][1]; const f32x2v T39 = (f32x2v){t39, t39}; Tb[2808 + lane] = f2bf(t39);
        r2[20] -= (f32x2v){a444[0], a444[1]} * T39; r2[21] -= (f32x2v){a444[2], a444[3]} * T39;
        const f32x4 a449 = *(const LAS f32x4*)(Af + 2712);
        r2[22] -= (f32x2v){a445[0], a445[1]} * T39; r2[23] -= (f32x2v){a445[2], a445[3]} * T39;
        const f32x4 a450 = *(const LAS f32x4*)(Af + 2760);
        r2[24] -= (f32x2v){a446[0], a446[1]} * T39; r2[25] -= (f32x2v){a446[2], a446[3]} * T39;
        const f32x4 a451 = *(const LAS f32x4*)(Af + 2764);
        r2[26] -= (f32x2v){a447[0], a447[1]} * T39; r2[27] -= (f32x2v){a447[2], a447[3]} * T39;
        const f32x4 a452 = *(const LAS f32x4*)(Af + 2768);
        r2[28] -= (f32x2v){a448[0], a448[1]} * T39; r2[29] -= (f32x2v){a448[2], a448[3]} * T39;
        const f32x4 a453 = *(const LAS f32x4*)(Af + 2772);
        r2[30] -= (f32x2v){a449[0], a449[1]} * T39; r2[31] -= (f32x2v){a449[2], a449[3]} * T39;
        const f32x4 a454 = *(const LAS f32x4*)(Af + 2776);
        const float t40 = r2[20][0]; const f32x2v T40 = (f32x2v){t40, t40}; Tb[2880 + lane] = f2bf(t40);
        r2[20] -= (f32x2v){a450[0], a450[1]} * T40; r2[21] -= (f32x2v){a450[2], a450[3]} * T40;
        const f32x4 a455 = *(const LAS f32x4*)(Af + 2780);
        r2[22] -= (f32x2v){a451[0], a451[1]} * T40; r2[23] -= (f32x2v){a451[2], a451[3]} * T40;
        const f32x4 a456 = *(const LAS f32x4*)(Af + 2828);
        r2[24] -= (f32x2v){a452[0], a452[1]} * T40; r2[25] -= (f32x2v){a452[2], a452[3]} * T40;
        const f32x4 a457 = *(const LAS f32x4*)(Af + 2832);
        r2[26] -= (f32x2v){a453[0], a453[1]} * T40; r2[27] -= (f32x2v){a453[2], a453[3]} * T40;
        const f32x4 a458 = *(const LAS f32x4*)(Af + 2836);
        r2[28] -= (f32x2v){a454[0], a454[1]} * T40; r2[29] -= (f32x2v){a454[2], a454[3]} * T40;
        const f32x4 a459 = *(const LAS f32x4*)(Af + 2840);
        r2[30] -= (f32x2v){a455[0], a455[1]} * T40; r2[31] -= (f32x2v){a455[2], a455[3]} * T40;
        const f32x4 a460 = *(const LAS f32x4*)(Af + 2844);
        const float t41 = r2[20][1]; const f32x2v T41 = (f32x2v){t41, t41}; Tb[2952 + lane] = f2bf(t41);
        r2[21] -= (f32x2v){a456[2], a456[3]} * T41;
        const f32x4 a461 = *(const LAS f32x4*)(Af + 2848);
        r2[22] -= (f32x2v){a457[0], a457[1]} * T41; r2[23] -= (f32x2v){a457[2], a457[3]} * T41;
        const f32x4 a462 = *(const LAS f32x4*)(Af + 2896);
        r2[24] -= (f32x2v){a458[0], a458[1]} * T41; r2[25] -= (f32x2v){a458[2], a458[3]} * T41;
        const f32x4 a463 = *(const LAS f32x4*)(Af + 2900);
        r2[26] -= (f32x2v){a459[0], a459[1]} * T41; r2[27] -= (f32x2v){a459[2], a459[3]} * T41;
        const f32x4 a464 = *(const LAS f32x4*)(Af + 2904);
        r2[28] -= (f32x2v){a460[0], a460[1]} * T41; r2[29] -= (f32x2v){a460[2], a460[3]} * T41;
        const f32x4 a465 = *(const LAS f32x4*)(Af + 2908);
        r2[30] -= (f32x2v){a461[0], a461[1]} * T41; r2[31] -= (f32x2v){a461[2], a461[3]} * T41;
        const f32x4 a466 = *(const LAS f32x4*)(Af + 2912);
        const float t42 = r2[21][0]; const f32x2v T42 = (f32x2v){t42, t42}; Tb[3024 + lane] = f2bf(t42);
        r2[21] -= (f32x2v){a462[2], a462[3]} * T42;
        const f32x4 a467 = *(const LAS f32x4*)(Af + 2916);
        r2[22] -= (f32x2v){a463[0], a463[1]} * T42; r2[23] -= (f32x2v){a463[2], a463[3]} * T42;
        const f32x4 a468 = *(const LAS f32x4*)(Af + 2968);
        r2[24] -= (f32x2v){a464[0], a464[1]} * T42; r2[25] -= (f32x2v){a464[2], a464[3]} * T42;
        const f32x4 a469 = *(const LAS f32x4*)(Af + 2972);
        r2[26] -= (f32x2v){a465[0], a465[1]} * T42; r2[27] -= (f32x2v){a465[2], a465[3]} * T42;
        const f32x4 a470 = *(const LAS f32x4*)(Af + 2976);
        r2[28] -= (f32x2v){a466[0], a466[1]} * T42; r2[29] -= (f32x2v){a466[2], a466[3]} * T42;
        const f32x4 a471 = *(const LAS f32x4*)(Af + 2980);
        r2[30] -= (f32x2v){a467[0], a467[1]} * T42; r2[31] -= (f32x2v){a467[2], a467[3]} * T42;
        const f32x4 a472 = *(const LAS f32x4*)(Af + 2984);
        const float t43 = r2[21][1]; const f32x2v T43 = (f32x2v){t43, t43}; Tb[3096 + lane] = f2bf(t43);
        r2[22] -= (f32x2v){a468[0], a468[1]} * T43; r2[23] -= (f32x2v){a468[2], a468[3]} * T43;
        const f32x4 a473 = *(const LAS f32x4*)(Af + 3036);
        r2[24] -= (f32x2v){a469[0], a469[1]} * T43; r2[25] -= (f32x2v){a469[2], a469[3]} * T43;
        const f32x4 a474 = *(const LAS f32x4*)(Af + 3040);
        r2[26] -= (f32x2v){a470[0], a470[1]} * T43; r2[27] -= (f32x2v){a470[2], a470[3]} * T43;
        const f32x4 a475 = *(const LAS f32x4*)(Af + 3044);
        r2[28] -= (f32x2v){a471[0], a471[1]} * T43; r2[29] -= (f32x2v){a471[2], a471[3]} * T43;
        const f32x4 a476 = *(const LAS f32x4*)(Af + 3048);
        r2[30] -= (f32x2v){a472[0], a472[1]} * T43; r2[31] -= (f32x2v){a472[2], a472[3]} * T43;
        const f32x4 a477 = *(const LAS f32x4*)(Af + 3052);
        const float t44 = r2[22][0]; const f32x2v T44 = (f32x2v){t44, t44}; Tb[3168 + lane] = f2bf(t44);
        r2[22] -= (f32x2v){a473[0], a473[1]} * T44; r2[23] -= (f32x2v){a473[2], a473[3]} * T44;
        const f32x4 a478 = *(const LAS f32x4*)(Af + 3104);
        r2[24] -= (f32x2v){a474[0], a474[1]} * T44; r2[25] -= (f32x2v){a474[2], a474[3]} * T44;
        const f32x4 a479 = *(const LAS f32x4*)(Af + 3108);
        r2[26] -= (f32x2v){a475[0], a475[1]} * T44; r2[27] -= (f32x2v){a475[2], a475[3]} * T44;
        const f32x4 a480 = *(const LAS f32x4*)(Af + 3112);
        r2[28] -= (f32x2v){a476[0], a476[1]} * T44; r2[29] -= (f32x2v){a476[2], a476[3]} * T44;
        const f32x4 a481 = *(const LAS f32x4*)(Af + 3116);
        r2[30] -= (f32x2v){a477[0], a477[1]} * T44; r2[31] -= (f32x2v){a477[2], a477[3]} * T44;
        const f32x4 a482 = *(const LAS f32x4*)(Af + 3120);
        const float t45 = r2[22][1]; const f32x2v T45 = (f32x2v){t45, t45}; Tb[3240 + lane] = f2bf(t45);
        r2[23] -= (f32x2v){a478[2], a478[3]} * T45;
        const f32x4 a483 = *(const LAS f32x4*)(Af + 3172);
        r2[24] -= (f32x2v){a479[0], a479[1]} * T45; r2[25] -= (f32x2v){a479[2], a479[3]} * T45;
        const f32x4 a484 = *(const LAS f32x4*)(Af + 3176);
        r2[26] -= (f32x2v){a480[0], a480[1]} * T45; r2[27] -= (f32x2v){a480[2], a480[3]} * T45;
        const f32x4 a485 = *(const LAS f32x4*)(Af + 3180);
        r2[28] -= (f32x2v){a481[0], a481[1]} * T45; r2[29] -= (f32x2v){a481[2], a481[3]} * T45;
        const f32x4 a486 = *(const LAS f32x4*)(Af + 3184);
        r2[30] -= (f32x2v){a482[0], a482[1]} * T45; r2[31] -= (f32x2v){a482[2], a482[3]} * T45;
        const f32x4 a487 = *(const LAS f32x4*)(Af + 3188);
        const float t46 = r2[23][0]; const f32x2v T46 = (f32x2v){t46, t46}; Tb[3312 + lane] = f2bf(t46);
        r2[23] -= (f32x2v){a483[2], a483[3]} * T46;
        const f32x4 a488 = *(const LAS f32x4*)(Af + 3244);
        r2[24] -= (f32x2v){a484[0], a484[1]} * T46; r2[25] -= (f32x2v){a484[2], a484[3]} * T46;
        const f32x4 a489 = *(const LAS f32x4*)(Af + 3248);
        r2[26] -= (f32x2v){a485[0], a485[1]} * T46; r2[27] -= (f32x2v){a485[2], a485[3]} * T46;
        const f32x4 a490 = *(const LAS f32x4*)(Af + 3252);
        r2[28] -= (f32x2v){a486[0], a486[1]} * T46; r2[29] -= (f32x2v){a486[2], a486[3]} * T46;
        const f32x4 a491 = *(const LAS f32x4*)(Af + 3256);
        r2[30] -= (f32x2v){a487[0], a487[1]} * T46; r2[31] -= (f32x2v){a487[2], a487[3]} * T46;
        const f32x4 a492 = *(const LAS f32x4*)(Af + 3312);
        const float t47 = r2[23][1]; const f32x2v T47 = (f32x2v){t47, t47}; Tb[3384 + lane] = f2bf(t47);
        r2[24] -= (f32x2v){a488[0], a488[1]} * T47; r2[25] -= (f32x2v){a488[2], a488[3]} * T47;
        const f32x4 a493 = *(const LAS f32x4*)(Af + 3316);
        r2[26] -= (f32x2v){a489[0], a489[1]} * T47; r2[27] -= (f32x2v){a489[2], a489[3]} * T47;
        const f32x4 a494 = *(const LAS f32x4*)(Af + 3320);
        r2[28] -= (f32x2v){a490[0], a490[1]} * T47; r2[29] -= (f32x2v){a490[2], a490[3]} * T47;
        const f32x4 a495 = *(const LAS f32x4*)(Af + 3324);
        r2[30] -= (f32x2v){a491[0], a491[1]} * T47; r2[31] -= (f32x2v){a491[2], a491[3]} * T47;
        const f32x4 a496 = *(const LAS f32x4*)(Af + 3380);
        const float t48 = r2[24][0]; const f32x2v T48 = (f32x2v){t48, t48}; Tb[3456 + lane] = f2bf(t48);
        r2[24] -= (f32x2v){a492[0], a492[1]} * T48; r2[25] -= (f32x2v){a492[2], a492[3]} * T48;
        const f32x4 a497 = *(const LAS f32x4*)(Af + 3384);
        r2[26] -= (f32x2v){a493[0], a493[1]} * T48; r2[27] -= (f32x2v){a493[2], a493[3]} * T48;
        const f32x4 a498 = *(const LAS f32x4*)(Af + 3388);
        r2[28] -= (f32x2v){a494[0], a494[1]} * T48; r2[29] -= (f32x2v){a494[2], a494[3]} * T48;
        const f32x4 a499 = *(const LAS f32x4*)(Af + 3392);
        r2[30] -= (f32x2v){a495[0], a495[1]} * T48; r2[31] -= (f32x2v){a495[2], a495[3]} * T48;
        const f32x4 a500 = *(const LAS f32x4*)(Af + 3448);
        const float t49 = r2[24][1]; const f32x2v T49 = (f32x2v){t49, t49}; Tb[3528 + lane] = f2bf(t49);
        r2[25] -= (f32x2v){a496[2], a496[3]} * T49;
        const f32x4 a501 = *(const LAS f32x4*)(Af + 3452);
        r2[26] -= (f32x2v){a497[0], a497[1]} * T49; r2[27] -= (f32x2v){a497[2], a497[3]} * T49;
        const f32x4 a502 = *(const LAS f32x4*)(Af + 3456);
        r2[28] -= (f32x2v){a498[0], a498[1]} * T49; r2[29] -= (f32x2v){a498[2], a498[3]} * T49;
        const f32x4 a503 = *(const LAS f32x4*)(Af + 3460);
        r2[30] -= (f32x2v){a499[0], a499[1]} * T49; r2[31] -= (f32x2v){a499[2], a499[3]} * T49;
        const f32x4 a504 = *(const LAS f32x4*)(Af + 3520);
        const float t50 = r2[25][0]; const f32x2v T50 = (f32x2v){t50, t50}; Tb[3600 + lane] = f2bf(t50);
        r2[25] -= (f32x2v){a500[2], a500[3]} * T50;
        const f32x4 a505 = *(const LAS f32x4*)(Af + 3524);
        r2[26] -= (f32x2v){a501[0], a501[1]} * T50; r2[27] -= (f32x2v){a501[2], a501[3]} * T50;
        const f32x4 a506 = *(const LAS f32x4*)(Af + 3528);
        r2[28] -= (f32x2v){a502[0], a502[1]} * T50; r2[29] -= (f32x2v){a502[2], a502[3]} * T50;
        const f32x4 a507 = *(const LAS f32x4*)(Af + 3588);
        r2[30] -= (f32x2v){a503[0], a503[1]} * T50; r2[31] -= (f32x2v){a503[2], a503[3]} * T50;
        const f32x4 a508 = *(const LAS f32x4*)(Af + 3592);
        const float t51 = r2[25][1]; const f32x2v T51 = (f32x2v){t51, t51}; Tb[3672 + lane] = f2bf(t51);
        r2[26] -= (f32x2v){a504[0], a504[1]} * T51; r2[27] -= (f32x2v){a504[2], a504[3]} * T51;
        const f32x4 a509 = *(const LAS f32x4*)(Af + 3596);
        r2[28] -= (f32x2v){a505[0], a505[1]} * T51; r2[29] -= (f32x2v){a505[2], a505[3]} * T51;
        const f32x4 a510 = *(const LAS f32x4*)(Af + 3656);
        r2[30] -= (f32x2v){a506[0], a506[1]} * T51; r2[31] -= (f32x2v){a506[2], a506[3]} * T51;
        const f32x4 a511 = *(const LAS f32x4*)(Af + 3660);
        const float t52 = r2[26][0]; const f32x2v T52 = (f32x2v){t52, t52}; Tb[3744 + lane] = f2bf(t52);
        r2[26] -= (f32x2v){a507[0], a507[1]} * T52; r2[27] -= (f32x2v){a507[2], a507[3]} * T52;
        const f32x4 a512 = *(const LAS f32x4*)(Af + 3664);
        r2[28] -= (f32x2v){a508[0], a508[1]} * T52; r2[29] -= (f32x2v){a508[2], a508[3]} * T52;
        const f32x4 a513 = *(const LAS f32x4*)(Af + 3724);
        r2[30] -= (f32x2v){a509[0], a509[1]} * T52; r2[31] -= (f32x2v){a509[2], a509[3]} * T52;
        const f32x4 a514 = *(const LAS f32x4*)(Af + 3728);
        const float t53 = r2[26][1]; const f32x2v T53 = (f32x2v){t53, t53}; Tb[3816 + lane] = f2bf(t53);
        r2[27] -= (f32x2v){a510[2], a510[3]} * T53;
        const f32x4 a515 = *(const LAS f32x4*)(Af + 3732);
        r2[28] -= (f32x2v){a511[0], a511[1]} * T53; r2[29] -= (f32x2v){a511[2], a511[3]} * T53;
        const f32x4 a516 = *(const LAS f32x4*)(Af + 3796);
        r2[30] -= (f32x2v){a512[0], a512[1]} * T53; r2[31] -= (f32x2v){a512[2], a512[3]} * T53;
        const f32x4 a517 = *(const LAS f32x4*)(Af + 3800);
        const float t54 = r2[27][0]; const f32x2v T54 = (f32x2v){t54, t54}; Tb[3888 + lane] = f2bf(t54);
        r2[27] -= (f32x2v){a513[2], a513[3]} * T54;
        const f32x4 a518 = *(const LAS f32x4*)(Af + 3864);
        r2[28] -= (f32x2v){a514[0], a514[1]} * T54; r2[29] -= (f32x2v){a514[2], a514[3]} * T54;
        const f32x4 a519 = *(const LAS f32x4*)(Af + 3868);
        r2[30] -= (f32x2v){a515[0], a515[1]} * T54; r2[31] -= (f32x2v){a515[2], a515[3]} * T54;
        const f32x4 a520 = *(const LAS f32x4*)(Af + 3932);
        const float t55 = r2[27][1]; const f32x2v T55 = (f32x2v){t55, t55}; Tb[3960 + lane] = f2bf(t55);
        r2[28] -= (f32x2v){a516[0], a516[1]} * T55; r2[29] -= (f32x2v){a516[2], a516[3]} * T55;
        const f32x4 a521 = *(const LAS f32x4*)(Af + 3936);
        r2[30] -= (f32x2v){a517[0], a517[1]} * T55; r2[31] -= (f32x2v){a517[2], a517[3]} * T55;
        const f32x4 a522 = *(const LAS f32x4*)(Af + 4000);
        const float t56 = r2[28][0]; const f32x2v T56 = (f32x2v){t56, t56}; Tb[4032 + lane] = f2bf(t56);
        r2[28] -= (f32x2v){a518[0], a518[1]} * T56; r2[29] -= (f32x2v){a518[2], a518[3]} * T56;
        const f32x4 a523 = *(const LAS f32x4*)(Af + 4004);
        r2[30] -= (f32x2v){a519[0], a519[1]} * T56; r2[31] -= (f32x2v){a519[2], a519[3]} * T56;
        const f32x4 a524 = *(const LAS f32x4*)(Af + 4072);
        const float t57 = r2[28][1]; const f32x2v T57 = (f32x2v){t57, t57}; Tb[4104 + lane] = f2bf(t57);
        r2[29] -= (f32x2v){a520[2], a520[3]} * T57;
        const f32x4 a525 = *(const LAS f32x4*)(Af + 4140);
        r2[30] -= (f32x2v){a521[0], a521[1]} * T57; r2[31] -= (f32x2v){a521[2], a521[3]} * T57;
        const f32x4 a526 = *(const LAS f32x4*)(Af + 4208);
        const float t58 = r2[29][0]; const f32x2v T58 = (f32x2v){t58, t58}; Tb[4176 + lane] = f2bf(t58);
        r2[29] -= (f32x2v){a522[2], a522[3]} * T58;
        const f32x4 a527 = *(const LAS f32x4*)(Af + 4276);
        r2[30] -= (f32x2v){a523[0], a523[1]} * T58; r2[31] -= (f32x2v){a523[2], a523[3]} * T58;
        const float t59 = r2[29][1]; const f32x2v T59 = (f32x2v){t59, t59}; Tb[4248 + lane] = f2bf(t59);
        r2[30] -= (f32x2v){a524[0], a524[1]} * T59; r2[31] -= (f32x2v){a524[2], a524[3]} * T59;
        const float t60 = r2[30][0]; const f32x2v T60 = (f32x2v){t60, t60}; Tb[4320 + lane] = f2bf(t60);
        r2[30] -= (f32x2v){a525[0], a525[1]} * T60; r2[31] -= (f32x2v){a525[2], a525[3]} * T60;
        const float t61 = r2[30][1]; const f32x2v T61 = (f32x2v){t61, t61}; Tb[4392 + lane] = f2bf(t61);
        r2[31] -= (f32x2v){a526[2], a526[3]} * T61;
        const float t62 = r2[31][0]; const f32x2v T62 = (f32x2v){t62, t62}; Tb[4464 + lane] = f2bf(t62);
        r2[31] -= (f32x2v){a527[2], a527[3]} * T62;
        Tb[4536 + lane] = f2bf(r2[31][1]);
    }
    __syncthreads();
#pragma unroll 2
    for (int r = 0; r < 8; ++r) {
        const int job = wid + 8 * r, kind = job >> 5, tile = job & 31, mt = tile >> 3, nt = tile & 7;
        const f32x4 acc = tile_mm(Tb, 72, mt, kind ? KbT : VbT, 72, nt, 2, fr, fq);
        u32x2 w; w.x = cvt_pk(acc[0], acc[1]); w.y = cvt_pk(acc[2], acc[3]);
        *(LAS u32x2*)((kind ? WT : UT) + (16 * nt + fr) * 72 + 16 * mt + 4 * fq) = w;
    }
    __syncthreads();
    bf16_t* GM = (bf16_t*)(p.ws + WS_GM) + (size_t)unit * 16384; bf16_t* GN = (bf16_t*)(p.ws + WS_GN) + (size_t)unit * 16384;
    bf16_t* GQ = (bf16_t*)(p.ws + WS_GQ) + (size_t)unit * 8192; bf16_t* GO = (bf16_t*)(p.ws + WS_GO) + (size_t)unit * 8192;
#pragma unroll 2
    for (int r = 0; r < 24; ++r) {
        const int job = wid + 8 * r;
        if (job < 64) { const int a = job >> 3, mt = job & 7;
            const f32x4 acc = tile_mm(WT, 72, a, KdT, 72, mt, 2, fr, fq);
            u32x2 w; w.x = cvt_pk(-acc[0], -acc[1]); w.y = cvt_pk(-acc[2], -acc[3]);
            *(u32x2*)(GM + ((mt * 4 + (a >> 1)) * 64 + lane) * 8 + (a & 1) * 4) = w;
        } else if (job < 128) { const int j = job - 64, mt = j >> 3, nt = j & 7;
            const f32x4 acc = tile_mm(KdT, 72, mt, UT, 72, nt, 2, fr, fq);
            u32x2 w; w.x = cvt_pk(acc[0], acc[1]); w.y = cvt_pk(acc[2], acc[3]);
            *(u32x2*)(GN + ((nt * 64 + lane) * 8 + mt) * 4) = w;
        } else if (job < 160) { const int j = job - 128, a = j >> 2, it = j & 3;
            const f32x4 acc = tile_mm(WT, 72, a, QK, 72, it, 2, fr, fq);
            const int i = 16 * it + fr; const float eg = __expf(gcs[i]);
            const u32x2 qv = *(const LAS u32x2*)(Qs + i * 136 + 16 * a + 4 * fq);
            u32x2 w; w.x = cvt_pk(bflo(qv.x) * eg - acc[0], bfhi(qv.x) * eg - acc[1]); w.y = cvt_pk(bflo(qv.y) * eg - acc[2], bfhi(qv.y) * eg - acc[3]);
            *(u32x2*)(GQ + ((it * 4 + (a >> 1)) * 64 + lane) * 8 + (a & 1) * 4) = w;
        } else { const int j = job - 160, mt = j >> 3, nt = j & 7;
            const f32x4 acc = tile_mm(QK, 72, mt, UT, 72, nt, 2, fr, fq);
            u32x2 w; w.x = cvt_pk(acc[0], acc[1]); w.y = cvt_pk(acc[2], acc[3]);
            *(u32x2*)(GO + ((nt * 64 + lane) * 4 + mt) * 4) = w;
        }
    }
    if (tid == 0) ((float*)(p.ws + WS_CTL + CTL_GLAST))[unit] = __expf(gclast);
    __syncthreads();
}

__device__ __forceinline__ void gdn_scan(const Params& p, LAS unsigned char* lds, int sb) {
    const int tid = threadIdx.x, lane = tid & 63, wid = tid >> 6, fr = lane & 15, fq = lane >> 4;
    const int bh = sb / (8 / CW), sp = sb % (8 / CW), unit0 = bh * 128, sl = sp * CW + wid;
    const u32x4* GMb = (const u32x4*)((const bf16_t*)(p.ws + WS_GM) + (size_t)unit0 * 16384);
    const u32x4* GQb = (const u32x4*)((const bf16_t*)(p.ws + WS_GQ) + (size_t)unit0 * 8192);
    const bf16_t* GNb = (const bf16_t*)(p.ws + WS_GN) + (size_t)unit0 * 16384;
    bf16_t* GOb = (bf16_t*)(p.ws + WS_GO) + (size_t)unit0 * 8192;
    const float* glast = (const float*)(p.ws + WS_CTL + CTL_GLAST) + unit0;
    const bool loader = (wid >= CW && wid < CW + 4);
#define SCAN_DMA(cc) do { _Pragma("unroll") for (int k = 0; k < 8; ++k) { const int inst = (wid - CW) * 8 + k; \
        __builtin_amdgcn_global_load_lds((const unsigned*)((const char*)(GMb + (size_t)(cc) * 2048) + inst * 1024 + lane * 16), (LAS unsigned*)(lds + ((cc) & 3) * 32768 + inst * 1024), 16, 0, 0); } } while (0)
#define SCAN_LOADN(dn, cc) do { const bf16_t* np_ = GNb + (size_t)((cc) < 128 ? (cc) : 127) * 16384 + (size_t)(sl * 64 + lane) * 32; \
        asm volatile("global_load_dwordx4 %0, %4, off\n\tglobal_load_dwordx4 %1, %4, off offset:16\n\tglobal_load_dwordx4 %2, %4, off offset:32\n\tglobal_load_dwordx4 %3, %4, off offset:48" \
            : "=&v"(dn[0]), "=&v"(dn[1]), "=&v"(dn[2]), "=&v"(dn[3]) : "v"(np_) : "memory"); } while (0)
#define SCAN_WAITN(dn, N) asm volatile("s_waitcnt vmcnt(" #N ")" : "+v"(dn[0]), "+v"(dn[1]), "+v"(dn[2]), "+v"(dn[3]) :: "memory")
#define SCAN_STEP(c, nn, RELOAD) do { \
        SCAN_WAITN(nn, 8); \
        const float gl = __shfl(((c) < 64) ? glr0 : glr1, (c) & 63); bf16x8 Sb[4]; \
        bf16_t* scp = (bf16_t*)GNb + (size_t)(c) * 16384 + (size_t)sl * 2048 + lane * 8; \
        _Pragma("unroll") for (int ks = 0; ks < 4; ++ks) { u32x4 w; w.x = cvt_pk(S[2 * ks][0], S[2 * ks][1]); w.y = cvt_pk(S[2 * ks][2], S[2 * ks][3]); \
            w.z = cvt_pk(S[2 * ks + 1][0], S[2 * ks + 1][1]); w.w = cvt_pk(S[2 * ks + 1][2], S[2 * ks + 1][3]); Sb[ks] = __builtin_bit_cast(bf16x8, w); } \
        const LAS unsigned char* slot = lds + ((c) & 3) * 32768 + lane * 16; \
        bf16x8 fa[2][2][4]; \
        _Pragma("unroll") for (int ks = 0; ks < 4; ++ks) { fa[0][0][ks] = *(const LAS bf16x8*)(slot + (0 * 4 + ks) * 1024); fa[0][1][ks] = *(const LAS bf16x8*)(slot + (1 * 4 + ks) * 1024); } \
        _Pragma("unroll") for (int mt = 0; mt < 8; ++mt) { const unsigned w0 = nn[mt >> 1][(mt & 1) * 2], w1 = nn[mt >> 1][(mt & 1) * 2 + 1]; \
            S[mt] = S[mt] * gl + (f32x4){bflo(w0), bfhi(w0), bflo(w1), bfhi(w1)}; } \
        _Pragma("unroll") for (int ks = 0; ks < 4; ++ks) *(u32x4*)(scp + ks * 512) = __builtin_bit_cast(u32x4, Sb[ks]);     \
        RELOAD; \
        _Pragma("unroll") for (int pr = 0; pr < 4; ++pr) { \
            if (pr < 3) { _Pragma("unroll") for (int ks = 0; ks < 4; ++ks) { fa[(pr + 1) & 1][0][ks] = *(const LAS bf16x8*)(slot + ((2 * pr + 2) * 4 + ks) * 1024); fa[(pr + 1) & 1][1][ks] = *(const LAS bf16x8*)(slot + ((2 * pr + 3) * 4 + ks) * 1024); } } \
            _Pragma("unroll") for (int ks = 0; ks < 4; ++ks) { S[2 * pr] = mfma16(fa[pr & 1][0][ks], Sb[ks], S[2 * pr]); S[2 * pr + 1] = mfma16(fa[pr & 1][1][ks], Sb[ks], S[2 * pr + 1]); } } \
        } while (0)
    if (loader) { SCAN_DMA(0); SCAN_DMA(1); SCAN_DMA(2); asm volatile("s_waitcnt vmcnt(0)" ::: "memory"); }
    f32x4 S[8];
#pragma unroll
    for (int mt = 0; mt < 8; ++mt) S[mt] = (f32x4){0.f, 0.f, 0.f, 0.f};
    float glr0 = glast[lane], glr1 = glast[64 + lane];
    asm volatile("" : "+v"(glr0), "+v"(glr1));
    u32x4 nnA[4], nnB[4];
    if (wid < CW) { SCAN_LOADN(nnA, 0); SCAN_LOADN(nnB, 1); SCAN_WAITN(nnA, 0); SCAN_WAITN(nnB, 0); }
    asm volatile("s_waitcnt lgkmcnt(0)" ::: "memory"); __builtin_amdgcn_s_barrier(); asm volatile("" ::: "memory");
#pragma unroll 1
    for (int c = 0; c < 128; c += 2) {
        if (loader) { if (c + 3 < 128) { SCAN_DMA(c + 3); asm volatile("s_waitcnt vmcnt(16)" ::: "memory"); } else asm volatile("s_waitcnt vmcnt(0)" ::: "memory"); }
        else if (wid < CW) { SCAN_STEP(c, nnA, SCAN_LOADN(nnA, c + 2)); }
        asm volatile("s_waitcnt lgkmcnt(0)" ::: "memory"); __builtin_amdgcn_s_barrier(); asm volatile("" ::: "memory");
        if (loader) { if (c + 4 < 128) { SCAN_DMA(c + 4); asm volatile("s_waitcnt vmcnt(16)" ::: "memory"); } else asm volatile("s_waitcnt vmcnt(0)" ::: "memory"); }
        else if (wid < CW) { SCAN_STEP(c + 1, nnB, SCAN_LOADN(nnB, c + 3)); }
        asm volatile("s_waitcnt lgkmcnt(0)" ::: "memory"); __builtin_amdgcn_s_barrier(); asm volatile("" ::: "memory");
    }
#undef SCAN_DMA
#undef SCAN_LOADN
#undef SCAN_WAITN
#undef SCAN_STEP
    __syncthreads();
    if (wid < CW) {
        float* go = p.out + O_GP + (size_t)bh * 16384;
#pragma unroll
        for (int mt = 0; mt < 8; ++mt)
#pragma unroll
            for (int e = 0; e < 4; ++e) go[(16 * mt + 4 * fq + e) * 128 + sl * 16 + fr] = S[mt][e];
    }
}

__device__ __forceinline__ void gdn_gate_unit(const Params& p, int unit, int lane) {
    const int fr = lane & 15, fq = lane >> 4, bh = unit >> 7, n = unit & 127, b = bh >> 2, h = bh & 3, tok0 = b * SEQ + n * 64;
    const bf16_t* GO = (const bf16_t*)(p.ws + WS_GO) + (size_t)unit * 8192;
    bf16_t* PB = (bf16_t*)(p.ws + WS_H);
    {
        bf16_t* GOw = (bf16_t*)(p.ws + WS_GO) + (size_t)unit * 8192;
        const bf16_t* GQ = (const bf16_t*)(p.ws + WS_GQ) + (size_t)unit * 8192; const bf16_t* SC = (const bf16_t*)(p.ws + WS_GN) + (size_t)unit * 16384;
        bf16x8 qa[4][4];
#pragma unroll
        for (int mt = 0; mt < 4; ++mt)
#pragma unroll
            for (int ks = 0; ks < 4; ++ks) qa[mt][ks] = *(const bf16x8*)(GQ + ((mt * 4 + ks) * 64 + lane) * 8);
#pragma unroll 2
        for (int nt = 0; nt < 8; ++nt) {
            bf16x8 sb[4];
#pragma unroll
            for (int ks = 0; ks < 4; ++ks) sb[ks] = *(const bf16x8*)(SC + nt * 2048 + (ks * 64 + lane) * 8);
            const u32x4 o0 = *(const u32x4*)(GOw + (nt * 64 + lane) * 16), o1 = *(const u32x4*)(GOw + (nt * 64 + lane) * 16 + 8);
            f32x4 acc[4];
            acc[0] = (f32x4){bflo(o0.x), bfhi(o0.x), bflo(o0.y), bfhi(o0.y)}; acc[1] = (f32x4){bflo(o0.z), bfhi(o0.z), bflo(o0.w), bfhi(o0.w)};
            acc[2] = (f32x4){bflo(o1.x), bfhi(o1.x), bflo(o1.y), bfhi(o1.y)}; acc[3] = (f32x4){bflo(o1.z), bfhi(o1.z), bflo(o1.w), bfhi(o1.w)};
#pragma unroll
            for (int ks = 0; ks < 4; ++ks)
#pragma unroll
                for (int mt = 0; mt < 4; ++mt) acc[mt] = mfma16(qa[mt][ks], sb[ks], acc[mt]);
            u32x4 w0, w1;
            w0.x = cvt_pk(acc[0][0], acc[0][1]); w0.y = cvt_pk(acc[0][2], acc[0][3]); w0.z = cvt_pk(acc[1][0], acc[1][1]); w0.w = cvt_pk(acc[1][2], acc[1][3]);
            w1.x = cvt_pk(acc[2][0], acc[2][1]); w1.y = cvt_pk(acc[2][2], acc[2][3]); w1.z = cvt_pk(acc[3][0], acc[3][1]); w1.w = cvt_pk(acc[3][2], acc[3][3]);
            *(u32x4*)(GOw + (nt * 64 + lane) * 16) = w0; *(u32x4*)(GOw + (nt * 64 + lane) * 16 + 8) = w1;
        }
        asm volatile("s_waitcnt vmcnt(0)" ::: "memory");
    }
    float ssq[16];
#pragma unroll
    for (int k = 0; k < 16; ++k) ssq[k] = 0.f;
#pragma unroll 1
    for (int nt = 0; nt < 8; ++nt) {
        const u32x4 a0 = *(const u32x4*)(GO + (nt * 64 + lane) * 16), a1 = *(const u32x4*)(GO + (nt * 64 + lane) * 16 + 8);
#pragma unroll
        for (int k = 0; k < 4; ++k) { const float l0 = bflo(a0[k]), h0 = bfhi(a0[k]), l1 = bflo(a1[k]), h1 = bfhi(a1[k]);
            ssq[2 * k] += l0 * l0; ssq[2 * k + 1] += h0 * h0; ssq[8 + 2 * k] += l1 * l1; ssq[8 + 2 * k + 1] += h1 * h1; }
    }
#pragma unroll
    for (int k = 0; k < 16; ++k) { float s = ssq[k]; s += __shfl_xor(s, 1); s += __shfl_xor(s, 2); s += __shfl_xor(s, 4); s += __shfl_xor(s, 8); ssq[k] = rsqrtf(s * (1.0f / 128.0f) + EPS); }
    const float* gn = p.in[15];
#pragma unroll 1
    for (int nt = 0; nt < 8; ++nt) {
        const int dv = 16 * nt + fr; const float g = gn[dv];
        const u32x4 a0 = *(const u32x4*)(GO + (nt * 64 + lane) * 16), a1 = *(const u32x4*)(GO + (nt * 64 + lane) * 16 + 8);
        const bf16_t* gzp = PB + (size_t)(tok0 + 4 * fq) * PW + 2304 + h * 128 + dv; bf16_t* mp = PB + (size_t)(tok0 + 4 * fq) * PW + 512 + h * 128 + dv;
#pragma unroll
        for (int k = 0; k < 16; ++k) {
            const unsigned w = (k < 8) ? a0[(k >> 1) & 3] : a1[(k >> 1) & 3]; const float o = (k & 1) ? bfhi(w) : bflo(w);
            const int to = 16 * (k >> 2) + (k & 3);
            const float gz = bf2f(gzp[(size_t)to * PW]);
            mp[(size_t)to * PW] = f2bf(o * ssq[k] * g * silu(gz));
        }
    }
}

__device__ __forceinline__ void attn_unit(const Params& p, LAS unsigned char* lds, int unit) {
    const int tid = threadIdx.x, lane = tid & 63, wid = tid >> 6, fr = lane & 15, fq = lane >> 4;
    const int b = unit >> 7, blk = (unit >> 1) & 63, kvh = unit & 1;
    LAS bf16_t* Ks = (LAS bf16_t*)lds; LAS bf16_t* Vt = (LAS bf16_t*)(lds + 36864);
    bf16_t* PB = (bf16_t*)(p.ws + WS_H);
    __syncthreads();
#pragma unroll
    for (int i = 0; i < 4; ++i) {
        const int q = tid + 512 * i, row = q >> 3, ch = q & 7, tp = blk * 128 - 128 + row;
        u32x4 kv = (u32x4){0u, 0u, 0u, 0u}, vv = (u32x4){0u, 0u, 0u, 0u};
        if (tp >= 0) { const bf16_t* base = PB + (size_t)(b * SEQ + tp) * PW; kv = *(const u32x4*)(base + 512 + kvh * 64 + ch * 8); vv = *(const u32x4*)(base + 640 + kvh * 64 + ch * 8); }
        *(LAS u32x4*)(Ks + row * 72 + ch * 8) = kv;
#pragma unroll
        for (int e = 0; e < 4; ++e) { const unsigned w = vv[e]; Vt[(ch * 8 + 2 * e) * 264 + row] = (bf16_t)(w & 0xffffu); Vt[(ch * 8 + 2 * e + 1) * 264 + row] = (bf16_t)(w >> 16); }
    }
    __syncthreads();
    const int qtok = b * SEQ + blk * 128 + 16 * wid + fr;
#pragma unroll 1
    for (int g = 0; g < 4; ++g) {
        const int h = kvh * 4 + g; const float slope = exp2f(-(float)(h + 1)), sink = p.in[11][h];
        bf16x8 qf[2];
#pragma unroll
        for (int ks = 0; ks < 2; ++ks) qf[ks] = *(const bf16x8*)(PB + (size_t)qtok * PW + h * 64 + ks * 32 + 8 * fq);
        f32x4 s[10]; float mx = sink;
#pragma unroll
        for (int j = 0; j < 10; ++j) {
            const int ct = (wid + j) < 15 ? (wid + j) : 15;
            f32x4 acc = (f32x4){0.f, 0.f, 0.f, 0.f};
#pragma unroll
            for (int ks = 0; ks < 2; ++ks) acc = mfma16(*(const LAS bf16x8*)(Ks + (16 * ct + fr) * 72 + ks * 32 + 8 * fq), qf[ks], acc);
#pragma unroll
            for (int e = 0; e < 4; ++e) {
                const int c = 16 * (wid + j) + 4 * fq + e, dist = 16 * wid + fr - c + 128;
                const bool ok = (wid + j <= 15) && dist >= 0 && dist <= 128 && (blk * 128 + c - 128 >= 0);
                const float v = ok ? acc[e] * 0.125f - slope * (float)dist : -INFINITY;
                acc[e] = v; mx = fmaxf(mx, v);
            }
            s[j] = acc;
            asm volatile("" ::: "memory");
        }
        mx = fmaxf(mx, __shfl_xor(mx, 16)); mx = fmaxf(mx, __shfl_xor(mx, 32));
        float sum = 0.f;
#pragma unroll
        for (int j = 0; j < 10; ++j)
#pragma unroll
            for (int e = 0; e < 4; ++e) { const float pv = __expf(s[j][e] - mx); s[j][e] = pv; sum += pv; }
        sum += __shfl_xor(sum, 16); sum += __shfl_xor(sum, 32);
        sum += __expf(sink - mx);
        const float inv = 1.0f / sum;
        bf16x8 pb[5];
#pragma unroll
        for (int kk = 0; kk < 5; ++kk) { u32x4 w; w.x = cvt_pk(s[2 * kk][0] * inv, s[2 * kk][1] * inv); w.y = cvt_pk(s[2 * kk][2] * inv, s[2 * kk][3] * inv);
            w.z = cvt_pk(s[2 * kk + 1][0] * inv, s[2 * kk + 1][1] * inv); w.w = cvt_pk(s[2 * kk + 1][2] * inv, s[2 * kk + 1][3] * inv); pb[kk] = __builtin_bit_cast(bf16x8, w); }
#pragma unroll
        for (int dt = 0; dt < 4; ++dt) {
            f32x4 acc = (f32x4){0.f, 0.f, 0.f, 0.f};
#pragma unroll
            for (int kk = 0; kk < 5; ++kk) {
                const int c0 = (wid + 2 * kk) < 15 ? (wid + 2 * kk) : 15, c1 = (wid + 2 * kk + 1) < 15 ? (wid + 2 * kk + 1) : 15;
                const u32x2 lo = *(const LAS u32x2*)(Vt + (16 * dt + fr) * 264 + 16 * c0 + 4 * fq), hi = *(const LAS u32x2*)(Vt + (16 * dt + fr) * 264 + 16 * c1 + 4 * fq);
                const u32x4 a = (u32x4){lo.x, lo.y, hi.x, hi.y};
                acc = mfma16(__builtin_bit_cast(bf16x8, a), pb[kk], acc);
            }
            u32x2 w; w.x = cvt_pk(acc[0], acc[1]); w.y = cvt_pk(acc[2], acc[3]);
            *(u32x2*)(PB + (size_t)qtok * PW + h * 64 + 16 * dt + 4 * fq) = w;
            asm volatile("" ::: "memory");
        }
    }
}

__device__ __forceinline__ void sattn_unit(const Params& p, int s, int h, int lane) {
    const int kvh = h >> 2; const bool wr = (h & 3) == 0;
    bf16_t* PB = (bf16_t*)(p.ws + WS_H) + (size_t)(MPR + s) * PW;
    const float* ck = p.in[2] + (size_t)s * 128 * 128 + kvh * 64 + lane; const float* cv = p.in[3] + (size_t)s * 128 * 128 + kvh * 64 + lane;
    float* nk = p.out + O_KS + (size_t)s * 128 * 128 + kvh * 64 + lane; float* nv = p.out + O_VS + (size_t)s * 128 * 128 + kvh * 64 + lane;
    const float q = bf2f(PB[h * 64 + lane]) * 0.125f, slope = exp2f(-(float)(h + 1)), sink = p.in[11][h];
    const float knew = bf2f(PB[512 + kvh * 64 + lane]), vnew = bf2f(PB[640 + kvh * 64 + lane]);
    float sc[3];
#pragma unroll
    for (int t = 0; t < 2; ++t) {
#pragma unroll 8
        for (int jj = 0; jj < 64; ++jj) {
            const int j = t * 64 + jj; const float kval = ck[(size_t)j * 128];
            if (wr && j >= 1) nk[(size_t)(j - 1) * 128] = kval;
            const float d = wave_sum(q * kval) - slope * (float)(128 - j); if (lane == jj) sc[t] = d;
        }
    }
    if (wr) nk[(size_t)127 * 128] = knew;
    sc[2] = wave_sum(q * knew);
    const float mx = fmaxf(fmaxf(wave_max(fmaxf(sc[0], sc[1])), sc[2]), sink);
    const float p0 = __expf(sc[0] - mx), p1 = __expf(sc[1] - mx), p2 = __expf(sc[2] - mx);
    const float inv = 1.0f / (wave_sum(p0 + p1) + p2 + __expf(sink - mx));
    float o = p2 * vnew;
#pragma unroll 8
    for (int jj = 0; jj < 64; ++jj) { const float vval = cv[(size_t)jj * 128]; if (wr && jj >= 1) nv[(size_t)(jj - 1) * 128] = vval; o += __shfl(p0, jj) * vval; }
#pragma unroll 8
    for (int jj = 0; jj < 64; ++jj) { const float vval = cv[(size_t)(64 + jj) * 128]; if (wr) nv[(size_t)(63 + jj) * 128] = vval; o += __shfl(p1, jj) * vval; }
    if (wr) nv[(size_t)127 * 128] = vnew;
    asm volatile("" ::: "memory");
    PB[h * 64 + lane] = f2bf(o * inv);
}

__device__ __forceinline__ void sgdn_unit(const Params& p, LAS unsigned char* lds, int s) {
    const int tid = threadIdx.x, wid = tid >> 6, h = tid >> 7, dv = tid & 127;
    LAS float* qs = (LAS float*)lds; LAS float* ks = qs + 512; LAS float* red = ks + 512;
    bf16_t* PB = (bf16_t*)(p.ws + WS_H) + (size_t)(MPR + s) * PW; const float* GBA = (const float*)(p.ws + WS_GBA) + (size_t)(MPR + s) * 8;
    const float* cw = p.in[12]; const float* hc = p.in[4] + (size_t)s * 3 * CONVC; float* nc = p.out + O_CS + (size_t)s * 3 * CONVC;
    __syncthreads();
    float val[3];
#pragma unroll
    for (int i = 0; i < 3; ++i) {
        const int c = i * 512 + tid; const float x3 = bf2f(PB[768 + c]), h0 = hc[c], h1 = hc[CONVC + c], h2 = hc[2 * CONVC + c];
        val[i] = silu(cw[c] * h0 + cw[CONVC + c] * h1 + cw[2 * CONVC + c] * h2 + cw[3 * CONVC + c] * x3);
        nc[c] = h1; nc[CONVC + c] = h2; nc[2 * CONVC + c] = x3;
    }
    const float sq = wave_sum(val[0] * val[0]), sk = wave_sum(val[1] * val[1]);
    if ((tid & 63) == 0) { red[wid] = sq; red[8 + wid] = sk; }
    __syncthreads();
    const float ssq = red[2 * h] + red[2 * h + 1], ssk = red[8 + 2 * h] + red[8 + 2 * h + 1];
    qs[tid] = val[0] * rsqrtf(ssq + EPS) * 0.08838834764831845f; ks[tid] = val[1] * rsqrtf(ssk + EPS);
    __syncthreads();
    const float beta = 1.0f / (1.0f + __expf(-GBA[h]));
    const float x = GBA[4 + h] + p.in[14][h]; const float sp = x > 20.f ? x : log1pf(__expf(x));
    const float eg = __expf(-__expf(p.in[13][h]) * sp);
    const float* S0 = p.in[5] + ((size_t)(s * 4 + h) * 128) * 128 + dv; float* S1 = p.out + O_GS + ((size_t)(s * 4 + h) * 128) * 128 + dv;
    float kS = 0.f;
#pragma unroll 1
    for (int hf = 0; hf < 4; ++hf) { float sv[32];
#pragma unroll
        for (int dk = 0; dk < 32; ++dk) sv[dk] = S0[(size_t)(hf * 32 + dk) * 128];
#pragma unroll
        for (int dk = 0; dk < 32; ++dk) kS += ks[h * 128 + hf * 32 + dk] * sv[dk]; }
    const float delta = beta * (val[2] - eg * kS);
    float o = 0.f;
#pragma unroll 1
    for (int hf = 0; hf < 4; ++hf) { float sv[32];
#pragma unroll
        for (int dk = 0; dk < 32; ++dk) sv[dk] = S0[(size_t)(hf * 32 + dk) * 128];
#pragma unroll
        for (int dk = 0; dk < 32; ++dk) { const float nvv = eg * sv[dk] + ks[h * 128 + hf * 32 + dk] * delta; S1[(size_t)(hf * 32 + dk) * 128] = nvv; o += qs[h * 128 + hf * 32 + dk] * nvv; } }
    const float so = wave_sum(o * o);
    if ((tid & 63) == 0) red[16 + wid] = so;
    __syncthreads();
    const float tot = red[16 + 2 * h] + red[16 + 2 * h + 1];
    const float gz = bf2f(PB[2304 + tid]);
    PB[512 + tid] = f2bf(o * rsqrtf(tot * (1.0f / 128.0f) + EPS) * p.in[15][dv] * silu(gz));
}

#define XB_TMO      128
#define XB_XCNT(j)  (256  + 64 * (j))
#define XB_XSUB(j)  (1280 + 64 * (j))
#define XB_XGEN(j)  (2304 + 64 * (j))
#define XB_TOP      3328
#define XB_TOPGEN   3392
#define XCD_BAR_WORDS 3456
#define XB_SPIN_CAP (1u << 18)

__device__ __forceinline__ unsigned xb_ld(unsigned* p)              { return __hip_atomic_load(p, __ATOMIC_RELAXED, __HIP_MEMORY_SCOPE_AGENT); }
__device__ __forceinline__ unsigned xb_add(unsigned* p, unsigned v) { return __hip_atomic_fetch_add(p, v, __ATOMIC_RELAXED, __HIP_MEMORY_SCOPE_AGENT); }
__device__ __forceinline__ unsigned xb_xcc_id() { return (unsigned)__builtin_amdgcn_s_getreg((3 << 11) | 20) & 0xFu; }
#define XB_SPIN(cond, bar) do { unsigned _sp = 0; while (cond) { __builtin_amdgcn_s_sleep(1); \
    if ((++_sp & 255u) == 0u) { if (xb_ld(&(bar)[XB_TMO])) break; if (_sp > XB_SPIN_CAP) { atomicAdd(&(bar)[XB_TMO], 1u); break; } } } } while (0)

struct XcdBarrier {
    unsigned* bar; unsigned x;
    volatile LAS unsigned* st;
};

__device__ __forceinline__ XcdBarrier xcd_barrier_post(unsigned* bar, volatile LAS unsigned* st) {
    XcdBarrier b; b.bar = bar; b.x = xb_xcc_id(); b.st = st;
    if (threadIdx.x == 0) (void)xb_add(&bar[XB_XCNT(b.x)], 1u);
    return b;
}
__device__ __forceinline__ void xcd_barrier_complete(unsigned* bar, unsigned x, unsigned& nloc, unsigned& nx) {
    const unsigned G = gridDim.x * gridDim.y * gridDim.z;
    unsigned sum, cnt, mine, sp = 0u;
    for (;;) {
        sum = 0u; cnt = 0u; mine = 0u;
#pragma unroll
        for (unsigned j = 0; j < 16; ++j) { const unsigned c = xb_ld(&bar[XB_XCNT(j)]); sum += c; cnt += (c > 0u) ? 1u : 0u; mine = (j == x) ? c : mine; }
        if (sum == G) break;
        __builtin_amdgcn_s_sleep(1);
        if ((++sp & 255u) == 0u) { if (xb_ld(&bar[XB_TMO])) break; if (sp > XB_SPIN_CAP) { atomicAdd(&bar[XB_TMO], 1u); break; } }
    }
    nloc = mine > 0u ? mine : 1u; nx = cnt > 0u ? cnt : 1u;
}

__device__ __forceinline__ void xcd_barrier(const XcdBarrier& b) {
    asm volatile("s_waitcnt vmcnt(0)" ::: "memory");
    __syncthreads();
    if (threadIdx.x == 0) {
        unsigned* bar = b.bar;
        __builtin_amdgcn_s_waitcnt(0);
        unsigned nloc = b.st[0], nx = b.st[1];
        if (nloc == 0u) { xcd_barrier_complete(bar, b.x, nloc, nx); b.st[0] = nloc; b.st[1] = nx; }
        const unsigned old = xb_add(&bar[XB_XSUB(b.x)], 1u);
        const unsigned gen = old / nloc;
        if (old + 1u == (gen + 1u) * nloc) {
            __builtin_amdgcn_fence(__ATOMIC_RELEASE, "agent");
            asm volatile("s_waitcnt vmcnt(0)" ::: "memory");
            const unsigned og = xb_add(&bar[XB_TOP], 1u);
            const unsigned tg = og / nx;
            if (og + 1u == (tg + 1u) * nx) xb_add(&bar[XB_TOPGEN], 1u);
            else XB_SPIN(xb_ld(&bar[XB_TOPGEN]) == tg, bar);
            __builtin_amdgcn_fence(__ATOMIC_ACQUIRE, "agent");
            xb_add(&bar[XB_XGEN(b.x)], 1u);
            asm volatile("s_waitcnt vmcnt(0)" ::: "memory");
        } else {
            XB_SPIN(xb_ld(&bar[XB_XGEN(b.x)]) == gen, bar);
            __builtin_amdgcn_fence(__ATOMIC_ACQUIRE, "agent");
            asm volatile("s_waitcnt vmcnt(0)" ::: "memory");
        }
    }
    __syncthreads();
}

__global__ void __launch_bounds__(512, 2) fwd_kernel(Params p, int ph_lo, int ph_hi) {
    extern __shared__ __attribute__((aligned(16))) unsigned char lds_raw[];
    LAS unsigned char* lds = (LAS unsigned char*)lds_raw;
    cg::grid_group grid = cg::this_grid();
    if (ph_lo < 0) grid.sync();
    volatile LAS unsigned* bst = (volatile LAS unsigned*)(lds + LDS_PHASE_BYTES);
    if (threadIdx.x < 2) bst[threadIdx.x] = 0u;
    __syncthreads();
    XcdBarrier xbar; xbar.bar = (unsigned*)(p.ws + WS_CTL + CTL_BAR); xbar.x = 0; xbar.st = bst;
    if (ph_hi - ph_lo > 1) xbar = xcd_barrier_post((unsigned*)(p.ws + WS_CTL + CTL_BAR), bst);
    const int tid = threadIdx.x, lane = tid & 63, wid = tid >> 6, G = gridDim.x, bx = blockIdx.x;
    unsigned char* ws = p.ws;
    bf16_t* XN = (bf16_t*)(ws + WS_XN); bf16_t* XN2 = (bf16_t*)(ws + WS_XN2); bf16_t* HB = (bf16_t*)(ws + WS_H);
    float* SS1 = (float*)(ws + WS_SSP1); float* SS2 = (float*)(ws + WS_SSP2);
    float* Y = p.out; float* X2 = (float*)(ws + WS_GM); float* X3 = (float*)(ws + WS_XN);
#ifndef PHMASK
#define PHMASK 0x7ff
#endif
#define IN(k) (((PHMASK >> (k)) & 1) && ph_lo <= (k) && (k) < ph_hi)
#define SEAM(k) do { if (IN(k) && IN((k) + 1)) { xcd_barrier(xbar); }     } while (0)

    if (IN(0)) p0_prologue(p, lds, bx, G);
    SEAM(0);
    if (IN(1)) {
        if (bx < 176) sk_ffn_in<false>(XN, (const bf16_t*)(ws + WS_W1IN), HB, bx, wid, lane & 15, lane >> 4);
        pg8::Gemm g{XN, (const bf16_t*)(ws + WS_W1IN), MPR, 2 * DFF, DM, DM}; pg8::StaticOrder S; S.init(MPR, 2 * DFF, G, bx);
        EpiSwiglu E{HB, nullptr}; pg8::gemm_phase<EpiSwiglu, pg8::StaticOrder>(lds, g, S, E, nullptr);
    }
    SEAM(1);
    if (IN(2)) {
        if (bx < 64) sk_ffn_out<false>(HB, (const bf16_t*)(ws + WS_W1OUT), p.in[1], nullptr, XN + (size_t)MPR * DM, bx, wid, lane & 15, lane >> 4);
        pg8::Gemm g{HB, (const bf16_t*)(ws + WS_W1OUT), MPR, DM, DFF, DFF}; pg8::StaticOrder S; S.init(MPR, DM, G, bx);
        EpiResid<false, false, true, true, true> E{p.in[0], p.in[1], nullptr, XN, SS1}; pg8::gemm_phase<EpiResid<false, false, true, true, true>, pg8::StaticOrder>(lds, g, S, E, nullptr);
    }
    SEAM(2);
    if (IN(3)) {
        if (bx < 89) sk_inproj(XN, (const bf16_t*)(ws + WS_WINMIX), HB, (float*)(ws + WS_GBA), bx, wid, lane & 15, lane >> 4);
        pg8::Gemm g{XN, (const bf16_t*)(ws + WS_WINMIX), MPR, NINP, DM, DM}; pg8::StaticOrder S; S.init(MPR, NINP, G, bx);
        EpiInproj E{HB, (float*)(ws + WS_GBA), SS1}; pg8::gemm_phase<EpiInproj, pg8::StaticOrder>(lds, g, S, E, nullptr);
    }
    SEAM(3);
    if (IN(4)) {
        for (int u = bx; u < 2048; u += G) gdn_prep_unit(p, lds, u);
    }
    SEAM(4);
    if (IN(5)) {
        if (bx < NSCAN) gdn_scan(p, lds, bx);
        else {
            const int ab = bx - NSCAN, NAB = G - NSCAN;
            if (NAB == 192) {
                if (ab < 128) { sattn_unit(p, ab, wid, lane); sgdn_unit(p, lds, ab); attn_unit(p, lds, 2 * ab); attn_unit(p, lds, 2 * ab + 1); }
                else { for (int k = 0; k < 4; ++k) attn_unit(p, lds, 256 + (ab - 128) * 4 + k); }
            } else {
                int it = ab;
#pragma unroll 1
                for (; it < 512; it += NAB) attn_unit(p, lds, it);
#pragma unroll 1
                for (; it < 640; it += NAB) { sattn_unit(p, it - 512, wid, lane); sgdn_unit(p, lds, it - 512); }
            }
            const bf16_t* PB = HB;
            for (int idx = ab * 512 + tid; idx < 149504; idx += NAB * 512) {
                if (idx < 131072) { const int w = idx >> 16, r = idx & 65535, b = r >> 14, j = (r >> 7) & 127, c = r & 127;
                    p.out[(w ? O_VP : O_KP) + r] = bf2f(PB[(size_t)(b * SEQ + SEQ - 128 + j) * PW + 512 + w * 128 + c]);
                } else { const int r = idx - 131072, b = r / (3 * CONVC), q = r % (3 * CONVC), rr = q / CONVC, c = q % CONVC;
                    p.out[O_CP + r] = bf2f(PB[(size_t)(b * SEQ + SEQ - 3 + rr) * PW + 768 + c]); }
            }
        }
    }
    SEAM(5);
    if (IN(6)) {
        for (int u = bx * 8 + wid; u < 2048; u += G * 8) gdn_gate_unit(p, u, lane);
    }
    SEAM(6);
#ifdef DBG_DUMP
    if (ph_lo == 11) {
        const float* src = (const float*)(ws + DBG_SRC);
        for (size_t i = (size_t)bx * 512 + tid; i < (size_t)MREAL * DM; i += (size_t)G * 512) Y[i] = (i < (size_t)MREAL * 8) ? ((const float*)(ws + WS_GBA))[i] : 0.f;
    }
#endif
    if (IN(7)) {
        if (bx < 32) sk_outproj(HB, (const bf16_t*)(ws + WS_WOUTMIX), XN, X2, XN2, bx, wid, lane & 15, lane >> 4);
        pg8::Gemm g{HB, (const bf16_t*)(ws + WS_WOUTMIX), MPR, DM, DM, PW}; pg8::StaticOrder S; S.init(MPR, DM, G, bx);
        EpiResid<true, true, true, true, false> E{XN, XN + (size_t)MPR * DM, X2, XN2, SS2}; pg8::gemm_phase<EpiResid<true, true, true, true, false>, pg8::StaticOrder>(lds, g, S, E, nullptr);
    }
    SEAM(7);
    if (IN(8)) {
        if (bx < 176) sk_ffn_in<true>(XN2, (const bf16_t*)(ws + WS_W2IN), HB, bx, wid, lane & 15, lane >> 4);
        pg8::Gemm g{XN2, (const bf16_t*)(ws + WS_W2IN), MPR, 2 * DFF, DM, DM}; pg8::StaticOrder S; S.init(MPR, 2 * DFF, G, bx);
        EpiSwiglu E{HB, SS2}; pg8::gemm_phase<EpiSwiglu, pg8::StaticOrder>(lds, g, S, E, nullptr);
    }
    SEAM(8);
    if (IN(9)) {
        if (bx < 64) sk_ffn_out<true>(HB, (const bf16_t*)(ws + WS_W2OUT), X2 + (size_t)MPR * DM, X3 + (size_t)MPR * DM, nullptr, bx, wid, lane & 15, lane >> 4);
        pg8::Gemm g{HB, (const bf16_t*)(ws + WS_W2OUT), MPR, DM, DFF, DFF}; pg8::StaticOrder S; S.init(MPR, DM, G, bx);
        EpiResid<false, true, false, false, true> E{X2, X2 + (size_t)MPR * DM, X3, nullptr, nullptr}; pg8::gemm_phase<EpiResid<false, true, false, false, true>, pg8::StaticOrder>(lds, g, S, E, nullptr);
    }
    SEAM(9);
    if (IN(10)) {
        const float* gf = p.in[20]; f32x4 gv[4];
#pragma unroll
        for (int j = 0; j < 4; ++j) gv[j] = *((const f32x4*)gf + lane + 64 * j);
        {
            f32x4 v[4], vn[4]; int m = bx * 8 + wid;
            if (m < MREAL) { const f32x4* xr = (const f32x4*)(X3 + (size_t)m * DM) + lane;
#pragma unroll
                for (int j = 0; j < 4; ++j) v[j] = xr[64 * j]; }
            for (; m < MREAL; m += G * 8) {
                const int mn = m + G * 8;
                if (mn < MREAL) { const f32x4* xr = (const f32x4*)(X3 + (size_t)mn * DM) + lane;
#pragma unroll
                    for (int j = 0; j < 4; ++j) vn[j] = xr[64 * j]; }
                float s = 0.f;
#pragma unroll
                for (int j = 0; j < 4; ++j) s += (v[j][0] * v[j][0] + v[j][1] * v[j][1]) + (v[j][2] * v[j][2] + v[j][3] * v[j][3]);
                const float rstd = rsqrtf(wave_sum(s) * (1.0f / DM) + EPS);
                f32x4* yr = (f32x4*)(Y + (size_t)m * DM) + lane;
#pragma unroll
                for (int j = 0; j < 4; ++j) yr[64 * j] = v[j] * rstd * gv[j];
#pragma unroll
                for (int j = 0; j < 4; ++j) v[j] = vn[j];
            }
        }
    }
#undef IN
#undef SEAM
}
}

#ifndef MK_N_LAUNCHES
#define MK_N_LAUNCHES 1
#endif
extern "C" void kernel_launch(void* const* d_in, const int* in_sizes, int n_in, void* d_out, int out_size, void* d_ws, size_t ws_size, hipStream_t stream) {
    static int grid = 0;
    if (grid == 0) {
        if (n_in != 21 || ws_size < mk::WS_END || out_size != 47269888) { fprintf(stderr, "kernel_launch: unexpected shapes (n_in %d, ws %zu, out %d)\n", n_in, ws_size, out_size); grid = -1; return; }
        int dev = 0, cus = 0, per_cu = 0;
        (void)hipGetDevice(&dev); (void)hipDeviceGetAttribute(&cus, hipDeviceAttributeMultiprocessorCount, dev);
        if (hipFuncSetAttribute((const void*)mk::fwd_kernel, hipFuncAttributeMaxDynamicSharedMemorySize, mk::LDS_BYTES) != hipSuccess) { fprintf(stderr, "kernel_launch: hipFuncSetAttribute failed\n"); grid = -1; return; }
        if (hipOccupancyMaxActiveBlocksPerMultiprocessor(&per_cu, (const void*)mk::fwd_kernel, 512, mk::LDS_BYTES) != hipSuccess || per_cu < 1) { fprintf(stderr, "kernel_launch: occupancy query failed (%d)\n", per_cu); per_cu = 1; }
        (void)hipGetLastError();
        grid = cus * per_cu;
        if (grid <= mk::NSCAN) { fprintf(stderr, "kernel_launch: grid %d too small\n", grid); grid = -1; return; }
    }
    if (grid < 0) return;
    (void)hipMemsetAsync((char*)d_ws + mk::WS_CTL + mk::CTL_BAR, 0, mk::CTL_BAR_BYTES, stream);
    mk::Params p{};
    for (int i = 0; i < 21; ++i) p.in[i] = (const float*)d_in[i];
    p.out = (float*)d_out; p.ws = (unsigned char*)d_ws;
#if MK_N_LAUNCHES == 1
    int lo = 0, hi = 11; void* args[] = {&p, &lo, &hi};
    hipError_t e = hipLaunchCooperativeKernel((const void*)mk::fwd_kernel, dim3(grid), dim3(512), args, mk::LDS_BYTES, stream);
    if (e != hipSuccess) fprintf(stderr, "kernel_launch: cooperative launch failed: %s (grid %d)\n", hipGetErrorString(e), grid);
#else
#ifndef MK_LAST
#define MK_LAST 11
#ifndef MK_DOUBLE
#define MK_DOUBLE 0x0
#endif
#define DBG_C0 512
#define DBG_C1 1024
#endif
    for (int ph = 0; ph < MK_LAST; ++ph) { const int reps = ((MK_DOUBLE >> ph) & 1) ? 2 : 1; for (int r = 0; r < reps; ++r) hipLaunchKernelGGL(mk::fwd_kernel, dim3(grid), dim3(512), mk::LDS_BYTES, stream, p, ph, ph + 1); }
#ifdef DBG_DUMP
    hipLaunchKernelGGL(mk::fwd_kernel, dim3(grid), dim3(512), mk::LDS_BYTES, stream, p, 11, 12);
#endif
#endif
}
```

```cpp
#include <hip/hip_runtime.h>
#include <hip/hip_cooperative_groups.h>
#include <cstdio>
namespace cg = cooperative_groups;
namespace pg8 {
#define PG8_LAS __attribute__((address_space(3)))
typedef unsigned short bf16_t;
typedef short bf16x8 __attribute__((ext_vector_type(8)));
typedef float f32x4 __attribute__((ext_vector_type(4)));
typedef unsigned u32x4 __attribute__((ext_vector_type(4)));
constexpr int BM = 256, BK = 64, HALF = 128, HTB = HALF * BK * 2  , STAGE_BYTES = 8 * HTB, NXCD = 8, WGM = 4;

__host__ __device__ __forceinline__ int lds_byte(int r, int c) { const int st = (r >> 4) * 2 + (c >> 5), rr = r & 15, cc = c & 31, ob = rr * 64 + cc * 2; return st * 1024 + (ob ^ (((ob >> 9) & 1) << 5)); }
__host__ __device__ __forceinline__ void stage_rc(int b, int& R, int& C) { const int st = b / 1024, sb = b % 1024, swz = sb ^ (((sb >> 9) & 1) << 5); R = (st >> 1) * 16 + swz / 64; C = (st & 1) * 32 + (swz % 64) / 2; }
__host__ __device__ __forceinline__ int perm32(int rho) { const int n = rho >> 4, i = rho & 15; return 8 * (i >> 2) + 4 * n + (i & 3); }

struct Unit { int pm, pn; };
struct Gemm { const bf16_t* A; const bf16_t* Bt; int M, N, K, lda; };

struct StaticOrder {
    int nM, nN, nwg, G, c;
    __host__ __device__ void init(int M, int N, int G_, int c_) { nM = M / BM; nN = N / BM; nwg = nM * nN; G = G_; c = c_; }
    __host__ __device__ bool next(int i, Unit& u) const {
        const long L = (long)i * G + c; if (L >= nwg) return false;
        int wgid = (int)L; { const int q = nwg / NXCD, r = nwg % NXCD, xcd = wgid % NXCD, off = wgid / NXCD; wgid = (xcd < r ? xcd * (q + 1) : r * (q + 1) + (xcd - r) * q) + off; }
        const int nig = WGM * nN, gid = wgid / nig, fm = gid * WGM, gsz = (nM - fm) < WGM ? (nM - fm) : WGM;
        u.pm = fm + ((wgid % nig) % gsz); u.pn = (wgid % nig) / gsz; return true;
    }
    __device__ __forceinline__ void a_ready(const Unit&) const {}
    __device__ __forceinline__ void done(const Unit&) const {}
};
struct CountedOrder : StaticOrder {
    const unsigned* ready; unsigned need; unsigned* tmo;
    __device__ __forceinline__ void a_ready(const Unit& u) const {
        if (threadIdx.x < 64) {
            const unsigned long long t0 = __builtin_amdgcn_s_memrealtime(); unsigned polls = 0;
            while ((unsigned)__builtin_amdgcn_readfirstlane(__hip_atomic_load(ready + 64 * u.pm, __ATOMIC_RELAXED, __HIP_MEMORY_SCOPE_AGENT)) < need) {
                if ((++polls & 255u) == 0u && __builtin_amdgcn_readfirstlane(__hip_atomic_load(tmo, __ATOMIC_RELAXED, __HIP_MEMORY_SCOPE_AGENT)) != 0u) break;
                if (__builtin_amdgcn_s_memrealtime() - t0 > 2000000ull) {
                    if (threadIdx.x == 0) { unsigned expect = 0u; __hip_atomic_compare_exchange_strong(tmo + 1, &expect, 0x600u | (unsigned)(u.pm & 0xff), __ATOMIC_RELAXED, __ATOMIC_RELAXED, __HIP_MEMORY_SCOPE_AGENT); __hip_atomic_store(tmo, 1u, __ATOMIC_RELAXED, __HIP_MEMORY_SCOPE_AGENT); }
                    break; }
                __builtin_amdgcn_s_sleep(2); }
            __builtin_amdgcn_fence(__ATOMIC_ACQUIRE, "agent");
            asm volatile("s_waitcnt vmcnt(0)" ::: "memory");
        }
#if !defined(BROKEN_HOOK_NO_BARRIER)
        asm volatile("" ::: "memory"); __builtin_amdgcn_s_barrier(); asm volatile("" ::: "memory");
#endif
    }
};

__device__ __forceinline__ unsigned cvt_pk_bf16(float lo, float hi) { unsigned r; asm volatile("v_cvt_pk_bf16_f32 %0, %1, %2" : "=v"(r) : "v"(lo), "v"(hi)); return r; }
typedef float f32x2 __attribute__((ext_vector_type(2)));
__device__ __forceinline__ f32x2 gelu_pk(f32x2 v) {
    const f32x2 av = __builtin_elementwise_abs(v), d = av * 0.2316418882f + 1.0f;
    f32x2 t; t.x = __builtin_amdgcn_rcpf(d.x); t.y = __builtin_amdgcn_rcpf(d.y);
    f32x2 q = t * 0.5307027145f + (-0.7265760135f); q = q * t + 0.7107068705f; q = q * t + (-0.142248368f); q = q * t + 0.127414796f; q = q * t;
    const f32x2 s = (v * v) * (-0.72134752044f);
    f32x2 e; e.x = __builtin_amdgcn_exp2f(s.x); e.y = __builtin_amdgcn_exp2f(s.y);
    const f32x2 m = v * (q * e), r = v - m;
    f32x2 o; o.x = v.x < 0.f ? m.x : r.x; o.y = v.y < 0.f ? m.y : r.y; return o;
}

struct EpiF32 {
    static constexpr bool PERM = false, AFTER_DRAIN = false;
    float* C; int ldc; const float* bias;
    __device__ __forceinline__ void operator()(const f32x4 (&acc)[2][2][4][2], const Unit& u, int wr, int wc, int fr, int fq) const {
        const int row0 = u.pm * BM + wr * 64 + fr, col0 = u.pn * BM + wc * 32 + 4 * fq;
        f32x4 bv[2][2];
#pragma unroll
        for (int bj = 0; bj < 2; ++bj)
#pragma unroll
            for (int n = 0; n < 2; ++n) bv[bj][n] = bias ? *(const f32x4*)(bias + col0 + bj * HALF + n * 16) : (f32x4){0.f, 0.f, 0.f, 0.f};
#pragma unroll
        for (int ai = 0; ai < 2; ++ai)
#pragma unroll
            for (int m = 0; m < 4; ++m) { float* rowp = C + (size_t)(row0 + ai * HALF + m * 16) * ldc + col0;
#pragma unroll
                for (int bj = 0; bj < 2; ++bj)
#pragma unroll
                    for (int n = 0; n < 2; ++n) *(f32x4*)(rowp + bj * HALF + n * 16) = acc[ai][bj][m][n] + bv[bj][n]; }
    }
};
template <int ACT  > struct EpiBf16 {
    static constexpr bool PERM = true, AFTER_DRAIN = false;
    bf16_t* O; int ldc; const float* bias; int split_cols; size_t split_stride;
    __device__ __forceinline__ void operator()(const f32x4 (&acc)[2][2][4][2], const Unit& u, int wr, int wc, int fr, int fq) const {
        const int row0 = u.pm * BM + wr * 64 + fr; int colt = u.pn * BM; bf16_t* base = O;
        if (split_cols) { const int t = colt / split_cols; base += (size_t)t * split_stride; colt -= t * split_cols; }
        const int col0 = colt + wc * 32 + 8 * fq, bcol0 = u.pn * BM + wc * 32 + 8 * fq;
        f32x4 bv[2][2];
#pragma unroll
        for (int bj = 0; bj < 2; ++bj)
#pragma unroll
            for (int n = 0; n < 2; ++n) bv[bj][n] = bias ? *(const f32x4*)(bias + bcol0 + bj * HALF + 4 * n) : (f32x4){0.f, 0.f, 0.f, 0.f};
#pragma unroll
        for (int ai = 0; ai < 2; ++ai)
#pragma unroll
            for (int m = 0; m < 4; ++m) { bf16_t* rowp = base + (size_t)(row0 + ai * HALF + m * 16) * ldc + col0;
#pragma unroll
                for (int bj = 0; bj < 2; ++bj) { f32x4 v0 = acc[ai][bj][m][0] + bv[bj][0], v1 = acc[ai][bj][m][1] + bv[bj][1];
                    if (ACT == 1) { f32x2 a = gelu_pk((f32x2){v0[0], v0[1]}), b = gelu_pk((f32x2){v0[2], v0[3]}), c = gelu_pk((f32x2){v1[0], v1[1]}), d = gelu_pk((f32x2){v1[2], v1[3]});
                        v0 = (f32x4){a.x, a.y, b.x, b.y}; v1 = (f32x4){c.x, c.y, d.x, d.y}; }
                    if (ACT == 2) {
#pragma unroll
                        for (int j = 0; j < 4; ++j) { v0[j] = 0.5f * v0[j] * (1.0f + erff(v0[j] * 0.70710678f)); v1[j] = 0.5f * v1[j] * (1.0f + erff(v1[j] * 0.70710678f)); } }
                    u32x4 w; w.x = cvt_pk_bf16(v0[0], v0[1]); w.y = cvt_pk_bf16(v0[2], v0[3]); w.z = cvt_pk_bf16(v1[0], v1[1]); w.w = cvt_pk_bf16(v1[2], v1[3]);
                    *(u32x4*)(rowp + bj * HALF) = w; } }
    }
};

struct PanelStats {
    unsigned* xbuf;
    unsigned* cnt;
    unsigned* tmo;
    int ntn; float eps;
    unsigned code;
    __device__ __forceinline__ bool run(const f32x4 (&v)[2][2][4][2], const Unit& u, int wr, int wc, int fr, int fq, PG8_LAS unsigned char* lds, int wid, int lane) const {
        typedef float f32x2v __attribute__((ext_vector_type(2)));
        PG8_LAS f32x2v* P = (PG8_LAS f32x2v*)lds;
        PG8_LAS f32x2v* S = (PG8_LAS f32x2v*)(lds + 8192);
        PG8_LAS unsigned* flag = (PG8_LAS unsigned*)(lds + 8192 + 2048);
#pragma unroll
        for (int ai = 0; ai < 2; ++ai)
#pragma unroll
            for (int m = 0; m < 4; ++m) {
                float s = 0.f;
#pragma unroll
                for (int bj = 0; bj < 2; ++bj)
#pragma unroll
                    for (int n = 0; n < 2; ++n) { const f32x4 x = v[ai][bj][m][n]; s += (x[0] + x[1]) + (x[2] + x[3]); }
                s += __shfl_xor(s, 16); s += __shfl_xor(s, 32);
                const float mw = s * (1.0f / 64.0f); float q = 0.f;
#pragma unroll
                for (int bj = 0; bj < 2; ++bj)
#pragma unroll
                    for (int n = 0; n < 2; ++n) { const f32x4 d = v[ai][bj][m][n] - mw; q += (d[0] * d[0] + d[1] * d[1]) + (d[2] * d[2] + d[3] * d[3]); }
                q += __shfl_xor(q, 16); q += __shfl_xor(q, 32);
                if (fq == 0) P[(ai * HALF + wr * 64 + m * 16 + fr) * 4 + wc] = (f32x2v){mw, q};
            }
        asm volatile("s_waitcnt lgkmcnt(0)" ::: "memory"); __builtin_amdgcn_s_barrier(); asm volatile("" ::: "memory");
#if defined(BROKEN_NO_WAIT)
        if (blockIdx.x >= 64) { const long long t0 = clock64(); while (clock64() - t0 < 60000) __builtin_amdgcn_s_sleep(8); }
#endif
        const int row = wid * 32 + (lane & 31);
        if (lane < 32) {
            const f32x2v a = P[row * 4 + 0], b = P[row * 4 + 1], c = P[row * 4 + 2], d = P[row * 4 + 3];
            const float mt = (a.x + b.x + c.x + d.x) * 0.25f;
            const float da = a.x - mt, db = b.x - mt, dc = c.x - mt, dd = d.x - mt;
            const float m2 = (a.y + b.y) + (c.y + d.y) + 64.0f * ((da * da + db * db) + (dc * dc + dd * dd));
            unsigned long long* slot = (unsigned long long*)xbuf + ((size_t)(u.pm * BM + row) * 4 + u.pn);
            __hip_atomic_store(slot, ((unsigned long long)__float_as_uint(m2) << 32) | __float_as_uint(mt), __ATOMIC_RELAXED, __HIP_MEMORY_SCOPE_AGENT);
        }
        asm volatile("s_waitcnt vmcnt(0)" ::: "memory");
        if (lane == 0) __hip_atomic_fetch_add(cnt + 64 * u.pm, 1u, __ATOMIC_RELAXED, __HIP_MEMORY_SCOPE_AGENT);
        if (wid == 0) {
            bool dead = false; const unsigned long long t0 = __builtin_amdgcn_s_memrealtime(); const unsigned want = 8u * (unsigned)ntn;
            for (;;) {
#if defined(BROKEN_NO_WAIT)
                break;
#endif
                if ((unsigned)__builtin_amdgcn_readfirstlane(__hip_atomic_load(cnt + 64 * u.pm, __ATOMIC_RELAXED, __HIP_MEMORY_SCOPE_AGENT)) >= want) break;
                if (__builtin_amdgcn_s_memrealtime() - t0 > 2000000ull) {
                    if (lane == 0) { unsigned expect = 0u; __hip_atomic_compare_exchange_strong(tmo + 1, &expect, code | (unsigned)(u.pm & 0xff), __ATOMIC_RELAXED, __ATOMIC_RELAXED, __HIP_MEMORY_SCOPE_AGENT);
                                     __hip_atomic_store(tmo, 1u, __ATOMIC_RELAXED, __HIP_MEMORY_SCOPE_AGENT); }
                    dead = true; break; }
                __builtin_amdgcn_s_sleep(2);
            }
            __builtin_amdgcn_fence(__ATOMIC_ACQUIRE, "agent");
            if (lane == 0) flag[0] = dead ? 1u : 0u;
        }
        asm volatile("s_waitcnt vmcnt(0) lgkmcnt(0)" ::: "memory"); __builtin_amdgcn_s_barrier(); asm volatile("" ::: "memory");
        const bool bad = flag[0] != 0u;
        if (lane < 32) {
            const unsigned long long* slot = (const unsigned long long*)xbuf + (size_t)(u.pm * BM + row) * 4; float mt[4], m2[4]; float ms = 0.f;
#pragma unroll
            for (int t = 0; t < 4; ++t) { if (t < ntn) { const unsigned long long w = __hip_atomic_load(slot + t, __ATOMIC_RELAXED, __HIP_MEMORY_SCOPE_AGENT); mt[t] = __uint_as_float((unsigned)w); m2[t] = __uint_as_float((unsigned)(w >> 32)); } else { mt[t] = 0.f; m2[t] = 0.f; } ms += mt[t]; }
            const float mean = ms / (float)ntn; float q = 0.f;
#pragma unroll
            for (int t = 0; t < 4; ++t) if (t < ntn) { const float dm = mt[t] - mean; q += m2[t] + 256.0f * dm * dm; }
            S[row] = (f32x2v){mean, 1.0f / sqrtf(q / (256.0f * (float)ntn) + eps)};
        }
        asm volatile("s_waitcnt lgkmcnt(0)" ::: "memory"); __builtin_amdgcn_s_barrier(); asm volatile("" ::: "memory");
        return bad;
    }
};
struct EpiLnRes {
    static constexpr bool PERM = false, AFTER_DRAIN = true;
    const float* base; float* out; int ldc; const float* bias; PanelStats st; unsigned poison;
    __device__ __forceinline__ void refuse(size_t i0, size_t stride, int M, int N) const { const float q = __builtin_nanf(""); for (size_t i = i0; i < (size_t)M * N; i += stride) out[(i / N) * ldc + i % N] = q;
        if (i0 == 0) { unsigned expect = 0u; __hip_atomic_compare_exchange_strong(st.tmo + 1, &expect, 0x7f0u, __ATOMIC_RELAXED, __ATOMIC_RELAXED, __HIP_MEMORY_SCOPE_AGENT); __hip_atomic_store(st.tmo, 1u, __ATOMIC_RELAXED, __HIP_MEMORY_SCOPE_AGENT); } }
    __device__ __forceinline__ void fused(f32x4 (&acc)[2][2][4][2], const Unit& u, int wr, int wc, int fr, int fq, PG8_LAS unsigned char* lds, int wid, int lane) const {
        typedef float f32x2v __attribute__((ext_vector_type(2)));
        const PG8_LAS f32x2v* S = (const PG8_LAS f32x2v*)(lds + 8192);
        const int col0 = u.pn * BM + wc * 32 + 4 * fq;
#pragma unroll
        for (int bj = 0; bj < 2; ++bj)
#pragma unroll
            for (int n = 0; n < 2; ++n) { const f32x4 bv = bias ? *(const f32x4*)(bias + col0 + bj * HALF + n * 16) : (f32x4){0.f, 0.f, 0.f, 0.f};
#pragma unroll
                for (int ai = 0; ai < 2; ++ai)
#pragma unroll
                    for (int m = 0; m < 4; ++m) acc[ai][bj][m][n] += bv; }
        const bool bad = st.run(acc, u, wr, wc, fr, fq, lds, wid, lane) || poison != 0u;
        const float qnan = __builtin_nanf("");
#pragma unroll
        for (int ai = 0; ai < 2; ++ai)
#pragma unroll
            for (int m = 0; m < 4; ++m) { const int r = ai * HALF + wr * 64 + m * 16 + fr; const f32x2v sr = S[r]; const size_t off = (size_t)(u.pm * BM + r) * ldc + col0;
#pragma unroll
                for (int bj = 0; bj < 2; ++bj)
#pragma unroll
                    for (int n = 0; n < 2; ++n) { const f32x4 bs = *(const f32x4*)(base + off + bj * HALF + n * 16); f32x4 o = bs + (acc[ai][bj][m][n] - sr.x) * sr.y;
                        if (bad) o = (f32x4){qnan, qnan, qnan, qnan}; *(f32x4*)(out + off + bj * HALF + n * 16) = o; }
                asm volatile("" ::: "memory"); }
    }
};
struct EpiLnResLn {
    static constexpr bool PERM = false, AFTER_DRAIN = true;
    const float* base; float* out; bf16_t* xn; int ldc; const float* bias; PanelStats st1, st2; unsigned poison;
    __device__ __forceinline__ void refuse(size_t i0, size_t stride, int M, int N) const { const float q = __builtin_nanf(""); for (size_t i = i0; i < (size_t)M * N; i += stride) { const size_t o = (i / N) * ldc + i % N; out[o] = q; xn[o] = (bf16_t)0x7fc0u; }
        if (i0 == 0) { unsigned expect = 0u; __hip_atomic_compare_exchange_strong(st1.tmo + 1, &expect, 0x7f0u, __ATOMIC_RELAXED, __ATOMIC_RELAXED, __HIP_MEMORY_SCOPE_AGENT); __hip_atomic_store(st1.tmo, 1u, __ATOMIC_RELAXED, __HIP_MEMORY_SCOPE_AGENT); } }
    __device__ __forceinline__ void fused(f32x4 (&acc)[2][2][4][2], const Unit& u, int wr, int wc, int fr, int fq, PG8_LAS unsigned char* lds, int wid, int lane) const {
        typedef float f32x2v __attribute__((ext_vector_type(2))); typedef unsigned u32x2v __attribute__((ext_vector_type(2)));
        const PG8_LAS f32x2v* S = (const PG8_LAS f32x2v*)(lds + 8192);
        const int col0 = u.pn * BM + wc * 32 + 4 * fq;
#pragma unroll
        for (int bj = 0; bj < 2; ++bj)
#pragma unroll
            for (int n = 0; n < 2; ++n) { const f32x4 bv = bias ? *(const f32x4*)(bias + col0 + bj * HALF + n * 16) : (f32x4){0.f, 0.f, 0.f, 0.f};
#pragma unroll
                for (int ai = 0; ai < 2; ++ai)
#pragma unroll
                    for (int m = 0; m < 4; ++m) acc[ai][bj][m][n] += bv; }
        bool bad = st1.run(acc, u, wr, wc, fr, fq, lds, wid, lane) || poison != 0u;
        const float qnan = __builtin_nanf("");
#pragma unroll
        for (int ai = 0; ai < 2; ++ai)
#pragma unroll
            for (int m = 0; m < 4; ++m) { const int r = ai * HALF + wr * 64 + m * 16 + fr; const f32x2v sr = S[r]; const size_t off = (size_t)(u.pm * BM + r) * ldc + col0;
#pragma unroll
                for (int bj = 0; bj < 2; ++bj)
#pragma unroll
                    for (int n = 0; n < 2; ++n) { const f32x4 bs = *(const f32x4*)(base + off + bj * HALF + n * 16); acc[ai][bj][m][n] = bs + (acc[ai][bj][m][n] - sr.x) * sr.y; }
                asm volatile("" : "+v"(acc[ai][0][m][0]), "+v"(acc[ai][0][m][1]), "+v"(acc[ai][1][m][0]), "+v"(acc[ai][1][m][1]));
                if (m & 1) asm volatile("" ::: "memory"); }
        const bool bad1 = bad;
        bad = st2.run(acc, u, wr, wc, fr, fq, lds, wid, lane) || bad;
#pragma unroll
        for (int ai = 0; ai < 2; ++ai)
#pragma unroll
            for (int m = 0; m < 4; ++m) { const int r = ai * HALF + wr * 64 + m * 16 + fr; const f32x2v sr = S[r]; const size_t off = (size_t)(u.pm * BM + r) * ldc + col0;
#pragma unroll
                for (int bj = 0; bj < 2; ++bj)
#pragma unroll
                    for (int n = 0; n < 2; ++n) { const f32x4 x1 = acc[ai][bj][m][n]; *(f32x4*)(out + off + bj * HALF + n * 16) = bad1 ? (f32x4){qnan, qnan, qnan, qnan} : x1;
                        const f32x4 o = (x1 - sr.x) * sr.y; u32x2v w; w.x = cvt_pk_bf16(o[0], o[1]); w.y = cvt_pk_bf16(o[2], o[3]);
                        if (bad) { w.x = 0x7fc07fc0u; w.y = 0x7fc07fc0u; } *(u32x2v*)(xn + off + bj * HALF + n * 16) = w; }
                asm volatile("" ::: "memory"); }
    }
};

template <class Epi, class Sched, bool STAMP = false>
__device__ __forceinline__ void gemm_phase(PG8_LAS unsigned char* lds, const Gemm g, const Sched S, const Epi E, unsigned long long* stamps) {
    const int tid = threadIdx.x, wid = __builtin_amdgcn_readfirstlane(tid >> 6), lane = tid & 63, wr = wid >> 2, wc = wid & 3, fr = lane & 15, fq = lane >> 4;
    const int K = g.K, nt = K / BK;
    int ts_lo = 0, ts_hi = 0, nts = 0; const unsigned long long rt_entry = STAMP ? (unsigned long long)wall_clock64() : 0ull;
#define PG8_STAMP() do { if (STAMP && wid == 0 && nts < 64) { const unsigned long long _c = (unsigned long long)clock64(); \
        ts_lo = (lane == nts) ? (int)(unsigned)_c : ts_lo; ts_hi = (lane == nts) ? (int)(unsigned)(_c >> 32) : ts_hi; ++nts; } } while (0)
    PG8_STAMP();
    unsigned voffA[2], voffB[2];
#pragma unroll
    for (int i = 0; i < 2; ++i) { int R, C; stage_rc(tid * 16 + i * 8192, R, C); const int Rb = Epi::PERM ? ((R & ~31) + perm32(R & 31)) : R;
        voffA[i] = (unsigned)(R * g.lda + C) * 2u; voffB[i] = (unsigned)(Rb * K + C) * 2u; }
    const size_t kstep = (size_t)(BK * 2);
    const size_t hstep = (size_t)HALF * K * 2;
    const size_t tstep = 2 * hstep;
    const size_t hstepA = (size_t)HALF * g.lda * 2, tstepA = 2 * hstepA;
    const unsigned ldsw = (unsigned)wid * 1024u;
    const int aoff = lds_byte(wr * 64 + fr, fq * 8), boff = lds_byte(wc * 32 + fr, fq * 8);
#define PG8_SA(b, h) (((b) * 2 + (h)) * HTB)
#define PG8_SB(b, h) ((4 + (b) * 2 + (h)) * HTB)
#define PG8_STAGE(bufoff, gbase, voff) do { _Pragma("unroll") for (int _i = 0; _i < 2; ++_i) \
        __builtin_amdgcn_global_load_lds((const unsigned*)((const char*)(gbase) + (voff)[_i]), (PG8_LAS unsigned*)(lds + (bufoff) + ldsw + _i * 8192), 16, 0, 0); } while (0)
#define PG8_LDA(dst, b, h) do { _Pragma("unroll") for (int m = 0; m < 4; ++m) _Pragma("unroll") for (int k = 0; k < 2; ++k) dst[m][k] = *(const PG8_LAS bf16x8*)(lds + PG8_SA(b, h) + aoff + m * 2048 + k * 1024); } while (0)
#define PG8_LDB(dst, b, h) do { _Pragma("unroll") for (int n = 0; n < 2; ++n) _Pragma("unroll") for (int k = 0; k < 2; ++k) dst[n][k] = *(const PG8_LAS bf16x8*)(lds + PG8_SB(b, h) + boff + n * 2048 + k * 1024); } while (0)
#define PG8_MMA(ai, bj, At, Bt) do { __builtin_amdgcn_s_setprio(1); _Pragma("unroll") for (int m = 0; m < 4; ++m) _Pragma("unroll") for (int n = 0; n < 2; ++n) _Pragma("unroll") for (int k = 0; k < 2; ++k) \
        acc[ai][bj][m][n] = __builtin_amdgcn_mfma_f32_16x16x32_bf16(Bt[n][k], At[m][k], acc[ai][bj][m][n], 0, 0, 0); __builtin_amdgcn_s_setprio(0); } while (0)
#define PG8_WAIT_V(n) asm volatile("s_waitcnt vmcnt(" #n ")" ::: "memory")
#define PG8_WAIT_L(n) asm volatile("s_waitcnt lgkmcnt(" #n ")" ::: "memory")
#define PG8_BAR __builtin_amdgcn_s_barrier()
#define PG8_SCHED __builtin_amdgcn_sched_barrier(0)
    Unit cur, nxt; int ui = 0;
    if (!S.next(0, cur)) return;
    f32x4 acc[2][2][4][2];
#pragma unroll
    for (int a = 0; a < 2; ++a)
#pragma unroll
        for (int b = 0; b < 2; ++b)
#pragma unroll
            for (int m = 0; m < 4; ++m)
#pragma unroll
                for (int n = 0; n < 2; ++n) acc[a][b][m][n] = (f32x4){0.f, 0.f, 0.f, 0.f};
    bf16x8 At[4][2], B0[2][2], B1[2][2];
    const char* cA = (const char*)g.A + (size_t)cur.pm * tstepA; const char* cB = (const char*)g.Bt + (size_t)cur.pn * tstep;
    S.a_ready(cur);
    PG8_STAGE(PG8_SB(0, 0), cB, voffB); PG8_STAGE(PG8_SA(0, 0), cA, voffA); PG8_STAGE(PG8_SB(0, 1), cB + hstep, voffB); PG8_STAGE(PG8_SA(0, 1), cA + hstepA, voffA);
    if (wr == 1) PG8_BAR;
    PG8_WAIT_V(4); PG8_BAR;
    PG8_STAGE(PG8_SB(1, 0), cB + kstep, voffB); PG8_STAGE(PG8_SA(1, 0), cA + kstep, voffA); PG8_STAGE(PG8_SB(1, 1), cB + hstep + kstep, voffB);
    PG8_WAIT_V(6); PG8_BAR;
    PG8_STAMP();
    for (;;) {
        const bool has_next = S.next(ui + 1, nxt);
        const char* nA = has_next ? (const char*)g.A + (size_t)nxt.pm * tstepA : cA; const char* nB = has_next ? (const char*)g.Bt + (size_t)nxt.pn * tstep : cB;
        for (int t = 0; t < nt; t += 2) {
            const bool last = (t == nt - 2);
            const char* a1 = cA + (size_t)(t + 1) * kstep;
            const char* a2 = last ? nA : cA + (size_t)(t + 2) * kstep; const char* b2 = last ? nB : cB + (size_t)(t + 2) * kstep;
            const char* a3 = a2 + kstep; const char* b3 = b2 + kstep;
            if (last && has_next) S.a_ready(nxt);
            PG8_LDB(B0, 0, 0); PG8_SCHED; PG8_LDA(At, 0, 0); PG8_STAGE(PG8_SA(1, 1), a1 + hstepA, voffA);
            PG8_WAIT_L(8); PG8_BAR; PG8_WAIT_L(0); PG8_MMA(0, 0, At, B0); PG8_BAR; PG8_SCHED;
            PG8_LDB(B1, 0, 1); PG8_STAGE(PG8_SB(0, 0), b2, voffB);
            PG8_BAR; PG8_WAIT_L(0); PG8_MMA(0, 1, At, B1); PG8_BAR;
            PG8_LDA(At, 0, 1); PG8_STAGE(PG8_SA(0, 0), a2, voffA);
            PG8_BAR; PG8_WAIT_L(0); PG8_MMA(1, 0, At, B0); PG8_BAR; PG8_SCHED;
            PG8_STAGE(PG8_SB(0, 1), b2 + hstep, voffB);
            PG8_WAIT_V(6); PG8_BAR; PG8_MMA(1, 1, At, B1); PG8_BAR;
            PG8_LDB(B0, 1, 0); PG8_SCHED; PG8_LDA(At, 1, 0); PG8_STAGE(PG8_SA(0, 1), a2 + hstepA, voffA);
            PG8_WAIT_L(8); PG8_BAR; PG8_WAIT_L(0); PG8_MMA(0, 0, At, B0); PG8_BAR; PG8_SCHED;
            PG8_LDB(B1, 1, 1); PG8_STAGE(PG8_SB(1, 0), b3, voffB);
            PG8_BAR; PG8_WAIT_L(0); PG8_MMA(0, 1, At, B1); PG8_BAR;
            PG8_LDA(At, 1, 1); PG8_STAGE(PG8_SA(1, 0), a3, voffA);
            PG8_BAR; PG8_WAIT_L(0); PG8_MMA(1, 0, At, B0); PG8_BAR; PG8_SCHED;
            PG8_STAGE(PG8_SB(1, 1), b3 + hstep, voffB);
            PG8_WAIT_V(6); PG8_BAR; PG8_MMA(1, 1, At, B1); PG8_BAR;
        }
        PG8_STAMP();
        if constexpr (!Epi::AFTER_DRAIN) { E(acc, cur, wr, wc, fr, fq); S.done(cur); }
        PG8_STAMP();
        if (!has_next) break;
#pragma unroll
        for (int a = 0; a < 2; ++a)
#pragma unroll
            for (int b = 0; b < 2; ++b)
#pragma unroll
                for (int m = 0; m < 4; ++m)
#pragma unroll
                    for (int n = 0; n < 2; ++n) acc[a][b][m][n] = (f32x4){0.f, 0.f, 0.f, 0.f};
        cur = nxt; cA = nA; cB = nB; ++ui;
    }
    PG8_WAIT_V(0);
    if (wr == 0) PG8_BAR;
    PG8_BAR;
    if constexpr (Epi::AFTER_DRAIN) { E.fused(acc, cur, wr, wc, fr, fq, lds, wid, lane); S.done(cur); }
    PG8_STAMP();
    if (STAMP && wid == 0) { stamps[lane] = lane < nts ? (((unsigned long long)(unsigned)ts_hi << 32) | (unsigned)ts_lo) : 0ull;
        if (lane == 62) stamps[62] = rt_entry; if (lane == 63) stamps[63] = (unsigned long long)wall_clock64(); }
#undef PG8_STAMP
#undef PG8_SA
#undef PG8_SB
#undef PG8_STAGE
#undef PG8_LDA
#undef PG8_LDB
#undef PG8_MMA
#undef PG8_WAIT_V
#undef PG8_WAIT_L
#undef PG8_BAR
#undef PG8_SCHED
}
}

namespace mk {
#define LAS __attribute__((address_space(3)))
using pg8::bf16_t; using pg8::bf16x8; using pg8::f32x4; using pg8::u32x4;
typedef unsigned u32x2 __attribute__((ext_vector_type(2)));

constexpr int DM = 1024, SEQ = 8192, NBATCH = 4, MPR = NBATCH * SEQ, MSAMP = 128, MREAL = MPR + MSAMP, MPAD = 33024;
constexpr int DFF = 2816, PW = 2816, NINP = 3072, CONVC = 1536;
constexpr float EPS = 1e-6f;
#ifndef SCAN_CW
#define SCAN_CW 2
#endif
constexpr int CW = SCAN_CW, NSCAN = 128 / CW;
constexpr int LDS_PHASE_BYTES = 147456, LDS_BYTES = LDS_PHASE_BYTES + 256;

constexpr size_t O_YP = 0, O_YS = 33554432, O_KP = 33685504, O_VP = 33751040, O_CP = 33816576, O_GP = 33835008,
                 O_KS = 34097152, O_VS = 36194304, O_CS = 38291456, O_GS = 38881280;
constexpr size_t MiB = 1u << 20;
constexpr size_t WS_CTL = 0, CTL_ZERO_BYTES = 1 * MiB;
constexpr size_t WS_W1IN = 1 * MiB, WS_W1OUT = 12 * MiB, WS_WINMIX = 18 * MiB, WS_WOUTMIX = 24 * MiB, WS_W2IN = 26 * MiB, WS_W2OUT = 37 * MiB;
constexpr size_t WS_GBA = 43 * MiB, WS_XN = 45 * MiB, WS_XN2 = 110 * MiB, WS_H = 175 * MiB, WS_GM = 353 * MiB, WS_GN = 417 * MiB;
constexpr size_t WS_GQ = 110 * MiB, WS_GO = 142 * MiB;
constexpr size_t WS_SSP1 = 481 * MiB, WS_SSP2 = 484 * MiB;
constexpr size_t WS_END = 487 * MiB;
constexpr size_t CTL_BAR = 0, CTL_BAR_BYTES = 16384, CTL_GLAST = 768 * 1024;

struct Params { const float* in[21]; float* out; unsigned char* ws; };

typedef float f32x2v __attribute__((ext_vector_type(2)));
typedef __bf16 bf16x2v __attribute__((ext_vector_type(2)));
__device__ __forceinline__ unsigned cvt_pk(float lo, float hi) { const f32x2v v = {lo, hi}; const bf16x2v b = __builtin_convertvector(v, bf16x2v); return __builtin_bit_cast(unsigned, b); }
__device__ __forceinline__ bf16_t f2bf(float f) { return (bf16_t)(cvt_pk(f, 0.f) & 0xffffu); }
__device__ __forceinline__ float bf2f(bf16_t h) { return __uint_as_float(((unsigned)h) << 16); }
__device__ __forceinline__ float bflo(unsigned w) { return __uint_as_float(w << 16); }
__device__ __forceinline__ float bfhi(unsigned w) { return __uint_as_float(w & 0xffff0000u); }
__device__ __forceinline__ float silu(float x) { return x * __builtin_amdgcn_rcpf(1.0f + __expf(-x)); }
__device__ __forceinline__ float wave_sum(float v) {
#pragma unroll
    for (int o = 1; o < 64; o <<= 1) v += __shfl_xor(v, o);
    return v;
}
__device__ __forceinline__ float wave_max(float v) {
#pragma unroll
    for (int o = 1; o < 64; o <<= 1) v = fmaxf(v, __shfl_xor(v, o));
    return v;
}
__device__ __forceinline__ f32x4 mfma16(bf16x8 a, bf16x8 b, f32x4 c) { return __builtin_amdgcn_mfma_f32_16x16x32_bf16(a, b, c, 0, 0, 0); }

__device__ __forceinline__ float row_rstd(const float* ssp, int r) {
    if (r >= MREAL) return 0.f;
    const f32x4 a = *(const f32x4*)(ssp + (size_t)r * 16), b = *(const f32x4*)(ssp + (size_t)r * 16 + 4), c = *(const f32x4*)(ssp + (size_t)r * 16 + 8), d = *(const f32x4*)(ssp + (size_t)r * 16 + 12);
    const float s = (((a[0] + a[1]) + (a[2] + a[3])) + ((b[0] + b[1]) + (b[2] + b[3]))) + (((c[0] + c[1]) + (c[2] + c[3])) + ((d[0] + d[1]) + (d[2] + d[3])));
    return rsqrtf(s * (1.0f / DM) + EPS);
}
struct EpiSwiglu {
    static constexpr bool PERM = true, AFTER_DRAIN = false;
    bf16_t* H; const float* ss;
    __device__ __forceinline__ void operator()(const f32x4 (&acc)[2][2][4][2], const pg8::Unit& u, int wr, int wc, int fr, int fq) const {
        const int row0 = u.pm * 256 + wr * 64 + fr, col0 = u.pn * 128 + wc * 32 + 8 * fq;
#pragma unroll
        for (int ai = 0; ai < 2; ++ai)
#pragma unroll
            for (int m = 0; m < 4; ++m) {
                const int r = row0 + ai * 128 + m * 16;
                const float rs = ss ? row_rstd(ss, r) : 1.0f;
                float h[8];
#pragma unroll
                for (int n = 0; n < 2; ++n)
#pragma unroll
                    for (int j = 0; j < 4; ++j) h[n * 4 + j] = silu(acc[ai][0][m][n][j] * rs) * (acc[ai][1][m][n][j] * rs);
                u32x4 w; w.x = cvt_pk(h[0], h[1]); w.y = cvt_pk(h[2], h[3]); w.z = cvt_pk(h[4], h[5]); w.w = cvt_pk(h[6], h[7]);
                *(u32x4*)(H + (size_t)r * DFF + col0) = w;
            }
    }
};
template <bool RESB16, bool WF32, bool WB16, bool SUMSQ, bool HALF> struct EpiResid {
    static constexpr bool PERM = true, AFTER_DRAIN = false;
    const void* resP; const void* resS; float* Yo; bf16_t* XBo; float* sso;
    __device__ __forceinline__ void operator()(const f32x4 (&acc)[2][2][4][2], const pg8::Unit& u, int wr, int wc, int fr, int fq) const {
        const int row0 = u.pm * 256 + wr * 64 + fr, col0 = u.pn * 256 + wc * 32 + 8 * fq;
        const char* const rP = (const char*)resP; const char* const rS = (const char*)resS - (size_t)MPR * DM * (RESB16 ? 2 : 4);
        float* const Y = Yo; const float scale = HALF ? 0.5f : 1.0f; bf16_t* const XB = XBo; float* const ss = sso;
#pragma unroll
        for (int ai = 0; ai < 2; ++ai)
#pragma unroll
            for (int m = 0; m < 4; ++m) {
                const int r = row0 + ai * 128 + m * 16; float s = 0.f;
                if (r < MREAL) {
                    const char* rp = ((r < MPR) ? rP : rS) + (size_t)r * DM * (RESB16 ? 2 : 4);
#pragma unroll
                    for (int bj = 0; bj < 2; ++bj) {
                        const int c = col0 + bj * 128;
                        f32x4 r0, r1;
                        if (RESB16) { const u32x4 w = *(const u32x4*)(rp + (size_t)c * 2); r0 = (f32x4){bflo(w.x), bfhi(w.x), bflo(w.y), bfhi(w.y)}; r1 = (f32x4){bflo(w.z), bfhi(w.z), bflo(w.w), bfhi(w.w)}; }
                        else { r0 = *(const f32x4*)(rp + (size_t)c * 4); r1 = *(const f32x4*)(rp + (size_t)c * 4 + 16); }
                        const f32x4 v0 = r0 + acc[ai][bj][m][0] * scale, v1 = r1 + acc[ai][bj][m][1] * scale;
                        if (WF32) { *(f32x4*)(Y + (size_t)r * DM + c) = v0; *(f32x4*)(Y + (size_t)r * DM + c + 4) = v1; }
                        if (WB16) { u32x4 w; w.x = cvt_pk(v0[0], v0[1]); w.y = cvt_pk(v0[2], v0[3]); w.z = cvt_pk(v1[0], v1[1]); w.w = cvt_pk(v1[2], v1[3]);
                            *(u32x4*)(XB + (size_t)r * DM + c) = w; }
                        if (SUMSQ) s += (v0[0] * v0[0] + v0[1] * v0[1]) + (v0[2] * v0[2] + v0[3] * v0[3]) + (v1[0] * v1[0] + v1[1] * v1[1]) + (v1[2] * v1[2] + v1[3] * v1[3]);
                    }
                }
                if (SUMSQ) { s += __shfl_xor(s, 16); s += __shfl_xor(s, 32); if (fq == 0 && r < MREAL) ss[(size_t)r * 16 + u.pn * 4 + wc] = s; }
            }
    }
};
struct EpiInproj {
    static constexpr bool PERM = true, AFTER_DRAIN = false;
    bf16_t* P; float* gba; const float* ss;
    __device__ __forceinline__ void operator()(const f32x4 (&acc)[2][2][4][2], const pg8::Unit& u, int wr, int wc, int fr, int fq) const {
        const int row0 = u.pm * 256 + wr * 64 + fr, col0 = u.pn * 256 + wc * 32 + 8 * fq;
#pragma unroll
        for (int ai = 0; ai < 2; ++ai)
#pragma unroll
            for (int m = 0; m < 4; ++m) {
                const int r = row0 + ai * 128 + m * 16;
                const float rs = row_rstd(ss, r);
                if (u.pn < 11) {
#pragma unroll
                    for (int bj = 0; bj < 2; ++bj) { const f32x4 v0 = acc[ai][bj][m][0] * rs, v1 = acc[ai][bj][m][1] * rs;
                        u32x4 w; w.x = cvt_pk(v0[0], v0[1]); w.y = cvt_pk(v0[2], v0[3]); w.z = cvt_pk(v1[0], v1[1]); w.w = cvt_pk(v1[2], v1[3]);
                        *(u32x4*)(P + (size_t)r * PW + col0 + bj * 128) = w; }
                } else if (wc == 0 && fq == 0) {
                    *(f32x4*)(gba + (size_t)r * 8) = acc[ai][0][m][0] * rs; *(f32x4*)(gba + (size_t)r * 8 + 4) = acc[ai][0][m][1] * rs;
                }
            }
    }
};


template <int NT, bool SS>
__device__ __forceinline__ void skinny_mm(const bf16_t* A, int lda, const bf16_t* W, int K, int wrow0, int wrow1, int wid, int fr, int fq, f32x4 (&acc)[NT], float& ss) {
    const bf16_t* ap = A + (size_t)(16 * wid + fr) * lda + 8 * fq;
    const bf16_t* w0 = W + (size_t)(wrow0 + fr) * K + 8 * fq; const bf16_t* w1 = W + (size_t)(wrow1 + fr) * K + 8 * fq;
#pragma unroll
    for (int nt = 0; nt < NT; ++nt) acc[nt] = (f32x4){0.f, 0.f, 0.f, 0.f};
    float s = 0.f;
#pragma unroll 8
    for (int ks = 0; ks < K / 32; ++ks) {
        const bf16x8 a = *(const bf16x8*)(ap + 32 * ks);
        acc[0] = mfma16(*(const bf16x8*)(w0 + 32 * ks), a, acc[0]);
        if (NT == 2) acc[NT - 1] = mfma16(*(const bf16x8*)(w1 + 32 * ks), a, acc[NT - 1]);
        if (SS) { const u32x4 u = __builtin_bit_cast(u32x4, a);
#pragma unroll
            for (int k = 0; k < 4; ++k) { const float lo = bflo(u[k]), hi = bfhi(u[k]); s += lo * lo + hi * hi; } }
    }
    if (SS) { s += __shfl_xor(s, 16); s += __shfl_xor(s, 32); }
    ss = s;
}
template <bool SS> __device__ __forceinline__ void sk_ffn_in(const bf16_t* X, const bf16_t* Wt, bf16_t* H, int slab, int wid, int fr, int fq) {
    const int j0 = 16 * slab, wr0 = (j0 >> 7) * 256 + (j0 & 127);
    f32x4 acc[2]; float ss;
    skinny_mm<2, SS>(X + (size_t)MPR * DM, DM, Wt, DM, wr0, wr0 + 128, wid, fr, fq, acc, ss);
    const float rs = SS ? rsqrtf(ss * (1.0f / DM) + EPS) : 1.0f;
    float h[4];
#pragma unroll
    for (int e = 0; e < 4; ++e) h[e] = silu(acc[0][e] * rs) * (acc[1][e] * rs);
    u32x2 w; w.x = cvt_pk(h[0], h[1]); w.y = cvt_pk(h[2], h[3]);
    *(u32x2*)(H + (size_t)(MPR + 16 * wid + fr) * DFF + j0 + 4 * fq) = w;
}
template <bool OUTF32> __device__ __forceinline__ void sk_ffn_out(const bf16_t* Hb, const bf16_t* Wt, const float* resf, float* outf, bf16_t* outb, int slab, int wid, int fr, int fq) {
    f32x4 acc[1]; float ss;
    skinny_mm<1, false>(Hb + (size_t)MPR * DFF, DFF, Wt, DFF, 16 * slab, 0, wid, fr, fq, acc, ss);
    const int rl = 16 * wid + fr, c = 16 * slab + 4 * fq;
    const f32x4 v = *(const f32x4*)(resf + (size_t)rl * DM + c) + acc[0] * 0.5f;
    if (OUTF32) *(f32x4*)(outf + (size_t)rl * DM + c) = v;
    else { u32x2 w; w.x = cvt_pk(v[0], v[1]); w.y = cvt_pk(v[2], v[3]); *(u32x2*)(outb + (size_t)rl * DM + c) = w; }
}
__device__ __forceinline__ void sk_inproj(const bf16_t* X, const bf16_t* Wt, bf16_t* P, float* gba, int slab, int wid, int fr, int fq) {
    const int n0 = 32 * slab; f32x4 acc[2]; float ss;
    skinny_mm<2, true>(X + (size_t)MPR * DM, DM, Wt, DM, n0, n0 + 16, wid, fr, fq, acc, ss);
    const float rs = rsqrtf(ss * (1.0f / DM) + EPS); const int r = MPR + 16 * wid + fr;
    if (n0 < PW) {
#pragma unroll
        for (int nt = 0; nt < 2; ++nt) { const f32x4 v = acc[nt] * rs; u32x2 w; w.x = cvt_pk(v[0], v[1]); w.y = cvt_pk(v[2], v[3]); *(u32x2*)(P + (size_t)r * PW + n0 + 16 * nt + 4 * fq) = w; }
    } else if (fq < 2) *(f32x4*)(gba + (size_t)r * 8 + 4 * fq) = acc[0] * rs;
}
__device__ __forceinline__ void sk_outproj(const bf16_t* Pm, const bf16_t* Wt, const bf16_t* X1b, float* X2f, bf16_t* X2b, int slab, int wid, int fr, int fq) {
    const int n0 = 32 * slab; f32x4 acc[2]; float ss;
    skinny_mm<2, false>(Pm + (size_t)MPR * PW, PW, Wt, DM, n0, n0 + 16, wid, fr, fq, acc, ss);
    const int r = MPR + 16 * wid + fr;
#pragma unroll
    for (int nt = 0; nt < 2; ++nt) { const int c = n0 + 16 * nt + 4 * fq; const u32x2 xr = *(const u32x2*)(X1b + (size_t)r * DM + c);
        const f32x4 v = (f32x4){bflo(xr.x), bfhi(xr.x), bflo(xr.y), bfhi(xr.y)} + acc[nt];
        *(f32x4*)(X2f + (size_t)r * DM + c) = v; u32x2 w; w.x = cvt_pk(v[0], v[1]); w.y = cvt_pk(v[2], v[3]); *(u32x2*)(X2b + (size_t)r * DM + c) = w; }
}

__device__ __forceinline__ void transpose_item(const float* W, int K, int N, bf16_t* WT, int k0, int n0, int drow0, const float* gs, LAS float* scr, int lane) {
    float wv[32];
#pragma unroll
    for (int i = 0; i < 32; ++i) { const int kk = 2 * i + (lane >> 5), n = n0 + (lane & 31); wv[i] = (n < N) ? W[(size_t)(k0 + kk) * N + n] : 0.f; }
#pragma unroll
    for (int i = 0; i < 32; ++i) { const int kk = 2 * i + (lane >> 5); float v = wv[i]; if (gs) v *= gs[k0 + kk]; scr[kk * 33 + (lane & 31)] = v; }
    asm volatile("s_waitcnt lgkmcnt(0)" ::: "memory");
    const int c = lane & 7;
#pragma unroll
    for (int j = 0; j < 4; ++j) { const int nn = (lane >> 3) + 8 * j; const LAS float* s = scr + (8 * c) * 33 + nn;
        u32x4 o; o.x = cvt_pk(s[0 * 33], s[1 * 33]); o.y = cvt_pk(s[2 * 33], s[3 * 33]); o.z = cvt_pk(s[4 * 33], s[5 * 33]); o.w = cvt_pk(s[6 * 33], s[7 * 33]);
        *(u32x4*)(WT + (size_t)(drow0 + nn) * K + k0 + 8 * c) = o; }
    asm volatile("s_waitcnt lgkmcnt(0)" ::: "memory");
}
__device__ __forceinline__ int map_ffin_row(int n0) { return n0 < DFF ? (n0 >> 7) * 256 + (n0 & 127) : ((n0 - DFF) >> 7) * 256 + 128 + ((n0 - DFF) & 127); }

__device__ __forceinline__ void p0_prologue(const Params& p, LAS unsigned char* lds, int vb, int G) {
    const int tid = threadIdx.x, lane = tid & 63, wid = tid >> 6;
    LAS float* scr = (LAS float*)(lds + wid * 16384);
    const int gw = vb * 8 + wid, NGW = G * 8;
    bf16_t* W1IN = (bf16_t*)(p.ws + WS_W1IN); bf16_t* W1OUT = (bf16_t*)(p.ws + WS_W1OUT); bf16_t* WINMIX = (bf16_t*)(p.ws + WS_WINMIX);
    bf16_t* WOUTMIX = (bf16_t*)(p.ws + WS_WOUTMIX); bf16_t* W2IN = (bf16_t*)(p.ws + WS_W2IN); bf16_t* W2OUT = (bf16_t*)(p.ws + WS_W2OUT);
    constexpr int I_FIN = 16 * 176, I_FOUT = 44 * 32, I_INMIX = 16 * 89, I_OUTMIX = 16 * 32;
    constexpr int NITEMS = 2 * I_FIN + 2 * I_FOUT + I_INMIX + I_OUTMIX;
    for (int it = gw; it < NITEMS; it += NGW) {
        int r = it;
        if (r < I_FIN) { const int kb = r / 176, nb = r % 176; transpose_item(p.in[7], DM, 2 * DFF, W1IN, kb * 64, nb * 32, map_ffin_row(nb * 32), nullptr, scr, lane); continue; } r -= I_FIN;
        if (r < I_FIN) { const int kb = r / 176, nb = r % 176; transpose_item(p.in[18], DM, 2 * DFF, W2IN, kb * 64, nb * 32, map_ffin_row(nb * 32), p.in[17], scr, lane); continue; } r -= I_FIN;
        if (r < I_FOUT) { const int kb = r / 32, nb = r % 32; transpose_item(p.in[8], DFF, DM, W1OUT, kb * 64, nb * 32, nb * 32, nullptr, scr, lane); continue; } r -= I_FOUT;
        if (r < I_FOUT) { const int kb = r / 32, nb = r % 32; transpose_item(p.in[19], DFF, DM, W2OUT, kb * 64, nb * 32, nb * 32, nullptr, scr, lane); continue; } r -= I_FOUT;
        if (r < I_INMIX) { const int kb = r / 89, nb = r % 89; transpose_item(p.in[10], DM, 2824, WINMIX, kb * 64, nb * 32, nb * 32, p.in[9], scr, lane); continue; } r -= I_INMIX;
        { const int kb = r / 32, nb = r % 32; transpose_item(p.in[16], DM, DM, WOUTMIX, kb * 64, nb * 32, nb * 32, nullptr, scr, lane); }
    }
    bf16_t* XN = (bf16_t*)(p.ws + WS_XN); const float* g1 = p.in[6];
    f32x4 gv[4];
#pragma unroll
    for (int j = 0; j < 4; ++j) gv[j] = *((const f32x4*)g1 + lane + 64 * j);
    {
        f32x4 v[4], vn[4];
        int m = gw;
        if (m < MREAL) { const f32x4* xr = (const f32x4*)((m < MPR) ? p.in[0] + (size_t)m * DM : p.in[1] + (size_t)(m - MPR) * DM) + lane;
#pragma unroll
            for (int j = 0; j < 4; ++j) v[j] = xr[64 * j]; }
        for (; m < MREAL; m += NGW) {
            const int mn = m + NGW;
            if (mn < MREAL) { const f32x4* xr = (const f32x4*)((mn < MPR) ? p.in[0] + (size_t)mn * DM : p.in[1] + (size_t)(mn - MPR) * DM) + lane;
#pragma unroll
                for (int j = 0; j < 4; ++j) vn[j] = xr[64 * j]; }
            float s = 0.f;
#pragma unroll
            for (int j = 0; j < 4; ++j) s += (v[j][0] * v[j][0] + v[j][1] * v[j][1]) + (v[j][2] * v[j][2] + v[j][3] * v[j][3]);
            const float rstd = rsqrtf(wave_sum(s) * (1.0f / DM) + EPS);
            unsigned long long* o8 = (unsigned long long*)(XN + (size_t)m * DM) + lane;
#pragma unroll
            for (int j = 0; j < 4; ++j) { const f32x4 y = v[j] * rstd * gv[j];
                o8[64 * j] = (unsigned long long)cvt_pk(y[0], y[1]) | ((unsigned long long)cvt_pk(y[2], y[3]) << 32); }
#pragma unroll
            for (int j = 0; j < 4; ++j) v[j] = vn[j];
        }
    }
}

template <bool SWX = false, bool SWY = false>
__device__ __forceinline__ f32x4 tile_mm(const LAS bf16_t* X, int ldx, int mt, const LAS bf16_t* Y, int ldy, int nt, int nks, int fr, int fq) {
    f32x4 acc = (f32x4){0.f, 0.f, 0.f, 0.f};
    const int rx = 16 * mt + fr, ry = 16 * nt + fr, sx = SWX ? ((rx >> 3) & 7) : 0, sy = SWY ? ((ry >> 3) & 7) : 0;
    const LAS bf16_t* xp = X + rx * ldx; const LAS bf16_t* yp = Y + ry * ldy;
    for (int ks = 0; ks < nks; ++ks) acc = mfma16(*(const LAS bf16x8*)(xp + 8 * ((4 * ks + fq) ^ sx)), *(const LAS bf16x8*)(yp + 8 * ((4 * ks + fq) ^ sy)), acc);
    return acc;
}
constexpr int G1_QS = 0, G1_KS = 17408, G1_VBT = 34816, G1_KBT = 53248, G1_KDT = 71680, G1_UT = 90112, G1_WT = 108544, G1_QK = 126976, G1_TB = 136192, G1_GC = 145408, G1_BETA = 145664;

__device__ __forceinline__ void gdn_prep_unit(const Params& p, LAS unsigned char* lds, int unit) {
    const int tid = threadIdx.x, lane = tid & 63, wid = tid >> 6, fr = lane & 15, fq = lane >> 4;
    const int bh = unit >> 7, n = unit & 127, b = bh >> 2, h = bh & 3;
    const int tok0 = b * SEQ + n * 64;
    LAS bf16_t* Qs = (LAS bf16_t*)(lds + G1_QS); LAS bf16_t* Ks = (LAS bf16_t*)(lds + G1_KS); LAS bf16_t* VbT = (LAS bf16_t*)(lds + G1_VBT);
    LAS bf16_t* KbT = (LAS bf16_t*)(lds + G1_KBT); LAS bf16_t* KdT = (LAS bf16_t*)(lds + G1_KDT); LAS bf16_t* UT = (LAS bf16_t*)(lds + G1_UT);
    LAS bf16_t* WT = (LAS bf16_t*)(lds + G1_WT); LAS float* Af = (LAS float*)(lds + G1_WT); LAS bf16_t* QK = (LAS bf16_t*)(lds + G1_QK);
    LAS bf16_t* Tb = (LAS bf16_t*)(lds + G1_TB); LAS float* gcs = (LAS float*)(lds + G1_GC); LAS float* betas = (LAS float*)(lds + G1_BETA);
    const bf16_t* PB = (const bf16_t*)(p.ws + WS_H); const float* GBA = (const float*)(p.ws + WS_GBA);
    LAS unsigned char* raw = lds + G1_UT;
    for (int pc4 = wid; pc4 < 51; pc4 += 8) {
        int pc = pc4 * 4 + (lane >> 4); pc = pc < 200 ? pc : 200;
        const int r = pc / 3, seg = pc - 3 * r; int tt = n * 64 - 3 + r; tt = tt < 0 ? 0 : tt;
        __builtin_amdgcn_global_load_lds((const unsigned*)(PB + (size_t)(b * SEQ + tt) * PW + 768 + seg * 512 + h * 128 + (lane & 15) * 8), (LAS unsigned*)(raw + pc4 * 1024), 16, 0, 0);
    }
    if (tid < 64) {
        const float* gb = GBA + (size_t)(tok0 + tid) * 8;
        const float bt = 1.0f / (1.0f + __expf(-gb[h]));
        const float x = gb[4 + h] + p.in[14][h]; const float sp = x > 20.f ? x : log1pf(__expf(x));
        float c = -__expf(p.in[13][h]) * sp;
#pragma unroll
        for (int o = 1; o < 64; o <<= 1) { const float t = __shfl_up(c, o); if (lane >= o) c += t; }
        gcs[tid] = c; betas[tid] = bt;
    }
    asm volatile("s_waitcnt vmcnt(0)" ::: "memory");
    __syncthreads();
    const float gclast = gcs[63];
    const float* cw = p.in[12];
#pragma unroll 1
    for (int it = 0; it < 6; ++it) {
        const int item = tid + 512 * it, l16 = item & 15, row = item >> 4, which = row >> 6, t = row & 63;
        const int cch = which * 512 + h * 128 + l16 * 8;
        float a[8];
#pragma unroll
        for (int e = 0; e < 8; ++e) a[e] = 0.f;
#pragma unroll
        for (int j = 0; j < 4; ++j) {
            const int tt = n * 64 + t - 3 + j;
            if (tt >= 0) {
                const u32x4 xv = *(const LAS u32x4*)(raw + ((t + j) * 3 + which) * 256 + l16 * 16);
                const f32x4 w0 = *(const f32x4*)(cw + j * CONVC + cch), w1 = *(const f32x4*)(cw + j * CONVC + cch + 4);
                a[0] += w0[0] * bflo(xv.x); a[1] += w0[1] * bfhi(xv.x); a[2] += w0[2] * bflo(xv.y); a[3] += w0[3] * bfhi(xv.y);
                a[4] += w1[0] * bflo(xv.z); a[5] += w1[1] * bfhi(xv.z); a[6] += w1[2] * bflo(xv.w); a[7] += w1[3] * bfhi(xv.w);
            }
        }
        float ss = 0.f;
#pragma unroll
        for (int e = 0; e < 8; ++e) { a[e] = silu(a[e]); ss += a[e] * a[e]; }
        ss += __shfl_xor(ss, 1); ss += __shfl_xor(ss, 2); ss += __shfl_xor(ss, 4); ss += __shfl_xor(ss, 8);
        const float gct = gcs[t], bt = betas[t];
        const int tsw = (((t >> 3) ^ (l16 & 7)) << 3) | (t & 7);
        if (which == 0) {
            const float sc = rsqrtf(ss + EPS) * 0.08838834764831845f;
            u32x4 w; w.x = cvt_pk(a[0] * sc, a[1] * sc); w.y = cvt_pk(a[2] * sc, a[3] * sc); w.z = cvt_pk(a[4] * sc, a[5] * sc); w.w = cvt_pk(a[6] * sc, a[7] * sc);
            *(LAS u32x4*)(Qs + t * 136 + l16 * 8) = w;
        } else if (which == 1) {
            const float sc = rsqrtf(ss + EPS);
            u32x4 w; w.x = cvt_pk(a[0] * sc, a[1] * sc); w.y = cvt_pk(a[2] * sc, a[3] * sc); w.z = cvt_pk(a[4] * sc, a[5] * sc); w.w = cvt_pk(a[6] * sc, a[7] * sc);
            *(LAS u32x4*)(Ks + t * 136 + l16 * 8) = w;
            const float sb = sc * bt * __expf(gct), sd = sc * __expf(gclast - gct);
#pragma unroll
            for (int e = 0; e < 8; ++e) { KbT[(l16 * 8 + e) * 72 + tsw] = f2bf(a[e] * sb); KdT[(l16 * 8 + e) * 72 + tsw] = f2bf(a[e] * sd); }
        } else {
#pragma unroll
            for (int e = 0; e < 8; ++e) VbT[(l16 * 8 + e) * 72 + tsw] = f2bf(a[e] * bt);
        }
    }
    __syncthreads();
#pragma unroll 2
    for (int r = 0; r < 4; ++r) {
        const int job = wid + 8 * r, kind = job >> 4, tile = job & 15, it = tile >> 2, jt = tile & 3;
        if (kind == 0) {
            if (jt > it) continue;
            const f32x4 acc = tile_mm(Ks, 136, it, Ks, 136, jt, 4, fr, fq);
            const int j = 16 * jt + fr; const float gcj = gcs[j];
            float v[4];
#pragma unroll
            for (int e = 0; e < 4; ++e) { const int i = 16 * it + 4 * fq + e; const bool ok = i > j; v[e] = ok ? acc[e] * __expf(gcs[i] - gcj) * betas[i] : 0.f; }
            *(LAS f32x4*)(Af + j * 68 + 16 * it + 4 * fq) = (f32x4){v[0], v[1], v[2], v[3]};
        } else {
            const f32x4 acc = tile_mm(Ks, 136, jt, Qs, 136, it, 4, fr, fq);
            const int i = 16 * it + fr; const float gci = gcs[i];
            float v[4];
#pragma unroll
            for (int e = 0; e < 4; ++e) { const int j = 16 * jt + 4 * fq + e; const bool ok = i >= j; v[e] = ok ? acc[e] * __expf(gci - gcs[j]) : 0.f; }
            u32x2 w; w.x = cvt_pk(v[0], v[1]); w.y = cvt_pk(v[2], v[3]); *(LAS u32x2*)(QK + i * 72 + 16 * jt + 4 * fq) = w;
        }
    }
    __syncthreads();
    if (wid == 0) {
        f32x2v r2[32];
#pragma unroll
        for (int k = 0; k < 32; ++k) r2[k] = (f32x2v){(lane == 2 * k) ? 1.0f : 0.0f, (lane == 2 * k + 1) ? 1.0f : 0.0f};
        const f32x4 a0 = *(const LAS f32x4*)(Af + 0);
        const f32x4 a1 = *(const LAS f32x4*)(Af + 4);
        const f32x4 a2 = *(const LAS f32x4*)(Af + 8);
        const f32x4 a3 = *(const LAS f32x4*)(Af + 12);
        const f32x4 a4 = *(const LAS f32x4*)(Af + 16);
        const float t0 = r2[0][0]; const f32x2v T0 = (f32x2v){t0, t0}; Tb[0 + lane] = f2bf(t0);
        r2[0] -= (f32x2v){a0[0], a0[1]} * T0; r2[1] -= (f32x2v){a0[2], a0[3]} * T0;
        const f32x4 a5 = *(const LAS f32x4*)(Af + 20);
        r2[2] -= (f32x2v){a1[0], a1[1]} * T0; r2[3] -= (f32x2v){a1[2], a1[3]} * T0;
        const f32x4 a6 = *(const LAS f32x4*)(Af + 24);
        r2[4] -= (f32x2v){a2[0], a2[1]} * T0; r2[5] -= (f32x2v){a2[2], a2[3]} * T0;
        const f32x4 a7 = *(const LAS f32x4*)(Af + 28);
        r2[6] -= (f32x2v){a3[0], a3[1]} * T0; r2[7] -= (f32x2v){a3[2], a3[3]} * T0;
        const f32x4 a8 = *(const LAS f32x4*)(Af + 32);
        r2[8] -= (f32x2v){a4[0], a4[1]} * T0; r2[9] -= (f32x2v){a4[2], a4[3]} * T0;
        const f32x4 a9 = *(const LAS f32x4*)(Af + 36);
        r2[10] -= (f32x2v){a5[0], a5[1]} * T0; r2[11] -= (f32x2v){a5[2], a5[3]} * T0;
        const f32x4 a10 = *(const LAS f32x4*)(Af + 40);
        r2[12] -= (f32x2v){a6[0], a6[1]} * T0; r2[13] -= (f32x2v){a6[2], a6[3]} * T0;
        const f32x4 a11 = *(const LAS f32x4*)(Af + 44);
        r2[14] -= (f32x2v){a7[0], a7[1]} * T0; r2[15] -= (f32x2v){a7[2], a7[3]} * T0;
        const f32x4 a12 = *(const LAS f32x4*)(Af + 48);
        r2[16] -= (f32x2v){a8[0], a8[1]} * T0; r2[17] -= (f32x2v){a8[2], a8[3]} * T0;
        const f32x4 a13 = *(const LAS f32x4*)(Af + 52);
        r2[18] -= (f32x2v){a9[0], a9[1]} * T0; r2[19] -= (f32x2v){a9[2], a9[3]} * T0;
        const f32x4 a14 = *(const LAS f32x4*)(Af + 56);
        r2[20] -= (f32x2v){a10[0], a10[1]} * T0; r2[21] -= (f32x2v){a10[2], a10[3]} * T0;
        const f32x4 a15 = *(const LAS f32x4*)(Af + 60);
        r2[22] -= (f32x2v){a11[0], a11[1]} * T0; r2[23] -= (f32x2v){a11[2], a11[3]} * T0;
        const f32x4 a16 = *(const LAS f32x4*)(Af + 68);
        r2[24] -= (f32x2v){a12[0], a12[1]} * T0; r2[25] -= (f32x2v){a12[2], a12[3]} * T0;
        const f32x4 a17 = *(const LAS f32x4*)(Af + 72);
        r2[26] -= (f32x2v){a13[0], a13[1]} * T0; r2[27] -= (f32x2v){a13[2], a13[3]} * T0;
        const f32x4 a18 = *(const LAS f32x4*)(Af + 76);
        r2[28] -= (f32x2v){a14[0], a14[1]} * T0; r2[29] -= (f32x2v){a14[2], a14[3]} * T0;
        const f32x4 a19 = *(const LAS f32x4*)(Af + 80);
        r2[30] -= (f32x2v){a15[0], a15[1]} * T0; r2[31] -= (f32x2v){a15[2], a15[3]} * T0;
        const f32x4 a20 = *(const LAS f32x4*)(Af + 84);
        const float t1 = r2[0][1]; const f32x2v T1 = (f32x2v){t1, t1}; Tb[72 + lane] = f2bf(t1);
        r2[1] -= (f32x2v){a16[2], a16[3]} * T1;
        const f32x4 a21 = *(const LAS f32x4*)(Af + 88);
        r2[2] -= (f32x2v){a17[0], a17[1]} * T1; r2[3] -= (f32x2v){a17[2], a17[3]} * T1;
        const f32x4 a22 = *(const LAS f32x4*)(Af + 92);
        r2[4] -= (f32x2v){a18[0], a18[1]} * T1; r2[5] -= (f32x2v){a18[2], a18[3]} * T1;
        const f32x4 a23 = *(const LAS f32x4*)(Af + 96);
        r2[6] -= (f32x2v){a19[0], a19[1]} * T1; r2[7] -= (f32x2v){a19[2], a19[3]} * T1;
        const f32x4 a24 = *(const LAS f32x4*)(Af + 100);
        r2[8] -= (f32x2v){a20[0], a20[1]} * T1; r2[9] -= (f32x2v){a20[2], a20[3]} * T1;
        const f32x4 a25 = *(const LAS f32x4*)(Af + 104);
        r2[10] -= (f32x2v){a21[0], a21[1]} * T1; r2[11] -= (f32x2v){a21[2], a21[3]} * T1;
        const f32x4 a26 = *(const LAS f32x4*)(Af + 108);
        r2[12] -= (f32x2v){a22[0], a22[1]} * T1; r2[13] -= (f32x2v){a22[2], a22[3]} * T1;
        const f32x4 a27 = *(const LAS f32x4*)(Af + 112);
        r2[14] -= (f32x2v){a23[0], a23[1]} * T1; r2[15] -= (f32x2v){a23[2], a23[3]} * T1;
        const f32x4 a28 = *(const LAS f32x4*)(Af + 116);
        r2[16] -= (f32x2v){a24[0], a24[1]} * T1; r2[17] -= (f32x2v){a24[2], a24[3]} * T1;
        const f32x4 a29 = *(const LAS f32x4*)(Af + 120);
        r2[18] -= (f32x2v){a25[0], a25[1]} * T1; r2[19] -= (f32x2v){a25[2], a25[3]} * T1;
        const f32x4 a30 = *(const LAS f32x4*)(Af + 124);
        r2[20] -= (f32x2v){a26[0], a26[1]} * T1; r2[21] -= (f32x2v){a26[2], a26[3]} * T1;
        const f32x4 a31 = *(const LAS f32x4*)(Af + 128);
        r2[22] -= (f32x2v){a27[0], a27[1]} * T1; r2[23] -= (f32x2v){a27[2], a27[3]} * T1;
        const f32x4 a32 = *(const LAS f32x4*)(Af + 136);
        r2[24] -= (f32x2v){a28[0], a28[1]} * T1; r2[25] -= (f32x2v){a28[2], a28[3]} * T1;
        const f32x4 a33 = *(const LAS f32x4*)(Af + 140);
        r2[26] -= (f32x2v){a29[0], a29[1]} * T1; r2[27] -= (f32x2v){a29[2], a29[3]} * T1;
        const f32x4 a34 = *(const LAS f32x4*)(Af + 144);
        r2[28] -= (f32x2v){a30[0], a30[1]} * T1; r2[29] -= (f32x2v){a30[2], a30[3]} * T1;
        const f32x4 a35 = *(const LAS f32x4*)(Af + 148);
        r2[30] -= (f32x2v){a31[0], a31[1]} * T1; r2[31] -= (f32x2v){a31[2], a31[3]} * T1;
        const f32x4 a36 = *(const LAS f32x4*)(Af + 152);
        const float t2 = r2[1][0]; const f32x2v T2 = (f32x2v){t2, t2}; Tb[144 + lane] = f2bf(t2);
        r2[1] -= (f32x2v){a32[2], a32[3]} * T2;
        const f32x4 a37 = *(const LAS f32x4*)(Af + 156);
        r2[2] -= (f32x2v){a33[0], a33[1]} * T2; r2[3] -= (f32x2v){a33[2], a33[3]} * T2;
        const f32x4 a38 = *(const LAS f32x4*)(Af + 160);
        r2[4] -= (f32x2v){a34[0], a34[1]} * T2; r2[5] -= (f32x2v){a34[2], a34[3]} * T2;
        const f32x4 a39 = *(const LAS f32x4*)(Af + 164);
        r2[6] -= (f32x2v){a35[0], a35[1]} * T2; r2[7] -= (f32x2v){a35[2], a35[3]} * T2;
        const f32x4 a40 = *(const LAS f32x4*)(Af + 168);
        r2[8] -= (f32x2v){a36[0], a36[1]} * T2; r2[9] -= (f32x2v){a36[2], a36[3]} * T2;
        const f32x4 a41 = *(const LAS f32x4*)(Af + 172);
        r2[10] -= (f32x2v){a37[0], a37[1]} * T2; r2[11] -= (f32x2v){a37[2], a37[3]} * T2;
        const f32x4 a42 = *(const LAS f32x4*)(Af + 176);
        r2[12] -= (f32x2v){a38[0], a38[1]} * T2; r2[13] -= (f32x2v){a38[2], a38[3]} * T2;
        const f32x4 a43 = *(const LAS f32x4*)(Af + 180);
        r2[14] -= (f32x2v){a39[0], a39[1]} * T2; r2[15] -= (f32x2v){a39[2], a39[3]} * T2;
        const f32x4 a44 = *(const LAS f32x4*)(Af + 184);
        r2[16] -= (f32x2v){a40[0], a40[1]} * T2; r2[17] -= (f32x2v){a40[2], a40[3]} * T2;
        const f32x4 a45 = *(const LAS f32x4*)(Af + 188);
        r2[18] -= (f32x2v){a41[0], a41[1]} * T2; r2[19] -= (f32x2v){a41[2], a41[3]} * T2;
        const f32x4 a46 = *(const LAS f32x4*)(Af + 192);
        r2[20] -= (f32x2v){a42[0], a42[1]} * T2; r2[21] -= (f32x2v){a42[2], a42[3]} * T2;
        const f32x4 a47 = *(const LAS f32x4*)(Af + 196);
        r2[22] -= (f32x2v){a43[0], a43[1]} * T2; r2[23] -= (f32x2v){a43[2], a43[3]} * T2;
        const f32x4 a48 = *(const LAS f32x4*)(Af + 208);
        r2[24] -= (f32x2v){a44[0], a44[1]} * T2; r2[25] -= (f32x2v){a44[2], a44[3]} * T2;
        const f32x4 a49 = *(const LAS f32x4*)(Af + 212);
        r2[26] -= (f32x2v){a45[0], a45[1]} * T2; r2[27] -= (f32x2v){a45[2], a45[3]} * T2;
        const f32x4 a50 = *(const LAS f32x4*)(Af + 216);
        r2[28] -= (f32x2v){a46[0], a46[1]} * T2; r2[29] -= (f32x2v){a46[2], a46[3]} * T2;
        const f32x4 a51 = *(const LAS f32x4*)(Af + 220);
        r2[30] -= (f32x2v){a47[0], a47[1]} * T2; r2[31] -= (f32x2v){a47[2], a47[3]} * T2;
        const f32x4 a52 = *(const LAS f32x4*)(Af + 224);
        const float t3 = r2[1][1]; const f32x2v T3 = (f32x2v){t3, t3}; Tb[216 + lane] = f2bf(t3);
        r2[2] -= (f32x2v){a48[0], a48[1]} * T3; r2[3] -= (f32x2v){a48[2], a48[3]} * T3;
        const f32x4 a53 = *(const LAS f32x4*)(Af + 228);
        r2[4] -= (f32x2v){a49[0], a49[1]} * T3; r2[5] -= (f32x2v){a49[2], a49[3]} * T3;
        const f32x4 a54 = *(const LAS f32x4*)(Af + 232);
        r2[6] -= (f32x2v){a50[0], a50[1]} * T3; r2[7] -= (f32x2v){a50[2], a50[3]} * T3;
        const f32x4 a55 = *(const LAS f32x4*)(Af + 236);
        r2[8] -= (f32x2v){a51[0], a51[1]} * T3; r2[9] -= (f32x2v){a51[2], a51[3]} * T3;
        const f32x4 a56 = *(const LAS f32x4*)(Af + 240);
        r2[10] -= (f32x2v){a52[0], a52[1]} * T3; r2[11] -= (f32x2v){a52[2], a52[3]} * T3;
        const f32x4 a57 = *(const LAS f32x4*)(Af + 244);
        r2[12] -= (f32x2v){a53[0], a53[1]} * T3; r2[13] -= (f32x2v){a53[2], a53[3]} * T3;
        const f32x4 a58 = *(const LAS f32x4*)(Af + 248);
        r2[14] -= (f32x2v){a54[0], a54[1]} * T3; r2[15] -= (f32x2v){a54[2], a54[3]} * T3;
        const f32x4 a59 = *(const LAS f32x4*)(Af + 252);
        r2[16] -= (f32x2v){a55[0], a55[1]} * T3; r2[17] -= (f32x2v){a55[2], a55[3]} * T3;
        const f32x4 a60 = *(const LAS f32x4*)(Af + 256);
        r2[18] -= (f32x2v){a56[0], a56[1]} * T3; r2[19] -= (f32x2v){a56[2], a56[3]} * T3;
        const f32x4 a61 = *(const LAS f32x4*)(Af + 260);
        r2[20] -= (f32x2v){a57[0], a57[1]} * T3; r2[21] -= (f32x2v){a57[2], a57[3]} * T3;
        const f32x4 a62 = *(const LAS f32x4*)(Af + 264);
        r2[22] -= (f32x2v){a58[0], a58[1]} * T3; r2[23] -= (f32x2v){a58[2], a58[3]} * T3;
        const f32x4 a63 = *(const LAS f32x4*)(Af + 276);
        r2[24] -= (f32x2v){a59[0], a59[1]} * T3; r2[25] -= (f32x2v){a59[2], a59[3]} * T3;
        const f32x4 a64 = *(const LAS f32x4*)(Af + 280);
        r2[26] -= (f32x2v){a60[0], a60[1]} * T3; r2[27] -= (f32x2v){a60[2], a60[3]} * T3;
        const f32x4 a65 = *(const LAS f32x4*)(Af + 284);
        r2[28] -= (f32x2v){a61[0], a61[1]} * T3; r2[29] -= (f32x2v){a61[2], a61[3]} * T3;
        const f32x4 a66 = *(const LAS f32x4*)(Af + 288);
        r2[30] -= (f32x2v){a62[0], a62[1]} * T3; r2[31] -= (f32x2v){a62[2], a62[3]} * T3;
        const f32x4 a67 = *(const LAS f32x4*)(Af + 292);
        const float t4 = r2[2][0]; const f32x2v T4 = (f32x2v){t4, t4}; Tb[288 + lane] = f2bf(t4);
        r2[2] -= (f32x2v){a63[0], a63[1]} * T4; r2[3] -= (f32x2v){a63[2], a63[3]} * T4;
        const f32x4 a68 = *(const LAS f32x4*)(Af + 296);
        r2[4] -= (f32x2v){a64[0], a64[1]} * T4; r2[5] -= (f32x2v){a64[2], a64[3]} * T4;
        const f32x4 a69 = *(const LAS f32x4*)(Af + 300);
        r2[6] -= (f32x2v){a65[0], a65[1]} * T4; r2[7] -= (f32x2v){a65[2], a65[3]} * T4;
        const f32x4 a70 = *(const LAS f32x4*)(Af + 304);
        r2[8] -= (f32x2v){a66[0], a66[1]} * T4; r2[9] -= (f32x2v){a66[2], a66[3]} * T4;
        const f32x4 a71 = *(const LAS f32x4*)(Af + 308);
        r2[10] -= (f32x2v){a67[0], a67[1]} * T4; r2[11] -= (f32x2v){a67[2], a67[3]} * T4;
        const f32x4 a72 = *(const LAS f32x4*)(Af + 312);
        r2[12] -= (f32x2v){a68[0], a68[1]} * T4; r2[13] -= (f32x2v){a68[2], a68[3]} * T4;
        const f32x4 a73 = *(const LAS f32x4*)(Af + 316);
        r2[14] -= (f32x2v){a69[0], a69[1]} * T4; r2[15] -= (f32x2v){a69[2], a69[3]} * T4;
        const f32x4 a74 = *(const LAS f32x4*)(Af + 320);
        r2[16] -= (f32x2v){a70[0], a70[1]} * T4; r2[17] -= (f32x2v){a70[2], a70[3]} * T4;
        const f32x4 a75 = *(const LAS f32x4*)(Af + 324);
        r2[18] -= (f32x2v){a71[0], a71[1]} * T4; r2[19] -= (f32x2v){a71[2], a71[3]} * T4;
        const f32x4 a76 = *(const LAS f32x4*)(Af + 328);
        r2[20] -= (f32x2v){a72[0], a72[1]} * T4; r2[21] -= (f32x2v){a72[2], a72[3]} * T4;
        const f32x4 a77 = *(const LAS f32x4*)(Af + 332);
        r2[22] -= (f32x2v){a73[0], a73[1]} * T4; r2[23] -= (f32x2v){a73[2], a73[3]} * T4;
        const f32x4 a78 = *(const LAS f32x4*)(Af + 344);
        r2[24] -= (f32x2v){a74[0], a74[1]} * T4; r2[25] -= (f32x2v){a74[2], a74[3]} * T4;
        const f32x4 a79 = *(const LAS f32x4*)(Af + 348);
        r2[26] -= (f32x2v){a75[0], a75[1]} * T4; r2[27] -= (f32x2v){a75[2], a75[3]} * T4;
        const f32x4 a80 = *(const LAS f32x4*)(Af + 352);
        r2[28] -= (f32x2v){a76[0], a76[1]} * T4; r2[29] -= (f32x2v){a76[2], a76[3]} * T4;
        const f32x4 a81 = *(const LAS f32x4*)(Af + 356);
        r2[30] -= (f32x2v){a77[0], a77[1]} * T4; r2[31] -= (f32x2v){a77[2], a77[3]} * T4;
        const f32x4 a82 = *(const LAS f32x4*)(Af + 360);
        const float t5 = r2[2][1]; const f32x2v T5 = (f32x2v){t5, t5}; Tb[360 + lane] = f2bf(t5);
        r2[3] -= (f32x2v){a78[2], a78[3]} * T5;
        const f32x4 a83 = *(const LAS f32x4*)(Af + 364);
        r2[4] -= (f32x2v){a79[0], a79[1]} * T5; r2[5] -= (f32x2v){a79[2], a79[3]} * T5;
        const f32x4 a84 = *(const LAS f32x4*)(Af + 368);
        r2[6] -= (f32x2v){a80[0], a80[1]} * T5; r2[7] -= (f32x2v){a80[2], a80[3]} * T5;
        const f32x4 a85 = *(const LAS f32x4*)(Af + 372);
        r2[8] -= (f32x2v){a81[0], a81[1]} * T5; r2[9] -= (f32x2v){a81[2], a81[3]} * T5;
        const f32x4 a86 = *(const LAS f32x4*)(Af + 376);
        r2[10] -= (f32x2v){a82[0], a82[1]} * T5; r2[11] -= (f32x2v){a82[2], a82[3]} * T5;
        const f32x4 a87 = *(const LAS f32x4*)(Af + 380);
        r2[12] -= (f32x2v){a83[0], a83[1]} * T5; r2[13] -= (f32x2v){a83[2], a83[3]} * T5;
        const f32x4 a88 = *(const LAS f32x4*)(Af + 384);
        r2[14] -= (f32x2v){a84[0], a84[1]} * T5; r2[15] -= (f32x2v){a84[2], a84[3]} * T5;
        const f32x4 a89 = *(const LAS f32x4*)(Af + 388);
        r2[16] -= (f32x2v){a85[0], a85[1]} * T5; r2[17] -= (f32x2v){a85[2], a85[3]} * T5;
        const f32x4 a90 = *(const LAS f32x4*)(Af + 392);
        r2[18] -= (f32x2v){a86[0], a86[1]} * T5; r2[19] -= (f32x2v){a86[2], a86[3]} * T5;
        const f32x4 a91 = *(const LAS f32x4*)(Af + 396);
        r2[20] -= (f32x2v){a87[0], a87[1]} * T5; r2[21] -= (f32x2v){a87[2], a87[3]} * T5;
        const f32x4 a92 = *(const LAS f32x4*)(Af + 400);
        r2[22] -= (f32x2v){a88[0], a88[1]} * T5; r2[23] -= (f32x2v){a88[2], a88[3]} * T5;
        const f32x4 a93 = *(const LAS f32x4*)(Af + 412);
        r2[24] -= (f32x2v){a89[0], a89[1]} * T5; r2[25] -= (f32x2v){a89[2], a89[3]} * T5;
        const f32x4 a94 = *(const LAS f32x4*)(Af + 416);
        r2[26] -= (f32x2v){a90[0], a90[1]} * T5; r2[27] -= (f32x2v){a90[2], a90[3]} * T5;
        const f32x4 a95 = *(const LAS f32x4*)(Af + 420);
        r2[28] -= (f32x2v){a91[0], a91[1]} * T5; r2[29] -= (f32x2v){a91[2], a91[3]} * T5;
        const f32x4 a96 = *(const LAS f32x4*)(Af + 424);
        r2[30] -= (f32x2v){a92[0], a92[1]} * T5; r2[31] -= (f32x2v){a92[2], a92[3]} * T5;
        const f32x4 a97 = *(const LAS f32x4*)(Af + 428);
        const float t6 = r2[3][0]; const f32x2v T6 = (f32x2v){t6, t6}; Tb[432 + lane] = f2bf(t6);
        r2[3] -= (f32x2v){a93[2], a93[3]} * T6;
        const f32x4 a98 = *(const LAS f32x4*)(Af + 432);
        r2[4] -= (f32x2v){a94[0], a94[1]} * T6; r2[5] -= (f32x2v){a94[2], a94[3]} * T6;
        const f32x4 a99 = *(const LAS f32x4*)(Af + 436);
        r2[6] -= (f32x2v){a95[0], a95[1]} * T6; r2[7] -= (f32x2v){a95[2], a95[3]} * T6;
        const f32x4 a100 = *(const LAS f32x4*)(Af + 440);
        r2[8] -= (f32x2v){a96[0], a96[1]} * T6; r2[9] -= (f32x2v){a96[2], a96[3]} * T6;
        const f32x4 a101 = *(const LAS f32x4*)(Af + 444);
        r2[10] -= (f32x2v){a97[0], a97[1]} * T6; r2[11] -= (f32x2v){a97[2], a97[3]} * T6;
        const f32x4 a102 = *(const LAS f32x4*)(Af + 448);
        r2[12] -= (f32x2v){a98[0], a98[1]} * T6; r2[13] -= (f32x2v){a98[2], a98[3]} * T6;
        const f32x4 a103 = *(const LAS f32x4*)(Af + 452);
        r2[14] -= (f32x2v){a99[0], a99[1]} * T6; r2[15] -= (f32x2v){a99[2], a99[3]} * T6;
        const f32x4 a104 = *(const LAS f32x4*)(Af + 456);
        r2[16] -= (f32x2v){a100[0], a100[1]} * T6; r2[17] -= (f32x2v){a100[2], a100[3]} * T6;
        const f32x4 a105 = *(const LAS f32x4*)(Af + 460);
        r2[18] -= (f32x2v){a101[0], a101[1]} * T6; r2[19] -= (f32x2v){a101[2], a101[3]} * T6;
        const f32x4 a106 = *(const LAS f32x4*)(Af + 464);
        r2[20] -= (f32x2v){a102[0], a102[1]} * T6; r2[21] -= (f32x2v){a102[2], a102[3]} * T6;
        const f32x4 a107 = *(const LAS f32x4*)(Af + 468);
        r2[22] -= (f32x2v){a103[0], a103[1]} * T6; r2[23] -= (f32x2v){a103[2], a103[3]} * T6;
        const f32x4 a108 = *(const LAS f32x4*)(Af + 484);
        r2[24] -= (f32x2v){a104[0], a104[1]} * T6; r2[25] -= (f32x2v){a104[2], a104[3]} * T6;
        const f32x4 a109 = *(const LAS f32x4*)(Af + 488);
        r2[26] -= (f32x2v){a105[0], a105[1]} * T6; r2[27] -= (f32x2v){a105[2], a105[3]} * T6;
        const f32x4 a110 = *(const LAS f32x4*)(Af + 492);
        r2[28] -= (f32x2v){a106[0], a106[1]} * T6; r2[29] -= (f32x2v){a106[2], a106[3]} * T6;
        const f32x4 a111 = *(const LAS f32x4*)(Af + 496);
        r2[30] -= (f32x2v){a107[0], a107[1]} * T6; r2[31] -= (f32x2v){a107[2], a107[3]} * T6;
        const f32x4 a112 = *(const LAS f32x4*)(Af + 500);
        const float t7 = r2[3][1]; const f32x2v T7 = (f32x2v){t7, t7}; Tb[504 + lane] = f2bf(t7);
        r2[4] -= (f32x2v){a108[0], a108[1]} * T7; r2[5] -= (f32x2v){a108[2], a108[3]} * T7;
        const f32x4 a113 = *(const LAS f32x4*)(Af + 504);
        r2[6] -= (f32x2v){a109[0], a109[1]} * T7; r2[7] -= (f32x2v){a109[2], a109[3]} * T7;
        const f32x4 a114 = *(const LAS f32x4*)(Af + 508);
        r2[8] -= (f32x2v){a110[0], a110[1]} * T7; r2[9] -= (f32x2v){a110[2], a110[3]} * T7;
        const f32x4 a115 = *(const LAS f32x4*)(Af + 512);
        r2[10] -= (f32x2v){a111[0], a111[1]} * T7; r2[11] -= (f32x2v){a111[2], a111[3]} * T7;
        const f32x4 a116 = *(const LAS f32x4*)(Af + 516);
        r2[12] -= (f32x2v){a112[0], a112[1]} * T7; r2[13] -= (f32x2v){a112[2], a112[3]} * T7;
        const f32x4 a117 = *(const LAS f32x4*)(Af + 520);
        r2[14] -= (f32x2v){a113[0], a113[1]} * T7; r2[15] -= (f32x2v){a113[2], a113[3]} * T7;
        const f32x4 a118 = *(const LAS f32x4*)(Af + 524);
        r2[16] -= (f32x2v){a114[0], a114[1]} * T7; r2[17] -= (f32x2v){a114[2], a114[3]} * T7;
        const f32x4 a119 = *(const LAS f32x4*)(Af + 528);
        r2[18] -= (f32x2v){a115[0], a115[1]} * T7; r2[19] -= (f32x2v){a115[2], a115[3]} * T7;
        const f32x4 a120 = *(const LAS f32x4*)(Af + 532);
        r2[20] -= (f32x2v){a116[0], a116[1]} * T7; r2[21] -= (f32x2v){a116[2], a116[3]} * T7;
        const f32x4 a121 = *(const LAS f32x4*)(Af + 536);
        r2[22] -= (f32x2v){a117[0], a117[1]} * T7; r2[23] -= (f32x2v){a117[2], a117[3]} * T7;
        const f32x4 a122 = *(const LAS f32x4*)(Af + 552);
        r2[24] -= (f32x2v){a118[0], a118[1]} * T7; r2[25] -= (f32x2v){a118[2], a118[3]} * T7;
        const f32x4 a123 = *(const LAS f32x4*)(Af + 556);
        r2[26] -= (f32x2v){a119[0], a119[1]} * T7; r2[27] -= (f32x2v){a119[2], a119[3]} * T7;
        const f32x4 a124 = *(const LAS f32x4*)(Af + 560);
        r2[28] -= (f32x2v){a120[0], a120[1]} * T7; r2[29] -= (f32x2v){a120[2], a120[3]} * T7;
        const f32x4 a125 = *(const LAS f32x4*)(Af + 564);
        r2[30] -= (f32x2v){a121[0], a121[1]} * T7; r2[31] -= (f32x2v){a121[2], a121[3]} * T7;
        const f32x4 a126 = *(const LAS f32x4*)(Af + 568);
        const float t8 = r2[4][0]; const f32x2v T8 = (f32x2v){t8, t8}; Tb[576 + lane] = f2bf(t8);
        r2[4] -= (f32x2v){a122[0], a122[1]} * T8; r2[5] -= (f32x2v){a122[2], a122[3]} * T8;
        const f32x4 a127 = *(const LAS f32x4*)(Af + 572);
        r2[6] -= (f32x2v){a123[0], a123[1]} * T8; r2[7] -= (f32x2v){a123[2], a123[3]} * T8;
        const f32x4 a128 = *(const LAS f32x4*)(Af + 576);
        r2[8] -= (f32x2v){a124[0], a124[1]} * T8; r2[9] -= (f32x2v){a124[2], a124[3]} * T8;
        const f32x4 a129 = *(const LAS f32x4*)(Af + 580);
        r2[10] -= (f32x2v){a125[0], a125[1]} * T8; r2[11] -= (f32x2v){a125[2], a125[3]} * T8;
        const f32x4 a130 = *(const LAS f32x4*)(Af + 584);
        r2[12] -= (f32x2v){a126[0], a126[1]} * T8; r2[13] -= (f32x2v){a126[2], a126[3]} * T8;
        const f32x4 a131 = *(const LAS f32x4*)(Af + 588);
        r2[14] -= (f32x2v){a127[0], a127[1]} * T8; r2[15] -= (f32x2v){a127[2], a127[3]} * T8;
        const f32x4 a132 = *(const LAS f32x4*)(Af + 592);
        r2[16] -= (f32x2v){a128[0], a128[1]} * T8; r2[17] -= (f32x2v){a128[2], a128[3]} * T8;
        const f32x4 a133 = *(const LAS f32x4*)(Af + 596);
        r2[18] -= (f32x2v){a129[0], a129[1]} * T8; r2[19] -= (f32x2v){a129[2], a129[3]} * T8;
        const f32x4 a134 = *(const LAS f32x4*)(Af + 600);
        r2[20] -= (f32x2v){a130[0], a130[1]} * T8; r2[21] -= (f32x2v){a130[2], a130[3]} * T8;
        const f32x4 a135 = *(const LAS f32x4*)(Af + 604);
        r2[22] -= (f32x2v){a131[0], a131[1]} * T8; r2[23] -= (f32x2v){a131[2], a131[3]} * T8;
        const f32x4 a136 = *(const LAS f32x4*)(Af + 620);
        r2[24] -= (f32x2v){a132[0], a132[1]} * T8; r2[25] -= (f32x2v){a132[2], a132[3]} * T8;
        const f32x4 a137 = *(const LAS f32x4*)(Af + 624);
        r2[26] -= (f32x2v){a133[0], a133[1]} * T8; r2[27] -= (f32x2v){a133[2], a133[3]} * T8;
        const f32x4 a138 = *(const LAS f32x4*)(Af + 628);
        r2[28] -= (f32x2v){a134[0], a134[1]} * T8; r2[29] -= (f32x2v){a134[2], a134[3]} * T8;
        const f32x4 a139 = *(const LAS f32x4*)(Af + 632);
        r2[30] -= (f32x2v){a135[0], a135[1]} * T8; r2[31] -= (f32x2v){a135[2], a135[3]} * T8;
        const f32x4 a140 = *(const LAS f32x4*)(Af + 636);
        const float t9 = r2[4][1]; const f32x2v T9 = (f32x2v){t9, t9}; Tb[648 + lane] = f2bf(t9);
        r2[5] -= (f32x2v){a136[2], a136[3]} * T9;
        const f32x4 a141 = *(const LAS f32x4*)(Af + 640);
        r2[6] -= (f32x2v){a137[0], a137[1]} * T9; r2[7] -= (f32x2v){a137[2], a137[3]} * T9;
        const f32x4 a142 = *(const LAS f32x4*)(Af + 644);
        r2[8] -= (f32x2v){a138[0], a138[1]} * T9; r2[9] -= (f32x2v){a138[2], a138[3]} * T9;
        const f32x4 a143 = *(const LAS f32x4*)(Af + 648);
        r2[10] -= (f32x2v){a139[0], a139[1]} * T9; r2[11] -= (f32x2v){a139[2], a139[3]} * T9;
        const f32x4 a144 = *(const LAS f32x4*)(Af + 652);
        r2[12] -= (f32x2v){a140[0], a140[1]} * T9; r2[13] -= (f32x2v){a140[2], a140[3]} * T9;
        const f32x4 a145 = *(const LAS f32x4*)(Af + 656);
        r2[14] -= (f32x2v){a141[0], a141[1]} * T9; r2[15] -= (f32x2v){a141[2], a141[3]} * T9;
        const f32x4 a146 = *(const LAS f32x4*)(Af + 660);
        r2[16] -= (f32x2v){a142[0], a142[1]} * T9; r2[17] -= (f32x2v){a142[2], a142[3]} * T9;
        const f32x4 a147 = *(const LAS f32x4*)(Af + 664);
        r2[18] -= (f32x2v){a143[0], a143[1]} * T9; r2[19] -= (f32x2v){a143[2], a143[3]} * T9;
        const f32x4 a148 = *(const LAS f32x4*)(Af + 668);
        r2[20] -= (f32x2v){a144[0], a144[1]} * T9; r2[21] -= (f32x2v){a144[2], a144[3]} * T9;
        const f32x4 a149 = *(const LAS f32x4*)(Af + 672);
        r2[22] -= (f32x2v){a145[0], a145[1]} * T9; r2[23] -= (f32x2v){a145[2], a145[3]} * T9;
        const f32x4 a150 = *(const LAS f32x4*)(Af + 688);
        r2[24] -= (f32x2v){a146[0], a146[1]} * T9; r2[25] -= (f32x2v){a146[2], a146[3]} * T9;
        const f32x4 a151 = *(const LAS f32x4*)(Af + 692);
        r2[26] -= (f32x2v){a147[0], a147[1]} * T9; r2[27] -= (f32x2v){a147[2], a147[3]} * T9;
        const f32x4 a152 = *(const LAS f32x4*)(Af + 696);
        r2[28] -= (f32x2v){a148[0], a148[1]} * T9; r2[29] -= (f32x2v){a148[2], a148[3]} * T9;
        const f32x4 a153 = *(const LAS f32x4*)(Af + 700);
        r2[30] -= (f32x2v){a149[0], a149[1]} * T9; r2[31] -= (f32x2v){a149[2], a149[3]} * T9;
        const f32x4 a154 = *(const LAS f32x4*)(Af + 704);
        const float t10 = r2[5][0]; const f32x2v T10 = (f32x2v){t10, t10}; Tb[720 + lane] = f2bf(t10);
        r2[5] -= (f32x2v){a150[2], a150[3]} * T10;
        const f32x4 a155 = *(const LAS f32x4*)(Af + 708);
        r2[6] -= (f32x2v){a151[0], a151[1]} * T10; r2[7] -= (f32x2v){a151[2], a151[3]} * T10;
        const f32x4 a156 = *(const LAS f32x4*)(Af + 712);
        r2[8] -= (f32x2v){a152[0], a152[1]} * T10; r2[9] -= (f32x2v){a152[2], a152[3]} * T10;
        const f32x4 a157 = *(const LAS f32x4*)(Af + 716);
        r2[10] -= (f32x2v){a153[0], a153[1]} * T10; r2[11] -= (f32x2v){a153[2], a153[3]} * T10;
        const f32x4 a158 = *(const LAS f32x4*)(Af + 720);
        r2[12] -= (f32x2v){a154[0], a154[1]} * T10; r2[13] -= (f32x2v){a154[2], a154[3]} * T10;
        const f32x4 a159 = *(const LAS f32x4*)(Af + 724);
        r2[14] -= (f32x2v){a155[0], a155[1]} * T10; r2[15] -= (f32x2v){a155[2], a155[3]} * T10;
        const f32x4 a160 = *(const LAS f32x4*)(Af + 728);
        r2[16] -= (f32x2v){a156[0], a156[1]} * T10; r2[17] -= (f32x2v){a156[2], a156[3]} * T10;
        const f32x4 a161 = *(const LAS f32x4*)(Af + 732);
        r2[18] -= (f32x2v){a157[0], a157[1]} * T10; r2[19] -= (f32x2v){a157[2], a157[3]} * T10;
        const f32x4 a162 = *(const LAS f32x4*)(Af + 736);
        r2[20] -= (f32x2v){a158[0], a158[1]} * T10; r2[21] -= (f32x2v){a158[2], a158[3]} * T10;
        const f32x4 a163 = *(const LAS f32x4*)(Af + 740);
        r2[22] -= (f32x2v){a159[0], a159[1]} * T10; r2[23] -= (f32x2v){a159[2], a159[3]} * T10;
        const f32x4 a164 = *(const LAS f32x4*)(Af + 760);
        r2[24] -= (f32x2v){a160[0], a160[1]} * T10; r2[25] -= (f32x2v){a160[2], a160[3]} * T10;
        const f32x4 a165 = *(const LAS f32x4*)(Af + 764);
        r2[26] -= (f32x2v){a161[0], a161[1]} * T10; r2[27] -= (f32x2v){a161[2], a161[3]} * T10;
        const f32x4 a166 = *(const LAS f32x4*)(Af + 768);
        r2[28] -= (f32x2v){a162[0], a162[1]} * T10; r2[29] -= (f32x2v){a162[2], a162[3]} * T10;
        const f32x4 a167 = *(const LAS f32x4*)(Af + 772);
        r2[30] -= (f32x2v){a163[0], a163[1]} * T10; r2[31] -= (f32x2v){a163[2], a163[3]} * T10;
        const f32x4 a168 = *(const LAS f32x4*)(Af + 776);
        const float t11 = r2[5][1]; const f32x2v T11 = (f32x2v){t11, t11}; Tb[792 + lane] = f2bf(t11);
        r2[6] -= (f32x2v){a164[0], a164[1]} * T11; r2[7] -= (f32x2v){a164[2], a164[3]} * T11;
        const f32x4 a169 = *(const LAS f32x4*)(Af + 780);
        r2[8] -= (f32x2v){a165[0], a165[1]} * T11; r2[9] -= (f32x2v){a165[2], a165[3]} * T11;
        const f32x4 a170 = *(const LAS f32x4*)(Af + 784);
        r2[10] -= (f32x2v){a166[0], a166[1]} * T11; r2[11] -= (f32x2v){a166[2], a166[3]} * T11;
        const f32x4 a171 = *(const LAS f32x4*)(Af + 788);
        r2[12] -= (f32x2v){a167[0], a167[1]} * T11; r2[13] -= (f32x2v){a167[2], a167[3]} * T11;
        const f32x4 a172 = *(const LAS f32x4*)(Af + 792);
        r2[14] -= (f32x2v){a168[0], a168[1]} * T11; r2[15] -= (f32x2v){a168[2], a168[3]} * T11;
        const f32x4 a173 = *(const LAS f32x4*)(Af + 796);
        r2[16] -= (f32x2v){a169[0], a169[1]} * T11; r2[17] -= (f32x2v){a169[2], a169[3]} * T11;
        const f32x4 a174 = *(const LAS f32x4*)(Af + 800);
        r2[18] -= (f32x2v){a170[0], a170[1]} * T11; r2[19] -= (f32x2v){a170[2], a170[3]} * T11;
        const f32x4 a175 = *(const LAS f32x4*)(Af + 804);
        r2[20] -= (f32x2v){a171[0], a171[1]} * T11; r2[21] -= (f32x2v){a171[2], a171[3]} * T11;
        const f32x4 a176 = *(const LAS f32x4*)(Af + 808);
        r2[22] -= (f32x2v){a172[0], a172[1]} * T11; r2[23] -= (f32x2v){a172[2], a172[3]} * T11;
        const f32x4 a177 = *(const LAS f32x4*)(Af + 828);
        r2[24] -= (f32x2v){a173[0], a173[1]} * T11; r2[25] -= (f32x2v){a173[2], a173[3]} * T11;
        const f32x4 a178 = *(const LAS f32x4*)(Af + 832);
        r2[26] -= (f32x2v){a174[0], a174[1]} * T11; r2[27] -= (f32x2v){a174[2], a174[3]} * T11;
        const f32x4 a179 = *(const LAS f32x4*)(Af + 836);
        r2[28] -= (f32x2v){a175[0], a175[1]} * T11; r2[29] -= (f32x2v){a175[2], a175[3]} * T11;
        const f32x4 a180 = *(const LAS f32x4*)(Af + 840);
        r2[30] -= (f32x2v){a176[0], a176[1]} * T11; r2[31] -= (f32x2v){a176[2], a176[3]} * T11;
        const f32x4 a181 = *(const LAS f32x4*)(Af + 844);
        const float t12 = r2[6][0]; const f32x2v T12 = (f32x2v){t12, t12}; Tb[864 + lane] = f2bf(t12);
        r2[6] -= (f32x2v){a177[0], a177[1]} * T12; r2[7] -= (f32x2v){a177[2], a177[3]} * T12;
        const f32x4 a182 = *(const LAS f32x4*)(Af + 848);
        r2[8] -= (f32x2v){a178[0], a178[1]} * T12; r2[9] -= (f32x2v){a178[2], a178[3]} * T12;
        const f32x4 a183 = *(const LAS f32x4*)(Af + 852);
        r2[10] -= (f32x2v){a179[0], a179[1]} * T12; r2[11] -= (f32x2v){a179[2], a179[3]} * T12;
        const f32x4 a184 = *(const LAS f32x4*)(Af + 856);
        r2[12] -= (f32x2v){a180[0], a180[1]} * T12; r2[13] -= (f32x2v){a180[2], a180[3]} * T12;
        const f32x4 a185 = *(const LAS f32x4*)(Af + 860);
        r2[14] -= (f32x2v){a181[0], a181[1]} * T12; r2[15] -= (f32x2v){a181[2], a181[3]} * T12;
        const f32x4 a186 = *(const LAS f32x4*)(Af + 864);
        r2[16] -= (f32x2v){a182[0], a182[1]} * T12; r2[17] -= (f32x2v){a182[2], a182[3]} * T12;
        const f32x4 a187 = *(const LAS f32x4*)(Af + 868);
        r2[18] -= (f32x2v){a183[0], a183[1]} * T12; r2[19] -= (f32x2v){a183[2], a183[3]} * T12;
        const f32x4 a188 = *(const LAS f32x4*)(Af + 872);
        r2[20] -= (f32x2v){a184[0], a184[1]} * T12; r2[21] -= (f32x2v){a184[2], a184[3]} * T12;
        const f32x4 a189 = *(const LAS f32x4*)(Af + 876);
        r2[22] -= (f32x2v){a185[0], a185[1]} * T12; r2[23] -= (f32x2v){a185[2], a185[3]} * T12;
        const f32x4 a190 = *(const LAS f32x4*)(Af + 896);
        r2[24] -= (f32x2v){a186[0], a186[1]} * T12; r2[25] -= (f32x2v){a186[2], a186[3]} * T12;
        const f32x4 a191 = *(const LAS f32x4*)(Af + 900);
        r2[26] -= (f32x2v){a187[0], a187[1]} * T12; r2[27] -= (f32x2v){a187[2], a187[3]} * T12;
        const f32x4 a192 = *(const LAS f32x4*)(Af + 904);
        r2[28] -= (f32x2v){a188[0], a188[1]} * T12; r2[29] -= (f32x2v){a188[2], a188[3]} * T12;
        const f32x4 a193 = *(const LAS f32x4*)(Af + 908);
        r2[30] -= (f32x2v){a189[0], a189[1]} * T12; r2[31] -= (f32x2v){a189[2], a189[3]} * T12;
        const f32x4 a194 = *(const LAS f32x4*)(Af + 912);
        const float t13 = r2[6][1]; const f32x2v T13 = (f32x2v){t13, t13}; Tb[936 + lane] = f2bf(t13);
        r2[7] -= (f32x2v){a190[2], a190[3]} * T13;
        const f32x4 a195 = *(const LAS f32x4*)(Af + 916);
        r2[8] -= (f32x2v){a191[0], a191[1]} * T13; r2[9] -= (f32x2v){a191[2], a191[3]} * T13;
        const f32x4 a196 = *(const LAS f32x4*)(Af + 920);
        r2[10] -= (f32x2v){a192[0], a192[1]} * T13; r2[11] -= (f32x2v){a192[2], a192[3]} * T13;
        const f32x4 a197 = *(const LAS f32x4*)(Af + 924);
        r2[12] -= (f32x2v){a193[0], a193[1]} * T13; r2[13] -= (f32x2v){a193[2], a193[3]} * T13;
        const f32x4 a198 = *(const LAS f32x4*)(Af + 928);
        r2[14] -= (f32x2v){a194[0], a194[1]} * T13; r2[15] -= (f32x2v){a194[2], a194[3]} * T13;
        const f32x4 a199 = *(const LAS f32x4*)(Af + 932);
        r2[16] -= (f32x2v){a195[0], a195[1]} * T13; r2[17] -= (f32x2v){a195[2], a195[3]} * T13;
        const f32x4 a200 = *(const LAS f32x4*)(Af + 936);
        r2[18] -= (f32x2v){a196[0], a196[1]} * T13; r2[19] -= (f32x2v){a196[2], a196[3]} * T13;
        const f32x4 a201 = *(const LAS f32x4*)(Af + 940);
        r2[20] -= (f32x2v){a197[0], a197[1]} * T13; r2[21] -= (f32x2v){a197[2], a197[3]} * T13;
        const f32x4 a202 = *(const LAS f32x4*)(Af + 944);
        r2[22] -= (f32x2v){a198[0], a198[1]} * T13; r2[23] -= (f32x2v){a198[2], a198[3]} * T13;
        const f32x4 a203 = *(const LAS f32x4*)(Af + 964);
        r2[24] -= (f32x2v){a199[0], a199[1]} * T13; r2[25] -= (f32x2v){a199[2], a199[3]} * T13;
        const f32x4 a204 = *(const LAS f32x4*)(Af + 968);
        r2[26] -= (f32x2v){a200[0], a200[1]} * T13; r2[27] -= (f32x2v){a200[2], a200[3]} * T13;
        const f32x4 a205 = *(const LAS f32x4*)(Af + 972);
        r2[28] -= (f32x2v){a201[0], a201[1]} * T13; r2[29] -= (f32x2v){a201[2], a201[3]} * T13;
        const f32x4 a206 = *(const LAS f32x4*)(Af + 976);
        r2[30] -= (f32x2v){a202[0], a202[1]} * T13; r2[31] -= (f32x2v){a202[2], a202[3]} * T13;
        const f32x4 a207 = *(const LAS f32x4*)(Af + 980);
        const float t14 = r2[7][0]; const f32x2v T14 = (f32x2v){t14, t14}; Tb[1008 + lane] = f2bf(t14);
        r2[7] -= (f32x2v){a203[2], a203[3]} * T14;
        const f32x4 a208 = *(const LAS f32x4*)(Af + 984);
        r2[8] -= (f32x2v){a204[0], a204[1]} * T14; r2[9] -= (f32x2v){a204[2], a204[3]} * T14;
        const f32x4 a209 = *(const LAS f32x4*)(Af + 988);
        r2[10] -= (f32x2v){a205[0], a205[1]} * T14; r2[11] -= (f32x2v){a205[2], a205[3]} * T14;
        const f32x4 a210 = *(const LAS f32x4*)(Af + 992);
        r2[12] -= (f32x2v){a206[0], a206[1]} * T14; r2[13] -= (f32x2v){a206[2], a206[3]} * T14;
        const f32x4 a211 = *(const LAS f32x4*)(Af + 996);
        r2[14] -= (f32x2v){a207[0], a207[1]} * T14; r2[15] -= (f32x2v){a207[2], a207[3]} * T14;
        const f32x4 a212 = *(const LAS f32x4*)(Af + 1000);
        r2[16] -= (f32x2v){a208[0], a208[1]} * T14; r2[17] -= (f32x2v){a208[2], a208[3]} * T14;
        const f32x4 a213 = *(const LAS f32x4*)(Af + 1004);
        r2[18] -= (f32x2v){a209[0], a209[1]} * T14; r2[19] -= (f32x2v){a209[2], a209[3]} * T14;
        const f32x4 a214 = *(const LAS f32x4*)(Af + 1008);
        r2[20] -= (f32x2v){a210[0], a210[1]} * T14; r2[21] -= (f32x2v){a210[2], a210[3]} * T14;
        const f32x4 a215 = *(const LAS f32x4*)(Af + 1012);
        r2[22] -= (f32x2v){a211[0], a211[1]} * T14; r2[23] -= (f32x2v){a211[2], a211[3]} * T14;
        const f32x4 a216 = *(const LAS f32x4*)(Af + 1036);
        r2[24] -= (f32x2v){a212[0], a212[1]} * T14; r2[25] -= (f32x2v){a212[2], a212[3]} * T14;
        const f32x4 a217 = *(const LAS f32x4*)(Af + 1040);
        r2[26] -= (f32x2v){a213[0], a213[1]} * T14; r2[27] -= (f32x2v){a213[2], a213[3]} * T14;
        const f32x4 a218 = *(const LAS f32x4*)(Af + 1044);
        r2[28] -= (f32x2v){a214[0], a214[1]} * T14; r2[29] -= (f32x2v){a214[2], a214[3]} * T14;
        const f32x4 a219 = *(const LAS f32x4*)(Af + 1048);
        r2[30] -= (f32x2v){a215[0], a215[1]} * T14; r2[31] -= (f32x2v){a215[2], a215[3]} * T14;
        const f32x4 a220 = *(const LAS f32x4*)(Af + 1052);
        const float t15 = r2[7][1]; const f32x2v T15 = (f32x2v){t15, t15}; Tb[1080 + lane] = f2bf(t15);
        r2[8] -= (f32x2v){a216[0], a216[1]} * T15; r2[9] -= (f32x2v){a216[2], a216[3]} * T15;
        const f32x4 a221 = *(const LAS f32x4*)(Af + 1056);
        r2[10] -= (f32x2v){a217[0], a217[1]} * T15; r2[11] -= (f32x2v){a217[2], a217[3]} * T15;
        const f32x4 a222 = *(const LAS f32x4*)(Af + 1060);
        r2[12] -= (f32x2v){a218[0], a218[1]} * T15; r2[13] -= (f32x2v){a218[2], a218[3]} * T15;
        const f32x4 a223 = *(const LAS f32x4*)(Af + 1064);
        r2[14] -= (f32x2v){a219[0], a219[1]} * T15; r2[15] -= (f32x2v){a219[2], a219[3]} * T15;
        const f32x4 a224 = *(const LAS f32x4*)(Af + 1068);
        r2[16] -= (f32x2v){a220[0], a220[1]} * T15; r2[17] -= (f32x2v){a220[2], a220[3]} * T15;
        const f32x4 a225 = *(const LAS f32x4*)(Af + 1072);
        r2[18] -= (f32x2v){a221[0], a221[1]} * T15; r2[19] -= (f32x2v){a221[2], a221[3]} * T15;
        const f32x4 a226 = *(const LAS f32x4*)(Af + 1076);
        r2[20] -= (f32x2v){a222[0], a222[1]} * T15; r2[21] -= (f32x2v){a222[2], a222[3]} * T15;
        const f32x4 a227 = *(const LAS f32x4*)(Af + 1080);
        r2[22] -= (f32x2v){a223[0], a223[1]} * T15; r2[23] -= (f32x2v){a223[2], a223[3]} * T15;
        const f32x4 a228 = *(const LAS f32x4*)(Af + 1104);
        r2[24] -= (f32x2v){a224[0], a224[1]} * T15; r2[25] -= (f32x2v){a224[2], a224[3]} * T15;
        const f32x4 a229 = *(const LAS f32x4*)(Af + 1108);
        r2[26] -= (f32x2v){a225[0], a225[1]} * T15; r2[27] -= (f32x2v){a225[2], a225[3]} * T15;
        const f32x4 a230 = *(const LAS f32x4*)(Af + 1112);
        r2[28] -= (f32x2v){a226[0], a226[1]} * T15; r2[29] -= (f32x2v){a226[2], a226[3]} * T15;
        const f32x4 a231 = *(const LAS f32x4*)(Af + 1116);
        r2[30] -= (f32x2v){a227[0], a227[1]} * T15; r2[31] -= (f32x2v){a227[2], a227[3]} * T15;
        const f32x4 a232 = *(const LAS f32x4*)(Af + 1120);
        const float t16 = r2[8][0]; const f32x2v T16 = (f32x2v){t16, t16}; Tb[1152 + lane] = f2bf(t16);
        r2[8] -= (f32x2v){a228[0], a228[1]} * T16; r2[9] -= (f32x2v){a228[2], a228[3]} * T16;
        const f32x4 a233 = *(const LAS f32x4*)(Af + 1124);
        r2[10] -= (f32x2v){a229[0], a229[1]} * T16; r2[11] -= (f32x2v){a229[2], a229[3]} * T16;
        const f32x4 a234 = *(const LAS f32x4*)(Af + 1128);
        r2[12] -= (f32x2v){a230[0], a230[1]} * T16; r2[13] -= (f32x2v){a230[2], a230[3]} * T16;
        const f32x4 a235 = *(const LAS f32x4*)(Af + 1132);
        r2[14] -= (f32x2v){a231[0], a231[1]} * T16; r2[15] -= (f32x2v){a231[2], a231[3]} * T16;
        const f32x4 a236 = *(const LAS f32x4*)(Af + 1136);
        r2[16] -= (f32x2v){a232[0], a232[1]} * T16; r2[17] -= (f32x2v){a232[2], a232[3]} * T16;
        const f32x4 a237 = *(const LAS f32x4*)(Af + 1140);
        r2[18] -= (f32x2v){a233[0], a233[1]} * T16; r2[19] -= (f32x2v){a233[2], a233[3]} * T16;
        const f32x4 a238 = *(const LAS f32x4*)(Af + 1144);
        r2[20] -= (f32x2v){a234[0], a234[1]} * T16; r2[21] -= (f32x2v){a234[2], a234[3]} * T16;
        const f32x4 a239 = *(const LAS f32x4*)(Af + 1148);
        r2[22] -= (f32x2v){a235[0], a235[1]} * T16; r2[23] -= (f32x2v){a235[2], a235[3]} * T16;
        const f32x4 a240 = *(const LAS f32x4*)(Af + 1172);
        r2[24] -= (f32x2v){a236[0], a236[1]} * T16; r2[25] -= (f32x2v){a236[2], a236[3]} * T16;
        const f32x4 a241 = *(const LAS f32x4*)(Af + 1176);
        r2[26] -= (f32x2v){a237[0], a237[1]} * T16; r2[27] -= (f32x2v){a237[2], a237[3]} * T16;
        const f32x4 a242 = *(const LAS f32x4*)(Af + 1180);
        r2[28] -= (f32x2v){a238[0], a238[1]} * T16; r2[29] -= (f32x2v){a238[2], a238[3]} * T16;
        const f32x4 a243 = *(const LAS f32x4*)(Af + 1184);
        r2[30] -= (f32x2v){a239[0], a239[1]} * T16; r2[31] -= (f32x2v){a239[2], a239[3]} * T16;
        const f32x4 a244 = *(const LAS f32x4*)(Af + 1188);
        const float t17 = r2[8][1]; const f32x2v T17 = (f32x2v){t17, t17}; Tb[1224 + lane] = f2bf(t17);
        r2[9] -= (f32x2v){a240[2], a240[3]} * T17;
        const f32x4 a245 = *(const LAS f32x4*)(Af + 1192);
        r2[10] -= (f32x2v){a241[0], a241[1]} * T17; r2[11] -= (f32x2v){a241[2], a241[3]} * T17;
        const f32x4 a246 = *(const LAS f32x4*)(Af + 1196);
        r2[12] -= (f32x2v){a242[0], a242[1]} * T17; r2[13] -= (f32x2v){a242[2], a242[3]} * T17;
        const f32x4 a247 = *(const LAS f32x4*)(Af + 1200);
        r2[14] -= (f32x2v){a243[0], a243[1]} * T17; r2[15] -= (f32x2v){a243[2], a243[3]} * T17;
        const f32x4 a248 = *(const LAS f32x4*)(Af + 1204);
        r2[16] -= (f32x2v){a244[0], a244[1]} * T17; r2[17] -= (f32x2v){a244[2], a244[3]} * T17;
        const f32x4 a249 = *(const LAS f32x4*)(Af + 1208);
        r2[18] -= (f32x2v){a245[0], a245[1]} * T17; r2[19] -= (f32x2v){a245[2], a245[3]} * T17;
        const f32x4 a250 = *(const LAS f32x4*)(Af + 1212);
        r2[20] -= (f32x2v){a246[0], a246[1]} * T17; r2[21] -= (f32x2v){a246[2], a246[3]} * T17;
        const f32x4 a251 = *(const LAS f32x4*)(Af + 1216);
        r2[22] -= (f32x2v){a247[0], a247[1]} * T17; r2[23] -= (f32x2v){a247[2], a247[3]} * T17;
        const f32x4 a252 = *(const LAS f32x4*)(Af + 1240);
        r2[24] -= (f32x2v){a248[0], a248[1]} * T17; r2[25] -= (f32x2v){a248[2], a248[3]} * T17;
        const f32x4 a253 = *(const LAS f32x4*)(Af + 1244);
        r2[26] -= (f32x2v){a249[0], a249[1]} * T17; r2[27] -= (f32x2v){a249[2], a249[3]} * T17;
        const f32x4 a254 = *(const LAS f32x4*)(Af + 1248);
        r2[28] -= (f32x2v){a250[0], a250[1]} * T17; r2[29] -= (f32x2v){a250[2], a250[3]} * T17;
        const f32x4 a255 = *(const LAS f32x4*)(Af + 1252);
        r2[30] -= (f32x2v){a251[0], a251[1]} * T17; r2[31] -= (f32x2v){a251[2], a251[3]} * T17;
        const f32x4 a256 = *(const LAS f32x4*)(Af + 1256);
        const float t18 = r2[9][0]; const f32x2v T18 = (f32x2v){t18, t18}; Tb[1296 + lane] = f2bf(t18);
        r2[9] -= (f32x2v){a252[2], a252[3]} * T18;
        const f32x4 a257 = *(const LAS f32x4*)(Af + 1260);
        r2[10] -= (f32x2v){a253[0], a253[1]} * T18; r2[11] -= (f32x2v){a253[2], a253[3]} * T18;
        const f32x4 a258 = *(const LAS f32x4*)(Af + 1264);
        r2[12] -= (f32x2v){a254[0], a254[1]} * T18; r2[13] -= (f32x2v){a254[2], a254[3]} * T18;
        const f32x4 a259 = *(const LAS f32x4*)(Af + 1268);
        r2[14] -= (f32x2v){a255[0], a255[1]} * T18; r2[15] -= (f32x2v){a255[2], a255[3]} * T18;
        const f32x4 a260 = *(const LAS f32x4*)(Af + 1272);
        r2[16] -= (f32x2v){a256[0], a256[1]} * T18; r2[17] -= (f32x2v){a256[2], a256[3]} * T18;
        const f32x4 a261 = *(const LAS f32x4*)(Af + 1276);
        r2[18] -= (f32x2v){a257[0], a257[1]} * T18; r2[19] -= (f32x2v){a257[2], a257[3]} * T18;
        const f32x4 a262 = *(const LAS f32x4*)(Af + 1280);
        r2[20] -= (f32x2v){a258[0], a258[1]} * T18; r2[21] -= (f32x2v){a258[2], a258[3]} * T18;
        const f32x4 a263 = *(const LAS f32x4*)(Af + 1284);
        r2[22] -= (f32x2v){a259[0], a259[1]} * T18; r2[23] -= (f32x2v){a259[2], a259[3]} * T18;
        const f32x4 a264 = *(const LAS f32x4*)(Af + 1312);
        r2[24] -= (f32x2v){a260[0], a260[1]} * T18; r2[25] -= (f32x2v){a260[2], a260[3]} * T18;
        const f32x4 a265 = *(const LAS f32x4*)(Af + 1316);
        r2[26] -= (f32x2v){a261[0], a261[1]} * T18; r2[27] -= (f32x2v){a261[2], a261[3]} * T18;
        const f32x4 a266 = *(const LAS f32x4*)(Af + 1320);
        r2[28] -= (f32x2v){a262[0], a262[1]} * T18; r2[29] -= (f32x2v){a262[2], a262[3]} * T18;
        const f32x4 a267 = *(const LAS f32x4*)(Af + 1324);
        r2[30] -= (f32x2v){a263[0], a263[1]} * T18; r2[31] -= (f32x2v){a263[2], a263[3]} * T18;
        const f32x4 a268 = *(const LAS f32x4*)(Af + 1328);
        const float t19 = r2[9][1]; const f32x2v T19 = (f32x2v){t19, t19}; Tb[1368 + lane] = f2bf(t19);
        r2[10] -= (f32x2v){a264[0], a264[1]} * T19; r2[11] -= (f32x2v){a264[2], a264[3]} * T19;
        const f32x4 a269 = *(const LAS f32x4*)(Af + 1332);
        r2[12] -= (f32x2v){a265[0], a265[1]} * T19; r2[13] -= (f32x2v){a265[2], a265[3]} * T19;
        const f32x4 a270 = *(const LAS f32x4*)(Af + 1336);
        r2[14] -= (f32x2v){a266[0], a266[1]} * T19; r2[15] -= (f32x2v){a266[2], a266[3]} * T19;
        const f32x4 a271 = *(const LAS f32x4*)(Af + 1340);
        r2[16] -= (f32x2v){a267[0], a267[1]} * T19; r2[17] -= (f32x2v){a267[2], a267[3]} * T19;
        const f32x4 a272 = *(const LAS f32x4*)(Af + 1344);
        r2[18] -= (f32x2v){a268[0], a268[1]} * T19; r2[19] -= (f32x2v){a268[2], a268[3]} * T19;
        const f32x4 a273 = *(const LAS f32x4*)(Af + 1348);
        r2[20] -= (f32x2v){a269[0], a269[1]} * T19; r2[21] -= (f32x2v){a269[2], a269[3]} * T19;
        const f32x4 a274 = *(const LAS f32x4*)(Af + 1352);
        r2[22] -= (f32x2v){a270[0], a270[1]} * T19; r2[23] -= (f32x2v){a270[2], a270[3]} * T19;
        const f32x4 a275 = *(const LAS f32x4*)(Af + 1380);
        r2[24] -= (f32x2v){a271[0], a271[1]} * T19; r2[25] -= (f32x2v){a271[2], a271[3]} * T19;
        const f32x4 a276 = *(const LAS f32x4*)(Af + 1384);
        r2[26] -= (f32x2v){a272[0], a272[1]} * T19; r2[27] -= (f32x2v){a272[2], a272[3]} * T19;
        const f32x4 a277 = *(const LAS f32x4*)(Af + 1388);
        r2[28] -= (f32x2v){a273[0], a273[1]} * T19; r2[29] -= (f32x2v){a273[2], a273[3]} * T19;
        const f32x4 a278 = *(const LAS f32x4*)(Af + 1392);
        r2[30] -= (f32x2v){a274[0], a274[1]} * T19; r2[31] -= (f32x2v){a274[2], a274[3]} * T19;
        const f32x4 a279 = *(const LAS f32x4*)(Af + 1396);
        const float t20 = r2[10][0]; const f32x2v T20 = (f32x2v){t20, t20}; Tb[1440 + lane] = f2bf(t20);
        r2[10] -= (f32x2v){a275[0], a275[1]} * T20; r2[11] -= (f32x2v){a275[2], a275[3]} * T20;
        const f32x4 a280 = *(const LAS f32x4*)(Af + 1400);
        r2[12] -= (f32x2v){a276[0], a276[1]} * T20; r2[13] -= (f32x2v){a276[2], a276[3]} * T20;
        const f32x4 a281 = *(const LAS f32x4*)(Af + 1404);
        r2[14] -= (f32x2v){a277[0], a277[1]} * T20; r2[15] -= (f32x2v){a277[2], a277[3]} * T20;
        const f32x4 a282 = *(const LAS f32x4*)(Af + 1408);
        r2[16] -= (f32x2v){a278[0], a278[1]} * T20; r2[17] -= (f32x2v){a278[2], a278[3]} * T20;
        const f32x4 a283 = *(const LAS f32x4*)(Af + 1412);
        r2[18] -= (f32x2v){a279[0], a279[1]} * T20; r2[19] -= (f32x2v){a279[2], a279[3]} * T20;
        const f32x4 a284 = *(const LAS f32x4*)(Af + 1416);
        r2[20] -= (f32x2v){a280[0], a280[1]} * T20; r2[21] -= (f32x2v){a280[2], a280[3]} * T20;
        const f32x4 a285 = *(const LAS f32x4*)(Af + 1420);
        r2[22] -= (f32x2v){a281[0], a281[1]} * T20; r2[23] -= (f32x2v){a281[2], a281[3]} * T20;
        const f32x4 a286 = *(const LAS f32x4*)(Af + 1448);
        r2[24] -= (f32x2v){a282[0], a282[1]} * T20; r2[25] -= (f32x2v){a282[2], a282[3]} * T20;
        const f32x4 a287 = *(const LAS f32x4*)(Af + 1452);
        r2[26] -= (f32x2v){a283[0], a283[1]} * T20; r2[27] -= (f32x2v){a283[2], a283[3]} * T20;
        const f32x4 a288 = *(const LAS f32x4*)(Af + 1456);
        r2[28] -= (f32x2v){a284[0], a284[1]} * T20; r2[29] -= (f32x2v){a284[2], a284[3]} * T20;
        const f32x4 a289 = *(const LAS f32x4*)(Af + 1460);
        r2[30] -= (f32x2v){a285[0], a285[1]} * T20; r2[31] -= (f32x2v){a285[2], a285[3]} * T20;
        const f32x4 a290 = *(const LAS f32x4*)(Af + 1464);
        const float t21 = r2[10][1]; const f32x2v T21 = (f32x2v){t21, t21}; Tb[1512 + lane] = f2bf(t21);
        r2[11] -= (f32x2v){a286[2], a286[3]} * T21;
        const f32x4 a291 = *(const LAS f32x4*)(Af + 1468);
        r2[12] -= (f32x2v){a287[0], a287[1]} * T21; r2[13] -= (f32x2v){a287[2], a287[3]} * T21;
        const f32x4 a292 = *(const LAS f32x4*)(Af + 1472);
        r2[14] -= (f32x2v){a288[0], a288[1]} * T21; r2[15] -= (f32x2v){a288[2], a288[3]} * T21;
        const f32x4 a293 = *(const LAS f32x4*)(Af + 1476);
        r2[16] -= (f32x2v){a289[0], a289[1]} * T21; r2[17] -= (f32x2v){a289[2], a289[3]} * T21;
        const f32x4 a294 = *(const LAS f32x4*)(Af + 1480);
        r2[18] -= (f32x2v){a290[0], a290[1]} * T21; r2[19] -= (f32x2v){a290[2], a290[3]} * T21;
        const f32x4 a295 = *(const LAS f32x4*)(Af + 1484);
        r2[20] -= (f32x2v){a291[0], a291[1]} * T21; r2[21] -= (f32x2v){a291[2], a291[3]} * T21;
        const f32x4 a296 = *(const LAS f32x4*)(Af + 1488);
        r2[22] -= (f32x2v){a292[0], a292[1]} * T21; r2[23] -= (f32x2v){a292[2], a292[3]} * T21;
        const f32x4 a297 = *(const LAS f32x4*)(Af + 1516);
        r2[24] -= (f32x2v){a293[0], a293[1]} * T21; r2[25] -= (f32x2v){a293[2], a293[3]} * T21;
        const f32x4 a298 = *(const LAS f32x4*)(Af + 1520);
        r2[26] -= (f32x2v){a294[0], a294[1]} * T21; r2[27] -= (f32x2v){a294[2], a294[3]} * T21;
        const f32x4 a299 = *(const LAS f32x4*)(Af + 1524);
        r2[28] -= (f32x2v){a295[0], a295[1]} * T21; r2[29] -= (f32x2v){a295[2], a295[3]} * T21;
        const f32x4 a300 = *(const LAS f32x4*)(Af + 1528);
        r2[30] -= (f32x2v){a296[0], a296[1]} * T21; r2[31] -= (f32x2v){a296[2], a296[3]} * T21;
        const f32x4 a301 = *(const LAS f32x4*)(Af + 1532);
        const float t22 = r2[11][0]; const f32x2v T22 = (f32x2v){t22, t22}; Tb[1584 + lane] = f2bf(t22);
        r2[11] -= (f32x2v){a297[2], a297[3]} * T22;
        const f32x4 a302 = *(const LAS f32x4*)(Af + 1536);
        r2[12] -= (f32x2v){a298[0], a298[1]} * T22; r2[13] -= (f32x2v){a298[2], a298[3]} * T22;
        const f32x4 a303 = *(const LAS f32x4*)(Af + 1540);
        r2[14] -= (f32x2v){a299[0], a299[1]} * T22; r2[15] -= (f32x2v){a299[2], a299[3]} * T22;
        const f32x4 a304 = *(const LAS f32x4*)(Af + 1544);
        r2[16] -= (f32x2v){a300[0], a300[1]} * T22; r2[17] -= (f32x2v){a300[2], a300[3]} * T22;
        const f32x4 a305 = *(const LAS f32x4*)(Af + 1548);
        r2[18] -= (f32x2v){a301[0], a301[1]} * T22; r2[19] -= (f32x2v){a301[2], a301[3]} * T22;
        const f32x4 a306 = *(const LAS f32x4*)(Af + 1552);
        r2[20] -= (f32x2v){a302[0], a302[1]} * T22; r2[21] -= (f32x2v){a302[2], a302[3]} * T22;
        const f32x4 a307 = *(const LAS f32x4*)(Af + 1556);
        r2[22] -= (f32x2v){a303[0], a303[1]} * T22; r2[23] -= (f32x2v){a303[2], a303[3]} * T22;
        const f32x4 a308 = *(const LAS f32x4*)(Af + 1588);
        r2[24] -= (f32x2v){a304[0], a304[1]} * T22; r2[25] -= (f32x2v){a304[2], a304[3]} * T22;
        const f32x4 a309 = *(const LAS f32x4*)(Af + 1592);
        r2[26] -= (f32x2v){a305[0], a305[1]} * T22; r2[27] -= (f32x2v){a305[2], a305[3]} * T22;
        const f32x4 a310 = *(const LAS f32x4*)(Af + 1596);
        r2[28] -= (f32x2v){a306[0], a306[1]} * T22; r2[29] -= (f32x2v){a306[2], a306[3]} * T22;
        const f32x4 a311 = *(const LAS f32x4*)(Af + 1600);
        r2[30] -= (f32x2v){a307[0], a307[1]} * T22; r2[31] -= (f32x2v){a307[2], a307[3]} * T22;
        const f32x4 a312 = *(const LAS f32x4*)(Af + 1604);
        const float t23 = r2[11][1]; const f32x2v T23 = (f32x2v){t23, t23}; Tb[1656 + lane] = f2bf(t23);
        r2[12] -= (f32x2v){a308[0], a308[1]} * T23; r2[13] -= (f32x2v){a308[2], a308[3]} * T23;
        const f32x4 a313 = *(const LAS f32x4*)(Af + 1608);
        r2[14] -= (f32x2v){a309[0], a309[1]} * T23; r2[15] -= (f32x2v){a309[2], a309[3]} * T23;
        const f32x4 a314 = *(const LAS f32x4*)(Af + 1612);
        r2[16] -= (f32x2v){a310[0], a310[1]} * T23; r2[17] -= (f32x2v){a310[2], a310[3]} * T23;
        const f32x4 a315 = *(const LAS f32x4*)(Af + 1616);
        r2[18] -= (f32x2v){a311[0], a311[1]} * T23; r2[19] -= (f32x2v){a311[2], a311[3]} * T23;
        const f32x4 a316 = *(const LAS f32x4*)(Af + 1620);
        r2[20] -= (f32x2v){a312[0], a312[1]} * T23; r2[21] -= (f32x2v){a312[2], a312[3]} * T23;
        const f32x4 a317 = *(const LAS f32x4*)(Af + 1624);
        r2[22] -= (f32x2v){a313[0], a313[1]} * T23; r2[23] -= (f32x2v){a313[2], a313[3]} * T23;
        const f32x4 a318 = *(const LAS f32x4*)(Af + 1656);
        r2[24] -= (f32x2v){a314[0], a314[1]} * T23; r2[25] -= (f32x2v){a314[2], a314[3]} * T23;
        const f32x4 a319 = *(const LAS f32x4*)(Af + 1660);
        r2[26] -= (f32x2v){a315[0], a315[1]} * T23; r2[27] -= (f32x2v){a315[2], a315[3]} * T23;
        const f32x4 a320 = *(const LAS f32x4*)(Af + 1664);
        r2[28] -= (f32x2v){a316[0], a316[1]} * T23; r2[29] -= (f32x2v){a316[2], a316[3]} * T23;
        const f32x4 a321 = *(const LAS f32x4*)(Af + 1668);
        r2[30] -= (f32x2v){a317[0], a317[1]} * T23; r2[31] -= (f32x2v){a317[2], a317[3]} * T23;
        const f32x4 a322 = *(const LAS f32x4*)(Af + 1672);
        const float t24 = r2[12][0]; const f32x2v T24 = (f32x2v){t24, t24}; Tb[1728 + lane] = f2bf(t24);
        r2[12] -= (f32x2v){a318[0], a318[1]} * T24; r2[13] -= (f32x2v){a318[2], a318[3]} * T24;
        const f32x4 a323 = *(const LAS f32x4*)(Af + 1676);
        r2[14] -= (f32x2v){a319[0], a319[1]} * T24; r2[15] -= (f32x2v){a319[2], a319[3]} * T24;
        const f32x4 a324 = *(const LAS f32x4*)(Af + 1680);
        r2[16] -= (f32x2v){a320[0], a320[1]} * T24; r2[17] -= (f32x2v){a320[2], a320[3]} * T24;
        const f32x4 a325 = *(const LAS f32x4*)(Af + 1684);
        r2[18] -= (f32x2v){a321[0], a321[1]} * T24; r2[19] -= (f32x2v){a321[2], a321[3]} * T24;
        const f32x4 a326 = *(const LAS f32x4*)(Af + 1688);
        r2[20] -= (f32x2v){a322[0], a322[1]} * T24; r2[21] -= (f32x2v){a322[2], a322[3]} * T24;
        const f32x4 a327 = *(const LAS f32x4*)(Af + 1692);
        r2[22] -= (f32x2v){a323[0], a323[1]} * T24; r2[23] -= (f32x2v){a323[2], a323[3]} * T24;
        const f32x4 a328 = *(const LAS f32x4*)(Af + 1724);
        r2[24] -= (f32x2v){a324[0], a324[1]} * T24; r2[25] -= (f32x2v){a324[2], a324[3]} * T24;
        const f32x4 a329 = *(const LAS f32x4*)(Af + 1728);
        r2[26] -= (f32x2v){a325[0], a325[1]} * T24; r2[27] -= (f32x2v){a325[2], a325[3]} * T24;
        const f32x4 a330 = *(const LAS f32x4*)(Af + 1732);
        r2[28] -= (f32x2v){a326[0], a326[1]} * T24; r2[29] -= (f32x2v){a326[2], a326[3]} * T24;
        const f32x4 a331 = *(const LAS f32x4*)(Af + 1736);
        r2[30] -= (f32x2v){a327[0], a327[1]} * T24; r2[31] -= (f32x2v){a327[2], a327[3]} * T24;
        const f32x4 a332 = *(const LAS f32x4*)(Af + 1740);
        const float t25 = r2[12][1]; const f32x2v T25 = (f32x2v){t25, t25}; Tb[1800 + lane] = f2bf(t25);
        r2[13] -= (f32x2v){a328[2], a328[3]} * T25;
        const f32x4 a333 = *(const LAS f32x4*)(Af + 1744);
        r2[14] -= (f32x2v){a329[0], a329[1]} * T25; r2[15] -= (f32x2v){a329[2], a329[3]} * T25;
        const f32x4 a334 = *(const LAS f32x4*)(Af + 1748);
        r2[16] -= (f32x2v){a330[0], a330[1]} * T25; r2[17] -= (f32x2v){a330[2], a330[3]} * T25;
        const f32x4 a335 = *(const LAS f32x4*)(Af + 1752);
        r2[18] -= (f32x2v){a331[0], a331[1]} * T25; r2[19] -= (f32x2v){a331[2], a331[3]} * T25;
        const f32x4 a336 = *(const LAS f32x4*)(Af + 1756);
        r2[20] -= (f32x2v){a332[0], a332[1]} * T25; r2[21] -= (f32x2v){a332[2], a332[3]} * T25;
        const f32x4 a337 = *(const LAS f32x4*)(Af + 1760);
        r2[22] -= (f32x2v){a333[0], a333[1]} * T25; r2[23] -= (f32x2v){a333[2], a333[3]} * T25;
        const f32x4 a338 = *(const LAS f32x4*)(Af + 1792);
        r2[24] -= (f32x2v){a334[0], a334[1]} * T25; r2[25] -= (f32x2v){a334[2], a334[3]} * T25;
        const f32x4 a339 = *(const LAS f32x4*)(Af + 1796);
        r2[26] -= (f32x2v){a335[0], a335[1]} * T25; r2[27] -= (f32x2v){a335[2], a335[3]} * T25;
        const f32x4 a340 = *(const LAS f32x4*)(Af + 1800);
        r2[28] -= (f32x2v){a336[0], a336[1]} * T25; r2[29] -= (f32x2v){a336[2], a336[3]} * T25;
        const f32x4 a341 = *(const LAS f32x4*)(Af + 1804);
        r2[30] -= (f32x2v){a337[0], a337[1]} * T25; r2[31] -= (f32x2v){a337[2], a337[3]} * T25;
        const f32x4 a342 = *(const LAS f32x4*)(Af + 1808);
        const float t26 = r2[13][0]; const f32x2v T26 = (f32x2v){t26, t26}; Tb[1872 + lane] = f2bf(t26);
        r2[13] -= (f32x2v){a338[2], a338[3]} * T26;
        const f32x4 a343 = *(const LAS f32x4*)(Af + 1812);
        r2[14] -= (f32x2v){a339[0], a339[1]} * T26; r2[15] -= (f32x2v){a339[2], a339[3]} * T26;
        const f32x4 a344 = *(const LAS f32x4*)(Af + 1816);
        r2[16] -= (f32x2v){a340[0], a340[1]} * T26; r2[17] -= (f32x2v){a340[2], a340[3]} * T26;
        const f32x4 a345 = *(const LAS f32x4*)(Af + 1820);
        r2[18] -= (f32x2v){a341[0], a341[1]} * T26; r2[19] -= (f32x2v){a341[2], a341[3]} * T26;
        const f32x4 a346 = *(const LAS f32x4*)(Af + 1824);
        r2[20] -= (f32x2v){a342[0], a342[1]} * T26; r2[21] -= (f32x2v){a342[2], a342[3]} * T26;
        const f32x4 a347 = *(const LAS f32x4*)(Af + 1828);
        r2[22] -= (f32x2v){a343[0], a343[1]} * T26; r2[23] -= (f32x2v){a343[2], a343[3]} * T26;
        const f32x4 a348 = *(const LAS f32x4*)(Af + 1864);
        r2[24] -= (f32x2v){a344[0], a344[1]} * T26; r2[25] -= (f32x2v){a344[2], a344[3]} * T26;
        const f32x4 a349 = *(const LAS f32x4*)(Af + 1868);
        r2[26] -= (f32x2v){a345[0], a345[1]} * T26; r2[27] -= (f32x2v){a345[2], a345[3]} * T26;
        const f32x4 a350 = *(const LAS f32x4*)(Af + 1872);
        r2[28] -= (f32x2v){a346[0], a346[1]} * T26; r2[29] -= (f32x2v){a346[2], a346[3]} * T26;
        const f32x4 a351 = *(const LAS f32x4*)(Af + 1876);
        r2[30] -= (f32x2v){a347[0], a347[1]} * T26; r2[31] -= (f32x2v){a347[2], a347[3]} * T26;
        const f32x4 a352 = *(const LAS f32x4*)(Af + 1880);
        const float t27 = r2[13][1]; const f32x2v T27 = (f32x2v){t27, t27}; Tb[1944 + lane] = f2bf(t27);
        r2[14] -= (f32x2v){a348[0], a348[1]} * T27; r2[15] -= (f32x2v){a348[2], a348[3]} * T27;
        const f32x4 a353 = *(const LAS f32x4*)(Af + 1884);
        r2[16] -= (f32x2v){a349[0], a349[1]} * T27; r2[17] -= (f32x2v){a349[2], a349[3]} * T27;
        const f32x4 a354 = *(const LAS f32x4*)(Af + 1888);
        r2[18] -= (f32x2v){a350[0], a350[1]} * T27; r2[19] -= (f32x2v){a350[2], a350[3]} * T27;
        const f32x4 a355 = *(const LAS f32x4*)(Af + 1892);
        r2[20] -= (f32x2v){a351[0], a351[1]} * T27; r2[21] -= (f32x2v){a351[2], a351[3]} * T27;
        const f32x4 a356 = *(const LAS f32x4*)(Af + 1896);
        r2[22] -= (f32x2v){a352[0], a352[1]} * T27; r2[23] -= (f32x2v){a352[2], a352[3]} * T27;
        const f32x4 a357 = *(const LAS f32x4*)(Af + 1932);
        r2[24] -= (f32x2v){a353[0], a353[1]} * T27; r2[25] -= (f32x2v){a353[2], a353[3]} * T27;
        const f32x4 a358 = *(const LAS f32x4*)(Af + 1936);
        r2[26] -= (f32x2v){a354[0], a354[1]} * T27; r2[27] -= (f32x2v){a354[2], a354[3]} * T27;
        const f32x4 a359 = *(const LAS f32x4*)(Af + 1940);
        r2[28] -= (f32x2v){a355[0], a355[1]} * T27; r2[29] -= (f32x2v){a355[2], a355[3]} * T27;
        const f32x4 a360 = *(const LAS f32x4*)(Af + 1944);
        r2[30] -= (f32x2v){a356[0], a356[1]} * T27; r2[31] -= (f32x2v){a356[2], a356[3]} * T27;
        const f32x4 a361 = *(const LAS f32x4*)(Af + 1948);
        const float t28 = r2[14][0]; const f32x2v T28 = (f32x2v){t28, t28}; Tb[2016 + lane] = f2bf(t28);
        r2[14] -= (f32x2v){a357[0], a357[1]} * T28; r2[15] -= (f32x2v){a357[2], a357[3]} * T28;
        const f32x4 a362 = *(const LAS f32x4*)(Af + 1952);
        r2[16] -= (f32x2v){a358[0], a358[1]} * T28; r2[17] -= (f32x2v){a358[2], a358[3]} * T28;
        const f32x4 a363 = *(const LAS f32x4*)(Af + 1956);
        r2[18] -= (f32x2v){a359[0], a359[1]} * T28; r2[19] -= (f32x2v){a359[2], a359[3]} * T28;
        const f32x4 a364 = *(const LAS f32x4*)(Af + 1960);
        r2[20] -= (f32x2v){a360[0], a360[1]} * T28; r2[21] -= (f32x2v){a360[2], a360[3]} * T28;
        const f32x4 a365 = *(const LAS f32x4*)(Af + 1964);
        r2[22] -= (f32x2v){a361[0], a361[1]} * T28; r2[23] -= (f32x2v){a361[2], a361[3]} * T28;
        const f32x4 a366 = *(const LAS f32x4*)(Af + 2000);
        r2[24] -= (f32x2v){a362[0], a362[1]} * T28; r2[25] -= (f32x2v){a362[2], a362[3]} * T28;
        const f32x4 a367 = *(const LAS f32x4*)(Af + 2004);
        r2[26] -= (f32x2v){a363[0], a363[1]} * T28; r2[27] -= (f32x2v){a363[2], a363[3]} * T28;
        const f32x4 a368 = *(const LAS f32x4*)(Af + 2008);
        r2[28] -= (f32x2v){a364[0], a364[1]} * T28; r2[29] -= (f32x2v){a364[2], a364[3]} * T28;
        const f32x4 a369 = *(const LAS f32x4*)(Af + 2012);
        r2[30] -= (f32x2v){a365[0], a365[1]} * T28; r2[31] -= (f32x2v){a365[2], a365[3]} * T28;
        const f32x4 a370 = *(const LAS f32x4*)(Af + 2016);
        const float t29 = r2[14][1]; const f32x2v T29 = (f32x2v){t29, t29}; Tb[2088 + lane] = f2bf(t29);
        r2[15] -= (f32x2v){a366[2], a366[3]} * T29;
        const f32x4 a371 = *(const LAS f32x4*)(Af + 2020);
        r2[16] -= (f32x2v){a367[0], a367[1]} * T29; r2[17] -= (f32x2v){a367[2], a367[3]} * T29;
        const f32x4 a372 = *(const LAS f32x4*)(Af + 2024);
        r2[18] -= (f32x2v){a368[0], a368[1]} * T29; r2[19] -= (f32x2v){a368[2], a368[3]} * T29;
        const f32x4 a373 = *(const LAS f32x4*)(Af + 2028);
        r2[20] -= (f32x2v){a369[0], a369[1]} * T29; r2[21] -= (f32x2v){a369[2], a369[3]} * T29;
        const f32x4 a374 = *(const LAS f32x4*)(Af + 2032);
        r2[22] -= (f32x2v){a370[0], a370[1]} * T29; r2[23] -= (f32x2v){a370[2], a370[3]} * T29;
        const f32x4 a375 = *(const LAS f32x4*)(Af + 2068);
        r2[24] -= (f32x2v){a371[0], a371[1]} * T29; r2[25] -= (f32x2v){a371[2], a371[3]} * T29;
        const f32x4 a376 = *(const LAS f32x4*)(Af + 2072);
        r2[26] -= (f32x2v){a372[0], a372[1]} * T29; r2[27] -= (f32x2v){a372[2], a372[3]} * T29;
        const f32x4 a377 = *(const LAS f32x4*)(Af + 2076);
        r2[28] -= (f32x2v){a373[0], a373[1]} * T29; r2[29] -= (f32x2v){a373[2], a373[3]} * T29;
        const f32x4 a378 = *(const LAS f32x4*)(Af + 2080);
        r2[30] -= (f32x2v){a374[0], a374[1]} * T29; r2[31] -= (f32x2v){a374[2], a374[3]} * T29;
        const f32x4 a379 = *(const LAS f32x4*)(Af + 2084);
        const float t30 = r2[15][0]; const f32x2v T30 = (f32x2v){t30, t30}; Tb[2160 + lane] = f2bf(t30);
        r2[15] -= (f32x2v){a375[2], a375[3]} * T30;
        const f32x4 a380 = *(const LAS f32x4*)(Af + 2088);
        r2[16] -= (f32x2v){a376[0], a376[1]} * T30; r2[17] -= (f32x2v){a376[2], a376[3]} * T30;
        const f32x4 a381 = *(const LAS f32x4*)(Af + 2092);
        r2[18] -= (f32x2v){a377[0], a377[1]} * T30; r2[19] -= (f32x2v){a377[2], a377[3]} * T30;
        const f32x4 a382 = *(const LAS f32x4*)(Af + 2096);
        r2[20] -= (f32x2v){a378[0], a378[1]} * T30; r2[21] -= (f32x2v){a378[2], a378[3]} * T30;
        const f32x4 a383 = *(const LAS f32x4*)(Af + 2100);
        r2[22] -= (f32x2v){a379[0], a379[1]} * T30; r2[23] -= (f32x2v){a379[2], a379[3]} * T30;
        const f32x4 a384 = *(const LAS f32x4*)(Af + 2140);
        r2[24] -= (f32x2v){a380[0], a380[1]} * T30; r2[25] -= (f32x2v){a380[2], a380[3]} * T30;
        const f32x4 a385 = *(const LAS f32x4*)(Af + 2144);
        r2[26] -= (f32x2v){a381[0], a381[1]} * T30; r2[27] -= (f32x2v){a381[2], a381[3]} * T30;
        const f32x4 a386 = *(const LAS f32x4*)(Af + 2148);
        r2[28] -= (f32x2v){a382[0], a382[1]} * T30; r2[29] -= (f32x2v){a382[2], a382[3]} * T30;
        const f32x4 a387 = *(const LAS f32x4*)(Af + 2152);
        r2[30] -= (f32x2v){a383[0], a383[1]} * T30; r2[31] -= (f32x2v){a383[2], a383[3]} * T30;
        const f32x4 a388 = *(const LAS f32x4*)(Af + 2156);
        const float t31 = r2[15][1]; const f32x2v T31 = (f32x2v){t31, t31}; Tb[2232 + lane] = f2bf(t31);
        r2[16] -= (f32x2v){a384[0], a384[1]} * T31; r2[17] -= (f32x2v){a384[2], a384[3]} * T31;
        const f32x4 a389 = *(const LAS f32x4*)(Af + 2160);
        r2[18] -= (f32x2v){a385[0], a385[1]} * T31; r2[19] -= (f32x2v){a385[2], a385[3]} * T31;
        const f32x4 a390 = *(const LAS f32x4*)(Af + 2164);
        r2[20] -= (f32x2v){a386[0], a386[1]} * T31; r2[21] -= (f32x2v){a386[2], a386[3]} * T31;
        const f32x4 a391 = *(const LAS f32x4*)(Af + 2168);
        r2[22] -= (f32x2v){a387[0], a387[1]} * T31; r2[23] -= (f32x2v){a387[2], a387[3]} * T31;
        const f32x4 a392 = *(const LAS f32x4*)(Af + 2208);
        r2[24] -= (f32x2v){a388[0], a388[1]} * T31; r2[25] -= (f32x2v){a388[2], a388[3]} * T31;
        const f32x4 a393 = *(const LAS f32x4*)(Af + 2212);
        r2[26] -= (f32x2v){a389[0], a389[1]} * T31; r2[27] -= (f32x2v){a389[2], a389[3]} * T31;
        const f32x4 a394 = *(const LAS f32x4*)(Af + 2216);
        r2[28] -= (f32x2v){a390[0], a390[1]} * T31; r2[29] -= (f32x2v){a390[2], a390[3]} * T31;
        const f32x4 a395 = *(const LAS f32x4*)(Af + 2220);
        r2[30] -= (f32x2v){a391[0], a391[1]} * T31; r2[31] -= (f32x2v){a391[2], a391[3]} * T31;
        const f32x4 a396 = *(const LAS f32x4*)(Af + 2224);
        const float t32 = r2[16][0]; const f32x2v T32 = (f32x2v){t32, t32}; Tb[2304 + lane] = f2bf(t32);
        r2[16] -= (f32x2v){a392[0], a392[1]} * T32; r2[17] -= (f32x2v){a392[2], a392[3]} * T32;
        const f32x4 a397 = *(const LAS f32x4*)(Af + 2228);
        r2[18] -= (f32x2v){a393[0], a393[1]} * T32; r2[19] -= (f32x2v){a393[2], a393[3]} * T32;
        const f32x4 a398 = *(const LAS f32x4*)(Af + 2232);
        r2[20] -= (f32x2v){a394[0], a394[1]} * T32; r2[21] -= (f32x2v){a394[2], a394[3]} * T32;
        const f32x4 a399 = *(const LAS f32x4*)(Af + 2236);
        r2[22] -= (f32x2v){a395[0], a395[1]} * T32; r2[23] -= (f32x2v){a395[2], a395[3]} * T32;
        const f32x4 a400 = *(const LAS f32x4*)(Af + 2276);
        r2[24] -= (f32x2v){a396[0], a396[1]} * T32; r2[25] -= (f32x2v){a396[2], a396[3]} * T32;
        const f32x4 a401 = *(const LAS f32x4*)(Af + 2280);
        r2[26] -= (f32x2v){a397[0], a397[1]} * T32; r2[27] -= (f32x2v){a397[2], a397[3]} * T32;
        const f32x4 a402 = *(const LAS f32x4*)(Af + 2284);
        r2[28] -= (f32x2v){a398[0], a398[1]} * T32; r2[29] -= (f32x2v){a398[2], a398[3]} * T32;
        const f32x4 a403 = *(const LAS f32x4*)(Af + 2288);
        r2[30] -= (f32x2v){a399[0], a399[1]} * T32; r2[31] -= (f32x2v){a399[2], a399[3]} * T32;
        const f32x4 a404 = *(const LAS f32x4*)(Af + 2292);
        const float t33 = r2[16][1]; const f32x2v T33 = (f32x2v){t33, t33}; Tb[2376 + lane] = f2bf(t33);
        r2[17] -= (f32x2v){a400[2], a400[3]} * T33;
        const f32x4 a405 = *(const LAS f32x4*)(Af + 2296);
        r2[18] -= (f32x2v){a401[0], a401[1]} * T33; r2[19] -= (f32x2v){a401[2], a401[3]} * T33;
        const f32x4 a406 = *(const LAS f32x4*)(Af + 2300);
        r2[20] -= (f32x2v){a402[0], a402[1]} * T33; r2[21] -= (f32x2v){a402[2], a402[3]} * T33;
        const f32x4 a407 = *(const LAS f32x4*)(Af + 2304);
        r2[22] -= (f32x2v){a403[0], a403[1]} * T33; r2[23] -= (f32x2v){a403[2], a403[3]} * T33;
        const f32x4 a408 = *(const LAS f32x4*)(Af + 2344);
        r2[24] -= (f32x2v){a404[0], a404[1]} * T33; r2[25] -= (f32x2v){a404[2], a404[3]} * T33;
        const f32x4 a409 = *(const LAS f32x4*)(Af + 2348);
        r2[26] -= (f32x2v){a405[0], a405[1]} * T33; r2[27] -= (f32x2v){a405[2], a405[3]} * T33;
        const f32x4 a410 = *(const LAS f32x4*)(Af + 2352);
        r2[28] -= (f32x2v){a406[0], a406[1]} * T33; r2[29] -= (f32x2v){a406[2], a406[3]} * T33;
        const f32x4 a411 = *(const LAS f32x4*)(Af + 2356);
        r2[30] -= (f32x2v){a407[0], a407[1]} * T33; r2[31] -= (f32x2v){a407[2], a407[3]} * T33;
        const f32x4 a412 = *(const LAS f32x4*)(Af + 2360);
        const float t34 = r2[17][0]; const f32x2v T34 = (f32x2v){t34, t34}; Tb[2448 + lane] = f2bf(t34);
        r2[17] -= (f32x2v){a408[2], a408[3]} * T34;
        const f32x4 a413 = *(const LAS f32x4*)(Af + 2364);
        r2[18] -= (f32x2v){a409[0], a409[1]} * T34; r2[19] -= (f32x2v){a409[2], a409[3]} * T34;
        const f32x4 a414 = *(const LAS f32x4*)(Af + 2368);
        r2[20] -= (f32x2v){a410[0], a410[1]} * T34; r2[21] -= (f32x2v){a410[2], a410[3]} * T34;
        const f32x4 a415 = *(const LAS f32x4*)(Af + 2372);
        r2[22] -= (f32x2v){a411[0], a411[1]} * T34; r2[23] -= (f32x2v){a411[2], a411[3]} * T34;
        const f32x4 a416 = *(const LAS f32x4*)(Af + 2416);
        r2[24] -= (f32x2v){a412[0], a412[1]} * T34; r2[25] -= (f32x2v){a412[2], a412[3]} * T34;
        const f32x4 a417 = *(const LAS f32x4*)(Af + 2420);
        r2[26] -= (f32x2v){a413[0], a413[1]} * T34; r2[27] -= (f32x2v){a413[2], a413[3]} * T34;
        const f32x4 a418 = *(const LAS f32x4*)(Af + 2424);
        r2[28] -= (f32x2v){a414[0], a414[1]} * T34; r2[29] -= (f32x2v){a414[2], a414[3]} * T34;
        const f32x4 a419 = *(const LAS f32x4*)(Af + 2428);
        r2[30] -= (f32x2v){a415[0], a415[1]} * T34; r2[31] -= (f32x2v){a415[2], a415[3]} * T34;
        const f32x4 a420 = *(const LAS f32x4*)(Af + 2432);
        const float t35 = r2[17][1]; const f32x2v T35 = (f32x2v){t35, t35}; Tb[2520 + lane] = f2bf(t35);
        r2[18] -= (f32x2v){a416[0], a416[1]} * T35; r2[19] -= (f32x2v){a416[2], a416[3]} * T35;
        const f32x4 a421 = *(const LAS f32x4*)(Af + 2436);
        r2[20] -= (f32x2v){a417[0], a417[1]} * T35; r2[21] -= (f32x2v){a417[2], a417[3]} * T35;
        const f32x4 a422 = *(const LAS f32x4*)(Af + 2440);
        r2[22] -= (f32x2v){a418[0], a418[1]} * T35; r2[23] -= (f32x2v){a418[2], a418[3]} * T35;
        const f32x4 a423 = *(const LAS f32x4*)(Af + 2484);
        r2[24] -= (f32x2v){a419[0], a419[1]} * T35; r2[25] -= (f32x2v){a419[2], a419[3]} * T35;
        const f32x4 a424 = *(const LAS f32x4*)(Af + 2488);
        r2[26] -= (f32x2v){a420[0], a420[1]} * T35; r2[27] -= (f32x2v){a420[2], a420[3]} * T35;
        const f32x4 a425 = *(const LAS f32x4*)(Af + 2492);
        r2[28] -= (f32x2v){a421[0], a421[1]} * T35; r2[29] -= (f32x2v){a421[2], a421[3]} * T35;
        const f32x4 a426 = *(const LAS f32x4*)(Af + 2496);
        r2[30] -= (f32x2v){a422[0], a422[1]} * T35; r2[31] -= (f32x2v){a422[2], a422[3]} * T35;
        const f32x4 a427 = *(const LAS f32x4*)(Af + 2500);
        const float t36 = r2[18][0]; const f32x2v T36 = (f32x2v){t36, t36}; Tb[2592 + lane] = f2bf(t36);
        r2[18] -= (f32x2v){a423[0], a423[1]} * T36; r2[19] -= (f32x2v){a423[2], a423[3]} * T36;
        const f32x4 a428 = *(const LAS f32x4*)(Af + 2504);
        r2[20] -= (f32x2v){a424[0], a424[1]} * T36; r2[21] -= (f32x2v){a424[2], a424[3]} * T36;
        const f32x4 a429 = *(const LAS f32x4*)(Af + 2508);
        r2[22] -= (f32x2v){a425[0], a425[1]} * T36; r2[23] -= (f32x2v){a425[2], a425[3]} * T36;
        const f32x4 a430 = *(const LAS f32x4*)(Af + 2552);
        r2[24] -= (f32x2v){a426[0], a426[1]} * T36; r2[25] -= (f32x2v){a426[2], a426[3]} * T36;
        const f32x4 a431 = *(const LAS f32x4*)(Af + 2556);
        r2[26] -= (f32x2v){a427[0], a427[1]} * T36; r2[27] -= (f32x2v){a427[2], a427[3]} * T36;
        const f32x4 a432 = *(const LAS f32x4*)(Af + 2560);
        r2[28] -= (f32x2v){a428[0], a428[1]} * T36; r2[29] -= (f32x2v){a428[2], a428[3]} * T36;
        const f32x4 a433 = *(const LAS f32x4*)(Af + 2564);
        r2[30] -= (f32x2v){a429[0], a429[1]} * T36; r2[31] -= (f32x2v){a429[2], a429[3]} * T36;
        const f32x4 a434 = *(const LAS f32x4*)(Af + 2568);
        const float t37 = r2[18][1]; const f32x2v T37 = (f32x2v){t37, t37}; Tb[2664 + lane] = f2bf(t37);
        r2[19] -= (f32x2v){a430[2], a430[3]} * T37;
        const f32x4 a435 = *(const LAS f32x4*)(Af + 2572);
        r2[20] -= (f32x2v){a431[0], a431[1]} * T37; r2[21] -= (f32x2v){a431[2], a431[3]} * T37;
        const f32x4 a436 = *(const LAS f32x4*)(Af + 2576);
        r2[22] -= (f32x2v){a432[0], a432[1]} * T37; r2[23] -= (f32x2v){a432[2], a432[3]} * T37;
        const f32x4 a437 = *(const LAS f32x4*)(Af + 2620);
        r2[24] -= (f32x2v){a433[0], a433[1]} * T37; r2[25] -= (f32x2v){a433[2], a433[3]} * T37;
        const f32x4 a438 = *(const LAS f32x4*)(Af + 2624);
        r2[26] -= (f32x2v){a434[0], a434[1]} * T37; r2[27] -= (f32x2v){a434[2], a434[3]} * T37;
        const f32x4 a439 = *(const LAS f32x4*)(Af + 2628);
        r2[28] -= (f32x2v){a435[0], a435[1]} * T37; r2[29] -= (f32x2v){a435[2], a435[3]} * T37;
        const f32x4 a440 = *(const LAS f32x4*)(Af + 2632);
        r2[30] -= (f32x2v){a436[0], a436[1]} * T37; r2[31] -= (f32x2v){a436[2], a436[3]} * T37;
        const f32x4 a441 = *(const LAS f32x4*)(Af + 2636);
        const float t38 = r2[19][0]; const f32x2v T38 = (f32x2v){t38, t38}; Tb[2736 + lane] = f2bf(t38);
        r2[19] -= (f32x2v){a437[2], a437[3]} * T38;
        const f32x4 a442 = *(const LAS f32x4*)(Af + 2640);
        r2[20] -= (f32x2v){a438[0], a438[1]} * T38; r2[21] -= (f32x2v){a438[2], a438[3]} * T38;
        const f32x4 a443 = *(const LAS f32x4*)(Af + 2644);
        r2[22] -= (f32x2v){a439[0], a439[1]} * T38; r2[23] -= (f32x2v){a439[2], a439[3]} * T38;
        const f32x4 a444 = *(const LAS f32x4*)(Af + 2692);
        r2[24] -= (f32x2v){a440[0], a440[1]} * T38; r2[25] -= (f32x2v){a440[2], a440[3]} * T38;
        const f32x4 a445 = *(const LAS f32x4*)(Af + 2696);
        r2[26] -= (f32x2v){a441[0], a441[1]} * T38; r2[27] -= (f32x2v){a441[2], a441[3]} * T38;
        const f32x4 a446 = *(const LAS f32x4*)(Af + 2700);
        r2[28] -= (f32x2v){a442[0], a442[1]} * T38; r2[29] -= (f32x2v){a442[2], a442[3]} * T38;
        const f32x4 a447 = *(const LAS f32x4*)(Af + 2704);
        r2[30] -= (f32x2v){a443[0], a443[1]} * T38; r2[31] -= (f32x2v){a443[2], a443[3]} * T38;
        const f32x4 a448 = *(const LAS f32x4*)(Af + 2708);
        const float t39 = r2[19][1]; const f32x2v T39 = (f32x2v){t39, t39}; Tb[2808 + lane] = f2bf(t39);
        r2[20] -= (f32x2v){a444[0], a444[1]} * T39; r2[21] -= (f32x2v){a444[2], a444[3]} * T39;
        const f32x4 a449 = *(const LAS f32x4*)(Af + 2712);
        r2[22] -= (f32x2v){a445[0], a445[1]} * T39; r2[23] -= (f32x2v){a445[2], a445[3]} * T39;
        const f32x4 a450 = *(const LAS f32x4*)(Af + 2760);
        r2[24] -= (f32x2v){a446[0], a446[1]} * T39; r2[25] -= (f32x2v){a446[2], a446[3]} * T39;
        const f32x4 a451 = *(const LAS f32x4*)(Af + 2764);
        r2[26] -= (f32x2v){a447[0], a447[1]} * T39; r2[27] -= (f32x2v){a447[2], a447[3]} * T39;
        const f32x4 a452 = *(const LAS f32x4*)(Af + 2768);
        r2[28] -= (f32x2v){a448[0], a448[1]} * T39; r2[29] -= (f32x2v){a448[2], a448[3]} * T39;
        const f32x4 a453 = *(const LAS f32x4*)(Af + 2772);
        r2[30] -= (f32x2v){a449[0], a449[1]} * T39; r2[31] -= (f32x2v){a449[2], a449[3]} * T39;
        const f32x4 a454 = *(const LAS f32x4*)(Af + 2776);
        const float t40 = r2[20][0]; const f32x2v T40 = (f32x2v){t40, t40}; Tb[2880 + lane] = f2bf(t40);
        r2[20] -= (f32x2v){a450[0], a450[1]} * T40; r2[21] -= (f32x2v){a450[2], a450[3]} * T40;
        const f32x4 a455 = *(const LAS f32x4*)(Af + 2780);
        r2[22] -= (f32x2v){a451[0], a451[1]} * T40; r2[23] -= (f32x2v){a451[2], a451[3]} * T40;
        const f32x4 a456 = *(const LAS f32x4*)(Af + 2828);
        r2[24] -= (f32x2v){a452[0], a452[1]} * T40; r2[25] -= (f32x2v){a452[2], a452[3]} * T40;
        const f32x4 a457 = *(const LAS f32x4*)(Af + 2832);
        r2[26] -= (f32x2v){a453[0], a453[1]} * T40; r2[27] -= (f32x2v){a453[2], a453[3]} * T40;
        const f32x4 a458 = *(const LAS f32x4*)(Af + 2836);
        r2[28] -= (f32x2v){a454[0], a454[1]} * T40; r2[29] -= (f32x2v){a454[2], a454[3]} * T40;
        const f32x4 a459 = *(const LAS f32x4*)(Af + 2840);
        r2[30] -= (f32x2v){a455[0], a455[1]} * T40; r2[31] -= (f32x2v){a455[2], a455[3]} * T40;
        const f32x4 a460 = *(const LAS f32x4*)(Af + 2844);
        const float t41 = r2[20][1]; const f32x2v T41 = (f32x2v){t41, t41}; Tb[2952 + lane] = f2bf(t41);
        r2[21] -= (f32x2v){a456[2], a456[3]} * T41;
        const f32x4 a461 = *(const LAS f32x4*)(Af + 2848);
        r2[22] -= (f32x2v){a457[0], a457[1]} * T41; r2[23] -= (f32x2v){a457[2], a457[3]} * T41;
        const f32x4 a462 = *(const LAS f32x4*)(Af + 2896);
        r2[24] -= (f32x2v){a458[0], a458[1]} * T41; r2[25] -= (f32x2v){a458[2], a458[3]} * T41;
        const f32x4 a463 = *(const LAS f32x4*)(Af + 2900);
        r2[26] -= (f32x2v){a459[0], a459[1]} * T41; r2[27] -= (f32x2v){a459[2], a459[3]} * T41;
        const f32x4 a464 = *(const LAS f32x4*)(Af + 2904);
        r2[28] -= (f32x2v){a460[0], a460[1]} * T41; r2[29] -= (f32x2v){a460[2], a460[3]} * T41;
        const f32x4 a465 = *(const LAS f32x4*)(Af + 2908);
        r2[30] -= (f32x2v){a461[0], a461[1]} * T41; r2[31] -= (f32x2v){a461[2], a461[3]} * T41;
        const f32x4 a466 = *(const LAS f32x4*)(Af + 2912);
        const float t42 = r2[21][0]; const f32x2v T42 = (f32x2v){t42, t42}; Tb[3024 + lane] = f2bf(t42);
        r2[21] -= (f32x2v){a462[2], a462[3]} * T42;
        const f32x4 a467 = *(const LAS f32x4*)(Af + 2916);
        r2[22] -= (f32x2v){a463[0], a463[1]} * T42; r2[23] -= (f32x2v){a463[2], a463[3]} * T42;
        const f32x4 a468 = *(const LAS f32x4*)(Af + 2968);
        r2[24] -= (f32x2v){a464[0], a464[1]} * T42; r2[25] -= (f32x2v){a464[2], a464[3]} * T42;
        const f32x4 a469 = *(const LAS f32x4*)(Af + 2972);
        r2[26] -= (f32x2v){a465[0], a465[1]} * T42; r2[27] -= (f32x2v){a465[2], a465[3]} * T42;
        const f32x4 a470 = *(const LAS f32x4*)(Af + 2976);
        r2[28] -= (f32x2v){a466[0], a466[1]} * T42; r2[29] -= (f32x2v){a466[2], a466[3]} * T42;
        const f32x4 a471 = *(const LAS f32x4*)(Af + 2980);
        r2[30] -= (f32x2v){a467[0], a467[1]} * T42; r2[31] -= (f32x2v){a467[2], a467[3]} * T42;
        const f32x4 a472 = *(const LAS f32x4*)(Af + 2984);
        const float t43 = r2[21][1]; const f32x2v T43 = (f32x2v){t43, t43}; Tb[3096 + lane] = f2bf(t43);
        r2[22] -= (f32x2v){a468[0], a468[1]} * T43; r2[23] -= (f32x2v){a468[2], a468[3]} * T43;
        const f32x4 a473 = *(const LAS f32x4*)(Af + 3036);
        r2[24] -= (f32x2v){a469[0], a469[1]} * T43; r2[25] -= (f32x2v){a469[2], a469[3]} * T43;
        const f32x4 a474 = *(const LAS f32x4*)(Af + 3040);
        r2[26] -= (f32x2v){a470[0], a470[1]} * T43; r2[27] -= (f32x2v){a470[2], a470[3]} * T43;
        const f32x4 a475 = *(const LAS f32x4*)(Af + 3044);
        r2[28] -= (f32x2v){a471[0], a471[1]} * T43; r2[29] -= (f32x2v){a471[2], a471[3]} * T43;
        const f32x4 a476 = *(const LAS f32x4*)(Af + 3048);
        r2[30] -= (f32x2v){a472[0], a472[1]} * T43; r2[31] -= (f32x2v){a472[2], a472[3]} * T43;
        const f32x4 a477 = *(const LAS f32x4*)(Af + 3052);
        const float t44 = r2[22][0]; const f32x2v T44 = (f32x2v){t44, t44}; Tb[3168 + lane] = f2bf(t44);
        r2[22] -= (f32x2v){a473[0], a473[1]} * T44; r2[23] -= (f32x2v){a473[2], a473[3]} * T44;
        const f32x4 a478 = *(const LAS f32x4*)(Af + 3104);
        r2[24] -= (f32x2v){a474[0], a474[1]} * T44; r2[25] -= (f32x2v){a474[2], a474[3]} * T44;
        const f32x4 a479 = *(const LAS f32x4*)(Af + 3108);
        r2[26] -= (f32x2v){a475[0], a475[1]} * T44; r2[27] -= (f32x2v){a475[2], a475[3]} * T44;
        const f32x4 a480 = *(const LAS f32x4*)(Af + 3112);
        r2[28] -= (f32x2v){a476[0], a476[1]} * T44; r2[29] -= (f32x2v){a476[2], a476[3]} * T44;
        const f32x4 a481 = *(const LAS f32x4*)(Af + 3116);
        r2[30] -= (f32x2v){a477[0], a477[1]} * T44; r2[31] -= (f32x2v){a477[2], a477[3]} * T44;
        const f32x4 a482 = *(const LAS f32x4*)(Af + 3120);
        const float t45 = r2[22][1]; const f32x2v T45 = (f32x2v){t45, t45}; Tb[3240 + lane] = f2bf(t45);
        r2[23] -= (f32x2v){a478[2], a478[3]} * T45;
        const f32x4 a483 = *(const LAS f32x4*)(Af + 3172);
        r2[24] -= (f32x2v){a479[0], a479[1]} * T45; r2[25] -= (f32x2v){a479[2], a479[3]} * T45;
        const f32x4 a484 = *(const LAS f32x4*)(Af + 3176);
        r2[26] -= (f32x2v){a480[0], a480[1]} * T45; r2[27] -= (f32x2v){a480[2], a480[3]} * T45;
        const f32x4 a485 = *(const LAS f32x4*)(Af + 3180);
        r2[28] -= (f32x2v){a481[0], a481[1]} * T45; r2[29] -= (f32x2v){a481[2], a481[3]} * T45;
        const f32x4 a486 = *(const LAS f32x4*)(Af + 3184);
        r2[30] -= (f32x2v){a482[0], a482[1]} * T45; r2[31] -= (f32x2v){a482[2], a482[3]} * T45;
        const f32x4 a487 = *(const LAS f32x4*)(Af + 3188);
        const float t46 = r2[23][0]; const f32x2v T46 = (f32x2v){t46, t46}; Tb[3312 + lane] = f2bf(t46);
        r2[23] -= (f32x2v){a483[2], a483[3]} * T46;
        const f32x4 a488 = *(const LAS f32x4*)(Af + 3244);
        r2[24] -= (f32x2v){a484[0], a484[1]} * T46; r2[25] -= (f32x2v){a484[2], a484[3]} * T46;
        const f32x4 a489 = *(const LAS f32x4*)(Af + 3248);
        r2[26] -= (f32x2v){a485[0], a485[1]} * T46; r2[27] -= (f32x2v){a485[2], a485[3]} * T46;
        const f32x4 a490 = *(const LAS f32x4*)(Af + 3252);
        r2[28] -= (f32x2v){a486[0], a486[1]} * T46; r2[29] -= (f32x2v){a486[2], a486[3]} * T46;
        const f32x4 a491 = *(const LAS f32x4*)(Af + 3256);
        r2[30] -= (f32x2v){a487[0], a487[1]} * T46; r2[31] -= (f32x2v){a487[2], a487[3]} * T46;
        const f32x4 a492 = *(const LAS f32x4*)(Af + 3312);
        const float t47 = r2[23][1]; const f32x2v T47 = (f32x2v){t47, t47}; Tb[3384 + lane] = f2bf(t47);
        r2[24] -= (f32x2v){a488[0], a488[1]} * T47; r2[25] -= (f32x2v){a488[2], a488[3]} * T47;
        const f32x4 a493 = *(const LAS f32x4*)(Af + 3316);
        r2[26] -= (f32x2v){a489[0], a489[1]} * T47; r2[27] -= (f32x2v){a489[2], a489[3]} * T47;
        const f32x4 a494 = *(const LAS f32x4*)(Af + 3320);
        r2[28] -= (f32x2v){a490[0], a490[1]} * T47; r2[29] -= (f32x2v){a490[2], a490[3]} * T47;
        const f32x4 a495 = *(const LAS f32x4*)(Af + 3324);
        r2[30] -= (f32x2v){a491[0], a491[1]} * T47; r2[31] -= (f32x2v){a491[2], a491[3]} * T47;
        const f32x4 a496 = *(const LAS f32x4*)(Af + 3380);
        const float t48 = r2[24][0]; const f32x2v T48 = (f32x2v){t48, t48}; Tb[3456 + lane] = f2bf(t48);
        r2[24] -= (f32x2v){a492[0], a492[1]} * T48; r2[25] -= (f32x2v){a492[2], a492[3]} * T48;
        const f32x4 a497 = *(const LAS f32x4*)(Af + 3384);
        r2[26] -= (f32x2v){a493[0], a493[1]} * T48; r2[27] -= (f32x2v){a493[2], a493[3]} * T48;
        const f32x4 a498 = *(const LAS f32x4*)(Af + 3388);
        r2[28] -= (f32x2v){a494[0], a494[1]} * T48; r2[29] -= (f32x2v){a494[2], a494[3]} * T48;
        const f32x4 a499 = *(const LAS f32x4*)(Af + 3392);
        r2[30] -= (f32x2v){a495[0], a495[1]} * T48; r2[31] -= (f32x2v){a495[2], a495[3]} * T48;
        const f32x4 a500 = *(const LAS f32x4*)(Af + 3448);
        const float t49 = r2[24][1]; const f32x2v T49 = (f32x2v){t49, t49}; Tb[3528 + lane] = f2bf(t49);
        r2[25] -= (f32x2v){a496[2], a496[3]} * T49;
        const f32x4 a501 = *(const LAS f32x4*)(Af + 3452);
        r2[26] -= (f32x2v){a497[0], a497[1]} * T49; r2[27] -= (f32x2v){a497[2], a497[3]} * T49;
        const f32x4 a502 = *(const LAS f32x4*)(Af + 3456);
        r2[28] -= (f32x2v){a498[0], a498[1]} * T49; r2[29] -= (f32x2v){a498[2], a498[3]} * T49;
        const f32x4 a503 = *(const LAS f32x4*)(Af + 3460);
        r2[30] -= (f32x2v){a499[0], a499[1]} * T49; r2[31] -= (f32x2v){a499[2], a499[3]} * T49;
        const f32x4 a504 = *(const LAS f32x4*)(Af + 3520);
        const float t50 = r2[25][0]; const f32x2v T50 = (f32x2v){t50, t50}; Tb[3600 + lane] = f2bf(t50);
        r2[25] -= (f32x2v){a500[2], a500[3]} * T50;
        const f32x4 a505 = *(const LAS f32x4*)(Af + 3524);
        r2[26] -= (f32x2v){a501[0], a501[1]} * T50; r2[27] -= (f32x2v){a501[2], a501[3]} * T50;
        const f32x4 a506 = *(const LAS f32x4*)(Af + 3528);
        r2[28] -= (f32x2v){a502[0], a502[1]} * T50; r2[29] -= (f32x2v){a502[2], a502[3]} * T50;
        const f32x4 a507 = *(const LAS f32x4*)(Af + 3588);
        r2[30] -= (f32x2v){a503[0], a503[1]} * T50; r2[31] -= (f32x2v){a503[2], a503[3]} * T50;
        const f32x4 a508 = *(const LAS f32x4*)(Af + 3592);
        const float t51 = r2[25][1]; const f32x2v T51 = (f32x2v){t51, t51}; Tb[3672 + lane] = f2bf(t51);
        r2[26] -= (f32x2v){a504[0], a504[1]} * T51; r2[27] -= (f32x2v){a504[2], a504[3]} * T51;
        const f32x4 a509 = *(const LAS f32x4*)(Af + 3596);
        r2[28] -= (f32x2v){a505[0], a505[1]} * T51; r2[29] -= (f32x2v){a505[2], a505[3]} * T51;
        const f32x4 a510 = *(const LAS f32x4*)(Af + 3656);
        r2[30] -= (f32x2v){a506[0], a506[1]} * T51; r2[31] -= (f32x2v){a506[2], a506[3]} * T51;
        const f32x4 a511 = *(const LAS f32x4*)(Af + 3660);
        const float t52 = r2[26][0]; const f32x2v T52 = (f32x2v){t52, t52}; Tb[3744 + lane] = f2bf(t52);
        r2[26] -= (f32x2v){a507[0], a507[1]} * T52; r2[27] -= (f32x2v){a507[2], a507[3]} * T52;
        const f32x4 a512 = *(const LAS f32x4*)(Af + 3664);
        r2[28] -= (f32x2v){a508[0], a508[1]} * T52; r2[29] -= (f32x2v){a508[2], a508[3]} * T52;
        const f32x4 a513 = *(const LAS f32x4*)(Af + 3724);
        r2[30] -= (f32x2v){a509[0], a509[1]} * T52; r2[31] -= (f32x2v){a509[2], a509[3]} * T52;
        const f32x4 a514 = *(const LAS f32x4*)(Af + 3728);
        const float t53 = r2[26][1]; const f32x2v T53 = (f32x2v){t53, t53}; Tb[3816 + lane] = f2bf(t53);
        r2[27] -= (f32x2v){a510[2], a510[3]} * T53;
        const f32x4 a515 = *(const LAS f32x4*)(Af + 3732);
        r2[28] -= (f32x2v){a511[0], a511[1]} * T53; r2[29] -= (f32x2v){a511[2], a511[3]} * T53;
        const f32x4 a516 = *(const LAS f32x4*)(Af + 3796);
        r2[30] -= (f32x2v){a512[0], a512[1]} * T53; r2[31] -= (f32x2v){a512[2], a512[3]} * T53;
        const f32x4 a517 = *(const LAS f32x4*)(Af + 3800);
        const float t54 = r2[27][0]; const f32x2v T54 = (f32x2v){t54, t54}; Tb[3888 + lane] = f2bf(t54);
        r2[27] -= (f32x2v){a513[2], a513[3]} * T54;
        const f32x4 a518 = *(const LAS f32x4*)(Af + 3864);
        r2[28] -= (f32x2v){a514[0], a514[1]} * T54; r2[29] -= (f32x2v){a514[2], a514[3]} * T54;
        const f32x4 a519 = *(const LAS f32x4*)(Af + 3868);
        r2[30] -= (f32x2v){a515[0], a515[1]} * T54; r2[31] -= (f32x2v){a515[2], a515[3]} * T54;
        const f32x4 a520 = *(const LAS f32x4*)(Af + 3932);
        const float t55 = r2[27][1]; const f32x2v T55 = (f32x2v){t55, t55}; Tb[3960 + lane] = f2bf(t55);
        r2[28] -= (f32x2v){a516[0], a516[1]} * T55; r2[29] -= (f32x2v){a516[2], a516[3]} * T55;
        const f32x4 a521 = *(const LAS f32x4*)(Af + 3936);
        r2[30] -= (f32x2v){a517[0], a517[1]} * T55; r2[31] -= (f32x2v){a517[2], a517[3]} * T55;
        const f32x4 a522 = *(const LAS f32x4*)(Af + 4000);
        const float t56 = r2[28][0]; const f32x2v T56 = (f32x2v){t56, t56}; Tb[4032 + lane] = f2bf(t56);
        r2[28] -= (f32x2v){a518[0], a518[1]} * T56; r2[29] -= (f32x2v){a518[2], a518[3]} * T56;
        const f32x4 a523 = *(const LAS f32x4*)(Af + 4004);
        r2[30] -= (f32x2v){a519[0], a519[1]} * T56; r2[31] -= (f32x2v){a519[2], a519[3]} * T56;
        const f32x4 a524 = *(const LAS f32x4*)(Af + 4072);
        const float t57 = r2[28][1]; const f32x2v T57 = (f32x2v){t57, t57}; Tb[4104 + lane] = f2bf(t57);
        r2[29] -= (f32x2v){a520[2], a520[3]} * T57;
        const f32x4 a525 = *(const LAS f32x4*)(Af + 4140);
        r2[30] -= (f32x2v){a521[0], a521[1]} * T57; r2[31] -= (f32x2v){a521[2], a521[3]} * T57;
        const f32x4 a526 = *(const LAS f32x4*)(Af + 4208);
        const float t58 = r2[29][0]; const f32x2v T58 = (f32x2v){t58, t58}; Tb[4176 + lane] = f2bf(t58);
        r2[29] -= (f32x2v){a522[2], a522[3]} * T58;
        const f32x4 a527 = *(const LAS f32x4*)(Af + 4276);
        r2[30] -= (f32x2v){a523[0], a523[1]} * T58; r2[31] -= (f32x2v){a523[2], a523[3]} * T58;
        const float t59 = r2[29][1]; const f32x2v T59 = (f32x2v){t59, t59}; Tb[4248 + lane] = f2bf(t59);
        r2[30] -= (f32x2v){a524[0], a524[1]} * T59; r2[31] -= (f32x2v){a524[2], a524[3]} * T59;
        const float t60 = r2[30][0]; const f32x2v T60 = (f32x2v){t60, t60}; Tb[4320 + lane] = f2bf(t60);
        r2[30] -= (f32x2v){a525[0], a525[1]} * T60; r2[31] -= (f32x2v){a525[2], a525[3]} * T60;
        const float t61 = r2[30][1]; const f32x2v T61 = (f32x2v){t61, t61}; Tb[4392 + lane] = f2bf(t61);
        r2[31] -= (f32x2v){a526[2], a526[3]} * T61;
        const float t62 = r2[31][0]; const f32x2v T62 = (f32x2v){t62, t62}; Tb[4464 + lane] = f2bf(t62);
        r2[31] -= (f32x2v){a527[2], a527[3]} * T62;
        Tb[4536 + lane] = f2bf(r2[31][1]);
    }
    __syncthreads();
#pragma unroll 2
    for (int r = 0; r < 8; ++r) {
        const int job = wid + 8 * r, kind = job >> 5, tile = job & 31, mt = tile >> 3, nt = tile & 7;
        const f32x4 acc = tile_mm<false, true>(Tb, 72, mt, kind ? KbT : VbT, 72, nt, 2, fr, fq);
        u32x2 w; w.x = cvt_pk(acc[0], acc[1]); w.y = cvt_pk(acc[2], acc[3]);
        { const int ch = 16 * nt + fr; *(LAS u32x2*)((kind ? WT : UT) + ch * 72 + 8 * ((2 * mt + (fq >> 1)) ^ ((ch >> 3) & 7)) + 4 * (fq & 1)) = w; }
    }
    __syncthreads();
    bf16_t* GM = (bf16_t*)(p.ws + WS_GM) + (size_t)unit * 16384; bf16_t* GN = (bf16_t*)(p.ws + WS_GN) + (size_t)unit * 16384;
    bf16_t* GQ = (bf16_t*)(p.ws + WS_GQ) + (size_t)unit * 8192; bf16_t* GO = (bf16_t*)(p.ws + WS_GO) + (size_t)unit * 8192;
#pragma unroll 2
    for (int r = 0; r < 24; ++r) {
        const int job = wid + 8 * r;
        if (job < 64) { const int a = job >> 3, mt = job & 7;
            const f32x4 acc = tile_mm<true, true>(WT, 72, a, KdT, 72, mt, 2, fr, fq);
            u32x2 w; w.x = cvt_pk(-acc[0], -acc[1]); w.y = cvt_pk(-acc[2], -acc[3]);
            *(u32x2*)(GM + ((mt * 4 + (a >> 1)) * 64 + lane) * 8 + (a & 1) * 4) = w;
        } else if (job < 128) { const int j = job - 64, mt = j >> 3, nt = j & 7;
            const f32x4 acc = tile_mm<true, true>(KdT, 72, mt, UT, 72, nt, 2, fr, fq);
            u32x2 w; w.x = cvt_pk(acc[0], acc[1]); w.y = cvt_pk(acc[2], acc[3]);
            *(u32x2*)(GN + ((nt * 64 + lane) * 8 + mt) * 4) = w;
        } else if (job < 160) { const int j = job - 128, a = j >> 2, it = j & 3;
            const f32x4 acc = tile_mm<true, false>(WT, 72, a, QK, 72, it, 2, fr, fq);
            const int i = 16 * it + fr; const float eg = __expf(gcs[i]);
            const u32x2 qv = *(const LAS u32x2*)(Qs + i * 136 + 16 * a + 4 * fq);
            u32x2 w; w.x = cvt_pk(bflo(qv.x) * eg - acc[0], bfhi(qv.x) * eg - acc[1]); w.y = cvt_pk(bflo(qv.y) * eg - acc[2], bfhi(qv.y) * eg - acc[3]);
            *(u32x2*)(GQ + ((it * 4 + (a >> 1)) * 64 + lane) * 8 + (a & 1) * 4) = w;
        } else { const int j = job - 160, mt = j >> 3, nt = j & 7;
            const f32x4 acc = tile_mm<false, true>(QK, 72, mt, UT, 72, nt, 2, fr, fq);
            u32x2 w; w.x = cvt_pk(acc[0], acc[1]); w.y = cvt_pk(acc[2], acc[3]);
            *(u32x2*)(GO + ((nt * 64 + lane) * 4 + mt) * 4) = w;
        }
    }
    if (tid == 0) ((float*)(p.ws + WS_CTL + CTL_GLAST))[unit] = __expf(gclast);
    __syncthreads();
}

__device__ __forceinline__ void gdn_scan(const Params& p, LAS unsigned char* lds, int sb) {
    const int tid = threadIdx.x, lane = tid & 63, wid = tid >> 6, fr = lane & 15, fq = lane >> 4;
    const int bh = sb / (8 / CW), sp = sb % (8 / CW), unit0 = bh * 128, sl = sp * CW + wid;
    const u32x4* GMb = (const u32x4*)((const bf16_t*)(p.ws + WS_GM) + (size_t)unit0 * 16384);
    const u32x4* GQb = (const u32x4*)((const bf16_t*)(p.ws + WS_GQ) + (size_t)unit0 * 8192);
    const bf16_t* GNb = (const bf16_t*)(p.ws + WS_GN) + (size_t)unit0 * 16384;
    bf16_t* GOb = (bf16_t*)(p.ws + WS_GO) + (size_t)unit0 * 8192;
    const float* glast = (const float*)(p.ws + WS_CTL + CTL_GLAST) + unit0;
    const bool loader = (wid >= CW && wid < CW + 4);
#define SCAN_DMA(cc) do { _Pragma("unroll") for (int k = 0; k < 8; ++k) { const int inst = (wid - CW) * 8 + k; \
        __builtin_amdgcn_global_load_lds((const unsigned*)((const char*)(GMb + (size_t)(cc) * 2048) + inst * 1024 + lane * 16), (LAS unsigned*)(lds + ((cc) & 3) * 32768 + inst * 1024), 16, 0, 0); } } while (0)
#define SCAN_LOADN(dn, cc) do { const bf16_t* np_ = GNb + (size_t)((cc) < 128 ? (cc) : 127) * 16384 + (size_t)(sl * 64 + lane) * 32; \
        asm volatile("global_load_dwordx4 %0, %4, off\n\tglobal_load_dwordx4 %1, %4, off offset:16\n\tglobal_load_dwordx4 %2, %4, off offset:32\n\tglobal_load_dwordx4 %3, %4, off offset:48" \
            : "=&v"(dn[0]), "=&v"(dn[1]), "=&v"(dn[2]), "=&v"(dn[3]) : "v"(np_) : "memory"); } while (0)
#define SCAN_WAITN(dn, N) asm volatile("s_waitcnt vmcnt(" #N ")" : "+v"(dn[0]), "+v"(dn[1]), "+v"(dn[2]), "+v"(dn[3]) :: "memory")
#define SCAN_STEP(c, nn, RELOAD) do { \
        SCAN_WAITN(nn, 8); \
        const float gl = __shfl(((c) < 64) ? glr0 : glr1, (c) & 63); bf16x8 Sb[4]; \
        bf16_t* scp = (bf16_t*)GNb + (size_t)(c) * 16384 + (size_t)sl * 2048 + lane * 8; \
        _Pragma("unroll") for (int ks = 0; ks < 4; ++ks) { u32x4 w; w.x = cvt_pk(S[2 * ks][0], S[2 * ks][1]); w.y = cvt_pk(S[2 * ks][2], S[2 * ks][3]); \
            w.z = cvt_pk(S[2 * ks + 1][0], S[2 * ks + 1][1]); w.w = cvt_pk(S[2 * ks + 1][2], S[2 * ks + 1][3]); Sb[ks] = __builtin_bit_cast(bf16x8, w); } \
        const LAS unsigned char* slot = lds + ((c) & 3) * 32768 + lane * 16; \
        bf16x8 fa[2][2][4]; \
        _Pragma("unroll") for (int ks = 0; ks < 4; ++ks) { fa[0][0][ks] = *(const LAS bf16x8*)(slot + (0 * 4 + ks) * 1024); fa[0][1][ks] = *(const LAS bf16x8*)(slot + (1 * 4 + ks) * 1024); } \
        _Pragma("unroll") for (int mt = 0; mt < 8; ++mt) { const unsigned w0 = nn[mt >> 1][(mt & 1) * 2], w1 = nn[mt >> 1][(mt & 1) * 2 + 1]; \
            S[mt] = S[mt] * gl + (f32x4){bflo(w0), bfhi(w0), bflo(w1), bfhi(w1)}; } \
        _Pragma("unroll") for (int ks = 0; ks < 4; ++ks) *(u32x4*)(scp + ks * 512) = __builtin_bit_cast(u32x4, Sb[ks]);     \
        RELOAD; \
        _Pragma("unroll") for (int pr = 0; pr < 4; ++pr) { \
            if (pr < 3) { _Pragma("unroll") for (int ks = 0; ks < 4; ++ks) { fa[(pr + 1) & 1][0][ks] = *(const LAS bf16x8*)(slot + ((2 * pr + 2) * 4 + ks) * 1024); fa[(pr + 1) & 1][1][ks] = *(const LAS bf16x8*)(slot + ((2 * pr + 3) * 4 + ks) * 1024); } } \
            _Pragma("unroll") for (int ks = 0; ks < 4; ++ks) { S[2 * pr] = mfma16(fa[pr & 1][0][ks], Sb[ks], S[2 * pr]); S[2 * pr + 1] = mfma16(fa[pr & 1][1][ks], Sb[ks], S[2 * pr + 1]); } } \
        } while (0)
    if (loader) { SCAN_DMA(0); SCAN_DMA(1); SCAN_DMA(2); asm volatile("s_waitcnt vmcnt(0)" ::: "memory"); }
    f32x4 S[8];
#pragma unroll
    for (int mt = 0; mt < 8; ++mt) S[mt] = (f32x4){0.f, 0.f, 0.f, 0.f};
    float glr0 = glast[lane], glr1 = glast[64 + lane];
    asm volatile("" : "+v"(glr0), "+v"(glr1));
    u32x4 nnA[4], nnB[4];
    if (wid < CW) { SCAN_LOADN(nnA, 0); SCAN_LOADN(nnB, 1); SCAN_WAITN(nnA, 0); SCAN_WAITN(nnB, 0); }
    asm volatile("s_waitcnt lgkmcnt(0)" ::: "memory"); __builtin_amdgcn_s_barrier(); asm volatile("" ::: "memory");
#pragma unroll 1
    for (int c = 0; c < 128; c += 2) {
        if (loader) { if (c + 3 < 128) { SCAN_DMA(c + 3); asm volatile("s_waitcnt vmcnt(16)" ::: "memory"); } else asm volatile("s_waitcnt vmcnt(0)" ::: "memory"); }
        else if (wid < CW) { SCAN_STEP(c, nnA, SCAN_LOADN(nnA, c + 2)); }
        asm volatile("s_waitcnt lgkmcnt(0)" ::: "memory"); __builtin_amdgcn_s_barrier(); asm volatile("" ::: "memory");
        if (loader) { if (c + 4 < 128) { SCAN_DMA(c + 4); asm volatile("s_waitcnt vmcnt(16)" ::: "memory"); } else asm volatile("s_waitcnt vmcnt(0)" ::: "memory"); }
        else if (wid < CW) { SCAN_STEP(c + 1, nnB, SCAN_LOADN(nnB, c + 3)); }
        asm volatile("s_waitcnt lgkmcnt(0)" ::: "memory"); __builtin_amdgcn_s_barrier(); asm volatile("" ::: "memory");
    }
#undef SCAN_DMA
#undef SCAN_LOADN
#undef SCAN_WAITN
#undef SCAN_STEP
    __syncthreads();
    if (wid < CW) {
        float* go = p.out + O_GP + (size_t)bh * 16384;
#pragma unroll
        for (int mt = 0; mt < 8; ++mt)
#pragma unroll
            for (int e = 0; e < 4; ++e) go[(16 * mt + 4 * fq + e) * 128 + sl * 16 + fr] = S[mt][e];
    }
}

__device__ __forceinline__ void gdn_gate_unit(const Params& p, int unit, int lane) {
    const int fr = lane & 15, fq = lane >> 4, bh = unit >> 7, n = unit & 127, b = bh >> 2, h = bh & 3, tok0 = b * SEQ + n * 64;
    const bf16_t* GO = (const bf16_t*)(p.ws + WS_GO) + (size_t)unit * 8192;
    bf16_t* PB = (bf16_t*)(p.ws + WS_H);
    {
        bf16_t* GOw = (bf16_t*)(p.ws + WS_GO) + (size_t)unit * 8192;
        const bf16_t* GQ = (const bf16_t*)(p.ws + WS_GQ) + (size_t)unit * 8192; const bf16_t* SC = (const bf16_t*)(p.ws + WS_GN) + (size_t)unit * 16384;
        bf16x8 qa[4][4];
#pragma unroll
        for (int mt = 0; mt < 4; ++mt)
#pragma unroll
            for (int ks = 0; ks < 4; ++ks) qa[mt][ks] = *(const bf16x8*)(GQ + ((mt * 4 + ks) * 64 + lane) * 8);
#pragma unroll 2
        for (int nt = 0; nt < 8; ++nt) {
            bf16x8 sb[4];
#pragma unroll
            for (int ks = 0; ks < 4; ++ks) sb[ks] = *(const bf16x8*)(SC + nt * 2048 + (ks * 64 + lane) * 8);
            const u32x4 o0 = *(const u32x4*)(GOw + (nt * 64 + lane) * 16), o1 = *(const u32x4*)(GOw + (nt * 64 + lane) * 16 + 8);
            f32x4 acc[4];
            acc[0] = (f32x4){bflo(o0.x), bfhi(o0.x), bflo(o0.y), bfhi(o0.y)}; acc[1] = (f32x4){bflo(o0.z), bfhi(o0.z), bflo(o0.w), bfhi(o0.w)};
            acc[2] = (f32x4){bflo(o1.x), bfhi(o1.x), bflo(o1.y), bfhi(o1.y)}; acc[3] = (f32x4){bflo(o1.z), bfhi(o1.z), bflo(o1.w), bfhi(o1.w)};
#pragma unroll
            for (int ks = 0; ks < 4; ++ks)
#pragma unroll
                for (int mt = 0; mt < 4; ++mt) acc[mt] = mfma16(qa[mt][ks], sb[ks], acc[mt]);
            u32x4 w0, w1;
            w0.x = cvt_pk(acc[0][0], acc[0][1]); w0.y = cvt_pk(acc[0][2], acc[0][3]); w0.z = cvt_pk(acc[1][0], acc[1][1]); w0.w = cvt_pk(acc[1][2], acc[1][3]);
            w1.x = cvt_pk(acc[2][0], acc[2][1]); w1.y = cvt_pk(acc[2][2], acc[2][3]); w1.z = cvt_pk(acc[3][0], acc[3][1]); w1.w = cvt_pk(acc[3][2], acc[3][3]);
            *(u32x4*)(GOw + (nt * 64 + lane) * 16) = w0; *(u32x4*)(GOw + (nt * 64 + lane) * 16 + 8) = w1;
        }
        asm volatile("s_waitcnt vmcnt(0)" ::: "memory");
    }
    float ssq[16];
#pragma unroll
    for (int k = 0; k < 16; ++k) ssq[k] = 0.f;
#pragma unroll 1
    for (int nt = 0; nt < 8; ++nt) {
        const u32x4 a0 = *(const u32x4*)(GO + (nt * 64 + lane) * 16), a1 = *(const u32x4*)(GO + (nt * 64 + lane) * 16 + 8);
#pragma unroll
        for (int k = 0; k < 4; ++k) { const float l0 = bflo(a0[k]), h0 = bfhi(a0[k]), l1 = bflo(a1[k]), h1 = bfhi(a1[k]);
            ssq[2 * k] += l0 * l0; ssq[2 * k + 1] += h0 * h0; ssq[8 + 2 * k] += l1 * l1; ssq[8 + 2 * k + 1] += h1 * h1; }
    }
#pragma unroll
    for (int k = 0; k < 16; ++k) { float s = ssq[k]; s += __shfl_xor(s, 1); s += __shfl_xor(s, 2); s += __shfl_xor(s, 4); s += __shfl_xor(s, 8); ssq[k] = rsqrtf(s * (1.0f / 128.0f) + EPS); }
    const float* gn = p.in[15];
#pragma unroll 1
    for (int nt = 0; nt < 8; ++nt) {
        const int dv = 16 * nt + fr; const float g = gn[dv];
        const u32x4 a0 = *(const u32x4*)(GO + (nt * 64 + lane) * 16), a1 = *(const u32x4*)(GO + (nt * 64 + lane) * 16 + 8);
        const bf16_t* gzp = PB + (size_t)(tok0 + 4 * fq) * PW + 2304 + h * 128 + dv; bf16_t* mp = PB + (size_t)(tok0 + 4 * fq) * PW + 512 + h * 128 + dv;
#pragma unroll
        for (int k = 0; k < 16; ++k) {
            const unsigned w = (k < 8) ? a0[(k >> 1) & 3] : a1[(k >> 1) & 3]; const float o = (k & 1) ? bfhi(w) : bflo(w);
            const int to = 16 * (k >> 2) + (k & 3);
            const float gz = bf2f(gzp[(size_t)to * PW]);
            mp[(size_t)to * PW] = f2bf(o * ssq[k] * g * silu(gz));
        }
    }
}

__device__ __forceinline__ void attn_unit(const Params& p, LAS unsigned char* lds, int unit) {
    const int tid = threadIdx.x, lane = tid & 63, wid = tid >> 6, fr = lane & 15, fq = lane >> 4;
    const int b = unit >> 7, blk = (unit >> 1) & 63, kvh = unit & 1;
    LAS bf16_t* Ks = (LAS bf16_t*)lds; LAS bf16_t* Vt = (LAS bf16_t*)(lds + 36864);
    bf16_t* PB = (bf16_t*)(p.ws + WS_H);
    __syncthreads();
#pragma unroll
    for (int i = 0; i < 4; ++i) {
        const int q = tid + 512 * i, row = q >> 3, ch = q & 7, tp = blk * 128 - 128 + row;
        u32x4 kv = (u32x4){0u, 0u, 0u, 0u}, vv = (u32x4){0u, 0u, 0u, 0u};
        if (tp >= 0) { const bf16_t* base = PB + (size_t)(b * SEQ + tp) * PW; kv = *(const u32x4*)(base + 512 + kvh * 64 + ch * 8); vv = *(const u32x4*)(base + 640 + kvh * 64 + ch * 8); }
        *(LAS u32x4*)(Ks + row * 72 + ch * 8) = kv;
#pragma unroll
        for (int e = 0; e < 4; ++e) { const unsigned w = vv[e]; Vt[(ch * 8 + 2 * e) * 264 + row] = (bf16_t)(w & 0xffffu); Vt[(ch * 8 + 2 * e + 1) * 264 + row] = (bf16_t)(w >> 16); }
    }
    __syncthreads();
    const int qtok = b * SEQ + blk * 128 + 16 * wid + fr;
#pragma unroll 1
    for (int g = 0; g < 4; ++g) {
        const int h = kvh * 4 + g; const float slope = exp2f(-(float)(h + 1)), sink = p.in[11][h];
        bf16x8 qf[2];
#pragma unroll
        for (int ks = 0; ks < 2; ++ks) qf[ks] = *(const bf16x8*)(PB + (size_t)qtok * PW + h * 64 + ks * 32 + 8 * fq);
        f32x4 s[10]; float mx = sink;
#pragma unroll
        for (int j = 0; j < 10; ++j) {
            const int ct = (wid + j) < 15 ? (wid + j) : 15;
            f32x4 acc = (f32x4){0.f, 0.f, 0.f, 0.f};
#pragma unroll
            for (int ks = 0; ks < 2; ++ks) acc = mfma16(*(const LAS bf16x8*)(Ks + (16 * ct + fr) * 72 + ks * 32 + 8 * fq), qf[ks], acc);
#pragma unroll
            for (int e = 0; e < 4; ++e) {
                const int c = 16 * (wid + j) + 4 * fq + e, dist = 16 * wid + fr - c + 128;
                const bool ok = (wid + j <= 15) && dist >= 0 && dist <= 128 && (blk * 128 + c - 128 >= 0);
                const float v = ok ? acc[e] * 0.125f - slope * (float)dist : -INFINITY;
                acc[e] = v; mx = fmaxf(mx, v);
            }
            s[j] = acc;
            asm volatile("" ::: "memory");
        }
        mx = fmaxf(mx, __shfl_xor(mx, 16)); mx = fmaxf(mx, __shfl_xor(mx, 32));
        float sum = 0.f;
#pragma unroll
        for (int j = 0; j < 10; ++j)
#pragma unroll
            for (int e = 0; e < 4; ++e) { const float pv = __expf(s[j][e] - mx); s[j][e] = pv; sum += pv; }
        sum += __shfl_xor(sum, 16); sum += __shfl_xor(sum, 32);
        sum += __expf(sink - mx);
        const float inv = 1.0f / sum;
        bf16x8 pb[5];
#pragma unroll
        for (int kk = 0; kk < 5; ++kk) { u32x4 w; w.x = cvt_pk(s[2 * kk][0] * inv, s[2 * kk][1] * inv); w.y = cvt_pk(s[2 * kk][2] * inv, s[2 * kk][3] * inv);
            w.z = cvt_pk(s[2 * kk + 1][0] * inv, s[2 * kk + 1][1] * inv); w.w = cvt_pk(s[2 * kk + 1][2] * inv, s[2 * kk + 1][3] * inv); pb[kk] = __builtin_bit_cast(bf16x8, w); }
#pragma unroll
        for (int dt = 0; dt < 4; ++dt) {
            f32x4 acc = (f32x4){0.f, 0.f, 0.f, 0.f};
#pragma unroll
            for (int kk = 0; kk < 5; ++kk) {
                const int c0 = (wid + 2 * kk) < 15 ? (wid + 2 * kk) : 15, c1 = (wid + 2 * kk + 1) < 15 ? (wid + 2 * kk + 1) : 15;
                const u32x2 lo = *(const LAS u32x2*)(Vt + (16 * dt + fr) * 264 + 16 * c0 + 4 * fq), hi = *(const LAS u32x2*)(Vt + (16 * dt + fr) * 264 + 16 * c1 + 4 * fq);
                const u32x4 a = (u32x4){lo.x, lo.y, hi.x, hi.y};
                acc = mfma16(__builtin_bit_cast(bf16x8, a), pb[kk], acc);
            }
            u32x2 w; w.x = cvt_pk(acc[0], acc[1]); w.y = cvt_pk(acc[2], acc[3]);
            *(u32x2*)(PB + (size_t)qtok * PW + h * 64 + 16 * dt + 4 * fq) = w;
            asm volatile("" ::: "memory");
        }
    }
}

__device__ __forceinline__ void sattn_unit(const Params& p, int s, int h, int lane) {
    const int kvh = h >> 2; const bool wr = (h & 3) == 0;
    bf16_t* PB = (bf16_t*)(p.ws + WS_H) + (size_t)(MPR + s) * PW;
    const float* ck = p.in[2] + (size_t)s * 128 * 128 + kvh * 64 + lane; const float* cv = p.in[3] + (size_t)s * 128 * 128 + kvh * 64 + lane;
    float* nk = p.out + O_KS + (size_t)s * 128 * 128 + kvh * 64 + lane; float* nv = p.out + O_VS + (size_t)s * 128 * 128 + kvh * 64 + lane;
    const float q = bf2f(PB[h * 64 + lane]) * 0.125f, slope = exp2f(-(float)(h + 1)), sink = p.in[11][h];
    const float knew = bf2f(PB[512 + kvh * 64 + lane]), vnew = bf2f(PB[640 + kvh * 64 + lane]);
    float sc[3];
#pragma unroll
    for (int t = 0; t < 2; ++t) {
#pragma unroll 8
        for (int jj = 0; jj < 64; ++jj) {
            const int j = t * 64 + jj; const float kval = ck[(size_t)j * 128];
            if (wr && j >= 1) nk[(size_t)(j - 1) * 128] = kval;
            const float d = wave_sum(q * kval) - slope * (float)(128 - j); if (lane == jj) sc[t] = d;
        }
    }
    if (wr) nk[(size_t)127 * 128] = knew;
    sc[2] = wave_sum(q * knew);
    const float mx = fmaxf(fmaxf(wave_max(fmaxf(sc[0], sc[1])), sc[2]), sink);
    const float p0 = __expf(sc[0] - mx), p1 = __expf(sc[1] - mx), p2 = __expf(sc[2] - mx);
    const float inv = 1.0f / (wave_sum(p0 + p1) + p2 + __expf(sink - mx));
    float o = p2 * vnew;
#pragma unroll 8
    for (int jj = 0; jj < 64; ++jj) { const float vval = cv[(size_t)jj * 128]; if (wr && jj >= 1) nv[(size_t)(jj - 1) * 128] = vval; o += __shfl(p0, jj) * vval; }
#pragma unroll 8
    for (int jj = 0; jj < 64; ++jj) { const float vval = cv[(size_t)(64 + jj) * 128]; if (wr) nv[(size_t)(63 + jj) * 128] = vval; o += __shfl(p1, jj) * vval; }
    if (wr) nv[(size_t)127 * 128] = vnew;
    asm volatile("" ::: "memory");
    PB[h * 64 + lane] = f2bf(o * inv);
}

__device__ __forceinline__ void sgdn_unit(const Params& p, LAS unsigned char* lds, int s) {
    const int tid = threadIdx.x, wid = tid >> 6, h = tid >> 7, dv = tid & 127;
    LAS float* qs = (LAS float*)lds; LAS float* ks = qs + 512; LAS float* red = ks + 512;
    bf16_t* PB = (bf16_t*)(p.ws + WS_H) + (size_t)(MPR + s) * PW; const float* GBA = (const float*)(p.ws + WS_GBA) + (size_t)(MPR + s) * 8;
    const float* cw = p.in[12]; const float* hc = p.in[4] + (size_t)s * 3 * CONVC; float* nc = p.out + O_CS + (size_t)s * 3 * CONVC;
    __syncthreads();
    float val[3];
#pragma unroll
    for (int i = 0; i < 3; ++i) {
        const int c = i * 512 + tid; const float x3 = bf2f(PB[768 + c]), h0 = hc[c], h1 = hc[CONVC + c], h2 = hc[2 * CONVC + c];
        val[i] = silu(cw[c] * h0 + cw[CONVC + c] * h1 + cw[2 * CONVC + c] * h2 + cw[3 * CONVC + c] * x3);
        nc[c] = h1; nc[CONVC + c] = h2; nc[2 * CONVC + c] = x3;
    }
    const float sq = wave_sum(val[0] * val[0]), sk = wave_sum(val[1] * val[1]);
    if ((tid & 63) == 0) { red[wid] = sq; red[8 + wid] = sk; }
    __syncthreads();
    const float ssq = red[2 * h] + red[2 * h + 1], ssk = red[8 + 2 * h] + red[8 + 2 * h + 1];
    qs[tid] = val[0] * rsqrtf(ssq + EPS) * 0.08838834764831845f; ks[tid] = val[1] * rsqrtf(ssk + EPS);
    __syncthreads();
    const float beta = 1.0f / (1.0f + __expf(-GBA[h]));
    const float x = GBA[4 + h] + p.in[14][h]; const float sp = x > 20.f ? x : log1pf(__expf(x));
    const float eg = __expf(-__expf(p.in[13][h]) * sp);
    const float* S0 = p.in[5] + ((size_t)(s * 4 + h) * 128) * 128 + dv; float* S1 = p.out + O_GS + ((size_t)(s * 4 + h) * 128) * 128 + dv;
    float kS = 0.f;
#pragma unroll 1
    for (int hf = 0; hf < 4; ++hf) { float sv[32];
#pragma unroll
        for (int dk = 0; dk < 32; ++dk) sv[dk] = S0[(size_t)(hf * 32 + dk) * 128];
#pragma unroll
        for (int dk = 0; dk < 32; ++dk) kS += ks[h * 128 + hf * 32 + dk] * sv[dk]; }
    const float delta = beta * (val[2] - eg * kS);
    float o = 0.f;
#pragma unroll 1
    for (int hf = 0; hf < 4; ++hf) { float sv[32];
#pragma unroll
        for (int dk = 0; dk < 32; ++dk) sv[dk] = S0[(size_t)(hf * 32 + dk) * 128];
#pragma unroll
        for (int dk = 0; dk < 32; ++dk) { const float nvv = eg * sv[dk] + ks[h * 128 + hf * 32 + dk] * delta; S1[(size_t)(hf * 32 + dk) * 128] = nvv; o += qs[h * 128 + hf * 32 + dk] * nvv; } }
    const float so = wave_sum(o * o);
    if ((tid & 63) == 0) red[16 + wid] = so;
    __syncthreads();
    const float tot = red[16 + 2 * h] + red[16 + 2 * h + 1];
    const float gz = bf2f(PB[2304 + tid]);
    PB[512 + tid] = f2bf(o * rsqrtf(tot * (1.0f / 128.0f) + EPS) * p.in[15][dv] * silu(gz));
}

#define XB_TMO      128
#define XB_XCNT(j)  (256  + 64 * (j))
#define XB_XSUB(j)  (1280 + 64 * (j))
#define XB_XGEN(j)  (2304 + 64 * (j))
#define XB_TOP      3328
#define XB_TOPGEN   3392
#define XCD_BAR_WORDS 3456
#define XB_SPIN_CAP (1u << 18)

__device__ __forceinline__ unsigned xb_ld(unsigned* p)              { return __hip_atomic_load(p, __ATOMIC_RELAXED, __HIP_MEMORY_SCOPE_AGENT); }
__device__ __forceinline__ unsigned xb_add(unsigned* p, unsigned v) { return __hip_atomic_fetch_add(p, v, __ATOMIC_RELAXED, __HIP_MEMORY_SCOPE_AGENT); }
__device__ __forceinline__ unsigned xb_xcc_id() { return (unsigned)__builtin_amdgcn_s_getreg((3 << 11) | 20) & 0xFu; }
#define XB_SPIN(cond, bar) do { unsigned _sp = 0; while (cond) { __builtin_amdgcn_s_sleep(1); \
    if ((++_sp & 255u) == 0u) { if (xb_ld(&(bar)[XB_TMO])) break; if (_sp > XB_SPIN_CAP) { atomicAdd(&(bar)[XB_TMO], 1u); break; } } } } while (0)

struct XcdBarrier {
    unsigned* bar; unsigned x;
    volatile LAS unsigned* st;
};

__device__ __forceinline__ XcdBarrier xcd_barrier_post(unsigned* bar, volatile LAS unsigned* st) {
    XcdBarrier b; b.bar = bar; b.x = xb_xcc_id(); b.st = st;
    if (threadIdx.x == 0) (void)xb_add(&bar[XB_XCNT(b.x)], 1u);
    return b;
}
__device__ __forceinline__ void xcd_barrier_complete(unsigned* bar, unsigned x, unsigned& nloc, unsigned& nx) {
    const unsigned G = gridDim.x * gridDim.y * gridDim.z;
    unsigned sum, cnt, mine, sp = 0u;
    for (;;) {
        sum = 0u; cnt = 0u; mine = 0u;
#pragma unroll
        for (unsigned j = 0; j < 16; ++j) { const unsigned c = xb_ld(&bar[XB_XCNT(j)]); sum += c; cnt += (c > 0u) ? 1u : 0u; mine = (j == x) ? c : mine; }
        if (sum == G) break;
        __builtin_amdgcn_s_sleep(1);
        if ((++sp & 255u) == 0u) { if (xb_ld(&bar[XB_TMO])) break; if (sp > XB_SPIN_CAP) { atomicAdd(&bar[XB_TMO], 1u); break; } }
    }
    nloc = mine > 0u ? mine : 1u; nx = cnt > 0u ? cnt : 1u;
}

__device__ __forceinline__ void xcd_barrier(const XcdBarrier& b) {
    asm volatile("s_waitcnt vmcnt(0)" ::: "memory");
    __syncthreads();
    if (threadIdx.x == 0) {
        unsigned* bar = b.bar;
        __builtin_amdgcn_s_waitcnt(0);
        unsigned nloc = b.st[0], nx = b.st[1];
        if (nloc == 0u) { xcd_barrier_complete(bar, b.x, nloc, nx); b.st[0] = nloc; b.st[1] = nx; }
        const unsigned old = xb_add(&bar[XB_XSUB(b.x)], 1u);
        const unsigned gen = old / nloc;
        if (old + 1u == (gen + 1u) * nloc) {
            __builtin_amdgcn_fence(__ATOMIC_RELEASE, "agent");
            asm volatile("s_waitcnt vmcnt(0)" ::: "memory");
            const unsigned og = xb_add(&bar[XB_TOP], 1u);
            const unsigned tg = og / nx;
            if (og + 1u == (tg + 1u) * nx) xb_add(&bar[XB_TOPGEN], 1u);
            else XB_SPIN(xb_ld(&bar[XB_TOPGEN]) == tg, bar);
            __builtin_amdgcn_fence(__ATOMIC_ACQUIRE, "agent");
            xb_add(&bar[XB_XGEN(b.x)], 1u);
            asm volatile("s_waitcnt vmcnt(0)" ::: "memory");
        } else {
            XB_SPIN(xb_ld(&bar[XB_XGEN(b.x)]) == gen, bar);
            __builtin_amdgcn_fence(__ATOMIC_ACQUIRE, "agent");
            asm volatile("s_waitcnt vmcnt(0)" ::: "memory");
        }
    }
    __syncthreads();
}

__global__ void __launch_bounds__(512, 2) fwd_kernel(Params p, int ph_lo, int ph_hi) {
    extern __shared__ __attribute__((aligned(16))) unsigned char lds_raw[];
    LAS unsigned char* lds = (LAS unsigned char*)lds_raw;
    cg::grid_group grid = cg::this_grid();
    if (ph_lo < 0) grid.sync();
    volatile LAS unsigned* bst = (volatile LAS unsigned*)(lds + LDS_PHASE_BYTES);
    if (threadIdx.x < 2) bst[threadIdx.x] = 0u;
    __syncthreads();
    XcdBarrier xbar; xbar.bar = (unsigned*)(p.ws + WS_CTL + CTL_BAR); xbar.x = 0; xbar.st = bst;
    if (ph_hi - ph_lo > 1) xbar = xcd_barrier_post((unsigned*)(p.ws + WS_CTL + CTL_BAR), bst);
    const int tid = threadIdx.x, lane = tid & 63, wid = tid >> 6, G = gridDim.x, bx = blockIdx.x;
    unsigned char* ws = p.ws;
    bf16_t* XN = (bf16_t*)(ws + WS_XN); bf16_t* XN2 = (bf16_t*)(ws + WS_XN2); bf16_t* HB = (bf16_t*)(ws + WS_H);
    float* SS1 = (float*)(ws + WS_SSP1); float* SS2 = (float*)(ws + WS_SSP2);
    float* Y = p.out; float* X2 = (float*)(ws + WS_GM); float* X3 = (float*)(ws + WS_XN);
#ifndef PHMASK
#define PHMASK 0x7ff
#endif
#define IN(k) (((PHMASK >> (k)) & 1) && ph_lo <= (k) && (k) < ph_hi)
#define SEAM(k) do { if (IN(k) && IN((k) + 1)) { xcd_barrier(xbar); }     } while (0)

    if (IN(0)) p0_prologue(p, lds, bx, G);
    SEAM(0);
    if (IN(1)) {
        if (bx < 176) sk_ffn_in<false>(XN, (const bf16_t*)(ws + WS_W1IN), HB, bx, wid, lane & 15, lane >> 4);
        pg8::Gemm g{XN, (const bf16_t*)(ws + WS_W1IN), MPR, 2 * DFF, DM, DM}; pg8::StaticOrder S; S.init(MPR, 2 * DFF, G, bx);
        EpiSwiglu E{HB, nullptr}; pg8::gemm_phase<EpiSwiglu, pg8::StaticOrder>(lds, g, S, E, nullptr);
    }
    SEAM(1);
    if (IN(2)) {
        if (bx < 64) sk_ffn_out<false>(HB, (const bf16_t*)(ws + WS_W1OUT), p.in[1], nullptr, XN + (size_t)MPR * DM, bx, wid, lane & 15, lane >> 4);
        pg8::Gemm g{HB, (const bf16_t*)(ws + WS_W1OUT), MPR, DM, DFF, DFF}; pg8::StaticOrder S; S.init(MPR, DM, G, bx);
        EpiResid<false, false, true, true, true> E{p.in[0], p.in[1], nullptr, XN, SS1}; pg8::gemm_phase<EpiResid<false, false, true, true, true>, pg8::StaticOrder>(lds, g, S, E, nullptr);
    }
    SEAM(2);
    if (IN(3)) {
        if (bx < 89) sk_inproj(XN, (const bf16_t*)(ws + WS_WINMIX), HB, (float*)(ws + WS_GBA), bx, wid, lane & 15, lane >> 4);
        pg8::Gemm g{XN, (const bf16_t*)(ws + WS_WINMIX), MPR, NINP, DM, DM}; pg8::StaticOrder S; S.init(MPR, NINP, G, bx);
        EpiInproj E{HB, (float*)(ws + WS_GBA), SS1}; pg8::gemm_phase<EpiInproj, pg8::StaticOrder>(lds, g, S, E, nullptr);
    }
    SEAM(3);
    if (IN(4)) {
        for (int u = bx; u < 2048; u += G) gdn_prep_unit(p, lds, u);
    }
    SEAM(4);
    if (IN(5)) {
        if (bx < NSCAN) gdn_scan(p, lds, bx);
        else {
            const int ab = bx - NSCAN, NAB = G - NSCAN;
            if (NAB == 192) {
                if (ab < 128) { sattn_unit(p, ab, wid, lane); sgdn_unit(p, lds, ab); attn_unit(p, lds, 2 * ab); attn_unit(p, lds, 2 * ab + 1); }
                else { for (int k = 0; k < 4; ++k) attn_unit(p, lds, 256 + (ab - 128) * 4 + k); }
            } else {
                int it = ab;
#pragma unroll 1
                for (; it < 512; it += NAB) attn_unit(p, lds, it);
#pragma unroll 1
                for (; it < 640; it += NAB) { sattn_unit(p, it - 512, wid, lane); sgdn_unit(p, lds, it - 512); }
            }
            const bf16_t* PB = HB;
            for (int idx = ab * 512 + tid; idx < 149504; idx += NAB * 512) {
                if (idx < 131072) { const int w = idx >> 16, r = idx & 65535, b = r >> 14, j = (r >> 7) & 127, c = r & 127;
                    p.out[(w ? O_VP : O_KP) + r] = bf2f(PB[(size_t)(b * SEQ + SEQ - 128 + j) * PW + 512 + w * 128 + c]);
                } else { const int r = idx - 131072, b = r / (3 * CONVC), q = r % (3 * CONVC), rr = q / CONVC, c = q % CONVC;
                    p.out[O_CP + r] = bf2f(PB[(size_t)(b * SEQ + SEQ - 3 + rr) * PW + 768 + c]); }
            }
        }
    }
    SEAM(5);
    if (IN(6)) {
        for (int u = bx * 8 + wid; u < 2048; u += G * 8) gdn_gate_unit(p, u, lane);
    }
    SEAM(6);
#ifdef DBG_DUMP
    if (ph_lo == 11) {
        const float* src = (const float*)(ws + DBG_SRC);
        for (size_t i = (size_t)bx * 512 + tid; i < (size_t)MREAL * DM; i += (size_t)G * 512) Y[i] = (i < (size_t)MREAL * 8) ? ((const float*)(ws + WS_GBA))[i] : 0.f;
    }
#endif
    if (IN(7)) {
        if (bx < 32) sk_outproj(HB, (const bf16_t*)(ws + WS_WOUTMIX), XN, X2, XN2, bx, wid, lane & 15, lane >> 4);
        pg8::Gemm g{HB, (const bf16_t*)(ws + WS_WOUTMIX), MPR, DM, DM, PW}; pg8::StaticOrder S; S.init(MPR, DM, G, bx);
        EpiResid<true, true, true, true, false> E{XN, XN + (size_t)MPR * DM, X2, XN2, SS2}; pg8::gemm_phase<EpiResid<true, true, true, true, false>, pg8::StaticOrder>(lds, g, S, E, nullptr);
    }
    SEAM(7);
    if (IN(8)) {
        if (bx < 176) sk_ffn_in<true>(XN2, (const bf16_t*)(ws + WS_W2IN), HB, bx, wid, lane & 15, lane >> 4);
        pg8::Gemm g{XN2, (const bf16_t*)(ws + WS_W2IN), MPR, 2 * DFF, DM, DM}; pg8::StaticOrder S; S.init(MPR, 2 * DFF, G, bx);
        EpiSwiglu E{HB, SS2}; pg8::gemm_phase<EpiSwiglu, pg8::StaticOrder>(lds, g, S, E, nullptr);
    }
    SEAM(8);
    if (IN(9)) {
        if (bx < 64) sk_ffn_out<true>(HB, (const bf16_t*)(ws + WS_W2OUT), X2 + (size_t)MPR * DM, X3 + (size_t)MPR * DM, nullptr, bx, wid, lane & 15, lane >> 4);
        pg8::Gemm g{HB, (const bf16_t*)(ws + WS_W2OUT), MPR, DM, DFF, DFF}; pg8::StaticOrder S; S.init(MPR, DM, G, bx);
        EpiResid<false, true, false, false, true> E{X2, X2 + (size_t)MPR * DM, X3, nullptr, nullptr}; pg8::gemm_phase<EpiResid<false, true, false, false, true>, pg8::StaticOrder>(lds, g, S, E, nullptr);
    }
    SEAM(9);
    if (IN(10)) {
        const float* gf = p.in[20]; f32x4 gv[4];
#pragma unroll
        for (int j = 0; j < 4; ++j) gv[j] = *((const f32x4*)gf + lane + 64 * j);
        {
            f32x4 v[4], vn[4]; int m = bx * 8 + wid;
            if (m < MREAL) { const f32x4* xr = (const f32x4*)(X3 + (size_t)m * DM) + lane;
#pragma unroll
                for (int j = 0; j < 4; ++j) v[j] = xr[64 * j]; }
            for (; m < MREAL; m += G * 8) {
                const int mn = m + G * 8;
                if (mn < MREAL) { const f32x4* xr = (const f32x4*)(X3 + (size_t)mn * DM) + lane;
#pragma unroll
                    for (int j = 0; j < 4; ++j) vn[j] = xr[64 * j]; }
                float s = 0.f;
#pragma unroll
                for (int j = 0; j < 4; ++j) s += (v[j][0] * v[j][0] + v[j][1] * v[j][1]) + (v[j][2] * v[j][2] + v[j][3] * v[j][3]);
                const float rstd = rsqrtf(wave_sum(s) * (1.0f / DM) + EPS);
                f32x4* yr = (f32x4*)(Y + (size_t)m * DM) + lane;
#pragma unroll
                for (int j = 0; j < 4; ++j) yr[64 * j] = v[j] * rstd * gv[j];
#pragma unroll
                for (int j = 0; j < 4; ++j) v[j] = vn[j];
            }
        }
    }
#undef IN
#undef SEAM
}
}

#ifndef MK_N_LAUNCHES
#define MK_N_LAUNCHES 1
#endif
extern "C" void kernel_launch(void* const* d_in, const int* in_sizes, int n_in, void* d_out, int out_size, void* d_ws, size_t ws_size, hipStream_t stream) {
    static int grid = 0;
    if (grid == 0) {
        if (n_in != 21 || ws_size < mk::WS_END || out_size != 47269888) { fprintf(stderr, "kernel_launch: unexpected shapes (n_in %d, ws %zu, out %d)\n", n_in, ws_size, out_size); grid = -1; return; }
        int dev = 0, cus = 0, per_cu = 0;
        (void)hipGetDevice(&dev); (void)hipDeviceGetAttribute(&cus, hipDeviceAttributeMultiprocessorCount, dev);
        if (hipFuncSetAttribute((const void*)mk::fwd_kernel, hipFuncAttributeMaxDynamicSharedMemorySize, mk::LDS_BYTES) != hipSuccess) { fprintf(stderr, "kernel_launch: hipFuncSetAttribute failed\n"); grid = -1; return; }
        if (hipOccupancyMaxActiveBlocksPerMultiprocessor(&per_cu, (const void*)mk::fwd_kernel, 512, mk::LDS_BYTES) != hipSuccess || per_cu < 1) { fprintf(stderr, "kernel_launch: occupancy query failed (%d)\n", per_cu); per_cu = 1; }
        (void)hipGetLastError();
        grid = cus * per_cu;
        if (grid <= mk::NSCAN) { fprintf(stderr, "kernel_launch: grid %d too small\n", grid); grid = -1; return; }
    }
    if (grid < 0) return;
    (void)hipMemsetAsync((char*)d_ws + mk::WS_CTL + mk::CTL_BAR, 0, mk::CTL_BAR_BYTES, stream);
    mk::Params p{};
    for (int i = 0; i < 21; ++i) p.in[i] = (const float*)d_in[i];
    p.out = (float*)d_out; p.ws = (unsigned char*)d_ws;
#if MK_N_LAUNCHES == 1
    int lo = 0, hi = 11; void* args[] = {&p, &lo, &hi};
    hipError_t e = hipLaunchCooperativeKernel((const void*)mk::fwd_kernel, dim3(grid), dim3(512), args, mk::LDS_BYTES, stream);
    if (e != hipSuccess) fprintf(stderr, "kernel_launch: cooperative launch failed: %s (grid %d)\n", hipGetErrorString(e), grid);
#else
#ifndef MK_LAST
#define MK_LAST 11
#ifndef MK_DOUBLE
#define MK_DOUBLE 0x0
#endif
#define DBG_C0 512
#define DBG_C1 1024
#endif
    for (int ph = 0; ph < MK_LAST; ++ph) { const int reps = ((MK_DOUBLE >> ph) & 1) ? 2 : 1; for (int r = 0; r < reps; ++r) hipLaunchKernelGGL(mk::fwd_kernel, dim3(grid), dim3(512), mk::LDS_BYTES, stream, p, ph, ph + 1); }
#ifdef DBG_DUMP
    hipLaunchKernelGGL(mk::fwd_kernel, dim3(grid), dim3(512), mk::LDS_BYTES, stream, p, 11, 12);
#endif
#endif
}
```

```cpp
#include <hip/hip_runtime.h>
#include <hip/hip_cooperative_groups.h>
#include <cstdio>
namespace cg = cooperative_groups;
namespace pg8 {
#define PG8_LAS __attribute__((address_space(3)))
typedef unsigned short bf16_t;
typedef short bf16x8 __attribute__((ext_vector_type(8)));
typedef float f32x4 __attribute__((ext_vector_type(4)));
typedef unsigned u32x4 __attribute__((ext_vector_type(4)));
constexpr int BM = 256, BK = 64, HALF = 128, HTB = HALF * BK * 2  , STAGE_BYTES = 8 * HTB, NXCD = 8, WGM = 4;

__host__ __device__ __forceinline__ int lds_byte(int r, int c) { const int st = (r >> 4) * 2 + (c >> 5), rr = r & 15, cc = c & 31, ob = rr * 64 + cc * 2; return st * 1024 + (ob ^ (((ob >> 9) & 1) << 5)); }
__host__ __device__ __forceinline__ void stage_rc(int b, int& R, int& C) { const int st = b / 1024, sb = b % 1024, swz = sb ^ (((sb >> 9) & 1) << 5); R = (st >> 1) * 16 + swz / 64; C = (st & 1) * 32 + (swz % 64) / 2; }
__host__ __device__ __forceinline__ int perm32(int rho) { const int n = rho >> 4, i = rho & 15; return 8 * (i >> 2) + 4 * n + (i & 3); }

struct Unit { int pm, pn; };
struct Gemm { const bf16_t* A; const bf16_t* Bt; int M, N, K, lda; };

struct StaticOrder {
    int nM, nN, nwg, G, c, wgm;
    __host__ __device__ void init(int M, int N, int G_, int c_, int wgm_ = WGM) { nM = M / BM; nN = N / BM; nwg = nM * nN; G = G_; c = c_; wgm = wgm_; }
    __host__ __device__ bool next(int i, Unit& u) const {
        const long L = (long)i * G + c; if (L >= nwg) return false;
        int wgid = (int)L; { const int q = nwg / NXCD, r = nwg % NXCD, xcd = wgid % NXCD, off = wgid / NXCD; wgid = (xcd < r ? xcd * (q + 1) : r * (q + 1) + (xcd - r) * q) + off; }
        const int nig = wgm * nN, gid = wgid / nig, fm = gid * wgm, gsz = (nM - fm) < wgm ? (nM - fm) : wgm;
        u.pm = fm + ((wgid % nig) % gsz); u.pn = (wgid % nig) / gsz; return true;
    }
    __device__ __forceinline__ void a_ready(const Unit&) const {}
    __device__ __forceinline__ void done(const Unit&) const {}
};

__device__ __forceinline__ unsigned cvt_pk_bf16(float lo, float hi) { unsigned r; asm volatile("v_cvt_pk_bf16_f32 %0, %1, %2" : "=v"(r) : "v"(lo), "v"(hi)); return r; }
typedef float f32x2 __attribute__((ext_vector_type(2)));
__device__ __forceinline__ f32x2 gelu_pk(f32x2 v) {
    const f32x2 av = __builtin_elementwise_abs(v), d = av * 0.2316418882f + 1.0f;
    f32x2 t; t.x = __builtin_amdgcn_rcpf(d.x); t.y = __builtin_amdgcn_rcpf(d.y);
    f32x2 q = t * 0.5307027145f + (-0.7265760135f); q = q * t + 0.7107068705f; q = q * t + (-0.142248368f); q = q * t + 0.127414796f; q = q * t;
    const f32x2 s = (v * v) * (-0.72134752044f);
    f32x2 e; e.x = __builtin_amdgcn_exp2f(s.x); e.y = __builtin_amdgcn_exp2f(s.y);
    const f32x2 m = v * (q * e), r = v - m;
    f32x2 o; o.x = v.x < 0.f ? m.x : r.x; o.y = v.y < 0.f ? m.y : r.y; return o;
}

template <int ACT  > struct EpiBf16 {
    static constexpr bool PERM = true, AFTER_DRAIN = false; static_assert(ACT == 0 || ACT == 1, "EpiBf16: ACT is 0 (none) or 1 (gelu_pk)");
    bf16_t* O; int ldc; const float* bias; int split_cols; size_t split_stride; float scale0;
    __device__ __forceinline__ void operator()(const f32x4 (&acc)[2][2][4][2], const Unit& u, int wr, int wc, int fr, int fq) const {
        const int row0 = u.pm * BM + wr * 64 + fr; int colt = u.pn * BM; bf16_t* base = O;
        float sc = 1.f; if (split_cols) { const int t = colt / split_cols; base += (size_t)t * split_stride; colt -= t * split_cols; if (t == 0) sc = scale0; }
        const int col0 = colt + wc * 32 + 8 * fq, bcol0 = u.pn * BM + wc * 32 + 8 * fq;
        f32x4 bv[2][2];
#pragma unroll
        for (int bj = 0; bj < 2; ++bj)
#pragma unroll
            for (int n = 0; n < 2; ++n) bv[bj][n] = bias ? *(const f32x4*)(bias + bcol0 + bj * HALF + 4 * n) : (f32x4){0.f, 0.f, 0.f, 0.f};
#pragma unroll
        for (int ai = 0; ai < 2; ++ai)
#pragma unroll
            for (int m = 0; m < 4; ++m) { bf16_t* rowp = base + (size_t)(row0 + ai * HALF + m * 16) * ldc + col0;
#pragma unroll
                for (int bj = 0; bj < 2; ++bj) { f32x4 v0 = acc[ai][bj][m][0] + bv[bj][0], v1 = acc[ai][bj][m][1] + bv[bj][1];
                    if (ACT == 1) { f32x2 a = gelu_pk((f32x2){v0[0], v0[1]}), b = gelu_pk((f32x2){v0[2], v0[3]}), c = gelu_pk((f32x2){v1[0], v1[1]}), d = gelu_pk((f32x2){v1[2], v1[3]});
                        v0 = (f32x4){a.x, a.y, b.x, b.y}; v1 = (f32x4){c.x, c.y, d.x, d.y}; }
                    v0 = v0 * sc; v1 = v1 * sc; u32x4 w; w.x = cvt_pk_bf16(v0[0], v0[1]); w.y = cvt_pk_bf16(v0[2], v0[3]); w.z = cvt_pk_bf16(v1[0], v1[1]); w.w = cvt_pk_bf16(v1[2], v1[3]);
                    *(u32x4*)(rowp + bj * HALF) = w; } }
    }
};

struct PanelStats {
    unsigned* xbuf;
    unsigned* cnt;
    unsigned* tmo;
    int ntn; float eps;
    unsigned code;
    __device__ __forceinline__ bool run(const f32x4 (&v)[2][2][4][2], const Unit& u, int wr, int wc, int fr, int fq, PG8_LAS unsigned char* lds, int wid, int lane) const {
        typedef float f32x2v __attribute__((ext_vector_type(2)));
        PG8_LAS f32x2v* P = (PG8_LAS f32x2v*)lds;
        PG8_LAS f32x2v* S = (PG8_LAS f32x2v*)(lds + 8192);
        PG8_LAS unsigned* flag = (PG8_LAS unsigned*)(lds + 8192 + 2048);
#pragma unroll
        for (int ai = 0; ai < 2; ++ai)
#pragma unroll
            for (int m = 0; m < 4; ++m) {
                float s = 0.f;
#pragma unroll
                for (int bj = 0; bj < 2; ++bj)
#pragma unroll
                    for (int n = 0; n < 2; ++n) { const f32x4 x = v[ai][bj][m][n]; s += (x[0] + x[1]) + (x[2] + x[3]); }
                s += __shfl_xor(s, 16); s += __shfl_xor(s, 32);
                const float mw = s * (1.0f / 64.0f); float q = 0.f;
#pragma unroll
                for (int bj = 0; bj < 2; ++bj)
#pragma unroll
                    for (int n = 0; n < 2; ++n) { const f32x4 d = v[ai][bj][m][n] - mw; q += (d[0] * d[0] + d[1] * d[1]) + (d[2] * d[2] + d[3] * d[3]); }
                q += __shfl_xor(q, 16); q += __shfl_xor(q, 32);
                if (fq == 0) P[(ai * HALF + wr * 64 + m * 16 + fr) * 4 + wc] = (f32x2v){mw, q};
            }
        asm volatile("s_waitcnt lgkmcnt(0)" ::: "memory"); __builtin_amdgcn_s_barrier(); asm volatile("" ::: "memory");
#if defined(BROKEN_EXCHANGE_NO_WAIT)
#warning BROKEN CONTROL BUILD: the row-statistics exchange does not wait; results are wrong by design
        if (blockIdx.x >= 64) { const long long t0_ = clock64(); while (clock64() - t0_ < 60000) __builtin_amdgcn_s_sleep(8); }
#endif
        const int row = wid * 32 + (lane & 31);
        if (lane < 32) {
            const f32x2v a = P[row * 4 + 0], b = P[row * 4 + 1], c = P[row * 4 + 2], d = P[row * 4 + 3];
            const float mt = (a.x + b.x + c.x + d.x) * 0.25f;
            const float da = a.x - mt, db = b.x - mt, dc = c.x - mt, dd = d.x - mt;
            const float m2 = (a.y + b.y) + (c.y + d.y) + 64.0f * ((da * da + db * db) + (dc * dc + dd * dd));
            unsigned long long* slot = (unsigned long long*)xbuf + ((size_t)(u.pm * BM + row) * 4 + u.pn);
            __hip_atomic_store(slot, ((unsigned long long)__float_as_uint(m2) << 32) | __float_as_uint(mt), __ATOMIC_RELAXED, __HIP_MEMORY_SCOPE_AGENT);
        }
        asm volatile("s_waitcnt vmcnt(0)" ::: "memory");
        if (lane == 0) __hip_atomic_fetch_add(cnt + 64 * u.pm, 1u, __ATOMIC_RELAXED, __HIP_MEMORY_SCOPE_AGENT);
        if (wid == 0) {
            bool dead = false; const unsigned long long t0 = __builtin_amdgcn_s_memrealtime(); const unsigned want = 8u * (unsigned)ntn;
            for (;;) {
#if defined(BROKEN_EXCHANGE_NO_WAIT)
                break;
#endif
                if ((unsigned)__builtin_amdgcn_readfirstlane(__hip_atomic_load(cnt + 64 * u.pm, __ATOMIC_RELAXED, __HIP_MEMORY_SCOPE_AGENT)) >= want) break;
                if (__builtin_amdgcn_s_memrealtime() - t0 > 2000000ull) {
                    if (lane == 0) { unsigned expect = 0u; __hip_atomic_compare_exchange_strong(tmo + 1, &expect, code | (unsigned)(u.pm & 0xff), __ATOMIC_RELAXED, __ATOMIC_RELAXED, __HIP_MEMORY_SCOPE_AGENT);
                                     __hip_atomic_store(tmo, 1u, __ATOMIC_RELAXED, __HIP_MEMORY_SCOPE_AGENT); }
                    dead = true; break; }
                __builtin_amdgcn_s_sleep(2);
            }
            __builtin_amdgcn_fence(__ATOMIC_ACQUIRE, "agent");
            if (lane == 0) flag[0] = dead ? 1u : 0u;
        }
        asm volatile("s_waitcnt vmcnt(0) lgkmcnt(0)" ::: "memory"); __builtin_amdgcn_s_barrier(); asm volatile("" ::: "memory");
        const bool bad = flag[0] != 0u;
        if (lane < 32) {
            const unsigned long long* slot = (const unsigned long long*)xbuf + (size_t)(u.pm * BM + row) * 4; float mt[4], m2[4]; float ms = 0.f;
#pragma unroll
            for (int t = 0; t < 4; ++t) { if (t < ntn) { const unsigned long long w = __hip_atomic_load(slot + t, __ATOMIC_RELAXED, __HIP_MEMORY_SCOPE_AGENT); mt[t] = __uint_as_float((unsigned)w); m2[t] = __uint_as_float((unsigned)(w >> 32)); } else { mt[t] = 0.f; m2[t] = 0.f; } ms += mt[t]; }
            const float mean = ms / (float)ntn; float q = 0.f;
#pragma unroll
            for (int t = 0; t < 4; ++t) if (t < ntn) { const float dm = mt[t] - mean; q += m2[t] + 256.0f * dm * dm; }
            S[row] = (f32x2v){mean, 1.0f / sqrtf(q / (256.0f * (float)ntn) + eps)};
        }
        asm volatile("s_waitcnt lgkmcnt(0)" ::: "memory"); __builtin_amdgcn_s_barrier(); asm volatile("" ::: "memory");
        return bad;
    }
};
struct EpiLnRes {
    static constexpr bool PERM = false, AFTER_DRAIN = true;
    const float* base; float* out; int ldc; const float* bias; PanelStats st; unsigned poison;
    __device__ __forceinline__ void fused(f32x4 (&acc)[2][2][4][2], const Unit& u, int wr, int wc, int fr, int fq, PG8_LAS unsigned char* lds, int wid, int lane) const {
        typedef float f32x2v __attribute__((ext_vector_type(2)));
        const PG8_LAS f32x2v* S = (const PG8_LAS f32x2v*)(lds + 8192);
        const int col0 = u.pn * BM + wc * 32 + 4 * fq;
#pragma unroll
        for (int bj = 0; bj < 2; ++bj)
#pragma unroll
            for (int n = 0; n < 2; ++n) { const f32x4 bv = bias ? *(const f32x4*)(bias + col0 + bj * HALF + n * 16) : (f32x4){0.f, 0.f, 0.f, 0.f};
#pragma unroll
                for (int ai = 0; ai < 2; ++ai)
#pragma unroll
                    for (int m = 0; m < 4; ++m) acc[ai][bj][m][n] += bv; }
        f32x4 pre[4][2][2];
#pragma unroll
        for (int m = 0; m < 4; ++m) { const size_t off = (size_t)(u.pm * BM + wr * 64 + m * 16 + fr) * ldc + col0;
#pragma unroll
            for (int bj = 0; bj < 2; ++bj)
#pragma unroll
                for (int n = 0; n < 2; ++n) pre[m][bj][n] = *(const f32x4*)(base + off + bj * HALF + n * 16); }
        const bool bad = st.run(acc, u, wr, wc, fr, fq, lds, wid, lane) || poison != 0u;
        const float qnan = __builtin_nanf("");
#pragma unroll
        for (int ai = 0; ai < 2; ++ai)
#pragma unroll
            for (int m = 0; m < 4; ++m) { const int r = ai * HALF + wr * 64 + m * 16 + fr; const f32x2v sr = S[r]; const size_t off = (size_t)(u.pm * BM + r) * ldc + col0;
#pragma unroll
                for (int bj = 0; bj < 2; ++bj)
#pragma unroll
                    for (int n = 0; n < 2; ++n) { const f32x4 bs = ai == 0 ? pre[m][bj][n] : *(const f32x4*)(base + off + bj * HALF + n * 16); f32x4 o = bs + (acc[ai][bj][m][n] - sr.x) * sr.y;
                        if (bad) o = (f32x4){qnan, qnan, qnan, qnan}; *(f32x4*)(out + off + bj * HALF + n * 16) = o; }
                if (m & 1) asm volatile("" ::: "memory"); }
    }
};
struct EpiLnResLn {
    static constexpr bool PERM = false, AFTER_DRAIN = true;
    const float* base; float* out; bf16_t* xn; int ldc; const float* bias; PanelStats st1, st2; unsigned poison;
    __device__ __forceinline__ void fused(f32x4 (&acc)[2][2][4][2], const Unit& u, int wr, int wc, int fr, int fq, PG8_LAS unsigned char* lds, int wid, int lane) const {
        typedef float f32x2v __attribute__((ext_vector_type(2))); typedef unsigned u32x2v __attribute__((ext_vector_type(2)));
        const PG8_LAS f32x2v* S = (const PG8_LAS f32x2v*)(lds + 8192);
        const int col0 = u.pn * BM + wc * 32 + 4 * fq;
#pragma unroll
        for (int bj = 0; bj < 2; ++bj)
#pragma unroll
            for (int n = 0; n < 2; ++n) { const f32x4 bv = bias ? *(const f32x4*)(bias + col0 + bj * HALF + n * 16) : (f32x4){0.f, 0.f, 0.f, 0.f};
#pragma unroll
                for (int ai = 0; ai < 2; ++ai)
#pragma unroll
                    for (int m = 0; m < 4; ++m) acc[ai][bj][m][n] += bv; }
        bool bad = st1.run(acc, u, wr, wc, fr, fq, lds, wid, lane) || poison != 0u;
        const float qnan = __builtin_nanf("");
#pragma unroll
        for (int ai = 0; ai < 2; ++ai)
#pragma unroll
            for (int m = 0; m < 4; ++m) { const int r = ai * HALF + wr * 64 + m * 16 + fr; const f32x2v sr = S[r]; const size_t off = (size_t)(u.pm * BM + r) * ldc + col0;
#pragma unroll
                for (int bj = 0; bj < 2; ++bj)
#pragma unroll
                    for (int n = 0; n < 2; ++n) { const f32x4 bs = *(const f32x4*)(base + off + bj * HALF + n * 16); acc[ai][bj][m][n] = bs + (acc[ai][bj][m][n] - sr.x) * sr.y; }
                asm volatile("" : "+v"(acc[ai][0][m][0]), "+v"(acc[ai][0][m][1]), "+v"(acc[ai][1][m][0]), "+v"(acc[ai][1][m][1]));
                if (m & 1) asm volatile("" ::: "memory"); }
        const bool bad1 = bad;
        bad = st2.run(acc, u, wr, wc, fr, fq, lds, wid, lane) || bad;
#pragma unroll
        for (int ai = 0; ai < 2; ++ai)
#pragma unroll
            for (int m = 0; m < 4; ++m) { const int r = ai * HALF + wr * 64 + m * 16 + fr; const f32x2v sr = S[r]; const size_t off = (size_t)(u.pm * BM + r) * ldc + col0;
#pragma unroll
                for (int bj = 0; bj < 2; ++bj)
#pragma unroll
                    for (int n = 0; n < 2; ++n) { const f32x4 x1 = acc[ai][bj][m][n]; *(f32x4*)(out + off + bj * HALF + n * 16) = bad1 ? (f32x4){qnan, qnan, qnan, qnan} : x1;
                        const f32x4 o = (x1 - sr.x) * sr.y; u32x2v w; w.x = cvt_pk_bf16(o[0], o[1]); w.y = cvt_pk_bf16(o[2], o[3]);
                        if (bad) { w.x = 0x7fc07fc0u; w.y = 0x7fc07fc0u; } *(u32x2v*)(xn + off + bj * HALF + n * 16) = w; }
                asm volatile("" ::: "memory"); }
    }
};

template <class Epi, class Sched, bool ALIGN_EPI = false, bool SP2 = false>
__device__ __forceinline__ void gemm_phase(PG8_LAS unsigned char* lds, const Gemm g, const Sched S, const Epi E) {
    const int tid = threadIdx.x, wid = __builtin_amdgcn_readfirstlane(tid >> 6), lane = tid & 63, wr = wid >> 2, wc = wid & 3, fr = lane & 15, fq = lane >> 4;
    const int K = g.K, nt = K / BK;
    unsigned voffA[2], voffB[2];
#pragma unroll
    for (int i = 0; i < 2; ++i) { int R, C; stage_rc(tid * 16 + i * 8192, R, C); const int Rb = Epi::PERM ? ((R & ~31) + perm32(R & 31)) : R;
        voffA[i] = (unsigned)(R * g.lda + C) * 2u; voffB[i] = (unsigned)(Rb * K + C) * 2u; }
    const size_t kstep = (size_t)(BK * 2);
    const size_t hstep = (size_t)HALF * K * 2;
    const size_t tstep = 2 * hstep;
    const size_t hstepA = (size_t)HALF * g.lda * 2, tstepA = 2 * hstepA;
    const unsigned ldsw = (unsigned)wid * 1024u;
    const int aoff = lds_byte(wr * 64 + fr, fq * 8), boff = lds_byte(wc * 32 + fr, fq * 8);
#define PG8_SA(b, h) (((b) * 2 + (h)) * HTB)
#define PG8_SB(b, h) ((4 + (b) * 2 + (h)) * HTB)
#define PG8_STAGE(bufoff, gbase, voff) do { _Pragma("unroll") for (int _i = 0; _i < 2; ++_i) \
        __builtin_amdgcn_global_load_lds((const unsigned*)((const char*)(gbase) + (voff)[_i]), (PG8_LAS unsigned*)(lds + (bufoff) + ldsw + _i * 8192), 16, 0, 0); } while (0)
#define PG8_LDA(dst, b, h) do { _Pragma("unroll") for (int m = 0; m < 4; ++m) _Pragma("unroll") for (int k = 0; k < 2; ++k) dst[m][k] = *(const PG8_LAS bf16x8*)(lds + PG8_SA(b, h) + aoff + m * 2048 + k * 1024); } while (0)
#define PG8_LDB(dst, b, h) do { _Pragma("unroll") for (int n = 0; n < 2; ++n) _Pragma("unroll") for (int k = 0; k < 2; ++k) dst[n][k] = *(const PG8_LAS bf16x8*)(lds + PG8_SB(b, h) + boff + n * 2048 + k * 1024); } while (0)
#define PG8_MMA(ai, bj, At, Bt) do { __builtin_amdgcn_s_setprio(1); _Pragma("unroll") for (int m = 0; m < 4; ++m) _Pragma("unroll") for (int n = 0; n < 2; ++n) _Pragma("unroll") for (int k = 0; k < 2; ++k) \
        acc[ai][bj][m][n] = __builtin_amdgcn_mfma_f32_16x16x32_bf16(Bt[n][k], At[m][k], acc[ai][bj][m][n], 0, 0, 0); __builtin_amdgcn_s_setprio(0); } while (0)
#define PG8_WAIT_V(n) asm volatile("s_waitcnt vmcnt(" #n ")" ::: "memory")
#define PG8_WAIT_L(n) asm volatile("s_waitcnt lgkmcnt(" #n ")" ::: "memory")
#define PG8_BAR __builtin_amdgcn_s_barrier()
#define PG8_SCHED __builtin_amdgcn_sched_barrier(0)
    Unit cur, nxt; int ui = 0;
    if (!S.next(0, cur)) return;
    f32x4 acc[2][2][4][2];
#pragma unroll
    for (int a = 0; a < 2; ++a)
#pragma unroll
        for (int b = 0; b < 2; ++b)
#pragma unroll
            for (int m = 0; m < 4; ++m)
#pragma unroll
                for (int n = 0; n < 2; ++n) acc[a][b][m][n] = (f32x4){0.f, 0.f, 0.f, 0.f};
    bf16x8 At[4][2], B0[2][2], B1[2][2];
    const char* cA = (const char*)g.A + (size_t)cur.pm * tstepA; const char* cB = (const char*)g.Bt + (size_t)cur.pn * tstep;
    S.a_ready(cur);
    if constexpr (SP2) {
        PG8_STAGE(PG8_SB(0, 0), cB, voffB); PG8_STAGE(PG8_SB(0, 1), cB + hstep, voffB); PG8_STAGE(PG8_SA(0, 0), cA, voffA); PG8_STAGE(PG8_SA(0, 1), cA + hstepA, voffA);
        if (wr == 1) PG8_BAR;
        PG8_WAIT_V(2); PG8_BAR;
        PG8_STAGE(PG8_SB(1, 0), cB + kstep, voffB); PG8_STAGE(PG8_SA(1, 0), cA + kstep, voffA); PG8_STAGE(PG8_SB(1, 1), cB + hstep + kstep, voffB);
        PG8_WAIT_V(6); PG8_BAR;
    } else {
        PG8_STAGE(PG8_SB(0, 0), cB, voffB); PG8_STAGE(PG8_SA(0, 0), cA, voffA); PG8_STAGE(PG8_SB(0, 1), cB + hstep, voffB); PG8_STAGE(PG8_SA(0, 1), cA + hstepA, voffA);
        if (wr == 1) PG8_BAR;
        PG8_WAIT_V(4); PG8_BAR;
        PG8_STAGE(PG8_SB(1, 0), cB + kstep, voffB); PG8_STAGE(PG8_SA(1, 0), cA + kstep, voffA); PG8_STAGE(PG8_SB(1, 1), cB + hstep + kstep, voffB);
        PG8_WAIT_V(6); PG8_BAR;
    }
    for (;;) {
        const bool has_next = S.next(ui + 1, nxt);
        const char* nA = has_next ? (const char*)g.A + (size_t)nxt.pm * tstepA : cA; const char* nB = has_next ? (const char*)g.Bt + (size_t)nxt.pn * tstep : cB;
        for (int t = 0; t < nt; t += 2) {
            const bool last = (t == nt - 2);
            const char* a1 = cA + (size_t)(t + 1) * kstep;
            const char* a2 = last ? nA : cA + (size_t)(t + 2) * kstep; const char* b2 = last ? nB : cB + (size_t)(t + 2) * kstep;
            const char* a3 = a2 + kstep; const char* b3 = b2 + kstep;
            if (last && has_next) S.a_ready(nxt);
            if constexpr (SP2) {
            PG8_LDB(B0, 0, 0); PG8_LDB(B1, 0, 1); PG8_SCHED; PG8_LDA(At, 0, 0); PG8_STAGE(PG8_SA(1, 1), a1 + hstepA, voffA);
            PG8_WAIT_V(8); PG8_WAIT_L(0); PG8_BAR; PG8_MMA(0, 0, At, B0); PG8_MMA(0, 1, At, B1); PG8_BAR; PG8_SCHED;
            PG8_LDA(At, 0, 1); PG8_STAGE(PG8_SB(0, 0), b2, voffB); PG8_STAGE(PG8_SB(0, 1), b2 + hstep, voffB); PG8_STAGE(PG8_SA(0, 0), a2, voffA);
            PG8_WAIT_V(8); PG8_WAIT_L(0); PG8_BAR; PG8_MMA(1, 0, At, B0); PG8_MMA(1, 1, At, B1); PG8_BAR; PG8_SCHED;
            PG8_LDB(B0, 1, 0); PG8_LDB(B1, 1, 1); PG8_SCHED; PG8_LDA(At, 1, 0); PG8_STAGE(PG8_SA(0, 1), a2 + hstepA, voffA);
            PG8_WAIT_V(8); PG8_WAIT_L(0); PG8_BAR; PG8_MMA(0, 0, At, B0); PG8_MMA(0, 1, At, B1); PG8_BAR; PG8_SCHED;
            PG8_LDA(At, 1, 1); PG8_STAGE(PG8_SB(1, 0), b3, voffB); PG8_STAGE(PG8_SB(1, 1), b3 + hstep, voffB); PG8_STAGE(PG8_SA(1, 0), a3, voffA);
            PG8_WAIT_V(8); PG8_WAIT_L(0); PG8_BAR; PG8_MMA(1, 0, At, B0); PG8_MMA(1, 1, At, B1); PG8_BAR; PG8_SCHED;
            } else {
            PG8_LDB(B0, 0, 0); PG8_SCHED; PG8_LDA(At, 0, 0); PG8_STAGE(PG8_SA(1, 1), a1 + hstepA, voffA);
            PG8_WAIT_L(8); PG8_BAR; PG8_WAIT_L(0); PG8_MMA(0, 0, At, B0); PG8_BAR; PG8_SCHED;
            PG8_LDB(B1, 0, 1); PG8_STAGE(PG8_SB(0, 0), b2, voffB);
            PG8_BAR; PG8_WAIT_L(0); PG8_MMA(0, 1, At, B1); PG8_BAR;
            PG8_LDA(At, 0, 1); PG8_STAGE(PG8_SA(0, 0), a2, voffA);
            PG8_BAR; PG8_WAIT_L(0); PG8_MMA(1, 0, At, B0); PG8_BAR; PG8_SCHED;
            PG8_STAGE(PG8_SB(0, 1), b2 + hstep, voffB);
            PG8_WAIT_V(6); PG8_BAR; PG8_MMA(1, 1, At, B1); PG8_BAR;
            PG8_LDB(B0, 1, 0); PG8_SCHED; PG8_LDA(At, 1, 0); PG8_STAGE(PG8_SA(0, 1), a2 + hstepA, voffA);
            PG8_WAIT_L(8); PG8_BAR; PG8_WAIT_L(0); PG8_MMA(0, 0, At, B0); PG8_BAR; PG8_SCHED;
            PG8_LDB(B1, 1, 1); PG8_STAGE(PG8_SB(1, 0), b3, voffB);
            PG8_BAR; PG8_WAIT_L(0); PG8_MMA(0, 1, At, B1); PG8_BAR;
            PG8_LDA(At, 1, 1); PG8_STAGE(PG8_SA(1, 0), a3, voffA);
            PG8_BAR; PG8_WAIT_L(0); PG8_MMA(1, 0, At, B0); PG8_BAR; PG8_SCHED;
            PG8_STAGE(PG8_SB(1, 1), b3 + hstep, voffB);
            PG8_WAIT_V(6); PG8_BAR; PG8_MMA(1, 1, At, B1); PG8_BAR;
            }
        }
        if constexpr (ALIGN_EPI) { if (wr == 0) PG8_BAR; }
        if constexpr (!Epi::AFTER_DRAIN) { E(acc, cur, wr, wc, fr, fq); S.done(cur); }
        if (!has_next) break;
#pragma unroll
        for (int a = 0; a < 2; ++a)
#pragma unroll
            for (int b = 0; b < 2; ++b)
#pragma unroll
                for (int m = 0; m < 4; ++m)
#pragma unroll
                    for (int n = 0; n < 2; ++n) acc[a][b][m][n] = (f32x4){0.f, 0.f, 0.f, 0.f};
        cur = nxt; cA = nA; cB = nB; ++ui;
        if constexpr (ALIGN_EPI) { if (wr == 1) PG8_BAR; }
    }
    PG8_WAIT_V(0);
    if constexpr (!ALIGN_EPI) { if (wr == 0) PG8_BAR; }
    PG8_BAR;
    if constexpr (Epi::AFTER_DRAIN) { E.fused(acc, cur, wr, wc, fr, fq, lds, wid, lane); S.done(cur); }
#undef PG8_SA
#undef PG8_SB
#undef PG8_STAGE
#undef PG8_LDA
#undef PG8_LDB
#undef PG8_MMA
#undef PG8_WAIT_V
#undef PG8_WAIT_L
#undef PG8_BAR
#undef PG8_SCHED
}
}

#ifndef GEMM_SP2
#define GEMM_SP2 true
#endif
#ifndef GEMM_ALIGN
#define GEMM_ALIGN true
#endif
namespace mk {
#define LAS __attribute__((address_space(3)))
using pg8::bf16_t; using pg8::bf16x8; using pg8::f32x4; using pg8::u32x4;
typedef unsigned u32x2 __attribute__((ext_vector_type(2)));

constexpr int DM = 1024, SEQ = 8192, NBATCH = 4, MPR = NBATCH * SEQ, MSAMP = 128, MREAL = MPR + MSAMP, MPAD = 33024;
constexpr int DFF = 2816, PW = 2816, NINP = 3072, CONVC = 1536;
constexpr float EPS = 1e-6f;
#ifndef SCAN_CW
#define SCAN_CW 2
#endif
constexpr int CW = SCAN_CW, NSCAN = 128 / CW;
constexpr int LDS_PHASE_BYTES = 147456, LDS_BYTES = LDS_PHASE_BYTES + 256;

constexpr size_t O_YP = 0, O_YS = 33554432, O_KP = 33685504, O_VP = 33751040, O_CP = 33816576, O_GP = 33835008,
                 O_KS = 34097152, O_VS = 36194304, O_CS = 38291456, O_GS = 38881280;
constexpr size_t MiB = 1u << 20;
constexpr size_t WS_CTL = 0, CTL_ZERO_BYTES = 1 * MiB;
constexpr size_t WS_W1IN = 1 * MiB, WS_W1OUT = 12 * MiB, WS_WINMIX = 18 * MiB, WS_WOUTMIX = 24 * MiB, WS_W2IN = 26 * MiB, WS_W2OUT = 37 * MiB;
constexpr size_t WS_GBA = 43 * MiB, WS_XN = 45 * MiB, WS_XN2 = 110 * MiB, WS_H = 175 * MiB, WS_GM = 353 * MiB, WS_GN = 417 * MiB;
constexpr size_t WS_GQ = 110 * MiB, WS_GO = 142 * MiB;
constexpr size_t WS_SSP1 = 481 * MiB, WS_SSP2 = 484 * MiB;
constexpr size_t WS_END = 487 * MiB;
constexpr size_t CTL_BAR = 0, CTL_BAR_BYTES = 16384, CTL_GLAST = 768 * 1024;

struct Params { const float* in[21]; float* out; unsigned char* ws; };

typedef float f32x2v __attribute__((ext_vector_type(2)));
typedef __bf16 bf16x2v __attribute__((ext_vector_type(2)));
__device__ __forceinline__ unsigned cvt_pk(float lo, float hi) { const f32x2v v = {lo, hi}; const bf16x2v b = __builtin_convertvector(v, bf16x2v); return __builtin_bit_cast(unsigned, b); }
__device__ __forceinline__ bf16_t f2bf(float f) { return (bf16_t)(cvt_pk(f, 0.f) & 0xffffu); }
__device__ __forceinline__ float bf2f(bf16_t h) { return __uint_as_float(((unsigned)h) << 16); }
__device__ __forceinline__ float bflo(unsigned w) { return __uint_as_float(w << 16); }
__device__ __forceinline__ float bfhi(unsigned w) { return __uint_as_float(w & 0xffff0000u); }
__device__ __forceinline__ float silu(float x) { return x * __builtin_amdgcn_rcpf(1.0f + __expf(-x)); }
__device__ __forceinline__ float wave_sum(float v) {
#pragma unroll
    for (int o = 1; o < 64; o <<= 1) v += __shfl_xor(v, o);
    return v;
}
__device__ __forceinline__ float wave_max(float v) {
#pragma unroll
    for (int o = 1; o < 64; o <<= 1) v = fmaxf(v, __shfl_xor(v, o));
    return v;
}
__device__ __forceinline__ f32x4 mfma16(bf16x8 a, bf16x8 b, f32x4 c) { return __builtin_amdgcn_mfma_f32_16x16x32_bf16(a, b, c, 0, 0, 0); }

__device__ __forceinline__ float row_rstd(const float* ssp, int r) {
    if (r >= MREAL) return 0.f;
    const f32x4 a = *(const f32x4*)(ssp + (size_t)r * 16), b = *(const f32x4*)(ssp + (size_t)r * 16 + 4), c = *(const f32x4*)(ssp + (size_t)r * 16 + 8), d = *(const f32x4*)(ssp + (size_t)r * 16 + 12);
    const float s = (((a[0] + a[1]) + (a[2] + a[3])) + ((b[0] + b[1]) + (b[2] + b[3]))) + (((c[0] + c[1]) + (c[2] + c[3])) + ((d[0] + d[1]) + (d[2] + d[3])));
    return rsqrtf(s * (1.0f / DM) + EPS);
}
struct EpiSwiglu {
    static constexpr bool PERM = true, AFTER_DRAIN = false;
    bf16_t* H; const float* ss;
    __device__ __forceinline__ void operator()(const f32x4 (&acc)[2][2][4][2], const pg8::Unit& u, int wr, int wc, int fr, int fq) const {
        const int row0 = u.pm * 256 + wr * 64 + fr, col0 = u.pn * 128 + wc * 32 + 8 * fq;
#pragma unroll
        for (int ai = 0; ai < 2; ++ai)
#pragma unroll
            for (int m = 0; m < 4; ++m) {
                const int r = row0 + ai * 128 + m * 16;
                const float rs = ss ? row_rstd(ss, r) : 1.0f;
                float h[8];
#pragma unroll
                for (int n = 0; n < 2; ++n)
#pragma unroll
                    for (int j = 0; j < 4; ++j) h[n * 4 + j] = silu(acc[ai][0][m][n][j] * rs) * (acc[ai][1][m][n][j] * rs);
                u32x4 w; w.x = cvt_pk(h[0], h[1]); w.y = cvt_pk(h[2], h[3]); w.z = cvt_pk(h[4], h[5]); w.w = cvt_pk(h[6], h[7]);
                *(u32x4*)(H + (size_t)r * DFF + col0) = w;
            }
    }
};
template <bool RESB16, bool WF32, bool WB16, bool SUMSQ, bool HALF> struct EpiResid {
    static constexpr bool PERM = true, AFTER_DRAIN = false;
    const void* resP; const void* resS; float* Yo; bf16_t* XBo; float* sso;
    __device__ __forceinline__ void operator()(const f32x4 (&acc)[2][2][4][2], const pg8::Unit& u, int wr, int wc, int fr, int fq) const {
        const int row0 = u.pm * 256 + wr * 64 + fr, col0 = u.pn * 256 + wc * 32 + 8 * fq;
        const char* const rP = (const char*)resP; const char* const rS = (const char*)resS - (size_t)MPR * DM * (RESB16 ? 2 : 4);
        float* const Y = Yo; const float scale = HALF ? 0.5f : 1.0f; bf16_t* const XB = XBo; float* const ss = sso;
#pragma unroll
        for (int ai = 0; ai < 2; ++ai)
#pragma unroll
            for (int m = 0; m < 4; ++m) {
                const int r = row0 + ai * 128 + m * 16; float s = 0.f;
                if (r < MREAL) {
                    const char* rp = ((r < MPR) ? rP : rS) + (size_t)r * DM * (RESB16 ? 2 : 4);
#pragma unroll
                    for (int bj = 0; bj < 2; ++bj) {
                        const int c = col0 + bj * 128;
                        f32x4 r0, r1;
                        if (RESB16) { const u32x4 w = *(const u32x4*)(rp + (size_t)c * 2); r0 = (f32x4){bflo(w.x), bfhi(w.x), bflo(w.y), bfhi(w.y)}; r1 = (f32x4){bflo(w.z), bfhi(w.z), bflo(w.w), bfhi(w.w)}; }
                        else { r0 = *(const f32x4*)(rp + (size_t)c * 4); r1 = *(const f32x4*)(rp + (size_t)c * 4 + 16); }
                        const f32x4 v0 = r0 + acc[ai][bj][m][0] * scale, v1 = r1 + acc[ai][bj][m][1] * scale;
                        if (WF32) { *(f32x4*)(Y + (size_t)r * DM + c) = v0; *(f32x4*)(Y + (size_t)r * DM + c + 4) = v1; }
                        if (WB16) { u32x4 w; w.x = cvt_pk(v0[0], v0[1]); w.y = cvt_pk(v0[2], v0[3]); w.z = cvt_pk(v1[0], v1[1]); w.w = cvt_pk(v1[2], v1[3]);
                            *(u32x4*)(XB + (size_t)r * DM + c) = w; }
                        if (SUMSQ) s += (v0[0] * v0[0] + v0[1] * v0[1]) + (v0[2] * v0[2] + v0[3] * v0[3]) + (v1[0] * v1[0] + v1[1] * v1[1]) + (v1[2] * v1[2] + v1[3] * v1[3]);
                    }
                }
                if (SUMSQ) { s += __shfl_xor(s, 16); s += __shfl_xor(s, 32); if (fq == 0 && r < MREAL) ss[(size_t)r * 16 + u.pn * 4 + wc] = s; }
            }
    }
};
struct EpiInproj {
    static constexpr bool PERM = true, AFTER_DRAIN = false;
    bf16_t* P; float* gba; const float* ss;
    __device__ __forceinline__ void operator()(const f32x4 (&acc)[2][2][4][2], const pg8::Unit& u, int wr, int wc, int fr, int fq) const {
        const int row0 = u.pm * 256 + wr * 64 + fr, col0 = u.pn * 256 + wc * 32 + 8 * fq;
#pragma unroll
        for (int ai = 0; ai < 2; ++ai)
#pragma unroll
            for (int m = 0; m < 4; ++m) {
                const int r = row0 + ai * 128 + m * 16;
                const float rs = row_rstd(ss, r);
                if (u.pn < 11) {
#pragma unroll
                    for (int bj = 0; bj < 2; ++bj) { const f32x4 v0 = acc[ai][bj][m][0] * rs, v1 = acc[ai][bj][m][1] * rs;
                        u32x4 w; w.x = cvt_pk(v0[0], v0[1]); w.y = cvt_pk(v0[2], v0[3]); w.z = cvt_pk(v1[0], v1[1]); w.w = cvt_pk(v1[2], v1[3]);
                        *(u32x4*)(P + (size_t)r * PW + col0 + bj * 128) = w; }
                } else if (wc == 0 && fq == 0) {
                    *(f32x4*)(gba + (size_t)r * 8) = acc[ai][0][m][0] * rs; *(f32x4*)(gba + (size_t)r * 8 + 4) = acc[ai][0][m][1] * rs;
                }
            }
    }
};


template <int NT, bool SS>
__device__ __forceinline__ void skinny_mm(const bf16_t* A, int lda, const bf16_t* W, int K, int wrow0, int wrow1, int wid, int fr, int fq, f32x4 (&acc)[NT], float& ss) {
    const bf16_t* ap = A + (size_t)(16 * wid + fr) * lda + 8 * fq;
    const bf16_t* w0 = W + (size_t)(wrow0 + fr) * K + 8 * fq; const bf16_t* w1 = W + (size_t)(wrow1 + fr) * K + 8 * fq;
#pragma unroll
    for (int nt = 0; nt < NT; ++nt) acc[nt] = (f32x4){0.f, 0.f, 0.f, 0.f};
    float s = 0.f;
#pragma unroll 8
    for (int ks = 0; ks < K / 32; ++ks) {
        const bf16x8 a = *(const bf16x8*)(ap + 32 * ks);
        acc[0] = mfma16(*(const bf16x8*)(w0 + 32 * ks), a, acc[0]);
        if (NT == 2) acc[NT - 1] = mfma16(*(const bf16x8*)(w1 + 32 * ks), a, acc[NT - 1]);
        if (SS) { const u32x4 u = __builtin_bit_cast(u32x4, a);
#pragma unroll
            for (int k = 0; k < 4; ++k) { const float lo = bflo(u[k]), hi = bfhi(u[k]); s += lo * lo + hi * hi; } }
    }
    if (SS) { s += __shfl_xor(s, 16); s += __shfl_xor(s, 32); }
    ss = s;
}
template <bool SS> __device__ __forceinline__ void sk_ffn_in(const bf16_t* X, const bf16_t* Wt, bf16_t* H, int slab, int wid, int fr, int fq) {
    const int j0 = 16 * slab, wr0 = (j0 >> 7) * 256 + (j0 & 127);
    f32x4 acc[2]; float ss;
    skinny_mm<2, SS>(X + (size_t)MPR * DM, DM, Wt, DM, wr0, wr0 + 128, wid, fr, fq, acc, ss);
    const float rs = SS ? rsqrtf(ss * (1.0f / DM) + EPS) : 1.0f;
    float h[4];
#pragma unroll
    for (int e = 0; e < 4; ++e) h[e] = silu(acc[0][e] * rs) * (acc[1][e] * rs);
    u32x2 w; w.x = cvt_pk(h[0], h[1]); w.y = cvt_pk(h[2], h[3]);
    *(u32x2*)(H + (size_t)(MPR + 16 * wid + fr) * DFF + j0 + 4 * fq) = w;
}
template <bool OUTF32> __device__ __forceinline__ void sk_ffn_out(const bf16_t* Hb, const bf16_t* Wt, const float* resf, float* outf, bf16_t* outb, int slab, int wid, int fr, int fq) {
    f32x4 acc[1]; float ss;
    skinny_mm<1, false>(Hb + (size_t)MPR * DFF, DFF, Wt, DFF, 16 * slab, 0, wid, fr, fq, acc, ss);
    const int rl = 16 * wid + fr, c = 16 * slab + 4 * fq;
    const f32x4 v = *(const f32x4*)(resf + (size_t)rl * DM + c) + acc[0] * 0.5f;
    if (OUTF32) *(f32x4*)(outf + (size_t)rl * DM + c) = v;
    else { u32x2 w; w.x = cvt_pk(v[0], v[1]); w.y = cvt_pk(v[2], v[3]); *(u32x2*)(outb + (size_t)rl * DM + c) = w; }
}
__device__ __forceinline__ void sk_inproj(const bf16_t* X, const bf16_t* Wt, bf16_t* P, float* gba, int slab, int wid, int fr, int fq) {
    const int n0 = 32 * slab; f32x4 acc[2]; float ss;
    skinny_mm<2, true>(X + (size_t)MPR * DM, DM, Wt, DM, n0, n0 + 16, wid, fr, fq, acc, ss);
    const float rs = rsqrtf(ss * (1.0f / DM) + EPS); const int r = MPR + 16 * wid + fr;
    if (n0 < PW) {
#pragma unroll
        for (int nt = 0; nt < 2; ++nt) { const f32x4 v = acc[nt] * rs; u32x2 w; w.x = cvt_pk(v[0], v[1]); w.y = cvt_pk(v[2], v[3]); *(u32x2*)(P + (size_t)r * PW + n0 + 16 * nt + 4 * fq) = w; }
    } else if (fq < 2) *(f32x4*)(gba + (size_t)r * 8 + 4 * fq) = acc[0] * rs;
}
__device__ __forceinline__ void sk_outproj(const bf16_t* Pm, const bf16_t* Wt, const bf16_t* X1b, float* X2f, bf16_t* X2b, int slab, int wid, int fr, int fq) {
    const int n0 = 32 * slab; f32x4 acc[2]; float ss;
    skinny_mm<2, false>(Pm + (size_t)MPR * PW, PW, Wt, DM, n0, n0 + 16, wid, fr, fq, acc, ss);
    const int r = MPR + 16 * wid + fr;
#pragma unroll
    for (int nt = 0; nt < 2; ++nt) { const int c = n0 + 16 * nt + 4 * fq; const u32x2 xr = *(const u32x2*)(X1b + (size_t)r * DM + c);
        const f32x4 v = (f32x4){bflo(xr.x), bfhi(xr.x), bflo(xr.y), bfhi(xr.y)} + acc[nt];
        *(f32x4*)(X2f + (size_t)r * DM + c) = v; u32x2 w; w.x = cvt_pk(v[0], v[1]); w.y = cvt_pk(v[2], v[3]); *(u32x2*)(X2b + (size_t)r * DM + c) = w; }
}

__device__ __forceinline__ void transpose_item(const float* W, int K, int N, bf16_t* WT, int k0, int n0, int drow0, const float* gs, LAS float* scr, int lane) {
    float wv[32];
#pragma unroll
    for (int i = 0; i < 32; ++i) { const int kk = 2 * i + (lane >> 5), n = n0 + (lane & 31); wv[i] = (n < N) ? W[(size_t)(k0 + kk) * N + n] : 0.f; }
#pragma unroll
    for (int i = 0; i < 32; ++i) { const int kk = 2 * i + (lane >> 5); float v = wv[i]; if (gs) v *= gs[k0 + kk]; scr[kk * 33 + (lane & 31)] = v; }
    asm volatile("s_waitcnt lgkmcnt(0)" ::: "memory");
    const int c = lane & 7;
#pragma unroll
    for (int j = 0; j < 4; ++j) { const int nn = (lane >> 3) + 8 * j; const LAS float* s = scr + (8 * c) * 33 + nn;
        u32x4 o; o.x = cvt_pk(s[0 * 33], s[1 * 33]); o.y = cvt_pk(s[2 * 33], s[3 * 33]); o.z = cvt_pk(s[4 * 33], s[5 * 33]); o.w = cvt_pk(s[6 * 33], s[7 * 33]);
        *(u32x4*)(WT + (size_t)(drow0 + nn) * K + k0 + 8 * c) = o; }
    asm volatile("s_waitcnt lgkmcnt(0)" ::: "memory");
}
__device__ __forceinline__ int map_ffin_row(int n0) { return n0 < DFF ? (n0 >> 7) * 256 + (n0 & 127) : ((n0 - DFF) >> 7) * 256 + 128 + ((n0 - DFF) & 127); }

__device__ __forceinline__ void p0_prologue(const Params& p, LAS unsigned char* lds, int vb, int G) {
    const int tid = threadIdx.x, lane = tid & 63, wid = tid >> 6;
    LAS float* scr = (LAS float*)(lds + wid * 16384);
    const int gw = vb * 8 + wid, NGW = G * 8;
    bf16_t* W1IN = (bf16_t*)(p.ws + WS_W1IN); bf16_t* W1OUT = (bf16_t*)(p.ws + WS_W1OUT); bf16_t* WINMIX = (bf16_t*)(p.ws + WS_WINMIX);
    bf16_t* WOUTMIX = (bf16_t*)(p.ws + WS_WOUTMIX); bf16_t* W2IN = (bf16_t*)(p.ws + WS_W2IN); bf16_t* W2OUT = (bf16_t*)(p.ws + WS_W2OUT);
    constexpr int I_FIN = 16 * 176, I_FOUT = 44 * 32, I_INMIX = 16 * 89, I_OUTMIX = 16 * 32;
    constexpr int NITEMS = 2 * I_FIN + 2 * I_FOUT + I_INMIX + I_OUTMIX;
    for (int it = gw; it < NITEMS; it += NGW) {
        int r = it;
        if (r < I_FIN) { const int kb = r / 176, nb = r % 176; transpose_item(p.in[7], DM, 2 * DFF, W1IN, kb * 64, nb * 32, map_ffin_row(nb * 32), nullptr, scr, lane); continue; } r -= I_FIN;
        if (r < I_FIN) { const int kb = r / 176, nb = r % 176; transpose_item(p.in[18], DM, 2 * DFF, W2IN, kb * 64, nb * 32, map_ffin_row(nb * 32), p.in[17], scr, lane); continue; } r -= I_FIN;
        if (r < I_FOUT) { const int kb = r / 32, nb = r % 32; transpose_item(p.in[8], DFF, DM, W1OUT, kb * 64, nb * 32, nb * 32, nullptr, scr, lane); continue; } r -= I_FOUT;
        if (r < I_FOUT) { const int kb = r / 32, nb = r % 32; transpose_item(p.in[19], DFF, DM, W2OUT, kb * 64, nb * 32, nb * 32, nullptr, scr, lane); continue; } r -= I_FOUT;
        if (r < I_INMIX) { const int kb = r / 89, nb = r % 89; transpose_item(p.in[10], DM, 2824, WINMIX, kb * 64, nb * 32, nb * 32, p.in[9], scr, lane); continue; } r -= I_INMIX;
        { const int kb = r / 32, nb = r % 32; transpose_item(p.in[16], DM, DM, WOUTMIX, kb * 64, nb * 32, nb * 32, nullptr, scr, lane); }
    }
    bf16_t* XN = (bf16_t*)(p.ws + WS_XN); const float* g1 = p.in[6];
    f32x4 gv[4];
#pragma unroll
    for (int j = 0; j < 4; ++j) gv[j] = *((const f32x4*)g1 + lane + 64 * j);
    {
        f32x4 v[4], vn[4];
        int m = gw;
        if (m < MREAL) { const f32x4* xr = (const f32x4*)((m < MPR) ? p.in[0] + (size_t)m * DM : p.in[1] + (size_t)(m - MPR) * DM) + lane;
#pragma unroll
            for (int j = 0; j < 4; ++j) v[j] = xr[64 * j]; }
        for (; m < MREAL; m += NGW) {
            const int mn = m + NGW;
            if (mn < MREAL) { const f32x4* xr = (const f32x4*)((mn < MPR) ? p.in[0] + (size_t)mn * DM : p.in[1] + (size_t)(mn - MPR) * DM) + lane;
#pragma unroll
                for (int j = 0; j < 4; ++j) vn[j] = xr[64 * j]; }
            float s = 0.f;
#pragma unroll
            for (int j = 0; j < 4; ++j) s += (v[j][0] * v[j][0] + v[j][1] * v[j][1]) + (v[j][2] * v[j][2] + v[j][3] * v[j][3]);
            const float rstd = rsqrtf(wave_sum(s) * (1.0f / DM) + EPS);
            unsigned long long* o8 = (unsigned long long*)(XN + (size_t)m * DM) + lane;
#pragma unroll
            for (int j = 0; j < 4; ++j) { const f32x4 y = v[j] * rstd * gv[j];
                o8[64 * j] = (unsigned long long)cvt_pk(y[0], y[1]) | ((unsigned long long)cvt_pk(y[2], y[3]) << 32); }
#pragma unroll
            for (int j = 0; j < 4; ++j) v[j] = vn[j];
        }
    }
}

template <bool SWX = false, bool SWY = false>
__device__ __forceinline__ f32x4 tile_mm(const LAS bf16_t* X, int ldx, int mt, const LAS bf16_t* Y, int ldy, int nt, int nks, int fr, int fq) {
    f32x4 acc = (f32x4){0.f, 0.f, 0.f, 0.f};
    const int rx = 16 * mt + fr, ry = 16 * nt + fr, sx = SWX ? ((rx >> 3) & 7) : 0, sy = SWY ? ((ry >> 3) & 7) : 0;
    const LAS bf16_t* xp = X + rx * ldx; const LAS bf16_t* yp = Y + ry * ldy;
    for (int ks = 0; ks < nks; ++ks) acc = mfma16(*(const LAS bf16x8*)(xp + 8 * ((4 * ks + fq) ^ sx)), *(const LAS bf16x8*)(yp + 8 * ((4 * ks + fq) ^ sy)), acc);
    return acc;
}
constexpr int G1_QS = 0, G1_KS = 17408, G1_VBT = 34816, G1_KBT = 53248, G1_KDT = 71680, G1_UT = 90112, G1_WT = 108544, G1_QK = 126976, G1_TB = 136192, G1_GC = 145408, G1_BETA = 145664;

__device__ __forceinline__ void gdn_prep_unit(const Params& p, LAS unsigned char* lds, int unit) {
    const int tid = threadIdx.x, lane = tid & 63, wid = tid >> 6, fr = lane & 15, fq = lane >> 4;
    const int bh = unit >> 7, n = unit & 127, b = bh >> 2, h = bh & 3;
    const int tok0 = b * SEQ + n * 64;
    LAS bf16_t* Qs = (LAS bf16_t*)(lds + G1_QS); LAS bf16_t* Ks = (LAS bf16_t*)(lds + G1_KS); LAS bf16_t* VbT = (LAS bf16_t*)(lds + G1_VBT);
    LAS bf16_t* KbT = (LAS bf16_t*)(lds + G1_KBT); LAS bf16_t* KdT = (LAS bf16_t*)(lds + G1_KDT); LAS bf16_t* UT = (LAS bf16_t*)(lds + G1_UT);
    LAS bf16_t* WT = (LAS bf16_t*)(lds + G1_WT); LAS float* Af = (LAS float*)(lds + G1_WT); LAS bf16_t* QK = (LAS bf16_t*)(lds + G1_QK);
    LAS bf16_t* Tb = (LAS bf16_t*)(lds + G1_TB); LAS float* gcs = (LAS float*)(lds + G1_GC); LAS float* betas = (LAS float*)(lds + G1_BETA);
    const bf16_t* PB = (const bf16_t*)(p.ws + WS_H); const float* GBA = (const float*)(p.ws + WS_GBA);
    LAS unsigned char* raw = lds + G1_UT;
    for (int pc4 = wid; pc4 < 51; pc4 += 8) {
        int pc = pc4 * 4 + (lane >> 4); pc = pc < 200 ? pc : 200;
        const int r = pc / 3, seg = pc - 3 * r; int tt = n * 64 - 3 + r; tt = tt < 0 ? 0 : tt;
        __builtin_amdgcn_global_load_lds((const unsigned*)(PB + (size_t)(b * SEQ + tt) * PW + 768 + seg * 512 + h * 128 + (lane & 15) * 8), (LAS unsigned*)(raw + pc4 * 1024), 16, 0, 0);
    }
    if (tid < 64) {
        const float* gb = GBA + (size_t)(tok0 + tid) * 8;
        const float bt = 1.0f / (1.0f + __expf(-gb[h]));
        const float x = gb[4 + h] + p.in[14][h]; const float sp = x > 20.f ? x : log1pf(__expf(x));
        float c = -__expf(p.in[13][h]) * sp;
#pragma unroll
        for (int o = 1; o < 64; o <<= 1) { const float t = __shfl_up(c, o); if (lane >= o) c += t; }
        gcs[tid] = c; betas[tid] = bt;
    }
    asm volatile("s_waitcnt vmcnt(0)" ::: "memory");
    __syncthreads();
    const float gclast = gcs[63];
    const float* cw = p.in[12];
#pragma unroll 1
    for (int it = 0; it < 6; ++it) {
        const int item = tid + 512 * it, l16 = item & 15, row = item >> 4, which = row >> 6, t = row & 63;
        const int cch = which * 512 + h * 128 + l16 * 8;
        float a[8];
#pragma unroll
        for (int e = 0; e < 8; ++e) a[e] = 0.f;
#pragma unroll
        for (int j = 0; j < 4; ++j) {
            const int tt = n * 64 + t - 3 + j;
            if (tt >= 0) {
                const u32x4 xv = *(const LAS u32x4*)(raw + ((t + j) * 3 + which) * 256 + l16 * 16);
                const f32x4 w0 = *(const f32x4*)(cw + j * CONVC + cch), w1 = *(const f32x4*)(cw + j * CONVC + cch + 4);
                a[0] += w0[0] * bflo(xv.x); a[1] += w0[1] * bfhi(xv.x); a[2] += w0[2] * bflo(xv.y); a[3] += w0[3] * bfhi(xv.y);
                a[4] += w1[0] * bflo(xv.z); a[5] += w1[1] * bfhi(xv.z); a[6] += w1[2] * bflo(xv.w); a[7] += w1[3] * bfhi(xv.w);
            }
        }
        float ss = 0.f;
#pragma unroll
        for (int e = 0; e < 8; ++e) { a[e] = silu(a[e]); ss += a[e] * a[e]; }
        ss += __shfl_xor(ss, 1); ss += __shfl_xor(ss, 2); ss += __shfl_xor(ss, 4); ss += __shfl_xor(ss, 8);
        const float gct = gcs[t], bt = betas[t];
        const int tsw = (((t >> 3) ^ (l16 & 7)) << 3) | (t & 7);
        if (which == 0) {
            const float sc = rsqrtf(ss + EPS) * 0.08838834764831845f;
            u32x4 w; w.x = cvt_pk(a[0] * sc, a[1] * sc); w.y = cvt_pk(a[2] * sc, a[3] * sc); w.z = cvt_pk(a[4] * sc, a[5] * sc); w.w = cvt_pk(a[6] * sc, a[7] * sc);
            *(LAS u32x4*)(Qs + t * 136 + l16 * 8) = w;
        } else if (which == 1) {
            const float sc = rsqrtf(ss + EPS);
            u32x4 w; w.x = cvt_pk(a[0] * sc, a[1] * sc); w.y = cvt_pk(a[2] * sc, a[3] * sc); w.z = cvt_pk(a[4] * sc, a[5] * sc); w.w = cvt_pk(a[6] * sc, a[7] * sc);
            *(LAS u32x4*)(Ks + t * 136 + l16 * 8) = w;
            const float sb = sc * bt * __expf(gct), sd = sc * __expf(gclast - gct);
#pragma unroll
            for (int e = 0; e < 8; ++e) { KbT[(l16 * 8 + e) * 72 + tsw] = f2bf(a[e] * sb); KdT[(l16 * 8 + e) * 72 + tsw] = f2bf(a[e] * sd); }
        } else {
#pragma unroll
            for (int e = 0; e < 8; ++e) VbT[(l16 * 8 + e) * 72 + tsw] = f2bf(a[e] * bt);
        }
    }
    __syncthreads();
#pragma unroll 2
    for (int r = 0; r < 4; ++r) {
        const int job = wid + 8 * r, kind = job >> 4, tile = job & 15, it = tile >> 2, jt = tile & 3;
        if (kind == 0) {
            if (jt > it) continue;
            const f32x4 acc = tile_mm(Ks, 136, it, Ks, 136, jt, 4, fr, fq);
            const int j = 16 * jt + fr; const float gcj = gcs[j];
            float v[4];
#pragma unroll
            for (int e = 0; e < 4; ++e) { const int i = 16 * it + 4 * fq + e; const bool ok = i > j; v[e] = ok ? acc[e] * __expf(gcs[i] - gcj) * betas[i] : 0.f; }
            *(LAS f32x4*)(Af + j * 68 + 16 * it + 4 * fq) = (f32x4){v[0], v[1], v[2], v[3]};
        } else {
            const f32x4 acc = tile_mm(Ks, 136, jt, Qs, 136, it, 4, fr, fq);
            const int i = 16 * it + fr; const float gci = gcs[i];
            float v[4];
#pragma unroll
            for (int e = 0; e < 4; ++e) { const int j = 16 * jt + 4 * fq + e; const bool ok = i >= j; v[e] = ok ? acc[e] * __expf(gci - gcs[j]) : 0.f; }
            u32x2 w; w.x = cvt_pk(v[0], v[1]); w.y = cvt_pk(v[2], v[3]); *(LAS u32x2*)(QK + i * 72 + 16 * jt + 4 * fq) = w;
        }
    }
    __syncthreads();
    if (wid == 0) {
        f32x2v r2[32];
#pragma unroll
        for (int k = 0; k < 32; ++k) r2[k] = (f32x2v){(lane == 2 * k) ? 1.0f : 0.0f, (lane == 2 * k + 1) ? 1.0f : 0.0f};
        const f32x4 a0 = *(const LAS f32x4*)(Af + 0);
        const f32x4 a1 = *(const LAS f32x4*)(Af + 4);
        const f32x4 a2 = *(const LAS f32x4*)(Af + 8);
        const f32x4 a3 = *(const LAS f32x4*)(Af + 12);
        const f32x4 a4 = *(const LAS f32x4*)(Af + 16);
        const float t0 = r2[0][0]; const f32x2v T0 = (f32x2v){t0, t0}; Tb[0 + lane] = f2bf(t0);
        r2[0] -= (f32x2v){a0[0], a0[1]} * T0; r2[1] -= (f32x2v){a0[2], a0[3]} * T0;
        const f32x4 a5 = *(const LAS f32x4*)(Af + 20);
        r2[2] -= (f32x2v){a1[0], a1[1]} * T0; r2[3] -= (f32x2v){a1[2], a1[3]} * T0;
        const f32x4 a6 = *(const LAS f32x4*)(Af + 24);
        r2[4] -= (f32x2v){a2[0], a2[1]} * T0; r2[5] -= (f32x2v){a2[2], a2[3]} * T0;
        const f32x4 a7 = *(const LAS f32x4*)(Af + 28);
        r2[6] -= (f32x2v){a3[0], a3[1]} * T0; r2[7] -= (f32x2v){a3[2], a3[3]} * T0;
        const f32x4 a8 = *(const LAS f32x4*)(Af + 32);
        r2[8] -= (f32x2v){a4[0], a4[1]} * T0; r2[9] -= (f32x2v){a4[2], a4[3]} * T0;
        const f32x4 a9 = *(const LAS f32x4*)(Af + 36);
        r2[10] -= (f32x2v){a5[0], a5[1]} * T0; r2[11] -= (f32x2v){a5[2], a5[3]} * T0;
        const f32x4 a10 = *(const LAS f32x4*)(Af + 40);
        r2[12] -= (f32x2v){a6[0], a6[1]} * T0; r2[13] -= (f32x2v){a6[2], a6[3]} * T0;
        const f32x4 a11 = *(const LAS f32x4*)(Af + 44);
        r2[14] -= (f32x2v){a7[0], a7[1]} * T0; r2[15] -= (f32x2v){a7[2], a7[3]} * T0;
        const f32x4 a12 = *(const LAS f32x4*)(Af + 48);
        r2[16] -= (f32x2v){a8[0], a8[1]} * T0; r2[17] -= (f32x2v){a8[2], a8[3]} * T0;
        const f32x4 a13 = *(const LAS f32x4*)(Af + 52);
        r2[18] -= (f32x2v){a9[0], a9[1]} * T0; r2[19] -= (f32x2v){a9[2], a9[3]} * T0;
        const f32x4 a14 = *(const LAS f32x4*)(Af + 56);
        r2[20] -= (f32x2v){a10[0], a10[1]} * T0; r2[21] -= (f32x2v){a10[2], a10[3]} * T0;
        const f32x4 a15 = *(const LAS f32x4*)(Af + 60);
        r2[22] -= (f32x2v){a11[0], a11[1]} * T0; r2[23] -= (f32x2v){a11[2], a11[3]} * T0;
        const f32x4 a16 = *(const LAS f32x4*)(Af + 68);
        r2[24] -= (f32x2v){a12[0], a12[1]} * T0; r2[25] -= (f32x2v){a12[2], a12[3]} * T0;
        const f32x4 a17 = *(const LAS f32x4*)(Af + 72);
        r2[26] -= (f32x2v){a13[0], a13[1]} * T0; r2[27] -= (f32x2v){a13[2], a13[3]} * T0;
        const f32x4 a18 = *(const LAS f32x4*)(Af + 76);
        r2[28] -= (f32x2v){a14[0], a14[1]} * T0; r2[29] -= (f32x2v){a14[2], a14[3]} * T0;
        const f32x4 a19 = *(const LAS f32x4*)(Af + 80);
        r2[30] -= (f32x2v){a15[0], a15[1]} * T0; r2[31] -= (f32x2v){a15[2], a15[3]} * T0;
        const f32x4 a20 = *(const LAS f32x4*)(Af + 84);
        const float t1 = r2[0][1]; const f32x2v T1 = (f32x2v){t1, t1}; Tb[72 + lane] = f2bf(t1);
        r2[1] -= (f32x2v){a16[2], a16[3]} * T1;
        const f32x4 a21 = *(const LAS f32x4*)(Af + 88);
        r2[2] -= (f32x2v){a17[0], a17[1]} * T1; r2[3] -= (f32x2v){a17[2], a17[3]} * T1;
        const f32x4 a22 = *(const LAS f32x4*)(Af + 92);
        r2[4] -= (f32x2v){a18[0], a18[1]} * T1; r2[5] -= (f32x2v){a18[2], a18[3]} * T1;
        const f32x4 a23 = *(const LAS f32x4*)(Af + 96);
        r2[6] -= (f32x2v){a19[0], a19[1]} * T1; r2[7] -= (f32x2v){a19[2], a19[3]} * T1;
        const f32x4 a24 = *(const LAS f32x4*)(Af + 100);
        r2[8] -= (f32x2v){a20[0], a20[1]} * T1; r2[9] -= (f32x2v){a20[2], a20[3]} * T1;
        const f32x4 a25 = *(const LAS f32x4*)(Af + 104);
        r2[10] -= (f32x2v){a21[0], a21[1]} * T1; r2[11] -= (f32x2v){a21[2], a21[3]} * T1;
        const f32x4 a26 = *(const LAS f32x4*)(Af + 108);
        r2[12] -= (f32x2v){a22[0], a22[1]} * T1; r2[13] -= (f32x2v){a22[2], a22[3]} * T1;
        const f32x4 a27 = *(const LAS f32x4*)(Af + 112);
        r2[14] -= (f32x2v){a23[0], a23[1]} * T1; r2[15] -= (f32x2v){a23[2], a23[3]} * T1;
        const f32x4 a28 = *(const LAS f32x4*)(Af + 116);
        r2[16] -= (f32x2v){a24[0], a24[1]} * T1; r2[17] -= (f32x2v){a24[2], a24[3]} * T1;
        const f32x4 a29 = *(const LAS f32x4*)(Af + 120);
        r2[18] -= (f32x2v){a25[0], a25[1]} * T1; r2[19] -= (f32x2v){a25[2], a25[3]} * T1;
        const f32x4 a30 = *(const LAS f32x4*)(Af + 124);
        r2[20] -= (f32x2v){a26[0], a26[1]} * T1; r2[21] -= (f32x2v){a26[2], a26[3]} * T1;
        const f32x4 a31 = *(const LAS f32x4*)(Af + 128);
        r2[22] -= (f32x2v){a27[0], a27[1]} * T1; r2[23] -= (f32x2v){a27[2], a27[3]} * T1;
        const f32x4 a32 = *(const LAS f32x4*)(Af + 136);
        r2[24] -= (f32x2v){a28[0], a28[1]} * T1; r2[25] -= (f32x2v){a28[2], a28[3]} * T1;
        const f32x4 a33 = *(const LAS f32x4*)(Af + 140);
        r2[26] -= (f32x2v){a29[0], a29[1]} * T1; r2[27] -= (f32x2v){a29[2], a29[3]} * T1;
        const f32x4 a34 = *(const LAS f32x4*)(Af + 144);
        r2[28] -= (f32x2v){a30[0], a30[1]} * T1; r2[29] -= (f32x2v){a30[2], a30[3]} * T1;
        const f32x4 a35 = *(const LAS f32x4*)(Af + 148);
        r2[30] -= (f32x2v){a31[0], a31[1]} * T1; r2[31] -= (f32x2v){a31[2], a31[3]} * T1;
        const f32x4 a36 = *(const LAS f32x4*)(Af + 152);
        const float t2 = r2[1][0]; const f32x2v T2 = (f32x2v){t2, t2}; Tb[144 + lane] = f2bf(t2);
        r2[1] -= (f32x2v){a32[2], a32[3]} * T2;
        const f32x4 a37 = *(const LAS f32x4*)(Af + 156);
        r2[2] -= (f32x2v){a33[0], a33[1]} * T2; r2[3] -= (f32x2v){a33[2], a33[3]} * T2;
        const f32x4 a38 = *(const LAS f32x4*)(Af + 160);
        r2[4] -= (f32x2v){a34[0], a34[1]} * T2; r2[5] -= (f32x2v){a34[2], a34[3]} * T2;
        const f32x4 a39 = *(const LAS f32x4*)(Af + 164);
        r2[6] -= (f32x2v){a35[0], a35[1]} * T2; r2[7] -= (f32x2v){a35[2], a35[3]} * T2;
        const f32x4 a40 = *(const LAS f32x4*)(Af + 168);
        r2[8] -= (f32x2v){a36[0], a36[1]} * T2; r2[9] -= (f32x2v){a36[2], a36[3]} * T2;
        const f32x4 a41 = *(const LAS f32x4*)(Af + 172);
        r2[10] -= (f32x2v){a37[0], a37[1]} * T2; r2[11] -= (f32x2v){a37[2], a37[3]} * T2;
        const f32x4 a42 = *(const LAS f32x4*)(Af + 176);
        r2[12] -= (f32x2v){a38[0], a38[1]} * T2; r2[13] -= (f32x2v){a38[2], a38[3]} * T2;
        const f32x4 a43 = *(const LAS f32x4*)(Af + 180);
        r2[14] -= (f32x2v){a39[0], a39[1]} * T2; r2[15] -= (f32x2v){a39[2], a39[3]} * T2;
        const f32x4 a44 = *(const LAS f32x4*)(Af + 184);
        r2[16] -= (f32x2v){a40[0], a40[1]} * T2; r2[17] -= (f32x2v){a40[2], a40[3]} * T2;
        const f32x4 a45 = *(const LAS f32x4*)(Af + 188);
        r2[18] -= (f32x2v){a41[0], a41[1]} * T2; r2[19] -= (f32x2v){a41[2], a41[3]} * T2;
        const f32x4 a46 = *(const LAS f32x4*)(Af + 192);
        r2[20] -= (f32x2v){a42[0], a42[1]} * T2; r2[21] -= (f32x2v){a42[2], a42[3]} * T2;
        const f32x4 a47 = *(const LAS f32x4*)(Af + 196);
        r2[22] -= (f32x2v){a43[0], a43[1]} * T2; r2[23] -= (f32x2v){a43[2], a43[3]} * T2;
        const f32x4 a48 = *(const LAS f32x4*)(Af + 208);
        r2[24] -= (f32x2v){a44[0], a44[1]} * T2; r2[25] -= (f32x2v){a44[2], a44[3]} * T2;
        const f32x4 a49 = *(const LAS f32x4*)(Af + 212);
        r2[26] -= (f32x2v){a45[0], a45[1]} * T2; r2[27] -= (f32x2v){a45[2], a45[3]} * T2;
        const f32x4 a50 = *(const LAS f32x4*)(Af + 216);
        r2[28] -= (f32x2v){a46[0], a46[1]} * T2; r2[29] -= (f32x2v){a46[2], a46[3]} * T2;
        const f32x4 a51 = *(const LAS f32x4*)(Af + 220);
        r2[30] -= (f32x2v){a47[0], a47[1]} * T2; r2[31] -= (f32x2v){a47[2], a47[3]} * T2;
        const f32x4 a52 = *(const LAS f32x4*)(Af + 224);
        const float t3 = r2[1][1]; const f32x2v T3 = (f32x2v){t3, t3}; Tb[216 + lane] = f2bf(t3);
        r2[2] -= (f32x2v){a48[0], a48[1]} * T3; r2[3] -= (f32x2v){a48[2], a48[3]} * T3;
        const f32x4 a53 = *(const LAS f32x4*)(Af + 228);
        r2[4] -= (f32x2v){a49[0], a49[1]} * T3; r2[5] -= (f32x2v){a49[2], a49[3]} * T3;
        const f32x4 a54 = *(const LAS f32x4*)(Af + 232);
        r2[6] -= (f32x2v){a50[0], a50[1]} * T3; r2[7] -= (f32x2v){a50[2], a50[3]} * T3;
        const f32x4 a55 = *(const LAS f32x4*)(Af + 236);
        r2[8] -= (f32x2v){a51[0], a51[1]} * T3; r2[9] -= (f32x2v){a51[2], a51[3]} * T3;
        const f32x4 a56 = *(const LAS f32x4*)(Af + 240);
        r2[10] -= (f32x2v){a52[0], a52[1]} * T3; r2[11] -= (f32x2v){a52[2], a52[3]} * T3;
        const f32x4 a57 = *(const LAS f32x4*)(Af + 244);
        r2[12] -= (f32x2v){a53[0], a53[1]} * T3; r2[13] -= (f32x2v){a53[2], a53[3]} * T3;
        const f32x4 a58 = *(const LAS f32x4*)(Af + 248);
        r2[14] -= (f32x2v){a54[0], a54[1]} * T3; r2[15] -= (f32x2v){a54[2], a54[3]} * T3;
        const f32x4 a59 = *(const LAS f32x4*)(Af + 252);
        r2[16] -= (f32x2v){a55[0], a55[1]} * T3; r2[17] -= (f32x2v){a55[2], a55[3]} * T3;
        const f32x4 a60 = *(const LAS f32x4*)(Af + 256);
        r2[18] -= (f32x2v){a56[0], a56[1]} * T3; r2[19] -= (f32x2v){a56[2], a56[3]} * T3;
        const f32x4 a61 = *(const LAS f32x4*)(Af + 260);
        r2[20] -= (f32x2v){a57[0], a57[1]} * T3; r2[21] -= (f32x2v){a57[2], a57[3]} * T3;
        const f32x4 a62 = *(const LAS f32x4*)(Af + 264);
        r2[22] -= (f32x2v){a58[0], a58[1]} * T3; r2[23] -= (f32x2v){a58[2], a58[3]} * T3;
        const f32x4 a63 = *(const LAS f32x4*)(Af + 276);
        r2[24] -= (f32x2v){a59[0], a59[1]} * T3; r2[25] -= (f32x2v){a59[2], a59[3]} * T3;
        const f32x4 a64 = *(const LAS f32x4*)(Af + 280);
        r2[26] -= (f32x2v){a60[0], a60[1]} * T3; r2[27] -= (f32x2v){a60[2], a60[3]} * T3;
        const f32x4 a65 = *(const LAS f32x4*)(Af + 284);
        r2[28] -= (f32x2v){a61[0], a61[1]} * T3; r2[29] -= (f32x2v){a61[2], a61[3]} * T3;
        const f32x4 a66 = *(const LAS f32x4*)(Af + 288);
        r2[30] -= (f32x2v){a62[0], a62[1]} * T3; r2[31] -= (f32x2v){a62[2], a62[3]} * T3;
        const f32x4 a67 = *(const LAS f32x4*)(Af + 292);
        const float t4 = r2[2][0]; const f32x2v T4 = (f32x2v){t4, t4}; Tb[288 + lane] = f2bf(t4);
        r2[2] -= (f32x2v){a63[0], a63[1]} * T4; r2[3] -= (f32x2v){a63[2], a63[3]} * T4;
        const f32x4 a68 = *(const LAS f32x4*)(Af + 296);
        r2[4] -= (f32x2v){a64[0], a64[1]} * T4; r2[5] -= (f32x2v){a64[2], a64[3]} * T4;
        const f32x4 a69 = *(const LAS f32x4*)(Af + 300);
        r2[6] -= (f32x2v){a65[0], a65[1]} * T4; r2[7] -= (f32x2v){a65[2], a65[3]} * T4;
        const f32x4 a70 = *(const LAS f32x4*)(Af + 304);
        r2[8] -= (f32x2v){a66[0], a66[1]} * T4; r2[9] -= (f32x2v){a66[2], a66[3]} * T4;
        const f32x4 a71 = *(const LAS f32x4*)(Af + 308);
        r2[10] -= (f32x2v){a67[0], a67[1]} * T4; r2[11] -= (f32x2v){a67[2], a67[3]} * T4;
        const f32x4 a72 = *(const LAS f32x4*)(Af + 312);
        r2[12] -= (f32x2v){a68[0], a68[1]} * T4; r2[13] -= (f32x2v){a68[2], a68[3]} * T4;
        const f32x4 a73 = *(const LAS f32x4*)(Af + 316);
        r2[14] -= (f32x2v){a69[0], a69[1]} * T4; r2[15] -= (f32x2v){a69[2], a69[3]} * T4;
        const f32x4 a74 = *(const LAS f32x4*)(Af + 320);
        r2[16] -= (f32x2v){a70[0], a70[1]} * T4; r2[17] -= (f32x2v){a70[2], a70[3]} * T4;
        const f32x4 a75 = *(const LAS f32x4*)(Af + 324);
        r2[18] -= (f32x2v){a71[0], a71[1]} * T4; r2[19] -= (f32x2v){a71[2], a71[3]} * T4;
        const f32x4 a76 = *(const LAS f32x4*)(Af + 328);
        r2[20] -= (f32x2v){a72[0], a72[1]} * T4; r2[21] -= (f32x2v){a72[2], a72[3]} * T4;
        const f32x4 a77 = *(const LAS f32x4*)(Af + 332);
        r2[22] -= (f32x2v){a73[0], a73[1]} * T4; r2[23] -= (f32x2v){a73[2], a73[3]} * T4;
        const f32x4 a78 = *(const LAS f32x4*)(Af + 344);
        r2[24] -= (f32x2v){a74[0], a74[1]} * T4; r2[25] -= (f32x2v){a74[2], a74[3]} * T4;
        const f32x4 a79 = *(const LAS f32x4*)(Af + 348);
        r2[26] -= (f32x2v){a75[0], a75[1]} * T4; r2[27] -= (f32x2v){a75[2], a75[3]} * T4;
        const f32x4 a80 = *(const LAS f32x4*)(Af + 352);
        r2[28] -= (f32x2v){a76[0], a76[1]} * T4; r2[29] -= (f32x2v){a76[2], a76[3]} * T4;
        const f32x4 a81 = *(const LAS f32x4*)(Af + 356);
        r2[30] -= (f32x2v){a77[0], a77[1]} * T4; r2[31] -= (f32x2v){a77[2], a77[3]} * T4;
        const f32x4 a82 = *(const LAS f32x4*)(Af + 360);
        const float t5 = r2[2][1]; const f32x2v T5 = (f32x2v){t5, t5}; Tb[360 + lane] = f2bf(t5);
        r2[3] -= (f32x2v){a78[2], a78[3]} * T5;
        const f32x4 a83 = *(const LAS f32x4*)(Af + 364);
        r2[4] -= (f32x2v){a79[0], a79[1]} * T5; r2[5] -= (f32x2v){a79[2], a79[3]} * T5;
        const f32x4 a84 = *(const LAS f32x4*)(Af + 368);
        r2[6] -= (f32x2v){a80[0], a80[1]} * T5; r2[7] -= (f32x2v){a80[2], a80[3]} * T5;
        const f32x4 a85 = *(const LAS f32x4*)(Af + 372);
        r2[8] -= (f32x2v){a81[0], a81[1]} * T5; r2[9] -= (f32x2v){a81[2], a81[3]} * T5;
        const f32x4 a86 = *(const LAS f32x4*)(Af + 376);
        r2[10] -= (f32x2v){a82[0], a82[1]} * T5; r2[11] -= (f32x2v){a82[2], a82[3]} * T5;
        const f32x4 a87 = *(const LAS f32x4*)(Af + 380);
        r2[12] -= (f32x2v){a83[0], a83[1]} * T5; r2[13] -= (f32x2v){a83[2], a83[3]} * T5;
        const f32x4 a88 = *(const LAS f32x4*)(Af + 384);
        r2[14] -= (f32x2v){a84[0], a84[1]} * T5; r2[15] -= (f32x2v){a84[2], a84[3]} * T5;
        const f32x4 a89 = *(const LAS f32x4*)(Af + 388);
        r2[16] -= (f32x2v){a85[0], a85[1]} * T5; r2[17] -= (f32x2v){a85[2], a85[3]} * T5;
        const f32x4 a90 = *(const LAS f32x4*)(Af + 392);
        r2[18] -= (f32x2v){a86[0], a86[1]} * T5; r2[19] -= (f32x2v){a86[2], a86[3]} * T5;
        const f32x4 a91 = *(const LAS f32x4*)(Af + 396);
        r2[20] -= (f32x2v){a87[0], a87[1]} * T5; r2[21] -= (f32x2v){a87[2], a87[3]} * T5;
        const f32x4 a92 = *(const LAS f32x4*)(Af + 400);
        r2[22] -= (f32x2v){a88[0], a88[1]} * T5; r2[23] -= (f32x2v){a88[2], a88[3]} * T5;
        const f32x4 a93 = *(const LAS f32x4*)(Af + 412);
        r2[24] -= (f32x2v){a89[0], a89[1]} * T5; r2[25] -= (f32x2v){a89[2], a89[3]} * T5;
        const f32x4 a94 = *(const LAS f32x4*)(Af + 416);
        r2[26] -= (f32x2v){a90[0], a90[1]} * T5; r2[27] -= (f32x2v){a90[2], a90[3]} * T5;
        const f32x4 a95 = *(const LAS f32x4*)(Af + 420);
        r2[28] -= (f32x2v){a91[0], a91[1]} * T5; r2[29] -= (f32x2v){a91[2], a91[3]} * T5;
        const f32x4 a96 = *(const LAS f32x4*)(Af + 424);
        r2[30] -= (f32x2v){a92[0], a92[1]} * T5; r2[31] -= (f32x2v){a92[2], a92[3]} * T5;
        const f32x4 a97 = *(const LAS f32x4*)(Af + 428);
        const float t6 = r2[3][0]; const f32x2v T6 = (f32x2v){t6, t6}; Tb[432 + lane] = f2bf(t6);
        r2[3] -= (f32x2v){a93[2], a93[3]} * T6;
        const f32x4 a98 = *(const LAS f32x4*)(Af + 432);
        r2[4] -= (f32x2v){a94[0], a94[1]} * T6; r2[5] -= (f32x2v){a94[2], a94[3]} * T6;
        const f32x4 a99 = *(const LAS f32x4*)(Af + 436);
        r2[6] -= (f32x2v){a95[0], a95[1]} * T6; r2[7] -= (f32x2v){a95[2], a95[3]} * T6;
        const f32x4 a100 = *(const LAS f32x4*)(Af + 440);
        r2[8] -= (f32x2v){a96[0], a96[1]} * T6; r2[9] -= (f32x2v){a96[2], a96[3]} * T6;
        const f32x4 a101 = *(const LAS f32x4*)(Af + 444);
        r2[10] -= (f32x2v){a97[0], a97[1]} * T6; r2[11] -= (f32x2v){a97[2], a97[3]} * T6;
        const f32x4 a102 = *(const LAS f32x4*)(Af + 448);
        r2[12] -= (f32x2v){a98[0], a98[1]} * T6; r2[13] -= (f32x2v){a98[2], a98[3]} * T6;
        const f32x4 a103 = *(const LAS f32x4*)(Af + 452);
        r2[14] -= (f32x2v){a99[0], a99[1]} * T6; r2[15] -= (f32x2v){a99[2], a99[3]} * T6;
        const f32x4 a104 = *(const LAS f32x4*)(Af + 456);
        r2[16] -= (f32x2v){a100[0], a100[1]} * T6; r2[17] -= (f32x2v){a100[2], a100[3]} * T6;
        const f32x4 a105 = *(const LAS f32x4*)(Af + 460);
        r2[18] -= (f32x2v){a101[0], a101[1]} * T6; r2[19] -= (f32x2v){a101[2], a101[3]} * T6;
        const f32x4 a106 = *(const LAS f32x4*)(Af + 464);
        r2[20] -= (f32x2v){a102[0], a102[1]} * T6; r2[21] -= (f32x2v){a102[2], a102[3]} * T6;
        const f32x4 a107 = *(const LAS f32x4*)(Af + 468);
        r2[22] -= (f32x2v){a103[0], a103[1]} * T6; r2[23] -= (f32x2v){a103[2], a103[3]} * T6;
        const f32x4 a108 = *(const LAS f32x4*)(Af + 484);
        r2[24] -= (f32x2v){a104[0], a104[1]} * T6; r2[25] -= (f32x2v){a104[2], a104[3]} * T6;
        const f32x4 a109 = *(const LAS f32x4*)(Af + 488);
        r2[26] -= (f32x2v){a105[0], a105[1]} * T6; r2[27] -= (f32x2v){a105[2], a105[3]} * T6;
        const f32x4 a110 = *(const LAS f32x4*)(Af + 492);
        r2[28] -= (f32x2v){a106[0], a106[1]} * T6; r2[29] -= (f32x2v){a106[2], a106[3]} * T6;
        const f32x4 a111 = *(const LAS f32x4*)(Af + 496);
        r2[30] -= (f32x2v){a107[0], a107[1]} * T6; r2[31] -= (f32x2v){a107[2], a107[3]} * T6;
        const f32x4 a112 = *(const LAS f32x4*)(Af + 500);
        const float t7 = r2[3][1]; const f32x2v T7 = (f32x2v){t7, t7}; Tb[504 + lane] = f2bf(t7);
        r2[4] -= (f32x2v){a108[0], a108[1]} * T7; r2[5] -= (f32x2v){a108[2], a108[3]} * T7;
        const f32x4 a113 = *(const LAS f32x4*)(Af + 504);
        r2[6] -= (f32x2v){a109[0], a109[1]} * T7; r2[7] -= (f32x2v){a109[2], a109[3]} * T7;
        const f32x4 a114 = *(const LAS f32x4*)(Af + 508);
        r2[8] -= (f32x2v){a110[0], a110[1]} * T7; r2[9] -= (f32x2v){a110[2], a110[3]} * T7;
        const f32x4 a115 = *(const LAS f32x4*)(Af + 512);
        r2[10] -= (f32x2v){a111[0], a111[1]} * T7; r2[11] -= (f32x2v){a111[2], a111[3]} * T7;
        const f32x4 a116 = *(const LAS f32x4*)(Af + 516);
        r2[12] -= (f32x2v){a112[0], a112[1]} * T7; r2[13] -= (f32x2v){a112[2], a112[3]} * T7;
        const f32x4 a117 = *(const LAS f32x4*)(Af + 520);
        r2[14] -= (f32x2v){a113[0], a113[1]} * T7; r2[15] -= (f32x2v){a113[2], a113[3]} * T7;
        const f32x4 a118 = *(const LAS f32x4*)(Af + 524);
        r2[16] -= (f32x2v){a114[0], a114[1]} * T7; r2[17] -= (f32x2v){a114[2], a114[3]} * T7;
        const f32x4 a119 = *(const LAS f32x4*)(Af + 528);
        r2[18] -= (f32x2v){a115[0], a115[1]} * T7; r2[19] -= (f32x2v){a115[2], a115[3]} * T7;
        const f32x4 a120 = *(const LAS f32x4*)(Af + 532);
        r2[20] -= (f32x2v){a116[0], a116[1]} * T7; r2[21] -= (f32x2v){a116[2], a116[3]} * T7;
        const f32x4 a121 = *(const LAS f32x4*)(Af + 536);
        r2[22] -= (f32x2v){a117[0], a117[1]} * T7; r2[23] -= (f32x2v){a117[2], a117[3]} * T7;
        const f32x4 a122 = *(const LAS f32x4*)(Af + 552);
        r2[24] -= (f32x2v){a118[0], a118[1]} * T7; r2[25] -= (f32x2v){a118[2], a118[3]} * T7;
        const f32x4 a123 = *(const LAS f32x4*)(Af + 556);
        r2[26] -= (f32x2v){a119[0], a119[1]} * T7; r2[27] -= (f32x2v){a119[2], a119[3]} * T7;
        const f32x4 a124 = *(const LAS f32x4*)(Af + 560);
        r2[28] -= (f32x2v){a120[0], a120[1]} * T7; r2[29] -= (f32x2v){a120[2], a120[3]} * T7;
        const f32x4 a125 = *(const LAS f32x4*)(Af + 564);
        r2[30] -= (f32x2v){a121[0], a121[1]} * T7; r2[31] -= (f32x2v){a121[2], a121[3]} * T7;
        const f32x4 a126 = *(const LAS f32x4*)(Af + 568);
        const float t8 = r2[4][0]; const f32x2v T8 = (f32x2v){t8, t8}; Tb[576 + lane] = f2bf(t8);
        r2[4] -= (f32x2v){a122[0], a122[1]} * T8; r2[5] -= (f32x2v){a122[2], a122[3]} * T8;
        const f32x4 a127 = *(const LAS f32x4*)(Af + 572);
        r2[6] -= (f32x2v){a123[0], a123[1]} * T8; r2[7] -= (f32x2v){a123[2], a123[3]} * T8;
        const f32x4 a128 = *(const LAS f32x4*)(Af + 576);
        r2[8] -= (f32x2v){a124[0], a124[1]} * T8; r2[9] -= (f32x2v){a124[2], a124[3]} * T8;
        const f32x4 a129 = *(const LAS f32x4*)(Af + 580);
        r2[10] -= (f32x2v){a125[0], a125[1]} * T8; r2[11] -= (f32x2v){a125[2], a125[3]} * T8;
        const f32x4 a130 = *(const LAS f32x4*)(Af + 584);
        r2[12] -= (f32x2v){a126[0], a126[1]} * T8; r2[13] -= (f32x2v){a126[2], a126[3]} * T8;
        const f32x4 a131 = *(const LAS f32x4*)(Af + 588);
        r2[14] -= (f32x2v){a127[0], a127[1]} * T8; r2[15] -= (f32x2v){a127[2], a127[3]} * T8;
        const f32x4 a132 = *(const LAS f32x4*)(Af + 592);
        r2[16] -= (f32x2v){a128[0], a128[1]} * T8; r2[17] -= (f32x2v){a128[2], a128[3]} * T8;
        const f32x4 a133 = *(const LAS f32x4*)(Af + 596);
        r2[18] -= (f32x2v){a129[0], a129[1]} * T8; r2[19] -= (f32x2v){a129[2], a129[3]} * T8;
        const f32x4 a134 = *(const LAS f32x4*)(Af + 600);
        r2[20] -= (f32x2v){a130[0], a130[1]} * T8; r2[21] -= (f32x2v){a130[2], a130[3]} * T8;
        const f32x4 a135 = *(const LAS f32x4*)(Af + 604);
        r2[22] -= (f32x2v){a131[0], a131[1]} * T8; r2[23] -= (f32x2v){a131[2], a131[3]} * T8;
        const f32x4 a136 = *(const LAS f32x4*)(Af + 620);
        r2[24] -= (f32x2v){a132[0], a132[1]} * T8; r2[25] -= (f32x2v){a132[2], a132[3]} * T8;
        const f32x4 a137 = *(const LAS f32x4*)(Af + 624);
        r2[26] -= (f32x2v){a133[0], a133[1]} * T8; r2[27] -= (f32x2v){a133[2], a133[3]} * T8;
        const f32x4 a138 = *(const LAS f32x4*)(Af + 628);
        r2[28] -= (f32x2v){a134[0], a134[1]} * T8; r2[29] -= (f32x2v){a134[2], a134[3]} * T8;
        const f32x4 a139 = *(const LAS f32x4*)(Af + 632);
        r2[30] -= (f32x2v){a135[0], a135[1]} * T8; r2[31] -= (f32x2v){a135[2], a135[3]} * T8;
        const f32x4 a140 = *(const LAS f32x4*)(Af + 636);
        const float t9 = r2[4][1]; const f32x2v T9 = (f32x2v){t9, t9}; Tb[648 + lane] = f2bf(t9);
        r2[5] -= (f32x2v){a136[2], a136[3]} * T9;
        const f32x4 a141 = *(const LAS f32x4*)(Af + 640);
        r2[6] -= (f32x2v){a137[0], a137[1]} * T9; r2[7] -= (f32x2v){a137[2], a137[3]} * T9;
        const f32x4 a142 = *(const LAS f32x4*)(Af + 644);
        r2[8] -= (f32x2v){a138[0], a138[1]} * T9; r2[9] -= (f32x2v){a138[2], a138[3]} * T9;
        const f32x4 a143 = *(const LAS f32x4*)(Af + 648);
        r2[10] -= (f32x2v){a139[0], a139[1]} * T9; r2[11] -= (f32x2v){a139[2], a139[3]} * T9;
        const f32x4 a144 = *(const LAS f32x4*)(Af + 652);
        r2[12] -= (f32x2v){a140[0], a140[1]} * T9; r2[13] -= (f32x2v){a140[2], a140[3]} * T9;
        const f32x4 a145 = *(const LAS f32x4*)(Af + 656);
        r2[14] -= (f32x2v){a141[0], a141[1]} * T9; r2[15] -= (f32x2v){a141[2], a141[3]} * T9;
        const f32x4 a146 = *(const LAS f32x4*)(Af + 660);
        r2[16] -= (f32x2v){a142[0], a142[1]} * T9; r2[17] -= (f32x2v){a142[2], a142[3]} * T9;
        const f32x4 a147 = *(const LAS f32x4*)(Af + 664);
        r2[18] -= (f32x2v){a143[0], a143[1]} * T9; r2[19] -= (f32x2v){a143[2], a143[3]} * T9;
        const f32x4 a148 = *(const LAS f32x4*)(Af + 668);
        r2[20] -= (f32x2v){a144[0], a144[1]} * T9; r2[21] -= (f32x2v){a144[2], a144[3]} * T9;
        const f32x4 a149 = *(const LAS f32x4*)(Af + 672);
        r2[22] -= (f32x2v){a145[0], a145[1]} * T9; r2[23] -= (f32x2v){a145[2], a145[3]} * T9;
        const f32x4 a150 = *(const LAS f32x4*)(Af + 688);
        r2[24] -= (f32x2v){a146[0], a146[1]} * T9; r2[25] -= (f32x2v){a146[2], a146[3]} * T9;
        const f32x4 a151 = *(const LAS f32x4*)(Af + 692);
        r2[26] -= (f32x2v){a147[0], a147[1]} * T9; r2[27] -= (f32x2v){a147[2], a147[3]} * T9;
        const f32x4 a152 = *(const LAS f32x4*)(Af + 696);
        r2[28] -= (f32x2v){a148[0], a148[1]} * T9; r2[29] -= (f32x2v){a148[2], a148[3]} * T9;
        const f32x4 a153 = *(const LAS f32x4*)(Af + 700);
        r2[30] -= (f32x2v){a149[0], a149[1]} * T9; r2[31] -= (f32x2v){a149[2], a149[3]} * T9;
        const f32x4 a154 = *(const LAS f32x4*)(Af + 704);
        const float t10 = r2[5][0]; const f32x2v T10 = (f32x2v){t10, t10}; Tb[720 + lane] = f2bf(t10);
        r2[5] -= (f32x2v){a150[2], a150[3]} * T10;
        const f32x4 a155 = *(const LAS f32x4*)(Af + 708);
        r2[6] -= (f32x2v){a151[0], a151[1]} * T10; r2[7] -= (f32x2v){a151[2], a151[3]} * T10;
        const f32x4 a156 = *(const LAS f32x4*)(Af + 712);
        r2[8] -= (f32x2v){a152[0], a152[1]} * T10; r2[9] -= (f32x2v){a152[2], a152[3]} * T10;
        const f32x4 a157 = *(const LAS f32x4*)(Af + 716);
        r2[10] -= (f32x2v){a153[0], a153[1]} * T10; r2[11] -= (f32x2v){a153[2], a153[3]} * T10;
        const f32x4 a158 = *(const LAS f32x4*)(Af + 720);
        r2[12] -= (f32x2v){a154[0], a154[1]} * T10; r2[13] -= (f32x2v){a154[2], a154[3]} * T10;
        const f32x4 a159 = *(const LAS f32x4*)(Af + 724);
        r2[14] -= (f32x2v){a155[0], a155[1]} * T10; r2[15] -= (f32x2v){a155[2], a155[3]} * T10;
        const f32x4 a160 = *(const LAS f32x4*)(Af + 728);
        r2[16] -= (f32x2v){a156[0], a156[1]} * T10; r2[17] -= (f32x2v){a156[2], a156[3]} * T10;
        const f32x4 a161 = *(const LAS f32x4*)(Af + 732);
        r2[18] -= (f32x2v){a157[0], a157[1]} * T10; r2[19] -= (f32x2v){a157[2], a157[3]} * T10;
        const f32x4 a162 = *(const LAS f32x4*)(Af + 736);
        r2[20] -= (f32x2v){a158[0], a158[1]} * T10; r2[21] -= (f32x2v){a158[2], a158[3]} * T10;
        const f32x4 a163 = *(const LAS f32x4*)(Af + 740);
        r2[22] -= (f32x2v){a159[0], a159[1]} * T10; r2[23] -= (f32x2v){a159[2], a159[3]} * T10;
        const f32x4 a164 = *(const LAS f32x4*)(Af + 760);
        r2[24] -= (f32x2v){a160[0], a160[1]} * T10; r2[25] -= (f32x2v){a160[2], a160[3]} * T10;
        const f32x4 a165 = *(const LAS f32x4*)(Af + 764);
        r2[26] -= (f32x2v){a161[0], a161[1]} * T10; r2[27] -= (f32x2v){a161[2], a161[3]} * T10;
        const f32x4 a166 = *(const LAS f32x4*)(Af + 768);
        r2[28] -= (f32x2v){a162[0], a162[1]} * T10; r2[29] -= (f32x2v){a162[2], a162[3]} * T10;
        const f32x4 a167 = *(const LAS f32x4*)(Af + 772);
        r2[30] -= (f32x2v){a163[0], a163[1]} * T10; r2[31] -= (f32x2v){a163[2], a163[3]} * T10;
        const f32x4 a168 = *(const LAS f32x4*)(Af + 776);
        const float t11 = r2[5][1]; const f32x2v T11 = (f32x2v){t11, t11}; Tb[792 + lane] = f2bf(t11);
        r2[6] -= (f32x2v){a164[0], a164[1]} * T11; r2[7] -= (f32x2v){a164[2], a164[3]} * T11;
        const f32x4 a169 = *(const LAS f32x4*)(Af + 780);
        r2[8] -= (f32x2v){a165[0], a165[1]} * T11; r2[9] -= (f32x2v){a165[2], a165[3]} * T11;
        const f32x4 a170 = *(const LAS f32x4*)(Af + 784);
        r2[10] -= (f32x2v){a166[0], a166[1]} * T11; r2[11] -= (f32x2v){a166[2], a166[3]} * T11;
        const f32x4 a171 = *(const LAS f32x4*)(Af + 788);
        r2[12] -= (f32x2v){a167[0], a167[1]} * T11; r2[13] -= (f32x2v){a167[2], a167[3]} * T11;
        const f32x4 a172 = *(const LAS f32x4*)(Af + 792);
        r2[14] -= (f32x2v){a168[0], a168[1]} * T11; r2[15] -= (f32x2v){a168[2], a168[3]} * T11;
        const f32x4 a173 = *(const LAS f32x4*)(Af + 796);
        r2[16] -= (f32x2v){a169[0], a169[1]} * T11; r2[17] -= (f32x2v){a169[2], a169[3]} * T11;
        const f32x4 a174 = *(const LAS f32x4*)(Af + 800);
        r2[18] -= (f32x2v){a170[0], a170[1]} * T11; r2[19] -= (f32x2v){a170[2], a170[3]} * T11;
        const f32x4 a175 = *(const LAS f32x4*)(Af + 804);
        r2[20] -= (f32x2v){a171[0], a171[1]} * T11; r2[21] -= (f32x2v){a171[2], a171[3]} * T11;
        const f32x4 a176 = *(const LAS f32x4*)(Af + 808);
        r2[22] -= (f32x2v){a172[0], a172[1]} * T11; r2[23] -= (f32x2v){a172[2], a172[3]} * T11;
        const f32x4 a177 = *(const LAS f32x4*)(Af + 828);
        r2[24] -= (f32x2v){a173[0], a173[1]} * T11; r2[25] -= (f32x2v){a173[2], a173[3]} * T11;
        const f32x4 a178 = *(const LAS f32x4*)(Af + 832);
        r2[26] -= (f32x2v){a174[0], a174[1]} * T11; r2[27] -= (f32x2v){a174[2], a174[3]} * T11;
        const f32x4 a179 = *(const LAS f32x4*)(Af + 836);
        r2[28] -= (f32x2v){a175[0], a175[1]} * T11; r2[29] -= (f32x2v){a175[2], a175[3]} * T11;
        const f32x4 a180 = *(const LAS f32x4*)(Af + 840);
        r2[30] -= (f32x2v){a176[0], a176[1]} * T11; r2[31] -= (f32x2v){a176[2], a176[3]} * T11;
        const f32x4 a181 = *(const LAS f32x4*)(Af + 844);
        const float t12 = r2[6][0]; const f32x2v T12 = (f32x2v){t12, t12}; Tb[864 + lane] = f2bf(t12);
        r2[6] -= (f32x2v){a177[0], a177[1]} * T12; r2[7] -= (f32x2v){a177[2], a177[3]} * T12;
        const f32x4 a182 = *(const LAS f32x4*)(Af + 848);
        r2[8] -= (f32x2v){a178[0], a178[1]} * T12; r2[9] -= (f32x2v){a178[2], a178[3]} * T12;
        const f32x4 a183 = *(const LAS f32x4*)(Af + 852);
        r2[10] -= (f32x2v){a179[0], a179[1]} * T12; r2[11] -= (f32x2v){a179[2], a179[3]} * T12;
        const f32x4 a184 = *(const LAS f32x4*)(Af + 856);
        r2[12] -= (f32x2v){a180[0], a180[1]} * T12; r2[13] -= (f32x2v){a180[2], a180[3]} * T12;
        const f32x4 a185 = *(const LAS f32x4*)(Af + 860);
        r2[14] -= (f32x2v){a181[0], a181[1]} * T12; r2[15] -= (f32x2v){a181[2], a181[3]} * T12;
        const f32x4 a186 = *(const LAS f32x4*)(Af + 864);
        r2[16] -= (f32x2v){a182[0], a182[1]} * T12; r2[17] -= (f32x2v){a182[2], a182[3]} * T12;
        const f32x4 a187 = *(const LAS f32x4*)(Af + 868);
        r2[18] -= (f32x2v){a183[0], a183[1]} * T12; r2[19] -= (f32x2v){a183[2], a183[3]} * T12;
        const f32x4 a188 = *(const LAS f32x4*)(Af + 872);
        r2[20] -= (f32x2v){a184[0], a184[1]} * T12; r2[21] -= (f32x2v){a184[2], a184[3]} * T12;
        const f32x4 a189 = *(const LAS f32x4*)(Af + 876);
        r2[22] -= (f32x2v){a185[0], a185[1]} * T12; r2[23] -= (f32x2v){a185[2], a185[3]} * T12;
        const f32x4 a190 = *(const LAS f32x4*)(Af + 896);
        r2[24] -= (f32x2v){a186[0], a186[1]} * T12; r2[25] -= (f32x2v){a186[2], a186[3]} * T12;
        const f32x4 a191 = *(const LAS f32x4*)(Af + 900);
        r2[26] -= (f32x2v){a187[0], a187[1]} * T12; r2[27] -= (f32x2v){a187[2], a187[3]} * T12;
        const f32x4 a192 = *(const LAS f32x4*)(Af + 904);
        r2[28] -= (f32x2v){a188[0], a188[1]} * T12; r2[29] -= (f32x2v){a188[2], a188[3]} * T12;
        const f32x4 a193 = *(const LAS f32x4*)(Af + 908);
        r2[30] -= (f32x2v){a189[0], a189[1]} * T12; r2[31] -= (f32x2v){a189[2], a189[3]} * T12;
        const f32x4 a194 = *(const LAS f32x4*)(Af + 912);
        const float t13 = r2[6][1]; const f32x2v T13 = (f32x2v){t13, t13}; Tb[936 + lane] = f2bf(t13);
        r2[7] -= (f32x2v){a190[2], a190[3]} * T13;
        const f32x4 a195 = *(const LAS f32x4*)(Af + 916);
        r2[8] -= (f32x2v){a191[0], a191[1]} * T13; r2[9] -= (f32x2v){a191[2], a191[3]} * T13;
        const f32x4 a196 = *(const LAS f32x4*)(Af + 920);
        r2[10] -= (f32x2v){a192[0], a192[1]} * T13; r2[11] -= (f32x2v){a192[2], a192[3]} * T13;
        const f32x4 a197 = *(const LAS f32x4*)(Af + 924);
        r2[12] -= (f32x2v){a193[0], a193[1]} * T13; r2[13] -= (f32x2v){a193[2], a193[3]} * T13;
        const f32x4 a198 = *(const LAS f32x4*)(Af + 928);
        r2[14] -= (f32x2v){a194[0], a194[1]} * T13; r2[15] -= (f32x2v){a194[2], a194[3]} * T13;
        const f32x4 a199 = *(const LAS f32x4*)(Af + 932);
        r2[16] -= (f32x2v){a195[0], a195[1]} * T13; r2[17] -= (f32x2v){a195[2], a195[3]} * T13;
        const f32x4 a200 = *(const LAS f32x4*)(Af + 936);
        r2[18] -= (f32x2v){a196[0], a196[1]} * T13; r2[19] -= (f32x2v){a196[2], a196[3]} * T13;
        const f32x4 a201 = *(const LAS f32x4*)(Af + 940);
        r2[20] -= (f32x2v){a197[0], a197[1]} * T13; r2[21] -= (f32x2v){a197[2], a197[3]} * T13;
        const f32x4 a202 = *(const LAS f32x4*)(Af + 944);
        r2[22] -= (f32x2v){a198[0], a198[1]} * T13; r2[23] -= (f32x2v){a198[2], a198[3]} * T13;
        const f32x4 a203 = *(const LAS f32x4*)(Af + 964);
        r2[24] -= (f32x2v){a199[0], a199[1]} * T13; r2[25] -= (f32x2v){a199[2], a199[3]} * T13;
        const f32x4 a204 = *(const LAS f32x4*)(Af + 968);
        r2[26] -= (f32x2v){a200[0], a200[1]} * T13; r2[27] -= (f32x2v){a200[2], a200[3]} * T13;
        const f32x4 a205 = *(const LAS f32x4*)(Af + 972);
        r2[28] -= (f32x2v){a201[0], a201[1]} * T13; r2[29] -= (f32x2v){a201[2], a201[3]} * T13;
        const f32x4 a206 = *(const LAS f32x4*)(Af + 976);
        r2[30] -= (f32x2v){a202[0], a202[1]} * T13; r2[31] -= (f32x2v){a202[2], a202[3]} * T13;
        const f32x4 a207 = *(const LAS f32x4*)(Af + 980);
        const float t14 = r2[7][0]; const f32x2v T14 = (f32x2v){t14, t14}; Tb[1008 + lane] = f2bf(t14);
        r2[7] -= (f32x2v){a203[2], a203[3]} * T14;
        const f32x4 a208 = *(const LAS f32x4*)(Af + 984);
        r2[8] -= (f32x2v){a204[0], a204[1]} * T14; r2[9] -= (f32x2v){a204[2], a204[3]} * T14;
        const f32x4 a209 = *(const LAS f32x4*)(Af + 988);
        r2[10] -= (f32x2v){a205[0], a205[1]} * T14; r2[11] -= (f32x2v){a205[2], a205[3]} * T14;
        const f32x4 a210 = *(const LAS f32x4*)(Af + 992);
        r2[12] -= (f32x2v){a206[0], a206[1]} * T14; r2[13] -= (f32x2v){a206[2], a206[3]} * T14;
        const f32x4 a211 = *(const LAS f32x4*)(Af + 996);
        r2[14] -= (f32x2v){a207[0], a207[1]} * T14; r2[15] -= (f32x2v){a207[2], a207[3]} * T14;
        const f32x4 a212 = *(const LAS f32x4*)(Af + 1000);
        r2[16] -= (f32x2v){a208[0], a208[1]} * T14; r2[17] -= (f32x2v){a208[2], a208[3]} * T14;
        const f32x4 a213 = *(const LAS f32x4*)(Af + 1004);
        r2[18] -= (f32x2v){a209[0], a209[1]} * T14; r2[19] -= (f32x2v){a209[2], a209[3]} * T14;
        const f32x4 a214 = *(const LAS f32x4*)(Af + 1008);
        r2[20] -= (f32x2v){a210[0], a210[1]} * T14; r2[21] -= (f32x2v){a210[2], a210[3]} * T14;
        const f32x4 a215 = *(const LAS f32x4*)(Af + 1012);
        r2[22] -= (f32x2v){a211[0], a211[1]} * T14; r2[23] -= (f32x2v){a211[2], a211[3]} * T14;
        const f32x4 a216 = *(const LAS f32x4*)(Af + 1036);
        r2[24] -= (f32x2v){a212[0], a212[1]} * T14; r2[25] -= (f32x2v){a212[2], a212[3]} * T14;
        const f32x4 a217 = *(const LAS f32x4*)(Af + 1040);
        r2[26] -= (f32x2v){a213[0], a213[1]} * T14; r2[27] -= (f32x2v){a213[2], a213[3]} * T14;
        const f32x4 a218 = *(const LAS f32x4*)(Af + 1044);
        r2[28] -= (f32x2v){a214[0], a214[1]} * T14; r2[29] -= (f32x2v){a214[2], a214[3]} * T14;
        const f32x4 a219 = *(const LAS f32x4*)(Af + 1048);
        r2[30] -= (f32x2v){a215[0], a215[1]} * T14; r2[31] -= (f32x2v){a215[2], a215[3]} * T14;
        const f32x4 a220 = *(const LAS f32x4*)(Af + 1052);
        const float t15 = r2[7][1]; const f32x2v T15 = (f32x2v){t15, t15}; Tb[1080 + lane] = f2bf(t15);
        r2[8] -= (f32x2v){a216[0], a216[1]} * T15; r2[9] -= (f32x2v){a216[2], a216[3]} * T15;
        const f32x4 a221 = *(const LAS f32x4*)(Af + 1056);
        r2[10] -= (f32x2v){a217[0], a217[1]} * T15; r2[11] -= (f32x2v){a217[2], a217[3]} * T15;
        const f32x4 a222 = *(const LAS f32x4*)(Af + 1060);
        r2[12] -= (f32x2v){a218[0], a218[1]} * T15; r2[13] -= (f32x2v){a218[2], a218[3]} * T15;
        const f32x4 a223 = *(const LAS f32x4*)(Af + 1064);
        r2[14] -= (f32x2v){a219[0], a219[1]} * T15; r2[15] -= (f32x2v){a219[2], a219[3]} * T15;
        const f32x4 a224 = *(const LAS f32x4*)(Af + 1068);
        r2[16] -= (f32x2v){a220[0], a220[1]} * T15; r2[17] -= (f32x2v){a220[2], a220[3]} * T15;
        const f32x4 a225 = *(const LAS f32x4*)(Af + 1072);
        r2[18] -= (f32x2v){a221[0], a221[1]} * T15; r2[19] -= (f32x2v){a221[2], a221[3]} * T15;
        const f32x4 a226 = *(const LAS f32x4*)(Af + 1076);
        r2[20] -= (f32x2v){a222[0], a222[1]} * T15; r2[21] -= (f32x2v){a222[2], a222[3]} * T15;
        const f32x4 a227 = *(const LAS f32x4*)(Af + 1080);
        r2[22] -= (f32x2v){a223[0], a223[1]} * T15; r2[23] -= (f32x2v){a223[2], a223[3]} * T15;
        const f32x4 a228 = *(const LAS f32x4*)(Af + 1104);
        r2[24] -= (f32x2v){a224[0], a224[1]} * T15; r2[25] -= (f32x2v){a224[2], a224[3]} * T15;
        const f32x4 a229 = *(const LAS f32x4*)(Af + 1108);
        r2[26] -= (f32x2v){a225[0], a225[1]} * T15; r2[27] -= (f32x2v){a225[2], a225[3]} * T15;
        const f32x4 a230 = *(const LAS f32x4*)(Af + 1112);
        r2[28] -= (f32x2v){a226[0], a226[1]} * T15; r2[29] -= (f32x2v){a226[2], a226[3]} * T15;
        const f32x4 a231 = *(const LAS f32x4*)(Af + 1116);
        r2[30] -= (f32x2v){a227[0], a227[1]} * T15; r2[31] -= (f32x2v){a227[2], a227[3]} * T15;
        const f32x4 a232 = *(const LAS f32x4*)(Af + 1120);
        const float t16 = r2[8][0]; const f32x2v T16 = (f32x2v){t16, t16}; Tb[1152 + lane] = f2bf(t16);
        r2[8] -= (f32x2v){a228[0], a228[1]} * T16; r2[9] -= (f32x2v){a228[2], a228[3]} * T16;
        const f32x4 a233 = *(const LAS f32x4*)(Af + 1124);
        r2[10] -= (f32x2v){a229[0], a229[1]} * T16; r2[11] -= (f32x2v){a229[2], a229[3]} * T16;
        const f32x4 a234 = *(const LAS f32x4*)(Af + 1128);
        r2[12] -= (f32x2v){a230[0], a230[1]} * T16; r2[13] -= (f32x2v){a230[2], a230[3]} * T16;
        const f32x4 a235 = *(const LAS f32x4*)(Af + 1132);
        r2[14] -= (f32x2v){a231[0], a231[1]} * T16; r2[15] -= (f32x2v){a231[2], a231[3]} * T16;
        const f32x4 a236 = *(const LAS f32x4*)(Af + 1136);
        r2[16] -= (f32x2v){a232[0], a232[1]} * T16; r2[17] -= (f32x2v){a232[2], a232[3]} * T16;
        const f32x4 a237 = *(const LAS f32x4*)(Af + 1140);
        r2[18] -= (f32x2v){a233[0], a233[1]} * T16; r2[19] -= (f32x2v){a233[2], a233[3]} * T16;
        const f32x4 a238 = *(const LAS f32x4*)(Af + 1144);
        r2[20] -= (f32x2v){a234[0], a234[1]} * T16; r2[21] -= (f32x2v){a234[2], a234[3]} * T16;
        const f32x4 a239 = *(const LAS f32x4*)(Af + 1148);
        r2[22] -= (f32x2v){a235[0], a235[1]} * T16; r2[23] -= (f32x2v){a235[2], a235[3]} * T16;
        const f32x4 a240 = *(const LAS f32x4*)(Af + 1172);
        r2[24] -= (f32x2v){a236[0], a236[1]} * T16; r2[25] -= (f32x2v){a236[2], a236[3]} * T16;
        const f32x4 a241 = *(const LAS f32x4*)(Af + 1176);
        r2[26] -= (f32x2v){a237[0], a237[1]} * T16; r2[27] -= (f32x2v){a237[2], a237[3]} * T16;
        const f32x4 a242 = *(const LAS f32x4*)(Af + 1180);
        r2[28] -= (f32x2v){a238[0], a238[1]} * T16; r2[29] -= (f32x2v){a238[2], a238[3]} * T16;
        const f32x4 a243 = *(const LAS f32x4*)(Af + 1184);
        r2[30] -= (f32x2v){a239[0], a239[1]} * T16; r2[31] -= (f32x2v){a239[2], a239[3]} * T16;
        const f32x4 a244 = *(const LAS f32x4*)(Af + 1188);
        const float t17 = r2[8][1]; const f32x2v T17 = (f32x2v){t17, t17}; Tb[1224 + lane] = f2bf(t17);
        r2[9] -= (f32x2v){a240[2], a240[3]} * T17;
        const f32x4 a245 = *(const LAS f32x4*)(Af + 1192);
        r2[10] -= (f32x2v){a241[0], a241[1]} * T17; r2[11] -= (f32x2v){a241[2], a241[3]} * T17;
        const f32x4 a246 = *(const LAS f32x4*)(Af + 1196);
        r2[12] -= (f32x2v){a242[0], a242[1]} * T17; r2[13] -= (f32x2v){a242[2], a242[3]} * T17;
        const f32x4 a247 = *(const LAS f32x4*)(Af + 1200);
        r2[14] -= (f32x2v){a243[0], a243[1]} * T17; r2[15] -= (f32x2v){a243[2], a243[3]} * T17;
        const f32x4 a248 = *(const LAS f32x4*)(Af + 1204);
        r2[16] -= (f32x2v){a244[0], a244[1]} * T17; r2[17] -= (f32x2v){a244[2], a244[3]} * T17;
        const f32x4 a249 = *(const LAS f32x4*)(Af + 1208);
        r2[18] -= (f32x2v){a245[0], a245[1]} * T17; r2[19] -= (f32x2v){a245[2], a245[3]} * T17;
        const f32x4 a250 = *(const LAS f32x4*)(Af + 1212);
        r2[20] -= (f32x2v){a246[0], a246[1]} * T17; r2[21] -= (f32x2v){a246[2], a246[3]} * T17;
        const f32x4 a251 = *(const LAS f32x4*)(Af + 1216);
        r2[22] -= (f32x2v){a247[0], a247[1]} * T17; r2[23] -= (f32x2v){a247[2], a247[3]} * T17;
        const f32x4 a252 = *(const LAS f32x4*)(Af + 1240);
        r2[24] -= (f32x2v){a248[0], a248[1]} * T17; r2[25] -= (f32x2v){a248[2], a248[3]} * T17;
        const f32x4 a253 = *(const LAS f32x4*)(Af + 1244);
        r2[26] -= (f32x2v){a249[0], a249[1]} * T17; r2[27] -= (f32x2v){a249[2], a249[3]} * T17;
        const f32x4 a254 = *(const LAS f32x4*)(Af + 1248);
        r2[28] -= (f32x2v){a250[0], a250[1]} * T17; r2[29] -= (f32x2v){a250[2], a250[3]} * T17;
        const f32x4 a255 = *(const LAS f32x4*)(Af + 1252);
        r2[30] -= (f32x2v){a251[0], a251[1]} * T17; r2[31] -= (f32x2v){a251[2], a251[3]} * T17;
        const f32x4 a256 = *(const LAS f32x4*)(Af + 1256);
        const float t18 = r2[9][0]; const f32x2v T18 = (f32x2v){t18, t18}; Tb[1296 + lane] = f2bf(t18);
        r2[9] -= (f32x2v){a252[2], a252[3]} * T18;
        const f32x4 a257 = *(const LAS f32x4*)(Af + 1260);
        r2[10] -= (f32x2v){a253[0], a253[1]} * T18; r2[11] -= (f32x2v){a253[2], a253[3]} * T18;
        const f32x4 a258 = *(const LAS f32x4*)(Af + 1264);
        r2[12] -= (f32x2v){a254[0], a254[1]} * T18; r2[13] -= (f32x2v){a254[2], a254[3]} * T18;
        const f32x4 a259 = *(const LAS f32x4*)(Af + 1268);
        r2[14] -= (f32x2v){a255[0], a255[1]} * T18; r2[15] -= (f32x2v){a255[2], a255[3]} * T18;
        const f32x4 a260 = *(const LAS f32x4*)(Af + 1272);
        r2[16] -= (f32x2v){a256[0], a256[1]} * T18; r2[17] -= (f32x2v){a256[2], a256[3]} * T18;
        const f32x4 a261 = *(const LAS f32x4*)(Af + 1276);
        r2[18] -= (f32x2v){a257[0], a257[1]} * T18; r2[19] -= (f32x2v){a257[2], a257[3]} * T18;
        const f32x4 a262 = *(const LAS f32x4*)(Af + 1280);
        r2[20] -= (f32x2v){a258[0], a258[1]} * T18; r2[21] -= (f32x2v){a258[2], a258[3]} * T18;
        const f32x4 a263 = *(const LAS f32x4*)(Af + 1284);
        r2[22] -= (f32x2v){a259[0], a259[1]} * T18; r2[23] -= (f32x2v){a259[2], a259[3]} * T18;
        const f32x4 a264 = *(const LAS f32x4*)(Af + 1312);
        r2[24] -= (f32x2v){a260[0], a260[1]} * T18; r2[25] -= (f32x2v){a260[2], a260[3]} * T18;
        const f32x4 a265 = *(const LAS f32x4*)(Af + 1316);
        r2[26] -= (f32x2v){a261[0], a261[1]} * T18; r2[27] -= (f32x2v){a261[2], a261[3]} * T18;
        const f32x4 a266 = *(const LAS f32x4*)(Af + 1320);
        r2[28] -= (f32x2v){a262[0], a262[1]} * T18; r2[29] -= (f32x2v){a262[2], a262[3]} * T18;
        const f32x4 a267 = *(const LAS f32x4*)(Af + 1324);
        r2[30] -= (f32x2v){a263[0], a263[1]} * T18; r2[31] -= (f32x2v){a263[2], a263[3]} * T18;
        const f32x4 a268 = *(const LAS f32x4*)(Af + 1328);
        const float t19 = r2[9][1]; const f32x2v T19 = (f32x2v){t19, t19}; Tb[1368 + lane] = f2bf(t19);
        r2[10] -= (f32x2v){a264[0], a264[1]} * T19; r2[11] -= (f32x2v){a264[2], a264[3]} * T19;
        const f32x4 a269 = *(const LAS f32x4*)(Af + 1332);
        r2[12] -= (f32x2v){a265[0], a265[1]} * T19; r2[13] -= (f32x2v){a265[2], a265[3]} * T19;
        const f32x4 a270 = *(const LAS f32x4*)(Af + 1336);
        r2[14] -= (f32x2v){a266[0], a266[1]} * T19; r2[15] -= (f32x2v){a266[2], a266[3]} * T19;
        const f32x4 a271 = *(const LAS f32x4*)(Af + 1340);
        r2[16] -= (f32x2v){a267[0], a267[1]} * T19; r2[17] -= (f32x2v){a267[2], a267[3]} * T19;
        const f32x4 a272 = *(const LAS f32x4*)(Af + 1344);
        r2[18] -= (f32x2v){a268[0], a268[1]} * T19; r2[19] -= (f32x2v){a268[2], a268[3]} * T19;
        const f32x4 a273 = *(const LAS f32x4*)(Af + 1348);
        r2[20] -= (f32x2v){a269[0], a269[1]} * T19; r2[21] -= (f32x2v){a269[2], a269[3]} * T19;
        const f32x4 a274 = *(const LAS f32x4*)(Af + 1352);
        r2[22] -= (f32x2v){a270[0], a270[1]} * T19; r2[23] -= (f32x2v){a270[2], a270[3]} * T19;
        const f32x4 a275 = *(const LAS f32x4*)(Af + 1380);
        r2[24] -= (f32x2v){a271[0], a271[1]} * T19; r2[25] -= (f32x2v){a271[2], a271[3]} * T19;
        const f32x4 a276 = *(const LAS f32x4*)(Af + 1384);
        r2[26] -= (f32x2v){a272[0], a272[1]} * T19; r2[27] -= (f32x2v){a272[2], a272[3]} * T19;
        const f32x4 a277 = *(const LAS f32x4*)(Af + 1388);
        r2[28] -= (f32x2v){a273[0], a273[1]} * T19; r2[29] -= (f32x2v){a273[2], a273[3]} * T19;
        const f32x4 a278 = *(const LAS f32x4*)(Af + 1392);
        r2[30] -= (f32x2v){a274[0], a274[1]} * T19; r2[31] -= (f32x2v){a274[2], a274[3]} * T19;
        const f32x4 a279 = *(const LAS f32x4*)(Af + 1396);
        const float t20 = r2[10][0]; const f32x2v T20 = (f32x2v){t20, t20}; Tb[1440 + lane] = f2bf(t20);
        r2[10] -= (f32x2v){a275[0], a275[1]} * T20; r2[11] -= (f32x2v){a275[2], a275[3]} * T20;
        const f32x4 a280 = *(const LAS f32x4*)(Af + 1400);
        r2[12] -= (f32x2v){a276[0], a276[1]} * T20; r2[13] -= (f32x2v){a276[2], a276[3]} * T20;
        const f32x4 a281 = *(const LAS f32x4*)(Af + 1404);
        r2[14] -= (f32x2v){a277[0], a277[1]} * T20; r2[15] -= (f32x2v){a277[2], a277[3]} * T20;
        const f32x4 a282 = *(const LAS f32x4*)(Af + 1408);
        r2[16] -= (f32x2v){a278[0], a278[1]} * T20; r2[17] -= (f32x2v){a278[2], a278[3]} * T20;
        const f32x4 a283 = *(const LAS f32x4*)(Af + 1412);
        r2[18] -= (f32x2v){a279[0], a279[1]} * T20; r2[19] -= (f32x2v){a279[2], a279[3]} * T20;
        const f32x4 a284 = *(const LAS f32x4*)(Af + 1416);
        r2[20] -= (f32x2v){a280[0], a280[1]} * T20; r2[21] -= (f32x2v){a280[2], a280[3]} * T20;
        const f32x4 a285 = *(const LAS f32x4*)(Af + 1420);
        r2[22] -= (f32x2v){a281[0], a281[1]} * T20; r2[23] -= (f32x2v){a281[2], a281[3]} * T20;
        const f32x4 a286 = *(const LAS f32x4*)(Af + 1448);
        r2[24] -= (f32x2v){a282[0], a282[1]} * T20; r2[25] -= (f32x2v){a282[2], a282[3]} * T20;
        const f32x4 a287 = *(const LAS f32x4*)(Af + 1452);
        r2[26] -= (f32x2v){a283[0], a283[1]} * T20; r2[27] -= (f32x2v){a283[2], a283[3]} * T20;
        const f32x4 a288 = *(const LAS f32x4*)(Af + 1456);
        r2[28] -= (f32x2v){a284[0], a284[1]} * T20; r2[29] -= (f32x2v){a284[2], a284[3]} * T20;
        const f32x4 a289 = *(const LAS f32x4*)(Af + 1460);
        r2[30] -= (f32x2v){a285[0], a285[1]} * T20; r2[31] -= (f32x2v){a285[2], a285[3]} * T20;
        const f32x4 a290 = *(const LAS f32x4*)(Af + 1464);
        const float t21 = r2[10][1]; const f32x2v T21 = (f32x2v){t21, t21}; Tb[1512 + lane] = f2bf(t21);
        r2[11] -= (f32x2v){a286[2], a286[3]} * T21;
        const f32x4 a291 = *(const LAS f32x4*)(Af + 1468);
        r2[12] -= (f32x2v){a287[0], a287[1]} * T21; r2[13] -= (f32x2v){a287[2], a287[3]} * T21;
        const f32x4 a292 = *(const LAS f32x4*)(Af + 1472);
        r2[14] -= (f32x2v){a288[0], a288[1]} * T21; r2[15] -= (f32x2v){a288[2], a288[3]} * T21;
        const f32x4 a293 = *(const LAS f32x4*)(Af + 1476);
        r2[16] -= (f32x2v){a289[0], a289[1]} * T21; r2[17] -= (f32x2v){a289[2], a289[3]} * T21;
        const f32x4 a294 = *(const LAS f32x4*)(Af + 1480);
        r2[18] -= (f32x2v){a290[0], a290[1]} * T21; r2[19] -= (f32x2v){a290[2], a290[3]} * T21;
        const f32x4 a295 = *(const LAS f32x4*)(Af + 1484);
        r2[20] -= (f32x2v){a291[0], a291[1]} * T21; r2[21] -= (f32x2v){a291[2], a291[3]} * T21;
        const f32x4 a296 = *(const LAS f32x4*)(Af + 1488);
        r2[22] -= (f32x2v){a292[0], a292[1]} * T21; r2[23] -= (f32x2v){a292[2], a292[3]} * T21;
        const f32x4 a297 = *(const LAS f32x4*)(Af + 1516);
        r2[24] -= (f32x2v){a293[0], a293[1]} * T21; r2[25] -= (f32x2v){a293[2], a293[3]} * T21;
        const f32x4 a298 = *(const LAS f32x4*)(Af + 1520);
        r2[26] -= (f32x2v){a294[0], a294[1]} * T21; r2[27] -= (f32x2v){a294[2], a294[3]} * T21;
        const f32x4 a299 = *(const LAS f32x4*)(Af + 1524);
        r2[28] -= (f32x2v){a295[0], a295[1]} * T21; r2[29] -= (f32x2v){a295[2], a295[3]} * T21;
        const f32x4 a300 = *(const LAS f32x4*)(Af + 1528);
        r2[30] -= (f32x2v){a296[0], a296[1]} * T21; r2[31] -= (f32x2v){a296[2], a296[3]} * T21;
        const f32x4 a301 = *(const LAS f32x4*)(Af + 1532);
        const float t22 = r2[11][0]; const f32x2v T22 = (f32x2v){t22, t22}; Tb[1584 + lane] = f2bf(t22);
        r2[11] -= (f32x2v){a297[2], a297[3]} * T22;
        const f32x4 a302 = *(const LAS f32x4*)(Af + 1536);
        r2[12] -= (f32x2v){a298[0], a298[1]} * T22; r2[13] -= (f32x2v){a298[2], a298[3]} * T22;
        const f32x4 a303 = *(const LAS f32x4*)(Af + 1540);
        r2[14] -= (f32x2v){a299[0], a299[1]} * T22; r2[15] -= (f32x2v){a299[2], a299[3]} * T22;
        const f32x4 a304 = *(const LAS f32x4*)(Af + 1544);
        r2[16] -= (f32x2v){a300[0], a300[1]} * T22; r2[17] -= (f32x2v){a300[2], a300[3]} * T22;
        const f32x4 a305 = *(const LAS f32x4*)(Af + 1548);
        r2[18] -= (f32x2v){a301[0], a301[1]} * T22; r2[19] -= (f32x2v){a301[2], a301[3]} * T22;
        const f32x4 a306 = *(const LAS f32x4*)(Af + 1552);
        r2[20] -= (f32x2v){a302[0], a302[1]} * T22; r2[21] -= (f32x2v){a302[2], a302[3]} * T22;
        const f32x4 a307 = *(const LAS f32x4*)(Af + 1556);
        r2[22] -= (f32x2v){a303[0], a303[1]} * T22; r2[23] -= (f32x2v){a303[2], a303[3]} * T22;
        const f32x4 a308 = *(const LAS f32x4*)(Af + 1588);
        r2[24] -= (f32x2v){a304[0], a304[1]} * T22; r2[25] -= (f32x2v){a304[2], a304[3]} * T22;
        const f32x4 a309 = *(const LAS f32x4*)(Af + 1592);
        r2[26] -= (f32x2v){a305[0], a305[1]} * T22; r2[27] -= (f32x2v){a305[2], a305[3]} * T22;
        const f32x4 a310 = *(const LAS f32x4*)(Af + 1596);
        r2[28] -= (f32x2v){a306[0], a306[1]} * T22; r2[29] -= (f32x2v){a306[2], a306[3]} * T22;
        const f32x4 a311 = *(const LAS f32x4*)(Af + 1600);
        r2[30] -= (f32x2v){a307[0], a307[1]} * T22; r2[31] -= (f32x2v){a307[2], a307[3]} * T22;
        const f32x4 a312 = *(const LAS f32x4*)(Af + 1604);
        const float t23 = r2[11][1]; const f32x2v T23 = (f32x2v){t23, t23}; Tb[1656 + lane] = f2bf(t23);
        r2[12] -= (f32x2v){a308[0], a308[1]} * T23; r2[13] -= (f32x2v){a308[2], a308[3]} * T23;
        const f32x4 a313 = *(const LAS f32x4*)(Af + 1608);
        r2[14] -= (f32x2v){a309[0], a309[1]} * T23; r2[15] -= (f32x2v){a309[2], a309[3]} * T23;
        const f32x4 a314 = *(const LAS f32x4*)(Af + 1612);
        r2[16] -= (f32x2v){a310[0], a310[1]} * T23; r2[17] -= (f32x2v){a310[2], a310[3]} * T23;
        const f32x4 a315 = *(const LAS f32x4*)(Af + 1616);
        r2[18] -= (f32x2v){a311[0], a311[1]} * T23; r2[19] -= (f32x2v){a311[2], a311[3]} * T23;
        const f32x4 a316 = *(const LAS f32x4*)(Af + 1620);
        r2[20] -= (f32x2v){a312[0], a312[1]} * T23; r2[21] -= (f32x2v){a312[2], a312[3]} * T23;
        const f32x4 a317 = *(const LAS f32x4*)(Af + 1624);
        r2[22] -= (f32x2v){a313[0], a313[1]} * T23; r2[23] -= (f32x2v){a313[2], a313[3]} * T23;
        const f32x4 a318 = *(const LAS f32x4*)(Af + 1656);
        r2[24] -= (f32x2v){a314[0], a314[1]} * T23; r2[25] -= (f32x2v){a314[2], a314[3]} * T23;
        const f32x4 a319 = *(const LAS f32x4*)(Af + 1660);
        r2[26] -= (f32x2v){a315[0], a315[1]} * T23; r2[27] -= (f32x2v){a315[2], a315[3]} * T23;
        const f32x4 a320 = *(const LAS f32x4*)(Af + 1664);
        r2[28] -= (f32x2v){a316[0], a316[1]} * T23; r2[29] -= (f32x2v){a316[2], a316[3]} * T23;
        const f32x4 a321 = *(const LAS f32x4*)(Af + 1668);
        r2[30] -= (f32x2v){a317[0], a317[1]} * T23; r2[31] -= (f32x2v){a317[2], a317[3]} * T23;
        const f32x4 a322 = *(const LAS f32x4*)(Af + 1672);
        const float t24 = r2[12][0]; const f32x2v T24 = (f32x2v){t24, t24}; Tb[1728 + lane] = f2bf(t24);
        r2[12] -= (f32x2v){a318[0], a318[1]} * T24; r2[13] -= (f32x2v){a318[2], a318[3]} * T24;
        const f32x4 a323 = *(const LAS f32x4*)(Af + 1676);
        r2[14] -= (f32x2v){a319[0], a319[1]} * T24; r2[15] -= (f32x2v){a319[2], a319[3]} * T24;
        const f32x4 a324 = *(const LAS f32x4*)(Af + 1680);
        r2[16] -= (f32x2v){a320[0], a320[1]} * T24; r2[17] -= (f32x2v){a320[2], a320[3]} * T24;
        const f32x4 a325 = *(const LAS f32x4*)(Af + 1684);
        r2[18] -= (f32x2v){a321[0], a321[1]} * T24; r2[19] -= (f32x2v){a321[2], a321[3]} * T24;
        const f32x4 a326 = *(const LAS f32x4*)(Af + 1688);
        r2[20] -= (f32x2v){a322[0], a322[1]} * T24; r2[21] -= (f32x2v){a322[2], a322[3]} * T24;
        const f32x4 a327 = *(const LAS f32x4*)(Af + 1692);
        r2[22] -= (f32x2v){a323[0], a323[1]} * T24; r2[23] -= (f32x2v){a323[2], a323[3]} * T24;
        const f32x4 a328 = *(const LAS f32x4*)(Af + 1724);
        r2[24] -= (f32x2v){a324[0], a324[1]} * T24; r2[25] -= (f32x2v){a324[2], a324[3]} * T24;
        const f32x4 a329 = *(const LAS f32x4*)(Af + 1728);
        r2[26] -= (f32x2v){a325[0], a325[1]} * T24; r2[27] -= (f32x2v){a325[2], a325[3]} * T24;
        const f32x4 a330 = *(const LAS f32x4*)(Af + 1732);
        r2[28] -= (f32x2v){a326[0], a326[1]} * T24; r2[29] -= (f32x2v){a326[2], a326[3]} * T24;
        const f32x4 a331 = *(const LAS f32x4*)(Af + 1736);
        r2[30] -= (f32x2v){a327[0], a327[1]} * T24; r2[31] -= (f32x2v){a327[2], a327[3]} * T24;
        const f32x4 a332 = *(const LAS f32x4*)(Af + 1740);
        const float t25 = r2[12][1]; const f32x2v T25 = (f32x2v){t25, t25}; Tb[1800 + lane] = f2bf(t25);
        r2[13] -= (f32x2v){a328[2], a328[3]} * T25;
        const f32x4 a333 = *(const LAS f32x4*)(Af + 1744);
        r2[14] -= (f32x2v){a329[0], a329[1]} * T25; r2[15] -= (f32x2v){a329[2], a329[3]} * T25;
        const f32x4 a334 = *(const LAS f32x4*)(Af + 1748);
        r2[16] -= (f32x2v){a330[0], a330[1]} * T25; r2[17] -= (f32x2v){a330[2], a330[3]} * T25;
        const f32x4 a335 = *(const LAS f32x4*)(Af + 1752);
        r2[18] -= (f32x2v){a331[0], a331[1]} * T25; r2[19] -= (f32x2v){a331[2], a331[3]} * T25;
        const f32x4 a336 = *(const LAS f32x4*)(Af + 1756);
        r2[20] -= (f32x2v){a332[0], a332[1]} * T25; r2[21] -= (f32x2v){a332[2], a332[3]} * T25;
        const f32x4 a337 = *(const LAS f32x4*)(Af + 1760);
        r2[22] -= (f32x2v){a333[0], a333[1]} * T25; r2[23] -= (f32x2v){a333[2], a333[3]} * T25;
        const f32x4 a338 = *(const LAS f32x4*)(Af + 1792);
        r2[24] -= (f32x2v){a334[0], a334[1]} * T25; r2[25] -= (f32x2v){a334[2], a334[3]} * T25;
        const f32x4 a339 = *(const LAS f32x4*)(Af + 1796);
        r2[26] -= (f32x2v){a335[0], a335[1]} * T25; r2[27] -= (f32x2v){a335[2], a335[3]} * T25;
        const f32x4 a340 = *(const LAS f32x4*)(Af + 1800);
        r2[28] -= (f32x2v){a336[0], a336[1]} * T25; r2[29] -= (f32x2v){a336[2], a336[3]} * T25;
        const f32x4 a341 = *(const LAS f32x4*)(Af + 1804);
        r2[30] -= (f32x2v){a337[0], a337[1]} * T25; r2[31] -= (f32x2v){a337[2], a337[3]} * T25;
        const f32x4 a342 = *(const LAS f32x4*)(Af + 1808);
        const float t26 = r2[13][0]; const f32x2v T26 = (f32x2v){t26, t26}; Tb[1872 + lane] = f2bf(t26);
        r2[13] -= (f32x2v){a338[2], a338[3]} * T26;
        const f32x4 a343 = *(const LAS f32x4*)(Af + 1812);
        r2[14] -= (f32x2v){a339[0], a339[1]} * T26; r2[15] -= (f32x2v){a339[2], a339[3]} * T26;
        const f32x4 a344 = *(const LAS f32x4*)(Af + 1816);
        r2[16] -= (f32x2v){a340[0], a340[1]} * T26; r2[17] -= (f32x2v){a340[2], a340[3]} * T26;
        const f32x4 a345 = *(const LAS f32x4*)(Af + 1820);
        r2[18] -= (f32x2v){a341[0], a341[1]} * T26; r2[19] -= (f32x2v){a341[2], a341[3]} * T26;
        const f32x4 a346 = *(const LAS f32x4*)(Af + 1824);
        r2[20] -= (f32x2v){a342[0], a342[1]} * T26; r2[21] -= (f32x2v){a342[2], a342[3]} * T26;
        const f32x4 a347 = *(const LAS f32x4*)(Af + 1828);
        r2[22] -= (f32x2v){a343[0], a343[1]} * T26; r2[23] -= (f32x2v){a343[2], a343[3]} * T26;
        const f32x4 a348 = *(const LAS f32x4*)(Af + 1864);
        r2[24] -= (f32x2v){a344[0], a344[1]} * T26; r2[25] -= (f32x2v){a344[2], a344[3]} * T26;
        const f32x4 a349 = *(const LAS f32x4*)(Af + 1868);
        r2[26] -= (f32x2v){a345[0], a345[1]} * T26; r2[27] -= (f32x2v){a345[2], a345[3]} * T26;
        const f32x4 a350 = *(const LAS f32x4*)(Af + 1872);
        r2[28] -= (f32x2v){a346[0], a346[1]} * T26; r2[29] -= (f32x2v){a346[2], a346[3]} * T26;
        const f32x4 a351 = *(const LAS f32x4*)(Af + 1876);
        r2[30] -= (f32x2v){a347[0], a347[1]} * T26; r2[31] -= (f32x2v){a347[2], a347[3]} * T26;
        const f32x4 a352 = *(const LAS f32x4*)(Af + 1880);
        const float t27 = r2[13][1]; const f32x2v T27 = (f32x2v){t27, t27}; Tb[1944 + lane] = f2bf(t27);
        r2[14] -= (f32x2v){a348[0], a348[1]} * T27; r2[15] -= (f32x2v){a348[2], a348[3]} * T27;
        const f32x4 a353 = *(const LAS f32x4*)(Af + 1884);
        r2[16] -= (f32x2v){a349[0], a349[1]} * T27; r2[17] -= (f32x2v){a349[2], a349[3]} * T27;
        const f32x4 a354 = *(const LAS f32x4*)(Af + 1888);
        r2[18] -= (f32x2v){a350[0], a350[1]} * T27; r2[19] -= (f32x2v){a350[2], a350[3]} * T27;
        const f32x4 a355 = *(const LAS f32x4*)(Af + 1892);
        r2[20] -= (f32x2v){a351[0], a351[1]} * T27; r2[21] -= (f32x2v){a351[2], a351[3]} * T27;
        const f32x4 a356 = *(const LAS f32x4*)(Af + 1896);
        r2[22] -= (f32x2v){a352[0], a352[1]} * T27; r2[23] -= (f32x2v){a352[2], a352[3]} * T27;
        const f32x4 a357 = *(const LAS f32x4*)(Af + 1932);
        r2[24] -= (f32x2v){a353[0], a353[1]} * T27; r2[25] -= (f32x2v){a353[2], a353[3]} * T27;
        const f32x4 a358 = *(const LAS f32x4*)(Af + 1936);
        r2[26] -= (f32x2v){a354[0], a354[1]} * T27; r2[27] -= (f32x2v){a354[2], a354[3]} * T27;
        const f32x4 a359 = *(const LAS f32x4*)(Af + 1940);
        r2[28] -= (f32x2v){a355[0], a355[1]} * T27; r2[29] -= (f32x2v){a355[2], a355[3]} * T27;
        const f32x4 a360 = *(const LAS f32x4*)(Af + 1944);
        r2[30] -= (f32x2v){a356[0], a356[1]} * T27; r2[31] -= (f32x2v){a356[2], a356[3]} * T27;
        const f32x4 a361 = *(const LAS f32x4*)(Af + 1948);
        const float t28 = r2[14][0]; const f32x2v T28 = (f32x2v){t28, t28}; Tb[2016 + lane] = f2bf(t28);
        r2[14] -= (f32x2v){a357[0], a357[1]} * T28; r2[15] -= (f32x2v){a357[2], a357[3]} * T28;
        const f32x4 a362 = *(const LAS f32x4*)(Af + 1952);
        r2[16] -= (f32x2v){a358[0], a358[1]} * T28; r2[17] -= (f32x2v){a358[2], a358[3]} * T28;
        const f32x4 a363 = *(const LAS f32x4*)(Af + 1956);
        r2[18] -= (f32x2v){a359[0], a359[1]} * T28; r2[19] -= (f32x2v){a359[2], a359[3]} * T28;
        const f32x4 a364 = *(const LAS f32x4*)(Af + 1960);
        r2[20] -= (f32x2v){a360[0], a360[1]} * T28; r2[21] -= (f32x2v){a360[2], a360[3]} * T28;
        const f32x4 a365 = *(const LAS f32x4*)(Af + 1964);
        r2[22] -= (f32x2v){a361[0], a361[1]} * T28; r2[23] -= (f32x2v){a361[2], a361[3]} * T28;
        const f32x4 a366 = *(const LAS f32x4*)(Af + 2000);
        r2[24] -= (f32x2v){a362[0], a362[1]} * T28; r2[25] -= (f32x2v){a362[2], a362[3]} * T28;
        const f32x4 a367 = *(const LAS f32x4*)(Af + 2004);
        r2[26] -= (f32x2v){a363[0], a363[1]} * T28; r2[27] -= (f32x2v){a363[2], a363[3]} * T28;
        const f32x4 a368 = *(const LAS f32x4*)(Af + 2008);
        r2[28] -= (f32x2v){a364[0], a364[1]} * T28; r2[29] -= (f32x2v){a364[2], a364[3]} * T28;
        const f32x4 a369 = *(const LAS f32x4*)(Af + 2012);
        r2[30] -= (f32x2v){a365[0], a365[1]} * T28; r2[31] -= (f32x2v){a365[2], a365[3]} * T28;
        const f32x4 a370 = *(const LAS f32x4*)(Af + 2016);
        const float t29 = r2[14][1]; const f32x2v T29 = (f32x2v){t29, t29}; Tb[2088 + lane] = f2bf(t29);
        r2[15] -= (f32x2v){a366[2], a366[3]} * T29;
        const f32x4 a371 = *(const LAS f32x4*)(Af + 2020);
        r2[16] -= (f32x2v){a367[0], a367[1]} * T29; r2[17] -= (f32x2v){a367[2], a367[3]} * T29;
        const f32x4 a372 = *(const LAS f32x4*)(Af + 2024);
        r2[18] -= (f32x2v){a368[0], a368[1]} * T29; r2[19] -= (f32x2v){a368[2], a368[3]} * T29;
        const f32x4 a373 = *(const LAS f32x4*)(Af + 2028);
        r2[20] -= (f32x2v){a369[0], a369[1]} * T29; r2[21] -= (f32x2v){a369[2], a369[3]} * T29;
        const f32x4 a374 = *(const LAS f32x4*)(Af + 2032);
        r2[22] -= (f32x2v){a370[0], a370[1]} * T29; r2[23] -= (f32x2v){a370[2], a370[3]} * T29;
        const f32x4 a375 = *(const LAS f32x4*)(Af + 2068);
        r2[24] -= (f32x2v){a371[0], a371[1]} * T29; r2[25] -= (f32x2v){a371[2], a371[3]} * T29;
        const f32x4 a376 = *(const LAS f32x4*)(Af + 2072);
        r2[26] -= (f32x2v){a372[0], a372[1]} * T29; r2[27] -= (f32x2v){a372[2], a372[3]} * T29;
        const f32x4 a377 = *(const LAS f32x4*)(Af + 2076);
        r2[28] -= (f32x2v){a373[0], a373[1]} * T29; r2[29] -= (f32x2v){a373[2], a373[3]} * T29;
        const f32x4 a378 = *(const LAS f32x4*)(Af + 2080);
        r2[30] -= (f32x2v){a374[0], a374[1]} * T29; r2[31] -= (f32x2v){a374[2], a374[3]} * T29;
        const f32x4 a379 = *(const LAS f32x4*)(Af + 2084);
        const float t30 = r2[15][0]; const f32x2v T30 = (f32x2v){t30, t30}; Tb[2160 + lane] = f2bf(t30);
        r2[15] -= (f32x2v){a375[2], a375[3]} * T30;
        const f32x4 a380 = *(const LAS f32x4*)(Af + 2088);
        r2[16] -= (f32x2v){a376[0], a376[1]} * T30; r2[17] -= (f32x2v){a376[2], a376[3]} * T30;
        const f32x4 a381 = *(const LAS f32x4*)(Af + 2092);
        r2[18] -= (f32x2v){a377[0], a377[1]} * T30; r2[19] -= (f32x2v){a377[2], a377[3]} * T30;
        const f32x4 a382 = *(const LAS f32x4*)(Af + 2096);
        r2[20] -= (f32x2v){a378[0], a378[1]} * T30; r2[21] -= (f32x2v){a378[2], a378[3]} * T30;
        const f32x4 a383 = *(const LAS f32x4*)(Af + 2100);
        r2[22] -= (f32x2v){a379[0], a379[1]} * T30; r2[23] -= (f32x2v){a379[2], a379[3]} * T30;
        const f32x4 a384 = *(const LAS f32x4*)(Af + 2140);
        r2[24] -= (f32x2v){a380[0], a380[1]} * T30; r2[25] -= (f32x2v){a380[2], a380[3]} * T30;
        const f32x4 a385 = *(const LAS f32x4*)(Af + 2144);
        r2[26] -= (f32x2v){a381[0], a381[1]} * T30; r2[27] -= (f32x2v){a381[2], a381[3]} * T30;
        const f32x4 a386 = *(const LAS f32x4*)(Af + 2148);
        r2[28] -= (f32x2v){a382[0], a382[1]} * T30; r2[29] -= (f32x2v){a382[2], a382[3]} * T30;
        const f32x4 a387 = *(const LAS f32x4*)(Af + 2152);
        r2[30] -= (f32x2v){a383[0], a383[1]} * T30; r2[31] -= (f32x2v){a383[2], a383[3]} * T30;
        const f32x4 a388 = *(const LAS f32x4*)(Af + 2156);
        const float t31 = r2[15][1]; const f32x2v T31 = (f32x2v){t31, t31}; Tb[2232 + lane] = f2bf(t31);
        r2[16] -= (f32x2v){a384[0], a384[1]} * T31; r2[17] -= (f32x2v){a384[2], a384[3]} * T31;
        const f32x4 a389 = *(const LAS f32x4*)(Af + 2160);
        r2[18] -= (f32x2v){a385[0], a385[1]} * T31; r2[19] -= (f32x2v){a385[2], a385[3]} * T31;
        const f32x4 a390 = *(const LAS f32x4*)(Af + 2164);
        r2[20] -= (f32x2v){a386[0], a386[1]} * T31; r2[21] -= (f32x2v){a386[2], a386[3]} * T31;
        const f32x4 a391 = *(const LAS f32x4*)(Af + 2168);
        r2[22] -= (f32x2v){a387[0], a387[1]} * T31; r2[23] -= (f32x2v){a387[2], a387[3]} * T31;
        const f32x4 a392 = *(const LAS f32x4*)(Af + 2208);
        r2[24] -= (f32x2v){a388[0], a388[1]} * T31; r2[25] -= (f32x2v){a388[2], a388[3]} * T31;
        const f32x4 a393 = *(const LAS f32x4*)(Af + 2212);
        r2[26] -= (f32x2v){a389[0], a389[1]} * T31; r2[27] -= (f32x2v){a389[2], a389[3]} * T31;
        const f32x4 a394 = *(const LAS f32x4*)(Af + 2216);
        r2[28] -= (f32x2v){a390[0], a390[1]} * T31; r2[29] -= (f32x2v){a390[2], a390[3]} * T31;
        const f32x4 a395 = *(const LAS f32x4*)(Af + 2220);
        r2[30] -= (f32x2v){a391[0], a391[1]} * T31; r2[31] -= (f32x2v){a391[2], a391[3]} * T31;
        const f32x4 a396 = *(const LAS f32x4*)(Af + 2224);
        const float t32 = r2[16][0]; const f32x2v T32 = (f32x2v){t32, t32}; Tb[2304 + lane] = f2bf(t32);
        r2[16] -= (f32x2v){a392[0], a392[1]} * T32; r2[17] -= (f32x2v){a392[2], a392[3]} * T32;
        const f32x4 a397 = *(const LAS f32x4*)(Af + 2228);
        r2[18] -= (f32x2v){a393[0], a393[1]} * T32; r2[19] -= (f32x2v){a393[2], a393[3]} * T32;
        const f32x4 a398 = *(const LAS f32x4*)(Af + 2232);
        r2[20] -= (f32x2v){a394[0], a394[1]} * T32; r2[21] -= (f32x2v){a394[2], a394[3]} * T32;
        const f32x4 a399 = *(const LAS f32x4*)(Af + 2236);
        r2[22] -= (f32x2v){a395[0], a395[1]} * T32; r2[23] -= (f32x2v){a395[2], a395[3]} * T32;
        const f32x4 a400 = *(const LAS f32x4*)(Af + 2276);
        r2[24] -= (f32x2v){a396[0], a396[1]} * T32; r2[25] -= (f32x2v){a396[2], a396[3]} * T32;
        const f32x4 a401 = *(const LAS f32x4*)(Af + 2280);
        r2[26] -= (f32x2v){a397[0], a397[1]} * T32; r2[27] -= (f32x2v){a397[2], a397[3]} * T32;
        const f32x4 a402 = *(const LAS f32x4*)(Af + 2284);
        r2[28] -= (f32x2v){a398[0], a398[1]} * T32; r2[29] -= (f32x2v){a398[2], a398[3]} * T32;
        const f32x4 a403 = *(const LAS f32x4*)(Af + 2288);
        r2[30] -= (f32x2v){a399[0], a399[1]} * T32; r2[31] -= (f32x2v){a399[2], a399[3]} * T32;
        const f32x4 a404 = *(const LAS f32x4*)(Af + 2292);
        const float t33 = r2[16][1]; const f32x2v T33 = (f32x2v){t33, t33}; Tb[2376 + lane] = f2bf(t33);
        r2[17] -= (f32x2v){a400[2], a400[3]} * T33;
        const f32x4 a405 = *(const LAS f32x4*)(Af + 2296);
        r2[18] -= (f32x2v){a401[0], a401[1]} * T33; r2[19] -= (f32x2v){a401[2], a401[3]} * T33;
        const f32x4 a406 = *(const LAS f32x4*)(Af + 2300);
        r2[20] -= (f32x2v){a402[0], a402[1]} * T33; r2[21] -= (f32x2v){a402[2], a402[3]} * T33;
        const f32x4 a407 = *(const LAS f32x4*)(Af + 2304);
        r2[22] -= (f32x2v){a403[0], a403[1]} * T33; r2[23] -= (f32x2v){a403[2], a403[3]} * T33;
        const f32x4 a408 = *(const LAS f32x4*)(Af + 2344);
        r2[24] -= (f32x2v){a404[0], a404[1]} * T33; r2[25] -= (f32x2v){a404[2], a404[3]} * T33;
        const f32x4 a409 = *(const LAS f32x4*)(Af + 2348);
        r2[26] -= (f32x2v){a405[0], a405[1]} * T33; r2[27] -= (f32x2v){a405[2], a405[3]} * T33;
        const f32x4 a410 = *(const LAS f32x4*)(Af + 2352);
        r2[28] -= (f32x2v){a406[0], a406[1]} * T33; r2[29] -= (f32x2v){a406[2], a406[3]} * T33;
        const f32x4 a411 = *(const LAS f32x4*)(Af + 2356);
        r2[30] -= (f32x2v){a407[0], a407[1]} * T33; r2[31] -= (f32x2v){a407[2], a407[3]} * T33;
        const f32x4 a412 = *(const LAS f32x4*)(Af + 2360);
        const float t34 = r2[17][0]; const f32x2v T34 = (f32x2v){t34, t34}; Tb[2448 + lane] = f2bf(t34);
        r2[17] -= (f32x2v){a408[2], a408[3]} * T34;
        const f32x4 a413 = *(const LAS f32x4*)(Af + 2364);
        r2[18] -= (f32x2v){a409[0], a409[1]} * T34; r2[19] -= (f32x2v){a409[2], a409[3]} * T34;
        const f32x4 a414 = *(const LAS f32x4*)(Af + 2368);
        r2[20] -= (f32x2v){a410[0], a410[1]} * T34; r2[21] -= (f32x2v){a410[2], a410[3]} * T34;
        const f32x4 a415 = *(const LAS f32x4*)(Af + 2372);
        r2[22] -= (f32x2v){a411[0], a411[1]} * T34; r2[23] -= (f32x2v){a411[2], a411[3]} * T34;
        const f32x4 a416 = *(const LAS f32x4*)(Af + 2416);
        r2[24] -= (f32x2v){a412[0], a412[1]} * T34; r2[25] -= (f32x2v){a412[2], a412[3]} * T34;
        const f32x4 a417 = *(const LAS f32x4*)(Af + 2420);
        r2[26] -= (f32x2v){a413[0], a413[1]} * T34; r2[27] -= (f32x2v){a413[2], a413[3]} * T34;
        const f32x4 a418 = *(const LAS f32x4*)(Af + 2424);
        r2[28] -= (f32x2v){a414[0], a414[1]} * T34; r2[29] -= (f32x2v){a414[2], a414[3]} * T34;
        const f32x4 a419 = *(const LAS f32x4*)(Af + 2428);
        r2[30] -= (f32x2v){a415[0], a415[1]} * T34; r2[31] -= (f32x2v){a415[2], a415[3]} * T34;
        const f32x4 a420 = *(const LAS f32x4*)(Af + 2432);
        const float t35 = r2[17][1]; const f32x2v T35 = (f32x2v){t35, t35}; Tb[2520 + lane] = f2bf(t35);
        r2[18] -= (f32x2v){a416[0], a416[1]} * T35; r2[19] -= (f32x2v){a416[2], a416[3]} * T35;
        const f32x4 a421 = *(const LAS f32x4*)(Af + 2436);
        r2[20] -= (f32x2v){a417[0], a417[1]} * T35; r2[21] -= (f32x2v){a417[2], a417[3]} * T35;
        const f32x4 a422 = *(const LAS f32x4*)(Af + 2440);
        r2[22] -= (f32x2v){a418[0], a418[1]} * T35; r2[23] -= (f32x2v){a418[2], a418[3]} * T35;
        const f32x4 a423 = *(const LAS f32x4*)(Af + 2484);
        r2[24] -= (f32x2v){a419[0], a419[1]} * T35; r2[25] -= (f32x2v){a419[2], a419[3]} * T35;
        const f32x4 a424 = *(const LAS f32x4*)(Af + 2488);
        r2[26] -= (f32x2v){a420[0], a420[1]} * T35; r2[27] -= (f32x2v){a420[2], a420[3]} * T35;
        const f32x4 a425 = *(const LAS f32x4*)(Af + 2492);
        r2[28] -= (f32x2v){a421[0], a421[1]} * T35; r2[29] -= (f32x2v){a421[2], a421[3]} * T35;
        const f32x4 a426 = *(const LAS f32x4*)(Af + 2496);
        r2[30] -= (f32x2v){a422[0], a422[1]} * T35; r2[31] -= (f32x2v){a422[2], a422[3]} * T35;
        const f32x4 a427 = *(const LAS f32x4*)(Af + 2500);
        const float t36 = r2[18][0]; const f32x2v T36 = (f32x2v){t36, t36}; Tb[2592 + lane] = f2bf(t36);
        r2[18] -= (f32x2v){a423[0], a423[1]} * T36; r2[19] -= (f32x2v){a423[2], a423[3]} * T36;
        const f32x4 a428 = *(const LAS f32x4*)(Af + 2504);
        r2[20] -= (f32x2v){a424[0], a424[1]} * T36; r2[21] -= (f32x2v){a424[2], a424[3]} * T36;
        const f32x4 a429 = *(const LAS f32x4*)(Af + 2508);
        r2[22] -= (f32x2v){a425[0], a425[1]} * T36; r2[23] -= (f32x2v){a425[2], a425[3]} * T36;
        const f32x4 a430 = *(const LAS f32x4*)(Af + 2552);
        r2[24] -= (f32x2v){a426[0], a426[1]} * T36; r2[25] -= (f32x2v){a426[2], a426[3]} * T36;
        const f32x4 a431 = *(const LAS f32x4*)(Af + 2556);
        r2[26] -= (f32x2v){a427[0], a427[1]} * T36; r2[27] -= (f32x2v){a427[2], a427[3]} * T36;
        const f32x4 a432 = *(const LAS f32x4*)(Af + 2560);
        r2[28] -= (f32x2v){a428[0], a428[1]} * T36; r2[29] -= (f32x2v){a428[2], a428[3]} * T36;
        const f32x4 a433 = *(const LAS f32x4*)(Af + 2564);
        r2[30] -= (f32x2v){a429[0], a429[1]} * T36; r2[31] -= (f32x2v){a429[2], a429[3]} * T36;
        const f32x4 a434 = *(const LAS f32x4*)(Af + 2568);
        const float t37 = r2[18][1]; const f32x2v T37 = (f32x2v){t37, t37}; Tb[2664 + lane] = f2bf(t37);
        r2[19] -= (f32x2v){a430[2], a430[3]} * T37;
        const f32x4 a435 = *(const LAS f32x4*)(Af + 2572);
        r2[20] -= (f32x2v){a431[0], a431[1]} * T37; r2[21] -= (f32x2v){a431[2], a431[3]} * T37;
        const f32x4 a436 = *(const LAS f32x4*)(Af + 2576);
        r2[22] -= (f32x2v){a432[0], a432[1]} * T37; r2[23] -= (f32x2v){a432[2], a432[3]} * T37;
        const f32x4 a437 = *(const LAS f32x4*)(Af + 2620);
        r2[24] -= (f32x2v){a433[0], a433[1]} * T37; r2[25] -= (f32x2v){a433[2], a433[3]} * T37;
        const f32x4 a438 = *(const LAS f32x4*)(Af + 2624);
        r2[26] -= (f32x2v){a434[0], a434[1]} * T37; r2[27] -= (f32x2v){a434[2], a434[3]} * T37;
        const f32x4 a439 = *(const LAS f32x4*)(Af + 2628);
        r2[28] -= (f32x2v){a435[0], a435[1]} * T37; r2[29] -= (f32x2v){a435[2], a435[3]} * T37;
        const f32x4 a440 = *(const LAS f32x4*)(Af + 2632);
        r2[30] -= (f32x2v){a436[0], a436[1]} * T37; r2[31] -= (f32x2v){a436[2], a436[3]} * T37;
        const f32x4 a441 = *(const LAS f32x4*)(Af + 2636);
        const float t38 = r2[19][0]; const f32x2v T38 = (f32x2v){t38, t38}; Tb[2736 + lane] = f2bf(t38);
        r2[19] -= (f32x2v){a437[2], a437[3]} * T38;
        const f32x4 a442 = *(const LAS f32x4*)(Af + 2640);
        r2[20] -= (f32x2v){a438[0], a438[1]} * T38; r2[21] -= (f32x2v){a438[2], a438[3]} * T38;
        const f32x4 a443 = *(const LAS f32x4*)(Af + 2644);
        r2[22] -= (f32x2v){a439[0], a439[1]} * T38; r2[23] -= (f32x2v){a439[2], a439[3]} * T38;
        const f32x4 a444 = *(const LAS f32x4*)(Af + 2692);
        r2[24] -= (f32x2v){a440[0], a440[1]} * T38; r2[25] -= (f32x2v){a440[2], a440[3]} * T38;
        const f32x4 a445 = *(const LAS f32x4*)(Af + 2696);
        r2[26] -= (f32x2v){a441[0], a441[1]} * T38; r2[27] -= (f32x2v){a441[2], a441[3]} * T38;
        const f32x4 a446 = *(const LAS f32x4*)(Af + 2700);
        r2[28] -= (f32x2v){a442[0], a442[1]} * T38; r2[29] -= (f32x2v){a442[2], a442[3]} * T38;
        const f32x4 a447 = *(const LAS f32x4*)(Af + 2704);
        r2[30] -= (f32x2v){a443[0], a443[1]} * T38; r2[31] -= (f32x2v){a443[2], a443[3]} * T38;
        const f32x4 a448 = *(const LAS f32x4*)(Af + 2708);
        const float t39 = r2[19][1]; const f32x2v T39 = (f32x2v){t39, t39}; Tb[2808 + lane] = f2bf(t39);
        r2[20] -= (f32x2v){a444[0], a444[1]} * T39; r2[21] -= (f32x2v){a444[2], a444[3]} * T39;
        const f32x4 a449 = *(const LAS f32x4*)(Af + 2712);
        r2[22] -= (f32x2v){a445[0], a445[1]} * T39; r2[23] -= (f32x2v){a445[2], a445[3]} * T39;
        const f32x4 a450 = *(const LAS f32x4*)(Af + 2760);
        r2[24] -= (f32x2v){a446[0], a446[1]} * T39; r2[25] -= (f32x2v){a446[2], a446[3]} * T39;
        const f32x4 a451 = *(const LAS f32x4*)(Af + 2764);
        r2[26] -= (f32x2v){a447[0], a447[1]} * T39; r2[27] -= (f32x2v){a447[2], a447[3]} * T39;
        const f32x4 a452 = *(const LAS f32x4*)(Af + 2768);
        r2[28] -= (f32x2v){a448[0], a448[1]} * T39; r2[29] -= (f32x2v){a448[2], a448[3]} * T39;
        const f32x4 a453 = *(const LAS f32x4*)(Af + 2772);
        r2[30] -= (f32x2v){a449[0], a449[1]} * T39; r2[31] -= (f32x2v){a449[2], a449[3]} * T39;
        const f32x4 a454 = *(const LAS f32x4*)(Af + 2776);
        const float t40 = r2[20][0]; const f32x2v T40 = (f32x2v){t40, t40}; Tb[2880 + lane] = f2bf(t40);
        r2[20] -= (f32x2v){a450[0], a450[1]} * T40; r2[21] -= (f32x2v){a450[2], a450[3]} * T40;
        const f32x4 a455 = *(const LAS f32x4*)(Af + 2780);
        r2[22] -= (f32x2v){a451[0], a451[1]} * T40; r2[23] -= (f32x2v){a451[2], a451[3]} * T40;
        const f32x4 a456 = *(const LAS f32x4*)(Af + 2828);
        r2[24] -= (f32x2v){a452[0], a452[1]} * T40; r2[25] -= (f32x2v){a452[2], a452[3]} * T40;
        const f32x4 a457 = *(const LAS f32x4*)(Af + 2832);
        r2[26] -= (f32x2v){a453[0], a453[1]} * T40; r2[27] -= (f32x2v){a453[2], a453[3]} * T40;
        const f32x4 a458 = *(const LAS f32x4*)(Af + 2836);
        r2[28] -= (f32x2v){a454[0], a454[1]} * T40; r2[29] -= (f32x2v){a454[2], a454[3]} * T40;
        const f32x4 a459 = *(const LAS f32x4*)(Af + 2840);
        r2[30] -= (f32x2v){a455[0], a455[1]} * T40; r2[31] -= (f32x2v){a455[2], a455[3]} * T40;
        const f32x4 a460 = *(const LAS f32x4*)(Af + 2844);
        const float t41 = r2[20][1]; const f32x2v T41 = (f32x2v){t41, t41}; Tb[2952 + lane] = f2bf(t41);
        r2[21] -= (f32x2v){a456[2], a456[3]} * T41;
        const f32x4 a461 = *(const LAS f32x4*)(Af + 2848);
        r2[22] -= (f32x2v){a457[0], a457[1]} * T41; r2[23] -= (f32x2v){a457[2], a457[3]} * T41;
        const f32x4 a462 = *(const LAS f32x4*)(Af + 2896);
        r2[24] -= (f32x2v){a458[0], a458[1]} * T41; r2[25] -= (f32x2v){a458[2], a458[3]} * T41;
        const f32x4 a463 = *(const LAS f32x4*)(Af + 2900);
        r2[26] -= (f32x2v){a459[0], a459[1]} * T41; r2[27] -= (f32x2v){a459[2], a459[3]} * T41;
        const f32x4 a464 = *(const LAS f32x4*)(Af + 2904);
        r2[28] -= (f32x2v){a460[0], a460[1]} * T41; r2[29] -= (f32x2v){a460[2], a460[3]} * T41;
        const f32x4 a465 = *(const LAS f32x4*)(Af + 2908);
        r2[30] -= (f32x2v){a461[0], a461[1]} * T41; r2[31] -= (f32x2v){a461[2], a461[3]} * T41;
        const f32x4 a466 = *(const LAS f32x4*)(Af + 2912);
        const float t42 = r2[21][0]; const f32x2v T42 = (f32x2v){t42, t42}; Tb[3024 + lane] = f2bf(t42);
        r2[21] -= (f32x2v){a462[2], a462[3]} * T42;
        const f32x4 a467 = *(const LAS f32x4*)(Af + 2916);
        r2[22] -= (f32x2v){a463[0], a463[1]} * T42; r2[23] -= (f32x2v){a463[2], a463[3]} * T42;
        const f32x4 a468 = *(const LAS f32x4*)(Af + 2968);
        r2[24] -= (f32x2v){a464[0], a464[1]} * T42; r2[25] -= (f32x2v){a464[2], a464[3]} * T42;
        const f32x4 a469 = *(const LAS f32x4*)(Af + 2972);
        r2[26] -= (f32x2v){a465[0], a465[1]} * T42; r2[27] -= (f32x2v){a465[2], a465[3]} * T42;
        const f32x4 a470 = *(const LAS f32x4*)(Af + 2976);
        r2[28] -= (f32x2v){a466[0], a466[1]} * T42; r2[29] -= (f32x2v){a466[2], a466[3]} * T42;
        const f32x4 a471 = *(const LAS f32x4*)(Af + 2980);
        r2[30] -= (f32x2v){a467[0], a467[1]} * T42; r2[31] -= (f32x2v){a467[2], a467[3]} * T42;
        const f32x4 a472 = *(const LAS f32x4*)(Af + 2984);
        const float t43 = r2[21][1]; const f32x2v T43 = (f32x2v){t43, t43}; Tb[3096 + lane] = f2bf(t43);
        r2[22] -= (f32x2v){a468[0], a468[1]} * T43; r2[23] -= (f32x2v){a468[2], a468[3]} * T43;
        const f32x4 a473 = *(const LAS f32x4*)(Af + 3036);
        r2[24] -= (f32x2v){a469[0], a469[1]} * T43; r2[25] -= (f32x2v){a469[2], a469[3]} * T43;
        const f32x4 a474 = *(const LAS f32x4*)(Af + 3040);
        r2[26] -= (f32x2v){a470[0], a470[1]} * T43; r2[27] -= (f32x2v){a470[2], a470[3]} * T43;
        const f32x4 a475 = *(const LAS f32x4*)(Af + 3044);
        r2[28] -= (f32x2v){a471[0], a471[1]} * T43; r2[29] -= (f32x2v){a471[2], a471[3]} * T43;
        const f32x4 a476 = *(const LAS f32x4*)(Af + 3048);
        r2[30] -= (f32x2v){a472[0], a472[1]} * T43; r2[31] -= (f32x2v){a472[2], a472[3]} * T43;
        const f32x4 a477 = *(const LAS f32x4*)(Af + 3052);
        const float t44 = r2[22][0]; const f32x2v T44 = (f32x2v){t44, t44}; Tb[3168 + lane] = f2bf(t44);
        r2[22] -= (f32x2v){a473[0], a473[1]} * T44; r2[23] -= (f32x2v){a473[2], a473[3]} * T44;
        const f32x4 a478 = *(const LAS f32x4*)(Af + 3104);
        r2[24] -= (f32x2v){a474[0], a474[1]} * T44; r2[25] -= (f32x2v){a474[2], a474[3]} * T44;
        const f32x4 a479 = *(const LAS f32x4*)(Af + 3108);
        r2[26] -= (f32x2v){a475[0], a475[1]} * T44; r2[27] -= (f32x2v){a475[2], a475[3]} * T44;
        const f32x4 a480 = *(const LAS f32x4*)(Af + 3112);
        r2[28] -= (f32x2v){a476[0], a476[1]} * T44; r2[29] -= (f32x2v){a476[2], a476[3]} * T44;
        const f32x4 a481 = *(const LAS f32x4*)(Af + 3116);
        r2[30] -= (f32x2v){a477[0], a477[1]} * T44; r2[31] -= (f32x2v){a477[2], a477[3]} * T44;
        const f32x4 a482 = *(const LAS f32x4*)(Af + 3120);
        const float t45 = r2[22][1]; const f32x2v T45 = (f32x2v){t45, t45}; Tb[3240 + lane] = f2bf(t45);
        r2[23] -= (f32x2v){a478[2], a478[3]} * T45;
        const f32x4 a483 = *(const LAS f32x4*)(Af + 3172);
        r2[24] -= (f32x2v){a479[0], a479[1]} * T45; r2[25] -= (f32x2v){a479[2], a479[3]} * T45;
        const f32x4 a484 = *(const LAS f32x4*)(Af + 3176);
        r2[26] -= (f32x2v){a480[0], a480[1]} * T45; r2[27] -= (f32x2v){a480[2], a480[3]} * T45;
        const f32x4 a485 = *(const LAS f32x4*)(Af + 3180);
        r2[28] -= (f32x2v){a481[0], a481[1]} * T45; r2[29] -= (f32x2v){a481[2], a481[3]} * T45;
        const f32x4 a486 = *(const LAS f32x4*)(Af + 3184);
        r2[30] -= (f32x2v){a482[0], a482[1]} * T45; r2[31] -= (f32x2v){a482[2], a482[3]} * T45;
        const f32x4 a487 = *(const LAS f32x4*)(Af + 3188);
        const float t46 = r2[23][0]; const f32x2v T46 = (f32x2v){t46, t46}; Tb[3312 + lane] = f2bf(t46);
        r2[23] -= (f32x2v){a483[2], a483[3]} * T46;
        const f32x4 a488 = *(const LAS f32x4*)(Af + 3244);
        r2[24] -= (f32x2v){a484[0], a484[1]} * T46; r2[25] -= (f32x2v){a484[2], a484[3]} * T46;
        const f32x4 a489 = *(const LAS f32x4*)(Af + 3248);
        r2[26] -= (f32x2v){a485[0], a485[1]} * T46; r2[27] -= (f32x2v){a485[2], a485[3]} * T46;
        const f32x4 a490 = *(const LAS f32x4*)(Af + 3252);
        r2[28] -= (f32x2v){a486[0], a486[1]} * T46; r2[29] -= (f32x2v){a486[2], a486[3]} * T46;
        const f32x4 a491 = *(const LAS f32x4*)(Af + 3256);
        r2[30] -= (f32x2v){a487[0], a487[1]} * T46; r2[31] -= (f32x2v){a487[2], a487[3]} * T46;
        const f32x4 a492 = *(const LAS f32x4*)(Af + 3312);
        const float t47 = r2[23][1]; const f32x2v T47 = (f32x2v){t47, t47}; Tb[3384 + lane] = f2bf(t47);
        r2[24] -= (f32x2v){a488[0], a488[1]} * T47; r2[25] -= (f32x2v){a488[2], a488[3]} * T47;
        const f32x4 a493 = *(const LAS f32x4*)(Af + 3316);
        r2[26] -= (f32x2v){a489[0], a489[1]} * T47; r2[27] -= (f32x2v){a489[2], a489[3]} * T47;
        const f32x4 a494 = *(const LAS f32x4*)(Af + 3320);
        r2[28] -= (f32x2v){a490[0], a490[1]} * T47; r2[29] -= (f32x2v){a490[2], a490[3]} * T47;
        const f32x4 a495 = *(const LAS f32x4*)(Af + 3324);
        r2[30] -= (f32x2v){a491[0], a491[1]} * T47; r2[31] -= (f32x2v){a491[2], a491[3]} * T47;
        const f32x4 a496 = *(const LAS f32x4*)(Af + 3380);
        const float t48 = r2[24][0]; const f32x2v T48 = (f32x2v){t48, t48}; Tb[3456 + lane] = f2bf(t48);
        r2[24] -= (f32x2v){a492[0], a492[1]} * T48; r2[25] -= (f32x2v){a492[2], a492[3]} * T48;
        const f32x4 a497 = *(const LAS f32x4*)(Af + 3384);
        r2[26] -= (f32x2v){a493[0], a493[1]} * T48; r2[27] -= (f32x2v){a493[2], a493[3]} * T48;
        const f32x4 a498 = *(const LAS f32x4*)(Af + 3388);
        r2[28] -= (f32x2v){a494[0], a494[1]} * T48; r2[29] -= (f32x2v){a494[2], a494[3]} * T48;
        const f32x4 a499 = *(const LAS f32x4*)(Af + 3392);
        r2[30] -= (f32x2v){a495[0], a495[1]} * T48; r2[31] -= (f32x2v){a495[2], a495[3]} * T48;
        const f32x4 a500 = *(const LAS f32x4*)(Af + 3448);
        const float t49 = r2[24][1]; const f32x2v T49 = (f32x2v){t49, t49}; Tb[3528 + lane] = f2bf(t49);
        r2[25] -= (f32x2v){a496[2], a496[3]} * T49;
        const f32x4 a501 = *(const LAS f32x4*)(Af + 3452);
        r2[26] -= (f32x2v){a497[0], a497[1]} * T49; r2[27] -= (f32x2v){a497[2], a497[3]} * T49;
        const f32x4 a502 = *(const LAS f32x4*)(Af + 3456);
        r2[28] -= (f32x2v){a498[0], a498[1]} * T49; r2[29] -= (f32x2v){a498[2], a498[3]} * T49;
        const f32x4 a503 = *(const LAS f32x4*)(Af + 3460);
        r2[30] -= (f32x2v){a499[0], a499[1]} * T49; r2[31] -= (f32x2v){a499[2], a499[3]} * T49;
        const f32x4 a504 = *(const LAS f32x4*)(Af + 3520);
        const float t50 = r2[25][0]; const f32x2v T50 = (f32x2v){t50, t50}; Tb[3600 + lane] = f2bf(t50);
        r2[25] -= (f32x2v){a500[2], a500[3]} * T50;
        const f32x4 a505 = *(const LAS f32x4*)(Af + 3524);
        r2[26] -= (f32x2v){a501[0], a501[1]} * T50; r2[27] -= (f32x2v){a501[2], a501[3]} * T50;
        const f32x4 a506 = *(const LAS f32x4*)(Af + 3528);
        r2[28] -= (f32x2v){a502[0], a502[1]} * T50; r2[29] -= (f32x2v){a502[2], a502[3]} * T50;
        const f32x4 a507 = *(const LAS f32x4*)(Af + 3588);
        r2[30] -= (f32x2v){a503[0], a503[1]} * T50; r2[31] -= (f32x2v){a503[2], a503[3]} * T50;
        const f32x4 a508 = *(const LAS f32x4*)(Af + 3592);
        const float t51 = r2[25][1]; const f32x2v T51 = (f32x2v){t51, t51}; Tb[3672 + lane] = f2bf(t51);
        r2[26] -= (f32x2v){a504[0], a504[1]} * T51; r2[27] -= (f32x2v){a504[2], a504[3]} * T51;
        const f32x4 a509 = *(const LAS f32x4*)(Af + 3596);
        r2[28] -= (f32x2v){a505[0], a505[1]} * T51; r2[29] -= (f32x2v){a505[2], a505[3]} * T51;
        const f32x4 a510 = *(const LAS f32x4*)(Af + 3656);
        r2[30] -= (f32x2v){a506[0], a506[1]} * T51; r2[31] -= (f32x2v){a506[2], a506[3]} * T51;
        const f32x4 a511 = *(const LAS f32x4*)(Af + 3660);
        const float t52 = r2[26][0]; const f32x2v T52 = (f32x2v){t52, t52}; Tb[3744 + lane] = f2bf(t52);
        r2[26] -= (f32x2v){a507[0], a507[1]} * T52; r2[27] -= (f32x2v){a507[2], a507[3]} * T52;
        const f32x4 a512 = *(const LAS f32x4*)(Af + 3664);
        r2[28] -= (f32x2v){a508[0], a508[1]} * T52; r2[29] -= (f32x2v){a508[2], a508[3]} * T52;
        const f32x4 a513 = *(const LAS f32x4*)(Af + 3724);
        r2[30] -= (f32x2v){a509[0], a509[1]} * T52; r2[31] -= (f32x2v){a509[2], a509[3]} * T52;
        const f32x4 a514 = *(const LAS f32x4*)(Af + 3728);
        const float t53 = r2[26][1]; const f32x2v T53 = (f32x2v){t53, t53}; Tb[3816 + lane] = f2bf(t53);
        r2[27] -= (f32x2v){a510[2], a510[3]} * T53;
        const f32x4 a515 = *(const LAS f32x4*)(Af + 3732);
        r2[28] -= (f32x2v){a511[0], a511[1]} * T53; r2[29] -= (f32x2v){a511[2], a511[3]} * T53;
        const f32x4 a516 = *(const LAS f32x4*)(Af + 3796);
        r2[30] -= (f32x2v){a512[0], a512[1]} * T53; r2[31] -= (f32x2v){a512[2], a512[3]} * T53;
        const f32x4 a517 = *(const LAS f32x4*)(Af + 3800);
        const float t54 = r2[27][0]; const f32x2v T54 = (f32x2v){t54, t54}; Tb[3888 + lane] = f2bf(t54);
        r2[27] -= (f32x2v){a513[2], a513[3]} * T54;
        const f32x4 a518 = *(const LAS f32x4*)(Af + 3864);
        r2[28] -= (f32x2v){a514[0], a514[1]} * T54; r2[29] -= (f32x2v){a514[2], a514[3]} * T54;
        const f32x4 a519 = *(const LAS f32x4*)(Af + 3868);
        r2[30] -= (f32x2v){a515[0], a515[1]} * T54; r2[31] -= (f32x2v){a515[2], a515[3]} * T54;
        const f32x4 a520 = *(const LAS f32x4*)(Af + 3932);
        const float t55 = r2[27][1]; const f32x2v T55 = (f32x2v){t55, t55}; Tb[3960 + lane] = f2bf(t55);
        r2[28] -= (f32x2v){a516[0], a516[1]} * T55; r2[29] -= (f32x2v){a516[2], a516[3]} * T55;
        const f32x4 a521 = *(const LAS f32x4*)(Af + 3936);
        r2[30] -= (f32x2v){a517[0], a517[1]} * T55; r2[31] -= (f32x2v){a517[2], a517[3]} * T55;
        const f32x4 a522 = *(const LAS f32x4*)(Af + 4000);
        const float t56 = r2[28][0]; const f32x2v T56 = (f32x2v){t56, t56}; Tb[4032 + lane] = f2bf(t56);
        r2[28] -= (f32x2v){a518[0], a518[1]} * T56; r2[29] -= (f32x2v){a518[2], a518[3]} * T56;
        const f32x4 a523 = *(const LAS f32x4*)(Af + 4004);
        r2[30] -= (f32x2v){a519[0], a519[1]} * T56; r2[31] -= (f32x2v){a519[2], a519[3]} * T56;
        const f32x4 a524 = *(const LAS f32x4*)(Af + 4072);
        const float t57 = r2[28][1]; const f32x2v T57 = (f32x2v){t57, t57}; Tb[4104 + lane] = f2bf(t57);
        r2[29] -= (f32x2v){a520[2], a520[3]} * T57;
        const f32x4 a525 = *(const LAS f32x4*)(Af + 4140);
        r2[30] -= (f32x2v){a521[0], a521[1]} * T57; r2[31] -= (f32x2v){a521[2], a521[3]} * T57;
        const f32x4 a526 = *(const LAS f32x4*)(Af + 4208);
        const float t58 = r2[29][0]; const f32x2v T58 = (f32x2v){t58, t58}; Tb[4176 + lane] = f2bf(t58);
        r2[29] -= (f32x2v){a522[2], a522[3]} * T58;
        const f32x4 a527 = *(const LAS f32x4*)(Af + 4276);
        r2[30] -= (f32x2v){a523[0], a523[1]} * T58; r2[31] -= (f32x2v){a523[2], a523[3]} * T58;
        const float t59 = r2[29][1]; const f32x2v T59 = (f32x2v){t59, t59}; Tb[4248 + lane] = f2bf(t59);
        r2[30] -= (f32x2v){a524[0], a524[1]} * T59; r2[31] -= (f32x2v){a524[2], a524[3]} * T59;
        const float t60 = r2[30][0]; const f32x2v T60 = (f32x2v){t60, t60}; Tb[4320 + lane] = f2bf(t60);
        r2[30] -= (f32x2v){a525[0], a525[1]} * T60; r2[31] -= (f32x2v){a525[2], a525[3]} * T60;
        const float t61 = r2[30][1]; const f32x2v T61 = (f32x2v){t61, t61}; Tb[4392 + lane] = f2bf(t61);
        r2[31] -= (f32x2v){a526[2], a526[3]} * T61;
        const float t62 = r2[31][0]; const f32x2v T62 = (f32x2v){t62, t62}; Tb[4464 + lane] = f2bf(t62);
        r2[31] -= (f32x2v){a527[2], a527[3]} * T62;
        Tb[4536 + lane] = f2bf(r2[31][1]);
    }
    __syncthreads();
#pragma unroll 2
    for (int r = 0; r < 8; ++r) {
        const int job = wid + 8 * r, kind = job >> 5, tile = job & 31, mt = tile >> 3, nt = tile & 7;
        const f32x4 acc = tile_mm<false, true>(Tb, 72, mt, kind ? KbT : VbT, 72, nt, 2, fr, fq);
        u32x2 w; w.x = cvt_pk(acc[0], acc[1]); w.y = cvt_pk(acc[2], acc[3]);
        { const int ch = 16 * nt + fr; *(LAS u32x2*)((kind ? WT : UT) + ch * 72 + 8 * ((2 * mt + (fq >> 1)) ^ ((ch >> 3) & 7)) + 4 * (fq & 1)) = w; }
    }
    __syncthreads();
    bf16_t* GM = (bf16_t*)(p.ws + WS_GM) + (size_t)unit * 16384; bf16_t* GN = (bf16_t*)(p.ws + WS_GN) + (size_t)unit * 16384;
    bf16_t* GQ = (bf16_t*)(p.ws + WS_GQ) + (size_t)unit * 8192; bf16_t* GO = (bf16_t*)(p.ws + WS_GO) + (size_t)unit * 8192;
#pragma unroll 2
    for (int r = 0; r < 24; ++r) {
        const int job = wid + 8 * r;
        if (job < 64) { const int a = job >> 3, mt = job & 7;
            const f32x4 acc = tile_mm<true, true>(WT, 72, a, KdT, 72, mt, 2, fr, fq);
            u32x2 w; w.x = cvt_pk(-acc[0], -acc[1]); w.y = cvt_pk(-acc[2], -acc[3]);
            *(u32x2*)(GM + ((mt * 4 + (a >> 1)) * 64 + lane) * 8 + (a & 1) * 4) = w;
        } else if (job < 128) { const int j = job - 64, mt = j >> 3, nt = j & 7;
            const f32x4 acc = tile_mm<true, true>(KdT, 72, mt, UT, 72, nt, 2, fr, fq);
            u32x2 w; w.x = cvt_pk(acc[0], acc[1]); w.y = cvt_pk(acc[2], acc[3]);
            *(u32x2*)(GN + ((nt * 64 + lane) * 8 + mt) * 4) = w;
        } else if (job < 160) { const int j = job - 128, a = j >> 2, it = j & 3;
            const f32x4 acc = tile_mm<true, false>(WT, 72, a, QK, 72, it, 2, fr, fq);
            const int i = 16 * it + fr; const float eg = __expf(gcs[i]);
            const u32x2 qv = *(const LAS u32x2*)(Qs + i * 136 + 16 * a + 4 * fq);
            u32x2 w; w.x = cvt_pk(bflo(qv.x) * eg - acc[0], bfhi(qv.x) * eg - acc[1]); w.y = cvt_pk(bflo(qv.y) * eg - acc[2], bfhi(qv.y) * eg - acc[3]);
            *(u32x2*)(GQ + ((it * 4 + (a >> 1)) * 64 + lane) * 8 + (a & 1) * 4) = w;
        } else { const int j = job - 160, mt = j >> 3, nt = j & 7;
            const f32x4 acc = tile_mm<false, true>(QK, 72, mt, UT, 72, nt, 2, fr, fq);
            u32x2 w; w.x = cvt_pk(acc[0], acc[1]); w.y = cvt_pk(acc[2], acc[3]);
            *(u32x2*)(GO + ((nt * 64 + lane) * 4 + mt) * 4) = w;
        }
    }
    if (tid == 0) ((float*)(p.ws + WS_CTL + CTL_GLAST))[unit] = __expf(gclast);
    __syncthreads();
}

__device__ __forceinline__ void gdn_scan(const Params& p, LAS unsigned char* lds, int sb) {
    const int tid = threadIdx.x, lane = tid & 63, wid = tid >> 6, fr = lane & 15, fq = lane >> 4;
    const int bh = sb / (8 / CW), sp = sb % (8 / CW), unit0 = bh * 128, sl = sp * CW + wid;
    const u32x4* GMb = (const u32x4*)((const bf16_t*)(p.ws + WS_GM) + (size_t)unit0 * 16384);
    const u32x4* GQb = (const u32x4*)((const bf16_t*)(p.ws + WS_GQ) + (size_t)unit0 * 8192);
    const bf16_t* GNb = (const bf16_t*)(p.ws + WS_GN) + (size_t)unit0 * 16384;
    bf16_t* GOb = (bf16_t*)(p.ws + WS_GO) + (size_t)unit0 * 8192;
    const float* glast = (const float*)(p.ws + WS_CTL + CTL_GLAST) + unit0;
    const bool loader = (wid >= CW && wid < CW + 4);
#define SCAN_DMA(cc) do { _Pragma("unroll") for (int k = 0; k < 8; ++k) { const int inst = (wid - CW) * 8 + k; \
        __builtin_amdgcn_global_load_lds((const unsigned*)((const char*)(GMb + (size_t)(cc) * 2048) + inst * 1024 + lane * 16), (LAS unsigned*)(lds + ((cc) & 3) * 32768 + inst * 1024), 16, 0, 0); } } while (0)
#define SCAN_LOADN(dn, cc) do { const bf16_t* np_ = GNb + (size_t)((cc) < 128 ? (cc) : 127) * 16384 + (size_t)(sl * 64 + lane) * 32; \
        asm volatile("global_load_dwordx4 %0, %4, off\n\tglobal_load_dwordx4 %1, %4, off offset:16\n\tglobal_load_dwordx4 %2, %4, off offset:32\n\tglobal_load_dwordx4 %3, %4, off offset:48" \
            : "=&v"(dn[0]), "=&v"(dn[1]), "=&v"(dn[2]), "=&v"(dn[3]) : "v"(np_) : "memory"); } while (0)
#define SCAN_WAITN(dn, N) asm volatile("s_waitcnt vmcnt(" #N ")" : "+v"(dn[0]), "+v"(dn[1]), "+v"(dn[2]), "+v"(dn[3]) :: "memory")
#define SCAN_STEP(c, nn, RELOAD) do { \
        SCAN_WAITN(nn, 8); \
        const float gl = __shfl(((c) < 64) ? glr0 : glr1, (c) & 63); bf16x8 Sb[4]; \
        bf16_t* scp = (bf16_t*)GNb + (size_t)(c) * 16384 + (size_t)sl * 2048 + lane * 8; \
        _Pragma("unroll") for (int ks = 0; ks < 4; ++ks) { u32x4 w; w.x = cvt_pk(S[2 * ks][0], S[2 * ks][1]); w.y = cvt_pk(S[2 * ks][2], S[2 * ks][3]); \
            w.z = cvt_pk(S[2 * ks + 1][0], S[2 * ks + 1][1]); w.w = cvt_pk(S[2 * ks + 1][2], S[2 * ks + 1][3]); Sb[ks] = __builtin_bit_cast(bf16x8, w); } \
        const LAS unsigned char* slot = lds + ((c) & 3) * 32768 + lane * 16; \
        bf16x8 fa[2][2][4]; \
        _Pragma("unroll") for (int ks = 0; ks < 4; ++ks) { fa[0][0][ks] = *(const LAS bf16x8*)(slot + (0 * 4 + ks) * 1024); fa[0][1][ks] = *(const LAS bf16x8*)(slot + (1 * 4 + ks) * 1024); } \
        _Pragma("unroll") for (int mt = 0; mt < 8; ++mt) { const unsigned w0 = nn[mt >> 1][(mt & 1) * 2], w1 = nn[mt >> 1][(mt & 1) * 2 + 1]; \
            S[mt] = S[mt] * gl + (f32x4){bflo(w0), bfhi(w0), bflo(w1), bfhi(w1)}; } \
        _Pragma("unroll") for (int ks = 0; ks < 4; ++ks) *(u32x4*)(scp + ks * 512) = __builtin_bit_cast(u32x4, Sb[ks]);     \
        RELOAD; \
        _Pragma("unroll") for (int pr = 0; pr < 4; ++pr) { \
            if (pr < 3) { _Pragma("unroll") for (int ks = 0; ks < 4; ++ks) { fa[(pr + 1) & 1][0][ks] = *(const LAS bf16x8*)(slot + ((2 * pr + 2) * 4 + ks) * 1024); fa[(pr + 1) & 1][1][ks] = *(const LAS bf16x8*)(slot + ((2 * pr + 3) * 4 + ks) * 1024); } } \
            _Pragma("unroll") for (int ks = 0; ks < 4; ++ks) { S[2 * pr] = mfma16(fa[pr & 1][0][ks], Sb[ks], S[2 * pr]); S[2 * pr + 1] = mfma16(fa[pr & 1][1][ks], Sb[ks], S[2 * pr + 1]); } } \
        } while (0)
    if (loader) { SCAN_DMA(0); SCAN_DMA(1); SCAN_DMA(2); asm volatile("s_waitcnt vmcnt(0)" ::: "memory"); }
    f32x4 S[8];
#pragma unroll
    for (int mt = 0; mt < 8; ++mt) S[mt] = (f32x4){0.f, 0.f, 0.f, 0.f};
    float glr0 = glast[lane], glr1 = glast[64 + lane];
    asm volatile("" : "+v"(glr0), "+v"(glr1));
    u32x4 nnA[4], nnB[4];
    if (wid < CW) { SCAN_LOADN(nnA, 0); SCAN_LOADN(nnB, 1); SCAN_WAITN(nnA, 0); SCAN_WAITN(nnB, 0); }
    asm volatile("s_waitcnt lgkmcnt(0)" ::: "memory"); __builtin_amdgcn_s_barrier(); asm volatile("" ::: "memory");
#pragma unroll 1
    for (int c = 0; c < 128; c += 2) {
        if (loader) { if (c + 3 < 128) { SCAN_DMA(c + 3); asm volatile("s_waitcnt vmcnt(16)" ::: "memory"); } else asm volatile("s_waitcnt vmcnt(0)" ::: "memory"); }
        else if (wid < CW) { SCAN_STEP(c, nnA, SCAN_LOADN(nnA, c + 2)); }
        asm volatile("s_waitcnt lgkmcnt(0)" ::: "memory"); __builtin_amdgcn_s_barrier(); asm volatile("" ::: "memory");
        if (loader) { if (c + 4 < 128) { SCAN_DMA(c + 4); asm volatile("s_waitcnt vmcnt(16)" ::: "memory"); } else asm volatile("s_waitcnt vmcnt(0)" ::: "memory"); }
        else if (wid < CW) { SCAN_STEP(c + 1, nnB, SCAN_LOADN(nnB, c + 3)); }
        asm volatile("s_waitcnt lgkmcnt(0)" ::: "memory"); __builtin_amdgcn_s_barrier(); asm volatile("" ::: "memory");
    }
#undef SCAN_DMA
#undef SCAN_LOADN
#undef SCAN_WAITN
#undef SCAN_STEP
    __syncthreads();
    if (wid < CW) {
        float* go = p.out + O_GP + (size_t)bh * 16384;
#pragma unroll
        for (int mt = 0; mt < 8; ++mt)
#pragma unroll
            for (int e = 0; e < 4; ++e) go[(16 * mt + 4 * fq + e) * 128 + sl * 16 + fr] = S[mt][e];
    }
}

__device__ __forceinline__ void gdn_gate_unit(const Params& p, int unit, int lane) {
    const int fr = lane & 15, fq = lane >> 4, bh = unit >> 7, n = unit & 127, b = bh >> 2, h = bh & 3, tok0 = b * SEQ + n * 64;
    const bf16_t* GO = (const bf16_t*)(p.ws + WS_GO) + (size_t)unit * 8192;
    bf16_t* PB = (bf16_t*)(p.ws + WS_H);
    {
        bf16_t* GOw = (bf16_t*)(p.ws + WS_GO) + (size_t)unit * 8192;
        const bf16_t* GQ = (const bf16_t*)(p.ws + WS_GQ) + (size_t)unit * 8192; const bf16_t* SC = (const bf16_t*)(p.ws + WS_GN) + (size_t)unit * 16384;
        bf16x8 qa[4][4];
#pragma unroll
        for (int mt = 0; mt < 4; ++mt)
#pragma unroll
            for (int ks = 0; ks < 4; ++ks) qa[mt][ks] = *(const bf16x8*)(GQ + ((mt * 4 + ks) * 64 + lane) * 8);
#pragma unroll 2
        for (int nt = 0; nt < 8; ++nt) {
            bf16x8 sb[4];
#pragma unroll
            for (int ks = 0; ks < 4; ++ks) sb[ks] = *(const bf16x8*)(SC + nt * 2048 + (ks * 64 + lane) * 8);
            const u32x4 o0 = *(const u32x4*)(GOw + (nt * 64 + lane) * 16), o1 = *(const u32x4*)(GOw + (nt * 64 + lane) * 16 + 8);
            f32x4 acc[4];
            acc[0] = (f32x4){bflo(o0.x), bfhi(o0.x), bflo(o0.y), bfhi(o0.y)}; acc[1] = (f32x4){bflo(o0.z), bfhi(o0.z), bflo(o0.w), bfhi(o0.w)};
            acc[2] = (f32x4){bflo(o1.x), bfhi(o1.x), bflo(o1.y), bfhi(o1.y)}; acc[3] = (f32x4){bflo(o1.z), bfhi(o1.z), bflo(o1.w), bfhi(o1.w)};
#pragma unroll
            for (int ks = 0; ks < 4; ++ks)
#pragma unroll
                for (int mt = 0; mt < 4; ++mt) acc[mt] = mfma16(qa[mt][ks], sb[ks], acc[mt]);
            u32x4 w0, w1;
            w0.x = cvt_pk(acc[0][0], acc[0][1]); w0.y = cvt_pk(acc[0][2], acc[0][3]); w0.z = cvt_pk(acc[1][0], acc[1][1]); w0.w = cvt_pk(acc[1][2], acc[1][3]);
            w1.x = cvt_pk(acc[2][0], acc[2][1]); w1.y = cvt_pk(acc[2][2], acc[2][3]); w1.z = cvt_pk(acc[3][0], acc[3][1]); w1.w = cvt_pk(acc[3][2], acc[3][3]);
            *(u32x4*)(GOw + (nt * 64 + lane) * 16) = w0; *(u32x4*)(GOw + (nt * 64 + lane) * 16 + 8) = w1;
        }
        asm volatile("s_waitcnt vmcnt(0)" ::: "memory");
    }
    float ssq[16];
#pragma unroll
    for (int k = 0; k < 16; ++k) ssq[k] = 0.f;
#pragma unroll 1
    for (int nt = 0; nt < 8; ++nt) {
        const u32x4 a0 = *(const u32x4*)(GO + (nt * 64 + lane) * 16), a1 = *(const u32x4*)(GO + (nt * 64 + lane) * 16 + 8);
#pragma unroll
        for (int k = 0; k < 4; ++k) { const float l0 = bflo(a0[k]), h0 = bfhi(a0[k]), l1 = bflo(a1[k]), h1 = bfhi(a1[k]);
            ssq[2 * k] += l0 * l0; ssq[2 * k + 1] += h0 * h0; ssq[8 + 2 * k] += l1 * l1; ssq[8 + 2 * k + 1] += h1 * h1; }
    }
#pragma unroll
    for (int k = 0; k < 16; ++k) { float s = ssq[k]; s += __shfl_xor(s, 1); s += __shfl_xor(s, 2); s += __shfl_xor(s, 4); s += __shfl_xor(s, 8); ssq[k] = rsqrtf(s * (1.0f / 128.0f) + EPS); }
    const float* gn = p.in[15];
#pragma unroll 1
    for (int nt = 0; nt < 8; ++nt) {
        const int dv = 16 * nt + fr; const float g = gn[dv];
        const u32x4 a0 = *(const u32x4*)(GO + (nt * 64 + lane) * 16), a1 = *(const u32x4*)(GO + (nt * 64 + lane) * 16 + 8);
        const bf16_t* gzp = PB + (size_t)(tok0 + 4 * fq) * PW + 2304 + h * 128 + dv; bf16_t* mp = PB + (size_t)(tok0 + 4 * fq) * PW + 512 + h * 128 + dv;
#pragma unroll
        for (int k = 0; k < 16; ++k) {
            const unsigned w = (k < 8) ? a0[(k >> 1) & 3] : a1[(k >> 1) & 3]; const float o = (k & 1) ? bfhi(w) : bflo(w);
            const int to = 16 * (k >> 2) + (k & 3);
            const float gz = bf2f(gzp[(size_t)to * PW]);
            mp[(size_t)to * PW] = f2bf(o * ssq[k] * g * silu(gz));
        }
    }
}

__device__ __forceinline__ void attn_unit(const Params& p, LAS unsigned char* lds, int unit) {
    const int tid = threadIdx.x, lane = tid & 63, wid = tid >> 6, fr = lane & 15, fq = lane >> 4;
    const int b = unit >> 7, blk = (unit >> 1) & 63, kvh = unit & 1;
    LAS bf16_t* Ks = (LAS bf16_t*)lds; LAS bf16_t* Vt = (LAS bf16_t*)(lds + 36864);
    bf16_t* PB = (bf16_t*)(p.ws + WS_H);
    __syncthreads();
#pragma unroll
    for (int i = 0; i < 4; ++i) {
        const int q = tid + 512 * i, row = q >> 3, ch = q & 7, tp = blk * 128 - 128 + row;
        u32x4 kv = (u32x4){0u, 0u, 0u, 0u}, vv = (u32x4){0u, 0u, 0u, 0u};
        if (tp >= 0) { const bf16_t* base = PB + (size_t)(b * SEQ + tp) * PW; kv = *(const u32x4*)(base + 512 + kvh * 64 + ch * 8); vv = *(const u32x4*)(base + 640 + kvh * 64 + ch * 8); }
        *(LAS u32x4*)(Ks + row * 72 + ch * 8) = kv;
#pragma unroll
        for (int e = 0; e < 4; ++e) { const unsigned w = vv[e]; Vt[(ch * 8 + 2 * e) * 264 + row] = (bf16_t)(w & 0xffffu); Vt[(ch * 8 + 2 * e + 1) * 264 + row] = (bf16_t)(w >> 16); }
    }
    __syncthreads();
    const int qtok = b * SEQ + blk * 128 + 16 * wid + fr;
#pragma unroll 1
    for (int g = 0; g < 4; ++g) {
        const int h = kvh * 4 + g; const float slope = exp2f(-(float)(h + 1)), sink = p.in[11][h];
        bf16x8 qf[2];
#pragma unroll
        for (int ks = 0; ks < 2; ++ks) qf[ks] = *(const bf16x8*)(PB + (size_t)qtok * PW + h * 64 + ks * 32 + 8 * fq);
        f32x4 s[10]; float mx = sink;
#pragma unroll
        for (int j = 0; j < 10; ++j) {
            const int ct = (wid + j) < 15 ? (wid + j) : 15;
            f32x4 acc = (f32x4){0.f, 0.f, 0.f, 0.f};
#pragma unroll
            for (int ks = 0; ks < 2; ++ks) acc = mfma16(*(const LAS bf16x8*)(Ks + (16 * ct + fr) * 72 + ks * 32 + 8 * fq), qf[ks], acc);
#pragma unroll
            for (int e = 0; e < 4; ++e) {
                const int c = 16 * (wid + j) + 4 * fq + e, dist = 16 * wid + fr - c + 128;
                const bool ok = (wid + j <= 15) && dist >= 0 && dist <= 128 && (blk * 128 + c - 128 >= 0);
                const float v = ok ? acc[e] * 0.125f - slope * (float)dist : -INFINITY;
                acc[e] = v; mx = fmaxf(mx, v);
            }
            s[j] = acc;
            asm volatile("" ::: "memory");
        }
        mx = fmaxf(mx, __shfl_xor(mx, 16)); mx = fmaxf(mx, __shfl_xor(mx, 32));
        float sum = 0.f;
#pragma unroll
        for (int j = 0; j < 10; ++j)
#pragma unroll
            for (int e = 0; e < 4; ++e) { const float pv = __expf(s[j][e] - mx); s[j][e] = pv; sum += pv; }
        sum += __shfl_xor(sum, 16); sum += __shfl_xor(sum, 32);
        sum += __expf(sink - mx);
        const float inv = 1.0f / sum;
        bf16x8 pb[5];
#pragma unroll
        for (int kk = 0; kk < 5; ++kk) { u32x4 w; w.x = cvt_pk(s[2 * kk][0] * inv, s[2 * kk][1] * inv); w.y = cvt_pk(s[2 * kk][2] * inv, s[2 * kk][3] * inv);
            w.z = cvt_pk(s[2 * kk + 1][0] * inv, s[2 * kk + 1][1] * inv); w.w = cvt_pk(s[2 * kk + 1][2] * inv, s[2 * kk + 1][3] * inv); pb[kk] = __builtin_bit_cast(bf16x8, w); }
#pragma unroll
        for (int dt = 0; dt < 4; ++dt) {
            f32x4 acc = (f32x4){0.f, 0.f, 0.f, 0.f};
#pragma unroll
            for (int kk = 0; kk < 5; ++kk) {
                const int c0 = (wid + 2 * kk) < 15 ? (wid + 2 * kk) : 15, c1 = (wid + 2 * kk + 1) < 15 ? (wid + 2 * kk + 1) : 15;
                const u32x2 lo = *(const LAS u32x2*)(Vt + (16 * dt + fr) * 264 + 16 * c0 + 4 * fq), hi = *(const LAS u32x2*)(Vt + (16 * dt + fr) * 264 + 16 * c1 + 4 * fq);
                const u32x4 a = (u32x4){lo.x, lo.y, hi.x, hi.y};
                acc = mfma16(__builtin_bit_cast(bf16x8, a), pb[kk], acc);
            }
            u32x2 w; w.x = cvt_pk(acc[0], acc[1]); w.y = cvt_pk(acc[2], acc[3]);
            *(u32x2*)(PB + (size_t)qtok * PW + h * 64 + 16 * dt + 4 * fq) = w;
            asm volatile("" ::: "memory");
        }
    }
}

__device__ __forceinline__ void sattn_unit(const Params& p, int s, int h, int lane) {
    const int kvh = h >> 2; const bool wr = (h & 3) == 0;
    bf16_t* PB = (bf16_t*)(p.ws + WS_H) + (size_t)(MPR + s) * PW;
    const float* ck = p.in[2] + (size_t)s * 128 * 128 + kvh * 64 + lane; const float* cv = p.in[3] + (size_t)s * 128 * 128 + kvh * 64 + lane;
    float* nk = p.out + O_KS + (size_t)s * 128 * 128 + kvh * 64 + lane; float* nv = p.out + O_VS + (size_t)s * 128 * 128 + kvh * 64 + lane;
    const float q = bf2f(PB[h * 64 + lane]) * 0.125f, slope = exp2f(-(float)(h + 1)), sink = p.in[11][h];
    const float knew = bf2f(PB[512 + kvh * 64 + lane]), vnew = bf2f(PB[640 + kvh * 64 + lane]);
    float sc[3];
#pragma unroll
    for (int t = 0; t < 2; ++t) {
#pragma unroll 8
        for (int jj = 0; jj < 64; ++jj) {
            const int j = t * 64 + jj; const float kval = ck[(size_t)j * 128];
            if (wr && j >= 1) nk[(size_t)(j - 1) * 128] = kval;
            const float d = wave_sum(q * kval) - slope * (float)(128 - j); if (lane == jj) sc[t] = d;
        }
    }
    if (wr) nk[(size_t)127 * 128] = knew;
    sc[2] = wave_sum(q * knew);
    const float mx = fmaxf(fmaxf(wave_max(fmaxf(sc[0], sc[1])), sc[2]), sink);
    const float p0 = __expf(sc[0] - mx), p1 = __expf(sc[1] - mx), p2 = __expf(sc[2] - mx);
    const float inv = 1.0f / (wave_sum(p0 + p1) + p2 + __expf(sink - mx));
    float o = p2 * vnew;
#pragma unroll 8
    for (int jj = 0; jj < 64; ++jj) { const float vval = cv[(size_t)jj * 128]; if (wr && jj >= 1) nv[(size_t)(jj - 1) * 128] = vval; o += __shfl(p0, jj) * vval; }
#pragma unroll 8
    for (int jj = 0; jj < 64; ++jj) { const float vval = cv[(size_t)(64 + jj) * 128]; if (wr) nv[(size_t)(63 + jj) * 128] = vval; o += __shfl(p1, jj) * vval; }
    if (wr) nv[(size_t)127 * 128] = vnew;
    asm volatile("" ::: "memory");
    PB[h * 64 + lane] = f2bf(o * inv);
}

__device__ __forceinline__ void sgdn_unit(const Params& p, LAS unsigned char* lds, int s) {
    const int tid = threadIdx.x, wid = tid >> 6, h = tid >> 7, dv = tid & 127;
    LAS float* qs = (LAS float*)lds; LAS float* ks = qs + 512; LAS float* red = ks + 512;
    bf16_t* PB = (bf16_t*)(p.ws + WS_H) + (size_t)(MPR + s) * PW; const float* GBA = (const float*)(p.ws + WS_GBA) + (size_t)(MPR + s) * 8;
    const float* cw = p.in[12]; const float* hc = p.in[4] + (size_t)s * 3 * CONVC; float* nc = p.out + O_CS + (size_t)s * 3 * CONVC;
    __syncthreads();
    float val[3];
#pragma unroll
    for (int i = 0; i < 3; ++i) {
        const int c = i * 512 + tid; const float x3 = bf2f(PB[768 + c]), h0 = hc[c], h1 = hc[CONVC + c], h2 = hc[2 * CONVC + c];
        val[i] = silu(cw[c] * h0 + cw[CONVC + c] * h1 + cw[2 * CONVC + c] * h2 + cw[3 * CONVC + c] * x3);
        nc[c] = h1; nc[CONVC + c] = h2; nc[2 * CONVC + c] = x3;
    }
    const float sq = wave_sum(val[0] * val[0]), sk = wave_sum(val[1] * val[1]);
    if ((tid & 63) == 0) { red[wid] = sq; red[8 + wid] = sk; }
    __syncthreads();
    const float ssq = red[2 * h] + red[2 * h + 1], ssk = red[8 + 2 * h] + red[8 + 2 * h + 1];
    qs[tid] = val[0] * rsqrtf(ssq + EPS) * 0.08838834764831845f; ks[tid] = val[1] * rsqrtf(ssk + EPS);
    __syncthreads();
    const float beta = 1.0f / (1.0f + __expf(-GBA[h]));
    const float x = GBA[4 + h] + p.in[14][h]; const float sp = x > 20.f ? x : log1pf(__expf(x));
    const float eg = __expf(-__expf(p.in[13][h]) * sp);
    const float* S0 = p.in[5] + ((size_t)(s * 4 + h) * 128) * 128 + dv; float* S1 = p.out + O_GS + ((size_t)(s * 4 + h) * 128) * 128 + dv;
    float kS = 0.f;
#pragma unroll 1
    for (int hf = 0; hf < 4; ++hf) { float sv[32];
#pragma unroll
        for (int dk = 0; dk < 32; ++dk) sv[dk] = S0[(size_t)(hf * 32 + dk) * 128];
#pragma unroll
        for (int dk = 0; dk < 32; ++dk) kS += ks[h * 128 + hf * 32 + dk] * sv[dk]; }
    const float delta = beta * (val[2] - eg * kS);
    float o = 0.f;
#pragma unroll 1
    for (int hf = 0; hf < 4; ++hf) { float sv[32];
#pragma unroll
        for (int dk = 0; dk < 32; ++dk) sv[dk] = S0[(size_t)(hf * 32 + dk) * 128];
#pragma unroll
        for (int dk = 0; dk < 32; ++dk) { const float nvv = eg * sv[dk] + ks[h * 128 + hf * 32 + dk] * delta; S1[(size_t)(hf * 32 + dk) * 128] = nvv; o += qs[h * 128 + hf * 32 + dk] * nvv; } }
    const float so = wave_sum(o * o);
    if ((tid & 63) == 0) red[16 + wid] = so;
    __syncthreads();
    const float tot = red[16 + 2 * h] + red[16 + 2 * h + 1];
    const float gz = bf2f(PB[2304 + tid]);
    PB[512 + tid] = f2bf(o * rsqrtf(tot * (1.0f / 128.0f) + EPS) * p.in[15][dv] * silu(gz));
}

#define XB_TMO      128
#define XB_XCNT(j)  (256  + 64 * (j))
#define XB_XSUB(j)  (1280 + 64 * (j))
#define XB_XGEN(j)  (2304 + 64 * (j))
#define XB_TOP      3328
#define XB_TOPGEN   3392
#define XCD_BAR_WORDS 3456
#define XB_SPIN_CAP (1u << 18)

__device__ __forceinline__ unsigned xb_ld(unsigned* p)              { return __hip_atomic_load(p, __ATOMIC_RELAXED, __HIP_MEMORY_SCOPE_AGENT); }
__device__ __forceinline__ unsigned xb_add(unsigned* p, unsigned v) { return __hip_atomic_fetch_add(p, v, __ATOMIC_RELAXED, __HIP_MEMORY_SCOPE_AGENT); }
__device__ __forceinline__ unsigned xb_xcc_id() { return (unsigned)__builtin_amdgcn_s_getreg((3 << 11) | 20) & 0xFu; }
#define XB_SPIN(cond, bar) do { unsigned _sp = 0; while (cond) { __builtin_amdgcn_s_sleep(1); \
    if ((++_sp & 255u) == 0u) { if (xb_ld(&(bar)[XB_TMO])) break; if (_sp > XB_SPIN_CAP) { atomicAdd(&(bar)[XB_TMO], 1u); break; } } } } while (0)

struct XcdBarrier {
    unsigned* bar; unsigned x;
    volatile LAS unsigned* st;
};

__device__ __forceinline__ XcdBarrier xcd_barrier_post(unsigned* bar, volatile LAS unsigned* st) {
    XcdBarrier b; b.bar = bar; b.x = xb_xcc_id(); b.st = st;
    if (threadIdx.x == 0) (void)xb_add(&bar[XB_XCNT(b.x)], 1u);
    return b;
}
__device__ __forceinline__ void xcd_barrier_complete(unsigned* bar, unsigned x, unsigned& nloc, unsigned& nx) {
    const unsigned G = gridDim.x * gridDim.y * gridDim.z;
    unsigned sum, cnt, mine, sp = 0u;
    for (;;) {
        sum = 0u; cnt = 0u; mine = 0u;
#pragma unroll
        for (unsigned j = 0; j < 16; ++j) { const unsigned c = xb_ld(&bar[XB_XCNT(j)]); sum += c; cnt += (c > 0u) ? 1u : 0u; mine = (j == x) ? c : mine; }
        if (sum == G) break;
        __builtin_amdgcn_s_sleep(1);
        if ((++sp & 255u) == 0u) { if (xb_ld(&bar[XB_TMO])) break; if (sp > XB_SPIN_CAP) { atomicAdd(&bar[XB_TMO], 1u); break; } }
    }
    nloc = mine > 0u ? mine : 1u; nx = cnt > 0u ? cnt : 1u;
}

__device__ __forceinline__ void xcd_barrier(const XcdBarrier& b) {
    asm volatile("s_waitcnt vmcnt(0)" ::: "memory");
    __syncthreads();
    if (threadIdx.x == 0) {
        unsigned* bar = b.bar;
        __builtin_amdgcn_s_waitcnt(0);
        unsigned nloc = b.st[0], nx = b.st[1];
        if (nloc == 0u) { xcd_barrier_complete(bar, b.x, nloc, nx); b.st[0] = nloc; b.st[1] = nx; }
        const unsigned old = xb_add(&bar[XB_XSUB(b.x)], 1u);
        const unsigned gen = old / nloc;
        if (old + 1u == (gen + 1u) * nloc) {
            __builtin_amdgcn_fence(__ATOMIC_RELEASE, "agent");
            asm volatile("s_waitcnt vmcnt(0)" ::: "memory");
            const unsigned og = xb_add(&bar[XB_TOP], 1u);
            const unsigned tg = og / nx;
            if (og + 1u == (tg + 1u) * nx) xb_add(&bar[XB_TOPGEN], 1u);
            else XB_SPIN(xb_ld(&bar[XB_TOPGEN]) == tg, bar);
            __builtin_amdgcn_fence(__ATOMIC_ACQUIRE, "agent");
            xb_add(&bar[XB_XGEN(b.x)], 1u);
            asm volatile("s_waitcnt vmcnt(0)" ::: "memory");
        } else {
            XB_SPIN(xb_ld(&bar[XB_XGEN(b.x)]) == gen, bar);
            __builtin_amdgcn_fence(__ATOMIC_ACQUIRE, "agent");
            asm volatile("s_waitcnt vmcnt(0)" ::: "memory");
        }
    }
    __syncthreads();
}

__global__ void __launch_bounds__(512, 2) fwd_kernel(Params p, int ph_lo, int ph_hi) {
    extern __shared__ __attribute__((aligned(16))) unsigned char lds_raw[];
    LAS unsigned char* lds = (LAS unsigned char*)lds_raw;
    cg::grid_group grid = cg::this_grid();
    if (ph_lo < 0) grid.sync();
    volatile LAS unsigned* bst = (volatile LAS unsigned*)(lds + LDS_PHASE_BYTES);
    if (threadIdx.x < 2) bst[threadIdx.x] = 0u;
    __syncthreads();
    XcdBarrier xbar; xbar.bar = (unsigned*)(p.ws + WS_CTL + CTL_BAR); xbar.x = 0; xbar.st = bst;
    if (ph_hi - ph_lo > 1) xbar = xcd_barrier_post((unsigned*)(p.ws + WS_CTL + CTL_BAR), bst);
    const int tid = threadIdx.x, lane = tid & 63, wid = tid >> 6, G = gridDim.x, bx = blockIdx.x;
    unsigned char* ws = p.ws;
    bf16_t* XN = (bf16_t*)(ws + WS_XN); bf16_t* XN2 = (bf16_t*)(ws + WS_XN2); bf16_t* HB = (bf16_t*)(ws + WS_H);
    float* SS1 = (float*)(ws + WS_SSP1); float* SS2 = (float*)(ws + WS_SSP2);
    float* Y = p.out; float* X2 = (float*)(ws + WS_GM); float* X3 = (float*)(ws + WS_XN);
#ifndef PHMASK
#define PHMASK 0x7ff
#endif
#define IN(k) (((PHMASK >> (k)) & 1) && ph_lo <= (k) && (k) < ph_hi)
#define SEAM(k) do { if (IN(k) && IN((k) + 1)) { xcd_barrier(xbar); }     } while (0)

    if (IN(0)) p0_prologue(p, lds, bx, G);
    SEAM(0);
    if (IN(1)) {
        if (bx < 176) sk_ffn_in<false>(XN, (const bf16_t*)(ws + WS_W1IN), HB, bx, wid, lane & 15, lane >> 4);
        pg8::Gemm g{XN, (const bf16_t*)(ws + WS_W1IN), MPR, 2 * DFF, DM, DM}; pg8::StaticOrder S; S.init(MPR, 2 * DFF, G, bx);
        EpiSwiglu E{HB, nullptr}; pg8::gemm_phase<EpiSwiglu, pg8::StaticOrder, GEMM_ALIGN, GEMM_SP2>(lds, g, S, E);
    }
    SEAM(1);
    if (IN(2)) {
        if (bx < 64) sk_ffn_out<false>(HB, (const bf16_t*)(ws + WS_W1OUT), p.in[1], nullptr, XN + (size_t)MPR * DM, bx, wid, lane & 15, lane >> 4);
        pg8::Gemm g{HB, (const bf16_t*)(ws + WS_W1OUT), MPR, DM, DFF, DFF}; pg8::StaticOrder S; S.init(MPR, DM, G, bx);
        EpiResid<false, false, true, true, true> E{p.in[0], p.in[1], nullptr, XN, SS1}; pg8::gemm_phase<EpiResid<false, false, true, true, true>, pg8::StaticOrder, GEMM_ALIGN, GEMM_SP2>(lds, g, S, E);
    }
    SEAM(2);
    if (IN(3)) {
        if (bx < 89) sk_inproj(XN, (const bf16_t*)(ws + WS_WINMIX), HB, (float*)(ws + WS_GBA), bx, wid, lane & 15, lane >> 4);
        pg8::Gemm g{XN, (const bf16_t*)(ws + WS_WINMIX), MPR, NINP, DM, DM}; pg8::StaticOrder S; S.init(MPR, NINP, G, bx);
        EpiInproj E{HB, (float*)(ws + WS_GBA), SS1}; pg8::gemm_phase<EpiInproj, pg8::StaticOrder, GEMM_ALIGN, GEMM_SP2>(lds, g, S, E);
    }
    SEAM(3);
    if (IN(4)) {
        for (int u = bx; u < 2048; u += G) gdn_prep_unit(p, lds, u);
    }
    SEAM(4);
    if (IN(5)) {
        if (bx < NSCAN) gdn_scan(p, lds, bx);
        else {
            const int ab = bx - NSCAN, NAB = G - NSCAN;
            if (NAB == 192) {
                if (ab < 128) { sattn_unit(p, ab, wid, lane); sgdn_unit(p, lds, ab); attn_unit(p, lds, 2 * ab); attn_unit(p, lds, 2 * ab + 1); }
                else { for (int k = 0; k < 4; ++k) attn_unit(p, lds, 256 + (ab - 128) * 4 + k); }
            } else {
                int it = ab;
#pragma unroll 1
                for (; it < 512; it += NAB) attn_unit(p, lds, it);
#pragma unroll 1
                for (; it < 640; it += NAB) { sattn_unit(p, it - 512, wid, lane); sgdn_unit(p, lds, it - 512); }
            }
            const bf16_t* PB = HB;
            for (int idx = ab * 512 + tid; idx < 149504; idx += NAB * 512) {
                if (idx < 131072) { const int w = idx >> 16, r = idx & 65535, b = r >> 14, j = (r >> 7) & 127, c = r & 127;
                    p.out[(w ? O_VP : O_KP) + r] = bf2f(PB[(size_t)(b * SEQ + SEQ - 128 + j) * PW + 512 + w * 128 + c]);
                } else { const int r = idx - 131072, b = r / (3 * CONVC), q = r % (3 * CONVC), rr = q / CONVC, c = q % CONVC;
                    p.out[O_CP + r] = bf2f(PB[(size_t)(b * SEQ + SEQ - 3 + rr) * PW + 768 + c]); }
            }
        }
    }
    SEAM(5);
    if (IN(6)) {
        for (int u = bx * 8 + wid; u < 2048; u += G * 8) gdn_gate_unit(p, u, lane);
    }
    SEAM(6);
#ifdef DBG_DUMP
    if (ph_lo == 11) {
        const float* src = (const float*)(ws + DBG_SRC);
        for (size_t i = (size_t)bx * 512 + tid; i < (size_t)MREAL * DM; i += (size_t)G * 512) Y[i] = (i < (size_t)MREAL * 8) ? ((const float*)(ws + WS_GBA))[i] : 0.f;
    }
#endif
    if (IN(7)) {
        if (bx < 32) sk_outproj(HB, (const bf16_t*)(ws + WS_WOUTMIX), XN, X2, XN2, bx, wid, lane & 15, lane >> 4);
        pg8::Gemm g{HB, (const bf16_t*)(ws + WS_WOUTMIX), MPR, DM, DM, PW}; pg8::StaticOrder S; S.init(MPR, DM, G, bx);
        EpiResid<true, true, true, true, false> E{XN, XN + (size_t)MPR * DM, X2, XN2, SS2}; pg8::gemm_phase<EpiResid<true, true, true, true, false>, pg8::StaticOrder, GEMM_ALIGN, GEMM_SP2>(lds, g, S, E);
    }
    SEAM(7);
    if (IN(8)) {
        if (bx < 176) sk_ffn_in<true>(XN2, (const bf16_t*)(ws + WS_W2IN), HB, bx, wid, lane & 15, lane >> 4);
        pg8::Gemm g{XN2, (const bf16_t*)(ws + WS_W2IN), MPR, 2 * DFF, DM, DM}; pg8::StaticOrder S; S.init(MPR, 2 * DFF, G, bx);
        EpiSwiglu E{HB, SS2}; pg8::gemm_phase<EpiSwiglu, pg8::StaticOrder, GEMM_ALIGN, GEMM_SP2>(lds, g, S, E);
    }
    SEAM(8);
    if (IN(9)) {
        if (bx < 64) sk_ffn_out<true>(HB, (const bf16_t*)(ws + WS_W2OUT), X2 + (size_t)MPR * DM, X3 + (size_t)MPR * DM, nullptr, bx, wid, lane & 15, lane >> 4);
        pg8::Gemm g{HB, (const bf16_t*)(ws + WS_W2OUT), MPR, DM, DFF, DFF}; pg8::StaticOrder S; S.init(MPR, DM, G, bx);
        EpiResid<false, true, false, false, true> E{X2, X2 + (size_t)MPR * DM, X3, nullptr, nullptr}; pg8::gemm_phase<EpiResid<false, true, false, false, true>, pg8::StaticOrder, GEMM_ALIGN, GEMM_SP2>(lds, g, S, E);
    }
    SEAM(9);
    if (IN(10)) {
        const float* gf = p.in[20]; f32x4 gv[4];
#pragma unroll
        for (int j = 0; j < 4; ++j) gv[j] = *((const f32x4*)gf + lane + 64 * j);
        {
            f32x4 v[4], vn[4]; int m = bx * 8 + wid;
            if (m < MREAL) { const f32x4* xr = (const f32x4*)(X3 + (size_t)m * DM) + lane;
#pragma unroll
                for (int j = 0; j < 4; ++j) v[j] = xr[64 * j]; }
            for (; m < MREAL; m += G * 8) {
                const int mn = m + G * 8;
                if (mn < MREAL) { const f32x4* xr = (const f32x4*)(X3 + (size_t)mn * DM) + lane;
#pragma unroll
                    for (int j = 0; j < 4; ++j) vn[j] = xr[64 * j]; }
                float s = 0.f;
#pragma unroll
                for (int j = 0; j < 4; ++j) s += (v[j][0] * v[j][0] + v[j][1] * v[j][1]) + (v[j][2] * v[j][2] + v[j][3] * v[j][3]);
                const float rstd = rsqrtf(wave_sum(s) * (1.0f / DM) + EPS);
                f32x4* yr = (f32x4*)(Y + (size_t)m * DM) + lane;
#pragma unroll
                for (int j = 0; j < 4; ++j) yr[64 * j] = v[j] * rstd * gv[j];
#pragma unroll
                for (int j = 0; j < 4; ++j) v[j] = vn[j];
            }
        }
    }
#undef IN
#undef SEAM
}
}

#ifndef MK_N_LAUNCHES
#define MK_N_LAUNCHES 1
#endif
extern "C" void kernel_launch(void* const* d_in, const int* in_sizes, int n_in, void* d_out, int out_size, void* d_ws, size_t ws_size, hipStream_t stream) {
    static int grid = 0;
    if (grid == 0) {
        if (n_in != 21 || ws_size < mk::WS_END || out_size != 47269888) { fprintf(stderr, "kernel_launch: unexpected shapes (n_in %d, ws %zu, out %d)\n", n_in, ws_size, out_size); grid = -1; return; }
        int dev = 0, cus = 0, per_cu = 0;
        (void)hipGetDevice(&dev); (void)hipDeviceGetAttribute(&cus, hipDeviceAttributeMultiprocessorCount, dev);
        if (hipFuncSetAttribute((const void*)mk::fwd_kernel, hipFuncAttributeMaxDynamicSharedMemorySize, mk::LDS_BYTES) != hipSuccess) { fprintf(stderr, "kernel_launch: hipFuncSetAttribute failed\n"); grid = -1; return; }
        if (hipOccupancyMaxActiveBlocksPerMultiprocessor(&per_cu, (const void*)mk::fwd_kernel, 512, mk::LDS_BYTES) != hipSuccess || per_cu < 1) { fprintf(stderr, "kernel_launch: occupancy query failed (%d)\n", per_cu); per_cu = 1; }
        (void)hipGetLastError();
        grid = cus * per_cu;
        if (grid <= mk::NSCAN) { fprintf(stderr, "kernel_launch: grid %d too small\n", grid); grid = -1; return; }
    }
    if (grid < 0) return;
    (void)hipMemsetAsync((char*)d_ws + mk::WS_CTL + mk::CTL_BAR, 0, mk::CTL_BAR_BYTES, stream);
    mk::Params p{};
    for (int i = 0; i < 21; ++i) p.in[i] = (const float*)d_in[i];
    p.out = (float*)d_out; p.ws = (unsigned char*)d_ws;
#if MK_N_LAUNCHES == 1
    int lo = 0, hi = 11; void* args[] = {&p, &lo, &hi};
    hipError_t e = hipLaunchCooperativeKernel((const void*)mk::fwd_kernel, dim3(grid), dim3(512), args, mk::LDS_BYTES, stream);
    if (e != hipSuccess) fprintf(stderr, "kernel_launch: cooperative launch failed: %s (grid %d)\n", hipGetErrorString(e), grid);
#else
#ifndef MK_LAST
#define MK_LAST 11
#ifndef MK_DOUBLE
#define MK_DOUBLE 0x0
#endif
#define DBG_C0 512
#define DBG_C1 1024
#endif
    for (int ph = 0; ph < MK_LAST; ++ph) { const int reps = ((MK_DOUBLE >> ph) & 1) ? 2 : 1; for (int r = 0; r < reps; ++r) hipLaunchKernelGGL(mk::fwd_kernel, dim3(grid), dim3(512), mk::LDS_BYTES, stream, p, ph, ph + 1); }
#ifdef DBG_DUMP
    hipLaunchKernelGGL(mk::fwd_kernel, dim3(grid), dim3(512), mk::LDS_BYTES, stream, p, 11, 12);
#endif
#endif
}
```

```cpp
#include <hip/hip_runtime.h>
#include <hip/hip_cooperative_groups.h>
#include <cstdio>
namespace cg = cooperative_groups;
namespace pg8 {
#define PG8_LAS __attribute__((address_space(3)))
typedef unsigned short bf16_t;
typedef short bf16x8 __attribute__((ext_vector_type(8)));
typedef float f32x4 __attribute__((ext_vector_type(4)));
typedef unsigned u32x4 __attribute__((ext_vector_type(4)));
constexpr int BM = 256, BK = 64, HALF = 128, HTB = HALF * BK * 2  , STAGE_BYTES = 8 * HTB, NXCD = 8, WGM = 4;

__host__ __device__ __forceinline__ int lds_byte(int r, int c) { const int st = (r >> 4) * 2 + (c >> 5), rr = r & 15, cc = c & 31, ob = rr * 64 + cc * 2; return st * 1024 + (ob ^ (((ob >> 9) & 1) << 5)); }
__host__ __device__ __forceinline__ void stage_rc(int b, int& R, int& C) { const int st = b / 1024, sb = b % 1024, swz = sb ^ (((sb >> 9) & 1) << 5); R = (st >> 1) * 16 + swz / 64; C = (st & 1) * 32 + (swz % 64) / 2; }
__host__ __device__ __forceinline__ int perm32(int rho) { const int n = rho >> 4, i = rho & 15; return 8 * (i >> 2) + 4 * n + (i & 3); }

struct Unit { int pm, pn; };
struct Gemm { const bf16_t* A; const bf16_t* Bt; int M, N, K, lda; };

struct StaticOrder {
    int nM, nN, nwg, G, c, wgm;
    __host__ __device__ void init(int M, int N, int G_, int c_, int wgm_ = WGM) { nM = M / BM; nN = N / BM; nwg = nM * nN; G = G_; c = c_; wgm = wgm_; }
    __host__ __device__ bool next(int i, Unit& u) const {
        const long L = (long)i * G + c; if (L >= nwg) return false;
        int wgid = (int)L; { const int q = nwg / NXCD, r = nwg % NXCD, xcd = wgid % NXCD, off = wgid / NXCD; wgid = (xcd < r ? xcd * (q + 1) : r * (q + 1) + (xcd - r) * q) + off; }
        const int nig = wgm * nN, gid = wgid / nig, fm = gid * wgm, gsz = (nM - fm) < wgm ? (nM - fm) : wgm;
        u.pm = fm + ((wgid % nig) % gsz); u.pn = (wgid % nig) / gsz; return true;
    }
    __device__ __forceinline__ void a_ready(const Unit&) const {}
    __device__ __forceinline__ void done(const Unit&) const {}
};

__device__ __forceinline__ unsigned cvt_pk_bf16(float lo, float hi) { unsigned r; asm volatile("v_cvt_pk_bf16_f32 %0, %1, %2" : "=v"(r) : "v"(lo), "v"(hi)); return r; }
typedef float f32x2 __attribute__((ext_vector_type(2)));
__device__ __forceinline__ f32x2 gelu_pk(f32x2 v) {
    const f32x2 av = __builtin_elementwise_abs(v), d = av * 0.2316418882f + 1.0f;
    f32x2 t; t.x = __builtin_amdgcn_rcpf(d.x); t.y = __builtin_amdgcn_rcpf(d.y);
    f32x2 q = t * 0.5307027145f + (-0.7265760135f); q = q * t + 0.7107068705f; q = q * t + (-0.142248368f); q = q * t + 0.127414796f; q = q * t;
    const f32x2 s = (v * v) * (-0.72134752044f);
    f32x2 e; e.x = __builtin_amdgcn_exp2f(s.x); e.y = __builtin_amdgcn_exp2f(s.y);
    const f32x2 m = v * (q * e), r = v - m;
    f32x2 o; o.x = v.x < 0.f ? m.x : r.x; o.y = v.y < 0.f ? m.y : r.y; return o;
}

template <int ACT  > struct EpiBf16 {
    static constexpr bool PERM = true, AFTER_DRAIN = false; static_assert(ACT == 0 || ACT == 1, "EpiBf16: ACT is 0 (none) or 1 (gelu_pk)");
    bf16_t* O; int ldc; const float* bias; int split_cols; size_t split_stride; float scale0;
    __device__ __forceinline__ void operator()(const f32x4 (&acc)[2][2][4][2], const Unit& u, int wr, int wc, int fr, int fq) const {
        const int row0 = u.pm * BM + wr * 64 + fr; int colt = u.pn * BM; bf16_t* base = O;
        float sc = 1.f; if (split_cols) { const int t = colt / split_cols; base += (size_t)t * split_stride; colt -= t * split_cols; if (t == 0) sc = scale0; }
        const int col0 = colt + wc * 32 + 8 * fq, bcol0 = u.pn * BM + wc * 32 + 8 * fq;
        f32x4 bv[2][2];
#pragma unroll
        for (int bj = 0; bj < 2; ++bj)
#pragma unroll
            for (int n = 0; n < 2; ++n) bv[bj][n] = bias ? *(const f32x4*)(bias + bcol0 + bj * HALF + 4 * n) : (f32x4){0.f, 0.f, 0.f, 0.f};
#pragma unroll
        for (int ai = 0; ai < 2; ++ai)
#pragma unroll
            for (int m = 0; m < 4; ++m) { bf16_t* rowp = base + (size_t)(row0 + ai * HALF + m * 16) * ldc + col0;
#pragma unroll
                for (int bj = 0; bj < 2; ++bj) { f32x4 v0 = acc[ai][bj][m][0] + bv[bj][0], v1 = acc[ai][bj][m][1] + bv[bj][1];
                    if (ACT == 1) { f32x2 a = gelu_pk((f32x2){v0[0], v0[1]}), b = gelu_pk((f32x2){v0[2], v0[3]}), c = gelu_pk((f32x2){v1[0], v1[1]}), d = gelu_pk((f32x2){v1[2], v1[3]});
                        v0 = (f32x4){a.x, a.y, b.x, b.y}; v1 = (f32x4){c.x, c.y, d.x, d.y}; }
                    v0 = v0 * sc; v1 = v1 * sc; u32x4 w; w.x = cvt_pk_bf16(v0[0], v0[1]); w.y = cvt_pk_bf16(v0[2], v0[3]); w.z = cvt_pk_bf16(v1[0], v1[1]); w.w = cvt_pk_bf16(v1[2], v1[3]);
                    *(u32x4*)(rowp + bj * HALF) = w; } }
    }
};

struct PanelStats {
    unsigned* xbuf;
    unsigned* cnt;
    unsigned* tmo;
    int ntn; float eps;
    unsigned code;
    __device__ __forceinline__ bool run(const f32x4 (&v)[2][2][4][2], const Unit& u, int wr, int wc, int fr, int fq, PG8_LAS unsigned char* lds, int wid, int lane) const {
        typedef float f32x2v __attribute__((ext_vector_type(2)));
        PG8_LAS f32x2v* P = (PG8_LAS f32x2v*)lds;
        PG8_LAS f32x2v* S = (PG8_LAS f32x2v*)(lds + 8192);
        PG8_LAS unsigned* flag = (PG8_LAS unsigned*)(lds + 8192 + 2048);
#pragma unroll
        for (int ai = 0; ai < 2; ++ai)
#pragma unroll
            for (int m = 0; m < 4; ++m) {
                float s = 0.f;
#pragma unroll
                for (int bj = 0; bj < 2; ++bj)
#pragma unroll
                    for (int n = 0; n < 2; ++n) { const f32x4 x = v[ai][bj][m][n]; s += (x[0] + x[1]) + (x[2] + x[3]); }
                s += __shfl_xor(s, 16); s += __shfl_xor(s, 32);
                const float mw = s * (1.0f / 64.0f); float q = 0.f;
#pragma unroll
                for (int bj = 0; bj < 2; ++bj)
#pragma unroll
                    for (int n = 0; n < 2; ++n) { const f32x4 d = v[ai][bj][m][n] - mw; q += (d[0] * d[0] + d[1] * d[1]) + (d[2] * d[2] + d[3] * d[3]); }
                q += __shfl_xor(q, 16); q += __shfl_xor(q, 32);
                if (fq == 0) P[(ai * HALF + wr * 64 + m * 16 + fr) * 4 + wc] = (f32x2v){mw, q};
            }
        asm volatile("s_waitcnt lgkmcnt(0)" ::: "memory"); __builtin_amdgcn_s_barrier(); asm volatile("" ::: "memory");
#if defined(BROKEN_EXCHANGE_NO_WAIT)
#warning BROKEN CONTROL BUILD: the row-statistics exchange does not wait; results are wrong by design
        if (blockIdx.x >= 64) { const long long t0_ = clock64(); while (clock64() - t0_ < 60000) __builtin_amdgcn_s_sleep(8); }
#endif
        const int row = wid * 32 + (lane & 31);
        if (lane < 32) {
            const f32x2v a = P[row * 4 + 0], b = P[row * 4 + 1], c = P[row * 4 + 2], d = P[row * 4 + 3];
            const float mt = (a.x + b.x + c.x + d.x) * 0.25f;
            const float da = a.x - mt, db = b.x - mt, dc = c.x - mt, dd = d.x - mt;
            const float m2 = (a.y + b.y) + (c.y + d.y) + 64.0f * ((da * da + db * db) + (dc * dc + dd * dd));
            unsigned long long* slot = (unsigned long long*)xbuf + ((size_t)(u.pm * BM + row) * 4 + u.pn);
            __hip_atomic_store(slot, ((unsigned long long)__float_as_uint(m2) << 32) | __float_as_uint(mt), __ATOMIC_RELAXED, __HIP_MEMORY_SCOPE_AGENT);
        }
        asm volatile("s_waitcnt vmcnt(0)" ::: "memory");
        if (lane == 0) __hip_atomic_fetch_add(cnt + 64 * u.pm, 1u, __ATOMIC_RELAXED, __HIP_MEMORY_SCOPE_AGENT);
        if (wid == 0) {
            bool dead = false; const unsigned long long t0 = __builtin_amdgcn_s_memrealtime(); const unsigned want = 8u * (unsigned)ntn;
            for (;;) {
#if defined(BROKEN_EXCHANGE_NO_WAIT)
                break;
#endif
                if ((unsigned)__builtin_amdgcn_readfirstlane(__hip_atomic_load(cnt + 64 * u.pm, __ATOMIC_RELAXED, __HIP_MEMORY_SCOPE_AGENT)) >= want) break;
                if (__builtin_amdgcn_s_memrealtime() - t0 > 2000000ull) {
                    if (lane == 0) { unsigned expect = 0u; __hip_atomic_compare_exchange_strong(tmo + 1, &expect, code | (unsigned)(u.pm & 0xff), __ATOMIC_RELAXED, __ATOMIC_RELAXED, __HIP_MEMORY_SCOPE_AGENT);
                                     __hip_atomic_store(tmo, 1u, __ATOMIC_RELAXED, __HIP_MEMORY_SCOPE_AGENT); }
                    dead = true; break; }
                __builtin_amdgcn_s_sleep(2);
            }
            __builtin_amdgcn_fence(__ATOMIC_ACQUIRE, "agent");
            if (lane == 0) flag[0] = dead ? 1u : 0u;
        }
        asm volatile("s_waitcnt vmcnt(0) lgkmcnt(0)" ::: "memory"); __builtin_amdgcn_s_barrier(); asm volatile("" ::: "memory");
        const bool bad = flag[0] != 0u;
        if (lane < 32) {
            const unsigned long long* slot = (const unsigned long long*)xbuf + (size_t)(u.pm * BM + row) * 4; float mt[4], m2[4]; float ms = 0.f;
#pragma unroll
            for (int t = 0; t < 4; ++t) { if (t < ntn) { const unsigned long long w = __hip_atomic_load(slot + t, __ATOMIC_RELAXED, __HIP_MEMORY_SCOPE_AGENT); mt[t] = __uint_as_float((unsigned)w); m2[t] = __uint_as_float((unsigned)(w >> 32)); } else { mt[t] = 0.f; m2[t] = 0.f; } ms += mt[t]; }
            const float mean = ms / (float)ntn; float q = 0.f;
#pragma unroll
            for (int t = 0; t < 4; ++t) if (t < ntn) { const float dm = mt[t] - mean; q += m2[t] + 256.0f * dm * dm; }
            S[row] = (f32x2v){mean, 1.0f / sqrtf(q / (256.0f * (float)ntn) + eps)};
        }
        asm volatile("s_waitcnt lgkmcnt(0)" ::: "memory"); __builtin_amdgcn_s_barrier(); asm volatile("" ::: "memory");
        return bad;
    }
};
struct EpiLnRes {
    static constexpr bool PERM = false, AFTER_DRAIN = true;
    const float* base; float* out; int ldc; const float* bias; PanelStats st; unsigned poison;
    __device__ __forceinline__ void fused(f32x4 (&acc)[2][2][4][2], const Unit& u, int wr, int wc, int fr, int fq, PG8_LAS unsigned char* lds, int wid, int lane) const {
        typedef float f32x2v __attribute__((ext_vector_type(2)));
        const PG8_LAS f32x2v* S = (const PG8_LAS f32x2v*)(lds + 8192);
        const int col0 = u.pn * BM + wc * 32 + 4 * fq;
#pragma unroll
        for (int bj = 0; bj < 2; ++bj)
#pragma unroll
            for (int n = 0; n < 2; ++n) { const f32x4 bv = bias ? *(const f32x4*)(bias + col0 + bj * HALF + n * 16) : (f32x4){0.f, 0.f, 0.f, 0.f};
#pragma unroll
                for (int ai = 0; ai < 2; ++ai)
#pragma unroll
                    for (int m = 0; m < 4; ++m) acc[ai][bj][m][n] += bv; }
        f32x4 pre[4][2][2];
#pragma unroll
        for (int m = 0; m < 4; ++m) { const size_t off = (size_t)(u.pm * BM + wr * 64 + m * 16 + fr) * ldc + col0;
#pragma unroll
            for (int bj = 0; bj < 2; ++bj)
#pragma unroll
                for (int n = 0; n < 2; ++n) pre[m][bj][n] = *(const f32x4*)(base + off + bj * HALF + n * 16); }
        const bool bad = st.run(acc, u, wr, wc, fr, fq, lds, wid, lane) || poison != 0u;
        const float qnan = __builtin_nanf("");
#pragma unroll
        for (int ai = 0; ai < 2; ++ai)
#pragma unroll
            for (int m = 0; m < 4; ++m) { const int r = ai * HALF + wr * 64 + m * 16 + fr; const f32x2v sr = S[r]; const size_t off = (size_t)(u.pm * BM + r) * ldc + col0;
#pragma unroll
                for (int bj = 0; bj < 2; ++bj)
#pragma unroll
                    for (int n = 0; n < 2; ++n) { const f32x4 bs = ai == 0 ? pre[m][bj][n] : *(const f32x4*)(base + off + bj * HALF + n * 16); f32x4 o = bs + (acc[ai][bj][m][n] - sr.x) * sr.y;
                        if (bad) o = (f32x4){qnan, qnan, qnan, qnan}; *(f32x4*)(out + off + bj * HALF + n * 16) = o; }
                if (m & 1) asm volatile("" ::: "memory"); }
    }
};
struct EpiLnResLn {
    static constexpr bool PERM = false, AFTER_DRAIN = true;
    const float* base; float* out; bf16_t* xn; int ldc; const float* bias; PanelStats st1, st2; unsigned poison;
    __device__ __forceinline__ void fused(f32x4 (&acc)[2][2][4][2], const Unit& u, int wr, int wc, int fr, int fq, PG8_LAS unsigned char* lds, int wid, int lane) const {
        typedef float f32x2v __attribute__((ext_vector_type(2))); typedef unsigned u32x2v __attribute__((ext_vector_type(2)));
        const PG8_LAS f32x2v* S = (const PG8_LAS f32x2v*)(lds + 8192);
        const int col0 = u.pn * BM + wc * 32 + 4 * fq;
#pragma unroll
        for (int bj = 0; bj < 2; ++bj)
#pragma unroll
            for (int n = 0; n < 2; ++n) { const f32x4 bv = bias ? *(const f32x4*)(bias + col0 + bj * HALF + n * 16) : (f32x4){0.f, 0.f, 0.f, 0.f};
#pragma unroll
                for (int ai = 0; ai < 2; ++ai)
#pragma unroll
                    for (int m = 0; m < 4; ++m) acc[ai][bj][m][n] += bv; }
        bool bad = st1.run(acc, u, wr, wc, fr, fq, lds, wid, lane) || poison != 0u;
        const float qnan = __builtin_nanf("");
#pragma unroll
        for (int ai = 0; ai < 2; ++ai)
#pragma unroll
            for (int m = 0; m < 4; ++m) { const int r = ai * HALF + wr * 64 + m * 16 + fr; const f32x2v sr = S[r]; const size_t off = (size_t)(u.pm * BM + r) * ldc + col0;
#pragma unroll
                for (int bj = 0; bj < 2; ++bj)
#pragma unroll
                    for (int n = 0; n < 2; ++n) { const f32x4 bs = *(const f32x4*)(base + off + bj * HALF + n * 16); acc[ai][bj][m][n] = bs + (acc[ai][bj][m][n] - sr.x) * sr.y; }
                asm volatile("" : "+v"(acc[ai][0][m][0]), "+v"(acc[ai][0][m][1]), "+v"(acc[ai][1][m][0]), "+v"(acc[ai][1][m][1]));
                if (m & 1) asm volatile("" ::: "memory"); }
        const bool bad1 = bad;
        bad = st2.run(acc, u, wr, wc, fr, fq, lds, wid, lane) || bad;
#pragma unroll
        for (int ai = 0; ai < 2; ++ai)
#pragma unroll
            for (int m = 0; m < 4; ++m) { const int r = ai * HALF + wr * 64 + m * 16 + fr; const f32x2v sr = S[r]; const size_t off = (size_t)(u.pm * BM + r) * ldc + col0;
#pragma unroll
                for (int bj = 0; bj < 2; ++bj)
#pragma unroll
                    for (int n = 0; n < 2; ++n) { const f32x4 x1 = acc[ai][bj][m][n]; *(f32x4*)(out + off + bj * HALF + n * 16) = bad1 ? (f32x4){qnan, qnan, qnan, qnan} : x1;
                        const f32x4 o = (x1 - sr.x) * sr.y; u32x2v w; w.x = cvt_pk_bf16(o[0], o[1]); w.y = cvt_pk_bf16(o[2], o[3]);
                        if (bad) { w.x = 0x7fc07fc0u; w.y = 0x7fc07fc0u; } *(u32x2v*)(xn + off + bj * HALF + n * 16) = w; }
                asm volatile("" ::: "memory"); }
    }
};

template <class Epi, class Sched, bool ALIGN_EPI = false, bool SP2 = false>
__device__ __forceinline__ void gemm_phase(PG8_LAS unsigned char* lds, const Gemm g, const Sched S, const Epi E) {
    const int tid = threadIdx.x, wid = __builtin_amdgcn_readfirstlane(tid >> 6), lane = tid & 63, wr = wid >> 2, wc = wid & 3, fr = lane & 15, fq = lane >> 4;
    const int K = g.K, nt = K / BK;
    unsigned voffA[2], voffB[2];
#pragma unroll
    for (int i = 0; i < 2; ++i) { int R, C; stage_rc(tid * 16 + i * 8192, R, C); const int Rb = Epi::PERM ? ((R & ~31) + perm32(R & 31)) : R;
        voffA[i] = (unsigned)(R * g.lda + C) * 2u; voffB[i] = (unsigned)(Rb * K + C) * 2u; }
    const size_t kstep = (size_t)(BK * 2);
    const size_t hstep = (size_t)HALF * K * 2;
    const size_t tstep = 2 * hstep;
    const size_t hstepA = (size_t)HALF * g.lda * 2, tstepA = 2 * hstepA;
    const unsigned ldsw = (unsigned)wid * 1024u;
    const int aoff = lds_byte(wr * 64 + fr, fq * 8), boff = lds_byte(wc * 32 + fr, fq * 8);
#define PG8_SA(b, h) (((b) * 2 + (h)) * HTB)
#define PG8_SB(b, h) ((4 + (b) * 2 + (h)) * HTB)
#define PG8_STAGE(bufoff, gbase, voff) do { _Pragma("unroll") for (int _i = 0; _i < 2; ++_i) \
        __builtin_amdgcn_global_load_lds((const unsigned*)((const char*)(gbase) + (voff)[_i]), (PG8_LAS unsigned*)(lds + (bufoff) + ldsw + _i * 8192), 16, 0, 0); } while (0)
#define PG8_LDA(dst, b, h) do { _Pragma("unroll") for (int m = 0; m < 4; ++m) _Pragma("unroll") for (int k = 0; k < 2; ++k) dst[m][k] = *(const PG8_LAS bf16x8*)(lds + PG8_SA(b, h) + aoff + m * 2048 + k * 1024); } while (0)
#define PG8_LDB(dst, b, h) do { _Pragma("unroll") for (int n = 0; n < 2; ++n) _Pragma("unroll") for (int k = 0; k < 2; ++k) dst[n][k] = *(const PG8_LAS bf16x8*)(lds + PG8_SB(b, h) + boff + n * 2048 + k * 1024); } while (0)
#define PG8_MMA(ai, bj, At, Bt) do { __builtin_amdgcn_s_setprio(1); _Pragma("unroll") for (int m = 0; m < 4; ++m) _Pragma("unroll") for (int n = 0; n < 2; ++n) _Pragma("unroll") for (int k = 0; k < 2; ++k) \
        acc[ai][bj][m][n] = __builtin_amdgcn_mfma_f32_16x16x32_bf16(Bt[n][k], At[m][k], acc[ai][bj][m][n], 0, 0, 0); __builtin_amdgcn_s_setprio(0); } while (0)
#define PG8_WAIT_V(n) asm volatile("s_waitcnt vmcnt(" #n ")" ::: "memory")
#define PG8_WAIT_L(n) asm volatile("s_waitcnt lgkmcnt(" #n ")" ::: "memory")
#define PG8_BAR __builtin_amdgcn_s_barrier()
#define PG8_SCHED __builtin_amdgcn_sched_barrier(0)
    Unit cur, nxt; int ui = 0;
    if (!S.next(0, cur)) return;
    f32x4 acc[2][2][4][2];
#pragma unroll
    for (int a = 0; a < 2; ++a)
#pragma unroll
        for (int b = 0; b < 2; ++b)
#pragma unroll
            for (int m = 0; m < 4; ++m)
#pragma unroll
                for (int n = 0; n < 2; ++n) acc[a][b][m][n] = (f32x4){0.f, 0.f, 0.f, 0.f};
    bf16x8 At[4][2], B0[2][2], B1[2][2];
    const char* cA = (const char*)g.A + (size_t)cur.pm * tstepA; const char* cB = (const char*)g.Bt + (size_t)cur.pn * tstep;
    S.a_ready(cur);
    if constexpr (SP2) {
        PG8_STAGE(PG8_SB(0, 0), cB, voffB); PG8_STAGE(PG8_SB(0, 1), cB + hstep, voffB); PG8_STAGE(PG8_SA(0, 0), cA, voffA); PG8_STAGE(PG8_SA(0, 1), cA + hstepA, voffA);
        if (wr == 1) PG8_BAR;
        PG8_WAIT_V(2); PG8_BAR;
        PG8_STAGE(PG8_SB(1, 0), cB + kstep, voffB); PG8_STAGE(PG8_SA(1, 0), cA + kstep, voffA); PG8_STAGE(PG8_SB(1, 1), cB + hstep + kstep, voffB);
        PG8_WAIT_V(6); PG8_BAR;
    } else {
        PG8_STAGE(PG8_SB(0, 0), cB, voffB); PG8_STAGE(PG8_SA(0, 0), cA, voffA); PG8_STAGE(PG8_SB(0, 1), cB + hstep, voffB); PG8_STAGE(PG8_SA(0, 1), cA + hstepA, voffA);
        if (wr == 1) PG8_BAR;
        PG8_WAIT_V(4); PG8_BAR;
        PG8_STAGE(PG8_SB(1, 0), cB + kstep, voffB); PG8_STAGE(PG8_SA(1, 0), cA + kstep, voffA); PG8_STAGE(PG8_SB(1, 1), cB + hstep + kstep, voffB);
        PG8_WAIT_V(6); PG8_BAR;
    }
    for (;;) {
        const bool has_next = S.next(ui + 1, nxt);
        const char* nA = has_next ? (const char*)g.A + (size_t)nxt.pm * tstepA : cA; const char* nB = has_next ? (const char*)g.Bt + (size_t)nxt.pn * tstep : cB;
        for (int t = 0; t < nt; t += 2) {
            const bool last = (t == nt - 2);
            const char* a1 = cA + (size_t)(t + 1) * kstep;
            const char* a2 = last ? nA : cA + (size_t)(t + 2) * kstep; const char* b2 = last ? nB : cB + (size_t)(t + 2) * kstep;
            const char* a3 = a2 + kstep; const char* b3 = b2 + kstep;
            if (last && has_next) S.a_ready(nxt);
            if constexpr (SP2) {
            PG8_LDB(B0, 0, 0); PG8_LDB(B1, 0, 1); PG8_SCHED; PG8_LDA(At, 0, 0); PG8_STAGE(PG8_SA(1, 1), a1 + hstepA, voffA);
            PG8_WAIT_V(8); PG8_WAIT_L(0); PG8_BAR; PG8_MMA(0, 0, At, B0); PG8_MMA(0, 1, At, B1); PG8_BAR; PG8_SCHED;
            PG8_LDA(At, 0, 1); PG8_STAGE(PG8_SB(0, 0), b2, voffB); PG8_STAGE(PG8_SB(0, 1), b2 + hstep, voffB); PG8_STAGE(PG8_SA(0, 0), a2, voffA);
            PG8_WAIT_V(8); PG8_WAIT_L(0); PG8_BAR; PG8_MMA(1, 0, At, B0); PG8_MMA(1, 1, At, B1); PG8_BAR; PG8_SCHED;
            PG8_LDB(B0, 1, 0); PG8_LDB(B1, 1, 1); PG8_SCHED; PG8_LDA(At, 1, 0); PG8_STAGE(PG8_SA(0, 1), a2 + hstepA, voffA);
            PG8_WAIT_V(8); PG8_WAIT_L(0); PG8_BAR; PG8_MMA(0, 0, At, B0); PG8_MMA(0, 1, At, B1); PG8_BAR; PG8_SCHED;
            PG8_LDA(At, 1, 1); PG8_STAGE(PG8_SB(1, 0), b3, voffB); PG8_STAGE(PG8_SB(1, 1), b3 + hstep, voffB); PG8_STAGE(PG8_SA(1, 0), a3, voffA);
            PG8_WAIT_V(8); PG8_WAIT_L(0); PG8_BAR; PG8_MMA(1, 0, At, B0); PG8_MMA(1, 1, At, B1); PG8_BAR; PG8_SCHED;
            } else {
            PG8_LDB(B0, 0, 0); PG8_SCHED; PG8_LDA(At, 0, 0); PG8_STAGE(PG8_SA(1, 1), a1 + hstepA, voffA);
            PG8_WAIT_L(8); PG8_BAR; PG8_WAIT_L(0); PG8_MMA(0, 0, At, B0); PG8_BAR; PG8_SCHED;
            PG8_LDB(B1, 0, 1); PG8_STAGE(PG8_SB(0, 0), b2, voffB);
            PG8_BAR; PG8_WAIT_L(0); PG8_MMA(0, 1, At, B1); PG8_BAR;
            PG8_LDA(At, 0, 1); PG8_STAGE(PG8_SA(0, 0), a2, voffA);
            PG8_BAR; PG8_WAIT_L(0); PG8_MMA(1, 0, At, B0); PG8_BAR; PG8_SCHED;
            PG8_STAGE(PG8_SB(0, 1), b2 + hstep, voffB);
            PG8_WAIT_V(6); PG8_BAR; PG8_MMA(1, 1, At, B1); PG8_BAR;
            PG8_LDB(B0, 1, 0); PG8_SCHED; PG8_LDA(At, 1, 0); PG8_STAGE(PG8_SA(0, 1), a2 + hstepA, voffA);
            PG8_WAIT_L(8); PG8_BAR; PG8_WAIT_L(0); PG8_MMA(0, 0, At, B0); PG8_BAR; PG8_SCHED;
            PG8_LDB(B1, 1, 1); PG8_STAGE(PG8_SB(1, 0), b3, voffB);
            PG8_BAR; PG8_WAIT_L(0); PG8_MMA(0, 1, At, B1); PG8_BAR;
            PG8_LDA(At, 1, 1); PG8_STAGE(PG8_SA(1, 0), a3, voffA);
            PG8_BAR; PG8_WAIT_L(0); PG8_MMA(1, 0, At, B0); PG8_BAR; PG8_SCHED;
            PG8_STAGE(PG8_SB(1, 1), b3 + hstep, voffB);
            PG8_WAIT_V(6); PG8_BAR; PG8_MMA(1, 1, At, B1); PG8_BAR;
            }
        }
        if constexpr (ALIGN_EPI) { if (wr == 0) PG8_BAR; }
        if constexpr (!Epi::AFTER_DRAIN) { E(acc, cur, wr, wc, fr, fq); S.done(cur); }
        if (!has_next) break;
#pragma unroll
        for (int a = 0; a < 2; ++a)
#pragma unroll
            for (int b = 0; b < 2; ++b)
#pragma unroll
                for (int m = 0; m < 4; ++m)
#pragma unroll
                    for (int n = 0; n < 2; ++n) acc[a][b][m][n] = (f32x4){0.f, 0.f, 0.f, 0.f};
        cur = nxt; cA = nA; cB = nB; ++ui;
        if constexpr (ALIGN_EPI) { if (wr == 1) PG8_BAR; }
    }
    PG8_WAIT_V(0);
    if constexpr (!ALIGN_EPI) { if (wr == 0) PG8_BAR; }
    PG8_BAR;
    if constexpr (Epi::AFTER_DRAIN) { E.fused(acc, cur, wr, wc, fr, fq, lds, wid, lane); S.done(cur); }
#undef PG8_SA
#undef PG8_SB
#undef PG8_STAGE
#undef PG8_LDA
#undef PG8_LDB
#undef PG8_MMA
#undef PG8_WAIT_V
#undef PG8_WAIT_L
#undef PG8_BAR
#undef PG8_SCHED
}
}

#ifndef GEMM_SP2
#define GEMM_SP2 true
#endif
#ifndef GEMM_ALIGN
#define GEMM_ALIGN true
#endif
namespace mk {
#define LAS __attribute__((address_space(3)))
using pg8::bf16_t; using pg8::bf16x8; using pg8::f32x4; using pg8::u32x4;
typedef unsigned u32x2 __attribute__((ext_vector_type(2)));

constexpr int DM = 1024, SEQ = 8192, NBATCH = 4, MPR = NBATCH * SEQ, MSAMP = 128, MREAL = MPR + MSAMP, MPAD = 33024;
constexpr int DFF = 2816, PW = 2816, NINP = 3072, CONVC = 1536;
constexpr float EPS = 1e-6f;
#ifndef SCAN_CW
#define SCAN_CW 2
#endif
constexpr int CW = SCAN_CW, NSCAN = 128 / CW;
constexpr int LDS_PHASE_BYTES = 155648, LDS_BYTES = LDS_PHASE_BYTES + 256;

constexpr size_t O_YP = 0, O_YS = 33554432, O_KP = 33685504, O_VP = 33751040, O_CP = 33816576, O_GP = 33835008,
                 O_KS = 34097152, O_VS = 36194304, O_CS = 38291456, O_GS = 38881280;
constexpr size_t MiB = 1u << 20;
constexpr size_t WS_CTL = 0, CTL_ZERO_BYTES = 1 * MiB;
constexpr size_t WS_W1IN = 1 * MiB, WS_W1OUT = 12 * MiB, WS_WINMIX = 18 * MiB, WS_WOUTMIX = 24 * MiB, WS_W2IN = 26 * MiB, WS_W2OUT = 37 * MiB;
constexpr size_t WS_GBA = 43 * MiB, WS_XN = 45 * MiB, WS_XN2 = 110 * MiB, WS_H = 175 * MiB, WS_GM = 353 * MiB, WS_GN = 417 * MiB;
constexpr size_t WS_GQ = 110 * MiB, WS_GO = 142 * MiB;
constexpr size_t WS_SSP1 = 481 * MiB, WS_SSP2 = 484 * MiB;
constexpr size_t WS_END = 487 * MiB;
constexpr size_t CTL_BAR = 0, CTL_BAR_BYTES = 16384, CTL_GLAST = 768 * 1024;

struct Params { const float* in[21]; float* out; unsigned char* ws; };

typedef float f32x2v __attribute__((ext_vector_type(2)));
typedef __bf16 bf16x2v __attribute__((ext_vector_type(2)));
__device__ __forceinline__ unsigned cvt_pk(float lo, float hi) { const f32x2v v = {lo, hi}; const bf16x2v b = __builtin_convertvector(v, bf16x2v); return __builtin_bit_cast(unsigned, b); }
__device__ __forceinline__ bf16_t f2bf(float f) { return (bf16_t)(cvt_pk(f, 0.f) & 0xffffu); }
__device__ __forceinline__ float bf2f(bf16_t h) { return __uint_as_float(((unsigned)h) << 16); }
__device__ __forceinline__ float bflo(unsigned w) { return __uint_as_float(w << 16); }
__device__ __forceinline__ float bfhi(unsigned w) { return __uint_as_float(w & 0xffff0000u); }
__device__ __forceinline__ float silu(float x) { return x * __builtin_amdgcn_rcpf(1.0f + __expf(-x)); }
__device__ __forceinline__ float wave_sum(float v) {
#pragma unroll
    for (int o = 1; o < 64; o <<= 1) v += __shfl_xor(v, o);
    return v;
}
__device__ __forceinline__ float wave_max(float v) {
#pragma unroll
    for (int o = 1; o < 64; o <<= 1) v = fmaxf(v, __shfl_xor(v, o));
    return v;
}
__device__ __forceinline__ f32x4 mfma16(bf16x8 a, bf16x8 b, f32x4 c) { return __builtin_amdgcn_mfma_f32_16x16x32_bf16(a, b, c, 0, 0, 0); }

__device__ __forceinline__ float row_rstd(const float* ssp, int r) {
    if (r >= MREAL) return 0.f;
    const f32x4 a = *(const f32x4*)(ssp + (size_t)r * 16), b = *(const f32x4*)(ssp + (size_t)r * 16 + 4), c = *(const f32x4*)(ssp + (size_t)r * 16 + 8), d = *(const f32x4*)(ssp + (size_t)r * 16 + 12);
    const float s = (((a[0] + a[1]) + (a[2] + a[3])) + ((b[0] + b[1]) + (b[2] + b[3]))) + (((c[0] + c[1]) + (c[2] + c[3])) + ((d[0] + d[1]) + (d[2] + d[3])));
    return rsqrtf(s * (1.0f / DM) + EPS);
}
struct EpiSwiglu {
    static constexpr bool PERM = true, AFTER_DRAIN = false;
    bf16_t* H; const float* ss;
    __device__ __forceinline__ void operator()(const f32x4 (&acc)[2][2][4][2], const pg8::Unit& u, int wr, int wc, int fr, int fq) const {
        const int row0 = u.pm * 256 + wr * 64 + fr, col0 = u.pn * 128 + wc * 32 + 8 * fq;
#pragma unroll
        for (int ai = 0; ai < 2; ++ai)
#pragma unroll
            for (int m = 0; m < 4; ++m) {
                const int r = row0 + ai * 128 + m * 16;
                const float rs = ss ? row_rstd(ss, r) : 1.0f;
                float h[8];
#pragma unroll
                for (int n = 0; n < 2; ++n)
#pragma unroll
                    for (int j = 0; j < 4; ++j) h[n * 4 + j] = silu(acc[ai][0][m][n][j] * rs) * (acc[ai][1][m][n][j] * rs);
                u32x4 w; w.x = cvt_pk(h[0], h[1]); w.y = cvt_pk(h[2], h[3]); w.z = cvt_pk(h[4], h[5]); w.w = cvt_pk(h[6], h[7]);
                *(u32x4*)(H + (size_t)r * DFF + col0) = w;
            }
    }
};
template <bool RESB16, bool WF32, bool WB16, bool SUMSQ, bool HALF> struct EpiResid {
    static constexpr bool PERM = true, AFTER_DRAIN = false;
    const void* resP; const void* resS; float* Yo; bf16_t* XBo; float* sso;
    __device__ __forceinline__ void operator()(const f32x4 (&acc)[2][2][4][2], const pg8::Unit& u, int wr, int wc, int fr, int fq) const {
        const int row0 = u.pm * 256 + wr * 64 + fr, col0 = u.pn * 256 + wc * 32 + 8 * fq;
        const char* const rP = (const char*)resP; const char* const rS = (const char*)resS - (size_t)MPR * DM * (RESB16 ? 2 : 4);
        float* const Y = Yo; const float scale = HALF ? 0.5f : 1.0f; bf16_t* const XB = XBo; float* const ss = sso;
#pragma unroll
        for (int ai = 0; ai < 2; ++ai)
#pragma unroll
            for (int m = 0; m < 4; ++m) {
                const int r = row0 + ai * 128 + m * 16; float s = 0.f;
                if (r < MREAL) {
                    const char* rp = ((r < MPR) ? rP : rS) + (size_t)r * DM * (RESB16 ? 2 : 4);
#pragma unroll
                    for (int bj = 0; bj < 2; ++bj) {
                        const int c = col0 + bj * 128;
                        f32x4 r0, r1;
                        if (RESB16) { const u32x4 w = *(const u32x4*)(rp + (size_t)c * 2); r0 = (f32x4){bflo(w.x), bfhi(w.x), bflo(w.y), bfhi(w.y)}; r1 = (f32x4){bflo(w.z), bfhi(w.z), bflo(w.w), bfhi(w.w)}; }
                        else { r0 = *(const f32x4*)(rp + (size_t)c * 4); r1 = *(const f32x4*)(rp + (size_t)c * 4 + 16); }
                        const f32x4 v0 = r0 + acc[ai][bj][m][0] * scale, v1 = r1 + acc[ai][bj][m][1] * scale;
                        if (WF32) { *(f32x4*)(Y + (size_t)r * DM + c) = v0; *(f32x4*)(Y + (size_t)r * DM + c + 4) = v1; }
                        if (WB16) { u32x4 w; w.x = cvt_pk(v0[0], v0[1]); w.y = cvt_pk(v0[2], v0[3]); w.z = cvt_pk(v1[0], v1[1]); w.w = cvt_pk(v1[2], v1[3]);
                            *(u32x4*)(XB + (size_t)r * DM + c) = w; }
                        if (SUMSQ) s += (v0[0] * v0[0] + v0[1] * v0[1]) + (v0[2] * v0[2] + v0[3] * v0[3]) + (v1[0] * v1[0] + v1[1] * v1[1]) + (v1[2] * v1[2] + v1[3] * v1[3]);
                    }
                }
                if (SUMSQ) { s += __shfl_xor(s, 16); s += __shfl_xor(s, 32); if (fq == 0 && r < MREAL) ss[(size_t)r * 16 + u.pn * 4 + wc] = s; }
            }
    }
};
struct EpiInproj {
    static constexpr bool PERM = true, AFTER_DRAIN = false;
    bf16_t* P; float* gba; const float* ss;
    __device__ __forceinline__ void operator()(const f32x4 (&acc)[2][2][4][2], const pg8::Unit& u, int wr, int wc, int fr, int fq) const {
        const int row0 = u.pm * 256 + wr * 64 + fr, col0 = u.pn * 256 + wc * 32 + 8 * fq;
#pragma unroll
        for (int ai = 0; ai < 2; ++ai)
#pragma unroll
            for (int m = 0; m < 4; ++m) {
                const int r = row0 + ai * 128 + m * 16;
                const float rs = row_rstd(ss, r);
                if (u.pn < 11) {
#pragma unroll
                    for (int bj = 0; bj < 2; ++bj) { const f32x4 v0 = acc[ai][bj][m][0] * rs, v1 = acc[ai][bj][m][1] * rs;
                        u32x4 w; w.x = cvt_pk(v0[0], v0[1]); w.y = cvt_pk(v0[2], v0[3]); w.z = cvt_pk(v1[0], v1[1]); w.w = cvt_pk(v1[2], v1[3]);
                        *(u32x4*)(P + (size_t)r * PW + col0 + bj * 128) = w; }
                } else if (wc == 0 && fq == 0) {
                    *(f32x4*)(gba + (size_t)r * 8) = acc[ai][0][m][0] * rs; *(f32x4*)(gba + (size_t)r * 8 + 4) = acc[ai][0][m][1] * rs;
                }
            }
    }
};


template <int NT, bool SS>
__device__ __forceinline__ void skinny_mm(const bf16_t* A, int lda, const bf16_t* W, int K, int wrow0, int wrow1, int wid, int fr, int fq, f32x4 (&acc)[NT], float& ss) {
    const bf16_t* ap = A + (size_t)(16 * wid + fr) * lda + 8 * fq;
    const bf16_t* w0 = W + (size_t)(wrow0 + fr) * K + 8 * fq; const bf16_t* w1 = W + (size_t)(wrow1 + fr) * K + 8 * fq;
#pragma unroll
    for (int nt = 0; nt < NT; ++nt) acc[nt] = (f32x4){0.f, 0.f, 0.f, 0.f};
    float s = 0.f;
#pragma unroll 8
    for (int ks = 0; ks < K / 32; ++ks) {
        const bf16x8 a = *(const bf16x8*)(ap + 32 * ks);
        acc[0] = mfma16(*(const bf16x8*)(w0 + 32 * ks), a, acc[0]);
        if (NT == 2) acc[NT - 1] = mfma16(*(const bf16x8*)(w1 + 32 * ks), a, acc[NT - 1]);
        if (SS) { const u32x4 u = __builtin_bit_cast(u32x4, a);
#pragma unroll
            for (int k = 0; k < 4; ++k) { const float lo = bflo(u[k]), hi = bfhi(u[k]); s += lo * lo + hi * hi; } }
    }
    if (SS) { s += __shfl_xor(s, 16); s += __shfl_xor(s, 32); }
    ss = s;
}
template <bool SS> __device__ __forceinline__ void sk_ffn_in(const bf16_t* X, const bf16_t* Wt, bf16_t* H, int slab, int wid, int fr, int fq) {
    const int j0 = 16 * slab, wr0 = (j0 >> 7) * 256 + (j0 & 127);
    f32x4 acc[2]; float ss;
    skinny_mm<2, SS>(X + (size_t)MPR * DM, DM, Wt, DM, wr0, wr0 + 128, wid, fr, fq, acc, ss);
    const float rs = SS ? rsqrtf(ss * (1.0f / DM) + EPS) : 1.0f;
    float h[4];
#pragma unroll
    for (int e = 0; e < 4; ++e) h[e] = silu(acc[0][e] * rs) * (acc[1][e] * rs);
    u32x2 w; w.x = cvt_pk(h[0], h[1]); w.y = cvt_pk(h[2], h[3]);
    *(u32x2*)(H + (size_t)(MPR + 16 * wid + fr) * DFF + j0 + 4 * fq) = w;
}
template <bool OUTF32> __device__ __forceinline__ void sk_ffn_out(const bf16_t* Hb, const bf16_t* Wt, const float* resf, float* outf, bf16_t* outb, int slab, int wid, int fr, int fq) {
    f32x4 acc[1]; float ss;
    skinny_mm<1, false>(Hb + (size_t)MPR * DFF, DFF, Wt, DFF, 16 * slab, 0, wid, fr, fq, acc, ss);
    const int rl = 16 * wid + fr, c = 16 * slab + 4 * fq;
    const f32x4 v = *(const f32x4*)(resf + (size_t)rl * DM + c) + acc[0] * 0.5f;
    if (OUTF32) *(f32x4*)(outf + (size_t)rl * DM + c) = v;
    else { u32x2 w; w.x = cvt_pk(v[0], v[1]); w.y = cvt_pk(v[2], v[3]); *(u32x2*)(outb + (size_t)rl * DM + c) = w; }
}
__device__ __forceinline__ void sk_inproj(const bf16_t* X, const bf16_t* Wt, bf16_t* P, float* gba, int slab, int wid, int fr, int fq) {
    const int n0 = 32 * slab; f32x4 acc[2]; float ss;
    skinny_mm<2, true>(X + (size_t)MPR * DM, DM, Wt, DM, n0, n0 + 16, wid, fr, fq, acc, ss);
    const float rs = rsqrtf(ss * (1.0f / DM) + EPS); const int r = MPR + 16 * wid + fr;
    if (n0 < PW) {
#pragma unroll
        for (int nt = 0; nt < 2; ++nt) { const f32x4 v = acc[nt] * rs; u32x2 w; w.x = cvt_pk(v[0], v[1]); w.y = cvt_pk(v[2], v[3]); *(u32x2*)(P + (size_t)r * PW + n0 + 16 * nt + 4 * fq) = w; }
    } else if (fq < 2) *(f32x4*)(gba + (size_t)r * 8 + 4 * fq) = acc[0] * rs;
}
__device__ __forceinline__ void sk_outproj(const bf16_t* Pm, const bf16_t* Wt, const bf16_t* X1b, float* X2f, bf16_t* X2b, int slab, int wid, int fr, int fq) {
    const int n0 = 32 * slab; f32x4 acc[2]; float ss;
    skinny_mm<2, false>(Pm + (size_t)MPR * PW, PW, Wt, DM, n0, n0 + 16, wid, fr, fq, acc, ss);
    const int r = MPR + 16 * wid + fr;
#pragma unroll
    for (int nt = 0; nt < 2; ++nt) { const int c = n0 + 16 * nt + 4 * fq; const u32x2 xr = *(const u32x2*)(X1b + (size_t)r * DM + c);
        const f32x4 v = (f32x4){bflo(xr.x), bfhi(xr.x), bflo(xr.y), bfhi(xr.y)} + acc[nt];
        *(f32x4*)(X2f + (size_t)r * DM + c) = v; u32x2 w; w.x = cvt_pk(v[0], v[1]); w.y = cvt_pk(v[2], v[3]); *(u32x2*)(X2b + (size_t)r * DM + c) = w; }
}

__device__ __forceinline__ void transpose_item(const float* W, int K, int N, bf16_t* WT, int k0, int n0, int drow0, const float* gs, LAS float* scr, int lane) {
    float wv[32];
#pragma unroll
    for (int i = 0; i < 32; ++i) { const int kk = 2 * i + (lane >> 5), n = n0 + (lane & 31); wv[i] = (n < N) ? W[(size_t)(k0 + kk) * N + n] : 0.f; }
#pragma unroll
    for (int i = 0; i < 32; ++i) { const int kk = 2 * i + (lane >> 5); float v = wv[i]; if (gs) v *= gs[k0 + kk]; scr[kk * 33 + (lane & 31)] = v; }
    asm volatile("s_waitcnt lgkmcnt(0)" ::: "memory");
    const int c = lane & 7;
#pragma unroll
    for (int j = 0; j < 4; ++j) { const int nn = (lane >> 3) + 8 * j; const LAS float* s = scr + (8 * c) * 33 + nn;
        u32x4 o; o.x = cvt_pk(s[0 * 33], s[1 * 33]); o.y = cvt_pk(s[2 * 33], s[3 * 33]); o.z = cvt_pk(s[4 * 33], s[5 * 33]); o.w = cvt_pk(s[6 * 33], s[7 * 33]);
        *(u32x4*)(WT + (size_t)(drow0 + nn) * K + k0 + 8 * c) = o; }
    asm volatile("s_waitcnt lgkmcnt(0)" ::: "memory");
}
__device__ __forceinline__ int map_ffin_row(int n0) { return n0 < DFF ? (n0 >> 7) * 256 + (n0 & 127) : ((n0 - DFF) >> 7) * 256 + 128 + ((n0 - DFF) & 127); }

__device__ __forceinline__ void p0_prologue(const Params& p, LAS unsigned char* lds, int vb, int G) {
    const int tid = threadIdx.x, lane = tid & 63, wid = tid >> 6;
    LAS float* scr = (LAS float*)(lds + wid * 16384);
    const int gw = vb * 8 + wid, NGW = G * 8;
    bf16_t* W1IN = (bf16_t*)(p.ws + WS_W1IN); bf16_t* W1OUT = (bf16_t*)(p.ws + WS_W1OUT); bf16_t* WINMIX = (bf16_t*)(p.ws + WS_WINMIX);
    bf16_t* WOUTMIX = (bf16_t*)(p.ws + WS_WOUTMIX); bf16_t* W2IN = (bf16_t*)(p.ws + WS_W2IN); bf16_t* W2OUT = (bf16_t*)(p.ws + WS_W2OUT);
    constexpr int I_FIN = 16 * 176, I_FOUT = 44 * 32, I_INMIX = 16 * 89, I_OUTMIX = 16 * 32;
    constexpr int NITEMS = 2 * I_FIN + 2 * I_FOUT + I_INMIX + I_OUTMIX;
    for (int it = gw; it < NITEMS; it += NGW) {
        int r = it;
        if (r < I_FIN) { const int kb = r / 176, nb = r % 176; transpose_item(p.in[7], DM, 2 * DFF, W1IN, kb * 64, nb * 32, map_ffin_row(nb * 32), nullptr, scr, lane); continue; } r -= I_FIN;
        if (r < I_FIN) { const int kb = r / 176, nb = r % 176; transpose_item(p.in[18], DM, 2 * DFF, W2IN, kb * 64, nb * 32, map_ffin_row(nb * 32), p.in[17], scr, lane); continue; } r -= I_FIN;
        if (r < I_FOUT) { const int kb = r / 32, nb = r % 32; transpose_item(p.in[8], DFF, DM, W1OUT, kb * 64, nb * 32, nb * 32, nullptr, scr, lane); continue; } r -= I_FOUT;
        if (r < I_FOUT) { const int kb = r / 32, nb = r % 32; transpose_item(p.in[19], DFF, DM, W2OUT, kb * 64, nb * 32, nb * 32, nullptr, scr, lane); continue; } r -= I_FOUT;
        if (r < I_INMIX) { const int kb = r / 89, nb = r % 89; transpose_item(p.in[10], DM, 2824, WINMIX, kb * 64, nb * 32, nb * 32, p.in[9], scr, lane); continue; } r -= I_INMIX;
        { const int kb = r / 32, nb = r % 32; transpose_item(p.in[16], DM, DM, WOUTMIX, kb * 64, nb * 32, nb * 32, nullptr, scr, lane); }
    }
    bf16_t* XN = (bf16_t*)(p.ws + WS_XN); const float* g1 = p.in[6];
    f32x4 gv[4];
#pragma unroll
    for (int j = 0; j < 4; ++j) gv[j] = *((const f32x4*)g1 + lane + 64 * j);
    {
        f32x4 v[4], vn[4];
        int m = gw;
        if (m < MREAL) { const f32x4* xr = (const f32x4*)((m < MPR) ? p.in[0] + (size_t)m * DM : p.in[1] + (size_t)(m - MPR) * DM) + lane;
#pragma unroll
            for (int j = 0; j < 4; ++j) v[j] = xr[64 * j]; }
        for (; m < MREAL; m += NGW) {
            const int mn = m + NGW;
            if (mn < MREAL) { const f32x4* xr = (const f32x4*)((mn < MPR) ? p.in[0] + (size_t)mn * DM : p.in[1] + (size_t)(mn - MPR) * DM) + lane;
#pragma unroll
                for (int j = 0; j < 4; ++j) vn[j] = xr[64 * j]; }
            float s = 0.f;
#pragma unroll
            for (int j = 0; j < 4; ++j) s += (v[j][0] * v[j][0] + v[j][1] * v[j][1]) + (v[j][2] * v[j][2] + v[j][3] * v[j][3]);
            const float rstd = rsqrtf(wave_sum(s) * (1.0f / DM) + EPS);
            unsigned long long* o8 = (unsigned long long*)(XN + (size_t)m * DM) + lane;
#pragma unroll
            for (int j = 0; j < 4; ++j) { const f32x4 y = v[j] * rstd * gv[j];
                o8[64 * j] = (unsigned long long)cvt_pk(y[0], y[1]) | ((unsigned long long)cvt_pk(y[2], y[3]) << 32); }
#pragma unroll
            for (int j = 0; j < 4; ++j) v[j] = vn[j];
        }
    }
}

template <bool SWX = false, bool SWY = false>
__device__ __forceinline__ f32x4 tile_mm(const LAS bf16_t* X, int ldx, int mt, const LAS bf16_t* Y, int ldy, int nt, int nks, int fr, int fq) {
    f32x4 acc = (f32x4){0.f, 0.f, 0.f, 0.f};
    const int rx = 16 * mt + fr, ry = 16 * nt + fr, sx = SWX ? ((rx >> 3) & 7) : 0, sy = SWY ? ((ry >> 3) & 7) : 0;
    const LAS bf16_t* xp = X + rx * ldx; const LAS bf16_t* yp = Y + ry * ldy;
    for (int ks = 0; ks < nks; ++ks) acc = mfma16(*(const LAS bf16x8*)(xp + 8 * ((4 * ks + fq) ^ sx)), *(const LAS bf16x8*)(yp + 8 * ((4 * ks + fq) ^ sy)), acc);
    return acc;
}
constexpr int G1_QS = 0, G1_KS = 17408, G1_VBT = 34816, G1_KBT = 53248, G1_KDT = 71680, G1_UT = 90112, G1_WT = 108544, G1_QK = 126976, G1_TB = 136192, G1_GC = 145408, G1_BETA = 145664, G1_TT = 146176, G1_A10 = 148736, G1_PT = 151296;

__device__ __forceinline__ void gdn_prep_unit(const Params& p, LAS unsigned char* lds, int unit) {
    const int tid = threadIdx.x, lane = tid & 63, wid = tid >> 6, fr = lane & 15, fq = lane >> 4;
    const int bh = unit >> 7, n = unit & 127, b = bh >> 2, h = bh & 3;
    const int tok0 = b * SEQ + n * 64;
    LAS bf16_t* Qs = (LAS bf16_t*)(lds + G1_QS); LAS bf16_t* Ks = (LAS bf16_t*)(lds + G1_KS); LAS bf16_t* VbT = (LAS bf16_t*)(lds + G1_VBT);
    LAS bf16_t* KbT = (LAS bf16_t*)(lds + G1_KBT); LAS bf16_t* KdT = (LAS bf16_t*)(lds + G1_KDT); LAS bf16_t* UT = (LAS bf16_t*)(lds + G1_UT);
    LAS bf16_t* WT = (LAS bf16_t*)(lds + G1_WT); LAS float* Af = (LAS float*)(lds + G1_WT); LAS bf16_t* QK = (LAS bf16_t*)(lds + G1_QK);
    LAS bf16_t* Tb = (LAS bf16_t*)(lds + G1_TB); LAS bf16_t* TT = (LAS bf16_t*)(lds + G1_TT); LAS bf16_t* A10b = (LAS bf16_t*)(lds + G1_A10); LAS bf16_t* PT = (LAS bf16_t*)(lds + G1_PT); LAS float* gcs = (LAS float*)(lds + G1_GC); LAS float* betas = (LAS float*)(lds + G1_BETA);
    const bf16_t* PB = (const bf16_t*)(p.ws + WS_H); const float* GBA = (const float*)(p.ws + WS_GBA);
    LAS unsigned char* raw = lds + G1_UT;
    for (int pc4 = wid; pc4 < 51; pc4 += 8) {
        int pc = pc4 * 4 + (lane >> 4); pc = pc < 200 ? pc : 200;
        const int r = pc / 3, seg = pc - 3 * r; int tt = n * 64 - 3 + r; tt = tt < 0 ? 0 : tt;
        __builtin_amdgcn_global_load_lds((const unsigned*)(PB + (size_t)(b * SEQ + tt) * PW + 768 + seg * 512 + h * 128 + (lane & 15) * 8), (LAS unsigned*)(raw + pc4 * 1024), 16, 0, 0);
    }
    if (tid < 64) {
        const float* gb = GBA + (size_t)(tok0 + tid) * 8;
        const float bt = 1.0f / (1.0f + __expf(-gb[h]));
        const float x = gb[4 + h] + p.in[14][h]; const float sp = x > 20.f ? x : log1pf(__expf(x));
        float c = -__expf(p.in[13][h]) * sp;
#pragma unroll
        for (int o = 1; o < 64; o <<= 1) { const float t = __shfl_up(c, o); if (lane >= o) c += t; }
        gcs[tid] = c; betas[tid] = bt;
    }
    asm volatile("s_waitcnt vmcnt(0)" ::: "memory");
    __syncthreads();
    const float gclast = gcs[63];
    const float* cw = p.in[12];
#pragma unroll 1
    for (int it = 0; it < 6; ++it) {
        const int item = tid + 512 * it, l16 = item & 15, row = item >> 4, which = row >> 6, t = row & 63;
        const int cch = which * 512 + h * 128 + l16 * 8;
        float a[8];
#pragma unroll
        for (int e = 0; e < 8; ++e) a[e] = 0.f;
#pragma unroll
        for (int j = 0; j < 4; ++j) {
            const int tt = n * 64 + t - 3 + j;
            if (tt >= 0) {
                const u32x4 xv = *(const LAS u32x4*)(raw + ((t + j) * 3 + which) * 256 + l16 * 16);
                const f32x4 w0 = *(const f32x4*)(cw + j * CONVC + cch), w1 = *(const f32x4*)(cw + j * CONVC + cch + 4);
                a[0] += w0[0] * bflo(xv.x); a[1] += w0[1] * bfhi(xv.x); a[2] += w0[2] * bflo(xv.y); a[3] += w0[3] * bfhi(xv.y);
                a[4] += w1[0] * bflo(xv.z); a[5] += w1[1] * bfhi(xv.z); a[6] += w1[2] * bflo(xv.w); a[7] += w1[3] * bfhi(xv.w);
            }
        }
        float ss = 0.f;
#pragma unroll
        for (int e = 0; e < 8; ++e) { a[e] = silu(a[e]); ss += a[e] * a[e]; }
        ss += __shfl_xor(ss, 1); ss += __shfl_xor(ss, 2); ss += __shfl_xor(ss, 4); ss += __shfl_xor(ss, 8);
        const float gct = gcs[t], bt = betas[t];
        const int tsw = (((t >> 3) ^ (l16 & 7)) << 3) | (t & 7);
        if (which == 0) {
            const float sc = rsqrtf(ss + EPS) * 0.08838834764831845f;
            u32x4 w; w.x = cvt_pk(a[0] * sc, a[1] * sc); w.y = cvt_pk(a[2] * sc, a[3] * sc); w.z = cvt_pk(a[4] * sc, a[5] * sc); w.w = cvt_pk(a[6] * sc, a[7] * sc);
            *(LAS u32x4*)(Qs + t * 136 + l16 * 8) = w;
        } else if (which == 1) {
            const float sc = rsqrtf(ss + EPS);
            u32x4 w; w.x = cvt_pk(a[0] * sc, a[1] * sc); w.y = cvt_pk(a[2] * sc, a[3] * sc); w.z = cvt_pk(a[4] * sc, a[5] * sc); w.w = cvt_pk(a[6] * sc, a[7] * sc);
            *(LAS u32x4*)(Ks + t * 136 + l16 * 8) = w;
            const float sb = sc * bt * __expf(gct), sd = sc * __expf(gclast - gct);
#pragma unroll
            for (int e = 0; e < 8; ++e) { KbT[(l16 * 8 + e) * 72 + tsw] = f2bf(a[e] * sb); KdT[(l16 * 8 + e) * 72 + tsw] = f2bf(a[e] * sd); }
        } else {
#pragma unroll
            for (int e = 0; e < 8; ++e) VbT[(l16 * 8 + e) * 72 + tsw] = f2bf(a[e] * bt);
        }
    }
    __syncthreads();
#pragma unroll 2
    for (int r = 0; r < 4; ++r) {
        const int job = wid + 8 * r, kind = job >> 4, tile = job & 15, it = tile >> 2, jt = tile & 3;
        if (kind == 0) {
            if (jt > it) continue;
            const f32x4 acc = tile_mm(Ks, 136, it, Ks, 136, jt, 4, fr, fq);
            const int j = 16 * jt + fr; const float gcj = gcs[j];
            float v[4];
#pragma unroll
            for (int e = 0; e < 4; ++e) { const int i = 16 * it + 4 * fq + e; const bool ok = i > j; v[e] = ok ? acc[e] * __expf(gcs[i] - gcj) * betas[i] : 0.f; }
            *(LAS f32x4*)(Af + j * 68 + 16 * it + 4 * fq) = (f32x4){v[0], v[1], v[2], v[3]};
            if (it >= 2 && jt < 2) {
#pragma unroll
                for (int e = 0; e < 4; ++e) A10b[(16 * (it - 2) + 4 * fq + e) * 40 + j] = f2bf(v[e]); }
        } else {
            const f32x4 acc = tile_mm(Ks, 136, jt, Qs, 136, it, 4, fr, fq);
            const int i = 16 * it + fr; const float gci = gcs[i];
            float v[4];
#pragma unroll
            for (int e = 0; e < 4; ++e) { const int j = 16 * jt + 4 * fq + e; const bool ok = i >= j; v[e] = ok ? acc[e] * __expf(gci - gcs[j]) : 0.f; }
            u32x2 w; w.x = cvt_pk(v[0], v[1]); w.y = cvt_pk(v[2], v[3]); *(LAS u32x2*)(QK + i * 72 + 16 * jt + 4 * fq) = w;
        }
    }
    __syncthreads();
    if (wid < 2) {
        const int ofs = wid * 32, cl = lane & 31; const LAS float* Ab = Af + ofs * 69; LAS bf16_t* Tw = Tb + ofs * 73 + cl; LAS bf16_t* Tt = (wid == 0) ? TT + cl * 40 : PT + cl * 40;
        f32x2v r2[16];
#pragma unroll
        for (int k = 0; k < 16; ++k) r2[k] = (f32x2v){(cl == 2 * k) ? 1.0f : 0.0f, (cl == 2 * k + 1) ? 1.0f : 0.0f};
        const f32x4 a0 = *(const LAS f32x4*)(Ab + 0);
        const f32x4 a1 = *(const LAS f32x4*)(Ab + 4);
        const f32x4 a2 = *(const LAS f32x4*)(Ab + 8);
        const f32x4 a3 = *(const LAS f32x4*)(Ab + 12);
        const f32x4 a4 = *(const LAS f32x4*)(Ab + 16);
        const float t0 = r2[0][0]; const f32x2v T0 = (f32x2v){t0, t0}; Tw[0] = f2bf(t0); Tt[0] = f2bf(t0);
        r2[0] -= (f32x2v){a0[0], a0[1]} * T0; r2[1] -= (f32x2v){a0[2], a0[3]} * T0;
        const f32x4 a5 = *(const LAS f32x4*)(Ab + 20);
        r2[2] -= (f32x2v){a1[0], a1[1]} * T0; r2[3] -= (f32x2v){a1[2], a1[3]} * T0;
        const f32x4 a6 = *(const LAS f32x4*)(Ab + 24);
        r2[4] -= (f32x2v){a2[0], a2[1]} * T0; r2[5] -= (f32x2v){a2[2], a2[3]} * T0;
        const f32x4 a7 = *(const LAS f32x4*)(Ab + 28);
        r2[6] -= (f32x2v){a3[0], a3[1]} * T0; r2[7] -= (f32x2v){a3[2], a3[3]} * T0;
        const f32x4 a8 = *(const LAS f32x4*)(Ab + 68);
        r2[8] -= (f32x2v){a4[0], a4[1]} * T0; r2[9] -= (f32x2v){a4[2], a4[3]} * T0;
        const f32x4 a9 = *(const LAS f32x4*)(Ab + 72);
        r2[10] -= (f32x2v){a5[0], a5[1]} * T0; r2[11] -= (f32x2v){a5[2], a5[3]} * T0;
        const f32x4 a10 = *(const LAS f32x4*)(Ab + 76);
        r2[12] -= (f32x2v){a6[0], a6[1]} * T0; r2[13] -= (f32x2v){a6[2], a6[3]} * T0;
        const f32x4 a11 = *(const LAS f32x4*)(Ab + 80);
        r2[14] -= (f32x2v){a7[0], a7[1]} * T0; r2[15] -= (f32x2v){a7[2], a7[3]} * T0;
        const f32x4 a12 = *(const LAS f32x4*)(Ab + 84);
        const float t1 = r2[0][1]; const f32x2v T1 = (f32x2v){t1, t1}; Tw[72] = f2bf(t1); Tt[1] = f2bf(t1);
        r2[1] -= (f32x2v){a8[2], a8[3]} * T1;
        const f32x4 a13 = *(const LAS f32x4*)(Ab + 88);
        r2[2] -= (f32x2v){a9[0], a9[1]} * T1; r2[3] -= (f32x2v){a9[2], a9[3]} * T1;
        const f32x4 a14 = *(const LAS f32x4*)(Ab + 92);
        r2[4] -= (f32x2v){a10[0], a10[1]} * T1; r2[5] -= (f32x2v){a10[2], a10[3]} * T1;
        const f32x4 a15 = *(const LAS f32x4*)(Ab + 96);
        r2[6] -= (f32x2v){a11[0], a11[1]} * T1; r2[7] -= (f32x2v){a11[2], a11[3]} * T1;
        const f32x4 a16 = *(const LAS f32x4*)(Ab + 136);
        r2[8] -= (f32x2v){a12[0], a12[1]} * T1; r2[9] -= (f32x2v){a12[2], a12[3]} * T1;
        const f32x4 a17 = *(const LAS f32x4*)(Ab + 140);
        r2[10] -= (f32x2v){a13[0], a13[1]} * T1; r2[11] -= (f32x2v){a13[2], a13[3]} * T1;
        const f32x4 a18 = *(const LAS f32x4*)(Ab + 144);
        r2[12] -= (f32x2v){a14[0], a14[1]} * T1; r2[13] -= (f32x2v){a14[2], a14[3]} * T1;
        const f32x4 a19 = *(const LAS f32x4*)(Ab + 148);
        r2[14] -= (f32x2v){a15[0], a15[1]} * T1; r2[15] -= (f32x2v){a15[2], a15[3]} * T1;
        const f32x4 a20 = *(const LAS f32x4*)(Ab + 152);
        const float t2 = r2[1][0]; const f32x2v T2 = (f32x2v){t2, t2}; Tw[144] = f2bf(t2); Tt[2] = f2bf(t2);
        r2[1] -= (f32x2v){a16[2], a16[3]} * T2;
        const f32x4 a21 = *(const LAS f32x4*)(Ab + 156);
        r2[2] -= (f32x2v){a17[0], a17[1]} * T2; r2[3] -= (f32x2v){a17[2], a17[3]} * T2;
        const f32x4 a22 = *(const LAS f32x4*)(Ab + 160);
        r2[4] -= (f32x2v){a18[0], a18[1]} * T2; r2[5] -= (f32x2v){a18[2], a18[3]} * T2;
        const f32x4 a23 = *(const LAS f32x4*)(Ab + 164);
        r2[6] -= (f32x2v){a19[0], a19[1]} * T2; r2[7] -= (f32x2v){a19[2], a19[3]} * T2;
        const f32x4 a24 = *(const LAS f32x4*)(Ab + 208);
        r2[8] -= (f32x2v){a20[0], a20[1]} * T2; r2[9] -= (f32x2v){a20[2], a20[3]} * T2;
        const f32x4 a25 = *(const LAS f32x4*)(Ab + 212);
        r2[10] -= (f32x2v){a21[0], a21[1]} * T2; r2[11] -= (f32x2v){a21[2], a21[3]} * T2;
        const f32x4 a26 = *(const LAS f32x4*)(Ab + 216);
        r2[12] -= (f32x2v){a22[0], a22[1]} * T2; r2[13] -= (f32x2v){a22[2], a22[3]} * T2;
        const f32x4 a27 = *(const LAS f32x4*)(Ab + 220);
        r2[14] -= (f32x2v){a23[0], a23[1]} * T2; r2[15] -= (f32x2v){a23[2], a23[3]} * T2;
        const f32x4 a28 = *(const LAS f32x4*)(Ab + 224);
        const float t3 = r2[1][1]; const f32x2v T3 = (f32x2v){t3, t3}; Tw[216] = f2bf(t3); Tt[3] = f2bf(t3);
        r2[2] -= (f32x2v){a24[0], a24[1]} * T3; r2[3] -= (f32x2v){a24[2], a24[3]} * T3;
        const f32x4 a29 = *(const LAS f32x4*)(Ab + 228);
        r2[4] -= (f32x2v){a25[0], a25[1]} * T3; r2[5] -= (f32x2v){a25[2], a25[3]} * T3;
        const f32x4 a30 = *(const LAS f32x4*)(Ab + 232);
        r2[6] -= (f32x2v){a26[0], a26[1]} * T3; r2[7] -= (f32x2v){a26[2], a26[3]} * T3;
        const f32x4 a31 = *(const LAS f32x4*)(Ab + 276);
        r2[8] -= (f32x2v){a27[0], a27[1]} * T3; r2[9] -= (f32x2v){a27[2], a27[3]} * T3;
        const f32x4 a32 = *(const LAS f32x4*)(Ab + 280);
        r2[10] -= (f32x2v){a28[0], a28[1]} * T3; r2[11] -= (f32x2v){a28[2], a28[3]} * T3;
        const f32x4 a33 = *(const LAS f32x4*)(Ab + 284);
        r2[12] -= (f32x2v){a29[0], a29[1]} * T3; r2[13] -= (f32x2v){a29[2], a29[3]} * T3;
        const f32x4 a34 = *(const LAS f32x4*)(Ab + 288);
        r2[14] -= (f32x2v){a30[0], a30[1]} * T3; r2[15] -= (f32x2v){a30[2], a30[3]} * T3;
        const f32x4 a35 = *(const LAS f32x4*)(Ab + 292);
        const float t4 = r2[2][0]; const f32x2v T4 = (f32x2v){t4, t4}; Tw[288] = f2bf(t4); Tt[4] = f2bf(t4);
        r2[2] -= (f32x2v){a31[0], a31[1]} * T4; r2[3] -= (f32x2v){a31[2], a31[3]} * T4;
        const f32x4 a36 = *(const LAS f32x4*)(Ab + 296);
        r2[4] -= (f32x2v){a32[0], a32[1]} * T4; r2[5] -= (f32x2v){a32[2], a32[3]} * T4;
        const f32x4 a37 = *(const LAS f32x4*)(Ab + 300);
        r2[6] -= (f32x2v){a33[0], a33[1]} * T4; r2[7] -= (f32x2v){a33[2], a33[3]} * T4;
        const f32x4 a38 = *(const LAS f32x4*)(Ab + 344);
        r2[8] -= (f32x2v){a34[0], a34[1]} * T4; r2[9] -= (f32x2v){a34[2], a34[3]} * T4;
        const f32x4 a39 = *(const LAS f32x4*)(Ab + 348);
        r2[10] -= (f32x2v){a35[0], a35[1]} * T4; r2[11] -= (f32x2v){a35[2], a35[3]} * T4;
        const f32x4 a40 = *(const LAS f32x4*)(Ab + 352);
        r2[12] -= (f32x2v){a36[0], a36[1]} * T4; r2[13] -= (f32x2v){a36[2], a36[3]} * T4;
        const f32x4 a41 = *(const LAS f32x4*)(Ab + 356);
        r2[14] -= (f32x2v){a37[0], a37[1]} * T4; r2[15] -= (f32x2v){a37[2], a37[3]} * T4;
        const f32x4 a42 = *(const LAS f32x4*)(Ab + 360);
        const float t5 = r2[2][1]; const f32x2v T5 = (f32x2v){t5, t5}; Tw[360] = f2bf(t5); Tt[5] = f2bf(t5);
        r2[3] -= (f32x2v){a38[2], a38[3]} * T5;
        const f32x4 a43 = *(const LAS f32x4*)(Ab + 364);
        r2[4] -= (f32x2v){a39[0], a39[1]} * T5; r2[5] -= (f32x2v){a39[2], a39[3]} * T5;
        const f32x4 a44 = *(const LAS f32x4*)(Ab + 368);
        r2[6] -= (f32x2v){a40[0], a40[1]} * T5; r2[7] -= (f32x2v){a40[2], a40[3]} * T5;
        const f32x4 a45 = *(const LAS f32x4*)(Ab + 412);
        r2[8] -= (f32x2v){a41[0], a41[1]} * T5; r2[9] -= (f32x2v){a41[2], a41[3]} * T5;
        const f32x4 a46 = *(const LAS f32x4*)(Ab + 416);
        r2[10] -= (f32x2v){a42[0], a42[1]} * T5; r2[11] -= (f32x2v){a42[2], a42[3]} * T5;
        const f32x4 a47 = *(const LAS f32x4*)(Ab + 420);
        r2[12] -= (f32x2v){a43[0], a43[1]} * T5; r2[13] -= (f32x2v){a43[2], a43[3]} * T5;
        const f32x4 a48 = *(const LAS f32x4*)(Ab + 424);
        r2[14] -= (f32x2v){a44[0], a44[1]} * T5; r2[15] -= (f32x2v){a44[2], a44[3]} * T5;
        const f32x4 a49 = *(const LAS f32x4*)(Ab + 428);
        const float t6 = r2[3][0]; const f32x2v T6 = (f32x2v){t6, t6}; Tw[432] = f2bf(t6); Tt[6] = f2bf(t6);
        r2[3] -= (f32x2v){a45[2], a45[3]} * T6;
        const f32x4 a50 = *(const LAS f32x4*)(Ab + 432);
        r2[4] -= (f32x2v){a46[0], a46[1]} * T6; r2[5] -= (f32x2v){a46[2], a46[3]} * T6;
        const f32x4 a51 = *(const LAS f32x4*)(Ab + 436);
        r2[6] -= (f32x2v){a47[0], a47[1]} * T6; r2[7] -= (f32x2v){a47[2], a47[3]} * T6;
        const f32x4 a52 = *(const LAS f32x4*)(Ab + 484);
        r2[8] -= (f32x2v){a48[0], a48[1]} * T6; r2[9] -= (f32x2v){a48[2], a48[3]} * T6;
        const f32x4 a53 = *(const LAS f32x4*)(Ab + 488);
        r2[10] -= (f32x2v){a49[0], a49[1]} * T6; r2[11] -= (f32x2v){a49[2], a49[3]} * T6;
        const f32x4 a54 = *(const LAS f32x4*)(Ab + 492);
        r2[12] -= (f32x2v){a50[0], a50[1]} * T6; r2[13] -= (f32x2v){a50[2], a50[3]} * T6;
        const f32x4 a55 = *(const LAS f32x4*)(Ab + 496);
        r2[14] -= (f32x2v){a51[0], a51[1]} * T6; r2[15] -= (f32x2v){a51[2], a51[3]} * T6;
        const f32x4 a56 = *(const LAS f32x4*)(Ab + 500);
        const float t7 = r2[3][1]; const f32x2v T7 = (f32x2v){t7, t7}; Tw[504] = f2bf(t7); Tt[7] = f2bf(t7);
        r2[4] -= (f32x2v){a52[0], a52[1]} * T7; r2[5] -= (f32x2v){a52[2], a52[3]} * T7;
        const f32x4 a57 = *(const LAS f32x4*)(Ab + 504);
        r2[6] -= (f32x2v){a53[0], a53[1]} * T7; r2[7] -= (f32x2v){a53[2], a53[3]} * T7;
        const f32x4 a58 = *(const LAS f32x4*)(Ab + 552);
        r2[8] -= (f32x2v){a54[0], a54[1]} * T7; r2[9] -= (f32x2v){a54[2], a54[3]} * T7;
        const f32x4 a59 = *(const LAS f32x4*)(Ab + 556);
        r2[10] -= (f32x2v){a55[0], a55[1]} * T7; r2[11] -= (f32x2v){a55[2], a55[3]} * T7;
        const f32x4 a60 = *(const LAS f32x4*)(Ab + 560);
        r2[12] -= (f32x2v){a56[0], a56[1]} * T7; r2[13] -= (f32x2v){a56[2], a56[3]} * T7;
        const f32x4 a61 = *(const LAS f32x4*)(Ab + 564);
        r2[14] -= (f32x2v){a57[0], a57[1]} * T7; r2[15] -= (f32x2v){a57[2], a57[3]} * T7;
        const f32x4 a62 = *(const LAS f32x4*)(Ab + 568);
        const float t8 = r2[4][0]; const f32x2v T8 = (f32x2v){t8, t8}; Tw[576] = f2bf(t8); Tt[8] = f2bf(t8);
        r2[4] -= (f32x2v){a58[0], a58[1]} * T8; r2[5] -= (f32x2v){a58[2], a58[3]} * T8;
        const f32x4 a63 = *(const LAS f32x4*)(Ab + 572);
        r2[6] -= (f32x2v){a59[0], a59[1]} * T8; r2[7] -= (f32x2v){a59[2], a59[3]} * T8;
        const f32x4 a64 = *(const LAS f32x4*)(Ab + 620);
        r2[8] -= (f32x2v){a60[0], a60[1]} * T8; r2[9] -= (f32x2v){a60[2], a60[3]} * T8;
        const f32x4 a65 = *(const LAS f32x4*)(Ab + 624);
        r2[10] -= (f32x2v){a61[0], a61[1]} * T8; r2[11] -= (f32x2v){a61[2], a61[3]} * T8;
        const f32x4 a66 = *(const LAS f32x4*)(Ab + 628);
        r2[12] -= (f32x2v){a62[0], a62[1]} * T8; r2[13] -= (f32x2v){a62[2], a62[3]} * T8;
        const f32x4 a67 = *(const LAS f32x4*)(Ab + 632);
        r2[14] -= (f32x2v){a63[0], a63[1]} * T8; r2[15] -= (f32x2v){a63[2], a63[3]} * T8;
        const f32x4 a68 = *(const LAS f32x4*)(Ab + 636);
        const float t9 = r2[4][1]; const f32x2v T9 = (f32x2v){t9, t9}; Tw[648] = f2bf(t9); Tt[9] = f2bf(t9);
        r2[5] -= (f32x2v){a64[2], a64[3]} * T9;
        const f32x4 a69 = *(const LAS f32x4*)(Ab + 640);
        r2[6] -= (f32x2v){a65[0], a65[1]} * T9; r2[7] -= (f32x2v){a65[2], a65[3]} * T9;
        const f32x4 a70 = *(const LAS f32x4*)(Ab + 688);
        r2[8] -= (f32x2v){a66[0], a66[1]} * T9; r2[9] -= (f32x2v){a66[2], a66[3]} * T9;
        const f32x4 a71 = *(const LAS f32x4*)(Ab + 692);
        r2[10] -= (f32x2v){a67[0], a67[1]} * T9; r2[11] -= (f32x2v){a67[2], a67[3]} * T9;
        const f32x4 a72 = *(const LAS f32x4*)(Ab + 696);
        r2[12] -= (f32x2v){a68[0], a68[1]} * T9; r2[13] -= (f32x2v){a68[2], a68[3]} * T9;
        const f32x4 a73 = *(const LAS f32x4*)(Ab + 700);
        r2[14] -= (f32x2v){a69[0], a69[1]} * T9; r2[15] -= (f32x2v){a69[2], a69[3]} * T9;
        const f32x4 a74 = *(const LAS f32x4*)(Ab + 704);
        const float t10 = r2[5][0]; const f32x2v T10 = (f32x2v){t10, t10}; Tw[720] = f2bf(t10); Tt[10] = f2bf(t10);
        r2[5] -= (f32x2v){a70[2], a70[3]} * T10;
        const f32x4 a75 = *(const LAS f32x4*)(Ab + 708);
        r2[6] -= (f32x2v){a71[0], a71[1]} * T10; r2[7] -= (f32x2v){a71[2], a71[3]} * T10;
        const f32x4 a76 = *(const LAS f32x4*)(Ab + 760);
        r2[8] -= (f32x2v){a72[0], a72[1]} * T10; r2[9] -= (f32x2v){a72[2], a72[3]} * T10;
        const f32x4 a77 = *(const LAS f32x4*)(Ab + 764);
        r2[10] -= (f32x2v){a73[0], a73[1]} * T10; r2[11] -= (f32x2v){a73[2], a73[3]} * T10;
        const f32x4 a78 = *(const LAS f32x4*)(Ab + 768);
        r2[12] -= (f32x2v){a74[0], a74[1]} * T10; r2[13] -= (f32x2v){a74[2], a74[3]} * T10;
        const f32x4 a79 = *(const LAS f32x4*)(Ab + 772);
        r2[14] -= (f32x2v){a75[0], a75[1]} * T10; r2[15] -= (f32x2v){a75[2], a75[3]} * T10;
        const f32x4 a80 = *(const LAS f32x4*)(Ab + 776);
        const float t11 = r2[5][1]; const f32x2v T11 = (f32x2v){t11, t11}; Tw[792] = f2bf(t11); Tt[11] = f2bf(t11);
        r2[6] -= (f32x2v){a76[0], a76[1]} * T11; r2[7] -= (f32x2v){a76[2], a76[3]} * T11;
        const f32x4 a81 = *(const LAS f32x4*)(Ab + 828);
        r2[8] -= (f32x2v){a77[0], a77[1]} * T11; r2[9] -= (f32x2v){a77[2], a77[3]} * T11;
        const f32x4 a82 = *(const LAS f32x4*)(Ab + 832);
        r2[10] -= (f32x2v){a78[0], a78[1]} * T11; r2[11] -= (f32x2v){a78[2], a78[3]} * T11;
        const f32x4 a83 = *(const LAS f32x4*)(Ab + 836);
        r2[12] -= (f32x2v){a79[0], a79[1]} * T11; r2[13] -= (f32x2v){a79[2], a79[3]} * T11;
        const f32x4 a84 = *(const LAS f32x4*)(Ab + 840);
        r2[14] -= (f32x2v){a80[0], a80[1]} * T11; r2[15] -= (f32x2v){a80[2], a80[3]} * T11;
        const f32x4 a85 = *(const LAS f32x4*)(Ab + 844);
        const float t12 = r2[6][0]; const f32x2v T12 = (f32x2v){t12, t12}; Tw[864] = f2bf(t12); Tt[12] = f2bf(t12);
        r2[6] -= (f32x2v){a81[0], a81[1]} * T12; r2[7] -= (f32x2v){a81[2], a81[3]} * T12;
        const f32x4 a86 = *(const LAS f32x4*)(Ab + 896);
        r2[8] -= (f32x2v){a82[0], a82[1]} * T12; r2[9] -= (f32x2v){a82[2], a82[3]} * T12;
        const f32x4 a87 = *(const LAS f32x4*)(Ab + 900);
        r2[10] -= (f32x2v){a83[0], a83[1]} * T12; r2[11] -= (f32x2v){a83[2], a83[3]} * T12;
        const f32x4 a88 = *(const LAS f32x4*)(Ab + 904);
        r2[12] -= (f32x2v){a84[0], a84[1]} * T12; r2[13] -= (f32x2v){a84[2], a84[3]} * T12;
        const f32x4 a89 = *(const LAS f32x4*)(Ab + 908);
        r2[14] -= (f32x2v){a85[0], a85[1]} * T12; r2[15] -= (f32x2v){a85[2], a85[3]} * T12;
        const f32x4 a90 = *(const LAS f32x4*)(Ab + 912);
        const float t13 = r2[6][1]; const f32x2v T13 = (f32x2v){t13, t13}; Tw[936] = f2bf(t13); Tt[13] = f2bf(t13);
        r2[7] -= (f32x2v){a86[2], a86[3]} * T13;
        const f32x4 a91 = *(const LAS f32x4*)(Ab + 964);
        r2[8] -= (f32x2v){a87[0], a87[1]} * T13; r2[9] -= (f32x2v){a87[2], a87[3]} * T13;
        const f32x4 a92 = *(const LAS f32x4*)(Ab + 968);
        r2[10] -= (f32x2v){a88[0], a88[1]} * T13; r2[11] -= (f32x2v){a88[2], a88[3]} * T13;
        const f32x4 a93 = *(const LAS f32x4*)(Ab + 972);
        r2[12] -= (f32x2v){a89[0], a89[1]} * T13; r2[13] -= (f32x2v){a89[2], a89[3]} * T13;
        const f32x4 a94 = *(const LAS f32x4*)(Ab + 976);
        r2[14] -= (f32x2v){a90[0], a90[1]} * T13; r2[15] -= (f32x2v){a90[2], a90[3]} * T13;
        const f32x4 a95 = *(const LAS f32x4*)(Ab + 980);
        const float t14 = r2[7][0]; const f32x2v T14 = (f32x2v){t14, t14}; Tw[1008] = f2bf(t14); Tt[14] = f2bf(t14);
        r2[7] -= (f32x2v){a91[2], a91[3]} * T14;
        const f32x4 a96 = *(const LAS f32x4*)(Ab + 1036);
        r2[8] -= (f32x2v){a92[0], a92[1]} * T14; r2[9] -= (f32x2v){a92[2], a92[3]} * T14;
        const f32x4 a97 = *(const LAS f32x4*)(Ab + 1040);
        r2[10] -= (f32x2v){a93[0], a93[1]} * T14; r2[11] -= (f32x2v){a93[2], a93[3]} * T14;
        const f32x4 a98 = *(const LAS f32x4*)(Ab + 1044);
        r2[12] -= (f32x2v){a94[0], a94[1]} * T14; r2[13] -= (f32x2v){a94[2], a94[3]} * T14;
        const f32x4 a99 = *(const LAS f32x4*)(Ab + 1048);
        r2[14] -= (f32x2v){a95[0], a95[1]} * T14; r2[15] -= (f32x2v){a95[2], a95[3]} * T14;
        const f32x4 a100 = *(const LAS f32x4*)(Ab + 1104);
        const float t15 = r2[7][1]; const f32x2v T15 = (f32x2v){t15, t15}; Tw[1080] = f2bf(t15); Tt[15] = f2bf(t15);
        r2[8] -= (f32x2v){a96[0], a96[1]} * T15; r2[9] -= (f32x2v){a96[2], a96[3]} * T15;
        const f32x4 a101 = *(const LAS f32x4*)(Ab + 1108);
        r2[10] -= (f32x2v){a97[0], a97[1]} * T15; r2[11] -= (f32x2v){a97[2], a97[3]} * T15;
        const f32x4 a102 = *(const LAS f32x4*)(Ab + 1112);
        r2[12] -= (f32x2v){a98[0], a98[1]} * T15; r2[13] -= (f32x2v){a98[2], a98[3]} * T15;
        const f32x4 a103 = *(const LAS f32x4*)(Ab + 1116);
        r2[14] -= (f32x2v){a99[0], a99[1]} * T15; r2[15] -= (f32x2v){a99[2], a99[3]} * T15;
        const f32x4 a104 = *(const LAS f32x4*)(Ab + 1172);
        const float t16 = r2[8][0]; const f32x2v T16 = (f32x2v){t16, t16}; Tw[1152] = f2bf(t16); Tt[16] = f2bf(t16);
        r2[8] -= (f32x2v){a100[0], a100[1]} * T16; r2[9] -= (f32x2v){a100[2], a100[3]} * T16;
        const f32x4 a105 = *(const LAS f32x4*)(Ab + 1176);
        r2[10] -= (f32x2v){a101[0], a101[1]} * T16; r2[11] -= (f32x2v){a101[2], a101[3]} * T16;
        const f32x4 a106 = *(const LAS f32x4*)(Ab + 1180);
        r2[12] -= (f32x2v){a102[0], a102[1]} * T16; r2[13] -= (f32x2v){a102[2], a102[3]} * T16;
        const f32x4 a107 = *(const LAS f32x4*)(Ab + 1184);
        r2[14] -= (f32x2v){a103[0], a103[1]} * T16; r2[15] -= (f32x2v){a103[2], a103[3]} * T16;
        const f32x4 a108 = *(const LAS f32x4*)(Ab + 1240);
        const float t17 = r2[8][1]; const f32x2v T17 = (f32x2v){t17, t17}; Tw[1224] = f2bf(t17); Tt[17] = f2bf(t17);
        r2[9] -= (f32x2v){a104[2], a104[3]} * T17;
        const f32x4 a109 = *(const LAS f32x4*)(Ab + 1244);
        r2[10] -= (f32x2v){a105[0], a105[1]} * T17; r2[11] -= (f32x2v){a105[2], a105[3]} * T17;
        const f32x4 a110 = *(const LAS f32x4*)(Ab + 1248);
        r2[12] -= (f32x2v){a106[0], a106[1]} * T17; r2[13] -= (f32x2v){a106[2], a106[3]} * T17;
        const f32x4 a111 = *(const LAS f32x4*)(Ab + 1252);
        r2[14] -= (f32x2v){a107[0], a107[1]} * T17; r2[15] -= (f32x2v){a107[2], a107[3]} * T17;
        const f32x4 a112 = *(const LAS f32x4*)(Ab + 1312);
        const float t18 = r2[9][0]; const f32x2v T18 = (f32x2v){t18, t18}; Tw[1296] = f2bf(t18); Tt[18] = f2bf(t18);
        r2[9] -= (f32x2v){a108[2], a108[3]} * T18;
        const f32x4 a113 = *(const LAS f32x4*)(Ab + 1316);
        r2[10] -= (f32x2v){a109[0], a109[1]} * T18; r2[11] -= (f32x2v){a109[2], a109[3]} * T18;
        const f32x4 a114 = *(const LAS f32x4*)(Ab + 1320);
        r2[12] -= (f32x2v){a110[0], a110[1]} * T18; r2[13] -= (f32x2v){a110[2], a110[3]} * T18;
        const f32x4 a115 = *(const LAS f32x4*)(Ab + 1380);
        r2[14] -= (f32x2v){a111[0], a111[1]} * T18; r2[15] -= (f32x2v){a111[2], a111[3]} * T18;
        const f32x4 a116 = *(const LAS f32x4*)(Ab + 1384);
        const float t19 = r2[9][1]; const f32x2v T19 = (f32x2v){t19, t19}; Tw[1368] = f2bf(t19); Tt[19] = f2bf(t19);
        r2[10] -= (f32x2v){a112[0], a112[1]} * T19; r2[11] -= (f32x2v){a112[2], a112[3]} * T19;
        const f32x4 a117 = *(const LAS f32x4*)(Ab + 1388);
        r2[12] -= (f32x2v){a113[0], a113[1]} * T19; r2[13] -= (f32x2v){a113[2], a113[3]} * T19;
        const f32x4 a118 = *(const LAS f32x4*)(Ab + 1448);
        r2[14] -= (f32x2v){a114[0], a114[1]} * T19; r2[15] -= (f32x2v){a114[2], a114[3]} * T19;
        const f32x4 a119 = *(const LAS f32x4*)(Ab + 1452);
        const float t20 = r2[10][0]; const f32x2v T20 = (f32x2v){t20, t20}; Tw[1440] = f2bf(t20); Tt[20] = f2bf(t20);
        r2[10] -= (f32x2v){a115[0], a115[1]} * T20; r2[11] -= (f32x2v){a115[2], a115[3]} * T20;
        const f32x4 a120 = *(const LAS f32x4*)(Ab + 1456);
        r2[12] -= (f32x2v){a116[0], a116[1]} * T20; r2[13] -= (f32x2v){a116[2], a116[3]} * T20;
        const f32x4 a121 = *(const LAS f32x4*)(Ab + 1516);
        r2[14] -= (f32x2v){a117[0], a117[1]} * T20; r2[15] -= (f32x2v){a117[2], a117[3]} * T20;
        const f32x4 a122 = *(const LAS f32x4*)(Ab + 1520);
        const float t21 = r2[10][1]; const f32x2v T21 = (f32x2v){t21, t21}; Tw[1512] = f2bf(t21); Tt[21] = f2bf(t21);
        r2[11] -= (f32x2v){a118[2], a118[3]} * T21;
        const f32x4 a123 = *(const LAS f32x4*)(Ab + 1524);
        r2[12] -= (f32x2v){a119[0], a119[1]} * T21; r2[13] -= (f32x2v){a119[2], a119[3]} * T21;
        const f32x4 a124 = *(const LAS f32x4*)(Ab + 1588);
        r2[14] -= (f32x2v){a120[0], a120[1]} * T21; r2[15] -= (f32x2v){a120[2], a120[3]} * T21;
        const f32x4 a125 = *(const LAS f32x4*)(Ab + 1592);
        const float t22 = r2[11][0]; const f32x2v T22 = (f32x2v){t22, t22}; Tw[1584] = f2bf(t22); Tt[22] = f2bf(t22);
        r2[11] -= (f32x2v){a121[2], a121[3]} * T22;
        const f32x4 a126 = *(const LAS f32x4*)(Ab + 1656);
        r2[12] -= (f32x2v){a122[0], a122[1]} * T22; r2[13] -= (f32x2v){a122[2], a122[3]} * T22;
        const f32x4 a127 = *(const LAS f32x4*)(Ab + 1660);
        r2[14] -= (f32x2v){a123[0], a123[1]} * T22; r2[15] -= (f32x2v){a123[2], a123[3]} * T22;
        const f32x4 a128 = *(const LAS f32x4*)(Ab + 1724);
        const float t23 = r2[11][1]; const f32x2v T23 = (f32x2v){t23, t23}; Tw[1656] = f2bf(t23); Tt[23] = f2bf(t23);
        r2[12] -= (f32x2v){a124[0], a124[1]} * T23; r2[13] -= (f32x2v){a124[2], a124[3]} * T23;
        const f32x4 a129 = *(const LAS f32x4*)(Ab + 1728);
        r2[14] -= (f32x2v){a125[0], a125[1]} * T23; r2[15] -= (f32x2v){a125[2], a125[3]} * T23;
        const f32x4 a130 = *(const LAS f32x4*)(Ab + 1792);
        const float t24 = r2[12][0]; const f32x2v T24 = (f32x2v){t24, t24}; Tw[1728] = f2bf(t24); Tt[24] = f2bf(t24);
        r2[12] -= (f32x2v){a126[0], a126[1]} * T24; r2[13] -= (f32x2v){a126[2], a126[3]} * T24;
        const f32x4 a131 = *(const LAS f32x4*)(Ab + 1796);
        r2[14] -= (f32x2v){a127[0], a127[1]} * T24; r2[15] -= (f32x2v){a127[2], a127[3]} * T24;
        const f32x4 a132 = *(const LAS f32x4*)(Ab + 1864);
        const float t25 = r2[12][1]; const f32x2v T25 = (f32x2v){t25, t25}; Tw[1800] = f2bf(t25); Tt[25] = f2bf(t25);
        r2[13] -= (f32x2v){a128[2], a128[3]} * T25;
        const f32x4 a133 = *(const LAS f32x4*)(Ab + 1932);
        r2[14] -= (f32x2v){a129[0], a129[1]} * T25; r2[15] -= (f32x2v){a129[2], a129[3]} * T25;
        const f32x4 a134 = *(const LAS f32x4*)(Ab + 2000);
        const float t26 = r2[13][0]; const f32x2v T26 = (f32x2v){t26, t26}; Tw[1872] = f2bf(t26); Tt[26] = f2bf(t26);
        r2[13] -= (f32x2v){a130[2], a130[3]} * T26;
        const f32x4 a135 = *(const LAS f32x4*)(Ab + 2068);
        r2[14] -= (f32x2v){a131[0], a131[1]} * T26; r2[15] -= (f32x2v){a131[2], a131[3]} * T26;
        const float t27 = r2[13][1]; const f32x2v T27 = (f32x2v){t27, t27}; Tw[1944] = f2bf(t27); Tt[27] = f2bf(t27);
        r2[14] -= (f32x2v){a132[0], a132[1]} * T27; r2[15] -= (f32x2v){a132[2], a132[3]} * T27;
        const float t28 = r2[14][0]; const f32x2v T28 = (f32x2v){t28, t28}; Tw[2016] = f2bf(t28); Tt[28] = f2bf(t28);
        r2[14] -= (f32x2v){a133[0], a133[1]} * T28; r2[15] -= (f32x2v){a133[2], a133[3]} * T28;
        const float t29 = r2[14][1]; const f32x2v T29 = (f32x2v){t29, t29}; Tw[2088] = f2bf(t29); Tt[29] = f2bf(t29);
        r2[15] -= (f32x2v){a134[2], a134[3]} * T29;
        const float t30 = r2[15][0]; const f32x2v T30 = (f32x2v){t30, t30}; Tw[2160] = f2bf(t30); Tt[30] = f2bf(t30);
        r2[15] -= (f32x2v){a135[2], a135[3]} * T30;
        Tw[2232] = f2bf(r2[15][1]); Tt[31] = f2bf(r2[15][1]);
    } else if (wid == 2) {
        *(LAS u32x4*)(Tb + (lane >> 1) * 72 + 32 + (lane & 1) * 16) = (u32x4){0u, 0u, 0u, 0u}; *(LAS u32x4*)(Tb + (lane >> 1) * 72 + 32 + (lane & 1) * 16 + 8) = (u32x4){0u, 0u, 0u, 0u};
    }
    __syncthreads();
    if (wid < 4) {
        const int mt = wid >> 1, nt = wid & 1; const f32x4 acc = tile_mm(A10b, 40, mt, TT, 40, nt, 1, fr, fq);
        u32x2 w; w.x = cvt_pk(acc[0], acc[1]); w.y = cvt_pk(acc[2], acc[3]); *(LAS u32x2*)(PT + (16 * nt + fr) * 40 + 16 * mt + 4 * fq) = w;
    }
    __syncthreads();
    if (wid < 4) {
        const int mt = wid >> 1, nt = wid & 1; const f32x4 acc = tile_mm(Tb + 32 * 72 + 32, 72, mt, PT, 40, nt, 1, fr, fq);
#pragma unroll
        for (int e = 0; e < 4; ++e) Tb[(32 + 16 * mt + 4 * fq + e) * 72 + 16 * nt + fr] = f2bf(-acc[e]);
    }
    __syncthreads();
#pragma unroll 2
    for (int r = 0; r < 8; ++r) {
        const int job = wid + 8 * r, kind = job >> 5, tile = job & 31, mt = tile >> 3, nt = tile & 7;
        const f32x4 acc = tile_mm<false, true>(Tb, 72, mt, kind ? KbT : VbT, 72, nt, 2, fr, fq);
        u32x2 w; w.x = cvt_pk(acc[0], acc[1]); w.y = cvt_pk(acc[2], acc[3]);
        { const int ch = 16 * nt + fr; *(LAS u32x2*)((kind ? WT : UT) + ch * 72 + 8 * ((2 * mt + (fq >> 1)) ^ ((ch >> 3) & 7)) + 4 * (fq & 1)) = w; }
    }
    __syncthreads();
    bf16_t* GM = (bf16_t*)(p.ws + WS_GM) + (size_t)unit * 16384; bf16_t* GN = (bf16_t*)(p.ws + WS_GN) + (size_t)unit * 16384;
    bf16_t* GQ = (bf16_t*)(p.ws + WS_GQ) + (size_t)unit * 8192; bf16_t* GO = (bf16_t*)(p.ws + WS_GO) + (size_t)unit * 8192;
#pragma unroll 2
    for (int r = 0; r < 24; ++r) {
        const int job = wid + 8 * r;
        if (job < 64) { const int a = job >> 3, mt = job & 7;
            const f32x4 acc = tile_mm<true, true>(WT, 72, a, KdT, 72, mt, 2, fr, fq);
            u32x2 w; w.x = cvt_pk(-acc[0], -acc[1]); w.y = cvt_pk(-acc[2], -acc[3]);
            *(u32x2*)(GM + ((mt * 4 + (a >> 1)) * 64 + lane) * 8 + (a & 1) * 4) = w;
        } else if (job < 128) { const int j = job - 64, mt = j >> 3, nt = j & 7;
            const f32x4 acc = tile_mm<true, true>(KdT, 72, mt, UT, 72, nt, 2, fr, fq);
            u32x2 w; w.x = cvt_pk(acc[0], acc[1]); w.y = cvt_pk(acc[2], acc[3]);
            *(u32x2*)(GN + ((nt * 64 + lane) * 8 + mt) * 4) = w;
        } else if (job < 160) { const int j = job - 128, a = j >> 2, it = j & 3;
            const f32x4 acc = tile_mm<true, false>(WT, 72, a, QK, 72, it, 2, fr, fq);
            const int i = 16 * it + fr; const float eg = __expf(gcs[i]);
            const u32x2 qv = *(const LAS u32x2*)(Qs + i * 136 + 16 * a + 4 * fq);
            u32x2 w; w.x = cvt_pk(bflo(qv.x) * eg - acc[0], bfhi(qv.x) * eg - acc[1]); w.y = cvt_pk(bflo(qv.y) * eg - acc[2], bfhi(qv.y) * eg - acc[3]);
            *(u32x2*)(GQ + ((it * 4 + (a >> 1)) * 64 + lane) * 8 + (a & 1) * 4) = w;
        } else { const int j = job - 160, mt = j >> 3, nt = j & 7;
            const f32x4 acc = tile_mm<false, true>(QK, 72, mt, UT, 72, nt, 2, fr, fq);
            u32x2 w; w.x = cvt_pk(acc[0], acc[1]); w.y = cvt_pk(acc[2], acc[3]);
            *(u32x2*)(GO + ((nt * 64 + lane) * 4 + mt) * 4) = w;
        }
    }
    if (tid == 0) ((float*)(p.ws + WS_CTL + CTL_GLAST))[unit] = __expf(gclast);
    __syncthreads();
}

__device__ __forceinline__ void gdn_scan(const Params& p, LAS unsigned char* lds, int sb) {
    const int tid = threadIdx.x, lane = tid & 63, wid = tid >> 6, fr = lane & 15, fq = lane >> 4;
    const int bh = sb / (8 / CW), sp = sb % (8 / CW), unit0 = bh * 128, sl = sp * CW + wid;
    const u32x4* GMb = (const u32x4*)((const bf16_t*)(p.ws + WS_GM) + (size_t)unit0 * 16384);
    const u32x4* GQb = (const u32x4*)((const bf16_t*)(p.ws + WS_GQ) + (size_t)unit0 * 8192);
    const bf16_t* GNb = (const bf16_t*)(p.ws + WS_GN) + (size_t)unit0 * 16384;
    bf16_t* GOb = (bf16_t*)(p.ws + WS_GO) + (size_t)unit0 * 8192;
    const float* glast = (const float*)(p.ws + WS_CTL + CTL_GLAST) + unit0;
    const bool loader = (wid >= CW && wid < CW + 4);
#define SCAN_DMA(cc) do { _Pragma("unroll") for (int k = 0; k < 8; ++k) { const int inst = (wid - CW) * 8 + k; \
        __builtin_amdgcn_global_load_lds((const unsigned*)((const char*)(GMb + (size_t)(cc) * 2048) + inst * 1024 + lane * 16), (LAS unsigned*)(lds + ((cc) & 3) * 32768 + inst * 1024), 16, 0, 0); } } while (0)
#define SCAN_LOADN(dn, cc) do { const bf16_t* np_ = GNb + (size_t)((cc) < 128 ? (cc) : 127) * 16384 + (size_t)(sl * 64 + lane) * 32; \
        asm volatile("global_load_dwordx4 %0, %4, off\n\tglobal_load_dwordx4 %1, %4, off offset:16\n\tglobal_load_dwordx4 %2, %4, off offset:32\n\tglobal_load_dwordx4 %3, %4, off offset:48" \
            : "=&v"(dn[0]), "=&v"(dn[1]), "=&v"(dn[2]), "=&v"(dn[3]) : "v"(np_) : "memory"); } while (0)
#define SCAN_WAITN(dn, N) asm volatile("s_waitcnt vmcnt(" #N ")" : "+v"(dn[0]), "+v"(dn[1]), "+v"(dn[2]), "+v"(dn[3]) :: "memory")
#define SCAN_STEP(c, nn, RELOAD) do { \
        SCAN_WAITN(nn, 8); \
        const float gl = __shfl(((c) < 64) ? glr0 : glr1, (c) & 63); bf16x8 Sb[4]; \
        bf16_t* scp = (bf16_t*)GNb + (size_t)(c) * 16384 + (size_t)sl * 2048 + lane * 8; \
        _Pragma("unroll") for (int ks = 0; ks < 4; ++ks) { u32x4 w; w.x = cvt_pk(S[2 * ks][0], S[2 * ks][1]); w.y = cvt_pk(S[2 * ks][2], S[2 * ks][3]); \
            w.z = cvt_pk(S[2 * ks + 1][0], S[2 * ks + 1][1]); w.w = cvt_pk(S[2 * ks + 1][2], S[2 * ks + 1][3]); Sb[ks] = __builtin_bit_cast(bf16x8, w); } \
        const LAS unsigned char* slot = lds + ((c) & 3) * 32768 + lane * 16; \
        bf16x8 fa[2][2][4]; \
        _Pragma("unroll") for (int ks = 0; ks < 4; ++ks) { fa[0][0][ks] = *(const LAS bf16x8*)(slot + (0 * 4 + ks) * 1024); fa[0][1][ks] = *(const LAS bf16x8*)(slot + (1 * 4 + ks) * 1024); } \
        _Pragma("unroll") for (int mt = 0; mt < 8; ++mt) { const unsigned w0 = nn[mt >> 1][(mt & 1) * 2], w1 = nn[mt >> 1][(mt & 1) * 2 + 1]; \
            S[mt] = S[mt] * gl + (f32x4){bflo(w0), bfhi(w0), bflo(w1), bfhi(w1)}; } \
        _Pragma("unroll") for (int ks = 0; ks < 4; ++ks) *(u32x4*)(scp + ks * 512) = __builtin_bit_cast(u32x4, Sb[ks]);     \
        RELOAD; \
        _Pragma("unroll") for (int pr = 0; pr < 4; ++pr) { \
            if (pr < 3) { _Pragma("unroll") for (int ks = 0; ks < 4; ++ks) { fa[(pr + 1) & 1][0][ks] = *(const LAS bf16x8*)(slot + ((2 * pr + 2) * 4 + ks) * 1024); fa[(pr + 1) & 1][1][ks] = *(const LAS bf16x8*)(slot + ((2 * pr + 3) * 4 + ks) * 1024); } } \
            _Pragma("unroll") for (int ks = 0; ks < 4; ++ks) { S[2 * pr] = mfma16(fa[pr & 1][0][ks], Sb[ks], S[2 * pr]); S[2 * pr + 1] = mfma16(fa[pr & 1][1][ks], Sb[ks], S[2 * pr + 1]); } } \
        } while (0)
    if (loader) { SCAN_DMA(0); SCAN_DMA(1); SCAN_DMA(2); asm volatile("s_waitcnt vmcnt(0)" ::: "memory"); }
    f32x4 S[8];
#pragma unroll
    for (int mt = 0; mt < 8; ++mt) S[mt] = (f32x4){0.f, 0.f, 0.f, 0.f};
    float glr0 = glast[lane], glr1 = glast[64 + lane];
    asm volatile("" : "+v"(glr0), "+v"(glr1));
    u32x4 nnA[4], nnB[4];
    if (wid < CW) { SCAN_LOADN(nnA, 0); SCAN_LOADN(nnB, 1); SCAN_WAITN(nnA, 0); SCAN_WAITN(nnB, 0); }
    asm volatile("s_waitcnt lgkmcnt(0)" ::: "memory"); __builtin_amdgcn_s_barrier(); asm volatile("" ::: "memory");
#pragma unroll 1
    for (int c = 0; c < 128; c += 2) {
        if (loader) { if (c + 3 < 128) { SCAN_DMA(c + 3); asm volatile("s_waitcnt vmcnt(16)" ::: "memory"); } else asm volatile("s_waitcnt vmcnt(0)" ::: "memory"); }
        else if (wid < CW) { SCAN_STEP(c, nnA, SCAN_LOADN(nnA, c + 2)); }
        asm volatile("s_waitcnt lgkmcnt(0)" ::: "memory"); __builtin_amdgcn_s_barrier(); asm volatile("" ::: "memory");
        if (loader) { if (c + 4 < 128) { SCAN_DMA(c + 4); asm volatile("s_waitcnt vmcnt(16)" ::: "memory"); } else asm volatile("s_waitcnt vmcnt(0)" ::: "memory"); }
        else if (wid < CW) { SCAN_STEP(c + 1, nnB, SCAN_LOADN(nnB, c + 3)); }
        asm volatile("s_waitcnt lgkmcnt(0)" ::: "memory"); __builtin_amdgcn_s_barrier(); asm volatile("" ::: "memory");
    }
#undef SCAN_DMA
#undef SCAN_LOADN
#undef SCAN_WAITN
#undef SCAN_STEP
    __syncthreads();
    if (wid < CW) {
        float* go = p.out + O_GP + (size_t)bh * 16384;
#pragma unroll
        for (int mt = 0; mt < 8; ++mt)
#pragma unroll
            for (int e = 0; e < 4; ++e) go[(16 * mt + 4 * fq + e) * 128 + sl * 16 + fr] = S[mt][e];
    }
}

__device__ __forceinline__ void gdn_gate_unit(const Params& p, int unit, int lane) {
    const int fr = lane & 15, fq = lane >> 4, bh = unit >> 7, n = unit & 127, b = bh >> 2, h = bh & 3, tok0 = b * SEQ + n * 64;
    const bf16_t* GO = (const bf16_t*)(p.ws + WS_GO) + (size_t)unit * 8192;
    bf16_t* PB = (bf16_t*)(p.ws + WS_H);
    {
        bf16_t* GOw = (bf16_t*)(p.ws + WS_GO) + (size_t)unit * 8192;
        const bf16_t* GQ = (const bf16_t*)(p.ws + WS_GQ) + (size_t)unit * 8192; const bf16_t* SC = (const bf16_t*)(p.ws + WS_GN) + (size_t)unit * 16384;
        bf16x8 qa[4][4];
#pragma unroll
        for (int mt = 0; mt < 4; ++mt)
#pragma unroll
            for (int ks = 0; ks < 4; ++ks) qa[mt][ks] = *(const bf16x8*)(GQ + ((mt * 4 + ks) * 64 + lane) * 8);
#pragma unroll 2
        for (int nt = 0; nt < 8; ++nt) {
            bf16x8 sb[4];
#pragma unroll
            for (int ks = 0; ks < 4; ++ks) sb[ks] = *(const bf16x8*)(SC + nt * 2048 + (ks * 64 + lane) * 8);
            const u32x4 o0 = *(const u32x4*)(GOw + (nt * 64 + lane) * 16), o1 = *(const u32x4*)(GOw + (nt * 64 + lane) * 16 + 8);
            f32x4 acc[4];
            acc[0] = (f32x4){bflo(o0.x), bfhi(o0.x), bflo(o0.y), bfhi(o0.y)}; acc[1] = (f32x4){bflo(o0.z), bfhi(o0.z), bflo(o0.w), bfhi(o0.w)};
            acc[2] = (f32x4){bflo(o1.x), bfhi(o1.x), bflo(o1.y), bfhi(o1.y)}; acc[3] = (f32x4){bflo(o1.z), bfhi(o1.z), bflo(o1.w), bfhi(o1.w)};
#pragma unroll
            for (int ks = 0; ks < 4; ++ks)
#pragma unroll
                for (int mt = 0; mt < 4; ++mt) acc[mt] = mfma16(qa[mt][ks], sb[ks], acc[mt]);
            u32x4 w0, w1;
            w0.x = cvt_pk(acc[0][0], acc[0][1]); w0.y = cvt_pk(acc[0][2], acc[0][3]); w0.z = cvt_pk(acc[1][0], acc[1][1]); w0.w = cvt_pk(acc[1][2], acc[1][3]);
            w1.x = cvt_pk(acc[2][0], acc[2][1]); w1.y = cvt_pk(acc[2][2], acc[2][3]); w1.z = cvt_pk(acc[3][0], acc[3][1]); w1.w = cvt_pk(acc[3][2], acc[3][3]);
            *(u32x4*)(GOw + (nt * 64 + lane) * 16) = w0; *(u32x4*)(GOw + (nt * 64 + lane) * 16 + 8) = w1;
        }
        asm volatile("s_waitcnt vmcnt(0)" ::: "memory");
    }
    float ssq[16];
#pragma unroll
    for (int k = 0; k < 16; ++k) ssq[k] = 0.f;
#pragma unroll 1
    for (int nt = 0; nt < 8; ++nt) {
        const u32x4 a0 = *(const u32x4*)(GO + (nt * 64 + lane) * 16), a1 = *(const u32x4*)(GO + (nt * 64 + lane) * 16 + 8);
#pragma unroll
        for (int k = 0; k < 4; ++k) { const float l0 = bflo(a0[k]), h0 = bfhi(a0[k]), l1 = bflo(a1[k]), h1 = bfhi(a1[k]);
            ssq[2 * k] += l0 * l0; ssq[2 * k + 1] += h0 * h0; ssq[8 + 2 * k] += l1 * l1; ssq[8 + 2 * k + 1] += h1 * h1; }
    }
#pragma unroll
    for (int k = 0; k < 16; ++k) { float s = ssq[k]; s += __shfl_xor(s, 1); s += __shfl_xor(s, 2); s += __shfl_xor(s, 4); s += __shfl_xor(s, 8); ssq[k] = rsqrtf(s * (1.0f / 128.0f) + EPS); }
    const float* gn = p.in[15];
#pragma unroll 1
    for (int nt = 0; nt < 8; ++nt) {
        const int dv = 16 * nt + fr; const float g = gn[dv];
        const u32x4 a0 = *(const u32x4*)(GO + (nt * 64 + lane) * 16), a1 = *(const u32x4*)(GO + (nt * 64 + lane) * 16 + 8);
        const bf16_t* gzp = PB + (size_t)(tok0 + 4 * fq) * PW + 2304 + h * 128 + dv; bf16_t* mp = PB + (size_t)(tok0 + 4 * fq) * PW + 512 + h * 128 + dv;
#pragma unroll
        for (int k = 0; k < 16; ++k) {
            const unsigned w = (k < 8) ? a0[(k >> 1) & 3] : a1[(k >> 1) & 3]; const float o = (k & 1) ? bfhi(w) : bflo(w);
            const int to = 16 * (k >> 2) + (k & 3);
            const float gz = bf2f(gzp[(size_t)to * PW]);
            mp[(size_t)to * PW] = f2bf(o * ssq[k] * g * silu(gz));
        }
    }
}

__device__ __forceinline__ void attn_unit(const Params& p, LAS unsigned char* lds, int unit) {
    const int tid = threadIdx.x, lane = tid & 63, wid = tid >> 6, fr = lane & 15, fq = lane >> 4;
    const int b = unit >> 7, blk = (unit >> 1) & 63, kvh = unit & 1;
    LAS bf16_t* Ks = (LAS bf16_t*)lds; LAS bf16_t* Vt = (LAS bf16_t*)(lds + 36864);
    bf16_t* PB = (bf16_t*)(p.ws + WS_H);
    __syncthreads();
#pragma unroll
    for (int i = 0; i < 4; ++i) {
        const int q = tid + 512 * i, row = q >> 3, ch = q & 7, tp = blk * 128 - 128 + row;
        u32x4 kv = (u32x4){0u, 0u, 0u, 0u}, vv = (u32x4){0u, 0u, 0u, 0u};
        if (tp >= 0) { const bf16_t* base = PB + (size_t)(b * SEQ + tp) * PW; kv = *(const u32x4*)(base + 512 + kvh * 64 + ch * 8); vv = *(const u32x4*)(base + 640 + kvh * 64 + ch * 8); }
        *(LAS u32x4*)(Ks + row * 72 + ch * 8) = kv;
#pragma unroll
        for (int e = 0; e < 4; ++e) { const unsigned w = vv[e]; Vt[(ch * 8 + 2 * e) * 264 + row] = (bf16_t)(w & 0xffffu); Vt[(ch * 8 + 2 * e + 1) * 264 + row] = (bf16_t)(w >> 16); }
    }
    __syncthreads();
    const int qtok = b * SEQ + blk * 128 + 16 * wid + fr;
#pragma unroll 1
    for (int g = 0; g < 4; ++g) {
        const int h = kvh * 4 + g; const float slope = exp2f(-(float)(h + 1)), sink = p.in[11][h];
        bf16x8 qf[2];
#pragma unroll
        for (int ks = 0; ks < 2; ++ks) qf[ks] = *(const bf16x8*)(PB + (size_t)qtok * PW + h * 64 + ks * 32 + 8 * fq);
        f32x4 s[10]; float mx = sink;
#pragma unroll
        for (int j = 0; j < 10; ++j) {
            const int ct = (wid + j) < 15 ? (wid + j) : 15;
            f32x4 acc = (f32x4){0.f, 0.f, 0.f, 0.f};
#pragma unroll
            for (int ks = 0; ks < 2; ++ks) acc = mfma16(*(const LAS bf16x8*)(Ks + (16 * ct + fr) * 72 + ks * 32 + 8 * fq), qf[ks], acc);
#pragma unroll
            for (int e = 0; e < 4; ++e) {
                const int c = 16 * (wid + j) + 4 * fq + e, dist = 16 * wid + fr - c + 128;
                const bool ok = (wid + j <= 15) && dist >= 0 && dist <= 128 && (blk * 128 + c - 128 >= 0);
                const float v = ok ? acc[e] * 0.125f - slope * (float)dist : -INFINITY;
                acc[e] = v; mx = fmaxf(mx, v);
            }
            s[j] = acc;
            asm volatile("" ::: "memory");
        }
        mx = fmaxf(mx, __shfl_xor(mx, 16)); mx = fmaxf(mx, __shfl_xor(mx, 32));
        float sum = 0.f;
#pragma unroll
        for (int j = 0; j < 10; ++j)
#pragma unroll
            for (int e = 0; e < 4; ++e) { const float pv = __expf(s[j][e] - mx); s[j][e] = pv; sum += pv; }
        sum += __shfl_xor(sum, 16); sum += __shfl_xor(sum, 32);
        sum += __expf(sink - mx);
        const float inv = 1.0f / sum;
        bf16x8 pb[5];
#pragma unroll
        for (int kk = 0; kk < 5; ++kk) { u32x4 w; w.x = cvt_pk(s[2 * kk][0] * inv, s[2 * kk][1] * inv); w.y = cvt_pk(s[2 * kk][2] * inv, s[2 * kk][3] * inv);
            w.z = cvt_pk(s[2 * kk + 1][0] * inv, s[2 * kk + 1][1] * inv); w.w = cvt_pk(s[2 * kk + 1][2] * inv, s[2 * kk + 1][3] * inv); pb[kk] = __builtin_bit_cast(bf16x8, w); }
#pragma unroll
        for (int dt = 0; dt < 4; ++dt) {
            f32x4 acc = (f32x4){0.f, 0.f, 0.f, 0.f};
#pragma unroll
            for (int kk = 0; kk < 5; ++kk) {
                const int c0 = (wid + 2 * kk) < 15 ? (wid + 2 * kk) : 15, c1 = (wid + 2 * kk + 1) < 15 ? (wid + 2 * kk + 1) : 15;
                const u32x2 lo = *(const LAS u32x2*)(Vt + (16 * dt + fr) * 264 + 16 * c0 + 4 * fq), hi = *(const LAS u32x2*)(Vt + (16 * dt + fr) * 264 + 16 * c1 + 4 * fq);
                const u32x4 a = (u32x4){lo.x, lo.y, hi.x, hi.y};
                acc = mfma16(__builtin_bit_cast(bf16x8, a), pb[kk], acc);
            }
            u32x2 w; w.x = cvt_pk(acc[0], acc[1]); w.y = cvt_pk(acc[2], acc[3]);
            *(u32x2*)(PB + (size_t)qtok * PW + h * 64 + 16 * dt + 4 * fq) = w;
            asm volatile("" ::: "memory");
        }
    }
}

__device__ __forceinline__ void sattn_unit(const Params& p, int s, int h, int lane) {
    const int kvh = h >> 2; const bool wr = (h & 3) == 0;
    bf16_t* PB = (bf16_t*)(p.ws + WS_H) + (size_t)(MPR + s) * PW;
    const float* ck = p.in[2] + (size_t)s * 128 * 128 + kvh * 64 + lane; const float* cv = p.in[3] + (size_t)s * 128 * 128 + kvh * 64 + lane;
    float* nk = p.out + O_KS + (size_t)s * 128 * 128 + kvh * 64 + lane; float* nv = p.out + O_VS + (size_t)s * 128 * 128 + kvh * 64 + lane;
    const float q = bf2f(PB[h * 64 + lane]) * 0.125f, slope = exp2f(-(float)(h + 1)), sink = p.in[11][h];
    const float knew = bf2f(PB[512 + kvh * 64 + lane]), vnew = bf2f(PB[640 + kvh * 64 + lane]);
    float sc[3];
#pragma unroll
    for (int t = 0; t < 2; ++t) {
#pragma unroll 8
        for (int jj = 0; jj < 64; ++jj) {
            const int j = t * 64 + jj; const float kval = ck[(size_t)j * 128];
            if (wr && j >= 1) nk[(size_t)(j - 1) * 128] = kval;
            const float d = wave_sum(q * kval) - slope * (float)(128 - j); if (lane == jj) sc[t] = d;
        }
    }
    if (wr) nk[(size_t)127 * 128] = knew;
    sc[2] = wave_sum(q * knew);
    const float mx = fmaxf(fmaxf(wave_max(fmaxf(sc[0], sc[1])), sc[2]), sink);
    const float p0 = __expf(sc[0] - mx), p1 = __expf(sc[1] - mx), p2 = __expf(sc[2] - mx);
    const float inv = 1.0f / (wave_sum(p0 + p1) + p2 + __expf(sink - mx));
    float o = p2 * vnew;
#pragma unroll 8
    for (int jj = 0; jj < 64; ++jj) { const float vval = cv[(size_t)jj * 128]; if (wr && jj >= 1) nv[(size_t)(jj - 1) * 128] = vval; o += __shfl(p0, jj) * vval; }
#pragma unroll 8
    for (int jj = 0; jj < 64; ++jj) { const float vval = cv[(size_t)(64 + jj) * 128]; if (wr) nv[(size_t)(63 + jj) * 128] = vval; o += __shfl(p1, jj) * vval; }
    if (wr) nv[(size_t)127 * 128] = vnew;
    asm volatile("" ::: "memory");
    PB[h * 64 + lane] = f2bf(o * inv);
}

__device__ __forceinline__ void sgdn_unit(const Params& p, LAS unsigned char* lds, int s) {
    const int tid = threadIdx.x, wid = tid >> 6, h = tid >> 7, dv = tid & 127;
    LAS float* qs = (LAS float*)lds; LAS float* ks = qs + 512; LAS float* red = ks + 512;
    bf16_t* PB = (bf16_t*)(p.ws + WS_H) + (size_t)(MPR + s) * PW; const float* GBA = (const float*)(p.ws + WS_GBA) + (size_t)(MPR + s) * 8;
    const float* cw = p.in[12]; const float* hc = p.in[4] + (size_t)s * 3 * CONVC; float* nc = p.out + O_CS + (size_t)s * 3 * CONVC;
    __syncthreads();
    float val[3];
#pragma unroll
    for (int i = 0; i < 3; ++i) {
        const int c = i * 512 + tid; const float x3 = bf2f(PB[768 + c]), h0 = hc[c], h1 = hc[CONVC + c], h2 = hc[2 * CONVC + c];
        val[i] = silu(cw[c] * h0 + cw[CONVC + c] * h1 + cw[2 * CONVC + c] * h2 + cw[3 * CONVC + c] * x3);
        nc[c] = h1; nc[CONVC + c] = h2; nc[2 * CONVC + c] = x3;
    }
    const float sq = wave_sum(val[0] * val[0]), sk = wave_sum(val[1] * val[1]);
    if ((tid & 63) == 0) { red[wid] = sq; red[8 + wid] = sk; }
    __syncthreads();
    const float ssq = red[2 * h] + red[2 * h + 1], ssk = red[8 + 2 * h] + red[8 + 2 * h + 1];
    qs[tid] = val[0] * rsqrtf(ssq + EPS) * 0.08838834764831845f; ks[tid] = val[1] * rsqrtf(ssk + EPS);
    __syncthreads();
    const float beta = 1.0f / (1.0f + __expf(-GBA[h]));
    const float x = GBA[4 + h] + p.in[14][h]; const float sp = x > 20.f ? x : log1pf(__expf(x));
    const float eg = __expf(-__expf(p.in[13][h]) * sp);
    const float* S0 = p.in[5] + ((size_t)(s * 4 + h) * 128) * 128 + dv; float* S1 = p.out + O_GS + ((size_t)(s * 4 + h) * 128) * 128 + dv;
    float kS = 0.f;
#pragma unroll 1
    for (int hf = 0; hf < 4; ++hf) { float sv[32];
#pragma unroll
        for (int dk = 0; dk < 32; ++dk) sv[dk] = S0[(size_t)(hf * 32 + dk) * 128];
#pragma unroll
        for (int dk = 0; dk < 32; ++dk) kS += ks[h * 128 + hf * 32 + dk] * sv[dk]; }
    const float delta = beta * (val[2] - eg * kS);
    float o = 0.f;
#pragma unroll 1
    for (int hf = 0; hf < 4; ++hf) { float sv[32];
#pragma unroll
        for (int dk = 0; dk < 32; ++dk) sv[dk] = S0[(size_t)(hf * 32 + dk) * 128];
#pragma unroll
        for (int dk = 0; dk < 32; ++dk) { const float nvv = eg * sv[dk] + ks[h * 128 + hf * 32 + dk] * delta; S1[(size_t)(hf * 32 + dk) * 128] = nvv; o += qs[h * 128 + hf * 32 + dk] * nvv; } }
    const float so = wave_sum(o * o);
    if ((tid & 63) == 0) red[16 + wid] = so;
    __syncthreads();
    const float tot = red[16 + 2 * h] + red[16 + 2 * h + 1];
    const float gz = bf2f(PB[2304 + tid]);
    PB[512 + tid] = f2bf(o * rsqrtf(tot * (1.0f / 128.0f) + EPS) * p.in[15][dv] * silu(gz));
}

#define XB_TMO      128
#define XB_XCNT(j)  (256  + 64 * (j))
#define XB_XSUB(j)  (1280 + 64 * (j))
#define XB_XGEN(j)  (2304 + 64 * (j))
#define XB_TOP      3328
#define XB_TOPGEN   3392
#define XCD_BAR_WORDS 3456
#define XB_SPIN_CAP (1u << 18)

__device__ __forceinline__ unsigned xb_ld(unsigned* p)              { return __hip_atomic_load(p, __ATOMIC_RELAXED, __HIP_MEMORY_SCOPE_AGENT); }
__device__ __forceinline__ unsigned xb_add(unsigned* p, unsigned v) { return __hip_atomic_fetch_add(p, v, __ATOMIC_RELAXED, __HIP_MEMORY_SCOPE_AGENT); }
__device__ __forceinline__ unsigned xb_xcc_id() { return (unsigned)__builtin_amdgcn_s_getreg((3 << 11) | 20) & 0xFu; }
#define XB_SPIN(cond, bar) do { unsigned _sp = 0; while (cond) { __builtin_amdgcn_s_sleep(1); \
    if ((++_sp & 255u) == 0u) { if (xb_ld(&(bar)[XB_TMO])) break; if (_sp > XB_SPIN_CAP) { atomicAdd(&(bar)[XB_TMO], 1u); break; } } } } while (0)

struct XcdBarrier {
    unsigned* bar; unsigned x;
    volatile LAS unsigned* st;
};

__device__ __forceinline__ XcdBarrier xcd_barrier_post(unsigned* bar, volatile LAS unsigned* st) {
    XcdBarrier b; b.bar = bar; b.x = xb_xcc_id(); b.st = st;
    if (threadIdx.x == 0) (void)xb_add(&bar[XB_XCNT(b.x)], 1u);
    return b;
}
__device__ __forceinline__ void xcd_barrier_complete(unsigned* bar, unsigned x, unsigned& nloc, unsigned& nx) {
    const unsigned G = gridDim.x * gridDim.y * gridDim.z;
    unsigned sum, cnt, mine, sp = 0u;
    for (;;) {
        sum = 0u; cnt = 0u; mine = 0u;
#pragma unroll
        for (unsigned j = 0; j < 16; ++j) { const unsigned c = xb_ld(&bar[XB_XCNT(j)]); sum += c; cnt += (c > 0u) ? 1u : 0u; mine = (j == x) ? c : mine; }
        if (sum == G) break;
        __builtin_amdgcn_s_sleep(1);
        if ((++sp & 255u) == 0u) { if (xb_ld(&bar[XB_TMO])) break; if (sp > XB_SPIN_CAP) { atomicAdd(&bar[XB_TMO], 1u); break; } }
    }
    nloc = mine > 0u ? mine : 1u; nx = cnt > 0u ? cnt : 1u;
}

__device__ __forceinline__ void xcd_barrier(const XcdBarrier& b) {
    asm volatile("s_waitcnt vmcnt(0)" ::: "memory");
    __syncthreads();
    if (threadIdx.x == 0) {
        unsigned* bar = b.bar;
        __builtin_amdgcn_s_waitcnt(0);
        unsigned nloc = b.st[0], nx = b.st[1];
        if (nloc == 0u) { xcd_barrier_complete(bar, b.x, nloc, nx); b.st[0] = nloc; b.st[1] = nx; }
        const unsigned old = xb_add(&bar[XB_XSUB(b.x)], 1u);
        const unsigned gen = old / nloc;
        if (old + 1u == (gen + 1u) * nloc) {
            __builtin_amdgcn_fence(__ATOMIC_RELEASE, "agent");
            asm volatile("s_waitcnt vmcnt(0)" ::: "memory");
            const unsigned og = xb_add(&bar[XB_TOP], 1u);
            const unsigned tg = og / nx;
            if (og + 1u == (tg + 1u) * nx) xb_add(&bar[XB_TOPGEN], 1u);
            else XB_SPIN(xb_ld(&bar[XB_TOPGEN]) == tg, bar);
            __builtin_amdgcn_fence(__ATOMIC_ACQUIRE, "agent");
            xb_add(&bar[XB_XGEN(b.x)], 1u);
            asm volatile("s_waitcnt vmcnt(0)" ::: "memory");
        } else {
            XB_SPIN(xb_ld(&bar[XB_XGEN(b.x)]) == gen, bar);
            __builtin_amdgcn_fence(__ATOMIC_ACQUIRE, "agent");
            asm volatile("s_waitcnt vmcnt(0)" ::: "memory");
        }
    }
    __syncthreads();
}

__global__ void __launch_bounds__(512, 2) fwd_kernel(Params p, int ph_lo, int ph_hi) {
    extern __shared__ __attribute__((aligned(16))) unsigned char lds_raw[];
    LAS unsigned char* lds = (LAS unsigned char*)lds_raw;
    cg::grid_group grid = cg::this_grid();
    if (ph_lo < 0) grid.sync();
    volatile LAS unsigned* bst = (volatile LAS unsigned*)(lds + LDS_PHASE_BYTES);
    if (threadIdx.x < 2) bst[threadIdx.x] = 0u;
    __syncthreads();
    XcdBarrier xbar; xbar.bar = (unsigned*)(p.ws + WS_CTL + CTL_BAR); xbar.x = 0; xbar.st = bst;
    if (ph_hi - ph_lo > 1) xbar = xcd_barrier_post((unsigned*)(p.ws + WS_CTL + CTL_BAR), bst);
    const int tid = threadIdx.x, lane = tid & 63, wid = tid >> 6, G = gridDim.x, bx = blockIdx.x;
    unsigned char* ws = p.ws;
    bf16_t* XN = (bf16_t*)(ws + WS_XN); bf16_t* XN2 = (bf16_t*)(ws + WS_XN2); bf16_t* HB = (bf16_t*)(ws + WS_H);
    float* SS1 = (float*)(ws + WS_SSP1); float* SS2 = (float*)(ws + WS_SSP2);
    float* Y = p.out; float* X2 = (float*)(ws + WS_GM); float* X3 = (float*)(ws + WS_XN);
#ifndef PHMASK
#define PHMASK 0x7ff
#endif
#define IN(k) (((PHMASK >> (k)) & 1) && ph_lo <= (k) && (k) < ph_hi)
#define SEAM(k) do { if (IN(k) && IN((k) + 1)) { xcd_barrier(xbar); }     } while (0)

    if (IN(0)) p0_prologue(p, lds, bx, G);
    SEAM(0);
    if (IN(1)) {
        if (bx < 176) sk_ffn_in<false>(XN, (const bf16_t*)(ws + WS_W1IN), HB, bx, wid, lane & 15, lane >> 4);
        pg8::Gemm g{XN, (const bf16_t*)(ws + WS_W1IN), MPR, 2 * DFF, DM, DM}; pg8::StaticOrder S; S.init(MPR, 2 * DFF, G, bx);
        EpiSwiglu E{HB, nullptr}; pg8::gemm_phase<EpiSwiglu, pg8::StaticOrder, GEMM_ALIGN, GEMM_SP2>(lds, g, S, E);
    }
    SEAM(1);
    if (IN(2)) {
        if (bx < 64) sk_ffn_out<false>(HB, (const bf16_t*)(ws + WS_W1OUT), p.in[1], nullptr, XN + (size_t)MPR * DM, bx, wid, lane & 15, lane >> 4);
        pg8::Gemm g{HB, (const bf16_t*)(ws + WS_W1OUT), MPR, DM, DFF, DFF}; pg8::StaticOrder S; S.init(MPR, DM, G, bx);
        EpiResid<false, false, true, true, true> E{p.in[0], p.in[1], nullptr, XN, SS1}; pg8::gemm_phase<EpiResid<false, false, true, true, true>, pg8::StaticOrder, GEMM_ALIGN, GEMM_SP2>(lds, g, S, E);
    }
    SEAM(2);
    if (IN(3)) {
        if (bx < 89) sk_inproj(XN, (const bf16_t*)(ws + WS_WINMIX), HB, (float*)(ws + WS_GBA), bx, wid, lane & 15, lane >> 4);
        pg8::Gemm g{XN, (const bf16_t*)(ws + WS_WINMIX), MPR, NINP, DM, DM}; pg8::StaticOrder S; S.init(MPR, NINP, G, bx);
        EpiInproj E{HB, (float*)(ws + WS_GBA), SS1}; pg8::gemm_phase<EpiInproj, pg8::StaticOrder, GEMM_ALIGN, GEMM_SP2>(lds, g, S, E);
    }
    SEAM(3);
    if (IN(4)) {
        for (int u = bx; u < 2048; u += G) gdn_prep_unit(p, lds, u);
    }
    SEAM(4);
    if (IN(5)) {
        if (bx < NSCAN) gdn_scan(p, lds, bx);
        else {
            const int ab = bx - NSCAN, NAB = G - NSCAN;
            if (NAB == 192) {
                if (ab < 128) { sattn_unit(p, ab, wid, lane); sgdn_unit(p, lds, ab); attn_unit(p, lds, 2 * ab); attn_unit(p, lds, 2 * ab + 1); }
                else { for (int k = 0; k < 4; ++k) attn_unit(p, lds, 256 + (ab - 128) * 4 + k); }
            } else {
                int it = ab;
#pragma unroll 1
                for (; it < 512; it += NAB) attn_unit(p, lds, it);
#pragma unroll 1
                for (; it < 640; it += NAB) { sattn_unit(p, it - 512, wid, lane); sgdn_unit(p, lds, it - 512); }
            }
            const bf16_t* PB = HB;
            for (int idx = ab * 512 + tid; idx < 149504; idx += NAB * 512) {
                if (idx < 131072) { const int w = idx >> 16, r = idx & 65535, b = r >> 14, j = (r >> 7) & 127, c = r & 127;
                    p.out[(w ? O_VP : O_KP) + r] = bf2f(PB[(size_t)(b * SEQ + SEQ - 128 + j) * PW + 512 + w * 128 + c]);
                } else { const int r = idx - 131072, b = r / (3 * CONVC), q = r % (3 * CONVC), rr = q / CONVC, c = q % CONVC;
                    p.out[O_CP + r] = bf2f(PB[(size_t)(b * SEQ + SEQ - 3 + rr) * PW + 768 + c]); }
            }
        }
    }
    SEAM(5);
    if (IN(6)) {
        for (int u = bx * 8 + wid; u < 2048; u += G * 8) gdn_gate_unit(p, u, lane);
    }
    SEAM(6);
#ifdef DBG_DUMP
    if (ph_lo == 11) {
        const float* src = (const float*)(ws + DBG_SRC);
        for (size_t i = (size_t)bx * 512 + tid; i < (size_t)MREAL * DM; i += (size_t)G * 512) Y[i] = (i < (size_t)MREAL * 8) ? ((const float*)(ws + WS_GBA))[i] : 0.f;
    }
#endif
    if (IN(7)) {
        if (bx < 32) sk_outproj(HB, (const bf16_t*)(ws + WS_WOUTMIX), XN, X2, XN2, bx, wid, lane & 15, lane >> 4);
        pg8::Gemm g{HB, (const bf16_t*)(ws + WS_WOUTMIX), MPR, DM, DM, PW}; pg8::StaticOrder S; S.init(MPR, DM, G, bx);
        EpiResid<true, true, true, true, false> E{XN, XN + (size_t)MPR * DM, X2, XN2, SS2}; pg8::gemm_phase<EpiResid<true, true, true, true, false>, pg8::StaticOrder, GEMM_ALIGN, GEMM_SP2>(lds, g, S, E);
    }
    SEAM(7);
    if (IN(8)) {
        if (bx < 176) sk_ffn_in<true>(XN2, (const bf16_t*)(ws + WS_W2IN), HB, bx, wid, lane & 15, lane >> 4);
        pg8::Gemm g{XN2, (const bf16_t*)(ws + WS_W2IN), MPR, 2 * DFF, DM, DM}; pg8::StaticOrder S; S.init(MPR, 2 * DFF, G, bx);
        EpiSwiglu E{HB, SS2}; pg8::gemm_phase<EpiSwiglu, pg8::StaticOrder, GEMM_ALIGN, GEMM_SP2>(lds, g, S, E);
    }
    SEAM(8);
    if (IN(9)) {
        if (bx < 64) sk_ffn_out<true>(HB, (const bf16_t*)(ws + WS_W2OUT), X2 + (size_t)MPR * DM, X3 + (size_t)MPR * DM, nullptr, bx, wid, lane & 15, lane >> 4);
        pg8::Gemm g{HB, (const bf16_t*)(ws + WS_W2OUT), MPR, DM, DFF, DFF}; pg8::StaticOrder S; S.init(MPR, DM, G, bx);
        EpiResid<false, true, false, false, true> E{X2, X2 + (size_t)MPR * DM, X3, nullptr, nullptr}; pg8::gemm_phase<EpiResid<false, true, false, false, true>, pg8::StaticOrder, GEMM_ALIGN, GEMM_SP2>(lds, g, S, E);
    }
    SEAM(9);
    if (IN(10)) {
        const float* gf = p.in[20]; f32x4 gv[4];
#pragma unroll
        for (int j = 0; j < 4; ++j) gv[j] = *((const f32x4*)gf + lane + 64 * j);
        {
            f32x4 v[4], vn[4]; int m = bx * 8 + wid;
            if (m < MREAL) { const f32x4* xr = (const f32x4*)(X3 + (size_t)m * DM) + lane;
#pragma unroll
                for (int j = 0; j < 4; ++j) v[j] = xr[64 * j]; }
            for (; m < MREAL; m += G * 8) {
                const int mn = m + G * 8;
                if (mn < MREAL) { const f32x4* xr = (const f32x4*)(X3 + (size_t)mn * DM) + lane;
#pragma unroll
                    for (int j = 0; j < 4; ++j) vn[j] = xr[64 * j]; }
                float s = 0.f;
#pragma unroll
                for (int j = 0; j < 4; ++j) s += (v[j][0] * v[j][0] + v[j][1] * v[j][1]) + (v[j][2] * v[j][2] + v[j][3] * v[j][3]);
                const float rstd = rsqrtf(wave_sum(s) * (1.0f / DM) + EPS);
                f32x4* yr = (f32x4*)(Y + (size_t)m * DM) + lane;
#pragma unroll
                for (int j = 0; j < 4; ++j) yr[64 * j] = v[j] * rstd * gv[j];
#pragma unroll
                for (int j = 0; j < 4; ++j) v[j] = vn[j];
            }
        }
    }
#undef IN
#undef SEAM
}
}

#ifndef MK_N_LAUNCHES
#define MK_N_LAUNCHES 1
#endif
extern "C" void kernel_launch(void* const* d_in, const int* in_sizes, int n_in, void* d_out, int out_size, void* d_ws, size_t ws_size, hipStream_t stream) {
    static int grid = 0;
    if (grid == 0) {
        if (n_in != 21 || ws_size < mk::WS_END || out_size != 47269888) { fprintf(stderr, "kernel_launch: unexpected shapes (n_in %d, ws %zu, out %d)\n", n_in, ws_size, out_size); grid = -1; return; }
        int dev = 0, cus = 0, per_cu = 0;
        (void)hipGetDevice(&dev); (void)hipDeviceGetAttribute(&cus, hipDeviceAttributeMultiprocessorCount, dev);
        if (hipFuncSetAttribute((const void*)mk::fwd_kernel, hipFuncAttributeMaxDynamicSharedMemorySize, mk::LDS_BYTES) != hipSuccess) { fprintf(stderr, "kernel_launch: hipFuncSetAttribute failed\n"); grid = -1; return; }
        if (hipOccupancyMaxActiveBlocksPerMultiprocessor(&per_cu, (const void*)mk::fwd_kernel, 512, mk::LDS_BYTES) != hipSuccess || per_cu < 1) { fprintf(stderr, "kernel_launch: occupancy query failed (%d)\n", per_cu); per_cu = 1; }
        (void)hipGetLastError();
        grid = cus * per_cu;
        if (grid <= mk::NSCAN) { fprintf(stderr, "kernel_launch: grid %d too small\n", grid); grid = -1; return; }
    }
    if (grid < 0) return;
    (void)hipMemsetAsync((char*)d_ws + mk::WS_CTL + mk::CTL_BAR, 0, mk::CTL_BAR_BYTES, stream);
    mk::Params p{};
    for (int i = 0; i < 21; ++i) p.in[i] = (const float*)d_in[i];
    p.out = (float*)d_out; p.ws = (unsigned char*)d_ws;
#if MK_N_LAUNCHES == 1
    int lo = 0, hi = 11; void* args[] = {&p, &lo, &hi};
    hipError_t e = hipLaunchCooperativeKernel((const void*)mk::fwd_kernel, dim3(grid), dim3(512), args, mk::LDS_BYTES, stream);
    if (e != hipSuccess) fprintf(stderr, "kernel_launch: cooperative launch failed: %s (grid %d)\n", hipGetErrorString(e), grid);
#else
#ifndef MK_LAST
#define MK_LAST 11
#ifndef MK_DOUBLE
#define MK_DOUBLE 0x0
#endif
#define DBG_C0 512
#define DBG_C1 1024
#endif
    for (int ph = 0; ph < MK_LAST; ++ph) { const int reps = ((MK_DOUBLE >> ph) & 1) ? 2 : 1; for (int r = 0; r < reps; ++r) hipLaunchKernelGGL(mk::fwd_kernel, dim3(grid), dim3(512), mk::LDS_BYTES, stream, p, ph, ph + 1); }
#ifdef DBG_DUMP
    hipLaunchKernelGGL(mk::fwd_kernel, dim3(grid), dim3(512), mk::LDS_BYTES, stream, p, 11, 12);
#endif
#endif
}
```

```cpp
#include <hip/hip_runtime.h>
#include <hip/hip_cooperative_groups.h>
#include <cstdio>
namespace cg = cooperative_groups;
namespace pg8 {
#define PG8_LAS __attribute__((address_space(3)))
typedef unsigned short bf16_t;
typedef short bf16x8 __attribute__((ext_vector_type(8)));
typedef float f32x4 __attribute__((ext_vector_type(4)));
typedef unsigned u32x4 __attribute__((ext_vector_type(4)));
constexpr int BM = 256, BK = 64, HALF = 128, HTB = HALF * BK * 2  , STAGE_BYTES = 8 * HTB, NXCD = 8, WGM = 4;

__host__ __device__ __forceinline__ int lds_byte(int r, int c) { const int st = (r >> 4) * 2 + (c >> 5), rr = r & 15, cc = c & 31, ob = rr * 64 + cc * 2; return st * 1024 + (ob ^ (((ob >> 9) & 1) << 5)); }
__host__ __device__ __forceinline__ void stage_rc(int b, int& R, int& C) { const int st = b / 1024, sb = b % 1024, swz = sb ^ (((sb >> 9) & 1) << 5); R = (st >> 1) * 16 + swz / 64; C = (st & 1) * 32 + (swz % 64) / 2; }
__host__ __device__ __forceinline__ int perm32(int rho) { const int n = rho >> 4, i = rho & 15; return 8 * (i >> 2) + 4 * n + (i & 3); }

struct Unit { int pm, pn; };
struct Gemm { const bf16_t* A; const bf16_t* Bt; int M, N, K, lda; };

struct StaticOrder {
    int nM, nN, nwg, G, c, wgm;
    __host__ __device__ void init(int M, int N, int G_, int c_, int wgm_ = WGM) { nM = M / BM; nN = N / BM; nwg = nM * nN; G = G_; c = c_; wgm = wgm_; }
    __host__ __device__ bool next(int i, Unit& u) const {
        const long L = (long)i * G + c; if (L >= nwg) return false;
        int wgid = (int)L; { const int q = nwg / NXCD, r = nwg % NXCD, xcd = wgid % NXCD, off = wgid / NXCD; wgid = (xcd < r ? xcd * (q + 1) : r * (q + 1) + (xcd - r) * q) + off; }
        const int nig = wgm * nN, gid = wgid / nig, fm = gid * wgm, gsz = (nM - fm) < wgm ? (nM - fm) : wgm;
        u.pm = fm + ((wgid % nig) % gsz); u.pn = (wgid % nig) / gsz; return true;
    }
    __device__ __forceinline__ void a_ready(const Unit&) const {}
    __device__ __forceinline__ void done(const Unit&) const {}
};

__device__ __forceinline__ unsigned cvt_pk_bf16(float lo, float hi) { unsigned r; asm volatile("v_cvt_pk_bf16_f32 %0, %1, %2" : "=v"(r) : "v"(lo), "v"(hi)); return r; }
typedef float f32x2 __attribute__((ext_vector_type(2)));
__device__ __forceinline__ f32x2 gelu_pk(f32x2 v) {
    const f32x2 av = __builtin_elementwise_abs(v), d = av * 0.2316418882f + 1.0f;
    f32x2 t; t.x = __builtin_amdgcn_rcpf(d.x); t.y = __builtin_amdgcn_rcpf(d.y);
    f32x2 q = t * 0.5307027145f + (-0.7265760135f); q = q * t + 0.7107068705f; q = q * t + (-0.142248368f); q = q * t + 0.127414796f; q = q * t;
    const f32x2 s = (v * v) * (-0.72134752044f);
    f32x2 e; e.x = __builtin_amdgcn_exp2f(s.x); e.y = __builtin_amdgcn_exp2f(s.y);
    const f32x2 m = v * (q * e), r = v - m;
    f32x2 o; o.x = v.x < 0.f ? m.x : r.x; o.y = v.y < 0.f ? m.y : r.y; return o;
}

template <int ACT  > struct EpiBf16 {
    static constexpr bool PERM = true, AFTER_DRAIN = false; static_assert(ACT == 0 || ACT == 1, "EpiBf16: ACT is 0 (none) or 1 (gelu_pk)");
    bf16_t* O; int ldc; const float* bias; int split_cols; size_t split_stride; float scale0;
    __device__ __forceinline__ void operator()(const f32x4 (&acc)[2][2][4][2], const Unit& u, int wr, int wc, int fr, int fq) const {
        const int row0 = u.pm * BM + wr * 64 + fr; int colt = u.pn * BM; bf16_t* base = O;
        float sc = 1.f; if (split_cols) { const int t = colt / split_cols; base += (size_t)t * split_stride; colt -= t * split_cols; if (t == 0) sc = scale0; }
        const int col0 = colt + wc * 32 + 8 * fq, bcol0 = u.pn * BM + wc * 32 + 8 * fq;
        f32x4 bv[2][2];
#pragma unroll
        for (int bj = 0; bj < 2; ++bj)
#pragma unroll
            for (int n = 0; n < 2; ++n) bv[bj][n] = bias ? *(const f32x4*)(bias + bcol0 + bj * HALF + 4 * n) : (f32x4){0.f, 0.f, 0.f, 0.f};
#pragma unroll
        for (int ai = 0; ai < 2; ++ai)
#pragma unroll
            for (int m = 0; m < 4; ++m) { bf16_t* rowp = base + (size_t)(row0 + ai * HALF + m * 16) * ldc + col0;
#pragma unroll
                for (int bj = 0; bj < 2; ++bj) { f32x4 v0 = acc[ai][bj][m][0] + bv[bj][0], v1 = acc[ai][bj][m][1] + bv[bj][1];
                    if (ACT == 1) { f32x2 a = gelu_pk((f32x2){v0[0], v0[1]}), b = gelu_pk((f32x2){v0[2], v0[3]}), c = gelu_pk((f32x2){v1[0], v1[1]}), d = gelu_pk((f32x2){v1[2], v1[3]});
                        v0 = (f32x4){a.x, a.y, b.x, b.y}; v1 = (f32x4){c.x, c.y, d.x, d.y}; }
                    v0 = v0 * sc; v1 = v1 * sc; u32x4 w; w.x = cvt_pk_bf16(v0[0], v0[1]); w.y = cvt_pk_bf16(v0[2], v0[3]); w.z = cvt_pk_bf16(v1[0], v1[1]); w.w = cvt_pk_bf16(v1[2], v1[3]);
                    *(u32x4*)(rowp + bj * HALF) = w; } }
    }
};

struct PanelStats {
    unsigned* xbuf;
    unsigned* cnt;
    unsigned* tmo;
    int ntn; float eps;
    unsigned code;
    __device__ __forceinline__ bool run(const f32x4 (&v)[2][2][4][2], const Unit& u, int wr, int wc, int fr, int fq, PG8_LAS unsigned char* lds, int wid, int lane) const {
        typedef float f32x2v __attribute__((ext_vector_type(2)));
        PG8_LAS f32x2v* P = (PG8_LAS f32x2v*)lds;
        PG8_LAS f32x2v* S = (PG8_LAS f32x2v*)(lds + 8192);
        PG8_LAS unsigned* flag = (PG8_LAS unsigned*)(lds + 8192 + 2048);
#pragma unroll
        for (int ai = 0; ai < 2; ++ai)
#pragma unroll
            for (int m = 0; m < 4; ++m) {
                float s = 0.f;
#pragma unroll
                for (int bj = 0; bj < 2; ++bj)
#pragma unroll
                    for (int n = 0; n < 2; ++n) { const f32x4 x = v[ai][bj][m][n]; s += (x[0] + x[1]) + (x[2] + x[3]); }
                s += __shfl_xor(s, 16); s += __shfl_xor(s, 32);
                const float mw = s * (1.0f / 64.0f); float q = 0.f;
#pragma unroll
                for (int bj = 0; bj < 2; ++bj)
#pragma unroll
                    for (int n = 0; n < 2; ++n) { const f32x4 d = v[ai][bj][m][n] - mw; q += (d[0] * d[0] + d[1] * d[1]) + (d[2] * d[2] + d[3] * d[3]); }
                q += __shfl_xor(q, 16); q += __shfl_xor(q, 32);
                if (fq == 0) P[(ai * HALF + wr * 64 + m * 16 + fr) * 4 + wc] = (f32x2v){mw, q};
            }
        asm volatile("s_waitcnt lgkmcnt(0)" ::: "memory"); __builtin_amdgcn_s_barrier(); asm volatile("" ::: "memory");
#if defined(BROKEN_EXCHANGE_NO_WAIT)
#warning BROKEN CONTROL BUILD: the row-statistics exchange does not wait; results are wrong by design
        if (blockIdx.x >= 64) { const long long t0_ = clock64(); while (clock64() - t0_ < 60000) __builtin_amdgcn_s_sleep(8); }
#endif
        const int row = wid * 32 + (lane & 31);
        if (lane < 32) {
            const f32x2v a = P[row * 4 + 0], b = P[row * 4 + 1], c = P[row * 4 + 2], d = P[row * 4 + 3];
            const float mt = (a.x + b.x + c.x + d.x) * 0.25f;
            const float da = a.x - mt, db = b.x - mt, dc = c.x - mt, dd = d.x - mt;
            const float m2 = (a.y + b.y) + (c.y + d.y) + 64.0f * ((da * da + db * db) + (dc * dc + dd * dd));
            unsigned long long* slot = (unsigned long long*)xbuf + ((size_t)(u.pm * BM + row) * 4 + u.pn);
            __hip_atomic_store(slot, ((unsigned long long)__float_as_uint(m2) << 32) | __float_as_uint(mt), __ATOMIC_RELAXED, __HIP_MEMORY_SCOPE_AGENT);
        }
        asm volatile("s_waitcnt vmcnt(0)" ::: "memory");
        if (lane == 0) __hip_atomic_fetch_add(cnt + 64 * u.pm, 1u, __ATOMIC_RELAXED, __HIP_MEMORY_SCOPE_AGENT);
        if (wid == 0) {
            bool dead = false; const unsigned long long t0 = __builtin_amdgcn_s_memrealtime(); const unsigned want = 8u * (unsigned)ntn;
            for (;;) {
#if defined(BROKEN_EXCHANGE_NO_WAIT)
                break;
#endif
                if ((unsigned)__builtin_amdgcn_readfirstlane(__hip_atomic_load(cnt + 64 * u.pm, __ATOMIC_RELAXED, __HIP_MEMORY_SCOPE_AGENT)) >= want) break;
                if (__builtin_amdgcn_s_memrealtime() - t0 > 2000000ull) {
                    if (lane == 0) { unsigned expect = 0u; __hip_atomic_compare_exchange_strong(tmo + 1, &expect, code | (unsigned)(u.pm & 0xff), __ATOMIC_RELAXED, __ATOMIC_RELAXED, __HIP_MEMORY_SCOPE_AGENT);
                                     __hip_atomic_store(tmo, 1u, __ATOMIC_RELAXED, __HIP_MEMORY_SCOPE_AGENT); }
                    dead = true; break; }
                __builtin_amdgcn_s_sleep(2);
            }
            __builtin_amdgcn_fence(__ATOMIC_ACQUIRE, "agent");
            if (lane == 0) flag[0] = dead ? 1u : 0u;
        }
        asm volatile("s_waitcnt vmcnt(0) lgkmcnt(0)" ::: "memory"); __builtin_amdgcn_s_barrier(); asm volatile("" ::: "memory");
        const bool bad = flag[0] != 0u;
        if (lane < 32) {
            const unsigned long long* slot = (const unsigned long long*)xbuf + (size_t)(u.pm * BM + row) * 4; float mt[4], m2[4]; float ms = 0.f;
#pragma unroll
            for (int t = 0; t < 4; ++t) { if (t < ntn) { const unsigned long long w = __hip_atomic_load(slot + t, __ATOMIC_RELAXED, __HIP_MEMORY_SCOPE_AGENT); mt[t] = __uint_as_float((unsigned)w); m2[t] = __uint_as_float((unsigned)(w >> 32)); } else { mt[t] = 0.f; m2[t] = 0.f; } ms += mt[t]; }
            const float mean = ms / (float)ntn; float q = 0.f;
#pragma unroll
            for (int t = 0; t < 4; ++t) if (t < ntn) { const float dm = mt[t] - mean; q += m2[t] + 256.0f * dm * dm; }
            S[row] = (f32x2v){mean, 1.0f / sqrtf(q / (256.0f * (float)ntn) + eps)};
        }
        asm volatile("s_waitcnt lgkmcnt(0)" ::: "memory"); __builtin_amdgcn_s_barrier(); asm volatile("" ::: "memory");
        return bad;
    }
};
struct EpiLnRes {
    static constexpr bool PERM = false, AFTER_DRAIN = true;
    const float* base; float* out; int ldc; const float* bias; PanelStats st; unsigned poison;
    __device__ __forceinline__ void fused(f32x4 (&acc)[2][2][4][2], const Unit& u, int wr, int wc, int fr, int fq, PG8_LAS unsigned char* lds, int wid, int lane) const {
        typedef float f32x2v __attribute__((ext_vector_type(2)));
        const PG8_LAS f32x2v* S = (const PG8_LAS f32x2v*)(lds + 8192);
        const int col0 = u.pn * BM + wc * 32 + 4 * fq;
#pragma unroll
        for (int bj = 0; bj < 2; ++bj)
#pragma unroll
            for (int n = 0; n < 2; ++n) { const f32x4 bv = bias ? *(const f32x4*)(bias + col0 + bj * HALF + n * 16) : (f32x4){0.f, 0.f, 0.f, 0.f};
#pragma unroll
                for (int ai = 0; ai < 2; ++ai)
#pragma unroll
                    for (int m = 0; m < 4; ++m) acc[ai][bj][m][n] += bv; }
        f32x4 pre[4][2][2];
#pragma unroll
        for (int m = 0; m < 4; ++m) { const size_t off = (size_t)(u.pm * BM + wr * 64 + m * 16 + fr) * ldc + col0;
#pragma unroll
            for (int bj = 0; bj < 2; ++bj)
#pragma unroll
                for (int n = 0; n < 2; ++n) pre[m][bj][n] = *(const f32x4*)(base + off + bj * HALF + n * 16); }
        const bool bad = st.run(acc, u, wr, wc, fr, fq, lds, wid, lane) || poison != 0u;
        const float qnan = __builtin_nanf("");
#pragma unroll
        for (int ai = 0; ai < 2; ++ai)
#pragma unroll
            for (int m = 0; m < 4; ++m) { const int r = ai * HALF + wr * 64 + m * 16 + fr; const f32x2v sr = S[r]; const size_t off = (size_t)(u.pm * BM + r) * ldc + col0;
#pragma unroll
                for (int bj = 0; bj < 2; ++bj)
#pragma unroll
                    for (int n = 0; n < 2; ++n) { const f32x4 bs = ai == 0 ? pre[m][bj][n] : *(const f32x4*)(base + off + bj * HALF + n * 16); f32x4 o = bs + (acc[ai][bj][m][n] - sr.x) * sr.y;
                        if (bad) o = (f32x4){qnan, qnan, qnan, qnan}; *(f32x4*)(out + off + bj * HALF + n * 16) = o; }
                if (m & 1) asm volatile("" ::: "memory"); }
    }
};
struct EpiLnResLn {
    static constexpr bool PERM = false, AFTER_DRAIN = true;
    const float* base; float* out; bf16_t* xn; int ldc; const float* bias; PanelStats st1, st2; unsigned poison;
    __device__ __forceinline__ void fused(f32x4 (&acc)[2][2][4][2], const Unit& u, int wr, int wc, int fr, int fq, PG8_LAS unsigned char* lds, int wid, int lane) const {
        typedef float f32x2v __attribute__((ext_vector_type(2))); typedef unsigned u32x2v __attribute__((ext_vector_type(2)));
        const PG8_LAS f32x2v* S = (const PG8_LAS f32x2v*)(lds + 8192);
        const int col0 = u.pn * BM + wc * 32 + 4 * fq;
#pragma unroll
        for (int bj = 0; bj < 2; ++bj)
#pragma unroll
            for (int n = 0; n < 2; ++n) { const f32x4 bv = bias ? *(const f32x4*)(bias + col0 + bj * HALF + n * 16) : (f32x4){0.f, 0.f, 0.f, 0.f};
#pragma unroll
                for (int ai = 0; ai < 2; ++ai)
#pragma unroll
                    for (int m = 0; m < 4; ++m) acc[ai][bj][m][n] += bv; }
        bool bad = st1.run(acc, u, wr, wc, fr, fq, lds, wid, lane) || poison != 0u;
        const float qnan = __builtin_nanf("");
#pragma unroll
        for (int ai = 0; ai < 2; ++ai)
#pragma unroll
            for (int m = 0; m < 4; ++m) { const int r = ai * HALF + wr * 64 + m * 16 + fr; const f32x2v sr = S[r]; const size_t off = (size_t)(u.pm * BM + r) * ldc + col0;
#pragma unroll
                for (int bj = 0; bj < 2; ++bj)
#pragma unroll
                    for (int n = 0; n < 2; ++n) { const f32x4 bs = *(const f32x4*)(base + off + bj * HALF + n * 16); acc[ai][bj][m][n] = bs + (acc[ai][bj][m][n] - sr.x) * sr.y; }
                asm volatile("" : "+v"(acc[ai][0][m][0]), "+v"(acc[ai][0][m][1]), "+v"(acc[ai][1][m][0]), "+v"(acc[ai][1][m][1]));
                if (m & 1) asm volatile("" ::: "memory"); }
        const bool bad1 = bad;
        bad = st2.run(acc, u, wr, wc, fr, fq, lds, wid, lane) || bad;
#pragma unroll
        for (int ai = 0; ai < 2; ++ai)
#pragma unroll
            for (int m = 0; m < 4; ++m) { const int r = ai * HALF + wr * 64 + m * 16 + fr; const f32x2v sr = S[r]; const size_t off = (size_t)(u.pm * BM + r) * ldc + col0;
#pragma unroll
                for (int bj = 0; bj < 2; ++bj)
#pragma unroll
                    for (int n = 0; n < 2; ++n) { const f32x4 x1 = acc[ai][bj][m][n]; *(f32x4*)(out + off + bj * HALF + n * 16) = bad1 ? (f32x4){qnan, qnan, qnan, qnan} : x1;
                        const f32x4 o = (x1 - sr.x) * sr.y; u32x2v w; w.x = cvt_pk_bf16(o[0], o[1]); w.y = cvt_pk_bf16(o[2], o[3]);
                        if (bad) { w.x = 0x7fc07fc0u; w.y = 0x7fc07fc0u; } *(u32x2v*)(xn + off + bj * HALF + n * 16) = w; }
                asm volatile("" ::: "memory"); }
    }
};

template <class Epi, class Sched, bool ALIGN_EPI = false, bool SP2 = false>
__device__ __forceinline__ void gemm_phase(PG8_LAS unsigned char* lds, const Gemm g, const Sched S, const Epi E) {
    const int tid = threadIdx.x, wid = __builtin_amdgcn_readfirstlane(tid >> 6), lane = tid & 63, wr = wid >> 2, wc = wid & 3, fr = lane & 15, fq = lane >> 4;
    const int K = g.K, nt = K / BK;
    unsigned voffA[2], voffB[2];
#pragma unroll
    for (int i = 0; i < 2; ++i) { int R, C; stage_rc(tid * 16 + i * 8192, R, C); const int Rb = Epi::PERM ? ((R & ~31) + perm32(R & 31)) : R;
        voffA[i] = (unsigned)(R * g.lda + C) * 2u; voffB[i] = (unsigned)(Rb * K + C) * 2u; }
    const size_t kstep = (size_t)(BK * 2);
    const size_t hstep = (size_t)HALF * K * 2;
    const size_t tstep = 2 * hstep;
    const size_t hstepA = (size_t)HALF * g.lda * 2, tstepA = 2 * hstepA;
    const unsigned ldsw = (unsigned)wid * 1024u;
    const int aoff = lds_byte(wr * 64 + fr, fq * 8), boff = lds_byte(wc * 32 + fr, fq * 8);
#define PG8_SA(b, h) (((b) * 2 + (h)) * HTB)
#define PG8_SB(b, h) ((4 + (b) * 2 + (h)) * HTB)
#define PG8_STAGE(bufoff, gbase, voff) do { _Pragma("unroll") for (int _i = 0; _i < 2; ++_i) \
        __builtin_amdgcn_global_load_lds((const unsigned*)((const char*)(gbase) + (voff)[_i]), (PG8_LAS unsigned*)(lds + (bufoff) + ldsw + _i * 8192), 16, 0, 0); } while (0)
#define PG8_LDA(dst, b, h) do { _Pragma("unroll") for (int m = 0; m < 4; ++m) _Pragma("unroll") for (int k = 0; k < 2; ++k) dst[m][k] = *(const PG8_LAS bf16x8*)(lds + PG8_SA(b, h) + aoff + m * 2048 + k * 1024); } while (0)
#define PG8_LDB(dst, b, h) do { _Pragma("unroll") for (int n = 0; n < 2; ++n) _Pragma("unroll") for (int k = 0; k < 2; ++k) dst[n][k] = *(const PG8_LAS bf16x8*)(lds + PG8_SB(b, h) + boff + n * 2048 + k * 1024); } while (0)
#define PG8_MMA(ai, bj, At, Bt) do { __builtin_amdgcn_s_setprio(1); _Pragma("unroll") for (int m = 0; m < 4; ++m) _Pragma("unroll") for (int n = 0; n < 2; ++n) _Pragma("unroll") for (int k = 0; k < 2; ++k) \
        acc[ai][bj][m][n] = __builtin_amdgcn_mfma_f32_16x16x32_bf16(Bt[n][k], At[m][k], acc[ai][bj][m][n], 0, 0, 0); __builtin_amdgcn_s_setprio(0); } while (0)
#define PG8_WAIT_V(n) asm volatile("s_waitcnt vmcnt(" #n ")" ::: "memory")
#define PG8_WAIT_L(n) asm volatile("s_waitcnt lgkmcnt(" #n ")" ::: "memory")
#define PG8_BAR __builtin_amdgcn_s_barrier()
#define PG8_SCHED __builtin_amdgcn_sched_barrier(0)
    Unit cur, nxt; int ui = 0;
    if (!S.next(0, cur)) return;
    f32x4 acc[2][2][4][2];
#pragma unroll
    for (int a = 0; a < 2; ++a)
#pragma unroll
        for (int b = 0; b < 2; ++b)
#pragma unroll
            for (int m = 0; m < 4; ++m)
#pragma unroll
                for (int n = 0; n < 2; ++n) acc[a][b][m][n] = (f32x4){0.f, 0.f, 0.f, 0.f};
    bf16x8 At[4][2], B0[2][2], B1[2][2];
    const char* cA = (const char*)g.A + (size_t)cur.pm * tstepA; const char* cB = (const char*)g.Bt + (size_t)cur.pn * tstep;
    S.a_ready(cur);
    if constexpr (SP2) {
        PG8_STAGE(PG8_SB(0, 0), cB, voffB); PG8_STAGE(PG8_SB(0, 1), cB + hstep, voffB); PG8_STAGE(PG8_SA(0, 0), cA, voffA); PG8_STAGE(PG8_SA(0, 1), cA + hstepA, voffA);
        if (wr == 1) PG8_BAR;
        PG8_WAIT_V(2); PG8_BAR;
        PG8_STAGE(PG8_SB(1, 0), cB + kstep, voffB); PG8_STAGE(PG8_SA(1, 0), cA + kstep, voffA); PG8_STAGE(PG8_SB(1, 1), cB + hstep + kstep, voffB);
        PG8_WAIT_V(6); PG8_BAR;
    } else {
        PG8_STAGE(PG8_SB(0, 0), cB, voffB); PG8_STAGE(PG8_SA(0, 0), cA, voffA); PG8_STAGE(PG8_SB(0, 1), cB + hstep, voffB); PG8_STAGE(PG8_SA(0, 1), cA + hstepA, voffA);
        if (wr == 1) PG8_BAR;
        PG8_WAIT_V(4); PG8_BAR;
        PG8_STAGE(PG8_SB(1, 0), cB + kstep, voffB); PG8_STAGE(PG8_SA(1, 0), cA + kstep, voffA); PG8_STAGE(PG8_SB(1, 1), cB + hstep + kstep, voffB);
        PG8_WAIT_V(6); PG8_BAR;
    }
    for (;;) {
        const bool has_next = S.next(ui + 1, nxt);
        const char* nA = has_next ? (const char*)g.A + (size_t)nxt.pm * tstepA : cA; const char* nB = has_next ? (const char*)g.Bt + (size_t)nxt.pn * tstep : cB;
        for (int t = 0; t < nt; t += 2) {
            const bool last = (t == nt - 2);
            const char* a1 = cA + (size_t)(t + 1) * kstep;
            const char* a2 = last ? nA : cA + (size_t)(t + 2) * kstep; const char* b2 = last ? nB : cB + (size_t)(t + 2) * kstep;
            const char* a3 = a2 + kstep; const char* b3 = b2 + kstep;
            if (last && has_next) S.a_ready(nxt);
            if constexpr (SP2) {
            PG8_LDB(B0, 0, 0); PG8_LDB(B1, 0, 1); PG8_SCHED; PG8_LDA(At, 0, 0); PG8_STAGE(PG8_SA(1, 1), a1 + hstepA, voffA);
            PG8_WAIT_V(8); PG8_WAIT_L(0); PG8_BAR; PG8_MMA(0, 0, At, B0); PG8_MMA(0, 1, At, B1); PG8_BAR; PG8_SCHED;
            PG8_LDA(At, 0, 1); PG8_STAGE(PG8_SB(0, 0), b2, voffB); PG8_STAGE(PG8_SB(0, 1), b2 + hstep, voffB); PG8_STAGE(PG8_SA(0, 0), a2, voffA);
            PG8_WAIT_V(8); PG8_WAIT_L(0); PG8_BAR; PG8_MMA(1, 0, At, B0); PG8_MMA(1, 1, At, B1); PG8_BAR; PG8_SCHED;
            PG8_LDB(B0, 1, 0); PG8_LDB(B1, 1, 1); PG8_SCHED; PG8_LDA(At, 1, 0); PG8_STAGE(PG8_SA(0, 1), a2 + hstepA, voffA);
            PG8_WAIT_V(8); PG8_WAIT_L(0); PG8_BAR; PG8_MMA(0, 0, At, B0); PG8_MMA(0, 1, At, B1); PG8_BAR; PG8_SCHED;
            PG8_LDA(At, 1, 1); PG8_STAGE(PG8_SB(1, 0), b3, voffB); PG8_STAGE(PG8_SB(1, 1), b3 + hstep, voffB); PG8_STAGE(PG8_SA(1, 0), a3, voffA);
            PG8_WAIT_V(8); PG8_WAIT_L(0); PG8_BAR; PG8_MMA(1, 0, At, B0); PG8_MMA(1, 1, At, B1); PG8_BAR; PG8_SCHED;
            } else {
            PG8_LDB(B0, 0, 0); PG8_SCHED; PG8_LDA(At, 0, 0); PG8_STAGE(PG8_SA(1, 1), a1 + hstepA, voffA);
            PG8_WAIT_L(8); PG8_BAR; PG8_WAIT_L(0); PG8_MMA(0, 0, At, B0); PG8_BAR; PG8_SCHED;
            PG8_LDB(B1, 0, 1); PG8_STAGE(PG8_SB(0, 0), b2, voffB);
            PG8_BAR; PG8_WAIT_L(0); PG8_MMA(0, 1, At, B1); PG8_BAR;
            PG8_LDA(At, 0, 1); PG8_STAGE(PG8_SA(0, 0), a2, voffA);
            PG8_BAR; PG8_WAIT_L(0); PG8_MMA(1, 0, At, B0); PG8_BAR; PG8_SCHED;
            PG8_STAGE(PG8_SB(0, 1), b2 + hstep, voffB);
            PG8_WAIT_V(6); PG8_BAR; PG8_MMA(1, 1, At, B1); PG8_BAR;
            PG8_LDB(B0, 1, 0); PG8_SCHED; PG8_LDA(At, 1, 0); PG8_STAGE(PG8_SA(0, 1), a2 + hstepA, voffA);
            PG8_WAIT_L(8); PG8_BAR; PG8_WAIT_L(0); PG8_MMA(0, 0, At, B0); PG8_BAR; PG8_SCHED;
            PG8_LDB(B1, 1, 1); PG8_STAGE(PG8_SB(1, 0), b3, voffB);
            PG8_BAR; PG8_WAIT_L(0); PG8_MMA(0, 1, At, B1); PG8_BAR;
            PG8_LDA(At, 1, 1); PG8_STAGE(PG8_SA(1, 0), a3, voffA);
            PG8_BAR; PG8_WAIT_L(0); PG8_MMA(1, 0, At, B0); PG8_BAR; PG8_SCHED;
            PG8_STAGE(PG8_SB(1, 1), b3 + hstep, voffB);
            PG8_WAIT_V(6); PG8_BAR; PG8_MMA(1, 1, At, B1); PG8_BAR;
            }
        }
        if constexpr (ALIGN_EPI) { if (wr == 0) PG8_BAR; }
        if constexpr (!Epi::AFTER_DRAIN) { E(acc, cur, wr, wc, fr, fq); S.done(cur); }
        if (!has_next) break;
#pragma unroll
        for (int a = 0; a < 2; ++a)
#pragma unroll
            for (int b = 0; b < 2; ++b)
#pragma unroll
                for (int m = 0; m < 4; ++m)
#pragma unroll
                    for (int n = 0; n < 2; ++n) acc[a][b][m][n] = (f32x4){0.f, 0.f, 0.f, 0.f};
        cur = nxt; cA = nA; cB = nB; ++ui;
        if constexpr (ALIGN_EPI) { if (wr == 1) PG8_BAR; }
    }
    PG8_WAIT_V(0);
    if constexpr (!ALIGN_EPI) { if (wr == 0) PG8_BAR; }
    PG8_BAR;
    if constexpr (Epi::AFTER_DRAIN) { E.fused(acc, cur, wr, wc, fr, fq, lds, wid, lane); S.done(cur); }
#undef PG8_SA
#undef PG8_SB
#undef PG8_STAGE
#undef PG8_LDA
#undef PG8_LDB
#undef PG8_MMA
#undef PG8_WAIT_V
#undef PG8_WAIT_L
#undef PG8_BAR
#undef PG8_SCHED
}
}

#ifndef GEMM_SP2
#define GEMM_SP2 true
#endif
#ifndef GEMM_ALIGN
#define GEMM_ALIGN true
#endif
namespace mk {
#define LAS __attribute__((address_space(3)))
using pg8::bf16_t; using pg8::bf16x8; using pg8::f32x4; using pg8::u32x4;
typedef unsigned u32x2 __attribute__((ext_vector_type(2)));

constexpr int DM = 1024, SEQ = 8192, NBATCH = 4, MPR = NBATCH * SEQ, MSAMP = 128, MREAL = MPR + MSAMP, MPAD = 33024;
constexpr int DFF = 2816, PW = 2816, NINP = 3072, CONVC = 1536;
constexpr float EPS = 1e-6f;
#ifndef SCAN_CW
#define SCAN_CW 2
#endif
constexpr int CW = SCAN_CW, NSCAN = 128 / CW;
constexpr int LDS_PHASE_BYTES = 155648, LDS_BYTES = LDS_PHASE_BYTES + 256;

constexpr size_t O_YP = 0, O_YS = 33554432, O_KP = 33685504, O_VP = 33751040, O_CP = 33816576, O_GP = 33835008,
                 O_KS = 34097152, O_VS = 36194304, O_CS = 38291456, O_GS = 38881280;
constexpr size_t MiB = 1u << 20;
constexpr size_t WS_CTL = 0, CTL_ZERO_BYTES = 1 * MiB;
constexpr size_t WS_W1IN = 1 * MiB, WS_W1OUT = 12 * MiB, WS_WINMIX = 18 * MiB, WS_WOUTMIX = 24 * MiB, WS_W2IN = 26 * MiB, WS_W2OUT = 37 * MiB;
constexpr size_t WS_GBA = 43 * MiB, WS_XN = 45 * MiB, WS_XN2 = 110 * MiB, WS_H = 175 * MiB, WS_GM = 353 * MiB, WS_GN = 417 * MiB;
constexpr size_t WS_GQ = 110 * MiB, WS_GO = 142 * MiB;
constexpr size_t WS_SSP1 = 481 * MiB, WS_SSP2 = 484 * MiB;
constexpr size_t WS_END = 487 * MiB;
constexpr size_t CTL_BAR = 0, CTL_BAR_BYTES = 16384, CTL_GLAST = 768 * 1024;

struct Params { const float* in[21]; float* out; unsigned char* ws; };

typedef float f32x2v __attribute__((ext_vector_type(2)));
typedef __bf16 bf16x2v __attribute__((ext_vector_type(2)));
__device__ __forceinline__ unsigned cvt_pk(float lo, float hi) { const f32x2v v = {lo, hi}; const bf16x2v b = __builtin_convertvector(v, bf16x2v); return __builtin_bit_cast(unsigned, b); }
__device__ __forceinline__ bf16_t f2bf(float f) { return (bf16_t)(cvt_pk(f, 0.f) & 0xffffu); }
__device__ __forceinline__ float bf2f(bf16_t h) { return __uint_as_float(((unsigned)h) << 16); }
__device__ __forceinline__ float bflo(unsigned w) { return __uint_as_float(w << 16); }
__device__ __forceinline__ float bfhi(unsigned w) { return __uint_as_float(w & 0xffff0000u); }
__device__ __forceinline__ float silu(float x) { return x * __builtin_amdgcn_rcpf(1.0f + __expf(-x)); }
__device__ __forceinline__ float wave_sum(float v) {
#pragma unroll
    for (int o = 1; o < 64; o <<= 1) v += __shfl_xor(v, o);
    return v;
}
__device__ __forceinline__ float wave_max(float v) {
#pragma unroll
    for (int o = 1; o < 64; o <<= 1) v = fmaxf(v, __shfl_xor(v, o));
    return v;
}
__device__ __forceinline__ f32x4 mfma16(bf16x8 a, bf16x8 b, f32x4 c) { return __builtin_amdgcn_mfma_f32_16x16x32_bf16(a, b, c, 0, 0, 0); }

__device__ __forceinline__ float row_rstd(const float* ssp, int r) {
    if (r >= MREAL) return 0.f;
    const f32x4 a = *(const f32x4*)(ssp + (size_t)r * 16), b = *(const f32x4*)(ssp + (size_t)r * 16 + 4), c = *(const f32x4*)(ssp + (size_t)r * 16 + 8), d = *(const f32x4*)(ssp + (size_t)r * 16 + 12);
    const float s = (((a[0] + a[1]) + (a[2] + a[3])) + ((b[0] + b[1]) + (b[2] + b[3]))) + (((c[0] + c[1]) + (c[2] + c[3])) + ((d[0] + d[1]) + (d[2] + d[3])));
    return rsqrtf(s * (1.0f / DM) + EPS);
}
struct EpiSwiglu {
    static constexpr bool PERM = true, AFTER_DRAIN = false;
    bf16_t* H; const float* ss;
    __device__ __forceinline__ void operator()(const f32x4 (&acc)[2][2][4][2], const pg8::Unit& u, int wr, int wc, int fr, int fq) const {
        const int row0 = u.pm * 256 + wr * 64 + fr, col0 = u.pn * 128 + wc * 32 + 8 * fq;
#pragma unroll
        for (int ai = 0; ai < 2; ++ai)
#pragma unroll
            for (int m = 0; m < 4; ++m) {
                const int r = row0 + ai * 128 + m * 16;
                const float rs = ss ? row_rstd(ss, r) : 1.0f;
                float h[8];
#pragma unroll
                for (int n = 0; n < 2; ++n)
#pragma unroll
                    for (int j = 0; j < 4; ++j) h[n * 4 + j] = silu(acc[ai][0][m][n][j] * rs) * (acc[ai][1][m][n][j] * rs);
                u32x4 w; w.x = cvt_pk(h[0], h[1]); w.y = cvt_pk(h[2], h[3]); w.z = cvt_pk(h[4], h[5]); w.w = cvt_pk(h[6], h[7]);
                *(u32x4*)(H + (size_t)r * DFF + col0) = w;
            }
    }
};
template <bool RESB16, bool WF32, bool WB16, bool SUMSQ, bool HALF> struct EpiResid {
    static constexpr bool PERM = true, AFTER_DRAIN = false;
    const void* resP; const void* resS; float* Yo; bf16_t* XBo; float* sso;
    __device__ __forceinline__ void operator()(const f32x4 (&acc)[2][2][4][2], const pg8::Unit& u, int wr, int wc, int fr, int fq) const {
        const int row0 = u.pm * 256 + wr * 64 + fr, col0 = u.pn * 256 + wc * 32 + 8 * fq;
        const char* const rP = (const char*)resP; const char* const rS = (const char*)resS - (size_t)MPR * DM * (RESB16 ? 2 : 4);
        float* const Y = Yo; const float scale = HALF ? 0.5f : 1.0f; bf16_t* const XB = XBo; float* const ss = sso;
#pragma unroll
        for (int ai = 0; ai < 2; ++ai)
#pragma unroll
            for (int m = 0; m < 4; ++m) {
                const int r = row0 + ai * 128 + m * 16; float s = 0.f;
                if (r < MREAL) {
                    const char* rp = ((r < MPR) ? rP : rS) + (size_t)r * DM * (RESB16 ? 2 : 4);
#pragma unroll
                    for (int bj = 0; bj < 2; ++bj) {
                        const int c = col0 + bj * 128;
                        f32x4 r0, r1;
                        if (RESB16) { const u32x4 w = *(const u32x4*)(rp + (size_t)c * 2); r0 = (f32x4){bflo(w.x), bfhi(w.x), bflo(w.y), bfhi(w.y)}; r1 = (f32x4){bflo(w.z), bfhi(w.z), bflo(w.w), bfhi(w.w)}; }
                        else { r0 = *(const f32x4*)(rp + (size_t)c * 4); r1 = *(const f32x4*)(rp + (size_t)c * 4 + 16); }
                        const f32x4 v0 = r0 + acc[ai][bj][m][0] * scale, v1 = r1 + acc[ai][bj][m][1] * scale;
                        if (WF32) { *(f32x4*)(Y + (size_t)r * DM + c) = v0; *(f32x4*)(Y + (size_t)r * DM + c + 4) = v1; }
                        if (WB16) { u32x4 w; w.x = cvt_pk(v0[0], v0[1]); w.y = cvt_pk(v0[2], v0[3]); w.z = cvt_pk(v1[0], v1[1]); w.w = cvt_pk(v1[2], v1[3]);
                            *(u32x4*)(XB + (size_t)r * DM + c) = w; }
                        if (SUMSQ) s += (v0[0] * v0[0] + v0[1] * v0[1]) + (v0[2] * v0[2] + v0[3] * v0[3]) + (v1[0] * v1[0] + v1[1] * v1[1]) + (v1[2] * v1[2] + v1[3] * v1[3]);
                    }
                }
                if (SUMSQ) { s += __shfl_xor(s, 16); s += __shfl_xor(s, 32); if (fq == 0 && r < MREAL) ss[(size_t)r * 16 + u.pn * 4 + wc] = s; }
            }
    }
};
struct EpiInproj {
    static constexpr bool PERM = true, AFTER_DRAIN = false;
    bf16_t* P; float* gba; const float* ss;
    __device__ __forceinline__ void operator()(const f32x4 (&acc)[2][2][4][2], const pg8::Unit& u, int wr, int wc, int fr, int fq) const {
        const int row0 = u.pm * 256 + wr * 64 + fr, col0 = u.pn * 256 + wc * 32 + 8 * fq;
#pragma unroll
        for (int ai = 0; ai < 2; ++ai)
#pragma unroll
            for (int m = 0; m < 4; ++m) {
                const int r = row0 + ai * 128 + m * 16;
                const float rs = row_rstd(ss, r);
                if (u.pn < 11) {
#pragma unroll
                    for (int bj = 0; bj < 2; ++bj) { const f32x4 v0 = acc[ai][bj][m][0] * rs, v1 = acc[ai][bj][m][1] * rs;
                        u32x4 w; w.x = cvt_pk(v0[0], v0[1]); w.y = cvt_pk(v0[2], v0[3]); w.z = cvt_pk(v1[0], v1[1]); w.w = cvt_pk(v1[2], v1[3]);
                        *(u32x4*)(P + (size_t)r * PW + col0 + bj * 128) = w; }
                } else if (wc == 0 && fq == 0) {
                    *(f32x4*)(gba + (size_t)r * 8) = acc[ai][0][m][0] * rs; *(f32x4*)(gba + (size_t)r * 8 + 4) = acc[ai][0][m][1] * rs;
                }
            }
    }
};


template <int NT, bool SS>
__device__ __forceinline__ void skinny_mm(const bf16_t* A, int lda, const bf16_t* W, int K, int wrow0, int wrow1, int wid, int fr, int fq, f32x4 (&acc)[NT], float& ss, LAS unsigned char* lds) {
    const int lane = fq * 16 + fr, kper = K >> 3, nks = kper >> 5;
    const bf16_t* ap = A + (size_t)fr * lda + wid * kper + 8 * fq;
    const bf16_t* w0 = W + (size_t)(wrow0 + fr) * K + wid * kper + 8 * fq; const bf16_t* w1 = W + (size_t)(wrow1 + fr) * K + wid * kper + 8 * fq;
    f32x4 pa[NT][8]; float sp[8];
#pragma unroll
    for (int mt = 0; mt < 8; ++mt) { sp[mt] = 0.f;
#pragma unroll
        for (int nt = 0; nt < NT; ++nt) pa[nt][mt] = (f32x4){0.f, 0.f, 0.f, 0.f}; }
#pragma unroll 2
    for (int ks = 0; ks < nks; ++ks) {
        const bf16x8 b0 = *(const bf16x8*)(w0 + 32 * ks); bf16x8 b1 = b0; if (NT == 2) b1 = *(const bf16x8*)(w1 + 32 * ks);
        bf16x8 av[8];
#pragma unroll
        for (int mt = 0; mt < 8; ++mt) av[mt] = *(const bf16x8*)(ap + (size_t)(16 * mt) * lda + 32 * ks);
#pragma unroll
        for (int mt = 0; mt < 8; ++mt) {
            pa[0][mt] = mfma16(b0, av[mt], pa[0][mt]);
            if (NT == 2) pa[NT - 1][mt] = mfma16(b1, av[mt], pa[NT - 1][mt]);
            if (SS) { const u32x4 u = __builtin_bit_cast(u32x4, av[mt]);
#pragma unroll
                for (int k = 0; k < 4; ++k) { const float lo = bflo(u[k]), hi = bfhi(u[k]); sp[mt] += lo * lo + hi * hi; } }
        }
    }
    LAS f32x4* red = (LAS f32x4*)lds;
    LAS float* sred = (LAS float*)(lds + 8 * NT * 8 * 64 * 16);
#pragma unroll
    for (int mt = 0; mt < 8; ++mt) {
#pragma unroll
        for (int nt = 0; nt < NT; ++nt) red[((wid * NT + nt) * 8 + mt) * 64 + lane] = pa[nt][mt];
        if (SS) sred[(wid * 8 + mt) * 64 + lane] = sp[mt];
    }
    __syncthreads();
    float s = 0.f;
#pragma unroll
    for (int nt = 0; nt < NT; ++nt) acc[nt] = (f32x4){0.f, 0.f, 0.f, 0.f};
#pragma unroll
    for (int v = 0; v < 8; ++v) {
#pragma unroll
        for (int nt = 0; nt < NT; ++nt) acc[nt] += red[((v * NT + nt) * 8 + wid) * 64 + lane];
        if (SS) s += sred[(v * 8 + wid) * 64 + lane];
    }
    if (SS) { s += __shfl_xor(s, 16); s += __shfl_xor(s, 32); }
    ss = s;
    __syncthreads();
}
template <bool SS> __device__ __forceinline__ void sk_ffn_in(const bf16_t* X, const bf16_t* Wt, bf16_t* H, int slab, int wid, int fr, int fq, LAS unsigned char* lds) {
    const int j0 = 16 * slab, wr0 = (j0 >> 7) * 256 + (j0 & 127);
    f32x4 acc[2]; float ss;
    skinny_mm<2, SS>(X + (size_t)MPR * DM, DM, Wt, DM, wr0, wr0 + 128, wid, fr, fq, acc, ss, lds);
    const float rs = SS ? rsqrtf(ss * (1.0f / DM) + EPS) : 1.0f;
    float h[4];
#pragma unroll
    for (int e = 0; e < 4; ++e) h[e] = silu(acc[0][e] * rs) * (acc[1][e] * rs);
    u32x2 w; w.x = cvt_pk(h[0], h[1]); w.y = cvt_pk(h[2], h[3]);
    *(u32x2*)(H + (size_t)(MPR + 16 * wid + fr) * DFF + j0 + 4 * fq) = w;
}
template <bool OUTF32> __device__ __forceinline__ void sk_ffn_out(const bf16_t* Hb, const bf16_t* Wt, const float* resf, float* outf, bf16_t* outb, int slab, int wid, int fr, int fq, LAS unsigned char* lds) {
    f32x4 acc[1]; float ss;
    skinny_mm<1, false>(Hb + (size_t)MPR * DFF, DFF, Wt, DFF, 16 * slab, 0, wid, fr, fq, acc, ss, lds);
    const int rl = 16 * wid + fr, c = 16 * slab + 4 * fq;
    const f32x4 v = *(const f32x4*)(resf + (size_t)rl * DM + c) + acc[0] * 0.5f;
    if (OUTF32) *(f32x4*)(outf + (size_t)rl * DM + c) = v;
    else { u32x2 w; w.x = cvt_pk(v[0], v[1]); w.y = cvt_pk(v[2], v[3]); *(u32x2*)(outb + (size_t)rl * DM + c) = w; }
}
__device__ __forceinline__ void sk_inproj(const bf16_t* X, const bf16_t* Wt, bf16_t* P, float* gba, int slab, int wid, int fr, int fq, LAS unsigned char* lds) {
    const int n0 = 32 * slab; f32x4 acc[2]; float ss;
    skinny_mm<2, true>(X + (size_t)MPR * DM, DM, Wt, DM, n0, n0 + 16, wid, fr, fq, acc, ss, lds);
    const float rs = rsqrtf(ss * (1.0f / DM) + EPS); const int r = MPR + 16 * wid + fr;
    if (n0 < PW) {
#pragma unroll
        for (int nt = 0; nt < 2; ++nt) { const f32x4 v = acc[nt] * rs; u32x2 w; w.x = cvt_pk(v[0], v[1]); w.y = cvt_pk(v[2], v[3]); *(u32x2*)(P + (size_t)r * PW + n0 + 16 * nt + 4 * fq) = w; }
    } else if (fq < 2) *(f32x4*)(gba + (size_t)r * 8 + 4 * fq) = acc[0] * rs;
}
__device__ __forceinline__ void sk_outproj(const bf16_t* Pm, const bf16_t* Wt, const bf16_t* X1b, float* X2f, bf16_t* X2b, int slab, int wid, int fr, int fq, LAS unsigned char* lds) {
    const int n0 = 32 * slab; f32x4 acc[2]; float ss;
    skinny_mm<2, false>(Pm + (size_t)MPR * PW, PW, Wt, DM, n0, n0 + 16, wid, fr, fq, acc, ss, lds);
    const int r = MPR + 16 * wid + fr;
#pragma unroll
    for (int nt = 0; nt < 2; ++nt) { const int c = n0 + 16 * nt + 4 * fq; const u32x2 xr = *(const u32x2*)(X1b + (size_t)r * DM + c);
        const f32x4 v = (f32x4){bflo(xr.x), bfhi(xr.x), bflo(xr.y), bfhi(xr.y)} + acc[nt];
        *(f32x4*)(X2f + (size_t)r * DM + c) = v; u32x2 w; w.x = cvt_pk(v[0], v[1]); w.y = cvt_pk(v[2], v[3]); *(u32x2*)(X2b + (size_t)r * DM + c) = w; }
}

__device__ __forceinline__ void transpose_item(const float* W, int K, int N, bf16_t* WT, int k0, int n0, int drow0, const float* gs, LAS float* scr, int lane) {
    float wv[32];
#pragma unroll
    for (int i = 0; i < 32; ++i) { const int kk = 2 * i + (lane >> 5), n = n0 + (lane & 31); wv[i] = (n < N) ? W[(size_t)(k0 + kk) * N + n] : 0.f; }
#pragma unroll
    for (int i = 0; i < 32; ++i) { const int kk = 2 * i + (lane >> 5); float v = wv[i]; if (gs) v *= gs[k0 + kk]; scr[kk * 33 + (lane & 31)] = v; }
    asm volatile("s_waitcnt lgkmcnt(0)" ::: "memory");
    const int c = lane & 7;
#pragma unroll
    for (int j = 0; j < 4; ++j) { const int nn = (lane >> 3) + 8 * j; const LAS float* s = scr + (8 * c) * 33 + nn;
        u32x4 o; o.x = cvt_pk(s[0 * 33], s[1 * 33]); o.y = cvt_pk(s[2 * 33], s[3 * 33]); o.z = cvt_pk(s[4 * 33], s[5 * 33]); o.w = cvt_pk(s[6 * 33], s[7 * 33]);
        *(u32x4*)(WT + (size_t)(drow0 + nn) * K + k0 + 8 * c) = o; }
    asm volatile("s_waitcnt lgkmcnt(0)" ::: "memory");
}
__device__ __forceinline__ int map_ffin_row(int n0) { return n0 < DFF ? (n0 >> 7) * 256 + (n0 & 127) : ((n0 - DFF) >> 7) * 256 + 128 + ((n0 - DFF) & 127); }

__device__ __forceinline__ void p0_prologue(const Params& p, LAS unsigned char* lds, int vb, int G) {
    const int tid = threadIdx.x, lane = tid & 63, wid = tid >> 6;
    LAS float* scr = (LAS float*)(lds + wid * 16384);
    const int gw = vb * 8 + wid, NGW = G * 8;
    bf16_t* W1IN = (bf16_t*)(p.ws + WS_W1IN); bf16_t* W1OUT = (bf16_t*)(p.ws + WS_W1OUT); bf16_t* WINMIX = (bf16_t*)(p.ws + WS_WINMIX);
    bf16_t* WOUTMIX = (bf16_t*)(p.ws + WS_WOUTMIX); bf16_t* W2IN = (bf16_t*)(p.ws + WS_W2IN); bf16_t* W2OUT = (bf16_t*)(p.ws + WS_W2OUT);
    constexpr int I_FIN = 16 * 176, I_FOUT = 44 * 32, I_INMIX = 16 * 89, I_OUTMIX = 16 * 32;
    constexpr int NITEMS = 2 * I_FIN + 2 * I_FOUT + I_INMIX + I_OUTMIX;
    for (int it = gw; it < NITEMS; it += NGW) {
        int r = it;
        if (r < I_FIN) { const int kb = r / 176, nb = r % 176; transpose_item(p.in[7], DM, 2 * DFF, W1IN, kb * 64, nb * 32, map_ffin_row(nb * 32), nullptr, scr, lane); continue; } r -= I_FIN;
        if (r < I_FIN) { const int kb = r / 176, nb = r % 176; transpose_item(p.in[18], DM, 2 * DFF, W2IN, kb * 64, nb * 32, map_ffin_row(nb * 32), p.in[17], scr, lane); continue; } r -= I_FIN;
        if (r < I_FOUT) { const int kb = r / 32, nb = r % 32; transpose_item(p.in[8], DFF, DM, W1OUT, kb * 64, nb * 32, nb * 32, nullptr, scr, lane); continue; } r -= I_FOUT;
        if (r < I_FOUT) { const int kb = r / 32, nb = r % 32; transpose_item(p.in[19], DFF, DM, W2OUT, kb * 64, nb * 32, nb * 32, nullptr, scr, lane); continue; } r -= I_FOUT;
        if (r < I_INMIX) { const int kb = r / 89, nb = r % 89; transpose_item(p.in[10], DM, 2824, WINMIX, kb * 64, nb * 32, nb * 32, p.in[9], scr, lane); continue; } r -= I_INMIX;
        { const int kb = r / 32, nb = r % 32; transpose_item(p.in[16], DM, DM, WOUTMIX, kb * 64, nb * 32, nb * 32, nullptr, scr, lane); }
    }
    bf16_t* XN = (bf16_t*)(p.ws + WS_XN); const float* g1 = p.in[6];
    f32x4 gv[4];
#pragma unroll
    for (int j = 0; j < 4; ++j) gv[j] = *((const f32x4*)g1 + lane + 64 * j);
    {
        f32x4 v[4], vn[4];
        int m = gw;
        if (m < MREAL) { const f32x4* xr = (const f32x4*)((m < MPR) ? p.in[0] + (size_t)m * DM : p.in[1] + (size_t)(m - MPR) * DM) + lane;
#pragma unroll
            for (int j = 0; j < 4; ++j) v[j] = xr[64 * j]; }
        for (; m < MREAL; m += NGW) {
            const int mn = m + NGW;
            if (mn < MREAL) { const f32x4* xr = (const f32x4*)((mn < MPR) ? p.in[0] + (size_t)mn * DM : p.in[1] + (size_t)(mn - MPR) * DM) + lane;
#pragma unroll
                for (int j = 0; j < 4; ++j) vn[j] = xr[64 * j]; }
            float s = 0.f;
#pragma unroll
            for (int j = 0; j < 4; ++j) s += (v[j][0] * v[j][0] + v[j][1] * v[j][1]) + (v[j][2] * v[j][2] + v[j][3] * v[j][3]);
            const float rstd = rsqrtf(wave_sum(s) * (1.0f / DM) + EPS);
            unsigned long long* o8 = (unsigned long long*)(XN + (size_t)m * DM) + lane;
#pragma unroll
            for (int j = 0; j < 4; ++j) { const f32x4 y = v[j] * rstd * gv[j];
                o8[64 * j] = (unsigned long long)cvt_pk(y[0], y[1]) | ((unsigned long long)cvt_pk(y[2], y[3]) << 32); }
#pragma unroll
            for (int j = 0; j < 4; ++j) v[j] = vn[j];
        }
    }
}

template <bool SWX = false, bool SWY = false>
__device__ __forceinline__ f32x4 tile_mm(const LAS bf16_t* X, int ldx, int mt, const LAS bf16_t* Y, int ldy, int nt, int nks, int fr, int fq) {
    f32x4 acc = (f32x4){0.f, 0.f, 0.f, 0.f};
    const int rx = 16 * mt + fr, ry = 16 * nt + fr, sx = SWX ? ((rx >> 3) & 7) : 0, sy = SWY ? ((ry >> 3) & 7) : 0;
    const LAS bf16_t* xp = X + rx * ldx; const LAS bf16_t* yp = Y + ry * ldy;
    for (int ks = 0; ks < nks; ++ks) acc = mfma16(*(const LAS bf16x8*)(xp + 8 * ((4 * ks + fq) ^ sx)), *(const LAS bf16x8*)(yp + 8 * ((4 * ks + fq) ^ sy)), acc);
    return acc;
}
constexpr int G1_QS = 0, G1_KS = 17408, G1_VBT = 34816, G1_KBT = 53248, G1_KDT = 71680, G1_UT = 90112, G1_WT = 108544, G1_QK = 126976, G1_TB = 136192, G1_GC = 145408, G1_BETA = 145664, G1_TT = 146176, G1_A10 = 148736, G1_PT = 151296;

__device__ __forceinline__ void gdn_prep_unit(const Params& p, LAS unsigned char* lds, int unit) {
    const int tid = threadIdx.x, lane = tid & 63, wid = tid >> 6, fr = lane & 15, fq = lane >> 4;
    const int bh = unit >> 7, n = unit & 127, b = bh >> 2, h = bh & 3;
    const int tok0 = b * SEQ + n * 64;
    LAS bf16_t* Qs = (LAS bf16_t*)(lds + G1_QS); LAS bf16_t* Ks = (LAS bf16_t*)(lds + G1_KS); LAS bf16_t* VbT = (LAS bf16_t*)(lds + G1_VBT);
    LAS bf16_t* KbT = (LAS bf16_t*)(lds + G1_KBT); LAS bf16_t* KdT = (LAS bf16_t*)(lds + G1_KDT); LAS bf16_t* UT = (LAS bf16_t*)(lds + G1_UT);
    LAS bf16_t* WT = (LAS bf16_t*)(lds + G1_WT); LAS float* Af = (LAS float*)(lds + G1_WT); LAS bf16_t* QK = (LAS bf16_t*)(lds + G1_QK);
    LAS bf16_t* Tb = (LAS bf16_t*)(lds + G1_TB); LAS bf16_t* TT = (LAS bf16_t*)(lds + G1_TT); LAS bf16_t* A10b = (LAS bf16_t*)(lds + G1_A10); LAS bf16_t* PT = (LAS bf16_t*)(lds + G1_PT); LAS float* gcs = (LAS float*)(lds + G1_GC); LAS float* betas = (LAS float*)(lds + G1_BETA);
    const bf16_t* PB = (const bf16_t*)(p.ws + WS_H); const float* GBA = (const float*)(p.ws + WS_GBA);
    LAS unsigned char* raw = lds + G1_UT;
    for (int pc4 = wid; pc4 < 51; pc4 += 8) {
        int pc = pc4 * 4 + (lane >> 4); pc = pc < 200 ? pc : 200;
        const int r = pc / 3, seg = pc - 3 * r; int tt = n * 64 - 3 + r; tt = tt < 0 ? 0 : tt;
        __builtin_amdgcn_global_load_lds((const unsigned*)(PB + (size_t)(b * SEQ + tt) * PW + 768 + seg * 512 + h * 128 + (lane & 15) * 8), (LAS unsigned*)(raw + pc4 * 1024), 16, 0, 0);
    }
    if (tid < 64) {
        const float* gb = GBA + (size_t)(tok0 + tid) * 8;
        const float bt = 1.0f / (1.0f + __expf(-gb[h]));
        const float x = gb[4 + h] + p.in[14][h]; const float sp = x > 20.f ? x : log1pf(__expf(x));
        float c = -__expf(p.in[13][h]) * sp;
#pragma unroll
        for (int o = 1; o < 64; o <<= 1) { const float t = __shfl_up(c, o); if (lane >= o) c += t; }
        gcs[tid] = c; betas[tid] = bt;
    }
    asm volatile("s_waitcnt vmcnt(0)" ::: "memory");
    __syncthreads();
    const float gclast = gcs[63];
    const float* cw = p.in[12];
#pragma unroll 1
    for (int it = 0; it < 6; ++it) {
        const int item = tid + 512 * it, l16 = item & 15, row = item >> 4, which = row >> 6, t = row & 63;
        const int cch = which * 512 + h * 128 + l16 * 8;
        float a[8];
#pragma unroll
        for (int e = 0; e < 8; ++e) a[e] = 0.f;
#pragma unroll
        for (int j = 0; j < 4; ++j) {
            const int tt = n * 64 + t - 3 + j;
            if (tt >= 0) {
                const u32x4 xv = *(const LAS u32x4*)(raw + ((t + j) * 3 + which) * 256 + l16 * 16);
                const f32x4 w0 = *(const f32x4*)(cw + j * CONVC + cch), w1 = *(const f32x4*)(cw + j * CONVC + cch + 4);
                a[0] += w0[0] * bflo(xv.x); a[1] += w0[1] * bfhi(xv.x); a[2] += w0[2] * bflo(xv.y); a[3] += w0[3] * bfhi(xv.y);
                a[4] += w1[0] * bflo(xv.z); a[5] += w1[1] * bfhi(xv.z); a[6] += w1[2] * bflo(xv.w); a[7] += w1[3] * bfhi(xv.w);
            }
        }
        float ss = 0.f;
#pragma unroll
        for (int e = 0; e < 8; ++e) { a[e] = silu(a[e]); ss += a[e] * a[e]; }
        ss += __shfl_xor(ss, 1); ss += __shfl_xor(ss, 2); ss += __shfl_xor(ss, 4); ss += __shfl_xor(ss, 8);
        const float gct = gcs[t], bt = betas[t];
        const int tsw = (((t >> 3) ^ (l16 & 7)) << 3) | (t & 7);
        if (which == 0) {
            const float sc = rsqrtf(ss + EPS) * 0.08838834764831845f;
            u32x4 w; w.x = cvt_pk(a[0] * sc, a[1] * sc); w.y = cvt_pk(a[2] * sc, a[3] * sc); w.z = cvt_pk(a[4] * sc, a[5] * sc); w.w = cvt_pk(a[6] * sc, a[7] * sc);
            *(LAS u32x4*)(Qs + t * 136 + l16 * 8) = w;
        } else if (which == 1) {
            const float sc = rsqrtf(ss + EPS);
            u32x4 w; w.x = cvt_pk(a[0] * sc, a[1] * sc); w.y = cvt_pk(a[2] * sc, a[3] * sc); w.z = cvt_pk(a[4] * sc, a[5] * sc); w.w = cvt_pk(a[6] * sc, a[7] * sc);
            *(LAS u32x4*)(Ks + t * 136 + l16 * 8) = w;
            const float sb = sc * bt * __expf(gct), sd = sc * __expf(gclast - gct);
#pragma unroll
            for (int e = 0; e < 8; ++e) { KbT[(l16 * 8 + e) * 72 + tsw] = f2bf(a[e] * sb); KdT[(l16 * 8 + e) * 72 + tsw] = f2bf(a[e] * sd); }
        } else {
#pragma unroll
            for (int e = 0; e < 8; ++e) VbT[(l16 * 8 + e) * 72 + tsw] = f2bf(a[e] * bt);
        }
    }
    __syncthreads();
#pragma unroll 2
    for (int r = 0; r < 4; ++r) {
        const int job = wid + 8 * r, kind = job >> 4, tile = job & 15, it = tile >> 2, jt = tile & 3;
        if (kind == 0) {
            if (jt > it) continue;
            const f32x4 acc = tile_mm(Ks, 136, it, Ks, 136, jt, 4, fr, fq);
            const int j = 16 * jt + fr; const float gcj = gcs[j];
            float v[4];
#pragma unroll
            for (int e = 0; e < 4; ++e) { const int i = 16 * it + 4 * fq + e; const bool ok = i > j; v[e] = ok ? acc[e] * __expf(gcs[i] - gcj) * betas[i] : 0.f; }
            *(LAS f32x4*)(Af + j * 68 + 16 * it + 4 * fq) = (f32x4){v[0], v[1], v[2], v[3]};
            if (it >= 2 && jt < 2) {
#pragma unroll
                for (int e = 0; e < 4; ++e) A10b[(16 * (it - 2) + 4 * fq + e) * 40 + j] = f2bf(v[e]); }
        } else {
            const f32x4 acc = tile_mm(Ks, 136, jt, Qs, 136, it, 4, fr, fq);
            const int i = 16 * it + fr; const float gci = gcs[i];
            float v[4];
#pragma unroll
            for (int e = 0; e < 4; ++e) { const int j = 16 * jt + 4 * fq + e; const bool ok = i >= j; v[e] = ok ? acc[e] * __expf(gci - gcs[j]) : 0.f; }
            u32x2 w; w.x = cvt_pk(v[0], v[1]); w.y = cvt_pk(v[2], v[3]); *(LAS u32x2*)(QK + i * 72 + 16 * jt + 4 * fq) = w;
        }
    }
    __syncthreads();
    if (wid < 2) {
        const int ofs = wid * 32, cl = lane & 31; const LAS float* Ab = Af + ofs * 69; LAS bf16_t* Tw = Tb + ofs * 73 + cl; LAS bf16_t* Tt = (wid == 0) ? TT + cl * 40 : PT + cl * 40;
        f32x2v r2[16];
#pragma unroll
        for (int k = 0; k < 16; ++k) r2[k] = (f32x2v){(cl == 2 * k) ? 1.0f : 0.0f, (cl == 2 * k + 1) ? 1.0f : 0.0f};
        const f32x4 a0 = *(const LAS f32x4*)(Ab + 0);
        const f32x4 a1 = *(const LAS f32x4*)(Ab + 4);
        const f32x4 a2 = *(const LAS f32x4*)(Ab + 8);
        const f32x4 a3 = *(const LAS f32x4*)(Ab + 12);
        const f32x4 a4 = *(const LAS f32x4*)(Ab + 16);
        const float t0 = r2[0][0]; const f32x2v T0 = (f32x2v){t0, t0}; Tw[0] = f2bf(t0); Tt[0] = f2bf(t0);
        r2[0] -= (f32x2v){a0[0], a0[1]} * T0; r2[1] -= (f32x2v){a0[2], a0[3]} * T0;
        const f32x4 a5 = *(const LAS f32x4*)(Ab + 20);
        r2[2] -= (f32x2v){a1[0], a1[1]} * T0; r2[3] -= (f32x2v){a1[2], a1[3]} * T0;
        const f32x4 a6 = *(const LAS f32x4*)(Ab + 24);
        r2[4] -= (f32x2v){a2[0], a2[1]} * T0; r2[5] -= (f32x2v){a2[2], a2[3]} * T0;
        const f32x4 a7 = *(const LAS f32x4*)(Ab + 28);
        r2[6] -= (f32x2v){a3[0], a3[1]} * T0; r2[7] -= (f32x2v){a3[2], a3[3]} * T0;
        const f32x4 a8 = *(const LAS f32x4*)(Ab + 68);
        r2[8] -= (f32x2v){a4[0], a4[1]} * T0; r2[9] -= (f32x2v){a4[2], a4[3]} * T0;
        const f32x4 a9 = *(const LAS f32x4*)(Ab + 72);
        r2[10] -= (f32x2v){a5[0], a5[1]} * T0; r2[11] -= (f32x2v){a5[2], a5[3]} * T0;
        const f32x4 a10 = *(const LAS f32x4*)(Ab + 76);
        r2[12] -= (f32x2v){a6[0], a6[1]} * T0; r2[13] -= (f32x2v){a6[2], a6[3]} * T0;
        const f32x4 a11 = *(const LAS f32x4*)(Ab + 80);
        r2[14] -= (f32x2v){a7[0], a7[1]} * T0; r2[15] -= (f32x2v){a7[2], a7[3]} * T0;
        const f32x4 a12 = *(const LAS f32x4*)(Ab + 84);
        const float t1 = r2[0][1]; const f32x2v T1 = (f32x2v){t1, t1}; Tw[72] = f2bf(t1); Tt[1] = f2bf(t1);
        r2[1] -= (f32x2v){a8[2], a8[3]} * T1;
        const f32x4 a13 = *(const LAS f32x4*)(Ab + 88);
        r2[2] -= (f32x2v){a9[0], a9[1]} * T1; r2[3] -= (f32x2v){a9[2], a9[3]} * T1;
        const f32x4 a14 = *(const LAS f32x4*)(Ab + 92);
        r2[4] -= (f32x2v){a10[0], a10[1]} * T1; r2[5] -= (f32x2v){a10[2], a10[3]} * T1;
        const f32x4 a15 = *(const LAS f32x4*)(Ab + 96);
        r2[6] -= (f32x2v){a11[0], a11[1]} * T1; r2[7] -= (f32x2v){a11[2], a11[3]} * T1;
        const f32x4 a16 = *(const LAS f32x4*)(Ab + 136);
        r2[8] -= (f32x2v){a12[0], a12[1]} * T1; r2[9] -= (f32x2v){a12[2], a12[3]} * T1;
        const f32x4 a17 = *(const LAS f32x4*)(Ab + 140);
        r2[10] -= (f32x2v){a13[0], a13[1]} * T1; r2[11] -= (f32x2v){a13[2], a13[3]} * T1;
        const f32x4 a18 = *(const LAS f32x4*)(Ab + 144);
        r2[12] -= (f32x2v){a14[0], a14[1]} * T1; r2[13] -= (f32x2v){a14[2], a14[3]} * T1;
        const f32x4 a19 = *(const LAS f32x4*)(Ab + 148);
        r2[14] -= (f32x2v){a15[0], a15[1]} * T1; r2[15] -= (f32x2v){a15[2], a15[3]} * T1;
        const f32x4 a20 = *(const LAS f32x4*)(Ab + 152);
        const float t2 = r2[1][0]; const f32x2v T2 = (f32x2v){t2, t2}; Tw[144] = f2bf(t2); Tt[2] = f2bf(t2);
        r2[1] -= (f32x2v){a16[2], a16[3]} * T2;
        const f32x4 a21 = *(const LAS f32x4*)(Ab + 156);
        r2[2] -= (f32x2v){a17[0], a17[1]} * T2; r2[3] -= (f32x2v){a17[2], a17[3]} * T2;
        const f32x4 a22 = *(const LAS f32x4*)(Ab + 160);
        r2[4] -= (f32x2v){a18[0], a18[1]} * T2; r2[5] -= (f32x2v){a18[2], a18[3]} * T2;
        const f32x4 a23 = *(const LAS f32x4*)(Ab + 164);
        r2[6] -= (f32x2v){a19[0], a19[1]} * T2; r2[7] -= (f32x2v){a19[2], a19[3]} * T2;
        const f32x4 a24 = *(const LAS f32x4*)(Ab + 208);
        r2[8] -= (f32x2v){a20[0], a20[1]} * T2; r2[9] -= (f32x2v){a20[2], a20[3]} * T2;
        const f32x4 a25 = *(const LAS f32x4*)(Ab + 212);
        r2[10] -= (f32x2v){a21[0], a21[1]} * T2; r2[11] -= (f32x2v){a21[2], a21[3]} * T2;
        const f32x4 a26 = *(const LAS f32x4*)(Ab + 216);
        r2[12] -= (f32x2v){a22[0], a22[1]} * T2; r2[13] -= (f32x2v){a22[2], a22[3]} * T2;
        const f32x4 a27 = *(const LAS f32x4*)(Ab + 220);
        r2[14] -= (f32x2v){a23[0], a23[1]} * T2; r2[15] -= (f32x2v){a23[2], a23[3]} * T2;
        const f32x4 a28 = *(const LAS f32x4*)(Ab + 224);
        const float t3 = r2[1][1]; const f32x2v T3 = (f32x2v){t3, t3}; Tw[216] = f2bf(t3); Tt[3] = f2bf(t3);
        r2[2] -= (f32x2v){a24[0], a24[1]} * T3; r2[3] -= (f32x2v){a24[2], a24[3]} * T3;
        const f32x4 a29 = *(const LAS f32x4*)(Ab + 228);
        r2[4] -= (f32x2v){a25[0], a25[1]} * T3; r2[5] -= (f32x2v){a25[2], a25[3]} * T3;
        const f32x4 a30 = *(const LAS f32x4*)(Ab + 232);
        r2[6] -= (f32x2v){a26[0], a26[1]} * T3; r2[7] -= (f32x2v){a26[2], a26[3]} * T3;
        const f32x4 a31 = *(const LAS f32x4*)(Ab + 276);
        r2[8] -= (f32x2v){a27[0], a27[1]} * T3; r2[9] -= (f32x2v){a27[2], a27[3]} * T3;
        const f32x4 a32 = *(const LAS f32x4*)(Ab + 280);
        r2[10] -= (f32x2v){a28[0], a28[1]} * T3; r2[11] -= (f32x2v){a28[2], a28[3]} * T3;
        const f32x4 a33 = *(const LAS f32x4*)(Ab + 284);
        r2[12] -= (f32x2v){a29[0], a29[1]} * T3; r2[13] -= (f32x2v){a29[2], a29[3]} * T3;
        const f32x4 a34 = *(const LAS f32x4*)(Ab + 288);
        r2[14] -= (f32x2v){a30[0], a30[1]} * T3; r2[15] -= (f32x2v){a30[2], a30[3]} * T3;
        const f32x4 a35 = *(const LAS f32x4*)(Ab + 292);
        const float t4 = r2[2][0]; const f32x2v T4 = (f32x2v){t4, t4}; Tw[288] = f2bf(t4); Tt[4] = f2bf(t4);
        r2[2] -= (f32x2v){a31[0], a31[1]} * T4; r2[3] -= (f32x2v){a31[2], a31[3]} * T4;
        const f32x4 a36 = *(const LAS f32x4*)(Ab + 296);
        r2[4] -= (f32x2v){a32[0], a32[1]} * T4; r2[5] -= (f32x2v){a32[2], a32[3]} * T4;
        const f32x4 a37 = *(const LAS f32x4*)(Ab + 300);
        r2[6] -= (f32x2v){a33[0], a33[1]} * T4; r2[7] -= (f32x2v){a33[2], a33[3]} * T4;
        const f32x4 a38 = *(const LAS f32x4*)(Ab + 344);
        r2[8] -= (f32x2v){a34[0], a34[1]} * T4; r2[9] -= (f32x2v){a34[2], a34[3]} * T4;
        const f32x4 a39 = *(const LAS f32x4*)(Ab + 348);
        r2[10] -= (f32x2v){a35[0], a35[1]} * T4; r2[11] -= (f32x2v){a35[2], a35[3]} * T4;
        const f32x4 a40 = *(const LAS f32x4*)(Ab + 352);
        r2[12] -= (f32x2v){a36[0], a36[1]} * T4; r2[13] -= (f32x2v){a36[2], a36[3]} * T4;
        const f32x4 a41 = *(const LAS f32x4*)(Ab + 356);
        r2[14] -= (f32x2v){a37[0], a37[1]} * T4; r2[15] -= (f32x2v){a37[2], a37[3]} * T4;
        const f32x4 a42 = *(const LAS f32x4*)(Ab + 360);
        const float t5 = r2[2][1]; const f32x2v T5 = (f32x2v){t5, t5}; Tw[360] = f2bf(t5); Tt[5] = f2bf(t5);
        r2[3] -= (f32x2v){a38[2], a38[3]} * T5;
        const f32x4 a43 = *(const LAS f32x4*)(Ab + 364);
        r2[4] -= (f32x2v){a39[0], a39[1]} * T5; r2[5] -= (f32x2v){a39[2], a39[3]} * T5;
        const f32x4 a44 = *(const LAS f32x4*)(Ab + 368);
        r2[6] -= (f32x2v){a40[0], a40[1]} * T5; r2[7] -= (f32x2v){a40[2], a40[3]} * T5;
        const f32x4 a45 = *(const LAS f32x4*)(Ab + 412);
        r2[8] -= (f32x2v){a41[0], a41[1]} * T5; r2[9] -= (f32x2v){a41[2], a41[3]} * T5;
        const f32x4 a46 = *(const LAS f32x4*)(Ab + 416);
        r2[10] -= (f32x2v){a42[0], a42[1]} * T5; r2[11] -= (f32x2v){a42[2], a42[3]} * T5;
        const f32x4 a47 = *(const LAS f32x4*)(Ab + 420);
        r2[12] -= (f32x2v){a43[0], a43[1]} * T5; r2[13] -= (f32x2v){a43[2], a43[3]} * T5;
        const f32x4 a48 = *(const LAS f32x4*)(Ab + 424);
        r2[14] -= (f32x2v){a44[0], a44[1]} * T5; r2[15] -= (f32x2v){a44[2], a44[3]} * T5;
        const f32x4 a49 = *(const LAS f32x4*)(Ab + 428);
        const float t6 = r2[3][0]; const f32x2v T6 = (f32x2v){t6, t6}; Tw[432] = f2bf(t6); Tt[6] = f2bf(t6);
        r2[3] -= (f32x2v){a45[2], a45[3]} * T6;
        const f32x4 a50 = *(const LAS f32x4*)(Ab + 432);
        r2[4] -= (f32x2v){a46[0], a46[1]} * T6; r2[5] -= (f32x2v){a46[2], a46[3]} * T6;
        const f32x4 a51 = *(const LAS f32x4*)(Ab + 436);
        r2[6] -= (f32x2v){a47[0], a47[1]} * T6; r2[7] -= (f32x2v){a47[2], a47[3]} * T6;
        const f32x4 a52 = *(const LAS f32x4*)(Ab + 484);
        r2[8] -= (f32x2v){a48[0], a48[1]} * T6; r2[9] -= (f32x2v){a48[2], a48[3]} * T6;
        const f32x4 a53 = *(const LAS f32x4*)(Ab + 488);
        r2[10] -= (f32x2v){a49[0], a49[1]} * T6; r2[11] -= (f32x2v){a49[2], a49[3]} * T6;
        const f32x4 a54 = *(const LAS f32x4*)(Ab + 492);
        r2[12] -= (f32x2v){a50[0], a50[1]} * T6; r2[13] -= (f32x2v){a50[2], a50[3]} * T6;
        const f32x4 a55 = *(const LAS f32x4*)(Ab + 496);
        r2[14] -= (f32x2v){a51[0], a51[1]} * T6; r2[15] -= (f32x2v){a51[2], a51[3]} * T6;
        const f32x4 a56 = *(const LAS f32x4*)(Ab + 500);
        const float t7 = r2[3][1]; const f32x2v T7 = (f32x2v){t7, t7}; Tw[504] = f2bf(t7); Tt[7] = f2bf(t7);
        r2[4] -= (f32x2v){a52[0], a52[1]} * T7; r2[5] -= (f32x2v){a52[2], a52[3]} * T7;
        const f32x4 a57 = *(const LAS f32x4*)(Ab + 504);
        r2[6] -= (f32x2v){a53[0], a53[1]} * T7; r2[7] -= (f32x2v){a53[2], a53[3]} * T7;
        const f32x4 a58 = *(const LAS f32x4*)(Ab + 552);
        r2[8] -= (f32x2v){a54[0], a54[1]} * T7; r2[9] -= (f32x2v){a54[2], a54[3]} * T7;
        const f32x4 a59 = *(const LAS f32x4*)(Ab + 556);
        r2[10] -= (f32x2v){a55[0], a55[1]} * T7; r2[11] -= (f32x2v){a55[2], a55[3]} * T7;
        const f32x4 a60 = *(const LAS f32x4*)(Ab + 560);
        r2[12] -= (f32x2v){a56[0], a56[1]} * T7; r2[13] -= (f32x2v){a56[2], a56[3]} * T7;
        const f32x4 a61 = *(const LAS f32x4*)(Ab + 564);
        r2[14] -= (f32x2v){a57[0], a57[1]} * T7; r2[15] -= (f32x2v){a57[2], a57[3]} * T7;
        const f32x4 a62 = *(const LAS f32x4*)(Ab + 568);
        const float t8 = r2[4][0]; const f32x2v T8 = (f32x2v){t8, t8}; Tw[576] = f2bf(t8); Tt[8] = f2bf(t8);
        r2[4] -= (f32x2v){a58[0], a58[1]} * T8; r2[5] -= (f32x2v){a58[2], a58[3]} * T8;
        const f32x4 a63 = *(const LAS f32x4*)(Ab + 572);
        r2[6] -= (f32x2v){a59[0], a59[1]} * T8; r2[7] -= (f32x2v){a59[2], a59[3]} * T8;
        const f32x4 a64 = *(const LAS f32x4*)(Ab + 620);
        r2[8] -= (f32x2v){a60[0], a60[1]} * T8; r2[9] -= (f32x2v){a60[2], a60[3]} * T8;
        const f32x4 a65 = *(const LAS f32x4*)(Ab + 624);
        r2[10] -= (f32x2v){a61[0], a61[1]} * T8; r2[11] -= (f32x2v){a61[2], a61[3]} * T8;
        const f32x4 a66 = *(const LAS f32x4*)(Ab + 628);
        r2[12] -= (f32x2v){a62[0], a62[1]} * T8; r2[13] -= (f32x2v){a62[2], a62[3]} * T8;
        const f32x4 a67 = *(const LAS f32x4*)(Ab + 632);
        r2[14] -= (f32x2v){a63[0], a63[1]} * T8; r2[15] -= (f32x2v){a63[2], a63[3]} * T8;
        const f32x4 a68 = *(const LAS f32x4*)(Ab + 636);
        const float t9 = r2[4][1]; const f32x2v T9 = (f32x2v){t9, t9}; Tw[648] = f2bf(t9); Tt[9] = f2bf(t9);
        r2[5] -= (f32x2v){a64[2], a64[3]} * T9;
        const f32x4 a69 = *(const LAS f32x4*)(Ab + 640);
        r2[6] -= (f32x2v){a65[0], a65[1]} * T9; r2[7] -= (f32x2v){a65[2], a65[3]} * T9;
        const f32x4 a70 = *(const LAS f32x4*)(Ab + 688);
        r2[8] -= (f32x2v){a66[0], a66[1]} * T9; r2[9] -= (f32x2v){a66[2], a66[3]} * T9;
        const f32x4 a71 = *(const LAS f32x4*)(Ab + 692);
        r2[10] -= (f32x2v){a67[0], a67[1]} * T9; r2[11] -= (f32x2v){a67[2], a67[3]} * T9;
        const f32x4 a72 = *(const LAS f32x4*)(Ab + 696);
        r2[12] -= (f32x2v){a68[0], a68[1]} * T9; r2[13] -= (f32x2v){a68[2], a68[3]} * T9;
        const f32x4 a73 = *(const LAS f32x4*)(Ab + 700);
        r2[14] -= (f32x2v){a69[0], a69[1]} * T9; r2[15] -= (f32x2v){a69[2], a69[3]} * T9;
        const f32x4 a74 = *(const LAS f32x4*)(Ab + 704);
        const float t10 = r2[5][0]; const f32x2v T10 = (f32x2v){t10, t10}; Tw[720] = f2bf(t10); Tt[10] = f2bf(t10);
        r2[5] -= (f32x2v){a70[2], a70[3]} * T10;
        const f32x4 a75 = *(const LAS f32x4*)(Ab + 708);
        r2[6] -= (f32x2v){a71[0], a71[1]} * T10; r2[7] -= (f32x2v){a71[2], a71[3]} * T10;
        const f32x4 a76 = *(const LAS f32x4*)(Ab + 760);
        r2[8] -= (f32x2v){a72[0], a72[1]} * T10; r2[9] -= (f32x2v){a72[2], a72[3]} * T10;
        const f32x4 a77 = *(const LAS f32x4*)(Ab + 764);
        r2[10] -= (f32x2v){a73[0], a73[1]} * T10; r2[11] -= (f32x2v){a73[2], a73[3]} * T10;
        const f32x4 a78 = *(const LAS f32x4*)(Ab + 768);
        r2[12] -= (f32x2v){a74[0], a74[1]} * T10; r2[13] -= (f32x2v){a74[2], a74[3]} * T10;
        const f32x4 a79 = *(const LAS f32x4*)(Ab + 772);
        r2[14] -= (f32x2v){a75[0], a75[1]} * T10; r2[15] -= (f32x2v){a75[2], a75[3]} * T10;
        const f32x4 a80 = *(const LAS f32x4*)(Ab + 776);
        const float t11 = r2[5][1]; const f32x2v T11 = (f32x2v){t11, t11}; Tw[792] = f2bf(t11); Tt[11] = f2bf(t11);
        r2[6] -= (f32x2v){a76[0], a76[1]} * T11; r2[7] -= (f32x2v){a76[2], a76[3]} * T11;
        const f32x4 a81 = *(const LAS f32x4*)(Ab + 828);
        r2[8] -= (f32x2v){a77[0], a77[1]} * T11; r2[9] -= (f32x2v){a77[2], a77[3]} * T11;
        const f32x4 a82 = *(const LAS f32x4*)(Ab + 832);
        r2[10] -= (f32x2v){a78[0], a78[1]} * T11; r2[11] -= (f32x2v){a78[2], a78[3]} * T11;
        const f32x4 a83 = *(const LAS f32x4*)(Ab + 836);
        r2[12] -= (f32x2v){a79[0], a79[1]} * T11; r2[13] -= (f32x2v){a79[2], a79[3]} * T11;
        const f32x4 a84 = *(const LAS f32x4*)(Ab + 840);
        r2[14] -= (f32x2v){a80[0], a80[1]} * T11; r2[15] -= (f32x2v){a80[2], a80[3]} * T11;
        const f32x4 a85 = *(const LAS f32x4*)(Ab + 844);
        const float t12 = r2[6][0]; const f32x2v T12 = (f32x2v){t12, t12}; Tw[864] = f2bf(t12); Tt[12] = f2bf(t12);
        r2[6] -= (f32x2v){a81[0], a81[1]} * T12; r2[7] -= (f32x2v){a81[2], a81[3]} * T12;
        const f32x4 a86 = *(const LAS f32x4*)(Ab + 896);
        r2[8] -= (f32x2v){a82[0], a82[1]} * T12; r2[9] -= (f32x2v){a82[2], a82[3]} * T12;
        const f32x4 a87 = *(const LAS f32x4*)(Ab + 900);
        r2[10] -= (f32x2v){a83[0], a83[1]} * T12; r2[11] -= (f32x2v){a83[2], a83[3]} * T12;
        const f32x4 a88 = *(const LAS f32x4*)(Ab + 904);
        r2[12] -= (f32x2v){a84[0], a84[1]} * T12; r2[13] -= (f32x2v){a84[2], a84[3]} * T12;
        const f32x4 a89 = *(const LAS f32x4*)(Ab + 908);
        r2[14] -= (f32x2v){a85[0], a85[1]} * T12; r2[15] -= (f32x2v){a85[2], a85[3]} * T12;
        const f32x4 a90 = *(const LAS f32x4*)(Ab + 912);
        const float t13 = r2[6][1]; const f32x2v T13 = (f32x2v){t13, t13}; Tw[936] = f2bf(t13); Tt[13] = f2bf(t13);
        r2[7] -= (f32x2v){a86[2], a86[3]} * T13;
        const f32x4 a91 = *(const LAS f32x4*)(Ab + 964);
        r2[8] -= (f32x2v){a87[0], a87[1]} * T13; r2[9] -= (f32x2v){a87[2], a87[3]} * T13;
        const f32x4 a92 = *(const LAS f32x4*)(Ab + 968);
        r2[10] -= (f32x2v){a88[0], a88[1]} * T13; r2[11] -= (f32x2v){a88[2], a88[3]} * T13;
        const f32x4 a93 = *(const LAS f32x4*)(Ab + 972);
        r2[12] -= (f32x2v){a89[0], a89[1]} * T13; r2[13] -= (f32x2v){a89[2], a89[3]} * T13;
        const f32x4 a94 = *(const LAS f32x4*)(Ab + 976);
        r2[14] -= (f32x2v){a90[0], a90[1]} * T13; r2[15] -= (f32x2v){a90[2], a90[3]} * T13;
        const f32x4 a95 = *(const LAS f32x4*)(Ab + 980);
        const float t14 = r2[7][0]; const f32x2v T14 = (f32x2v){t14, t14}; Tw[1008] = f2bf(t14); Tt[14] = f2bf(t14);
        r2[7] -= (f32x2v){a91[2], a91[3]} * T14;
        const f32x4 a96 = *(const LAS f32x4*)(Ab + 1036);
        r2[8] -= (f32x2v){a92[0], a92[1]} * T14; r2[9] -= (f32x2v){a92[2], a92[3]} * T14;
        const f32x4 a97 = *(const LAS f32x4*)(Ab + 1040);
        r2[10] -= (f32x2v){a93[0], a93[1]} * T14; r2[11] -= (f32x2v){a93[2], a93[3]} * T14;
        const f32x4 a98 = *(const LAS f32x4*)(Ab + 1044);
        r2[12] -= (f32x2v){a94[0], a94[1]} * T14; r2[13] -= (f32x2v){a94[2], a94[3]} * T14;
        const f32x4 a99 = *(const LAS f32x4*)(Ab + 1048);
        r2[14] -= (f32x2v){a95[0], a95[1]} * T14; r2[15] -= (f32x2v){a95[2], a95[3]} * T14;
        const f32x4 a100 = *(const LAS f32x4*)(Ab + 1104);
        const float t15 = r2[7][1]; const f32x2v T15 = (f32x2v){t15, t15}; Tw[1080] = f2bf(t15); Tt[15] = f2bf(t15);
        r2[8] -= (f32x2v){a96[0], a96[1]} * T15; r2[9] -= (f32x2v){a96[2], a96[3]} * T15;
        const f32x4 a101 = *(const LAS f32x4*)(Ab + 1108);
        r2[10] -= (f32x2v){a97[0], a97[1]} * T15; r2[11] -= (f32x2v){a97[2], a97[3]} * T15;
        const f32x4 a102 = *(const LAS f32x4*)(Ab + 1112);
        r2[12] -= (f32x2v){a98[0], a98[1]} * T15; r2[13] -= (f32x2v){a98[2], a98[3]} * T15;
        const f32x4 a103 = *(const LAS f32x4*)(Ab + 1116);
        r2[14] -= (f32x2v){a99[0], a99[1]} * T15; r2[15] -= (f32x2v){a99[2], a99[3]} * T15;
        const f32x4 a104 = *(const LAS f32x4*)(Ab + 1172);
        const float t16 = r2[8][0]; const f32x2v T16 = (f32x2v){t16, t16}; Tw[1152] = f2bf(t16); Tt[16] = f2bf(t16);
        r2[8] -= (f32x2v){a100[0], a100[1]} * T16; r2[9] -= (f32x2v){a100[2], a100[3]} * T16;
        const f32x4 a105 = *(const LAS f32x4*)(Ab + 1176);
        r2[10] -= (f32x2v){a101[0], a101[1]} * T16; r2[11] -= (f32x2v){a101[2], a101[3]} * T16;
        const f32x4 a106 = *(const LAS f32x4*)(Ab + 1180);
        r2[12] -= (f32x2v){a102[0], a102[1]} * T16; r2[13] -= (f32x2v){a102[2], a102[3]} * T16;
        const f32x4 a107 = *(const LAS f32x4*)(Ab + 1184);
        r2[14] -= (f32x2v){a103[0], a103[1]} * T16; r2[15] -= (f32x2v){a103[2], a103[3]} * T16;
        const f32x4 a108 = *(const LAS f32x4*)(Ab + 1240);
        const float t17 = r2[8][1]; const f32x2v T17 = (f32x2v){t17, t17}; Tw[1224] = f2bf(t17); Tt[17] = f2bf(t17);
        r2[9] -= (f32x2v){a104[2], a104[3]} * T17;
        const f32x4 a109 = *(const LAS f32x4*)(Ab + 1244);
        r2[10] -= (f32x2v){a105[0], a105[1]} * T17; r2[11] -= (f32x2v){a105[2], a105[3]} * T17;
        const f32x4 a110 = *(const LAS f32x4*)(Ab + 1248);
        r2[12] -= (f32x2v){a106[0], a106[1]} * T17; r2[13] -= (f32x2v){a106[2], a106[3]} * T17;
        const f32x4 a111 = *(const LAS f32x4*)(Ab + 1252);
        r2[14] -= (f32x2v){a107[0], a107[1]} * T17; r2[15] -= (f32x2v){a107[2], a107[3]} * T17;
        const f32x4 a112 = *(const LAS f32x4*)(Ab + 1312);
        const float t18 = r2[9][0]; const f32x2v T18 = (f32x2v){t18, t18}; Tw[1296] = f2bf(t18); Tt[18] = f2bf(t18);
        r2[9] -= (f32x2v){a108[2], a108[3]} * T18;
        const f32x4 a113 = *(const LAS f32x4*)(Ab + 1316);
        r2[10] -= (f32x2v){a109[0], a109[1]} * T18; r2[11] -= (f32x2v){a109[2], a109[3]} * T18;
        const f32x4 a114 = *(const LAS f32x4*)(Ab + 1320);
        r2[12] -= (f32x2v){a110[0], a110[1]} * T18; r2[13] -= (f32x2v){a110[2], a110[3]} * T18;
        const f32x4 a115 = *(const LAS f32x4*)(Ab + 1380);
        r2[14] -= (f32x2v){a111[0], a111[1]} * T18; r2[15] -= (f32x2v){a111[2], a111[3]} * T18;
        const f32x4 a116 = *(const LAS f32x4*)(Ab + 1384);
        const float t19 = r2[9][1]; const f32x2v T19 = (f32x2v){t19, t19}; Tw[1368] = f2bf(t19); Tt[19] = f2bf(t19);
        r2[10] -= (f32x2v){a112[0], a112[1]} * T19; r2[11] -= (f32x2v){a112[2], a112[3]} * T19;
        const f32x4 a117 = *(const LAS f32x4*)(Ab + 1388);
        r2[12] -= (f32x2v){a113[0], a113[1]} * T19; r2[13] -= (f32x2v){a113[2], a113[3]} * T19;
        const f32x4 a118 = *(const LAS f32x4*)(Ab + 1448);
        r2[14] -= (f32x2v){a114[0], a114[1]} * T19; r2[15] -= (f32x2v){a114[2], a114[3]} * T19;
        const f32x4 a119 = *(const LAS f32x4*)(Ab + 1452);
        const float t20 = r2[10][0]; const f32x2v T20 = (f32x2v){t20, t20}; Tw[1440] = f2bf(t20); Tt[20] = f2bf(t20);
        r2[10] -= (f32x2v){a115[0], a115[1]} * T20; r2[11] -= (f32x2v){a115[2], a115[3]} * T20;
        const f32x4 a120 = *(const LAS f32x4*)(Ab + 1456);
        r2[12] -= (f32x2v){a116[0], a116[1]} * T20; r2[13] -= (f32x2v){a116[2], a116[3]} * T20;
        const f32x4 a121 = *(const LAS f32x4*)(Ab + 1516);
        r2[14] -= (f32x2v){a117[0], a117[1]} * T20; r2[15] -= (f32x2v){a117[2], a117[3]} * T20;
        const f32x4 a122 = *(const LAS f32x4*)(Ab + 1520);
        const float t21 = r2[10][1]; const f32x2v T21 = (f32x2v){t21, t21}; Tw[1512] = f2bf(t21); Tt[21] = f2bf(t21);
        r2[11] -= (f32x2v){a118[2], a118[3]} * T21;
        const f32x4 a123 = *(const LAS f32x4*)(Ab + 1524);
        r2[12] -= (f32x2v){a119[0], a119[1]} * T21; r2[13] -= (f32x2v){a119[2], a119[3]} * T21;
        const f32x4 a124 = *(const LAS f32x4*)(Ab + 1588);
        r2[14] -= (f32x2v){a120[0], a120[1]} * T21; r2[15] -= (f32x2v){a120[2], a120[3]} * T21;
        const f32x4 a125 = *(const LAS f32x4*)(Ab + 1592);
        const float t22 = r2[11][0]; const f32x2v T22 = (f32x2v){t22, t22}; Tw[1584] = f2bf(t22); Tt[22] = f2bf(t22);
        r2[11] -= (f32x2v){a121[2], a121[3]} * T22;
        const f32x4 a126 = *(const LAS f32x4*)(Ab + 1656);
        r2[12] -= (f32x2v){a122[0], a122[1]} * T22; r2[13] -= (f32x2v){a122[2], a122[3]} * T22;
        const f32x4 a127 = *(const LAS f32x4*)(Ab + 1660);
        r2[14] -= (f32x2v){a123[0], a123[1]} * T22; r2[15] -= (f32x2v){a123[2], a123[3]} * T22;
        const f32x4 a128 = *(const LAS f32x4*)(Ab + 1724);
        const float t23 = r2[11][1]; const f32x2v T23 = (f32x2v){t23, t23}; Tw[1656] = f2bf(t23); Tt[23] = f2bf(t23);
        r2[12] -= (f32x2v){a124[0], a124[1]} * T23; r2[13] -= (f32x2v){a124[2], a124[3]} * T23;
        const f32x4 a129 = *(const LAS f32x4*)(Ab + 1728);
        r2[14] -= (f32x2v){a125[0], a125[1]} * T23; r2[15] -= (f32x2v){a125[2], a125[3]} * T23;
        const f32x4 a130 = *(const LAS f32x4*)(Ab + 1792);
        const float t24 = r2[12][0]; const f32x2v T24 = (f32x2v){t24, t24}; Tw[1728] = f2bf(t24); Tt[24] = f2bf(t24);
        r2[12] -= (f32x2v){a126[0], a126[1]} * T24; r2[13] -= (f32x2v){a126[2], a126[3]} * T24;
        const f32x4 a131 = *(const LAS f32x4*)(Ab + 1796);
        r2[14] -= (f32x2v){a127[0], a127[1]} * T24; r2[15] -= (f32x2v){a127[2], a127[3]} * T24;
        const f32x4 a132 = *(const LAS f32x4*)(Ab + 1864);
        const float t25 = r2[12][1]; const f32x2v T25 = (f32x2v){t25, t25}; Tw[1800] = f2bf(t25); Tt[25] = f2bf(t25);
        r2[13] -= (f32x2v){a128[2], a128[3]} * T25;
        const f32x4 a133 = *(const LAS f32x4*)(Ab + 1932);
        r2[14] -= (f32x2v){a129[0], a129[1]} * T25; r2[15] -= (f32x2v){a129[2], a129[3]} * T25;
        const f32x4 a134 = *(const LAS f32x4*)(Ab + 2000);
        const float t26 = r2[13][0]; const f32x2v T26 = (f32x2v){t26, t26}; Tw[1872] = f2bf(t26); Tt[26] = f2bf(t26);
        r2[13] -= (f32x2v){a130[2], a130[3]} * T26;
        const f32x4 a135 = *(const LAS f32x4*)(Ab + 2068);
        r2[14] -= (f32x2v){a131[0], a131[1]} * T26; r2[15] -= (f32x2v){a131[2], a131[3]} * T26;
        const float t27 = r2[13][1]; const f32x2v T27 = (f32x2v){t27, t27}; Tw[1944] = f2bf(t27); Tt[27] = f2bf(t27);
        r2[14] -= (f32x2v){a132[0], a132[1]} * T27; r2[15] -= (f32x2v){a132[2], a132[3]} * T27;
        const float t28 = r2[14][0]; const f32x2v T28 = (f32x2v){t28, t28}; Tw[2016] = f2bf(t28); Tt[28] = f2bf(t28);
        r2[14] -= (f32x2v){a133[0], a133[1]} * T28; r2[15] -= (f32x2v){a133[2], a133[3]} * T28;
        const float t29 = r2[14][1]; const f32x2v T29 = (f32x2v){t29, t29}; Tw[2088] = f2bf(t29); Tt[29] = f2bf(t29);
        r2[15] -= (f32x2v){a134[2], a134[3]} * T29;
        const float t30 = r2[15][0]; const f32x2v T30 = (f32x2v){t30, t30}; Tw[2160] = f2bf(t30); Tt[30] = f2bf(t30);
        r2[15] -= (f32x2v){a135[2], a135[3]} * T30;
        Tw[2232] = f2bf(r2[15][1]); Tt[31] = f2bf(r2[15][1]);
    } else if (wid == 2) {
        *(LAS u32x4*)(Tb + (lane >> 1) * 72 + 32 + (lane & 1) * 16) = (u32x4){0u, 0u, 0u, 0u}; *(LAS u32x4*)(Tb + (lane >> 1) * 72 + 32 + (lane & 1) * 16 + 8) = (u32x4){0u, 0u, 0u, 0u};
    }
    __syncthreads();
    if (wid < 4) {
        const int mt = wid >> 1, nt = wid & 1; const f32x4 acc = tile_mm(A10b, 40, mt, TT, 40, nt, 1, fr, fq);
        u32x2 w; w.x = cvt_pk(acc[0], acc[1]); w.y = cvt_pk(acc[2], acc[3]); *(LAS u32x2*)(PT + (16 * nt + fr) * 40 + 16 * mt + 4 * fq) = w;
    }
    __syncthreads();
    if (wid < 4) {
        const int mt = wid >> 1, nt = wid & 1; const f32x4 acc = tile_mm(Tb + 32 * 72 + 32, 72, mt, PT, 40, nt, 1, fr, fq);
#pragma unroll
        for (int e = 0; e < 4; ++e) Tb[(32 + 16 * mt + 4 * fq + e) * 72 + 16 * nt + fr] = f2bf(-acc[e]);
    }
    __syncthreads();
#pragma unroll 2
    for (int r = 0; r < 8; ++r) {
        const int job = wid + 8 * r, kind = job >> 5, tile = job & 31, mt = tile >> 3, nt = tile & 7;
        const f32x4 acc = tile_mm<false, true>(Tb, 72, mt, kind ? KbT : VbT, 72, nt, 2, fr, fq);
        u32x2 w; w.x = cvt_pk(acc[0], acc[1]); w.y = cvt_pk(acc[2], acc[3]);
        { const int ch = 16 * nt + fr; *(LAS u32x2*)((kind ? WT : UT) + ch * 72 + 8 * ((2 * mt + (fq >> 1)) ^ ((ch >> 3) & 7)) + 4 * (fq & 1)) = w; }
    }
    __syncthreads();
    bf16_t* GM = (bf16_t*)(p.ws + WS_GM) + (size_t)unit * 16384; bf16_t* GN = (bf16_t*)(p.ws + WS_GN) + (size_t)unit * 16384;
    bf16_t* GQ = (bf16_t*)(p.ws + WS_GQ) + (size_t)unit * 8192; bf16_t* GO = (bf16_t*)(p.ws + WS_GO) + (size_t)unit * 8192;
#pragma unroll 2
    for (int r = 0; r < 24; ++r) {
        const int job = wid + 8 * r;
        if (job < 64) { const int a = job >> 3, mt = job & 7;
            const f32x4 acc = tile_mm<true, true>(WT, 72, a, KdT, 72, mt, 2, fr, fq);
            u32x2 w; w.x = cvt_pk(-acc[0], -acc[1]); w.y = cvt_pk(-acc[2], -acc[3]);
            *(u32x2*)(GM + ((mt * 4 + (a >> 1)) * 64 + lane) * 8 + (a & 1) * 4) = w;
        } else if (job < 128) { const int j = job - 64, mt = j >> 3, nt = j & 7;
            const f32x4 acc = tile_mm<true, true>(KdT, 72, mt, UT, 72, nt, 2, fr, fq);
            u32x2 w; w.x = cvt_pk(acc[0], acc[1]); w.y = cvt_pk(acc[2], acc[3]);
            *(u32x2*)(GN + ((nt * 64 + lane) * 8 + mt) * 4) = w;
        } else if (job < 160) { const int j = job - 128, a = j >> 2, it = j & 3;
            const f32x4 acc = tile_mm<true, false>(WT, 72, a, QK, 72, it, 2, fr, fq);
            const int i = 16 * it + fr; const float eg = __expf(gcs[i]);
            const u32x2 qv = *(const LAS u32x2*)(Qs + i * 136 + 16 * a + 4 * fq);
            u32x2 w; w.x = cvt_pk(bflo(qv.x) * eg - acc[0], bfhi(qv.x) * eg - acc[1]); w.y = cvt_pk(bflo(qv.y) * eg - acc[2], bfhi(qv.y) * eg - acc[3]);
            *(u32x2*)(GQ + ((it * 4 + (a >> 1)) * 64 + lane) * 8 + (a & 1) * 4) = w;
        } else { const int j = job - 160, mt = j >> 3, nt = j & 7;
            const f32x4 acc = tile_mm<false, true>(QK, 72, mt, UT, 72, nt, 2, fr, fq);
            u32x2 w; w.x = cvt_pk(acc[0], acc[1]); w.y = cvt_pk(acc[2], acc[3]);
            *(u32x2*)(GO + ((nt * 64 + lane) * 4 + mt) * 4) = w;
        }
    }
    if (tid == 0) ((float*)(p.ws + WS_CTL + CTL_GLAST))[unit] = __expf(gclast);
    __syncthreads();
}

__device__ __forceinline__ void gdn_scan(const Params& p, LAS unsigned char* lds, int sb) {
    const int tid = threadIdx.x, lane = tid & 63, wid = tid >> 6, fr = lane & 15, fq = lane >> 4;
    const int bh = sb / (8 / CW), sp = sb % (8 / CW), unit0 = bh * 128, sl = sp * CW + wid;
    const u32x4* GMb = (const u32x4*)((const bf16_t*)(p.ws + WS_GM) + (size_t)unit0 * 16384);
    const u32x4* GQb = (const u32x4*)((const bf16_t*)(p.ws + WS_GQ) + (size_t)unit0 * 8192);
    const bf16_t* GNb = (const bf16_t*)(p.ws + WS_GN) + (size_t)unit0 * 16384;
    bf16_t* GOb = (bf16_t*)(p.ws + WS_GO) + (size_t)unit0 * 8192;
    const float* glast = (const float*)(p.ws + WS_CTL + CTL_GLAST) + unit0;
    const bool loader = (wid >= CW && wid < CW + 4);
#define SCAN_DMA(cc) do { _Pragma("unroll") for (int k = 0; k < 8; ++k) { const int inst = (wid - CW) * 8 + k; \
        __builtin_amdgcn_global_load_lds((const unsigned*)((const char*)(GMb + (size_t)(cc) * 2048) + inst * 1024 + lane * 16), (LAS unsigned*)(lds + ((cc) & 3) * 32768 + inst * 1024), 16, 0, 0); } } while (0)
#define SCAN_LOADN(dn, cc) do { const bf16_t* np_ = GNb + (size_t)((cc) < 128 ? (cc) : 127) * 16384 + (size_t)(sl * 64 + lane) * 32; \
        asm volatile("global_load_dwordx4 %0, %4, off\n\tglobal_load_dwordx4 %1, %4, off offset:16\n\tglobal_load_dwordx4 %2, %4, off offset:32\n\tglobal_load_dwordx4 %3, %4, off offset:48" \
            : "=&v"(dn[0]), "=&v"(dn[1]), "=&v"(dn[2]), "=&v"(dn[3]) : "v"(np_) : "memory"); } while (0)
#define SCAN_WAITN(dn, N) asm volatile("s_waitcnt vmcnt(" #N ")" : "+v"(dn[0]), "+v"(dn[1]), "+v"(dn[2]), "+v"(dn[3]) :: "memory")
#define SCAN_STEP(c, nn, RELOAD) do { \
        SCAN_WAITN(nn, 8); \
        const float gl = __shfl(((c) < 64) ? glr0 : glr1, (c) & 63); bf16x8 Sb[4]; \
        bf16_t* scp = (bf16_t*)GNb + (size_t)(c) * 16384 + (size_t)sl * 2048 + lane * 8; \
        _Pragma("unroll") for (int ks = 0; ks < 4; ++ks) { u32x4 w; w.x = cvt_pk(S[2 * ks][0], S[2 * ks][1]); w.y = cvt_pk(S[2 * ks][2], S[2 * ks][3]); \
            w.z = cvt_pk(S[2 * ks + 1][0], S[2 * ks + 1][1]); w.w = cvt_pk(S[2 * ks + 1][2], S[2 * ks + 1][3]); Sb[ks] = __builtin_bit_cast(bf16x8, w); } \
        const LAS unsigned char* slot = lds + ((c) & 3) * 32768 + lane * 16; \
        bf16x8 fa[2][2][4]; \
        _Pragma("unroll") for (int ks = 0; ks < 4; ++ks) { fa[0][0][ks] = *(const LAS bf16x8*)(slot + (0 * 4 + ks) * 1024); fa[0][1][ks] = *(const LAS bf16x8*)(slot + (1 * 4 + ks) * 1024); } \
        _Pragma("unroll") for (int mt = 0; mt < 8; ++mt) { const unsigned w0 = nn[mt >> 1][(mt & 1) * 2], w1 = nn[mt >> 1][(mt & 1) * 2 + 1]; \
            S[mt] = S[mt] * gl + (f32x4){bflo(w0), bfhi(w0), bflo(w1), bfhi(w1)}; } \
        _Pragma("unroll") for (int ks = 0; ks < 4; ++ks) *(u32x4*)(scp + ks * 512) = __builtin_bit_cast(u32x4, Sb[ks]);     \
        RELOAD; \
        _Pragma("unroll") for (int pr = 0; pr < 4; ++pr) { \
            if (pr < 3) { _Pragma("unroll") for (int ks = 0; ks < 4; ++ks) { fa[(pr + 1) & 1][0][ks] = *(const LAS bf16x8*)(slot + ((2 * pr + 2) * 4 + ks) * 1024); fa[(pr + 1) & 1][1][ks] = *(const LAS bf16x8*)(slot + ((2 * pr + 3) * 4 + ks) * 1024); } } \
            _Pragma("unroll") for (int ks = 0; ks < 4; ++ks) { S[2 * pr] = mfma16(fa[pr & 1][0][ks], Sb[ks], S[2 * pr]); S[2 * pr + 1] = mfma16(fa[pr & 1][1][ks], Sb[ks], S[2 * pr + 1]); } } \
        } while (0)
    if (loader) { SCAN_DMA(0); SCAN_DMA(1); SCAN_DMA(2); asm volatile("s_waitcnt vmcnt(0)" ::: "memory"); }
    f32x4 S[8];
#pragma unroll
    for (int mt = 0; mt < 8; ++mt) S[mt] = (f32x4){0.f, 0.f, 0.f, 0.f};
    float glr0 = glast[lane], glr1 = glast[64 + lane];
    asm volatile("" : "+v"(glr0), "+v"(glr1));
    u32x4 nnA[4], nnB[4];
    if (wid < CW) { SCAN_LOADN(nnA, 0); SCAN_LOADN(nnB, 1); SCAN_WAITN(nnA, 0); SCAN_WAITN(nnB, 0); }
    asm volatile("s_waitcnt lgkmcnt(0)" ::: "memory"); __builtin_amdgcn_s_barrier(); asm volatile("" ::: "memory");
#pragma unroll 1
    for (int c = 0; c < 128; c += 2) {
        if (loader) { if (c + 3 < 128) { SCAN_DMA(c + 3); asm volatile("s_waitcnt vmcnt(16)" ::: "memory"); } else asm volatile("s_waitcnt vmcnt(0)" ::: "memory"); }
        else if (wid < CW) { SCAN_STEP(c, nnA, SCAN_LOADN(nnA, c + 2)); }
        asm volatile("s_waitcnt lgkmcnt(0)" ::: "memory"); __builtin_amdgcn_s_barrier(); asm volatile("" ::: "memory");
        if (loader) { if (c + 4 < 128) { SCAN_DMA(c + 4); asm volatile("s_waitcnt vmcnt(16)" ::: "memory"); } else asm volatile("s_waitcnt vmcnt(0)" ::: "memory"); }
        else if (wid < CW) { SCAN_STEP(c + 1, nnB, SCAN_LOADN(nnB, c + 3)); }
        asm volatile("s_waitcnt lgkmcnt(0)" ::: "memory"); __builtin_amdgcn_s_barrier(); asm volatile("" ::: "memory");
    }
#undef SCAN_DMA
#undef SCAN_LOADN
#undef SCAN_WAITN
#undef SCAN_STEP
    __syncthreads();
    if (wid < CW) {
        float* go = p.out + O_GP + (size_t)bh * 16384;
#pragma unroll
        for (int mt = 0; mt < 8; ++mt)
#pragma unroll
            for (int e = 0; e < 4; ++e) go[(16 * mt + 4 * fq + e) * 128 + sl * 16 + fr] = S[mt][e];
    }
}

__device__ __forceinline__ void gdn_gate_unit(const Params& p, int unit, int lane) {
    const int fr = lane & 15, fq = lane >> 4, bh = unit >> 7, n = unit & 127, b = bh >> 2, h = bh & 3, tok0 = b * SEQ + n * 64;
    const bf16_t* GO = (const bf16_t*)(p.ws + WS_GO) + (size_t)unit * 8192;
    bf16_t* PB = (bf16_t*)(p.ws + WS_H);
    {
        bf16_t* GOw = (bf16_t*)(p.ws + WS_GO) + (size_t)unit * 8192;
        const bf16_t* GQ = (const bf16_t*)(p.ws + WS_GQ) + (size_t)unit * 8192; const bf16_t* SC = (const bf16_t*)(p.ws + WS_GN) + (size_t)unit * 16384;
        bf16x8 qa[4][4];
#pragma unroll
        for (int mt = 0; mt < 4; ++mt)
#pragma unroll
            for (int ks = 0; ks < 4; ++ks) qa[mt][ks] = *(const bf16x8*)(GQ + ((mt * 4 + ks) * 64 + lane) * 8);
#pragma unroll 2
        for (int nt = 0; nt < 8; ++nt) {
            bf16x8 sb[4];
#pragma unroll
            for (int ks = 0; ks < 4; ++ks) sb[ks] = *(const bf16x8*)(SC + nt * 2048 + (ks * 64 + lane) * 8);
            const u32x4 o0 = *(const u32x4*)(GOw + (nt * 64 + lane) * 16), o1 = *(const u32x4*)(GOw + (nt * 64 + lane) * 16 + 8);
            f32x4 acc[4];
            acc[0] = (f32x4){bflo(o0.x), bfhi(o0.x), bflo(o0.y), bfhi(o0.y)}; acc[1] = (f32x4){bflo(o0.z), bfhi(o0.z), bflo(o0.w), bfhi(o0.w)};
            acc[2] = (f32x4){bflo(o1.x), bfhi(o1.x), bflo(o1.y), bfhi(o1.y)}; acc[3] = (f32x4){bflo(o1.z), bfhi(o1.z), bflo(o1.w), bfhi(o1.w)};
#pragma unroll
            for (int ks = 0; ks < 4; ++ks)
#pragma unroll
                for (int mt = 0; mt < 4; ++mt) acc[mt] = mfma16(qa[mt][ks], sb[ks], acc[mt]);
            u32x4 w0, w1;
            w0.x = cvt_pk(acc[0][0], acc[0][1]); w0.y = cvt_pk(acc[0][2], acc[0][3]); w0.z = cvt_pk(acc[1][0], acc[1][1]); w0.w = cvt_pk(acc[1][2], acc[1][3]);
            w1.x = cvt_pk(acc[2][0], acc[2][1]); w1.y = cvt_pk(acc[2][2], acc[2][3]); w1.z = cvt_pk(acc[3][0], acc[3][1]); w1.w = cvt_pk(acc[3][2], acc[3][3]);
            *(u32x4*)(GOw + (nt * 64 + lane) * 16) = w0; *(u32x4*)(GOw + (nt * 64 + lane) * 16 + 8) = w1;
        }
        asm volatile("s_waitcnt vmcnt(0)" ::: "memory");
    }
    float ssq[16];
#pragma unroll
    for (int k = 0; k < 16; ++k) ssq[k] = 0.f;
#pragma unroll 1
    for (int nt = 0; nt < 8; ++nt) {
        const u32x4 a0 = *(const u32x4*)(GO + (nt * 64 + lane) * 16), a1 = *(const u32x4*)(GO + (nt * 64 + lane) * 16 + 8);
#pragma unroll
        for (int k = 0; k < 4; ++k) { const float l0 = bflo(a0[k]), h0 = bfhi(a0[k]), l1 = bflo(a1[k]), h1 = bfhi(a1[k]);
            ssq[2 * k] += l0 * l0; ssq[2 * k + 1] += h0 * h0; ssq[8 + 2 * k] += l1 * l1; ssq[8 + 2 * k + 1] += h1 * h1; }
    }
#pragma unroll
    for (int k = 0; k < 16; ++k) { float s = ssq[k]; s += __shfl_xor(s, 1); s += __shfl_xor(s, 2); s += __shfl_xor(s, 4); s += __shfl_xor(s, 8); ssq[k] = rsqrtf(s * (1.0f / 128.0f) + EPS); }
    const float* gn = p.in[15];
#pragma unroll 1
    for (int nt = 0; nt < 8; ++nt) {
        const int dv = 16 * nt + fr; const float g = gn[dv];
        const u32x4 a0 = *(const u32x4*)(GO + (nt * 64 + lane) * 16), a1 = *(const u32x4*)(GO + (nt * 64 + lane) * 16 + 8);
        const bf16_t* gzp = PB + (size_t)(tok0 + 4 * fq) * PW + 2304 + h * 128 + dv; bf16_t* mp = PB + (size_t)(tok0 + 4 * fq) * PW + 512 + h * 128 + dv;
#pragma unroll
        for (int k = 0; k < 16; ++k) {
            const unsigned w = (k < 8) ? a0[(k >> 1) & 3] : a1[(k >> 1) & 3]; const float o = (k & 1) ? bfhi(w) : bflo(w);
            const int to = 16 * (k >> 2) + (k & 3);
            const float gz = bf2f(gzp[(size_t)to * PW]);
            mp[(size_t)to * PW] = f2bf(o * ssq[k] * g * silu(gz));
        }
    }
}

__device__ __forceinline__ void attn_unit(const Params& p, LAS unsigned char* lds, int unit) {
    const int tid = threadIdx.x, lane = tid & 63, wid = tid >> 6, fr = lane & 15, fq = lane >> 4;
    const int b = unit >> 7, blk = (unit >> 1) & 63, kvh = unit & 1;
    LAS bf16_t* Ks = (LAS bf16_t*)lds; LAS bf16_t* Vt = (LAS bf16_t*)(lds + 36864);
    bf16_t* PB = (bf16_t*)(p.ws + WS_H);
    __syncthreads();
#pragma unroll
    for (int i = 0; i < 4; ++i) {
        const int q = tid + 512 * i, row = q >> 3, ch = q & 7, tp = blk * 128 - 128 + row;
        u32x4 kv = (u32x4){0u, 0u, 0u, 0u}, vv = (u32x4){0u, 0u, 0u, 0u};
        if (tp >= 0) { const bf16_t* base = PB + (size_t)(b * SEQ + tp) * PW; kv = *(const u32x4*)(base + 512 + kvh * 64 + ch * 8); vv = *(const u32x4*)(base + 640 + kvh * 64 + ch * 8); }
        *(LAS u32x4*)(Ks + row * 72 + ch * 8) = kv;
#pragma unroll
        for (int e = 0; e < 4; ++e) { const unsigned w = vv[e]; Vt[(ch * 8 + 2 * e) * 264 + row] = (bf16_t)(w & 0xffffu); Vt[(ch * 8 + 2 * e + 1) * 264 + row] = (bf16_t)(w >> 16); }
    }
    __syncthreads();
    const int qtok = b * SEQ + blk * 128 + 16 * wid + fr;
#pragma unroll 1
    for (int g = 0; g < 4; ++g) {
        const int h = kvh * 4 + g; const float slope = exp2f(-(float)(h + 1)), sink = p.in[11][h];
        bf16x8 qf[2];
#pragma unroll
        for (int ks = 0; ks < 2; ++ks) qf[ks] = *(const bf16x8*)(PB + (size_t)qtok * PW + h * 64 + ks * 32 + 8 * fq);
        f32x4 s[10]; float mx = sink;
#pragma unroll
        for (int j = 0; j < 10; ++j) {
            const int ct = (wid + j) < 15 ? (wid + j) : 15;
            f32x4 acc = (f32x4){0.f, 0.f, 0.f, 0.f};
#pragma unroll
            for (int ks = 0; ks < 2; ++ks) acc = mfma16(*(const LAS bf16x8*)(Ks + (16 * ct + fr) * 72 + ks * 32 + 8 * fq), qf[ks], acc);
#pragma unroll
            for (int e = 0; e < 4; ++e) {
                const int c = 16 * (wid + j) + 4 * fq + e, dist = 16 * wid + fr - c + 128;
                const bool ok = (wid + j <= 15) && dist >= 0 && dist <= 128 && (blk * 128 + c - 128 >= 0);
                const float v = ok ? acc[e] * 0.125f - slope * (float)dist : -INFINITY;
                acc[e] = v; mx = fmaxf(mx, v);
            }
            s[j] = acc;
            asm volatile("" ::: "memory");
        }
        mx = fmaxf(mx, __shfl_xor(mx, 16)); mx = fmaxf(mx, __shfl_xor(mx, 32));
        float sum = 0.f;
#pragma unroll
        for (int j = 0; j < 10; ++j)
#pragma unroll
            for (int e = 0; e < 4; ++e) { const float pv = __expf(s[j][e] - mx); s[j][e] = pv; sum += pv; }
        sum += __shfl_xor(sum, 16); sum += __shfl_xor(sum, 32);
        sum += __expf(sink - mx);
        const float inv = 1.0f / sum;
        bf16x8 pb[5];
#pragma unroll
        for (int kk = 0; kk < 5; ++kk) { u32x4 w; w.x = cvt_pk(s[2 * kk][0] * inv, s[2 * kk][1] * inv); w.y = cvt_pk(s[2 * kk][2] * inv, s[2 * kk][3] * inv);
            w.z = cvt_pk(s[2 * kk + 1][0] * inv, s[2 * kk + 1][1] * inv); w.w = cvt_pk(s[2 * kk + 1][2] * inv, s[2 * kk + 1][3] * inv); pb[kk] = __builtin_bit_cast(bf16x8, w); }
#pragma unroll
        for (int dt = 0; dt < 4; ++dt) {
            f32x4 acc = (f32x4){0.f, 0.f, 0.f, 0.f};
#pragma unroll
            for (int kk = 0; kk < 5; ++kk) {
                const int c0 = (wid + 2 * kk) < 15 ? (wid + 2 * kk) : 15, c1 = (wid + 2 * kk + 1) < 15 ? (wid + 2 * kk + 1) : 15;
                const u32x2 lo = *(const LAS u32x2*)(Vt + (16 * dt + fr) * 264 + 16 * c0 + 4 * fq), hi = *(const LAS u32x2*)(Vt + (16 * dt + fr) * 264 + 16 * c1 + 4 * fq);
                const u32x4 a = (u32x4){lo.x, lo.y, hi.x, hi.y};
                acc = mfma16(__builtin_bit_cast(bf16x8, a), pb[kk], acc);
            }
            u32x2 w; w.x = cvt_pk(acc[0], acc[1]); w.y = cvt_pk(acc[2], acc[3]);
            *(u32x2*)(PB + (size_t)qtok * PW + h * 64 + 16 * dt + 4 * fq) = w;
            asm volatile("" ::: "memory");
        }
    }
}

__device__ __forceinline__ void sattn_unit(const Params& p, int s, int h, int lane) {
    const int kvh = h >> 2; const bool wr = (h & 3) == 0;
    bf16_t* PB = (bf16_t*)(p.ws + WS_H) + (size_t)(MPR + s) * PW;
    const float* ck = p.in[2] + (size_t)s * 128 * 128 + kvh * 64 + lane; const float* cv = p.in[3] + (size_t)s * 128 * 128 + kvh * 64 + lane;
    float* nk = p.out + O_KS + (size_t)s * 128 * 128 + kvh * 64 + lane; float* nv = p.out + O_VS + (size_t)s * 128 * 128 + kvh * 64 + lane;
    const float q = bf2f(PB[h * 64 + lane]) * 0.125f, slope = exp2f(-(float)(h + 1)), sink = p.in[11][h];
    const float knew = bf2f(PB[512 + kvh * 64 + lane]), vnew = bf2f(PB[640 + kvh * 64 + lane]);
    float sc[3];
#pragma unroll
    for (int t = 0; t < 2; ++t) {
#pragma unroll 8
        for (int jj = 0; jj < 64; ++jj) {
            const int j = t * 64 + jj; const float kval = ck[(size_t)j * 128];
            if (wr && j >= 1) nk[(size_t)(j - 1) * 128] = kval;
            const float d = wave_sum(q * kval) - slope * (float)(128 - j); if (lane == jj) sc[t] = d;
        }
    }
    if (wr) nk[(size_t)127 * 128] = knew;
    sc[2] = wave_sum(q * knew);
    const float mx = fmaxf(fmaxf(wave_max(fmaxf(sc[0], sc[1])), sc[2]), sink);
    const float p0 = __expf(sc[0] - mx), p1 = __expf(sc[1] - mx), p2 = __expf(sc[2] - mx);
    const float inv = 1.0f / (wave_sum(p0 + p1) + p2 + __expf(sink - mx));
    float o = p2 * vnew;
#pragma unroll 8
    for (int jj = 0; jj < 64; ++jj) { const float vval = cv[(size_t)jj * 128]; if (wr && jj >= 1) nv[(size_t)(jj - 1) * 128] = vval; o += __shfl(p0, jj) * vval; }
#pragma unroll 8
    for (int jj = 0; jj < 64; ++jj) { const float vval = cv[(size_t)(64 + jj) * 128]; if (wr) nv[(size_t)(63 + jj) * 128] = vval; o += __shfl(p1, jj) * vval; }
    if (wr) nv[(size_t)127 * 128] = vnew;
    asm volatile("" ::: "memory");
    PB[h * 64 + lane] = f2bf(o * inv);
}

__device__ __forceinline__ void sgdn_unit(const Params& p, LAS unsigned char* lds, int s) {
    const int tid = threadIdx.x, wid = tid >> 6, h = tid >> 7, dv = tid & 127;
    LAS float* qs = (LAS float*)lds; LAS float* ks = qs + 512; LAS float* red = ks + 512;
    bf16_t* PB = (bf16_t*)(p.ws + WS_H) + (size_t)(MPR + s) * PW; const float* GBA = (const float*)(p.ws + WS_GBA) + (size_t)(MPR + s) * 8;
    const float* cw = p.in[12]; const float* hc = p.in[4] + (size_t)s * 3 * CONVC; float* nc = p.out + O_CS + (size_t)s * 3 * CONVC;
    __syncthreads();
    float val[3];
#pragma unroll
    for (int i = 0; i < 3; ++i) {
        const int c = i * 512 + tid; const float x3 = bf2f(PB[768 + c]), h0 = hc[c], h1 = hc[CONVC + c], h2 = hc[2 * CONVC + c];
        val[i] = silu(cw[c] * h0 + cw[CONVC + c] * h1 + cw[2 * CONVC + c] * h2 + cw[3 * CONVC + c] * x3);
        nc[c] = h1; nc[CONVC + c] = h2; nc[2 * CONVC + c] = x3;
    }
    const float sq = wave_sum(val[0] * val[0]), sk = wave_sum(val[1] * val[1]);
    if ((tid & 63) == 0) { red[wid] = sq; red[8 + wid] = sk; }
    __syncthreads();
    const float ssq = red[2 * h] + red[2 * h + 1], ssk = red[8 + 2 * h] + red[8 + 2 * h + 1];
    qs[tid] = val[0] * rsqrtf(ssq + EPS) * 0.08838834764831845f; ks[tid] = val[1] * rsqrtf(ssk + EPS);
    __syncthreads();
    const float beta = 1.0f / (1.0f + __expf(-GBA[h]));
    const float x = GBA[4 + h] + p.in[14][h]; const float sp = x > 20.f ? x : log1pf(__expf(x));
    const float eg = __expf(-__expf(p.in[13][h]) * sp);
    const float* S0 = p.in[5] + ((size_t)(s * 4 + h) * 128) * 128 + dv; float* S1 = p.out + O_GS + ((size_t)(s * 4 + h) * 128) * 128 + dv;
    float kS = 0.f;
#pragma unroll 1
    for (int hf = 0; hf < 4; ++hf) { float sv[32];
#pragma unroll
        for (int dk = 0; dk < 32; ++dk) sv[dk] = S0[(size_t)(hf * 32 + dk) * 128];
#pragma unroll
        for (int dk = 0; dk < 32; ++dk) kS += ks[h * 128 + hf * 32 + dk] * sv[dk]; }
    const float delta = beta * (val[2] - eg * kS);
    float o = 0.f;
#pragma unroll 1
    for (int hf = 0; hf < 4; ++hf) { float sv[32];
#pragma unroll
        for (int dk = 0; dk < 32; ++dk) sv[dk] = S0[(size_t)(hf * 32 + dk) * 128];
#pragma unroll
        for (int dk = 0; dk < 32; ++dk) { const float nvv = eg * sv[dk] + ks[h * 128 + hf * 32 + dk] * delta; S1[(size_t)(hf * 32 + dk) * 128] = nvv; o += qs[h * 128 + hf * 32 + dk] * nvv; } }
    const float so = wave_sum(o * o);
    if ((tid & 63) == 0) red[16 + wid] = so;
    __syncthreads();
    const float tot = red[16 + 2 * h] + red[16 + 2 * h + 1];
    const float gz = bf2f(PB[2304 + tid]);
    PB[512 + tid] = f2bf(o * rsqrtf(tot * (1.0f / 128.0f) + EPS) * p.in[15][dv] * silu(gz));
}

#define XB_TMO      128
#define XB_XCNT(j)  (256  + 64 * (j))
#define XB_XSUB(j)  (1280 + 64 * (j))
#define XB_XGEN(j)  (2304 + 64 * (j))
#define XB_TOP      3328
#define XB_TOPGEN   3392
#define XCD_BAR_WORDS 3456
#define XB_SPIN_CAP (1u << 18)

__device__ __forceinline__ unsigned xb_ld(unsigned* p)              { return __hip_atomic_load(p, __ATOMIC_RELAXED, __HIP_MEMORY_SCOPE_AGENT); }
__device__ __forceinline__ unsigned xb_add(unsigned* p, unsigned v) { return __hip_atomic_fetch_add(p, v, __ATOMIC_RELAXED, __HIP_MEMORY_SCOPE_AGENT); }
__device__ __forceinline__ unsigned xb_xcc_id() { return (unsigned)__builtin_amdgcn_s_getreg((3 << 11) | 20) & 0xFu; }
#define XB_SPIN(cond, bar) do { unsigned _sp = 0; while (cond) { __builtin_amdgcn_s_sleep(1); \
    if ((++_sp & 255u) == 0u) { if (xb_ld(&(bar)[XB_TMO])) break; if (_sp > XB_SPIN_CAP) { atomicAdd(&(bar)[XB_TMO], 1u); break; } } } } while (0)

struct XcdBarrier {
    unsigned* bar; unsigned x;
    volatile LAS unsigned* st;
};

__device__ __forceinline__ XcdBarrier xcd_barrier_post(unsigned* bar, volatile LAS unsigned* st) {
    XcdBarrier b; b.bar = bar; b.x = xb_xcc_id(); b.st = st;
    if (threadIdx.x == 0) (void)xb_add(&bar[XB_XCNT(b.x)], 1u);
    return b;
}
__device__ __forceinline__ void xcd_barrier_complete(unsigned* bar, unsigned x, unsigned& nloc, unsigned& nx) {
    const unsigned G = gridDim.x * gridDim.y * gridDim.z;
    unsigned sum, cnt, mine, sp = 0u;
    for (;;) {
        sum = 0u; cnt = 0u; mine = 0u;
#pragma unroll
        for (unsigned j = 0; j < 16; ++j) { const unsigned c = xb_ld(&bar[XB_XCNT(j)]); sum += c; cnt += (c > 0u) ? 1u : 0u; mine = (j == x) ? c : mine; }
        if (sum == G) break;
        __builtin_amdgcn_s_sleep(1);
        if ((++sp & 255u) == 0u) { if (xb_ld(&bar[XB_TMO])) break; if (sp > XB_SPIN_CAP) { atomicAdd(&bar[XB_TMO], 1u); break; } }
    }
    nloc = mine > 0u ? mine : 1u; nx = cnt > 0u ? cnt : 1u;
}

__device__ __forceinline__ void xcd_barrier(const XcdBarrier& b) {
    asm volatile("s_waitcnt vmcnt(0)" ::: "memory");
    __syncthreads();
    if (threadIdx.x == 0) {
        unsigned* bar = b.bar;
        __builtin_amdgcn_s_waitcnt(0);
        unsigned nloc = b.st[0], nx = b.st[1];
        if (nloc == 0u) { xcd_barrier_complete(bar, b.x, nloc, nx); b.st[0] = nloc; b.st[1] = nx; }
        const unsigned old = xb_add(&bar[XB_XSUB(b.x)], 1u);
        const unsigned gen = old / nloc;
        if (old + 1u == (gen + 1u) * nloc) {
            __builtin_amdgcn_fence(__ATOMIC_RELEASE, "agent");
            asm volatile("s_waitcnt vmcnt(0)" ::: "memory");
            const unsigned og = xb_add(&bar[XB_TOP], 1u);
            const unsigned tg = og / nx;
            if (og + 1u == (tg + 1u) * nx) xb_add(&bar[XB_TOPGEN], 1u);
            else XB_SPIN(xb_ld(&bar[XB_TOPGEN]) == tg, bar);
            __builtin_amdgcn_fence(__ATOMIC_ACQUIRE, "agent");
            xb_add(&bar[XB_XGEN(b.x)], 1u);
            asm volatile("s_waitcnt vmcnt(0)" ::: "memory");
        } else {
            XB_SPIN(xb_ld(&bar[XB_XGEN(b.x)]) == gen, bar);
            __builtin_amdgcn_fence(__ATOMIC_ACQUIRE, "agent");
            asm volatile("s_waitcnt vmcnt(0)" ::: "memory");
        }
    }
    __syncthreads();
}

__global__ void __launch_bounds__(512, 2) fwd_kernel(Params p, int ph_lo, int ph_hi) {
    extern __shared__ __attribute__((aligned(16))) unsigned char lds_raw[];
    LAS unsigned char* lds = (LAS unsigned char*)lds_raw;
    cg::grid_group grid = cg::this_grid();
    if (ph_lo < 0) grid.sync();
    volatile LAS unsigned* bst = (volatile LAS unsigned*)(lds + LDS_PHASE_BYTES);
    if (threadIdx.x < 2) bst[threadIdx.x] = 0u;
    __syncthreads();
    XcdBarrier xbar; xbar.bar = (unsigned*)(p.ws + WS_CTL + CTL_BAR); xbar.x = 0; xbar.st = bst;
    if (ph_hi - ph_lo > 1) xbar = xcd_barrier_post((unsigned*)(p.ws + WS_CTL + CTL_BAR), bst);
    const int tid = threadIdx.x, lane = tid & 63, wid = tid >> 6, G = gridDim.x, bx = blockIdx.x;
    unsigned char* ws = p.ws;
    bf16_t* XN = (bf16_t*)(ws + WS_XN); bf16_t* XN2 = (bf16_t*)(ws + WS_XN2); bf16_t* HB = (bf16_t*)(ws + WS_H);
    float* SS1 = (float*)(ws + WS_SSP1); float* SS2 = (float*)(ws + WS_SSP2);
    float* Y = p.out; float* X2 = (float*)(ws + WS_GM); float* X3 = (float*)(ws + WS_XN);
#ifndef PHMASK
#define PHMASK 0x7ff
#endif
#define IN(k) (((PHMASK >> (k)) & 1) && ph_lo <= (k) && (k) < ph_hi)
#define SEAM(k) do { if (IN(k) && IN((k) + 1)) { xcd_barrier(xbar); }     } while (0)

    if (IN(0)) p0_prologue(p, lds, bx, G);
    SEAM(0);
    if (IN(1)) {
        if (bx < 176) sk_ffn_in<false>(XN, (const bf16_t*)(ws + WS_W1IN), HB, bx, wid, lane & 15, lane >> 4, lds);
        pg8::Gemm g{XN, (const bf16_t*)(ws + WS_W1IN), MPR, 2 * DFF, DM, DM}; pg8::StaticOrder S; S.init(MPR, 2 * DFF, G, bx);
        EpiSwiglu E{HB, nullptr}; pg8::gemm_phase<EpiSwiglu, pg8::StaticOrder, GEMM_ALIGN, GEMM_SP2>(lds, g, S, E);
    }
    SEAM(1);
    if (IN(2)) {
        if (bx < 64) sk_ffn_out<false>(HB, (const bf16_t*)(ws + WS_W1OUT), p.in[1], nullptr, XN + (size_t)MPR * DM, bx, wid, lane & 15, lane >> 4, lds);
        pg8::Gemm g{HB, (const bf16_t*)(ws + WS_W1OUT), MPR, DM, DFF, DFF}; pg8::StaticOrder S; S.init(MPR, DM, G, bx);
        EpiResid<false, false, true, true, true> E{p.in[0], p.in[1], nullptr, XN, SS1}; pg8::gemm_phase<EpiResid<false, false, true, true, true>, pg8::StaticOrder, GEMM_ALIGN, GEMM_SP2>(lds, g, S, E);
    }
    SEAM(2);
    if (IN(3)) {
        if (bx < 89) sk_inproj(XN, (const bf16_t*)(ws + WS_WINMIX), HB, (float*)(ws + WS_GBA), bx, wid, lane & 15, lane >> 4, lds);
        pg8::Gemm g{XN, (const bf16_t*)(ws + WS_WINMIX), MPR, NINP, DM, DM}; pg8::StaticOrder S; S.init(MPR, NINP, G, bx);
        EpiInproj E{HB, (float*)(ws + WS_GBA), SS1}; pg8::gemm_phase<EpiInproj, pg8::StaticOrder, GEMM_ALIGN, GEMM_SP2>(lds, g, S, E);
    }
    SEAM(3);
    if (IN(4)) {
        for (int u = bx; u < 2048; u += G) gdn_prep_unit(p, lds, u);
    }
    SEAM(4);
    if (IN(5)) {
        if (bx < NSCAN) gdn_scan(p, lds, bx);
        else {
            const int ab = bx - NSCAN, NAB = G - NSCAN;
            if (NAB == 192) {
                if (ab < 128) { sattn_unit(p, ab, wid, lane); sgdn_unit(p, lds, ab); attn_unit(p, lds, 2 * ab); attn_unit(p, lds, 2 * ab + 1); }
                else { for (int k = 0; k < 4; ++k) attn_unit(p, lds, 256 + (ab - 128) * 4 + k); }
            } else {
                int it = ab;
#pragma unroll 1
                for (; it < 512; it += NAB) attn_unit(p, lds, it);
#pragma unroll 1
                for (; it < 640; it += NAB) { sattn_unit(p, it - 512, wid, lane); sgdn_unit(p, lds, it - 512); }
            }
            const bf16_t* PB = HB;
            for (int idx = ab * 512 + tid; idx < 149504; idx += NAB * 512) {
                if (idx < 131072) { const int w = idx >> 16, r = idx & 65535, b = r >> 14, j = (r >> 7) & 127, c = r & 127;
                    p.out[(w ? O_VP : O_KP) + r] = bf2f(PB[(size_t)(b * SEQ + SEQ - 128 + j) * PW + 512 + w * 128 + c]);
                } else { const int r = idx - 131072, b = r / (3 * CONVC), q = r % (3 * CONVC), rr = q / CONVC, c = q % CONVC;
                    p.out[O_CP + r] = bf2f(PB[(size_t)(b * SEQ + SEQ - 3 + rr) * PW + 768 + c]); }
            }
        }
    }
    SEAM(5);
    if (IN(6)) {
        for (int u = bx * 8 + wid; u < 2048; u += G * 8) gdn_gate_unit(p, u, lane);
    }
    SEAM(6);
#ifdef DBG_DUMP
    if (ph_lo == 11) {
        const float* src = (const float*)(ws + DBG_SRC);
        for (size_t i = (size_t)bx * 512 + tid; i < (size_t)MREAL * DM; i += (size_t)G * 512) Y[i] = (i < (size_t)MREAL * 8) ? ((const float*)(ws + WS_GBA))[i] : 0.f;
    }
#endif
    if (IN(7)) {
        if (bx < 32) sk_outproj(HB, (const bf16_t*)(ws + WS_WOUTMIX), XN, X2, XN2, bx, wid, lane & 15, lane >> 4, lds);
        pg8::Gemm g{HB, (const bf16_t*)(ws + WS_WOUTMIX), MPR, DM, DM, PW}; pg8::StaticOrder S; S.init(MPR, DM, G, bx);
        EpiResid<true, true, true, true, false> E{XN, XN + (size_t)MPR * DM, X2, XN2, SS2}; pg8::gemm_phase<EpiResid<true, true, true, true, false>, pg8::StaticOrder, GEMM_ALIGN, GEMM_SP2>(lds, g, S, E);
    }
    SEAM(7);
    if (IN(8)) {
        if (bx < 176) sk_ffn_in<true>(XN2, (const bf16_t*)(ws + WS_W2IN), HB, bx, wid, lane & 15, lane >> 4, lds);
        pg8::Gemm g{XN2, (const bf16_t*)(ws + WS_W2IN), MPR, 2 * DFF, DM, DM}; pg8::StaticOrder S; S.init(MPR, 2 * DFF, G, bx);
        EpiSwiglu E{HB, SS2}; pg8::gemm_phase<EpiSwiglu, pg8::StaticOrder, GEMM_ALIGN, GEMM_SP2>(lds, g, S, E);
    }
    SEAM(8);
    if (IN(9)) {
        if (bx < 64) sk_ffn_out<true>(HB, (const bf16_t*)(ws + WS_W2OUT), X2 + (size_t)MPR * DM, X3 + (size_t)MPR * DM, nullptr, bx, wid, lane & 15, lane >> 4, lds);
        pg8::Gemm g{HB, (const bf16_t*)(ws + WS_W2OUT), MPR, DM, DFF, DFF}; pg8::StaticOrder S; S.init(MPR, DM, G, bx);
        EpiResid<false, true, false, false, true> E{X2, X2 + (size_t)MPR * DM, X3, nullptr, nullptr}; pg8::gemm_phase<EpiResid<false, true, false, false, true>, pg8::StaticOrder, GEMM_ALIGN, GEMM_SP2>(lds, g, S, E);
    }
    SEAM(9);
    if (IN(10)) {
        const float* gf = p.in[20]; f32x4 gv[4];
#pragma unroll
        for (int j = 0; j < 4; ++j) gv[j] = *((const f32x4*)gf + lane + 64 * j);
        {
            f32x4 v[4], vn[4]; int m = bx * 8 + wid;
            if (m < MREAL) { const f32x4* xr = (const f32x4*)(X3 + (size_t)m * DM) + lane;
#pragma unroll
                for (int j = 0; j < 4; ++j) v[j] = xr[64 * j]; }
            for (; m < MREAL; m += G * 8) {
                const int mn = m + G * 8;
                if (mn < MREAL) { const f32x4* xr = (const f32x4*)(X3 + (size_t)mn * DM) + lane;
#pragma unroll
                    for (int j = 0; j < 4; ++j) vn[j] = xr[64 * j]; }
                float s = 0.f;
#pragma unroll
                for (int j = 0; j < 4; ++j) s += (v[j][0] * v[j][0] + v[j][1] * v[j][1]) + (v[j][2] * v[j][2] + v[j][3] * v[j][3]);
                const float rstd = rsqrtf(wave_sum(s) * (1.0f / DM) + EPS);
                f32x4* yr = (f32x4*)(Y + (size_t)m * DM) + lane;
#pragma unroll
                for (int j = 0; j < 4; ++j) yr[64 * j] = v[j] * rstd * gv[j];
#pragma unroll
                for (int j = 0; j < 4; ++j) v[j] = vn[j];
            }
        }
    }
#undef IN
#undef SEAM
}
}

#ifndef MK_N_LAUNCHES
#define MK_N_LAUNCHES 1
#endif
extern "C" void kernel_launch(void* const* d_in, const int* in_sizes, int n_in, void* d_out, int out_size, void* d_ws, size_t ws_size, hipStream_t stream) {
    static int grid = 0;
    if (grid == 0) {
        if (n_in != 21 || ws_size < mk::WS_END || out_size != 47269888) { fprintf(stderr, "kernel_launch: unexpected shapes (n_in %d, ws %zu, out %d)\n", n_in, ws_size, out_size); grid = -1; return; }
        int dev = 0, cus = 0, per_cu = 0;
        (void)hipGetDevice(&dev); (void)hipDeviceGetAttribute(&cus, hipDeviceAttributeMultiprocessorCount, dev);
        if (hipFuncSetAttribute((const void*)mk::fwd_kernel, hipFuncAttributeMaxDynamicSharedMemorySize, mk::LDS_BYTES) != hipSuccess) { fprintf(stderr, "kernel_launch: hipFuncSetAttribute failed\n"); grid = -1; return; }
        if (hipOccupancyMaxActiveBlocksPerMultiprocessor(&per_cu, (const void*)mk::fwd_kernel, 512, mk::LDS_BYTES) != hipSuccess || per_cu < 1) { fprintf(stderr, "kernel_launch: occupancy query failed (%d)\n", per_cu); per_cu = 1; }
        (void)hipGetLastError();
        grid = cus * per_cu;
        if (grid <= mk::NSCAN) { fprintf(stderr, "kernel_launch: grid %d too small\n", grid); grid = -1; return; }
    }
    if (grid < 0) return;
    (void)hipMemsetAsync((char*)d_ws + mk::WS_CTL + mk::CTL_BAR, 0, mk::CTL_BAR_BYTES, stream);
    mk::Params p{};
    for (int i = 0; i < 21; ++i) p.in[i] = (const float*)d_in[i];
    p.out = (float*)d_out; p.ws = (unsigned char*)d_ws;
#if MK_N_LAUNCHES == 1
    int lo = 0, hi = 11; void* args[] = {&p, &lo, &hi};
    hipError_t e = hipLaunchCooperativeKernel((const void*)mk::fwd_kernel, dim3(grid), dim3(512), args, mk::LDS_BYTES, stream);
    if (e != hipSuccess) fprintf(stderr, "kernel_launch: cooperative launch failed: %s (grid %d)\n", hipGetErrorString(e), grid);
#else
#ifndef MK_LAST
#define MK_LAST 11
#ifndef MK_DOUBLE
#define MK_DOUBLE 0x0
#endif
#define DBG_C0 512
#define DBG_C1 1024
#endif
    for (int ph = 0; ph < MK_LAST; ++ph) { const int reps = ((MK_DOUBLE >> ph) & 1) ? 2 : 1; for (int r = 0; r < reps; ++r) hipLaunchKernelGGL(mk::fwd_kernel, dim3(grid), dim3(512), mk::LDS_BYTES, stream, p, ph, ph + 1); }
#ifdef DBG_DUMP
    hipLaunchKernelGGL(mk::fwd_kernel, dim3(grid), dim3(512), mk::LDS_BYTES, stream, p, 11, 12);
#endif
#endif
}
```

```cpp
#include <hip/hip_runtime.h>
#include <hip/hip_cooperative_groups.h>
#include <cstdio>
namespace cg = cooperative_groups;
namespace pg8 {
#define PG8_LAS __attribute__((address_space(3)))
typedef unsigned short bf16_t;
typedef short bf16x8 __attribute__((ext_vector_type(8)));
typedef float f32x4 __attribute__((ext_vector_type(4)));
typedef unsigned u32x4 __attribute__((ext_vector_type(4)));
constexpr int BM = 256, BK = 64, HALF = 128, HTB = HALF * BK * 2  , STAGE_BYTES = 8 * HTB, NXCD = 8, WGM = 4;

__host__ __device__ __forceinline__ int lds_byte(int r, int c) { const int st = (r >> 4) * 2 + (c >> 5), rr = r & 15, cc = c & 31, ob = rr * 64 + cc * 2; return st * 1024 + (ob ^ (((ob >> 9) & 1) << 5)); }
__host__ __device__ __forceinline__ void stage_rc(int b, int& R, int& C) { const int st = b / 1024, sb = b % 1024, swz = sb ^ (((sb >> 9) & 1) << 5); R = (st >> 1) * 16 + swz / 64; C = (st & 1) * 32 + (swz % 64) / 2; }
__host__ __device__ __forceinline__ int perm32(int rho) { const int n = rho >> 4, i = rho & 15; return 8 * (i >> 2) + 4 * n + (i & 3); }

struct Unit { int pm, pn; };
struct Gemm { const bf16_t* A; const bf16_t* Bt; int M, N, K, lda; };

struct StaticOrder {
    int nM, nN, nwg, G, c, wgm;
    __host__ __device__ void init(int M, int N, int G_, int c_, int wgm_ = WGM) { nM = M / BM; nN = N / BM; nwg = nM * nN; G = G_; c = c_; wgm = wgm_; }
    __host__ __device__ bool next(int i, Unit& u) const {
        const long L = (long)i * G + c; if (L >= nwg) return false;
        int wgid = (int)L; { const int q = nwg / NXCD, r = nwg % NXCD, xcd = wgid % NXCD, off = wgid / NXCD; wgid = (xcd < r ? xcd * (q + 1) : r * (q + 1) + (xcd - r) * q) + off; }
        const int nig = wgm * nN, gid = wgid / nig, fm = gid * wgm, gsz = (nM - fm) < wgm ? (nM - fm) : wgm;
        u.pm = fm + ((wgid % nig) % gsz); u.pn = (wgid % nig) / gsz; return true;
    }
    __device__ __forceinline__ void a_ready(const Unit&) const {}
    __device__ __forceinline__ void done(const Unit&) const {}
};

__device__ __forceinline__ unsigned cvt_pk_bf16(float lo, float hi) { unsigned r; asm volatile("v_cvt_pk_bf16_f32 %0, %1, %2" : "=v"(r) : "v"(lo), "v"(hi)); return r; }
typedef float f32x2 __attribute__((ext_vector_type(2)));
__device__ __forceinline__ f32x2 gelu_pk(f32x2 v) {
    const f32x2 av = __builtin_elementwise_abs(v), d = av * 0.2316418882f + 1.0f;
    f32x2 t; t.x = __builtin_amdgcn_rcpf(d.x); t.y = __builtin_amdgcn_rcpf(d.y);
    f32x2 q = t * 0.5307027145f + (-0.7265760135f); q = q * t + 0.7107068705f; q = q * t + (-0.142248368f); q = q * t + 0.127414796f; q = q * t;
    const f32x2 s = (v * v) * (-0.72134752044f);
    f32x2 e; e.x = __builtin_amdgcn_exp2f(s.x); e.y = __builtin_amdgcn_exp2f(s.y);
    const f32x2 m = v * (q * e), r = v - m;
    f32x2 o; o.x = v.x < 0.f ? m.x : r.x; o.y = v.y < 0.f ? m.y : r.y; return o;
}

template <int ACT  > struct EpiBf16 {
    static constexpr bool PERM = true, AFTER_DRAIN = false; static_assert(ACT == 0 || ACT == 1, "EpiBf16: ACT is 0 (none) or 1 (gelu_pk)");
    bf16_t* O; int ldc; const float* bias; int split_cols; size_t split_stride; float scale0;
    __device__ __forceinline__ void operator()(const f32x4 (&acc)[2][2][4][2], const Unit& u, int wr, int wc, int fr, int fq) const {
        const int row0 = u.pm * BM + wr * 64 + fr; int colt = u.pn * BM; bf16_t* base = O;
        float sc = 1.f; if (split_cols) { const int t = colt / split_cols; base += (size_t)t * split_stride; colt -= t * split_cols; if (t == 0) sc = scale0; }
        const int col0 = colt + wc * 32 + 8 * fq, bcol0 = u.pn * BM + wc * 32 + 8 * fq;
        f32x4 bv[2][2];
#pragma unroll
        for (int bj = 0; bj < 2; ++bj)
#pragma unroll
            for (int n = 0; n < 2; ++n) bv[bj][n] = bias ? *(const f32x4*)(bias + bcol0 + bj * HALF + 4 * n) : (f32x4){0.f, 0.f, 0.f, 0.f};
#pragma unroll
        for (int ai = 0; ai < 2; ++ai)
#pragma unroll
            for (int m = 0; m < 4; ++m) { bf16_t* rowp = base + (size_t)(row0 + ai * HALF + m * 16) * ldc + col0;
#pragma unroll
                for (int bj = 0; bj < 2; ++bj) { f32x4 v0 = acc[ai][bj][m][0] + bv[bj][0], v1 = acc[ai][bj][m][1] + bv[bj][1];
                    if (ACT == 1) { f32x2 a = gelu_pk((f32x2){v0[0], v0[1]}), b = gelu_pk((f32x2){v0[2], v0[3]}), c = gelu_pk((f32x2){v1[0], v1[1]}), d = gelu_pk((f32x2){v1[2], v1[3]});
                        v0 = (f32x4){a.x, a.y, b.x, b.y}; v1 = (f32x4){c.x, c.y, d.x, d.y}; }
                    v0 = v0 * sc; v1 = v1 * sc; u32x4 w; w.x = cvt_pk_bf16(v0[0], v0[1]); w.y = cvt_pk_bf16(v0[2], v0[3]); w.z = cvt_pk_bf16(v1[0], v1[1]); w.w = cvt_pk_bf16(v1[2], v1[3]);
                    *(u32x4*)(rowp + bj * HALF) = w; } }
    }
};

struct PanelStats {
    unsigned* xbuf;
    unsigned* cnt;
    unsigned* tmo;
    int ntn; float eps;
    unsigned code;
    __device__ __forceinline__ bool run(const f32x4 (&v)[2][2][4][2], const Unit& u, int wr, int wc, int fr, int fq, PG8_LAS unsigned char* lds, int wid, int lane) const {
        typedef float f32x2v __attribute__((ext_vector_type(2)));
        PG8_LAS f32x2v* P = (PG8_LAS f32x2v*)lds;
        PG8_LAS f32x2v* S = (PG8_LAS f32x2v*)(lds + 8192);
        PG8_LAS unsigned* flag = (PG8_LAS unsigned*)(lds + 8192 + 2048);
#pragma unroll
        for (int ai = 0; ai < 2; ++ai)
#pragma unroll
            for (int m = 0; m < 4; ++m) {
                float s = 0.f;
#pragma unroll
                for (int bj = 0; bj < 2; ++bj)
#pragma unroll
                    for (int n = 0; n < 2; ++n) { const f32x4 x = v[ai][bj][m][n]; s += (x[0] + x[1]) + (x[2] + x[3]); }
                s += __shfl_xor(s, 16); s += __shfl_xor(s, 32);
                const float mw = s * (1.0f / 64.0f); float q = 0.f;
#pragma unroll
                for (int bj = 0; bj < 2; ++bj)
#pragma unroll
                    for (int n = 0; n < 2; ++n) { const f32x4 d = v[ai][bj][m][n] - mw; q += (d[0] * d[0] + d[1] * d[1]) + (d[2] * d[2] + d[3] * d[3]); }
                q += __shfl_xor(q, 16); q += __shfl_xor(q, 32);
                if (fq == 0) P[(ai * HALF + wr * 64 + m * 16 + fr) * 4 + wc] = (f32x2v){mw, q};
            }
        asm volatile("s_waitcnt lgkmcnt(0)" ::: "memory"); __builtin_amdgcn_s_barrier(); asm volatile("" ::: "memory");
#if defined(BROKEN_EXCHANGE_NO_WAIT)
#warning BROKEN CONTROL BUILD: the row-statistics exchange does not wait; results are wrong by design
        if (blockIdx.x >= 64) { const long long t0_ = clock64(); while (clock64() - t0_ < 60000) __builtin_amdgcn_s_sleep(8); }
#endif
        const int row = wid * 32 + (lane & 31);
        if (lane < 32) {
            const f32x2v a = P[row * 4 + 0], b = P[row * 4 + 1], c = P[row * 4 + 2], d = P[row * 4 + 3];
            const float mt = (a.x + b.x + c.x + d.x) * 0.25f;
            const float da = a.x - mt, db = b.x - mt, dc = c.x - mt, dd = d.x - mt;
            const float m2 = (a.y + b.y) + (c.y + d.y) + 64.0f * ((da * da + db * db) + (dc * dc + dd * dd));
            unsigned long long* slot = (unsigned long long*)xbuf + ((size_t)(u.pm * BM + row) * 4 + u.pn);
            __hip_atomic_store(slot, ((unsigned long long)__float_as_uint(m2) << 32) | __float_as_uint(mt), __ATOMIC_RELAXED, __HIP_MEMORY_SCOPE_AGENT);
        }
        asm volatile("s_waitcnt vmcnt(0)" ::: "memory");
        if (lane == 0) __hip_atomic_fetch_add(cnt + 64 * u.pm, 1u, __ATOMIC_RELAXED, __HIP_MEMORY_SCOPE_AGENT);
        if (wid == 0) {
            bool dead = false; const unsigned long long t0 = __builtin_amdgcn_s_memrealtime(); const unsigned want = 8u * (unsigned)ntn;
            for (;;) {
#if defined(BROKEN_EXCHANGE_NO_WAIT)
                break;
#endif
                if ((unsigned)__builtin_amdgcn_readfirstlane(__hip_atomic_load(cnt + 64 * u.pm, __ATOMIC_RELAXED, __HIP_MEMORY_SCOPE_AGENT)) >= want) break;
                if (__builtin_amdgcn_s_memrealtime() - t0 > 2000000ull) {
                    if (lane == 0) { unsigned expect = 0u; __hip_atomic_compare_exchange_strong(tmo + 1, &expect, code | (unsigned)(u.pm & 0xff), __ATOMIC_RELAXED, __ATOMIC_RELAXED, __HIP_MEMORY_SCOPE_AGENT);
                                     __hip_atomic_store(tmo, 1u, __ATOMIC_RELAXED, __HIP_MEMORY_SCOPE_AGENT); }
                    dead = true; break; }
                __builtin_amdgcn_s_sleep(2);
            }
            __builtin_amdgcn_fence(__ATOMIC_ACQUIRE, "agent");
            if (lane == 0) flag[0] = dead ? 1u : 0u;
        }
        asm volatile("s_waitcnt vmcnt(0) lgkmcnt(0)" ::: "memory"); __builtin_amdgcn_s_barrier(); asm volatile("" ::: "memory");
        const bool bad = flag[0] != 0u;
        if (lane < 32) {
            const unsigned long long* slot = (const unsigned long long*)xbuf + (size_t)(u.pm * BM + row) * 4; float mt[4], m2[4]; float ms = 0.f;
#pragma unroll
            for (int t = 0; t < 4; ++t) { if (t < ntn) { const unsigned long long w = __hip_atomic_load(slot + t, __ATOMIC_RELAXED, __HIP_MEMORY_SCOPE_AGENT); mt[t] = __uint_as_float((unsigned)w); m2[t] = __uint_as_float((unsigned)(w >> 32)); } else { mt[t] = 0.f; m2[t] = 0.f; } ms += mt[t]; }
            const float mean = ms / (float)ntn; float q = 0.f;
#pragma unroll
            for (int t = 0; t < 4; ++t) if (t < ntn) { const float dm = mt[t] - mean; q += m2[t] + 256.0f * dm * dm; }
            S[row] = (f32x2v){mean, 1.0f / sqrtf(q / (256.0f * (float)ntn) + eps)};
        }
        asm volatile("s_waitcnt lgkmcnt(0)" ::: "memory"); __builtin_amdgcn_s_barrier(); asm volatile("" ::: "memory");
        return bad;
    }
};
struct EpiLnRes {
    static constexpr bool PERM = false, AFTER_DRAIN = true;
    const float* base; float* out; int ldc; const float* bias; PanelStats st; unsigned poison;
    __device__ __forceinline__ void fused(f32x4 (&acc)[2][2][4][2], const Unit& u, int wr, int wc, int fr, int fq, PG8_LAS unsigned char* lds, int wid, int lane) const {
        typedef float f32x2v __attribute__((ext_vector_type(2)));
        const PG8_LAS f32x2v* S = (const PG8_LAS f32x2v*)(lds + 8192);
        const int col0 = u.pn * BM + wc * 32 + 4 * fq;
#pragma unroll
        for (int bj = 0; bj < 2; ++bj)
#pragma unroll
            for (int n = 0; n < 2; ++n) { const f32x4 bv = bias ? *(const f32x4*)(bias + col0 + bj * HALF + n * 16) : (f32x4){0.f, 0.f, 0.f, 0.f};
#pragma unroll
                for (int ai = 0; ai < 2; ++ai)
#pragma unroll
                    for (int m = 0; m < 4; ++m) acc[ai][bj][m][n] += bv; }
        f32x4 pre[4][2][2];
#pragma unroll
        for (int m = 0; m < 4; ++m) { const size_t off = (size_t)(u.pm * BM + wr * 64 + m * 16 + fr) * ldc + col0;
#pragma unroll
            for (int bj = 0; bj < 2; ++bj)
#pragma unroll
                for (int n = 0; n < 2; ++n) pre[m][bj][n] = *(const f32x4*)(base + off + bj * HALF + n * 16); }
        const bool bad = st.run(acc, u, wr, wc, fr, fq, lds, wid, lane) || poison != 0u;
        const float qnan = __builtin_nanf("");
#pragma unroll
        for (int ai = 0; ai < 2; ++ai)
#pragma unroll
            for (int m = 0; m < 4; ++m) { const int r = ai * HALF + wr * 64 + m * 16 + fr; const f32x2v sr = S[r]; const size_t off = (size_t)(u.pm * BM + r) * ldc + col0;
#pragma unroll
                for (int bj = 0; bj < 2; ++bj)
#pragma unroll
                    for (int n = 0; n < 2; ++n) { const f32x4 bs = ai == 0 ? pre[m][bj][n] : *(const f32x4*)(base + off + bj * HALF + n * 16); f32x4 o = bs + (acc[ai][bj][m][n] - sr.x) * sr.y;
                        if (bad) o = (f32x4){qnan, qnan, qnan, qnan}; *(f32x4*)(out + off + bj * HALF + n * 16) = o; }
                if (m & 1) asm volatile("" ::: "memory"); }
    }
};
struct EpiLnResLn {
    static constexpr bool PERM = false, AFTER_DRAIN = true;
    const float* base; float* out; bf16_t* xn; int ldc; const float* bias; PanelStats st1, st2; unsigned poison;
    __device__ __forceinline__ void fused(f32x4 (&acc)[2][2][4][2], const Unit& u, int wr, int wc, int fr, int fq, PG8_LAS unsigned char* lds, int wid, int lane) const {
        typedef float f32x2v __attribute__((ext_vector_type(2))); typedef unsigned u32x2v __attribute__((ext_vector_type(2)));
        const PG8_LAS f32x2v* S = (const PG8_LAS f32x2v*)(lds + 8192);
        const int col0 = u.pn * BM + wc * 32 + 4 * fq;
#pragma unroll
        for (int bj = 0; bj < 2; ++bj)
#pragma unroll
            for (int n = 0; n < 2; ++n) { const f32x4 bv = bias ? *(const f32x4*)(bias + col0 + bj * HALF + n * 16) : (f32x4){0.f, 0.f, 0.f, 0.f};
#pragma unroll
                for (int ai = 0; ai < 2; ++ai)
#pragma unroll
                    for (int m = 0; m < 4; ++m) acc[ai][bj][m][n] += bv; }
        bool bad = st1.run(acc, u, wr, wc, fr, fq, lds, wid, lane) || poison != 0u;
        const float qnan = __builtin_nanf("");
#pragma unroll
        for (int ai = 0; ai < 2; ++ai)
#pragma unroll
            for (int m = 0; m < 4; ++m) { const int r = ai * HALF + wr * 64 + m * 16 + fr; const f32x2v sr = S[r]; const size_t off = (size_t)(u.pm * BM + r) * ldc + col0;
#pragma unroll
                for (int bj = 0; bj < 2; ++bj)
#pragma unroll
                    for (int n = 0; n < 2; ++n) { const f32x4 bs = *(const f32x4*)(base + off + bj * HALF + n * 16); acc[ai][bj][m][n] = bs + (acc[ai][bj][m][n] - sr.x) * sr.y; }
                asm volatile("" : "+v"(acc[ai][0][m][0]), "+v"(acc[ai][0][m][1]), "+v"(acc[ai][1][m][0]), "+v"(acc[ai][1][m][1]));
                if (m & 1) asm volatile("" ::: "memory"); }
        const bool bad1 = bad;
        bad = st2.run(acc, u, wr, wc, fr, fq, lds, wid, lane) || bad;
#pragma unroll
        for (int ai = 0; ai < 2; ++ai)
#pragma unroll
            for (int m = 0; m < 4; ++m) { const int r = ai * HALF + wr * 64 + m * 16 + fr; const f32x2v sr = S[r]; const size_t off = (size_t)(u.pm * BM + r) * ldc + col0;
#pragma unroll
                for (int bj = 0; bj < 2; ++bj)
#pragma unroll
                    for (int n = 0; n < 2; ++n) { const f32x4 x1 = acc[ai][bj][m][n]; *(f32x4*)(out + off + bj * HALF + n * 16) = bad1 ? (f32x4){qnan, qnan, qnan, qnan} : x1;
                        const f32x4 o = (x1 - sr.x) * sr.y; u32x2v w; w.x = cvt_pk_bf16(o[0], o[1]); w.y = cvt_pk_bf16(o[2], o[3]);
                        if (bad) { w.x = 0x7fc07fc0u; w.y = 0x7fc07fc0u; } *(u32x2v*)(xn + off + bj * HALF + n * 16) = w; }
                asm volatile("" ::: "memory"); }
    }
};

template <class Epi, class Sched, bool ALIGN_EPI = false, bool SP2 = false>
__device__ __forceinline__ void gemm_phase(PG8_LAS unsigned char* lds, const Gemm g, const Sched S, const Epi E) {
    const int tid = threadIdx.x, wid = __builtin_amdgcn_readfirstlane(tid >> 6), lane = tid & 63, wr = wid >> 2, wc = wid & 3, fr = lane & 15, fq = lane >> 4;
    const int K = g.K, nt = K / BK;
    unsigned voffA[2], voffB[2];
#pragma unroll
    for (int i = 0; i < 2; ++i) { int R, C; stage_rc(tid * 16 + i * 8192, R, C); const int Rb = Epi::PERM ? ((R & ~31) + perm32(R & 31)) : R;
        voffA[i] = (unsigned)(R * g.lda + C) * 2u; voffB[i] = (unsigned)(Rb * K + C) * 2u; }
    const size_t kstep = (size_t)(BK * 2);
    const size_t hstep = (size_t)HALF * K * 2;
    const size_t tstep = 2 * hstep;
    const size_t hstepA = (size_t)HALF * g.lda * 2, tstepA = 2 * hstepA;
    const unsigned ldsw = (unsigned)wid * 1024u;
    const int aoff = lds_byte(wr * 64 + fr, fq * 8), boff = lds_byte(wc * 32 + fr, fq * 8);
#define PG8_SA(b, h) (((b) * 2 + (h)) * HTB)
#define PG8_SB(b, h) ((4 + (b) * 2 + (h)) * HTB)
#define PG8_STAGE(bufoff, gbase, voff) do { _Pragma("unroll") for (int _i = 0; _i < 2; ++_i) \
        __builtin_amdgcn_global_load_lds((const unsigned*)((const char*)(gbase) + (voff)[_i]), (PG8_LAS unsigned*)(lds + (bufoff) + ldsw + _i * 8192), 16, 0, 0); } while (0)
#define PG8_LDA(dst, b, h) do { _Pragma("unroll") for (int m = 0; m < 4; ++m) _Pragma("unroll") for (int k = 0; k < 2; ++k) dst[m][k] = *(const PG8_LAS bf16x8*)(lds + PG8_SA(b, h) + aoff + m * 2048 + k * 1024); } while (0)
#define PG8_LDB(dst, b, h) do { _Pragma("unroll") for (int n = 0; n < 2; ++n) _Pragma("unroll") for (int k = 0; k < 2; ++k) dst[n][k] = *(const PG8_LAS bf16x8*)(lds + PG8_SB(b, h) + boff + n * 2048 + k * 1024); } while (0)
#define PG8_MMA(ai, bj, At, Bt) do { __builtin_amdgcn_s_setprio(1); _Pragma("unroll") for (int m = 0; m < 4; ++m) _Pragma("unroll") for (int n = 0; n < 2; ++n) _Pragma("unroll") for (int k = 0; k < 2; ++k) \
        acc[ai][bj][m][n] = __builtin_amdgcn_mfma_f32_16x16x32_bf16(Bt[n][k], At[m][k], acc[ai][bj][m][n], 0, 0, 0); __builtin_amdgcn_s_setprio(0); } while (0)
#define PG8_WAIT_V(n) asm volatile("s_waitcnt vmcnt(" #n ")" ::: "memory")
#define PG8_WAIT_L(n) asm volatile("s_waitcnt lgkmcnt(" #n ")" ::: "memory")
#define PG8_BAR __builtin_amdgcn_s_barrier()
#define PG8_SCHED __builtin_amdgcn_sched_barrier(0)
    Unit cur, nxt; int ui = 0;
    if (!S.next(0, cur)) return;
    f32x4 acc[2][2][4][2];
#pragma unroll
    for (int a = 0; a < 2; ++a)
#pragma unroll
        for (int b = 0; b < 2; ++b)
#pragma unroll
            for (int m = 0; m < 4; ++m)
#pragma unroll
                for (int n = 0; n < 2; ++n) acc[a][b][m][n] = (f32x4){0.f, 0.f, 0.f, 0.f};
    bf16x8 At[4][2], B0[2][2], B1[2][2];
    const char* cA = (const char*)g.A + (size_t)cur.pm * tstepA; const char* cB = (const char*)g.Bt + (size_t)cur.pn * tstep;
    S.a_ready(cur);
    if constexpr (SP2) {
        PG8_STAGE(PG8_SB(0, 0), cB, voffB); PG8_STAGE(PG8_SB(0, 1), cB + hstep, voffB); PG8_STAGE(PG8_SA(0, 0), cA, voffA); PG8_STAGE(PG8_SA(0, 1), cA + hstepA, voffA);
        if (wr == 1) PG8_BAR;
        PG8_WAIT_V(2); PG8_BAR;
        PG8_STAGE(PG8_SB(1, 0), cB + kstep, voffB); PG8_STAGE(PG8_SA(1, 0), cA + kstep, voffA); PG8_STAGE(PG8_SB(1, 1), cB + hstep + kstep, voffB);
        PG8_WAIT_V(6); PG8_BAR;
    } else {
        PG8_STAGE(PG8_SB(0, 0), cB, voffB); PG8_STAGE(PG8_SA(0, 0), cA, voffA); PG8_STAGE(PG8_SB(0, 1), cB + hstep, voffB); PG8_STAGE(PG8_SA(0, 1), cA + hstepA, voffA);
        if (wr == 1) PG8_BAR;
        PG8_WAIT_V(4); PG8_BAR;
        PG8_STAGE(PG8_SB(1, 0), cB + kstep, voffB); PG8_STAGE(PG8_SA(1, 0), cA + kstep, voffA); PG8_STAGE(PG8_SB(1, 1), cB + hstep + kstep, voffB);
        PG8_WAIT_V(6); PG8_BAR;
    }
    for (;;) {
        const bool has_next = S.next(ui + 1, nxt);
        const char* nA = has_next ? (const char*)g.A + (size_t)nxt.pm * tstepA : cA; const char* nB = has_next ? (const char*)g.Bt + (size_t)nxt.pn * tstep : cB;
        for (int t = 0; t < nt; t += 2) {
            const bool last = (t == nt - 2);
            const char* a1 = cA + (size_t)(t + 1) * kstep;
            const char* a2 = last ? nA : cA + (size_t)(t + 2) * kstep; const char* b2 = last ? nB : cB + (size_t)(t + 2) * kstep;
            const char* a3 = a2 + kstep; const char* b3 = b2 + kstep;
            if (last && has_next) S.a_ready(nxt);
            if constexpr (SP2) {
            PG8_LDB(B0, 0, 0); PG8_LDB(B1, 0, 1); PG8_SCHED; PG8_LDA(At, 0, 0); PG8_STAGE(PG8_SA(1, 1), a1 + hstepA, voffA);
            PG8_WAIT_V(8); PG8_WAIT_L(0); PG8_BAR; PG8_MMA(0, 0, At, B0); PG8_MMA(0, 1, At, B1); PG8_BAR; PG8_SCHED;
            PG8_LDA(At, 0, 1); PG8_STAGE(PG8_SB(0, 0), b2, voffB); PG8_STAGE(PG8_SB(0, 1), b2 + hstep, voffB); PG8_STAGE(PG8_SA(0, 0), a2, voffA);
            PG8_WAIT_V(8); PG8_WAIT_L(0); PG8_BAR; PG8_MMA(1, 0, At, B0); PG8_MMA(1, 1, At, B1); PG8_BAR; PG8_SCHED;
            PG8_LDB(B0, 1, 0); PG8_LDB(B1, 1, 1); PG8_SCHED; PG8_LDA(At, 1, 0); PG8_STAGE(PG8_SA(0, 1), a2 + hstepA, voffA);
            PG8_WAIT_V(8); PG8_WAIT_L(0); PG8_BAR; PG8_MMA(0, 0, At, B0); PG8_MMA(0, 1, At, B1); PG8_BAR; PG8_SCHED;
            PG8_LDA(At, 1, 1); PG8_STAGE(PG8_SB(1, 0), b3, voffB); PG8_STAGE(PG8_SB(1, 1), b3 + hstep, voffB); PG8_STAGE(PG8_SA(1, 0), a3, voffA);
            PG8_WAIT_V(8); PG8_WAIT_L(0); PG8_BAR; PG8_MMA(1, 0, At, B0); PG8_MMA(1, 1, At, B1); PG8_BAR; PG8_SCHED;
            } else {
            PG8_LDB(B0, 0, 0); PG8_SCHED; PG8_LDA(At, 0, 0); PG8_STAGE(PG8_SA(1, 1), a1 + hstepA, voffA);
            PG8_WAIT_L(8); PG8_BAR; PG8_WAIT_L(0); PG8_MMA(0, 0, At, B0); PG8_BAR; PG8_SCHED;
            PG8_LDB(B1, 0, 1); PG8_STAGE(PG8_SB(0, 0), b2, voffB);
            PG8_BAR; PG8_WAIT_L(0); PG8_MMA(0, 1, At, B1); PG8_BAR;
            PG8_LDA(At, 0, 1); PG8_STAGE(PG8_SA(0, 0), a2, voffA);
            PG8_BAR; PG8_WAIT_L(0); PG8_MMA(1, 0, At, B0); PG8_BAR; PG8_SCHED;
            PG8_STAGE(PG8_SB(0, 1), b2 + hstep, voffB);
            PG8_WAIT_V(6); PG8_BAR; PG8_MMA(1, 1, At, B1); PG8_BAR;
            PG8_LDB(B0, 1, 0); PG8_SCHED; PG8_LDA(At, 1, 0); PG8_STAGE(PG8_SA(0, 1), a2 + hstepA, voffA);
            PG8_WAIT_L(8); PG8_BAR; PG8_WAIT_L(0); PG8_MMA(0, 0, At, B0); PG8_BAR; PG8_SCHED;
            PG8_LDB(B1, 1, 1); PG8_STAGE(PG8_SB(1, 0), b3, voffB);
            PG8_BAR; PG8_WAIT_L(0); PG8_MMA(0, 1, At, B1); PG8_BAR;
            PG8_LDA(At, 1, 1); PG8_STAGE(PG8_SA(1, 0), a3, voffA);
            PG8_BAR; PG8_WAIT_L(0); PG8_MMA(1, 0, At, B0); PG8_BAR; PG8_SCHED;
            PG8_STAGE(PG8_SB(1, 1), b3 + hstep, voffB);
            PG8_WAIT_V(6); PG8_BAR; PG8_MMA(1, 1, At, B1); PG8_BAR;
            }
        }
        if constexpr (ALIGN_EPI) { if (wr == 0) PG8_BAR; }
        if constexpr (!Epi::AFTER_DRAIN) { E(acc, cur, wr, wc, fr, fq); S.done(cur); }
        if (!has_next) break;
#pragma unroll
        for (int a = 0; a < 2; ++a)
#pragma unroll
            for (int b = 0; b < 2; ++b)
#pragma unroll
                for (int m = 0; m < 4; ++m)
#pragma unroll
                    for (int n = 0; n < 2; ++n) acc[a][b][m][n] = (f32x4){0.f, 0.f, 0.f, 0.f};
        cur = nxt; cA = nA; cB = nB; ++ui;
        if constexpr (ALIGN_EPI) { if (wr == 1) PG8_BAR; }
    }
    PG8_WAIT_V(0);
    if constexpr (!ALIGN_EPI) { if (wr == 0) PG8_BAR; }
    PG8_BAR;
    if constexpr (Epi::AFTER_DRAIN) { E.fused(acc, cur, wr, wc, fr, fq, lds, wid, lane); S.done(cur); }
#undef PG8_SA
#undef PG8_SB
#undef PG8_STAGE
#undef PG8_LDA
#undef PG8_LDB
#undef PG8_MMA
#undef PG8_WAIT_V
#undef PG8_WAIT_L
#undef PG8_BAR
#undef PG8_SCHED
}
}

#ifndef GEMM_SP2
#define GEMM_SP2 true
#endif
#ifndef GEMM_ALIGN
#define GEMM_ALIGN true
#endif
namespace mk {
#define LAS __attribute__((address_space(3)))
using pg8::bf16_t; using pg8::bf16x8; using pg8::f32x4; using pg8::u32x4;
typedef unsigned u32x2 __attribute__((ext_vector_type(2)));

constexpr int DM = 1024, SEQ = 8192, NBATCH = 4, MPR = NBATCH * SEQ, MSAMP = 128, MREAL = MPR + MSAMP, MPAD = 33024;
constexpr int DFF = 2816, PW = 2816, NINP = 3072, CONVC = 1536;
constexpr float EPS = 1e-6f;
#ifndef SCAN_CW
#define SCAN_CW 2
#endif
constexpr int CW = SCAN_CW, NSCAN = 128 / CW;
constexpr int LDS_PHASE_BYTES = 155648, LDS_BYTES = LDS_PHASE_BYTES + 256;

constexpr size_t O_YP = 0, O_YS = 33554432, O_KP = 33685504, O_VP = 33751040, O_CP = 33816576, O_GP = 33835008,
                 O_KS = 34097152, O_VS = 36194304, O_CS = 38291456, O_GS = 38881280;
constexpr size_t MiB = 1u << 20;
constexpr size_t WS_CTL = 0, CTL_ZERO_BYTES = 1 * MiB;
constexpr size_t WS_W1IN = 1 * MiB, WS_W1OUT = 12 * MiB, WS_WINMIX = 18 * MiB, WS_WOUTMIX = 24 * MiB, WS_W2IN = 26 * MiB, WS_W2OUT = 37 * MiB;
constexpr size_t WS_GBA = 43 * MiB, WS_XN = 45 * MiB, WS_XN2 = 110 * MiB, WS_H = 175 * MiB, WS_GM = 353 * MiB, WS_GN = 417 * MiB;
constexpr size_t WS_GQ = 110 * MiB, WS_GO = 142 * MiB;
constexpr size_t WS_SSP1 = 481 * MiB, WS_SSP2 = 484 * MiB;
constexpr size_t WS_END = 487 * MiB;
constexpr size_t CTL_BAR = 0, CTL_BAR_BYTES = 16384, CTL_GLAST = 768 * 1024;

struct Params { const float* in[21]; float* out; unsigned char* ws; };

typedef float f32x2v __attribute__((ext_vector_type(2)));
typedef __bf16 bf16x2v __attribute__((ext_vector_type(2)));
__device__ __forceinline__ unsigned cvt_pk(float lo, float hi) { const f32x2v v = {lo, hi}; const bf16x2v b = __builtin_convertvector(v, bf16x2v); return __builtin_bit_cast(unsigned, b); }
__device__ __forceinline__ bf16_t f2bf(float f) { return (bf16_t)(cvt_pk(f, 0.f) & 0xffffu); }
__device__ __forceinline__ float bf2f(bf16_t h) { return __uint_as_float(((unsigned)h) << 16); }
__device__ __forceinline__ float bflo(unsigned w) { return __uint_as_float(w << 16); }
__device__ __forceinline__ float bfhi(unsigned w) { return __uint_as_float(w & 0xffff0000u); }
__device__ __forceinline__ float silu(float x) { return x * __builtin_amdgcn_rcpf(1.0f + __expf(-x)); }
__device__ __forceinline__ float wave_sum(float v) {
#pragma unroll
    for (int o = 1; o < 64; o <<= 1) v += __shfl_xor(v, o);
    return v;
}
__device__ __forceinline__ float wave_max(float v) {
#pragma unroll
    for (int o = 1; o < 64; o <<= 1) v = fmaxf(v, __shfl_xor(v, o));
    return v;
}
__device__ __forceinline__ f32x4 mfma16(bf16x8 a, bf16x8 b, f32x4 c) { return __builtin_amdgcn_mfma_f32_16x16x32_bf16(a, b, c, 0, 0, 0); }

__device__ __forceinline__ float row_rstd(const float* ssp, int r) {
    if (r >= MREAL) return 0.f;
    const f32x4 a = *(const f32x4*)(ssp + (size_t)r * 16), b = *(const f32x4*)(ssp + (size_t)r * 16 + 4), c = *(const f32x4*)(ssp + (size_t)r * 16 + 8), d = *(const f32x4*)(ssp + (size_t)r * 16 + 12);
    const float s = (((a[0] + a[1]) + (a[2] + a[3])) + ((b[0] + b[1]) + (b[2] + b[3]))) + (((c[0] + c[1]) + (c[2] + c[3])) + ((d[0] + d[1]) + (d[2] + d[3])));
    return rsqrtf(s * (1.0f / DM) + EPS);
}
struct EpiSwiglu {
    static constexpr bool PERM = true, AFTER_DRAIN = false;
    bf16_t* H; const float* ss;
    __device__ __forceinline__ void operator()(const f32x4 (&acc)[2][2][4][2], const pg8::Unit& u, int wr, int wc, int fr, int fq) const {
        const int row0 = u.pm * 256 + wr * 64 + fr, col0 = u.pn * 128 + wc * 32 + 8 * fq;
#pragma unroll
        for (int ai = 0; ai < 2; ++ai)
#pragma unroll
            for (int m = 0; m < 4; ++m) {
                const int r = row0 + ai * 128 + m * 16;
                const float rs = ss ? row_rstd(ss, r) : 1.0f;
                float h[8];
#pragma unroll
                for (int n = 0; n < 2; ++n)
#pragma unroll
                    for (int j = 0; j < 4; ++j) h[n * 4 + j] = silu(acc[ai][0][m][n][j] * rs) * (acc[ai][1][m][n][j] * rs);
                u32x4 w; w.x = cvt_pk(h[0], h[1]); w.y = cvt_pk(h[2], h[3]); w.z = cvt_pk(h[4], h[5]); w.w = cvt_pk(h[6], h[7]);
                *(u32x4*)(H + (size_t)r * DFF + col0) = w;
            }
    }
};
template <bool RESB16, bool WF32, bool WB16, bool SUMSQ, bool HALF> struct EpiResid {
    static constexpr bool PERM = true, AFTER_DRAIN = false;
    const void* resP; const void* resS; float* Yo; bf16_t* XBo; float* sso;
    __device__ __forceinline__ void operator()(const f32x4 (&acc)[2][2][4][2], const pg8::Unit& u, int wr, int wc, int fr, int fq) const {
        const int row0 = u.pm * 256 + wr * 64 + fr, col0 = u.pn * 256 + wc * 32 + 8 * fq;
        const char* const rP = (const char*)resP; const char* const rS = (const char*)resS - (size_t)MPR * DM * (RESB16 ? 2 : 4);
        float* const Y = Yo; const float scale = HALF ? 0.5f : 1.0f; bf16_t* const XB = XBo; float* const ss = sso;
#pragma unroll
        for (int ai = 0; ai < 2; ++ai)
#pragma unroll
            for (int m = 0; m < 4; ++m) {
                const int r = row0 + ai * 128 + m * 16; float s = 0.f;
                if (r < MREAL) {
                    const char* rp = ((r < MPR) ? rP : rS) + (size_t)r * DM * (RESB16 ? 2 : 4);
#pragma unroll
                    for (int bj = 0; bj < 2; ++bj) {
                        const int c = col0 + bj * 128;
                        f32x4 r0, r1;
                        if (RESB16) { const u32x4 w = *(const u32x4*)(rp + (size_t)c * 2); r0 = (f32x4){bflo(w.x), bfhi(w.x), bflo(w.y), bfhi(w.y)}; r1 = (f32x4){bflo(w.z), bfhi(w.z), bflo(w.w), bfhi(w.w)}; }
                        else { r0 = *(const f32x4*)(rp + (size_t)c * 4); r1 = *(const f32x4*)(rp + (size_t)c * 4 + 16); }
                        const f32x4 v0 = r0 + acc[ai][bj][m][0] * scale, v1 = r1 + acc[ai][bj][m][1] * scale;
                        if (WF32) { *(f32x4*)(Y + (size_t)r * DM + c) = v0; *(f32x4*)(Y + (size_t)r * DM + c + 4) = v1; }
                        if (WB16) { u32x4 w; w.x = cvt_pk(v0[0], v0[1]); w.y = cvt_pk(v0[2], v0[3]); w.z = cvt_pk(v1[0], v1[1]); w.w = cvt_pk(v1[2], v1[3]);
                            *(u32x4*)(XB + (size_t)r * DM + c) = w; }
                        if (SUMSQ) s += (v0[0] * v0[0] + v0[1] * v0[1]) + (v0[2] * v0[2] + v0[3] * v0[3]) + (v1[0] * v1[0] + v1[1] * v1[1]) + (v1[2] * v1[2] + v1[3] * v1[3]);
                    }
                }
                if (SUMSQ) { s += __shfl_xor(s, 16); s += __shfl_xor(s, 32); if (fq == 0 && r < MREAL) ss[(size_t)r * 16 + u.pn * 4 + wc] = s; }
            }
    }
};
struct EpiInproj {
    static constexpr bool PERM = true, AFTER_DRAIN = false;
    bf16_t* P; float* gba; const float* ss;
    __device__ __forceinline__ void operator()(const f32x4 (&acc)[2][2][4][2], const pg8::Unit& u, int wr, int wc, int fr, int fq) const {
        const int row0 = u.pm * 256 + wr * 64 + fr, col0 = u.pn * 256 + wc * 32 + 8 * fq;
#pragma unroll
        for (int ai = 0; ai < 2; ++ai)
#pragma unroll
            for (int m = 0; m < 4; ++m) {
                const int r = row0 + ai * 128 + m * 16;
                const float rs = row_rstd(ss, r);
                if (u.pn < 11) {
#pragma unroll
                    for (int bj = 0; bj < 2; ++bj) { const f32x4 v0 = acc[ai][bj][m][0] * rs, v1 = acc[ai][bj][m][1] * rs;
                        u32x4 w; w.x = cvt_pk(v0[0], v0[1]); w.y = cvt_pk(v0[2], v0[3]); w.z = cvt_pk(v1[0], v1[1]); w.w = cvt_pk(v1[2], v1[3]);
                        *(u32x4*)(P + (size_t)r * PW + col0 + bj * 128) = w; }
                } else if (wc == 0 && fq == 0) {
                    *(f32x4*)(gba + (size_t)r * 8) = acc[ai][0][m][0] * rs; *(f32x4*)(gba + (size_t)r * 8 + 4) = acc[ai][0][m][1] * rs;
                }
            }
    }
};


template <int NT, bool SS>
__device__ __forceinline__ void skinny_mm(const bf16_t* A, int lda, const bf16_t* W, int K, int wrow0, int wrow1, int wid, int fr, int fq, f32x4 (&acc)[NT], float& ss, LAS unsigned char* lds) {
    const int lane = fq * 16 + fr, kper = K >> 3, nks = kper >> 5;
    const bf16_t* ap = A + (size_t)fr * lda + wid * kper + 8 * fq;
    const bf16_t* w0 = W + (size_t)(wrow0 + fr) * K + wid * kper + 8 * fq; const bf16_t* w1 = W + (size_t)(wrow1 + fr) * K + wid * kper + 8 * fq;
    f32x4 pa[NT][8]; float sp[8];
#pragma unroll
    for (int mt = 0; mt < 8; ++mt) { sp[mt] = 0.f;
#pragma unroll
        for (int nt = 0; nt < NT; ++nt) pa[nt][mt] = (f32x4){0.f, 0.f, 0.f, 0.f}; }
#pragma unroll 2
    for (int ks = 0; ks < nks; ++ks) {
        const bf16x8 b0 = *(const bf16x8*)(w0 + 32 * ks); bf16x8 b1 = b0; if (NT == 2) b1 = *(const bf16x8*)(w1 + 32 * ks);
        bf16x8 av[8];
#pragma unroll
        for (int mt = 0; mt < 8; ++mt) av[mt] = *(const bf16x8*)(ap + (size_t)(16 * mt) * lda + 32 * ks);
#pragma unroll
        for (int mt = 0; mt < 8; ++mt) {
            pa[0][mt] = mfma16(b0, av[mt], pa[0][mt]);
            if (NT == 2) pa[NT - 1][mt] = mfma16(b1, av[mt], pa[NT - 1][mt]);
            if (SS) { const u32x4 u = __builtin_bit_cast(u32x4, av[mt]);
#pragma unroll
                for (int k = 0; k < 4; ++k) { const float lo = bflo(u[k]), hi = bfhi(u[k]); sp[mt] += lo * lo + hi * hi; } }
        }
    }
    LAS f32x4* red = (LAS f32x4*)lds;
    LAS float* sred = (LAS float*)(lds + 8 * NT * 8 * 64 * 16);
#pragma unroll
    for (int mt = 0; mt < 8; ++mt) {
#pragma unroll
        for (int nt = 0; nt < NT; ++nt) red[((wid * NT + nt) * 8 + mt) * 64 + lane] = pa[nt][mt];
        if (SS) sred[(wid * 8 + mt) * 64 + lane] = sp[mt];
    }
    __syncthreads();
    float s = 0.f;
#pragma unroll
    for (int nt = 0; nt < NT; ++nt) acc[nt] = (f32x4){0.f, 0.f, 0.f, 0.f};
#pragma unroll
    for (int v = 0; v < 8; ++v) {
#pragma unroll
        for (int nt = 0; nt < NT; ++nt) acc[nt] += red[((v * NT + nt) * 8 + wid) * 64 + lane];
        if (SS) s += sred[(v * 8 + wid) * 64 + lane];
    }
    if (SS) { s += __shfl_xor(s, 16); s += __shfl_xor(s, 32); }
    ss = s;
    __syncthreads();
}
template <bool SS> __device__ __forceinline__ void sk_ffn_in(const bf16_t* X, const bf16_t* Wt, bf16_t* H, int slab, int wid, int fr, int fq, LAS unsigned char* lds) {
    const int j0 = 16 * slab, wr0 = (j0 >> 7) * 256 + (j0 & 127);
    f32x4 acc[2]; float ss;
    skinny_mm<2, SS>(X + (size_t)MPR * DM, DM, Wt, DM, wr0, wr0 + 128, wid, fr, fq, acc, ss, lds);
    const float rs = SS ? rsqrtf(ss * (1.0f / DM) + EPS) : 1.0f;
    float h[4];
#pragma unroll
    for (int e = 0; e < 4; ++e) h[e] = silu(acc[0][e] * rs) * (acc[1][e] * rs);
    u32x2 w; w.x = cvt_pk(h[0], h[1]); w.y = cvt_pk(h[2], h[3]);
    *(u32x2*)(H + (size_t)(MPR + 16 * wid + fr) * DFF + j0 + 4 * fq) = w;
}
template <bool OUTF32> __device__ __forceinline__ void sk_ffn_out(const bf16_t* Hb, const bf16_t* Wt, const float* resf, float* outf, bf16_t* outb, int slab, int wid, int fr, int fq, LAS unsigned char* lds) {
    f32x4 acc[1]; float ss;
    skinny_mm<1, false>(Hb + (size_t)MPR * DFF, DFF, Wt, DFF, 16 * slab, 0, wid, fr, fq, acc, ss, lds);
    const int rl = 16 * wid + fr, c = 16 * slab + 4 * fq;
    f32x4 rv;
    if (OUTF32) { const u32x2 xr = *(const u32x2*)((const bf16_t*)resf + (size_t)rl * DM + c); rv = (f32x4){bflo(xr.x), bfhi(xr.x), bflo(xr.y), bfhi(xr.y)}; }
    else rv = *(const f32x4*)(resf + (size_t)rl * DM + c);
    const f32x4 v = rv + acc[0] * 0.5f;
    { u32x2 w; w.x = cvt_pk(v[0], v[1]); w.y = cvt_pk(v[2], v[3]); *(u32x2*)(outb + (size_t)rl * DM + c) = w; }
}
__device__ __forceinline__ void sk_inproj(const bf16_t* X, const bf16_t* Wt, bf16_t* P, float* gba, int slab, int wid, int fr, int fq, LAS unsigned char* lds) {
    const int n0 = 32 * slab; f32x4 acc[2]; float ss;
    skinny_mm<2, true>(X + (size_t)MPR * DM, DM, Wt, DM, n0, n0 + 16, wid, fr, fq, acc, ss, lds);
    const float rs = rsqrtf(ss * (1.0f / DM) + EPS); const int r = MPR + 16 * wid + fr;
    if (n0 < PW) {
#pragma unroll
        for (int nt = 0; nt < 2; ++nt) { const f32x4 v = acc[nt] * rs; u32x2 w; w.x = cvt_pk(v[0], v[1]); w.y = cvt_pk(v[2], v[3]); *(u32x2*)(P + (size_t)r * PW + n0 + 16 * nt + 4 * fq) = w; }
    } else if (fq < 2) *(f32x4*)(gba + (size_t)r * 8 + 4 * fq) = acc[0] * rs;
}
__device__ __forceinline__ void sk_outproj(const bf16_t* Pm, const bf16_t* Wt, const bf16_t* X1b, float* X2f, bf16_t* X2b, int slab, int wid, int fr, int fq, LAS unsigned char* lds) {
    const int n0 = 32 * slab; f32x4 acc[2]; float ss;
    skinny_mm<2, false>(Pm + (size_t)MPR * PW, PW, Wt, DM, n0, n0 + 16, wid, fr, fq, acc, ss, lds);
    const int r = MPR + 16 * wid + fr;
#pragma unroll
    for (int nt = 0; nt < 2; ++nt) { const int c = n0 + 16 * nt + 4 * fq; const u32x2 xr = *(const u32x2*)(X1b + (size_t)r * DM + c);
        const f32x4 v = (f32x4){bflo(xr.x), bfhi(xr.x), bflo(xr.y), bfhi(xr.y)} + acc[nt];
        u32x2 w; w.x = cvt_pk(v[0], v[1]); w.y = cvt_pk(v[2], v[3]); *(u32x2*)(X2b + (size_t)r * DM + c) = w; }
}

__device__ __forceinline__ void transpose_item(const float* W, int K, int N, bf16_t* WT, int k0, int n0, int drow0, const float* gs, LAS float* scr, int lane) {
    float wv[32];
#pragma unroll
    for (int i = 0; i < 32; ++i) { const int kk = 2 * i + (lane >> 5), n = n0 + (lane & 31); wv[i] = (n < N) ? W[(size_t)(k0 + kk) * N + n] : 0.f; }
#pragma unroll
    for (int i = 0; i < 32; ++i) { const int kk = 2 * i + (lane >> 5); float v = wv[i]; if (gs) v *= gs[k0 + kk]; scr[kk * 33 + (lane & 31)] = v; }
    asm volatile("s_waitcnt lgkmcnt(0)" ::: "memory");
    const int c = lane & 7;
#pragma unroll
    for (int j = 0; j < 4; ++j) { const int nn = (lane >> 3) + 8 * j; const LAS float* s = scr + (8 * c) * 33 + nn;
        u32x4 o; o.x = cvt_pk(s[0 * 33], s[1 * 33]); o.y = cvt_pk(s[2 * 33], s[3 * 33]); o.z = cvt_pk(s[4 * 33], s[5 * 33]); o.w = cvt_pk(s[6 * 33], s[7 * 33]);
        *(u32x4*)(WT + (size_t)(drow0 + nn) * K + k0 + 8 * c) = o; }
    asm volatile("s_waitcnt lgkmcnt(0)" ::: "memory");
}
__device__ __forceinline__ int map_ffin_row(int n0) { return n0 < DFF ? (n0 >> 7) * 256 + (n0 & 127) : ((n0 - DFF) >> 7) * 256 + 128 + ((n0 - DFF) & 127); }

__device__ __forceinline__ void p0_prologue(const Params& p, LAS unsigned char* lds, int vb, int G) {
    const int tid = threadIdx.x, lane = tid & 63, wid = tid >> 6;
    LAS float* scr = (LAS float*)(lds + wid * 16384);
    const int gw = vb * 8 + wid, NGW = G * 8;
    bf16_t* W1IN = (bf16_t*)(p.ws + WS_W1IN); bf16_t* W1OUT = (bf16_t*)(p.ws + WS_W1OUT); bf16_t* WINMIX = (bf16_t*)(p.ws + WS_WINMIX);
    bf16_t* WOUTMIX = (bf16_t*)(p.ws + WS_WOUTMIX); bf16_t* W2IN = (bf16_t*)(p.ws + WS_W2IN); bf16_t* W2OUT = (bf16_t*)(p.ws + WS_W2OUT);
    constexpr int I_FIN = 16 * 176, I_FOUT = 44 * 32, I_INMIX = 16 * 89, I_OUTMIX = 16 * 32;
    constexpr int NITEMS = 2 * I_FIN + 2 * I_FOUT + I_INMIX + I_OUTMIX;
    for (int it = gw; it < NITEMS; it += NGW) {
        int r = it;
        if (r < I_FIN) { const int kb = r / 176, nb = r % 176; transpose_item(p.in[7], DM, 2 * DFF, W1IN, kb * 64, nb * 32, map_ffin_row(nb * 32), nullptr, scr, lane); continue; } r -= I_FIN;
        if (r < I_FIN) { const int kb = r / 176, nb = r % 176; transpose_item(p.in[18], DM, 2 * DFF, W2IN, kb * 64, nb * 32, map_ffin_row(nb * 32), p.in[17], scr, lane); continue; } r -= I_FIN;
        if (r < I_FOUT) { const int kb = r / 32, nb = r % 32; transpose_item(p.in[8], DFF, DM, W1OUT, kb * 64, nb * 32, nb * 32, nullptr, scr, lane); continue; } r -= I_FOUT;
        if (r < I_FOUT) { const int kb = r / 32, nb = r % 32; transpose_item(p.in[19], DFF, DM, W2OUT, kb * 64, nb * 32, nb * 32, nullptr, scr, lane); continue; } r -= I_FOUT;
        if (r < I_INMIX) { const int kb = r / 89, nb = r % 89; transpose_item(p.in[10], DM, 2824, WINMIX, kb * 64, nb * 32, nb * 32, p.in[9], scr, lane); continue; } r -= I_INMIX;
        { const int kb = r / 32, nb = r % 32; transpose_item(p.in[16], DM, DM, WOUTMIX, kb * 64, nb * 32, nb * 32, nullptr, scr, lane); }
    }
    bf16_t* XN = (bf16_t*)(p.ws + WS_XN); const float* g1 = p.in[6];
    f32x4 gv[4];
#pragma unroll
    for (int j = 0; j < 4; ++j) gv[j] = *((const f32x4*)g1 + lane + 64 * j);
    {
        f32x4 v[4], vn[4];
        int m = gw;
        if (m < MREAL) { const f32x4* xr = (const f32x4*)((m < MPR) ? p.in[0] + (size_t)m * DM : p.in[1] + (size_t)(m - MPR) * DM) + lane;
#pragma unroll
            for (int j = 0; j < 4; ++j) v[j] = xr[64 * j]; }
        for (; m < MREAL; m += NGW) {
            const int mn = m + NGW;
            if (mn < MREAL) { const f32x4* xr = (const f32x4*)((mn < MPR) ? p.in[0] + (size_t)mn * DM : p.in[1] + (size_t)(mn - MPR) * DM) + lane;
#pragma unroll
                for (int j = 0; j < 4; ++j) vn[j] = xr[64 * j]; }
            float s = 0.f;
#pragma unroll
            for (int j = 0; j < 4; ++j) s += (v[j][0] * v[j][0] + v[j][1] * v[j][1]) + (v[j][2] * v[j][2] + v[j][3] * v[j][3]);
            const float rstd = rsqrtf(wave_sum(s) * (1.0f / DM) + EPS);
            unsigned long long* o8 = (unsigned long long*)(XN + (size_t)m * DM) + lane;
#pragma unroll
            for (int j = 0; j < 4; ++j) { const f32x4 y = v[j] * rstd * gv[j];
                o8[64 * j] = (unsigned long long)cvt_pk(y[0], y[1]) | ((unsigned long long)cvt_pk(y[2], y[3]) << 32); }
#pragma unroll
            for (int j = 0; j < 4; ++j) v[j] = vn[j];
        }
    }
}

template <bool SWX = false, bool SWY = false>
__device__ __forceinline__ f32x4 tile_mm(const LAS bf16_t* X, int ldx, int mt, const LAS bf16_t* Y, int ldy, int nt, int nks, int fr, int fq) {
    f32x4 acc = (f32x4){0.f, 0.f, 0.f, 0.f};
    const int rx = 16 * mt + fr, ry = 16 * nt + fr, sx = SWX ? ((rx >> 3) & 7) : 0, sy = SWY ? ((ry >> 3) & 7) : 0;
    const LAS bf16_t* xp = X + rx * ldx; const LAS bf16_t* yp = Y + ry * ldy;
    for (int ks = 0; ks < nks; ++ks) acc = mfma16(*(const LAS bf16x8*)(xp + 8 * ((4 * ks + fq) ^ sx)), *(const LAS bf16x8*)(yp + 8 * ((4 * ks + fq) ^ sy)), acc);
    return acc;
}
constexpr int G1_QS = 0, G1_KS = 17408, G1_VBT = 34816, G1_KBT = 53248, G1_KDT = 71680, G1_UT = 90112, G1_WT = 108544, G1_QK = 126976, G1_TB = 136192, G1_GC = 145408, G1_BETA = 145664, G1_TT = 146176, G1_A10 = 148736, G1_PT = 151296;

__device__ __forceinline__ void gdn_prep_unit(const Params& p, LAS unsigned char* lds, int unit) {
    const int tid = threadIdx.x, lane = tid & 63, wid = tid >> 6, fr = lane & 15, fq = lane >> 4;
    const int bh = unit >> 7, n = unit & 127, b = bh >> 2, h = bh & 3;
    const int tok0 = b * SEQ + n * 64;
    LAS bf16_t* Qs = (LAS bf16_t*)(lds + G1_QS); LAS bf16_t* Ks = (LAS bf16_t*)(lds + G1_KS); LAS bf16_t* VbT = (LAS bf16_t*)(lds + G1_VBT);
    LAS bf16_t* KbT = (LAS bf16_t*)(lds + G1_KBT); LAS bf16_t* KdT = (LAS bf16_t*)(lds + G1_KDT); LAS bf16_t* UT = (LAS bf16_t*)(lds + G1_UT);
    LAS bf16_t* WT = (LAS bf16_t*)(lds + G1_WT); LAS float* Af = (LAS float*)(lds + G1_WT); LAS bf16_t* QK = (LAS bf16_t*)(lds + G1_QK);
    LAS bf16_t* Tb = (LAS bf16_t*)(lds + G1_TB); LAS bf16_t* TT = (LAS bf16_t*)(lds + G1_TT); LAS bf16_t* A10b = (LAS bf16_t*)(lds + G1_A10); LAS bf16_t* PT = (LAS bf16_t*)(lds + G1_PT); LAS float* gcs = (LAS float*)(lds + G1_GC); LAS float* betas = (LAS float*)(lds + G1_BETA);
    const bf16_t* PB = (const bf16_t*)(p.ws + WS_H); const float* GBA = (const float*)(p.ws + WS_GBA);
    LAS unsigned char* raw = lds + G1_UT;
    for (int pc4 = wid; pc4 < 51; pc4 += 8) {
        int pc = pc4 * 4 + (lane >> 4); pc = pc < 200 ? pc : 200;
        const int r = pc / 3, seg = pc - 3 * r; int tt = n * 64 - 3 + r; tt = tt < 0 ? 0 : tt;
        __builtin_amdgcn_global_load_lds((const unsigned*)(PB + (size_t)(b * SEQ + tt) * PW + 768 + seg * 512 + h * 128 + (lane & 15) * 8), (LAS unsigned*)(raw + pc4 * 1024), 16, 0, 0);
    }
    if (tid < 64) {
        const float* gb = GBA + (size_t)(tok0 + tid) * 8;
        const float bt = 1.0f / (1.0f + __expf(-gb[h]));
        const float x = gb[4 + h] + p.in[14][h]; const float sp = x > 20.f ? x : log1pf(__expf(x));
        float c = -__expf(p.in[13][h]) * sp;
#pragma unroll
        for (int o = 1; o < 64; o <<= 1) { const float t = __shfl_up(c, o); if (lane >= o) c += t; }
        gcs[tid] = c; betas[tid] = bt;
    }
    asm volatile("s_waitcnt vmcnt(0)" ::: "memory");
    __syncthreads();
    const float gclast = gcs[63];
    const float* cw = p.in[12];
#pragma unroll 1
    for (int it = 0; it < 6; ++it) {
        const int item = tid + 512 * it, l16 = item & 15, row = item >> 4, which = row >> 6, t = row & 63;
        const int cch = which * 512 + h * 128 + l16 * 8;
        float a[8];
#pragma unroll
        for (int e = 0; e < 8; ++e) a[e] = 0.f;
#pragma unroll
        for (int j = 0; j < 4; ++j) {
            const int tt = n * 64 + t - 3 + j;
            if (tt >= 0) {
                const u32x4 xv = *(const LAS u32x4*)(raw + ((t + j) * 3 + which) * 256 + l16 * 16);
                const f32x4 w0 = *(const f32x4*)(cw + j * CONVC + cch), w1 = *(const f32x4*)(cw + j * CONVC + cch + 4);
                a[0] += w0[0] * bflo(xv.x); a[1] += w0[1] * bfhi(xv.x); a[2] += w0[2] * bflo(xv.y); a[3] += w0[3] * bfhi(xv.y);
                a[4] += w1[0] * bflo(xv.z); a[5] += w1[1] * bfhi(xv.z); a[6] += w1[2] * bflo(xv.w); a[7] += w1[3] * bfhi(xv.w);
            }
        }
        float ss = 0.f;
#pragma unroll
        for (int e = 0; e < 8; ++e) { a[e] = silu(a[e]); ss += a[e] * a[e]; }
        ss += __shfl_xor(ss, 1); ss += __shfl_xor(ss, 2); ss += __shfl_xor(ss, 4); ss += __shfl_xor(ss, 8);
        const float gct = gcs[t], bt = betas[t];
        const int tsw = (((t >> 3) ^ (l16 & 7)) << 3) | (t & 7);
        if (which == 0) {
            const float sc = rsqrtf(ss + EPS) * 0.08838834764831845f;
            u32x4 w; w.x = cvt_pk(a[0] * sc, a[1] * sc); w.y = cvt_pk(a[2] * sc, a[3] * sc); w.z = cvt_pk(a[4] * sc, a[5] * sc); w.w = cvt_pk(a[6] * sc, a[7] * sc);
            *(LAS u32x4*)(Qs + t * 136 + l16 * 8) = w;
        } else if (which == 1) {
            const float sc = rsqrtf(ss + EPS);
            u32x4 w; w.x = cvt_pk(a[0] * sc, a[1] * sc); w.y = cvt_pk(a[2] * sc, a[3] * sc); w.z = cvt_pk(a[4] * sc, a[5] * sc); w.w = cvt_pk(a[6] * sc, a[7] * sc);
            *(LAS u32x4*)(Ks + t * 136 + l16 * 8) = w;
            const float sb = sc * bt * __expf(gct), sd = sc * __expf(gclast - gct);
#pragma unroll
            for (int e = 0; e < 8; ++e) { KbT[(l16 * 8 + e) * 72 + tsw] = f2bf(a[e] * sb); KdT[(l16 * 8 + e) * 72 + tsw] = f2bf(a[e] * sd); }
        } else {
#pragma unroll
            for (int e = 0; e < 8; ++e) VbT[(l16 * 8 + e) * 72 + tsw] = f2bf(a[e] * bt);
        }
    }
    __syncthreads();
#pragma unroll 2
    for (int r = 0; r < 4; ++r) {
        const int job = wid + 8 * r, kind = job >> 4, tile = job & 15, it = tile >> 2, jt = tile & 3;
        if (kind == 0) {
            if (jt > it) continue;
            const f32x4 acc = tile_mm(Ks, 136, it, Ks, 136, jt, 4, fr, fq);
            const int j = 16 * jt + fr; const float gcj = gcs[j];
            float v[4];
#pragma unroll
            for (int e = 0; e < 4; ++e) { const int i = 16 * it + 4 * fq + e; const bool ok = i > j; v[e] = ok ? acc[e] * __expf(gcs[i] - gcj) * betas[i] : 0.f; }
            *(LAS f32x4*)(Af + j * 68 + 16 * it + 4 * fq) = (f32x4){v[0], v[1], v[2], v[3]};
            if (it >= 2 && jt < 2) {
#pragma unroll
                for (int e = 0; e < 4; ++e) A10b[(16 * (it - 2) + 4 * fq + e) * 40 + j] = f2bf(v[e]); }
        } else {
            const f32x4 acc = tile_mm(Ks, 136, jt, Qs, 136, it, 4, fr, fq);
            const int i = 16 * it + fr; const float gci = gcs[i];
            float v[4];
#pragma unroll
            for (int e = 0; e < 4; ++e) { const int j = 16 * jt + 4 * fq + e; const bool ok = i >= j; v[e] = ok ? acc[e] * __expf(gci - gcs[j]) : 0.f; }
            u32x2 w; w.x = cvt_pk(v[0], v[1]); w.y = cvt_pk(v[2], v[3]); *(LAS u32x2*)(QK + i * 72 + 16 * jt + 4 * fq) = w;
        }
    }
    __syncthreads();
    if (wid < 2) {
        const int ofs = wid * 32, cl = lane & 31; const LAS float* Ab = Af + ofs * 69; LAS bf16_t* Tw = Tb + ofs * 73 + cl; LAS bf16_t* Tt = (wid == 0) ? TT + cl * 40 : PT + cl * 40;
        f32x2v r2[16];
#pragma unroll
        for (int k = 0; k < 16; ++k) r2[k] = (f32x2v){(cl == 2 * k) ? 1.0f : 0.0f, (cl == 2 * k + 1) ? 1.0f : 0.0f};
        const f32x4 a0 = *(const LAS f32x4*)(Ab + 0);
        const f32x4 a1 = *(const LAS f32x4*)(Ab + 4);
        const f32x4 a2 = *(const LAS f32x4*)(Ab + 8);
        const f32x4 a3 = *(const LAS f32x4*)(Ab + 12);
        const f32x4 a4 = *(const LAS f32x4*)(Ab + 16);
        const float t0 = r2[0][0]; const f32x2v T0 = (f32x2v){t0, t0}; Tw[0] = f2bf(t0); Tt[0] = f2bf(t0);
        r2[0] -= (f32x2v){a0[0], a0[1]} * T0; r2[1] -= (f32x2v){a0[2], a0[3]} * T0;
        const f32x4 a5 = *(const LAS f32x4*)(Ab + 20);
        r2[2] -= (f32x2v){a1[0], a1[1]} * T0; r2[3] -= (f32x2v){a1[2], a1[3]} * T0;
        const f32x4 a6 = *(const LAS f32x4*)(Ab + 24);
        r2[4] -= (f32x2v){a2[0], a2[1]} * T0; r2[5] -= (f32x2v){a2[2], a2[3]} * T0;
        const f32x4 a7 = *(const LAS f32x4*)(Ab + 28);
        r2[6] -= (f32x2v){a3[0], a3[1]} * T0; r2[7] -= (f32x2v){a3[2], a3[3]} * T0;
        const f32x4 a8 = *(const LAS f32x4*)(Ab + 68);
        r2[8] -= (f32x2v){a4[0], a4[1]} * T0; r2[9] -= (f32x2v){a4[2], a4[3]} * T0;
        const f32x4 a9 = *(const LAS f32x4*)(Ab + 72);
        r2[10] -= (f32x2v){a5[0], a5[1]} * T0; r2[11] -= (f32x2v){a5[2], a5[3]} * T0;
        const f32x4 a10 = *(const LAS f32x4*)(Ab + 76);
        r2[12] -= (f32x2v){a6[0], a6[1]} * T0; r2[13] -= (f32x2v){a6[2], a6[3]} * T0;
        const f32x4 a11 = *(const LAS f32x4*)(Ab + 80);
        r2[14] -= (f32x2v){a7[0], a7[1]} * T0; r2[15] -= (f32x2v){a7[2], a7[3]} * T0;
        const f32x4 a12 = *(const LAS f32x4*)(Ab + 84);
        const float t1 = r2[0][1]; const f32x2v T1 = (f32x2v){t1, t1}; Tw[72] = f2bf(t1); Tt[1] = f2bf(t1);
        r2[1] -= (f32x2v){a8[2], a8[3]} * T1;
        const f32x4 a13 = *(const LAS f32x4*)(Ab + 88);
        r2[2] -= (f32x2v){a9[0], a9[1]} * T1; r2[3] -= (f32x2v){a9[2], a9[3]} * T1;
        const f32x4 a14 = *(const LAS f32x4*)(Ab + 92);
        r2[4] -= (f32x2v){a10[0], a10[1]} * T1; r2[5] -= (f32x2v){a10[2], a10[3]} * T1;
        const f32x4 a15 = *(const LAS f32x4*)(Ab + 96);
        r2[6] -= (f32x2v){a11[0], a11[1]} * T1; r2[7] -= (f32x2v){a11[2], a11[3]} * T1;
        const f32x4 a16 = *(const LAS f32x4*)(Ab + 136);
        r2[8] -= (f32x2v){a12[0], a12[1]} * T1; r2[9] -= (f32x2v){a12[2], a12[3]} * T1;
        const f32x4 a17 = *(const LAS f32x4*)(Ab + 140);
        r2[10] -= (f32x2v){a13[0], a13[1]} * T1; r2[11] -= (f32x2v){a13[2], a13[3]} * T1;
        const f32x4 a18 = *(const LAS f32x4*)(Ab + 144);
        r2[12] -= (f32x2v){a14[0], a14[1]} * T1; r2[13] -= (f32x2v){a14[2], a14[3]} * T1;
        const f32x4 a19 = *(const LAS f32x4*)(Ab + 148);
        r2[14] -= (f32x2v){a15[0], a15[1]} * T1; r2[15] -= (f32x2v){a15[2], a15[3]} * T1;
        const f32x4 a20 = *(const LAS f32x4*)(Ab + 152);
        const float t2 = r2[1][0]; const f32x2v T2 = (f32x2v){t2, t2}; Tw[144] = f2bf(t2); Tt[2] = f2bf(t2);
        r2[1] -= (f32x2v){a16[2], a16[3]} * T2;
        const f32x4 a21 = *(const LAS f32x4*)(Ab + 156);
        r2[2] -= (f32x2v){a17[0], a17[1]} * T2; r2[3] -= (f32x2v){a17[2], a17[3]} * T2;
        const f32x4 a22 = *(const LAS f32x4*)(Ab + 160);
        r2[4] -= (f32x2v){a18[0], a18[1]} * T2; r2[5] -= (f32x2v){a18[2], a18[3]} * T2;
        const f32x4 a23 = *(const LAS f32x4*)(Ab + 164);
        r2[6] -= (f32x2v){a19[0], a19[1]} * T2; r2[7] -= (f32x2v){a19[2], a19[3]} * T2;
        const f32x4 a24 = *(const LAS f32x4*)(Ab + 208);
        r2[8] -= (f32x2v){a20[0], a20[1]} * T2; r2[9] -= (f32x2v){a20[2], a20[3]} * T2;
        const f32x4 a25 = *(const LAS f32x4*)(Ab + 212);
        r2[10] -= (f32x2v){a21[0], a21[1]} * T2; r2[11] -= (f32x2v){a21[2], a21[3]} * T2;
        const f32x4 a26 = *(const LAS f32x4*)(Ab + 216);
        r2[12] -= (f32x2v){a22[0], a22[1]} * T2; r2[13] -= (f32x2v){a22[2], a22[3]} * T2;
        const f32x4 a27 = *(const LAS f32x4*)(Ab + 220);
        r2[14] -= (f32x2v){a23[0], a23[1]} * T2; r2[15] -= (f32x2v){a23[2], a23[3]} * T2;
        const f32x4 a28 = *(const LAS f32x4*)(Ab + 224);
        const float t3 = r2[1][1]; const f32x2v T3 = (f32x2v){t3, t3}; Tw[216] = f2bf(t3); Tt[3] = f2bf(t3);
        r2[2] -= (f32x2v){a24[0], a24[1]} * T3; r2[3] -= (f32x2v){a24[2], a24[3]} * T3;
        const f32x4 a29 = *(const LAS f32x4*)(Ab + 228);
        r2[4] -= (f32x2v){a25[0], a25[1]} * T3; r2[5] -= (f32x2v){a25[2], a25[3]} * T3;
        const f32x4 a30 = *(const LAS f32x4*)(Ab + 232);
        r2[6] -= (f32x2v){a26[0], a26[1]} * T3; r2[7] -= (f32x2v){a26[2], a26[3]} * T3;
        const f32x4 a31 = *(const LAS f32x4*)(Ab + 276);
        r2[8] -= (f32x2v){a27[0], a27[1]} * T3; r2[9] -= (f32x2v){a27[2], a27[3]} * T3;
        const f32x4 a32 = *(const LAS f32x4*)(Ab + 280);
        r2[10] -= (f32x2v){a28[0], a28[1]} * T3; r2[11] -= (f32x2v){a28[2], a28[3]} * T3;
        const f32x4 a33 = *(const LAS f32x4*)(Ab + 284);
        r2[12] -= (f32x2v){a29[0], a29[1]} * T3; r2[13] -= (f32x2v){a29[2], a29[3]} * T3;
        const f32x4 a34 = *(const LAS f32x4*)(Ab + 288);
        r2[14] -= (f32x2v){a30[0], a30[1]} * T3; r2[15] -= (f32x2v){a30[2], a30[3]} * T3;
        const f32x4 a35 = *(const LAS f32x4*)(Ab + 292);
        const float t4 = r2[2][0]; const f32x2v T4 = (f32x2v){t4, t4}; Tw[288] = f2bf(t4); Tt[4] = f2bf(t4);
        r2[2] -= (f32x2v){a31[0], a31[1]} * T4; r2[3] -= (f32x2v){a31[2], a31[3]} * T4;
        const f32x4 a36 = *(const LAS f32x4*)(Ab + 296);
        r2[4] -= (f32x2v){a32[0], a32[1]} * T4; r2[5] -= (f32x2v){a32[2], a32[3]} * T4;
        const f32x4 a37 = *(const LAS f32x4*)(Ab + 300);
        r2[6] -= (f32x2v){a33[0], a33[1]} * T4; r2[7] -= (f32x2v){a33[2], a33[3]} * T4;
        const f32x4 a38 = *(const LAS f32x4*)(Ab + 344);
        r2[8] -= (f32x2v){a34[0], a34[1]} * T4; r2[9] -= (f32x2v){a34[2], a34[3]} * T4;
        const f32x4 a39 = *(const LAS f32x4*)(Ab + 348);
        r2[10] -= (f32x2v){a35[0], a35[1]} * T4; r2[11] -= (f32x2v){a35[2], a35[3]} * T4;
        const f32x4 a40 = *(const LAS f32x4*)(Ab + 352);
        r2[12] -= (f32x2v){a36[0], a36[1]} * T4; r2[13] -= (f32x2v){a36[2], a36[3]} * T4;
        const f32x4 a41 = *(const LAS f32x4*)(Ab + 356);
        r2[14] -= (f32x2v){a37[0], a37[1]} * T4; r2[15] -= (f32x2v){a37[2], a37[3]} * T4;
        const f32x4 a42 = *(const LAS f32x4*)(Ab + 360);
        const float t5 = r2[2][1]; const f32x2v T5 = (f32x2v){t5, t5}; Tw[360] = f2bf(t5); Tt[5] = f2bf(t5);
        r2[3] -= (f32x2v){a38[2], a38[3]} * T5;
        const f32x4 a43 = *(const LAS f32x4*)(Ab + 364);
        r2[4] -= (f32x2v){a39[0], a39[1]} * T5; r2[5] -= (f32x2v){a39[2], a39[3]} * T5;
        const f32x4 a44 = *(const LAS f32x4*)(Ab + 368);
        r2[6] -= (f32x2v){a40[0], a40[1]} * T5; r2[7] -= (f32x2v){a40[2], a40[3]} * T5;
        const f32x4 a45 = *(const LAS f32x4*)(Ab + 412);
        r2[8] -= (f32x2v){a41[0], a41[1]} * T5; r2[9] -= (f32x2v){a41[2], a41[3]} * T5;
        const f32x4 a46 = *(const LAS f32x4*)(Ab + 416);
        r2[10] -= (f32x2v){a42[0], a42[1]} * T5; r2[11] -= (f32x2v){a42[2], a42[3]} * T5;
        const f32x4 a47 = *(const LAS f32x4*)(Ab + 420);
        r2[12] -= (f32x2v){a43[0], a43[1]} * T5; r2[13] -= (f32x2v){a43[2], a43[3]} * T5;
        const f32x4 a48 = *(const LAS f32x4*)(Ab + 424);
        r2[14] -= (f32x2v){a44[0], a44[1]} * T5; r2[15] -= (f32x2v){a44[2], a44[3]} * T5;
        const f32x4 a49 = *(const LAS f32x4*)(Ab + 428);
        const float t6 = r2[3][0]; const f32x2v T6 = (f32x2v){t6, t6}; Tw[432] = f2bf(t6); Tt[6] = f2bf(t6);
        r2[3] -= (f32x2v){a45[2], a45[3]} * T6;
        const f32x4 a50 = *(const LAS f32x4*)(Ab + 432);
        r2[4] -= (f32x2v){a46[0], a46[1]} * T6; r2[5] -= (f32x2v){a46[2], a46[3]} * T6;
        const f32x4 a51 = *(const LAS f32x4*)(Ab + 436);
        r2[6] -= (f32x2v){a47[0], a47[1]} * T6; r2[7] -= (f32x2v){a47[2], a47[3]} * T6;
        const f32x4 a52 = *(const LAS f32x4*)(Ab + 484);
        r2[8] -= (f32x2v){a48[0], a48[1]} * T6; r2[9] -= (f32x2v){a48[2], a48[3]} * T6;
        const f32x4 a53 = *(const LAS f32x4*)(Ab + 488);
        r2[10] -= (f32x2v){a49[0], a49[1]} * T6; r2[11] -= (f32x2v){a49[2], a49[3]} * T6;
        const f32x4 a54 = *(const LAS f32x4*)(Ab + 492);
        r2[12] -= (f32x2v){a50[0], a50[1]} * T6; r2[13] -= (f32x2v){a50[2], a50[3]} * T6;
        const f32x4 a55 = *(const LAS f32x4*)(Ab + 496);
        r2[14] -= (f32x2v){a51[0], a51[1]} * T6; r2[15] -= (f32x2v){a51[2], a51[3]} * T6;
        const f32x4 a56 = *(const LAS f32x4*)(Ab + 500);
        const float t7 = r2[3][1]; const f32x2v T7 = (f32x2v){t7, t7}; Tw[504] = f2bf(t7); Tt[7] = f2bf(t7);
        r2[4] -= (f32x2v){a52[0], a52[1]} * T7; r2[5] -= (f32x2v){a52[2], a52[3]} * T7;
        const f32x4 a57 = *(const LAS f32x4*)(Ab + 504);
        r2[6] -= (f32x2v){a53[0], a53[1]} * T7; r2[7] -= (f32x2v){a53[2], a53[3]} * T7;
        const f32x4 a58 = *(const LAS f32x4*)(Ab + 552);
        r2[8] -= (f32x2v){a54[0], a54[1]} * T7; r2[9] -= (f32x2v){a54[2], a54[3]} * T7;
        const f32x4 a59 = *(const LAS f32x4*)(Ab + 556);
        r2[10] -= (f32x2v){a55[0], a55[1]} * T7; r2[11] -= (f32x2v){a55[2], a55[3]} * T7;
        const f32x4 a60 = *(const LAS f32x4*)(Ab + 560);
        r2[12] -= (f32x2v){a56[0], a56[1]} * T7; r2[13] -= (f32x2v){a56[2], a56[3]} * T7;
        const f32x4 a61 = *(const LAS f32x4*)(Ab + 564);
        r2[14] -= (f32x2v){a57[0], a57[1]} * T7; r2[15] -= (f32x2v){a57[2], a57[3]} * T7;
        const f32x4 a62 = *(const LAS f32x4*)(Ab + 568);
        const float t8 = r2[4][0]; const f32x2v T8 = (f32x2v){t8, t8}; Tw[576] = f2bf(t8); Tt[8] = f2bf(t8);
        r2[4] -= (f32x2v){a58[0], a58[1]} * T8; r2[5] -= (f32x2v){a58[2], a58[3]} * T8;
        const f32x4 a63 = *(const LAS f32x4*)(Ab + 572);
        r2[6] -= (f32x2v){a59[0], a59[1]} * T8; r2[7] -= (f32x2v){a59[2], a59[3]} * T8;
        const f32x4 a64 = *(const LAS f32x4*)(Ab + 620);
        r2[8] -= (f32x2v){a60[0], a60[1]} * T8; r2[9] -= (f32x2v){a60[2], a60[3]} * T8;
        const f32x4 a65 = *(const LAS f32x4*)(Ab + 624);
        r2[10] -= (f32x2v){a61[0], a61[1]} * T8; r2[11] -= (f32x2v){a61[2], a61[3]} * T8;
        const f32x4 a66 = *(const LAS f32x4*)(Ab + 628);
        r2[12] -= (f32x2v){a62[0], a62[1]} * T8; r2[13] -= (f32x2v){a62[2], a62[3]} * T8;
        const f32x4 a67 = *(const LAS f32x4*)(Ab + 632);
        r2[14] -= (f32x2v){a63[0], a63[1]} * T8; r2[15] -= (f32x2v){a63[2], a63[3]} * T8;
        const f32x4 a68 = *(const LAS f32x4*)(Ab + 636);
        const float t9 = r2[4][1]; const f32x2v T9 = (f32x2v){t9, t9}; Tw[648] = f2bf(t9); Tt[9] = f2bf(t9);
        r2[5] -= (f32x2v){a64[2], a64[3]} * T9;
        const f32x4 a69 = *(const LAS f32x4*)(Ab + 640);
        r2[6] -= (f32x2v){a65[0], a65[1]} * T9; r2[7] -= (f32x2v){a65[2], a65[3]} * T9;
        const f32x4 a70 = *(const LAS f32x4*)(Ab + 688);
        r2[8] -= (f32x2v){a66[0], a66[1]} * T9; r2[9] -= (f32x2v){a66[2], a66[3]} * T9;
        const f32x4 a71 = *(const LAS f32x4*)(Ab + 692);
        r2[10] -= (f32x2v){a67[0], a67[1]} * T9; r2[11] -= (f32x2v){a67[2], a67[3]} * T9;
        const f32x4 a72 = *(const LAS f32x4*)(Ab + 696);
        r2[12] -= (f32x2v){a68[0], a68[1]} * T9; r2[13] -= (f32x2v){a68[2], a68[3]} * T9;
        const f32x4 a73 = *(const LAS f32x4*)(Ab + 700);
        r2[14] -= (f32x2v){a69[0], a69[1]} * T9; r2[15] -= (f32x2v){a69[2], a69[3]} * T9;
        const f32x4 a74 = *(const LAS f32x4*)(Ab + 704);
        const float t10 = r2[5][0]; const f32x2v T10 = (f32x2v){t10, t10}; Tw[720] = f2bf(t10); Tt[10] = f2bf(t10);
        r2[5] -= (f32x2v){a70[2], a70[3]} * T10;
        const f32x4 a75 = *(const LAS f32x4*)(Ab + 708);
        r2[6] -= (f32x2v){a71[0], a71[1]} * T10; r2[7] -= (f32x2v){a71[2], a71[3]} * T10;
        const f32x4 a76 = *(const LAS f32x4*)(Ab + 760);
        r2[8] -= (f32x2v){a72[0], a72[1]} * T10; r2[9] -= (f32x2v){a72[2], a72[3]} * T10;
        const f32x4 a77 = *(const LAS f32x4*)(Ab + 764);
        r2[10] -= (f32x2v){a73[0], a73[1]} * T10; r2[11] -= (f32x2v){a73[2], a73[3]} * T10;
        const f32x4 a78 = *(const LAS f32x4*)(Ab + 768);
        r2[12] -= (f32x2v){a74[0], a74[1]} * T10; r2[13] -= (f32x2v){a74[2], a74[3]} * T10;
        const f32x4 a79 = *(const LAS f32x4*)(Ab + 772);
        r2[14] -= (f32x2v){a75[0], a75[1]} * T10; r2[15] -= (f32x2v){a75[2], a75[3]} * T10;
        const f32x4 a80 = *(const LAS f32x4*)(Ab + 776);
        const float t11 = r2[5][1]; const f32x2v T11 = (f32x2v){t11, t11}; Tw[792] = f2bf(t11); Tt[11] = f2bf(t11);
        r2[6] -= (f32x2v){a76[0], a76[1]} * T11; r2[7] -= (f32x2v){a76[2], a76[3]} * T11;
        const f32x4 a81 = *(const LAS f32x4*)(Ab + 828);
        r2[8] -= (f32x2v){a77[0], a77[1]} * T11; r2[9] -= (f32x2v){a77[2], a77[3]} * T11;
        const f32x4 a82 = *(const LAS f32x4*)(Ab + 832);
        r2[10] -= (f32x2v){a78[0], a78[1]} * T11; r2[11] -= (f32x2v){a78[2], a78[3]} * T11;
        const f32x4 a83 = *(const LAS f32x4*)(Ab + 836);
        r2[12] -= (f32x2v){a79[0], a79[1]} * T11; r2[13] -= (f32x2v){a79[2], a79[3]} * T11;
        const f32x4 a84 = *(const LAS f32x4*)(Ab + 840);
        r2[14] -= (f32x2v){a80[0], a80[1]} * T11; r2[15] -= (f32x2v){a80[2], a80[3]} * T11;
        const f32x4 a85 = *(const LAS f32x4*)(Ab + 844);
        const float t12 = r2[6][0]; const f32x2v T12 = (f32x2v){t12, t12}; Tw[864] = f2bf(t12); Tt[12] = f2bf(t12);
        r2[6] -= (f32x2v){a81[0], a81[1]} * T12; r2[7] -= (f32x2v){a81[2], a81[3]} * T12;
        const f32x4 a86 = *(const LAS f32x4*)(Ab + 896);
        r2[8] -= (f32x2v){a82[0], a82[1]} * T12; r2[9] -= (f32x2v){a82[2], a82[3]} * T12;
        const f32x4 a87 = *(const LAS f32x4*)(Ab + 900);
        r2[10] -= (f32x2v){a83[0], a83[1]} * T12; r2[11] -= (f32x2v){a83[2], a83[3]} * T12;
        const f32x4 a88 = *(const LAS f32x4*)(Ab + 904);
        r2[12] -= (f32x2v){a84[0], a84[1]} * T12; r2[13] -= (f32x2v){a84[2], a84[3]} * T12;
        const f32x4 a89 = *(const LAS f32x4*)(Ab + 908);
        r2[14] -= (f32x2v){a85[0], a85[1]} * T12; r2[15] -= (f32x2v){a85[2], a85[3]} * T12;
        const f32x4 a90 = *(const LAS f32x4*)(Ab + 912);
        const float t13 = r2[6][1]; const f32x2v T13 = (f32x2v){t13, t13}; Tw[936] = f2bf(t13); Tt[13] = f2bf(t13);
        r2[7] -= (f32x2v){a86[2], a86[3]} * T13;
        const f32x4 a91 = *(const LAS f32x4*)(Ab + 964);
        r2[8] -= (f32x2v){a87[0], a87[1]} * T13; r2[9] -= (f32x2v){a87[2], a87[3]} * T13;
        const f32x4 a92 = *(const LAS f32x4*)(Ab + 968);
        r2[10] -= (f32x2v){a88[0], a88[1]} * T13; r2[11] -= (f32x2v){a88[2], a88[3]} * T13;
        const f32x4 a93 = *(const LAS f32x4*)(Ab + 972);
        r2[12] -= (f32x2v){a89[0], a89[1]} * T13; r2[13] -= (f32x2v){a89[2], a89[3]} * T13;
        const f32x4 a94 = *(const LAS f32x4*)(Ab + 976);
        r2[14] -= (f32x2v){a90[0], a90[1]} * T13; r2[15] -= (f32x2v){a90[2], a90[3]} * T13;
        const f32x4 a95 = *(const LAS f32x4*)(Ab + 980);
        const float t14 = r2[7][0]; const f32x2v T14 = (f32x2v){t14, t14}; Tw[1008] = f2bf(t14); Tt[14] = f2bf(t14);
        r2[7] -= (f32x2v){a91[2], a91[3]} * T14;
        const f32x4 a96 = *(const LAS f32x4*)(Ab + 1036);
        r2[8] -= (f32x2v){a92[0], a92[1]} * T14; r2[9] -= (f32x2v){a92[2], a92[3]} * T14;
        const f32x4 a97 = *(const LAS f32x4*)(Ab + 1040);
        r2[10] -= (f32x2v){a93[0], a93[1]} * T14; r2[11] -= (f32x2v){a93[2], a93[3]} * T14;
        const f32x4 a98 = *(const LAS f32x4*)(Ab + 1044);
        r2[12] -= (f32x2v){a94[0], a94[1]} * T14; r2[13] -= (f32x2v){a94[2], a94[3]} * T14;
        const f32x4 a99 = *(const LAS f32x4*)(Ab + 1048);
        r2[14] -= (f32x2v){a95[0], a95[1]} * T14; r2[15] -= (f32x2v){a95[2], a95[3]} * T14;
        const f32x4 a100 = *(const LAS f32x4*)(Ab + 1104);
        const float t15 = r2[7][1]; const f32x2v T15 = (f32x2v){t15, t15}; Tw[1080] = f2bf(t15); Tt[15] = f2bf(t15);
        r2[8] -= (f32x2v){a96[0], a96[1]} * T15; r2[9] -= (f32x2v){a96[2], a96[3]} * T15;
        const f32x4 a101 = *(const LAS f32x4*)(Ab + 1108);
        r2[10] -= (f32x2v){a97[0], a97[1]} * T15; r2[11] -= (f32x2v){a97[2], a97[3]} * T15;
        const f32x4 a102 = *(const LAS f32x4*)(Ab + 1112);
        r2[12] -= (f32x2v){a98[0], a98[1]} * T15; r2[13] -= (f32x2v){a98[2], a98[3]} * T15;
        const f32x4 a103 = *(const LAS f32x4*)(Ab + 1116);
        r2[14] -= (f32x2v){a99[0], a99[1]} * T15; r2[15] -= (f32x2v){a99[2], a99[3]} * T15;
        const f32x4 a104 = *(const LAS f32x4*)(Ab + 1172);
        const float t16 = r2[8][0]; const f32x2v T16 = (f32x2v){t16, t16}; Tw[1152] = f2bf(t16); Tt[16] = f2bf(t16);
        r2[8] -= (f32x2v){a100[0], a100[1]} * T16; r2[9] -= (f32x2v){a100[2], a100[3]} * T16;
        const f32x4 a105 = *(const LAS f32x4*)(Ab + 1176);
        r2[10] -= (f32x2v){a101[0], a101[1]} * T16; r2[11] -= (f32x2v){a101[2], a101[3]} * T16;
        const f32x4 a106 = *(const LAS f32x4*)(Ab + 1180);
        r2[12] -= (f32x2v){a102[0], a102[1]} * T16; r2[13] -= (f32x2v){a102[2], a102[3]} * T16;
        const f32x4 a107 = *(const LAS f32x4*)(Ab + 1184);
        r2[14] -= (f32x2v){a103[0], a103[1]} * T16; r2[15] -= (f32x2v){a103[2], a103[3]} * T16;
        const f32x4 a108 = *(const LAS f32x4*)(Ab + 1240);
        const float t17 = r2[8][1]; const f32x2v T17 = (f32x2v){t17, t17}; Tw[1224] = f2bf(t17); Tt[17] = f2bf(t17);
        r2[9] -= (f32x2v){a104[2], a104[3]} * T17;
        const f32x4 a109 = *(const LAS f32x4*)(Ab + 1244);
        r2[10] -= (f32x2v){a105[0], a105[1]} * T17; r2[11] -= (f32x2v){a105[2], a105[3]} * T17;
        const f32x4 a110 = *(const LAS f32x4*)(Ab + 1248);
        r2[12] -= (f32x2v){a106[0], a106[1]} * T17; r2[13] -= (f32x2v){a106[2], a106[3]} * T17;
        const f32x4 a111 = *(const LAS f32x4*)(Ab + 1252);
        r2[14] -= (f32x2v){a107[0], a107[1]} * T17; r2[15] -= (f32x2v){a107[2], a107[3]} * T17;
        const f32x4 a112 = *(const LAS f32x4*)(Ab + 1312);
        const float t18 = r2[9][0]; const f32x2v T18 = (f32x2v){t18, t18}; Tw[1296] = f2bf(t18); Tt[18] = f2bf(t18);
        r2[9] -= (f32x2v){a108[2], a108[3]} * T18;
        const f32x4 a113 = *(const LAS f32x4*)(Ab + 1316);
        r2[10] -= (f32x2v){a109[0], a109[1]} * T18; r2[11] -= (f32x2v){a109[2], a109[3]} * T18;
        const f32x4 a114 = *(const LAS f32x4*)(Ab + 1320);
        r2[12] -= (f32x2v){a110[0], a110[1]} * T18; r2[13] -= (f32x2v){a110[2], a110[3]} * T18;
        const f32x4 a115 = *(const LAS f32x4*)(Ab + 1380);
        r2[14] -= (f32x2v){a111[0], a111[1]} * T18; r2[15] -= (f32x2v){a111[2], a111[3]} * T18;
        const f32x4 a116 = *(const LAS f32x4*)(Ab + 1384);
        const float t19 = r2[9][1]; const f32x2v T19 = (f32x2v){t19, t19}; Tw[1368] = f2bf(t19); Tt[19] = f2bf(t19);
        r2[10] -= (f32x2v){a112[0], a112[1]} * T19; r2[11] -= (f32x2v){a112[2], a112[3]} * T19;
        const f32x4 a117 = *(const LAS f32x4*)(Ab + 1388);
        r2[12] -= (f32x2v){a113[0], a113[1]} * T19; r2[13] -= (f32x2v){a113[2], a113[3]} * T19;
        const f32x4 a118 = *(const LAS f32x4*)(Ab + 1448);
        r2[14] -= (f32x2v){a114[0], a114[1]} * T19; r2[15] -= (f32x2v){a114[2], a114[3]} * T19;
        const f32x4 a119 = *(const LAS f32x4*)(Ab + 1452);
        const float t20 = r2[10][0]; const f32x2v T20 = (f32x2v){t20, t20}; Tw[1440] = f2bf(t20); Tt[20] = f2bf(t20);
        r2[10] -= (f32x2v){a115[0], a115[1]} * T20; r2[11] -= (f32x2v){a115[2], a115[3]} * T20;
        const f32x4 a120 = *(const LAS f32x4*)(Ab + 1456);
        r2[12] -= (f32x2v){a116[0], a116[1]} * T20; r2[13] -= (f32x2v){a116[2], a116[3]} * T20;
        const f32x4 a121 = *(const LAS f32x4*)(Ab + 1516);
        r2[14] -= (f32x2v){a117[0], a117[1]} * T20; r2[15] -= (f32x2v){a117[2], a117[3]} * T20;
        const f32x4 a122 = *(const LAS f32x4*)(Ab + 1520);
        const float t21 = r2[10][1]; const f32x2v T21 = (f32x2v){t21, t21}; Tw[1512] = f2bf(t21); Tt[21] = f2bf(t21);
        r2[11] -= (f32x2v){a118[2], a118[3]} * T21;
        const f32x4 a123 = *(const LAS f32x4*)(Ab + 1524);
        r2[12] -= (f32x2v){a119[0], a119[1]} * T21; r2[13] -= (f32x2v){a119[2], a119[3]} * T21;
        const f32x4 a124 = *(const LAS f32x4*)(Ab + 1588);
        r2[14] -= (f32x2v){a120[0], a120[1]} * T21; r2[15] -= (f32x2v){a120[2], a120[3]} * T21;
        const f32x4 a125 = *(const LAS f32x4*)(Ab + 1592);
        const float t22 = r2[11][0]; const f32x2v T22 = (f32x2v){t22, t22}; Tw[1584] = f2bf(t22); Tt[22] = f2bf(t22);
        r2[11] -= (f32x2v){a121[2], a121[3]} * T22;
        const f32x4 a126 = *(const LAS f32x4*)(Ab + 1656);
        r2[12] -= (f32x2v){a122[0], a122[1]} * T22; r2[13] -= (f32x2v){a122[2], a122[3]} * T22;
        const f32x4 a127 = *(const LAS f32x4*)(Ab + 1660);
        r2[14] -= (f32x2v){a123[0], a123[1]} * T22; r2[15] -= (f32x2v){a123[2], a123[3]} * T22;
        const f32x4 a128 = *(const LAS f32x4*)(Ab + 1724);
        const float t23 = r2[11][1]; const f32x2v T23 = (f32x2v){t23, t23}; Tw[1656] = f2bf(t23); Tt[23] = f2bf(t23);
        r2[12] -= (f32x2v){a124[0], a124[1]} * T23; r2[13] -= (f32x2v){a124[2], a124[3]} * T23;
        const f32x4 a129 = *(const LAS f32x4*)(Ab + 1728);
        r2[14] -= (f32x2v){a125[0], a125[1]} * T23; r2[15] -= (f32x2v){a125[2], a125[3]} * T23;
        const f32x4 a130 = *(const LAS f32x4*)(Ab + 1792);
        const float t24 = r2[12][0]; const f32x2v T24 = (f32x2v){t24, t24}; Tw[1728] = f2bf(t24); Tt[24] = f2bf(t24);
        r2[12] -= (f32x2v){a126[0], a126[1]} * T24; r2[13] -= (f32x2v){a126[2], a126[3]} * T24;
        const f32x4 a131 = *(const LAS f32x4*)(Ab + 1796);
        r2[14] -= (f32x2v){a127[0], a127[1]} * T24; r2[15] -= (f32x2v){a127[2], a127[3]} * T24;
        const f32x4 a132 = *(const LAS f32x4*)(Ab + 1864);
        const float t25 = r2[12][1]; const f32x2v T25 = (f32x2v){t25, t25}; Tw[1800] = f2bf(t25); Tt[25] = f2bf(t25);
        r2[13] -= (f32x2v){a128[2], a128[3]} * T25;
        const f32x4 a133 = *(const LAS f32x4*)(Ab + 1932);
        r2[14] -= (f32x2v){a129[0], a129[1]} * T25; r2[15] -= (f32x2v){a129[2], a129[3]} * T25;
        const f32x4 a134 = *(const LAS f32x4*)(Ab + 2000);
        const float t26 = r2[13][0]; const f32x2v T26 = (f32x2v){t26, t26}; Tw[1872] = f2bf(t26); Tt[26] = f2bf(t26);
        r2[13] -= (f32x2v){a130[2], a130[3]} * T26;
        const f32x4 a135 = *(const LAS f32x4*)(Ab + 2068);
        r2[14] -= (f32x2v){a131[0], a131[1]} * T26; r2[15] -= (f32x2v){a131[2], a131[3]} * T26;
        const float t27 = r2[13][1]; const f32x2v T27 = (f32x2v){t27, t27}; Tw[1944] = f2bf(t27); Tt[27] = f2bf(t27);
        r2[14] -= (f32x2v){a132[0], a132[1]} * T27; r2[15] -= (f32x2v){a132[2], a132[3]} * T27;
        const float t28 = r2[14][0]; const f32x2v T28 = (f32x2v){t28, t28}; Tw[2016] = f2bf(t28); Tt[28] = f2bf(t28);
        r2[14] -= (f32x2v){a133[0], a133[1]} * T28; r2[15] -= (f32x2v){a133[2], a133[3]} * T28;
        const float t29 = r2[14][1]; const f32x2v T29 = (f32x2v){t29, t29}; Tw[2088] = f2bf(t29); Tt[29] = f2bf(t29);
        r2[15] -= (f32x2v){a134[2], a134[3]} * T29;
        const float t30 = r2[15][0]; const f32x2v T30 = (f32x2v){t30, t30}; Tw[2160] = f2bf(t30); Tt[30] = f2bf(t30);
        r2[15] -= (f32x2v){a135[2], a135[3]} * T30;
        Tw[2232] = f2bf(r2[15][1]); Tt[31] = f2bf(r2[15][1]);
    } else if (wid == 2) {
        *(LAS u32x4*)(Tb + (lane >> 1) * 72 + 32 + (lane & 1) * 16) = (u32x4){0u, 0u, 0u, 0u}; *(LAS u32x4*)(Tb + (lane >> 1) * 72 + 32 + (lane & 1) * 16 + 8) = (u32x4){0u, 0u, 0u, 0u};
    }
    __syncthreads();
    if (wid < 4) {
        const int mt = wid >> 1, nt = wid & 1; const f32x4 acc = tile_mm(A10b, 40, mt, TT, 40, nt, 1, fr, fq);
        u32x2 w; w.x = cvt_pk(acc[0], acc[1]); w.y = cvt_pk(acc[2], acc[3]); *(LAS u32x2*)(PT + (16 * nt + fr) * 40 + 16 * mt + 4 * fq) = w;
    }
    __syncthreads();
    if (wid < 4) {
        const int mt = wid >> 1, nt = wid & 1; const f32x4 acc = tile_mm(Tb + 32 * 72 + 32, 72, mt, PT, 40, nt, 1, fr, fq);
#pragma unroll
        for (int e = 0; e < 4; ++e) Tb[(32 + 16 * mt + 4 * fq + e) * 72 + 16 * nt + fr] = f2bf(-acc[e]);
    }
    __syncthreads();
#pragma unroll 2
    for (int r = 0; r < 8; ++r) {
        const int job = wid + 8 * r, kind = job >> 5, tile = job & 31, mt = tile >> 3, nt = tile & 7;
        const f32x4 acc = tile_mm<false, true>(Tb, 72, mt, kind ? KbT : VbT, 72, nt, 2, fr, fq);
        u32x2 w; w.x = cvt_pk(acc[0], acc[1]); w.y = cvt_pk(acc[2], acc[3]);
        { const int ch = 16 * nt + fr; *(LAS u32x2*)((kind ? WT : UT) + ch * 72 + 8 * ((2 * mt + (fq >> 1)) ^ ((ch >> 3) & 7)) + 4 * (fq & 1)) = w; }
    }
    __syncthreads();
    bf16_t* GM = (bf16_t*)(p.ws + WS_GM) + (size_t)unit * 16384; bf16_t* GN = (bf16_t*)(p.ws + WS_GN) + (size_t)unit * 16384;
    bf16_t* GQ = (bf16_t*)(p.ws + WS_GQ) + (size_t)unit * 8192; bf16_t* GO = (bf16_t*)(p.ws + WS_GO) + (size_t)unit * 8192;
#pragma unroll 2
    for (int r = 0; r < 24; ++r) {
        const int job = wid + 8 * r;
        if (job < 64) { const int a = job >> 3, mt = job & 7;
            const f32x4 acc = tile_mm<true, true>(WT, 72, a, KdT, 72, mt, 2, fr, fq);
            u32x2 w; w.x = cvt_pk(-acc[0], -acc[1]); w.y = cvt_pk(-acc[2], -acc[3]);
            *(u32x2*)(GM + ((mt * 4 + (a >> 1)) * 64 + lane) * 8 + (a & 1) * 4) = w;
        } else if (job < 128) { const int j = job - 64, mt = j >> 3, nt = j & 7;
            const f32x4 acc = tile_mm<true, true>(KdT, 72, mt, UT, 72, nt, 2, fr, fq);
            u32x2 w; w.x = cvt_pk(acc[0], acc[1]); w.y = cvt_pk(acc[2], acc[3]);
            *(u32x2*)(GN + ((nt * 64 + lane) * 8 + mt) * 4) = w;
        } else if (job < 160) { const int j = job - 128, a = j >> 2, it = j & 3;
            const f32x4 acc = tile_mm<true, false>(WT, 72, a, QK, 72, it, 2, fr, fq);
            const int i = 16 * it + fr; const float eg = __expf(gcs[i]);
            const u32x2 qv = *(const LAS u32x2*)(Qs + i * 136 + 16 * a + 4 * fq);
            u32x2 w; w.x = cvt_pk(bflo(qv.x) * eg - acc[0], bfhi(qv.x) * eg - acc[1]); w.y = cvt_pk(bflo(qv.y) * eg - acc[2], bfhi(qv.y) * eg - acc[3]);
            *(u32x2*)(GQ + ((it * 4 + (a >> 1)) * 64 + lane) * 8 + (a & 1) * 4) = w;
        } else { const int j = job - 160, mt = j >> 3, nt = j & 7;
            const f32x4 acc = tile_mm<false, true>(QK, 72, mt, UT, 72, nt, 2, fr, fq);
            u32x2 w; w.x = cvt_pk(acc[0], acc[1]); w.y = cvt_pk(acc[2], acc[3]);
            *(u32x2*)(GO + ((nt * 64 + lane) * 4 + mt) * 4) = w;
        }
    }
    if (tid == 0) ((float*)(p.ws + WS_CTL + CTL_GLAST))[unit] = __expf(gclast);
    __syncthreads();
}

__device__ __forceinline__ void gdn_scan(const Params& p, LAS unsigned char* lds, int sb) {
    const int tid = threadIdx.x, lane = tid & 63, wid = tid >> 6, fr = lane & 15, fq = lane >> 4;
    const int bh = sb / (8 / CW), sp = sb % (8 / CW), unit0 = bh * 128, sl = sp * CW + wid;
    const u32x4* GMb = (const u32x4*)((const bf16_t*)(p.ws + WS_GM) + (size_t)unit0 * 16384);
    const u32x4* GQb = (const u32x4*)((const bf16_t*)(p.ws + WS_GQ) + (size_t)unit0 * 8192);
    const bf16_t* GNb = (const bf16_t*)(p.ws + WS_GN) + (size_t)unit0 * 16384;
    bf16_t* GOb = (bf16_t*)(p.ws + WS_GO) + (size_t)unit0 * 8192;
    const float* glast = (const float*)(p.ws + WS_CTL + CTL_GLAST) + unit0;
    const bool loader = (wid >= CW && wid < CW + 4);
#define SCAN_DMA(cc) do { _Pragma("unroll") for (int k = 0; k < 8; ++k) { const int inst = (wid - CW) * 8 + k; \
        __builtin_amdgcn_global_load_lds((const unsigned*)((const char*)(GMb + (size_t)(cc) * 2048) + inst * 1024 + lane * 16), (LAS unsigned*)(lds + ((cc) & 3) * 32768 + inst * 1024), 16, 0, 0); } } while (0)
#define SCAN_LOADN(dn, cc) do { const bf16_t* np_ = GNb + (size_t)((cc) < 128 ? (cc) : 127) * 16384 + (size_t)(sl * 64 + lane) * 32; \
        asm volatile("global_load_dwordx4 %0, %4, off\n\tglobal_load_dwordx4 %1, %4, off offset:16\n\tglobal_load_dwordx4 %2, %4, off offset:32\n\tglobal_load_dwordx4 %3, %4, off offset:48" \
            : "=&v"(dn[0]), "=&v"(dn[1]), "=&v"(dn[2]), "=&v"(dn[3]) : "v"(np_) : "memory"); } while (0)
#define SCAN_WAITN(dn, N) asm volatile("s_waitcnt vmcnt(" #N ")" : "+v"(dn[0]), "+v"(dn[1]), "+v"(dn[2]), "+v"(dn[3]) :: "memory")
#define SCAN_STEP(c, nn, RELOAD) do { \
        SCAN_WAITN(nn, 8); \
        const float gl = __shfl(((c) < 64) ? glr0 : glr1, (c) & 63); bf16x8 Sb[4]; \
        bf16_t* scp = (bf16_t*)GNb + (size_t)(c) * 16384 + (size_t)sl * 2048 + lane * 8; \
        _Pragma("unroll") for (int ks = 0; ks < 4; ++ks) { u32x4 w; w.x = cvt_pk(S[2 * ks][0], S[2 * ks][1]); w.y = cvt_pk(S[2 * ks][2], S[2 * ks][3]); \
            w.z = cvt_pk(S[2 * ks + 1][0], S[2 * ks + 1][1]); w.w = cvt_pk(S[2 * ks + 1][2], S[2 * ks + 1][3]); Sb[ks] = __builtin_bit_cast(bf16x8, w); } \
        const LAS unsigned char* slot = lds + ((c) & 3) * 32768 + lane * 16; \
        bf16x8 fa[2][2][4]; \
        _Pragma("unroll") for (int ks = 0; ks < 4; ++ks) { fa[0][0][ks] = *(const LAS bf16x8*)(slot + (0 * 4 + ks) * 1024); fa[0][1][ks] = *(const LAS bf16x8*)(slot + (1 * 4 + ks) * 1024); } \
        _Pragma("unroll") for (int mt = 0; mt < 8; ++mt) { const unsigned w0 = nn[mt >> 1][(mt & 1) * 2], w1 = nn[mt >> 1][(mt & 1) * 2 + 1]; \
            S[mt] = S[mt] * gl + (f32x4){bflo(w0), bfhi(w0), bflo(w1), bfhi(w1)}; } \
        _Pragma("unroll") for (int ks = 0; ks < 4; ++ks) *(u32x4*)(scp + ks * 512) = __builtin_bit_cast(u32x4, Sb[ks]);     \
        RELOAD; \
        _Pragma("unroll") for (int pr = 0; pr < 4; ++pr) { \
            if (pr < 3) { _Pragma("unroll") for (int ks = 0; ks < 4; ++ks) { fa[(pr + 1) & 1][0][ks] = *(const LAS bf16x8*)(slot + ((2 * pr + 2) * 4 + ks) * 1024); fa[(pr + 1) & 1][1][ks] = *(const LAS bf16x8*)(slot + ((2 * pr + 3) * 4 + ks) * 1024); } } \
            _Pragma("unroll") for (int ks = 0; ks < 4; ++ks) { S[2 * pr] = mfma16(fa[pr & 1][0][ks], Sb[ks], S[2 * pr]); S[2 * pr + 1] = mfma16(fa[pr & 1][1][ks], Sb[ks], S[2 * pr + 1]); } } \
        } while (0)
    if (loader) { SCAN_DMA(0); SCAN_DMA(1); SCAN_DMA(2); asm volatile("s_waitcnt vmcnt(0)" ::: "memory"); }
    f32x4 S[8];
#pragma unroll
    for (int mt = 0; mt < 8; ++mt) S[mt] = (f32x4){0.f, 0.f, 0.f, 0.f};
    float glr0 = glast[lane], glr1 = glast[64 + lane];
    asm volatile("" : "+v"(glr0), "+v"(glr1));
    u32x4 nnA[4], nnB[4];
    if (wid < CW) { SCAN_LOADN(nnA, 0); SCAN_LOADN(nnB, 1); SCAN_WAITN(nnA, 0); SCAN_WAITN(nnB, 0); }
    asm volatile("s_waitcnt lgkmcnt(0)" ::: "memory"); __builtin_amdgcn_s_barrier(); asm volatile("" ::: "memory");
#pragma unroll 1
    for (int c = 0; c < 128; c += 2) {
        if (loader) { if (c + 3 < 128) { SCAN_DMA(c + 3); asm volatile("s_waitcnt vmcnt(16)" ::: "memory"); } else asm volatile("s_waitcnt vmcnt(0)" ::: "memory"); }
        else if (wid < CW) { SCAN_STEP(c, nnA, SCAN_LOADN(nnA, c + 2)); }
        asm volatile("s_waitcnt lgkmcnt(0)" ::: "memory"); __builtin_amdgcn_s_barrier(); asm volatile("" ::: "memory");
        if (loader) { if (c + 4 < 128) { SCAN_DMA(c + 4); asm volatile("s_waitcnt vmcnt(16)" ::: "memory"); } else asm volatile("s_waitcnt vmcnt(0)" ::: "memory"); }
        else if (wid < CW) { SCAN_STEP(c + 1, nnB, SCAN_LOADN(nnB, c + 3)); }
        asm volatile("s_waitcnt lgkmcnt(0)" ::: "memory"); __builtin_amdgcn_s_barrier(); asm volatile("" ::: "memory");
    }
#undef SCAN_DMA
#undef SCAN_LOADN
#undef SCAN_WAITN
#undef SCAN_STEP
    __syncthreads();
    if (wid < CW) {
        float* go = p.out + O_GP + (size_t)bh * 16384;
#pragma unroll
        for (int mt = 0; mt < 8; ++mt)
#pragma unroll
            for (int e = 0; e < 4; ++e) go[(16 * mt + 4 * fq + e) * 128 + sl * 16 + fr] = S[mt][e];
    }
}

__device__ __forceinline__ void gdn_gate_unit(const Params& p, int unit, int lane) {
    const int fr = lane & 15, fq = lane >> 4, bh = unit >> 7, n = unit & 127, b = bh >> 2, h = bh & 3, tok0 = b * SEQ + n * 64;
    const bf16_t* GO = (const bf16_t*)(p.ws + WS_GO) + (size_t)unit * 8192;
    bf16_t* PB = (bf16_t*)(p.ws + WS_H);
    {
        bf16_t* GOw = (bf16_t*)(p.ws + WS_GO) + (size_t)unit * 8192;
        const bf16_t* GQ = (const bf16_t*)(p.ws + WS_GQ) + (size_t)unit * 8192; const bf16_t* SC = (const bf16_t*)(p.ws + WS_GN) + (size_t)unit * 16384;
        bf16x8 qa[4][4];
#pragma unroll
        for (int mt = 0; mt < 4; ++mt)
#pragma unroll
            for (int ks = 0; ks < 4; ++ks) qa[mt][ks] = *(const bf16x8*)(GQ + ((mt * 4 + ks) * 64 + lane) * 8);
#pragma unroll 2
        for (int nt = 0; nt < 8; ++nt) {
            bf16x8 sb[4];
#pragma unroll
            for (int ks = 0; ks < 4; ++ks) sb[ks] = *(const bf16x8*)(SC + nt * 2048 + (ks * 64 + lane) * 8);
            const u32x4 o0 = *(const u32x4*)(GOw + (nt * 64 + lane) * 16), o1 = *(const u32x4*)(GOw + (nt * 64 + lane) * 16 + 8);
            f32x4 acc[4];
            acc[0] = (f32x4){bflo(o0.x), bfhi(o0.x), bflo(o0.y), bfhi(o0.y)}; acc[1] = (f32x4){bflo(o0.z), bfhi(o0.z), bflo(o0.w), bfhi(o0.w)};
            acc[2] = (f32x4){bflo(o1.x), bfhi(o1.x), bflo(o1.y), bfhi(o1.y)}; acc[3] = (f32x4){bflo(o1.z), bfhi(o1.z), bflo(o1.w), bfhi(o1.w)};
#pragma unroll
            for (int ks = 0; ks < 4; ++ks)
#pragma unroll
                for (int mt = 0; mt < 4; ++mt) acc[mt] = mfma16(qa[mt][ks], sb[ks], acc[mt]);
            u32x4 w0, w1;
            w0.x = cvt_pk(acc[0][0], acc[0][1]); w0.y = cvt_pk(acc[0][2], acc[0][3]); w0.z = cvt_pk(acc[1][0], acc[1][1]); w0.w = cvt_pk(acc[1][2], acc[1][3]);
            w1.x = cvt_pk(acc[2][0], acc[2][1]); w1.y = cvt_pk(acc[2][2], acc[2][3]); w1.z = cvt_pk(acc[3][0], acc[3][1]); w1.w = cvt_pk(acc[3][2], acc[3][3]);
            *(u32x4*)(GOw + (nt * 64 + lane) * 16) = w0; *(u32x4*)(GOw + (nt * 64 + lane) * 16 + 8) = w1;
        }
        asm volatile("s_waitcnt vmcnt(0)" ::: "memory");
    }
    float ssq[16];
#pragma unroll
    for (int k = 0; k < 16; ++k) ssq[k] = 0.f;
#pragma unroll 1
    for (int nt = 0; nt < 8; ++nt) {
        const u32x4 a0 = *(const u32x4*)(GO + (nt * 64 + lane) * 16), a1 = *(const u32x4*)(GO + (nt * 64 + lane) * 16 + 8);
#pragma unroll
        for (int k = 0; k < 4; ++k) { const float l0 = bflo(a0[k]), h0 = bfhi(a0[k]), l1 = bflo(a1[k]), h1 = bfhi(a1[k]);
            ssq[2 * k] += l0 * l0; ssq[2 * k + 1] += h0 * h0; ssq[8 + 2 * k] += l1 * l1; ssq[8 + 2 * k + 1] += h1 * h1; }
    }
#pragma unroll
    for (int k = 0; k < 16; ++k) { float s = ssq[k]; s += __shfl_xor(s, 1); s += __shfl_xor(s, 2); s += __shfl_xor(s, 4); s += __shfl_xor(s, 8); ssq[k] = rsqrtf(s * (1.0f / 128.0f) + EPS); }
    const float* gn = p.in[15];
#pragma unroll 1
    for (int nt = 0; nt < 8; ++nt) {
        const int dv = 16 * nt + fr; const float g = gn[dv];
        const u32x4 a0 = *(const u32x4*)(GO + (nt * 64 + lane) * 16), a1 = *(const u32x4*)(GO + (nt * 64 + lane) * 16 + 8);
        const bf16_t* gzp = PB + (size_t)(tok0 + 4 * fq) * PW + 2304 + h * 128 + dv; bf16_t* mp = PB + (size_t)(tok0 + 4 * fq) * PW + 512 + h * 128 + dv;
#pragma unroll
        for (int k = 0; k < 16; ++k) {
            const unsigned w = (k < 8) ? a0[(k >> 1) & 3] : a1[(k >> 1) & 3]; const float o = (k & 1) ? bfhi(w) : bflo(w);
            const int to = 16 * (k >> 2) + (k & 3);
            const float gz = bf2f(gzp[(size_t)to * PW]);
            mp[(size_t)to * PW] = f2bf(o * ssq[k] * g * silu(gz));
        }
    }
}

__device__ __forceinline__ void attn_unit(const Params& p, LAS unsigned char* lds, int unit) {
    const int tid = threadIdx.x, lane = tid & 63, wid = tid >> 6, fr = lane & 15, fq = lane >> 4;
    const int b = unit >> 7, blk = (unit >> 1) & 63, kvh = unit & 1;
    LAS bf16_t* Ks = (LAS bf16_t*)lds; LAS bf16_t* Vt = (LAS bf16_t*)(lds + 36864);
    bf16_t* PB = (bf16_t*)(p.ws + WS_H);
    __syncthreads();
#pragma unroll
    for (int i = 0; i < 4; ++i) {
        const int q = tid + 512 * i, row = q >> 3, ch = q & 7, tp = blk * 128 - 128 + row;
        u32x4 kv = (u32x4){0u, 0u, 0u, 0u}, vv = (u32x4){0u, 0u, 0u, 0u};
        if (tp >= 0) { const bf16_t* base = PB + (size_t)(b * SEQ + tp) * PW; kv = *(const u32x4*)(base + 512 + kvh * 64 + ch * 8); vv = *(const u32x4*)(base + 640 + kvh * 64 + ch * 8); }
        *(LAS u32x4*)(Ks + row * 72 + ch * 8) = kv;
#pragma unroll
        for (int e = 0; e < 4; ++e) { const unsigned w = vv[e]; Vt[(ch * 8 + 2 * e) * 264 + row] = (bf16_t)(w & 0xffffu); Vt[(ch * 8 + 2 * e + 1) * 264 + row] = (bf16_t)(w >> 16); }
    }
    __syncthreads();
    const int qtok = b * SEQ + blk * 128 + 16 * wid + fr;
#pragma unroll 1
    for (int g = 0; g < 4; ++g) {
        const int h = kvh * 4 + g; const float slope = exp2f(-(float)(h + 1)), sink = p.in[11][h];
        bf16x8 qf[2];
#pragma unroll
        for (int ks = 0; ks < 2; ++ks) qf[ks] = *(const bf16x8*)(PB + (size_t)qtok * PW + h * 64 + ks * 32 + 8 * fq);
        f32x4 s[10]; float mx = sink;
#pragma unroll
        for (int j = 0; j < 10; ++j) {
            const int ct = (wid + j) < 15 ? (wid + j) : 15;
            f32x4 acc = (f32x4){0.f, 0.f, 0.f, 0.f};
#pragma unroll
            for (int ks = 0; ks < 2; ++ks) acc = mfma16(*(const LAS bf16x8*)(Ks + (16 * ct + fr) * 72 + ks * 32 + 8 * fq), qf[ks], acc);
#pragma unroll
            for (int e = 0; e < 4; ++e) {
                const int c = 16 * (wid + j) + 4 * fq + e, dist = 16 * wid + fr - c + 128;
                const bool ok = (wid + j <= 15) && dist >= 0 && dist <= 128 && (blk * 128 + c - 128 >= 0);
                const float v = ok ? acc[e] * 0.125f - slope * (float)dist : -INFINITY;
                acc[e] = v; mx = fmaxf(mx, v);
            }
            s[j] = acc;
            asm volatile("" ::: "memory");
        }
        mx = fmaxf(mx, __shfl_xor(mx, 16)); mx = fmaxf(mx, __shfl_xor(mx, 32));
        float sum = 0.f;
#pragma unroll
        for (int j = 0; j < 10; ++j)
#pragma unroll
            for (int e = 0; e < 4; ++e) { const float pv = __expf(s[j][e] - mx); s[j][e] = pv; sum += pv; }
        sum += __shfl_xor(sum, 16); sum += __shfl_xor(sum, 32);
        sum += __expf(sink - mx);
        const float inv = 1.0f / sum;
        bf16x8 pb[5];
#pragma unroll
        for (int kk = 0; kk < 5; ++kk) { u32x4 w; w.x = cvt_pk(s[2 * kk][0] * inv, s[2 * kk][1] * inv); w.y = cvt_pk(s[2 * kk][2] * inv, s[2 * kk][3] * inv);
            w.z = cvt_pk(s[2 * kk + 1][0] * inv, s[2 * kk + 1][1] * inv); w.w = cvt_pk(s[2 * kk + 1][2] * inv, s[2 * kk + 1][3] * inv); pb[kk] = __builtin_bit_cast(bf16x8, w); }
#pragma unroll
        for (int dt = 0; dt < 4; ++dt) {
            f32x4 acc = (f32x4){0.f, 0.f, 0.f, 0.f};
#pragma unroll
            for (int kk = 0; kk < 5; ++kk) {
                const int c0 = (wid + 2 * kk) < 15 ? (wid + 2 * kk) : 15, c1 = (wid + 2 * kk + 1) < 15 ? (wid + 2 * kk + 1) : 15;
                const u32x2 lo = *(const LAS u32x2*)(Vt + (16 * dt + fr) * 264 + 16 * c0 + 4 * fq), hi = *(const LAS u32x2*)(Vt + (16 * dt + fr) * 264 + 16 * c1 + 4 * fq);
                const u32x4 a = (u32x4){lo.x, lo.y, hi.x, hi.y};
                acc = mfma16(__builtin_bit_cast(bf16x8, a), pb[kk], acc);
            }
            u32x2 w; w.x = cvt_pk(acc[0], acc[1]); w.y = cvt_pk(acc[2], acc[3]);
            *(u32x2*)(PB + (size_t)qtok * PW + h * 64 + 16 * dt + 4 * fq) = w;
            asm volatile("" ::: "memory");
        }
    }
}

__device__ __forceinline__ void sattn_unit(const Params& p, int s, int h, int lane) {
    const int kvh = h >> 2; const bool wr = (h & 3) == 0;
    bf16_t* PB = (bf16_t*)(p.ws + WS_H) + (size_t)(MPR + s) * PW;
    const float* ck = p.in[2] + (size_t)s * 128 * 128 + kvh * 64 + lane; const float* cv = p.in[3] + (size_t)s * 128 * 128 + kvh * 64 + lane;
    float* nk = p.out + O_KS + (size_t)s * 128 * 128 + kvh * 64 + lane; float* nv = p.out + O_VS + (size_t)s * 128 * 128 + kvh * 64 + lane;
    const float q = bf2f(PB[h * 64 + lane]) * 0.125f, slope = exp2f(-(float)(h + 1)), sink = p.in[11][h];
    const float knew = bf2f(PB[512 + kvh * 64 + lane]), vnew = bf2f(PB[640 + kvh * 64 + lane]);
    float sc[3];
#pragma unroll
    for (int t = 0; t < 2; ++t) {
#pragma unroll 8
        for (int jj = 0; jj < 64; ++jj) {
            const int j = t * 64 + jj; const float kval = ck[(size_t)j * 128];
            if (wr && j >= 1) nk[(size_t)(j - 1) * 128] = kval;
            const float d = wave_sum(q * kval) - slope * (float)(128 - j); if (lane == jj) sc[t] = d;
        }
    }
    if (wr) nk[(size_t)127 * 128] = knew;
    sc[2] = wave_sum(q * knew);
    const float mx = fmaxf(fmaxf(wave_max(fmaxf(sc[0], sc[1])), sc[2]), sink);
    const float p0 = __expf(sc[0] - mx), p1 = __expf(sc[1] - mx), p2 = __expf(sc[2] - mx);
    const float inv = 1.0f / (wave_sum(p0 + p1) + p2 + __expf(sink - mx));
    float o = p2 * vnew;
#pragma unroll 8
    for (int jj = 0; jj < 64; ++jj) { const float vval = cv[(size_t)jj * 128]; if (wr && jj >= 1) nv[(size_t)(jj - 1) * 128] = vval; o += __shfl(p0, jj) * vval; }
#pragma unroll 8
    for (int jj = 0; jj < 64; ++jj) { const float vval = cv[(size_t)(64 + jj) * 128]; if (wr) nv[(size_t)(63 + jj) * 128] = vval; o += __shfl(p1, jj) * vval; }
    if (wr) nv[(size_t)127 * 128] = vnew;
    asm volatile("" ::: "memory");
    PB[h * 64 + lane] = f2bf(o * inv);
}

__device__ __forceinline__ void sgdn_unit(const Params& p, LAS unsigned char* lds, int s) {
    const int tid = threadIdx.x, wid = tid >> 6, h = tid >> 7, dv = tid & 127;
    LAS float* qs = (LAS float*)lds; LAS float* ks = qs + 512; LAS float* red = ks + 512;
    bf16_t* PB = (bf16_t*)(p.ws + WS_H) + (size_t)(MPR + s) * PW; const float* GBA = (const float*)(p.ws + WS_GBA) + (size_t)(MPR + s) * 8;
    const float* cw = p.in[12]; const float* hc = p.in[4] + (size_t)s * 3 * CONVC; float* nc = p.out + O_CS + (size_t)s * 3 * CONVC;
    __syncthreads();
    float val[3];
#pragma unroll
    for (int i = 0; i < 3; ++i) {
        const int c = i * 512 + tid; const float x3 = bf2f(PB[768 + c]), h0 = hc[c], h1 = hc[CONVC + c], h2 = hc[2 * CONVC + c];
        val[i] = silu(cw[c] * h0 + cw[CONVC + c] * h1 + cw[2 * CONVC + c] * h2 + cw[3 * CONVC + c] * x3);
        nc[c] = h1; nc[CONVC + c] = h2; nc[2 * CONVC + c] = x3;
    }
    const float sq = wave_sum(val[0] * val[0]), sk = wave_sum(val[1] * val[1]);
    if ((tid & 63) == 0) { red[wid] = sq; red[8 + wid] = sk; }
    __syncthreads();
    const float ssq = red[2 * h] + red[2 * h + 1], ssk = red[8 + 2 * h] + red[8 + 2 * h + 1];
    qs[tid] = val[0] * rsqrtf(ssq + EPS) * 0.08838834764831845f; ks[tid] = val[1] * rsqrtf(ssk + EPS);
    __syncthreads();
    const float beta = 1.0f / (1.0f + __expf(-GBA[h]));
    const float x = GBA[4 + h] + p.in[14][h]; const float sp = x > 20.f ? x : log1pf(__expf(x));
    const float eg = __expf(-__expf(p.in[13][h]) * sp);
    const float* S0 = p.in[5] + ((size_t)(s * 4 + h) * 128) * 128 + dv; float* S1 = p.out + O_GS + ((size_t)(s * 4 + h) * 128) * 128 + dv;
    float kS = 0.f;
#pragma unroll 1
    for (int hf = 0; hf < 4; ++hf) { float sv[32];
#pragma unroll
        for (int dk = 0; dk < 32; ++dk) sv[dk] = S0[(size_t)(hf * 32 + dk) * 128];
#pragma unroll
        for (int dk = 0; dk < 32; ++dk) kS += ks[h * 128 + hf * 32 + dk] * sv[dk]; }
    const float delta = beta * (val[2] - eg * kS);
    float o = 0.f;
#pragma unroll 1
    for (int hf = 0; hf < 4; ++hf) { float sv[32];
#pragma unroll
        for (int dk = 0; dk < 32; ++dk) sv[dk] = S0[(size_t)(hf * 32 + dk) * 128];
#pragma unroll
        for (int dk = 0; dk < 32; ++dk) { const float nvv = eg * sv[dk] + ks[h * 128 + hf * 32 + dk] * delta; S1[(size_t)(hf * 32 + dk) * 128] = nvv; o += qs[h * 128 + hf * 32 + dk] * nvv; } }
    const float so = wave_sum(o * o);
    if ((tid & 63) == 0) red[16 + wid] = so;
    __syncthreads();
    const float tot = red[16 + 2 * h] + red[16 + 2 * h + 1];
    const float gz = bf2f(PB[2304 + tid]);
    PB[512 + tid] = f2bf(o * rsqrtf(tot * (1.0f / 128.0f) + EPS) * p.in[15][dv] * silu(gz));
}

#define XB_TMO      128
#define XB_XCNT(j)  (256  + 64 * (j))
#define XB_XSUB(j)  (1280 + 64 * (j))
#define XB_XGEN(j)  (2304 + 64 * (j))
#define XB_TOP      3328
#define XB_TOPGEN   3392
#define XCD_BAR_WORDS 3456
#define XB_SPIN_CAP (1u << 18)

__device__ __forceinline__ unsigned xb_ld(unsigned* p)              { return __hip_atomic_load(p, __ATOMIC_RELAXED, __HIP_MEMORY_SCOPE_AGENT); }
__device__ __forceinline__ unsigned xb_add(unsigned* p, unsigned v) { return __hip_atomic_fetch_add(p, v, __ATOMIC_RELAXED, __HIP_MEMORY_SCOPE_AGENT); }
__device__ __forceinline__ unsigned xb_xcc_id() { return (unsigned)__builtin_amdgcn_s_getreg((3 << 11) | 20) & 0xFu; }
#define XB_SPIN(cond, bar) do { unsigned _sp = 0; while (cond) { __builtin_amdgcn_s_sleep(1); \
    if ((++_sp & 255u) == 0u) { if (xb_ld(&(bar)[XB_TMO])) break; if (_sp > XB_SPIN_CAP) { atomicAdd(&(bar)[XB_TMO], 1u); break; } } } } while (0)

struct XcdBarrier {
    unsigned* bar; unsigned x;
    volatile LAS unsigned* st;
};

__device__ __forceinline__ XcdBarrier xcd_barrier_post(unsigned* bar, volatile LAS unsigned* st) {
    XcdBarrier b; b.bar = bar; b.x = xb_xcc_id(); b.st = st;
    if (threadIdx.x == 0) (void)xb_add(&bar[XB_XCNT(b.x)], 1u);
    return b;
}
__device__ __forceinline__ void xcd_barrier_complete(unsigned* bar, unsigned x, unsigned& nloc, unsigned& nx) {
    const unsigned G = gridDim.x * gridDim.y * gridDim.z;
    unsigned sum, cnt, mine, sp = 0u;
    for (;;) {
        sum = 0u; cnt = 0u; mine = 0u;
#pragma unroll
        for (unsigned j = 0; j < 16; ++j) { const unsigned c = xb_ld(&bar[XB_XCNT(j)]); sum += c; cnt += (c > 0u) ? 1u : 0u; mine = (j == x) ? c : mine; }
        if (sum == G) break;
        __builtin_amdgcn_s_sleep(1);
        if ((++sp & 255u) == 0u) { if (xb_ld(&bar[XB_TMO])) break; if (sp > XB_SPIN_CAP) { atomicAdd(&bar[XB_TMO], 1u); break; } }
    }
    nloc = mine > 0u ? mine : 1u; nx = cnt > 0u ? cnt : 1u;
}

__device__ __forceinline__ void xcd_barrier(const XcdBarrier& b) {
    asm volatile("s_waitcnt vmcnt(0)" ::: "memory");
    __syncthreads();
    if (threadIdx.x == 0) {
        unsigned* bar = b.bar;
        __builtin_amdgcn_s_waitcnt(0);
        unsigned nloc = b.st[0], nx = b.st[1];
        if (nloc == 0u) { xcd_barrier_complete(bar, b.x, nloc, nx); b.st[0] = nloc; b.st[1] = nx; }
        const unsigned old = xb_add(&bar[XB_XSUB(b.x)], 1u);
        const unsigned gen = old / nloc;
        if (old + 1u == (gen + 1u) * nloc) {
            __builtin_amdgcn_fence(__ATOMIC_RELEASE, "agent");
            asm volatile("s_waitcnt vmcnt(0)" ::: "memory");
            const unsigned og = xb_add(&bar[XB_TOP], 1u);
            const unsigned tg = og / nx;
            if (og + 1u == (tg + 1u) * nx) xb_add(&bar[XB_TOPGEN], 1u);
            else XB_SPIN(xb_ld(&bar[XB_TOPGEN]) == tg, bar);
            __builtin_amdgcn_fence(__ATOMIC_ACQUIRE, "agent");
            xb_add(&bar[XB_XGEN(b.x)], 1u);
            asm volatile("s_waitcnt vmcnt(0)" ::: "memory");
        } else {
            XB_SPIN(xb_ld(&bar[XB_XGEN(b.x)]) == gen, bar);
            __builtin_amdgcn_fence(__ATOMIC_ACQUIRE, "agent");
            asm volatile("s_waitcnt vmcnt(0)" ::: "memory");
        }
    }
    __syncthreads();
}

__global__ void __launch_bounds__(512, 2) fwd_kernel(Params p, int ph_lo, int ph_hi) {
    extern __shared__ __attribute__((aligned(16))) unsigned char lds_raw[];
    LAS unsigned char* lds = (LAS unsigned char*)lds_raw;
    cg::grid_group grid = cg::this_grid();
    if (ph_lo < 0) grid.sync();
    volatile LAS unsigned* bst = (volatile LAS unsigned*)(lds + LDS_PHASE_BYTES);
    if (threadIdx.x < 2) bst[threadIdx.x] = 0u;
    __syncthreads();
    XcdBarrier xbar; xbar.bar = (unsigned*)(p.ws + WS_CTL + CTL_BAR); xbar.x = 0; xbar.st = bst;
    if (ph_hi - ph_lo > 1) xbar = xcd_barrier_post((unsigned*)(p.ws + WS_CTL + CTL_BAR), bst);
    const int tid = threadIdx.x, lane = tid & 63, wid = tid >> 6, G = gridDim.x, bx = blockIdx.x;
    unsigned char* ws = p.ws;
    bf16_t* XN = (bf16_t*)(ws + WS_XN); bf16_t* XN2 = (bf16_t*)(ws + WS_XN2); bf16_t* HB = (bf16_t*)(ws + WS_H);
    float* SS1 = (float*)(ws + WS_SSP1); float* SS2 = (float*)(ws + WS_SSP2);
    float* Y = p.out; bf16_t* X3b = (bf16_t*)(ws + WS_GM);
#ifndef PHMASK
#define PHMASK 0x7ff
#endif
#define IN(k) (((PHMASK >> (k)) & 1) && ph_lo <= (k) && (k) < ph_hi)
#define SEAM(k) do { if (IN(k) && IN((k) + 1)) { xcd_barrier(xbar); }     } while (0)

    if (IN(0)) p0_prologue(p, lds, bx, G);
    SEAM(0);
    if (IN(1)) {
        if (bx < 176) sk_ffn_in<false>(XN, (const bf16_t*)(ws + WS_W1IN), HB, bx, wid, lane & 15, lane >> 4, lds);
        pg8::Gemm g{XN, (const bf16_t*)(ws + WS_W1IN), MPR, 2 * DFF, DM, DM}; pg8::StaticOrder S; S.init(MPR, 2 * DFF, G, bx);
        EpiSwiglu E{HB, nullptr}; pg8::gemm_phase<EpiSwiglu, pg8::StaticOrder, GEMM_ALIGN, GEMM_SP2>(lds, g, S, E);
    }
    SEAM(1);
    if (IN(2)) {
        if (bx < 64) sk_ffn_out<false>(HB, (const bf16_t*)(ws + WS_W1OUT), p.in[1], nullptr, XN + (size_t)MPR * DM, bx, wid, lane & 15, lane >> 4, lds);
        pg8::Gemm g{HB, (const bf16_t*)(ws + WS_W1OUT), MPR, DM, DFF, DFF}; pg8::StaticOrder S; S.init(MPR, DM, G, bx);
        EpiResid<false, false, true, true, true> E{p.in[0], p.in[1], nullptr, XN, SS1}; pg8::gemm_phase<EpiResid<false, false, true, true, true>, pg8::StaticOrder, GEMM_ALIGN, GEMM_SP2>(lds, g, S, E);
    }
    SEAM(2);
    if (IN(3)) {
        if (bx < 89) sk_inproj(XN, (const bf16_t*)(ws + WS_WINMIX), HB, (float*)(ws + WS_GBA), bx, wid, lane & 15, lane >> 4, lds);
        pg8::Gemm g{XN, (const bf16_t*)(ws + WS_WINMIX), MPR, NINP, DM, DM}; pg8::StaticOrder S; S.init(MPR, NINP, G, bx);
        EpiInproj E{HB, (float*)(ws + WS_GBA), SS1}; pg8::gemm_phase<EpiInproj, pg8::StaticOrder, GEMM_ALIGN, GEMM_SP2>(lds, g, S, E);
    }
    SEAM(3);
    if (IN(4)) {
        for (int u = bx; u < 2048; u += G) gdn_prep_unit(p, lds, u);
    }
    SEAM(4);
    if (IN(5)) {
        if (bx < NSCAN) gdn_scan(p, lds, bx);
        else {
            const int ab = bx - NSCAN, NAB = G - NSCAN;
            if (NAB == 192) {
                if (ab < 128) { sattn_unit(p, ab, wid, lane); sgdn_unit(p, lds, ab); attn_unit(p, lds, 2 * ab); attn_unit(p, lds, 2 * ab + 1); }
                else { for (int k = 0; k < 4; ++k) attn_unit(p, lds, 256 + (ab - 128) * 4 + k); }
            } else {
                int it = ab;
#pragma unroll 1
                for (; it < 512; it += NAB) attn_unit(p, lds, it);
#pragma unroll 1
                for (; it < 640; it += NAB) { sattn_unit(p, it - 512, wid, lane); sgdn_unit(p, lds, it - 512); }
            }
            const bf16_t* PB = HB;
            for (int idx = ab * 512 + tid; idx < 149504; idx += NAB * 512) {
                if (idx < 131072) { const int w = idx >> 16, r = idx & 65535, b = r >> 14, j = (r >> 7) & 127, c = r & 127;
                    p.out[(w ? O_VP : O_KP) + r] = bf2f(PB[(size_t)(b * SEQ + SEQ - 128 + j) * PW + 512 + w * 128 + c]);
                } else { const int r = idx - 131072, b = r / (3 * CONVC), q = r % (3 * CONVC), rr = q / CONVC, c = q % CONVC;
                    p.out[O_CP + r] = bf2f(PB[(size_t)(b * SEQ + SEQ - 3 + rr) * PW + 768 + c]); }
            }
        }
    }
    SEAM(5);
    if (IN(6)) {
        for (int u = bx * 8 + wid; u < 2048; u += G * 8) gdn_gate_unit(p, u, lane);
    }
    SEAM(6);
#ifdef DBG_DUMP
    if (ph_lo == 11) {
        const float* src = (const float*)(ws + DBG_SRC);
        for (size_t i = (size_t)bx * 512 + tid; i < (size_t)MREAL * DM; i += (size_t)G * 512) Y[i] = (i < (size_t)MREAL * 8) ? ((const float*)(ws + WS_GBA))[i] : 0.f;
    }
#endif
    if (IN(7)) {
        if (bx < 32) sk_outproj(HB, (const bf16_t*)(ws + WS_WOUTMIX), XN, nullptr, XN2, bx, wid, lane & 15, lane >> 4, lds);
        pg8::Gemm g{HB, (const bf16_t*)(ws + WS_WOUTMIX), MPR, DM, DM, PW}; pg8::StaticOrder S; S.init(MPR, DM, G, bx);
        EpiResid<true, false, true, true, false> E{XN, XN + (size_t)MPR * DM, nullptr, XN2, SS2}; pg8::gemm_phase<EpiResid<true, false, true, true, false>, pg8::StaticOrder, GEMM_ALIGN, GEMM_SP2>(lds, g, S, E);
    }
    SEAM(7);
    if (IN(8)) {
        if (bx < 176) sk_ffn_in<true>(XN2, (const bf16_t*)(ws + WS_W2IN), HB, bx, wid, lane & 15, lane >> 4, lds);
        pg8::Gemm g{XN2, (const bf16_t*)(ws + WS_W2IN), MPR, 2 * DFF, DM, DM}; pg8::StaticOrder S; S.init(MPR, 2 * DFF, G, bx);
        EpiSwiglu E{HB, SS2}; pg8::gemm_phase<EpiSwiglu, pg8::StaticOrder, GEMM_ALIGN, GEMM_SP2>(lds, g, S, E);
    }
    SEAM(8);
    if (IN(9)) {
        if (bx < 64) sk_ffn_out<true>(HB, (const bf16_t*)(ws + WS_W2OUT), (const float*)(XN2 + (size_t)MPR * DM), nullptr, X3b + (size_t)MPR * DM, bx, wid, lane & 15, lane >> 4, lds);
        pg8::Gemm g{HB, (const bf16_t*)(ws + WS_W2OUT), MPR, DM, DFF, DFF}; pg8::StaticOrder S; S.init(MPR, DM, G, bx);
        EpiResid<true, false, true, false, true> E{XN2, XN2 + (size_t)MPR * DM, nullptr, X3b, nullptr}; pg8::gemm_phase<EpiResid<true, false, true, false, true>, pg8::StaticOrder, GEMM_ALIGN, GEMM_SP2>(lds, g, S, E);
    }
    SEAM(9);
    if (IN(10)) {
        const float* gf = p.in[20]; f32x4 gv[4];
#pragma unroll
        for (int j = 0; j < 4; ++j) gv[j] = *((const f32x4*)gf + lane + 64 * j);
        {
            f32x4 v[4], vn[4]; int m = bx * 8 + wid;
            if (m < MREAL) { const u32x2* xr = (const u32x2*)(X3b + (size_t)m * DM) + lane;
#pragma unroll
                for (int j = 0; j < 4; ++j) { const u32x2 w = xr[64 * j]; v[j] = (f32x4){bflo(w.x), bfhi(w.x), bflo(w.y), bfhi(w.y)}; } }
            for (; m < MREAL; m += G * 8) {
                const int mn = m + G * 8;
                if (mn < MREAL) { const u32x2* xr = (const u32x2*)(X3b + (size_t)mn * DM) + lane;
#pragma unroll
                    for (int j = 0; j < 4; ++j) { const u32x2 w = xr[64 * j]; vn[j] = (f32x4){bflo(w.x), bfhi(w.x), bflo(w.y), bfhi(w.y)}; } }
                float s = 0.f;
#pragma unroll
                for (int j = 0; j < 4; ++j) s += (v[j][0] * v[j][0] + v[j][1] * v[j][1]) + (v[j][2] * v[j][2] + v[j][3] * v[j][3]);
                const float rstd = rsqrtf(wave_sum(s) * (1.0f / DM) + EPS);
                f32x4* yr = (f32x4*)(Y + (size_t)m * DM) + lane;
#pragma unroll
                for (int j = 0; j < 4; ++j) yr[64 * j] = v[j] * rstd * gv[j];
#pragma unroll
                for (int j = 0; j < 4; ++j) v[j] = vn[j];
            }
        }
    }
#undef IN
#undef SEAM
}
}

#ifndef MK_N_LAUNCHES
#define MK_N_LAUNCHES 1
#endif
extern "C" void kernel_launch(void* const* d_in, const int* in_sizes, int n_in, void* d_out, int out_size, void* d_ws, size_t ws_size, hipStream_t stream) {
    static int grid = 0;
    if (grid == 0) {
        if (n_in != 21 || ws_size < mk::WS_END || out_size != 47269888) { fprintf(stderr, "kernel_launch: unexpected shapes (n_in %d, ws %zu, out %d)\n", n_in, ws_size, out_size); grid = -1; return; }
        int dev = 0, cus = 0, per_cu = 0;
        (void)hipGetDevice(&dev); (void)hipDeviceGetAttribute(&cus, hipDeviceAttributeMultiprocessorCount, dev);
        if (hipFuncSetAttribute((const void*)mk::fwd_kernel, hipFuncAttributeMaxDynamicSharedMemorySize, mk::LDS_BYTES) != hipSuccess) { fprintf(stderr, "kernel_launch: hipFuncSetAttribute failed\n"); grid = -1; return; }
        if (hipOccupancyMaxActiveBlocksPerMultiprocessor(&per_cu, (const void*)mk::fwd_kernel, 512, mk::LDS_BYTES) != hipSuccess || per_cu < 1) { fprintf(stderr, "kernel_launch: occupancy query failed (%d)\n", per_cu); per_cu = 1; }
        (void)hipGetLastError();
        grid = cus * per_cu;
        if (grid <= mk::NSCAN) { fprintf(stderr, "kernel_launch: grid %d too small\n", grid); grid = -1; return; }
    }
    if (grid < 0) return;
    (void)hipMemsetAsync((char*)d_ws + mk::WS_CTL + mk::CTL_BAR, 0, mk::CTL_BAR_BYTES, stream);
    mk::Params p{};
    for (int i = 0; i < 21; ++i) p.in[i] = (const float*)d_in[i];
    p.out = (float*)d_out; p.ws = (unsigned char*)d_ws;
#if MK_N_LAUNCHES == 1
    int lo = 0, hi = 11; void* args[] = {&p, &lo, &hi};
    hipError_t e = hipLaunchCooperativeKernel((const void*)mk::fwd_kernel, dim3(grid), dim3(512), args, mk::LDS_BYTES, stream);
    if (e != hipSuccess) fprintf(stderr, "kernel_launch: cooperative launch failed: %s (grid %d)\n", hipGetErrorString(e), grid);
#else
#ifndef MK_LAST
#define MK_LAST 11
#ifndef MK_DOUBLE
#define MK_DOUBLE 0x0
#endif
#define DBG_C0 512
#define DBG_C1 1024
#endif
    for (int ph = 0; ph < MK_LAST; ++ph) { const int reps = ((MK_DOUBLE >> ph) & 1) ? 2 : 1; for (int r = 0; r < reps; ++r) hipLaunchKernelGGL(mk::fwd_kernel, dim3(grid), dim3(512), mk::LDS_BYTES, stream, p, ph, ph + 1); }
#ifdef DBG_DUMP
    hipLaunchKernelGGL(mk::fwd_kernel, dim3(grid), dim3(512), mk::LDS_BYTES, stream, p, 11, 12);
#endif
#endif
}
```

```cpp
#include <hip/hip_runtime.h>
#include <hip/hip_cooperative_groups.h>
#include <cstdio>
namespace cg = cooperative_groups;
namespace pg8 {
#define PG8_LAS __attribute__((address_space(3)))
typedef unsigned short bf16_t;
typedef short bf16x8 __attribute__((ext_vector_type(8)));
typedef float f32x4 __attribute__((ext_vector_type(4)));
typedef unsigned u32x4 __attribute__((ext_vector_type(4)));
constexpr int BM = 256, BK = 64, HALF = 128, HTB = HALF * BK * 2  , STAGE_BYTES = 8 * HTB, NXCD = 8, WGM = 4;

__host__ __device__ __forceinline__ int lds_byte(int r, int c) { const int st = (r >> 4) * 2 + (c >> 5), rr = r & 15, cc = c & 31, ob = rr * 64 + cc * 2; return st * 1024 + (ob ^ (((ob >> 9) & 1) << 5)); }
__host__ __device__ __forceinline__ void stage_rc(int b, int& R, int& C) { const int st = b / 1024, sb = b % 1024, swz = sb ^ (((sb >> 9) & 1) << 5); R = (st >> 1) * 16 + swz / 64; C = (st & 1) * 32 + (swz % 64) / 2; }
__host__ __device__ __forceinline__ int perm32(int rho) { const int n = rho >> 4, i = rho & 15; return 8 * (i >> 2) + 4 * n + (i & 3); }

struct Unit { int pm, pn; };
struct Gemm { const bf16_t* A; const bf16_t* Bt; int M, N, K, lda; };

struct StaticOrder {
    int nM, nN, nwg, G, c, wgm;
    __host__ __device__ void init(int M, int N, int G_, int c_, int wgm_ = WGM) { nM = M / BM; nN = N / BM; nwg = nM * nN; G = G_; c = c_; wgm = wgm_; }
    __host__ __device__ bool next(int i, Unit& u) const {
        const long L = (long)i * G + c; if (L >= nwg) return false;
        int wgid = (int)L; { const int q = nwg / NXCD, r = nwg % NXCD, xcd = wgid % NXCD, off = wgid / NXCD; wgid = (xcd < r ? xcd * (q + 1) : r * (q + 1) + (xcd - r) * q) + off; }
        const int nig = wgm * nN, gid = wgid / nig, fm = gid * wgm, gsz = (nM - fm) < wgm ? (nM - fm) : wgm;
        u.pm = fm + ((wgid % nig) % gsz); u.pn = (wgid % nig) / gsz; return true;
    }
    __device__ __forceinline__ void a_ready(const Unit&) const {}
    __device__ __forceinline__ void done(const Unit&) const {}
};

__device__ __forceinline__ unsigned cvt_pk_bf16(float lo, float hi) { unsigned r; asm volatile("v_cvt_pk_bf16_f32 %0, %1, %2" : "=v"(r) : "v"(lo), "v"(hi)); return r; }
typedef float f32x2 __attribute__((ext_vector_type(2)));
__device__ __forceinline__ f32x2 gelu_pk(f32x2 v) {
    const f32x2 av = __builtin_elementwise_abs(v), d = av * 0.2316418882f + 1.0f;
    f32x2 t; t.x = __builtin_amdgcn_rcpf(d.x); t.y = __builtin_amdgcn_rcpf(d.y);
    f32x2 q = t * 0.5307027145f + (-0.7265760135f); q = q * t + 0.7107068705f; q = q * t + (-0.142248368f); q = q * t + 0.127414796f; q = q * t;
    const f32x2 s = (v * v) * (-0.72134752044f);
    f32x2 e; e.x = __builtin_amdgcn_exp2f(s.x); e.y = __builtin_amdgcn_exp2f(s.y);
    const f32x2 m = v * (q * e), r = v - m;
    f32x2 o; o.x = v.x < 0.f ? m.x : r.x; o.y = v.y < 0.f ? m.y : r.y; return o;
}

template <int ACT  > struct EpiBf16 {
    static constexpr bool PERM = true, AFTER_DRAIN = false; static_assert(ACT == 0 || ACT == 1, "EpiBf16: ACT is 0 (none) or 1 (gelu_pk)");
    bf16_t* O; int ldc; const float* bias; int split_cols; size_t split_stride; float scale0;
    __device__ __forceinline__ void operator()(const f32x4 (&acc)[2][2][4][2], const Unit& u, int wr, int wc, int fr, int fq) const {
        const int row0 = u.pm * BM + wr * 64 + fr; int colt = u.pn * BM; bf16_t* base = O;
        float sc = 1.f; if (split_cols) { const int t = colt / split_cols; base += (size_t)t * split_stride; colt -= t * split_cols; if (t == 0) sc = scale0; }
        const int col0 = colt + wc * 32 + 8 * fq, bcol0 = u.pn * BM + wc * 32 + 8 * fq;
        f32x4 bv[2][2];
#pragma unroll
        for (int bj = 0; bj < 2; ++bj)
#pragma unroll
            for (int n = 0; n < 2; ++n) bv[bj][n] = bias ? *(const f32x4*)(bias + bcol0 + bj * HALF + 4 * n) : (f32x4){0.f, 0.f, 0.f, 0.f};
#pragma unroll
        for (int ai = 0; ai < 2; ++ai)
#pragma unroll
            for (int m = 0; m < 4; ++m) { bf16_t* rowp = base + (size_t)(row0 + ai * HALF + m * 16) * ldc + col0;
#pragma unroll
                for (int bj = 0; bj < 2; ++bj) { f32x4 v0 = acc[ai][bj][m][0] + bv[bj][0], v1 = acc[ai][bj][m][1] + bv[bj][1];
                    if (ACT == 1) { f32x2 a = gelu_pk((f32x2){v0[0], v0[1]}), b = gelu_pk((f32x2){v0[2], v0[3]}), c = gelu_pk((f32x2){v1[0], v1[1]}), d = gelu_pk((f32x2){v1[2], v1[3]});
                        v0 = (f32x4){a.x, a.y, b.x, b.y}; v1 = (f32x4){c.x, c.y, d.x, d.y}; }
                    v0 = v0 * sc; v1 = v1 * sc; u32x4 w; w.x = cvt_pk_bf16(v0[0], v0[1]); w.y = cvt_pk_bf16(v0[2], v0[3]); w.z = cvt_pk_bf16(v1[0], v1[1]); w.w = cvt_pk_bf16(v1[2], v1[3]);
                    *(u32x4*)(rowp + bj * HALF) = w; } }
    }
};

struct PanelStats {
    unsigned* xbuf;
    unsigned* cnt;
    unsigned* tmo;
    int ntn; float eps;
    unsigned code;
    __device__ __forceinline__ bool run(const f32x4 (&v)[2][2][4][2], const Unit& u, int wr, int wc, int fr, int fq, PG8_LAS unsigned char* lds, int wid, int lane) const {
        typedef float f32x2v __attribute__((ext_vector_type(2)));
        PG8_LAS f32x2v* P = (PG8_LAS f32x2v*)lds;
        PG8_LAS f32x2v* S = (PG8_LAS f32x2v*)(lds + 8192);
        PG8_LAS unsigned* flag = (PG8_LAS unsigned*)(lds + 8192 + 2048);
#pragma unroll
        for (int ai = 0; ai < 2; ++ai)
#pragma unroll
            for (int m = 0; m < 4; ++m) {
                float s = 0.f;
#pragma unroll
                for (int bj = 0; bj < 2; ++bj)
#pragma unroll
                    for (int n = 0; n < 2; ++n) { const f32x4 x = v[ai][bj][m][n]; s += (x[0] + x[1]) + (x[2] + x[3]); }
                s += __shfl_xor(s, 16); s += __shfl_xor(s, 32);
                const float mw = s * (1.0f / 64.0f); float q = 0.f;
#pragma unroll
                for (int bj = 0; bj < 2; ++bj)
#pragma unroll
                    for (int n = 0; n < 2; ++n) { const f32x4 d = v[ai][bj][m][n] - mw; q += (d[0] * d[0] + d[1] * d[1]) + (d[2] * d[2] + d[3] * d[3]); }
                q += __shfl_xor(q, 16); q += __shfl_xor(q, 32);
                if (fq == 0) P[(ai * HALF + wr * 64 + m * 16 + fr) * 4 + wc] = (f32x2v){mw, q};
            }
        asm volatile("s_waitcnt lgkmcnt(0)" ::: "memory"); __builtin_amdgcn_s_barrier(); asm volatile("" ::: "memory");
#if defined(BROKEN_EXCHANGE_NO_WAIT)
#warning BROKEN CONTROL BUILD: the row-statistics exchange does not wait; results are wrong by design
        if (blockIdx.x >= 64) { const long long t0_ = clock64(); while (clock64() - t0_ < 60000) __builtin_amdgcn_s_sleep(8); }
#endif
        const int row = wid * 32 + (lane & 31);
        if (lane < 32) {
            const f32x2v a = P[row * 4 + 0], b = P[row * 4 + 1], c = P[row * 4 + 2], d = P[row * 4 + 3];
            const float mt = (a.x + b.x + c.x + d.x) * 0.25f;
            const float da = a.x - mt, db = b.x - mt, dc = c.x - mt, dd = d.x - mt;
            const float m2 = (a.y + b.y) + (c.y + d.y) + 64.0f * ((da * da + db * db) + (dc * dc + dd * dd));
            unsigned long long* slot = (unsigned long long*)xbuf + ((size_t)(u.pm * BM + row) * 4 + u.pn);
            __hip_atomic_store(slot, ((unsigned long long)__float_as_uint(m2) << 32) | __float_as_uint(mt), __ATOMIC_RELAXED, __HIP_MEMORY_SCOPE_AGENT);
        }
        asm volatile("s_waitcnt vmcnt(0)" ::: "memory");
        if (lane == 0) __hip_atomic_fetch_add(cnt + 64 * u.pm, 1u, __ATOMIC_RELAXED, __HIP_MEMORY_SCOPE_AGENT);
        if (wid == 0) {
            bool dead = false; const unsigned long long t0 = __builtin_amdgcn_s_memrealtime(); const unsigned want = 8u * (unsigned)ntn;
            for (;;) {
#if defined(BROKEN_EXCHANGE_NO_WAIT)
                break;
#endif
                if ((unsigned)__builtin_amdgcn_readfirstlane(__hip_atomic_load(cnt + 64 * u.pm, __ATOMIC_RELAXED, __HIP_MEMORY_SCOPE_AGENT)) >= want) break;
                if (__builtin_amdgcn_s_memrealtime() - t0 > 2000000ull) {
                    if (lane == 0) { unsigned expect = 0u; __hip_atomic_compare_exchange_strong(tmo + 1, &expect, code | (unsigned)(u.pm & 0xff), __ATOMIC_RELAXED, __ATOMIC_RELAXED, __HIP_MEMORY_SCOPE_AGENT);
                                     __hip_atomic_store(tmo, 1u, __ATOMIC_RELAXED, __HIP_MEMORY_SCOPE_AGENT); }
                    dead = true; break; }
                __builtin_amdgcn_s_sleep(2);
            }
            __builtin_amdgcn_fence(__ATOMIC_ACQUIRE, "agent");
            if (lane == 0) flag[0] = dead ? 1u : 0u;
        }
        asm volatile("s_waitcnt vmcnt(0) lgkmcnt(0)" ::: "memory"); __builtin_amdgcn_s_barrier(); asm volatile("" ::: "memory");
        const bool bad = flag[0] != 0u;
        if (lane < 32) {
            const unsigned long long* slot = (const unsigned long long*)xbuf + (size_t)(u.pm * BM + row) * 4; float mt[4], m2[4]; float ms = 0.f;
#pragma unroll
            for (int t = 0; t < 4; ++t) { if (t < ntn) { const unsigned long long w = __hip_atomic_load(slot + t, __ATOMIC_RELAXED, __HIP_MEMORY_SCOPE_AGENT); mt[t] = __uint_as_float((unsigned)w); m2[t] = __uint_as_float((unsigned)(w >> 32)); } else { mt[t] = 0.f; m2[t] = 0.f; } ms += mt[t]; }
            const float mean = ms / (float)ntn; float q = 0.f;
#pragma unroll
            for (int t = 0; t < 4; ++t) if (t < ntn) { const float dm = mt[t] - mean; q += m2[t] + 256.0f * dm * dm; }
            S[row] = (f32x2v){mean, 1.0f / sqrtf(q / (256.0f * (float)ntn) + eps)};
        }
        asm volatile("s_waitcnt lgkmcnt(0)" ::: "memory"); __builtin_amdgcn_s_barrier(); asm volatile("" ::: "memory");
        return bad;
    }
};
struct EpiLnRes {
    static constexpr bool PERM = false, AFTER_DRAIN = true;
    const float* base; float* out; int ldc; const float* bias; PanelStats st; unsigned poison;
    __device__ __forceinline__ void fused(f32x4 (&acc)[2][2][4][2], const Unit& u, int wr, int wc, int fr, int fq, PG8_LAS unsigned char* lds, int wid, int lane) const {
        typedef float f32x2v __attribute__((ext_vector_type(2)));
        const PG8_LAS f32x2v* S = (const PG8_LAS f32x2v*)(lds + 8192);
        const int col0 = u.pn * BM + wc * 32 + 4 * fq;
#pragma unroll
        for (int bj = 0; bj < 2; ++bj)
#pragma unroll
            for (int n = 0; n < 2; ++n) { const f32x4 bv = bias ? *(const f32x4*)(bias + col0 + bj * HALF + n * 16) : (f32x4){0.f, 0.f, 0.f, 0.f};
#pragma unroll
                for (int ai = 0; ai < 2; ++ai)
#pragma unroll
                    for (int m = 0; m < 4; ++m) acc[ai][bj][m][n] += bv; }
        f32x4 pre[4][2][2];
#pragma unroll
        for (int m = 0; m < 4; ++m) { const size_t off = (size_t)(u.pm * BM + wr * 64 + m * 16 + fr) * ldc + col0;
#pragma unroll
            for (int bj = 0; bj < 2; ++bj)
#pragma unroll
                for (int n = 0; n < 2; ++n) pre[m][bj][n] = *(const f32x4*)(base + off + bj * HALF + n * 16); }
        const bool bad = st.run(acc, u, wr, wc, fr, fq, lds, wid, lane) || poison != 0u;
        const float qnan = __builtin_nanf("");
#pragma unroll
        for (int ai = 0; ai < 2; ++ai)
#pragma unroll
            for (int m = 0; m < 4; ++m) { const int r = ai * HALF + wr * 64 + m * 16 + fr; const f32x2v sr = S[r]; const size_t off = (size_t)(u.pm * BM + r) * ldc + col0;
#pragma unroll
                for (int bj = 0; bj < 2; ++bj)
#pragma unroll
                    for (int n = 0; n < 2; ++n) { const f32x4 bs = ai == 0 ? pre[m][bj][n] : *(const f32x4*)(base + off + bj * HALF + n * 16); f32x4 o = bs + (acc[ai][bj][m][n] - sr.x) * sr.y;
                        if (bad) o = (f32x4){qnan, qnan, qnan, qnan}; *(f32x4*)(out + off + bj * HALF + n * 16) = o; }
                if (m & 1) asm volatile("" ::: "memory"); }
    }
};
struct EpiLnResLn {
    static constexpr bool PERM = false, AFTER_DRAIN = true;
    const float* base; float* out; bf16_t* xn; int ldc; const float* bias; PanelStats st1, st2; unsigned poison;
    __device__ __forceinline__ void fused(f32x4 (&acc)[2][2][4][2], const Unit& u, int wr, int wc, int fr, int fq, PG8_LAS unsigned char* lds, int wid, int lane) const {
        typedef float f32x2v __attribute__((ext_vector_type(2))); typedef unsigned u32x2v __attribute__((ext_vector_type(2)));
        const PG8_LAS f32x2v* S = (const PG8_LAS f32x2v*)(lds + 8192);
        const int col0 = u.pn * BM + wc * 32 + 4 * fq;
#pragma unroll
        for (int bj = 0; bj < 2; ++bj)
#pragma unroll
            for (int n = 0; n < 2; ++n) { const f32x4 bv = bias ? *(const f32x4*)(bias + col0 + bj * HALF + n * 16) : (f32x4){0.f, 0.f, 0.f, 0.f};
#pragma unroll
                for (int ai = 0; ai < 2; ++ai)
#pragma unroll
                    for (int m = 0; m < 4; ++m) acc[ai][bj][m][n] += bv; }
        bool bad = st1.run(acc, u, wr, wc, fr, fq, lds, wid, lane) || poison != 0u;
        const float qnan = __builtin_nanf("");
#pragma unroll
        for (int ai = 0; ai < 2; ++ai)
#pragma unroll
            for (int m = 0; m < 4; ++m) { const int r = ai * HALF + wr * 64 + m * 16 + fr; const f32x2v sr = S[r]; const size_t off = (size_t)(u.pm * BM + r) * ldc + col0;
#pragma unroll
                for (int bj = 0; bj < 2; ++bj)
#pragma unroll
                    for (int n = 0; n < 2; ++n) { const f32x4 bs = *(const f32x4*)(base + off + bj * HALF + n * 16); acc[ai][bj][m][n] = bs + (acc[ai][bj][m][n] - sr.x) * sr.y; }
                asm volatile("" : "+v"(acc[ai][0][m][0]), "+v"(acc[ai][0][m][1]), "+v"(acc[ai][1][m][0]), "+v"(acc[ai][1][m][1]));
                if (m & 1) asm volatile("" ::: "memory"); }
        const bool bad1 = bad;
        bad = st2.run(acc, u, wr, wc, fr, fq, lds, wid, lane) || bad;
#pragma unroll
        for (int ai = 0; ai < 2; ++ai)
#pragma unroll
            for (int m = 0; m < 4; ++m) { const int r = ai * HALF + wr * 64 + m * 16 + fr; const f32x2v sr = S[r]; const size_t off = (size_t)(u.pm * BM + r) * ldc + col0;
#pragma unroll
                for (int bj = 0; bj < 2; ++bj)
#pragma unroll
                    for (int n = 0; n < 2; ++n) { const f32x4 x1 = acc[ai][bj][m][n]; *(f32x4*)(out + off + bj * HALF + n * 16) = bad1 ? (f32x4){qnan, qnan, qnan, qnan} : x1;
                        const f32x4 o = (x1 - sr.x) * sr.y; u32x2v w; w.x = cvt_pk_bf16(o[0], o[1]); w.y = cvt_pk_bf16(o[2], o[3]);
                        if (bad) { w.x = 0x7fc07fc0u; w.y = 0x7fc07fc0u; } *(u32x2v*)(xn + off + bj * HALF + n * 16) = w; }
                asm volatile("" ::: "memory"); }
    }
};

template <class Epi, class Sched, bool ALIGN_EPI = false, bool SP2 = false>
__device__ __forceinline__ void gemm_phase(PG8_LAS unsigned char* lds, const Gemm g, const Sched S, const Epi E) {
    const int tid = threadIdx.x, wid = __builtin_amdgcn_readfirstlane(tid >> 6), lane = tid & 63, wr = wid >> 2, wc = wid & 3, fr = lane & 15, fq = lane >> 4;
    const int K = g.K, nt = K / BK;
    unsigned voffA[2], voffB[2];
#pragma unroll
    for (int i = 0; i < 2; ++i) { int R, C; stage_rc(tid * 16 + i * 8192, R, C); const int Rb = Epi::PERM ? ((R & ~31) + perm32(R & 31)) : R;
        voffA[i] = (unsigned)(R * g.lda + C) * 2u; voffB[i] = (unsigned)(Rb * K + C) * 2u; }
    const size_t kstep = (size_t)(BK * 2);
    const size_t hstep = (size_t)HALF * K * 2;
    const size_t tstep = 2 * hstep;
    const size_t hstepA = (size_t)HALF * g.lda * 2, tstepA = 2 * hstepA;
    const unsigned ldsw = (unsigned)wid * 1024u;
    const int aoff = lds_byte(wr * 64 + fr, fq * 8), boff = lds_byte(wc * 32 + fr, fq * 8);
#define PG8_SA(b, h) (((b) * 2 + (h)) * HTB)
#define PG8_SB(b, h) ((4 + (b) * 2 + (h)) * HTB)
#define PG8_STAGE(bufoff, gbase, voff) do { _Pragma("unroll") for (int _i = 0; _i < 2; ++_i) \
        __builtin_amdgcn_global_load_lds((const unsigned*)((const char*)(gbase) + (voff)[_i]), (PG8_LAS unsigned*)(lds + (bufoff) + ldsw + _i * 8192), 16, 0, 0); } while (0)
#define PG8_LDA(dst, b, h) do { _Pragma("unroll") for (int m = 0; m < 4; ++m) _Pragma("unroll") for (int k = 0; k < 2; ++k) dst[m][k] = *(const PG8_LAS bf16x8*)(lds + PG8_SA(b, h) + aoff + m * 2048 + k * 1024); } while (0)
#define PG8_LDB(dst, b, h) do { _Pragma("unroll") for (int n = 0; n < 2; ++n) _Pragma("unroll") for (int k = 0; k < 2; ++k) dst[n][k] = *(const PG8_LAS bf16x8*)(lds + PG8_SB(b, h) + boff + n * 2048 + k * 1024); } while (0)
#define PG8_MMA(ai, bj, At, Bt) do { __builtin_amdgcn_s_setprio(1); _Pragma("unroll") for (int m = 0; m < 4; ++m) _Pragma("unroll") for (int n = 0; n < 2; ++n) _Pragma("unroll") for (int k = 0; k < 2; ++k) \
        acc[ai][bj][m][n] = __builtin_amdgcn_mfma_f32_16x16x32_bf16(Bt[n][k], At[m][k], acc[ai][bj][m][n], 0, 0, 0); __builtin_amdgcn_s_setprio(0); } while (0)
#define PG8_WAIT_V(n) asm volatile("s_waitcnt vmcnt(" #n ")" ::: "memory")
#define PG8_WAIT_L(n) asm volatile("s_waitcnt lgkmcnt(" #n ")" ::: "memory")
#define PG8_BAR __builtin_amdgcn_s_barrier()
#define PG8_SCHED __builtin_amdgcn_sched_barrier(0)
    Unit cur, nxt; int ui = 0;
    if (!S.next(0, cur)) return;
    f32x4 acc[2][2][4][2];
#pragma unroll
    for (int a = 0; a < 2; ++a)
#pragma unroll
        for (int b = 0; b < 2; ++b)
#pragma unroll
            for (int m = 0; m < 4; ++m)
#pragma unroll
                for (int n = 0; n < 2; ++n) acc[a][b][m][n] = (f32x4){0.f, 0.f, 0.f, 0.f};
    bf16x8 At[4][2], B0[2][2], B1[2][2];
    const char* cA = (const char*)g.A + (size_t)cur.pm * tstepA; const char* cB = (const char*)g.Bt + (size_t)cur.pn * tstep;
    S.a_ready(cur);
    if constexpr (SP2) {
        PG8_STAGE(PG8_SB(0, 0), cB, voffB); PG8_STAGE(PG8_SB(0, 1), cB + hstep, voffB); PG8_STAGE(PG8_SA(0, 0), cA, voffA); PG8_STAGE(PG8_SA(0, 1), cA + hstepA, voffA);
        if (wr == 1) PG8_BAR;
        PG8_WAIT_V(2); PG8_BAR;
        PG8_STAGE(PG8_SB(1, 0), cB + kstep, voffB); PG8_STAGE(PG8_SA(1, 0), cA + kstep, voffA); PG8_STAGE(PG8_SB(1, 1), cB + hstep + kstep, voffB);
        PG8_WAIT_V(6); PG8_BAR;
    } else {
        PG8_STAGE(PG8_SB(0, 0), cB, voffB); PG8_STAGE(PG8_SA(0, 0), cA, voffA); PG8_STAGE(PG8_SB(0, 1), cB + hstep, voffB); PG8_STAGE(PG8_SA(0, 1), cA + hstepA, voffA);
        if (wr == 1) PG8_BAR;
        PG8_WAIT_V(4); PG8_BAR;
        PG8_STAGE(PG8_SB(1, 0), cB + kstep, voffB); PG8_STAGE(PG8_SA(1, 0), cA + kstep, voffA); PG8_STAGE(PG8_SB(1, 1), cB + hstep + kstep, voffB);
        PG8_WAIT_V(6); PG8_BAR;
    }
    for (;;) {
        const bool has_next = S.next(ui + 1, nxt);
        const char* nA = has_next ? (const char*)g.A + (size_t)nxt.pm * tstepA : cA; const char* nB = has_next ? (const char*)g.Bt + (size_t)nxt.pn * tstep : cB;
        for (int t = 0; t < nt; t += 2) {
            const bool last = (t == nt - 2);
            const char* a1 = cA + (size_t)(t + 1) * kstep;
            const char* a2 = last ? nA : cA + (size_t)(t + 2) * kstep; const char* b2 = last ? nB : cB + (size_t)(t + 2) * kstep;
            const char* a3 = a2 + kstep; const char* b3 = b2 + kstep;
            if (last && has_next) S.a_ready(nxt);
            if constexpr (SP2) {
            PG8_LDB(B0, 0, 0); PG8_LDB(B1, 0, 1); PG8_SCHED; PG8_LDA(At, 0, 0); PG8_STAGE(PG8_SA(1, 1), a1 + hstepA, voffA);
            PG8_WAIT_V(8); PG8_WAIT_L(0); PG8_BAR; PG8_MMA(0, 0, At, B0); PG8_MMA(0, 1, At, B1); PG8_BAR; PG8_SCHED;
            PG8_LDA(At, 0, 1); PG8_STAGE(PG8_SB(0, 0), b2, voffB); PG8_STAGE(PG8_SB(0, 1), b2 + hstep, voffB); PG8_STAGE(PG8_SA(0, 0), a2, voffA);
            PG8_WAIT_V(8); PG8_WAIT_L(0); PG8_BAR; PG8_MMA(1, 0, At, B0); PG8_MMA(1, 1, At, B1); PG8_BAR; PG8_SCHED;
            PG8_LDB(B0, 1, 0); PG8_LDB(B1, 1, 1); PG8_SCHED; PG8_LDA(At, 1, 0); PG8_STAGE(PG8_SA(0, 1), a2 + hstepA, voffA);
            PG8_WAIT_V(8); PG8_WAIT_L(0); PG8_BAR; PG8_MMA(0, 0, At, B0); PG8_MMA(0, 1, At, B1); PG8_BAR; PG8_SCHED;
            PG8_LDA(At, 1, 1); PG8_STAGE(PG8_SB(1, 0), b3, voffB); PG8_STAGE(PG8_SB(1, 1), b3 + hstep, voffB); PG8_STAGE(PG8_SA(1, 0), a3, voffA);
            PG8_WAIT_V(8); PG8_WAIT_L(0); PG8_BAR; PG8_MMA(1, 0, At, B0); PG8_MMA(1, 1, At, B1); PG8_BAR; PG8_SCHED;
            } else {
            PG8_LDB(B0, 0, 0); PG8_SCHED; PG8_LDA(At, 0, 0); PG8_STAGE(PG8_SA(1, 1), a1 + hstepA, voffA);
            PG8_WAIT_L(8); PG8_BAR; PG8_WAIT_L(0); PG8_MMA(0, 0, At, B0); PG8_BAR; PG8_SCHED;
            PG8_LDB(B1, 0, 1); PG8_STAGE(PG8_SB(0, 0), b2, voffB);
            PG8_BAR; PG8_WAIT_L(0); PG8_MMA(0, 1, At, B1); PG8_BAR;
            PG8_LDA(At, 0, 1); PG8_STAGE(PG8_SA(0, 0), a2, voffA);
            PG8_BAR; PG8_WAIT_L(0); PG8_MMA(1, 0, At, B0); PG8_BAR; PG8_SCHED;
            PG8_STAGE(PG8_SB(0, 1), b2 + hstep, voffB);
            PG8_WAIT_V(6); PG8_BAR; PG8_MMA(1, 1, At, B1); PG8_BAR;
            PG8_LDB(B0, 1, 0); PG8_SCHED; PG8_LDA(At, 1, 0); PG8_STAGE(PG8_SA(0, 1), a2 + hstepA, voffA);
            PG8_WAIT_L(8); PG8_BAR; PG8_WAIT_L(0); PG8_MMA(0, 0, At, B0); PG8_BAR; PG8_SCHED;
            PG8_LDB(B1, 1, 1); PG8_STAGE(PG8_SB(1, 0), b3, voffB);
            PG8_BAR; PG8_WAIT_L(0); PG8_MMA(0, 1, At, B1); PG8_BAR;
            PG8_LDA(At, 1, 1); PG8_STAGE(PG8_SA(1, 0), a3, voffA);
            PG8_BAR; PG8_WAIT_L(0); PG8_MMA(1, 0, At, B0); PG8_BAR; PG8_SCHED;
            PG8_STAGE(PG8_SB(1, 1), b3 + hstep, voffB);
            PG8_WAIT_V(6); PG8_BAR; PG8_MMA(1, 1, At, B1); PG8_BAR;
            }
        }
        if constexpr (ALIGN_EPI) { if (wr == 0) PG8_BAR; }
        if constexpr (!Epi::AFTER_DRAIN) { E(acc, cur, wr, wc, fr, fq); S.done(cur); }
        if (!has_next) break;
#pragma unroll
        for (int a = 0; a < 2; ++a)
#pragma unroll
            for (int b = 0; b < 2; ++b)
#pragma unroll
                for (int m = 0; m < 4; ++m)
#pragma unroll
                    for (int n = 0; n < 2; ++n) acc[a][b][m][n] = (f32x4){0.f, 0.f, 0.f, 0.f};
        cur = nxt; cA = nA; cB = nB; ++ui;
        if constexpr (ALIGN_EPI) { if (wr == 1) PG8_BAR; }
    }
    PG8_WAIT_V(0);
    if constexpr (!ALIGN_EPI) { if (wr == 0) PG8_BAR; }
    PG8_BAR;
    if constexpr (Epi::AFTER_DRAIN) { E.fused(acc, cur, wr, wc, fr, fq, lds, wid, lane); S.done(cur); }
#undef PG8_SA
#undef PG8_SB
#undef PG8_STAGE
#undef PG8_LDA
#undef PG8_LDB
#undef PG8_MMA
#undef PG8_WAIT_V
#undef PG8_WAIT_L
#undef PG8_BAR
#undef PG8_SCHED
}
}

#ifndef GEMM_SP2
#define GEMM_SP2 true
#endif
#ifndef GEMM_ALIGN
#define GEMM_ALIGN true
#endif
namespace mk {
#define LAS __attribute__((address_space(3)))
using pg8::bf16_t; using pg8::bf16x8; using pg8::f32x4; using pg8::u32x4;
typedef unsigned u32x2 __attribute__((ext_vector_type(2)));

constexpr int DM = 1024, SEQ = 8192, NBATCH = 4, MPR = NBATCH * SEQ, MSAMP = 128, MREAL = MPR + MSAMP, MPAD = 33024;
constexpr int DFF = 2816, PW = 2816, NINP = 3072, CONVC = 1536;
constexpr float EPS = 1e-6f;
#ifndef SCAN_CW
#define SCAN_CW 2
#endif
constexpr int CW = SCAN_CW, NSCAN = 128 / CW;
constexpr int LDS_PHASE_BYTES = 155648, LDS_BYTES = LDS_PHASE_BYTES + 256;

constexpr size_t O_YP = 0, O_YS = 33554432, O_KP = 33685504, O_VP = 33751040, O_CP = 33816576, O_GP = 33835008,
                 O_KS = 34097152, O_VS = 36194304, O_CS = 38291456, O_GS = 38881280;
constexpr size_t MiB = 1u << 20;
constexpr size_t WS_CTL = 0, CTL_ZERO_BYTES = 1 * MiB;
constexpr size_t WS_W1IN = 1 * MiB, WS_W1OUT = 12 * MiB, WS_WINMIX = 18 * MiB, WS_WOUTMIX = 24 * MiB, WS_W2IN = 26 * MiB, WS_W2OUT = 37 * MiB;
constexpr size_t WS_GBA = 43 * MiB, WS_XN = 45 * MiB, WS_XN2 = 110 * MiB, WS_H = 175 * MiB, WS_GM = 353 * MiB, WS_GN = 417 * MiB;
constexpr size_t WS_GQ = 110 * MiB, WS_GO = 142 * MiB;
constexpr size_t WS_SSP1 = 481 * MiB, WS_SSP2 = 484 * MiB;
constexpr size_t WS_END = 487 * MiB;
constexpr size_t CTL_BAR = 0, CTL_BAR_BYTES = 16384, CTL_GLAST = 768 * 1024;

struct Params { const float* in[21]; float* out; unsigned char* ws; };

typedef float f32x2v __attribute__((ext_vector_type(2)));
typedef __bf16 bf16x2v __attribute__((ext_vector_type(2)));
__device__ __forceinline__ unsigned cvt_pk(float lo, float hi) { const f32x2v v = {lo, hi}; const bf16x2v b = __builtin_convertvector(v, bf16x2v); return __builtin_bit_cast(unsigned, b); }
__device__ __forceinline__ bf16_t f2bf(float f) { return (bf16_t)(cvt_pk(f, 0.f) & 0xffffu); }
__device__ __forceinline__ float bf2f(bf16_t h) { return __uint_as_float(((unsigned)h) << 16); }
__device__ __forceinline__ float bflo(unsigned w) { return __uint_as_float(w << 16); }
__device__ __forceinline__ float bfhi(unsigned w) { return __uint_as_float(w & 0xffff0000u); }
__device__ __forceinline__ float silu(float x) { return x * __builtin_amdgcn_rcpf(1.0f + __expf(-x)); }
__device__ __forceinline__ float wave_sum(float v) {
#pragma unroll
    for (int o = 1; o < 64; o <<= 1) v += __shfl_xor(v, o);
    return v;
}
__device__ __forceinline__ float wave_max(float v) {
#pragma unroll
    for (int o = 1; o < 64; o <<= 1) v = fmaxf(v, __shfl_xor(v, o));
    return v;
}
__device__ __forceinline__ float row16_sum(float v) {
    v += __builtin_bit_cast(float, __builtin_amdgcn_update_dpp(0, __builtin_bit_cast(int, v), 0xB1, 0xF, 0xF, true));
    v += __builtin_bit_cast(float, __builtin_amdgcn_update_dpp(0, __builtin_bit_cast(int, v), 0x4E, 0xF, 0xF, true));
    v += __builtin_bit_cast(float, __builtin_amdgcn_update_dpp(0, __builtin_bit_cast(int, v), 0x141, 0xF, 0xF, true));
    v += __builtin_bit_cast(float, __builtin_amdgcn_update_dpp(0, __builtin_bit_cast(int, v), 0x140, 0xF, 0xF, true));
    return v;
}
__device__ __forceinline__ f32x4 mfma16(bf16x8 a, bf16x8 b, f32x4 c) { return __builtin_amdgcn_mfma_f32_16x16x32_bf16(a, b, c, 0, 0, 0); }

__device__ __forceinline__ float row_rstd(const float* ssp, int r) {
    if (r >= MREAL) return 0.f;
    const f32x4 a = *(const f32x4*)(ssp + (size_t)r * 16), b = *(const f32x4*)(ssp + (size_t)r * 16 + 4), c = *(const f32x4*)(ssp + (size_t)r * 16 + 8), d = *(const f32x4*)(ssp + (size_t)r * 16 + 12);
    const float s = (((a[0] + a[1]) + (a[2] + a[3])) + ((b[0] + b[1]) + (b[2] + b[3]))) + (((c[0] + c[1]) + (c[2] + c[3])) + ((d[0] + d[1]) + (d[2] + d[3])));
    return rsqrtf(s * (1.0f / DM) + EPS);
}
struct EpiSwiglu {
    static constexpr bool PERM = true, AFTER_DRAIN = false;
    bf16_t* H; const float* ss;
    __device__ __forceinline__ void operator()(const f32x4 (&acc)[2][2][4][2], const pg8::Unit& u, int wr, int wc, int fr, int fq) const {
        const int row0 = u.pm * 256 + wr * 64 + fr, col0 = u.pn * 128 + wc * 32 + 8 * fq;
#pragma unroll
        for (int ai = 0; ai < 2; ++ai)
#pragma unroll
            for (int m = 0; m < 4; ++m) {
                const int r = row0 + ai * 128 + m * 16;
                const float rs = ss ? row_rstd(ss, r) : 1.0f;
                float h[8];
#pragma unroll
                for (int n = 0; n < 2; ++n)
#pragma unroll
                    for (int j = 0; j < 4; ++j) h[n * 4 + j] = silu(acc[ai][0][m][n][j] * rs) * (acc[ai][1][m][n][j] * rs);
                u32x4 w; w.x = cvt_pk(h[0], h[1]); w.y = cvt_pk(h[2], h[3]); w.z = cvt_pk(h[4], h[5]); w.w = cvt_pk(h[6], h[7]);
                *(u32x4*)(H + (size_t)r * DFF + col0) = w;
            }
    }
};
template <bool RESB16, bool WF32, bool WB16, bool SUMSQ, bool HALF> struct EpiResid {
    static constexpr bool PERM = true, AFTER_DRAIN = false;
    const void* resP; const void* resS; float* Yo; bf16_t* XBo; float* sso;
    __device__ __forceinline__ void operator()(const f32x4 (&acc)[2][2][4][2], const pg8::Unit& u, int wr, int wc, int fr, int fq) const {
        const int row0 = u.pm * 256 + wr * 64 + fr, col0 = u.pn * 256 + wc * 32 + 8 * fq;
        const char* const rP = (const char*)resP; const char* const rS = (const char*)resS - (size_t)MPR * DM * (RESB16 ? 2 : 4);
        float* const Y = Yo; const float scale = HALF ? 0.5f : 1.0f; bf16_t* const XB = XBo; float* const ss = sso;
#pragma unroll
        for (int ai = 0; ai < 2; ++ai)
#pragma unroll
            for (int m = 0; m < 4; ++m) {
                const int r = row0 + ai * 128 + m * 16; float s = 0.f;
                if (r < MREAL) {
                    const char* rp = ((r < MPR) ? rP : rS) + (size_t)r * DM * (RESB16 ? 2 : 4);
#pragma unroll
                    for (int bj = 0; bj < 2; ++bj) {
                        const int c = col0 + bj * 128;
                        f32x4 r0, r1;
                        if (RESB16) { const u32x4 w = *(const u32x4*)(rp + (size_t)c * 2); r0 = (f32x4){bflo(w.x), bfhi(w.x), bflo(w.y), bfhi(w.y)}; r1 = (f32x4){bflo(w.z), bfhi(w.z), bflo(w.w), bfhi(w.w)}; }
                        else { r0 = *(const f32x4*)(rp + (size_t)c * 4); r1 = *(const f32x4*)(rp + (size_t)c * 4 + 16); }
                        const f32x4 v0 = r0 + acc[ai][bj][m][0] * scale, v1 = r1 + acc[ai][bj][m][1] * scale;
                        if (WF32) { *(f32x4*)(Y + (size_t)r * DM + c) = v0; *(f32x4*)(Y + (size_t)r * DM + c + 4) = v1; }
                        if (WB16) { u32x4 w; w.x = cvt_pk(v0[0], v0[1]); w.y = cvt_pk(v0[2], v0[3]); w.z = cvt_pk(v1[0], v1[1]); w.w = cvt_pk(v1[2], v1[3]);
                            *(u32x4*)(XB + (size_t)r * DM + c) = w; }
                        if (SUMSQ) s += (v0[0] * v0[0] + v0[1] * v0[1]) + (v0[2] * v0[2] + v0[3] * v0[3]) + (v1[0] * v1[0] + v1[1] * v1[1]) + (v1[2] * v1[2] + v1[3] * v1[3]);
                    }
                }
                if (SUMSQ) { s += __shfl_xor(s, 16); s += __shfl_xor(s, 32); if (fq == 0 && r < MREAL) ss[(size_t)r * 16 + u.pn * 4 + wc] = s; }
            }
    }
};
struct EpiInproj {
    static constexpr bool PERM = true, AFTER_DRAIN = false;
    bf16_t* P; float* gba; const float* ss;
    __device__ __forceinline__ void operator()(const f32x4 (&acc)[2][2][4][2], const pg8::Unit& u, int wr, int wc, int fr, int fq) const {
        const int row0 = u.pm * 256 + wr * 64 + fr, col0 = u.pn * 256 + wc * 32 + 8 * fq;
#pragma unroll
        for (int ai = 0; ai < 2; ++ai)
#pragma unroll
            for (int m = 0; m < 4; ++m) {
                const int r = row0 + ai * 128 + m * 16;
                const float rs = row_rstd(ss, r);
                if (u.pn < 11) {
#pragma unroll
                    for (int bj = 0; bj < 2; ++bj) { const f32x4 v0 = acc[ai][bj][m][0] * rs, v1 = acc[ai][bj][m][1] * rs;
                        u32x4 w; w.x = cvt_pk(v0[0], v0[1]); w.y = cvt_pk(v0[2], v0[3]); w.z = cvt_pk(v1[0], v1[1]); w.w = cvt_pk(v1[2], v1[3]);
                        *(u32x4*)(P + (size_t)r * PW + col0 + bj * 128) = w; }
                } else if (wc == 0 && fq == 0) {
                    *(f32x4*)(gba + (size_t)r * 8) = acc[ai][0][m][0] * rs; *(f32x4*)(gba + (size_t)r * 8 + 4) = acc[ai][0][m][1] * rs;
                }
            }
    }
};


template <int NT, bool SS>
__device__ __forceinline__ void skinny_mm(const bf16_t* A, int lda, const bf16_t* W, int K, int wrow0, int wrow1, int wid, int fr, int fq, f32x4 (&acc)[NT], float& ss, LAS unsigned char* lds) {
    const int lane = fq * 16 + fr, kper = K >> 3, nks = kper >> 5;
    const bf16_t* ap = A + (size_t)fr * lda + wid * kper + 8 * fq;
    const bf16_t* w0 = W + (size_t)(wrow0 + fr) * K + wid * kper + 8 * fq; const bf16_t* w1 = W + (size_t)(wrow1 + fr) * K + wid * kper + 8 * fq;
    f32x4 pa[NT][8]; float sp[8];
#pragma unroll
    for (int mt = 0; mt < 8; ++mt) { sp[mt] = 0.f;
#pragma unroll
        for (int nt = 0; nt < NT; ++nt) pa[nt][mt] = (f32x4){0.f, 0.f, 0.f, 0.f}; }
#pragma unroll 2
    for (int ks = 0; ks < nks; ++ks) {
        const bf16x8 b0 = *(const bf16x8*)(w0 + 32 * ks); bf16x8 b1 = b0; if (NT == 2) b1 = *(const bf16x8*)(w1 + 32 * ks);
        bf16x8 av[8];
#pragma unroll
        for (int mt = 0; mt < 8; ++mt) av[mt] = *(const bf16x8*)(ap + (size_t)(16 * mt) * lda + 32 * ks);
#pragma unroll
        for (int mt = 0; mt < 8; ++mt) {
            pa[0][mt] = mfma16(b0, av[mt], pa[0][mt]);
            if (NT == 2) pa[NT - 1][mt] = mfma16(b1, av[mt], pa[NT - 1][mt]);
            if (SS) { const u32x4 u = __builtin_bit_cast(u32x4, av[mt]);
#pragma unroll
                for (int k = 0; k < 4; ++k) { const float lo = bflo(u[k]), hi = bfhi(u[k]); sp[mt] += lo * lo + hi * hi; } }
        }
    }
    LAS f32x4* red = (LAS f32x4*)lds;
    LAS float* sred = (LAS float*)(lds + 8 * NT * 8 * 64 * 16);
#pragma unroll
    for (int mt = 0; mt < 8; ++mt) {
#pragma unroll
        for (int nt = 0; nt < NT; ++nt) red[((wid * NT + nt) * 8 + mt) * 64 + lane] = pa[nt][mt];
        if (SS) sred[(wid * 8 + mt) * 64 + lane] = sp[mt];
    }
    __syncthreads();
    float s = 0.f;
#pragma unroll
    for (int nt = 0; nt < NT; ++nt) acc[nt] = (f32x4){0.f, 0.f, 0.f, 0.f};
#pragma unroll
    for (int v = 0; v < 8; ++v) {
#pragma unroll
        for (int nt = 0; nt < NT; ++nt) acc[nt] += red[((v * NT + nt) * 8 + wid) * 64 + lane];
        if (SS) s += sred[(v * 8 + wid) * 64 + lane];
    }
    if (SS) { s += __shfl_xor(s, 16); s += __shfl_xor(s, 32); }
    ss = s;
    __syncthreads();
}
template <bool SS> __device__ __forceinline__ void sk_ffn_in(const bf16_t* X, const bf16_t* Wt, bf16_t* H, int slab, int wid, int fr, int fq, LAS unsigned char* lds) {
    const int j0 = 16 * slab, wr0 = (j0 >> 7) * 256 + (j0 & 127);
    f32x4 acc[2]; float ss;
    skinny_mm<2, SS>(X + (size_t)MPR * DM, DM, Wt, DM, wr0, wr0 + 128, wid, fr, fq, acc, ss, lds);
    const float rs = SS ? rsqrtf(ss * (1.0f / DM) + EPS) : 1.0f;
    float h[4];
#pragma unroll
    for (int e = 0; e < 4; ++e) h[e] = silu(acc[0][e] * rs) * (acc[1][e] * rs);
    u32x2 w; w.x = cvt_pk(h[0], h[1]); w.y = cvt_pk(h[2], h[3]);
    *(u32x2*)(H + (size_t)(MPR + 16 * wid + fr) * DFF + j0 + 4 * fq) = w;
}
template <bool OUTF32> __device__ __forceinline__ void sk_ffn_out(const bf16_t* Hb, const bf16_t* Wt, const float* resf, float* outf, bf16_t* outb, int slab, int wid, int fr, int fq, LAS unsigned char* lds) {
    f32x4 acc[1]; float ss;
    skinny_mm<1, false>(Hb + (size_t)MPR * DFF, DFF, Wt, DFF, 16 * slab, 0, wid, fr, fq, acc, ss, lds);
    const int rl = 16 * wid + fr, c = 16 * slab + 4 * fq;
    f32x4 rv;
    if (OUTF32) { const u32x2 xr = *(const u32x2*)((const bf16_t*)resf + (size_t)rl * DM + c); rv = (f32x4){bflo(xr.x), bfhi(xr.x), bflo(xr.y), bfhi(xr.y)}; }
    else rv = *(const f32x4*)(resf + (size_t)rl * DM + c);
    const f32x4 v = rv + acc[0] * 0.5f;
    { u32x2 w; w.x = cvt_pk(v[0], v[1]); w.y = cvt_pk(v[2], v[3]); *(u32x2*)(outb + (size_t)rl * DM + c) = w; }
}
__device__ __forceinline__ void sk_inproj(const bf16_t* X, const bf16_t* Wt, bf16_t* P, float* gba, int slab, int wid, int fr, int fq, LAS unsigned char* lds) {
    const int n0 = 32 * slab; f32x4 acc[2]; float ss;
    skinny_mm<2, true>(X + (size_t)MPR * DM, DM, Wt, DM, n0, n0 + 16, wid, fr, fq, acc, ss, lds);
    const float rs = rsqrtf(ss * (1.0f / DM) + EPS); const int r = MPR + 16 * wid + fr;
    if (n0 < PW) {
#pragma unroll
        for (int nt = 0; nt < 2; ++nt) { const f32x4 v = acc[nt] * rs; u32x2 w; w.x = cvt_pk(v[0], v[1]); w.y = cvt_pk(v[2], v[3]); *(u32x2*)(P + (size_t)r * PW + n0 + 16 * nt + 4 * fq) = w; }
    } else if (fq < 2) *(f32x4*)(gba + (size_t)r * 8 + 4 * fq) = acc[0] * rs;
}
__device__ __forceinline__ void sk_outproj(const bf16_t* Pm, const bf16_t* Wt, const bf16_t* X1b, float* X2f, bf16_t* X2b, int slab, int wid, int fr, int fq, LAS unsigned char* lds) {
    const int n0 = 32 * slab; f32x4 acc[2]; float ss;
    skinny_mm<2, false>(Pm + (size_t)MPR * PW, PW, Wt, DM, n0, n0 + 16, wid, fr, fq, acc, ss, lds);
    const int r = MPR + 16 * wid + fr;
#pragma unroll
    for (int nt = 0; nt < 2; ++nt) { const int c = n0 + 16 * nt + 4 * fq; const u32x2 xr = *(const u32x2*)(X1b + (size_t)r * DM + c);
        const f32x4 v = (f32x4){bflo(xr.x), bfhi(xr.x), bflo(xr.y), bfhi(xr.y)} + acc[nt];
        u32x2 w; w.x = cvt_pk(v[0], v[1]); w.y = cvt_pk(v[2], v[3]); *(u32x2*)(X2b + (size_t)r * DM + c) = w; }
}

__device__ __forceinline__ void transpose_item(const float* W, int K, int N, bf16_t* WT, int k0, int n0, int drow0, const float* gs, LAS float* scr, int lane) {
    float wv[32];
#pragma unroll
    for (int i = 0; i < 32; ++i) { const int kk = 2 * i + (lane >> 5), n = n0 + (lane & 31); wv[i] = (n < N) ? W[(size_t)(k0 + kk) * N + n] : 0.f; }
#pragma unroll
    for (int i = 0; i < 32; ++i) { const int kk = 2 * i + (lane >> 5); float v = wv[i]; if (gs) v *= gs[k0 + kk]; scr[kk * 33 + (lane & 31)] = v; }
    asm volatile("s_waitcnt lgkmcnt(0)" ::: "memory");
    const int c = lane & 7;
#pragma unroll
    for (int j = 0; j < 4; ++j) { const int nn = (lane >> 3) + 8 * j; const LAS float* s = scr + (8 * c) * 33 + nn;
        u32x4 o; o.x = cvt_pk(s[0 * 33], s[1 * 33]); o.y = cvt_pk(s[2 * 33], s[3 * 33]); o.z = cvt_pk(s[4 * 33], s[5 * 33]); o.w = cvt_pk(s[6 * 33], s[7 * 33]);
        *(u32x4*)(WT + (size_t)(drow0 + nn) * K + k0 + 8 * c) = o; }
    asm volatile("s_waitcnt lgkmcnt(0)" ::: "memory");
}
__device__ __forceinline__ int map_ffin_row(int n0) { return n0 < DFF ? (n0 >> 7) * 256 + (n0 & 127) : ((n0 - DFF) >> 7) * 256 + 128 + ((n0 - DFF) & 127); }

__device__ __forceinline__ void p0_prologue(const Params& p, LAS unsigned char* lds, int vb, int G) {
    const int tid = threadIdx.x, lane = tid & 63, wid = tid >> 6;
    LAS float* scr = (LAS float*)(lds + wid * 16384);
    const int gw = vb * 8 + wid, NGW = G * 8;
    bf16_t* W1IN = (bf16_t*)(p.ws + WS_W1IN); bf16_t* W1OUT = (bf16_t*)(p.ws + WS_W1OUT); bf16_t* WINMIX = (bf16_t*)(p.ws + WS_WINMIX);
    bf16_t* WOUTMIX = (bf16_t*)(p.ws + WS_WOUTMIX); bf16_t* W2IN = (bf16_t*)(p.ws + WS_W2IN); bf16_t* W2OUT = (bf16_t*)(p.ws + WS_W2OUT);
    constexpr int I_FIN = 16 * 176, I_FOUT = 44 * 32, I_INMIX = 16 * 89, I_OUTMIX = 16 * 32;
    constexpr int NITEMS = 2 * I_FIN + 2 * I_FOUT + I_INMIX + I_OUTMIX;
    for (int it = gw; it < NITEMS; it += NGW) {
        int r = it;
        if (r < I_FIN) { const int kb = r / 176, nb = r % 176; transpose_item(p.in[7], DM, 2 * DFF, W1IN, kb * 64, nb * 32, map_ffin_row(nb * 32), nullptr, scr, lane); continue; } r -= I_FIN;
        if (r < I_FIN) { const int kb = r / 176, nb = r % 176; transpose_item(p.in[18], DM, 2 * DFF, W2IN, kb * 64, nb * 32, map_ffin_row(nb * 32), p.in[17], scr, lane); continue; } r -= I_FIN;
        if (r < I_FOUT) { const int kb = r / 32, nb = r % 32; transpose_item(p.in[8], DFF, DM, W1OUT, kb * 64, nb * 32, nb * 32, nullptr, scr, lane); continue; } r -= I_FOUT;
        if (r < I_FOUT) { const int kb = r / 32, nb = r % 32; transpose_item(p.in[19], DFF, DM, W2OUT, kb * 64, nb * 32, nb * 32, nullptr, scr, lane); continue; } r -= I_FOUT;
        if (r < I_INMIX) { const int kb = r / 89, nb = r % 89; transpose_item(p.in[10], DM, 2824, WINMIX, kb * 64, nb * 32, nb * 32, p.in[9], scr, lane); continue; } r -= I_INMIX;
        { const int kb = r / 32, nb = r % 32; transpose_item(p.in[16], DM, DM, WOUTMIX, kb * 64, nb * 32, nb * 32, nullptr, scr, lane); }
    }
    bf16_t* XN = (bf16_t*)(p.ws + WS_XN); const float* g1 = p.in[6];
    f32x4 gv[4];
#pragma unroll
    for (int j = 0; j < 4; ++j) gv[j] = *((const f32x4*)g1 + lane + 64 * j);
    {
        f32x4 v[4], vn[4];
        int m = gw;
        if (m < MREAL) { const f32x4* xr = (const f32x4*)((m < MPR) ? p.in[0] + (size_t)m * DM : p.in[1] + (size_t)(m - MPR) * DM) + lane;
#pragma unroll
            for (int j = 0; j < 4; ++j) v[j] = xr[64 * j]; }
        for (; m < MREAL; m += NGW) {
            const int mn = m + NGW;
            if (mn < MREAL) { const f32x4* xr = (const f32x4*)((mn < MPR) ? p.in[0] + (size_t)mn * DM : p.in[1] + (size_t)(mn - MPR) * DM) + lane;
#pragma unroll
                for (int j = 0; j < 4; ++j) vn[j] = xr[64 * j]; }
            float s = 0.f;
#pragma unroll
            for (int j = 0; j < 4; ++j) s += (v[j][0] * v[j][0] + v[j][1] * v[j][1]) + (v[j][2] * v[j][2] + v[j][3] * v[j][3]);
            const float rstd = rsqrtf(wave_sum(s) * (1.0f / DM) + EPS);
            unsigned long long* o8 = (unsigned long long*)(XN + (size_t)m * DM) + lane;
#pragma unroll
            for (int j = 0; j < 4; ++j) { const f32x4 y = v[j] * rstd * gv[j];
                o8[64 * j] = (unsigned long long)cvt_pk(y[0], y[1]) | ((unsigned long long)cvt_pk(y[2], y[3]) << 32); }
#pragma unroll
            for (int j = 0; j < 4; ++j) v[j] = vn[j];
        }
    }
}

template <bool SWX = false, bool SWY = false>
__device__ __forceinline__ f32x4 tile_mm(const LAS bf16_t* X, int ldx, int mt, const LAS bf16_t* Y, int ldy, int nt, int nks, int fr, int fq) {
    f32x4 acc = (f32x4){0.f, 0.f, 0.f, 0.f};
    const int rx = 16 * mt + fr, ry = 16 * nt + fr, sx = SWX ? ((rx >> 3) & 7) : 0, sy = SWY ? ((ry >> 3) & 7) : 0;
    const LAS bf16_t* xp = X + rx * ldx; const LAS bf16_t* yp = Y + ry * ldy;
    for (int ks = 0; ks < nks; ++ks) acc = mfma16(*(const LAS bf16x8*)(xp + 8 * ((4 * ks + fq) ^ sx)), *(const LAS bf16x8*)(yp + 8 * ((4 * ks + fq) ^ sy)), acc);
    return acc;
}
constexpr int G1_QS = 0, G1_KS = 17408, G1_VBT = 34816, G1_KBT = 53248, G1_KDT = 71680, G1_UT = 90112, G1_WT = 108544, G1_QK = 126976, G1_TB = 136192, G1_GC = 145408, G1_BETA = 145664, G1_TT = 146176, G1_A10 = 148736, G1_PT = 151296;

__device__ __forceinline__ void gdn_prep_unit(const Params& p, LAS unsigned char* lds, int unit) {
    const int tid = threadIdx.x, lane = tid & 63, wid = tid >> 6, fr = lane & 15, fq = lane >> 4;
    const int bh = unit >> 7, n = unit & 127, b = bh >> 2, h = bh & 3;
    const int tok0 = b * SEQ + n * 64;
    LAS bf16_t* Qs = (LAS bf16_t*)(lds + G1_QS); LAS bf16_t* Ks = (LAS bf16_t*)(lds + G1_KS); LAS bf16_t* VbT = (LAS bf16_t*)(lds + G1_VBT);
    LAS bf16_t* KbT = (LAS bf16_t*)(lds + G1_KBT); LAS bf16_t* KdT = (LAS bf16_t*)(lds + G1_KDT); LAS bf16_t* UT = (LAS bf16_t*)(lds + G1_UT);
    LAS bf16_t* WT = (LAS bf16_t*)(lds + G1_WT); LAS float* Af = (LAS float*)(lds + G1_WT); LAS bf16_t* QK = (LAS bf16_t*)(lds + G1_QK);
    LAS bf16_t* Tb = (LAS bf16_t*)(lds + G1_TB); LAS bf16_t* TT = (LAS bf16_t*)(lds + G1_TT); LAS bf16_t* A10b = (LAS bf16_t*)(lds + G1_A10); LAS bf16_t* PT = (LAS bf16_t*)(lds + G1_PT); LAS float* gcs = (LAS float*)(lds + G1_GC); LAS float* betas = (LAS float*)(lds + G1_BETA);
    const bf16_t* PB = (const bf16_t*)(p.ws + WS_H); const float* GBA = (const float*)(p.ws + WS_GBA);
    LAS unsigned char* raw = lds + G1_UT;
    for (int pc4 = wid; pc4 < 51; pc4 += 8) {
        int pc = pc4 * 4 + (lane >> 4); pc = pc < 200 ? pc : 200;
        const int r = pc / 3, seg = pc - 3 * r; int tt = n * 64 - 3 + r; tt = tt < 0 ? 0 : tt;
        __builtin_amdgcn_global_load_lds((const unsigned*)(PB + (size_t)(b * SEQ + tt) * PW + 768 + seg * 512 + h * 128 + (lane & 15) * 8), (LAS unsigned*)(raw + pc4 * 1024), 16, 0, 0);
    }
    if (tid < 64) {
        const float* gb = GBA + (size_t)(tok0 + tid) * 8;
        const float bt = 1.0f / (1.0f + __expf(-gb[h]));
        const float x = gb[4 + h] + p.in[14][h]; const float sp = x > 20.f ? x : log1pf(__expf(x));
        float c = -__expf(p.in[13][h]) * sp;
#pragma unroll
        for (int o = 1; o < 64; o <<= 1) { const float t = __shfl_up(c, o); if (lane >= o) c += t; }
        gcs[tid] = c; betas[tid] = bt;
    }
    asm volatile("s_waitcnt vmcnt(0)" ::: "memory");
    __syncthreads();
    const float gclast = gcs[63];
    const float* cw = p.in[12];
#pragma unroll 1
    for (int it = 0; it < 6; ++it) {
        const int item = tid + 512 * it, l16 = item & 15, row = item >> 4, which = row >> 6, t = row & 63;
        const int cch = which * 512 + h * 128 + l16 * 8;
        float a[8];
#pragma unroll
        for (int e = 0; e < 8; ++e) a[e] = 0.f;
#pragma unroll
        for (int j = 0; j < 4; ++j) {
            const int tt = n * 64 + t - 3 + j;
            if (tt >= 0) {
                const u32x4 xv = *(const LAS u32x4*)(raw + ((t + j) * 3 + which) * 256 + l16 * 16);
                const f32x4 w0 = *(const f32x4*)(cw + j * CONVC + cch), w1 = *(const f32x4*)(cw + j * CONVC + cch + 4);
                a[0] += w0[0] * bflo(xv.x); a[1] += w0[1] * bfhi(xv.x); a[2] += w0[2] * bflo(xv.y); a[3] += w0[3] * bfhi(xv.y);
                a[4] += w1[0] * bflo(xv.z); a[5] += w1[1] * bfhi(xv.z); a[6] += w1[2] * bflo(xv.w); a[7] += w1[3] * bfhi(xv.w);
            }
        }
        float ss = 0.f;
#pragma unroll
        for (int e = 0; e < 8; ++e) { a[e] = silu(a[e]); ss += a[e] * a[e]; }
        ss = row16_sum(ss);
        const float gct = gcs[t], bt = betas[t];
        const int tsw = (((t >> 3) ^ (l16 & 7)) << 3) | (t & 7);
        if (which == 0) {
            const float sc = rsqrtf(ss + EPS) * 0.08838834764831845f;
            u32x4 w; w.x = cvt_pk(a[0] * sc, a[1] * sc); w.y = cvt_pk(a[2] * sc, a[3] * sc); w.z = cvt_pk(a[4] * sc, a[5] * sc); w.w = cvt_pk(a[6] * sc, a[7] * sc);
            *(LAS u32x4*)(Qs + t * 136 + l16 * 8) = w;
        } else if (which == 1) {
            const float sc = rsqrtf(ss + EPS);
            u32x4 w; w.x = cvt_pk(a[0] * sc, a[1] * sc); w.y = cvt_pk(a[2] * sc, a[3] * sc); w.z = cvt_pk(a[4] * sc, a[5] * sc); w.w = cvt_pk(a[6] * sc, a[7] * sc);
            *(LAS u32x4*)(Ks + t * 136 + l16 * 8) = w;
            const float sb = sc * bt * __expf(gct), sd = sc * __expf(gclast - gct);
#pragma unroll
            for (int e = 0; e < 8; ++e) { KbT[(l16 * 8 + e) * 72 + tsw] = f2bf(a[e] * sb); KdT[(l16 * 8 + e) * 72 + tsw] = f2bf(a[e] * sd); }
        } else {
#pragma unroll
            for (int e = 0; e < 8; ++e) VbT[(l16 * 8 + e) * 72 + tsw] = f2bf(a[e] * bt);
        }
    }
    __syncthreads();
#pragma unroll 2
    for (int r = 0; r < 4; ++r) {
        const int job = wid + 8 * r, kind = job >> 4, tile = job & 15, it = tile >> 2, jt = tile & 3;
        if (kind == 0) {
            if (jt > it) continue;
            const f32x4 acc = tile_mm(Ks, 136, it, Ks, 136, jt, 4, fr, fq);
            const int j = 16 * jt + fr; const float gcj = gcs[j];
            float v[4];
#pragma unroll
            for (int e = 0; e < 4; ++e) { const int i = 16 * it + 4 * fq + e; const bool ok = i > j; v[e] = ok ? acc[e] * __expf(gcs[i] - gcj) * betas[i] : 0.f; }
            *(LAS f32x4*)(Af + j * 68 + 16 * it + 4 * fq) = (f32x4){v[0], v[1], v[2], v[3]};
            if (it >= 2 && jt < 2) {
#pragma unroll
                for (int e = 0; e < 4; ++e) A10b[(16 * (it - 2) + 4 * fq + e) * 40 + j] = f2bf(v[e]); }
        } else {
            const f32x4 acc = tile_mm(Ks, 136, jt, Qs, 136, it, 4, fr, fq);
            const int i = 16 * it + fr; const float gci = gcs[i];
            float v[4];
#pragma unroll
            for (int e = 0; e < 4; ++e) { const int j = 16 * jt + 4 * fq + e; const bool ok = i >= j; v[e] = ok ? acc[e] * __expf(gci - gcs[j]) : 0.f; }
            u32x2 w; w.x = cvt_pk(v[0], v[1]); w.y = cvt_pk(v[2], v[3]); *(LAS u32x2*)(QK + i * 72 + 16 * jt + 4 * fq) = w;
        }
    }
    __syncthreads();
    if (wid < 2) {
        const int ofs = wid * 32, cl = lane & 31; const LAS float* Ab = Af + ofs * 69; LAS bf16_t* Tw = Tb + ofs * 73 + cl; LAS bf16_t* Tt = (wid == 0) ? TT + cl * 40 : PT + cl * 40;
        f32x2v r2[16];
#pragma unroll
        for (int k = 0; k < 16; ++k) r2[k] = (f32x2v){(cl == 2 * k) ? 1.0f : 0.0f, (cl == 2 * k + 1) ? 1.0f : 0.0f};
        const f32x4 a0 = *(const LAS f32x4*)(Ab + 0);
        const f32x4 a1 = *(const LAS f32x4*)(Ab + 4);
        const f32x4 a2 = *(const LAS f32x4*)(Ab + 8);
        const f32x4 a3 = *(const LAS f32x4*)(Ab + 12);
        const f32x4 a4 = *(const LAS f32x4*)(Ab + 16);
        const float t0 = r2[0][0]; const f32x2v T0 = (f32x2v){t0, t0}; Tw[0] = f2bf(t0); Tt[0] = f2bf(t0);
        r2[0] -= (f32x2v){a0[0], a0[1]} * T0; r2[1] -= (f32x2v){a0[2], a0[3]} * T0;
        const f32x4 a5 = *(const LAS f32x4*)(Ab + 20);
        r2[2] -= (f32x2v){a1[0], a1[1]} * T0; r2[3] -= (f32x2v){a1[2], a1[3]} * T0;
        const f32x4 a6 = *(const LAS f32x4*)(Ab + 24);
        r2[4] -= (f32x2v){a2[0], a2[1]} * T0; r2[5] -= (f32x2v){a2[2], a2[3]} * T0;
        const f32x4 a7 = *(const LAS f32x4*)(Ab + 28);
        r2[6] -= (f32x2v){a3[0], a3[1]} * T0; r2[7] -= (f32x2v){a3[2], a3[3]} * T0;
        const f32x4 a8 = *(const LAS f32x4*)(Ab + 68);
        r2[8] -= (f32x2v){a4[0], a4[1]} * T0; r2[9] -= (f32x2v){a4[2], a4[3]} * T0;
        const f32x4 a9 = *(const LAS f32x4*)(Ab + 72);
        r2[10] -= (f32x2v){a5[0], a5[1]} * T0; r2[11] -= (f32x2v){a5[2], a5[3]} * T0;
        const f32x4 a10 = *(const LAS f32x4*)(Ab + 76);
        r2[12] -= (f32x2v){a6[0], a6[1]} * T0; r2[13] -= (f32x2v){a6[2], a6[3]} * T0;
        const f32x4 a11 = *(const LAS f32x4*)(Ab + 80);
        r2[14] -= (f32x2v){a7[0], a7[1]} * T0; r2[15] -= (f32x2v){a7[2], a7[3]} * T0;
        const f32x4 a12 = *(const LAS f32x4*)(Ab + 84);
        const float t1 = r2[0][1]; const f32x2v T1 = (f32x2v){t1, t1}; Tw[72] = f2bf(t1); Tt[1] = f2bf(t1);
        r2[1] -= (f32x2v){a8[2], a8[3]} * T1;
        const f32x4 a13 = *(const LAS f32x4*)(Ab + 88);
        r2[2] -= (f32x2v){a9[0], a9[1]} * T1; r2[3] -= (f32x2v){a9[2], a9[3]} * T1;
        const f32x4 a14 = *(const LAS f32x4*)(Ab + 92);
        r2[4] -= (f32x2v){a10[0], a10[1]} * T1; r2[5] -= (f32x2v){a10[2], a10[3]} * T1;
        const f32x4 a15 = *(const LAS f32x4*)(Ab + 96);
        r2[6] -= (f32x2v){a11[0], a11[1]} * T1; r2[7] -= (f32x2v){a11[2], a11[3]} * T1;
        const f32x4 a16 = *(const LAS f32x4*)(Ab + 136);
        r2[8] -= (f32x2v){a12[0], a12[1]} * T1; r2[9] -= (f32x2v){a12[2], a12[3]} * T1;
        const f32x4 a17 = *(const LAS f32x4*)(Ab + 140);
        r2[10] -= (f32x2v){a13[0], a13[1]} * T1; r2[11] -= (f32x2v){a13[2], a13[3]} * T1;
        const f32x4 a18 = *(const LAS f32x4*)(Ab + 144);
        r2[12] -= (f32x2v){a14[0], a14[1]} * T1; r2[13] -= (f32x2v){a14[2], a14[3]} * T1;
        const f32x4 a19 = *(const LAS f32x4*)(Ab + 148);
        r2[14] -= (f32x2v){a15[0], a15[1]} * T1; r2[15] -= (f32x2v){a15[2], a15[3]} * T1;
        const f32x4 a20 = *(const LAS f32x4*)(Ab + 152);
        const float t2 = r2[1][0]; const f32x2v T2 = (f32x2v){t2, t2}; Tw[144] = f2bf(t2); Tt[2] = f2bf(t2);
        r2[1] -= (f32x2v){a16[2], a16[3]} * T2;
        const f32x4 a21 = *(const LAS f32x4*)(Ab + 156);
        r2[2] -= (f32x2v){a17[0], a17[1]} * T2; r2[3] -= (f32x2v){a17[2], a17[3]} * T2;
        const f32x4 a22 = *(const LAS f32x4*)(Ab + 160);
        r2[4] -= (f32x2v){a18[0], a18[1]} * T2; r2[5] -= (f32x2v){a18[2], a18[3]} * T2;
        const f32x4 a23 = *(const LAS f32x4*)(Ab + 164);
        r2[6] -= (f32x2v){a19[0], a19[1]} * T2; r2[7] -= (f32x2v){a19[2], a19[3]} * T2;
        const f32x4 a24 = *(const LAS f32x4*)(Ab + 208);
        r2[8] -= (f32x2v){a20[0], a20[1]} * T2; r2[9] -= (f32x2v){a20[2], a20[3]} * T2;
        const f32x4 a25 = *(const LAS f32x4*)(Ab + 212);
        r2[10] -= (f32x2v){a21[0], a21[1]} * T2; r2[11] -= (f32x2v){a21[2], a21[3]} * T2;
        const f32x4 a26 = *(const LAS f32x4*)(Ab + 216);
        r2[12] -= (f32x2v){a22[0], a22[1]} * T2; r2[13] -= (f32x2v){a22[2], a22[3]} * T2;
        const f32x4 a27 = *(const LAS f32x4*)(Ab + 220);
        r2[14] -= (f32x2v){a23[0], a23[1]} * T2; r2[15] -= (f32x2v){a23[2], a23[3]} * T2;
        const f32x4 a28 = *(const LAS f32x4*)(Ab + 224);
        const float t3 = r2[1][1]; const f32x2v T3 = (f32x2v){t3, t3}; Tw[216] = f2bf(t3); Tt[3] = f2bf(t3);
        r2[2] -= (f32x2v){a24[0], a24[1]} * T3; r2[3] -= (f32x2v){a24[2], a24[3]} * T3;
        const f32x4 a29 = *(const LAS f32x4*)(Ab + 228);
        r2[4] -= (f32x2v){a25[0], a25[1]} * T3; r2[5] -= (f32x2v){a25[2], a25[3]} * T3;
        const f32x4 a30 = *(const LAS f32x4*)(Ab + 232);
        r2[6] -= (f32x2v){a26[0], a26[1]} * T3; r2[7] -= (f32x2v){a26[2], a26[3]} * T3;
        const f32x4 a31 = *(const LAS f32x4*)(Ab + 276);
        r2[8] -= (f32x2v){a27[0], a27[1]} * T3; r2[9] -= (f32x2v){a27[2], a27[3]} * T3;
        const f32x4 a32 = *(const LAS f32x4*)(Ab + 280);
        r2[10] -= (f32x2v){a28[0], a28[1]} * T3; r2[11] -= (f32x2v){a28[2], a28[3]} * T3;
        const f32x4 a33 = *(const LAS f32x4*)(Ab + 284);
        r2[12] -= (f32x2v){a29[0], a29[1]} * T3; r2[13] -= (f32x2v){a29[2], a29[3]} * T3;
        const f32x4 a34 = *(const LAS f32x4*)(Ab + 288);
        r2[14] -= (f32x2v){a30[0], a30[1]} * T3; r2[15] -= (f32x2v){a30[2], a30[3]} * T3;
        const f32x4 a35 = *(const LAS f32x4*)(Ab + 292);
        const float t4 = r2[2][0]; const f32x2v T4 = (f32x2v){t4, t4}; Tw[288] = f2bf(t4); Tt[4] = f2bf(t4);
        r2[2] -= (f32x2v){a31[0], a31[1]} * T4; r2[3] -= (f32x2v){a31[2], a31[3]} * T4;
        const f32x4 a36 = *(const LAS f32x4*)(Ab + 296);
        r2[4] -= (f32x2v){a32[0], a32[1]} * T4; r2[5] -= (f32x2v){a32[2], a32[3]} * T4;
        const f32x4 a37 = *(const LAS f32x4*)(Ab + 300);
        r2[6] -= (f32x2v){a33[0], a33[1]} * T4; r2[7] -= (f32x2v){a33[2], a33[3]} * T4;
        const f32x4 a38 = *(const LAS f32x4*)(Ab + 344);
        r2[8] -= (f32x2v){a34[0], a34[1]} * T4; r2[9] -= (f32x2v){a34[2], a34[3]} * T4;
        const f32x4 a39 = *(const LAS f32x4*)(Ab + 348);
        r2[10] -= (f32x2v){a35[0], a35[1]} * T4; r2[11] -= (f32x2v){a35[2], a35[3]} * T4;
        const f32x4 a40 = *(const LAS f32x4*)(Ab + 352);
        r2[12] -= (f32x2v){a36[0], a36[1]} * T4; r2[13] -= (f32x2v){a36[2], a36[3]} * T4;
        const f32x4 a41 = *(const LAS f32x4*)(Ab + 356);
        r2[14] -= (f32x2v){a37[0], a37[1]} * T4; r2[15] -= (f32x2v){a37[2], a37[3]} * T4;
        const f32x4 a42 = *(const LAS f32x4*)(Ab + 360);
        const float t5 = r2[2][1]; const f32x2v T5 = (f32x2v){t5, t5}; Tw[360] = f2bf(t5); Tt[5] = f2bf(t5);
        r2[3] -= (f32x2v){a38[2], a38[3]} * T5;
        const f32x4 a43 = *(const LAS f32x4*)(Ab + 364);
        r2[4] -= (f32x2v){a39[0], a39[1]} * T5; r2[5] -= (f32x2v){a39[2], a39[3]} * T5;
        const f32x4 a44 = *(const LAS f32x4*)(Ab + 368);
        r2[6] -= (f32x2v){a40[0], a40[1]} * T5; r2[7] -= (f32x2v){a40[2], a40[3]} * T5;
        const f32x4 a45 = *(const LAS f32x4*)(Ab + 412);
        r2[8] -= (f32x2v){a41[0], a41[1]} * T5; r2[9] -= (f32x2v){a41[2], a41[3]} * T5;
        const f32x4 a46 = *(const LAS f32x4*)(Ab + 416);
        r2[10] -= (f32x2v){a42[0], a42[1]} * T5; r2[11] -= (f32x2v){a42[2], a42[3]} * T5;
        const f32x4 a47 = *(const LAS f32x4*)(Ab + 420);
        r2[12] -= (f32x2v){a43[0], a43[1]} * T5; r2[13] -= (f32x2v){a43[2], a43[3]} * T5;
        const f32x4 a48 = *(const LAS f32x4*)(Ab + 424);
        r2[14] -= (f32x2v){a44[0], a44[1]} * T5; r2[15] -= (f32x2v){a44[2], a44[3]} * T5;
        const f32x4 a49 = *(const LAS f32x4*)(Ab + 428);
        const float t6 = r2[3][0]; const f32x2v T6 = (f32x2v){t6, t6}; Tw[432] = f2bf(t6); Tt[6] = f2bf(t6);
        r2[3] -= (f32x2v){a45[2], a45[3]} * T6;
        const f32x4 a50 = *(const LAS f32x4*)(Ab + 432);
        r2[4] -= (f32x2v){a46[0], a46[1]} * T6; r2[5] -= (f32x2v){a46[2], a46[3]} * T6;
        const f32x4 a51 = *(const LAS f32x4*)(Ab + 436);
        r2[6] -= (f32x2v){a47[0], a47[1]} * T6; r2[7] -= (f32x2v){a47[2], a47[3]} * T6;
        const f32x4 a52 = *(const LAS f32x4*)(Ab + 484);
        r2[8] -= (f32x2v){a48[0], a48[1]} * T6; r2[9] -= (f32x2v){a48[2], a48[3]} * T6;
        const f32x4 a53 = *(const LAS f32x4*)(Ab + 488);
        r2[10] -= (f32x2v){a49[0], a49[1]} * T6; r2[11] -= (f32x2v){a49[2], a49[3]} * T6;
        const f32x4 a54 = *(const LAS f32x4*)(Ab + 492);
        r2[12] -= (f32x2v){a50[0], a50[1]} * T6; r2[13] -= (f32x2v){a50[2], a50[3]} * T6;
        const f32x4 a55 = *(const LAS f32x4*)(Ab + 496);
        r2[14] -= (f32x2v){a51[0], a51[1]} * T6; r2[15] -= (f32x2v){a51[2], a51[3]} * T6;
        const f32x4 a56 = *(const LAS f32x4*)(Ab + 500);
        const float t7 = r2[3][1]; const f32x2v T7 = (f32x2v){t7, t7}; Tw[504] = f2bf(t7); Tt[7] = f2bf(t7);
        r2[4] -= (f32x2v){a52[0], a52[1]} * T7; r2[5] -= (f32x2v){a52[2], a52[3]} * T7;
        const f32x4 a57 = *(const LAS f32x4*)(Ab + 504);
        r2[6] -= (f32x2v){a53[0], a53[1]} * T7; r2[7] -= (f32x2v){a53[2], a53[3]} * T7;
        const f32x4 a58 = *(const LAS f32x4*)(Ab + 552);
        r2[8] -= (f32x2v){a54[0], a54[1]} * T7; r2[9] -= (f32x2v){a54[2], a54[3]} * T7;
        const f32x4 a59 = *(const LAS f32x4*)(Ab + 556);
        r2[10] -= (f32x2v){a55[0], a55[1]} * T7; r2[11] -= (f32x2v){a55[2], a55[3]} * T7;
        const f32x4 a60 = *(const LAS f32x4*)(Ab + 560);
        r2[12] -= (f32x2v){a56[0], a56[1]} * T7; r2[13] -= (f32x2v){a56[2], a56[3]} * T7;
        const f32x4 a61 = *(const LAS f32x4*)(Ab + 564);
        r2[14] -= (f32x2v){a57[0], a57[1]} * T7; r2[15] -= (f32x2v){a57[2], a57[3]} * T7;
        const f32x4 a62 = *(const LAS f32x4*)(Ab + 568);
        const float t8 = r2[4][0]; const f32x2v T8 = (f32x2v){t8, t8}; Tw[576] = f2bf(t8); Tt[8] = f2bf(t8);
        r2[4] -= (f32x2v){a58[0], a58[1]} * T8; r2[5] -= (f32x2v){a58[2], a58[3]} * T8;
        const f32x4 a63 = *(const LAS f32x4*)(Ab + 572);
        r2[6] -= (f32x2v){a59[0], a59[1]} * T8; r2[7] -= (f32x2v){a59[2], a59[3]} * T8;
        const f32x4 a64 = *(const LAS f32x4*)(Ab + 620);
        r2[8] -= (f32x2v){a60[0], a60[1]} * T8; r2[9] -= (f32x2v){a60[2], a60[3]} * T8;
        const f32x4 a65 = *(const LAS f32x4*)(Ab + 624);
        r2[10] -= (f32x2v){a61[0], a61[1]} * T8; r2[11] -= (f32x2v){a61[2], a61[3]} * T8;
        const f32x4 a66 = *(const LAS f32x4*)(Ab + 628);
        r2[12] -= (f32x2v){a62[0], a62[1]} * T8; r2[13] -= (f32x2v){a62[2], a62[3]} * T8;
        const f32x4 a67 = *(const LAS f32x4*)(Ab + 632);
        r2[14] -= (f32x2v){a63[0], a63[1]} * T8; r2[15] -= (f32x2v){a63[2], a63[3]} * T8;
        const f32x4 a68 = *(const LAS f32x4*)(Ab + 636);
        const float t9 = r2[4][1]; const f32x2v T9 = (f32x2v){t9, t9}; Tw[648] = f2bf(t9); Tt[9] = f2bf(t9);
        r2[5] -= (f32x2v){a64[2], a64[3]} * T9;
        const f32x4 a69 = *(const LAS f32x4*)(Ab + 640);
        r2[6] -= (f32x2v){a65[0], a65[1]} * T9; r2[7] -= (f32x2v){a65[2], a65[3]} * T9;
        const f32x4 a70 = *(const LAS f32x4*)(Ab + 688);
        r2[8] -= (f32x2v){a66[0], a66[1]} * T9; r2[9] -= (f32x2v){a66[2], a66[3]} * T9;
        const f32x4 a71 = *(const LAS f32x4*)(Ab + 692);
        r2[10] -= (f32x2v){a67[0], a67[1]} * T9; r2[11] -= (f32x2v){a67[2], a67[3]} * T9;
        const f32x4 a72 = *(const LAS f32x4*)(Ab + 696);
        r2[12] -= (f32x2v){a68[0], a68[1]} * T9; r2[13] -= (f32x2v){a68[2], a68[3]} * T9;
        const f32x4 a73 = *(const LAS f32x4*)(Ab + 700);
        r2[14] -= (f32x2v){a69[0], a69[1]} * T9; r2[15] -= (f32x2v){a69[2], a69[3]} * T9;
        const f32x4 a74 = *(const LAS f32x4*)(Ab + 704);
        const float t10 = r2[5][0]; const f32x2v T10 = (f32x2v){t10, t10}; Tw[720] = f2bf(t10); Tt[10] = f2bf(t10);
        r2[5] -= (f32x2v){a70[2], a70[3]} * T10;
        const f32x4 a75 = *(const LAS f32x4*)(Ab + 708);
        r2[6] -= (f32x2v){a71[0], a71[1]} * T10; r2[7] -= (f32x2v){a71[2], a71[3]} * T10;
        const f32x4 a76 = *(const LAS f32x4*)(Ab + 760);
        r2[8] -= (f32x2v){a72[0], a72[1]} * T10; r2[9] -= (f32x2v){a72[2], a72[3]} * T10;
        const f32x4 a77 = *(const LAS f32x4*)(Ab + 764);
        r2[10] -= (f32x2v){a73[0], a73[1]} * T10; r2[11] -= (f32x2v){a73[2], a73[3]} * T10;
        const f32x4 a78 = *(const LAS f32x4*)(Ab + 768);
        r2[12] -= (f32x2v){a74[0], a74[1]} * T10; r2[13] -= (f32x2v){a74[2], a74[3]} * T10;
        const f32x4 a79 = *(const LAS f32x4*)(Ab + 772);
        r2[14] -= (f32x2v){a75[0], a75[1]} * T10; r2[15] -= (f32x2v){a75[2], a75[3]} * T10;
        const f32x4 a80 = *(const LAS f32x4*)(Ab + 776);
        const float t11 = r2[5][1]; const f32x2v T11 = (f32x2v){t11, t11}; Tw[792] = f2bf(t11); Tt[11] = f2bf(t11);
        r2[6] -= (f32x2v){a76[0], a76[1]} * T11; r2[7] -= (f32x2v){a76[2], a76[3]} * T11;
        const f32x4 a81 = *(const LAS f32x4*)(Ab + 828);
        r2[8] -= (f32x2v){a77[0], a77[1]} * T11; r2[9] -= (f32x2v){a77[2], a77[3]} * T11;
        const f32x4 a82 = *(const LAS f32x4*)(Ab + 832);
        r2[10] -= (f32x2v){a78[0], a78[1]} * T11; r2[11] -= (f32x2v){a78[2], a78[3]} * T11;
        const f32x4 a83 = *(const LAS f32x4*)(Ab + 836);
        r2[12] -= (f32x2v){a79[0], a79[1]} * T11; r2[13] -= (f32x2v){a79[2], a79[3]} * T11;
        const f32x4 a84 = *(const LAS f32x4*)(Ab + 840);
        r2[14] -= (f32x2v){a80[0], a80[1]} * T11; r2[15] -= (f32x2v){a80[2], a80[3]} * T11;
        const f32x4 a85 = *(const LAS f32x4*)(Ab + 844);
        const float t12 = r2[6][0]; const f32x2v T12 = (f32x2v){t12, t12}; Tw[864] = f2bf(t12); Tt[12] = f2bf(t12);
        r2[6] -= (f32x2v){a81[0], a81[1]} * T12; r2[7] -= (f32x2v){a81[2], a81[3]} * T12;
        const f32x4 a86 = *(const LAS f32x4*)(Ab + 896);
        r2[8] -= (f32x2v){a82[0], a82[1]} * T12; r2[9] -= (f32x2v){a82[2], a82[3]} * T12;
        const f32x4 a87 = *(const LAS f32x4*)(Ab + 900);
        r2[10] -= (f32x2v){a83[0], a83[1]} * T12; r2[11] -= (f32x2v){a83[2], a83[3]} * T12;
        const f32x4 a88 = *(const LAS f32x4*)(Ab + 904);
        r2[12] -= (f32x2v){a84[0], a84[1]} * T12; r2[13] -= (f32x2v){a84[2], a84[3]} * T12;
        const f32x4 a89 = *(const LAS f32x4*)(Ab + 908);
        r2[14] -= (f32x2v){a85[0], a85[1]} * T12; r2[15] -= (f32x2v){a85[2], a85[3]} * T12;
        const f32x4 a90 = *(const LAS f32x4*)(Ab + 912);
        const float t13 = r2[6][1]; const f32x2v T13 = (f32x2v){t13, t13}; Tw[936] = f2bf(t13); Tt[13] = f2bf(t13);
        r2[7] -= (f32x2v){a86[2], a86[3]} * T13;
        const f32x4 a91 = *(const LAS f32x4*)(Ab + 964);
        r2[8] -= (f32x2v){a87[0], a87[1]} * T13; r2[9] -= (f32x2v){a87[2], a87[3]} * T13;
        const f32x4 a92 = *(const LAS f32x4*)(Ab + 968);
        r2[10] -= (f32x2v){a88[0], a88[1]} * T13; r2[11] -= (f32x2v){a88[2], a88[3]} * T13;
        const f32x4 a93 = *(const LAS f32x4*)(Ab + 972);
        r2[12] -= (f32x2v){a89[0], a89[1]} * T13; r2[13] -= (f32x2v){a89[2], a89[3]} * T13;
        const f32x4 a94 = *(const LAS f32x4*)(Ab + 976);
        r2[14] -= (f32x2v){a90[0], a90[1]} * T13; r2[15] -= (f32x2v){a90[2], a90[3]} * T13;
        const f32x4 a95 = *(const LAS f32x4*)(Ab + 980);
        const float t14 = r2[7][0]; const f32x2v T14 = (f32x2v){t14, t14}; Tw[1008] = f2bf(t14); Tt[14] = f2bf(t14);
        r2[7] -= (f32x2v){a91[2], a91[3]} * T14;
        const f32x4 a96 = *(const LAS f32x4*)(Ab + 1036);
        r2[8] -= (f32x2v){a92[0], a92[1]} * T14; r2[9] -= (f32x2v){a92[2], a92[3]} * T14;
        const f32x4 a97 = *(const LAS f32x4*)(Ab + 1040);
        r2[10] -= (f32x2v){a93[0], a93[1]} * T14; r2[11] -= (f32x2v){a93[2], a93[3]} * T14;
        const f32x4 a98 = *(const LAS f32x4*)(Ab + 1044);
        r2[12] -= (f32x2v){a94[0], a94[1]} * T14; r2[13] -= (f32x2v){a94[2], a94[3]} * T14;
        const f32x4 a99 = *(const LAS f32x4*)(Ab + 1048);
        r2[14] -= (f32x2v){a95[0], a95[1]} * T14; r2[15] -= (f32x2v){a95[2], a95[3]} * T14;
        const f32x4 a100 = *(const LAS f32x4*)(Ab + 1104);
        const float t15 = r2[7][1]; const f32x2v T15 = (f32x2v){t15, t15}; Tw[1080] = f2bf(t15); Tt[15] = f2bf(t15);
        r2[8] -= (f32x2v){a96[0], a96[1]} * T15; r2[9] -= (f32x2v){a96[2], a96[3]} * T15;
        const f32x4 a101 = *(const LAS f32x4*)(Ab + 1108);
        r2[10] -= (f32x2v){a97[0], a97[1]} * T15; r2[11] -= (f32x2v){a97[2], a97[3]} * T15;
        const f32x4 a102 = *(const LAS f32x4*)(Ab + 1112);
        r2[12] -= (f32x2v){a98[0], a98[1]} * T15; r2[13] -= (f32x2v){a98[2], a98[3]} * T15;
        const f32x4 a103 = *(const LAS f32x4*)(Ab + 1116);
        r2[14] -= (f32x2v){a99[0], a99[1]} * T15; r2[15] -= (f32x2v){a99[2], a99[3]} * T15;
        const f32x4 a104 = *(const LAS f32x4*)(Ab + 1172);
        const float t16 = r2[8][0]; const f32x2v T16 = (f32x2v){t16, t16}; Tw[1152] = f2bf(t16); Tt[16] = f2bf(t16);
        r2[8] -= (f32x2v){a100[0], a100[1]} * T16; r2[9] -= (f32x2v){a100[2], a100[3]} * T16;
        const f32x4 a105 = *(const LAS f32x4*)(Ab + 1176);
        r2[10] -= (f32x2v){a101[0], a101[1]} * T16; r2[11] -= (f32x2v){a101[2], a101[3]} * T16;
        const f32x4 a106 = *(const LAS f32x4*)(Ab + 1180);
        r2[12] -= (f32x2v){a102[0], a102[1]} * T16; r2[13] -= (f32x2v){a102[2], a102[3]} * T16;
        const f32x4 a107 = *(const LAS f32x4*)(Ab + 1184);
        r2[14] -= (f32x2v){a103[0], a103[1]} * T16; r2[15] -= (f32x2v){a103[2], a103[3]} * T16;
        const f32x4 a108 = *(const LAS f32x4*)(Ab + 1240);
        const float t17 = r2[8][1]; const f32x2v T17 = (f32x2v){t17, t17}; Tw[1224] = f2bf(t17); Tt[17] = f2bf(t17);
        r2[9] -= (f32x2v){a104[2], a104[3]} * T17;
        const f32x4 a109 = *(const LAS f32x4*)(Ab + 1244);
        r2[10] -= (f32x2v){a105[0], a105[1]} * T17; r2[11] -= (f32x2v){a105[2], a105[3]} * T17;
        const f32x4 a110 = *(const LAS f32x4*)(Ab + 1248);
        r2[12] -= (f32x2v){a106[0], a106[1]} * T17; r2[13] -= (f32x2v){a106[2], a106[3]} * T17;
        const f32x4 a111 = *(const LAS f32x4*)(Ab + 1252);
        r2[14] -= (f32x2v){a107[0], a107[1]} * T17; r2[15] -= (f32x2v){a107[2], a107[3]} * T17;
        const f32x4 a112 = *(const LAS f32x4*)(Ab + 1312);
        const float t18 = r2[9][0]; const f32x2v T18 = (f32x2v){t18, t18}; Tw[1296] = f2bf(t18); Tt[18] = f2bf(t18);
        r2[9] -= (f32x2v){a108[2], a108[3]} * T18;
        const f32x4 a113 = *(const LAS f32x4*)(Ab + 1316);
        r2[10] -= (f32x2v){a109[0], a109[1]} * T18; r2[11] -= (f32x2v){a109[2], a109[3]} * T18;
        const f32x4 a114 = *(const LAS f32x4*)(Ab + 1320);
        r2[12] -= (f32x2v){a110[0], a110[1]} * T18; r2[13] -= (f32x2v){a110[2], a110[3]} * T18;
        const f32x4 a115 = *(const LAS f32x4*)(Ab + 1380);
        r2[14] -= (f32x2v){a111[0], a111[1]} * T18; r2[15] -= (f32x2v){a111[2], a111[3]} * T18;
        const f32x4 a116 = *(const LAS f32x4*)(Ab + 1384);
        const float t19 = r2[9][1]; const f32x2v T19 = (f32x2v){t19, t19}; Tw[1368] = f2bf(t19); Tt[19] = f2bf(t19);
        r2[10] -= (f32x2v){a112[0], a112[1]} * T19; r2[11] -= (f32x2v){a112[2], a112[3]} * T19;
        const f32x4 a117 = *(const LAS f32x4*)(Ab + 1388);
        r2[12] -= (f32x2v){a113[0], a113[1]} * T19; r2[13] -= (f32x2v){a113[2], a113[3]} * T19;
        const f32x4 a118 = *(const LAS f32x4*)(Ab + 1448);
        r2[14] -= (f32x2v){a114[0], a114[1]} * T19; r2[15] -= (f32x2v){a114[2], a114[3]} * T19;
        const f32x4 a119 = *(const LAS f32x4*)(Ab + 1452);
        const float t20 = r2[10][0]; const f32x2v T20 = (f32x2v){t20, t20}; Tw[1440] = f2bf(t20); Tt[20] = f2bf(t20);
        r2[10] -= (f32x2v){a115[0], a115[1]} * T20; r2[11] -= (f32x2v){a115[2], a115[3]} * T20;
        const f32x4 a120 = *(const LAS f32x4*)(Ab + 1456);
        r2[12] -= (f32x2v){a116[0], a116[1]} * T20; r2[13] -= (f32x2v){a116[2], a116[3]} * T20;
        const f32x4 a121 = *(const LAS f32x4*)(Ab + 1516);
        r2[14] -= (f32x2v){a117[0], a117[1]} * T20; r2[15] -= (f32x2v){a117[2], a117[3]} * T20;
        const f32x4 a122 = *(const LAS f32x4*)(Ab + 1520);
        const float t21 = r2[10][1]; const f32x2v T21 = (f32x2v){t21, t21}; Tw[1512] = f2bf(t21); Tt[21] = f2bf(t21);
        r2[11] -= (f32x2v){a118[2], a118[3]} * T21;
        const f32x4 a123 = *(const LAS f32x4*)(Ab + 1524);
        r2[12] -= (f32x2v){a119[0], a119[1]} * T21; r2[13] -= (f32x2v){a119[2], a119[3]} * T21;
        const f32x4 a124 = *(const LAS f32x4*)(Ab + 1588);
        r2[14] -= (f32x2v){a120[0], a120[1]} * T21; r2[15] -= (f32x2v){a120[2], a120[3]} * T21;
        const f32x4 a125 = *(const LAS f32x4*)(Ab + 1592);
        const float t22 = r2[11][0]; const f32x2v T22 = (f32x2v){t22, t22}; Tw[1584] = f2bf(t22); Tt[22] = f2bf(t22);
        r2[11] -= (f32x2v){a121[2], a121[3]} * T22;
        const f32x4 a126 = *(const LAS f32x4*)(Ab + 1656);
        r2[12] -= (f32x2v){a122[0], a122[1]} * T22; r2[13] -= (f32x2v){a122[2], a122[3]} * T22;
        const f32x4 a127 = *(const LAS f32x4*)(Ab + 1660);
        r2[14] -= (f32x2v){a123[0], a123[1]} * T22; r2[15] -= (f32x2v){a123[2], a123[3]} * T22;
        const f32x4 a128 = *(const LAS f32x4*)(Ab + 1724);
        const float t23 = r2[11][1]; const f32x2v T23 = (f32x2v){t23, t23}; Tw[1656] = f2bf(t23); Tt[23] = f2bf(t23);
        r2[12] -= (f32x2v){a124[0], a124[1]} * T23; r2[13] -= (f32x2v){a124[2], a124[3]} * T23;
        const f32x4 a129 = *(const LAS f32x4*)(Ab + 1728);
        r2[14] -= (f32x2v){a125[0], a125[1]} * T23; r2[15] -= (f32x2v){a125[2], a125[3]} * T23;
        const f32x4 a130 = *(const LAS f32x4*)(Ab + 1792);
        const float t24 = r2[12][0]; const f32x2v T24 = (f32x2v){t24, t24}; Tw[1728] = f2bf(t24); Tt[24] = f2bf(t24);
        r2[12] -= (f32x2v){a126[0], a126[1]} * T24; r2[13] -= (f32x2v){a126[2], a126[3]} * T24;
        const f32x4 a131 = *(const LAS f32x4*)(Ab + 1796);
        r2[14] -= (f32x2v){a127[0], a127[1]} * T24; r2[15] -= (f32x2v){a127[2], a127[3]} * T24;
        const f32x4 a132 = *(const LAS f32x4*)(Ab + 1864);
        const float t25 = r2[12][1]; const f32x2v T25 = (f32x2v){t25, t25}; Tw[1800] = f2bf(t25); Tt[25] = f2bf(t25);
        r2[13] -= (f32x2v){a128[2], a128[3]} * T25;
        const f32x4 a133 = *(const LAS f32x4*)(Ab + 1932);
        r2[14] -= (f32x2v){a129[0], a129[1]} * T25; r2[15] -= (f32x2v){a129[2], a129[3]} * T25;
        const f32x4 a134 = *(const LAS f32x4*)(Ab + 2000);
        const float t26 = r2[13][0]; const f32x2v T26 = (f32x2v){t26, t26}; Tw[1872] = f2bf(t26); Tt[26] = f2bf(t26);
        r2[13] -= (f32x2v){a130[2], a130[3]} * T26;
        const f32x4 a135 = *(const LAS f32x4*)(Ab + 2068);
        r2[14] -= (f32x2v){a131[0], a131[1]} * T26; r2[15] -= (f32x2v){a131[2], a131[3]} * T26;
        const float t27 = r2[13][1]; const f32x2v T27 = (f32x2v){t27, t27}; Tw[1944] = f2bf(t27); Tt[27] = f2bf(t27);
        r2[14] -= (f32x2v){a132[0], a132[1]} * T27; r2[15] -= (f32x2v){a132[2], a132[3]} * T27;
        const float t28 = r2[14][0]; const f32x2v T28 = (f32x2v){t28, t28}; Tw[2016] = f2bf(t28); Tt[28] = f2bf(t28);
        r2[14] -= (f32x2v){a133[0], a133[1]} * T28; r2[15] -= (f32x2v){a133[2], a133[3]} * T28;
        const float t29 = r2[14][1]; const f32x2v T29 = (f32x2v){t29, t29}; Tw[2088] = f2bf(t29); Tt[29] = f2bf(t29);
        r2[15] -= (f32x2v){a134[2], a134[3]} * T29;
        const float t30 = r2[15][0]; const f32x2v T30 = (f32x2v){t30, t30}; Tw[2160] = f2bf(t30); Tt[30] = f2bf(t30);
        r2[15] -= (f32x2v){a135[2], a135[3]} * T30;
        Tw[2232] = f2bf(r2[15][1]); Tt[31] = f2bf(r2[15][1]);
    } else if (wid == 2) {
        *(LAS u32x4*)(Tb + (lane >> 1) * 72 + 32 + (lane & 1) * 16) = (u32x4){0u, 0u, 0u, 0u}; *(LAS u32x4*)(Tb + (lane >> 1) * 72 + 32 + (lane & 1) * 16 + 8) = (u32x4){0u, 0u, 0u, 0u};
    }
    __syncthreads();
    if (wid < 4) {
        const int mt = wid >> 1, nt = wid & 1; const f32x4 acc = tile_mm(A10b, 40, mt, TT, 40, nt, 1, fr, fq);
        u32x2 w; w.x = cvt_pk(acc[0], acc[1]); w.y = cvt_pk(acc[2], acc[3]); *(LAS u32x2*)(PT + (16 * nt + fr) * 40 + 16 * mt + 4 * fq) = w;
    }
    __syncthreads();
    if (wid < 4) {
        const int mt = wid >> 1, nt = wid & 1; const f32x4 acc = tile_mm(Tb + 32 * 72 + 32, 72, mt, PT, 40, nt, 1, fr, fq);
#pragma unroll
        for (int e = 0; e < 4; ++e) Tb[(32 + 16 * mt + 4 * fq + e) * 72 + 16 * nt + fr] = f2bf(-acc[e]);
    }
    __syncthreads();
#pragma unroll 2
    for (int r = 0; r < 8; ++r) {
        const int job = wid + 8 * r, kind = job >> 5, tile = job & 31, mt = tile >> 3, nt = tile & 7;
        const f32x4 acc = tile_mm<false, true>(Tb, 72, mt, kind ? KbT : VbT, 72, nt, 2, fr, fq);
        u32x2 w; w.x = cvt_pk(acc[0], acc[1]); w.y = cvt_pk(acc[2], acc[3]);
        { const int ch = 16 * nt + fr; *(LAS u32x2*)((kind ? WT : UT) + ch * 72 + 8 * ((2 * mt + (fq >> 1)) ^ ((ch >> 3) & 7)) + 4 * (fq & 1)) = w; }
    }
    __syncthreads();
    bf16_t* GM = (bf16_t*)(p.ws + WS_GM) + (size_t)unit * 16384; bf16_t* GN = (bf16_t*)(p.ws + WS_GN) + (size_t)unit * 16384;
    bf16_t* GQ = (bf16_t*)(p.ws + WS_GQ) + (size_t)unit * 8192; bf16_t* GO = (bf16_t*)(p.ws + WS_GO) + (size_t)unit * 8192;
#pragma unroll 2
    for (int r = 0; r < 24; ++r) {
        const int job = wid + 8 * r;
        if (job < 64) { const int a = job >> 3, mt = job & 7;
            const f32x4 acc = tile_mm<true, true>(WT, 72, a, KdT, 72, mt, 2, fr, fq);
            u32x2 w; w.x = cvt_pk(-acc[0], -acc[1]); w.y = cvt_pk(-acc[2], -acc[3]);
            *(u32x2*)(GM + ((mt * 4 + (a >> 1)) * 64 + lane) * 8 + (a & 1) * 4) = w;
        } else if (job < 128) { const int j = job - 64, mt = j >> 3, nt = j & 7;
            const f32x4 acc = tile_mm<true, true>(KdT, 72, mt, UT, 72, nt, 2, fr, fq);
            u32x2 w; w.x = cvt_pk(acc[0], acc[1]); w.y = cvt_pk(acc[2], acc[3]);
            *(u32x2*)(GN + ((nt * 64 + lane) * 8 + mt) * 4) = w;
        } else if (job < 160) { const int j = job - 128, a = j >> 2, it = j & 3;
            const f32x4 acc = tile_mm<true, false>(WT, 72, a, QK, 72, it, 2, fr, fq);
            const int i = 16 * it + fr; const float eg = __expf(gcs[i]);
            const u32x2 qv = *(const LAS u32x2*)(Qs + i * 136 + 16 * a + 4 * fq);
            u32x2 w; w.x = cvt_pk(bflo(qv.x) * eg - acc[0], bfhi(qv.x) * eg - acc[1]); w.y = cvt_pk(bflo(qv.y) * eg - acc[2], bfhi(qv.y) * eg - acc[3]);
            *(u32x2*)(GQ + ((it * 4 + (a >> 1)) * 64 + lane) * 8 + (a & 1) * 4) = w;
        } else { const int j = job - 160, mt = j >> 3, nt = j & 7;
            const f32x4 acc = tile_mm<false, true>(QK, 72, mt, UT, 72, nt, 2, fr, fq);
            u32x2 w; w.x = cvt_pk(acc[0], acc[1]); w.y = cvt_pk(acc[2], acc[3]);
            *(u32x2*)(GO + ((nt * 64 + lane) * 4 + mt) * 4) = w;
        }
    }
    if (tid == 0) ((float*)(p.ws + WS_CTL + CTL_GLAST))[unit] = __expf(gclast);
    __syncthreads();
}

__device__ __forceinline__ void gdn_scan(const Params& p, LAS unsigned char* lds, int sb) {
    const int tid = threadIdx.x, lane = tid & 63, wid = tid >> 6, fr = lane & 15, fq = lane >> 4;
    const int bh = sb / (8 / CW), sp = sb % (8 / CW), unit0 = bh * 128, sl = sp * CW + wid;
    const u32x4* GMb = (const u32x4*)((const bf16_t*)(p.ws + WS_GM) + (size_t)unit0 * 16384);
    const u32x4* GQb = (const u32x4*)((const bf16_t*)(p.ws + WS_GQ) + (size_t)unit0 * 8192);
    const bf16_t* GNb = (const bf16_t*)(p.ws + WS_GN) + (size_t)unit0 * 16384;
    bf16_t* GOb = (bf16_t*)(p.ws + WS_GO) + (size_t)unit0 * 8192;
    const float* glast = (const float*)(p.ws + WS_CTL + CTL_GLAST) + unit0;
    const bool loader = (wid >= CW && wid < CW + 4);
#define SCAN_DMA(cc) do { _Pragma("unroll") for (int k = 0; k < 8; ++k) { const int inst = (wid - CW) * 8 + k; \
        __builtin_amdgcn_global_load_lds((const unsigned*)((const char*)(GMb + (size_t)(cc) * 2048) + inst * 1024 + lane * 16), (LAS unsigned*)(lds + ((cc) & 3) * 32768 + inst * 1024), 16, 0, 0); } } while (0)
#define SCAN_LOADN(dn, cc) do { const bf16_t* np_ = GNb + (size_t)((cc) < 128 ? (cc) : 127) * 16384 + (size_t)(sl * 64 + lane) * 32; \
        asm volatile("global_load_dwordx4 %0, %4, off\n\tglobal_load_dwordx4 %1, %4, off offset:16\n\tglobal_load_dwordx4 %2, %4, off offset:32\n\tglobal_load_dwordx4 %3, %4, off offset:48" \
            : "=&v"(dn[0]), "=&v"(dn[1]), "=&v"(dn[2]), "=&v"(dn[3]) : "v"(np_) : "memory"); } while (0)
#define SCAN_WAITN(dn, N) asm volatile("s_waitcnt vmcnt(" #N ")" : "+v"(dn[0]), "+v"(dn[1]), "+v"(dn[2]), "+v"(dn[3]) :: "memory")
#define SCAN_STEP(c, nn, RELOAD) do { \
        SCAN_WAITN(nn, 8); \
        const float gl = __shfl(((c) < 64) ? glr0 : glr1, (c) & 63); bf16x8 Sb[4]; \
        bf16_t* scp = (bf16_t*)GNb + (size_t)(c) * 16384 + (size_t)sl * 2048 + lane * 8; \
        _Pragma("unroll") for (int ks = 0; ks < 4; ++ks) { u32x4 w; w.x = cvt_pk(S[2 * ks][0], S[2 * ks][1]); w.y = cvt_pk(S[2 * ks][2], S[2 * ks][3]); \
            w.z = cvt_pk(S[2 * ks + 1][0], S[2 * ks + 1][1]); w.w = cvt_pk(S[2 * ks + 1][2], S[2 * ks + 1][3]); Sb[ks] = __builtin_bit_cast(bf16x8, w); } \
        const LAS unsigned char* slot = lds + ((c) & 3) * 32768 + lane * 16; \
        bf16x8 fa[2][2][4]; \
        _Pragma("unroll") for (int ks = 0; ks < 4; ++ks) { fa[0][0][ks] = *(const LAS bf16x8*)(slot + (0 * 4 + ks) * 1024); fa[0][1][ks] = *(const LAS bf16x8*)(slot + (1 * 4 + ks) * 1024); } \
        _Pragma("unroll") for (int mt = 0; mt < 8; ++mt) { const unsigned w0 = nn[mt >> 1][(mt & 1) * 2], w1 = nn[mt >> 1][(mt & 1) * 2 + 1]; \
            S[mt] = S[mt] * gl + (f32x4){bflo(w0), bfhi(w0), bflo(w1), bfhi(w1)}; } \
        _Pragma("unroll") for (int ks = 0; ks < 4; ++ks) *(u32x4*)(scp + ks * 512) = __builtin_bit_cast(u32x4, Sb[ks]);     \
        RELOAD; \
        _Pragma("unroll") for (int pr = 0; pr < 4; ++pr) { \
            if (pr < 3) { _Pragma("unroll") for (int ks = 0; ks < 4; ++ks) { fa[(pr + 1) & 1][0][ks] = *(const LAS bf16x8*)(slot + ((2 * pr + 2) * 4 + ks) * 1024); fa[(pr + 1) & 1][1][ks] = *(const LAS bf16x8*)(slot + ((2 * pr + 3) * 4 + ks) * 1024); } } \
            _Pragma("unroll") for (int ks = 0; ks < 4; ++ks) { S[2 * pr] = mfma16(fa[pr & 1][0][ks], Sb[ks], S[2 * pr]); S[2 * pr + 1] = mfma16(fa[pr & 1][1][ks], Sb[ks], S[2 * pr + 1]); } } \
        } while (0)
    if (loader) { SCAN_DMA(0); SCAN_DMA(1); SCAN_DMA(2); asm volatile("s_waitcnt vmcnt(0)" ::: "memory"); }
    f32x4 S[8];
#pragma unroll
    for (int mt = 0; mt < 8; ++mt) S[mt] = (f32x4){0.f, 0.f, 0.f, 0.f};
    float glr0 = glast[lane], glr1 = glast[64 + lane];
    asm volatile("" : "+v"(glr0), "+v"(glr1));
    u32x4 nnA[4], nnB[4];
    if (wid < CW) { SCAN_LOADN(nnA, 0); SCAN_LOADN(nnB, 1); SCAN_WAITN(nnA, 0); SCAN_WAITN(nnB, 0); }
    asm volatile("s_waitcnt lgkmcnt(0)" ::: "memory"); __builtin_amdgcn_s_barrier(); asm volatile("" ::: "memory");
#pragma unroll 1
    for (int c = 0; c < 128; c += 2) {
        if (loader) { if (c + 3 < 128) { SCAN_DMA(c + 3); asm volatile("s_waitcnt vmcnt(16)" ::: "memory"); } else asm volatile("s_waitcnt vmcnt(0)" ::: "memory"); }
        else if (wid < CW) { SCAN_STEP(c, nnA, SCAN_LOADN(nnA, c + 2)); }
        asm volatile("s_waitcnt lgkmcnt(0)" ::: "memory"); __builtin_amdgcn_s_barrier(); asm volatile("" ::: "memory");
        if (loader) { if (c + 4 < 128) { SCAN_DMA(c + 4); asm volatile("s_waitcnt vmcnt(16)" ::: "memory"); } else asm volatile("s_waitcnt vmcnt(0)" ::: "memory"); }
        else if (wid < CW) { SCAN_STEP(c + 1, nnB, SCAN_LOADN(nnB, c + 3)); }
        asm volatile("s_waitcnt lgkmcnt(0)" ::: "memory"); __builtin_amdgcn_s_barrier(); asm volatile("" ::: "memory");
    }
#undef SCAN_DMA
#undef SCAN_LOADN
#undef SCAN_WAITN
#undef SCAN_STEP
    __syncthreads();
    if (wid < CW) {
        float* go = p.out + O_GP + (size_t)bh * 16384;
#pragma unroll
        for (int mt = 0; mt < 8; ++mt)
#pragma unroll
            for (int e = 0; e < 4; ++e) go[(16 * mt + 4 * fq + e) * 128 + sl * 16 + fr] = S[mt][e];
    }
}

__device__ __forceinline__ void gdn_gate_unit(const Params& p, int unit, int lane) {
    const int fr = lane & 15, fq = lane >> 4, bh = unit >> 7, n = unit & 127, b = bh >> 2, h = bh & 3, tok0 = b * SEQ + n * 64;
    const bf16_t* GO = (const bf16_t*)(p.ws + WS_GO) + (size_t)unit * 8192;
    bf16_t* PB = (bf16_t*)(p.ws + WS_H);
    {
        bf16_t* GOw = (bf16_t*)(p.ws + WS_GO) + (size_t)unit * 8192;
        const bf16_t* GQ = (const bf16_t*)(p.ws + WS_GQ) + (size_t)unit * 8192; const bf16_t* SC = (const bf16_t*)(p.ws + WS_GN) + (size_t)unit * 16384;
        bf16x8 qa[4][4];
#pragma unroll
        for (int mt = 0; mt < 4; ++mt)
#pragma unroll
            for (int ks = 0; ks < 4; ++ks) qa[mt][ks] = *(const bf16x8*)(GQ + ((mt * 4 + ks) * 64 + lane) * 8);
#pragma unroll 2
        for (int nt = 0; nt < 8; ++nt) {
            bf16x8 sb[4];
#pragma unroll
            for (int ks = 0; ks < 4; ++ks) sb[ks] = *(const bf16x8*)(SC + nt * 2048 + (ks * 64 + lane) * 8);
            const u32x4 o0 = *(const u32x4*)(GOw + (nt * 64 + lane) * 16), o1 = *(const u32x4*)(GOw + (nt * 64 + lane) * 16 + 8);
            f32x4 acc[4];
            acc[0] = (f32x4){bflo(o0.x), bfhi(o0.x), bflo(o0.y), bfhi(o0.y)}; acc[1] = (f32x4){bflo(o0.z), bfhi(o0.z), bflo(o0.w), bfhi(o0.w)};
            acc[2] = (f32x4){bflo(o1.x), bfhi(o1.x), bflo(o1.y), bfhi(o1.y)}; acc[3] = (f32x4){bflo(o1.z), bfhi(o1.z), bflo(o1.w), bfhi(o1.w)};
#pragma unroll
            for (int ks = 0; ks < 4; ++ks)
#pragma unroll
                for (int mt = 0; mt < 4; ++mt) acc[mt] = mfma16(qa[mt][ks], sb[ks], acc[mt]);
            u32x4 w0, w1;
            w0.x = cvt_pk(acc[0][0], acc[0][1]); w0.y = cvt_pk(acc[0][2], acc[0][3]); w0.z = cvt_pk(acc[1][0], acc[1][1]); w0.w = cvt_pk(acc[1][2], acc[1][3]);
            w1.x = cvt_pk(acc[2][0], acc[2][1]); w1.y = cvt_pk(acc[2][2], acc[2][3]); w1.z = cvt_pk(acc[3][0], acc[3][1]); w1.w = cvt_pk(acc[3][2], acc[3][3]);
            *(u32x4*)(GOw + (nt * 64 + lane) * 16) = w0; *(u32x4*)(GOw + (nt * 64 + lane) * 16 + 8) = w1;
        }
        asm volatile("s_waitcnt vmcnt(0)" ::: "memory");
    }
    float ssq[16];
#pragma unroll
    for (int k = 0; k < 16; ++k) ssq[k] = 0.f;
#pragma unroll 1
    for (int nt = 0; nt < 8; ++nt) {
        const u32x4 a0 = *(const u32x4*)(GO + (nt * 64 + lane) * 16), a1 = *(const u32x4*)(GO + (nt * 64 + lane) * 16 + 8);
#pragma unroll
        for (int k = 0; k < 4; ++k) { const float l0 = bflo(a0[k]), h0 = bfhi(a0[k]), l1 = bflo(a1[k]), h1 = bfhi(a1[k]);
            ssq[2 * k] += l0 * l0; ssq[2 * k + 1] += h0 * h0; ssq[8 + 2 * k] += l1 * l1; ssq[8 + 2 * k + 1] += h1 * h1; }
    }
#pragma unroll
    for (int k = 0; k < 16; ++k) { float s = row16_sum(ssq[k]); ssq[k] = rsqrtf(s * (1.0f / 128.0f) + EPS); }
    const float* gn = p.in[15];
#pragma unroll 1
    for (int nt = 0; nt < 8; ++nt) {
        const int dv = 16 * nt + fr; const float g = gn[dv];
        const u32x4 a0 = *(const u32x4*)(GO + (nt * 64 + lane) * 16), a1 = *(const u32x4*)(GO + (nt * 64 + lane) * 16 + 8);
        const bf16_t* gzp = PB + (size_t)(tok0 + 4 * fq) * PW + 2304 + h * 128 + dv; bf16_t* mp = PB + (size_t)(tok0 + 4 * fq) * PW + 512 + h * 128 + dv;
#pragma unroll
        for (int k = 0; k < 16; ++k) {
            const unsigned w = (k < 8) ? a0[(k >> 1) & 3] : a1[(k >> 1) & 3]; const float o = (k & 1) ? bfhi(w) : bflo(w);
            const int to = 16 * (k >> 2) + (k & 3);
            const float gz = bf2f(gzp[(size_t)to * PW]);
            mp[(size_t)to * PW] = f2bf(o * ssq[k] * g * silu(gz));
        }
    }
}

__device__ __forceinline__ void attn_unit(const Params& p, LAS unsigned char* lds, int unit) {
    const int tid = threadIdx.x, lane = tid & 63, wid = tid >> 6, fr = lane & 15, fq = lane >> 4;
    const int b = unit >> 7, blk = (unit >> 1) & 63, kvh = unit & 1;
    LAS bf16_t* Ks = (LAS bf16_t*)lds; LAS bf16_t* Vt = (LAS bf16_t*)(lds + 36864);
    bf16_t* PB = (bf16_t*)(p.ws + WS_H);
    __syncthreads();
#pragma unroll
    for (int i = 0; i < 4; ++i) {
        const int q = tid + 512 * i, row = q >> 3, ch = q & 7, tp = blk * 128 - 128 + row;
        u32x4 kv = (u32x4){0u, 0u, 0u, 0u}, vv = (u32x4){0u, 0u, 0u, 0u};
        if (tp >= 0) { const bf16_t* base = PB + (size_t)(b * SEQ + tp) * PW; kv = *(const u32x4*)(base + 512 + kvh * 64 + ch * 8); vv = *(const u32x4*)(base + 640 + kvh * 64 + ch * 8); }
        *(LAS u32x4*)(Ks + row * 72 + ch * 8) = kv;
#pragma unroll
        for (int e = 0; e < 4; ++e) { const unsigned w = vv[e]; Vt[(ch * 8 + 2 * e) * 264 + row] = (bf16_t)(w & 0xffffu); Vt[(ch * 8 + 2 * e + 1) * 264 + row] = (bf16_t)(w >> 16); }
    }
    __syncthreads();
    const int qtok = b * SEQ + blk * 128 + 16 * wid + fr;
#pragma unroll 1
    for (int g = 0; g < 4; ++g) {
        const int h = kvh * 4 + g; const float slope = exp2f(-(float)(h + 1)), sink = p.in[11][h];
        bf16x8 qf[2];
#pragma unroll
        for (int ks = 0; ks < 2; ++ks) qf[ks] = *(const bf16x8*)(PB + (size_t)qtok * PW + h * 64 + ks * 32 + 8 * fq);
        f32x4 s[10]; float mx = sink;
#pragma unroll
        for (int j = 0; j < 10; ++j) {
            const int ct = (wid + j) < 15 ? (wid + j) : 15;
            f32x4 acc = (f32x4){0.f, 0.f, 0.f, 0.f};
#pragma unroll
            for (int ks = 0; ks < 2; ++ks) acc = mfma16(*(const LAS bf16x8*)(Ks + (16 * ct + fr) * 72 + ks * 32 + 8 * fq), qf[ks], acc);
#pragma unroll
            for (int e = 0; e < 4; ++e) {
                const int c = 16 * (wid + j) + 4 * fq + e, dist = 16 * wid + fr - c + 128;
                const bool ok = (wid + j <= 15) && dist >= 0 && dist <= 128 && (blk * 128 + c - 128 >= 0);
                const float v = ok ? acc[e] * 0.125f - slope * (float)dist : -INFINITY;
                acc[e] = v; mx = fmaxf(mx, v);
            }
            s[j] = acc;
            asm volatile("" ::: "memory");
        }
        mx = fmaxf(mx, __shfl_xor(mx, 16)); mx = fmaxf(mx, __shfl_xor(mx, 32));
        float sum = 0.f;
#pragma unroll
        for (int j = 0; j < 10; ++j)
#pragma unroll
            for (int e = 0; e < 4; ++e) { const float pv = __expf(s[j][e] - mx); s[j][e] = pv; sum += pv; }
        sum += __shfl_xor(sum, 16); sum += __shfl_xor(sum, 32);
        sum += __expf(sink - mx);
        const float inv = 1.0f / sum;
        bf16x8 pb[5];
#pragma unroll
        for (int kk = 0; kk < 5; ++kk) { u32x4 w; w.x = cvt_pk(s[2 * kk][0] * inv, s[2 * kk][1] * inv); w.y = cvt_pk(s[2 * kk][2] * inv, s[2 * kk][3] * inv);
            w.z = cvt_pk(s[2 * kk + 1][0] * inv, s[2 * kk + 1][1] * inv); w.w = cvt_pk(s[2 * kk + 1][2] * inv, s[2 * kk + 1][3] * inv); pb[kk] = __builtin_bit_cast(bf16x8, w); }
#pragma unroll
        for (int dt = 0; dt < 4; ++dt) {
            f32x4 acc = (f32x4){0.f, 0.f, 0.f, 0.f};
#pragma unroll
            for (int kk = 0; kk < 5; ++kk) {
                const int c0 = (wid + 2 * kk) < 15 ? (wid + 2 * kk) : 15, c1 = (wid + 2 * kk + 1) < 15 ? (wid + 2 * kk + 1) : 15;
                const u32x2 lo = *(const LAS u32x2*)(Vt + (16 * dt + fr) * 264 + 16 * c0 + 4 * fq), hi = *(const LAS u32x2*)(Vt + (16 * dt + fr) * 264 + 16 * c1 + 4 * fq);
                const u32x4 a = (u32x4){lo.x, lo.y, hi.x, hi.y};
                acc = mfma16(__builtin_bit_cast(bf16x8, a), pb[kk], acc);
            }
            u32x2 w; w.x = cvt_pk(acc[0], acc[1]); w.y = cvt_pk(acc[2], acc[3]);
            *(u32x2*)(PB + (size_t)qtok * PW + h * 64 + 16 * dt + 4 * fq) = w;
            asm volatile("" ::: "memory");
        }
    }
}

__device__ __forceinline__ void sattn_unit(const Params& p, int s, int h, int lane) {
    const int kvh = h >> 2; const bool wr = (h & 3) == 0;
    bf16_t* PB = (bf16_t*)(p.ws + WS_H) + (size_t)(MPR + s) * PW;
    const float* ck = p.in[2] + (size_t)s * 128 * 128 + kvh * 64 + lane; const float* cv = p.in[3] + (size_t)s * 128 * 128 + kvh * 64 + lane;
    float* nk = p.out + O_KS + (size_t)s * 128 * 128 + kvh * 64 + lane; float* nv = p.out + O_VS + (size_t)s * 128 * 128 + kvh * 64 + lane;
    const float q = bf2f(PB[h * 64 + lane]) * 0.125f, slope = exp2f(-(float)(h + 1)), sink = p.in[11][h];
    const float knew = bf2f(PB[512 + kvh * 64 + lane]), vnew = bf2f(PB[640 + kvh * 64 + lane]);
    float sc[3];
#pragma unroll
    for (int t = 0; t < 2; ++t) {
#pragma unroll 8
        for (int jj = 0; jj < 64; ++jj) {
            const int j = t * 64 + jj; const float kval = ck[(size_t)j * 128];
            if (wr && j >= 1) nk[(size_t)(j - 1) * 128] = kval;
            const float d = wave_sum(q * kval) - slope * (float)(128 - j); if (lane == jj) sc[t] = d;
        }
    }
    if (wr) nk[(size_t)127 * 128] = knew;
    sc[2] = wave_sum(q * knew);
    const float mx = fmaxf(fmaxf(wave_max(fmaxf(sc[0], sc[1])), sc[2]), sink);
    const float p0 = __expf(sc[0] - mx), p1 = __expf(sc[1] - mx), p2 = __expf(sc[2] - mx);
    const float inv = 1.0f / (wave_sum(p0 + p1) + p2 + __expf(sink - mx));
    float o = p2 * vnew;
#pragma unroll 8
    for (int jj = 0; jj < 64; ++jj) { const float vval = cv[(size_t)jj * 128]; if (wr && jj >= 1) nv[(size_t)(jj - 1) * 128] = vval; o += __shfl(p0, jj) * vval; }
#pragma unroll 8
    for (int jj = 0; jj < 64; ++jj) { const float vval = cv[(size_t)(64 + jj) * 128]; if (wr) nv[(size_t)(63 + jj) * 128] = vval; o += __shfl(p1, jj) * vval; }
    if (wr) nv[(size_t)127 * 128] = vnew;
    asm volatile("" ::: "memory");
    PB[h * 64 + lane] = f2bf(o * inv);
}

__device__ __forceinline__ void sgdn_unit(const Params& p, LAS unsigned char* lds, int s) {
    const int tid = threadIdx.x, wid = tid >> 6, h = tid >> 7, dv = tid & 127;
    LAS float* qs = (LAS float*)lds; LAS float* ks = qs + 512; LAS float* red = ks + 512;
    bf16_t* PB = (bf16_t*)(p.ws + WS_H) + (size_t)(MPR + s) * PW; const float* GBA = (const float*)(p.ws + WS_GBA) + (size_t)(MPR + s) * 8;
    const float* cw = p.in[12]; const float* hc = p.in[4] + (size_t)s * 3 * CONVC; float* nc = p.out + O_CS + (size_t)s * 3 * CONVC;
    __syncthreads();
    float val[3];
#pragma unroll
    for (int i = 0; i < 3; ++i) {
        const int c = i * 512 + tid; const float x3 = bf2f(PB[768 + c]), h0 = hc[c], h1 = hc[CONVC + c], h2 = hc[2 * CONVC + c];
        val[i] = silu(cw[c] * h0 + cw[CONVC + c] * h1 + cw[2 * CONVC + c] * h2 + cw[3 * CONVC + c] * x3);
        nc[c] = h1; nc[CONVC + c] = h2; nc[2 * CONVC + c] = x3;
    }
    const float sq = wave_sum(val[0] * val[0]), sk = wave_sum(val[1] * val[1]);
    if ((tid & 63) == 0) { red[wid] = sq; red[8 + wid] = sk; }
    __syncthreads();
    const float ssq = red[2 * h] + red[2 * h + 1], ssk = red[8 + 2 * h] + red[8 + 2 * h + 1];
    qs[tid] = val[0] * rsqrtf(ssq + EPS) * 0.08838834764831845f; ks[tid] = val[1] * rsqrtf(ssk + EPS);
    __syncthreads();
    const float beta = 1.0f / (1.0f + __expf(-GBA[h]));
    const float x = GBA[4 + h] + p.in[14][h]; const float sp = x > 20.f ? x : log1pf(__expf(x));
    const float eg = __expf(-__expf(p.in[13][h]) * sp);
    const float* S0 = p.in[5] + ((size_t)(s * 4 + h) * 128) * 128 + dv; float* S1 = p.out + O_GS + ((size_t)(s * 4 + h) * 128) * 128 + dv;
    float kS = 0.f;
#pragma unroll 1
    for (int hf = 0; hf < 4; ++hf) { float sv[32];
#pragma unroll
        for (int dk = 0; dk < 32; ++dk) sv[dk] = S0[(size_t)(hf * 32 + dk) * 128];
#pragma unroll
        for (int dk = 0; dk < 32; ++dk) kS += ks[h * 128 + hf * 32 + dk] * sv[dk]; }
    const float delta = beta * (val[2] - eg * kS);
    float o = 0.f;
#pragma unroll 1
    for (int hf = 0; hf < 4; ++hf) { float sv[32];
#pragma unroll
        for (int dk = 0; dk < 32; ++dk) sv[dk] = S0[(size_t)(hf * 32 + dk) * 128];
#pragma unroll
        for (int dk = 0; dk < 32; ++dk) { const float nvv = eg * sv[dk] + ks[h * 128 + hf * 32 + dk] * delta; S1[(size_t)(hf * 32 + dk) * 128] = nvv; o += qs[h * 128 + hf * 32 + dk] * nvv; } }
    const float so = wave_sum(o * o);
    if ((tid & 63) == 0) red[16 + wid] = so;
    __syncthreads();
    const float tot = red[16 + 2 * h] + red[16 + 2 * h + 1];
    const float gz = bf2f(PB[2304 + tid]);
    PB[512 + tid] = f2bf(o * rsqrtf(tot * (1.0f / 128.0f) + EPS) * p.in[15][dv] * silu(gz));
}

#define XB_TMO      128
#define XB_XCNT(j)  (256  + 64 * (j))
#define XB_XSUB(j)  (1280 + 64 * (j))
#define XB_XGEN(j)  (2304 + 64 * (j))
#define XB_TOP      3328
#define XB_TOPGEN   3392
#define XCD_BAR_WORDS 3456
#define XB_SPIN_CAP (1u << 18)

__device__ __forceinline__ unsigned xb_ld(unsigned* p)              { return __hip_atomic_load(p, __ATOMIC_RELAXED, __HIP_MEMORY_SCOPE_AGENT); }
__device__ __forceinline__ unsigned xb_add(unsigned* p, unsigned v) { return __hip_atomic_fetch_add(p, v, __ATOMIC_RELAXED, __HIP_MEMORY_SCOPE_AGENT); }
__device__ __forceinline__ unsigned xb_xcc_id() { return (unsigned)__builtin_amdgcn_s_getreg((3 << 11) | 20) & 0xFu; }
#define XB_SPIN(cond, bar) do { unsigned _sp = 0; while (cond) { __builtin_amdgcn_s_sleep(1); \
    if ((++_sp & 255u) == 0u) { if (xb_ld(&(bar)[XB_TMO])) break; if (_sp > XB_SPIN_CAP) { atomicAdd(&(bar)[XB_TMO], 1u); break; } } } } while (0)

struct XcdBarrier {
    unsigned* bar; unsigned x;
    volatile LAS unsigned* st;
};

__device__ __forceinline__ XcdBarrier xcd_barrier_post(unsigned* bar, volatile LAS unsigned* st) {
    XcdBarrier b; b.bar = bar; b.x = xb_xcc_id(); b.st = st;
    if (threadIdx.x == 0) (void)xb_add(&bar[XB_XCNT(b.x)], 1u);
    return b;
}
__device__ __forceinline__ void xcd_barrier_complete(unsigned* bar, unsigned x, unsigned& nloc, unsigned& nx) {
    const unsigned G = gridDim.x * gridDim.y * gridDim.z;
    unsigned sum, cnt, mine, sp = 0u;
    for (;;) {
        sum = 0u; cnt = 0u; mine = 0u;
#pragma unroll
        for (unsigned j = 0; j < 16; ++j) { const unsigned c = xb_ld(&bar[XB_XCNT(j)]); sum += c; cnt += (c > 0u) ? 1u : 0u; mine = (j == x) ? c : mine; }
        if (sum == G) break;
        __builtin_amdgcn_s_sleep(1);
        if ((++sp & 255u) == 0u) { if (xb_ld(&bar[XB_TMO])) break; if (sp > XB_SPIN_CAP) { atomicAdd(&bar[XB_TMO], 1u); break; } }
    }
    nloc = mine > 0u ? mine : 1u; nx = cnt > 0u ? cnt : 1u;
}

__device__ __forceinline__ void xcd_barrier(const XcdBarrier& b) {
    asm volatile("s_waitcnt vmcnt(0)" ::: "memory");
    __syncthreads();
    if (threadIdx.x == 0) {
        unsigned* bar = b.bar;
        __builtin_amdgcn_s_waitcnt(0);
        unsigned nloc = b.st[0], nx = b.st[1];
        if (nloc == 0u) { xcd_barrier_complete(bar, b.x, nloc, nx); b.st[0] = nloc; b.st[1] = nx; }
        const unsigned old = xb_add(&bar[XB_XSUB(b.x)], 1u);
        const unsigned gen = old / nloc;
        if (old + 1u == (gen + 1u) * nloc) {
            __builtin_amdgcn_fence(__ATOMIC_RELEASE, "agent");
            asm volatile("s_waitcnt vmcnt(0)" ::: "memory");
            const unsigned og = xb_add(&bar[XB_TOP], 1u);
            const unsigned tg = og / nx;
            if (og + 1u == (tg + 1u) * nx) xb_add(&bar[XB_TOPGEN], 1u);
            else XB_SPIN(xb_ld(&bar[XB_TOPGEN]) == tg, bar);
            __builtin_amdgcn_fence(__ATOMIC_ACQUIRE, "agent");
            xb_add(&bar[XB_XGEN(b.x)], 1u);
            asm volatile("s_waitcnt vmcnt(0)" ::: "memory");
        } else {
            XB_SPIN(xb_ld(&bar[XB_XGEN(b.x)]) == gen, bar);
            __builtin_amdgcn_fence(__ATOMIC_ACQUIRE, "agent");
            asm volatile("s_waitcnt vmcnt(0)" ::: "memory");
        }
    }
    __syncthreads();
}

__global__ void __launch_bounds__(512, 2) fwd_kernel(Params p, int ph_lo, int ph_hi) {
    extern __shared__ __attribute__((aligned(16))) unsigned char lds_raw[];
    LAS unsigned char* lds = (LAS unsigned char*)lds_raw;
    cg::grid_group grid = cg::this_grid();
    if (ph_lo < 0) grid.sync();
    volatile LAS unsigned* bst = (volatile LAS unsigned*)(lds + LDS_PHASE_BYTES);
    if (threadIdx.x < 2) bst[threadIdx.x] = 0u;
    __syncthreads();
    XcdBarrier xbar; xbar.bar = (unsigned*)(p.ws + WS_CTL + CTL_BAR); xbar.x = 0; xbar.st = bst;
    if (ph_hi - ph_lo > 1) xbar = xcd_barrier_post((unsigned*)(p.ws + WS_CTL + CTL_BAR), bst);
    const int tid = threadIdx.x, lane = tid & 63, wid = tid >> 6, G = gridDim.x, bx = blockIdx.x;
    unsigned char* ws = p.ws;
    bf16_t* XN = (bf16_t*)(ws + WS_XN); bf16_t* XN2 = (bf16_t*)(ws + WS_XN2); bf16_t* HB = (bf16_t*)(ws + WS_H);
    float* SS1 = (float*)(ws + WS_SSP1); float* SS2 = (float*)(ws + WS_SSP2);
    float* Y = p.out; bf16_t* X3b = (bf16_t*)(ws + WS_GM);
#ifndef PHMASK
#define PHMASK 0x7ff
#endif
#define IN(k) (((PHMASK >> (k)) & 1) && ph_lo <= (k) && (k) < ph_hi)
#define SEAM(k) do { if (IN(k) && IN((k) + 1)) { xcd_barrier(xbar); }     } while (0)

    if (IN(0)) p0_prologue(p, lds, bx, G);
    SEAM(0);
    if (IN(1)) {
        if (bx < 176) sk_ffn_in<false>(XN, (const bf16_t*)(ws + WS_W1IN), HB, bx, wid, lane & 15, lane >> 4, lds);
        pg8::Gemm g{XN, (const bf16_t*)(ws + WS_W1IN), MPR, 2 * DFF, DM, DM}; pg8::StaticOrder S; S.init(MPR, 2 * DFF, G, bx);
        EpiSwiglu E{HB, nullptr}; pg8::gemm_phase<EpiSwiglu, pg8::StaticOrder, GEMM_ALIGN, GEMM_SP2>(lds, g, S, E);
    }
    SEAM(1);
    if (IN(2)) {
        if (bx < 64) sk_ffn_out<false>(HB, (const bf16_t*)(ws + WS_W1OUT), p.in[1], nullptr, XN + (size_t)MPR * DM, bx, wid, lane & 15, lane >> 4, lds);
        pg8::Gemm g{HB, (const bf16_t*)(ws + WS_W1OUT), MPR, DM, DFF, DFF}; pg8::StaticOrder S; S.init(MPR, DM, G, bx);
        EpiResid<false, false, true, true, true> E{p.in[0], p.in[1], nullptr, XN, SS1}; pg8::gemm_phase<EpiResid<false, false, true, true, true>, pg8::StaticOrder, GEMM_ALIGN, GEMM_SP2>(lds, g, S, E);
    }
    SEAM(2);
    if (IN(3)) {
        if (bx < 89) sk_inproj(XN, (const bf16_t*)(ws + WS_WINMIX), HB, (float*)(ws + WS_GBA), bx, wid, lane & 15, lane >> 4, lds);
        pg8::Gemm g{XN, (const bf16_t*)(ws + WS_WINMIX), MPR, NINP, DM, DM}; pg8::StaticOrder S; S.init(MPR, NINP, G, bx);
        EpiInproj E{HB, (float*)(ws + WS_GBA), SS1}; pg8::gemm_phase<EpiInproj, pg8::StaticOrder, GEMM_ALIGN, GEMM_SP2>(lds, g, S, E);
    }
    SEAM(3);
    if (IN(4)) {
        for (int u = bx; u < 2048; u += G) gdn_prep_unit(p, lds, u);
    }
    SEAM(4);
    if (IN(5)) {
        if (bx < NSCAN) gdn_scan(p, lds, bx);
        else {
            const int ab = bx - NSCAN, NAB = G - NSCAN;
            if (NAB == 192) {
                if (ab < 128) { sattn_unit(p, ab, wid, lane); sgdn_unit(p, lds, ab); attn_unit(p, lds, 2 * ab); attn_unit(p, lds, 2 * ab + 1); }
                else { for (int k = 0; k < 4; ++k) attn_unit(p, lds, 256 + (ab - 128) * 4 + k); }
            } else {
                int it = ab;
#pragma unroll 1
                for (; it < 512; it += NAB) attn_unit(p, lds, it);
#pragma unroll 1
                for (; it < 640; it += NAB) { sattn_unit(p, it - 512, wid, lane); sgdn_unit(p, lds, it - 512); }
            }
            const bf16_t* PB = HB;
            for (int idx = ab * 512 + tid; idx < 149504; idx += NAB * 512) {
                if (idx < 131072) { const int w = idx >> 16, r = idx & 65535, b = r >> 14, j = (r >> 7) & 127, c = r & 127;
                    p.out[(w ? O_VP : O_KP) + r] = bf2f(PB[(size_t)(b * SEQ + SEQ - 128 + j) * PW + 512 + w * 128 + c]);
                } else { const int r = idx - 131072, b = r / (3 * CONVC), q = r % (3 * CONVC), rr = q / CONVC, c = q % CONVC;
                    p.out[O_CP + r] = bf2f(PB[(size_t)(b * SEQ + SEQ - 3 + rr) * PW + 768 + c]); }
            }
        }
    }
    SEAM(5);
    if (IN(6)) {
        for (int u = bx * 8 + wid; u < 2048; u += G * 8) gdn_gate_unit(p, u, lane);
    }
    SEAM(6);
#ifdef DBG_DUMP
    if (ph_lo == 11) {
        const float* src = (const float*)(ws + DBG_SRC);
        for (size_t i = (size_t)bx * 512 + tid; i < (size_t)MREAL * DM; i += (size_t)G * 512) Y[i] = (i < (size_t)MREAL * 8) ? ((const float*)(ws + WS_GBA))[i] : 0.f;
    }
#endif
    if (IN(7)) {
        if (bx < 32) sk_outproj(HB, (const bf16_t*)(ws + WS_WOUTMIX), XN, nullptr, XN2, bx, wid, lane & 15, lane >> 4, lds);
        pg8::Gemm g{HB, (const bf16_t*)(ws + WS_WOUTMIX), MPR, DM, DM, PW}; pg8::StaticOrder S; S.init(MPR, DM, G, bx);
        EpiResid<true, false, true, true, false> E{XN, XN + (size_t)MPR * DM, nullptr, XN2, SS2}; pg8::gemm_phase<EpiResid<true, false, true, true, false>, pg8::StaticOrder, GEMM_ALIGN, GEMM_SP2>(lds, g, S, E);
    }
    SEAM(7);
    if (IN(8)) {
        if (bx < 176) sk_ffn_in<true>(XN2, (const bf16_t*)(ws + WS_W2IN), HB, bx, wid, lane & 15, lane >> 4, lds);
        pg8::Gemm g{XN2, (const bf16_t*)(ws + WS_W2IN), MPR, 2 * DFF, DM, DM}; pg8::StaticOrder S; S.init(MPR, 2 * DFF, G, bx);
        EpiSwiglu E{HB, SS2}; pg8::gemm_phase<EpiSwiglu, pg8::StaticOrder, GEMM_ALIGN, GEMM_SP2>(lds, g, S, E);
    }
    SEAM(8);
    if (IN(9)) {
        if (bx < 64) sk_ffn_out<true>(HB, (const bf16_t*)(ws + WS_W2OUT), (const float*)(XN2 + (size_t)MPR * DM), nullptr, X3b + (size_t)MPR * DM, bx, wid, lane & 15, lane >> 4, lds);
        pg8::Gemm g{HB, (const bf16_t*)(ws + WS_W2OUT), MPR, DM, DFF, DFF}; pg8::StaticOrder S; S.init(MPR, DM, G, bx);
        EpiResid<true, false, true, false, true> E{XN2, XN2 + (size_t)MPR * DM, nullptr, X3b, nullptr}; pg8::gemm_phase<EpiResid<true, false, true, false, true>, pg8::StaticOrder, GEMM_ALIGN, GEMM_SP2>(lds, g, S, E);
    }
    SEAM(9);
    if (IN(10)) {
        const float* gf = p.in[20]; f32x4 gv[4];
#pragma unroll
        for (int j = 0; j < 4; ++j) gv[j] = *((const f32x4*)gf + lane + 64 * j);
        {
            f32x4 v[4], vn[4]; int m = bx * 8 + wid;
            if (m < MREAL) { const u32x2* xr = (const u32x2*)(X3b + (size_t)m * DM) + lane;
#pragma unroll
                for (int j = 0; j < 4; ++j) { const u32x2 w = xr[64 * j]; v[j] = (f32x4){bflo(w.x), bfhi(w.x), bflo(w.y), bfhi(w.y)}; } }
            for (; m < MREAL; m += G * 8) {
                const int mn = m + G * 8;
                if (mn < MREAL) { const u32x2* xr = (const u32x2*)(X3b + (size_t)mn * DM) + lane;
#pragma unroll
                    for (int j = 0; j < 4; ++j) { const u32x2 w = xr[64 * j]; vn[j] = (f32x4){bflo(w.x), bfhi(w.x), bflo(w.y), bfhi(w.y)}; } }
                float s = 0.f;
#pragma unroll
                for (int j = 0; j < 4; ++j) s += (v[j][0] * v[j][0] + v[j][1] * v[j][1]) + (v[j][2] * v[j][2] + v[j][3] * v[j][3]);
                const float rstd = rsqrtf(wave_sum(s) * (1.0f / DM) + EPS);
                f32x4* yr = (f32x4*)(Y + (size_t)m * DM) + lane;
#pragma unroll
                for (int j = 0; j < 4; ++j) yr[64 * j] = v[j] * rstd * gv[j];
#pragma unroll
                for (int j = 0; j < 4; ++j) v[j] = vn[j];
            }
        }
    }
#undef IN
#undef SEAM
}
}

#ifndef MK_N_LAUNCHES
#define MK_N_LAUNCHES 1
#endif
extern "C" void kernel_launch(void* const* d_in, const int* in_sizes, int n_in, void* d_out, int out_size, void* d_ws, size_t ws_size, hipStream_t stream) {
    static int grid = 0;
    if (grid == 0) {
        if (n_in != 21 || ws_size < mk::WS_END || out_size != 47269888) { fprintf(stderr, "kernel_launch: unexpected shapes (n_in %d, ws %zu, out %d)\n", n_in, ws_size, out_size); grid = -1; return; }
        int dev = 0, cus = 0, per_cu = 0;
        (void)hipGetDevice(&dev); (void)hipDeviceGetAttribute(&cus, hipDeviceAttributeMultiprocessorCount, dev);
        if (hipFuncSetAttribute((const void*)mk::fwd_kernel, hipFuncAttributeMaxDynamicSharedMemorySize, mk::LDS_BYTES) != hipSuccess) { fprintf(stderr, "kernel_launch: hipFuncSetAttribute failed\n"); grid = -1; return; }
        if (hipOccupancyMaxActiveBlocksPerMultiprocessor(&per_cu, (const void*)mk::fwd_kernel, 512, mk::LDS_BYTES) != hipSuccess || per_cu < 1) { fprintf(stderr, "kernel_launch: occupancy query failed (%d)\n", per_cu); per_cu = 1; }
        (void)hipGetLastError();
        grid = cus * per_cu;
        if (grid <= mk::NSCAN) { fprintf(stderr, "kernel_launch: grid %d too small\n", grid); grid = -1; return; }
    }
    if (grid < 0) return;
    (void)hipMemsetAsync((char*)d_ws + mk::WS_CTL + mk::CTL_BAR, 0, mk::CTL_BAR_BYTES, stream);
    mk::Params p{};
    for (int i = 0; i < 21; ++i) p.in[i] = (const float*)d_in[i];
    p.out = (float*)d_out; p.ws = (unsigned char*)d_ws;
#if MK_N_LAUNCHES == 1
    int lo = 0, hi = 11; void* args[] = {&p, &lo, &hi};
    hipError_t e = hipLaunchCooperativeKernel((const void*)mk::fwd_kernel, dim3(grid), dim3(512), args, mk::LDS_BYTES, stream);
    if (e != hipSuccess) fprintf(stderr, "kernel_launch: cooperative launch failed: %s (grid %d)\n", hipGetErrorString(e), grid);
#else
#ifndef MK_LAST
#define MK_LAST 11
#ifndef MK_DOUBLE
#define MK_DOUBLE 0x0
#endif
#define DBG_C0 512
#define DBG_C1 1024
#endif
    for (int ph = 0; ph < MK_LAST; ++ph) { const int reps = ((MK_DOUBLE >> ph) & 1) ? 2 : 1; for (int r = 0; r < reps; ++r) hipLaunchKernelGGL(mk::fwd_kernel, dim3(grid), dim3(512), mk::LDS_BYTES, stream, p, ph, ph + 1); }
#ifdef DBG_DUMP
    hipLaunchKernelGGL(mk::fwd_kernel, dim3(grid), dim3(512), mk::LDS_BYTES, stream, p, 11, 12);
#endif
#endif
}
```

```cpp
#include <hip/hip_runtime.h>
#include <hip/hip_cooperative_groups.h>
#include <cstdio>
namespace cg = cooperative_groups;
namespace pg8 {
#define PG8_LAS __attribute__((address_space(3)))
typedef unsigned short bf16_t;
typedef short bf16x8 __attribute__((ext_vector_type(8)));
typedef float f32x4 __attribute__((ext_vector_type(4)));
typedef unsigned u32x4 __attribute__((ext_vector_type(4)));
constexpr int BM = 256, BK = 64, HALF = 128, HTB = HALF * BK * 2  , STAGE_BYTES = 8 * HTB, NXCD = 8, WGM = 4;

__host__ __device__ __forceinline__ int lds_byte(int r, int c) { const int st = (r >> 4) * 2 + (c >> 5), rr = r & 15, cc = c & 31, ob = rr * 64 + cc * 2; return st * 1024 + (ob ^ (((ob >> 9) & 1) << 5)); }
__host__ __device__ __forceinline__ void stage_rc(int b, int& R, int& C) { const int st = b / 1024, sb = b % 1024, swz = sb ^ (((sb >> 9) & 1) << 5); R = (st >> 1) * 16 + swz / 64; C = (st & 1) * 32 + (swz % 64) / 2; }
__host__ __device__ __forceinline__ int perm32(int rho) { const int n = rho >> 4, i = rho & 15; return 8 * (i >> 2) + 4 * n + (i & 3); }

struct Unit { int pm, pn; };
struct Gemm { const bf16_t* A; const bf16_t* Bt; int M, N, K, lda; };

struct StaticOrder {
    int nM, nN, nwg, G, c, wgm;
    __host__ __device__ void init(int M, int N, int G_, int c_, int wgm_ = WGM) { nM = M / BM; nN = N / BM; nwg = nM * nN; G = G_; c = c_; wgm = wgm_; }
    __host__ __device__ bool next(int i, Unit& u) const {
        const long L = (long)i * G + c; if (L >= nwg) return false;
        int wgid = (int)L; { const int q = nwg / NXCD, r = nwg % NXCD, xcd = wgid % NXCD, off = wgid / NXCD; wgid = (xcd < r ? xcd * (q + 1) : r * (q + 1) + (xcd - r) * q) + off; }
        const int nig = wgm * nN, gid = wgid / nig, fm = gid * wgm, gsz = (nM - fm) < wgm ? (nM - fm) : wgm;
        u.pm = fm + ((wgid % nig) % gsz); u.pn = (wgid % nig) / gsz; return true;
    }
    __device__ __forceinline__ void a_ready(const Unit&) const {}
    __device__ __forceinline__ void done(const Unit&) const {}
};

__device__ __forceinline__ unsigned cvt_pk_bf16(float lo, float hi) { unsigned r; asm volatile("v_cvt_pk_bf16_f32 %0, %1, %2" : "=v"(r) : "v"(lo), "v"(hi)); return r; }
typedef float f32x2 __attribute__((ext_vector_type(2)));
__device__ __forceinline__ f32x2 gelu_pk(f32x2 v) {
    const f32x2 av = __builtin_elementwise_abs(v), d = av * 0.2316418882f + 1.0f;
    f32x2 t; t.x = __builtin_amdgcn_rcpf(d.x); t.y = __builtin_amdgcn_rcpf(d.y);
    f32x2 q = t * 0.5307027145f + (-0.7265760135f); q = q * t + 0.7107068705f; q = q * t + (-0.142248368f); q = q * t + 0.127414796f; q = q * t;
    const f32x2 s = (v * v) * (-0.72134752044f);
    f32x2 e; e.x = __builtin_amdgcn_exp2f(s.x); e.y = __builtin_amdgcn_exp2f(s.y);
    const f32x2 m = v * (q * e), r = v - m;
    f32x2 o; o.x = v.x < 0.f ? m.x : r.x; o.y = v.y < 0.f ? m.y : r.y; return o;
}

template <int ACT  > struct EpiBf16 {
    static constexpr bool PERM = true, AFTER_DRAIN = false; static_assert(ACT == 0 || ACT == 1, "EpiBf16: ACT is 0 (none) or 1 (gelu_pk)");
    bf16_t* O; int ldc; const float* bias; int split_cols; size_t split_stride; float scale0;
    __device__ __forceinline__ void operator()(const f32x4 (&acc)[2][2][4][2], const Unit& u, int wr, int wc, int fr, int fq) const {
        const int row0 = u.pm * BM + wr * 64 + fr; int colt = u.pn * BM; bf16_t* base = O;
        float sc = 1.f; if (split_cols) { const int t = colt / split_cols; base += (size_t)t * split_stride; colt -= t * split_cols; if (t == 0) sc = scale0; }
        const int col0 = colt + wc * 32 + 8 * fq, bcol0 = u.pn * BM + wc * 32 + 8 * fq;
        f32x4 bv[2][2];
#pragma unroll
        for (int bj = 0; bj < 2; ++bj)
#pragma unroll
            for (int n = 0; n < 2; ++n) bv[bj][n] = bias ? *(const f32x4*)(bias + bcol0 + bj * HALF + 4 * n) : (f32x4){0.f, 0.f, 0.f, 0.f};
#pragma unroll
        for (int ai = 0; ai < 2; ++ai)
#pragma unroll
            for (int m = 0; m < 4; ++m) { bf16_t* rowp = base + (size_t)(row0 + ai * HALF + m * 16) * ldc + col0;
#pragma unroll
                for (int bj = 0; bj < 2; ++bj) { f32x4 v0 = acc[ai][bj][m][0] + bv[bj][0], v1 = acc[ai][bj][m][1] + bv[bj][1];
                    if (ACT == 1) { f32x2 a = gelu_pk((f32x2){v0[0], v0[1]}), b = gelu_pk((f32x2){v0[2], v0[3]}), c = gelu_pk((f32x2){v1[0], v1[1]}), d = gelu_pk((f32x2){v1[2], v1[3]});
                        v0 = (f32x4){a.x, a.y, b.x, b.y}; v1 = (f32x4){c.x, c.y, d.x, d.y}; }
                    v0 = v0 * sc; v1 = v1 * sc; u32x4 w; w.x = cvt_pk_bf16(v0[0], v0[1]); w.y = cvt_pk_bf16(v0[2], v0[3]); w.z = cvt_pk_bf16(v1[0], v1[1]); w.w = cvt_pk_bf16(v1[2], v1[3]);
                    *(u32x4*)(rowp + bj * HALF) = w; } }
    }
};

struct PanelStats {
    unsigned* xbuf;
    unsigned* cnt;
    unsigned* tmo;
    int ntn; float eps;
    unsigned code;
    __device__ __forceinline__ bool run(const f32x4 (&v)[2][2][4][2], const Unit& u, int wr, int wc, int fr, int fq, PG8_LAS unsigned char* lds, int wid, int lane) const {
        typedef float f32x2v __attribute__((ext_vector_type(2)));
        PG8_LAS f32x2v* P = (PG8_LAS f32x2v*)lds;
        PG8_LAS f32x2v* S = (PG8_LAS f32x2v*)(lds + 8192);
        PG8_LAS unsigned* flag = (PG8_LAS unsigned*)(lds + 8192 + 2048);
#pragma unroll
        for (int ai = 0; ai < 2; ++ai)
#pragma unroll
            for (int m = 0; m < 4; ++m) {
                float s = 0.f;
#pragma unroll
                for (int bj = 0; bj < 2; ++bj)
#pragma unroll
                    for (int n = 0; n < 2; ++n) { const f32x4 x = v[ai][bj][m][n]; s += (x[0] + x[1]) + (x[2] + x[3]); }
                s += __shfl_xor(s, 16); s += __shfl_xor(s, 32);
                const float mw = s * (1.0f / 64.0f); float q = 0.f;
#pragma unroll
                for (int bj = 0; bj < 2; ++bj)
#pragma unroll
                    for (int n = 0; n < 2; ++n) { const f32x4 d = v[ai][bj][m][n] - mw; q += (d[0] * d[0] + d[1] * d[1]) + (d[2] * d[2] + d[3] * d[3]); }
                q += __shfl_xor(q, 16); q += __shfl_xor(q, 32);
                if (fq == 0) P[(ai * HALF + wr * 64 + m * 16 + fr) * 4 + wc] = (f32x2v){mw, q};
            }
        asm volatile("s_waitcnt lgkmcnt(0)" ::: "memory"); __builtin_amdgcn_s_barrier(); asm volatile("" ::: "memory");
#if defined(BROKEN_EXCHANGE_NO_WAIT)
#warning BROKEN CONTROL BUILD: the row-statistics exchange does not wait; results are wrong by design
        if (blockIdx.x >= 64) { const long long t0_ = clock64(); while (clock64() - t0_ < 60000) __builtin_amdgcn_s_sleep(8); }
#endif
        const int row = wid * 32 + (lane & 31);
        if (lane < 32) {
            const f32x2v a = P[row * 4 + 0], b = P[row * 4 + 1], c = P[row * 4 + 2], d = P[row * 4 + 3];
            const float mt = (a.x + b.x + c.x + d.x) * 0.25f;
            const float da = a.x - mt, db = b.x - mt, dc = c.x - mt, dd = d.x - mt;
            const float m2 = (a.y + b.y) + (c.y + d.y) + 64.0f * ((da * da + db * db) + (dc * dc + dd * dd));
            unsigned long long* slot = (unsigned long long*)xbuf + ((size_t)(u.pm * BM + row) * 4 + u.pn);
            __hip_atomic_store(slot, ((unsigned long long)__float_as_uint(m2) << 32) | __float_as_uint(mt), __ATOMIC_RELAXED, __HIP_MEMORY_SCOPE_AGENT);
        }
        asm volatile("s_waitcnt vmcnt(0)" ::: "memory");
        if (lane == 0) __hip_atomic_fetch_add(cnt + 64 * u.pm, 1u, __ATOMIC_RELAXED, __HIP_MEMORY_SCOPE_AGENT);
        if (wid == 0) {
            bool dead = false; const unsigned long long t0 = __builtin_amdgcn_s_memrealtime(); const unsigned want = 8u * (unsigned)ntn;
            for (;;) {
#if defined(BROKEN_EXCHANGE_NO_WAIT)
                break;
#endif
                if ((unsigned)__builtin_amdgcn_readfirstlane(__hip_atomic_load(cnt + 64 * u.pm, __ATOMIC_RELAXED, __HIP_MEMORY_SCOPE_AGENT)) >= want) break;
                if (__builtin_amdgcn_s_memrealtime() - t0 > 2000000ull) {
                    if (lane == 0) { unsigned expect = 0u; __hip_atomic_compare_exchange_strong(tmo + 1, &expect, code | (unsigned)(u.pm & 0xff), __ATOMIC_RELAXED, __ATOMIC_RELAXED, __HIP_MEMORY_SCOPE_AGENT);
                                     __hip_atomic_store(tmo, 1u, __ATOMIC_RELAXED, __HIP_MEMORY_SCOPE_AGENT); }
                    dead = true; break; }
                __builtin_amdgcn_s_sleep(2);
            }
            __builtin_amdgcn_fence(__ATOMIC_ACQUIRE, "agent");
            if (lane == 0) flag[0] = dead ? 1u : 0u;
        }
        asm volatile("s_waitcnt vmcnt(0) lgkmcnt(0)" ::: "memory"); __builtin_amdgcn_s_barrier(); asm volatile("" ::: "memory");
        const bool bad = flag[0] != 0u;
        if (lane < 32) {
            const unsigned long long* slot = (const unsigned long long*)xbuf + (size_t)(u.pm * BM + row) * 4; float mt[4], m2[4]; float ms = 0.f;
#pragma unroll
            for (int t = 0; t < 4; ++t) { if (t < ntn) { const unsigned long long w = __hip_atomic_load(slot + t, __ATOMIC_RELAXED, __HIP_MEMORY_SCOPE_AGENT); mt[t] = __uint_as_float((unsigned)w); m2[t] = __uint_as_float((unsigned)(w >> 32)); } else { mt[t] = 0.f; m2[t] = 0.f; } ms += mt[t]; }
            const float mean = ms / (float)ntn; float q = 0.f;
#pragma unroll
            for (int t = 0; t < 4; ++t) if (t < ntn) { const float dm = mt[t] - mean; q += m2[t] + 256.0f * dm * dm; }
            S[row] = (f32x2v){mean, 1.0f / sqrtf(q / (256.0f * (float)ntn) + eps)};
        }
        asm volatile("s_waitcnt lgkmcnt(0)" ::: "memory"); __builtin_amdgcn_s_barrier(); asm volatile("" ::: "memory");
        return bad;
    }
};
struct EpiLnRes {
    static constexpr bool PERM = false, AFTER_DRAIN = true;
    const float* base; float* out; int ldc; const float* bias; PanelStats st; unsigned poison;
    __device__ __forceinline__ void fused(f32x4 (&acc)[2][2][4][2], const Unit& u, int wr, int wc, int fr, int fq, PG8_LAS unsigned char* lds, int wid, int lane) const {
        typedef float f32x2v __attribute__((ext_vector_type(2)));
        const PG8_LAS f32x2v* S = (const PG8_LAS f32x2v*)(lds + 8192);
        const int col0 = u.pn * BM + wc * 32 + 4 * fq;
#pragma unroll
        for (int bj = 0; bj < 2; ++bj)
#pragma unroll
            for (int n = 0; n < 2; ++n) { const f32x4 bv = bias ? *(const f32x4*)(bias + col0 + bj * HALF + n * 16) : (f32x4){0.f, 0.f, 0.f, 0.f};
#pragma unroll
                for (int ai = 0; ai < 2; ++ai)
#pragma unroll
                    for (int m = 0; m < 4; ++m) acc[ai][bj][m][n] += bv; }
        f32x4 pre[4][2][2];
#pragma unroll
        for (int m = 0; m < 4; ++m) { const size_t off = (size_t)(u.pm * BM + wr * 64 + m * 16 + fr) * ldc + col0;
#pragma unroll
            for (int bj = 0; bj < 2; ++bj)
#pragma unroll
                for (int n = 0; n < 2; ++n) pre[m][bj][n] = *(const f32x4*)(base + off + bj * HALF + n * 16); }
        const bool bad = st.run(acc, u, wr, wc, fr, fq, lds, wid, lane) || poison != 0u;
        const float qnan = __builtin_nanf("");
#pragma unroll
        for (int ai = 0; ai < 2; ++ai)
#pragma unroll
            for (int m = 0; m < 4; ++m) { const int r = ai * HALF + wr * 64 + m * 16 + fr; const f32x2v sr = S[r]; const size_t off = (size_t)(u.pm * BM + r) * ldc + col0;
#pragma unroll
                for (int bj = 0; bj < 2; ++bj)
#pragma unroll
                    for (int n = 0; n < 2; ++n) { const f32x4 bs = ai == 0 ? pre[m][bj][n] : *(const f32x4*)(base + off + bj * HALF + n * 16); f32x4 o = bs + (acc[ai][bj][m][n] - sr.x) * sr.y;
                        if (bad) o = (f32x4){qnan, qnan, qnan, qnan}; *(f32x4*)(out + off + bj * HALF + n * 16) = o; }
                if (m & 1) asm volatile("" ::: "memory"); }
    }
};
struct EpiLnResLn {
    static constexpr bool PERM = false, AFTER_DRAIN = true;
    const float* base; float* out; bf16_t* xn; int ldc; const float* bias; PanelStats st1, st2; unsigned poison;
    __device__ __forceinline__ void fused(f32x4 (&acc)[2][2][4][2], const Unit& u, int wr, int wc, int fr, int fq, PG8_LAS unsigned char* lds, int wid, int lane) const {
        typedef float f32x2v __attribute__((ext_vector_type(2))); typedef unsigned u32x2v __attribute__((ext_vector_type(2)));
        const PG8_LAS f32x2v* S = (const PG8_LAS f32x2v*)(lds + 8192);
        const int col0 = u.pn * BM + wc * 32 + 4 * fq;
#pragma unroll
        for (int bj = 0; bj < 2; ++bj)
#pragma unroll
            for (int n = 0; n < 2; ++n) { const f32x4 bv = bias ? *(const f32x4*)(bias + col0 + bj * HALF + n * 16) : (f32x4){0.f, 0.f, 0.f, 0.f};
#pragma unroll
                for (int ai = 0; ai < 2; ++ai)
#pragma unroll
                    for (int m = 0; m < 4; ++m) acc[ai][bj][m][n] += bv; }
        bool bad = st1.run(acc, u, wr, wc, fr, fq, lds, wid, lane) || poison != 0u;
        const float qnan = __builtin_nanf("");
#pragma unroll
        for (int ai = 0; ai < 2; ++ai)
#pragma unroll
            for (int m = 0; m < 4; ++m) { const int r = ai * HALF + wr * 64 + m * 16 + fr; const f32x2v sr = S[r]; const size_t off = (size_t)(u.pm * BM + r) * ldc + col0;
#pragma unroll
                for (int bj = 0; bj < 2; ++bj)
#pragma unroll
                    for (int n = 0; n < 2; ++n) { const f32x4 bs = *(const f32x4*)(base + off + bj * HALF + n * 16); acc[ai][bj][m][n] = bs + (acc[ai][bj][m][n] - sr.x) * sr.y; }
                asm volatile("" : "+v"(acc[ai][0][m][0]), "+v"(acc[ai][0][m][1]), "+v"(acc[ai][1][m][0]), "+v"(acc[ai][1][m][1]));
                if (m & 1) asm volatile("" ::: "memory"); }
        const bool bad1 = bad;
        bad = st2.run(acc, u, wr, wc, fr, fq, lds, wid, lane) || bad;
#pragma unroll
        for (int ai = 0; ai < 2; ++ai)
#pragma unroll
            for (int m = 0; m < 4; ++m) { const int r = ai * HALF + wr * 64 + m * 16 + fr; const f32x2v sr = S[r]; const size_t off = (size_t)(u.pm * BM + r) * ldc + col0;
#pragma unroll
                for (int bj = 0; bj < 2; ++bj)
#pragma unroll
                    for (int n = 0; n < 2; ++n) { const f32x4 x1 = acc[ai][bj][m][n]; *(f32x4*)(out + off + bj * HALF + n * 16) = bad1 ? (f32x4){qnan, qnan, qnan, qnan} : x1;
                        const f32x4 o = (x1 - sr.x) * sr.y; u32x2v w; w.x = cvt_pk_bf16(o[0], o[1]); w.y = cvt_pk_bf16(o[2], o[3]);
                        if (bad) { w.x = 0x7fc07fc0u; w.y = 0x7fc07fc0u; } *(u32x2v*)(xn + off + bj * HALF + n * 16) = w; }
                asm volatile("" ::: "memory"); }
    }
};

template <class Epi, class Sched, bool ALIGN_EPI = false, bool SP2 = false>
__device__ __forceinline__ void gemm_phase(PG8_LAS unsigned char* lds, const Gemm g, const Sched S, const Epi E) {
    const int tid = threadIdx.x, wid = __builtin_amdgcn_readfirstlane(tid >> 6), lane = tid & 63, wr = wid >> 2, wc = wid & 3, fr = lane & 15, fq = lane >> 4;
    const int K = g.K, nt = K / BK;
    unsigned voffA[2], voffB[2];
#pragma unroll
    for (int i = 0; i < 2; ++i) { int R, C; stage_rc(tid * 16 + i * 8192, R, C); const int Rb = Epi::PERM ? ((R & ~31) + perm32(R & 31)) : R;
        voffA[i] = (unsigned)(R * g.lda + C) * 2u; voffB[i] = (unsigned)(Rb * K + C) * 2u; }
    const size_t kstep = (size_t)(BK * 2);
    const size_t hstep = (size_t)HALF * K * 2;
    const size_t tstep = 2 * hstep;
    const size_t hstepA = (size_t)HALF * g.lda * 2, tstepA = 2 * hstepA;
    const unsigned ldsw = (unsigned)wid * 1024u;
    const int aoff = lds_byte(wr * 64 + fr, fq * 8), boff = lds_byte(wc * 32 + fr, fq * 8);
#define PG8_SA(b, h) (((b) * 2 + (h)) * HTB)
#define PG8_SB(b, h) ((4 + (b) * 2 + (h)) * HTB)
#define PG8_STAGE(bufoff, gbase, voff) do { _Pragma("unroll") for (int _i = 0; _i < 2; ++_i) \
        __builtin_amdgcn_global_load_lds((const unsigned*)((const char*)(gbase) + (voff)[_i]), (PG8_LAS unsigned*)(lds + (bufoff) + ldsw + _i * 8192), 16, 0, 0); } while (0)
#define PG8_LDA(dst, b, h) do { _Pragma("unroll") for (int m = 0; m < 4; ++m) _Pragma("unroll") for (int k = 0; k < 2; ++k) dst[m][k] = *(const PG8_LAS bf16x8*)(lds + PG8_SA(b, h) + aoff + m * 2048 + k * 1024); } while (0)
#define PG8_LDB(dst, b, h) do { _Pragma("unroll") for (int n = 0; n < 2; ++n) _Pragma("unroll") for (int k = 0; k < 2; ++k) dst[n][k] = *(const PG8_LAS bf16x8*)(lds + PG8_SB(b, h) + boff + n * 2048 + k * 1024); } while (0)
#define PG8_MMA(ai, bj, At, Bt) do { __builtin_amdgcn_s_setprio(1); _Pragma("unroll") for (int m = 0; m < 4; ++m) _Pragma("unroll") for (int n = 0; n < 2; ++n) _Pragma("unroll") for (int k = 0; k < 2; ++k) \
        acc[ai][bj][m][n] = __builtin_amdgcn_mfma_f32_16x16x32_bf16(Bt[n][k], At[m][k], acc[ai][bj][m][n], 0, 0, 0); __builtin_amdgcn_s_setprio(0); } while (0)
#define PG8_WAIT_V(n) asm volatile("s_waitcnt vmcnt(" #n ")" ::: "memory")
#define PG8_WAIT_L(n) asm volatile("s_waitcnt lgkmcnt(" #n ")" ::: "memory")
#define PG8_BAR __builtin_amdgcn_s_barrier()
#define PG8_SCHED __builtin_amdgcn_sched_barrier(0)
    Unit cur, nxt; int ui = 0;
    if (!S.next(0, cur)) return;
    f32x4 acc[2][2][4][2];
#pragma unroll
    for (int a = 0; a < 2; ++a)
#pragma unroll
        for (int b = 0; b < 2; ++b)
#pragma unroll
            for (int m = 0; m < 4; ++m)
#pragma unroll
                for (int n = 0; n < 2; ++n) acc[a][b][m][n] = (f32x4){0.f, 0.f, 0.f, 0.f};
    bf16x8 At[4][2], B0[2][2], B1[2][2];
    const char* cA = (const char*)g.A + (size_t)cur.pm * tstepA; const char* cB = (const char*)g.Bt + (size_t)cur.pn * tstep;
    S.a_ready(cur);
    if constexpr (SP2) {
        PG8_STAGE(PG8_SB(0, 0), cB, voffB); PG8_STAGE(PG8_SB(0, 1), cB + hstep, voffB); PG8_STAGE(PG8_SA(0, 0), cA, voffA); PG8_STAGE(PG8_SA(0, 1), cA + hstepA, voffA);
        if (wr == 1) PG8_BAR;
        PG8_WAIT_V(2); PG8_BAR;
        PG8_STAGE(PG8_SB(1, 0), cB + kstep, voffB); PG8_STAGE(PG8_SA(1, 0), cA + kstep, voffA); PG8_STAGE(PG8_SB(1, 1), cB + hstep + kstep, voffB);
        PG8_WAIT_V(6); PG8_BAR;
    } else {
        PG8_STAGE(PG8_SB(0, 0), cB, voffB); PG8_STAGE(PG8_SA(0, 0), cA, voffA); PG8_STAGE(PG8_SB(0, 1), cB + hstep, voffB); PG8_STAGE(PG8_SA(0, 1), cA + hstepA, voffA);
        if (wr == 1) PG8_BAR;
        PG8_WAIT_V(4); PG8_BAR;
        PG8_STAGE(PG8_SB(1, 0), cB + kstep, voffB); PG8_STAGE(PG8_SA(1, 0), cA + kstep, voffA); PG8_STAGE(PG8_SB(1, 1), cB + hstep + kstep, voffB);
        PG8_WAIT_V(6); PG8_BAR;
    }
    for (;;) {
        const bool has_next = S.next(ui + 1, nxt);
        const char* nA = has_next ? (const char*)g.A + (size_t)nxt.pm * tstepA : cA; const char* nB = has_next ? (const char*)g.Bt + (size_t)nxt.pn * tstep : cB;
        for (int t = 0; t < nt; t += 2) {
            const bool last = (t == nt - 2);
            const char* a1 = cA + (size_t)(t + 1) * kstep;
            const char* a2 = last ? nA : cA + (size_t)(t + 2) * kstep; const char* b2 = last ? nB : cB + (size_t)(t + 2) * kstep;
            const char* a3 = a2 + kstep; const char* b3 = b2 + kstep;
            if (last && has_next) S.a_ready(nxt);
            if constexpr (SP2) {
            PG8_LDB(B0, 0, 0); PG8_LDB(B1, 0, 1); PG8_SCHED; PG8_LDA(At, 0, 0); PG8_STAGE(PG8_SA(1, 1), a1 + hstepA, voffA);
            PG8_WAIT_V(8); PG8_WAIT_L(0); PG8_BAR; PG8_MMA(0, 0, At, B0); PG8_MMA(0, 1, At, B1); PG8_BAR; PG8_SCHED;
            PG8_LDA(At, 0, 1); PG8_STAGE(PG8_SB(0, 0), b2, voffB); PG8_STAGE(PG8_SB(0, 1), b2 + hstep, voffB); PG8_STAGE(PG8_SA(0, 0), a2, voffA);
            PG8_WAIT_V(8); PG8_WAIT_L(0); PG8_BAR; PG8_MMA(1, 0, At, B0); PG8_MMA(1, 1, At, B1); PG8_BAR; PG8_SCHED;
            PG8_LDB(B0, 1, 0); PG8_LDB(B1, 1, 1); PG8_SCHED; PG8_LDA(At, 1, 0); PG8_STAGE(PG8_SA(0, 1), a2 + hstepA, voffA);
            PG8_WAIT_V(8); PG8_WAIT_L(0); PG8_BAR; PG8_MMA(0, 0, At, B0); PG8_MMA(0, 1, At, B1); PG8_BAR; PG8_SCHED;
            PG8_LDA(At, 1, 1); PG8_STAGE(PG8_SB(1, 0), b3, voffB); PG8_STAGE(PG8_SB(1, 1), b3 + hstep, voffB); PG8_STAGE(PG8_SA(1, 0), a3, voffA);
            PG8_WAIT_V(8); PG8_WAIT_L(0); PG8_BAR; PG8_MMA(1, 0, At, B0); PG8_MMA(1, 1, At, B1); PG8_BAR; PG8_SCHED;
            } else {
            PG8_LDB(B0, 0, 0); PG8_SCHED; PG8_LDA(At, 0, 0); PG8_STAGE(PG8_SA(1, 1), a1 + hstepA, voffA);
            PG8_WAIT_L(8); PG8_BAR; PG8_WAIT_L(0); PG8_MMA(0, 0, At, B0); PG8_BAR; PG8_SCHED;
            PG8_LDB(B1, 0, 1); PG8_STAGE(PG8_SB(0, 0), b2, voffB);
            PG8_BAR; PG8_WAIT_L(0); PG8_MMA(0, 1, At, B1); PG8_BAR;
            PG8_LDA(At, 0, 1); PG8_STAGE(PG8_SA(0, 0), a2, voffA);
            PG8_BAR; PG8_WAIT_L(0); PG8_MMA(1, 0, At, B0); PG8_BAR; PG8_SCHED;
            PG8_STAGE(PG8_SB(0, 1), b2 + hstep, voffB);
            PG8_WAIT_V(6); PG8_BAR; PG8_MMA(1, 1, At, B1); PG8_BAR;
            PG8_LDB(B0, 1, 0); PG8_SCHED; PG8_LDA(At, 1, 0); PG8_STAGE(PG8_SA(0, 1), a2 + hstepA, voffA);
            PG8_WAIT_L(8); PG8_BAR; PG8_WAIT_L(0); PG8_MMA(0, 0, At, B0); PG8_BAR; PG8_SCHED;
            PG8_LDB(B1, 1, 1); PG8_STAGE(PG8_SB(1, 0), b3, voffB);
            PG8_BAR; PG8_WAIT_L(0); PG8_MMA(0, 1, At, B1); PG8_BAR;
            PG8_LDA(At, 1, 1); PG8_STAGE(PG8_SA(1, 0), a3, voffA);
            PG8_BAR; PG8_WAIT_L(0); PG8_MMA(1, 0, At, B0); PG8_BAR; PG8_SCHED;
            PG8_STAGE(PG8_SB(1, 1), b3 + hstep, voffB);
            PG8_WAIT_V(6); PG8_BAR; PG8_MMA(1, 1, At, B1); PG8_BAR;
            }
        }
        if constexpr (ALIGN_EPI) { if (wr == 0) PG8_BAR; }
        if constexpr (!Epi::AFTER_DRAIN) { E(acc, cur, wr, wc, fr, fq); S.done(cur); }
        if (!has_next) break;
#pragma unroll
        for (int a = 0; a < 2; ++a)
#pragma unroll
            for (int b = 0; b < 2; ++b)
#pragma unroll
                for (int m = 0; m < 4; ++m)
#pragma unroll
                    for (int n = 0; n < 2; ++n) acc[a][b][m][n] = (f32x4){0.f, 0.f, 0.f, 0.f};
        cur = nxt; cA = nA; cB = nB; ++ui;
        if constexpr (ALIGN_EPI) { if (wr == 1) PG8_BAR; }
    }
    PG8_WAIT_V(0);
    if constexpr (!ALIGN_EPI) { if (wr == 0) PG8_BAR; }
    PG8_BAR;
    if constexpr (Epi::AFTER_DRAIN) { E.fused(acc, cur, wr, wc, fr, fq, lds, wid, lane); S.done(cur); }
#undef PG8_SA
#undef PG8_SB
#undef PG8_STAGE
#undef PG8_LDA
#undef PG8_LDB
#undef PG8_MMA
#undef PG8_WAIT_V
#undef PG8_WAIT_L
#undef PG8_BAR
#undef PG8_SCHED
}
}

#ifndef GEMM_SP2
#define GEMM_SP2 true
#endif
#ifndef GEMM_ALIGN
#define GEMM_ALIGN true
#endif
namespace mk {
#define LAS __attribute__((address_space(3)))
using pg8::bf16_t; using pg8::bf16x8; using pg8::f32x4; using pg8::u32x4;
typedef unsigned u32x2 __attribute__((ext_vector_type(2)));

constexpr int DM = 1024, SEQ = 8192, NBATCH = 4, MPR = NBATCH * SEQ, MSAMP = 128, MREAL = MPR + MSAMP, MPAD = 33024;
constexpr int DFF = 2816, PW = 2816, NINP = 3072, CONVC = 1536;
constexpr float EPS = 1e-6f;
#ifndef SCAN_CW
#define SCAN_CW 2
#endif
constexpr int CW = SCAN_CW, NSCAN = 128 / CW;
constexpr int LDS_PHASE_BYTES = 155648, LDS_BYTES = LDS_PHASE_BYTES + 256;

constexpr size_t O_YP = 0, O_YS = 33554432, O_KP = 33685504, O_VP = 33751040, O_CP = 33816576, O_GP = 33835008,
                 O_KS = 34097152, O_VS = 36194304, O_CS = 38291456, O_GS = 38881280;
constexpr size_t MiB = 1u << 20;
constexpr size_t WS_CTL = 0, CTL_ZERO_BYTES = 1 * MiB;
constexpr size_t WS_W1IN = 1 * MiB, WS_W1OUT = 12 * MiB, WS_WINMIX = 18 * MiB, WS_WOUTMIX = 24 * MiB, WS_W2IN = 26 * MiB, WS_W2OUT = 37 * MiB;
constexpr size_t WS_GBA = 43 * MiB, WS_XN = 45 * MiB, WS_XN2 = 110 * MiB, WS_H = 175 * MiB, WS_GM = 353 * MiB, WS_GN = 417 * MiB;
constexpr size_t WS_GQ = 110 * MiB, WS_GO = 142 * MiB;
constexpr size_t WS_SSP1 = 481 * MiB, WS_SSP2 = 484 * MiB;
constexpr size_t WS_END = 487 * MiB;
constexpr size_t CTL_BAR = 0, CTL_BAR_BYTES = 16384, CTL_GLAST = 768 * 1024;

struct Params { const float* in[21]; float* out; unsigned char* ws; };

typedef float f32x2v __attribute__((ext_vector_type(2)));
typedef __bf16 bf16x2v __attribute__((ext_vector_type(2)));
__device__ __forceinline__ unsigned cvt_pk(float lo, float hi) { const f32x2v v = {lo, hi}; const bf16x2v b = __builtin_convertvector(v, bf16x2v); return __builtin_bit_cast(unsigned, b); }
__device__ __forceinline__ bf16_t f2bf(float f) { return (bf16_t)(cvt_pk(f, 0.f) & 0xffffu); }
__device__ __forceinline__ float bf2f(bf16_t h) { return __uint_as_float(((unsigned)h) << 16); }
__device__ __forceinline__ float bflo(unsigned w) { return __uint_as_float(w << 16); }
__device__ __forceinline__ float bfhi(unsigned w) { return __uint_as_float(w & 0xffff0000u); }
__device__ __forceinline__ float silu(float x) { return x * __builtin_amdgcn_rcpf(1.0f + __expf(-x)); }
__device__ __forceinline__ float wave_sum(float v) {
#pragma unroll
    for (int o = 1; o < 64; o <<= 1) v += __shfl_xor(v, o);
    return v;
}
__device__ __forceinline__ float wave_max(float v) {
#pragma unroll
    for (int o = 1; o < 64; o <<= 1) v = fmaxf(v, __shfl_xor(v, o));
    return v;
}
__device__ __forceinline__ float row16_sum(float v) {
    v += __builtin_bit_cast(float, __builtin_amdgcn_update_dpp(0, __builtin_bit_cast(int, v), 0xB1, 0xF, 0xF, true));
    v += __builtin_bit_cast(float, __builtin_amdgcn_update_dpp(0, __builtin_bit_cast(int, v), 0x4E, 0xF, 0xF, true));
    v += __builtin_bit_cast(float, __builtin_amdgcn_update_dpp(0, __builtin_bit_cast(int, v), 0x141, 0xF, 0xF, true));
    v += __builtin_bit_cast(float, __builtin_amdgcn_update_dpp(0, __builtin_bit_cast(int, v), 0x140, 0xF, 0xF, true));
    return v;
}
__device__ __forceinline__ f32x4 mfma16(bf16x8 a, bf16x8 b, f32x4 c) { return __builtin_amdgcn_mfma_f32_16x16x32_bf16(a, b, c, 0, 0, 0); }

__device__ __forceinline__ float row_rstd(const float* ssp, int r) {
    if (r >= MREAL) return 0.f;
    const f32x4 a = *(const f32x4*)(ssp + (size_t)r * 16), b = *(const f32x4*)(ssp + (size_t)r * 16 + 4), c = *(const f32x4*)(ssp + (size_t)r * 16 + 8), d = *(const f32x4*)(ssp + (size_t)r * 16 + 12);
    const float s = (((a[0] + a[1]) + (a[2] + a[3])) + ((b[0] + b[1]) + (b[2] + b[3]))) + (((c[0] + c[1]) + (c[2] + c[3])) + ((d[0] + d[1]) + (d[2] + d[3])));
    return rsqrtf(s * (1.0f / DM) + EPS);
}
struct EpiSwiglu {
    static constexpr bool PERM = true, AFTER_DRAIN = false;
    bf16_t* H; const float* ss;
    __device__ __forceinline__ void operator()(const f32x4 (&acc)[2][2][4][2], const pg8::Unit& u, int wr, int wc, int fr, int fq) const {
        const int row0 = u.pm * 256 + wr * 64 + fr, col0 = u.pn * 128 + wc * 32 + 8 * fq;
#pragma unroll
        for (int ai = 0; ai < 2; ++ai)
#pragma unroll
            for (int m = 0; m < 4; ++m) {
                const int r = row0 + ai * 128 + m * 16;
                const float rs = ss ? row_rstd(ss, r) : 1.0f;
                float h[8];
#pragma unroll
                for (int n = 0; n < 2; ++n)
#pragma unroll
                    for (int j = 0; j < 4; ++j) h[n * 4 + j] = silu(acc[ai][0][m][n][j] * rs) * (acc[ai][1][m][n][j] * rs);
                u32x4 w; w.x = cvt_pk(h[0], h[1]); w.y = cvt_pk(h[2], h[3]); w.z = cvt_pk(h[4], h[5]); w.w = cvt_pk(h[6], h[7]);
                *(u32x4*)(H + (size_t)r * DFF + col0) = w;
            }
    }
};
template <bool RESB16, bool WF32, bool WB16, bool SUMSQ, bool HALF> struct EpiResid {
    static constexpr bool PERM = true, AFTER_DRAIN = false;
    const void* resP; const void* resS; float* Yo; bf16_t* XBo; float* sso;
    __device__ __forceinline__ void operator()(const f32x4 (&acc)[2][2][4][2], const pg8::Unit& u, int wr, int wc, int fr, int fq) const {
        const int row0 = u.pm * 256 + wr * 64 + fr, col0 = u.pn * 256 + wc * 32 + 8 * fq;
        const char* const rP = (const char*)resP; const char* const rS = (const char*)resS - (size_t)MPR * DM * (RESB16 ? 2 : 4);
        float* const Y = Yo; const float scale = HALF ? 0.5f : 1.0f; bf16_t* const XB = XBo; float* const ss = sso;
#pragma unroll
        for (int ai = 0; ai < 2; ++ai)
#pragma unroll
            for (int m = 0; m < 4; ++m) {
                const int r = row0 + ai * 128 + m * 16; float s = 0.f;
                if (r < MREAL) {
                    const char* rp = ((r < MPR) ? rP : rS) + (size_t)r * DM * (RESB16 ? 2 : 4);
#pragma unroll
                    for (int bj = 0; bj < 2; ++bj) {
                        const int c = col0 + bj * 128;
                        f32x4 r0, r1;
                        if (RESB16) { const u32x4 w = *(const u32x4*)(rp + (size_t)c * 2); r0 = (f32x4){bflo(w.x), bfhi(w.x), bflo(w.y), bfhi(w.y)}; r1 = (f32x4){bflo(w.z), bfhi(w.z), bflo(w.w), bfhi(w.w)}; }
                        else { r0 = *(const f32x4*)(rp + (size_t)c * 4); r1 = *(const f32x4*)(rp + (size_t)c * 4 + 16); }
                        const f32x4 v0 = r0 + acc[ai][bj][m][0] * scale, v1 = r1 + acc[ai][bj][m][1] * scale;
                        if (WF32) { *(f32x4*)(Y + (size_t)r * DM + c) = v0; *(f32x4*)(Y + (size_t)r * DM + c + 4) = v1; }
                        if (WB16) { u32x4 w; w.x = cvt_pk(v0[0], v0[1]); w.y = cvt_pk(v0[2], v0[3]); w.z = cvt_pk(v1[0], v1[1]); w.w = cvt_pk(v1[2], v1[3]);
                            *(u32x4*)(XB + (size_t)r * DM + c) = w; }
                        if (SUMSQ) s += (v0[0] * v0[0] + v0[1] * v0[1]) + (v0[2] * v0[2] + v0[3] * v0[3]) + (v1[0] * v1[0] + v1[1] * v1[1]) + (v1[2] * v1[2] + v1[3] * v1[3]);
                    }
                }
                if (SUMSQ) { s += __shfl_xor(s, 16); s += __shfl_xor(s, 32); if (fq == 0 && r < MREAL) ss[(size_t)r * 16 + u.pn * 4 + wc] = s; }
            }
    }
};
struct EpiInproj {
    static constexpr bool PERM = true, AFTER_DRAIN = false;
    bf16_t* P; float* gba; const float* ss;
    __device__ __forceinline__ void operator()(const f32x4 (&acc)[2][2][4][2], const pg8::Unit& u, int wr, int wc, int fr, int fq) const {
        const int row0 = u.pm * 256 + wr * 64 + fr, col0 = u.pn * 256 + wc * 32 + 8 * fq;
#pragma unroll
        for (int ai = 0; ai < 2; ++ai)
#pragma unroll
            for (int m = 0; m < 4; ++m) {
                const int r = row0 + ai * 128 + m * 16;
                const float rs = row_rstd(ss, r);
                if (u.pn < 11) {
#pragma unroll
                    for (int bj = 0; bj < 2; ++bj) { const f32x4 v0 = acc[ai][bj][m][0] * rs, v1 = acc[ai][bj][m][1] * rs;
                        u32x4 w; w.x = cvt_pk(v0[0], v0[1]); w.y = cvt_pk(v0[2], v0[3]); w.z = cvt_pk(v1[0], v1[1]); w.w = cvt_pk(v1[2], v1[3]);
                        *(u32x4*)(P + (size_t)r * PW + col0 + bj * 128) = w; }
                } else if (wc == 0 && fq == 0) {
                    *(f32x4*)(gba + (size_t)r * 8) = acc[ai][0][m][0] * rs; *(f32x4*)(gba + (size_t)r * 8 + 4) = acc[ai][0][m][1] * rs;
                }
            }
    }
};


template <int NT, bool SS>
__device__ __forceinline__ void skinny_mm(const bf16_t* A, int lda, const bf16_t* W, int K, int wrow0, int wrow1, int wid, int fr, int fq, f32x4 (&acc)[NT], float& ss, LAS unsigned char* lds) {
    const int lane = fq * 16 + fr, kper = K >> 3, nks = kper >> 5;
    const bf16_t* ap = A + (size_t)fr * lda + wid * kper + 8 * fq;
    const bf16_t* w0 = W + (size_t)(wrow0 + fr) * K + wid * kper + 8 * fq; const bf16_t* w1 = W + (size_t)(wrow1 + fr) * K + wid * kper + 8 * fq;
    f32x4 pa[NT][8]; float sp[8];
#pragma unroll
    for (int mt = 0; mt < 8; ++mt) { sp[mt] = 0.f;
#pragma unroll
        for (int nt = 0; nt < NT; ++nt) pa[nt][mt] = (f32x4){0.f, 0.f, 0.f, 0.f}; }
#pragma unroll 2
    for (int ks = 0; ks < nks; ++ks) {
        const bf16x8 b0 = *(const bf16x8*)(w0 + 32 * ks); bf16x8 b1 = b0; if (NT == 2) b1 = *(const bf16x8*)(w1 + 32 * ks);
        bf16x8 av[8];
#pragma unroll
        for (int mt = 0; mt < 8; ++mt) av[mt] = *(const bf16x8*)(ap + (size_t)(16 * mt) * lda + 32 * ks);
#pragma unroll
        for (int mt = 0; mt < 8; ++mt) {
            pa[0][mt] = mfma16(b0, av[mt], pa[0][mt]);
            if (NT == 2) pa[NT - 1][mt] = mfma16(b1, av[mt], pa[NT - 1][mt]);
            if (SS) { const u32x4 u = __builtin_bit_cast(u32x4, av[mt]);
#pragma unroll
                for (int k = 0; k < 4; ++k) { const float lo = bflo(u[k]), hi = bfhi(u[k]); sp[mt] += lo * lo + hi * hi; } }
        }
    }
    LAS f32x4* red = (LAS f32x4*)lds;
    LAS float* sred = (LAS float*)(lds + 8 * NT * 8 * 64 * 16);
#pragma unroll
    for (int mt = 0; mt < 8; ++mt) {
#pragma unroll
        for (int nt = 0; nt < NT; ++nt) red[((wid * NT + nt) * 8 + mt) * 64 + lane] = pa[nt][mt];
        if (SS) sred[(wid * 8 + mt) * 64 + lane] = sp[mt];
    }
    __syncthreads();
    float s = 0.f;
#pragma unroll
    for (int nt = 0; nt < NT; ++nt) acc[nt] = (f32x4){0.f, 0.f, 0.f, 0.f};
#pragma unroll
    for (int v = 0; v < 8; ++v) {
#pragma unroll
        for (int nt = 0; nt < NT; ++nt) acc[nt] += red[((v * NT + nt) * 8 + wid) * 64 + lane];
        if (SS) s += sred[(v * 8 + wid) * 64 + lane];
    }
    if (SS) { s += __shfl_xor(s, 16); s += __shfl_xor(s, 32); }
    ss = s;
    __syncthreads();
}
template <bool SS> __device__ __forceinline__ void sk_ffn_in(const bf16_t* X, const bf16_t* Wt, bf16_t* H, int slab, int wid, int fr, int fq, LAS unsigned char* lds) {
    const int j0 = 16 * slab, wr0 = (j0 >> 7) * 256 + (j0 & 127);
    f32x4 acc[2]; float ss;
    skinny_mm<2, SS>(X + (size_t)MPR * DM, DM, Wt, DM, wr0, wr0 + 128, wid, fr, fq, acc, ss, lds);
    const float rs = SS ? rsqrtf(ss * (1.0f / DM) + EPS) : 1.0f;
    float h[4];
#pragma unroll
    for (int e = 0; e < 4; ++e) h[e] = silu(acc[0][e] * rs) * (acc[1][e] * rs);
    u32x2 w; w.x = cvt_pk(h[0], h[1]); w.y = cvt_pk(h[2], h[3]);
    *(u32x2*)(H + (size_t)(MPR + 16 * wid + fr) * DFF + j0 + 4 * fq) = w;
}
template <bool OUTF32> __device__ __forceinline__ void sk_ffn_out(const bf16_t* Hb, const bf16_t* Wt, const float* resf, float* outf, bf16_t* outb, int slab, int wid, int fr, int fq, LAS unsigned char* lds) {
    f32x4 acc[1]; float ss;
    skinny_mm<1, false>(Hb + (size_t)MPR * DFF, DFF, Wt, DFF, 16 * slab, 0, wid, fr, fq, acc, ss, lds);
    const int rl = 16 * wid + fr, c = 16 * slab + 4 * fq;
    f32x4 rv;
    if (OUTF32) { const u32x2 xr = *(const u32x2*)((const bf16_t*)resf + (size_t)rl * DM + c); rv = (f32x4){bflo(xr.x), bfhi(xr.x), bflo(xr.y), bfhi(xr.y)}; }
    else rv = *(const f32x4*)(resf + (size_t)rl * DM + c);
    const f32x4 v = rv + acc[0] * 0.5f;
    { u32x2 w; w.x = cvt_pk(v[0], v[1]); w.y = cvt_pk(v[2], v[3]); *(u32x2*)(outb + (size_t)rl * DM + c) = w; }
}
__device__ __forceinline__ void sk_inproj(const bf16_t* X, const bf16_t* Wt, bf16_t* P, float* gba, int slab, int wid, int fr, int fq, LAS unsigned char* lds) {
    const int n0 = 32 * slab; f32x4 acc[2]; float ss;
    skinny_mm<2, true>(X + (size_t)MPR * DM, DM, Wt, DM, n0, n0 + 16, wid, fr, fq, acc, ss, lds);
    const float rs = rsqrtf(ss * (1.0f / DM) + EPS); const int r = MPR + 16 * wid + fr;
    if (n0 < PW) {
#pragma unroll
        for (int nt = 0; nt < 2; ++nt) { const f32x4 v = acc[nt] * rs; u32x2 w; w.x = cvt_pk(v[0], v[1]); w.y = cvt_pk(v[2], v[3]); *(u32x2*)(P + (size_t)r * PW + n0 + 16 * nt + 4 * fq) = w; }
    } else if (fq < 2) *(f32x4*)(gba + (size_t)r * 8 + 4 * fq) = acc[0] * rs;
}
__device__ __forceinline__ void sk_outproj(const bf16_t* Pm, const bf16_t* Wt, const bf16_t* X1b, float* X2f, bf16_t* X2b, int slab, int wid, int fr, int fq, LAS unsigned char* lds) {
    const int n0 = 32 * slab; f32x4 acc[2]; float ss;
    skinny_mm<2, false>(Pm + (size_t)MPR * PW, PW, Wt, DM, n0, n0 + 16, wid, fr, fq, acc, ss, lds);
    const int r = MPR + 16 * wid + fr;
#pragma unroll
    for (int nt = 0; nt < 2; ++nt) { const int c = n0 + 16 * nt + 4 * fq; const u32x2 xr = *(const u32x2*)(X1b + (size_t)r * DM + c);
        const f32x4 v = (f32x4){bflo(xr.x), bfhi(xr.x), bflo(xr.y), bfhi(xr.y)} + acc[nt];
        u32x2 w; w.x = cvt_pk(v[0], v[1]); w.y = cvt_pk(v[2], v[3]); *(u32x2*)(X2b + (size_t)r * DM + c) = w; }
}

__device__ __forceinline__ void transpose_item(const float* W, int K, int N, bf16_t* WT, int k0, int n0, int drow0, const float* gs, LAS float* scr, int lane) {
    float wv[32];
#pragma unroll
    for (int i = 0; i < 32; ++i) { const int kk = 2 * i + (lane >> 5), n = n0 + (lane & 31); wv[i] = (n < N) ? W[(size_t)(k0 + kk) * N + n] : 0.f; }
#pragma unroll
    for (int i = 0; i < 32; ++i) { const int kk = 2 * i + (lane >> 5); float v = wv[i]; if (gs) v *= gs[k0 + kk]; scr[kk * 33 + (lane & 31)] = v; }
    asm volatile("s_waitcnt lgkmcnt(0)" ::: "memory");
    const int c = lane & 7;
#pragma unroll
    for (int j = 0; j < 4; ++j) { const int nn = (lane >> 3) + 8 * j; const LAS float* s = scr + (8 * c) * 33 + nn;
        u32x4 o; o.x = cvt_pk(s[0 * 33], s[1 * 33]); o.y = cvt_pk(s[2 * 33], s[3 * 33]); o.z = cvt_pk(s[4 * 33], s[5 * 33]); o.w = cvt_pk(s[6 * 33], s[7 * 33]);
        *(u32x4*)(WT + (size_t)(drow0 + nn) * K + k0 + 8 * c) = o; }
    asm volatile("s_waitcnt lgkmcnt(0)" ::: "memory");
}
__device__ __forceinline__ int map_ffin_row(int n0) { return n0 < DFF ? (n0 >> 7) * 256 + (n0 & 127) : ((n0 - DFF) >> 7) * 256 + 128 + ((n0 - DFF) & 127); }

__device__ __forceinline__ void p0_prologue(const Params& p, LAS unsigned char* lds, int vb, int G) {
    const int tid = threadIdx.x, lane = tid & 63, wid = tid >> 6;
    LAS float* scr = (LAS float*)(lds + wid * 16384);
    const int gw = vb * 8 + wid, NGW = G * 8;
    bf16_t* W1IN = (bf16_t*)(p.ws + WS_W1IN); bf16_t* W1OUT = (bf16_t*)(p.ws + WS_W1OUT); bf16_t* WINMIX = (bf16_t*)(p.ws + WS_WINMIX);
    bf16_t* WOUTMIX = (bf16_t*)(p.ws + WS_WOUTMIX); bf16_t* W2IN = (bf16_t*)(p.ws + WS_W2IN); bf16_t* W2OUT = (bf16_t*)(p.ws + WS_W2OUT);
    constexpr int I_FIN = 16 * 176, I_FOUT = 44 * 32, I_INMIX = 16 * 89, I_OUTMIX = 16 * 32;
    constexpr int NITEMS = 2 * I_FIN + 2 * I_FOUT + I_INMIX + I_OUTMIX;
    for (int it = gw; it < NITEMS; it += NGW) {
        int r = it;
        if (r < I_FIN) { const int kb = r / 176, nb = r % 176; transpose_item(p.in[7], DM, 2 * DFF, W1IN, kb * 64, nb * 32, map_ffin_row(nb * 32), nullptr, scr, lane); continue; } r -= I_FIN;
        if (r < I_FIN) { const int kb = r / 176, nb = r % 176; transpose_item(p.in[18], DM, 2 * DFF, W2IN, kb * 64, nb * 32, map_ffin_row(nb * 32), p.in[17], scr, lane); continue; } r -= I_FIN;
        if (r < I_FOUT) { const int kb = r / 32, nb = r % 32; transpose_item(p.in[8], DFF, DM, W1OUT, kb * 64, nb * 32, nb * 32, nullptr, scr, lane); continue; } r -= I_FOUT;
        if (r < I_FOUT) { const int kb = r / 32, nb = r % 32; transpose_item(p.in[19], DFF, DM, W2OUT, kb * 64, nb * 32, nb * 32, nullptr, scr, lane); continue; } r -= I_FOUT;
        if (r < I_INMIX) { const int kb = r / 89, nb = r % 89; transpose_item(p.in[10], DM, 2824, WINMIX, kb * 64, nb * 32, nb * 32, p.in[9], scr, lane); continue; } r -= I_INMIX;
        { const int kb = r / 32, nb = r % 32; transpose_item(p.in[16], DM, DM, WOUTMIX, kb * 64, nb * 32, nb * 32, nullptr, scr, lane); }
    }
    bf16_t* XN = (bf16_t*)(p.ws + WS_XN); const float* g1 = p.in[6];
    f32x4 gv[4];
#pragma unroll
    for (int j = 0; j < 4; ++j) gv[j] = *((const f32x4*)g1 + lane + 64 * j);
    {
        f32x4 v[4], vn[4];
        int m = gw;
        if (m < MREAL) { const f32x4* xr = (const f32x4*)((m < MPR) ? p.in[0] + (size_t)m * DM : p.in[1] + (size_t)(m - MPR) * DM) + lane;
#pragma unroll
            for (int j = 0; j < 4; ++j) v[j] = xr[64 * j]; }
        for (; m < MREAL; m += NGW) {
            const int mn = m + NGW;
            if (mn < MREAL) { const f32x4* xr = (const f32x4*)((mn < MPR) ? p.in[0] + (size_t)mn * DM : p.in[1] + (size_t)(mn - MPR) * DM) + lane;
#pragma unroll
                for (int j = 0; j < 4; ++j) vn[j] = xr[64 * j]; }
            float s = 0.f;
#pragma unroll
            for (int j = 0; j < 4; ++j) s += (v[j][0] * v[j][0] + v[j][1] * v[j][1]) + (v[j][2] * v[j][2] + v[j][3] * v[j][3]);
            const float rstd = rsqrtf(wave_sum(s) * (1.0f / DM) + EPS);
            unsigned long long* o8 = (unsigned long long*)(XN + (size_t)m * DM) + lane;
#pragma unroll
            for (int j = 0; j < 4; ++j) { const f32x4 y = v[j] * rstd * gv[j];
                o8[64 * j] = (unsigned long long)cvt_pk(y[0], y[1]) | ((unsigned long long)cvt_pk(y[2], y[3]) << 32); }
#pragma unroll
            for (int j = 0; j < 4; ++j) v[j] = vn[j];
        }
    }
}

template <bool SWX = false, bool SWY = false>
__device__ __forceinline__ f32x4 tile_mm(const LAS bf16_t* X, int ldx, int mt, const LAS bf16_t* Y, int ldy, int nt, int nks, int fr, int fq) {
    f32x4 acc = (f32x4){0.f, 0.f, 0.f, 0.f};
    const int rx = 16 * mt + fr, ry = 16 * nt + fr, sx = SWX ? ((rx >> 3) & 7) : 0, sy = SWY ? ((ry >> 3) & 7) : 0;
    const LAS bf16_t* xp = X + rx * ldx; const LAS bf16_t* yp = Y + ry * ldy;
    for (int ks = 0; ks < nks; ++ks) acc = mfma16(*(const LAS bf16x8*)(xp + 8 * ((4 * ks + fq) ^ sx)), *(const LAS bf16x8*)(yp + 8 * ((4 * ks + fq) ^ sy)), acc);
    return acc;
}
constexpr int G1_QS = 0, G1_KS = 17408, G1_VBT = 34816, G1_KBT = 53248, G1_KDT = 71680, G1_UT = 90112, G1_WT = 108544, G1_QK = 126976, G1_TB = 136192, G1_GC = 145408, G1_BETA = 145664, G1_TT = 146176, G1_A10 = 148736, G1_PT = 151296;

__device__ __forceinline__ void gdn_prep_unit(const Params& p, LAS unsigned char* lds, int unit) {
    const int tid = threadIdx.x, lane = tid & 63, wid = tid >> 6, fr = lane & 15, fq = lane >> 4;
    const int bh = unit >> 7, n = unit & 127, b = bh >> 2, h = bh & 3;
    const int tok0 = b * SEQ + n * 64;
    LAS bf16_t* Qs = (LAS bf16_t*)(lds + G1_QS); LAS bf16_t* Ks = (LAS bf16_t*)(lds + G1_KS); LAS bf16_t* VbT = (LAS bf16_t*)(lds + G1_VBT);
    LAS bf16_t* KbT = (LAS bf16_t*)(lds + G1_KBT); LAS bf16_t* KdT = (LAS bf16_t*)(lds + G1_KDT); LAS bf16_t* UT = (LAS bf16_t*)(lds + G1_UT);
    LAS bf16_t* WT = (LAS bf16_t*)(lds + G1_WT); LAS float* Af = (LAS float*)(lds + G1_WT); LAS bf16_t* QK = (LAS bf16_t*)(lds + G1_QK);
    LAS bf16_t* Tb = (LAS bf16_t*)(lds + G1_TB); LAS bf16_t* TT = (LAS bf16_t*)(lds + G1_TT); LAS bf16_t* A10b = (LAS bf16_t*)(lds + G1_A10); LAS bf16_t* PT = (LAS bf16_t*)(lds + G1_PT); LAS float* gcs = (LAS float*)(lds + G1_GC); LAS float* betas = (LAS float*)(lds + G1_BETA);
    const bf16_t* PB = (const bf16_t*)(p.ws + WS_H); const float* GBA = (const float*)(p.ws + WS_GBA);
    LAS unsigned char* raw = lds + G1_UT;
    for (int pc4 = wid; pc4 < 51; pc4 += 8) {
        int pc = pc4 * 4 + (lane >> 4); pc = pc < 200 ? pc : 200;
        const int r = pc / 3, seg = pc - 3 * r; int tt = n * 64 - 3 + r; tt = tt < 0 ? 0 : tt;
        __builtin_amdgcn_global_load_lds((const unsigned*)(PB + (size_t)(b * SEQ + tt) * PW + 768 + seg * 512 + h * 128 + (lane & 15) * 8), (LAS unsigned*)(raw + pc4 * 1024), 16, 0, 0);
    }
    if (tid < 64) {
        const float* gb = GBA + (size_t)(tok0 + tid) * 8;
        const float bt = 1.0f / (1.0f + __expf(-gb[h]));
        const float x = gb[4 + h] + p.in[14][h]; const float sp = x > 20.f ? x : log1pf(__expf(x));
        float c = -__expf(p.in[13][h]) * sp;
#pragma unroll
        for (int o = 1; o < 64; o <<= 1) { const float t = __shfl_up(c, o); if (lane >= o) c += t; }
        gcs[tid] = c; betas[tid] = bt;
    }
    asm volatile("s_waitcnt vmcnt(0)" ::: "memory");
    __syncthreads();
    const float gclast = gcs[63];
    const float* cw = p.in[12];
#pragma unroll 1
    for (int it = 0; it < 6; ++it) {
        const int item = tid + 512 * it, l16 = item & 15, row = item >> 4, which = row >> 6, t = row & 63;
        const int cch = which * 512 + h * 128 + l16 * 8;
        float a[8];
#pragma unroll
        for (int e = 0; e < 8; ++e) a[e] = 0.f;
#pragma unroll
        for (int j = 0; j < 4; ++j) {
            const int tt = n * 64 + t - 3 + j;
            if (tt >= 0) {
                const u32x4 xv = *(const LAS u32x4*)(raw + ((t + j) * 3 + which) * 256 + l16 * 16);
                const f32x4 w0 = *(const f32x4*)(cw + j * CONVC + cch), w1 = *(const f32x4*)(cw + j * CONVC + cch + 4);
                a[0] += w0[0] * bflo(xv.x); a[1] += w0[1] * bfhi(xv.x); a[2] += w0[2] * bflo(xv.y); a[3] += w0[3] * bfhi(xv.y);
                a[4] += w1[0] * bflo(xv.z); a[5] += w1[1] * bfhi(xv.z); a[6] += w1[2] * bflo(xv.w); a[7] += w1[3] * bfhi(xv.w);
            }
        }
        float ss = 0.f;
#pragma unroll
        for (int e = 0; e < 8; ++e) { a[e] = silu(a[e]); ss += a[e] * a[e]; }
        ss = row16_sum(ss);
        const float gct = gcs[t], bt = betas[t];
        const int tsw = (((t >> 3) ^ (l16 & 7)) << 3) | (t & 7);
        if (which == 0) {
            const float sc = rsqrtf(ss + EPS) * 0.08838834764831845f;
            u32x4 w; w.x = cvt_pk(a[0] * sc, a[1] * sc); w.y = cvt_pk(a[2] * sc, a[3] * sc); w.z = cvt_pk(a[4] * sc, a[5] * sc); w.w = cvt_pk(a[6] * sc, a[7] * sc);
            *(LAS u32x4*)(Qs + t * 136 + l16 * 8) = w;
        } else if (which == 1) {
            const float sc = rsqrtf(ss + EPS);
            u32x4 w; w.x = cvt_pk(a[0] * sc, a[1] * sc); w.y = cvt_pk(a[2] * sc, a[3] * sc); w.z = cvt_pk(a[4] * sc, a[5] * sc); w.w = cvt_pk(a[6] * sc, a[7] * sc);
            *(LAS u32x4*)(Ks + t * 136 + l16 * 8) = w;
            const float sb = sc * bt * __expf(gct), sd = sc * __expf(gclast - gct);
#pragma unroll
            for (int e = 0; e < 8; ++e) { KbT[(l16 * 8 + e) * 72 + tsw] = f2bf(a[e] * sb); KdT[(l16 * 8 + e) * 72 + tsw] = f2bf(a[e] * sd); }
        } else {
#pragma unroll
            for (int e = 0; e < 8; ++e) VbT[(l16 * 8 + e) * 72 + tsw] = f2bf(a[e] * bt);
        }
    }
    __syncthreads();
#pragma unroll 2
    for (int r = 0; r < 4; ++r) {
        const int job = wid + 8 * r, kind = job >> 4, tile = job & 15, it = tile >> 2, jt = tile & 3;
        if (kind == 0) {
            if (jt > it) continue;
            const f32x4 acc = tile_mm(Ks, 136, it, Ks, 136, jt, 4, fr, fq);
            const int j = 16 * jt + fr; const float gcj = gcs[j];
            float v[4];
#pragma unroll
            for (int e = 0; e < 4; ++e) { const int i = 16 * it + 4 * fq + e; const bool ok = i > j; v[e] = ok ? acc[e] * __expf(gcs[i] - gcj) * betas[i] : 0.f; }
            *(LAS f32x4*)(Af + j * 68 + 16 * it + 4 * fq) = (f32x4){v[0], v[1], v[2], v[3]};
            if (it >= 2 && jt < 2) {
#pragma unroll
                for (int e = 0; e < 4; ++e) A10b[(16 * (it - 2) + 4 * fq + e) * 40 + j] = f2bf(v[e]); }
        } else {
            const f32x4 acc = tile_mm(Ks, 136, jt, Qs, 136, it, 4, fr, fq);
            const int i = 16 * it + fr; const float gci = gcs[i];
            float v[4];
#pragma unroll
            for (int e = 0; e < 4; ++e) { const int j = 16 * jt + 4 * fq + e; const bool ok = i >= j; v[e] = ok ? acc[e] * __expf(gci - gcs[j]) : 0.f; }
            u32x2 w; w.x = cvt_pk(v[0], v[1]); w.y = cvt_pk(v[2], v[3]); *(LAS u32x2*)(QK + i * 72 + 16 * jt + 4 * fq) = w;
        }
    }
    __syncthreads();
    if (wid < 2) {
        const int ofs = wid * 32, cl = lane & 31; const LAS float* Ab = Af + ofs * 69; LAS bf16_t* Tw = Tb + ofs * 73 + cl; LAS bf16_t* Tt = (wid == 0) ? TT + cl * 40 : PT + cl * 40;
        f32x2v r2[16];
#pragma unroll
        for (int k = 0; k < 16; ++k) r2[k] = (f32x2v){(cl == 2 * k) ? 1.0f : 0.0f, (cl == 2 * k + 1) ? 1.0f : 0.0f};
        const f32x4 a0 = *(const LAS f32x4*)(Ab + 0);
        const f32x4 a1 = *(const LAS f32x4*)(Ab + 4);
        const f32x4 a2 = *(const LAS f32x4*)(Ab + 8);
        const f32x4 a3 = *(const LAS f32x4*)(Ab + 12);
        const f32x4 a4 = *(const LAS f32x4*)(Ab + 16);
        const float t0 = r2[0][0]; const f32x2v T0 = (f32x2v){t0, t0}; Tw[0] = f2bf(t0); Tt[0] = f2bf(t0);
        r2[0] -= (f32x2v){a0[0], a0[1]} * T0; r2[1] -= (f32x2v){a0[2], a0[3]} * T0;
        const f32x4 a5 = *(const LAS f32x4*)(Ab + 20);
        r2[2] -= (f32x2v){a1[0], a1[1]} * T0; r2[3] -= (f32x2v){a1[2], a1[3]} * T0;
        const f32x4 a6 = *(const LAS f32x4*)(Ab + 24);
        r2[4] -= (f32x2v){a2[0], a2[1]} * T0; r2[5] -= (f32x2v){a2[2], a2[3]} * T0;
        const f32x4 a7 = *(const LAS f32x4*)(Ab + 28);
        r2[6] -= (f32x2v){a3[0], a3[1]} * T0; r2[7] -= (f32x2v){a3[2], a3[3]} * T0;
        const f32x4 a8 = *(const LAS f32x4*)(Ab + 68);
        r2[8] -= (f32x2v){a4[0], a4[1]} * T0; r2[9] -= (f32x2v){a4[2], a4[3]} * T0;
        const f32x4 a9 = *(const LAS f32x4*)(Ab + 72);
        r2[10] -= (f32x2v){a5[0], a5[1]} * T0; r2[11] -= (f32x2v){a5[2], a5[3]} * T0;
        const f32x4 a10 = *(const LAS f32x4*)(Ab + 76);
        r2[12] -= (f32x2v){a6[0], a6[1]} * T0; r2[13] -= (f32x2v){a6[2], a6[3]} * T0;
        const f32x4 a11 = *(const LAS f32x4*)(Ab + 80);
        r2[14] -= (f32x2v){a7[0], a7[1]} * T0; r2[15] -= (f32x2v){a7[2], a7[3]} * T0;
        const f32x4 a12 = *(const LAS f32x4*)(Ab + 84);
        const float t1 = r2[0][1]; const f32x2v T1 = (f32x2v){t1, t1}; Tw[72] = f2bf(t1); Tt[1] = f2bf(t1);
        r2[1] -= (f32x2v){a8[2], a8[3]} * T1;
        const f32x4 a13 = *(const LAS f32x4*)(Ab + 88);
        r2[2] -= (f32x2v){a9[0], a9[1]} * T1; r2[3] -= (f32x2v){a9[2], a9[3]} * T1;
        const f32x4 a14 = *(const LAS f32x4*)(Ab + 92);
        r2[4] -= (f32x2v){a10[0], a10[1]} * T1; r2[5] -= (f32x2v){a10[2], a10[3]} * T1;
        const f32x4 a15 = *(const LAS f32x4*)(Ab + 96);
        r2[6] -= (f32x2v){a11[0], a11[1]} * T1; r2[7] -= (f32x2v){a11[2], a11[3]} * T1;
        const f32x4 a16 = *(const LAS f32x4*)(Ab + 136);
        r2[8] -= (f32x2v){a12[0], a12[1]} * T1; r2[9] -= (f32x2v){a12[2], a12[3]} * T1;
        const f32x4 a17 = *(const LAS f32x4*)(Ab + 140);
        r2[10] -= (f32x2v){a13[0], a13[1]} * T1; r2[11] -= (f32x2v){a13[2], a13[3]} * T1;
        const f32x4 a18 = *(const LAS f32x4*)(Ab + 144);
        r2[12] -= (f32x2v){a14[0], a14[1]} * T1; r2[13] -= (f32x2v){a14[2], a14[3]} * T1;
        const f32x4 a19 = *(const LAS f32x4*)(Ab + 148);
        r2[14] -= (f32x2v){a15[0], a15[1]} * T1; r2[15] -= (f32x2v){a15[2], a15[3]} * T1;
        const f32x4 a20 = *(const LAS f32x4*)(Ab + 152);
        const float t2 = r2[1][0]; const f32x2v T2 = (f32x2v){t2, t2}; Tw[144] = f2bf(t2); Tt[2] = f2bf(t2);
        r2[1] -= (f32x2v){a16[2], a16[3]} * T2;
        const f32x4 a21 = *(const LAS f32x4*)(Ab + 156);
        r2[2] -= (f32x2v){a17[0], a17[1]} * T2; r2[3] -= (f32x2v){a17[2], a17[3]} * T2;
        const f32x4 a22 = *(const LAS f32x4*)(Ab + 160);
        r2[4] -= (f32x2v){a18[0], a18[1]} * T2; r2[5] -= (f32x2v){a18[2], a18[3]} * T2;
        const f32x4 a23 = *(const LAS f32x4*)(Ab + 164);
        r2[6] -= (f32x2v){a19[0], a19[1]} * T2; r2[7] -= (f32x2v){a19[2], a19[3]} * T2;
        const f32x4 a24 = *(const LAS f32x4*)(Ab + 208);
        r2[8] -= (f32x2v){a20[0], a20[1]} * T2; r2[9] -= (f32x2v){a20[2], a20[3]} * T2;
        const f32x4 a25 = *(const LAS f32x4*)(Ab + 212);
        r2[10] -= (f32x2v){a21[0], a21[1]} * T2; r2[11] -= (f32x2v){a21[2], a21[3]} * T2;
        const f32x4 a26 = *(const LAS f32x4*)(Ab + 216);
        r2[12] -= (f32x2v){a22[0], a22[1]} * T2; r2[13] -= (f32x2v){a22[2], a22[3]} * T2;
        const f32x4 a27 = *(const LAS f32x4*)(Ab + 220);
        r2[14] -= (f32x2v){a23[0], a23[1]} * T2; r2[15] -= (f32x2v){a23[2], a23[3]} * T2;
        const f32x4 a28 = *(const LAS f32x4*)(Ab + 224);
        const float t3 = r2[1][1]; const f32x2v T3 = (f32x2v){t3, t3}; Tw[216] = f2bf(t3); Tt[3] = f2bf(t3);
        r2[2] -= (f32x2v){a24[0], a24[1]} * T3; r2[3] -= (f32x2v){a24[2], a24[3]} * T3;
        const f32x4 a29 = *(const LAS f32x4*)(Ab + 228);
        r2[4] -= (f32x2v){a25[0], a25[1]} * T3; r2[5] -= (f32x2v){a25[2], a25[3]} * T3;
        const f32x4 a30 = *(const LAS f32x4*)(Ab + 232);
        r2[6] -= (f32x2v){a26[0], a26[1]} * T3; r2[7] -= (f32x2v){a26[2], a26[3]} * T3;
        const f32x4 a31 = *(const LAS f32x4*)(Ab + 276);
        r2[8] -= (f32x2v){a27[0], a27[1]} * T3; r2[9] -= (f32x2v){a27[2], a27[3]} * T3;
        const f32x4 a32 = *(const LAS f32x4*)(Ab + 280);
        r2[10] -= (f32x2v){a28[0], a28[1]} * T3; r2[11] -= (f32x2v){a28[2], a28[3]} * T3;
        const f32x4 a33 = *(const LAS f32x4*)(Ab + 284);
        r2[12] -= (f32x2v){a29[0], a29[1]} * T3; r2[13] -= (f32x2v){a29[2], a29[3]} * T3;
        const f32x4 a34 = *(const LAS f32x4*)(Ab + 288);
        r2[14] -= (f32x2v){a30[0], a30[1]} * T3; r2[15] -= (f32x2v){a30[2], a30[3]} * T3;
        const f32x4 a35 = *(const LAS f32x4*)(Ab + 292);
        const float t4 = r2[2][0]; const f32x2v T4 = (f32x2v){t4, t4}; Tw[288] = f2bf(t4); Tt[4] = f2bf(t4);
        r2[2] -= (f32x2v){a31[0], a31[1]} * T4; r2[3] -= (f32x2v){a31[2], a31[3]} * T4;
        const f32x4 a36 = *(const LAS f32x4*)(Ab + 296);
        r2[4] -= (f32x2v){a32[0], a32[1]} * T4; r2[5] -= (f32x2v){a32[2], a32[3]} * T4;
        const f32x4 a37 = *(const LAS f32x4*)(Ab + 300);
        r2[6] -= (f32x2v){a33[0], a33[1]} * T4; r2[7] -= (f32x2v){a33[2], a33[3]} * T4;
        const f32x4 a38 = *(const LAS f32x4*)(Ab + 344);
        r2[8] -= (f32x2v){a34[0], a34[1]} * T4; r2[9] -= (f32x2v){a34[2], a34[3]} * T4;
        const f32x4 a39 = *(const LAS f32x4*)(Ab + 348);
        r2[10] -= (f32x2v){a35[0], a35[1]} * T4; r2[11] -= (f32x2v){a35[2], a35[3]} * T4;
        const f32x4 a40 = *(const LAS f32x4*)(Ab + 352);
        r2[12] -= (f32x2v){a36[0], a36[1]} * T4; r2[13] -= (f32x2v){a36[2], a36[3]} * T4;
        const f32x4 a41 = *(const LAS f32x4*)(Ab + 356);
        r2[14] -= (f32x2v){a37[0], a37[1]} * T4; r2[15] -= (f32x2v){a37[2], a37[3]} * T4;
        const f32x4 a42 = *(const LAS f32x4*)(Ab + 360);
        const float t5 = r2[2][1]; const f32x2v T5 = (f32x2v){t5, t5}; Tw[360] = f2bf(t5); Tt[5] = f2bf(t5);
        r2[3] -= (f32x2v){a38[2], a38[3]} * T5;
        const f32x4 a43 = *(const LAS f32x4*)(Ab + 364);
        r2[4] -= (f32x2v){a39[0], a39[1]} * T5; r2[5] -= (f32x2v){a39[2], a39[3]} * T5;
        const f32x4 a44 = *(const LAS f32x4*)(Ab + 368);
        r2[6] -= (f32x2v){a40[0], a40[1]} * T5; r2[7] -= (f32x2v){a40[2], a40[3]} * T5;
        const f32x4 a45 = *(const LAS f32x4*)(Ab + 412);
        r2[8] -= (f32x2v){a41[0], a41[1]} * T5; r2[9] -= (f32x2v){a41[2], a41[3]} * T5;
        const f32x4 a46 = *(const LAS f32x4*)(Ab + 416);
        r2[10] -= (f32x2v){a42[0], a42[1]} * T5; r2[11] -= (f32x2v){a42[2], a42[3]} * T5;
        const f32x4 a47 = *(const LAS f32x4*)(Ab + 420);
        r2[12] -= (f32x2v){a43[0], a43[1]} * T5; r2[13] -= (f32x2v){a43[2], a43[3]} * T5;
        const f32x4 a48 = *(const LAS f32x4*)(Ab + 424);
        r2[14] -= (f32x2v){a44[0], a44[1]} * T5; r2[15] -= (f32x2v){a44[2], a44[3]} * T5;
        const f32x4 a49 = *(const LAS f32x4*)(Ab + 428);
        const float t6 = r2[3][0]; const f32x2v T6 = (f32x2v){t6, t6}; Tw[432] = f2bf(t6); Tt[6] = f2bf(t6);
        r2[3] -= (f32x2v){a45[2], a45[3]} * T6;
        const f32x4 a50 = *(const LAS f32x4*)(Ab + 432);
        r2[4] -= (f32x2v){a46[0], a46[1]} * T6; r2[5] -= (f32x2v){a46[2], a46[3]} * T6;
        const f32x4 a51 = *(const LAS f32x4*)(Ab + 436);
        r2[6] -= (f32x2v){a47[0], a47[1]} * T6; r2[7] -= (f32x2v){a47[2], a47[3]} * T6;
        const f32x4 a52 = *(const LAS f32x4*)(Ab + 484);
        r2[8] -= (f32x2v){a48[0], a48[1]} * T6; r2[9] -= (f32x2v){a48[2], a48[3]} * T6;
        const f32x4 a53 = *(const LAS f32x4*)(Ab + 488);
        r2[10] -= (f32x2v){a49[0], a49[1]} * T6; r2[11] -= (f32x2v){a49[2], a49[3]} * T6;
        const f32x4 a54 = *(const LAS f32x4*)(Ab + 492);
        r2[12] -= (f32x2v){a50[0], a50[1]} * T6; r2[13] -= (f32x2v){a50[2], a50[3]} * T6;
        const f32x4 a55 = *(const LAS f32x4*)(Ab + 496);
        r2[14] -= (f32x2v){a51[0], a51[1]} * T6; r2[15] -= (f32x2v){a51[2], a51[3]} * T6;
        const f32x4 a56 = *(const LAS f32x4*)(Ab + 500);
        const float t7 = r2[3][1]; const f32x2v T7 = (f32x2v){t7, t7}; Tw[504] = f2bf(t7); Tt[7] = f2bf(t7);
        r2[4] -= (f32x2v){a52[0], a52[1]} * T7; r2[5] -= (f32x2v){a52[2], a52[3]} * T7;
        const f32x4 a57 = *(const LAS f32x4*)(Ab + 504);
        r2[6] -= (f32x2v){a53[0], a53[1]} * T7; r2[7] -= (f32x2v){a53[2], a53[3]} * T7;
        const f32x4 a58 = *(const LAS f32x4*)(Ab + 552);
        r2[8] -= (f32x2v){a54[0], a54[1]} * T7; r2[9] -= (f32x2v){a54[2], a54[3]} * T7;
        const f32x4 a59 = *(const LAS f32x4*)(Ab + 556);
        r2[10] -= (f32x2v){a55[0], a55[1]} * T7; r2[11] -= (f32x2v){a55[2], a55[3]} * T7;
        const f32x4 a60 = *(const LAS f32x4*)(Ab + 560);
        r2[12] -= (f32x2v){a56[0], a56[1]} * T7; r2[13] -= (f32x2v){a56[2], a56[3]} * T7;
        const f32x4 a61 = *(const LAS f32x4*)(Ab + 564);
        r2[14] -= (f32x2v){a57[0], a57[1]} * T7; r2[15] -= (f32x2v){a57[2], a57[3]} * T7;
        const f32x4 a62 = *(const LAS f32x4*)(Ab + 568);
        const float t8 = r2[4][0]; const f32x2v T8 = (f32x2v){t8, t8}; Tw[576] = f2bf(t8); Tt[8] = f2bf(t8);
        r2[4] -= (f32x2v){a58[0], a58[1]} * T8; r2[5] -= (f32x2v){a58[2], a58[3]} * T8;
        const f32x4 a63 = *(const LAS f32x4*)(Ab + 572);
        r2[6] -= (f32x2v){a59[0], a59[1]} * T8; r2[7] -= (f32x2v){a59[2], a59[3]} * T8;
        const f32x4 a64 = *(const LAS f32x4*)(Ab + 620);
        r2[8] -= (f32x2v){a60[0], a60[1]} * T8; r2[9] -= (f32x2v){a60[2], a60[3]} * T8;
        const f32x4 a65 = *(const LAS f32x4*)(Ab + 624);
        r2[10] -= (f32x2v){a61[0], a61[1]} * T8; r2[11] -= (f32x2v){a61[2], a61[3]} * T8;
        const f32x4 a66 = *(const LAS f32x4*)(Ab + 628);
        r2[12] -= (f32x2v){a62[0], a62[1]} * T8; r2[13] -= (f32x2v){a62[2], a62[3]} * T8;
        const f32x4 a67 = *(const LAS f32x4*)(Ab + 632);
        r2[14] -= (f32x2v){a63[0], a63[1]} * T8; r2[15] -= (f32x2v){a63[2], a63[3]} * T8;
        const f32x4 a68 = *(const LAS f32x4*)(Ab + 636);
        const float t9 = r2[4][1]; const f32x2v T9 = (f32x2v){t9, t9}; Tw[648] = f2bf(t9); Tt[9] = f2bf(t9);
        r2[5] -= (f32x2v){a64[2], a64[3]} * T9;
        const f32x4 a69 = *(const LAS f32x4*)(Ab + 640);
        r2[6] -= (f32x2v){a65[0], a65[1]} * T9; r2[7] -= (f32x2v){a65[2], a65[3]} * T9;
        const f32x4 a70 = *(const LAS f32x4*)(Ab + 688);
        r2[8] -= (f32x2v){a66[0], a66[1]} * T9; r2[9] -= (f32x2v){a66[2], a66[3]} * T9;
        const f32x4 a71 = *(const LAS f32x4*)(Ab + 692);
        r2[10] -= (f32x2v){a67[0], a67[1]} * T9; r2[11] -= (f32x2v){a67[2], a67[3]} * T9;
        const f32x4 a72 = *(const LAS f32x4*)(Ab + 696);
        r2[12] -= (f32x2v){a68[0], a68[1]} * T9; r2[13] -= (f32x2v){a68[2], a68[3]} * T9;
        const f32x4 a73 = *(const LAS f32x4*)(Ab + 700);
        r2[14] -= (f32x2v){a69[0], a69[1]} * T9; r2[15] -= (f32x2v){a69[2], a69[3]} * T9;
        const f32x4 a74 = *(const LAS f32x4*)(Ab + 704);
        const float t10 = r2[5][0]; const f32x2v T10 = (f32x2v){t10, t10}; Tw[720] = f2bf(t10); Tt[10] = f2bf(t10);
        r2[5] -= (f32x2v){a70[2], a70[3]} * T10;
        const f32x4 a75 = *(const LAS f32x4*)(Ab + 708);
        r2[6] -= (f32x2v){a71[0], a71[1]} * T10; r2[7] -= (f32x2v){a71[2], a71[3]} * T10;
        const f32x4 a76 = *(const LAS f32x4*)(Ab + 760);
        r2[8] -= (f32x2v){a72[0], a72[1]} * T10; r2[9] -= (f32x2v){a72[2], a72[3]} * T10;
        const f32x4 a77 = *(const LAS f32x4*)(Ab + 764);
        r2[10] -= (f32x2v){a73[0], a73[1]} * T10; r2[11] -= (f32x2v){a73[2], a73[3]} * T10;
        const f32x4 a78 = *(const LAS f32x4*)(Ab + 768);
        r2[12] -= (f32x2v){a74[0], a74[1]} * T10; r2[13] -= (f32x2v){a74[2], a74[3]} * T10;
        const f32x4 a79 = *(const LAS f32x4*)(Ab + 772);
        r2[14] -= (f32x2v){a75[0], a75[1]} * T10; r2[15] -= (f32x2v){a75[2], a75[3]} * T10;
        const f32x4 a80 = *(const LAS f32x4*)(Ab + 776);
        const float t11 = r2[5][1]; const f32x2v T11 = (f32x2v){t11, t11}; Tw[792] = f2bf(t11); Tt[11] = f2bf(t11);
        r2[6] -= (f32x2v){a76[0], a76[1]} * T11; r2[7] -= (f32x2v){a76[2], a76[3]} * T11;
        const f32x4 a81 = *(const LAS f32x4*)(Ab + 828);
        r2[8] -= (f32x2v){a77[0], a77[1]} * T11; r2[9] -= (f32x2v){a77[2], a77[3]} * T11;
        const f32x4 a82 = *(const LAS f32x4*)(Ab + 832);
        r2[10] -= (f32x2v){a78[0], a78[1]} * T11; r2[11] -= (f32x2v){a78[2], a78[3]} * T11;
        const f32x4 a83 = *(const LAS f32x4*)(Ab + 836);
        r2[12] -= (f32x2v){a79[0], a79[1]} * T11; r2[13] -= (f32x2v){a79[2], a79[3]} * T11;
        const f32x4 a84 = *(const LAS f32x4*)(Ab + 840);
        r2[14] -= (f32x2v){a80[0], a80[1]} * T11; r2[15] -= (f32x2v){a80[2], a80[3]} * T11;
        const f32x4 a85 = *(const LAS f32x4*)(Ab + 844);
        const float t12 = r2[6][0]; const f32x2v T12 = (f32x2v){t12, t12}; Tw[864] = f2bf(t12); Tt[12] = f2bf(t12);
        r2[6] -= (f32x2v){a81[0], a81[1]} * T12; r2[7] -= (f32x2v){a81[2], a81[3]} * T12;
        const f32x4 a86 = *(const LAS f32x4*)(Ab + 896);
        r2[8] -= (f32x2v){a82[0], a82[1]} * T12; r2[9] -= (f32x2v){a82[2], a82[3]} * T12;
        const f32x4 a87 = *(const LAS f32x4*)(Ab + 900);
        r2[10] -= (f32x2v){a83[0], a83[1]} * T12; r2[11] -= (f32x2v){a83[2], a83[3]} * T12;
        const f32x4 a88 = *(const LAS f32x4*)(Ab + 904);
        r2[12] -= (f32x2v){a84[0], a84[1]} * T12; r2[13] -= (f32x2v){a84[2], a84[3]} * T12;
        const f32x4 a89 = *(const LAS f32x4*)(Ab + 908);
        r2[14] -= (f32x2v){a85[0], a85[1]} * T12; r2[15] -= (f32x2v){a85[2], a85[3]} * T12;
        const f32x4 a90 = *(const LAS f32x4*)(Ab + 912);
        const float t13 = r2[6][1]; const f32x2v T13 = (f32x2v){t13, t13}; Tw[936] = f2bf(t13); Tt[13] = f2bf(t13);
        r2[7] -= (f32x2v){a86[2], a86[3]} * T13;
        const f32x4 a91 = *(const LAS f32x4*)(Ab + 964);
        r2[8] -= (f32x2v){a87[0], a87[1]} * T13; r2[9] -= (f32x2v){a87[2], a87[3]} * T13;
        const f32x4 a92 = *(const LAS f32x4*)(Ab + 968);
        r2[10] -= (f32x2v){a88[0], a88[1]} * T13; r2[11] -= (f32x2v){a88[2], a88[3]} * T13;
        const f32x4 a93 = *(const LAS f32x4*)(Ab + 972);
        r2[12] -= (f32x2v){a89[0], a89[1]} * T13; r2[13] -= (f32x2v){a89[2], a89[3]} * T13;
        const f32x4 a94 = *(const LAS f32x4*)(Ab + 976);
        r2[14] -= (f32x2v){a90[0], a90[1]} * T13; r2[15] -= (f32x2v){a90[2], a90[3]} * T13;
        const f32x4 a95 = *(const LAS f32x4*)(Ab + 980);
        const float t14 = r2[7][0]; const f32x2v T14 = (f32x2v){t14, t14}; Tw[1008] = f2bf(t14); Tt[14] = f2bf(t14);
        r2[7] -= (f32x2v){a91[2], a91[3]} * T14;
        const f32x4 a96 = *(const LAS f32x4*)(Ab + 1036);
        r2[8] -= (f32x2v){a92[0], a92[1]} * T14; r2[9] -= (f32x2v){a92[2], a92[3]} * T14;
        const f32x4 a97 = *(const LAS f32x4*)(Ab + 1040);
        r2[10] -= (f32x2v){a93[0], a93[1]} * T14; r2[11] -= (f32x2v){a93[2], a93[3]} * T14;
        const f32x4 a98 = *(const LAS f32x4*)(Ab + 1044);
        r2[12] -= (f32x2v){a94[0], a94[1]} * T14; r2[13] -= (f32x2v){a94[2], a94[3]} * T14;
        const f32x4 a99 = *(const LAS f32x4*)(Ab + 1048);
        r2[14] -= (f32x2v){a95[0], a95[1]} * T14; r2[15] -= (f32x2v){a95[2], a95[3]} * T14;
        const f32x4 a100 = *(const LAS f32x4*)(Ab + 1104);
        const float t15 = r2[7][1]; const f32x2v T15 = (f32x2v){t15, t15}; Tw[1080] = f2bf(t15); Tt[15] = f2bf(t15);
        r2[8] -= (f32x2v){a96[0], a96[1]} * T15; r2[9] -= (f32x2v){a96[2], a96[3]} * T15;
        const f32x4 a101 = *(const LAS f32x4*)(Ab + 1108);
        r2[10] -= (f32x2v){a97[0], a97[1]} * T15; r2[11] -= (f32x2v){a97[2], a97[3]} * T15;
        const f32x4 a102 = *(const LAS f32x4*)(Ab + 1112);
        r2[12] -= (f32x2v){a98[0], a98[1]} * T15; r2[13] -= (f32x2v){a98[2], a98[3]} * T15;
        const f32x4 a103 = *(const LAS f32x4*)(Ab + 1116);
        r2[14] -= (f32x2v){a99[0], a99[1]} * T15; r2[15] -= (f32x2v){a99[2], a99[3]} * T15;
        const f32x4 a104 = *(const LAS f32x4*)(Ab + 1172);
        const float t16 = r2[8][0]; const f32x2v T16 = (f32x2v){t16, t16}; Tw[1152] = f2bf(t16); Tt[16] = f2bf(t16);
        r2[8] -= (f32x2v){a100[0], a100[1]} * T16; r2[9] -= (f32x2v){a100[2], a100[3]} * T16;
        const f32x4 a105 = *(const LAS f32x4*)(Ab + 1176);
        r2[10] -= (f32x2v){a101[0], a101[1]} * T16; r2[11] -= (f32x2v){a101[2], a101[3]} * T16;
        const f32x4 a106 = *(const LAS f32x4*)(Ab + 1180);
        r2[12] -= (f32x2v){a102[0], a102[1]} * T16; r2[13] -= (f32x2v){a102[2], a102[3]} * T16;
        const f32x4 a107 = *(const LAS f32x4*)(Ab + 1184);
        r2[14] -= (f32x2v){a103[0], a103[1]} * T16; r2[15] -= (f32x2v){a103[2], a103[3]} * T16;
        const f32x4 a108 = *(const LAS f32x4*)(Ab + 1240);
        const float t17 = r2[8][1]; const f32x2v T17 = (f32x2v){t17, t17}; Tw[1224] = f2bf(t17); Tt[17] = f2bf(t17);
        r2[9] -= (f32x2v){a104[2], a104[3]} * T17;
        const f32x4 a109 = *(const LAS f32x4*)(Ab + 1244);
        r2[10] -= (f32x2v){a105[0], a105[1]} * T17; r2[11] -= (f32x2v){a105[2], a105[3]} * T17;
        const f32x4 a110 = *(const LAS f32x4*)(Ab + 1248);
        r2[12] -= (f32x2v){a106[0], a106[1]} * T17; r2[13] -= (f32x2v){a106[2], a106[3]} * T17;
        const f32x4 a111 = *(const LAS f32x4*)(Ab + 1252);
        r2[14] -= (f32x2v){a107[0], a107[1]} * T17; r2[15] -= (f32x2v){a107[2], a107[3]} * T17;
        const f32x4 a112 = *(const LAS f32x4*)(Ab + 1312);
        const float t18 = r2[9][0]; const f32x2v T18 = (f32x2v){t18, t18}; Tw[1296] = f2bf(t18); Tt[18] = f2bf(t18);
        r2[9] -= (f32x2v){a108[2], a108[3]} * T18;
        const f32x4 a113 = *(const LAS f32x4*)(Ab + 1316);
        r2[10] -= (f32x2v){a109[0], a109[1]} * T18; r2[11] -= (f32x2v){a109[2], a109[3]} * T18;
        const f32x4 a114 = *(const LAS f32x4*)(Ab + 1320);
        r2[12] -= (f32x2v){a110[0], a110[1]} * T18; r2[13] -= (f32x2v){a110[2], a110[3]} * T18;
        const f32x4 a115 = *(const LAS f32x4*)(Ab + 1380);
        r2[14] -= (f32x2v){a111[0], a111[1]} * T18; r2[15] -= (f32x2v){a111[2], a111[3]} * T18;
        const f32x4 a116 = *(const LAS f32x4*)(Ab + 1384);
        const float t19 = r2[9][1]; const f32x2v T19 = (f32x2v){t19, t19}; Tw[1368] = f2bf(t19); Tt[19] = f2bf(t19);
        r2[10] -= (f32x2v){a112[0], a112[1]} * T19; r2[11] -= (f32x2v){a112[2], a112[3]} * T19;
        const f32x4 a117 = *(const LAS f32x4*)(Ab + 1388);
        r2[12] -= (f32x2v){a113[0], a113[1]} * T19; r2[13] -= (f32x2v){a113[2], a113[3]} * T19;
        const f32x4 a118 = *(const LAS f32x4*)(Ab + 1448);
        r2[14] -= (f32x2v){a114[0], a114[1]} * T19; r2[15] -= (f32x2v){a114[2], a114[3]} * T19;
        const f32x4 a119 = *(const LAS f32x4*)(Ab + 1452);
        const float t20 = r2[10][0]; const f32x2v T20 = (f32x2v){t20, t20}; Tw[1440] = f2bf(t20); Tt[20] = f2bf(t20);
        r2[10] -= (f32x2v){a115[0], a115[1]} * T20; r2[11] -= (f32x2v){a115[2], a115[3]} * T20;
        const f32x4 a120 = *(const LAS f32x4*)(Ab + 1456);
        r2[12] -= (f32x2v){a116[0], a116[1]} * T20; r2[13] -= (f32x2v){a116[2], a116[3]} * T20;
        const f32x4 a121 = *(const LAS f32x4*)(Ab + 1516);
        r2[14] -= (f32x2v){a117[0], a117[1]} * T20; r2[15] -= (f32x2v){a117[2], a117[3]} * T20;
        const f32x4 a122 = *(const LAS f32x4*)(Ab + 1520);
        const float t21 = r2[10][1]; const f32x2v T21 = (f32x2v){t21, t21}; Tw[1512] = f2bf(t21); Tt[21] = f2bf(t21);
        r2[11] -= (f32x2v){a118[2], a118[3]} * T21;
        const f32x4 a123 = *(const LAS f32x4*)(Ab + 1524);
        r2[12] -= (f32x2v){a119[0], a119[1]} * T21; r2[13] -= (f32x2v){a119[2], a119[3]} * T21;
        const f32x4 a124 = *(const LAS f32x4*)(Ab + 1588);
        r2[14] -= (f32x2v){a120[0], a120[1]} * T21; r2[15] -= (f32x2v){a120[2], a120[3]} * T21;
        const f32x4 a125 = *(const LAS f32x4*)(Ab + 1592);
        const float t22 = r2[11][0]; const f32x2v T22 = (f32x2v){t22, t22}; Tw[1584] = f2bf(t22); Tt[22] = f2bf(t22);
        r2[11] -= (f32x2v){a121[2], a121[3]} * T22;
        const f32x4 a126 = *(const LAS f32x4*)(Ab + 1656);
        r2[12] -= (f32x2v){a122[0], a122[1]} * T22; r2[13] -= (f32x2v){a122[2], a122[3]} * T22;
        const f32x4 a127 = *(const LAS f32x4*)(Ab + 1660);
        r2[14] -= (f32x2v){a123[0], a123[1]} * T22; r2[15] -= (f32x2v){a123[2], a123[3]} * T22;
        const f32x4 a128 = *(const LAS f32x4*)(Ab + 1724);
        const float t23 = r2[11][1]; const f32x2v T23 = (f32x2v){t23, t23}; Tw[1656] = f2bf(t23); Tt[23] = f2bf(t23);
        r2[12] -= (f32x2v){a124[0], a124[1]} * T23; r2[13] -= (f32x2v){a124[2], a124[3]} * T23;
        const f32x4 a129 = *(const LAS f32x4*)(Ab + 1728);
        r2[14] -= (f32x2v){a125[0], a125[1]} * T23; r2[15] -= (f32x2v){a125[2], a125[3]} * T23;
        const f32x4 a130 = *(const LAS f32x4*)(Ab + 1792);
        const float t24 = r2[12][0]; const f32x2v T24 = (f32x2v){t24, t24}; Tw[1728] = f2bf(t24); Tt[24] = f2bf(t24);
        r2[12] -= (f32x2v){a126[0], a126[1]} * T24; r2[13] -= (f32x2v){a126[2], a126[3]} * T24;
        const f32x4 a131 = *(const LAS f32x4*)(Ab + 1796);
        r2[14] -= (f32x2v){a127[0], a127[1]} * T24; r2[15] -= (f32x2v){a127[2], a127[3]} * T24;
        const f32x4 a132 = *(const LAS f32x4*)(Ab + 1864);
        const float t25 = r2[12][1]; const f32x2v T25 = (f32x2v){t25, t25}; Tw[1800] = f2bf(t25); Tt[25] = f2bf(t25);
        r2[13] -= (f32x2v){a128[2], a128[3]} * T25;
        const f32x4 a133 = *(const LAS f32x4*)(Ab + 1932);
        r2[14] -= (f32x2v){a129[0], a129[1]} * T25; r2[15] -= (f32x2v){a129[2], a129[3]} * T25;
        const f32x4 a134 = *(const LAS f32x4*)(Ab + 2000);
        const float t26 = r2[13][0]; const f32x2v T26 = (f32x2v){t26, t26}; Tw[1872] = f2bf(t26); Tt[26] = f2bf(t26);
        r2[13] -= (f32x2v){a130[2], a130[3]} * T26;
        const f32x4 a135 = *(const LAS f32x4*)(Ab + 2068);
        r2[14] -= (f32x2v){a131[0], a131[1]} * T26; r2[15] -= (f32x2v){a131[2], a131[3]} * T26;
        const float t27 = r2[13][1]; const f32x2v T27 = (f32x2v){t27, t27}; Tw[1944] = f2bf(t27); Tt[27] = f2bf(t27);
        r2[14] -= (f32x2v){a132[0], a132[1]} * T27; r2[15] -= (f32x2v){a132[2], a132[3]} * T27;
        const float t28 = r2[14][0]; const f32x2v T28 = (f32x2v){t28, t28}; Tw[2016] = f2bf(t28); Tt[28] = f2bf(t28);
        r2[14] -= (f32x2v){a133[0], a133[1]} * T28; r2[15] -= (f32x2v){a133[2], a133[3]} * T28;
        const float t29 = r2[14][1]; const f32x2v T29 = (f32x2v){t29, t29}; Tw[2088] = f2bf(t29); Tt[29] = f2bf(t29);
        r2[15] -= (f32x2v){a134[2], a134[3]} * T29;
        const float t30 = r2[15][0]; const f32x2v T30 = (f32x2v){t30, t30}; Tw[2160] = f2bf(t30); Tt[30] = f2bf(t30);
        r2[15] -= (f32x2v){a135[2], a135[3]} * T30;
        Tw[2232] = f2bf(r2[15][1]); Tt[31] = f2bf(r2[15][1]);
    } else if (wid == 2) {
        *(LAS u32x4*)(Tb + (lane >> 1) * 72 + 32 + (lane & 1) * 16) = (u32x4){0u, 0u, 0u, 0u}; *(LAS u32x4*)(Tb + (lane >> 1) * 72 + 32 + (lane & 1) * 16 + 8) = (u32x4){0u, 0u, 0u, 0u};
    }
    __syncthreads();
    if (wid < 4) {
        const int mt = wid >> 1, nt = wid & 1; const f32x4 acc = tile_mm(A10b, 40, mt, TT, 40, nt, 1, fr, fq);
        u32x2 w; w.x = cvt_pk(acc[0], acc[1]); w.y = cvt_pk(acc[2], acc[3]); *(LAS u32x2*)(PT + (16 * nt + fr) * 40 + 16 * mt + 4 * fq) = w;
    }
    __syncthreads();
    if (wid < 4) {
        const int mt = wid >> 1, nt = wid & 1; const f32x4 acc = tile_mm(Tb + 32 * 72 + 32, 72, mt, PT, 40, nt, 1, fr, fq);
#pragma unroll
        for (int e = 0; e < 4; ++e) Tb[(32 + 16 * mt + 4 * fq + e) * 72 + 16 * nt + fr] = f2bf(-acc[e]);
    }
    __syncthreads();
#pragma unroll 2
    for (int r = 0; r < 8; ++r) {
        const int job = wid + 8 * r, kind = job >> 5, tile = job & 31, mt = tile >> 3, nt = tile & 7;
        const f32x4 acc = tile_mm<false, true>(Tb, 72, mt, kind ? KbT : VbT, 72, nt, 2, fr, fq);
        u32x2 w; w.x = cvt_pk(acc[0], acc[1]); w.y = cvt_pk(acc[2], acc[3]);
        { const int ch = 16 * nt + fr; *(LAS u32x2*)((kind ? WT : UT) + ch * 72 + 8 * ((2 * mt + (fq >> 1)) ^ ((ch >> 3) & 7)) + 4 * (fq & 1)) = w; }
    }
    __syncthreads();
    bf16_t* GM = (bf16_t*)(p.ws + WS_GM) + (size_t)unit * 16384; bf16_t* GN = (bf16_t*)(p.ws + WS_GN) + (size_t)unit * 16384;
    bf16_t* GQ = (bf16_t*)(p.ws + WS_GQ) + (size_t)unit * 8192; bf16_t* GO = (bf16_t*)(p.ws + WS_GO) + (size_t)unit * 8192;
#pragma unroll 2
    for (int r = 0; r < 24; ++r) {
        const int job = wid + 8 * r;
        if (job < 64) { const int a = job >> 3, mt = job & 7;
            const f32x4 acc = tile_mm<true, true>(WT, 72, a, KdT, 72, mt, 2, fr, fq);
            u32x2 w; w.x = cvt_pk(-acc[0], -acc[1]); w.y = cvt_pk(-acc[2], -acc[3]);
            *(u32x2*)(GM + ((mt * 4 + (a >> 1)) * 64 + lane) * 8 + (a & 1) * 4) = w;
        } else if (job < 128) { const int j = job - 64, mt = j >> 3, nt = j & 7;
            const f32x4 acc = tile_mm<true, true>(KdT, 72, mt, UT, 72, nt, 2, fr, fq);
            u32x2 w; w.x = cvt_pk(acc[0], acc[1]); w.y = cvt_pk(acc[2], acc[3]);
            *(u32x2*)(GN + ((nt * 64 + lane) * 8 + mt) * 4) = w;
        } else if (job < 160) { const int j = job - 128, a = j >> 2, it = j & 3;
            const f32x4 acc = tile_mm<true, false>(WT, 72, a, QK, 72, it, 2, fr, fq);
            const int i = 16 * it + fr; const float eg = __expf(gcs[i]);
            const u32x2 qv = *(const LAS u32x2*)(Qs + i * 136 + 16 * a + 4 * fq);
            u32x2 w; w.x = cvt_pk(bflo(qv.x) * eg - acc[0], bfhi(qv.x) * eg - acc[1]); w.y = cvt_pk(bflo(qv.y) * eg - acc[2], bfhi(qv.y) * eg - acc[3]);
            *(u32x2*)(GQ + ((it * 4 + (a >> 1)) * 64 + lane) * 8 + (a & 1) * 4) = w;
        } else { const int j = job - 160, mt = j >> 3, nt = j & 7;
            const f32x4 acc = tile_mm<false, true>(QK, 72, mt, UT, 72, nt, 2, fr, fq);
            u32x2 w; w.x = cvt_pk(acc[0], acc[1]); w.y = cvt_pk(acc[2], acc[3]);
            *(u32x2*)(GO + ((nt * 64 + lane) * 4 + mt) * 4) = w;
        }
    }
    if (tid == 0) ((float*)(p.ws + WS_CTL + CTL_GLAST))[unit] = __expf(gclast);
    __syncthreads();
}

__device__ __forceinline__ void gdn_scan(const Params& p, LAS unsigned char* lds, int sb) {
    const int tid = threadIdx.x, lane = tid & 63, wid = tid >> 6, fr = lane & 15, fq = lane >> 4;
    const int bh = sb / (8 / CW), sp = sb % (8 / CW), unit0 = bh * 128, sl = sp * CW + wid;
    const u32x4* GMb = (const u32x4*)((const bf16_t*)(p.ws + WS_GM) + (size_t)unit0 * 16384);
    const u32x4* GQb = (const u32x4*)((const bf16_t*)(p.ws + WS_GQ) + (size_t)unit0 * 8192);
    const bf16_t* GNb = (const bf16_t*)(p.ws + WS_GN) + (size_t)unit0 * 16384;
    bf16_t* GOb = (bf16_t*)(p.ws + WS_GO) + (size_t)unit0 * 8192;
    const float* glast = (const float*)(p.ws + WS_CTL + CTL_GLAST) + unit0;
    const bool loader = (wid >= CW && wid < CW + 4);
#define SCAN_DMA(cc) do { _Pragma("unroll") for (int k = 0; k < 8; ++k) { const int inst = (wid - CW) * 8 + k; \
        __builtin_amdgcn_global_load_lds((const unsigned*)((const char*)(GMb + (size_t)(cc) * 2048) + inst * 1024 + lane * 16), (LAS unsigned*)(lds + ((cc) & 3) * 32768 + inst * 1024), 16, 0, 0); } } while (0)
#define SCAN_LOADN(dn, cc) do { const bf16_t* np_ = GNb + (size_t)((cc) < 128 ? (cc) : 127) * 16384 + (size_t)(sl * 64 + lane) * 32; \
        asm volatile("global_load_dwordx4 %0, %4, off\n\tglobal_load_dwordx4 %1, %4, off offset:16\n\tglobal_load_dwordx4 %2, %4, off offset:32\n\tglobal_load_dwordx4 %3, %4, off offset:48" \
            : "=&v"(dn[0]), "=&v"(dn[1]), "=&v"(dn[2]), "=&v"(dn[3]) : "v"(np_) : "memory"); } while (0)
#define SCAN_WAITN(dn, N) asm volatile("s_waitcnt vmcnt(" #N ")" : "+v"(dn[0]), "+v"(dn[1]), "+v"(dn[2]), "+v"(dn[3]) :: "memory")
#define SCAN_STEP(c, nn, RELOAD) do { \
        SCAN_WAITN(nn, 8); \
        const float gl = __shfl(((c) < 64) ? glr0 : glr1, (c) & 63); bf16x8 Sb[4]; \
        bf16_t* scp = (bf16_t*)GNb + (size_t)(c) * 16384 + (size_t)sl * 2048 + lane * 8; \
        _Pragma("unroll") for (int ks = 0; ks < 4; ++ks) { u32x4 w; w.x = cvt_pk(S[2 * ks][0], S[2 * ks][1]); w.y = cvt_pk(S[2 * ks][2], S[2 * ks][3]); \
            w.z = cvt_pk(S[2 * ks + 1][0], S[2 * ks + 1][1]); w.w = cvt_pk(S[2 * ks + 1][2], S[2 * ks + 1][3]); Sb[ks] = __builtin_bit_cast(bf16x8, w); } \
        const LAS unsigned char* slot = lds + ((c) & 3) * 32768 + lane * 16; \
        bf16x8 fa[2][2][4]; \
        _Pragma("unroll") for (int ks = 0; ks < 4; ++ks) { fa[0][0][ks] = *(const LAS bf16x8*)(slot + (0 * 4 + ks) * 1024); fa[0][1][ks] = *(const LAS bf16x8*)(slot + (1 * 4 + ks) * 1024); } \
        _Pragma("unroll") for (int mt = 0; mt < 8; ++mt) { const unsigned w0 = nn[mt >> 1][(mt & 1) * 2], w1 = nn[mt >> 1][(mt & 1) * 2 + 1]; \
            S[mt] = S[mt] * gl + (f32x4){bflo(w0), bfhi(w0), bflo(w1), bfhi(w1)}; } \
        _Pragma("unroll") for (int ks = 0; ks < 4; ++ks) *(u32x4*)(scp + ks * 512) = __builtin_bit_cast(u32x4, Sb[ks]);     \
        RELOAD; \
        _Pragma("unroll") for (int pr = 0; pr < 4; ++pr) { \
            if (pr < 3) { _Pragma("unroll") for (int ks = 0; ks < 4; ++ks) { fa[(pr + 1) & 1][0][ks] = *(const LAS bf16x8*)(slot + ((2 * pr + 2) * 4 + ks) * 1024); fa[(pr + 1) & 1][1][ks] = *(const LAS bf16x8*)(slot + ((2 * pr + 3) * 4 + ks) * 1024); } } \
            _Pragma("unroll") for (int ks = 0; ks < 4; ++ks) { S[2 * pr] = mfma16(fa[pr & 1][0][ks], Sb[ks], S[2 * pr]); S[2 * pr + 1] = mfma16(fa[pr & 1][1][ks], Sb[ks], S[2 * pr + 1]); } } \
        } while (0)
    if (loader) { SCAN_DMA(0); SCAN_DMA(1); SCAN_DMA(2); asm volatile("s_waitcnt vmcnt(0)" ::: "memory"); }
    f32x4 S[8];
#pragma unroll
    for (int mt = 0; mt < 8; ++mt) S[mt] = (f32x4){0.f, 0.f, 0.f, 0.f};
    float glr0 = glast[lane], glr1 = glast[64 + lane];
    asm volatile("" : "+v"(glr0), "+v"(glr1));
    u32x4 nnA[4], nnB[4];
    if (wid < CW) { SCAN_LOADN(nnA, 0); SCAN_LOADN(nnB, 1); SCAN_WAITN(nnA, 0); SCAN_WAITN(nnB, 0); }
    asm volatile("s_waitcnt lgkmcnt(0)" ::: "memory"); __builtin_amdgcn_s_barrier(); asm volatile("" ::: "memory");
#pragma unroll 1
    for (int c = 0; c < 128; c += 2) {
        if (loader) { if (c + 3 < 128) { SCAN_DMA(c + 3); asm volatile("s_waitcnt vmcnt(16)" ::: "memory"); } else asm volatile("s_waitcnt vmcnt(0)" ::: "memory"); }
        else if (wid < CW) { SCAN_STEP(c, nnA, SCAN_LOADN(nnA, c + 2)); }
        asm volatile("s_waitcnt lgkmcnt(0)" ::: "memory"); __builtin_amdgcn_s_barrier(); asm volatile("" ::: "memory");
        if (loader) { if (c + 4 < 128) { SCAN_DMA(c + 4); asm volatile("s_waitcnt vmcnt(16)" ::: "memory"); } else asm volatile("s_waitcnt vmcnt(0)" ::: "memory"); }
        else if (wid < CW) { SCAN_STEP(c + 1, nnB, SCAN_LOADN(nnB, c + 3)); }
        asm volatile("s_waitcnt lgkmcnt(0)" ::: "memory"); __builtin_amdgcn_s_barrier(); asm volatile("" ::: "memory");
    }
#undef SCAN_DMA
#undef SCAN_LOADN
#undef SCAN_WAITN
#undef SCAN_STEP
    __syncthreads();
    if (wid < CW) {
        float* go = p.out + O_GP + (size_t)bh * 16384;
#pragma unroll
        for (int mt = 0; mt < 8; ++mt)
#pragma unroll
            for (int e = 0; e < 4; ++e) go[(16 * mt + 4 * fq + e) * 128 + sl * 16 + fr] = S[mt][e];
    }
}

__device__ __forceinline__ void gdn_gate_unit(const Params& p, int unit, int lane) {
    const int fr = lane & 15, fq = lane >> 4, bh = unit >> 7, n = unit & 127, b = bh >> 2, h = bh & 3, tok0 = b * SEQ + n * 64;
    const bf16_t* GO = (const bf16_t*)(p.ws + WS_GO) + (size_t)unit * 8192;
    bf16_t* PB = (bf16_t*)(p.ws + WS_H);
    float ssq[16];
#pragma unroll
    for (int k = 0; k < 16; ++k) ssq[k] = 0.f;
    {
        bf16_t* GOw = (bf16_t*)(p.ws + WS_GO) + (size_t)unit * 8192;
        const bf16_t* GQ = (const bf16_t*)(p.ws + WS_GQ) + (size_t)unit * 8192; const bf16_t* SC = (const bf16_t*)(p.ws + WS_GN) + (size_t)unit * 16384;
        bf16x8 qa[4][4];
#pragma unroll
        for (int mt = 0; mt < 4; ++mt)
#pragma unroll
            for (int ks = 0; ks < 4; ++ks) qa[mt][ks] = *(const bf16x8*)(GQ + ((mt * 4 + ks) * 64 + lane) * 8);
#pragma unroll 2
        for (int nt = 0; nt < 8; ++nt) {
            bf16x8 sb[4];
#pragma unroll
            for (int ks = 0; ks < 4; ++ks) sb[ks] = *(const bf16x8*)(SC + nt * 2048 + (ks * 64 + lane) * 8);
            const u32x4 o0 = *(const u32x4*)(GOw + (nt * 64 + lane) * 16), o1 = *(const u32x4*)(GOw + (nt * 64 + lane) * 16 + 8);
            f32x4 acc[4];
            acc[0] = (f32x4){bflo(o0.x), bfhi(o0.x), bflo(o0.y), bfhi(o0.y)}; acc[1] = (f32x4){bflo(o0.z), bfhi(o0.z), bflo(o0.w), bfhi(o0.w)};
            acc[2] = (f32x4){bflo(o1.x), bfhi(o1.x), bflo(o1.y), bfhi(o1.y)}; acc[3] = (f32x4){bflo(o1.z), bfhi(o1.z), bflo(o1.w), bfhi(o1.w)};
#pragma unroll
            for (int ks = 0; ks < 4; ++ks)
#pragma unroll
                for (int mt = 0; mt < 4; ++mt) acc[mt] = mfma16(qa[mt][ks], sb[ks], acc[mt]);
#pragma unroll
            for (int mt = 0; mt < 4; ++mt)
#pragma unroll
                for (int e = 0; e < 4; ++e) ssq[4 * mt + e] += acc[mt][e] * acc[mt][e];
            u32x4 w0, w1;
            w0.x = cvt_pk(acc[0][0], acc[0][1]); w0.y = cvt_pk(acc[0][2], acc[0][3]); w0.z = cvt_pk(acc[1][0], acc[1][1]); w0.w = cvt_pk(acc[1][2], acc[1][3]);
            w1.x = cvt_pk(acc[2][0], acc[2][1]); w1.y = cvt_pk(acc[2][2], acc[2][3]); w1.z = cvt_pk(acc[3][0], acc[3][1]); w1.w = cvt_pk(acc[3][2], acc[3][3]);
            *(u32x4*)(GOw + (nt * 64 + lane) * 16) = w0; *(u32x4*)(GOw + (nt * 64 + lane) * 16 + 8) = w1;
        }
        asm volatile("s_waitcnt vmcnt(0)" ::: "memory");
    }
#pragma unroll
    for (int k = 0; k < 16; ++k) { float s = row16_sum(ssq[k]); ssq[k] = rsqrtf(s * (1.0f / 128.0f) + EPS); }
    const float* gn = p.in[15];
#pragma unroll 2
    for (int nt = 0; nt < 8; ++nt) {
        const int dv = 16 * nt + fr; const float g = gn[dv];
        const u32x4 a0 = *(const u32x4*)(GO + (nt * 64 + lane) * 16), a1 = *(const u32x4*)(GO + (nt * 64 + lane) * 16 + 8);
        const bf16_t* gzp = PB + (size_t)(tok0 + 4 * fq) * PW + 2304 + h * 128 + dv; bf16_t* mp = PB + (size_t)(tok0 + 4 * fq) * PW + 512 + h * 128 + dv;
#pragma unroll
        for (int k = 0; k < 16; ++k) {
            const unsigned w = (k < 8) ? a0[(k >> 1) & 3] : a1[(k >> 1) & 3]; const float o = (k & 1) ? bfhi(w) : bflo(w);
            const int to = 16 * (k >> 2) + (k & 3);
            const float gz = bf2f(gzp[(size_t)to * PW]);
            mp[(size_t)to * PW] = f2bf(o * ssq[k] * g * silu(gz));
        }
    }
}

__device__ __forceinline__ void attn_unit(const Params& p, LAS unsigned char* lds, int unit) {
    const int tid = threadIdx.x, lane = tid & 63, wid = tid >> 6, fr = lane & 15, fq = lane >> 4;
    const int b = unit >> 7, blk = (unit >> 1) & 63, kvh = unit & 1;
    LAS bf16_t* Ks = (LAS bf16_t*)lds; LAS bf16_t* Vt = (LAS bf16_t*)(lds + 36864);
    bf16_t* PB = (bf16_t*)(p.ws + WS_H);
    __syncthreads();
#pragma unroll
    for (int i = 0; i < 4; ++i) {
        const int q = tid + 512 * i, row = q >> 3, ch = q & 7, tp = blk * 128 - 128 + row;
        u32x4 kv = (u32x4){0u, 0u, 0u, 0u}, vv = (u32x4){0u, 0u, 0u, 0u};
        if (tp >= 0) { const bf16_t* base = PB + (size_t)(b * SEQ + tp) * PW; kv = *(const u32x4*)(base + 512 + kvh * 64 + ch * 8); vv = *(const u32x4*)(base + 640 + kvh * 64 + ch * 8); }
        *(LAS u32x4*)(Ks + row * 72 + ch * 8) = kv;
#pragma unroll
        for (int e = 0; e < 4; ++e) { const unsigned w = vv[e]; Vt[(ch * 8 + 2 * e) * 264 + row] = (bf16_t)(w & 0xffffu); Vt[(ch * 8 + 2 * e + 1) * 264 + row] = (bf16_t)(w >> 16); }
    }
    __syncthreads();
    const int qtok = b * SEQ + blk * 128 + 16 * wid + fr;
#pragma unroll 1
    for (int g = 0; g < 4; ++g) {
        const int h = kvh * 4 + g; const float slope = exp2f(-(float)(h + 1)), sink = p.in[11][h];
        bf16x8 qf[2];
#pragma unroll
        for (int ks = 0; ks < 2; ++ks) qf[ks] = *(const bf16x8*)(PB + (size_t)qtok * PW + h * 64 + ks * 32 + 8 * fq);
        f32x4 s[10]; float mx = sink;
#pragma unroll
        for (int j = 0; j < 10; ++j) {
            const int ct = (wid + j) < 15 ? (wid + j) : 15;
            f32x4 acc = (f32x4){0.f, 0.f, 0.f, 0.f};
#pragma unroll
            for (int ks = 0; ks < 2; ++ks) acc = mfma16(*(const LAS bf16x8*)(Ks + (16 * ct + fr) * 72 + ks * 32 + 8 * fq), qf[ks], acc);
#pragma unroll
            for (int e = 0; e < 4; ++e) {
                const int c = 16 * (wid + j) + 4 * fq + e, dist = 16 * wid + fr - c + 128;
                const bool ok = (wid + j <= 15) && dist >= 0 && dist <= 128 && (blk * 128 + c - 128 >= 0);
                const float v = ok ? acc[e] * 0.125f - slope * (float)dist : -INFINITY;
                acc[e] = v; mx = fmaxf(mx, v);
            }
            s[j] = acc;
            asm volatile("" ::: "memory");
        }
        mx = fmaxf(mx, __shfl_xor(mx, 16)); mx = fmaxf(mx, __shfl_xor(mx, 32));
        float sum = 0.f;
#pragma unroll
        for (int j = 0; j < 10; ++j)
#pragma unroll
            for (int e = 0; e < 4; ++e) { const float pv = __expf(s[j][e] - mx); s[j][e] = pv; sum += pv; }
        sum += __shfl_xor(sum, 16); sum += __shfl_xor(sum, 32);
        sum += __expf(sink - mx);
        const float inv = 1.0f / sum;
        bf16x8 pb[5];
#pragma unroll
        for (int kk = 0; kk < 5; ++kk) { u32x4 w; w.x = cvt_pk(s[2 * kk][0] * inv, s[2 * kk][1] * inv); w.y = cvt_pk(s[2 * kk][2] * inv, s[2 * kk][3] * inv);
            w.z = cvt_pk(s[2 * kk + 1][0] * inv, s[2 * kk + 1][1] * inv); w.w = cvt_pk(s[2 * kk + 1][2] * inv, s[2 * kk + 1][3] * inv); pb[kk] = __builtin_bit_cast(bf16x8, w); }
#pragma unroll
        for (int dt = 0; dt < 4; ++dt) {
            f32x4 acc = (f32x4){0.f, 0.f, 0.f, 0.f};
#pragma unroll
            for (int kk = 0; kk < 5; ++kk) {
                const int c0 = (wid + 2 * kk) < 15 ? (wid + 2 * kk) : 15, c1 = (wid + 2 * kk + 1) < 15 ? (wid + 2 * kk + 1) : 15;
                const u32x2 lo = *(const LAS u32x2*)(Vt + (16 * dt + fr) * 264 + 16 * c0 + 4 * fq), hi = *(const LAS u32x2*)(Vt + (16 * dt + fr) * 264 + 16 * c1 + 4 * fq);
                const u32x4 a = (u32x4){lo.x, lo.y, hi.x, hi.y};
                acc = mfma16(__builtin_bit_cast(bf16x8, a), pb[kk], acc);
            }
            u32x2 w; w.x = cvt_pk(acc[0], acc[1]); w.y = cvt_pk(acc[2], acc[3]);
            *(u32x2*)(PB + (size_t)qtok * PW + h * 64 + 16 * dt + 4 * fq) = w;
            asm volatile("" ::: "memory");
        }
    }
}

__device__ __forceinline__ void sattn_unit(const Params& p, int s, int h, int lane) {
    const int kvh = h >> 2; const bool wr = (h & 3) == 0;
    bf16_t* PB = (bf16_t*)(p.ws + WS_H) + (size_t)(MPR + s) * PW;
    const float* ck = p.in[2] + (size_t)s * 128 * 128 + kvh * 64 + lane; const float* cv = p.in[3] + (size_t)s * 128 * 128 + kvh * 64 + lane;
    float* nk = p.out + O_KS + (size_t)s * 128 * 128 + kvh * 64 + lane; float* nv = p.out + O_VS + (size_t)s * 128 * 128 + kvh * 64 + lane;
    const float q = bf2f(PB[h * 64 + lane]) * 0.125f, slope = exp2f(-(float)(h + 1)), sink = p.in[11][h];
    const float knew = bf2f(PB[512 + kvh * 64 + lane]), vnew = bf2f(PB[640 + kvh * 64 + lane]);
    float sc[3];
#pragma unroll
    for (int t = 0; t < 2; ++t) {
#pragma unroll 8
        for (int jj = 0; jj < 64; ++jj) {
            const int j = t * 64 + jj; const float kval = ck[(size_t)j * 128];
            if (wr && j >= 1) nk[(size_t)(j - 1) * 128] = kval;
            const float d = wave_sum(q * kval) - slope * (float)(128 - j); if (lane == jj) sc[t] = d;
        }
    }
    if (wr) nk[(size_t)127 * 128] = knew;
    sc[2] = wave_sum(q * knew);
    const float mx = fmaxf(fmaxf(wave_max(fmaxf(sc[0], sc[1])), sc[2]), sink);
    const float p0 = __expf(sc[0] - mx), p1 = __expf(sc[1] - mx), p2 = __expf(sc[2] - mx);
    const float inv = 1.0f / (wave_sum(p0 + p1) + p2 + __expf(sink - mx));
    float o = p2 * vnew;
#pragma unroll 8
    for (int jj = 0; jj < 64; ++jj) { const float vval = cv[(size_t)jj * 128]; if (wr && jj >= 1) nv[(size_t)(jj - 1) * 128] = vval; o += __shfl(p0, jj) * vval; }
#pragma unroll 8
    for (int jj = 0; jj < 64; ++jj) { const float vval = cv[(size_t)(64 + jj) * 128]; if (wr) nv[(size_t)(63 + jj) * 128] = vval; o += __shfl(p1, jj) * vval; }
    if (wr) nv[(size_t)127 * 128] = vnew;
    asm volatile("" ::: "memory");
    PB[h * 64 + lane] = f2bf(o * inv);
}

__device__ __forceinline__ void sgdn_unit(const Params& p, LAS unsigned char* lds, int s) {
    const int tid = threadIdx.x, wid = tid >> 6, h = tid >> 7, dv = tid & 127;
    LAS float* qs = (LAS float*)lds; LAS float* ks = qs + 512; LAS float* red = ks + 512;
    bf16_t* PB = (bf16_t*)(p.ws + WS_H) + (size_t)(MPR + s) * PW; const float* GBA = (const float*)(p.ws + WS_GBA) + (size_t)(MPR + s) * 8;
    const float* cw = p.in[12]; const float* hc = p.in[4] + (size_t)s * 3 * CONVC; float* nc = p.out + O_CS + (size_t)s * 3 * CONVC;
    __syncthreads();
    float val[3];
#pragma unroll
    for (int i = 0; i < 3; ++i) {
        const int c = i * 512 + tid; const float x3 = bf2f(PB[768 + c]), h0 = hc[c], h1 = hc[CONVC + c], h2 = hc[2 * CONVC + c];
        val[i] = silu(cw[c] * h0 + cw[CONVC + c] * h1 + cw[2 * CONVC + c] * h2 + cw[3 * CONVC + c] * x3);
        nc[c] = h1; nc[CONVC + c] = h2; nc[2 * CONVC + c] = x3;
    }
    const float sq = wave_sum(val[0] * val[0]), sk = wave_sum(val[1] * val[1]);
    if ((tid & 63) == 0) { red[wid] = sq; red[8 + wid] = sk; }
    __syncthreads();
    const float ssq = red[2 * h] + red[2 * h + 1], ssk = red[8 + 2 * h] + red[8 + 2 * h + 1];
    qs[tid] = val[0] * rsqrtf(ssq + EPS) * 0.08838834764831845f; ks[tid] = val[1] * rsqrtf(ssk + EPS);
    __syncthreads();
    const float beta = 1.0f / (1.0f + __expf(-GBA[h]));
    const float x = GBA[4 + h] + p.in[14][h]; const float sp = x > 20.f ? x : log1pf(__expf(x));
    const float eg = __expf(-__expf(p.in[13][h]) * sp);
    const float* S0 = p.in[5] + ((size_t)(s * 4 + h) * 128) * 128 + dv; float* S1 = p.out + O_GS + ((size_t)(s * 4 + h) * 128) * 128 + dv;
    float kS = 0.f;
#pragma unroll 1
    for (int hf = 0; hf < 4; ++hf) { float sv[32];
#pragma unroll
        for (int dk = 0; dk < 32; ++dk) sv[dk] = S0[(size_t)(hf * 32 + dk) * 128];
#pragma unroll
        for (int dk = 0; dk < 32; ++dk) kS += ks[h * 128 + hf * 32 + dk] * sv[dk]; }
    const float delta = beta * (val[2] - eg * kS);
    float o = 0.f;
#pragma unroll 1
    for (int hf = 0; hf < 4; ++hf) { float sv[32];
#pragma unroll
        for (int dk = 0; dk < 32; ++dk) sv[dk] = S0[(size_t)(hf * 32 + dk) * 128];
#pragma unroll
        for (int dk = 0; dk < 32; ++dk) { const float nvv = eg * sv[dk] + ks[h * 128 + hf * 32 + dk] * delta; S1[(size_t)(hf * 32 + dk) * 128] = nvv; o += qs[h * 128 + hf * 32 + dk] * nvv; } }
    const float so = wave_sum(o * o);
    if ((tid & 63) == 0) red[16 + wid] = so;
    __syncthreads();
    const float tot = red[16 + 2 * h] + red[16 + 2 * h + 1];
    const float gz = bf2f(PB[2304 + tid]);
    PB[512 + tid] = f2bf(o * rsqrtf(tot * (1.0f / 128.0f) + EPS) * p.in[15][dv] * silu(gz));
}

#define XB_TMO      128
#define XB_XCNT(j)  (256  + 64 * (j))
#define XB_XSUB(j)  (1280 + 64 * (j))
#define XB_XGEN(j)  (2304 + 64 * (j))
#define XB_TOP      3328
#define XB_TOPGEN   3392
#define XCD_BAR_WORDS 3456
#define XB_SPIN_CAP (1u << 18)

__device__ __forceinline__ unsigned xb_ld(unsigned* p)              { return __hip_atomic_load(p, __ATOMIC_RELAXED, __HIP_MEMORY_SCOPE_AGENT); }
__device__ __forceinline__ unsigned xb_add(unsigned* p, unsigned v) { return __hip_atomic_fetch_add(p, v, __ATOMIC_RELAXED, __HIP_MEMORY_SCOPE_AGENT); }
__device__ __forceinline__ unsigned xb_xcc_id() { return (unsigned)__builtin_amdgcn_s_getreg((3 << 11) | 20) & 0xFu; }
#define XB_SPIN(cond, bar) do { unsigned _sp = 0; while (cond) { __builtin_amdgcn_s_sleep(1); \
    if ((++_sp & 255u) == 0u) { if (xb_ld(&(bar)[XB_TMO])) break; if (_sp > XB_SPIN_CAP) { atomicAdd(&(bar)[XB_TMO], 1u); break; } } } } while (0)

struct XcdBarrier {
    unsigned* bar; unsigned x;
    volatile LAS unsigned* st;
};

__device__ __forceinline__ XcdBarrier xcd_barrier_post(unsigned* bar, volatile LAS unsigned* st) {
    XcdBarrier b; b.bar = bar; b.x = xb_xcc_id(); b.st = st;
    if (threadIdx.x == 0) (void)xb_add(&bar[XB_XCNT(b.x)], 1u);
    return b;
}
__device__ __forceinline__ void xcd_barrier_complete(unsigned* bar, unsigned x, unsigned& nloc, unsigned& nx) {
    const unsigned G = gridDim.x * gridDim.y * gridDim.z;
    unsigned sum, cnt, mine, sp = 0u;
    for (;;) {
        sum = 0u; cnt = 0u; mine = 0u;
#pragma unroll
        for (unsigned j = 0; j < 16; ++j) { const unsigned c = xb_ld(&bar[XB_XCNT(j)]); sum += c; cnt += (c > 0u) ? 1u : 0u; mine = (j == x) ? c : mine; }
        if (sum == G) break;
        __builtin_amdgcn_s_sleep(1);
        if ((++sp & 255u) == 0u) { if (xb_ld(&bar[XB_TMO])) break; if (sp > XB_SPIN_CAP) { atomicAdd(&bar[XB_TMO], 1u); break; } }
    }
    nloc = mine > 0u ? mine : 1u; nx = cnt > 0u ? cnt : 1u;
}

__device__ __forceinline__ void xcd_barrier(const XcdBarrier& b) {
    asm volatile("s_waitcnt vmcnt(0)" ::: "memory");
    __syncthreads();
    if (threadIdx.x == 0) {
        unsigned* bar = b.bar;
        __builtin_amdgcn_s_waitcnt(0);
        unsigned nloc = b.st[0], nx = b.st[1];
        if (nloc == 0u) { xcd_barrier_complete(bar, b.x, nloc, nx); b.st[0] = nloc; b.st[1] = nx; }
        const unsigned old = xb_add(&bar[XB_XSUB(b.x)], 1u);
        const unsigned gen = old / nloc;
        if (old + 1u == (gen + 1u) * nloc) {
            __builtin_amdgcn_fence(__ATOMIC_RELEASE, "agent");
            asm volatile("s_waitcnt vmcnt(0)" ::: "memory");
            const unsigned og = xb_add(&bar[XB_TOP], 1u);
            const unsigned tg = og / nx;
            if (og + 1u == (tg + 1u) * nx) xb_add(&bar[XB_TOPGEN], 1u);
            else XB_SPIN(xb_ld(&bar[XB_TOPGEN]) == tg, bar);
            __builtin_amdgcn_fence(__ATOMIC_ACQUIRE, "agent");
            xb_add(&bar[XB_XGEN(b.x)], 1u);
            asm volatile("s_waitcnt vmcnt(0)" ::: "memory");
        } else {
            XB_SPIN(xb_ld(&bar[XB_XGEN(b.x)]) == gen, bar);
            __builtin_amdgcn_fence(__ATOMIC_ACQUIRE, "agent");
            asm volatile("s_waitcnt vmcnt(0)" ::: "memory");
        }
    }
    __syncthreads();
}

__global__ void __launch_bounds__(512, 2) fwd_kernel(Params p, int ph_lo, int ph_hi) {
    extern __shared__ __attribute__((aligned(16))) unsigned char lds_raw[];
    LAS unsigned char* lds = (LAS unsigned char*)lds_raw;
    cg::grid_group grid = cg::this_grid();
    if (ph_lo < 0) grid.sync();
    volatile LAS unsigned* bst = (volatile LAS unsigned*)(lds + LDS_PHASE_BYTES);
    if (threadIdx.x < 2) bst[threadIdx.x] = 0u;
    __syncthreads();
    XcdBarrier xbar; xbar.bar = (unsigned*)(p.ws + WS_CTL + CTL_BAR); xbar.x = 0; xbar.st = bst;
    if (ph_hi - ph_lo > 1) xbar = xcd_barrier_post((unsigned*)(p.ws + WS_CTL + CTL_BAR), bst);
    const int tid = threadIdx.x, lane = tid & 63, wid = tid >> 6, G = gridDim.x, bx = blockIdx.x;
    unsigned char* ws = p.ws;
    bf16_t* XN = (bf16_t*)(ws + WS_XN); bf16_t* XN2 = (bf16_t*)(ws + WS_XN2); bf16_t* HB = (bf16_t*)(ws + WS_H);
    float* SS1 = (float*)(ws + WS_SSP1); float* SS2 = (float*)(ws + WS_SSP2);
    float* Y = p.out; bf16_t* X3b = (bf16_t*)(ws + WS_GM);
#ifndef PHMASK
#define PHMASK 0x7ff
#endif
#define IN(k) (((PHMASK >> (k)) & 1) && ph_lo <= (k) && (k) < ph_hi)
#define SEAM(k) do { if (IN(k) && IN((k) + 1)) { xcd_barrier(xbar); }     } while (0)

    if (IN(0)) p0_prologue(p, lds, bx, G);
    SEAM(0);
    if (IN(1)) {
        if (bx < 176) sk_ffn_in<false>(XN, (const bf16_t*)(ws + WS_W1IN), HB, bx, wid, lane & 15, lane >> 4, lds);
        pg8::Gemm g{XN, (const bf16_t*)(ws + WS_W1IN), MPR, 2 * DFF, DM, DM}; pg8::StaticOrder S; S.init(MPR, 2 * DFF, G, bx);
        EpiSwiglu E{HB, nullptr}; pg8::gemm_phase<EpiSwiglu, pg8::StaticOrder, GEMM_ALIGN, GEMM_SP2>(lds, g, S, E);
    }
    SEAM(1);
    if (IN(2)) {
        if (bx < 64) sk_ffn_out<false>(HB, (const bf16_t*)(ws + WS_W1OUT), p.in[1], nullptr, XN + (size_t)MPR * DM, bx, wid, lane & 15, lane >> 4, lds);
        pg8::Gemm g{HB, (const bf16_t*)(ws + WS_W1OUT), MPR, DM, DFF, DFF}; pg8::StaticOrder S; S.init(MPR, DM, G, bx);
        EpiResid<false, false, true, true, true> E{p.in[0], p.in[1], nullptr, XN, SS1}; pg8::gemm_phase<EpiResid<false, false, true, true, true>, pg8::StaticOrder, GEMM_ALIGN, GEMM_SP2>(lds, g, S, E);
    }
    SEAM(2);
    if (IN(3)) {
        if (bx < 89) sk_inproj(XN, (const bf16_t*)(ws + WS_WINMIX), HB, (float*)(ws + WS_GBA), bx, wid, lane & 15, lane >> 4, lds);
        pg8::Gemm g{XN, (const bf16_t*)(ws + WS_WINMIX), MPR, NINP, DM, DM}; pg8::StaticOrder S; S.init(MPR, NINP, G, bx);
        EpiInproj E{HB, (float*)(ws + WS_GBA), SS1}; pg8::gemm_phase<EpiInproj, pg8::StaticOrder, GEMM_ALIGN, GEMM_SP2>(lds, g, S, E);
    }
    SEAM(3);
    if (IN(4)) {
        for (int u = bx; u < 2048; u += G) gdn_prep_unit(p, lds, u);
    }
    SEAM(4);
    if (IN(5)) {
        if (bx < NSCAN) gdn_scan(p, lds, bx);
        else {
            const int ab = bx - NSCAN, NAB = G - NSCAN;
            if (NAB == 192) {
                if (ab < 128) { sattn_unit(p, ab, wid, lane); sgdn_unit(p, lds, ab); attn_unit(p, lds, 2 * ab); attn_unit(p, lds, 2 * ab + 1); }
                else { for (int k = 0; k < 4; ++k) attn_unit(p, lds, 256 + (ab - 128) * 4 + k); }
            } else {
                int it = ab;
#pragma unroll 1
                for (; it < 512; it += NAB) attn_unit(p, lds, it);
#pragma unroll 1
                for (; it < 640; it += NAB) { sattn_unit(p, it - 512, wid, lane); sgdn_unit(p, lds, it - 512); }
            }
            const bf16_t* PB = HB;
            for (int idx = ab * 512 + tid; idx < 149504; idx += NAB * 512) {
                if (idx < 131072) { const int w = idx >> 16, r = idx & 65535, b = r >> 14, j = (r >> 7) & 127, c = r & 127;
                    p.out[(w ? O_VP : O_KP) + r] = bf2f(PB[(size_t)(b * SEQ + SEQ - 128 + j) * PW + 512 + w * 128 + c]);
                } else { const int r = idx - 131072, b = r / (3 * CONVC), q = r % (3 * CONVC), rr = q / CONVC, c = q % CONVC;
                    p.out[O_CP + r] = bf2f(PB[(size_t)(b * SEQ + SEQ - 3 + rr) * PW + 768 + c]); }
            }
        }
    }
    SEAM(5);
    if (IN(6)) {
        for (int u = bx * 8 + wid; u < 2048; u += G * 8) gdn_gate_unit(p, u, lane);
    }
    SEAM(6);
#ifdef DBG_DUMP
    if (ph_lo == 11) {
        const float* src = (const float*)(ws + DBG_SRC);
        for (size_t i = (size_t)bx * 512 + tid; i < (size_t)MREAL * DM; i += (size_t)G * 512) Y[i] = (i < (size_t)MREAL * 8) ? ((const float*)(ws + WS_GBA))[i] : 0.f;
    }
#endif
    if (IN(7)) {
        if (bx < 32) sk_outproj(HB, (const bf16_t*)(ws + WS_WOUTMIX), XN, nullptr, XN2, bx, wid, lane & 15, lane >> 4, lds);
        pg8::Gemm g{HB, (const bf16_t*)(ws + WS_WOUTMIX), MPR, DM, DM, PW}; pg8::StaticOrder S; S.init(MPR, DM, G, bx);
        EpiResid<true, false, true, true, false> E{XN, XN + (size_t)MPR * DM, nullptr, XN2, SS2}; pg8::gemm_phase<EpiResid<true, false, true, true, false>, pg8::StaticOrder, GEMM_ALIGN, GEMM_SP2>(lds, g, S, E);
    }
    SEAM(7);
    if (IN(8)) {
        if (bx < 176) sk_ffn_in<true>(XN2, (const bf16_t*)(ws + WS_W2IN), HB, bx, wid, lane & 15, lane >> 4, lds);
        pg8::Gemm g{XN2, (const bf16_t*)(ws + WS_W2IN), MPR, 2 * DFF, DM, DM}; pg8::StaticOrder S; S.init(MPR, 2 * DFF, G, bx);
        EpiSwiglu E{HB, SS2}; pg8::gemm_phase<EpiSwiglu, pg8::StaticOrder, GEMM_ALIGN, GEMM_SP2>(lds, g, S, E);
    }
    SEAM(8);
    if (IN(9)) {
        if (bx < 64) sk_ffn_out<true>(HB, (const bf16_t*)(ws + WS_W2OUT), (const float*)(XN2 + (size_t)MPR * DM), nullptr, X3b + (size_t)MPR * DM, bx, wid, lane & 15, lane >> 4, lds);
        pg8::Gemm g{HB, (const bf16_t*)(ws + WS_W2OUT), MPR, DM, DFF, DFF}; pg8::StaticOrder S; S.init(MPR, DM, G, bx);
        EpiResid<true, false, true, false, true> E{XN2, XN2 + (size_t)MPR * DM, nullptr, X3b, nullptr}; pg8::gemm_phase<EpiResid<true, false, true, false, true>, pg8::StaticOrder, GEMM_ALIGN, GEMM_SP2>(lds, g, S, E);
    }
    SEAM(9);
    if (IN(10)) {
        const float* gf = p.in[20]; f32x4 gv[4];
#pragma unroll
        for (int j = 0; j < 4; ++j) gv[j] = *((const f32x4*)gf + lane + 64 * j);
        {
            f32x4 v[4], vn[4]; int m = bx * 8 + wid;
            if (m < MREAL) { const u32x2* xr = (const u32x2*)(X3b + (size_t)m * DM) + lane;
#pragma unroll
                for (int j = 0; j < 4; ++j) { const u32x2 w = xr[64 * j]; v[j] = (f32x4){bflo(w.x), bfhi(w.x), bflo(w.y), bfhi(w.y)}; } }
            for (; m < MREAL; m += G * 8) {
                const int mn = m + G * 8;
                if (mn < MREAL) { const u32x2* xr = (const u32x2*)(X3b + (size_t)mn * DM) + lane;
#pragma unroll
                    for (int j = 0; j < 4; ++j) { const u32x2 w = xr[64 * j]; vn[j] = (f32x4){bflo(w.x), bfhi(w.x), bflo(w.y), bfhi(w.y)}; } }
                float s = 0.f;
#pragma unroll
                for (int j = 0; j < 4; ++j) s += (v[j][0] * v[j][0] + v[j][1] * v[j][1]) + (v[j][2] * v[j][2] + v[j][3] * v[j][3]);
                const float rstd = rsqrtf(wave_sum(s) * (1.0f / DM) + EPS);
                f32x4* yr = (f32x4*)(Y + (size_t)m * DM) + lane;
#pragma unroll
                for (int j = 0; j < 4; ++j) yr[64 * j] = v[j] * rstd * gv[j];
#pragma unroll
                for (int j = 0; j < 4; ++j) v[j] = vn[j];
            }
        }
    }
#undef IN
#undef SEAM
}
}

#ifndef MK_N_LAUNCHES
#define MK_N_LAUNCHES 1
#endif
extern "C" void kernel_launch(void* const* d_in, const int* in_sizes, int n_in, void* d_out, int out_size, void* d_ws, size_t ws_size, hipStream_t stream) {
    static int grid = 0;
    if (grid == 0) {
        if (n_in != 21 || ws_size < mk::WS_END || out_size != 47269888) { fprintf(stderr, "kernel_launch: unexpected shapes (n_in %d, ws %zu, out %d)\n", n_in, ws_size, out_size); grid = -1; return; }
        int dev = 0, cus = 0, per_cu = 0;
        (void)hipGetDevice(&dev); (void)hipDeviceGetAttribute(&cus, hipDeviceAttributeMultiprocessorCount, dev);
        if (hipFuncSetAttribute((const void*)mk::fwd_kernel, hipFuncAttributeMaxDynamicSharedMemorySize, mk::LDS_BYTES) != hipSuccess) { fprintf(stderr, "kernel_launch: hipFuncSetAttribute failed\n"); grid = -1; return; }
        if (hipOccupancyMaxActiveBlocksPerMultiprocessor(&per_cu, (const void*)mk::fwd_kernel, 512, mk::LDS_BYTES) != hipSuccess || per_cu < 1) { fprintf(stderr, "kernel_launch: occupancy query failed (%d)\n", per_cu); per_cu = 1; }
        (void)hipGetLastError();
        grid = cus * per_cu;
        if (grid <= mk::NSCAN) { fprintf(stderr, "kernel_launch: grid %d too small\n", grid); grid = -1; return; }
    }
    if (grid < 0) return;
    (void)hipMemsetAsync((char*)d_ws + mk::WS_CTL + mk::CTL_BAR, 0, mk::CTL_BAR_BYTES, stream);
    mk::Params p{};
    for (int i = 0; i < 21; ++i) p.in[i] = (const float*)d_in[i];
    p.out = (float*)d_out; p.ws = (unsigned char*)d_ws;
#if MK_N_LAUNCHES == 1
    int lo = 0, hi = 11; void* args[] = {&p, &lo, &hi};
    hipError_t e = hipLaunchCooperativeKernel((const void*)mk::fwd_kernel, dim3(grid), dim3(512), args, mk::LDS_BYTES, stream);
    if (e != hipSuccess) fprintf(stderr, "kernel_launch: cooperative launch failed: %s (grid %d)\n", hipGetErrorString(e), grid);
#else
#ifndef MK_LAST
#define MK_LAST 11
#ifndef MK_DOUBLE
#define MK_DOUBLE 0x0
#endif
#define DBG_C0 512
#define DBG_C1 1024
#endif
    for (int ph = 0; ph < MK_LAST; ++ph) { const int reps = ((MK_DOUBLE >> ph) & 1) ? 2 : 1; for (int r = 0; r < reps; ++r) hipLaunchKernelGGL(mk::fwd_kernel, dim3(grid), dim3(512), mk::LDS_BYTES, stream, p, ph, ph + 1); }
#ifdef DBG_DUMP
    hipLaunchKernelGGL(mk::fwd_kernel, dim3(grid), dim3(512), mk::LDS_BYTES, stream, p, 11, 12);
#endif
#endif
}
```

```cpp
#include <hip/hip_runtime.h>
#include <hip/hip_cooperative_groups.h>
#include <cstdio>
namespace cg = cooperative_groups;
namespace pg8 {
#define PG8_LAS __attribute__((address_space(3)))
typedef unsigned short bf16_t;
typedef short bf16x8 __attribute__((ext_vector_type(8)));
typedef float f32x4 __attribute__((ext_vector_type(4)));
typedef unsigned u32x4 __attribute__((ext_vector_type(4)));
constexpr int BM = 256, BK = 64, HALF = 128, HTB = HALF * BK * 2  , STAGE_BYTES = 8 * HTB, NXCD = 8, WGM = 4;

__host__ __device__ __forceinline__ int lds_byte(int r, int c) { const int st = (r >> 4) * 2 + (c >> 5), rr = r & 15, cc = c & 31, ob = rr * 64 + cc * 2; return st * 1024 + (ob ^ (((ob >> 9) & 1) << 5)); }
__host__ __device__ __forceinline__ void stage_rc(int b, int& R, int& C) { const int st = b / 1024, sb = b % 1024, swz = sb ^ (((sb >> 9) & 1) << 5); R = (st >> 1) * 16 + swz / 64; C = (st & 1) * 32 + (swz % 64) / 2; }
__host__ __device__ __forceinline__ int perm32(int rho) { const int n = rho >> 4, i = rho & 15; return 8 * (i >> 2) + 4 * n + (i & 3); }

struct Unit { int pm, pn; };
struct Gemm { const bf16_t* A; const bf16_t* Bt; int M, N, K, lda; };

struct StaticOrder {
    int nM, nN, nwg, G, c, wgm;
    __host__ __device__ void init(int M, int N, int G_, int c_, int wgm_ = WGM) { nM = M / BM; nN = N / BM; nwg = nM * nN; G = G_; c = c_; wgm = wgm_; }
    __host__ __device__ bool next(int i, Unit& u) const {
        const long L = (long)i * G + c; if (L >= nwg) return false;
        int wgid = (int)L; { const int q = nwg / NXCD, r = nwg % NXCD, xcd = wgid % NXCD, off = wgid / NXCD; wgid = (xcd < r ? xcd * (q + 1) : r * (q + 1) + (xcd - r) * q) + off; }
        const int nig = wgm * nN, gid = wgid / nig, fm = gid * wgm, gsz = (nM - fm) < wgm ? (nM - fm) : wgm;
        u.pm = fm + ((wgid % nig) % gsz); u.pn = (wgid % nig) / gsz; return true;
    }
    __device__ __forceinline__ void a_ready(const Unit&) const {}
    __device__ __forceinline__ void done(const Unit&) const {}
};

__device__ __forceinline__ unsigned cvt_pk_bf16(float lo, float hi) { unsigned r; asm volatile("v_cvt_pk_bf16_f32 %0, %1, %2" : "=v"(r) : "v"(lo), "v"(hi)); return r; }
typedef float f32x2 __attribute__((ext_vector_type(2)));
__device__ __forceinline__ f32x2 gelu_pk(f32x2 v) {
    const f32x2 av = __builtin_elementwise_abs(v), d = av * 0.2316418882f + 1.0f;
    f32x2 t; t.x = __builtin_amdgcn_rcpf(d.x); t.y = __builtin_amdgcn_rcpf(d.y);
    f32x2 q = t * 0.5307027145f + (-0.7265760135f); q = q * t + 0.7107068705f; q = q * t + (-0.142248368f); q = q * t + 0.127414796f; q = q * t;
    const f32x2 s = (v * v) * (-0.72134752044f);
    f32x2 e; e.x = __builtin_amdgcn_exp2f(s.x); e.y = __builtin_amdgcn_exp2f(s.y);
    const f32x2 m = v * (q * e), r = v - m;
    f32x2 o; o.x = v.x < 0.f ? m.x : r.x; o.y = v.y < 0.f ? m.y : r.y; return o;
}

template <int ACT  > struct EpiBf16 {
    static constexpr bool PERM = true, AFTER_DRAIN = false; static_assert(ACT == 0 || ACT == 1, "EpiBf16: ACT is 0 (none) or 1 (gelu_pk)");
    bf16_t* O; int ldc; const float* bias; int split_cols; size_t split_stride; float scale0;
    __device__ __forceinline__ void operator()(const f32x4 (&acc)[2][2][4][2], const Unit& u, int wr, int wc, int fr, int fq) const {
        const int row0 = u.pm * BM + wr * 64 + fr; int colt = u.pn * BM; bf16_t* base = O;
        float sc = 1.f; if (split_cols) { const int t = colt / split_cols; base += (size_t)t * split_stride; colt -= t * split_cols; if (t == 0) sc = scale0; }
        const int col0 = colt + wc * 32 + 8 * fq, bcol0 = u.pn * BM + wc * 32 + 8 * fq;
        f32x4 bv[2][2];
#pragma unroll
        for (int bj = 0; bj < 2; ++bj)
#pragma unroll
            for (int n = 0; n < 2; ++n) bv[bj][n] = bias ? *(const f32x4*)(bias + bcol0 + bj * HALF + 4 * n) : (f32x4){0.f, 0.f, 0.f, 0.f};
#pragma unroll
        for (int ai = 0; ai < 2; ++ai)
#pragma unroll
            for (int m = 0; m < 4; ++m) { bf16_t* rowp = base + (size_t)(row0 + ai * HALF + m * 16) * ldc + col0;
#pragma unroll
                for (int bj = 0; bj < 2; ++bj) { f32x4 v0 = acc[ai][bj][m][0] + bv[bj][0], v1 = acc[ai][bj][m][1] + bv[bj][1];
                    if (ACT == 1) { f32x2 a = gelu_pk((f32x2){v0[0], v0[1]}), b = gelu_pk((f32x2){v0[2], v0[3]}), c = gelu_pk((f32x2){v1[0], v1[1]}), d = gelu_pk((f32x2){v1[2], v1[3]});
                        v0 = (f32x4){a.x, a.y, b.x, b.y}; v1 = (f32x4){c.x, c.y, d.x, d.y}; }
                    v0 = v0 * sc; v1 = v1 * sc; u32x4 w; w.x = cvt_pk_bf16(v0[0], v0[1]); w.y = cvt_pk_bf16(v0[2], v0[3]); w.z = cvt_pk_bf16(v1[0], v1[1]); w.w = cvt_pk_bf16(v1[2], v1[3]);
                    *(u32x4*)(rowp + bj * HALF) = w; } }
    }
};

struct PanelStats {
    unsigned* xbuf;
    unsigned* cnt;
    unsigned* tmo;
    int ntn; float eps;
    unsigned code;
    __device__ __forceinline__ bool run(const f32x4 (&v)[2][2][4][2], const Unit& u, int wr, int wc, int fr, int fq, PG8_LAS unsigned char* lds, int wid, int lane) const {
        typedef float f32x2v __attribute__((ext_vector_type(2)));
        PG8_LAS f32x2v* P = (PG8_LAS f32x2v*)lds;
        PG8_LAS f32x2v* S = (PG8_LAS f32x2v*)(lds + 8192);
        PG8_LAS unsigned* flag = (PG8_LAS unsigned*)(lds + 8192 + 2048);
#pragma unroll
        for (int ai = 0; ai < 2; ++ai)
#pragma unroll
            for (int m = 0; m < 4; ++m) {
                float s = 0.f;
#pragma unroll
                for (int bj = 0; bj < 2; ++bj)
#pragma unroll
                    for (int n = 0; n < 2; ++n) { const f32x4 x = v[ai][bj][m][n]; s += (x[0] + x[1]) + (x[2] + x[3]); }
                s += __shfl_xor(s, 16); s += __shfl_xor(s, 32);
                const float mw = s * (1.0f / 64.0f); float q = 0.f;
#pragma unroll
                for (int bj = 0; bj < 2; ++bj)
#pragma unroll
                    for (int n = 0; n < 2; ++n) { const f32x4 d = v[ai][bj][m][n] - mw; q += (d[0] * d[0] + d[1] * d[1]) + (d[2] * d[2] + d[3] * d[3]); }
                q += __shfl_xor(q, 16); q += __shfl_xor(q, 32);
                if (fq == 0) P[(ai * HALF + wr * 64 + m * 16 + fr) * 4 + wc] = (f32x2v){mw, q};
            }
        asm volatile("s_waitcnt lgkmcnt(0)" ::: "memory"); __builtin_amdgcn_s_barrier(); asm volatile("" ::: "memory");
#if defined(BROKEN_EXCHANGE_NO_WAIT)
#warning BROKEN CONTROL BUILD: the row-statistics exchange does not wait; results are wrong by design
        if (blockIdx.x >= 64) { const long long t0_ = clock64(); while (clock64() - t0_ < 60000) __builtin_amdgcn_s_sleep(8); }
#endif
        const int row = wid * 32 + (lane & 31);
        if (lane < 32) {
            const f32x2v a = P[row * 4 + 0], b = P[row * 4 + 1], c = P[row * 4 + 2], d = P[row * 4 + 3];
            const float mt = (a.x + b.x + c.x + d.x) * 0.25f;
            const float da = a.x - mt, db = b.x - mt, dc = c.x - mt, dd = d.x - mt;
            const float m2 = (a.y + b.y) + (c.y + d.y) + 64.0f * ((da * da + db * db) + (dc * dc + dd * dd));
            unsigned long long* slot = (unsigned long long*)xbuf + ((size_t)(u.pm * BM + row) * 4 + u.pn);
            __hip_atomic_store(slot, ((unsigned long long)__float_as_uint(m2) << 32) | __float_as_uint(mt), __ATOMIC_RELAXED, __HIP_MEMORY_SCOPE_AGENT);
        }
        asm volatile("s_waitcnt vmcnt(0)" ::: "memory");
        if (lane == 0) __hip_atomic_fetch_add(cnt + 64 * u.pm, 1u, __ATOMIC_RELAXED, __HIP_MEMORY_SCOPE_AGENT);
        if (wid == 0) {
            bool dead = false; const unsigned long long t0 = __builtin_amdgcn_s_memrealtime(); const unsigned want = 8u * (unsigned)ntn;
            for (;;) {
#if defined(BROKEN_EXCHANGE_NO_WAIT)
                break;
#endif
                if ((unsigned)__builtin_amdgcn_readfirstlane(__hip_atomic_load(cnt + 64 * u.pm, __ATOMIC_RELAXED, __HIP_MEMORY_SCOPE_AGENT)) >= want) break;
                if (__builtin_amdgcn_s_memrealtime() - t0 > 2000000ull) {
                    if (lane == 0) { unsigned expect = 0u; __hip_atomic_compare_exchange_strong(tmo + 1, &expect, code | (unsigned)(u.pm & 0xff), __ATOMIC_RELAXED, __ATOMIC_RELAXED, __HIP_MEMORY_SCOPE_AGENT);
                                     __hip_atomic_store(tmo, 1u, __ATOMIC_RELAXED, __HIP_MEMORY_SCOPE_AGENT); }
                    dead = true; break; }
                __builtin_amdgcn_s_sleep(2);
            }
            __builtin_amdgcn_fence(__ATOMIC_ACQUIRE, "agent");
            if (lane == 0) flag[0] = dead ? 1u : 0u;
        }
        asm volatile("s_waitcnt vmcnt(0) lgkmcnt(0)" ::: "memory"); __builtin_amdgcn_s_barrier(); asm volatile("" ::: "memory");
        const bool bad = flag[0] != 0u;
        if (lane < 32) {
            const unsigned long long* slot = (const unsigned long long*)xbuf + (size_t)(u.pm * BM + row) * 4; float mt[4], m2[4]; float ms = 0.f;
#pragma unroll
            for (int t = 0; t < 4; ++t) { if (t < ntn) { const unsigned long long w = __hip_atomic_load(slot + t, __ATOMIC_RELAXED, __HIP_MEMORY_SCOPE_AGENT); mt[t] = __uint_as_float((unsigned)w); m2[t] = __uint_as_float((unsigned)(w >> 32)); } else { mt[t] = 0.f; m2[t] = 0.f; } ms += mt[t]; }
            const float mean = ms / (float)ntn; float q = 0.f;
#pragma unroll
            for (int t = 0; t < 4; ++t) if (t < ntn) { const float dm = mt[t] - mean; q += m2[t] + 256.0f * dm * dm; }
            S[row] = (f32x2v){mean, 1.0f / sqrtf(q / (256.0f * (float)ntn) + eps)};
        }
        asm volatile("s_waitcnt lgkmcnt(0)" ::: "memory"); __builtin_amdgcn_s_barrier(); asm volatile("" ::: "memory");
        return bad;
    }
};
struct EpiLnRes {
    static constexpr bool PERM = false, AFTER_DRAIN = true;
    const float* base; float* out; int ldc; const float* bias; PanelStats st; unsigned poison;
    __device__ __forceinline__ void fused(f32x4 (&acc)[2][2][4][2], const Unit& u, int wr, int wc, int fr, int fq, PG8_LAS unsigned char* lds, int wid, int lane) const {
        typedef float f32x2v __attribute__((ext_vector_type(2)));
        const PG8_LAS f32x2v* S = (const PG8_LAS f32x2v*)(lds + 8192);
        const int col0 = u.pn * BM + wc * 32 + 4 * fq;
#pragma unroll
        for (int bj = 0; bj < 2; ++bj)
#pragma unroll
            for (int n = 0; n < 2; ++n) { const f32x4 bv = bias ? *(const f32x4*)(bias + col0 + bj * HALF + n * 16) : (f32x4){0.f, 0.f, 0.f, 0.f};
#pragma unroll
                for (int ai = 0; ai < 2; ++ai)
#pragma unroll
                    for (int m = 0; m < 4; ++m) acc[ai][bj][m][n] += bv; }
        f32x4 pre[4][2][2];
#pragma unroll
        for (int m = 0; m < 4; ++m) { const size_t off = (size_t)(u.pm * BM + wr * 64 + m * 16 + fr) * ldc + col0;
#pragma unroll
            for (int bj = 0; bj < 2; ++bj)
#pragma unroll
                for (int n = 0; n < 2; ++n) pre[m][bj][n] = *(const f32x4*)(base + off + bj * HALF + n * 16); }
        const bool bad = st.run(acc, u, wr, wc, fr, fq, lds, wid, lane) || poison != 0u;
        const float qnan = __builtin_nanf("");
#pragma unroll
        for (int ai = 0; ai < 2; ++ai)
#pragma unroll
            for (int m = 0; m < 4; ++m) { const int r = ai * HALF + wr * 64 + m * 16 + fr; const f32x2v sr = S[r]; const size_t off = (size_t)(u.pm * BM + r) * ldc + col0;
#pragma unroll
                for (int bj = 0; bj < 2; ++bj)
#pragma unroll
                    for (int n = 0; n < 2; ++n) { const f32x4 bs = ai == 0 ? pre[m][bj][n] : *(const f32x4*)(base + off + bj * HALF + n * 16); f32x4 o = bs + (acc[ai][bj][m][n] - sr.x) * sr.y;
                        if (bad) o = (f32x4){qnan, qnan, qnan, qnan}; *(f32x4*)(out + off + bj * HALF + n * 16) = o; }
                if (m & 1) asm volatile("" ::: "memory"); }
    }
};
struct EpiLnResLn {
    static constexpr bool PERM = false, AFTER_DRAIN = true;
    const float* base; float* out; bf16_t* xn; int ldc; const float* bias; PanelStats st1, st2; unsigned poison;
    __device__ __forceinline__ void fused(f32x4 (&acc)[2][2][4][2], const Unit& u, int wr, int wc, int fr, int fq, PG8_LAS unsigned char* lds, int wid, int lane) const {
        typedef float f32x2v __attribute__((ext_vector_type(2))); typedef unsigned u32x2v __attribute__((ext_vector_type(2)));
        const PG8_LAS f32x2v* S = (const PG8_LAS f32x2v*)(lds + 8192);
        const int col0 = u.pn * BM + wc * 32 + 4 * fq;
#pragma unroll
        for (int bj = 0; bj < 2; ++bj)
#pragma unroll
            for (int n = 0; n < 2; ++n) { const f32x4 bv = bias ? *(const f32x4*)(bias + col0 + bj * HALF + n * 16) : (f32x4){0.f, 0.f, 0.f, 0.f};
#pragma unroll
                for (int ai = 0; ai < 2; ++ai)
#pragma unroll
                    for (int m = 0; m < 4; ++m) acc[ai][bj][m][n] += bv; }
        bool bad = st1.run(acc, u, wr, wc, fr, fq, lds, wid, lane) || poison != 0u;
        const float qnan = __builtin_nanf("");
#pragma unroll
        for (int ai = 0; ai < 2; ++ai)
#pragma unroll
            for (int m = 0; m < 4; ++m) { const int r = ai * HALF + wr * 64 + m * 16 + fr; const f32x2v sr = S[r]; const size_t off = (size_t)(u.pm * BM + r) * ldc + col0;
#pragma unroll
                for (int bj = 0; bj < 2; ++bj)
#pragma unroll
                    for (int n = 0; n < 2; ++n) { const f32x4 bs = *(const f32x4*)(base + off + bj * HALF + n * 16); acc[ai][bj][m][n] = bs + (acc[ai][bj][m][n] - sr.x) * sr.y; }
                asm volatile("" : "+v"(acc[ai][0][m][0]), "+v"(acc[ai][0][m][1]), "+v"(acc[ai][1][m][0]), "+v"(acc[ai][1][m][1]));
                if (m & 1) asm volatile("" ::: "memory"); }
        const bool bad1 = bad;
        bad = st2.run(acc, u, wr, wc, fr, fq, lds, wid, lane) || bad;
#pragma unroll
        for (int ai = 0; ai < 2; ++ai)
#pragma unroll
            for (int m = 0; m < 4; ++m) { const int r = ai * HALF + wr * 64 + m * 16 + fr; const f32x2v sr = S[r]; const size_t off = (size_t)(u.pm * BM + r) * ldc + col0;
#pragma unroll
                for (int bj = 0; bj < 2; ++bj)
#pragma unroll
                    for (int n = 0; n < 2; ++n) { const f32x4 x1 = acc[ai][bj][m][n]; *(f32x4*)(out + off + bj * HALF + n * 16) = bad1 ? (f32x4){qnan, qnan, qnan, qnan} : x1;
                        const f32x4 o = (x1 - sr.x) * sr.y; u32x2v w; w.x = cvt_pk_bf16(o[0], o[1]); w.y = cvt_pk_bf16(o[2], o[3]);
                        if (bad) { w.x = 0x7fc07fc0u; w.y = 0x7fc07fc0u; } *(u32x2v*)(xn + off + bj * HALF + n * 16) = w; }
                asm volatile("" ::: "memory"); }
    }
};

template <class Epi, class Sched, bool ALIGN_EPI = false, bool SP2 = false>
__device__ __forceinline__ void gemm_phase(PG8_LAS unsigned char* lds, const Gemm g, const Sched S, const Epi E) {
    const int tid = threadIdx.x, wid = __builtin_amdgcn_readfirstlane(tid >> 6), lane = tid & 63, wr = wid >> 2, wc = wid & 3, fr = lane & 15, fq = lane >> 4;
    const int K = g.K, nt = K / BK;
    unsigned voffA[2], voffB[2];
#pragma unroll
    for (int i = 0; i < 2; ++i) { int R, C; stage_rc(tid * 16 + i * 8192, R, C); const int Rb = Epi::PERM ? ((R & ~31) + perm32(R & 31)) : R;
        voffA[i] = (unsigned)(R * g.lda + C) * 2u; voffB[i] = (unsigned)(Rb * K + C) * 2u; }
    const size_t kstep = (size_t)(BK * 2);
    const size_t hstep = (size_t)HALF * K * 2;
    const size_t tstep = 2 * hstep;
    const size_t hstepA = (size_t)HALF * g.lda * 2, tstepA = 2 * hstepA;
    const unsigned ldsw = (unsigned)wid * 1024u;
    const int aoff = lds_byte(wr * 64 + fr, fq * 8), boff = lds_byte(wc * 32 + fr, fq * 8);
#define PG8_SA(b, h) (((b) * 2 + (h)) * HTB)
#define PG8_SB(b, h) ((4 + (b) * 2 + (h)) * HTB)
#define PG8_STAGE(bufoff, gbase, voff) do { _Pragma("unroll") for (int _i = 0; _i < 2; ++_i) \
        __builtin_amdgcn_global_load_lds((const unsigned*)((const char*)(gbase) + (voff)[_i]), (PG8_LAS unsigned*)(lds + (bufoff) + ldsw + _i * 8192), 16, 0, 0); } while (0)
#define PG8_LDA(dst, b, h) do { _Pragma("unroll") for (int m = 0; m < 4; ++m) _Pragma("unroll") for (int k = 0; k < 2; ++k) dst[m][k] = *(const PG8_LAS bf16x8*)(lds + PG8_SA(b, h) + aoff + m * 2048 + k * 1024); } while (0)
#define PG8_LDB(dst, b, h) do { _Pragma("unroll") for (int n = 0; n < 2; ++n) _Pragma("unroll") for (int k = 0; k < 2; ++k) dst[n][k] = *(const PG8_LAS bf16x8*)(lds + PG8_SB(b, h) + boff + n * 2048 + k * 1024); } while (0)
#define PG8_MMA(ai, bj, At, Bt) do { __builtin_amdgcn_s_setprio(1); _Pragma("unroll") for (int m = 0; m < 4; ++m) _Pragma("unroll") for (int n = 0; n < 2; ++n) _Pragma("unroll") for (int k = 0; k < 2; ++k) \
        acc[ai][bj][m][n] = __builtin_amdgcn_mfma_f32_16x16x32_bf16(Bt[n][k], At[m][k], acc[ai][bj][m][n], 0, 0, 0); __builtin_amdgcn_s_setprio(0); } while (0)
#define PG8_WAIT_V(n) asm volatile("s_waitcnt vmcnt(" #n ")" ::: "memory")
#define PG8_WAIT_L(n) asm volatile("s_waitcnt lgkmcnt(" #n ")" ::: "memory")
#define PG8_BAR __builtin_amdgcn_s_barrier()
#define PG8_SCHED __builtin_amdgcn_sched_barrier(0)
    Unit cur, nxt; int ui = 0;
    if (!S.next(0, cur)) return;
    f32x4 acc[2][2][4][2];
#pragma unroll
    for (int a = 0; a < 2; ++a)
#pragma unroll
        for (int b = 0; b < 2; ++b)
#pragma unroll
            for (int m = 0; m < 4; ++m)
#pragma unroll
                for (int n = 0; n < 2; ++n) acc[a][b][m][n] = (f32x4){0.f, 0.f, 0.f, 0.f};
    bf16x8 At[4][2], B0[2][2], B1[2][2];
    const char* cA = (const char*)g.A + (size_t)cur.pm * tstepA; const char* cB = (const char*)g.Bt + (size_t)cur.pn * tstep;
    S.a_ready(cur);
    if constexpr (SP2) {
        PG8_STAGE(PG8_SB(0, 0), cB, voffB); PG8_STAGE(PG8_SB(0, 1), cB + hstep, voffB); PG8_STAGE(PG8_SA(0, 0), cA, voffA); PG8_STAGE(PG8_SA(0, 1), cA + hstepA, voffA);
        if (wr == 1) PG8_BAR;
        PG8_WAIT_V(2); PG8_BAR;
        PG8_STAGE(PG8_SB(1, 0), cB + kstep, voffB); PG8_STAGE(PG8_SA(1, 0), cA + kstep, voffA); PG8_STAGE(PG8_SB(1, 1), cB + hstep + kstep, voffB);
        PG8_WAIT_V(6); PG8_BAR;
    } else {
        PG8_STAGE(PG8_SB(0, 0), cB, voffB); PG8_STAGE(PG8_SA(0, 0), cA, voffA); PG8_STAGE(PG8_SB(0, 1), cB + hstep, voffB); PG8_STAGE(PG8_SA(0, 1), cA + hstepA, voffA);
        if (wr == 1) PG8_BAR;
        PG8_WAIT_V(4); PG8_BAR;
        PG8_STAGE(PG8_SB(1, 0), cB + kstep, voffB); PG8_STAGE(PG8_SA(1, 0), cA + kstep, voffA); PG8_STAGE(PG8_SB(1, 1), cB + hstep + kstep, voffB);
        PG8_WAIT_V(6); PG8_BAR;
    }
    for (;;) {
        const bool has_next = S.next(ui + 1, nxt);
        const char* nA = has_next ? (const char*)g.A + (size_t)nxt.pm * tstepA : cA; const char* nB = has_next ? (const char*)g.Bt + (size_t)nxt.pn * tstep : cB;
        for (int t = 0; t < nt; t += 2) {
            const bool last = (t == nt - 2);
            const char* a1 = cA + (size_t)(t + 1) * kstep;
            const char* a2 = last ? nA : cA + (size_t)(t + 2) * kstep; const char* b2 = last ? nB : cB + (size_t)(t + 2) * kstep;
            const char* a3 = a2 + kstep; const char* b3 = b2 + kstep;
            if (last && has_next) S.a_ready(nxt);
            if constexpr (SP2) {
            PG8_LDB(B0, 0, 0); PG8_LDB(B1, 0, 1); PG8_SCHED; PG8_LDA(At, 0, 0); PG8_STAGE(PG8_SA(1, 1), a1 + hstepA, voffA);
            PG8_WAIT_V(8); PG8_WAIT_L(0); PG8_BAR; PG8_MMA(0, 0, At, B0); PG8_MMA(0, 1, At, B1); PG8_BAR; PG8_SCHED;
            PG8_LDA(At, 0, 1); PG8_STAGE(PG8_SB(0, 0), b2, voffB); PG8_STAGE(PG8_SB(0, 1), b2 + hstep, voffB); PG8_STAGE(PG8_SA(0, 0), a2, voffA);
            PG8_WAIT_V(8); PG8_WAIT_L(0); PG8_BAR; PG8_MMA(1, 0, At, B0); PG8_MMA(1, 1, At, B1); PG8_BAR; PG8_SCHED;
            PG8_LDB(B0, 1, 0); PG8_LDB(B1, 1, 1); PG8_SCHED; PG8_LDA(At, 1, 0); PG8_STAGE(PG8_SA(0, 1), a2 + hstepA, voffA);
            PG8_WAIT_V(8); PG8_WAIT_L(0); PG8_BAR; PG8_MMA(0, 0, At, B0); PG8_MMA(0, 1, At, B1); PG8_BAR; PG8_SCHED;
            PG8_LDA(At, 1, 1); PG8_STAGE(PG8_SB(1, 0), b3, voffB); PG8_STAGE(PG8_SB(1, 1), b3 + hstep, voffB); PG8_STAGE(PG8_SA(1, 0), a3, voffA);
            PG8_WAIT_V(8); PG8_WAIT_L(0); PG8_BAR; PG8_MMA(1, 0, At, B0); PG8_MMA(1, 1, At, B1); PG8_BAR; PG8_SCHED;
            } else {
            PG8_LDB(B0, 0, 0); PG8_SCHED; PG8_LDA(At, 0, 0); PG8_STAGE(PG8_SA(1, 1), a1 + hstepA, voffA);
            PG8_WAIT_L(8); PG8_BAR; PG8_WAIT_L(0); PG8_MMA(0, 0, At, B0); PG8_BAR; PG8_SCHED;
            PG8_LDB(B1, 0, 1); PG8_STAGE(PG8_SB(0, 0), b2, voffB);
            PG8_BAR; PG8_WAIT_L(0); PG8_MMA(0, 1, At, B1); PG8_BAR;
            PG8_LDA(At, 0, 1); PG8_STAGE(PG8_SA(0, 0), a2, voffA);
            PG8_BAR; PG8_WAIT_L(0); PG8_MMA(1, 0, At, B0); PG8_BAR; PG8_SCHED;
            PG8_STAGE(PG8_SB(0, 1), b2 + hstep, voffB);
            PG8_WAIT_V(6); PG8_BAR; PG8_MMA(1, 1, At, B1); PG8_BAR;
            PG8_LDB(B0, 1, 0); PG8_SCHED; PG8_LDA(At, 1, 0); PG8_STAGE(PG8_SA(0, 1), a2 + hstepA, voffA);
            PG8_WAIT_L(8); PG8_BAR; PG8_WAIT_L(0); PG8_MMA(0, 0, At, B0); PG8_BAR; PG8_SCHED;
            PG8_LDB(B1, 1, 1); PG8_STAGE(PG8_SB(1, 0), b3, voffB);
            PG8_BAR; PG8_WAIT_L(0); PG8_MMA(0, 1, At, B1); PG8_BAR;
            PG8_LDA(At, 1, 1); PG8_STAGE(PG8_SA(1, 0), a3, voffA);
            PG8_BAR; PG8_WAIT_L(0); PG8_MMA(1, 0, At, B0); PG8_BAR; PG8_SCHED;
            PG8_STAGE(PG8_SB(1, 1), b3 + hstep, voffB);
            PG8_WAIT_V(6); PG8_BAR; PG8_MMA(1, 1, At, B1); PG8_BAR;
            }
        }
        if constexpr (ALIGN_EPI) { if (wr == 0) PG8_BAR; }
        if constexpr (!Epi::AFTER_DRAIN) { E(acc, cur, wr, wc, fr, fq); S.done(cur); }
        if (!has_next) break;
#pragma unroll
        for (int a = 0; a < 2; ++a)
#pragma unroll
            for (int b = 0; b < 2; ++b)
#pragma unroll
                for (int m = 0; m < 4; ++m)
#pragma unroll
                    for (int n = 0; n < 2; ++n) acc[a][b][m][n] = (f32x4){0.f, 0.f, 0.f, 0.f};
        cur = nxt; cA = nA; cB = nB; ++ui;
        if constexpr (ALIGN_EPI) { if (wr == 1) PG8_BAR; }
    }
    PG8_WAIT_V(0);
    if constexpr (!ALIGN_EPI) { if (wr == 0) PG8_BAR; }
    PG8_BAR;
    if constexpr (Epi::AFTER_DRAIN) { E.fused(acc, cur, wr, wc, fr, fq, lds, wid, lane); S.done(cur); }
#undef PG8_SA
#undef PG8_SB
#undef PG8_STAGE
#undef PG8_LDA
#undef PG8_LDB
#undef PG8_MMA
#undef PG8_WAIT_V
#undef PG8_WAIT_L
#undef PG8_BAR
#undef PG8_SCHED
}
}

#ifndef GEMM_SP2
#define GEMM_SP2 true
#endif
#ifndef GEMM_ALIGN
#define GEMM_ALIGN true
#endif
namespace mk {
#define LAS __attribute__((address_space(3)))
using pg8::bf16_t; using pg8::bf16x8; using pg8::f32x4; using pg8::u32x4;
typedef unsigned u32x2 __attribute__((ext_vector_type(2)));

constexpr int DM = 1024, SEQ = 8192, NBATCH = 4, MPR = NBATCH * SEQ, MSAMP = 128, MREAL = MPR + MSAMP, MPAD = 33024;
constexpr int DFF = 2816, PW = 2816, NINP = 3072, CONVC = 1536;
constexpr float EPS = 1e-6f;
#ifndef SCAN_CW
#define SCAN_CW 2
#endif
constexpr int CW = SCAN_CW, NSCAN = 128 / CW;
constexpr int LDS_PHASE_BYTES = 155648, LDS_BYTES = LDS_PHASE_BYTES + 256;

constexpr size_t O_YP = 0, O_YS = 33554432, O_KP = 33685504, O_VP = 33751040, O_CP = 33816576, O_GP = 33835008,
                 O_KS = 34097152, O_VS = 36194304, O_CS = 38291456, O_GS = 38881280;
constexpr size_t MiB = 1u << 20;
constexpr size_t WS_CTL = 0, CTL_ZERO_BYTES = 1 * MiB;
constexpr size_t WS_W1IN = 1 * MiB, WS_W1OUT = 12 * MiB, WS_WINMIX = 18 * MiB, WS_WOUTMIX = 24 * MiB, WS_W2IN = 26 * MiB, WS_W2OUT = 37 * MiB;
constexpr size_t WS_GBA = 43 * MiB, WS_XN = 45 * MiB, WS_XN2 = 110 * MiB, WS_H = 175 * MiB, WS_GM = 353 * MiB, WS_GN = 417 * MiB;
constexpr size_t WS_GQ = 110 * MiB, WS_GO = 142 * MiB;
constexpr size_t WS_SSP1 = 481 * MiB, WS_SSP2 = 484 * MiB;
constexpr size_t WS_END = 487 * MiB;
constexpr size_t CTL_BAR = 0, CTL_BAR_BYTES = 16384, CTL_GLAST = 768 * 1024;

struct Params { const float* in[21]; float* out; unsigned char* ws; };

typedef float f32x2v __attribute__((ext_vector_type(2)));
typedef __bf16 bf16x2v __attribute__((ext_vector_type(2)));
__device__ __forceinline__ unsigned cvt_pk(float lo, float hi) { const f32x2v v = {lo, hi}; const bf16x2v b = __builtin_convertvector(v, bf16x2v); return __builtin_bit_cast(unsigned, b); }
__device__ __forceinline__ bf16_t f2bf(float f) { return (bf16_t)(cvt_pk(f, 0.f) & 0xffffu); }
__device__ __forceinline__ float bf2f(bf16_t h) { return __uint_as_float(((unsigned)h) << 16); }
__device__ __forceinline__ float bflo(unsigned w) { return __uint_as_float(w << 16); }
__device__ __forceinline__ float bfhi(unsigned w) { return __uint_as_float(w & 0xffff0000u); }
__device__ __forceinline__ float silu(float x) { return x * __builtin_amdgcn_rcpf(1.0f + __expf(-x)); }
__device__ __forceinline__ float wave_sum(float v) {
#pragma unroll
    for (int o = 1; o < 64; o <<= 1) v += __shfl_xor(v, o);
    return v;
}
__device__ __forceinline__ float wave_max(float v) {
#pragma unroll
    for (int o = 1; o < 64; o <<= 1) v = fmaxf(v, __shfl_xor(v, o));
    return v;
}
__device__ __forceinline__ float row16_sum(float v) {
    v += __builtin_bit_cast(float, __builtin_amdgcn_update_dpp(0, __builtin_bit_cast(int, v), 0xB1, 0xF, 0xF, true));
    v += __builtin_bit_cast(float, __builtin_amdgcn_update_dpp(0, __builtin_bit_cast(int, v), 0x4E, 0xF, 0xF, true));
    v += __builtin_bit_cast(float, __builtin_amdgcn_update_dpp(0, __builtin_bit_cast(int, v), 0x141, 0xF, 0xF, true));
    v += __builtin_bit_cast(float, __builtin_amdgcn_update_dpp(0, __builtin_bit_cast(int, v), 0x140, 0xF, 0xF, true));
    return v;
}
__device__ __forceinline__ f32x4 mfma16(bf16x8 a, bf16x8 b, f32x4 c) { return __builtin_amdgcn_mfma_f32_16x16x32_bf16(a, b, c, 0, 0, 0); }

__device__ __forceinline__ float row_rstd(const float* ssp, int r) {
    if (r >= MREAL) return 0.f;
    const f32x4 a = *(const f32x4*)(ssp + (size_t)r * 16), b = *(const f32x4*)(ssp + (size_t)r * 16 + 4), c = *(const f32x4*)(ssp + (size_t)r * 16 + 8), d = *(const f32x4*)(ssp + (size_t)r * 16 + 12);
    const float s = (((a[0] + a[1]) + (a[2] + a[3])) + ((b[0] + b[1]) + (b[2] + b[3]))) + (((c[0] + c[1]) + (c[2] + c[3])) + ((d[0] + d[1]) + (d[2] + d[3])));
    return rsqrtf(s * (1.0f / DM) + EPS);
}
__device__ __forceinline__ float row_rstd4(const float* ssp, int r, int fq) {
    const f32x4 a = *(const f32x4*)(ssp + (size_t)r * 16 + 4 * fq);
    float s = (a[0] + a[1]) + (a[2] + a[3]);
    s += __shfl_xor(s, 16); s += __shfl_xor(s, 32);
    return rsqrtf(s * (1.0f / DM) + EPS);
}
__device__ __forceinline__ void swiglu2(float g0, float u0, float g1, float u1, float& h0, float& h1) {
    const float c0 = fmaxf(g0, -40.f), c1 = fmaxf(g1, -40.f);
    const float a = 1.0f + __expf(-c0), b = 1.0f + __expf(-c1), r = __builtin_amdgcn_rcpf(a * b);
    h0 = c0 * (r * b) * u0; h1 = c1 * (r * a) * u1;
}
struct EpiSwiglu {
    static constexpr bool PERM = true, AFTER_DRAIN = false;
    bf16_t* H; const float* ss;
    __device__ __forceinline__ void operator()(const f32x4 (&acc)[2][2][4][2], const pg8::Unit& u, int wr, int wc, int fr, int fq) const {
        const int row0 = u.pm * 256 + wr * 64 + fr, col0 = u.pn * 128 + wc * 32 + 8 * fq;
#pragma unroll
        for (int ai = 0; ai < 2; ++ai)
#pragma unroll
            for (int m = 0; m < 4; ++m) {
                const int r = row0 + ai * 128 + m * 16;
                const float rs = ss ? row_rstd4(ss, r, fq) : 1.0f;
                float h[8];
#pragma unroll
                for (int n = 0; n < 2; ++n)
#pragma unroll
                    for (int j = 0; j < 4; j += 2) swiglu2(acc[ai][0][m][n][j] * rs, acc[ai][1][m][n][j] * rs, acc[ai][0][m][n][j + 1] * rs, acc[ai][1][m][n][j + 1] * rs, h[n * 4 + j], h[n * 4 + j + 1]);
                u32x4 w; w.x = cvt_pk(h[0], h[1]); w.y = cvt_pk(h[2], h[3]); w.z = cvt_pk(h[4], h[5]); w.w = cvt_pk(h[6], h[7]);
                *(u32x4*)(H + (size_t)r * DFF + col0) = w;
            }
    }
};
template <bool RESB16, bool WF32, bool WB16, bool SUMSQ, bool HALF> struct EpiResid {
    static constexpr bool PERM = true, AFTER_DRAIN = false;
    const void* resP; const void* resS; float* Yo; bf16_t* XBo; float* sso;
    __device__ __forceinline__ void operator()(const f32x4 (&acc)[2][2][4][2], const pg8::Unit& u, int wr, int wc, int fr, int fq) const {
        const int row0 = u.pm * 256 + wr * 64 + fr, col0 = u.pn * 256 + wc * 32 + 8 * fq;
        const char* const rP = (const char*)resP; const char* const rS = (const char*)resS - (size_t)MPR * DM * (RESB16 ? 2 : 4);
        float* const Y = Yo; const float scale = HALF ? 0.5f : 1.0f; bf16_t* const XB = XBo; float* const ss = sso;
#pragma unroll
        for (int ai = 0; ai < 2; ++ai)
#pragma unroll
            for (int m = 0; m < 4; ++m) {
                const int r = row0 + ai * 128 + m * 16; float s = 0.f;
                if (r < MREAL) {
                    const char* rp = ((r < MPR) ? rP : rS) + (size_t)r * DM * (RESB16 ? 2 : 4);
#pragma unroll
                    for (int bj = 0; bj < 2; ++bj) {
                        const int c = col0 + bj * 128;
                        f32x4 r0, r1;
                        if (RESB16) { const u32x4 w = *(const u32x4*)(rp + (size_t)c * 2); r0 = (f32x4){bflo(w.x), bfhi(w.x), bflo(w.y), bfhi(w.y)}; r1 = (f32x4){bflo(w.z), bfhi(w.z), bflo(w.w), bfhi(w.w)}; }
                        else { r0 = *(const f32x4*)(rp + (size_t)c * 4); r1 = *(const f32x4*)(rp + (size_t)c * 4 + 16); }
                        const f32x4 v0 = r0 + acc[ai][bj][m][0] * scale, v1 = r1 + acc[ai][bj][m][1] * scale;
                        if (WF32) { *(f32x4*)(Y + (size_t)r * DM + c) = v0; *(f32x4*)(Y + (size_t)r * DM + c + 4) = v1; }
                        if (WB16) { u32x4 w; w.x = cvt_pk(v0[0], v0[1]); w.y = cvt_pk(v0[2], v0[3]); w.z = cvt_pk(v1[0], v1[1]); w.w = cvt_pk(v1[2], v1[3]);
                            *(u32x4*)(XB + (size_t)r * DM + c) = w; }
                        if (SUMSQ) s += (v0[0] * v0[0] + v0[1] * v0[1]) + (v0[2] * v0[2] + v0[3] * v0[3]) + (v1[0] * v1[0] + v1[1] * v1[1]) + (v1[2] * v1[2] + v1[3] * v1[3]);
                    }
                }
                if (SUMSQ) { s += __shfl_xor(s, 16); s += __shfl_xor(s, 32); if (fq == 0 && r < MREAL) ss[(size_t)r * 16 + u.pn * 4 + wc] = s; }
            }
    }
};
struct EpiInproj {
    static constexpr bool PERM = true, AFTER_DRAIN = false;
    bf16_t* P; float* gba; const float* ss;
    __device__ __forceinline__ void operator()(const f32x4 (&acc)[2][2][4][2], const pg8::Unit& u, int wr, int wc, int fr, int fq) const {
        const int row0 = u.pm * 256 + wr * 64 + fr, col0 = u.pn * 256 + wc * 32 + 8 * fq;
#pragma unroll
        for (int ai = 0; ai < 2; ++ai)
#pragma unroll
            for (int m = 0; m < 4; ++m) {
                const int r = row0 + ai * 128 + m * 16;
                const float rs = row_rstd4(ss, r, fq);
                if (u.pn < 11) {
#pragma unroll
                    for (int bj = 0; bj < 2; ++bj) { const f32x4 v0 = acc[ai][bj][m][0] * rs, v1 = acc[ai][bj][m][1] * rs;
                        u32x4 w; w.x = cvt_pk(v0[0], v0[1]); w.y = cvt_pk(v0[2], v0[3]); w.z = cvt_pk(v1[0], v1[1]); w.w = cvt_pk(v1[2], v1[3]);
                        *(u32x4*)(P + (size_t)r * PW + col0 + bj * 128) = w; }
                } else if (wc == 0 && fq == 0) {
                    *(f32x4*)(gba + (size_t)r * 8) = acc[ai][0][m][0] * rs; *(f32x4*)(gba + (size_t)r * 8 + 4) = acc[ai][0][m][1] * rs;
                }
            }
    }
};


template <int NT, bool SS>
__device__ __forceinline__ void skinny_mm(const bf16_t* A, int lda, const bf16_t* W, int K, int wrow0, int wrow1, int wid, int fr, int fq, f32x4 (&acc)[NT], float& ss, LAS unsigned char* lds) {
    const int lane = fq * 16 + fr, kper = K >> 3, nks = kper >> 5;
    const bf16_t* ap = A + (size_t)fr * lda + wid * kper + 8 * fq;
    const bf16_t* w0 = W + (size_t)(wrow0 + fr) * K + wid * kper + 8 * fq; const bf16_t* w1 = W + (size_t)(wrow1 + fr) * K + wid * kper + 8 * fq;
    f32x4 pa[NT][8]; float sp[8];
#pragma unroll
    for (int mt = 0; mt < 8; ++mt) { sp[mt] = 0.f;
#pragma unroll
        for (int nt = 0; nt < NT; ++nt) pa[nt][mt] = (f32x4){0.f, 0.f, 0.f, 0.f}; }
#pragma unroll 2
    for (int ks = 0; ks < nks; ++ks) {
        const bf16x8 b0 = *(const bf16x8*)(w0 + 32 * ks); bf16x8 b1 = b0; if (NT == 2) b1 = *(const bf16x8*)(w1 + 32 * ks);
        bf16x8 av[8];
#pragma unroll
        for (int mt = 0; mt < 8; ++mt) av[mt] = *(const bf16x8*)(ap + (size_t)(16 * mt) * lda + 32 * ks);
#pragma unroll
        for (int mt = 0; mt < 8; ++mt) {
            pa[0][mt] = mfma16(b0, av[mt], pa[0][mt]);
            if (NT == 2) pa[NT - 1][mt] = mfma16(b1, av[mt], pa[NT - 1][mt]);
            if (SS) { const u32x4 u = __builtin_bit_cast(u32x4, av[mt]);
#pragma unroll
                for (int k = 0; k < 4; ++k) { const float lo = bflo(u[k]), hi = bfhi(u[k]); sp[mt] += lo * lo + hi * hi; } }
        }
    }
    LAS f32x4* red = (LAS f32x4*)lds;
    LAS float* sred = (LAS float*)(lds + 8 * NT * 8 * 64 * 16);
#pragma unroll
    for (int mt = 0; mt < 8; ++mt) {
#pragma unroll
        for (int nt = 0; nt < NT; ++nt) red[((wid * NT + nt) * 8 + mt) * 64 + lane] = pa[nt][mt];
        if (SS) sred[(wid * 8 + mt) * 64 + lane] = sp[mt];
    }
    __syncthreads();
    float s = 0.f;
#pragma unroll
    for (int nt = 0; nt < NT; ++nt) acc[nt] = (f32x4){0.f, 0.f, 0.f, 0.f};
#pragma unroll
    for (int v = 0; v < 8; ++v) {
#pragma unroll
        for (int nt = 0; nt < NT; ++nt) acc[nt] += red[((v * NT + nt) * 8 + wid) * 64 + lane];
        if (SS) s += sred[(v * 8 + wid) * 64 + lane];
    }
    if (SS) { s += __shfl_xor(s, 16); s += __shfl_xor(s, 32); }
    ss = s;
    __syncthreads();
}
template <bool SS> __device__ __forceinline__ void sk_ffn_in(const bf16_t* X, const bf16_t* Wt, bf16_t* H, int slab, int wid, int fr, int fq, LAS unsigned char* lds) {
    const int j0 = 16 * slab, wr0 = (j0 >> 7) * 256 + (j0 & 127);
    f32x4 acc[2]; float ss;
    skinny_mm<2, SS>(X + (size_t)MPR * DM, DM, Wt, DM, wr0, wr0 + 128, wid, fr, fq, acc, ss, lds);
    const float rs = SS ? rsqrtf(ss * (1.0f / DM) + EPS) : 1.0f;
    float h[4];
#pragma unroll
    for (int e = 0; e < 4; ++e) h[e] = silu(acc[0][e] * rs) * (acc[1][e] * rs);
    u32x2 w; w.x = cvt_pk(h[0], h[1]); w.y = cvt_pk(h[2], h[3]);
    *(u32x2*)(H + (size_t)(MPR + 16 * wid + fr) * DFF + j0 + 4 * fq) = w;
}
template <bool OUTF32> __device__ __forceinline__ void sk_ffn_out(const bf16_t* Hb, const bf16_t* Wt, const float* resf, float* outf, bf16_t* outb, int slab, int wid, int fr, int fq, LAS unsigned char* lds) {
    f32x4 acc[1]; float ss;
    skinny_mm<1, false>(Hb + (size_t)MPR * DFF, DFF, Wt, DFF, 16 * slab, 0, wid, fr, fq, acc, ss, lds);
    const int rl = 16 * wid + fr, c = 16 * slab + 4 * fq;
    f32x4 rv;
    if (OUTF32) { const u32x2 xr = *(const u32x2*)((const bf16_t*)resf + (size_t)rl * DM + c); rv = (f32x4){bflo(xr.x), bfhi(xr.x), bflo(xr.y), bfhi(xr.y)}; }
    else rv = *(const f32x4*)(resf + (size_t)rl * DM + c);
    const f32x4 v = rv + acc[0] * 0.5f;
    { u32x2 w; w.x = cvt_pk(v[0], v[1]); w.y = cvt_pk(v[2], v[3]); *(u32x2*)(outb + (size_t)rl * DM + c) = w; }
}
__device__ __forceinline__ void sk_inproj(const bf16_t* X, const bf16_t* Wt, bf16_t* P, float* gba, int slab, int wid, int fr, int fq, LAS unsigned char* lds) {
    const int n0 = 32 * slab; f32x4 acc[2]; float ss;
    skinny_mm<2, true>(X + (size_t)MPR * DM, DM, Wt, DM, n0, n0 + 16, wid, fr, fq, acc, ss, lds);
    const float rs = rsqrtf(ss * (1.0f / DM) + EPS); const int r = MPR + 16 * wid + fr;
    if (n0 < PW) {
#pragma unroll
        for (int nt = 0; nt < 2; ++nt) { const f32x4 v = acc[nt] * rs; u32x2 w; w.x = cvt_pk(v[0], v[1]); w.y = cvt_pk(v[2], v[3]); *(u32x2*)(P + (size_t)r * PW + n0 + 16 * nt + 4 * fq) = w; }
    } else if (fq < 2) *(f32x4*)(gba + (size_t)r * 8 + 4 * fq) = acc[0] * rs;
}
__device__ __forceinline__ void sk_outproj(const bf16_t* Pm, const bf16_t* Wt, const bf16_t* X1b, float* X2f, bf16_t* X2b, int slab, int wid, int fr, int fq, LAS unsigned char* lds) {
    const int n0 = 32 * slab; f32x4 acc[2]; float ss;
    skinny_mm<2, false>(Pm + (size_t)MPR * PW, PW, Wt, DM, n0, n0 + 16, wid, fr, fq, acc, ss, lds);
    const int r = MPR + 16 * wid + fr;
#pragma unroll
    for (int nt = 0; nt < 2; ++nt) { const int c = n0 + 16 * nt + 4 * fq; const u32x2 xr = *(const u32x2*)(X1b + (size_t)r * DM + c);
        const f32x4 v = (f32x4){bflo(xr.x), bfhi(xr.x), bflo(xr.y), bfhi(xr.y)} + acc[nt];
        u32x2 w; w.x = cvt_pk(v[0], v[1]); w.y = cvt_pk(v[2], v[3]); *(u32x2*)(X2b + (size_t)r * DM + c) = w; }
}

__device__ __forceinline__ void transpose_item(const float* W, int K, int N, bf16_t* WT, int k0, int n0, int drow0, const float* gs, LAS float* scr, int lane) {
    float wv[32];
#pragma unroll
    for (int i = 0; i < 32; ++i) { const int kk = 2 * i + (lane >> 5), n = n0 + (lane & 31); wv[i] = (n < N) ? W[(size_t)(k0 + kk) * N + n] : 0.f; }
#pragma unroll
    for (int i = 0; i < 32; ++i) { const int kk = 2 * i + (lane >> 5); float v = wv[i]; if (gs) v *= gs[k0 + kk]; scr[kk * 33 + (lane & 31)] = v; }
    asm volatile("s_waitcnt lgkmcnt(0)" ::: "memory");
    const int c = lane & 7;
#pragma unroll
    for (int j = 0; j < 4; ++j) { const int nn = (lane >> 3) + 8 * j; const LAS float* s = scr + (8 * c) * 33 + nn;
        u32x4 o; o.x = cvt_pk(s[0 * 33], s[1 * 33]); o.y = cvt_pk(s[2 * 33], s[3 * 33]); o.z = cvt_pk(s[4 * 33], s[5 * 33]); o.w = cvt_pk(s[6 * 33], s[7 * 33]);
        *(u32x4*)(WT + (size_t)(drow0 + nn) * K + k0 + 8 * c) = o; }
    asm volatile("s_waitcnt lgkmcnt(0)" ::: "memory");
}
__device__ __forceinline__ int map_ffin_row(int n0) { return n0 < DFF ? (n0 >> 7) * 256 + (n0 & 127) : ((n0 - DFF) >> 7) * 256 + 128 + ((n0 - DFF) & 127); }

__device__ __forceinline__ void p0_prologue(const Params& p, LAS unsigned char* lds, int vb, int G) {
    const int tid = threadIdx.x, lane = tid & 63, wid = tid >> 6;
    LAS float* scr = (LAS float*)(lds + wid * 16384);
    const int gw = vb * 8 + wid, NGW = G * 8;
    bf16_t* W1IN = (bf16_t*)(p.ws + WS_W1IN); bf16_t* W1OUT = (bf16_t*)(p.ws + WS_W1OUT); bf16_t* WINMIX = (bf16_t*)(p.ws + WS_WINMIX);
    bf16_t* WOUTMIX = (bf16_t*)(p.ws + WS_WOUTMIX); bf16_t* W2IN = (bf16_t*)(p.ws + WS_W2IN); bf16_t* W2OUT = (bf16_t*)(p.ws + WS_W2OUT);
    constexpr int I_FIN = 16 * 176, I_FOUT = 44 * 32, I_INMIX = 16 * 89, I_OUTMIX = 16 * 32;
    constexpr int NITEMS = 2 * I_FIN + 2 * I_FOUT + I_INMIX + I_OUTMIX;
    for (int it = gw; it < NITEMS; it += NGW) {
        int r = it;
        if (r < I_FIN) { const int kb = r / 176, nb = r % 176; transpose_item(p.in[7], DM, 2 * DFF, W1IN, kb * 64, nb * 32, map_ffin_row(nb * 32), nullptr, scr, lane); continue; } r -= I_FIN;
        if (r < I_FIN) { const int kb = r / 176, nb = r % 176; transpose_item(p.in[18], DM, 2 * DFF, W2IN, kb * 64, nb * 32, map_ffin_row(nb * 32), p.in[17], scr, lane); continue; } r -= I_FIN;
        if (r < I_FOUT) { const int kb = r / 32, nb = r % 32; transpose_item(p.in[8], DFF, DM, W1OUT, kb * 64, nb * 32, nb * 32, nullptr, scr, lane); continue; } r -= I_FOUT;
        if (r < I_FOUT) { const int kb = r / 32, nb = r % 32; transpose_item(p.in[19], DFF, DM, W2OUT, kb * 64, nb * 32, nb * 32, nullptr, scr, lane); continue; } r -= I_FOUT;
        if (r < I_INMIX) { const int kb = r / 89, nb = r % 89; transpose_item(p.in[10], DM, 2824, WINMIX, kb * 64, nb * 32, nb * 32, p.in[9], scr, lane); continue; } r -= I_INMIX;
        { const int kb = r / 32, nb = r % 32; transpose_item(p.in[16], DM, DM, WOUTMIX, kb * 64, nb * 32, nb * 32, nullptr, scr, lane); }
    }
    bf16_t* XN = (bf16_t*)(p.ws + WS_XN); const float* g1 = p.in[6];
    f32x4 gv[4];
#pragma unroll
    for (int j = 0; j < 4; ++j) gv[j] = *((const f32x4*)g1 + lane + 64 * j);
    {
        f32x4 v[4], vn[4];
        int m = gw;
        if (m < MREAL) { const f32x4* xr = (const f32x4*)((m < MPR) ? p.in[0] + (size_t)m * DM : p.in[1] + (size_t)(m - MPR) * DM) + lane;
#pragma unroll
            for (int j = 0; j < 4; ++j) v[j] = xr[64 * j]; }
        for (; m < MREAL; m += NGW) {
            const int mn = m + NGW;
            if (mn < MREAL) { const f32x4* xr = (const f32x4*)((mn < MPR) ? p.in[0] + (size_t)mn * DM : p.in[1] + (size_t)(mn - MPR) * DM) + lane;
#pragma unroll
                for (int j = 0; j < 4; ++j) vn[j] = xr[64 * j]; }
            float s = 0.f;
#pragma unroll
            for (int j = 0; j < 4; ++j) s += (v[j][0] * v[j][0] + v[j][1] * v[j][1]) + (v[j][2] * v[j][2] + v[j][3] * v[j][3]);
            const float rstd = rsqrtf(wave_sum(s) * (1.0f / DM) + EPS);
            unsigned long long* o8 = (unsigned long long*)(XN + (size_t)m * DM) + lane;
#pragma unroll
            for (int j = 0; j < 4; ++j) { const f32x4 y = v[j] * rstd * gv[j];
                o8[64 * j] = (unsigned long long)cvt_pk(y[0], y[1]) | ((unsigned long long)cvt_pk(y[2], y[3]) << 32); }
#pragma unroll
            for (int j = 0; j < 4; ++j) v[j] = vn[j];
        }
    }
}

template <bool SWX = false, bool SWY = false>
__device__ __forceinline__ f32x4 tile_mm(const LAS bf16_t* X, int ldx, int mt, const LAS bf16_t* Y, int ldy, int nt, int nks, int fr, int fq) {
    f32x4 acc = (f32x4){0.f, 0.f, 0.f, 0.f};
    const int rx = 16 * mt + fr, ry = 16 * nt + fr, sx = SWX ? ((rx >> 3) & 7) : 0, sy = SWY ? ((ry >> 3) & 7) : 0;
    const LAS bf16_t* xp = X + rx * ldx; const LAS bf16_t* yp = Y + ry * ldy;
    for (int ks = 0; ks < nks; ++ks) acc = mfma16(*(const LAS bf16x8*)(xp + 8 * ((4 * ks + fq) ^ sx)), *(const LAS bf16x8*)(yp + 8 * ((4 * ks + fq) ^ sy)), acc);
    return acc;
}
constexpr int G1_QS = 0, G1_KS = 17408, G1_VBT = 34816, G1_KBT = 53248, G1_KDT = 71680, G1_UT = 90112, G1_WT = 108544, G1_QK = 126976, G1_TB = 136192, G1_GC = 145408, G1_BETA = 145664, G1_TT = 146176, G1_A10 = 148736, G1_PT = 151296;

__device__ __forceinline__ void gdn_prep_unit(const Params& p, LAS unsigned char* lds, int unit) {
    const int tid = threadIdx.x, lane = tid & 63, wid = tid >> 6, fr = lane & 15, fq = lane >> 4;
    const int bh = unit >> 7, n = unit & 127, b = bh >> 2, h = bh & 3;
    const int tok0 = b * SEQ + n * 64;
    LAS bf16_t* Qs = (LAS bf16_t*)(lds + G1_QS); LAS bf16_t* Ks = (LAS bf16_t*)(lds + G1_KS); LAS bf16_t* VbT = (LAS bf16_t*)(lds + G1_VBT);
    LAS bf16_t* KbT = (LAS bf16_t*)(lds + G1_KBT); LAS bf16_t* KdT = (LAS bf16_t*)(lds + G1_KDT); LAS bf16_t* UT = (LAS bf16_t*)(lds + G1_UT);
    LAS bf16_t* WT = (LAS bf16_t*)(lds + G1_WT); LAS float* Af = (LAS float*)(lds + G1_WT); LAS bf16_t* QK = (LAS bf16_t*)(lds + G1_QK);
    LAS bf16_t* Tb = (LAS bf16_t*)(lds + G1_TB); LAS bf16_t* TT = (LAS bf16_t*)(lds + G1_TT); LAS bf16_t* A10b = (LAS bf16_t*)(lds + G1_A10); LAS bf16_t* PT = (LAS bf16_t*)(lds + G1_PT); LAS float* gcs = (LAS float*)(lds + G1_GC); LAS float* betas = (LAS float*)(lds + G1_BETA);
    const bf16_t* PB = (const bf16_t*)(p.ws + WS_H); const float* GBA = (const float*)(p.ws + WS_GBA);
    LAS unsigned char* raw = lds + G1_UT;
    for (int pc4 = wid; pc4 < 51; pc4 += 8) {
        int pc = pc4 * 4 + (lane >> 4); pc = pc < 200 ? pc : 200;
        const int r = pc / 3, seg = pc - 3 * r; int tt = n * 64 - 3 + r; tt = tt < 0 ? 0 : tt;
        __builtin_amdgcn_global_load_lds((const unsigned*)(PB + (size_t)(b * SEQ + tt) * PW + 768 + seg * 512 + h * 128 + (lane & 15) * 8), (LAS unsigned*)(raw + pc4 * 1024), 16, 0, 0);
    }
    if (tid < 64) {
        const float* gb = GBA + (size_t)(tok0 + tid) * 8;
        const float bt = 1.0f / (1.0f + __expf(-gb[h]));
        const float x = gb[4 + h] + p.in[14][h]; const float sp = x > 20.f ? x : log1pf(__expf(x));
        float c = -__expf(p.in[13][h]) * sp;
#pragma unroll
        for (int o = 1; o < 64; o <<= 1) { const float t = __shfl_up(c, o); if (lane >= o) c += t; }
        gcs[tid] = c; betas[tid] = bt;
    }
    asm volatile("s_waitcnt vmcnt(0)" ::: "memory");
    __syncthreads();
    const float gclast = gcs[63];
    const float* cw = p.in[12];
#pragma unroll 1
    for (int it = 0; it < 6; ++it) {
        const int item = tid + 512 * it, l16 = item & 15, row = item >> 4, which = row >> 6, t = row & 63;
        const int cch = which * 512 + h * 128 + l16 * 8;
        float a[8];
#pragma unroll
        for (int e = 0; e < 8; ++e) a[e] = 0.f;
#pragma unroll
        for (int j = 0; j < 4; ++j) {
            const int tt = n * 64 + t - 3 + j;
            if (tt >= 0) {
                const u32x4 xv = *(const LAS u32x4*)(raw + ((t + j) * 3 + which) * 256 + l16 * 16);
                const f32x4 w0 = *(const f32x4*)(cw + j * CONVC + cch), w1 = *(const f32x4*)(cw + j * CONVC + cch + 4);
                a[0] += w0[0] * bflo(xv.x); a[1] += w0[1] * bfhi(xv.x); a[2] += w0[2] * bflo(xv.y); a[3] += w0[3] * bfhi(xv.y);
                a[4] += w1[0] * bflo(xv.z); a[5] += w1[1] * bfhi(xv.z); a[6] += w1[2] * bflo(xv.w); a[7] += w1[3] * bfhi(xv.w);
            }
        }
        float ss = 0.f;
#pragma unroll
        for (int e = 0; e < 8; ++e) { a[e] = silu(a[e]); ss += a[e] * a[e]; }
        ss = row16_sum(ss);
        const float gct = gcs[t], bt = betas[t];
        const int tsw = (((t >> 3) ^ (l16 & 7)) << 3) | (t & 7);
        if (which == 0) {
            const float sc = rsqrtf(ss + EPS) * 0.08838834764831845f;
            u32x4 w; w.x = cvt_pk(a[0] * sc, a[1] * sc); w.y = cvt_pk(a[2] * sc, a[3] * sc); w.z = cvt_pk(a[4] * sc, a[5] * sc); w.w = cvt_pk(a[6] * sc, a[7] * sc);
            *(LAS u32x4*)(Qs + t * 136 + l16 * 8) = w;
        } else if (which == 1) {
            const float sc = rsqrtf(ss + EPS);
            u32x4 w; w.x = cvt_pk(a[0] * sc, a[1] * sc); w.y = cvt_pk(a[2] * sc, a[3] * sc); w.z = cvt_pk(a[4] * sc, a[5] * sc); w.w = cvt_pk(a[6] * sc, a[7] * sc);
            *(LAS u32x4*)(Ks + t * 136 + l16 * 8) = w;
            const float sb = sc * bt * __expf(gct), sd = sc * __expf(gclast - gct);
#pragma unroll
            for (int e = 0; e < 8; ++e) { KbT[(l16 * 8 + e) * 72 + tsw] = f2bf(a[e] * sb); KdT[(l16 * 8 + e) * 72 + tsw] = f2bf(a[e] * sd); }
        } else {
#pragma unroll
            for (int e = 0; e < 8; ++e) VbT[(l16 * 8 + e) * 72 + tsw] = f2bf(a[e] * bt);
        }
    }
    __syncthreads();
#pragma unroll 2
    for (int r = 0; r < 4; ++r) {
        const int job = wid + 8 * r, kind = job >> 4, tile = job & 15, it = tile >> 2, jt = tile & 3;
        if (kind == 0) {
            if (jt > it) continue;
            const f32x4 acc = tile_mm(Ks, 136, it, Ks, 136, jt, 4, fr, fq);
            const int j = 16 * jt + fr; const float gcj = gcs[j];
            float v[4];
#pragma unroll
            for (int e = 0; e < 4; ++e) { const int i = 16 * it + 4 * fq + e; const bool ok = i > j; v[e] = ok ? acc[e] * __expf(gcs[i] - gcj) * betas[i] : 0.f; }
            *(LAS f32x4*)(Af + j * 68 + 16 * it + 4 * fq) = (f32x4){v[0], v[1], v[2], v[3]};
            if (it >= 2 && jt < 2) {
#pragma unroll
                for (int e = 0; e < 4; ++e) A10b[(16 * (it - 2) + 4 * fq + e) * 40 + j] = f2bf(v[e]); }
        } else {
            const f32x4 acc = tile_mm(Ks, 136, jt, Qs, 136, it, 4, fr, fq);
            const int i = 16 * it + fr; const float gci = gcs[i];
            float v[4];
#pragma unroll
            for (int e = 0; e < 4; ++e) { const int j = 16 * jt + 4 * fq + e; const bool ok = i >= j; v[e] = ok ? acc[e] * __expf(gci - gcs[j]) : 0.f; }
            u32x2 w; w.x = cvt_pk(v[0], v[1]); w.y = cvt_pk(v[2], v[3]); *(LAS u32x2*)(QK + i * 72 + 16 * jt + 4 * fq) = w;
        }
    }
    __syncthreads();
    if (wid < 2) {
        const int ofs = wid * 32, cl = lane & 31; const LAS float* Ab = Af + ofs * 69; LAS bf16_t* Tw = Tb + ofs * 73 + cl; LAS bf16_t* Tt = (wid == 0) ? TT + cl * 40 : PT + cl * 40;
        f32x2v r2[16];
#pragma unroll
        for (int k = 0; k < 16; ++k) r2[k] = (f32x2v){(cl == 2 * k) ? 1.0f : 0.0f, (cl == 2 * k + 1) ? 1.0f : 0.0f};
        const f32x4 a0 = *(const LAS f32x4*)(Ab + 0);
        const f32x4 a1 = *(const LAS f32x4*)(Ab + 4);
        const f32x4 a2 = *(const LAS f32x4*)(Ab + 8);
        const f32x4 a3 = *(const LAS f32x4*)(Ab + 12);
        const f32x4 a4 = *(const LAS f32x4*)(Ab + 16);
        const float t0 = r2[0][0]; const f32x2v T0 = (f32x2v){t0, t0}; Tw[0] = f2bf(t0); Tt[0] = f2bf(t0);
        r2[0] -= (f32x2v){a0[0], a0[1]} * T0; r2[1] -= (f32x2v){a0[2], a0[3]} * T0;
        const f32x4 a5 = *(const LAS f32x4*)(Ab + 20);
        r2[2] -= (f32x2v){a1[0], a1[1]} * T0; r2[3] -= (f32x2v){a1[2], a1[3]} * T0;
        const f32x4 a6 = *(const LAS f32x4*)(Ab + 24);
        r2[4] -= (f32x2v){a2[0], a2[1]} * T0; r2[5] -= (f32x2v){a2[2], a2[3]} * T0;
        const f32x4 a7 = *(const LAS f32x4*)(Ab + 28);
        r2[6] -= (f32x2v){a3[0], a3[1]} * T0; r2[7] -= (f32x2v){a3[2], a3[3]} * T0;
        const f32x4 a8 = *(const LAS f32x4*)(Ab + 68);
        r2[8] -= (f32x2v){a4[0], a4[1]} * T0; r2[9] -= (f32x2v){a4[2], a4[3]} * T0;
        const f32x4 a9 = *(const LAS f32x4*)(Ab + 72);
        r2[10] -= (f32x2v){a5[0], a5[1]} * T0; r2[11] -= (f32x2v){a5[2], a5[3]} * T0;
        const f32x4 a10 = *(const LAS f32x4*)(Ab + 76);
        r2[12] -= (f32x2v){a6[0], a6[1]} * T0; r2[13] -= (f32x2v){a6[2], a6[3]} * T0;
        const f32x4 a11 = *(const LAS f32x4*)(Ab + 80);
        r2[14] -= (f32x2v){a7[0], a7[1]} * T0; r2[15] -= (f32x2v){a7[2], a7[3]} * T0;
        const f32x4 a12 = *(const LAS f32x4*)(Ab + 84);
        const float t1 = r2[0][1]; const f32x2v T1 = (f32x2v){t1, t1}; Tw[72] = f2bf(t1); Tt[1] = f2bf(t1);
        r2[1] -= (f32x2v){a8[2], a8[3]} * T1;
        const f32x4 a13 = *(const LAS f32x4*)(Ab + 88);
        r2[2] -= (f32x2v){a9[0], a9[1]} * T1; r2[3] -= (f32x2v){a9[2], a9[3]} * T1;
        const f32x4 a14 = *(const LAS f32x4*)(Ab + 92);
        r2[4] -= (f32x2v){a10[0], a10[1]} * T1; r2[5] -= (f32x2v){a10[2], a10[3]} * T1;
        const f32x4 a15 = *(const LAS f32x4*)(Ab + 96);
        r2[6] -= (f32x2v){a11[0], a11[1]} * T1; r2[7] -= (f32x2v){a11[2], a11[3]} * T1;
        const f32x4 a16 = *(const LAS f32x4*)(Ab + 136);
        r2[8] -= (f32x2v){a12[0], a12[1]} * T1; r2[9] -= (f32x2v){a12[2], a12[3]} * T1;
        const f32x4 a17 = *(const LAS f32x4*)(Ab + 140);
        r2[10] -= (f32x2v){a13[0], a13[1]} * T1; r2[11] -= (f32x2v){a13[2], a13[3]} * T1;
        const f32x4 a18 = *(const LAS f32x4*)(Ab + 144);
        r2[12] -= (f32x2v){a14[0], a14[1]} * T1; r2[13] -= (f32x2v){a14[2], a14[3]} * T1;
        const f32x4 a19 = *(const LAS f32x4*)(Ab + 148);
        r2[14] -= (f32x2v){a15[0], a15[1]} * T1; r2[15] -= (f32x2v){a15[2], a15[3]} * T1;
        const f32x4 a20 = *(const LAS f32x4*)(Ab + 152);
        const float t2 = r2[1][0]; const f32x2v T2 = (f32x2v){t2, t2}; Tw[144] = f2bf(t2); Tt[2] = f2bf(t2);
        r2[1] -= (f32x2v){a16[2], a16[3]} * T2;
        const f32x4 a21 = *(const LAS f32x4*)(Ab + 156);
        r2[2] -= (f32x2v){a17[0], a17[1]} * T2; r2[3] -= (f32x2v){a17[2], a17[3]} * T2;
        const f32x4 a22 = *(const LAS f32x4*)(Ab + 160);
        r2[4] -= (f32x2v){a18[0], a18[1]} * T2; r2[5] -= (f32x2v){a18[2], a18[3]} * T2;
        const f32x4 a23 = *(const LAS f32x4*)(Ab + 164);
        r2[6] -= (f32x2v){a19[0], a19[1]} * T2; r2[7] -= (f32x2v){a19[2], a19[3]} * T2;
        const f32x4 a24 = *(const LAS f32x4*)(Ab + 208);
        r2[8] -= (f32x2v){a20[0], a20[1]} * T2; r2[9] -= (f32x2v){a20[2], a20[3]} * T2;
        const f32x4 a25 = *(const LAS f32x4*)(Ab + 212);
        r2[10] -= (f32x2v){a21[0], a21[1]} * T2; r2[11] -= (f32x2v){a21[2], a21[3]} * T2;
        const f32x4 a26 = *(const LAS f32x4*)(Ab + 216);
        r2[12] -= (f32x2v){a22[0], a22[1]} * T2; r2[13] -= (f32x2v){a22[2], a22[3]} * T2;
        const f32x4 a27 = *(const LAS f32x4*)(Ab + 220);
        r2[14] -= (f32x2v){a23[0], a23[1]} * T2; r2[15] -= (f32x2v){a23[2], a23[3]} * T2;
        const f32x4 a28 = *(const LAS f32x4*)(Ab + 224);
        const float t3 = r2[1][1]; const f32x2v T3 = (f32x2v){t3, t3}; Tw[216] = f2bf(t3); Tt[3] = f2bf(t3);
        r2[2] -= (f32x2v){a24[0], a24[1]} * T3; r2[3] -= (f32x2v){a24[2], a24[3]} * T3;
        const f32x4 a29 = *(const LAS f32x4*)(Ab + 228);
        r2[4] -= (f32x2v){a25[0], a25[1]} * T3; r2[5] -= (f32x2v){a25[2], a25[3]} * T3;
        const f32x4 a30 = *(const LAS f32x4*)(Ab + 232);
        r2[6] -= (f32x2v){a26[0], a26[1]} * T3; r2[7] -= (f32x2v){a26[2], a26[3]} * T3;
        const f32x4 a31 = *(const LAS f32x4*)(Ab + 276);
        r2[8] -= (f32x2v){a27[0], a27[1]} * T3; r2[9] -= (f32x2v){a27[2], a27[3]} * T3;
        const f32x4 a32 = *(const LAS f32x4*)(Ab + 280);
        r2[10] -= (f32x2v){a28[0], a28[1]} * T3; r2[11] -= (f32x2v){a28[2], a28[3]} * T3;
        const f32x4 a33 = *(const LAS f32x4*)(Ab + 284);
        r2[12] -= (f32x2v){a29[0], a29[1]} * T3; r2[13] -= (f32x2v){a29[2], a29[3]} * T3;
        const f32x4 a34 = *(const LAS f32x4*)(Ab + 288);
        r2[14] -= (f32x2v){a30[0], a30[1]} * T3; r2[15] -= (f32x2v){a30[2], a30[3]} * T3;
        const f32x4 a35 = *(const LAS f32x4*)(Ab + 292);
        const float t4 = r2[2][0]; const f32x2v T4 = (f32x2v){t4, t4}; Tw[288] = f2bf(t4); Tt[4] = f2bf(t4);
        r2[2] -= (f32x2v){a31[0], a31[1]} * T4; r2[3] -= (f32x2v){a31[2], a31[3]} * T4;
        const f32x4 a36 = *(const LAS f32x4*)(Ab + 296);
        r2[4] -= (f32x2v){a32[0], a32[1]} * T4; r2[5] -= (f32x2v){a32[2], a32[3]} * T4;
        const f32x4 a37 = *(const LAS f32x4*)(Ab + 300);
        r2[6] -= (f32x2v){a33[0], a33[1]} * T4; r2[7] -= (f32x2v){a33[2], a33[3]} * T4;
        const f32x4 a38 = *(const LAS f32x4*)(Ab + 344);
        r2[8] -= (f32x2v){a34[0], a34[1]} * T4; r2[9] -= (f32x2v){a34[2], a34[3]} * T4;
        const f32x4 a39 = *(const LAS f32x4*)(Ab + 348);
        r2[10] -= (f32x2v){a35[0], a35[1]} * T4; r2[11] -= (f32x2v){a35[2], a35[3]} * T4;
        const f32x4 a40 = *(const LAS f32x4*)(Ab + 352);
        r2[12] -= (f32x2v){a36[0], a36[1]} * T4; r2[13] -= (f32x2v){a36[2], a36[3]} * T4;
        const f32x4 a41 = *(const LAS f32x4*)(Ab + 356);
        r2[14] -= (f32x2v){a37[0], a37[1]} * T4; r2[15] -= (f32x2v){a37[2], a37[3]} * T4;
        const f32x4 a42 = *(const LAS f32x4*)(Ab + 360);
        const float t5 = r2[2][1]; const f32x2v T5 = (f32x2v){t5, t5}; Tw[360] = f2bf(t5); Tt[5] = f2bf(t5);
        r2[3] -= (f32x2v){a38[2], a38[3]} * T5;
        const f32x4 a43 = *(const LAS f32x4*)(Ab + 364);
        r2[4] -= (f32x2v){a39[0], a39[1]} * T5; r2[5] -= (f32x2v){a39[2], a39[3]} * T5;
        const f32x4 a44 = *(const LAS f32x4*)(Ab + 368);
        r2[6] -= (f32x2v){a40[0], a40[1]} * T5; r2[7] -= (f32x2v){a40[2], a40[3]} * T5;
        const f32x4 a45 = *(const LAS f32x4*)(Ab + 412);
        r2[8] -= (f32x2v){a41[0], a41[1]} * T5; r2[9] -= (f32x2v){a41[2], a41[3]} * T5;
        const f32x4 a46 = *(const LAS f32x4*)(Ab + 416);
        r2[10] -= (f32x2v){a42[0], a42[1]} * T5; r2[11] -= (f32x2v){a42[2], a42[3]} * T5;
        const f32x4 a47 = *(const LAS f32x4*)(Ab + 420);
        r2[12] -= (f32x2v){a43[0], a43[1]} * T5; r2[13] -= (f32x2v){a43[2], a43[3]} * T5;
        const f32x4 a48 = *(const LAS f32x4*)(Ab + 424);
        r2[14] -= (f32x2v){a44[0], a44[1]} * T5; r2[15] -= (f32x2v){a44[2], a44[3]} * T5;
        const f32x4 a49 = *(const LAS f32x4*)(Ab + 428);
        const float t6 = r2[3][0]; const f32x2v T6 = (f32x2v){t6, t6}; Tw[432] = f2bf(t6); Tt[6] = f2bf(t6);
        r2[3] -= (f32x2v){a45[2], a45[3]} * T6;
        const f32x4 a50 = *(const LAS f32x4*)(Ab + 432);
        r2[4] -= (f32x2v){a46[0], a46[1]} * T6; r2[5] -= (f32x2v){a46[2], a46[3]} * T6;
        const f32x4 a51 = *(const LAS f32x4*)(Ab + 436);
        r2[6] -= (f32x2v){a47[0], a47[1]} * T6; r2[7] -= (f32x2v){a47[2], a47[3]} * T6;
        const f32x4 a52 = *(const LAS f32x4*)(Ab + 484);
        r2[8] -= (f32x2v){a48[0], a48[1]} * T6; r2[9] -= (f32x2v){a48[2], a48[3]} * T6;
        const f32x4 a53 = *(const LAS f32x4*)(Ab + 488);
        r2[10] -= (f32x2v){a49[0], a49[1]} * T6; r2[11] -= (f32x2v){a49[2], a49[3]} * T6;
        const f32x4 a54 = *(const LAS f32x4*)(Ab + 492);
        r2[12] -= (f32x2v){a50[0], a50[1]} * T6; r2[13] -= (f32x2v){a50[2], a50[3]} * T6;
        const f32x4 a55 = *(const LAS f32x4*)(Ab + 496);
        r2[14] -= (f32x2v){a51[0], a51[1]} * T6; r2[15] -= (f32x2v){a51[2], a51[3]} * T6;
        const f32x4 a56 = *(const LAS f32x4*)(Ab + 500);
        const float t7 = r2[3][1]; const f32x2v T7 = (f32x2v){t7, t7}; Tw[504] = f2bf(t7); Tt[7] = f2bf(t7);
        r2[4] -= (f32x2v){a52[0], a52[1]} * T7; r2[5] -= (f32x2v){a52[2], a52[3]} * T7;
        const f32x4 a57 = *(const LAS f32x4*)(Ab + 504);
        r2[6] -= (f32x2v){a53[0], a53[1]} * T7; r2[7] -= (f32x2v){a53[2], a53[3]} * T7;
        const f32x4 a58 = *(const LAS f32x4*)(Ab + 552);
        r2[8] -= (f32x2v){a54[0], a54[1]} * T7; r2[9] -= (f32x2v){a54[2], a54[3]} * T7;
        const f32x4 a59 = *(const LAS f32x4*)(Ab + 556);
        r2[10] -= (f32x2v){a55[0], a55[1]} * T7; r2[11] -= (f32x2v){a55[2], a55[3]} * T7;
        const f32x4 a60 = *(const LAS f32x4*)(Ab + 560);
        r2[12] -= (f32x2v){a56[0], a56[1]} * T7; r2[13] -= (f32x2v){a56[2], a56[3]} * T7;
        const f32x4 a61 = *(const LAS f32x4*)(Ab + 564);
        r2[14] -= (f32x2v){a57[0], a57[1]} * T7; r2[15] -= (f32x2v){a57[2], a57[3]} * T7;
        const f32x4 a62 = *(const LAS f32x4*)(Ab + 568);
        const float t8 = r2[4][0]; const f32x2v T8 = (f32x2v){t8, t8}; Tw[576] = f2bf(t8); Tt[8] = f2bf(t8);
        r2[4] -= (f32x2v){a58[0], a58[1]} * T8; r2[5] -= (f32x2v){a58[2], a58[3]} * T8;
        const f32x4 a63 = *(const LAS f32x4*)(Ab + 572);
        r2[6] -= (f32x2v){a59[0], a59[1]} * T8; r2[7] -= (f32x2v){a59[2], a59[3]} * T8;
        const f32x4 a64 = *(const LAS f32x4*)(Ab + 620);
        r2[8] -= (f32x2v){a60[0], a60[1]} * T8; r2[9] -= (f32x2v){a60[2], a60[3]} * T8;
        const f32x4 a65 = *(const LAS f32x4*)(Ab + 624);
        r2[10] -= (f32x2v){a61[0], a61[1]} * T8; r2[11] -= (f32x2v){a61[2], a61[3]} * T8;
        const f32x4 a66 = *(const LAS f32x4*)(Ab + 628);
        r2[12] -= (f32x2v){a62[0], a62[1]} * T8; r2[13] -= (f32x2v){a62[2], a62[3]} * T8;
        const f32x4 a67 = *(const LAS f32x4*)(Ab + 632);
        r2[14] -= (f32x2v){a63[0], a63[1]} * T8; r2[15] -= (f32x2v){a63[2], a63[3]} * T8;
        const f32x4 a68 = *(const LAS f32x4*)(Ab + 636);
        const float t9 = r2[4][1]; const f32x2v T9 = (f32x2v){t9, t9}; Tw[648] = f2bf(t9); Tt[9] = f2bf(t9);
        r2[5] -= (f32x2v){a64[2], a64[3]} * T9;
        const f32x4 a69 = *(const LAS f32x4*)(Ab + 640);
        r2[6] -= (f32x2v){a65[0], a65[1]} * T9; r2[7] -= (f32x2v){a65[2], a65[3]} * T9;
        const f32x4 a70 = *(const LAS f32x4*)(Ab + 688);
        r2[8] -= (f32x2v){a66[0], a66[1]} * T9; r2[9] -= (f32x2v){a66[2], a66[3]} * T9;
        const f32x4 a71 = *(const LAS f32x4*)(Ab + 692);
        r2[10] -= (f32x2v){a67[0], a67[1]} * T9; r2[11] -= (f32x2v){a67[2], a67[3]} * T9;
        const f32x4 a72 = *(const LAS f32x4*)(Ab + 696);
        r2[12] -= (f32x2v){a68[0], a68[1]} * T9; r2[13] -= (f32x2v){a68[2], a68[3]} * T9;
        const f32x4 a73 = *(const LAS f32x4*)(Ab + 700);
        r2[14] -= (f32x2v){a69[0], a69[1]} * T9; r2[15] -= (f32x2v){a69[2], a69[3]} * T9;
        const f32x4 a74 = *(const LAS f32x4*)(Ab + 704);
        const float t10 = r2[5][0]; const f32x2v T10 = (f32x2v){t10, t10}; Tw[720] = f2bf(t10); Tt[10] = f2bf(t10);
        r2[5] -= (f32x2v){a70[2], a70[3]} * T10;
        const f32x4 a75 = *(const LAS f32x4*)(Ab + 708);
        r2[6] -= (f32x2v){a71[0], a71[1]} * T10; r2[7] -= (f32x2v){a71[2], a71[3]} * T10;
        const f32x4 a76 = *(const LAS f32x4*)(Ab + 760);
        r2[8] -= (f32x2v){a72[0], a72[1]} * T10; r2[9] -= (f32x2v){a72[2], a72[3]} * T10;
        const f32x4 a77 = *(const LAS f32x4*)(Ab + 764);
        r2[10] -= (f32x2v){a73[0], a73[1]} * T10; r2[11] -= (f32x2v){a73[2], a73[3]} * T10;
        const f32x4 a78 = *(const LAS f32x4*)(Ab + 768);
        r2[12] -= (f32x2v){a74[0], a74[1]} * T10; r2[13] -= (f32x2v){a74[2], a74[3]} * T10;
        const f32x4 a79 = *(const LAS f32x4*)(Ab + 772);
        r2[14] -= (f32x2v){a75[0], a75[1]} * T10; r2[15] -= (f32x2v){a75[2], a75[3]} * T10;
        const f32x4 a80 = *(const LAS f32x4*)(Ab + 776);
        const float t11 = r2[5][1]; const f32x2v T11 = (f32x2v){t11, t11}; Tw[792] = f2bf(t11); Tt[11] = f2bf(t11);
        r2[6] -= (f32x2v){a76[0], a76[1]} * T11; r2[7] -= (f32x2v){a76[2], a76[3]} * T11;
        const f32x4 a81 = *(const LAS f32x4*)(Ab + 828);
        r2[8] -= (f32x2v){a77[0], a77[1]} * T11; r2[9] -= (f32x2v){a77[2], a77[3]} * T11;
        const f32x4 a82 = *(const LAS f32x4*)(Ab + 832);
        r2[10] -= (f32x2v){a78[0], a78[1]} * T11; r2[11] -= (f32x2v){a78[2], a78[3]} * T11;
        const f32x4 a83 = *(const LAS f32x4*)(Ab + 836);
        r2[12] -= (f32x2v){a79[0], a79[1]} * T11; r2[13] -= (f32x2v){a79[2], a79[3]} * T11;
        const f32x4 a84 = *(const LAS f32x4*)(Ab + 840);
        r2[14] -= (f32x2v){a80[0], a80[1]} * T11; r2[15] -= (f32x2v){a80[2], a80[3]} * T11;
        const f32x4 a85 = *(const LAS f32x4*)(Ab + 844);
        const float t12 = r2[6][0]; const f32x2v T12 = (f32x2v){t12, t12}; Tw[864] = f2bf(t12); Tt[12] = f2bf(t12);
        r2[6] -= (f32x2v){a81[0], a81[1]} * T12; r2[7] -= (f32x2v){a81[2], a81[3]} * T12;
        const f32x4 a86 = *(const LAS f32x4*)(Ab + 896);
        r2[8] -= (f32x2v){a82[0], a82[1]} * T12; r2[9] -= (f32x2v){a82[2], a82[3]} * T12;
        const f32x4 a87 = *(const LAS f32x4*)(Ab + 900);
        r2[10] -= (f32x2v){a83[0], a83[1]} * T12; r2[11] -= (f32x2v){a83[2], a83[3]} * T12;
        const f32x4 a88 = *(const LAS f32x4*)(Ab + 904);
        r2[12] -= (f32x2v){a84[0], a84[1]} * T12; r2[13] -= (f32x2v){a84[2], a84[3]} * T12;
        const f32x4 a89 = *(const LAS f32x4*)(Ab + 908);
        r2[14] -= (f32x2v){a85[0], a85[1]} * T12; r2[15] -= (f32x2v){a85[2], a85[3]} * T12;
        const f32x4 a90 = *(const LAS f32x4*)(Ab + 912);
        const float t13 = r2[6][1]; const f32x2v T13 = (f32x2v){t13, t13}; Tw[936] = f2bf(t13); Tt[13] = f2bf(t13);
        r2[7] -= (f32x2v){a86[2], a86[3]} * T13;
        const f32x4 a91 = *(const LAS f32x4*)(Ab + 964);
        r2[8] -= (f32x2v){a87[0], a87[1]} * T13; r2[9] -= (f32x2v){a87[2], a87[3]} * T13;
        const f32x4 a92 = *(const LAS f32x4*)(Ab + 968);
        r2[10] -= (f32x2v){a88[0], a88[1]} * T13; r2[11] -= (f32x2v){a88[2], a88[3]} * T13;
        const f32x4 a93 = *(const LAS f32x4*)(Ab + 972);
        r2[12] -= (f32x2v){a89[0], a89[1]} * T13; r2[13] -= (f32x2v){a89[2], a89[3]} * T13;
        const f32x4 a94 = *(const LAS f32x4*)(Ab + 976);
        r2[14] -= (f32x2v){a90[0], a90[1]} * T13; r2[15] -= (f32x2v){a90[2], a90[3]} * T13;
        const f32x4 a95 = *(const LAS f32x4*)(Ab + 980);
        const float t14 = r2[7][0]; const f32x2v T14 = (f32x2v){t14, t14}; Tw[1008] = f2bf(t14); Tt[14] = f2bf(t14);
        r2[7] -= (f32x2v){a91[2], a91[3]} * T14;
        const f32x4 a96 = *(const LAS f32x4*)(Ab + 1036);
        r2[8] -= (f32x2v){a92[0], a92[1]} * T14; r2[9] -= (f32x2v){a92[2], a92[3]} * T14;
        const f32x4 a97 = *(const LAS f32x4*)(Ab + 1040);
        r2[10] -= (f32x2v){a93[0], a93[1]} * T14; r2[11] -= (f32x2v){a93[2], a93[3]} * T14;
        const f32x4 a98 = *(const LAS f32x4*)(Ab + 1044);
        r2[12] -= (f32x2v){a94[0], a94[1]} * T14; r2[13] -= (f32x2v){a94[2], a94[3]} * T14;
        const f32x4 a99 = *(const LAS f32x4*)(Ab + 1048);
        r2[14] -= (f32x2v){a95[0], a95[1]} * T14; r2[15] -= (f32x2v){a95[2], a95[3]} * T14;
        const f32x4 a100 = *(const LAS f32x4*)(Ab + 1104);
        const float t15 = r2[7][1]; const f32x2v T15 = (f32x2v){t15, t15}; Tw[1080] = f2bf(t15); Tt[15] = f2bf(t15);
        r2[8] -= (f32x2v){a96[0], a96[1]} * T15; r2[9] -= (f32x2v){a96[2], a96[3]} * T15;
        const f32x4 a101 = *(const LAS f32x4*)(Ab + 1108);
        r2[10] -= (f32x2v){a97[0], a97[1]} * T15; r2[11] -= (f32x2v){a97[2], a97[3]} * T15;
        const f32x4 a102 = *(const LAS f32x4*)(Ab + 1112);
        r2[12] -= (f32x2v){a98[0], a98[1]} * T15; r2[13] -= (f32x2v){a98[2], a98[3]} * T15;
        const f32x4 a103 = *(const LAS f32x4*)(Ab + 1116);
        r2[14] -= (f32x2v){a99[0], a99[1]} * T15; r2[15] -= (f32x2v){a99[2], a99[3]} * T15;
        const f32x4 a104 = *(const LAS f32x4*)(Ab + 1172);
        const float t16 = r2[8][0]; const f32x2v T16 = (f32x2v){t16, t16}; Tw[1152] = f2bf(t16); Tt[16] = f2bf(t16);
        r2[8] -= (f32x2v){a100[0], a100[1]} * T16; r2[9] -= (f32x2v){a100[2], a100[3]} * T16;
        const f32x4 a105 = *(const LAS f32x4*)(Ab + 1176);
        r2[10] -= (f32x2v){a101[0], a101[1]} * T16; r2[11] -= (f32x2v){a101[2], a101[3]} * T16;
        const f32x4 a106 = *(const LAS f32x4*)(Ab + 1180);
        r2[12] -= (f32x2v){a102[0], a102[1]} * T16; r2[13] -= (f32x2v){a102[2], a102[3]} * T16;
        const f32x4 a107 = *(const LAS f32x4*)(Ab + 1184);
        r2[14] -= (f32x2v){a103[0], a103[1]} * T16; r2[15] -= (f32x2v){a103[2], a103[3]} * T16;
        const f32x4 a108 = *(const LAS f32x4*)(Ab + 1240);
        const float t17 = r2[8][1]; const f32x2v T17 = (f32x2v){t17, t17}; Tw[1224] = f2bf(t17); Tt[17] = f2bf(t17);
        r2[9] -= (f32x2v){a104[2], a104[3]} * T17;
        const f32x4 a109 = *(const LAS f32x4*)(Ab + 1244);
        r2[10] -= (f32x2v){a105[0], a105[1]} * T17; r2[11] -= (f32x2v){a105[2], a105[3]} * T17;
        const f32x4 a110 = *(const LAS f32x4*)(Ab + 1248);
        r2[12] -= (f32x2v){a106[0], a106[1]} * T17; r2[13] -= (f32x2v){a106[2], a106[3]} * T17;
        const f32x4 a111 = *(const LAS f32x4*)(Ab + 1252);
        r2[14] -= (f32x2v){a107[0], a107[1]} * T17; r2[15] -= (f32x2v){a107[2], a107[3]} * T17;
        const f32x4 a112 = *(const LAS f32x4*)(Ab + 1312);
        const float t18 = r2[9][0]; const f32x2v T18 = (f32x2v){t18, t18}; Tw[1296] = f2bf(t18); Tt[18] = f2bf(t18);
        r2[9] -= (f32x2v){a108[2], a108[3]} * T18;
        const f32x4 a113 = *(const LAS f32x4*)(Ab + 1316);
        r2[10] -= (f32x2v){a109[0], a109[1]} * T18; r2[11] -= (f32x2v){a109[2], a109[3]} * T18;
        const f32x4 a114 = *(const LAS f32x4*)(Ab + 1320);
        r2[12] -= (f32x2v){a110[0], a110[1]} * T18; r2[13] -= (f32x2v){a110[2], a110[3]} * T18;
        const f32x4 a115 = *(const LAS f32x4*)(Ab + 1380);
        r2[14] -= (f32x2v){a111[0], a111[1]} * T18; r2[15] -= (f32x2v){a111[2], a111[3]} * T18;
        const f32x4 a116 = *(const LAS f32x4*)(Ab + 1384);
        const float t19 = r2[9][1]; const f32x2v T19 = (f32x2v){t19, t19}; Tw[1368] = f2bf(t19); Tt[19] = f2bf(t19);
        r2[10] -= (f32x2v){a112[0], a112[1]} * T19; r2[11] -= (f32x2v){a112[2], a112[3]} * T19;
        const f32x4 a117 = *(const LAS f32x4*)(Ab + 1388);
        r2[12] -= (f32x2v){a113[0], a113[1]} * T19; r2[13] -= (f32x2v){a113[2], a113[3]} * T19;
        const f32x4 a118 = *(const LAS f32x4*)(Ab + 1448);
        r2[14] -= (f32x2v){a114[0], a114[1]} * T19; r2[15] -= (f32x2v){a114[2], a114[3]} * T19;
        const f32x4 a119 = *(const LAS f32x4*)(Ab + 1452);
        const float t20 = r2[10][0]; const f32x2v T20 = (f32x2v){t20, t20}; Tw[1440] = f2bf(t20); Tt[20] = f2bf(t20);
        r2[10] -= (f32x2v){a115[0], a115[1]} * T20; r2[11] -= (f32x2v){a115[2], a115[3]} * T20;
        const f32x4 a120 = *(const LAS f32x4*)(Ab + 1456);
        r2[12] -= (f32x2v){a116[0], a116[1]} * T20; r2[13] -= (f32x2v){a116[2], a116[3]} * T20;
        const f32x4 a121 = *(const LAS f32x4*)(Ab + 1516);
        r2[14] -= (f32x2v){a117[0], a117[1]} * T20; r2[15] -= (f32x2v){a117[2], a117[3]} * T20;
        const f32x4 a122 = *(const LAS f32x4*)(Ab + 1520);
        const float t21 = r2[10][1]; const f32x2v T21 = (f32x2v){t21, t21}; Tw[1512] = f2bf(t21); Tt[21] = f2bf(t21);
        r2[11] -= (f32x2v){a118[2], a118[3]} * T21;
        const f32x4 a123 = *(const LAS f32x4*)(Ab + 1524);
        r2[12] -= (f32x2v){a119[0], a119[1]} * T21; r2[13] -= (f32x2v){a119[2], a119[3]} * T21;
        const f32x4 a124 = *(const LAS f32x4*)(Ab + 1588);
        r2[14] -= (f32x2v){a120[0], a120[1]} * T21; r2[15] -= (f32x2v){a120[2], a120[3]} * T21;
        const f32x4 a125 = *(const LAS f32x4*)(Ab + 1592);
        const float t22 = r2[11][0]; const f32x2v T22 = (f32x2v){t22, t22}; Tw[1584] = f2bf(t22); Tt[22] = f2bf(t22);
        r2[11] -= (f32x2v){a121[2], a121[3]} * T22;
        const f32x4 a126 = *(const LAS f32x4*)(Ab + 1656);
        r2[12] -= (f32x2v){a122[0], a122[1]} * T22; r2[13] -= (f32x2v){a122[2], a122[3]} * T22;
        const f32x4 a127 = *(const LAS f32x4*)(Ab + 1660);
        r2[14] -= (f32x2v){a123[0], a123[1]} * T22; r2[15] -= (f32x2v){a123[2], a123[3]} * T22;
        const f32x4 a128 = *(const LAS f32x4*)(Ab + 1724);
        const float t23 = r2[11][1]; const f32x2v T23 = (f32x2v){t23, t23}; Tw[1656] = f2bf(t23); Tt[23] = f2bf(t23);
        r2[12] -= (f32x2v){a124[0], a124[1]} * T23; r2[13] -= (f32x2v){a124[2], a124[3]} * T23;
        const f32x4 a129 = *(const LAS f32x4*)(Ab + 1728);
        r2[14] -= (f32x2v){a125[0], a125[1]} * T23; r2[15] -= (f32x2v){a125[2], a125[3]} * T23;
        const f32x4 a130 = *(const LAS f32x4*)(Ab + 1792);
        const float t24 = r2[12][0]; const f32x2v T24 = (f32x2v){t24, t24}; Tw[1728] = f2bf(t24); Tt[24] = f2bf(t24);
        r2[12] -= (f32x2v){a126[0], a126[1]} * T24; r2[13] -= (f32x2v){a126[2], a126[3]} * T24;
        const f32x4 a131 = *(const LAS f32x4*)(Ab + 1796);
        r2[14] -= (f32x2v){a127[0], a127[1]} * T24; r2[15] -= (f32x2v){a127[2], a127[3]} * T24;
        const f32x4 a132 = *(const LAS f32x4*)(Ab + 1864);
        const float t25 = r2[12][1]; const f32x2v T25 = (f32x2v){t25, t25}; Tw[1800] = f2bf(t25); Tt[25] = f2bf(t25);
        r2[13] -= (f32x2v){a128[2], a128[3]} * T25;
        const f32x4 a133 = *(const LAS f32x4*)(Ab + 1932);
        r2[14] -= (f32x2v){a129[0], a129[1]} * T25; r2[15] -= (f32x2v){a129[2], a129[3]} * T25;
        const f32x4 a134 = *(const LAS f32x4*)(Ab + 2000);
        const float t26 = r2[13][0]; const f32x2v T26 = (f32x2v){t26, t26}; Tw[1872] = f2bf(t26); Tt[26] = f2bf(t26);
        r2[13] -= (f32x2v){a130[2], a130[3]} * T26;
        const f32x4 a135 = *(const LAS f32x4*)(Ab + 2068);
        r2[14] -= (f32x2v){a131[0], a131[1]} * T26; r2[15] -= (f32x2v){a131[2], a131[3]} * T26;
        const float t27 = r2[13][1]; const f32x2v T27 = (f32x2v){t27, t27}; Tw[1944] = f2bf(t27); Tt[27] = f2bf(t27);
        r2[14] -= (f32x2v){a132[0], a132[1]} * T27; r2[15] -= (f32x2v){a132[2], a132[3]} * T27;
        const float t28 = r2[14][0]; const f32x2v T28 = (f32x2v){t28, t28}; Tw[2016] = f2bf(t28); Tt[28] = f2bf(t28);
        r2[14] -= (f32x2v){a133[0], a133[1]} * T28; r2[15] -= (f32x2v){a133[2], a133[3]} * T28;
        const float t29 = r2[14][1]; const f32x2v T29 = (f32x2v){t29, t29}; Tw[2088] = f2bf(t29); Tt[29] = f2bf(t29);
        r2[15] -= (f32x2v){a134[2], a134[3]} * T29;
        const float t30 = r2[15][0]; const f32x2v T30 = (f32x2v){t30, t30}; Tw[2160] = f2bf(t30); Tt[30] = f2bf(t30);
        r2[15] -= (f32x2v){a135[2], a135[3]} * T30;
        Tw[2232] = f2bf(r2[15][1]); Tt[31] = f2bf(r2[15][1]);
    } else if (wid == 2) {
        *(LAS u32x4*)(Tb + (lane >> 1) * 72 + 32 + (lane & 1) * 16) = (u32x4){0u, 0u, 0u, 0u}; *(LAS u32x4*)(Tb + (lane >> 1) * 72 + 32 + (lane & 1) * 16 + 8) = (u32x4){0u, 0u, 0u, 0u};
    }
    __syncthreads();
    if (wid < 4) {
        const int mt = wid >> 1, nt = wid & 1; const f32x4 acc = tile_mm(A10b, 40, mt, TT, 40, nt, 1, fr, fq);
        u32x2 w; w.x = cvt_pk(acc[0], acc[1]); w.y = cvt_pk(acc[2], acc[3]); *(LAS u32x2*)(PT + (16 * nt + fr) * 40 + 16 * mt + 4 * fq) = w;
    }
    __syncthreads();
    if (wid < 4) {
        const int mt = wid >> 1, nt = wid & 1; const f32x4 acc = tile_mm(Tb + 32 * 72 + 32, 72, mt, PT, 40, nt, 1, fr, fq);
#pragma unroll
        for (int e = 0; e < 4; ++e) Tb[(32 + 16 * mt + 4 * fq + e) * 72 + 16 * nt + fr] = f2bf(-acc[e]);
    }
    __syncthreads();
#pragma unroll 2
    for (int r = 0; r < 8; ++r) {
        const int job = wid + 8 * r, kind = job >> 5, tile = job & 31, mt = tile >> 3, nt = tile & 7;
        const f32x4 acc = tile_mm<false, true>(Tb, 72, mt, kind ? KbT : VbT, 72, nt, 2, fr, fq);
        u32x2 w; w.x = cvt_pk(acc[0], acc[1]); w.y = cvt_pk(acc[2], acc[3]);
        { const int ch = 16 * nt + fr; *(LAS u32x2*)((kind ? WT : UT) + ch * 72 + 8 * ((2 * mt + (fq >> 1)) ^ ((ch >> 3) & 7)) + 4 * (fq & 1)) = w; }
    }
    __syncthreads();
    bf16_t* GM = (bf16_t*)(p.ws + WS_GM) + (size_t)unit * 16384; bf16_t* GN = (bf16_t*)(p.ws + WS_GN) + (size_t)unit * 16384;
    bf16_t* GQ = (bf16_t*)(p.ws + WS_GQ) + (size_t)unit * 8192; bf16_t* GO = (bf16_t*)(p.ws + WS_GO) + (size_t)unit * 8192;
#pragma unroll 2
    for (int r = 0; r < 24; ++r) {
        const int job = wid + 8 * r;
        if (job < 64) { const int a = job >> 3, mt = job & 7;
            const f32x4 acc = tile_mm<true, true>(WT, 72, a, KdT, 72, mt, 2, fr, fq);
            u32x2 w; w.x = cvt_pk(-acc[0], -acc[1]); w.y = cvt_pk(-acc[2], -acc[3]);
            *(u32x2*)(GM + ((mt * 4 + (a >> 1)) * 64 + lane) * 8 + (a & 1) * 4) = w;
        } else if (job < 128) { const int j = job - 64, mt = j >> 3, nt = j & 7;
            const f32x4 acc = tile_mm<true, true>(KdT, 72, mt, UT, 72, nt, 2, fr, fq);
            u32x2 w; w.x = cvt_pk(acc[0], acc[1]); w.y = cvt_pk(acc[2], acc[3]);
            *(u32x2*)(GN + ((nt * 64 + lane) * 8 + mt) * 4) = w;
        } else if (job < 160) { const int j = job - 128, a = j >> 2, it = j & 3;
            const f32x4 acc = tile_mm<true, false>(WT, 72, a, QK, 72, it, 2, fr, fq);
            const int i = 16 * it + fr; const float eg = __expf(gcs[i]);
            const u32x2 qv = *(const LAS u32x2*)(Qs + i * 136 + 16 * a + 4 * fq);
            u32x2 w; w.x = cvt_pk(bflo(qv.x) * eg - acc[0], bfhi(qv.x) * eg - acc[1]); w.y = cvt_pk(bflo(qv.y) * eg - acc[2], bfhi(qv.y) * eg - acc[3]);
            *(u32x2*)(GQ + ((it * 4 + (a >> 1)) * 64 + lane) * 8 + (a & 1) * 4) = w;
        } else { const int j = job - 160, mt = j >> 3, nt = j & 7;
            const f32x4 acc = tile_mm<false, true>(QK, 72, mt, UT, 72, nt, 2, fr, fq);
            u32x2 w; w.x = cvt_pk(acc[0], acc[1]); w.y = cvt_pk(acc[2], acc[3]);
            *(u32x2*)(GO + ((nt * 64 + lane) * 4 + mt) * 4) = w;
        }
    }
    if (tid == 0) ((float*)(p.ws + WS_CTL + CTL_GLAST))[unit] = __expf(gclast);
    __syncthreads();
}

__device__ __forceinline__ void gdn_scan(const Params& p, LAS unsigned char* lds, int sb) {
    const int tid = threadIdx.x, lane = tid & 63, wid = tid >> 6, fr = lane & 15, fq = lane >> 4;
    const int bh = sb / (8 / CW), sp = sb % (8 / CW), unit0 = bh * 128, sl = sp * CW + wid;
    const u32x4* GMb = (const u32x4*)((const bf16_t*)(p.ws + WS_GM) + (size_t)unit0 * 16384);
    const u32x4* GQb = (const u32x4*)((const bf16_t*)(p.ws + WS_GQ) + (size_t)unit0 * 8192);
    const bf16_t* GNb = (const bf16_t*)(p.ws + WS_GN) + (size_t)unit0 * 16384;
    bf16_t* GOb = (bf16_t*)(p.ws + WS_GO) + (size_t)unit0 * 8192;
    const float* glast = (const float*)(p.ws + WS_CTL + CTL_GLAST) + unit0;
    const bool loader = (wid >= CW && wid < CW + 4);
#define SCAN_DMA(cc) do { _Pragma("unroll") for (int k = 0; k < 8; ++k) { const int inst = (wid - CW) * 8 + k; \
        __builtin_amdgcn_global_load_lds((const unsigned*)((const char*)(GMb + (size_t)(cc) * 2048) + inst * 1024 + lane * 16), (LAS unsigned*)(lds + ((cc) & 3) * 32768 + inst * 1024), 16, 0, 0); } } while (0)
#define SCAN_LOADN(dn, cc) do { const bf16_t* np_ = GNb + (size_t)((cc) < 128 ? (cc) : 127) * 16384 + (size_t)(sl * 64 + lane) * 32; \
        asm volatile("global_load_dwordx4 %0, %4, off\n\tglobal_load_dwordx4 %1, %4, off offset:16\n\tglobal_load_dwordx4 %2, %4, off offset:32\n\tglobal_load_dwordx4 %3, %4, off offset:48" \
            : "=&v"(dn[0]), "=&v"(dn[1]), "=&v"(dn[2]), "=&v"(dn[3]) : "v"(np_) : "memory"); } while (0)
#define SCAN_WAITN(dn, N) asm volatile("s_waitcnt vmcnt(" #N ")" : "+v"(dn[0]), "+v"(dn[1]), "+v"(dn[2]), "+v"(dn[3]) :: "memory")
#define SCAN_STEP(c, nn, RELOAD) do { \
        SCAN_WAITN(nn, 8); \
        const float gl = __shfl(((c) < 64) ? glr0 : glr1, (c) & 63); bf16x8 Sb[4]; \
        bf16_t* scp = (bf16_t*)GNb + (size_t)(c) * 16384 + (size_t)sl * 2048 + lane * 8; \
        _Pragma("unroll") for (int ks = 0; ks < 4; ++ks) { u32x4 w; w.x = cvt_pk(S[2 * ks][0], S[2 * ks][1]); w.y = cvt_pk(S[2 * ks][2], S[2 * ks][3]); \
            w.z = cvt_pk(S[2 * ks + 1][0], S[2 * ks + 1][1]); w.w = cvt_pk(S[2 * ks + 1][2], S[2 * ks + 1][3]); Sb[ks] = __builtin_bit_cast(bf16x8, w); } \
        const LAS unsigned char* slot = lds + ((c) & 3) * 32768 + lane * 16; \
        bf16x8 fa[2][2][4]; \
        _Pragma("unroll") for (int ks = 0; ks < 4; ++ks) { fa[0][0][ks] = *(const LAS bf16x8*)(slot + (0 * 4 + ks) * 1024); fa[0][1][ks] = *(const LAS bf16x8*)(slot + (1 * 4 + ks) * 1024); } \
        _Pragma("unroll") for (int mt = 0; mt < 8; ++mt) { const unsigned w0 = nn[mt >> 1][(mt & 1) * 2], w1 = nn[mt >> 1][(mt & 1) * 2 + 1]; \
            S[mt] = S[mt] * gl + (f32x4){bflo(w0), bfhi(w0), bflo(w1), bfhi(w1)}; } \
        _Pragma("unroll") for (int ks = 0; ks < 4; ++ks) *(u32x4*)(scp + ks * 512) = __builtin_bit_cast(u32x4, Sb[ks]);     \
        RELOAD; \
        _Pragma("unroll") for (int pr = 0; pr < 4; ++pr) { \
            if (pr < 3) { _Pragma("unroll") for (int ks = 0; ks < 4; ++ks) { fa[(pr + 1) & 1][0][ks] = *(const LAS bf16x8*)(slot + ((2 * pr + 2) * 4 + ks) * 1024); fa[(pr + 1) & 1][1][ks] = *(const LAS bf16x8*)(slot + ((2 * pr + 3) * 4 + ks) * 1024); } } \
            _Pragma("unroll") for (int ks = 0; ks < 4; ++ks) { S[2 * pr] = mfma16(fa[pr & 1][0][ks], Sb[ks], S[2 * pr]); S[2 * pr + 1] = mfma16(fa[pr & 1][1][ks], Sb[ks], S[2 * pr + 1]); } } \
        } while (0)
    if (loader) { SCAN_DMA(0); SCAN_DMA(1); SCAN_DMA(2); asm volatile("s_waitcnt vmcnt(0)" ::: "memory"); }
    f32x4 S[8];
#pragma unroll
    for (int mt = 0; mt < 8; ++mt) S[mt] = (f32x4){0.f, 0.f, 0.f, 0.f};
    float glr0 = glast[lane], glr1 = glast[64 + lane];
    asm volatile("" : "+v"(glr0), "+v"(glr1));
    u32x4 nnA[4], nnB[4];
    if (wid < CW) { SCAN_LOADN(nnA, 0); SCAN_LOADN(nnB, 1); SCAN_WAITN(nnA, 0); SCAN_WAITN(nnB, 0); }
    asm volatile("s_waitcnt lgkmcnt(0)" ::: "memory"); __builtin_amdgcn_s_barrier(); asm volatile("" ::: "memory");
#pragma unroll 1
    for (int c = 0; c < 128; c += 2) {
        if (loader) { if (c + 3 < 128) { SCAN_DMA(c + 3); asm volatile("s_waitcnt vmcnt(16)" ::: "memory"); } else asm volatile("s_waitcnt vmcnt(0)" ::: "memory"); }
        else if (wid < CW) { SCAN_STEP(c, nnA, SCAN_LOADN(nnA, c + 2)); }
        asm volatile("s_waitcnt lgkmcnt(0)" ::: "memory"); __builtin_amdgcn_s_barrier(); asm volatile("" ::: "memory");
        if (loader) { if (c + 4 < 128) { SCAN_DMA(c + 4); asm volatile("s_waitcnt vmcnt(16)" ::: "memory"); } else asm volatile("s_waitcnt vmcnt(0)" ::: "memory"); }
        else if (wid < CW) { SCAN_STEP(c + 1, nnB, SCAN_LOADN(nnB, c + 3)); }
        asm volatile("s_waitcnt lgkmcnt(0)" ::: "memory"); __builtin_amdgcn_s_barrier(); asm volatile("" ::: "memory");
    }
#undef SCAN_DMA
#undef SCAN_LOADN
#undef SCAN_WAITN
#undef SCAN_STEP
    __syncthreads();
    if (wid < CW) {
        float* go = p.out + O_GP + (size_t)bh * 16384;
#pragma unroll
        for (int mt = 0; mt < 8; ++mt)
#pragma unroll
            for (int e = 0; e < 4; ++e) go[(16 * mt + 4 * fq + e) * 128 + sl * 16 + fr] = S[mt][e];
    }
}

__device__ __forceinline__ void gdn_gate_unit(const Params& p, int unit, int lane) {
    const int fr = lane & 15, fq = lane >> 4, bh = unit >> 7, n = unit & 127, b = bh >> 2, h = bh & 3, tok0 = b * SEQ + n * 64;
    const bf16_t* GO = (const bf16_t*)(p.ws + WS_GO) + (size_t)unit * 8192;
    bf16_t* PB = (bf16_t*)(p.ws + WS_H);
    float ssq[16];
#pragma unroll
    for (int k = 0; k < 16; ++k) ssq[k] = 0.f;
    {
        bf16_t* GOw = (bf16_t*)(p.ws + WS_GO) + (size_t)unit * 8192;
        const bf16_t* GQ = (const bf16_t*)(p.ws + WS_GQ) + (size_t)unit * 8192; const bf16_t* SC = (const bf16_t*)(p.ws + WS_GN) + (size_t)unit * 16384;
        bf16x8 qa[4][4];
#pragma unroll
        for (int mt = 0; mt < 4; ++mt)
#pragma unroll
            for (int ks = 0; ks < 4; ++ks) qa[mt][ks] = *(const bf16x8*)(GQ + ((mt * 4 + ks) * 64 + lane) * 8);
#pragma unroll 2
        for (int nt = 0; nt < 8; ++nt) {
            bf16x8 sb[4];
#pragma unroll
            for (int ks = 0; ks < 4; ++ks) sb[ks] = *(const bf16x8*)(SC + nt * 2048 + (ks * 64 + lane) * 8);
            const u32x4 o0 = *(const u32x4*)(GOw + (nt * 64 + lane) * 16), o1 = *(const u32x4*)(GOw + (nt * 64 + lane) * 16 + 8);
            f32x4 acc[4];
            acc[0] = (f32x4){bflo(o0.x), bfhi(o0.x), bflo(o0.y), bfhi(o0.y)}; acc[1] = (f32x4){bflo(o0.z), bfhi(o0.z), bflo(o0.w), bfhi(o0.w)};
            acc[2] = (f32x4){bflo(o1.x), bfhi(o1.x), bflo(o1.y), bfhi(o1.y)}; acc[3] = (f32x4){bflo(o1.z), bfhi(o1.z), bflo(o1.w), bfhi(o1.w)};
#pragma unroll
            for (int ks = 0; ks < 4; ++ks)
#pragma unroll
                for (int mt = 0; mt < 4; ++mt) acc[mt] = mfma16(qa[mt][ks], sb[ks], acc[mt]);
#pragma unroll
            for (int mt = 0; mt < 4; ++mt)
#pragma unroll
                for (int e = 0; e < 4; ++e) ssq[4 * mt + e] += acc[mt][e] * acc[mt][e];
            u32x4 w0, w1;
            w0.x = cvt_pk(acc[0][0], acc[0][1]); w0.y = cvt_pk(acc[0][2], acc[0][3]); w0.z = cvt_pk(acc[1][0], acc[1][1]); w0.w = cvt_pk(acc[1][2], acc[1][3]);
            w1.x = cvt_pk(acc[2][0], acc[2][1]); w1.y = cvt_pk(acc[2][2], acc[2][3]); w1.z = cvt_pk(acc[3][0], acc[3][1]); w1.w = cvt_pk(acc[3][2], acc[3][3]);
            *(u32x4*)(GOw + (nt * 64 + lane) * 16) = w0; *(u32x4*)(GOw + (nt * 64 + lane) * 16 + 8) = w1;
        }
        asm volatile("s_waitcnt vmcnt(0)" ::: "memory");
    }
#pragma unroll
    for (int k = 0; k < 16; ++k) { float s = row16_sum(ssq[k]); ssq[k] = rsqrtf(s * (1.0f / 128.0f) + EPS); }
    const float* gn = p.in[15];
#pragma unroll 2
    for (int nt = 0; nt < 8; ++nt) {
        const int dv = 16 * nt + fr; const float g = gn[dv];
        const u32x4 a0 = *(const u32x4*)(GO + (nt * 64 + lane) * 16), a1 = *(const u32x4*)(GO + (nt * 64 + lane) * 16 + 8);
        const bf16_t* gzp = PB + (size_t)(tok0 + 4 * fq) * PW + 2304 + h * 128 + dv; bf16_t* mp = PB + (size_t)(tok0 + 4 * fq) * PW + 512 + h * 128 + dv;
#pragma unroll
        for (int k = 0; k < 16; ++k) {
            const unsigned w = (k < 8) ? a0[(k >> 1) & 3] : a1[(k >> 1) & 3]; const float o = (k & 1) ? bfhi(w) : bflo(w);
            const int to = 16 * (k >> 2) + (k & 3);
            const float gz = bf2f(gzp[(size_t)to * PW]);
            mp[(size_t)to * PW] = f2bf(o * ssq[k] * g * silu(gz));
        }
    }
}

__device__ __forceinline__ void attn_unit(const Params& p, LAS unsigned char* lds, int unit) {
    const int tid = threadIdx.x, lane = tid & 63, wid = tid >> 6, fr = lane & 15, fq = lane >> 4;
    const int b = unit >> 7, blk = (unit >> 1) & 63, kvh = unit & 1;
    LAS bf16_t* Ks = (LAS bf16_t*)lds; LAS bf16_t* Vt = (LAS bf16_t*)(lds + 36864);
    bf16_t* PB = (bf16_t*)(p.ws + WS_H);
    __syncthreads();
#pragma unroll
    for (int i = 0; i < 4; ++i) {
        const int q = tid + 512 * i, row = q >> 3, ch = q & 7, tp = blk * 128 - 128 + row;
        u32x4 kv = (u32x4){0u, 0u, 0u, 0u}, vv = (u32x4){0u, 0u, 0u, 0u};
        if (tp >= 0) { const bf16_t* base = PB + (size_t)(b * SEQ + tp) * PW; kv = *(const u32x4*)(base + 512 + kvh * 64 + ch * 8); vv = *(const u32x4*)(base + 640 + kvh * 64 + ch * 8); }
        *(LAS u32x4*)(Ks + row * 72 + ch * 8) = kv;
#pragma unroll
        for (int e = 0; e < 4; ++e) { const unsigned w = vv[e]; Vt[(ch * 8 + 2 * e) * 264 + row] = (bf16_t)(w & 0xffffu); Vt[(ch * 8 + 2 * e + 1) * 264 + row] = (bf16_t)(w >> 16); }
    }
    __syncthreads();
    const int qtok = b * SEQ + blk * 128 + 16 * wid + fr;
#pragma unroll 1
    for (int g = 0; g < 4; ++g) {
        const int h = kvh * 4 + g; const float slope = exp2f(-(float)(h + 1)), sink = p.in[11][h];
        bf16x8 qf[2];
#pragma unroll
        for (int ks = 0; ks < 2; ++ks) qf[ks] = *(const bf16x8*)(PB + (size_t)qtok * PW + h * 64 + ks * 32 + 8 * fq);
        f32x4 s[10]; float mx = sink;
#pragma unroll
        for (int j = 0; j < 10; ++j) {
            const int ct = (wid + j) < 15 ? (wid + j) : 15;
            f32x4 acc = (f32x4){0.f, 0.f, 0.f, 0.f};
#pragma unroll
            for (int ks = 0; ks < 2; ++ks) acc = mfma16(*(const LAS bf16x8*)(Ks + (16 * ct + fr) * 72 + ks * 32 + 8 * fq), qf[ks], acc);
#pragma unroll
            for (int e = 0; e < 4; ++e) {
                const int c = 16 * (wid + j) + 4 * fq + e, dist = 16 * wid + fr - c + 128;
                const bool ok = (wid + j <= 15) && dist >= 0 && dist <= 128 && (blk * 128 + c - 128 >= 0);
                const float v = ok ? acc[e] * 0.125f - slope * (float)dist : -INFINITY;
                acc[e] = v; mx = fmaxf(mx, v);
            }
            s[j] = acc;
            asm volatile("" ::: "memory");
        }
        mx = fmaxf(mx, __shfl_xor(mx, 16)); mx = fmaxf(mx, __shfl_xor(mx, 32));
        float sum = 0.f;
#pragma unroll
        for (int j = 0; j < 10; ++j)
#pragma unroll
            for (int e = 0; e < 4; ++e) { const float pv = __expf(s[j][e] - mx); s[j][e] = pv; sum += pv; }
        sum += __shfl_xor(sum, 16); sum += __shfl_xor(sum, 32);
        sum += __expf(sink - mx);
        const float inv = 1.0f / sum;
        bf16x8 pb[5];
#pragma unroll
        for (int kk = 0; kk < 5; ++kk) { u32x4 w; w.x = cvt_pk(s[2 * kk][0] * inv, s[2 * kk][1] * inv); w.y = cvt_pk(s[2 * kk][2] * inv, s[2 * kk][3] * inv);
            w.z = cvt_pk(s[2 * kk + 1][0] * inv, s[2 * kk + 1][1] * inv); w.w = cvt_pk(s[2 * kk + 1][2] * inv, s[2 * kk + 1][3] * inv); pb[kk] = __builtin_bit_cast(bf16x8, w); }
#pragma unroll
        for (int dt = 0; dt < 4; ++dt) {
            f32x4 acc = (f32x4){0.f, 0.f, 0.f, 0.f};
#pragma unroll
            for (int kk = 0; kk < 5; ++kk) {
                const int c0 = (wid + 2 * kk) < 15 ? (wid + 2 * kk) : 15, c1 = (wid + 2 * kk + 1) < 15 ? (wid + 2 * kk + 1) : 15;
                const u32x2 lo = *(const LAS u32x2*)(Vt + (16 * dt + fr) * 264 + 16 * c0 + 4 * fq), hi = *(const LAS u32x2*)(Vt + (16 * dt + fr) * 264 + 16 * c1 + 4 * fq);
                const u32x4 a = (u32x4){lo.x, lo.y, hi.x, hi.y};
                acc = mfma16(__builtin_bit_cast(bf16x8, a), pb[kk], acc);
            }
            u32x2 w; w.x = cvt_pk(acc[0], acc[1]); w.y = cvt_pk(acc[2], acc[3]);
            *(u32x2*)(PB + (size_t)qtok * PW + h * 64 + 16 * dt + 4 * fq) = w;
            asm volatile("" ::: "memory");
        }
    }
}

__device__ __forceinline__ void sattn_unit(const Params& p, int s, int h, int lane) {
    const int kvh = h >> 2; const bool wr = (h & 3) == 0;
    bf16_t* PB = (bf16_t*)(p.ws + WS_H) + (size_t)(MPR + s) * PW;
    const float* ck = p.in[2] + (size_t)s * 128 * 128 + kvh * 64 + lane; const float* cv = p.in[3] + (size_t)s * 128 * 128 + kvh * 64 + lane;
    float* nk = p.out + O_KS + (size_t)s * 128 * 128 + kvh * 64 + lane; float* nv = p.out + O_VS + (size_t)s * 128 * 128 + kvh * 64 + lane;
    const float q = bf2f(PB[h * 64 + lane]) * 0.125f, slope = exp2f(-(float)(h + 1)), sink = p.in[11][h];
    const float knew = bf2f(PB[512 + kvh * 64 + lane]), vnew = bf2f(PB[640 + kvh * 64 + lane]);
    float sc[3];
#pragma unroll
    for (int t = 0; t < 2; ++t) {
#pragma unroll 8
        for (int jj = 0; jj < 64; ++jj) {
            const int j = t * 64 + jj; const float kval = ck[(size_t)j * 128];
            if (wr && j >= 1) nk[(size_t)(j - 1) * 128] = kval;
            const float d = wave_sum(q * kval) - slope * (float)(128 - j); if (lane == jj) sc[t] = d;
        }
    }
    if (wr) nk[(size_t)127 * 128] = knew;
    sc[2] = wave_sum(q * knew);
    const float mx = fmaxf(fmaxf(wave_max(fmaxf(sc[0], sc[1])), sc[2]), sink);
    const float p0 = __expf(sc[0] - mx), p1 = __expf(sc[1] - mx), p2 = __expf(sc[2] - mx);
    const float inv = 1.0f / (wave_sum(p0 + p1) + p2 + __expf(sink - mx));
    float o = p2 * vnew;
#pragma unroll 8
    for (int jj = 0; jj < 64; ++jj) { const float vval = cv[(size_t)jj * 128]; if (wr && jj >= 1) nv[(size_t)(jj - 1) * 128] = vval; o += __shfl(p0, jj) * vval; }
#pragma unroll 8
    for (int jj = 0; jj < 64; ++jj) { const float vval = cv[(size_t)(64 + jj) * 128]; if (wr) nv[(size_t)(63 + jj) * 128] = vval; o += __shfl(p1, jj) * vval; }
    if (wr) nv[(size_t)127 * 128] = vnew;
    asm volatile("" ::: "memory");
    PB[h * 64 + lane] = f2bf(o * inv);
}

__device__ __forceinline__ void sgdn_unit(const Params& p, LAS unsigned char* lds, int s) {
    const int tid = threadIdx.x, wid = tid >> 6, h = tid >> 7, dv = tid & 127;
    LAS float* qs = (LAS float*)lds; LAS float* ks = qs + 512; LAS float* red = ks + 512;
    bf16_t* PB = (bf16_t*)(p.ws + WS_H) + (size_t)(MPR + s) * PW; const float* GBA = (const float*)(p.ws + WS_GBA) + (size_t)(MPR + s) * 8;
    const float* cw = p.in[12]; const float* hc = p.in[4] + (size_t)s * 3 * CONVC; float* nc = p.out + O_CS + (size_t)s * 3 * CONVC;
    __syncthreads();
    float val[3];
#pragma unroll
    for (int i = 0; i < 3; ++i) {
        const int c = i * 512 + tid; const float x3 = bf2f(PB[768 + c]), h0 = hc[c], h1 = hc[CONVC + c], h2 = hc[2 * CONVC + c];
        val[i] = silu(cw[c] * h0 + cw[CONVC + c] * h1 + cw[2 * CONVC + c] * h2 + cw[3 * CONVC + c] * x3);
        nc[c] = h1; nc[CONVC + c] = h2; nc[2 * CONVC + c] = x3;
    }
    const float sq = wave_sum(val[0] * val[0]), sk = wave_sum(val[1] * val[1]);
    if ((tid & 63) == 0) { red[wid] = sq; red[8 + wid] = sk; }
    __syncthreads();
    const float ssq = red[2 * h] + red[2 * h + 1], ssk = red[8 + 2 * h] + red[8 + 2 * h + 1];
    qs[tid] = val[0] * rsqrtf(ssq + EPS) * 0.08838834764831845f; ks[tid] = val[1] * rsqrtf(ssk + EPS);
    __syncthreads();
    const float beta = 1.0f / (1.0f + __expf(-GBA[h]));
    const float x = GBA[4 + h] + p.in[14][h]; const float sp = x > 20.f ? x : log1pf(__expf(x));
    const float eg = __expf(-__expf(p.in[13][h]) * sp);
    const float* S0 = p.in[5] + ((size_t)(s * 4 + h) * 128) * 128 + dv; float* S1 = p.out + O_GS + ((size_t)(s * 4 + h) * 128) * 128 + dv;
    float kS = 0.f;
#pragma unroll 1
    for (int hf = 0; hf < 4; ++hf) { float sv[32];
#pragma unroll
        for (int dk = 0; dk < 32; ++dk) sv[dk] = S0[(size_t)(hf * 32 + dk) * 128];
#pragma unroll
        for (int dk = 0; dk < 32; ++dk) kS += ks[h * 128 + hf * 32 + dk] * sv[dk]; }
    const float delta = beta * (val[2] - eg * kS);
    float o = 0.f;
#pragma unroll 1
    for (int hf = 0; hf < 4; ++hf) { float sv[32];
#pragma unroll
        for (int dk = 0; dk < 32; ++dk) sv[dk] = S0[(size_t)(hf * 32 + dk) * 128];
#pragma unroll
        for (int dk = 0; dk < 32; ++dk) { const float nvv = eg * sv[dk] + ks[h * 128 + hf * 32 + dk] * delta; S1[(size_t)(hf * 32 + dk) * 128] = nvv; o += qs[h * 128 + hf * 32 + dk] * nvv; } }
    const float so = wave_sum(o * o);
    if ((tid & 63) == 0) red[16 + wid] = so;
    __syncthreads();
    const float tot = red[16 + 2 * h] + red[16 + 2 * h + 1];
    const float gz = bf2f(PB[2304 + tid]);
    PB[512 + tid] = f2bf(o * rsqrtf(tot * (1.0f / 128.0f) + EPS) * p.in[15][dv] * silu(gz));
}

#define XB_TMO      128
#define XB_XCNT(j)  (256  + 64 * (j))
#define XB_XSUB(j)  (1280 + 64 * (j))
#define XB_XGEN(j)  (2304 + 64 * (j))
#define XB_TOP      3328
#define XB_TOPGEN   3392
#define XCD_BAR_WORDS 3456
#define XB_SPIN_CAP (1u << 18)

__device__ __forceinline__ unsigned xb_ld(unsigned* p)              { return __hip_atomic_load(p, __ATOMIC_RELAXED, __HIP_MEMORY_SCOPE_AGENT); }
__device__ __forceinline__ unsigned xb_add(unsigned* p, unsigned v) { return __hip_atomic_fetch_add(p, v, __ATOMIC_RELAXED, __HIP_MEMORY_SCOPE_AGENT); }
__device__ __forceinline__ unsigned xb_xcc_id() { return (unsigned)__builtin_amdgcn_s_getreg((3 << 11) | 20) & 0xFu; }
#define XB_SPIN(cond, bar) do { unsigned _sp = 0; while (cond) { __builtin_amdgcn_s_sleep(1); \
    if ((++_sp & 255u) == 0u) { if (xb_ld(&(bar)[XB_TMO])) break; if (_sp > XB_SPIN_CAP) { atomicAdd(&(bar)[XB_TMO], 1u); break; } } } } while (0)

struct XcdBarrier {
    unsigned* bar; unsigned x;
    volatile LAS unsigned* st;
};

__device__ __forceinline__ XcdBarrier xcd_barrier_post(unsigned* bar, volatile LAS unsigned* st) {
    XcdBarrier b; b.bar = bar; b.x = xb_xcc_id(); b.st = st;
    if (threadIdx.x == 0) (void)xb_add(&bar[XB_XCNT(b.x)], 1u);
    return b;
}
__device__ __forceinline__ void xcd_barrier_complete(unsigned* bar, unsigned x, unsigned& nloc, unsigned& nx) {
    const unsigned G = gridDim.x * gridDim.y * gridDim.z;
    unsigned sum, cnt, mine, sp = 0u;
    for (;;) {
        sum = 0u; cnt = 0u; mine = 0u;
#pragma unroll
        for (unsigned j = 0; j < 16; ++j) { const unsigned c = xb_ld(&bar[XB_XCNT(j)]); sum += c; cnt += (c > 0u) ? 1u : 0u; mine = (j == x) ? c : mine; }
        if (sum == G) break;
        __builtin_amdgcn_s_sleep(1);
        if ((++sp & 255u) == 0u) { if (xb_ld(&bar[XB_TMO])) break; if (sp > XB_SPIN_CAP) { atomicAdd(&bar[XB_TMO], 1u); break; } }
    }
    nloc = mine > 0u ? mine : 1u; nx = cnt > 0u ? cnt : 1u;
}

__device__ __forceinline__ void xcd_barrier(const XcdBarrier& b) {
    asm volatile("s_waitcnt vmcnt(0)" ::: "memory");
    __syncthreads();
    if (threadIdx.x == 0) {
        unsigned* bar = b.bar;
        __builtin_amdgcn_s_waitcnt(0);
        unsigned nloc = b.st[0], nx = b.st[1];
        if (nloc == 0u) { xcd_barrier_complete(bar, b.x, nloc, nx); b.st[0] = nloc; b.st[1] = nx; }
        const unsigned old = xb_add(&bar[XB_XSUB(b.x)], 1u);
        const unsigned gen = old / nloc;
        if (old + 1u == (gen + 1u) * nloc) {
            __builtin_amdgcn_fence(__ATOMIC_RELEASE, "agent");
            asm volatile("s_waitcnt vmcnt(0)" ::: "memory");
            const unsigned og = xb_add(&bar[XB_TOP], 1u);
            const unsigned tg = og / nx;
            if (og + 1u == (tg + 1u) * nx) xb_add(&bar[XB_TOPGEN], 1u);
            else XB_SPIN(xb_ld(&bar[XB_TOPGEN]) == tg, bar);
            __builtin_amdgcn_fence(__ATOMIC_ACQUIRE, "agent");
            xb_add(&bar[XB_XGEN(b.x)], 1u);
            asm volatile("s_waitcnt vmcnt(0)" ::: "memory");
        } else {
            XB_SPIN(xb_ld(&bar[XB_XGEN(b.x)]) == gen, bar);
            __builtin_amdgcn_fence(__ATOMIC_ACQUIRE, "agent");
            asm volatile("s_waitcnt vmcnt(0)" ::: "memory");
        }
    }
    __syncthreads();
}

__global__ void __launch_bounds__(512, 2) fwd_kernel(Params p, int ph_lo, int ph_hi) {
    extern __shared__ __attribute__((aligned(16))) unsigned char lds_raw[];
    LAS unsigned char* lds = (LAS unsigned char*)lds_raw;
    cg::grid_group grid = cg::this_grid();
    if (ph_lo < 0) grid.sync();
    volatile LAS unsigned* bst = (volatile LAS unsigned*)(lds + LDS_PHASE_BYTES);
    if (threadIdx.x < 2) bst[threadIdx.x] = 0u;
    __syncthreads();
    XcdBarrier xbar; xbar.bar = (unsigned*)(p.ws + WS_CTL + CTL_BAR); xbar.x = 0; xbar.st = bst;
    if (ph_hi - ph_lo > 1) xbar = xcd_barrier_post((unsigned*)(p.ws + WS_CTL + CTL_BAR), bst);
    const int tid = threadIdx.x, lane = tid & 63, wid = tid >> 6, G = gridDim.x, bx = blockIdx.x;
    unsigned char* ws = p.ws;
    bf16_t* XN = (bf16_t*)(ws + WS_XN); bf16_t* XN2 = (bf16_t*)(ws + WS_XN2); bf16_t* HB = (bf16_t*)(ws + WS_H);
    float* SS1 = (float*)(ws + WS_SSP1); float* SS2 = (float*)(ws + WS_SSP2);
    float* Y = p.out; bf16_t* X3b = (bf16_t*)(ws + WS_GM);
#ifndef PHMASK
#define PHMASK 0x7ff
#endif
#define IN(k) (((PHMASK >> (k)) & 1) && ph_lo <= (k) && (k) < ph_hi)
#define SEAM(k) do { if (IN(k) && IN((k) + 1)) { xcd_barrier(xbar); }     } while (0)

    if (IN(0)) p0_prologue(p, lds, bx, G);
    SEAM(0);
    if (IN(1)) {
        if (bx < 176) sk_ffn_in<false>(XN, (const bf16_t*)(ws + WS_W1IN), HB, bx, wid, lane & 15, lane >> 4, lds);
        pg8::Gemm g{XN, (const bf16_t*)(ws + WS_W1IN), MPR, 2 * DFF, DM, DM}; pg8::StaticOrder S; S.init(MPR, 2 * DFF, G, bx);
        EpiSwiglu E{HB, nullptr}; pg8::gemm_phase<EpiSwiglu, pg8::StaticOrder, GEMM_ALIGN, GEMM_SP2>(lds, g, S, E);
    }
    SEAM(1);
    if (IN(2)) {
        if (bx < 64) sk_ffn_out<false>(HB, (const bf16_t*)(ws + WS_W1OUT), p.in[1], nullptr, XN + (size_t)MPR * DM, bx, wid, lane & 15, lane >> 4, lds);
        pg8::Gemm g{HB, (const bf16_t*)(ws + WS_W1OUT), MPR, DM, DFF, DFF}; pg8::StaticOrder S; S.init(MPR, DM, G, bx);
        EpiResid<false, false, true, true, true> E{p.in[0], p.in[1], nullptr, XN, SS1}; pg8::gemm_phase<EpiResid<false, false, true, true, true>, pg8::StaticOrder, GEMM_ALIGN, GEMM_SP2>(lds, g, S, E);
    }
    SEAM(2);
    if (IN(3)) {
        if (bx < 89) sk_inproj(XN, (const bf16_t*)(ws + WS_WINMIX), HB, (float*)(ws + WS_GBA), bx, wid, lane & 15, lane >> 4, lds);
        pg8::Gemm g{XN, (const bf16_t*)(ws + WS_WINMIX), MPR, NINP, DM, DM}; pg8::StaticOrder S; S.init(MPR, NINP, G, bx);
        EpiInproj E{HB, (float*)(ws + WS_GBA), SS1}; pg8::gemm_phase<EpiInproj, pg8::StaticOrder, GEMM_ALIGN, GEMM_SP2>(lds, g, S, E);
    }
    SEAM(3);
    if (IN(4)) {
        for (int u = bx; u < 2048; u += G) gdn_prep_unit(p, lds, u);
    }
    SEAM(4);
    if (IN(5)) {
        if (bx < NSCAN) gdn_scan(p, lds, bx);
        else {
            const int ab = bx - NSCAN, NAB = G - NSCAN;
            if (NAB == 192) {
                if (ab < 128) { sattn_unit(p, ab, wid, lane); sgdn_unit(p, lds, ab); attn_unit(p, lds, 2 * ab); attn_unit(p, lds, 2 * ab + 1); }
                else { for (int k = 0; k < 4; ++k) attn_unit(p, lds, 256 + (ab - 128) * 4 + k); }
            } else {
                int it = ab;
#pragma unroll 1
                for (; it < 512; it += NAB) attn_unit(p, lds, it);
#pragma unroll 1
                for (; it < 640; it += NAB) { sattn_unit(p, it - 512, wid, lane); sgdn_unit(p, lds, it - 512); }
            }
            const bf16_t* PB = HB;
            for (int idx = ab * 512 + tid; idx < 149504; idx += NAB * 512) {
                if (idx < 131072) { const int w = idx >> 16, r = idx & 65535, b = r >> 14, j = (r >> 7) & 127, c = r & 127;
                    p.out[(w ? O_VP : O_KP) + r] = bf2f(PB[(size_t)(b * SEQ + SEQ - 128 + j) * PW + 512 + w * 128 + c]);
                } else { const int r = idx - 131072, b = r / (3 * CONVC), q = r % (3 * CONVC), rr = q / CONVC, c = q % CONVC;
                    p.out[O_CP + r] = bf2f(PB[(size_t)(b * SEQ + SEQ - 3 + rr) * PW + 768 + c]); }
            }
        }
    }
    SEAM(5);
    if (IN(6)) {
        for (int u = bx * 8 + wid; u < 2048; u += G * 8) gdn_gate_unit(p, u, lane);
    }
    SEAM(6);
#ifdef DBG_DUMP
    if (ph_lo == 11) {
        const float* src = (const float*)(ws + DBG_SRC);
        for (size_t i = (size_t)bx * 512 + tid; i < (size_t)MREAL * DM; i += (size_t)G * 512) Y[i] = (i < (size_t)MREAL * 8) ? ((const float*)(ws + WS_GBA))[i] : 0.f;
    }
#endif
    if (IN(7)) {
        if (bx < 32) sk_outproj(HB, (const bf16_t*)(ws + WS_WOUTMIX), XN, nullptr, XN2, bx, wid, lane & 15, lane >> 4, lds);
        pg8::Gemm g{HB, (const bf16_t*)(ws + WS_WOUTMIX), MPR, DM, DM, PW}; pg8::StaticOrder S; S.init(MPR, DM, G, bx);
        EpiResid<true, false, true, true, false> E{XN, XN + (size_t)MPR * DM, nullptr, XN2, SS2}; pg8::gemm_phase<EpiResid<true, false, true, true, false>, pg8::StaticOrder, GEMM_ALIGN, GEMM_SP2>(lds, g, S, E);
    }
    SEAM(7);
    if (IN(8)) {
        if (bx < 176) sk_ffn_in<true>(XN2, (const bf16_t*)(ws + WS_W2IN), HB, bx, wid, lane & 15, lane >> 4, lds);
        pg8::Gemm g{XN2, (const bf16_t*)(ws + WS_W2IN), MPR, 2 * DFF, DM, DM}; pg8::StaticOrder S; S.init(MPR, 2 * DFF, G, bx);
        EpiSwiglu E{HB, SS2}; pg8::gemm_phase<EpiSwiglu, pg8::StaticOrder, GEMM_ALIGN, GEMM_SP2>(lds, g, S, E);
    }
    SEAM(8);
    if (IN(9)) {
        if (bx < 64) sk_ffn_out<true>(HB, (const bf16_t*)(ws + WS_W2OUT), (const float*)(XN2 + (size_t)MPR * DM), nullptr, X3b + (size_t)MPR * DM, bx, wid, lane & 15, lane >> 4, lds);
        pg8::Gemm g{HB, (const bf16_t*)(ws + WS_W2OUT), MPR, DM, DFF, DFF}; pg8::StaticOrder S; S.init(MPR, DM, G, bx);
        EpiResid<true, false, true, false, true> E{XN2, XN2 + (size_t)MPR * DM, nullptr, X3b, nullptr}; pg8::gemm_phase<EpiResid<true, false, true, false, true>, pg8::StaticOrder, GEMM_ALIGN, GEMM_SP2>(lds, g, S, E);
    }
    SEAM(9);
    if (IN(10)) {
        const float* gf = p.in[20]; f32x4 gv[4];
#pragma unroll
        for (int j = 0; j < 4; ++j) gv[j] = *((const f32x4*)gf + lane + 64 * j);
        {
            f32x4 v[4], vn[4]; int m = bx * 8 + wid;
            if (m < MREAL) { const u32x2* xr = (const u32x2*)(X3b + (size_t)m * DM) + lane;
#pragma unroll
                for (int j = 0; j < 4; ++j) { const u32x2 w = xr[64 * j]; v[j] = (f32x4){bflo(w.x), bfhi(w.x), bflo(w.y), bfhi(w.y)}; } }
            for (; m < MREAL; m += G * 8) {
                const int mn = m + G * 8;
                if (mn < MREAL) { const u32x2* xr = (const u32x2*)(X3b + (size_t)mn * DM) + lane;
#pragma unroll
                    for (int j = 0; j < 4; ++j) { const u32x2 w = xr[64 * j]; vn[j] = (f32x4){bflo(w.x), bfhi(w.x), bflo(w.y), bfhi(w.y)}; } }
                float s = 0.f;
#pragma unroll
                for (int j = 0; j < 4; ++j) s += (v[j][0] * v[j][0] + v[j][1] * v[j][1]) + (v[j][2] * v[j][2] + v[j][3] * v[j][3]);
                const float rstd = rsqrtf(wave_sum(s) * (1.0f / DM) + EPS);
                f32x4* yr = (f32x4*)(Y + (size_t)m * DM) + lane;
#pragma unroll
                for (int j = 0; j < 4; ++j) yr[64 * j] = v[j] * rstd * gv[j];
#pragma unroll
                for (int j = 0; j < 4; ++j) v[j] = vn[j];
            }
        }
    }
#undef IN
#undef SEAM
}
}

#ifndef MK_N_LAUNCHES
#define MK_N_LAUNCHES 1
#endif
extern "C" void kernel_launch(void* const* d_in, const int* in_sizes, int n_in, void* d_out, int out_size, void* d_ws, size_t ws_size, hipStream_t stream) {
    static int grid = 0;
    if (grid == 0) {
        if (n_in != 21 || ws_size < mk::WS_END || out_size != 47269888) { fprintf(stderr, "kernel_launch: unexpected shapes (n_in %d, ws %zu, out %d)\n", n_in, ws_size, out_size); grid = -1; return; }
        int dev = 0, cus = 0, per_cu = 0;
        (void)hipGetDevice(&dev); (void)hipDeviceGetAttribute(&cus, hipDeviceAttributeMultiprocessorCount, dev);
        if (hipFuncSetAttribute((const void*)mk::fwd_kernel, hipFuncAttributeMaxDynamicSharedMemorySize, mk::LDS_BYTES) != hipSuccess) { fprintf(stderr, "kernel_launch: hipFuncSetAttribute failed\n"); grid = -1; return; }
        if (hipOccupancyMaxActiveBlocksPerMultiprocessor(&per_cu, (const void*)mk::fwd_kernel, 512, mk::LDS_BYTES) != hipSuccess || per_cu < 1) { fprintf(stderr, "kernel_launch: occupancy query failed (%d)\n", per_cu); per_cu = 1; }
        (void)hipGetLastError();
        grid = cus * per_cu;
        if (grid <= mk::NSCAN) { fprintf(stderr, "kernel_launch: grid %d too small\n", grid); grid = -1; return; }
    }
    if (grid < 0) return;
    (void)hipMemsetAsync((char*)d_ws + mk::WS_CTL + mk::CTL_BAR, 0, mk::CTL_BAR_BYTES, stream);
    mk::Params p{};
    for (int i = 0; i < 21; ++i) p.in[i] = (const float*)d_in[i];
    p.out = (float*)d_out; p.ws = (unsigned char*)d_ws;
#if MK_N_LAUNCHES == 1
    int lo = 0, hi = 11; void* args[] = {&p, &lo, &hi};
    hipError_t e = hipLaunchCooperativeKernel((const void*)mk::fwd_kernel, dim3(grid), dim3(512), args, mk::LDS_BYTES, stream);
    if (e != hipSuccess) fprintf(stderr, "kernel_launch: cooperative launch failed: %s (grid %d)\n", hipGetErrorString(e), grid);
#else
#ifndef MK_LAST
#define MK_LAST 11
#ifndef MK_DOUBLE
#define MK_DOUBLE 0x0
#endif
#define DBG_C0 512
#define DBG_C1 1024
#endif
    for (int ph = 0; ph < MK_LAST; ++ph) { const int reps = ((MK_DOUBLE >> ph) & 1) ? 2 : 1; for (int r = 0; r < reps; ++r) hipLaunchKernelGGL(mk::fwd_kernel, dim3(grid), dim3(512), mk::LDS_BYTES, stream, p, ph, ph + 1); }
#ifdef DBG_DUMP
    hipLaunchKernelGGL(mk::fwd_kernel, dim3(grid), dim3(512), mk::LDS_BYTES, stream, p, 11, 12);
#endif
#endif
}
```

```cpp
#include <hip/hip_runtime.h>
#include <hip/hip_cooperative_groups.h>
#include <cstdio>
namespace cg = cooperative_groups;
namespace pg8 {
#define PG8_LAS __attribute__((address_space(3)))
typedef unsigned short bf16_t;
typedef short bf16x8 __attribute__((ext_vector_type(8)));
typedef float f32x4 __attribute__((ext_vector_type(4)));
typedef unsigned u32x4 __attribute__((ext_vector_type(4)));
constexpr int BM = 256, BK = 64, HALF = 128, HTB = HALF * BK * 2  , STAGE_BYTES = 8 * HTB, NXCD = 8, WGM = 4;

__host__ __device__ __forceinline__ int lds_byte(int r, int c) { const int st = (r >> 4) * 2 + (c >> 5), rr = r & 15, cc = c & 31, ob = rr * 64 + cc * 2; return st * 1024 + (ob ^ (((ob >> 9) & 1) << 5)); }
__host__ __device__ __forceinline__ void stage_rc(int b, int& R, int& C) { const int st = b / 1024, sb = b % 1024, swz = sb ^ (((sb >> 9) & 1) << 5); R = (st >> 1) * 16 + swz / 64; C = (st & 1) * 32 + (swz % 64) / 2; }
__host__ __device__ __forceinline__ int perm32(int rho) { const int n = rho >> 4, i = rho & 15; return 8 * (i >> 2) + 4 * n + (i & 3); }

struct Unit { int pm, pn; };
struct Gemm { const bf16_t* A; const bf16_t* Bt; int M, N, K, lda; };

struct StaticOrder {
    int nM, nN, nwg, G, c, wgm;
    __host__ __device__ void init(int M, int N, int G_, int c_, int wgm_ = WGM) { nM = M / BM; nN = N / BM; nwg = nM * nN; G = G_; c = c_; wgm = wgm_; }
    __host__ __device__ bool next(int i, Unit& u) const {
        const long L = (long)i * G + c; if (L >= nwg) return false;
        int wgid = (int)L; { const int q = nwg / NXCD, r = nwg % NXCD, xcd = wgid % NXCD, off = wgid / NXCD; wgid = (xcd < r ? xcd * (q + 1) : r * (q + 1) + (xcd - r) * q) + off; }
        const int nig = wgm * nN, gid = wgid / nig, fm = gid * wgm, gsz = (nM - fm) < wgm ? (nM - fm) : wgm;
        u.pm = fm + ((wgid % nig) % gsz); u.pn = (wgid % nig) / gsz; return true;
    }
    __device__ __forceinline__ void a_ready(const Unit&) const {}
    __device__ __forceinline__ void done(const Unit&) const {}
};

__device__ __forceinline__ unsigned cvt_pk_bf16(float lo, float hi) { unsigned r; asm volatile("v_cvt_pk_bf16_f32 %0, %1, %2" : "=v"(r) : "v"(lo), "v"(hi)); return r; }
typedef float f32x2 __attribute__((ext_vector_type(2)));
__device__ __forceinline__ f32x2 gelu_pk(f32x2 v) {
    const f32x2 av = __builtin_elementwise_abs(v), d = av * 0.2316418882f + 1.0f;
    f32x2 t; t.x = __builtin_amdgcn_rcpf(d.x); t.y = __builtin_amdgcn_rcpf(d.y);
    f32x2 q = t * 0.5307027145f + (-0.7265760135f); q = q * t + 0.7107068705f; q = q * t + (-0.142248368f); q = q * t + 0.127414796f; q = q * t;
    const f32x2 s = (v * v) * (-0.72134752044f);
    f32x2 e; e.x = __builtin_amdgcn_exp2f(s.x); e.y = __builtin_amdgcn_exp2f(s.y);
    const f32x2 m = v * (q * e), r = v - m;
    f32x2 o; o.x = v.x < 0.f ? m.x : r.x; o.y = v.y < 0.f ? m.y : r.y; return o;
}

template <int ACT  > struct EpiBf16 {
    static constexpr bool PERM = true, AFTER_DRAIN = false; static_assert(ACT == 0 || ACT == 1, "EpiBf16: ACT is 0 (none) or 1 (gelu_pk)");
    bf16_t* O; int ldc; const float* bias; int split_cols; size_t split_stride; float scale0;
    __device__ __forceinline__ void operator()(const f32x4 (&acc)[2][2][4][2], const Unit& u, int wr, int wc, int fr, int fq) const {
        const int row0 = u.pm * BM + wr * 64 + fr; int colt = u.pn * BM; bf16_t* base = O;
        float sc = 1.f; if (split_cols) { const int t = colt / split_cols; base += (size_t)t * split_stride; colt -= t * split_cols; if (t == 0) sc = scale0; }
        const int col0 = colt + wc * 32 + 8 * fq, bcol0 = u.pn * BM + wc * 32 + 8 * fq;
        f32x4 bv[2][2];
#pragma unroll
        for (int bj = 0; bj < 2; ++bj)
#pragma unroll
            for (int n = 0; n < 2; ++n) bv[bj][n] = bias ? *(const f32x4*)(bias + bcol0 + bj * HALF + 4 * n) : (f32x4){0.f, 0.f, 0.f, 0.f};
#pragma unroll
        for (int ai = 0; ai < 2; ++ai)
#pragma unroll
            for (int m = 0; m < 4; ++m) { bf16_t* rowp = base + (size_t)(row0 + ai * HALF + m * 16) * ldc + col0;
#pragma unroll
                for (int bj = 0; bj < 2; ++bj) { f32x4 v0 = acc[ai][bj][m][0] + bv[bj][0], v1 = acc[ai][bj][m][1] + bv[bj][1];
                    if (ACT == 1) { f32x2 a = gelu_pk((f32x2){v0[0], v0[1]}), b = gelu_pk((f32x2){v0[2], v0[3]}), c = gelu_pk((f32x2){v1[0], v1[1]}), d = gelu_pk((f32x2){v1[2], v1[3]});
                        v0 = (f32x4){a.x, a.y, b.x, b.y}; v1 = (f32x4){c.x, c.y, d.x, d.y}; }
                    v0 = v0 * sc; v1 = v1 * sc; u32x4 w; w.x = cvt_pk_bf16(v0[0], v0[1]); w.y = cvt_pk_bf16(v0[2], v0[3]); w.z = cvt_pk_bf16(v1[0], v1[1]); w.w = cvt_pk_bf16(v1[2], v1[3]);
                    *(u32x4*)(rowp + bj * HALF) = w; } }
    }
};

struct PanelStats {
    unsigned* xbuf;
    unsigned* cnt;
    unsigned* tmo;
    int ntn; float eps;
    unsigned code;
    __device__ __forceinline__ bool run(const f32x4 (&v)[2][2][4][2], const Unit& u, int wr, int wc, int fr, int fq, PG8_LAS unsigned char* lds, int wid, int lane) const {
        typedef float f32x2v __attribute__((ext_vector_type(2)));
        PG8_LAS f32x2v* P = (PG8_LAS f32x2v*)lds;
        PG8_LAS f32x2v* S = (PG8_LAS f32x2v*)(lds + 8192);
        PG8_LAS unsigned* flag = (PG8_LAS unsigned*)(lds + 8192 + 2048);
#pragma unroll
        for (int ai = 0; ai < 2; ++ai)
#pragma unroll
            for (int m = 0; m < 4; ++m) {
                float s = 0.f;
#pragma unroll
                for (int bj = 0; bj < 2; ++bj)
#pragma unroll
                    for (int n = 0; n < 2; ++n) { const f32x4 x = v[ai][bj][m][n]; s += (x[0] + x[1]) + (x[2] + x[3]); }
                s += __shfl_xor(s, 16); s += __shfl_xor(s, 32);
                const float mw = s * (1.0f / 64.0f); float q = 0.f;
#pragma unroll
                for (int bj = 0; bj < 2; ++bj)
#pragma unroll
                    for (int n = 0; n < 2; ++n) { const f32x4 d = v[ai][bj][m][n] - mw; q += (d[0] * d[0] + d[1] * d[1]) + (d[2] * d[2] + d[3] * d[3]); }
                q += __shfl_xor(q, 16); q += __shfl_xor(q, 32);
                if (fq == 0) P[(ai * HALF + wr * 64 + m * 16 + fr) * 4 + wc] = (f32x2v){mw, q};
            }
        asm volatile("s_waitcnt lgkmcnt(0)" ::: "memory"); __builtin_amdgcn_s_barrier(); asm volatile("" ::: "memory");
#if defined(BROKEN_EXCHANGE_NO_WAIT)
#warning BROKEN CONTROL BUILD: the row-statistics exchange does not wait; results are wrong by design
        if (blockIdx.x >= 64) { const long long t0_ = clock64(); while (clock64() - t0_ < 60000) __builtin_amdgcn_s_sleep(8); }
#endif
        const int row = wid * 32 + (lane & 31);
        if (lane < 32) {
            const f32x2v a = P[row * 4 + 0], b = P[row * 4 + 1], c = P[row * 4 + 2], d = P[row * 4 + 3];
            const float mt = (a.x + b.x + c.x + d.x) * 0.25f;
            const float da = a.x - mt, db = b.x - mt, dc = c.x - mt, dd = d.x - mt;
            const float m2 = (a.y + b.y) + (c.y + d.y) + 64.0f * ((da * da + db * db) + (dc * dc + dd * dd));
            unsigned long long* slot = (unsigned long long*)xbuf + ((size_t)(u.pm * BM + row) * 4 + u.pn);
            __hip_atomic_store(slot, ((unsigned long long)__float_as_uint(m2) << 32) | __float_as_uint(mt), __ATOMIC_RELAXED, __HIP_MEMORY_SCOPE_AGENT);
        }
        asm volatile("s_waitcnt vmcnt(0)" ::: "memory");
        if (lane == 0) __hip_atomic_fetch_add(cnt + 64 * u.pm, 1u, __ATOMIC_RELAXED, __HIP_MEMORY_SCOPE_AGENT);
        if (wid == 0) {
            bool dead = false; const unsigned long long t0 = __builtin_amdgcn_s_memrealtime(); const unsigned want = 8u * (unsigned)ntn;
            for (;;) {
#if defined(BROKEN_EXCHANGE_NO_WAIT)
                break;
#endif
                if ((unsigned)__builtin_amdgcn_readfirstlane(__hip_atomic_load(cnt + 64 * u.pm, __ATOMIC_RELAXED, __HIP_MEMORY_SCOPE_AGENT)) >= want) break;
                if (__builtin_amdgcn_s_memrealtime() - t0 > 2000000ull) {
                    if (lane == 0) { unsigned expect = 0u; __hip_atomic_compare_exchange_strong(tmo + 1, &expect, code | (unsigned)(u.pm & 0xff), __ATOMIC_RELAXED, __ATOMIC_RELAXED, __HIP_MEMORY_SCOPE_AGENT);
                                     __hip_atomic_store(tmo, 1u, __ATOMIC_RELAXED, __HIP_MEMORY_SCOPE_AGENT); }
                    dead = true; break; }
                __builtin_amdgcn_s_sleep(2);
            }
            __builtin_amdgcn_fence(__ATOMIC_ACQUIRE, "agent");
            if (lane == 0) flag[0] = dead ? 1u : 0u;
        }
        asm volatile("s_waitcnt vmcnt(0) lgkmcnt(0)" ::: "memory"); __builtin_amdgcn_s_barrier(); asm volatile("" ::: "memory");
        const bool bad = flag[0] != 0u;
        if (lane < 32) {
            const unsigned long long* slot = (const unsigned long long*)xbuf + (size_t)(u.pm * BM + row) * 4; float mt[4], m2[4]; float ms = 0.f;
#pragma unroll
            for (int t = 0; t < 4; ++t) { if (t < ntn) { const unsigned long long w = __hip_atomic_load(slot + t, __ATOMIC_RELAXED, __HIP_MEMORY_SCOPE_AGENT); mt[t] = __uint_as_float((unsigned)w); m2[t] = __uint_as_float((unsigned)(w >> 32)); } else { mt[t] = 0.f; m2[t] = 0.f; } ms += mt[t]; }
            const float mean = ms / (float)ntn; float q = 0.f;
#pragma unroll
            for (int t = 0; t < 4; ++t) if (t < ntn) { const float dm = mt[t] - mean; q += m2[t] + 256.0f * dm * dm; }
            S[row] = (f32x2v){mean, 1.0f / sqrtf(q / (256.0f * (float)ntn) + eps)};
        }
        asm volatile("s_waitcnt lgkmcnt(0)" ::: "memory"); __builtin_amdgcn_s_barrier(); asm volatile("" ::: "memory");
        return bad;
    }
};
struct EpiLnRes {
    static constexpr bool PERM = false, AFTER_DRAIN = true;
    const float* base; float* out; int ldc; const float* bias; PanelStats st; unsigned poison;
    __device__ __forceinline__ void fused(f32x4 (&acc)[2][2][4][2], const Unit& u, int wr, int wc, int fr, int fq, PG8_LAS unsigned char* lds, int wid, int lane) const {
        typedef float f32x2v __attribute__((ext_vector_type(2)));
        const PG8_LAS f32x2v* S = (const PG8_LAS f32x2v*)(lds + 8192);
        const int col0 = u.pn * BM + wc * 32 + 4 * fq;
#pragma unroll
        for (int bj = 0; bj < 2; ++bj)
#pragma unroll
            for (int n = 0; n < 2; ++n) { const f32x4 bv = bias ? *(const f32x4*)(bias + col0 + bj * HALF + n * 16) : (f32x4){0.f, 0.f, 0.f, 0.f};
#pragma unroll
                for (int ai = 0; ai < 2; ++ai)
#pragma unroll
                    for (int m = 0; m < 4; ++m) acc[ai][bj][m][n] += bv; }
        f32x4 pre[4][2][2];
#pragma unroll
        for (int m = 0; m < 4; ++m) { const size_t off = (size_t)(u.pm * BM + wr * 64 + m * 16 + fr) * ldc + col0;
#pragma unroll
            for (int bj = 0; bj < 2; ++bj)
#pragma unroll
                for (int n = 0; n < 2; ++n) pre[m][bj][n] = *(const f32x4*)(base + off + bj * HALF + n * 16); }
        const bool bad = st.run(acc, u, wr, wc, fr, fq, lds, wid, lane) || poison != 0u;
        const float qnan = __builtin_nanf("");
#pragma unroll
        for (int ai = 0; ai < 2; ++ai)
#pragma unroll
            for (int m = 0; m < 4; ++m) { const int r = ai * HALF + wr * 64 + m * 16 + fr; const f32x2v sr = S[r]; const size_t off = (size_t)(u.pm * BM + r) * ldc + col0;
#pragma unroll
                for (int bj = 0; bj < 2; ++bj)
#pragma unroll
                    for (int n = 0; n < 2; ++n) { const f32x4 bs = ai == 0 ? pre[m][bj][n] : *(const f32x4*)(base + off + bj * HALF + n * 16); f32x4 o = bs + (acc[ai][bj][m][n] - sr.x) * sr.y;
                        if (bad) o = (f32x4){qnan, qnan, qnan, qnan}; *(f32x4*)(out + off + bj * HALF + n * 16) = o; }
                if (m & 1) asm volatile("" ::: "memory"); }
    }
};
struct EpiLnResLn {
    static constexpr bool PERM = false, AFTER_DRAIN = true;
    const float* base; float* out; bf16_t* xn; int ldc; const float* bias; PanelStats st1, st2; unsigned poison;
    __device__ __forceinline__ void fused(f32x4 (&acc)[2][2][4][2], const Unit& u, int wr, int wc, int fr, int fq, PG8_LAS unsigned char* lds, int wid, int lane) const {
        typedef float f32x2v __attribute__((ext_vector_type(2))); typedef unsigned u32x2v __attribute__((ext_vector_type(2)));
        const PG8_LAS f32x2v* S = (const PG8_LAS f32x2v*)(lds + 8192);
        const int col0 = u.pn * BM + wc * 32 + 4 * fq;
#pragma unroll
        for (int bj = 0; bj < 2; ++bj)
#pragma unroll
            for (int n = 0; n < 2; ++n) { const f32x4 bv = bias ? *(const f32x4*)(bias + col0 + bj * HALF + n * 16) : (f32x4){0.f, 0.f, 0.f, 0.f};
#pragma unroll
                for (int ai = 0; ai < 2; ++ai)
#pragma unroll
                    for (int m = 0; m < 4; ++m) acc[ai][bj][m][n] += bv; }
        bool bad = st1.run(acc, u, wr, wc, fr, fq, lds, wid, lane) || poison != 0u;
        const float qnan = __builtin_nanf("");
#pragma unroll
        for (int ai = 0; ai < 2; ++ai)
#pragma unroll
            for (int m = 0; m < 4; ++m) { const int r = ai * HALF + wr * 64 + m * 16 + fr; const f32x2v sr = S[r]; const size_t off = (size_t)(u.pm * BM + r) * ldc + col0;
#pragma unroll
                for (int bj = 0; bj < 2; ++bj)
#pragma unroll
                    for (int n = 0; n < 2; ++n) { const f32x4 bs = *(const f32x4*)(base + off + bj * HALF + n * 16); acc[ai][bj][m][n] = bs + (acc[ai][bj][m][n] - sr.x) * sr.y; }
                asm volatile("" : "+v"(acc[ai][0][m][0]), "+v"(acc[ai][0][m][1]), "+v"(acc[ai][1][m][0]), "+v"(acc[ai][1][m][1]));
                if (m & 1) asm volatile("" ::: "memory"); }
        const bool bad1 = bad;
        bad = st2.run(acc, u, wr, wc, fr, fq, lds, wid, lane) || bad;
#pragma unroll
        for (int ai = 0; ai < 2; ++ai)
#pragma unroll
            for (int m = 0; m < 4; ++m) { const int r = ai * HALF + wr * 64 + m * 16 + fr; const f32x2v sr = S[r]; const size_t off = (size_t)(u.pm * BM + r) * ldc + col0;
#pragma unroll
                for (int bj = 0; bj < 2; ++bj)
#pragma unroll
                    for (int n = 0; n < 2; ++n) { const f32x4 x1 = acc[ai][bj][m][n]; *(f32x4*)(out + off + bj * HALF + n * 16) = bad1 ? (f32x4){qnan, qnan, qnan, qnan} : x1;
                        const f32x4 o = (x1 - sr.x) * sr.y; u32x2v w; w.x = cvt_pk_bf16(o[0], o[1]); w.y = cvt_pk_bf16(o[2], o[3]);
                        if (bad) { w.x = 0x7fc07fc0u; w.y = 0x7fc07fc0u; } *(u32x2v*)(xn + off + bj * HALF + n * 16) = w; }
                asm volatile("" ::: "memory"); }
    }
};

template <class Epi, class Sched, bool ALIGN_EPI = false, bool SP2 = false>
__device__ __forceinline__ void gemm_phase(PG8_LAS unsigned char* lds, const Gemm g, const Sched S, const Epi E) {
    const int tid = threadIdx.x, wid = __builtin_amdgcn_readfirstlane(tid >> 6), lane = tid & 63, wr = wid >> 2, wc = wid & 3, fr = lane & 15, fq = lane >> 4;
    const int K = g.K, nt = K / BK;
    unsigned voffA[2], voffB[2];
#pragma unroll
    for (int i = 0; i < 2; ++i) { int R, C; stage_rc(tid * 16 + i * 8192, R, C); const int Rb = Epi::PERM ? ((R & ~31) + perm32(R & 31)) : R;
        voffA[i] = (unsigned)(R * g.lda + C) * 2u; voffB[i] = (unsigned)(Rb * K + C) * 2u; }
    const size_t kstep = (size_t)(BK * 2);
    const size_t hstep = (size_t)HALF * K * 2;
    const size_t tstep = 2 * hstep;
    const size_t hstepA = (size_t)HALF * g.lda * 2, tstepA = 2 * hstepA;
    const unsigned ldsw = (unsigned)wid * 1024u;
    const int aoff = lds_byte(wr * 64 + fr, fq * 8), boff = lds_byte(wc * 32 + fr, fq * 8);
#define PG8_SA(b, h) (((b) * 2 + (h)) * HTB)
#define PG8_SB(b, h) ((4 + (b) * 2 + (h)) * HTB)
#define PG8_STAGE(bufoff, gbase, voff) do { _Pragma("unroll") for (int _i = 0; _i < 2; ++_i) \
        __builtin_amdgcn_global_load_lds((const unsigned*)((const char*)(gbase) + (voff)[_i]), (PG8_LAS unsigned*)(lds + (bufoff) + ldsw + _i * 8192), 16, 0, 0); } while (0)
#define PG8_LDA(dst, b, h) do { _Pragma("unroll") for (int m = 0; m < 4; ++m) _Pragma("unroll") for (int k = 0; k < 2; ++k) dst[m][k] = *(const PG8_LAS bf16x8*)(lds + PG8_SA(b, h) + aoff + m * 2048 + k * 1024); } while (0)
#define PG8_LDB(dst, b, h) do { _Pragma("unroll") for (int n = 0; n < 2; ++n) _Pragma("unroll") for (int k = 0; k < 2; ++k) dst[n][k] = *(const PG8_LAS bf16x8*)(lds + PG8_SB(b, h) + boff + n * 2048 + k * 1024); } while (0)
#define PG8_MMA(ai, bj, At, Bt) do { __builtin_amdgcn_s_setprio(1); _Pragma("unroll") for (int m = 0; m < 4; ++m) _Pragma("unroll") for (int n = 0; n < 2; ++n) _Pragma("unroll") for (int k = 0; k < 2; ++k) \
        acc[ai][bj][m][n] = __builtin_amdgcn_mfma_f32_16x16x32_bf16(Bt[n][k], At[m][k], acc[ai][bj][m][n], 0, 0, 0); __builtin_amdgcn_s_setprio(0); } while (0)
#define PG8_WAIT_V(n) asm volatile("s_waitcnt vmcnt(" #n ")" ::: "memory")
#define PG8_WAIT_L(n) asm volatile("s_waitcnt lgkmcnt(" #n ")" ::: "memory")
#define PG8_BAR __builtin_amdgcn_s_barrier()
#define PG8_SCHED __builtin_amdgcn_sched_barrier(0)
    Unit cur, nxt; int ui = 0;
    if (!S.next(0, cur)) return;
    f32x4 acc[2][2][4][2];
#pragma unroll
    for (int a = 0; a < 2; ++a)
#pragma unroll
        for (int b = 0; b < 2; ++b)
#pragma unroll
            for (int m = 0; m < 4; ++m)
#pragma unroll
                for (int n = 0; n < 2; ++n) acc[a][b][m][n] = (f32x4){0.f, 0.f, 0.f, 0.f};
    bf16x8 At[4][2], B0[2][2], B1[2][2];
    const char* cA = (const char*)g.A + (size_t)cur.pm * tstepA; const char* cB = (const char*)g.Bt + (size_t)cur.pn * tstep;
    S.a_ready(cur);
    if constexpr (SP2) {
        PG8_STAGE(PG8_SB(0, 0), cB, voffB); PG8_STAGE(PG8_SB(0, 1), cB + hstep, voffB); PG8_STAGE(PG8_SA(0, 0), cA, voffA); PG8_STAGE(PG8_SA(0, 1), cA + hstepA, voffA);
        if (wr == 1) PG8_BAR;
        PG8_WAIT_V(2); PG8_BAR;
        PG8_STAGE(PG8_SB(1, 0), cB + kstep, voffB); PG8_STAGE(PG8_SA(1, 0), cA + kstep, voffA); PG8_STAGE(PG8_SB(1, 1), cB + hstep + kstep, voffB);
        PG8_WAIT_V(6); PG8_BAR;
    } else {
        PG8_STAGE(PG8_SB(0, 0), cB, voffB); PG8_STAGE(PG8_SA(0, 0), cA, voffA); PG8_STAGE(PG8_SB(0, 1), cB + hstep, voffB); PG8_STAGE(PG8_SA(0, 1), cA + hstepA, voffA);
        if (wr == 1) PG8_BAR;
        PG8_WAIT_V(4); PG8_BAR;
        PG8_STAGE(PG8_SB(1, 0), cB + kstep, voffB); PG8_STAGE(PG8_SA(1, 0), cA + kstep, voffA); PG8_STAGE(PG8_SB(1, 1), cB + hstep + kstep, voffB);
        PG8_WAIT_V(6); PG8_BAR;
    }
    for (;;) {
        const bool has_next = S.next(ui + 1, nxt);
        const char* nA = has_next ? (const char*)g.A + (size_t)nxt.pm * tstepA : cA; const char* nB = has_next ? (const char*)g.Bt + (size_t)nxt.pn * tstep : cB;
        for (int t = 0; t < nt; t += 2) {
            const bool last = (t == nt - 2);
            const char* a1 = cA + (size_t)(t + 1) * kstep;
            const char* a2 = last ? nA : cA + (size_t)(t + 2) * kstep; const char* b2 = last ? nB : cB + (size_t)(t + 2) * kstep;
            const char* a3 = a2 + kstep; const char* b3 = b2 + kstep;
            if (last && has_next) S.a_ready(nxt);
            if constexpr (SP2) {
            PG8_LDB(B0, 0, 0); PG8_LDB(B1, 0, 1); PG8_SCHED; PG8_LDA(At, 0, 0); PG8_STAGE(PG8_SA(1, 1), a1 + hstepA, voffA);
            PG8_WAIT_V(8); PG8_WAIT_L(0); PG8_BAR; PG8_MMA(0, 0, At, B0); PG8_MMA(0, 1, At, B1); PG8_BAR; PG8_SCHED;
            PG8_LDA(At, 0, 1); PG8_STAGE(PG8_SB(0, 0), b2, voffB); PG8_STAGE(PG8_SB(0, 1), b2 + hstep, voffB); PG8_STAGE(PG8_SA(0, 0), a2, voffA);
            PG8_WAIT_V(8); PG8_WAIT_L(0); PG8_BAR; PG8_MMA(1, 0, At, B0); PG8_MMA(1, 1, At, B1); PG8_BAR; PG8_SCHED;
            PG8_LDB(B0, 1, 0); PG8_LDB(B1, 1, 1); PG8_SCHED; PG8_LDA(At, 1, 0); PG8_STAGE(PG8_SA(0, 1), a2 + hstepA, voffA);
            PG8_WAIT_V(8); PG8_WAIT_L(0); PG8_BAR; PG8_MMA(0, 0, At, B0); PG8_MMA(0, 1, At, B1); PG8_BAR; PG8_SCHED;
            PG8_LDA(At, 1, 1); PG8_STAGE(PG8_SB(1, 0), b3, voffB); PG8_STAGE(PG8_SB(1, 1), b3 + hstep, voffB); PG8_STAGE(PG8_SA(1, 0), a3, voffA);
            PG8_WAIT_V(8); PG8_WAIT_L(0); PG8_BAR; PG8_MMA(1, 0, At, B0); PG8_MMA(1, 1, At, B1); PG8_BAR; PG8_SCHED;
            } else {
            PG8_LDB(B0, 0, 0); PG8_SCHED; PG8_LDA(At, 0, 0); PG8_STAGE(PG8_SA(1, 1), a1 + hstepA, voffA);
            PG8_WAIT_L(8); PG8_BAR; PG8_WAIT_L(0); PG8_MMA(0, 0, At, B0); PG8_BAR; PG8_SCHED;
            PG8_LDB(B1, 0, 1); PG8_STAGE(PG8_SB(0, 0), b2, voffB);
            PG8_BAR; PG8_WAIT_L(0); PG8_MMA(0, 1, At, B1); PG8_BAR;
            PG8_LDA(At, 0, 1); PG8_STAGE(PG8_SA(0, 0), a2, voffA);
            PG8_BAR; PG8_WAIT_L(0); PG8_MMA(1, 0, At, B0); PG8_BAR; PG8_SCHED;
            PG8_STAGE(PG8_SB(0, 1), b2 + hstep, voffB);
            PG8_WAIT_V(6); PG8_BAR; PG8_MMA(1, 1, At, B1); PG8_BAR;
            PG8_LDB(B0, 1, 0); PG8_SCHED; PG8_LDA(At, 1, 0); PG8_STAGE(PG8_SA(0, 1), a2 + hstepA, voffA);
            PG8_WAIT_L(8); PG8_BAR; PG8_WAIT_L(0); PG8_MMA(0, 0, At, B0); PG8_BAR; PG8_SCHED;
            PG8_LDB(B1, 1, 1); PG8_STAGE(PG8_SB(1, 0), b3, voffB);
            PG8_BAR; PG8_WAIT_L(0); PG8_MMA(0, 1, At, B1); PG8_BAR;
            PG8_LDA(At, 1, 1); PG8_STAGE(PG8_SA(1, 0), a3, voffA);
            PG8_BAR; PG8_WAIT_L(0); PG8_MMA(1, 0, At, B0); PG8_BAR; PG8_SCHED;
            PG8_STAGE(PG8_SB(1, 1), b3 + hstep, voffB);
            PG8_WAIT_V(6); PG8_BAR; PG8_MMA(1, 1, At, B1); PG8_BAR;
            }
        }
        if constexpr (ALIGN_EPI) { if (wr == 0) PG8_BAR; }
        if constexpr (!Epi::AFTER_DRAIN) { E(acc, cur, wr, wc, fr, fq); S.done(cur); }
        if (!has_next) break;
#pragma unroll
        for (int a = 0; a < 2; ++a)
#pragma unroll
            for (int b = 0; b < 2; ++b)
#pragma unroll
                for (int m = 0; m < 4; ++m)
#pragma unroll
                    for (int n = 0; n < 2; ++n) acc[a][b][m][n] = (f32x4){0.f, 0.f, 0.f, 0.f};
        cur = nxt; cA = nA; cB = nB; ++ui;
        if constexpr (ALIGN_EPI) { if (wr == 1) PG8_BAR; }
    }
    PG8_WAIT_V(0);
    if constexpr (!ALIGN_EPI) { if (wr == 0) PG8_BAR; }
    PG8_BAR;
    if constexpr (Epi::AFTER_DRAIN) { E.fused(acc, cur, wr, wc, fr, fq, lds, wid, lane); S.done(cur); }
#undef PG8_SA
#undef PG8_SB
#undef PG8_STAGE
#undef PG8_LDA
#undef PG8_LDB
#undef PG8_MMA
#undef PG8_WAIT_V
#undef PG8_WAIT_L
#undef PG8_BAR
#undef PG8_SCHED
}
}

#ifndef GEMM_SP2
#define GEMM_SP2 true
#endif
#ifndef GEMM_ALIGN
#define GEMM_ALIGN true
#endif
namespace mk {
#define LAS __attribute__((address_space(3)))
using pg8::bf16_t; using pg8::bf16x8; using pg8::f32x4; using pg8::u32x4;
typedef unsigned u32x2 __attribute__((ext_vector_type(2)));

constexpr int DM = 1024, SEQ = 8192, NBATCH = 4, MPR = NBATCH * SEQ, MSAMP = 128, MREAL = MPR + MSAMP, MPAD = 33024;
constexpr int DFF = 2816, PW = 2816, NINP = 3072, CONVC = 1536;
constexpr float EPS = 1e-6f;
#ifndef SCAN_CW
#define SCAN_CW 2
#endif
constexpr int CW = SCAN_CW, NSCAN = 128 / CW;
constexpr int LDS_PHASE_BYTES = 155648, LDS_BYTES = LDS_PHASE_BYTES + 256;

constexpr size_t O_YP = 0, O_YS = 33554432, O_KP = 33685504, O_VP = 33751040, O_CP = 33816576, O_GP = 33835008,
                 O_KS = 34097152, O_VS = 36194304, O_CS = 38291456, O_GS = 38881280;
constexpr size_t MiB = 1u << 20;
constexpr size_t WS_CTL = 0, CTL_ZERO_BYTES = 1 * MiB;
constexpr size_t WS_W1IN = 1 * MiB, WS_W1OUT = 12 * MiB, WS_WINMIX = 18 * MiB, WS_WOUTMIX = 24 * MiB, WS_W2IN = 26 * MiB, WS_W2OUT = 37 * MiB;
constexpr size_t WS_GBA = 43 * MiB, WS_XN = 45 * MiB, WS_XN2 = 110 * MiB, WS_H = 175 * MiB, WS_GM = 353 * MiB, WS_GN = 417 * MiB;
constexpr size_t WS_GQ = 110 * MiB, WS_GO = 142 * MiB;
constexpr size_t WS_SSP1 = 481 * MiB, WS_SSP2 = 484 * MiB;
constexpr size_t WS_END = 487 * MiB;
constexpr size_t CTL_BAR = 0, CTL_BAR_BYTES = 16384, CTL_GLAST = 768 * 1024;

struct Params { const float* in[21]; float* out; unsigned char* ws; };

typedef float f32x2v __attribute__((ext_vector_type(2)));
typedef __bf16 bf16x2v __attribute__((ext_vector_type(2)));
__device__ __forceinline__ unsigned cvt_pk(float lo, float hi) { const f32x2v v = {lo, hi}; const bf16x2v b = __builtin_convertvector(v, bf16x2v); return __builtin_bit_cast(unsigned, b); }
__device__ __forceinline__ bf16_t f2bf(float f) { return (bf16_t)(cvt_pk(f, 0.f) & 0xffffu); }
__device__ __forceinline__ float bf2f(bf16_t h) { return __uint_as_float(((unsigned)h) << 16); }
__device__ __forceinline__ float bflo(unsigned w) { return __uint_as_float(w << 16); }
__device__ __forceinline__ float bfhi(unsigned w) { return __uint_as_float(w & 0xffff0000u); }
__device__ __forceinline__ float silu(float x) { return x * __builtin_amdgcn_rcpf(1.0f + __expf(-x)); }
__device__ __forceinline__ float wave_sum(float v) {
#pragma unroll
    for (int o = 1; o < 64; o <<= 1) v += __shfl_xor(v, o);
    return v;
}
__device__ __forceinline__ float wave_max(float v) {
#pragma unroll
    for (int o = 1; o < 64; o <<= 1) v = fmaxf(v, __shfl_xor(v, o));
    return v;
}
__device__ __forceinline__ float row16_sum(float v) {
    v += __builtin_bit_cast(float, __builtin_amdgcn_update_dpp(0, __builtin_bit_cast(int, v), 0xB1, 0xF, 0xF, true));
    v += __builtin_bit_cast(float, __builtin_amdgcn_update_dpp(0, __builtin_bit_cast(int, v), 0x4E, 0xF, 0xF, true));
    v += __builtin_bit_cast(float, __builtin_amdgcn_update_dpp(0, __builtin_bit_cast(int, v), 0x141, 0xF, 0xF, true));
    v += __builtin_bit_cast(float, __builtin_amdgcn_update_dpp(0, __builtin_bit_cast(int, v), 0x140, 0xF, 0xF, true));
    return v;
}
__device__ __forceinline__ f32x4 mfma16(bf16x8 a, bf16x8 b, f32x4 c) { return __builtin_amdgcn_mfma_f32_16x16x32_bf16(a, b, c, 0, 0, 0); }

__device__ __forceinline__ float row_rstd(const float* ssp, int r) {
    if (r >= MREAL) return 0.f;
    const f32x4 a = *(const f32x4*)(ssp + (size_t)r * 16), b = *(const f32x4*)(ssp + (size_t)r * 16 + 4), c = *(const f32x4*)(ssp + (size_t)r * 16 + 8), d = *(const f32x4*)(ssp + (size_t)r * 16 + 12);
    const float s = (((a[0] + a[1]) + (a[2] + a[3])) + ((b[0] + b[1]) + (b[2] + b[3]))) + (((c[0] + c[1]) + (c[2] + c[3])) + ((d[0] + d[1]) + (d[2] + d[3])));
    return rsqrtf(s * (1.0f / DM) + EPS);
}
__device__ __forceinline__ float row_rstd4(const float* ssp, int r, int fq) {
    const f32x4 a = *(const f32x4*)(ssp + (size_t)r * 16 + 4 * fq);
    float s = (a[0] + a[1]) + (a[2] + a[3]);
    s += __shfl_xor(s, 16); s += __shfl_xor(s, 32);
    return rsqrtf(s * (1.0f / DM) + EPS);
}
__device__ __forceinline__ void swiglu2(float g0, float u0, float g1, float u1, float& h0, float& h1) {
    const float c0 = fmaxf(g0, -40.f), c1 = fmaxf(g1, -40.f);
    const float a = 1.0f + __expf(-c0), b = 1.0f + __expf(-c1), r = __builtin_amdgcn_rcpf(a * b);
    h0 = c0 * (r * b) * u0; h1 = c1 * (r * a) * u1;
}
struct EpiSwiglu {
    static constexpr bool PERM = true, AFTER_DRAIN = false;
    bf16_t* H; const float* ss;
    __device__ __forceinline__ void operator()(const f32x4 (&acc)[2][2][4][2], const pg8::Unit& u, int wr, int wc, int fr, int fq) const {
        const int row0 = u.pm * 256 + wr * 64 + fr, col0 = u.pn * 128 + wc * 32 + 8 * fq;
#pragma unroll
        for (int ai = 0; ai < 2; ++ai)
#pragma unroll
            for (int m = 0; m < 4; ++m) {
                const int r = row0 + ai * 128 + m * 16;
                const float rs = ss ? row_rstd4(ss, r, fq) : 1.0f;
                float h[8];
#pragma unroll
                for (int n = 0; n < 2; ++n)
#pragma unroll
                    for (int j = 0; j < 4; j += 2) swiglu2(acc[ai][0][m][n][j] * rs, acc[ai][1][m][n][j] * rs, acc[ai][0][m][n][j + 1] * rs, acc[ai][1][m][n][j + 1] * rs, h[n * 4 + j], h[n * 4 + j + 1]);
                u32x4 w; w.x = cvt_pk(h[0], h[1]); w.y = cvt_pk(h[2], h[3]); w.z = cvt_pk(h[4], h[5]); w.w = cvt_pk(h[6], h[7]);
                *(u32x4*)(H + (size_t)r * DFF + col0) = w;
            }
    }
};
template <bool RESB16, bool WF32, bool WB16, bool SUMSQ, bool HALF> struct EpiResid {
    static constexpr bool PERM = true, AFTER_DRAIN = false;
    const void* resP; const void* resS; float* Yo; bf16_t* XBo; float* sso;
    __device__ __forceinline__ void operator()(const f32x4 (&acc)[2][2][4][2], const pg8::Unit& u, int wr, int wc, int fr, int fq) const {
        const int row0 = u.pm * 256 + wr * 64 + fr, col0 = u.pn * 256 + wc * 32 + 8 * fq;
        const char* const rP = (const char*)resP; const char* const rS = (const char*)resS - (size_t)MPR * DM * (RESB16 ? 2 : 4);
        float* const Y = Yo; const float scale = HALF ? 0.5f : 1.0f; bf16_t* const XB = XBo; float* const ss = sso;
#pragma unroll
        for (int ai = 0; ai < 2; ++ai)
#pragma unroll
            for (int m = 0; m < 4; ++m) {
                const int r = row0 + ai * 128 + m * 16; float s = 0.f;
                if (r < MREAL) {
                    const char* rp = ((r < MPR) ? rP : rS) + (size_t)r * DM * (RESB16 ? 2 : 4);
#pragma unroll
                    for (int bj = 0; bj < 2; ++bj) {
                        const int c = col0 + bj * 128;
                        f32x4 r0, r1;
                        if (RESB16) { const u32x4 w = *(const u32x4*)(rp + (size_t)c * 2); r0 = (f32x4){bflo(w.x), bfhi(w.x), bflo(w.y), bfhi(w.y)}; r1 = (f32x4){bflo(w.z), bfhi(w.z), bflo(w.w), bfhi(w.w)}; }
                        else { r0 = *(const f32x4*)(rp + (size_t)c * 4); r1 = *(const f32x4*)(rp + (size_t)c * 4 + 16); }
                        const f32x4 v0 = r0 + acc[ai][bj][m][0] * scale, v1 = r1 + acc[ai][bj][m][1] * scale;
                        if (WF32) { *(f32x4*)(Y + (size_t)r * DM + c) = v0; *(f32x4*)(Y + (size_t)r * DM + c + 4) = v1; }
                        if (WB16) { u32x4 w; w.x = cvt_pk(v0[0], v0[1]); w.y = cvt_pk(v0[2], v0[3]); w.z = cvt_pk(v1[0], v1[1]); w.w = cvt_pk(v1[2], v1[3]);
                            *(u32x4*)(XB + (size_t)r * DM + c) = w; }
                        if (SUMSQ) s += (v0[0] * v0[0] + v0[1] * v0[1]) + (v0[2] * v0[2] + v0[3] * v0[3]) + (v1[0] * v1[0] + v1[1] * v1[1]) + (v1[2] * v1[2] + v1[3] * v1[3]);
                    }
                }
                if (SUMSQ) { s += __shfl_xor(s, 16); s += __shfl_xor(s, 32); if (fq == 0 && r < MREAL) ss[(size_t)r * 16 + u.pn * 4 + wc] = s; }
            }
    }
};
struct EpiInproj {
    static constexpr bool PERM = true, AFTER_DRAIN = false;
    bf16_t* P; float* gba; const float* ss;
    __device__ __forceinline__ void operator()(const f32x4 (&acc)[2][2][4][2], const pg8::Unit& u, int wr, int wc, int fr, int fq) const {
        const int row0 = u.pm * 256 + wr * 64 + fr, col0 = u.pn * 256 + wc * 32 + 8 * fq;
#pragma unroll
        for (int ai = 0; ai < 2; ++ai)
#pragma unroll
            for (int m = 0; m < 4; ++m) {
                const int r = row0 + ai * 128 + m * 16;
                const float rs = row_rstd4(ss, r, fq);
                if (u.pn < 11) {
#pragma unroll
                    for (int bj = 0; bj < 2; ++bj) { const f32x4 v0 = acc[ai][bj][m][0] * rs, v1 = acc[ai][bj][m][1] * rs;
                        u32x4 w; w.x = cvt_pk(v0[0], v0[1]); w.y = cvt_pk(v0[2], v0[3]); w.z = cvt_pk(v1[0], v1[1]); w.w = cvt_pk(v1[2], v1[3]);
                        *(u32x4*)(P + (size_t)r * PW + col0 + bj * 128) = w; }
                } else if (wc == 0 && fq == 0) {
                    *(f32x4*)(gba + (size_t)r * 8) = acc[ai][0][m][0] * rs; *(f32x4*)(gba + (size_t)r * 8 + 4) = acc[ai][0][m][1] * rs;
                }
            }
    }
};


template <int NT, bool SS>
__device__ __forceinline__ void skinny_mm(const bf16_t* A, int lda, const bf16_t* W, int K, int wrow0, int wrow1, int wid, int fr, int fq, f32x4 (&acc)[NT], float& ss, LAS unsigned char* lds) {
    const int lane = fq * 16 + fr, kper = K >> 3, nks = kper >> 5;
    const bf16_t* ap = A + (size_t)fr * lda + wid * kper + 8 * fq;
    const bf16_t* w0 = W + (size_t)(wrow0 + fr) * K + wid * kper + 8 * fq; const bf16_t* w1 = W + (size_t)(wrow1 + fr) * K + wid * kper + 8 * fq;
    f32x4 pa[NT][8]; float sp[8];
#pragma unroll
    for (int mt = 0; mt < 8; ++mt) { sp[mt] = 0.f;
#pragma unroll
        for (int nt = 0; nt < NT; ++nt) pa[nt][mt] = (f32x4){0.f, 0.f, 0.f, 0.f}; }
#pragma unroll 2
    for (int ks = 0; ks < nks; ++ks) {
        const bf16x8 b0 = *(const bf16x8*)(w0 + 32 * ks); bf16x8 b1 = b0; if (NT == 2) b1 = *(const bf16x8*)(w1 + 32 * ks);
        bf16x8 av[8];
#pragma unroll
        for (int mt = 0; mt < 8; ++mt) av[mt] = *(const bf16x8*)(ap + (size_t)(16 * mt) * lda + 32 * ks);
#pragma unroll
        for (int mt = 0; mt < 8; ++mt) {
            pa[0][mt] = mfma16(b0, av[mt], pa[0][mt]);
            if (NT == 2) pa[NT - 1][mt] = mfma16(b1, av[mt], pa[NT - 1][mt]);
            if (SS) { const u32x4 u = __builtin_bit_cast(u32x4, av[mt]);
#pragma unroll
                for (int k = 0; k < 4; ++k) { const float lo = bflo(u[k]), hi = bfhi(u[k]); sp[mt] += lo * lo + hi * hi; } }
        }
    }
    LAS f32x4* red = (LAS f32x4*)lds;
    LAS float* sred = (LAS float*)(lds + 8 * NT * 8 * 64 * 16);
#pragma unroll
    for (int mt = 0; mt < 8; ++mt) {
#pragma unroll
        for (int nt = 0; nt < NT; ++nt) red[((wid * NT + nt) * 8 + mt) * 64 + lane] = pa[nt][mt];
        if (SS) sred[(wid * 8 + mt) * 64 + lane] = sp[mt];
    }
    __syncthreads();
    float s = 0.f;
#pragma unroll
    for (int nt = 0; nt < NT; ++nt) acc[nt] = (f32x4){0.f, 0.f, 0.f, 0.f};
#pragma unroll
    for (int v = 0; v < 8; ++v) {
#pragma unroll
        for (int nt = 0; nt < NT; ++nt) acc[nt] += red[((v * NT + nt) * 8 + wid) * 64 + lane];
        if (SS) s += sred[(v * 8 + wid) * 64 + lane];
    }
    if (SS) { s += __shfl_xor(s, 16); s += __shfl_xor(s, 32); }
    ss = s;
    __syncthreads();
}
template <bool SS> __device__ __forceinline__ void sk_ffn_in(const bf16_t* X, const bf16_t* Wt, bf16_t* H, int slab, int wid, int fr, int fq, LAS unsigned char* lds) {
    const int j0 = 16 * slab, wr0 = (j0 >> 7) * 256 + (j0 & 127);
    f32x4 acc[2]; float ss;
    skinny_mm<2, SS>(X + (size_t)MPR * DM, DM, Wt, DM, wr0, wr0 + 128, wid, fr, fq, acc, ss, lds);
    const float rs = SS ? rsqrtf(ss * (1.0f / DM) + EPS) : 1.0f;
    float h[4];
#pragma unroll
    for (int e = 0; e < 4; ++e) h[e] = silu(acc[0][e] * rs) * (acc[1][e] * rs);
    u32x2 w; w.x = cvt_pk(h[0], h[1]); w.y = cvt_pk(h[2], h[3]);
    *(u32x2*)(H + (size_t)(MPR + 16 * wid + fr) * DFF + j0 + 4 * fq) = w;
}
template <bool OUTF32> __device__ __forceinline__ void sk_ffn_out(const bf16_t* Hb, const bf16_t* Wt, const float* resf, float* outf, bf16_t* outb, int slab, int wid, int fr, int fq, LAS unsigned char* lds) {
    f32x4 acc[1]; float ss;
    skinny_mm<1, false>(Hb + (size_t)MPR * DFF, DFF, Wt, DFF, 16 * slab, 0, wid, fr, fq, acc, ss, lds);
    const int rl = 16 * wid + fr, c = 16 * slab + 4 * fq;
    f32x4 rv;
    if (OUTF32) { const u32x2 xr = *(const u32x2*)((const bf16_t*)resf + (size_t)rl * DM + c); rv = (f32x4){bflo(xr.x), bfhi(xr.x), bflo(xr.y), bfhi(xr.y)}; }
    else rv = *(const f32x4*)(resf + (size_t)rl * DM + c);
    const f32x4 v = rv + acc[0] * 0.5f;
    { u32x2 w; w.x = cvt_pk(v[0], v[1]); w.y = cvt_pk(v[2], v[3]); *(u32x2*)(outb + (size_t)rl * DM + c) = w; }
}
__device__ __forceinline__ void sk_inproj(const bf16_t* X, const bf16_t* Wt, bf16_t* P, float* gba, int slab, int wid, int fr, int fq, LAS unsigned char* lds) {
    const int n0 = 32 * slab; f32x4 acc[2]; float ss;
    skinny_mm<2, true>(X + (size_t)MPR * DM, DM, Wt, DM, n0, n0 + 16, wid, fr, fq, acc, ss, lds);
    const float rs = rsqrtf(ss * (1.0f / DM) + EPS); const int r = MPR + 16 * wid + fr;
    if (n0 < PW) {
#pragma unroll
        for (int nt = 0; nt < 2; ++nt) { const f32x4 v = acc[nt] * rs; u32x2 w; w.x = cvt_pk(v[0], v[1]); w.y = cvt_pk(v[2], v[3]); *(u32x2*)(P + (size_t)r * PW + n0 + 16 * nt + 4 * fq) = w; }
    } else if (fq < 2) *(f32x4*)(gba + (size_t)r * 8 + 4 * fq) = acc[0] * rs;
}
__device__ __forceinline__ void sk_outproj(const bf16_t* Pm, const bf16_t* Wt, const bf16_t* X1b, float* X2f, bf16_t* X2b, int slab, int wid, int fr, int fq, LAS unsigned char* lds) {
    const int n0 = 32 * slab; f32x4 acc[2]; float ss;
    skinny_mm<2, false>(Pm + (size_t)MPR * PW, PW, Wt, DM, n0, n0 + 16, wid, fr, fq, acc, ss, lds);
    const int r = MPR + 16 * wid + fr;
#pragma unroll
    for (int nt = 0; nt < 2; ++nt) { const int c = n0 + 16 * nt + 4 * fq; const u32x2 xr = *(const u32x2*)(X1b + (size_t)r * DM + c);
        const f32x4 v = (f32x4){bflo(xr.x), bfhi(xr.x), bflo(xr.y), bfhi(xr.y)} + acc[nt];
        u32x2 w; w.x = cvt_pk(v[0], v[1]); w.y = cvt_pk(v[2], v[3]); *(u32x2*)(X2b + (size_t)r * DM + c) = w; }
}

__device__ __forceinline__ void transpose_item(const float* W, int K, int N, bf16_t* WT, int k0, int n0, int drow0, const float* gs, LAS float* scr, int lane) {
    float wv[32];
#pragma unroll
    for (int i = 0; i < 32; ++i) { const int kk = 2 * i + (lane >> 5), n = n0 + (lane & 31); wv[i] = (n < N) ? W[(size_t)(k0 + kk) * N + n] : 0.f; }
#pragma unroll
    for (int i = 0; i < 32; ++i) { const int kk = 2 * i + (lane >> 5); float v = wv[i]; if (gs) v *= gs[k0 + kk]; scr[kk * 33 + (lane & 31)] = v; }
    asm volatile("s_waitcnt lgkmcnt(0)" ::: "memory");
    const int c = lane & 7;
#pragma unroll
    for (int j = 0; j < 4; ++j) { const int nn = (lane >> 3) + 8 * j; const LAS float* s = scr + (8 * c) * 33 + nn;
        u32x4 o; o.x = cvt_pk(s[0 * 33], s[1 * 33]); o.y = cvt_pk(s[2 * 33], s[3 * 33]); o.z = cvt_pk(s[4 * 33], s[5 * 33]); o.w = cvt_pk(s[6 * 33], s[7 * 33]);
        *(u32x4*)(WT + (size_t)(drow0 + nn) * K + k0 + 8 * c) = o; }
    asm volatile("s_waitcnt lgkmcnt(0)" ::: "memory");
}
__device__ __forceinline__ int map_ffin_row(int n0) { return n0 < DFF ? (n0 >> 7) * 256 + (n0 & 127) : ((n0 - DFF) >> 7) * 256 + 128 + ((n0 - DFF) & 127); }

__device__ __forceinline__ void p0_prologue(const Params& p, LAS unsigned char* lds, int vb, int G) {
    const int tid = threadIdx.x, lane = tid & 63, wid = tid >> 6;
    LAS float* scr = (LAS float*)(lds + wid * 16384);
    const int gw = vb * 8 + wid, NGW = G * 8;
    bf16_t* W1IN = (bf16_t*)(p.ws + WS_W1IN); bf16_t* W1OUT = (bf16_t*)(p.ws + WS_W1OUT); bf16_t* WINMIX = (bf16_t*)(p.ws + WS_WINMIX);
    bf16_t* WOUTMIX = (bf16_t*)(p.ws + WS_WOUTMIX); bf16_t* W2IN = (bf16_t*)(p.ws + WS_W2IN); bf16_t* W2OUT = (bf16_t*)(p.ws + WS_W2OUT);
    constexpr int I_FIN = 16 * 176, I_FOUT = 44 * 32, I_INMIX = 16 * 89;
    constexpr int NITEMS = I_FIN + I_FOUT + I_INMIX;
    for (int it = gw; it < NITEMS; it += NGW) {
        int r = it;
        if (r < I_FIN) { const int kb = r / 176, nb = r % 176; transpose_item(p.in[7], DM, 2 * DFF, W1IN, kb * 64, nb * 32, map_ffin_row(nb * 32), nullptr, scr, lane); continue; } r -= I_FIN;
        if (r < I_FOUT) { const int kb = r / 32, nb = r % 32; transpose_item(p.in[8], DFF, DM, W1OUT, kb * 64, nb * 32, nb * 32, nullptr, scr, lane); continue; } r -= I_FOUT;
        { const int kb = r / 89, nb = r % 89; transpose_item(p.in[10], DM, 2824, WINMIX, kb * 64, nb * 32, nb * 32, p.in[9], scr, lane); }
    }
    bf16_t* XN = (bf16_t*)(p.ws + WS_XN); const float* g1 = p.in[6];
    f32x4 gv[4];
#pragma unroll
    for (int j = 0; j < 4; ++j) gv[j] = *((const f32x4*)g1 + lane + 64 * j);
    {
        f32x4 v[4], vn[4];
        int m = gw;
        if (m < MREAL) { const f32x4* xr = (const f32x4*)((m < MPR) ? p.in[0] + (size_t)m * DM : p.in[1] + (size_t)(m - MPR) * DM) + lane;
#pragma unroll
            for (int j = 0; j < 4; ++j) v[j] = xr[64 * j]; }
        for (; m < MREAL; m += NGW) {
            const int mn = m + NGW;
            if (mn < MREAL) { const f32x4* xr = (const f32x4*)((mn < MPR) ? p.in[0] + (size_t)mn * DM : p.in[1] + (size_t)(mn - MPR) * DM) + lane;
#pragma unroll
                for (int j = 0; j < 4; ++j) vn[j] = xr[64 * j]; }
            float s = 0.f;
#pragma unroll
            for (int j = 0; j < 4; ++j) s += (v[j][0] * v[j][0] + v[j][1] * v[j][1]) + (v[j][2] * v[j][2] + v[j][3] * v[j][3]);
            const float rstd = rsqrtf(wave_sum(s) * (1.0f / DM) + EPS);
            unsigned long long* o8 = (unsigned long long*)(XN + (size_t)m * DM) + lane;
#pragma unroll
            for (int j = 0; j < 4; ++j) { const f32x4 y = v[j] * rstd * gv[j];
                o8[64 * j] = (unsigned long long)cvt_pk(y[0], y[1]) | ((unsigned long long)cvt_pk(y[2], y[3]) << 32); }
#pragma unroll
            for (int j = 0; j < 4; ++j) v[j] = vn[j];
        }
    }
}

template <bool SWX = false, bool SWY = false>
__device__ __forceinline__ f32x4 tile_mm(const LAS bf16_t* X, int ldx, int mt, const LAS bf16_t* Y, int ldy, int nt, int nks, int fr, int fq) {
    f32x4 acc = (f32x4){0.f, 0.f, 0.f, 0.f};
    const int rx = 16 * mt + fr, ry = 16 * nt + fr, sx = SWX ? ((rx >> 3) & 7) : 0, sy = SWY ? ((ry >> 3) & 7) : 0;
    const LAS bf16_t* xp = X + rx * ldx; const LAS bf16_t* yp = Y + ry * ldy;
    for (int ks = 0; ks < nks; ++ks) acc = mfma16(*(const LAS bf16x8*)(xp + 8 * ((4 * ks + fq) ^ sx)), *(const LAS bf16x8*)(yp + 8 * ((4 * ks + fq) ^ sy)), acc);
    return acc;
}
constexpr int G1_QS = 0, G1_KS = 17408, G1_VBT = 34816, G1_KBT = 53248, G1_KDT = 71680, G1_UT = 90112, G1_WT = 108544, G1_QK = 126976, G1_TB = 136192, G1_GC = 145408, G1_BETA = 145664, G1_TT = 146176, G1_A10 = 148736, G1_PT = 151296;

__device__ __forceinline__ void gdn_prep_unit(const Params& p, LAS unsigned char* lds, int unit) {
    const int tid = threadIdx.x, lane = tid & 63, wid = tid >> 6, fr = lane & 15, fq = lane >> 4;
    const int bh = unit >> 7, n = unit & 127, b = bh >> 2, h = bh & 3;
    const int tok0 = b * SEQ + n * 64;
    LAS bf16_t* Qs = (LAS bf16_t*)(lds + G1_QS); LAS bf16_t* Ks = (LAS bf16_t*)(lds + G1_KS); LAS bf16_t* VbT = (LAS bf16_t*)(lds + G1_VBT);
    LAS bf16_t* KbT = (LAS bf16_t*)(lds + G1_KBT); LAS bf16_t* KdT = (LAS bf16_t*)(lds + G1_KDT); LAS bf16_t* UT = (LAS bf16_t*)(lds + G1_UT);
    LAS bf16_t* WT = (LAS bf16_t*)(lds + G1_WT); LAS float* Af = (LAS float*)(lds + G1_WT); LAS bf16_t* QK = (LAS bf16_t*)(lds + G1_QK);
    LAS bf16_t* Tb = (LAS bf16_t*)(lds + G1_TB); LAS bf16_t* TT = (LAS bf16_t*)(lds + G1_TT); LAS bf16_t* A10b = (LAS bf16_t*)(lds + G1_A10); LAS bf16_t* PT = (LAS bf16_t*)(lds + G1_PT); LAS float* gcs = (LAS float*)(lds + G1_GC); LAS float* betas = (LAS float*)(lds + G1_BETA);
    const bf16_t* PB = (const bf16_t*)(p.ws + WS_H); const float* GBA = (const float*)(p.ws + WS_GBA);
    LAS unsigned char* raw = lds + G1_UT;
    for (int pc4 = wid; pc4 < 51; pc4 += 8) {
        int pc = pc4 * 4 + (lane >> 4); pc = pc < 200 ? pc : 200;
        const int r = pc / 3, seg = pc - 3 * r; int tt = n * 64 - 3 + r; tt = tt < 0 ? 0 : tt;
        __builtin_amdgcn_global_load_lds((const unsigned*)(PB + (size_t)(b * SEQ + tt) * PW + 768 + seg * 512 + h * 128 + (lane & 15) * 8), (LAS unsigned*)(raw + pc4 * 1024), 16, 0, 0);
    }
    if (tid < 64) {
        const float* gb = GBA + (size_t)(tok0 + tid) * 8;
        const float bt = 1.0f / (1.0f + __expf(-gb[h]));
        const float x = gb[4 + h] + p.in[14][h]; const float sp = x > 20.f ? x : log1pf(__expf(x));
        float c = -__expf(p.in[13][h]) * sp;
#pragma unroll
        for (int o = 1; o < 64; o <<= 1) { const float t = __shfl_up(c, o); if (lane >= o) c += t; }
        gcs[tid] = c; betas[tid] = bt;
    }
    asm volatile("s_waitcnt vmcnt(0)" ::: "memory");
    __syncthreads();
    const float gclast = gcs[63];
    const float* cw = p.in[12];
#pragma unroll 1
    for (int it = 0; it < 6; ++it) {
        const int item = tid + 512 * it, l16 = item & 15, row = item >> 4, which = row >> 6, t = row & 63;
        const int cch = which * 512 + h * 128 + l16 * 8;
        float a[8];
#pragma unroll
        for (int e = 0; e < 8; ++e) a[e] = 0.f;
#pragma unroll
        for (int j = 0; j < 4; ++j) {
            const int tt = n * 64 + t - 3 + j;
            if (tt >= 0) {
                const u32x4 xv = *(const LAS u32x4*)(raw + ((t + j) * 3 + which) * 256 + l16 * 16);
                const f32x4 w0 = *(const f32x4*)(cw + j * CONVC + cch), w1 = *(const f32x4*)(cw + j * CONVC + cch + 4);
                a[0] += w0[0] * bflo(xv.x); a[1] += w0[1] * bfhi(xv.x); a[2] += w0[2] * bflo(xv.y); a[3] += w0[3] * bfhi(xv.y);
                a[4] += w1[0] * bflo(xv.z); a[5] += w1[1] * bfhi(xv.z); a[6] += w1[2] * bflo(xv.w); a[7] += w1[3] * bfhi(xv.w);
            }
        }
        float ss = 0.f;
#pragma unroll
        for (int e = 0; e < 8; ++e) { a[e] = silu(a[e]); ss += a[e] * a[e]; }
        ss = row16_sum(ss);
        const float gct = gcs[t], bt = betas[t];
        const int tsw = (((t >> 3) ^ (l16 & 7)) << 3) | (t & 7);
        if (which == 0) {
            const float sc = rsqrtf(ss + EPS) * 0.08838834764831845f;
            u32x4 w; w.x = cvt_pk(a[0] * sc, a[1] * sc); w.y = cvt_pk(a[2] * sc, a[3] * sc); w.z = cvt_pk(a[4] * sc, a[5] * sc); w.w = cvt_pk(a[6] * sc, a[7] * sc);
            *(LAS u32x4*)(Qs + t * 136 + l16 * 8) = w;
        } else if (which == 1) {
            const float sc = rsqrtf(ss + EPS);
            u32x4 w; w.x = cvt_pk(a[0] * sc, a[1] * sc); w.y = cvt_pk(a[2] * sc, a[3] * sc); w.z = cvt_pk(a[4] * sc, a[5] * sc); w.w = cvt_pk(a[6] * sc, a[7] * sc);
            *(LAS u32x4*)(Ks + t * 136 + l16 * 8) = w;
            const float sb = sc * bt * __expf(gct), sd = sc * __expf(gclast - gct);
#pragma unroll
            for (int e = 0; e < 8; ++e) { KbT[(l16 * 8 + e) * 72 + tsw] = f2bf(a[e] * sb); KdT[(l16 * 8 + e) * 72 + tsw] = f2bf(a[e] * sd); }
        } else {
#pragma unroll
            for (int e = 0; e < 8; ++e) VbT[(l16 * 8 + e) * 72 + tsw] = f2bf(a[e] * bt);
        }
    }
    __syncthreads();
#pragma unroll 2
    for (int r = 0; r < 4; ++r) {
        const int job = wid + 8 * r, kind = job >> 4, tile = job & 15, it = tile >> 2, jt = tile & 3;
        if (kind == 0) {
            if (jt > it) continue;
            const f32x4 acc = tile_mm(Ks, 136, it, Ks, 136, jt, 4, fr, fq);
            const int j = 16 * jt + fr; const float gcj = gcs[j];
            float v[4];
#pragma unroll
            for (int e = 0; e < 4; ++e) { const int i = 16 * it + 4 * fq + e; const bool ok = i > j; v[e] = ok ? acc[e] * __expf(gcs[i] - gcj) * betas[i] : 0.f; }
            *(LAS f32x4*)(Af + j * 68 + 16 * it + 4 * fq) = (f32x4){v[0], v[1], v[2], v[3]};
            if (it >= 2 && jt < 2) {
#pragma unroll
                for (int e = 0; e < 4; ++e) A10b[(16 * (it - 2) + 4 * fq + e) * 40 + j] = f2bf(v[e]); }
        } else {
            const f32x4 acc = tile_mm(Ks, 136, jt, Qs, 136, it, 4, fr, fq);
            const int i = 16 * it + fr; const float gci = gcs[i];
            float v[4];
#pragma unroll
            for (int e = 0; e < 4; ++e) { const int j = 16 * jt + 4 * fq + e; const bool ok = i >= j; v[e] = ok ? acc[e] * __expf(gci - gcs[j]) : 0.f; }
            u32x2 w; w.x = cvt_pk(v[0], v[1]); w.y = cvt_pk(v[2], v[3]); *(LAS u32x2*)(QK + i * 72 + 16 * jt + 4 * fq) = w;
        }
    }
    __syncthreads();
    if (wid < 2) {
        const int ofs = wid * 32, cl = lane & 31; const LAS float* Ab = Af + ofs * 69; LAS bf16_t* Tw = Tb + ofs * 73 + cl; LAS bf16_t* Tt = (wid == 0) ? TT + cl * 40 : PT + cl * 40;
        f32x2v r2[16];
#pragma unroll
        for (int k = 0; k < 16; ++k) r2[k] = (f32x2v){(cl == 2 * k) ? 1.0f : 0.0f, (cl == 2 * k + 1) ? 1.0f : 0.0f};
        const f32x4 a0 = *(const LAS f32x4*)(Ab + 0);
        const f32x4 a1 = *(const LAS f32x4*)(Ab + 4);
        const f32x4 a2 = *(const LAS f32x4*)(Ab + 8);
        const f32x4 a3 = *(const LAS f32x4*)(Ab + 12);
        const f32x4 a4 = *(const LAS f32x4*)(Ab + 16);
        const float t0 = r2[0][0]; const f32x2v T0 = (f32x2v){t0, t0}; Tw[0] = f2bf(t0); Tt[0] = f2bf(t0);
        r2[0] -= (f32x2v){a0[0], a0[1]} * T0; r2[1] -= (f32x2v){a0[2], a0[3]} * T0;
        const f32x4 a5 = *(const LAS f32x4*)(Ab + 20);
        r2[2] -= (f32x2v){a1[0], a1[1]} * T0; r2[3] -= (f32x2v){a1[2], a1[3]} * T0;
        const f32x4 a6 = *(const LAS f32x4*)(Ab + 24);
        r2[4] -= (f32x2v){a2[0], a2[1]} * T0; r2[5] -= (f32x2v){a2[2], a2[3]} * T0;
        const f32x4 a7 = *(const LAS f32x4*)(Ab + 28);
        r2[6] -= (f32x2v){a3[0], a3[1]} * T0; r2[7] -= (f32x2v){a3[2], a3[3]} * T0;
        const f32x4 a8 = *(const LAS f32x4*)(Ab + 68);
        r2[8] -= (f32x2v){a4[0], a4[1]} * T0; r2[9] -= (f32x2v){a4[2], a4[3]} * T0;
        const f32x4 a9 = *(const LAS f32x4*)(Ab + 72);
        r2[10] -= (f32x2v){a5[0], a5[1]} * T0; r2[11] -= (f32x2v){a5[2], a5[3]} * T0;
        const f32x4 a10 = *(const LAS f32x4*)(Ab + 76);
        r2[12] -= (f32x2v){a6[0], a6[1]} * T0; r2[13] -= (f32x2v){a6[2], a6[3]} * T0;
        const f32x4 a11 = *(const LAS f32x4*)(Ab + 80);
        r2[14] -= (f32x2v){a7[0], a7[1]} * T0; r2[15] -= (f32x2v){a7[2], a7[3]} * T0;
        const f32x4 a12 = *(const LAS f32x4*)(Ab + 84);
        const float t1 = r2[0][1]; const f32x2v T1 = (f32x2v){t1, t1}; Tw[72] = f2bf(t1); Tt[1] = f2bf(t1);
        r2[1] -= (f32x2v){a8[2], a8[3]} * T1;
        const f32x4 a13 = *(const LAS f32x4*)(Ab + 88);
        r2[2] -= (f32x2v){a9[0], a9[1]} * T1; r2[3] -= (f32x2v){a9[2], a9[3]} * T1;
        const f32x4 a14 = *(const LAS f32x4*)(Ab + 92);
        r2[4] -= (f32x2v){a10[0], a10[1]} * T1; r2[5] -= (f32x2v){a10[2], a10[3]} * T1;
        const f32x4 a15 = *(const LAS f32x4*)(Ab + 96);
        r2[6] -= (f32x2v){a11[0], a11[1]} * T1; r2[7] -= (f32x2v){a11[2], a11[3]} * T1;
        const f32x4 a16 = *(const LAS f32x4*)(Ab + 136);
        r2[8] -= (f32x2v){a12[0], a12[1]} * T1; r2[9] -= (f32x2v){a12[2], a12[3]} * T1;
        const f32x4 a17 = *(const LAS f32x4*)(Ab + 140);
        r2[10] -= (f32x2v){a13[0], a13[1]} * T1; r2[11] -= (f32x2v){a13[2], a13[3]} * T1;
        const f32x4 a18 = *(const LAS f32x4*)(Ab + 144);
        r2[12] -= (f32x2v){a14[0], a14[1]} * T1; r2[13] -= (f32x2v){a14[2], a14[3]} * T1;
        const f32x4 a19 = *(const LAS f32x4*)(Ab + 148);
        r2[14] -= (f32x2v){a15[0], a15[1]} * T1; r2[15] -= (f32x2v){a15[2], a15[3]} * T1;
        const f32x4 a20 = *(const LAS f32x4*)(Ab + 152);
        const float t2 = r2[1][0]; const f32x2v T2 = (f32x2v){t2, t2}; Tw[144] = f2bf(t2); Tt[2] = f2bf(t2);
        r2[1] -= (f32x2v){a16[2], a16[3]} * T2;
        const f32x4 a21 = *(const LAS f32x4*)(Ab + 156);
        r2[2] -= (f32x2v){a17[0], a17[1]} * T2; r2[3] -= (f32x2v){a17[2], a17[3]} * T2;
        const f32x4 a22 = *(const LAS f32x4*)(Ab + 160);
        r2[4] -= (f32x2v){a18[0], a18[1]} * T2; r2[5] -= (f32x2v){a18[2], a18[3]} * T2;
        const f32x4 a23 = *(const LAS f32x4*)(Ab + 164);
        r2[6] -= (f32x2v){a19[0], a19[1]} * T2; r2[7] -= (f32x2v){a19[2], a19[3]} * T2;
        const f32x4 a24 = *(const LAS f32x4*)(Ab + 208);
        r2[8] -= (f32x2v){a20[0], a20[1]} * T2; r2[9] -= (f32x2v){a20[2], a20[3]} * T2;
        const f32x4 a25 = *(const LAS f32x4*)(Ab + 212);
        r2[10] -= (f32x2v){a21[0], a21[1]} * T2; r2[11] -= (f32x2v){a21[2], a21[3]} * T2;
        const f32x4 a26 = *(const LAS f32x4*)(Ab + 216);
        r2[12] -= (f32x2v){a22[0], a22[1]} * T2; r2[13] -= (f32x2v){a22[2], a22[3]} * T2;
        const f32x4 a27 = *(const LAS f32x4*)(Ab + 220);
        r2[14] -= (f32x2v){a23[0], a23[1]} * T2; r2[15] -= (f32x2v){a23[2], a23[3]} * T2;
        const f32x4 a28 = *(const LAS f32x4*)(Ab + 224);
        const float t3 = r2[1][1]; const f32x2v T3 = (f32x2v){t3, t3}; Tw[216] = f2bf(t3); Tt[3] = f2bf(t3);
        r2[2] -= (f32x2v){a24[0], a24[1]} * T3; r2[3] -= (f32x2v){a24[2], a24[3]} * T3;
        const f32x4 a29 = *(const LAS f32x4*)(Ab + 228);
        r2[4] -= (f32x2v){a25[0], a25[1]} * T3; r2[5] -= (f32x2v){a25[2], a25[3]} * T3;
        const f32x4 a30 = *(const LAS f32x4*)(Ab + 232);
        r2[6] -= (f32x2v){a26[0], a26[1]} * T3; r2[7] -= (f32x2v){a26[2], a26[3]} * T3;
        const f32x4 a31 = *(const LAS f32x4*)(Ab + 276);
        r2[8] -= (f32x2v){a27[0], a27[1]} * T3; r2[9] -= (f32x2v){a27[2], a27[3]} * T3;
        const f32x4 a32 = *(const LAS f32x4*)(Ab + 280);
        r2[10] -= (f32x2v){a28[0], a28[1]} * T3; r2[11] -= (f32x2v){a28[2], a28[3]} * T3;
        const f32x4 a33 = *(const LAS f32x4*)(Ab + 284);
        r2[12] -= (f32x2v){a29[0], a29[1]} * T3; r2[13] -= (f32x2v){a29[2], a29[3]} * T3;
        const f32x4 a34 = *(const LAS f32x4*)(Ab + 288);
        r2[14] -= (f32x2v){a30[0], a30[1]} * T3; r2[15] -= (f32x2v){a30[2], a30[3]} * T3;
        const f32x4 a35 = *(const LAS f32x4*)(Ab + 292);
        const float t4 = r2[2][0]; const f32x2v T4 = (f32x2v){t4, t4}; Tw[288] = f2bf(t4); Tt[4] = f2bf(t4);
        r2[2] -= (f32x2v){a31[0], a31[1]} * T4; r2[3] -= (f32x2v){a31[2], a31[3]} * T4;
        const f32x4 a36 = *(const LAS f32x4*)(Ab + 296);
        r2[4] -= (f32x2v){a32[0], a32[1]} * T4; r2[5] -= (f32x2v){a32[2], a32[3]} * T4;
        const f32x4 a37 = *(const LAS f32x4*)(Ab + 300);
        r2[6] -= (f32x2v){a33[0], a33[1]} * T4; r2[7] -= (f32x2v){a33[2], a33[3]} * T4;
        const f32x4 a38 = *(const LAS f32x4*)(Ab + 344);
        r2[8] -= (f32x2v){a34[0], a34[1]} * T4; r2[9] -= (f32x2v){a34[2], a34[3]} * T4;
        const f32x4 a39 = *(const LAS f32x4*)(Ab + 348);
        r2[10] -= (f32x2v){a35[0], a35[1]} * T4; r2[11] -= (f32x2v){a35[2], a35[3]} * T4;
        const f32x4 a40 = *(const LAS f32x4*)(Ab + 352);
        r2[12] -= (f32x2v){a36[0], a36[1]} * T4; r2[13] -= (f32x2v){a36[2], a36[3]} * T4;
        const f32x4 a41 = *(const LAS f32x4*)(Ab + 356);
        r2[14] -= (f32x2v){a37[0], a37[1]} * T4; r2[15] -= (f32x2v){a37[2], a37[3]} * T4;
        const f32x4 a42 = *(const LAS f32x4*)(Ab + 360);
        const float t5 = r2[2][1]; const f32x2v T5 = (f32x2v){t5, t5}; Tw[360] = f2bf(t5); Tt[5] = f2bf(t5);
        r2[3] -= (f32x2v){a38[2], a38[3]} * T5;
        const f32x4 a43 = *(const LAS f32x4*)(Ab + 364);
        r2[4] -= (f32x2v){a39[0], a39[1]} * T5; r2[5] -= (f32x2v){a39[2], a39[3]} * T5;
        const f32x4 a44 = *(const LAS f32x4*)(Ab + 368);
        r2[6] -= (f32x2v){a40[0], a40[1]} * T5; r2[7] -= (f32x2v){a40[2], a40[3]} * T5;
        const f32x4 a45 = *(const LAS f32x4*)(Ab + 412);
        r2[8] -= (f32x2v){a41[0], a41[1]} * T5; r2[9] -= (f32x2v){a41[2], a41[3]} * T5;
        const f32x4 a46 = *(const LAS f32x4*)(Ab + 416);
        r2[10] -= (f32x2v){a42[0], a42[1]} * T5; r2[11] -= (f32x2v){a42[2], a42[3]} * T5;
        const f32x4 a47 = *(const LAS f32x4*)(Ab + 420);
        r2[12] -= (f32x2v){a43[0], a43[1]} * T5; r2[13] -= (f32x2v){a43[2], a43[3]} * T5;
        const f32x4 a48 = *(const LAS f32x4*)(Ab + 424);
        r2[14] -= (f32x2v){a44[0], a44[1]} * T5; r2[15] -= (f32x2v){a44[2], a44[3]} * T5;
        const f32x4 a49 = *(const LAS f32x4*)(Ab + 428);
        const float t6 = r2[3][0]; const f32x2v T6 = (f32x2v){t6, t6}; Tw[432] = f2bf(t6); Tt[6] = f2bf(t6);
        r2[3] -= (f32x2v){a45[2], a45[3]} * T6;
        const f32x4 a50 = *(const LAS f32x4*)(Ab + 432);
        r2[4] -= (f32x2v){a46[0], a46[1]} * T6; r2[5] -= (f32x2v){a46[2], a46[3]} * T6;
        const f32x4 a51 = *(const LAS f32x4*)(Ab + 436);
        r2[6] -= (f32x2v){a47[0], a47[1]} * T6; r2[7] -= (f32x2v){a47[2], a47[3]} * T6;
        const f32x4 a52 = *(const LAS f32x4*)(Ab + 484);
        r2[8] -= (f32x2v){a48[0], a48[1]} * T6; r2[9] -= (f32x2v){a48[2], a48[3]} * T6;
        const f32x4 a53 = *(const LAS f32x4*)(Ab + 488);
        r2[10] -= (f32x2v){a49[0], a49[1]} * T6; r2[11] -= (f32x2v){a49[2], a49[3]} * T6;
        const f32x4 a54 = *(const LAS f32x4*)(Ab + 492);
        r2[12] -= (f32x2v){a50[0], a50[1]} * T6; r2[13] -= (f32x2v){a50[2], a50[3]} * T6;
        const f32x4 a55 = *(const LAS f32x4*)(Ab + 496);
        r2[14] -= (f32x2v){a51[0], a51[1]} * T6; r2[15] -= (f32x2v){a51[2], a51[3]} * T6;
        const f32x4 a56 = *(const LAS f32x4*)(Ab + 500);
        const float t7 = r2[3][1]; const f32x2v T7 = (f32x2v){t7, t7}; Tw[504] = f2bf(t7); Tt[7] = f2bf(t7);
        r2[4] -= (f32x2v){a52[0], a52[1]} * T7; r2[5] -= (f32x2v){a52[2], a52[3]} * T7;
        const f32x4 a57 = *(const LAS f32x4*)(Ab + 504);
        r2[6] -= (f32x2v){a53[0], a53[1]} * T7; r2[7] -= (f32x2v){a53[2], a53[3]} * T7;
        const f32x4 a58 = *(const LAS f32x4*)(Ab + 552);
        r2[8] -= (f32x2v){a54[0], a54[1]} * T7; r2[9] -= (f32x2v){a54[2], a54[3]} * T7;
        const f32x4 a59 = *(const LAS f32x4*)(Ab + 556);
        r2[10] -= (f32x2v){a55[0], a55[1]} * T7; r2[11] -= (f32x2v){a55[2], a55[3]} * T7;
        const f32x4 a60 = *(const LAS f32x4*)(Ab + 560);
        r2[12] -= (f32x2v){a56[0], a56[1]} * T7; r2[13] -= (f32x2v){a56[2], a56[3]} * T7;
        const f32x4 a61 = *(const LAS f32x4*)(Ab + 564);
        r2[14] -= (f32x2v){a57[0], a57[1]} * T7; r2[15] -= (f32x2v){a57[2], a57[3]} * T7;
        const f32x4 a62 = *(const LAS f32x4*)(Ab + 568);
        const float t8 = r2[4][0]; const f32x2v T8 = (f32x2v){t8, t8}; Tw[576] = f2bf(t8); Tt[8] = f2bf(t8);
        r2[4] -= (f32x2v){a58[0], a58[1]} * T8; r2[5] -= (f32x2v){a58[2], a58[3]} * T8;
        const f32x4 a63 = *(const LAS f32x4*)(Ab + 572);
        r2[6] -= (f32x2v){a59[0], a59[1]} * T8; r2[7] -= (f32x2v){a59[2], a59[3]} * T8;
        const f32x4 a64 = *(const LAS f32x4*)(Ab + 620);
        r2[8] -= (f32x2v){a60[0], a60[1]} * T8; r2[9] -= (f32x2v){a60[2], a60[3]} * T8;
        const f32x4 a65 = *(const LAS f32x4*)(Ab + 624);
        r2[10] -= (f32x2v){a61[0], a61[1]} * T8; r2[11] -= (f32x2v){a61[2], a61[3]} * T8;
        const f32x4 a66 = *(const LAS f32x4*)(Ab + 628);
        r2[12] -= (f32x2v){a62[0], a62[1]} * T8; r2[13] -= (f32x2v){a62[2], a62[3]} * T8;
        const f32x4 a67 = *(const LAS f32x4*)(Ab + 632);
        r2[14] -= (f32x2v){a63[0], a63[1]} * T8; r2[15] -= (f32x2v){a63[2], a63[3]} * T8;
        const f32x4 a68 = *(const LAS f32x4*)(Ab + 636);
        const float t9 = r2[4][1]; const f32x2v T9 = (f32x2v){t9, t9}; Tw[648] = f2bf(t9); Tt[9] = f2bf(t9);
        r2[5] -= (f32x2v){a64[2], a64[3]} * T9;
        const f32x4 a69 = *(const LAS f32x4*)(Ab + 640);
        r2[6] -= (f32x2v){a65[0], a65[1]} * T9; r2[7] -= (f32x2v){a65[2], a65[3]} * T9;
        const f32x4 a70 = *(const LAS f32x4*)(Ab + 688);
        r2[8] -= (f32x2v){a66[0], a66[1]} * T9; r2[9] -= (f32x2v){a66[2], a66[3]} * T9;
        const f32x4 a71 = *(const LAS f32x4*)(Ab + 692);
        r2[10] -= (f32x2v){a67[0], a67[1]} * T9; r2[11] -= (f32x2v){a67[2], a67[3]} * T9;
        const f32x4 a72 = *(const LAS f32x4*)(Ab + 696);
        r2[12] -= (f32x2v){a68[0], a68[1]} * T9; r2[13] -= (f32x2v){a68[2], a68[3]} * T9;
        const f32x4 a73 = *(const LAS f32x4*)(Ab + 700);
        r2[14] -= (f32x2v){a69[0], a69[1]} * T9; r2[15] -= (f32x2v){a69[2], a69[3]} * T9;
        const f32x4 a74 = *(const LAS f32x4*)(Ab + 704);
        const float t10 = r2[5][0]; const f32x2v T10 = (f32x2v){t10, t10}; Tw[720] = f2bf(t10); Tt[10] = f2bf(t10);
        r2[5] -= (f32x2v){a70[2], a70[3]} * T10;
        const f32x4 a75 = *(const LAS f32x4*)(Ab + 708);
        r2[6] -= (f32x2v){a71[0], a71[1]} * T10; r2[7] -= (f32x2v){a71[2], a71[3]} * T10;
        const f32x4 a76 = *(const LAS f32x4*)(Ab + 760);
        r2[8] -= (f32x2v){a72[0], a72[1]} * T10; r2[9] -= (f32x2v){a72[2], a72[3]} * T10;
        const f32x4 a77 = *(const LAS f32x4*)(Ab + 764);
        r2[10] -= (f32x2v){a73[0], a73[1]} * T10; r2[11] -= (f32x2v){a73[2], a73[3]} * T10;
        const f32x4 a78 = *(const LAS f32x4*)(Ab + 768);
        r2[12] -= (f32x2v){a74[0], a74[1]} * T10; r2[13] -= (f32x2v){a74[2], a74[3]} * T10;
        const f32x4 a79 = *(const LAS f32x4*)(Ab + 772);
        r2[14] -= (f32x2v){a75[0], a75[1]} * T10; r2[15] -= (f32x2v){a75[2], a75[3]} * T10;
        const f32x4 a80 = *(const LAS f32x4*)(Ab + 776);
        const float t11 = r2[5][1]; const f32x2v T11 = (f32x2v){t11, t11}; Tw[792] = f2bf(t11); Tt[11] = f2bf(t11);
        r2[6] -= (f32x2v){a76[0], a76[1]} * T11; r2[7] -= (f32x2v){a76[2], a76[3]} * T11;
        const f32x4 a81 = *(const LAS f32x4*)(Ab + 828);
        r2[8] -= (f32x2v){a77[0], a77[1]} * T11; r2[9] -= (f32x2v){a77[2], a77[3]} * T11;
        const f32x4 a82 = *(const LAS f32x4*)(Ab + 832);
        r2[10] -= (f32x2v){a78[0], a78[1]} * T11; r2[11] -= (f32x2v){a78[2], a78[3]} * T11;
        const f32x4 a83 = *(const LAS f32x4*)(Ab + 836);
        r2[12] -= (f32x2v){a79[0], a79[1]} * T11; r2[13] -= (f32x2v){a79[2], a79[3]} * T11;
        const f32x4 a84 = *(const LAS f32x4*)(Ab + 840);
        r2[14] -= (f32x2v){a80[0], a80[1]} * T11; r2[15] -= (f32x2v){a80[2], a80[3]} * T11;
        const f32x4 a85 = *(const LAS f32x4*)(Ab + 844);
        const float t12 = r2[6][0]; const f32x2v T12 = (f32x2v){t12, t12}; Tw[864] = f2bf(t12); Tt[12] = f2bf(t12);
        r2[6] -= (f32x2v){a81[0], a81[1]} * T12; r2[7] -= (f32x2v){a81[2], a81[3]} * T12;
        const f32x4 a86 = *(const LAS f32x4*)(Ab + 896);
        r2[8] -= (f32x2v){a82[0], a82[1]} * T12; r2[9] -= (f32x2v){a82[2], a82[3]} * T12;
        const f32x4 a87 = *(const LAS f32x4*)(Ab + 900);
        r2[10] -= (f32x2v){a83[0], a83[1]} * T12; r2[11] -= (f32x2v){a83[2], a83[3]} * T12;
        const f32x4 a88 = *(const LAS f32x4*)(Ab + 904);
        r2[12] -= (f32x2v){a84[0], a84[1]} * T12; r2[13] -= (f32x2v){a84[2], a84[3]} * T12;
        const f32x4 a89 = *(const LAS f32x4*)(Ab + 908);
        r2[14] -= (f32x2v){a85[0], a85[1]} * T12; r2[15] -= (f32x2v){a85[2], a85[3]} * T12;
        const f32x4 a90 = *(const LAS f32x4*)(Ab + 912);
        const float t13 = r2[6][1]; const f32x2v T13 = (f32x2v){t13, t13}; Tw[936] = f2bf(t13); Tt[13] = f2bf(t13);
        r2[7] -= (f32x2v){a86[2], a86[3]} * T13;
        const f32x4 a91 = *(const LAS f32x4*)(Ab + 964);
        r2[8] -= (f32x2v){a87[0], a87[1]} * T13; r2[9] -= (f32x2v){a87[2], a87[3]} * T13;
        const f32x4 a92 = *(const LAS f32x4*)(Ab + 968);
        r2[10] -= (f32x2v){a88[0], a88[1]} * T13; r2[11] -= (f32x2v){a88[2], a88[3]} * T13;
        const f32x4 a93 = *(const LAS f32x4*)(Ab + 972);
        r2[12] -= (f32x2v){a89[0], a89[1]} * T13; r2[13] -= (f32x2v){a89[2], a89[3]} * T13;
        const f32x4 a94 = *(const LAS f32x4*)(Ab + 976);
        r2[14] -= (f32x2v){a90[0], a90[1]} * T13; r2[15] -= (f32x2v){a90[2], a90[3]} * T13;
        const f32x4 a95 = *(const LAS f32x4*)(Ab + 980);
        const float t14 = r2[7][0]; const f32x2v T14 = (f32x2v){t14, t14}; Tw[1008] = f2bf(t14); Tt[14] = f2bf(t14);
        r2[7] -= (f32x2v){a91[2], a91[3]} * T14;
        const f32x4 a96 = *(const LAS f32x4*)(Ab + 1036);
        r2[8] -= (f32x2v){a92[0], a92[1]} * T14; r2[9] -= (f32x2v){a92[2], a92[3]} * T14;
        const f32x4 a97 = *(const LAS f32x4*)(Ab + 1040);
        r2[10] -= (f32x2v){a93[0], a93[1]} * T14; r2[11] -= (f32x2v){a93[2], a93[3]} * T14;
        const f32x4 a98 = *(const LAS f32x4*)(Ab + 1044);
        r2[12] -= (f32x2v){a94[0], a94[1]} * T14; r2[13] -= (f32x2v){a94[2], a94[3]} * T14;
        const f32x4 a99 = *(const LAS f32x4*)(Ab + 1048);
        r2[14] -= (f32x2v){a95[0], a95[1]} * T14; r2[15] -= (f32x2v){a95[2], a95[3]} * T14;
        const f32x4 a100 = *(const LAS f32x4*)(Ab + 1104);
        const float t15 = r2[7][1]; const f32x2v T15 = (f32x2v){t15, t15}; Tw[1080] = f2bf(t15); Tt[15] = f2bf(t15);
        r2[8] -= (f32x2v){a96[0], a96[1]} * T15; r2[9] -= (f32x2v){a96[2], a96[3]} * T15;
        const f32x4 a101 = *(const LAS f32x4*)(Ab + 1108);
        r2[10] -= (f32x2v){a97[0], a97[1]} * T15; r2[11] -= (f32x2v){a97[2], a97[3]} * T15;
        const f32x4 a102 = *(const LAS f32x4*)(Ab + 1112);
        r2[12] -= (f32x2v){a98[0], a98[1]} * T15; r2[13] -= (f32x2v){a98[2], a98[3]} * T15;
        const f32x4 a103 = *(const LAS f32x4*)(Ab + 1116);
        r2[14] -= (f32x2v){a99[0], a99[1]} * T15; r2[15] -= (f32x2v){a99[2], a99[3]} * T15;
        const f32x4 a104 = *(const LAS f32x4*)(Ab + 1172);
        const float t16 = r2[8][0]; const f32x2v T16 = (f32x2v){t16, t16}; Tw[1152] = f2bf(t16); Tt[16] = f2bf(t16);
        r2[8] -= (f32x2v){a100[0], a100[1]} * T16; r2[9] -= (f32x2v){a100[2], a100[3]} * T16;
        const f32x4 a105 = *(const LAS f32x4*)(Ab + 1176);
        r2[10] -= (f32x2v){a101[0], a101[1]} * T16; r2[11] -= (f32x2v){a101[2], a101[3]} * T16;
        const f32x4 a106 = *(const LAS f32x4*)(Ab + 1180);
        r2[12] -= (f32x2v){a102[0], a102[1]} * T16; r2[13] -= (f32x2v){a102[2], a102[3]} * T16;
        const f32x4 a107 = *(const LAS f32x4*)(Ab + 1184);
        r2[14] -= (f32x2v){a103[0], a103[1]} * T16; r2[15] -= (f32x2v){a103[2], a103[3]} * T16;
        const f32x4 a108 = *(const LAS f32x4*)(Ab + 1240);
        const float t17 = r2[8][1]; const f32x2v T17 = (f32x2v){t17, t17}; Tw[1224] = f2bf(t17); Tt[17] = f2bf(t17);
        r2[9] -= (f32x2v){a104[2], a104[3]} * T17;
        const f32x4 a109 = *(const LAS f32x4*)(Ab + 1244);
        r2[10] -= (f32x2v){a105[0], a105[1]} * T17; r2[11] -= (f32x2v){a105[2], a105[3]} * T17;
        const f32x4 a110 = *(const LAS f32x4*)(Ab + 1248);
        r2[12] -= (f32x2v){a106[0], a106[1]} * T17; r2[13] -= (f32x2v){a106[2], a106[3]} * T17;
        const f32x4 a111 = *(const LAS f32x4*)(Ab + 1252);
        r2[14] -= (f32x2v){a107[0], a107[1]} * T17; r2[15] -= (f32x2v){a107[2], a107[3]} * T17;
        const f32x4 a112 = *(const LAS f32x4*)(Ab + 1312);
        const float t18 = r2[9][0]; const f32x2v T18 = (f32x2v){t18, t18}; Tw[1296] = f2bf(t18); Tt[18] = f2bf(t18);
        r2[9] -= (f32x2v){a108[2], a108[3]} * T18;
        const f32x4 a113 = *(const LAS f32x4*)(Ab + 1316);
        r2[10] -= (f32x2v){a109[0], a109[1]} * T18; r2[11] -= (f32x2v){a109[2], a109[3]} * T18;
        const f32x4 a114 = *(const LAS f32x4*)(Ab + 1320);
        r2[12] -= (f32x2v){a110[0], a110[1]} * T18; r2[13] -= (f32x2v){a110[2], a110[3]} * T18;
        const f32x4 a115 = *(const LAS f32x4*)(Ab + 1380);
        r2[14] -= (f32x2v){a111[0], a111[1]} * T18; r2[15] -= (f32x2v){a111[2], a111[3]} * T18;
        const f32x4 a116 = *(const LAS f32x4*)(Ab + 1384);
        const float t19 = r2[9][1]; const f32x2v T19 = (f32x2v){t19, t19}; Tw[1368] = f2bf(t19); Tt[19] = f2bf(t19);
        r2[10] -= (f32x2v){a112[0], a112[1]} * T19; r2[11] -= (f32x2v){a112[2], a112[3]} * T19;
        const f32x4 a117 = *(const LAS f32x4*)(Ab + 1388);
        r2[12] -= (f32x2v){a113[0], a113[1]} * T19; r2[13] -= (f32x2v){a113[2], a113[3]} * T19;
        const f32x4 a118 = *(const LAS f32x4*)(Ab + 1448);
        r2[14] -= (f32x2v){a114[0], a114[1]} * T19; r2[15] -= (f32x2v){a114[2], a114[3]} * T19;
        const f32x4 a119 = *(const LAS f32x4*)(Ab + 1452);
        const float t20 = r2[10][0]; const f32x2v T20 = (f32x2v){t20, t20}; Tw[1440] = f2bf(t20); Tt[20] = f2bf(t20);
        r2[10] -= (f32x2v){a115[0], a115[1]} * T20; r2[11] -= (f32x2v){a115[2], a115[3]} * T20;
        const f32x4 a120 = *(const LAS f32x4*)(Ab + 1456);
        r2[12] -= (f32x2v){a116[0], a116[1]} * T20; r2[13] -= (f32x2v){a116[2], a116[3]} * T20;
        const f32x4 a121 = *(const LAS f32x4*)(Ab + 1516);
        r2[14] -= (f32x2v){a117[0], a117[1]} * T20; r2[15] -= (f32x2v){a117[2], a117[3]} * T20;
        const f32x4 a122 = *(const LAS f32x4*)(Ab + 1520);
        const float t21 = r2[10][1]; const f32x2v T21 = (f32x2v){t21, t21}; Tw[1512] = f2bf(t21); Tt[21] = f2bf(t21);
        r2[11] -= (f32x2v){a118[2], a118[3]} * T21;
        const f32x4 a123 = *(const LAS f32x4*)(Ab + 1524);
        r2[12] -= (f32x2v){a119[0], a119[1]} * T21; r2[13] -= (f32x2v){a119[2], a119[3]} * T21;
        const f32x4 a124 = *(const LAS f32x4*)(Ab + 1588);
        r2[14] -= (f32x2v){a120[0], a120[1]} * T21; r2[15] -= (f32x2v){a120[2], a120[3]} * T21;
        const f32x4 a125 = *(const LAS f32x4*)(Ab + 1592);
        const float t22 = r2[11][0]; const f32x2v T22 = (f32x2v){t22, t22}; Tw[1584] = f2bf(t22); Tt[22] = f2bf(t22);
        r2[11] -= (f32x2v){a121[2], a121[3]} * T22;
        const f32x4 a126 = *(const LAS f32x4*)(Ab + 1656);
        r2[12] -= (f32x2v){a122[0], a122[1]} * T22; r2[13] -= (f32x2v){a122[2], a122[3]} * T22;
        const f32x4 a127 = *(const LAS f32x4*)(Ab + 1660);
        r2[14] -= (f32x2v){a123[0], a123[1]} * T22; r2[15] -= (f32x2v){a123[2], a123[3]} * T22;
        const f32x4 a128 = *(const LAS f32x4*)(Ab + 1724);
        const float t23 = r2[11][1]; const f32x2v T23 = (f32x2v){t23, t23}; Tw[1656] = f2bf(t23); Tt[23] = f2bf(t23);
        r2[12] -= (f32x2v){a124[0], a124[1]} * T23; r2[13] -= (f32x2v){a124[2], a124[3]} * T23;
        const f32x4 a129 = *(const LAS f32x4*)(Ab + 1728);
        r2[14] -= (f32x2v){a125[0], a125[1]} * T23; r2[15] -= (f32x2v){a125[2], a125[3]} * T23;
        const f32x4 a130 = *(const LAS f32x4*)(Ab + 1792);
        const float t24 = r2[12][0]; const f32x2v T24 = (f32x2v){t24, t24}; Tw[1728] = f2bf(t24); Tt[24] = f2bf(t24);
        r2[12] -= (f32x2v){a126[0], a126[1]} * T24; r2[13] -= (f32x2v){a126[2], a126[3]} * T24;
        const f32x4 a131 = *(const LAS f32x4*)(Ab + 1796);
        r2[14] -= (f32x2v){a127[0], a127[1]} * T24; r2[15] -= (f32x2v){a127[2], a127[3]} * T24;
        const f32x4 a132 = *(const LAS f32x4*)(Ab + 1864);
        const float t25 = r2[12][1]; const f32x2v T25 = (f32x2v){t25, t25}; Tw[1800] = f2bf(t25); Tt[25] = f2bf(t25);
        r2[13] -= (f32x2v){a128[2], a128[3]} * T25;
        const f32x4 a133 = *(const LAS f32x4*)(Ab + 1932);
        r2[14] -= (f32x2v){a129[0], a129[1]} * T25; r2[15] -= (f32x2v){a129[2], a129[3]} * T25;
        const f32x4 a134 = *(const LAS f32x4*)(Ab + 2000);
        const float t26 = r2[13][0]; const f32x2v T26 = (f32x2v){t26, t26}; Tw[1872] = f2bf(t26); Tt[26] = f2bf(t26);
        r2[13] -= (f32x2v){a130[2], a130[3]} * T26;
        const f32x4 a135 = *(const LAS f32x4*)(Ab + 2068);
        r2[14] -= (f32x2v){a131[0], a131[1]} * T26; r2[15] -= (f32x2v){a131[2], a131[3]} * T26;
        const float t27 = r2[13][1]; const f32x2v T27 = (f32x2v){t27, t27}; Tw[1944] = f2bf(t27); Tt[27] = f2bf(t27);
        r2[14] -= (f32x2v){a132[0], a132[1]} * T27; r2[15] -= (f32x2v){a132[2], a132[3]} * T27;
        const float t28 = r2[14][0]; const f32x2v T28 = (f32x2v){t28, t28}; Tw[2016] = f2bf(t28); Tt[28] = f2bf(t28);
        r2[14] -= (f32x2v){a133[0], a133[1]} * T28; r2[15] -= (f32x2v){a133[2], a133[3]} * T28;
        const float t29 = r2[14][1]; const f32x2v T29 = (f32x2v){t29, t29}; Tw[2088] = f2bf(t29); Tt[29] = f2bf(t29);
        r2[15] -= (f32x2v){a134[2], a134[3]} * T29;
        const float t30 = r2[15][0]; const f32x2v T30 = (f32x2v){t30, t30}; Tw[2160] = f2bf(t30); Tt[30] = f2bf(t30);
        r2[15] -= (f32x2v){a135[2], a135[3]} * T30;
        Tw[2232] = f2bf(r2[15][1]); Tt[31] = f2bf(r2[15][1]);
    } else if (wid == 2) {
        *(LAS u32x4*)(Tb + (lane >> 1) * 72 + 32 + (lane & 1) * 16) = (u32x4){0u, 0u, 0u, 0u}; *(LAS u32x4*)(Tb + (lane >> 1) * 72 + 32 + (lane & 1) * 16 + 8) = (u32x4){0u, 0u, 0u, 0u};
    }
    __syncthreads();
    if (wid < 4) {
        const int mt = wid >> 1, nt = wid & 1; const f32x4 acc = tile_mm(A10b, 40, mt, TT, 40, nt, 1, fr, fq);
        u32x2 w; w.x = cvt_pk(acc[0], acc[1]); w.y = cvt_pk(acc[2], acc[3]); *(LAS u32x2*)(PT + (16 * nt + fr) * 40 + 16 * mt + 4 * fq) = w;
    }
    __syncthreads();
    if (wid < 4) {
        const int mt = wid >> 1, nt = wid & 1; const f32x4 acc = tile_mm(Tb + 32 * 72 + 32, 72, mt, PT, 40, nt, 1, fr, fq);
#pragma unroll
        for (int e = 0; e < 4; ++e) Tb[(32 + 16 * mt + 4 * fq + e) * 72 + 16 * nt + fr] = f2bf(-acc[e]);
    }
    __syncthreads();
#pragma unroll 2
    for (int r = 0; r < 8; ++r) {
        const int job = wid + 8 * r, kind = job >> 5, tile = job & 31, mt = tile >> 3, nt = tile & 7;
        const f32x4 acc = tile_mm<false, true>(Tb, 72, mt, kind ? KbT : VbT, 72, nt, 2, fr, fq);
        u32x2 w; w.x = cvt_pk(acc[0], acc[1]); w.y = cvt_pk(acc[2], acc[3]);
        { const int ch = 16 * nt + fr; *(LAS u32x2*)((kind ? WT : UT) + ch * 72 + 8 * ((2 * mt + (fq >> 1)) ^ ((ch >> 3) & 7)) + 4 * (fq & 1)) = w; }
    }
    __syncthreads();
    bf16_t* GM = (bf16_t*)(p.ws + WS_GM) + (size_t)unit * 16384; bf16_t* GN = (bf16_t*)(p.ws + WS_GN) + (size_t)unit * 16384;
    bf16_t* GQ = (bf16_t*)(p.ws + WS_GQ) + (size_t)unit * 8192; bf16_t* GO = (bf16_t*)(p.ws + WS_GO) + (size_t)unit * 8192;
#pragma unroll 2
    for (int r = 0; r < 24; ++r) {
        const int job = wid + 8 * r;
        if (job < 64) { const int a = job >> 3, mt = job & 7;
            const f32x4 acc = tile_mm<true, true>(WT, 72, a, KdT, 72, mt, 2, fr, fq);
            u32x2 w; w.x = cvt_pk(-acc[0], -acc[1]); w.y = cvt_pk(-acc[2], -acc[3]);
            *(u32x2*)(GM + ((mt * 4 + (a >> 1)) * 64 + lane) * 8 + (a & 1) * 4) = w;
        } else if (job < 128) { const int j = job - 64, mt = j >> 3, nt = j & 7;
            const f32x4 acc = tile_mm<true, true>(KdT, 72, mt, UT, 72, nt, 2, fr, fq);
            u32x2 w; w.x = cvt_pk(acc[0], acc[1]); w.y = cvt_pk(acc[2], acc[3]);
            *(u32x2*)(GN + ((nt * 64 + lane) * 8 + mt) * 4) = w;
        } else if (job < 160) { const int j = job - 128, a = j >> 2, it = j & 3;
            const f32x4 acc = tile_mm<true, false>(WT, 72, a, QK, 72, it, 2, fr, fq);
            const int i = 16 * it + fr; const float eg = __expf(gcs[i]);
            const u32x2 qv = *(const LAS u32x2*)(Qs + i * 136 + 16 * a + 4 * fq);
            u32x2 w; w.x = cvt_pk(bflo(qv.x) * eg - acc[0], bfhi(qv.x) * eg - acc[1]); w.y = cvt_pk(bflo(qv.y) * eg - acc[2], bfhi(qv.y) * eg - acc[3]);
            *(u32x2*)(GQ + ((it * 4 + (a >> 1)) * 64 + lane) * 8 + (a & 1) * 4) = w;
        } else { const int j = job - 160, mt = j >> 3, nt = j & 7;
            const f32x4 acc = tile_mm<false, true>(QK, 72, mt, UT, 72, nt, 2, fr, fq);
            u32x2 w; w.x = cvt_pk(acc[0], acc[1]); w.y = cvt_pk(acc[2], acc[3]);
            *(u32x2*)(GO + ((nt * 64 + lane) * 4 + mt) * 4) = w;
        }
    }
    if (tid == 0) ((float*)(p.ws + WS_CTL + CTL_GLAST))[unit] = __expf(gclast);
    __syncthreads();
}

__device__ __forceinline__ void gdn_scan(const Params& p, LAS unsigned char* lds, int sb) {
    const int tid = threadIdx.x, lane = tid & 63, wid = tid >> 6, fr = lane & 15, fq = lane >> 4;
    const int bh = sb / (8 / CW), sp = sb % (8 / CW), unit0 = bh * 128, sl = sp * CW + wid;
    const u32x4* GMb = (const u32x4*)((const bf16_t*)(p.ws + WS_GM) + (size_t)unit0 * 16384);
    const u32x4* GQb = (const u32x4*)((const bf16_t*)(p.ws + WS_GQ) + (size_t)unit0 * 8192);
    const bf16_t* GNb = (const bf16_t*)(p.ws + WS_GN) + (size_t)unit0 * 16384;
    bf16_t* GOb = (bf16_t*)(p.ws + WS_GO) + (size_t)unit0 * 8192;
    const float* glast = (const float*)(p.ws + WS_CTL + CTL_GLAST) + unit0;
    const bool loader = (wid >= CW && wid < CW + 4);
#define SCAN_DMA(cc) do { _Pragma("unroll") for (int k = 0; k < 8; ++k) { const int inst = (wid - CW) * 8 + k; \
        __builtin_amdgcn_global_load_lds((const unsigned*)((const char*)(GMb + (size_t)(cc) * 2048) + inst * 1024 + lane * 16), (LAS unsigned*)(lds + ((cc) & 3) * 32768 + inst * 1024), 16, 0, 0); } } while (0)
#define SCAN_LOADN(dn, cc) do { const bf16_t* np_ = GNb + (size_t)((cc) < 128 ? (cc) : 127) * 16384 + (size_t)(sl * 64 + lane) * 32; \
        asm volatile("global_load_dwordx4 %0, %4, off\n\tglobal_load_dwordx4 %1, %4, off offset:16\n\tglobal_load_dwordx4 %2, %4, off offset:32\n\tglobal_load_dwordx4 %3, %4, off offset:48" \
            : "=&v"(dn[0]), "=&v"(dn[1]), "=&v"(dn[2]), "=&v"(dn[3]) : "v"(np_) : "memory"); } while (0)
#define SCAN_WAITN(dn, N) asm volatile("s_waitcnt vmcnt(" #N ")" : "+v"(dn[0]), "+v"(dn[1]), "+v"(dn[2]), "+v"(dn[3]) :: "memory")
#define SCAN_STEP(c, nn, RELOAD) do { \
        SCAN_WAITN(nn, 8); \
        const float gl = __shfl(((c) < 64) ? glr0 : glr1, (c) & 63); bf16x8 Sb[4]; \
        bf16_t* scp = (bf16_t*)GNb + (size_t)(c) * 16384 + (size_t)sl * 2048 + lane * 8; \
        _Pragma("unroll") for (int ks = 0; ks < 4; ++ks) { u32x4 w; w.x = cvt_pk(S[2 * ks][0], S[2 * ks][1]); w.y = cvt_pk(S[2 * ks][2], S[2 * ks][3]); \
            w.z = cvt_pk(S[2 * ks + 1][0], S[2 * ks + 1][1]); w.w = cvt_pk(S[2 * ks + 1][2], S[2 * ks + 1][3]); Sb[ks] = __builtin_bit_cast(bf16x8, w); } \
        const LAS unsigned char* slot = lds + ((c) & 3) * 32768 + lane * 16; \
        bf16x8 fa[2][2][4]; \
        _Pragma("unroll") for (int ks = 0; ks < 4; ++ks) { fa[0][0][ks] = *(const LAS bf16x8*)(slot + (0 * 4 + ks) * 1024); fa[0][1][ks] = *(const LAS bf16x8*)(slot + (1 * 4 + ks) * 1024); } \
        _Pragma("unroll") for (int mt = 0; mt < 8; ++mt) { const unsigned w0 = nn[mt >> 1][(mt & 1) * 2], w1 = nn[mt >> 1][(mt & 1) * 2 + 1]; \
            S[mt] = S[mt] * gl + (f32x4){bflo(w0), bfhi(w0), bflo(w1), bfhi(w1)}; } \
        _Pragma("unroll") for (int ks = 0; ks < 4; ++ks) *(u32x4*)(scp + ks * 512) = __builtin_bit_cast(u32x4, Sb[ks]);     \
        RELOAD; \
        _Pragma("unroll") for (int pr = 0; pr < 4; ++pr) { \
            if (pr < 3) { _Pragma("unroll") for (int ks = 0; ks < 4; ++ks) { fa[(pr + 1) & 1][0][ks] = *(const LAS bf16x8*)(slot + ((2 * pr + 2) * 4 + ks) * 1024); fa[(pr + 1) & 1][1][ks] = *(const LAS bf16x8*)(slot + ((2 * pr + 3) * 4 + ks) * 1024); } } \
            _Pragma("unroll") for (int ks = 0; ks < 4; ++ks) { S[2 * pr] = mfma16(fa[pr & 1][0][ks], Sb[ks], S[2 * pr]); S[2 * pr + 1] = mfma16(fa[pr & 1][1][ks], Sb[ks], S[2 * pr + 1]); } } \
        } while (0)
    if (loader) { SCAN_DMA(0); SCAN_DMA(1); SCAN_DMA(2); asm volatile("s_waitcnt vmcnt(0)" ::: "memory"); }
    f32x4 S[8];
#pragma unroll
    for (int mt = 0; mt < 8; ++mt) S[mt] = (f32x4){0.f, 0.f, 0.f, 0.f};
    float glr0 = glast[lane], glr1 = glast[64 + lane];
    asm volatile("" : "+v"(glr0), "+v"(glr1));
    u32x4 nnA[4], nnB[4];
    if (wid < CW) { SCAN_LOADN(nnA, 0); SCAN_LOADN(nnB, 1); SCAN_WAITN(nnA, 0); SCAN_WAITN(nnB, 0); }
    asm volatile("s_waitcnt lgkmcnt(0)" ::: "memory"); __builtin_amdgcn_s_barrier(); asm volatile("" ::: "memory");
#pragma unroll 1
    for (int c = 0; c < 128; c += 2) {
        if (loader) { if (c + 3 < 128) { SCAN_DMA(c + 3); asm volatile("s_waitcnt vmcnt(16)" ::: "memory"); } else asm volatile("s_waitcnt vmcnt(0)" ::: "memory"); }
        else if (wid < CW) { SCAN_STEP(c, nnA, SCAN_LOADN(nnA, c + 2)); }
        asm volatile("s_waitcnt lgkmcnt(0)" ::: "memory"); __builtin_amdgcn_s_barrier(); asm volatile("" ::: "memory");
        if (loader) { if (c + 4 < 128) { SCAN_DMA(c + 4); asm volatile("s_waitcnt vmcnt(16)" ::: "memory"); } else asm volatile("s_waitcnt vmcnt(0)" ::: "memory"); }
        else if (wid < CW) { SCAN_STEP(c + 1, nnB, SCAN_LOADN(nnB, c + 3)); }
        asm volatile("s_waitcnt lgkmcnt(0)" ::: "memory"); __builtin_amdgcn_s_barrier(); asm volatile("" ::: "memory");
    }
#undef SCAN_DMA
#undef SCAN_LOADN
#undef SCAN_WAITN
#undef SCAN_STEP
    __syncthreads();
    if (wid < CW) {
        float* go = p.out + O_GP + (size_t)bh * 16384;
#pragma unroll
        for (int mt = 0; mt < 8; ++mt)
#pragma unroll
            for (int e = 0; e < 4; ++e) go[(16 * mt + 4 * fq + e) * 128 + sl * 16 + fr] = S[mt][e];
    }
}

__device__ __forceinline__ void gdn_gate_unit(const Params& p, int unit, int lane) {
    const int fr = lane & 15, fq = lane >> 4, bh = unit >> 7, n = unit & 127, b = bh >> 2, h = bh & 3, tok0 = b * SEQ + n * 64;
    const bf16_t* GO = (const bf16_t*)(p.ws + WS_GO) + (size_t)unit * 8192;
    bf16_t* PB = (bf16_t*)(p.ws + WS_H);
    float ssq[16];
#pragma unroll
    for (int k = 0; k < 16; ++k) ssq[k] = 0.f;
    {
        bf16_t* GOw = (bf16_t*)(p.ws + WS_GO) + (size_t)unit * 8192;
        const bf16_t* GQ = (const bf16_t*)(p.ws + WS_GQ) + (size_t)unit * 8192; const bf16_t* SC = (const bf16_t*)(p.ws + WS_GN) + (size_t)unit * 16384;
        bf16x8 qa[4][4];
#pragma unroll
        for (int mt = 0; mt < 4; ++mt)
#pragma unroll
            for (int ks = 0; ks < 4; ++ks) qa[mt][ks] = *(const bf16x8*)(GQ + ((mt * 4 + ks) * 64 + lane) * 8);
#pragma unroll 2
        for (int nt = 0; nt < 8; ++nt) {
            bf16x8 sb[4];
#pragma unroll
            for (int ks = 0; ks < 4; ++ks) sb[ks] = *(const bf16x8*)(SC + nt * 2048 + (ks * 64 + lane) * 8);
            const u32x4 o0 = *(const u32x4*)(GOw + (nt * 64 + lane) * 16), o1 = *(const u32x4*)(GOw + (nt * 64 + lane) * 16 + 8);
            f32x4 acc[4];
            acc[0] = (f32x4){bflo(o0.x), bfhi(o0.x), bflo(o0.y), bfhi(o0.y)}; acc[1] = (f32x4){bflo(o0.z), bfhi(o0.z), bflo(o0.w), bfhi(o0.w)};
            acc[2] = (f32x4){bflo(o1.x), bfhi(o1.x), bflo(o1.y), bfhi(o1.y)}; acc[3] = (f32x4){bflo(o1.z), bfhi(o1.z), bflo(o1.w), bfhi(o1.w)};
#pragma unroll
            for (int ks = 0; ks < 4; ++ks)
#pragma unroll
                for (int mt = 0; mt < 4; ++mt) acc[mt] = mfma16(qa[mt][ks], sb[ks], acc[mt]);
#pragma unroll
            for (int mt = 0; mt < 4; ++mt)
#pragma unroll
                for (int e = 0; e < 4; ++e) ssq[4 * mt + e] += acc[mt][e] * acc[mt][e];
            u32x4 w0, w1;
            w0.x = cvt_pk(acc[0][0], acc[0][1]); w0.y = cvt_pk(acc[0][2], acc[0][3]); w0.z = cvt_pk(acc[1][0], acc[1][1]); w0.w = cvt_pk(acc[1][2], acc[1][3]);
            w1.x = cvt_pk(acc[2][0], acc[2][1]); w1.y = cvt_pk(acc[2][2], acc[2][3]); w1.z = cvt_pk(acc[3][0], acc[3][1]); w1.w = cvt_pk(acc[3][2], acc[3][3]);
            *(u32x4*)(GOw + (nt * 64 + lane) * 16) = w0; *(u32x4*)(GOw + (nt * 64 + lane) * 16 + 8) = w1;
        }
        asm volatile("s_waitcnt vmcnt(0)" ::: "memory");
    }
#pragma unroll
    for (int k = 0; k < 16; ++k) { float s = row16_sum(ssq[k]); ssq[k] = rsqrtf(s * (1.0f / 128.0f) + EPS); }
    const float* gn = p.in[15];
#pragma unroll 2
    for (int nt = 0; nt < 8; ++nt) {
        const int dv = 16 * nt + fr; const float g = gn[dv];
        const u32x4 a0 = *(const u32x4*)(GO + (nt * 64 + lane) * 16), a1 = *(const u32x4*)(GO + (nt * 64 + lane) * 16 + 8);
        const bf16_t* gzp = PB + (size_t)(tok0 + 4 * fq) * PW + 2304 + h * 128 + dv; bf16_t* mp = PB + (size_t)(tok0 + 4 * fq) * PW + 512 + h * 128 + dv;
#pragma unroll
        for (int k = 0; k < 16; ++k) {
            const unsigned w = (k < 8) ? a0[(k >> 1) & 3] : a1[(k >> 1) & 3]; const float o = (k & 1) ? bfhi(w) : bflo(w);
            const int to = 16 * (k >> 2) + (k & 3);
            const float gz = bf2f(gzp[(size_t)to * PW]);
            mp[(size_t)to * PW] = f2bf(o * ssq[k] * g * silu(gz));
        }
    }
}

__device__ __forceinline__ void attn_unit(const Params& p, LAS unsigned char* lds, int unit) {
    const int tid = threadIdx.x, lane = tid & 63, wid = tid >> 6, fr = lane & 15, fq = lane >> 4;
    const int b = unit >> 7, blk = (unit >> 1) & 63, kvh = unit & 1;
    LAS bf16_t* Ks = (LAS bf16_t*)lds; LAS bf16_t* Vt = (LAS bf16_t*)(lds + 36864);
    bf16_t* PB = (bf16_t*)(p.ws + WS_H);
    __syncthreads();
#pragma unroll
    for (int i = 0; i < 4; ++i) {
        const int q = tid + 512 * i, row = q >> 3, ch = q & 7, tp = blk * 128 - 128 + row;
        u32x4 kv = (u32x4){0u, 0u, 0u, 0u}, vv = (u32x4){0u, 0u, 0u, 0u};
        if (tp >= 0) { const bf16_t* base = PB + (size_t)(b * SEQ + tp) * PW; kv = *(const u32x4*)(base + 512 + kvh * 64 + ch * 8); vv = *(const u32x4*)(base + 640 + kvh * 64 + ch * 8); }
        *(LAS u32x4*)(Ks + row * 72 + ch * 8) = kv;
#pragma unroll
        for (int e = 0; e < 4; ++e) { const unsigned w = vv[e]; Vt[(ch * 8 + 2 * e) * 264 + row] = (bf16_t)(w & 0xffffu); Vt[(ch * 8 + 2 * e + 1) * 264 + row] = (bf16_t)(w >> 16); }
    }
    __syncthreads();
    const int qtok = b * SEQ + blk * 128 + 16 * wid + fr;
#pragma unroll 1
    for (int g = 0; g < 4; ++g) {
        const int h = kvh * 4 + g; const float slope = exp2f(-(float)(h + 1)), sink = p.in[11][h];
        bf16x8 qf[2];
#pragma unroll
        for (int ks = 0; ks < 2; ++ks) qf[ks] = *(const bf16x8*)(PB + (size_t)qtok * PW + h * 64 + ks * 32 + 8 * fq);
        f32x4 s[10]; float mx = sink;
#pragma unroll
        for (int j = 0; j < 10; ++j) {
            const int ct = (wid + j) < 15 ? (wid + j) : 15;
            f32x4 acc = (f32x4){0.f, 0.f, 0.f, 0.f};
#pragma unroll
            for (int ks = 0; ks < 2; ++ks) acc = mfma16(*(const LAS bf16x8*)(Ks + (16 * ct + fr) * 72 + ks * 32 + 8 * fq), qf[ks], acc);
#pragma unroll
            for (int e = 0; e < 4; ++e) {
                const int c = 16 * (wid + j) + 4 * fq + e, dist = 16 * wid + fr - c + 128;
                const bool ok = (wid + j <= 15) && dist >= 0 && dist <= 128 && (blk * 128 + c - 128 >= 0);
                const float v = ok ? acc[e] * 0.125f - slope * (float)dist : -INFINITY;
                acc[e] = v; mx = fmaxf(mx, v);
            }
            s[j] = acc;
            asm volatile("" ::: "memory");
        }
        mx = fmaxf(mx, __shfl_xor(mx, 16)); mx = fmaxf(mx, __shfl_xor(mx, 32));
        float sum = 0.f;
#pragma unroll
        for (int j = 0; j < 10; ++j)
#pragma unroll
            for (int e = 0; e < 4; ++e) { const float pv = __expf(s[j][e] - mx); s[j][e] = pv; sum += pv; }
        sum += __shfl_xor(sum, 16); sum += __shfl_xor(sum, 32);
        sum += __expf(sink - mx);
        const float inv = 1.0f / sum;
        bf16x8 pb[5];
#pragma unroll
        for (int kk = 0; kk < 5; ++kk) { u32x4 w; w.x = cvt_pk(s[2 * kk][0] * inv, s[2 * kk][1] * inv); w.y = cvt_pk(s[2 * kk][2] * inv, s[2 * kk][3] * inv);
            w.z = cvt_pk(s[2 * kk + 1][0] * inv, s[2 * kk + 1][1] * inv); w.w = cvt_pk(s[2 * kk + 1][2] * inv, s[2 * kk + 1][3] * inv); pb[kk] = __builtin_bit_cast(bf16x8, w); }
#pragma unroll
        for (int dt = 0; dt < 4; ++dt) {
            f32x4 acc = (f32x4){0.f, 0.f, 0.f, 0.f};
#pragma unroll
            for (int kk = 0; kk < 5; ++kk) {
                const int c0 = (wid + 2 * kk) < 15 ? (wid + 2 * kk) : 15, c1 = (wid + 2 * kk + 1) < 15 ? (wid + 2 * kk + 1) : 15;
                const u32x2 lo = *(const LAS u32x2*)(Vt + (16 * dt + fr) * 264 + 16 * c0 + 4 * fq), hi = *(const LAS u32x2*)(Vt + (16 * dt + fr) * 264 + 16 * c1 + 4 * fq);
                const u32x4 a = (u32x4){lo.x, lo.y, hi.x, hi.y};
                acc = mfma16(__builtin_bit_cast(bf16x8, a), pb[kk], acc);
            }
            u32x2 w; w.x = cvt_pk(acc[0], acc[1]); w.y = cvt_pk(acc[2], acc[3]);
            *(u32x2*)(PB + (size_t)qtok * PW + h * 64 + 16 * dt + 4 * fq) = w;
            asm volatile("" ::: "memory");
        }
    }
}

__device__ __forceinline__ void sattn_unit(const Params& p, int s, int h, int lane) {
    const int kvh = h >> 2; const bool wr = (h & 3) == 0;
    bf16_t* PB = (bf16_t*)(p.ws + WS_H) + (size_t)(MPR + s) * PW;
    const float* ck = p.in[2] + (size_t)s * 128 * 128 + kvh * 64 + lane; const float* cv = p.in[3] + (size_t)s * 128 * 128 + kvh * 64 + lane;
    float* nk = p.out + O_KS + (size_t)s * 128 * 128 + kvh * 64 + lane; float* nv = p.out + O_VS + (size_t)s * 128 * 128 + kvh * 64 + lane;
    const float q = bf2f(PB[h * 64 + lane]) * 0.125f, slope = exp2f(-(float)(h + 1)), sink = p.in[11][h];
    const float knew = bf2f(PB[512 + kvh * 64 + lane]), vnew = bf2f(PB[640 + kvh * 64 + lane]);
    float sc[3];
#pragma unroll
    for (int t = 0; t < 2; ++t) {
#pragma unroll 8
        for (int jj = 0; jj < 64; ++jj) {
            const int j = t * 64 + jj; const float kval = ck[(size_t)j * 128];
            if (wr && j >= 1) nk[(size_t)(j - 1) * 128] = kval;
            const float d = wave_sum(q * kval) - slope * (float)(128 - j); if (lane == jj) sc[t] = d;
        }
    }
    if (wr) nk[(size_t)127 * 128] = knew;
    sc[2] = wave_sum(q * knew);
    const float mx = fmaxf(fmaxf(wave_max(fmaxf(sc[0], sc[1])), sc[2]), sink);
    const float p0 = __expf(sc[0] - mx), p1 = __expf(sc[1] - mx), p2 = __expf(sc[2] - mx);
    const float inv = 1.0f / (wave_sum(p0 + p1) + p2 + __expf(sink - mx));
    float o = p2 * vnew;
#pragma unroll 8
    for (int jj = 0; jj < 64; ++jj) { const float vval = cv[(size_t)jj * 128]; if (wr && jj >= 1) nv[(size_t)(jj - 1) * 128] = vval; o += __shfl(p0, jj) * vval; }
#pragma unroll 8
    for (int jj = 0; jj < 64; ++jj) { const float vval = cv[(size_t)(64 + jj) * 128]; if (wr) nv[(size_t)(63 + jj) * 128] = vval; o += __shfl(p1, jj) * vval; }
    if (wr) nv[(size_t)127 * 128] = vnew;
    asm volatile("" ::: "memory");
    PB[h * 64 + lane] = f2bf(o * inv);
}

__device__ __forceinline__ void sgdn_unit(const Params& p, LAS unsigned char* lds, int s) {
    const int tid = threadIdx.x, wid = tid >> 6, h = tid >> 7, dv = tid & 127;
    LAS float* qs = (LAS float*)lds; LAS float* ks = qs + 512; LAS float* red = ks + 512;
    bf16_t* PB = (bf16_t*)(p.ws + WS_H) + (size_t)(MPR + s) * PW; const float* GBA = (const float*)(p.ws + WS_GBA) + (size_t)(MPR + s) * 8;
    const float* cw = p.in[12]; const float* hc = p.in[4] + (size_t)s * 3 * CONVC; float* nc = p.out + O_CS + (size_t)s * 3 * CONVC;
    __syncthreads();
    float val[3];
#pragma unroll
    for (int i = 0; i < 3; ++i) {
        const int c = i * 512 + tid; const float x3 = bf2f(PB[768 + c]), h0 = hc[c], h1 = hc[CONVC + c], h2 = hc[2 * CONVC + c];
        val[i] = silu(cw[c] * h0 + cw[CONVC + c] * h1 + cw[2 * CONVC + c] * h2 + cw[3 * CONVC + c] * x3);
        nc[c] = h1; nc[CONVC + c] = h2; nc[2 * CONVC + c] = x3;
    }
    const float sq = wave_sum(val[0] * val[0]), sk = wave_sum(val[1] * val[1]);
    if ((tid & 63) == 0) { red[wid] = sq; red[8 + wid] = sk; }
    __syncthreads();
    const float ssq = red[2 * h] + red[2 * h + 1], ssk = red[8 + 2 * h] + red[8 + 2 * h + 1];
    qs[tid] = val[0] * rsqrtf(ssq + EPS) * 0.08838834764831845f; ks[tid] = val[1] * rsqrtf(ssk + EPS);
    __syncthreads();
    const float beta = 1.0f / (1.0f + __expf(-GBA[h]));
    const float x = GBA[4 + h] + p.in[14][h]; const float sp = x > 20.f ? x : log1pf(__expf(x));
    const float eg = __expf(-__expf(p.in[13][h]) * sp);
    const float* S0 = p.in[5] + ((size_t)(s * 4 + h) * 128) * 128 + dv; float* S1 = p.out + O_GS + ((size_t)(s * 4 + h) * 128) * 128 + dv;
    float kS = 0.f;
#pragma unroll 1
    for (int hf = 0; hf < 4; ++hf) { float sv[32];
#pragma unroll
        for (int dk = 0; dk < 32; ++dk) sv[dk] = S0[(size_t)(hf * 32 + dk) * 128];
#pragma unroll
        for (int dk = 0; dk < 32; ++dk) kS += ks[h * 128 + hf * 32 + dk] * sv[dk]; }
    const float delta = beta * (val[2] - eg * kS);
    float o = 0.f;
#pragma unroll 1
    for (int hf = 0; hf < 4; ++hf) { float sv[32];
#pragma unroll
        for (int dk = 0; dk < 32; ++dk) sv[dk] = S0[(size_t)(hf * 32 + dk) * 128];
#pragma unroll
        for (int dk = 0; dk < 32; ++dk) { const float nvv = eg * sv[dk] + ks[h * 128 + hf * 32 + dk] * delta; S1[(size_t)(hf * 32 + dk) * 128] = nvv; o += qs[h * 128 + hf * 32 + dk] * nvv; } }
    const float so = wave_sum(o * o);
    if ((tid & 63) == 0) red[16 + wid] = so;
    __syncthreads();
    const float tot = red[16 + 2 * h] + red[16 + 2 * h + 1];
    const float gz = bf2f(PB[2304 + tid]);
    PB[512 + tid] = f2bf(o * rsqrtf(tot * (1.0f / 128.0f) + EPS) * p.in[15][dv] * silu(gz));
}

__device__ __forceinline__ void late_weight_items(const Params& p, LAS unsigned char* lds, int gw, int NGW) {
    const int lane = threadIdx.x & 63, wid = threadIdx.x >> 6;
    LAS float* scr = (LAS float*)(lds + wid * 16384);
    bf16_t* WOUTMIX = (bf16_t*)(p.ws + WS_WOUTMIX); bf16_t* W2IN = (bf16_t*)(p.ws + WS_W2IN); bf16_t* W2OUT = (bf16_t*)(p.ws + WS_W2OUT);
    constexpr int I_FIN = 16 * 176, I_FOUT = 44 * 32, I_OUTMIX = 16 * 32;
    for (int it = gw; it < I_FIN + I_FOUT + I_OUTMIX; it += NGW) {
        int r = it;
        if (r < I_OUTMIX) { const int kb = r / 32, nb = r % 32; transpose_item(p.in[16], DM, DM, WOUTMIX, kb * 64, nb * 32, nb * 32, nullptr, scr, lane); continue; } r -= I_OUTMIX;
        if (r < I_FIN) { const int kb = r / 176, nb = r % 176; transpose_item(p.in[18], DM, 2 * DFF, W2IN, kb * 64, nb * 32, map_ffin_row(nb * 32), p.in[17], scr, lane); continue; } r -= I_FIN;
        { const int kb = r / 32, nb = r % 32; transpose_item(p.in[19], DFF, DM, W2OUT, kb * 64, nb * 32, nb * 32, nullptr, scr, lane); }
    }
}
#define XB_TMO      128
#define XB_XCNT(j)  (256  + 64 * (j))
#define XB_XSUB(j)  (1280 + 64 * (j))
#define XB_XGEN(j)  (2304 + 64 * (j))
#define XB_TOP      3328
#define XB_TOPGEN   3392
#define XCD_BAR_WORDS 3456
#define XB_SPIN_CAP (1u << 18)

__device__ __forceinline__ unsigned xb_ld(unsigned* p)              { return __hip_atomic_load(p, __ATOMIC_RELAXED, __HIP_MEMORY_SCOPE_AGENT); }
__device__ __forceinline__ unsigned xb_add(unsigned* p, unsigned v) { return __hip_atomic_fetch_add(p, v, __ATOMIC_RELAXED, __HIP_MEMORY_SCOPE_AGENT); }
__device__ __forceinline__ unsigned xb_xcc_id() { return (unsigned)__builtin_amdgcn_s_getreg((3 << 11) | 20) & 0xFu; }
#define XB_SPIN(cond, bar) do { unsigned _sp = 0; while (cond) { __builtin_amdgcn_s_sleep(1); \
    if ((++_sp & 255u) == 0u) { if (xb_ld(&(bar)[XB_TMO])) break; if (_sp > XB_SPIN_CAP) { atomicAdd(&(bar)[XB_TMO], 1u); break; } } } } while (0)

struct XcdBarrier {
    unsigned* bar; unsigned x;
    volatile LAS unsigned* st;
};

__device__ __forceinline__ XcdBarrier xcd_barrier_post(unsigned* bar, volatile LAS unsigned* st) {
    XcdBarrier b; b.bar = bar; b.x = xb_xcc_id(); b.st = st;
    if (threadIdx.x == 0) (void)xb_add(&bar[XB_XCNT(b.x)], 1u);
    return b;
}
__device__ __forceinline__ void xcd_barrier_complete(unsigned* bar, unsigned x, unsigned& nloc, unsigned& nx) {
    const unsigned G = gridDim.x * gridDim.y * gridDim.z;
    unsigned sum, cnt, mine, sp = 0u;
    for (;;) {
        sum = 0u; cnt = 0u; mine = 0u;
#pragma unroll
        for (unsigned j = 0; j < 16; ++j) { const unsigned c = xb_ld(&bar[XB_XCNT(j)]); sum += c; cnt += (c > 0u) ? 1u : 0u; mine = (j == x) ? c : mine; }
        if (sum == G) break;
        __builtin_amdgcn_s_sleep(1);
        if ((++sp & 255u) == 0u) { if (xb_ld(&bar[XB_TMO])) break; if (sp > XB_SPIN_CAP) { atomicAdd(&bar[XB_TMO], 1u); break; } }
    }
    nloc = mine > 0u ? mine : 1u; nx = cnt > 0u ? cnt : 1u;
}

__device__ __forceinline__ void xcd_barrier(const XcdBarrier& b) {
    asm volatile("s_waitcnt vmcnt(0)" ::: "memory");
    __syncthreads();
    if (threadIdx.x == 0) {
        unsigned* bar = b.bar;
        __builtin_amdgcn_s_waitcnt(0);
        unsigned nloc = b.st[0], nx = b.st[1];
        if (nloc == 0u) { xcd_barrier_complete(bar, b.x, nloc, nx); b.st[0] = nloc; b.st[1] = nx; }
        const unsigned old = xb_add(&bar[XB_XSUB(b.x)], 1u);
        const unsigned gen = old / nloc;
        if (old + 1u == (gen + 1u) * nloc) {
            __builtin_amdgcn_fence(__ATOMIC_RELEASE, "agent");
            asm volatile("s_waitcnt vmcnt(0)" ::: "memory");
            const unsigned og = xb_add(&bar[XB_TOP], 1u);
            const unsigned tg = og / nx;
            if (og + 1u == (tg + 1u) * nx) xb_add(&bar[XB_TOPGEN], 1u);
            else XB_SPIN(xb_ld(&bar[XB_TOPGEN]) == tg, bar);
            __builtin_amdgcn_fence(__ATOMIC_ACQUIRE, "agent");
            xb_add(&bar[XB_XGEN(b.x)], 1u);
            asm volatile("s_waitcnt vmcnt(0)" ::: "memory");
        } else {
            XB_SPIN(xb_ld(&bar[XB_XGEN(b.x)]) == gen, bar);
            __builtin_amdgcn_fence(__ATOMIC_ACQUIRE, "agent");
            asm volatile("s_waitcnt vmcnt(0)" ::: "memory");
        }
    }
    __syncthreads();
}

__global__ void __launch_bounds__(512, 2) fwd_kernel(Params p, int ph_lo, int ph_hi) {
    extern __shared__ __attribute__((aligned(16))) unsigned char lds_raw[];
    LAS unsigned char* lds = (LAS unsigned char*)lds_raw;
    cg::grid_group grid = cg::this_grid();
    if (ph_lo < 0) grid.sync();
    volatile LAS unsigned* bst = (volatile LAS unsigned*)(lds + LDS_PHASE_BYTES);
    if (threadIdx.x < 2) bst[threadIdx.x] = 0u;
    __syncthreads();
    XcdBarrier xbar; xbar.bar = (unsigned*)(p.ws + WS_CTL + CTL_BAR); xbar.x = 0; xbar.st = bst;
    if (ph_hi - ph_lo > 1) xbar = xcd_barrier_post((unsigned*)(p.ws + WS_CTL + CTL_BAR), bst);
    const int tid = threadIdx.x, lane = tid & 63, wid = tid >> 6, G = gridDim.x, bx = blockIdx.x;
    unsigned char* ws = p.ws;
    bf16_t* XN = (bf16_t*)(ws + WS_XN); bf16_t* XN2 = (bf16_t*)(ws + WS_XN2); bf16_t* HB = (bf16_t*)(ws + WS_H);
    float* SS1 = (float*)(ws + WS_SSP1); float* SS2 = (float*)(ws + WS_SSP2);
    float* Y = p.out; bf16_t* X3b = (bf16_t*)(ws + WS_GM);
#ifndef PHMASK
#define PHMASK 0x7ff
#endif
#define IN(k) (((PHMASK >> (k)) & 1) && ph_lo <= (k) && (k) < ph_hi)
#define SEAM(k) do { if (IN(k) && IN((k) + 1)) { xcd_barrier(xbar); }     } while (0)

    if (IN(0)) p0_prologue(p, lds, bx, G);
    SEAM(0);
    if (IN(1)) {
        if (bx < 176) sk_ffn_in<false>(XN, (const bf16_t*)(ws + WS_W1IN), HB, bx, wid, lane & 15, lane >> 4, lds);
        pg8::Gemm g{XN, (const bf16_t*)(ws + WS_W1IN), MPR, 2 * DFF, DM, DM}; pg8::StaticOrder S; S.init(MPR, 2 * DFF, G, bx);
        EpiSwiglu E{HB, nullptr}; pg8::gemm_phase<EpiSwiglu, pg8::StaticOrder, GEMM_ALIGN, GEMM_SP2>(lds, g, S, E);
    }
    SEAM(1);
    if (IN(2)) {
        if (bx < 64) sk_ffn_out<false>(HB, (const bf16_t*)(ws + WS_W1OUT), p.in[1], nullptr, XN + (size_t)MPR * DM, bx, wid, lane & 15, lane >> 4, lds);
        pg8::Gemm g{HB, (const bf16_t*)(ws + WS_W1OUT), MPR, DM, DFF, DFF}; pg8::StaticOrder S; S.init(MPR, DM, G, bx);
        EpiResid<false, false, true, true, true> E{p.in[0], p.in[1], nullptr, XN, SS1}; pg8::gemm_phase<EpiResid<false, false, true, true, true>, pg8::StaticOrder, GEMM_ALIGN, GEMM_SP2>(lds, g, S, E);
    }
    SEAM(2);
    if (IN(3)) {
        if (bx < 89) sk_inproj(XN, (const bf16_t*)(ws + WS_WINMIX), HB, (float*)(ws + WS_GBA), bx, wid, lane & 15, lane >> 4, lds);
        pg8::Gemm g{XN, (const bf16_t*)(ws + WS_WINMIX), MPR, NINP, DM, DM}; pg8::StaticOrder S; S.init(MPR, NINP, G, bx);
        EpiInproj E{HB, (float*)(ws + WS_GBA), SS1}; pg8::gemm_phase<EpiInproj, pg8::StaticOrder, GEMM_ALIGN, GEMM_SP2>(lds, g, S, E);
    }
    SEAM(3);
    if (IN(4)) {
        for (int u = bx; u < 2048; u += G) gdn_prep_unit(p, lds, u);
    }
    SEAM(4);
    if (IN(5)) {
        if (bx < NSCAN) gdn_scan(p, lds, bx);
        else {
            const int ab = bx - NSCAN, NAB = G - NSCAN;
            if (NAB == 192) {
                if (ab < 128) { sattn_unit(p, ab, wid, lane); sgdn_unit(p, lds, ab); attn_unit(p, lds, 2 * ab); attn_unit(p, lds, 2 * ab + 1); }
                else { for (int k = 0; k < 4; ++k) attn_unit(p, lds, 256 + (ab - 128) * 4 + k); }
            } else {
                int it = ab;
#pragma unroll 1
                for (; it < 512; it += NAB) attn_unit(p, lds, it);
#pragma unroll 1
                for (; it < 640; it += NAB) { sattn_unit(p, it - 512, wid, lane); sgdn_unit(p, lds, it - 512); }
            }
            const bf16_t* PB = HB;
            for (int idx = ab * 512 + tid; idx < 149504; idx += NAB * 512) {
                if (idx < 131072) { const int w = idx >> 16, r = idx & 65535, b = r >> 14, j = (r >> 7) & 127, c = r & 127;
                    p.out[(w ? O_VP : O_KP) + r] = bf2f(PB[(size_t)(b * SEQ + SEQ - 128 + j) * PW + 512 + w * 128 + c]);
                } else { const int r = idx - 131072, b = r / (3 * CONVC), q = r % (3 * CONVC), rr = q / CONVC, c = q % CONVC;
                    p.out[O_CP + r] = bf2f(PB[(size_t)(b * SEQ + SEQ - 3 + rr) * PW + 768 + c]); }
            }
            __syncthreads();
            late_weight_items(p, lds, ab * 8 + wid, NAB * 8);
        }
    }
    SEAM(5);
    if (IN(6)) {
        for (int u = bx * 8 + wid; u < 2048; u += G * 8) gdn_gate_unit(p, u, lane);
    }
    SEAM(6);
#ifdef DBG_DUMP
    if (ph_lo == 11) {
        const float* src = (const float*)(ws + DBG_SRC);
        for (size_t i = (size_t)bx * 512 + tid; i < (size_t)MREAL * DM; i += (size_t)G * 512) Y[i] = (i < (size_t)MREAL * 8) ? ((const float*)(ws + WS_GBA))[i] : 0.f;
    }
#endif
    if (IN(7)) {
        if (bx < 32) sk_outproj(HB, (const bf16_t*)(ws + WS_WOUTMIX), XN, nullptr, XN2, bx, wid, lane & 15, lane >> 4, lds);
        pg8::Gemm g{HB, (const bf16_t*)(ws + WS_WOUTMIX), MPR, DM, DM, PW}; pg8::StaticOrder S; S.init(MPR, DM, G, bx);
        EpiResid<true, false, true, true, false> E{XN, XN + (size_t)MPR * DM, nullptr, XN2, SS2}; pg8::gemm_phase<EpiResid<true, false, true, true, false>, pg8::StaticOrder, GEMM_ALIGN, GEMM_SP2>(lds, g, S, E);
    }
    SEAM(7);
    if (IN(8)) {
        if (bx < 176) sk_ffn_in<true>(XN2, (const bf16_t*)(ws + WS_W2IN), HB, bx, wid, lane & 15, lane >> 4, lds);
        pg8::Gemm g{XN2, (const bf16_t*)(ws + WS_W2IN), MPR, 2 * DFF, DM, DM}; pg8::StaticOrder S; S.init(MPR, 2 * DFF, G, bx);
        EpiSwiglu E{HB, SS2}; pg8::gemm_phase<EpiSwiglu, pg8::StaticOrder, GEMM_ALIGN, GEMM_SP2>(lds, g, S, E);
    }
    SEAM(8);
    if (IN(9)) {
        if (bx < 64) sk_ffn_out<true>(HB, (const bf16_t*)(ws + WS_W2OUT), (const float*)(XN2 + (size_t)MPR * DM), nullptr, X3b + (size_t)MPR * DM, bx, wid, lane & 15, lane >> 4, lds);
        pg8::Gemm g{HB, (const bf16_t*)(ws + WS_W2OUT), MPR, DM, DFF, DFF}; pg8::StaticOrder S; S.init(MPR, DM, G, bx);
        EpiResid<true, false, true, false, true> E{XN2, XN2 + (size_t)MPR * DM, nullptr, X3b, nullptr}; pg8::gemm_phase<EpiResid<true, false, true, false, true>, pg8::StaticOrder, GEMM_ALIGN, GEMM_SP2>(lds, g, S, E);
    }
    SEAM(9);
    if (IN(10)) {
        const float* gf = p.in[20]; f32x4 gv[4];
#pragma unroll
        for (int j = 0; j < 4; ++j) gv[j] = *((const f32x4*)gf + lane + 64 * j);
        {
            f32x4 v[4], vn[4]; int m = bx * 8 + wid;
            if (m < MREAL) { const u32x2* xr = (const u32x2*)(X3b + (size_t)m * DM) + lane;
#pragma unroll
                for (int j = 0; j < 4; ++j) { const u32x2 w = xr[64 * j]; v[j] = (f32x4){bflo(w.x), bfhi(w.x), bflo(w.y), bfhi(w.y)}; } }
            for (; m < MREAL; m += G * 8) {
                const int mn = m + G * 8;
                if (mn < MREAL) { const u32x2* xr = (const u32x2*)(X3b + (size_t)mn * DM) + lane;
#pragma unroll
                    for (int j = 0; j < 4; ++j) { const u32x2 w = xr[64 * j]; vn[j] = (f32x4){bflo(w.x), bfhi(w.x), bflo(w.y), bfhi(w.y)}; } }
                float s = 0.f;
#pragma unroll
                for (int j = 0; j < 4; ++j) s += (v[j][0] * v[j][0] + v[j][1] * v[j][1]) + (v[j][2] * v[j][2] + v[j][3] * v[j][3]);
                const float rstd = rsqrtf(wave_sum(s) * (1.0f / DM) + EPS);
                f32x4* yr = (f32x4*)(Y + (size_t)m * DM) + lane;
#pragma unroll
                for (int j = 0; j < 4; ++j) yr[64 * j] = v[j] * rstd * gv[j];
#pragma unroll
                for (int j = 0; j < 4; ++j) v[j] = vn[j];
            }
        }
    }
#undef IN
#undef SEAM
}
}

#ifndef MK_N_LAUNCHES
#define MK_N_LAUNCHES 1
#endif
extern "C" void kernel_launch(void* const* d_in, const int* in_sizes, int n_in, void* d_out, int out_size, void* d_ws, size_t ws_size, hipStream_t stream) {
    static int grid = 0;
    if (grid == 0) {
        if (n_in != 21 || ws_size < mk::WS_END || out_size != 47269888) { fprintf(stderr, "kernel_launch: unexpected shapes (n_in %d, ws %zu, out %d)\n", n_in, ws_size, out_size); grid = -1; return; }
        int dev = 0, cus = 0, per_cu = 0;
        (void)hipGetDevice(&dev); (void)hipDeviceGetAttribute(&cus, hipDeviceAttributeMultiprocessorCount, dev);
        if (hipFuncSetAttribute((const void*)mk::fwd_kernel, hipFuncAttributeMaxDynamicSharedMemorySize, mk::LDS_BYTES) != hipSuccess) { fprintf(stderr, "kernel_launch: hipFuncSetAttribute failed\n"); grid = -1; return; }
        if (hipOccupancyMaxActiveBlocksPerMultiprocessor(&per_cu, (const void*)mk::fwd_kernel, 512, mk::LDS_BYTES) != hipSuccess || per_cu < 1) { fprintf(stderr, "kernel_launch: occupancy query failed (%d)\n", per_cu); per_cu = 1; }
        (void)hipGetLastError();
        grid = cus * per_cu;
        if (grid <= mk::NSCAN) { fprintf(stderr, "kernel_launch: grid %d too small\n", grid); grid = -1; return; }
    }
    if (grid < 0) return;
    (void)hipMemsetAsync((char*)d_ws + mk::WS_CTL + mk::CTL_BAR, 0, mk::CTL_BAR_BYTES, stream);
    mk::Params p{};
    for (int i = 0; i < 21; ++i) p.in[i] = (const float*)d_in[i];
    p.out = (float*)d_out; p.ws = (unsigned char*)d_ws;
#if MK_N_LAUNCHES == 1
    int lo = 0, hi = 11; void* args[] = {&p, &lo, &hi};
    hipError_t e = hipLaunchCooperativeKernel((const void*)mk::fwd_kernel, dim3(grid), dim3(512), args, mk::LDS_BYTES, stream);
    if (e != hipSuccess) fprintf(stderr, "kernel_launch: cooperative launch failed: %s (grid %d)\n", hipGetErrorString(e), grid);
#else
#ifndef MK_LAST
#define MK_LAST 11
#ifndef MK_DOUBLE
#define MK_DOUBLE 0x0
#endif
#define DBG_C0 512
#define DBG_C1 1024
#endif
    for (int ph = 0; ph < MK_LAST; ++ph) { const int reps = ((MK_DOUBLE >> ph) & 1) ? 2 : 1; for (int r = 0; r < reps; ++r) hipLaunchKernelGGL(mk::fwd_kernel, dim3(grid), dim3(512), mk::LDS_BYTES, stream, p, ph, ph + 1); }
#ifdef DBG_DUMP
    hipLaunchKernelGGL(mk::fwd_kernel, dim3(grid), dim3(512), mk::LDS_BYTES, stream, p, 11, 12);
#endif
#endif
}
```

```cpp
#include <hip/hip_runtime.h>
#include <hip/hip_cooperative_groups.h>
#include <cstdio>
namespace cg = cooperative_groups;
namespace pg8 {
#define PG8_LAS __attribute__((address_space(3)))
typedef unsigned short bf16_t;
typedef short bf16x8 __attribute__((ext_vector_type(8)));
typedef float f32x4 __attribute__((ext_vector_type(4)));
typedef unsigned u32x4 __attribute__((ext_vector_type(4)));
constexpr int BM = 256, BK = 64, HALF = 128, HTB = HALF * BK * 2  , STAGE_BYTES = 8 * HTB, NXCD = 8, WGM = 4;

__host__ __device__ __forceinline__ int lds_byte(int r, int c) { const int st = (r >> 4) * 2 + (c >> 5), rr = r & 15, cc = c & 31, ob = rr * 64 + cc * 2; return st * 1024 + (ob ^ (((ob >> 9) & 1) << 5)); }
__host__ __device__ __forceinline__ void stage_rc(int b, int& R, int& C) { const int st = b / 1024, sb = b % 1024, swz = sb ^ (((sb >> 9) & 1) << 5); R = (st >> 1) * 16 + swz / 64; C = (st & 1) * 32 + (swz % 64) / 2; }
__host__ __device__ __forceinline__ int perm32(int rho) { const int n = rho >> 4, i = rho & 15; return 8 * (i >> 2) + 4 * n + (i & 3); }

struct Unit { int pm, pn; };
struct Gemm { const bf16_t* A; const bf16_t* Bt; int M, N, K, lda; };

struct StaticOrder {
    int nM, nN, nwg, G, c, wgm;
    __host__ __device__ void init(int M, int N, int G_, int c_, int wgm_ = WGM) { nM = M / BM; nN = N / BM; nwg = nM * nN; G = G_; c = c_; wgm = wgm_; }
    __host__ __device__ bool next(int i, Unit& u) const {
        const long L = (long)i * G + c; if (L >= nwg) return false;
        int wgid = (int)L; { const int q = nwg / NXCD, r = nwg % NXCD, xcd = wgid % NXCD, off = wgid / NXCD; wgid = (xcd < r ? xcd * (q + 1) : r * (q + 1) + (xcd - r) * q) + off; }
        const int nig = wgm * nN, gid = wgid / nig, fm = gid * wgm, gsz = (nM - fm) < wgm ? (nM - fm) : wgm;
        u.pm = fm + ((wgid % nig) % gsz); u.pn = (wgid % nig) / gsz; return true;
    }
    __device__ __forceinline__ void a_ready(const Unit&) const {}
    __device__ __forceinline__ void done(const Unit&) const {}
};

__device__ __forceinline__ unsigned cvt_pk_bf16(float lo, float hi) { unsigned r; asm volatile("v_cvt_pk_bf16_f32 %0, %1, %2" : "=v"(r) : "v"(lo), "v"(hi)); return r; }
typedef float f32x2 __attribute__((ext_vector_type(2)));
__device__ __forceinline__ f32x2 gelu_pk(f32x2 v) {
    const f32x2 av = __builtin_elementwise_abs(v), d = av * 0.2316418882f + 1.0f;
    f32x2 t; t.x = __builtin_amdgcn_rcpf(d.x); t.y = __builtin_amdgcn_rcpf(d.y);
    f32x2 q = t * 0.5307027145f + (-0.7265760135f); q = q * t + 0.7107068705f; q = q * t + (-0.142248368f); q = q * t + 0.127414796f; q = q * t;
    const f32x2 s = (v * v) * (-0.72134752044f);
    f32x2 e; e.x = __builtin_amdgcn_exp2f(s.x); e.y = __builtin_amdgcn_exp2f(s.y);
    const f32x2 m = v * (q * e), r = v - m;
    f32x2 o; o.x = v.x < 0.f ? m.x : r.x; o.y = v.y < 0.f ? m.y : r.y; return o;
}

template <int ACT  > struct EpiBf16 {
    static constexpr bool PERM = true, AFTER_DRAIN = false; static_assert(ACT == 0 || ACT == 1, "EpiBf16: ACT is 0 (none) or 1 (gelu_pk)");
    bf16_t* O; int ldc; const float* bias; int split_cols; size_t split_stride; float scale0;
    __device__ __forceinline__ void operator()(const f32x4 (&acc)[2][2][4][2], const Unit& u, int wr, int wc, int fr, int fq) const {
        const int row0 = u.pm * BM + wr * 64 + fr; int colt = u.pn * BM; bf16_t* base = O;
        float sc = 1.f; if (split_cols) { const int t = colt / split_cols; base += (size_t)t * split_stride; colt -= t * split_cols; if (t == 0) sc = scale0; }
        const int col0 = colt + wc * 32 + 8 * fq, bcol0 = u.pn * BM + wc * 32 + 8 * fq;
        f32x4 bv[2][2];
#pragma unroll
        for (int bj = 0; bj < 2; ++bj)
#pragma unroll
            for (int n = 0; n < 2; ++n) bv[bj][n] = bias ? *(const f32x4*)(bias + bcol0 + bj * HALF + 4 * n) : (f32x4){0.f, 0.f, 0.f, 0.f};
#pragma unroll
        for (int ai = 0; ai < 2; ++ai)
#pragma unroll
            for (int m = 0; m < 4; ++m) { bf16_t* rowp = base + (size_t)(row0 + ai * HALF + m * 16) * ldc + col0;
#pragma unroll
                for (int bj = 0; bj < 2; ++bj) { f32x4 v0 = acc[ai][bj][m][0] + bv[bj][0], v1 = acc[ai][bj][m][1] + bv[bj][1];
                    if (ACT == 1) { f32x2 a = gelu_pk((f32x2){v0[0], v0[1]}), b = gelu_pk((f32x2){v0[2], v0[3]}), c = gelu_pk((f32x2){v1[0], v1[1]}), d = gelu_pk((f32x2){v1[2], v1[3]});
                        v0 = (f32x4){a.x, a.y, b.x, b.y}; v1 = (f32x4){c.x, c.y, d.x, d.y}; }
                    v0 = v0 * sc; v1 = v1 * sc; u32x4 w; w.x = cvt_pk_bf16(v0[0], v0[1]); w.y = cvt_pk_bf16(v0[2], v0[3]); w.z = cvt_pk_bf16(v1[0], v1[1]); w.w = cvt_pk_bf16(v1[2], v1[3]);
                    *(u32x4*)(rowp + bj * HALF) = w; } }
    }
};

struct PanelStats {
    unsigned* xbuf;
    unsigned* cnt;
    unsigned* tmo;
    int ntn; float eps;
    unsigned code;
    __device__ __forceinline__ bool run(const f32x4 (&v)[2][2][4][2], const Unit& u, int wr, int wc, int fr, int fq, PG8_LAS unsigned char* lds, int wid, int lane) const {
        typedef float f32x2v __attribute__((ext_vector_type(2)));
        PG8_LAS f32x2v* P = (PG8_LAS f32x2v*)lds;
        PG8_LAS f32x2v* S = (PG8_LAS f32x2v*)(lds + 8192);
        PG8_LAS unsigned* flag = (PG8_LAS unsigned*)(lds + 8192 + 2048);
#pragma unroll
        for (int ai = 0; ai < 2; ++ai)
#pragma unroll
            for (int m = 0; m < 4; ++m) {
                float s = 0.f;
#pragma unroll
                for (int bj = 0; bj < 2; ++bj)
#pragma unroll
                    for (int n = 0; n < 2; ++n) { const f32x4 x = v[ai][bj][m][n]; s += (x[0] + x[1]) + (x[2] + x[3]); }
                s += __shfl_xor(s, 16); s += __shfl_xor(s, 32);
                const float mw = s * (1.0f / 64.0f); float q = 0.f;
#pragma unroll
                for (int bj = 0; bj < 2; ++bj)
#pragma unroll
                    for (int n = 0; n < 2; ++n) { const f32x4 d = v[ai][bj][m][n] - mw; q += (d[0] * d[0] + d[1] * d[1]) + (d[2] * d[2] + d[3] * d[3]); }
                q += __shfl_xor(q, 16); q += __shfl_xor(q, 32);
                if (fq == 0) P[(ai * HALF + wr * 64 + m * 16 + fr) * 4 + wc] = (f32x2v){mw, q};
            }
        asm volatile("s_waitcnt lgkmcnt(0)" ::: "memory"); __builtin_amdgcn_s_barrier(); asm volatile("" ::: "memory");
#if defined(BROKEN_EXCHANGE_NO_WAIT)
#warning BROKEN CONTROL BUILD: the row-statistics exchange does not wait; results are wrong by design
        if (blockIdx.x >= 64) { const long long t0_ = clock64(); while (clock64() - t0_ < 60000) __builtin_amdgcn_s_sleep(8); }
#endif
        const int row = wid * 32 + (lane & 31);
        if (lane < 32) {
            const f32x2v a = P[row * 4 + 0], b = P[row * 4 + 1], c = P[row * 4 + 2], d = P[row * 4 + 3];
            const float mt = (a.x + b.x + c.x + d.x) * 0.25f;
            const float da = a.x - mt, db = b.x - mt, dc = c.x - mt, dd = d.x - mt;
            const float m2 = (a.y + b.y) + (c.y + d.y) + 64.0f * ((da * da + db * db) + (dc * dc + dd * dd));
            unsigned long long* slot = (unsigned long long*)xbuf + ((size_t)(u.pm * BM + row) * 4 + u.pn);
            __hip_atomic_store(slot, ((unsigned long long)__float_as_uint(m2) << 32) | __float_as_uint(mt), __ATOMIC_RELAXED, __HIP_MEMORY_SCOPE_AGENT);
        }
        asm volatile("s_waitcnt vmcnt(0)" ::: "memory");
        if (lane == 0) __hip_atomic_fetch_add(cnt + 64 * u.pm, 1u, __ATOMIC_RELAXED, __HIP_MEMORY_SCOPE_AGENT);
        if (wid == 0) {
            bool dead = false; const unsigned long long t0 = __builtin_amdgcn_s_memrealtime(); const unsigned want = 8u * (unsigned)ntn;
            for (;;) {
#if defined(BROKEN_EXCHANGE_NO_WAIT)
                break;
#endif
                if ((unsigned)__builtin_amdgcn_readfirstlane(__hip_atomic_load(cnt + 64 * u.pm, __ATOMIC_RELAXED, __HIP_MEMORY_SCOPE_AGENT)) >= want) break;
                if (__builtin_amdgcn_s_memrealtime() - t0 > 2000000ull) {
                    if (lane == 0) { unsigned expect = 0u; __hip_atomic_compare_exchange_strong(tmo + 1, &expect, code | (unsigned)(u.pm & 0xff), __ATOMIC_RELAXED, __ATOMIC_RELAXED, __HIP_MEMORY_SCOPE_AGENT);
                                     __hip_atomic_store(tmo, 1u, __ATOMIC_RELAXED, __HIP_MEMORY_SCOPE_AGENT); }
                    dead = true; break; }
                __builtin_amdgcn_s_sleep(2);
            }
            __builtin_amdgcn_fence(__ATOMIC_ACQUIRE, "agent");
            if (lane == 0) flag[0] = dead ? 1u : 0u;
        }
        asm volatile("s_waitcnt vmcnt(0) lgkmcnt(0)" ::: "memory"); __builtin_amdgcn_s_barrier(); asm volatile("" ::: "memory");
        const bool bad = flag[0] != 0u;
        if (lane < 32) {
            const unsigned long long* slot = (const unsigned long long*)xbuf + (size_t)(u.pm * BM + row) * 4; float mt[4], m2[4]; float ms = 0.f;
#pragma unroll
            for (int t = 0; t < 4; ++t) { if (t < ntn) { const unsigned long long w = __hip_atomic_load(slot + t, __ATOMIC_RELAXED, __HIP_MEMORY_SCOPE_AGENT); mt[t] = __uint_as_float((unsigned)w); m2[t] = __uint_as_float((unsigned)(w >> 32)); } else { mt[t] = 0.f; m2[t] = 0.f; } ms += mt[t]; }
            const float mean = ms / (float)ntn; float q = 0.f;
#pragma unroll
            for (int t = 0; t < 4; ++t) if (t < ntn) { const float dm = mt[t] - mean; q += m2[t] + 256.0f * dm * dm; }
            S[row] = (f32x2v){mean, 1.0f / sqrtf(q / (256.0f * (float)ntn) + eps)};
        }
        asm volatile("s_waitcnt lgkmcnt(0)" ::: "memory"); __builtin_amdgcn_s_barrier(); asm volatile("" ::: "memory");
        return bad;
    }
};
struct EpiLnRes {
    static constexpr bool PERM = false, AFTER_DRAIN = true;
    const float* base; float* out; int ldc; const float* bias; PanelStats st; unsigned poison;
    __device__ __forceinline__ void fused(f32x4 (&acc)[2][2][4][2], const Unit& u, int wr, int wc, int fr, int fq, PG8_LAS unsigned char* lds, int wid, int lane) const {
        typedef float f32x2v __attribute__((ext_vector_type(2)));
        const PG8_LAS f32x2v* S = (const PG8_LAS f32x2v*)(lds + 8192);
        const int col0 = u.pn * BM + wc * 32 + 4 * fq;
#pragma unroll
        for (int bj = 0; bj < 2; ++bj)
#pragma unroll
            for (int n = 0; n < 2; ++n) { const f32x4 bv = bias ? *(const f32x4*)(bias + col0 + bj * HALF + n * 16) : (f32x4){0.f, 0.f, 0.f, 0.f};
#pragma unroll
                for (int ai = 0; ai < 2; ++ai)
#pragma unroll
                    for (int m = 0; m < 4; ++m) acc[ai][bj][m][n] += bv; }
        f32x4 pre[4][2][2];
#pragma unroll
        for (int m = 0; m < 4; ++m) { const size_t off = (size_t)(u.pm * BM + wr * 64 + m * 16 + fr) * ldc + col0;
#pragma unroll
            for (int bj = 0; bj < 2; ++bj)
#pragma unroll
                for (int n = 0; n < 2; ++n) pre[m][bj][n] = *(const f32x4*)(base + off + bj * HALF + n * 16); }
        const bool bad = st.run(acc, u, wr, wc, fr, fq, lds, wid, lane) || poison != 0u;
        const float qnan = __builtin_nanf("");
#pragma unroll
        for (int ai = 0; ai < 2; ++ai)
#pragma unroll
            for (int m = 0; m < 4; ++m) { const int r = ai * HALF + wr * 64 + m * 16 + fr; const f32x2v sr = S[r]; const size_t off = (size_t)(u.pm * BM + r) * ldc + col0;
#pragma unroll
                for (int bj = 0; bj < 2; ++bj)
#pragma unroll
                    for (int n = 0; n < 2; ++n) { const f32x4 bs = ai == 0 ? pre[m][bj][n] : *(const f32x4*)(base + off + bj * HALF + n * 16); f32x4 o = bs + (acc[ai][bj][m][n] - sr.x) * sr.y;
                        if (bad) o = (f32x4){qnan, qnan, qnan, qnan}; *(f32x4*)(out + off + bj * HALF + n * 16) = o; }
                if (m & 1) asm volatile("" ::: "memory"); }
    }
};
struct EpiLnResLn {
    static constexpr bool PERM = false, AFTER_DRAIN = true;
    const float* base; float* out; bf16_t* xn; int ldc; const float* bias; PanelStats st1, st2; unsigned poison;
    __device__ __forceinline__ void fused(f32x4 (&acc)[2][2][4][2], const Unit& u, int wr, int wc, int fr, int fq, PG8_LAS unsigned char* lds, int wid, int lane) const {
        typedef float f32x2v __attribute__((ext_vector_type(2))); typedef unsigned u32x2v __attribute__((ext_vector_type(2)));
        const PG8_LAS f32x2v* S = (const PG8_LAS f32x2v*)(lds + 8192);
        const int col0 = u.pn * BM + wc * 32 + 4 * fq;
#pragma unroll
        for (int bj = 0; bj < 2; ++bj)
#pragma unroll
            for (int n = 0; n < 2; ++n) { const f32x4 bv = bias ? *(const f32x4*)(bias + col0 + bj * HALF + n * 16) : (f32x4){0.f, 0.f, 0.f, 0.f};
#pragma unroll
                for (int ai = 0; ai < 2; ++ai)
#pragma unroll
                    for (int m = 0; m < 4; ++m) acc[ai][bj][m][n] += bv; }
        bool bad = st1.run(acc, u, wr, wc, fr, fq, lds, wid, lane) || poison != 0u;
        const float qnan = __builtin_nanf("");
#pragma unroll
        for (int ai = 0; ai < 2; ++ai)
#pragma unroll
            for (int m = 0; m < 4; ++m) { const int r = ai * HALF + wr * 64 + m * 16 + fr; const f32x2v sr = S[r]; const size_t off = (size_t)(u.pm * BM + r) * ldc + col0;
#pragma unroll
                for (int bj = 0; bj < 2; ++bj)
#pragma unroll
                    for (int n = 0; n < 2; ++n) { const f32x4 bs = *(const f32x4*)(base + off + bj * HALF + n * 16); acc[ai][bj][m][n] = bs + (acc[ai][bj][m][n] - sr.x) * sr.y; }
                asm volatile("" : "+v"(acc[ai][0][m][0]), "+v"(acc[ai][0][m][1]), "+v"(acc[ai][1][m][0]), "+v"(acc[ai][1][m][1]));
                if (m & 1) asm volatile("" ::: "memory"); }
        const bool bad1 = bad;
        bad = st2.run(acc, u, wr, wc, fr, fq, lds, wid, lane) || bad;
#pragma unroll
        for (int ai = 0; ai < 2; ++ai)
#pragma unroll
            for (int m = 0; m < 4; ++m) { const int r = ai * HALF + wr * 64 + m * 16 + fr; const f32x2v sr = S[r]; const size_t off = (size_t)(u.pm * BM + r) * ldc + col0;
#pragma unroll
                for (int bj = 0; bj < 2; ++bj)
#pragma unroll
                    for (int n = 0; n < 2; ++n) { const f32x4 x1 = acc[ai][bj][m][n]; *(f32x4*)(out + off + bj * HALF + n * 16) = bad1 ? (f32x4){qnan, qnan, qnan, qnan} : x1;
                        const f32x4 o = (x1 - sr.x) * sr.y; u32x2v w; w.x = cvt_pk_bf16(o[0], o[1]); w.y = cvt_pk_bf16(o[2], o[3]);
                        if (bad) { w.x = 0x7fc07fc0u; w.y = 0x7fc07fc0u; } *(u32x2v*)(xn + off + bj * HALF + n * 16) = w; }
                asm volatile("" ::: "memory"); }
    }
};

template <class Epi, class Sched, bool ALIGN_EPI = false, bool SP2 = false>
__device__ __forceinline__ void gemm_phase(PG8_LAS unsigned char* lds, const Gemm g, const Sched S, const Epi E) {
    const int tid = threadIdx.x, wid = __builtin_amdgcn_readfirstlane(tid >> 6), lane = tid & 63, wr = wid >> 2, wc = wid & 3, fr = lane & 15, fq = lane >> 4;
    const int K = g.K, nt = K / BK;
    unsigned voffA[2], voffB[2];
#pragma unroll
    for (int i = 0; i < 2; ++i) { int R, C; stage_rc(tid * 16 + i * 8192, R, C); const int Rb = Epi::PERM ? ((R & ~31) + perm32(R & 31)) : R;
        voffA[i] = (unsigned)(R * g.lda + C) * 2u; voffB[i] = (unsigned)(Rb * K + C) * 2u; }
    const size_t kstep = (size_t)(BK * 2);
    const size_t hstep = (size_t)HALF * K * 2;
    const size_t tstep = 2 * hstep;
    const size_t hstepA = (size_t)HALF * g.lda * 2, tstepA = 2 * hstepA;
    const unsigned ldsw = (unsigned)wid * 1024u;
    const int aoff = lds_byte(wr * 64 + fr, fq * 8), boff = lds_byte(wc * 32 + fr, fq * 8);
#define PG8_SA(b, h) (((b) * 2 + (h)) * HTB)
#define PG8_SB(b, h) ((4 + (b) * 2 + (h)) * HTB)
#define PG8_STAGE(bufoff, gbase, voff) do { _Pragma("unroll") for (int _i = 0; _i < 2; ++_i) \
        __builtin_amdgcn_global_load_lds((const unsigned*)((const char*)(gbase) + (voff)[_i]), (PG8_LAS unsigned*)(lds + (bufoff) + ldsw + _i * 8192), 16, 0, 0); } while (0)
#define PG8_LDA(dst, b, h) do { _Pragma("unroll") for (int m = 0; m < 4; ++m) _Pragma("unroll") for (int k = 0; k < 2; ++k) dst[m][k] = *(const PG8_LAS bf16x8*)(lds + PG8_SA(b, h) + aoff + m * 2048 + k * 1024); } while (0)
#define PG8_LDB(dst, b, h) do { _Pragma("unroll") for (int n = 0; n < 2; ++n) _Pragma("unroll") for (int k = 0; k < 2; ++k) dst[n][k] = *(const PG8_LAS bf16x8*)(lds + PG8_SB(b, h) + boff + n * 2048 + k * 1024); } while (0)
#define PG8_MMA(ai, bj, At, Bt) do { __builtin_amdgcn_s_setprio(1); _Pragma("unroll") for (int m = 0; m < 4; ++m) _Pragma("unroll") for (int n = 0; n < 2; ++n) _Pragma("unroll") for (int k = 0; k < 2; ++k) \
        acc[ai][bj][m][n] = __builtin_amdgcn_mfma_f32_16x16x32_bf16(Bt[n][k], At[m][k], acc[ai][bj][m][n], 0, 0, 0); __builtin_amdgcn_s_setprio(0); } while (0)
#define PG8_WAIT_V(n) asm volatile("s_waitcnt vmcnt(" #n ")" ::: "memory")
#define PG8_WAIT_L(n) asm volatile("s_waitcnt lgkmcnt(" #n ")" ::: "memory")
#define PG8_BAR __builtin_amdgcn_s_barrier()
#define PG8_SCHED __builtin_amdgcn_sched_barrier(0)
    Unit cur, nxt; int ui = 0;
    if (!S.next(0, cur)) return;
    f32x4 acc[2][2][4][2];
#pragma unroll
    for (int a = 0; a < 2; ++a)
#pragma unroll
        for (int b = 0; b < 2; ++b)
#pragma unroll
            for (int m = 0; m < 4; ++m)
#pragma unroll
                for (int n = 0; n < 2; ++n) acc[a][b][m][n] = (f32x4){0.f, 0.f, 0.f, 0.f};
    bf16x8 At[4][2], B0[2][2], B1[2][2];
    const char* cA = (const char*)g.A + (size_t)cur.pm * tstepA; const char* cB = (const char*)g.Bt + (size_t)cur.pn * tstep;
    S.a_ready(cur);
    if constexpr (SP2) {
        PG8_STAGE(PG8_SB(0, 0), cB, voffB); PG8_STAGE(PG8_SB(0, 1), cB + hstep, voffB); PG8_STAGE(PG8_SA(0, 0), cA, voffA); PG8_STAGE(PG8_SA(0, 1), cA + hstepA, voffA);
        if (wr == 1) PG8_BAR;
        PG8_WAIT_V(2); PG8_BAR;
        PG8_STAGE(PG8_SB(1, 0), cB + kstep, voffB); PG8_STAGE(PG8_SA(1, 0), cA + kstep, voffA); PG8_STAGE(PG8_SB(1, 1), cB + hstep + kstep, voffB);
        PG8_WAIT_V(6); PG8_BAR;
    } else {
        PG8_STAGE(PG8_SB(0, 0), cB, voffB); PG8_STAGE(PG8_SA(0, 0), cA, voffA); PG8_STAGE(PG8_SB(0, 1), cB + hstep, voffB); PG8_STAGE(PG8_SA(0, 1), cA + hstepA, voffA);
        if (wr == 1) PG8_BAR;
        PG8_WAIT_V(4); PG8_BAR;
        PG8_STAGE(PG8_SB(1, 0), cB + kstep, voffB); PG8_STAGE(PG8_SA(1, 0), cA + kstep, voffA); PG8_STAGE(PG8_SB(1, 1), cB + hstep + kstep, voffB);
        PG8_WAIT_V(6); PG8_BAR;
    }
    for (;;) {
        const bool has_next = S.next(ui + 1, nxt);
        const char* nA = has_next ? (const char*)g.A + (size_t)nxt.pm * tstepA : cA; const char* nB = has_next ? (const char*)g.Bt + (size_t)nxt.pn * tstep : cB;
        for (int t = 0; t < nt; t += 2) {
            const bool last = (t == nt - 2);
            const char* a1 = cA + (size_t)(t + 1) * kstep;
            const char* a2 = last ? nA : cA + (size_t)(t + 2) * kstep; const char* b2 = last ? nB : cB + (size_t)(t + 2) * kstep;
            const char* a3 = a2 + kstep; const char* b3 = b2 + kstep;
            if (last && has_next) S.a_ready(nxt);
            if constexpr (SP2) {
            PG8_LDB(B0, 0, 0); PG8_LDB(B1, 0, 1); PG8_SCHED; PG8_LDA(At, 0, 0); PG8_STAGE(PG8_SA(1, 1), a1 + hstepA, voffA);
            PG8_WAIT_V(8); PG8_WAIT_L(0); PG8_BAR; PG8_MMA(0, 0, At, B0); PG8_MMA(0, 1, At, B1); PG8_BAR; PG8_SCHED;
            PG8_LDA(At, 0, 1); PG8_STAGE(PG8_SB(0, 0), b2, voffB); PG8_STAGE(PG8_SB(0, 1), b2 + hstep, voffB); PG8_STAGE(PG8_SA(0, 0), a2, voffA);
            PG8_WAIT_V(8); PG8_WAIT_L(0); PG8_BAR; PG8_MMA(1, 0, At, B0); PG8_MMA(1, 1, At, B1); PG8_BAR; PG8_SCHED;
            PG8_LDB(B0, 1, 0); PG8_LDB(B1, 1, 1); PG8_SCHED; PG8_LDA(At, 1, 0); PG8_STAGE(PG8_SA(0, 1), a2 + hstepA, voffA);
            PG8_WAIT_V(8); PG8_WAIT_L(0); PG8_BAR; PG8_MMA(0, 0, At, B0); PG8_MMA(0, 1, At, B1); PG8_BAR; PG8_SCHED;
            PG8_LDA(At, 1, 1); PG8_STAGE(PG8_SB(1, 0), b3, voffB); PG8_STAGE(PG8_SB(1, 1), b3 + hstep, voffB); PG8_STAGE(PG8_SA(1, 0), a3, voffA);
            PG8_WAIT_V(8); PG8_WAIT_L(0); PG8_BAR; PG8_MMA(1, 0, At, B0); PG8_MMA(1, 1, At, B1); PG8_BAR; PG8_SCHED;
            } else {
            PG8_LDB(B0, 0, 0); PG8_SCHED; PG8_LDA(At, 0, 0); PG8_STAGE(PG8_SA(1, 1), a1 + hstepA, voffA);
            PG8_WAIT_L(8); PG8_BAR; PG8_WAIT_L(0); PG8_MMA(0, 0, At, B0); PG8_BAR; PG8_SCHED;
            PG8_LDB(B1, 0, 1); PG8_STAGE(PG8_SB(0, 0), b2, voffB);
            PG8_BAR; PG8_WAIT_L(0); PG8_MMA(0, 1, At, B1); PG8_BAR;
            PG8_LDA(At, 0, 1); PG8_STAGE(PG8_SA(0, 0), a2, voffA);
            PG8_BAR; PG8_WAIT_L(0); PG8_MMA(1, 0, At, B0); PG8_BAR; PG8_SCHED;
            PG8_STAGE(PG8_SB(0, 1), b2 + hstep, voffB);
            PG8_WAIT_V(6); PG8_BAR; PG8_MMA(1, 1, At, B1); PG8_BAR;
            PG8_LDB(B0, 1, 0); PG8_SCHED; PG8_LDA(At, 1, 0); PG8_STAGE(PG8_SA(0, 1), a2 + hstepA, voffA);
            PG8_WAIT_L(8); PG8_BAR; PG8_WAIT_L(0); PG8_MMA(0, 0, At, B0); PG8_BAR; PG8_SCHED;
            PG8_LDB(B1, 1, 1); PG8_STAGE(PG8_SB(1, 0), b3, voffB);
            PG8_BAR; PG8_WAIT_L(0); PG8_MMA(0, 1, At, B1); PG8_BAR;
            PG8_LDA(At, 1, 1); PG8_STAGE(PG8_SA(1, 0), a3, voffA);
            PG8_BAR; PG8_WAIT_L(0); PG8_MMA(1, 0, At, B0); PG8_BAR; PG8_SCHED;
            PG8_STAGE(PG8_SB(1, 1), b3 + hstep, voffB);
            PG8_WAIT_V(6); PG8_BAR; PG8_MMA(1, 1, At, B1); PG8_BAR;
            }
        }
        if constexpr (ALIGN_EPI) { if (wr == 0) PG8_BAR; }
        if constexpr (!Epi::AFTER_DRAIN) { E(acc, cur, wr, wc, fr, fq); S.done(cur); }
        if (!has_next) break;
#pragma unroll
        for (int a = 0; a < 2; ++a)
#pragma unroll
            for (int b = 0; b < 2; ++b)
#pragma unroll
                for (int m = 0; m < 4; ++m)
#pragma unroll
                    for (int n = 0; n < 2; ++n) acc[a][b][m][n] = (f32x4){0.f, 0.f, 0.f, 0.f};
        cur = nxt; cA = nA; cB = nB; ++ui;
        if constexpr (ALIGN_EPI) { if (wr == 1) PG8_BAR; }
    }
    PG8_WAIT_V(0);
    if constexpr (!ALIGN_EPI) { if (wr == 0) PG8_BAR; }
    PG8_BAR;
    if constexpr (Epi::AFTER_DRAIN) { E.fused(acc, cur, wr, wc, fr, fq, lds, wid, lane); S.done(cur); }
#undef PG8_SA
#undef PG8_SB
#undef PG8_STAGE
#undef PG8_LDA
#undef PG8_LDB
#undef PG8_MMA
#undef PG8_WAIT_V
#undef PG8_WAIT_L
#undef PG8_BAR
#undef PG8_SCHED
}
}

#ifndef GEMM_SP2
#define GEMM_SP2 true
#endif
#ifndef GEMM_ALIGN
#define GEMM_ALIGN true
#endif
namespace mk {
#define LAS __attribute__((address_space(3)))
using pg8::bf16_t; using pg8::bf16x8; using pg8::f32x4; using pg8::u32x4;
typedef unsigned u32x2 __attribute__((ext_vector_type(2)));

constexpr int DM = 1024, SEQ = 8192, NBATCH = 4, MPR = NBATCH * SEQ, MSAMP = 128, MREAL = MPR + MSAMP, MPAD = 33024;
constexpr int DFF = 2816, PW = 2816, NINP = 3072, CONVC = 1536;
constexpr float EPS = 1e-6f;
#ifndef SCAN_CW
#define SCAN_CW 2
#endif
constexpr int CW = SCAN_CW, NSCAN = 128 / CW;
constexpr int LDS_PHASE_BYTES = 155648, LDS_BYTES = LDS_PHASE_BYTES + 256;

constexpr size_t O_YP = 0, O_YS = 33554432, O_KP = 33685504, O_VP = 33751040, O_CP = 33816576, O_GP = 33835008,
                 O_KS = 34097152, O_VS = 36194304, O_CS = 38291456, O_GS = 38881280;
constexpr size_t MiB = 1u << 20;
constexpr size_t WS_CTL = 0, CTL_ZERO_BYTES = 1 * MiB;
constexpr size_t WS_W1IN = 1 * MiB, WS_W1OUT = 12 * MiB, WS_WINMIX = 18 * MiB, WS_WOUTMIX = 24 * MiB, WS_W2IN = 26 * MiB, WS_W2OUT = 37 * MiB;
constexpr size_t WS_GBA = 43 * MiB, WS_XN = 45 * MiB, WS_XN2 = 110 * MiB, WS_H = 175 * MiB, WS_GM = 353 * MiB, WS_GN = 417 * MiB;
constexpr size_t WS_GQ = 110 * MiB, WS_GO = 142 * MiB;
constexpr size_t WS_SSP1 = 481 * MiB, WS_SSP2 = 484 * MiB;
constexpr size_t WS_END = 487 * MiB;
constexpr size_t CTL_BAR = 0, CTL_BAR_BYTES = 16384, CTL_GLAST = 768 * 1024;

struct Params { const float* in[21]; float* out; unsigned char* ws; };

typedef float f32x2v __attribute__((ext_vector_type(2)));
typedef __bf16 bf16x2v __attribute__((ext_vector_type(2)));
__device__ __forceinline__ unsigned cvt_pk(float lo, float hi) { const f32x2v v = {lo, hi}; const bf16x2v b = __builtin_convertvector(v, bf16x2v); return __builtin_bit_cast(unsigned, b); }
__device__ __forceinline__ bf16_t f2bf(float f) { return (bf16_t)(cvt_pk(f, 0.f) & 0xffffu); }
__device__ __forceinline__ float bf2f(bf16_t h) { return __uint_as_float(((unsigned)h) << 16); }
__device__ __forceinline__ float bflo(unsigned w) { return __uint_as_float(w << 16); }
__device__ __forceinline__ float bfhi(unsigned w) { return __uint_as_float(w & 0xffff0000u); }
__device__ __forceinline__ float silu(float x) { return x * __builtin_amdgcn_rcpf(1.0f + __expf(-x)); }
__device__ __forceinline__ float wave_sum(float v) {
#pragma unroll
    for (int o = 1; o < 64; o <<= 1) v += __shfl_xor(v, o);
    return v;
}
__device__ __forceinline__ float wave_max(float v) {
#pragma unroll
    for (int o = 1; o < 64; o <<= 1) v = fmaxf(v, __shfl_xor(v, o));
    return v;
}
__device__ __forceinline__ float row16_sum(float v) {
    v += __builtin_bit_cast(float, __builtin_amdgcn_update_dpp(0, __builtin_bit_cast(int, v), 0xB1, 0xF, 0xF, true));
    v += __builtin_bit_cast(float, __builtin_amdgcn_update_dpp(0, __builtin_bit_cast(int, v), 0x4E, 0xF, 0xF, true));
    v += __builtin_bit_cast(float, __builtin_amdgcn_update_dpp(0, __builtin_bit_cast(int, v), 0x141, 0xF, 0xF, true));
    v += __builtin_bit_cast(float, __builtin_amdgcn_update_dpp(0, __builtin_bit_cast(int, v), 0x140, 0xF, 0xF, true));
    return v;
}
__device__ __forceinline__ f32x4 mfma16(bf16x8 a, bf16x8 b, f32x4 c) { return __builtin_amdgcn_mfma_f32_16x16x32_bf16(a, b, c, 0, 0, 0); }

__device__ __forceinline__ float row_rstd(const float* ssp, int r) {
    if (r >= MREAL) return 0.f;
    const f32x4 a = *(const f32x4*)(ssp + (size_t)r * 16), b = *(const f32x4*)(ssp + (size_t)r * 16 + 4), c = *(const f32x4*)(ssp + (size_t)r * 16 + 8), d = *(const f32x4*)(ssp + (size_t)r * 16 + 12);
    const float s = (((a[0] + a[1]) + (a[2] + a[3])) + ((b[0] + b[1]) + (b[2] + b[3]))) + (((c[0] + c[1]) + (c[2] + c[3])) + ((d[0] + d[1]) + (d[2] + d[3])));
    return rsqrtf(s * (1.0f / DM) + EPS);
}
__device__ __forceinline__ float row_rstd4(const float* ssp, int r, int fq) {
    const f32x4 a = *(const f32x4*)(ssp + (size_t)r * 16 + 4 * fq);
    float s = (a[0] + a[1]) + (a[2] + a[3]);
    s += __shfl_xor(s, 16); s += __shfl_xor(s, 32);
    return rsqrtf(s * (1.0f / DM) + EPS);
}
__device__ __forceinline__ void swiglu2(float g0, float u0, float g1, float u1, float& h0, float& h1) {
    const float c0 = fmaxf(g0, -40.f), c1 = fmaxf(g1, -40.f);
    const float a = 1.0f + __expf(-c0), b = 1.0f + __expf(-c1), r = __builtin_amdgcn_rcpf(a * b);
    h0 = c0 * (r * b) * u0; h1 = c1 * (r * a) * u1;
}
struct EpiSwiglu {
    static constexpr bool PERM = true, AFTER_DRAIN = false;
    bf16_t* H; const float* ss;
    __device__ __forceinline__ void operator()(const f32x4 (&acc)[2][2][4][2], const pg8::Unit& u, int wr, int wc, int fr, int fq) const {
        const int row0 = u.pm * 256 + wr * 64 + fr, col0 = u.pn * 128 + wc * 32 + 8 * fq;
#pragma unroll
        for (int ai = 0; ai < 2; ++ai)
#pragma unroll
            for (int m = 0; m < 4; ++m) {
                const int r = row0 + ai * 128 + m * 16;
                const float rs = ss ? row_rstd4(ss, r, fq) : 1.0f;
                float h[8];
#pragma unroll
                for (int n = 0; n < 2; ++n)
#pragma unroll
                    for (int j = 0; j < 4; j += 2) swiglu2(acc[ai][0][m][n][j] * rs, acc[ai][1][m][n][j] * rs, acc[ai][0][m][n][j + 1] * rs, acc[ai][1][m][n][j + 1] * rs, h[n * 4 + j], h[n * 4 + j + 1]);
                u32x4 w; w.x = cvt_pk(h[0], h[1]); w.y = cvt_pk(h[2], h[3]); w.z = cvt_pk(h[4], h[5]); w.w = cvt_pk(h[6], h[7]);
                *(u32x4*)(H + (size_t)r * DFF + col0) = w;
            }
    }
};
template <bool RESB16, bool WF32, bool WB16, bool SUMSQ, bool HALF> struct EpiResid {
    static constexpr bool PERM = true, AFTER_DRAIN = false;
    const void* resP; const void* resS; float* Yo; bf16_t* XBo; float* sso;
    __device__ __forceinline__ void operator()(const f32x4 (&acc)[2][2][4][2], const pg8::Unit& u, int wr, int wc, int fr, int fq) const {
        const int row0 = u.pm * 256 + wr * 64 + fr, col0 = u.pn * 256 + wc * 32 + 8 * fq;
        const char* const rP = (const char*)resP; const char* const rS = (const char*)resS - (size_t)MPR * DM * (RESB16 ? 2 : 4);
        float* const Y = Yo; const float scale = HALF ? 0.5f : 1.0f; bf16_t* const XB = XBo; float* const ss = sso;
#pragma unroll
        for (int ai = 0; ai < 2; ++ai)
#pragma unroll
            for (int m = 0; m < 4; ++m) {
                const int r = row0 + ai * 128 + m * 16; float s = 0.f;
                if (r < MREAL) {
                    const char* rp = ((r < MPR) ? rP : rS) + (size_t)r * DM * (RESB16 ? 2 : 4);
#pragma unroll
                    for (int bj = 0; bj < 2; ++bj) {
                        const int c = col0 + bj * 128;
                        f32x4 r0, r1;
                        if (RESB16) { const u32x4 w = *(const u32x4*)(rp + (size_t)c * 2); r0 = (f32x4){bflo(w.x), bfhi(w.x), bflo(w.y), bfhi(w.y)}; r1 = (f32x4){bflo(w.z), bfhi(w.z), bflo(w.w), bfhi(w.w)}; }
                        else { r0 = *(const f32x4*)(rp + (size_t)c * 4); r1 = *(const f32x4*)(rp + (size_t)c * 4 + 16); }
                        const f32x4 v0 = r0 + acc[ai][bj][m][0] * scale, v1 = r1 + acc[ai][bj][m][1] * scale;
                        if (WF32) { *(f32x4*)(Y + (size_t)r * DM + c) = v0; *(f32x4*)(Y + (size_t)r * DM + c + 4) = v1; }
                        if (WB16) { u32x4 w; w.x = cvt_pk(v0[0], v0[1]); w.y = cvt_pk(v0[2], v0[3]); w.z = cvt_pk(v1[0], v1[1]); w.w = cvt_pk(v1[2], v1[3]);
                            *(u32x4*)(XB + (size_t)r * DM + c) = w; }
                        if (SUMSQ) s += (v0[0] * v0[0] + v0[1] * v0[1]) + (v0[2] * v0[2] + v0[3] * v0[3]) + (v1[0] * v1[0] + v1[1] * v1[1]) + (v1[2] * v1[2] + v1[3] * v1[3]);
                    }
                }
                if (SUMSQ) { s += __shfl_xor(s, 16); s += __shfl_xor(s, 32); if (fq == 0 && r < MREAL) ss[(size_t)r * 16 + u.pn * 4 + wc] = s; }
            }
    }
};
struct EpiInproj {
    static constexpr bool PERM = true, AFTER_DRAIN = false;
    bf16_t* P; float* gba; const float* ss;
    __device__ __forceinline__ void operator()(const f32x4 (&acc)[2][2][4][2], const pg8::Unit& u, int wr, int wc, int fr, int fq) const {
        const int row0 = u.pm * 256 + wr * 64 + fr, col0 = u.pn * 256 + wc * 32 + 8 * fq;
#pragma unroll
        for (int ai = 0; ai < 2; ++ai)
#pragma unroll
            for (int m = 0; m < 4; ++m) {
                const int r = row0 + ai * 128 + m * 16;
                const float rs = row_rstd4(ss, r, fq);
                if (u.pn < 11) {
#pragma unroll
                    for (int bj = 0; bj < 2; ++bj) { const f32x4 v0 = acc[ai][bj][m][0] * rs, v1 = acc[ai][bj][m][1] * rs;
                        u32x4 w; w.x = cvt_pk(v0[0], v0[1]); w.y = cvt_pk(v0[2], v0[3]); w.z = cvt_pk(v1[0], v1[1]); w.w = cvt_pk(v1[2], v1[3]);
                        *(u32x4*)(P + (size_t)r * PW + col0 + bj * 128) = w; }
                } else if (wc == 0 && fq == 0) {
                    *(f32x4*)(gba + (size_t)r * 8) = acc[ai][0][m][0] * rs; *(f32x4*)(gba + (size_t)r * 8 + 4) = acc[ai][0][m][1] * rs;
                }
            }
    }
};


template <int NT, bool SS>
__device__ __forceinline__ void skinny_mm(const bf16_t* A, int lda, const bf16_t* W, int K, int wrow0, int wrow1, int wid, int fr, int fq, f32x4 (&acc)[NT], float& ss, LAS unsigned char* lds) {
    const int lane = fq * 16 + fr, kper = K >> 3, nks = kper >> 5;
    const bf16_t* ap = A + (size_t)fr * lda + wid * kper + 8 * fq;
    const bf16_t* w0 = W + (size_t)(wrow0 + fr) * K + wid * kper + 8 * fq; const bf16_t* w1 = W + (size_t)(wrow1 + fr) * K + wid * kper + 8 * fq;
    f32x4 pa[NT][8]; float sp[8];
#pragma unroll
    for (int mt = 0; mt < 8; ++mt) { sp[mt] = 0.f;
#pragma unroll
        for (int nt = 0; nt < NT; ++nt) pa[nt][mt] = (f32x4){0.f, 0.f, 0.f, 0.f}; }
#pragma unroll 2
    for (int ks = 0; ks < nks; ++ks) {
        const bf16x8 b0 = *(const bf16x8*)(w0 + 32 * ks); bf16x8 b1 = b0; if (NT == 2) b1 = *(const bf16x8*)(w1 + 32 * ks);
        bf16x8 av[8];
#pragma unroll
        for (int mt = 0; mt < 8; ++mt) av[mt] = *(const bf16x8*)(ap + (size_t)(16 * mt) * lda + 32 * ks);
#pragma unroll
        for (int mt = 0; mt < 8; ++mt) {
            pa[0][mt] = mfma16(b0, av[mt], pa[0][mt]);
            if (NT == 2) pa[NT - 1][mt] = mfma16(b1, av[mt], pa[NT - 1][mt]);
            if (SS) { const u32x4 u = __builtin_bit_cast(u32x4, av[mt]);
#pragma unroll
                for (int k = 0; k < 4; ++k) { const float lo = bflo(u[k]), hi = bfhi(u[k]); sp[mt] += lo * lo + hi * hi; } }
        }
    }
    LAS f32x4* red = (LAS f32x4*)lds;
    LAS float* sred = (LAS float*)(lds + 8 * NT * 8 * 64 * 16);
#pragma unroll
    for (int mt = 0; mt < 8; ++mt) {
#pragma unroll
        for (int nt = 0; nt < NT; ++nt) red[((wid * NT + nt) * 8 + mt) * 64 + lane] = pa[nt][mt];
        if (SS) sred[(wid * 8 + mt) * 64 + lane] = sp[mt];
    }
    __syncthreads();
    float s = 0.f;
#pragma unroll
    for (int nt = 0; nt < NT; ++nt) acc[nt] = (f32x4){0.f, 0.f, 0.f, 0.f};
#pragma unroll
    for (int v = 0; v < 8; ++v) {
#pragma unroll
        for (int nt = 0; nt < NT; ++nt) acc[nt] += red[((v * NT + nt) * 8 + wid) * 64 + lane];
        if (SS) s += sred[(v * 8 + wid) * 64 + lane];
    }
    if (SS) { s += __shfl_xor(s, 16); s += __shfl_xor(s, 32); }
    ss = s;
    __syncthreads();
}
template <bool SS> __device__ __forceinline__ void sk_ffn_in(const bf16_t* X, const bf16_t* Wt, bf16_t* H, int slab, int wid, int fr, int fq, LAS unsigned char* lds) {
    const int j0 = 16 * slab, wr0 = (j0 >> 7) * 256 + (j0 & 127);
    f32x4 acc[2]; float ss;
    skinny_mm<2, SS>(X + (size_t)MPR * DM, DM, Wt, DM, wr0, wr0 + 128, wid, fr, fq, acc, ss, lds);
    const float rs = SS ? rsqrtf(ss * (1.0f / DM) + EPS) : 1.0f;
    float h[4];
#pragma unroll
    for (int e = 0; e < 4; ++e) h[e] = silu(acc[0][e] * rs) * (acc[1][e] * rs);
    u32x2 w; w.x = cvt_pk(h[0], h[1]); w.y = cvt_pk(h[2], h[3]);
    *(u32x2*)(H + (size_t)(MPR + 16 * wid + fr) * DFF + j0 + 4 * fq) = w;
}
template <bool OUTF32> __device__ __forceinline__ void sk_ffn_out(const bf16_t* Hb, const bf16_t* Wt, const float* resf, float* outf, bf16_t* outb, int slab, int wid, int fr, int fq, LAS unsigned char* lds) {
    f32x4 acc[1]; float ss;
    skinny_mm<1, false>(Hb + (size_t)MPR * DFF, DFF, Wt, DFF, 16 * slab, 0, wid, fr, fq, acc, ss, lds);
    const int rl = 16 * wid + fr, c = 16 * slab + 4 * fq;
    f32x4 rv;
    if (OUTF32) { const u32x2 xr = *(const u32x2*)((const bf16_t*)resf + (size_t)rl * DM + c); rv = (f32x4){bflo(xr.x), bfhi(xr.x), bflo(xr.y), bfhi(xr.y)}; }
    else rv = *(const f32x4*)(resf + (size_t)rl * DM + c);
    const f32x4 v = rv + acc[0] * 0.5f;
    { u32x2 w; w.x = cvt_pk(v[0], v[1]); w.y = cvt_pk(v[2], v[3]); *(u32x2*)(outb + (size_t)rl * DM + c) = w; }
}
__device__ __forceinline__ void sk_inproj(const bf16_t* X, const bf16_t* Wt, bf16_t* P, float* gba, int slab, int wid, int fr, int fq, LAS unsigned char* lds) {
    const int n0 = 32 * slab; f32x4 acc[2]; float ss;
    skinny_mm<2, true>(X + (size_t)MPR * DM, DM, Wt, DM, n0, n0 + 16, wid, fr, fq, acc, ss, lds);
    const float rs = rsqrtf(ss * (1.0f / DM) + EPS); const int r = MPR + 16 * wid + fr;
    if (n0 < PW) {
#pragma unroll
        for (int nt = 0; nt < 2; ++nt) { const f32x4 v = acc[nt] * rs; u32x2 w; w.x = cvt_pk(v[0], v[1]); w.y = cvt_pk(v[2], v[3]); *(u32x2*)(P + (size_t)r * PW + n0 + 16 * nt + 4 * fq) = w; }
    } else if (fq < 2) *(f32x4*)(gba + (size_t)r * 8 + 4 * fq) = acc[0] * rs;
}
__device__ __forceinline__ void sk_outproj(const bf16_t* Pm, const bf16_t* Wt, const bf16_t* X1b, float* X2f, bf16_t* X2b, int slab, int wid, int fr, int fq, LAS unsigned char* lds) {
    const int n0 = 32 * slab; f32x4 acc[2]; float ss;
    skinny_mm<2, false>(Pm + (size_t)MPR * PW, PW, Wt, DM, n0, n0 + 16, wid, fr, fq, acc, ss, lds);
    const int r = MPR + 16 * wid + fr;
#pragma unroll
    for (int nt = 0; nt < 2; ++nt) { const int c = n0 + 16 * nt + 4 * fq; const u32x2 xr = *(const u32x2*)(X1b + (size_t)r * DM + c);
        const f32x4 v = (f32x4){bflo(xr.x), bfhi(xr.x), bflo(xr.y), bfhi(xr.y)} + acc[nt];
        u32x2 w; w.x = cvt_pk(v[0], v[1]); w.y = cvt_pk(v[2], v[3]); *(u32x2*)(X2b + (size_t)r * DM + c) = w; }
}

__device__ __forceinline__ void transpose_item(const float* W, int K, int N, bf16_t* WT, int k0, int n0, int drow0, const float* gs, LAS float* scr, int lane) {
    float wv[32];
#pragma unroll
    for (int i = 0; i < 32; ++i) { const int kk = 2 * i + (lane >> 5), n = n0 + (lane & 31); wv[i] = (n < N) ? W[(size_t)(k0 + kk) * N + n] : 0.f; }
#pragma unroll
    for (int i = 0; i < 32; ++i) { const int kk = 2 * i + (lane >> 5); float v = wv[i]; if (gs) v *= gs[k0 + kk]; scr[kk * 33 + (lane & 31)] = v; }
    asm volatile("s_waitcnt lgkmcnt(0)" ::: "memory");
    const int c = lane & 7;
#pragma unroll
    for (int j = 0; j < 4; ++j) { const int nn = (lane >> 3) + 8 * j; const LAS float* s = scr + (8 * c) * 33 + nn;
        u32x4 o; o.x = cvt_pk(s[0 * 33], s[1 * 33]); o.y = cvt_pk(s[2 * 33], s[3 * 33]); o.z = cvt_pk(s[4 * 33], s[5 * 33]); o.w = cvt_pk(s[6 * 33], s[7 * 33]);
        *(u32x4*)(WT + (size_t)(drow0 + nn) * K + k0 + 8 * c) = o; }
    asm volatile("s_waitcnt lgkmcnt(0)" ::: "memory");
}
__device__ __forceinline__ int map_ffin_row(int n0) { return n0 < DFF ? (n0 >> 7) * 256 + (n0 & 127) : ((n0 - DFF) >> 7) * 256 + 128 + ((n0 - DFF) & 127); }

__device__ __forceinline__ void p0_prologue(const Params& p, LAS unsigned char* lds, int vb, int G) {
    const int tid = threadIdx.x, lane = tid & 63, wid = tid >> 6;
    LAS float* scr = (LAS float*)(lds + wid * 16384);
    const int gw = vb * 8 + wid, NGW = G * 8;
    bf16_t* W1IN = (bf16_t*)(p.ws + WS_W1IN); bf16_t* W1OUT = (bf16_t*)(p.ws + WS_W1OUT); bf16_t* WINMIX = (bf16_t*)(p.ws + WS_WINMIX);
    bf16_t* WOUTMIX = (bf16_t*)(p.ws + WS_WOUTMIX); bf16_t* W2IN = (bf16_t*)(p.ws + WS_W2IN); bf16_t* W2OUT = (bf16_t*)(p.ws + WS_W2OUT);
    constexpr int I_FIN = 16 * 176, I_FOUT = 44 * 32, I_INMIX = 16 * 89;
    constexpr int NITEMS = I_FIN + I_FOUT + I_INMIX;
    for (int it = gw; it < NITEMS; it += NGW) {
        int r = it;
        if (r < I_FIN) { const int kb = r / 176, nb = r % 176; transpose_item(p.in[7], DM, 2 * DFF, W1IN, kb * 64, nb * 32, map_ffin_row(nb * 32), nullptr, scr, lane); continue; } r -= I_FIN;
        if (r < I_FOUT) { const int kb = r / 32, nb = r % 32; transpose_item(p.in[8], DFF, DM, W1OUT, kb * 64, nb * 32, nb * 32, nullptr, scr, lane); continue; } r -= I_FOUT;
        { const int kb = r / 89, nb = r % 89; transpose_item(p.in[10], DM, 2824, WINMIX, kb * 64, nb * 32, nb * 32, p.in[9], scr, lane); }
    }
    bf16_t* XN = (bf16_t*)(p.ws + WS_XN); const float* g1 = p.in[6];
    f32x4 gv[4];
#pragma unroll
    for (int j = 0; j < 4; ++j) gv[j] = *((const f32x4*)g1 + lane + 64 * j);
    {
        f32x4 v[4], vn[4];
        int m = gw;
        if (m < MREAL) { const f32x4* xr = (const f32x4*)((m < MPR) ? p.in[0] + (size_t)m * DM : p.in[1] + (size_t)(m - MPR) * DM) + lane;
#pragma unroll
            for (int j = 0; j < 4; ++j) v[j] = xr[64 * j]; }
        for (; m < MREAL; m += NGW) {
            const int mn = m + NGW;
            if (mn < MREAL) { const f32x4* xr = (const f32x4*)((mn < MPR) ? p.in[0] + (size_t)mn * DM : p.in[1] + (size_t)(mn - MPR) * DM) + lane;
#pragma unroll
                for (int j = 0; j < 4; ++j) vn[j] = xr[64 * j]; }
            float s = 0.f;
#pragma unroll
            for (int j = 0; j < 4; ++j) s += (v[j][0] * v[j][0] + v[j][1] * v[j][1]) + (v[j][2] * v[j][2] + v[j][3] * v[j][3]);
            const float rstd = rsqrtf(wave_sum(s) * (1.0f / DM) + EPS);
            unsigned long long* o8 = (unsigned long long*)(XN + (size_t)m * DM) + lane;
#pragma unroll
            for (int j = 0; j < 4; ++j) { const f32x4 y = v[j] * rstd * gv[j];
                o8[64 * j] = (unsigned long long)cvt_pk(y[0], y[1]) | ((unsigned long long)cvt_pk(y[2], y[3]) << 32); }
#pragma unroll
            for (int j = 0; j < 4; ++j) v[j] = vn[j];
        }
    }
}

template <bool SWX = false, bool SWY = false>
__device__ __forceinline__ f32x4 tile_mm(const LAS bf16_t* X, int ldx, int mt, const LAS bf16_t* Y, int ldy, int nt, int nks, int fr, int fq) {
    f32x4 acc = (f32x4){0.f, 0.f, 0.f, 0.f};
    const int rx = 16 * mt + fr, ry = 16 * nt + fr, sx = SWX ? ((rx >> 3) & 7) : 0, sy = SWY ? ((ry >> 3) & 7) : 0;
    const LAS bf16_t* xp = X + rx * ldx; const LAS bf16_t* yp = Y + ry * ldy;
    for (int ks = 0; ks < nks; ++ks) acc = mfma16(*(const LAS bf16x8*)(xp + 8 * ((4 * ks + fq) ^ sx)), *(const LAS bf16x8*)(yp + 8 * ((4 * ks + fq) ^ sy)), acc);
    return acc;
}
constexpr int G1_QS = 0, G1_KS = 17408, G1_VBT = 34816, G1_KBT = 53248, G1_KDT = 71680, G1_UT = 90112, G1_WT = 108544, G1_QK = 126976, G1_TB = 136192, G1_GC = 145408, G1_BETA = 145664, G1_TT = 146176, G1_A10 = 148736, G1_PT = 151296;

__device__ __forceinline__ void gdn_prep_unit(const Params& p, LAS unsigned char* lds, int unit) {
    const int tid = threadIdx.x, lane = tid & 63, wid = tid >> 6, fr = lane & 15, fq = lane >> 4;
    const int bh = unit >> 7, n = unit & 127, b = bh >> 2, h = bh & 3;
    const int tok0 = b * SEQ + n * 64;
    LAS bf16_t* Qs = (LAS bf16_t*)(lds + G1_QS); LAS bf16_t* Ks = (LAS bf16_t*)(lds + G1_KS); LAS bf16_t* VbT = (LAS bf16_t*)(lds + G1_VBT);
    LAS bf16_t* KbT = (LAS bf16_t*)(lds + G1_KBT); LAS bf16_t* KdT = (LAS bf16_t*)(lds + G1_KDT); LAS bf16_t* UT = (LAS bf16_t*)(lds + G1_UT);
    LAS bf16_t* WT = (LAS bf16_t*)(lds + G1_WT); LAS float* Af = (LAS float*)(lds + G1_WT); LAS bf16_t* QK = (LAS bf16_t*)(lds + G1_QK);
    LAS bf16_t* Tb = (LAS bf16_t*)(lds + G1_TB); LAS bf16_t* TT = (LAS bf16_t*)(lds + G1_TT); LAS bf16_t* A10b = (LAS bf16_t*)(lds + G1_A10); LAS bf16_t* PT = (LAS bf16_t*)(lds + G1_PT); LAS float* gcs = (LAS float*)(lds + G1_GC); LAS float* betas = (LAS float*)(lds + G1_BETA);
    const bf16_t* PB = (const bf16_t*)(p.ws + WS_H); const float* GBA = (const float*)(p.ws + WS_GBA);
    LAS unsigned char* raw = lds + G1_UT;
    for (int pc4 = wid; pc4 < 51; pc4 += 8) {
        int pc = pc4 * 4 + (lane >> 4); pc = pc < 200 ? pc : 200;
        const int r = pc / 3, seg = pc - 3 * r; int tt = n * 64 - 3 + r; tt = tt < 0 ? 0 : tt;
        __builtin_amdgcn_global_load_lds((const unsigned*)(PB + (size_t)(b * SEQ + tt) * PW + 768 + seg * 512 + h * 128 + (lane & 15) * 8), (LAS unsigned*)(raw + pc4 * 1024), 16, 0, 0);
    }
    if (tid < 64) {
        const float* gb = GBA + (size_t)(tok0 + tid) * 8;
        const float bt = 1.0f / (1.0f + __expf(-gb[h]));
        const float x = gb[4 + h] + p.in[14][h]; const float sp = x > 20.f ? x : log1pf(__expf(x));
        float c = -__expf(p.in[13][h]) * sp;
#pragma unroll
        for (int o = 1; o < 64; o <<= 1) { const float t = __shfl_up(c, o); if (lane >= o) c += t; }
        gcs[tid] = c; betas[tid] = bt;
    }
    asm volatile("s_waitcnt vmcnt(0)" ::: "memory");
    __syncthreads();
    const float gclast = gcs[63];
    const float* cw = p.in[12];
    f32x4 cwv[4][2];
#pragma unroll 1
    for (int it = 0; it < 6; ++it) {
        const int item = tid + 512 * it, l16 = item & 15, row = item >> 4, which = row >> 6, t = row & 63;
        const int cch = which * 512 + h * 128 + l16 * 8;
        if ((it & 1) == 0) {
#pragma unroll
            for (int j = 0; j < 4; ++j) { cwv[j][0] = *(const f32x4*)(cw + j * CONVC + cch); cwv[j][1] = *(const f32x4*)(cw + j * CONVC + cch + 4); }
        }
        float a[8];
#pragma unroll
        for (int e = 0; e < 8; ++e) a[e] = 0.f;
#pragma unroll
        for (int j = 0; j < 4; ++j) {
            const int tt = n * 64 + t - 3 + j;
            u32x4 xv = *(const LAS u32x4*)(raw + ((t + j) * 3 + which) * 256 + l16 * 16);
            if (tt < 0) xv = (u32x4){0u, 0u, 0u, 0u};
            const f32x4 w0 = cwv[j][0], w1 = cwv[j][1];
            a[0] += w0[0] * bflo(xv.x); a[1] += w0[1] * bfhi(xv.x); a[2] += w0[2] * bflo(xv.y); a[3] += w0[3] * bfhi(xv.y);
            a[4] += w1[0] * bflo(xv.z); a[5] += w1[1] * bfhi(xv.z); a[6] += w1[2] * bflo(xv.w); a[7] += w1[3] * bfhi(xv.w);
        }
        float ss = 0.f;
#pragma unroll
        for (int e = 0; e < 8; ++e) { a[e] = silu(a[e]); ss += a[e] * a[e]; }
        ss = row16_sum(ss);
        const float gct = gcs[t], bt = betas[t];
        const int tsw = (((t >> 3) ^ (l16 & 7)) << 3) | (t & 7);
        if (which == 0) {
            const float sc = rsqrtf(ss + EPS) * 0.08838834764831845f;
            u32x4 w; w.x = cvt_pk(a[0] * sc, a[1] * sc); w.y = cvt_pk(a[2] * sc, a[3] * sc); w.z = cvt_pk(a[4] * sc, a[5] * sc); w.w = cvt_pk(a[6] * sc, a[7] * sc);
            *(LAS u32x4*)(Qs + t * 136 + l16 * 8) = w;
        } else if (which == 1) {
            const float sc = rsqrtf(ss + EPS);
            u32x4 w; w.x = cvt_pk(a[0] * sc, a[1] * sc); w.y = cvt_pk(a[2] * sc, a[3] * sc); w.z = cvt_pk(a[4] * sc, a[5] * sc); w.w = cvt_pk(a[6] * sc, a[7] * sc);
            *(LAS u32x4*)(Ks + t * 136 + l16 * 8) = w;
            const float sb = sc * bt * __expf(gct), sd = sc * __expf(gclast - gct);
#pragma unroll
            for (int e = 0; e < 8; ++e) { KbT[(l16 * 8 + e) * 72 + tsw] = f2bf(a[e] * sb); KdT[(l16 * 8 + e) * 72 + tsw] = f2bf(a[e] * sd); }
        } else {
#pragma unroll
            for (int e = 0; e < 8; ++e) VbT[(l16 * 8 + e) * 72 + tsw] = f2bf(a[e] * bt);
        }
    }
    __syncthreads();
#pragma unroll 2
    for (int r = 0; r < 4; ++r) {
        const int job = wid + 8 * r, kind = job >> 4, tile = job & 15, it = tile >> 2, jt = tile & 3;
        if (kind == 0) {
            if (jt > it) continue;
            const f32x4 acc = tile_mm(Ks, 136, it, Ks, 136, jt, 4, fr, fq);
            const int j = 16 * jt + fr; const float gcj = gcs[j];
            float v[4];
#pragma unroll
            for (int e = 0; e < 4; ++e) { const int i = 16 * it + 4 * fq + e; const bool ok = i > j; v[e] = ok ? acc[e] * __expf(gcs[i] - gcj) * betas[i] : 0.f; }
            *(LAS f32x4*)(Af + j * 68 + 16 * it + 4 * fq) = (f32x4){v[0], v[1], v[2], v[3]};
            if (it >= 2 && jt < 2) {
#pragma unroll
                for (int e = 0; e < 4; ++e) A10b[(16 * (it - 2) + 4 * fq + e) * 40 + j] = f2bf(v[e]); }
        } else {
            const f32x4 acc = tile_mm(Ks, 136, jt, Qs, 136, it, 4, fr, fq);
            const int i = 16 * it + fr; const float gci = gcs[i];
            float v[4];
#pragma unroll
            for (int e = 0; e < 4; ++e) { const int j = 16 * jt + 4 * fq + e; const bool ok = i >= j; v[e] = ok ? acc[e] * __expf(gci - gcs[j]) : 0.f; }
            u32x2 w; w.x = cvt_pk(v[0], v[1]); w.y = cvt_pk(v[2], v[3]); *(LAS u32x2*)(QK + i * 72 + 16 * jt + 4 * fq) = w;
        }
    }
    __syncthreads();
    if (wid < 2) {
        const int ofs = wid * 32, cl = lane & 31; const LAS float* Ab = Af + ofs * 69; LAS bf16_t* Tw = Tb + ofs * 73 + cl; LAS bf16_t* Tt = (wid == 0) ? TT + cl * 40 : PT + cl * 40;
        f32x2v r2[16];
#pragma unroll
        for (int k = 0; k < 16; ++k) r2[k] = (f32x2v){(cl == 2 * k) ? 1.0f : 0.0f, (cl == 2 * k + 1) ? 1.0f : 0.0f};
        const f32x4 a0 = *(const LAS f32x4*)(Ab + 0);
        const f32x4 a1 = *(const LAS f32x4*)(Ab + 4);
        const f32x4 a2 = *(const LAS f32x4*)(Ab + 8);
        const f32x4 a3 = *(const LAS f32x4*)(Ab + 12);
        const f32x4 a4 = *(const LAS f32x4*)(Ab + 16);
        const float t0 = r2[0][0]; const f32x2v T0 = (f32x2v){t0, t0}; Tw[0] = f2bf(t0); Tt[0] = f2bf(t0);
        r2[0] -= (f32x2v){a0[0], a0[1]} * T0; r2[1] -= (f32x2v){a0[2], a0[3]} * T0;
        const f32x4 a5 = *(const LAS f32x4*)(Ab + 20);
        r2[2] -= (f32x2v){a1[0], a1[1]} * T0; r2[3] -= (f32x2v){a1[2], a1[3]} * T0;
        const f32x4 a6 = *(const LAS f32x4*)(Ab + 24);
        r2[4] -= (f32x2v){a2[0], a2[1]} * T0; r2[5] -= (f32x2v){a2[2], a2[3]} * T0;
        const f32x4 a7 = *(const LAS f32x4*)(Ab + 28);
        r2[6] -= (f32x2v){a3[0], a3[1]} * T0; r2[7] -= (f32x2v){a3[2], a3[3]} * T0;
        const f32x4 a8 = *(const LAS f32x4*)(Ab + 68);
        r2[8] -= (f32x2v){a4[0], a4[1]} * T0; r2[9] -= (f32x2v){a4[2], a4[3]} * T0;
        const f32x4 a9 = *(const LAS f32x4*)(Ab + 72);
        r2[10] -= (f32x2v){a5[0], a5[1]} * T0; r2[11] -= (f32x2v){a5[2], a5[3]} * T0;
        const f32x4 a10 = *(const LAS f32x4*)(Ab + 76);
        r2[12] -= (f32x2v){a6[0], a6[1]} * T0; r2[13] -= (f32x2v){a6[2], a6[3]} * T0;
        const f32x4 a11 = *(const LAS f32x4*)(Ab + 80);
        r2[14] -= (f32x2v){a7[0], a7[1]} * T0; r2[15] -= (f32x2v){a7[2], a7[3]} * T0;
        const f32x4 a12 = *(const LAS f32x4*)(Ab + 84);
        const float t1 = r2[0][1]; const f32x2v T1 = (f32x2v){t1, t1}; Tw[72] = f2bf(t1); Tt[1] = f2bf(t1);
        r2[1] -= (f32x2v){a8[2], a8[3]} * T1;
        const f32x4 a13 = *(const LAS f32x4*)(Ab + 88);
        r2[2] -= (f32x2v){a9[0], a9[1]} * T1; r2[3] -= (f32x2v){a9[2], a9[3]} * T1;
        const f32x4 a14 = *(const LAS f32x4*)(Ab + 92);
        r2[4] -= (f32x2v){a10[0], a10[1]} * T1; r2[5] -= (f32x2v){a10[2], a10[3]} * T1;
        const f32x4 a15 = *(const LAS f32x4*)(Ab + 96);
        r2[6] -= (f32x2v){a11[0], a11[1]} * T1; r2[7] -= (f32x2v){a11[2], a11[3]} * T1;
        const f32x4 a16 = *(const LAS f32x4*)(Ab + 136);
        r2[8] -= (f32x2v){a12[0], a12[1]} * T1; r2[9] -= (f32x2v){a12[2], a12[3]} * T1;
        const f32x4 a17 = *(const LAS f32x4*)(Ab + 140);
        r2[10] -= (f32x2v){a13[0], a13[1]} * T1; r2[11] -= (f32x2v){a13[2], a13[3]} * T1;
        const f32x4 a18 = *(const LAS f32x4*)(Ab + 144);
        r2[12] -= (f32x2v){a14[0], a14[1]} * T1; r2[13] -= (f32x2v){a14[2], a14[3]} * T1;
        const f32x4 a19 = *(const LAS f32x4*)(Ab + 148);
        r2[14] -= (f32x2v){a15[0], a15[1]} * T1; r2[15] -= (f32x2v){a15[2], a15[3]} * T1;
        const f32x4 a20 = *(const LAS f32x4*)(Ab + 152);
        const float t2 = r2[1][0]; const f32x2v T2 = (f32x2v){t2, t2}; Tw[144] = f2bf(t2); Tt[2] = f2bf(t2);
        r2[1] -= (f32x2v){a16[2], a16[3]} * T2;
        const f32x4 a21 = *(const LAS f32x4*)(Ab + 156);
        r2[2] -= (f32x2v){a17[0], a17[1]} * T2; r2[3] -= (f32x2v){a17[2], a17[3]} * T2;
        const f32x4 a22 = *(const LAS f32x4*)(Ab + 160);
        r2[4] -= (f32x2v){a18[0], a18[1]} * T2; r2[5] -= (f32x2v){a18[2], a18[3]} * T2;
        const f32x4 a23 = *(const LAS f32x4*)(Ab + 164);
        r2[6] -= (f32x2v){a19[0], a19[1]} * T2; r2[7] -= (f32x2v){a19[2], a19[3]} * T2;
        const f32x4 a24 = *(const LAS f32x4*)(Ab + 208);
        r2[8] -= (f32x2v){a20[0], a20[1]} * T2; r2[9] -= (f32x2v){a20[2], a20[3]} * T2;
        const f32x4 a25 = *(const LAS f32x4*)(Ab + 212);
        r2[10] -= (f32x2v){a21[0], a21[1]} * T2; r2[11] -= (f32x2v){a21[2], a21[3]} * T2;
        const f32x4 a26 = *(const LAS f32x4*)(Ab + 216);
        r2[12] -= (f32x2v){a22[0], a22[1]} * T2; r2[13] -= (f32x2v){a22[2], a22[3]} * T2;
        const f32x4 a27 = *(const LAS f32x4*)(Ab + 220);
        r2[14] -= (f32x2v){a23[0], a23[1]} * T2; r2[15] -= (f32x2v){a23[2], a23[3]} * T2;
        const f32x4 a28 = *(const LAS f32x4*)(Ab + 224);
        const float t3 = r2[1][1]; const f32x2v T3 = (f32x2v){t3, t3}; Tw[216] = f2bf(t3); Tt[3] = f2bf(t3);
        r2[2] -= (f32x2v){a24[0], a24[1]} * T3; r2[3] -= (f32x2v){a24[2], a24[3]} * T3;
        const f32x4 a29 = *(const LAS f32x4*)(Ab + 228);
        r2[4] -= (f32x2v){a25[0], a25[1]} * T3; r2[5] -= (f32x2v){a25[2], a25[3]} * T3;
        const f32x4 a30 = *(const LAS f32x4*)(Ab + 232);
        r2[6] -= (f32x2v){a26[0], a26[1]} * T3; r2[7] -= (f32x2v){a26[2], a26[3]} * T3;
        const f32x4 a31 = *(const LAS f32x4*)(Ab + 276);
        r2[8] -= (f32x2v){a27[0], a27[1]} * T3; r2[9] -= (f32x2v){a27[2], a27[3]} * T3;
        const f32x4 a32 = *(const LAS f32x4*)(Ab + 280);
        r2[10] -= (f32x2v){a28[0], a28[1]} * T3; r2[11] -= (f32x2v){a28[2], a28[3]} * T3;
        const f32x4 a33 = *(const LAS f32x4*)(Ab + 284);
        r2[12] -= (f32x2v){a29[0], a29[1]} * T3; r2[13] -= (f32x2v){a29[2], a29[3]} * T3;
        const f32x4 a34 = *(const LAS f32x4*)(Ab + 288);
        r2[14] -= (f32x2v){a30[0], a30[1]} * T3; r2[15] -= (f32x2v){a30[2], a30[3]} * T3;
        const f32x4 a35 = *(const LAS f32x4*)(Ab + 292);
        const float t4 = r2[2][0]; const f32x2v T4 = (f32x2v){t4, t4}; Tw[288] = f2bf(t4); Tt[4] = f2bf(t4);
        r2[2] -= (f32x2v){a31[0], a31[1]} * T4; r2[3] -= (f32x2v){a31[2], a31[3]} * T4;
        const f32x4 a36 = *(const LAS f32x4*)(Ab + 296);
        r2[4] -= (f32x2v){a32[0], a32[1]} * T4; r2[5] -= (f32x2v){a32[2], a32[3]} * T4;
        const f32x4 a37 = *(const LAS f32x4*)(Ab + 300);
        r2[6] -= (f32x2v){a33[0], a33[1]} * T4; r2[7] -= (f32x2v){a33[2], a33[3]} * T4;
        const f32x4 a38 = *(const LAS f32x4*)(Ab + 344);
        r2[8] -= (f32x2v){a34[0], a34[1]} * T4; r2[9] -= (f32x2v){a34[2], a34[3]} * T4;
        const f32x4 a39 = *(const LAS f32x4*)(Ab + 348);
        r2[10] -= (f32x2v){a35[0], a35[1]} * T4; r2[11] -= (f32x2v){a35[2], a35[3]} * T4;
        const f32x4 a40 = *(const LAS f32x4*)(Ab + 352);
        r2[12] -= (f32x2v){a36[0], a36[1]} * T4; r2[13] -= (f32x2v){a36[2], a36[3]} * T4;
        const f32x4 a41 = *(const LAS f32x4*)(Ab + 356);
        r2[14] -= (f32x2v){a37[0], a37[1]} * T4; r2[15] -= (f32x2v){a37[2], a37[3]} * T4;
        const f32x4 a42 = *(const LAS f32x4*)(Ab + 360);
        const float t5 = r2[2][1]; const f32x2v T5 = (f32x2v){t5, t5}; Tw[360] = f2bf(t5); Tt[5] = f2bf(t5);
        r2[3] -= (f32x2v){a38[2], a38[3]} * T5;
        const f32x4 a43 = *(const LAS f32x4*)(Ab + 364);
        r2[4] -= (f32x2v){a39[0], a39[1]} * T5; r2[5] -= (f32x2v){a39[2], a39[3]} * T5;
        const f32x4 a44 = *(const LAS f32x4*)(Ab + 368);
        r2[6] -= (f32x2v){a40[0], a40[1]} * T5; r2[7] -= (f32x2v){a40[2], a40[3]} * T5;
        const f32x4 a45 = *(const LAS f32x4*)(Ab + 412);
        r2[8] -= (f32x2v){a41[0], a41[1]} * T5; r2[9] -= (f32x2v){a41[2], a41[3]} * T5;
        const f32x4 a46 = *(const LAS f32x4*)(Ab + 416);
        r2[10] -= (f32x2v){a42[0], a42[1]} * T5; r2[11] -= (f32x2v){a42[2], a42[3]} * T5;
        const f32x4 a47 = *(const LAS f32x4*)(Ab + 420);
        r2[12] -= (f32x2v){a43[0], a43[1]} * T5; r2[13] -= (f32x2v){a43[2], a43[3]} * T5;
        const f32x4 a48 = *(const LAS f32x4*)(Ab + 424);
        r2[14] -= (f32x2v){a44[0], a44[1]} * T5; r2[15] -= (f32x2v){a44[2], a44[3]} * T5;
        const f32x4 a49 = *(const LAS f32x4*)(Ab + 428);
        const float t6 = r2[3][0]; const f32x2v T6 = (f32x2v){t6, t6}; Tw[432] = f2bf(t6); Tt[6] = f2bf(t6);
        r2[3] -= (f32x2v){a45[2], a45[3]} * T6;
        const f32x4 a50 = *(const LAS f32x4*)(Ab + 432);
        r2[4] -= (f32x2v){a46[0], a46[1]} * T6; r2[5] -= (f32x2v){a46[2], a46[3]} * T6;
        const f32x4 a51 = *(const LAS f32x4*)(Ab + 436);
        r2[6] -= (f32x2v){a47[0], a47[1]} * T6; r2[7] -= (f32x2v){a47[2], a47[3]} * T6;
        const f32x4 a52 = *(const LAS f32x4*)(Ab + 484);
        r2[8] -= (f32x2v){a48[0], a48[1]} * T6; r2[9] -= (f32x2v){a48[2], a48[3]} * T6;
        const f32x4 a53 = *(const LAS f32x4*)(Ab + 488);
        r2[10] -= (f32x2v){a49[0], a49[1]} * T6; r2[11] -= (f32x2v){a49[2], a49[3]} * T6;
        const f32x4 a54 = *(const LAS f32x4*)(Ab + 492);
        r2[12] -= (f32x2v){a50[0], a50[1]} * T6; r2[13] -= (f32x2v){a50[2], a50[3]} * T6;
        const f32x4 a55 = *(const LAS f32x4*)(Ab + 496);
        r2[14] -= (f32x2v){a51[0], a51[1]} * T6; r2[15] -= (f32x2v){a51[2], a51[3]} * T6;
        const f32x4 a56 = *(const LAS f32x4*)(Ab + 500);
        const float t7 = r2[3][1]; const f32x2v T7 = (f32x2v){t7, t7}; Tw[504] = f2bf(t7); Tt[7] = f2bf(t7);
        r2[4] -= (f32x2v){a52[0], a52[1]} * T7; r2[5] -= (f32x2v){a52[2], a52[3]} * T7;
        const f32x4 a57 = *(const LAS f32x4*)(Ab + 504);
        r2[6] -= (f32x2v){a53[0], a53[1]} * T7; r2[7] -= (f32x2v){a53[2], a53[3]} * T7;
        const f32x4 a58 = *(const LAS f32x4*)(Ab + 552);
        r2[8] -= (f32x2v){a54[0], a54[1]} * T7; r2[9] -= (f32x2v){a54[2], a54[3]} * T7;
        const f32x4 a59 = *(const LAS f32x4*)(Ab + 556);
        r2[10] -= (f32x2v){a55[0], a55[1]} * T7; r2[11] -= (f32x2v){a55[2], a55[3]} * T7;
        const f32x4 a60 = *(const LAS f32x4*)(Ab + 560);
        r2[12] -= (f32x2v){a56[0], a56[1]} * T7; r2[13] -= (f32x2v){a56[2], a56[3]} * T7;
        const f32x4 a61 = *(const LAS f32x4*)(Ab + 564);
        r2[14] -= (f32x2v){a57[0], a57[1]} * T7; r2[15] -= (f32x2v){a57[2], a57[3]} * T7;
        const f32x4 a62 = *(const LAS f32x4*)(Ab + 568);
        const float t8 = r2[4][0]; const f32x2v T8 = (f32x2v){t8, t8}; Tw[576] = f2bf(t8); Tt[8] = f2bf(t8);
        r2[4] -= (f32x2v){a58[0], a58[1]} * T8; r2[5] -= (f32x2v){a58[2], a58[3]} * T8;
        const f32x4 a63 = *(const LAS f32x4*)(Ab + 572);
        r2[6] -= (f32x2v){a59[0], a59[1]} * T8; r2[7] -= (f32x2v){a59[2], a59[3]} * T8;
        const f32x4 a64 = *(const LAS f32x4*)(Ab + 620);
        r2[8] -= (f32x2v){a60[0], a60[1]} * T8; r2[9] -= (f32x2v){a60[2], a60[3]} * T8;
        const f32x4 a65 = *(const LAS f32x4*)(Ab + 624);
        r2[10] -= (f32x2v){a61[0], a61[1]} * T8; r2[11] -= (f32x2v){a61[2], a61[3]} * T8;
        const f32x4 a66 = *(const LAS f32x4*)(Ab + 628);
        r2[12] -= (f32x2v){a62[0], a62[1]} * T8; r2[13] -= (f32x2v){a62[2], a62[3]} * T8;
        const f32x4 a67 = *(const LAS f32x4*)(Ab + 632);
        r2[14] -= (f32x2v){a63[0], a63[1]} * T8; r2[15] -= (f32x2v){a63[2], a63[3]} * T8;
        const f32x4 a68 = *(const LAS f32x4*)(Ab + 636);
        const float t9 = r2[4][1]; const f32x2v T9 = (f32x2v){t9, t9}; Tw[648] = f2bf(t9); Tt[9] = f2bf(t9);
        r2[5] -= (f32x2v){a64[2], a64[3]} * T9;
        const f32x4 a69 = *(const LAS f32x4*)(Ab + 640);
        r2[6] -= (f32x2v){a65[0], a65[1]} * T9; r2[7] -= (f32x2v){a65[2], a65[3]} * T9;
        const f32x4 a70 = *(const LAS f32x4*)(Ab + 688);
        r2[8] -= (f32x2v){a66[0], a66[1]} * T9; r2[9] -= (f32x2v){a66[2], a66[3]} * T9;
        const f32x4 a71 = *(const LAS f32x4*)(Ab + 692);
        r2[10] -= (f32x2v){a67[0], a67[1]} * T9; r2[11] -= (f32x2v){a67[2], a67[3]} * T9;
        const f32x4 a72 = *(const LAS f32x4*)(Ab + 696);
        r2[12] -= (f32x2v){a68[0], a68[1]} * T9; r2[13] -= (f32x2v){a68[2], a68[3]} * T9;
        const f32x4 a73 = *(const LAS f32x4*)(Ab + 700);
        r2[14] -= (f32x2v){a69[0], a69[1]} * T9; r2[15] -= (f32x2v){a69[2], a69[3]} * T9;
        const f32x4 a74 = *(const LAS f32x4*)(Ab + 704);
        const float t10 = r2[5][0]; const f32x2v T10 = (f32x2v){t10, t10}; Tw[720] = f2bf(t10); Tt[10] = f2bf(t10);
        r2[5] -= (f32x2v){a70[2], a70[3]} * T10;
        const f32x4 a75 = *(const LAS f32x4*)(Ab + 708);
        r2[6] -= (f32x2v){a71[0], a71[1]} * T10; r2[7] -= (f32x2v){a71[2], a71[3]} * T10;
        const f32x4 a76 = *(const LAS f32x4*)(Ab + 760);
        r2[8] -= (f32x2v){a72[0], a72[1]} * T10; r2[9] -= (f32x2v){a72[2], a72[3]} * T10;
        const f32x4 a77 = *(const LAS f32x4*)(Ab + 764);
        r2[10] -= (f32x2v){a73[0], a73[1]} * T10; r2[11] -= (f32x2v){a73[2], a73[3]} * T10;
        const f32x4 a78 = *(const LAS f32x4*)(Ab + 768);
        r2[12] -= (f32x2v){a74[0], a74[1]} * T10; r2[13] -= (f32x2v){a74[2], a74[3]} * T10;
        const f32x4 a79 = *(const LAS f32x4*)(Ab + 772);
        r2[14] -= (f32x2v){a75[0], a75[1]} * T10; r2[15] -= (f32x2v){a75[2], a75[3]} * T10;
        const f32x4 a80 = *(const LAS f32x4*)(Ab + 776);
        const float t11 = r2[5][1]; const f32x2v T11 = (f32x2v){t11, t11}; Tw[792] = f2bf(t11); Tt[11] = f2bf(t11);
        r2[6] -= (f32x2v){a76[0], a76[1]} * T11; r2[7] -= (f32x2v){a76[2], a76[3]} * T11;
        const f32x4 a81 = *(const LAS f32x4*)(Ab + 828);
        r2[8] -= (f32x2v){a77[0], a77[1]} * T11; r2[9] -= (f32x2v){a77[2], a77[3]} * T11;
        const f32x4 a82 = *(const LAS f32x4*)(Ab + 832);
        r2[10] -= (f32x2v){a78[0], a78[1]} * T11; r2[11] -= (f32x2v){a78[2], a78[3]} * T11;
        const f32x4 a83 = *(const LAS f32x4*)(Ab + 836);
        r2[12] -= (f32x2v){a79[0], a79[1]} * T11; r2[13] -= (f32x2v){a79[2], a79[3]} * T11;
        const f32x4 a84 = *(const LAS f32x4*)(Ab + 840);
        r2[14] -= (f32x2v){a80[0], a80[1]} * T11; r2[15] -= (f32x2v){a80[2], a80[3]} * T11;
        const f32x4 a85 = *(const LAS f32x4*)(Ab + 844);
        const float t12 = r2[6][0]; const f32x2v T12 = (f32x2v){t12, t12}; Tw[864] = f2bf(t12); Tt[12] = f2bf(t12);
        r2[6] -= (f32x2v){a81[0], a81[1]} * T12; r2[7] -= (f32x2v){a81[2], a81[3]} * T12;
        const f32x4 a86 = *(const LAS f32x4*)(Ab + 896);
        r2[8] -= (f32x2v){a82[0], a82[1]} * T12; r2[9] -= (f32x2v){a82[2], a82[3]} * T12;
        const f32x4 a87 = *(const LAS f32x4*)(Ab + 900);
        r2[10] -= (f32x2v){a83[0], a83[1]} * T12; r2[11] -= (f32x2v){a83[2], a83[3]} * T12;
        const f32x4 a88 = *(const LAS f32x4*)(Ab + 904);
        r2[12] -= (f32x2v){a84[0], a84[1]} * T12; r2[13] -= (f32x2v){a84[2], a84[3]} * T12;
        const f32x4 a89 = *(const LAS f32x4*)(Ab + 908);
        r2[14] -= (f32x2v){a85[0], a85[1]} * T12; r2[15] -= (f32x2v){a85[2], a85[3]} * T12;
        const f32x4 a90 = *(const LAS f32x4*)(Ab + 912);
        const float t13 = r2[6][1]; const f32x2v T13 = (f32x2v){t13, t13}; Tw[936] = f2bf(t13); Tt[13] = f2bf(t13);
        r2[7] -= (f32x2v){a86[2], a86[3]} * T13;
        const f32x4 a91 = *(const LAS f32x4*)(Ab + 964);
        r2[8] -= (f32x2v){a87[0], a87[1]} * T13; r2[9] -= (f32x2v){a87[2], a87[3]} * T13;
        const f32x4 a92 = *(const LAS f32x4*)(Ab + 968);
        r2[10] -= (f32x2v){a88[0], a88[1]} * T13; r2[11] -= (f32x2v){a88[2], a88[3]} * T13;
        const f32x4 a93 = *(const LAS f32x4*)(Ab + 972);
        r2[12] -= (f32x2v){a89[0], a89[1]} * T13; r2[13] -= (f32x2v){a89[2], a89[3]} * T13;
        const f32x4 a94 = *(const LAS f32x4*)(Ab + 976);
        r2[14] -= (f32x2v){a90[0], a90[1]} * T13; r2[15] -= (f32x2v){a90[2], a90[3]} * T13;
        const f32x4 a95 = *(const LAS f32x4*)(Ab + 980);
        const float t14 = r2[7][0]; const f32x2v T14 = (f32x2v){t14, t14}; Tw[1008] = f2bf(t14); Tt[14] = f2bf(t14);
        r2[7] -= (f32x2v){a91[2], a91[3]} * T14;
        const f32x4 a96 = *(const LAS f32x4*)(Ab + 1036);
        r2[8] -= (f32x2v){a92[0], a92[1]} * T14; r2[9] -= (f32x2v){a92[2], a92[3]} * T14;
        const f32x4 a97 = *(const LAS f32x4*)(Ab + 1040);
        r2[10] -= (f32x2v){a93[0], a93[1]} * T14; r2[11] -= (f32x2v){a93[2], a93[3]} * T14;
        const f32x4 a98 = *(const LAS f32x4*)(Ab + 1044);
        r2[12] -= (f32x2v){a94[0], a94[1]} * T14; r2[13] -= (f32x2v){a94[2], a94[3]} * T14;
        const f32x4 a99 = *(const LAS f32x4*)(Ab + 1048);
        r2[14] -= (f32x2v){a95[0], a95[1]} * T14; r2[15] -= (f32x2v){a95[2], a95[3]} * T14;
        const f32x4 a100 = *(const LAS f32x4*)(Ab + 1104);
        const float t15 = r2[7][1]; const f32x2v T15 = (f32x2v){t15, t15}; Tw[1080] = f2bf(t15); Tt[15] = f2bf(t15);
        r2[8] -= (f32x2v){a96[0], a96[1]} * T15; r2[9] -= (f32x2v){a96[2], a96[3]} * T15;
        const f32x4 a101 = *(const LAS f32x4*)(Ab + 1108);
        r2[10] -= (f32x2v){a97[0], a97[1]} * T15; r2[11] -= (f32x2v){a97[2], a97[3]} * T15;
        const f32x4 a102 = *(const LAS f32x4*)(Ab + 1112);
        r2[12] -= (f32x2v){a98[0], a98[1]} * T15; r2[13] -= (f32x2v){a98[2], a98[3]} * T15;
        const f32x4 a103 = *(const LAS f32x4*)(Ab + 1116);
        r2[14] -= (f32x2v){a99[0], a99[1]} * T15; r2[15] -= (f32x2v){a99[2], a99[3]} * T15;
        const f32x4 a104 = *(const LAS f32x4*)(Ab + 1172);
        const float t16 = r2[8][0]; const f32x2v T16 = (f32x2v){t16, t16}; Tw[1152] = f2bf(t16); Tt[16] = f2bf(t16);
        r2[8] -= (f32x2v){a100[0], a100[1]} * T16; r2[9] -= (f32x2v){a100[2], a100[3]} * T16;
        const f32x4 a105 = *(const LAS f32x4*)(Ab + 1176);
        r2[10] -= (f32x2v){a101[0], a101[1]} * T16; r2[11] -= (f32x2v){a101[2], a101[3]} * T16;
        const f32x4 a106 = *(const LAS f32x4*)(Ab + 1180);
        r2[12] -= (f32x2v){a102[0], a102[1]} * T16; r2[13] -= (f32x2v){a102[2], a102[3]} * T16;
        const f32x4 a107 = *(const LAS f32x4*)(Ab + 1184);
        r2[14] -= (f32x2v){a103[0], a103[1]} * T16; r2[15] -= (f32x2v){a103[2], a103[3]} * T16;
        const f32x4 a108 = *(const LAS f32x4*)(Ab + 1240);
        const float t17 = r2[8][1]; const f32x2v T17 = (f32x2v){t17, t17}; Tw[1224] = f2bf(t17); Tt[17] = f2bf(t17);
        r2[9] -= (f32x2v){a104[2], a104[3]} * T17;
        const f32x4 a109 = *(const LAS f32x4*)(Ab + 1244);
        r2[10] -= (f32x2v){a105[0], a105[1]} * T17; r2[11] -= (f32x2v){a105[2], a105[3]} * T17;
        const f32x4 a110 = *(const LAS f32x4*)(Ab + 1248);
        r2[12] -= (f32x2v){a106[0], a106[1]} * T17; r2[13] -= (f32x2v){a106[2], a106[3]} * T17;
        const f32x4 a111 = *(const LAS f32x4*)(Ab + 1252);
        r2[14] -= (f32x2v){a107[0], a107[1]} * T17; r2[15] -= (f32x2v){a107[2], a107[3]} * T17;
        const f32x4 a112 = *(const LAS f32x4*)(Ab + 1312);
        const float t18 = r2[9][0]; const f32x2v T18 = (f32x2v){t18, t18}; Tw[1296] = f2bf(t18); Tt[18] = f2bf(t18);
        r2[9] -= (f32x2v){a108[2], a108[3]} * T18;
        const f32x4 a113 = *(const LAS f32x4*)(Ab + 1316);
        r2[10] -= (f32x2v){a109[0], a109[1]} * T18; r2[11] -= (f32x2v){a109[2], a109[3]} * T18;
        const f32x4 a114 = *(const LAS f32x4*)(Ab + 1320);
        r2[12] -= (f32x2v){a110[0], a110[1]} * T18; r2[13] -= (f32x2v){a110[2], a110[3]} * T18;
        const f32x4 a115 = *(const LAS f32x4*)(Ab + 1380);
        r2[14] -= (f32x2v){a111[0], a111[1]} * T18; r2[15] -= (f32x2v){a111[2], a111[3]} * T18;
        const f32x4 a116 = *(const LAS f32x4*)(Ab + 1384);
        const float t19 = r2[9][1]; const f32x2v T19 = (f32x2v){t19, t19}; Tw[1368] = f2bf(t19); Tt[19] = f2bf(t19);
        r2[10] -= (f32x2v){a112[0], a112[1]} * T19; r2[11] -= (f32x2v){a112[2], a112[3]} * T19;
        const f32x4 a117 = *(const LAS f32x4*)(Ab + 1388);
        r2[12] -= (f32x2v){a113[0], a113[1]} * T19; r2[13] -= (f32x2v){a113[2], a113[3]} * T19;
        const f32x4 a118 = *(const LAS f32x4*)(Ab + 1448);
        r2[14] -= (f32x2v){a114[0], a114[1]} * T19; r2[15] -= (f32x2v){a114[2], a114[3]} * T19;
        const f32x4 a119 = *(const LAS f32x4*)(Ab + 1452);
        const float t20 = r2[10][0]; const f32x2v T20 = (f32x2v){t20, t20}; Tw[1440] = f2bf(t20); Tt[20] = f2bf(t20);
        r2[10] -= (f32x2v){a115[0], a115[1]} * T20; r2[11] -= (f32x2v){a115[2], a115[3]} * T20;
        const f32x4 a120 = *(const LAS f32x4*)(Ab + 1456);
        r2[12] -= (f32x2v){a116[0], a116[1]} * T20; r2[13] -= (f32x2v){a116[2], a116[3]} * T20;
        const f32x4 a121 = *(const LAS f32x4*)(Ab + 1516);
        r2[14] -= (f32x2v){a117[0], a117[1]} * T20; r2[15] -= (f32x2v){a117[2], a117[3]} * T20;
        const f32x4 a122 = *(const LAS f32x4*)(Ab + 1520);
        const float t21 = r2[10][1]; const f32x2v T21 = (f32x2v){t21, t21}; Tw[1512] = f2bf(t21); Tt[21] = f2bf(t21);
        r2[11] -= (f32x2v){a118[2], a118[3]} * T21;
        const f32x4 a123 = *(const LAS f32x4*)(Ab + 1524);
        r2[12] -= (f32x2v){a119[0], a119[1]} * T21; r2[13] -= (f32x2v){a119[2], a119[3]} * T21;
        const f32x4 a124 = *(const LAS f32x4*)(Ab + 1588);
        r2[14] -= (f32x2v){a120[0], a120[1]} * T21; r2[15] -= (f32x2v){a120[2], a120[3]} * T21;
        const f32x4 a125 = *(const LAS f32x4*)(Ab + 1592);
        const float t22 = r2[11][0]; const f32x2v T22 = (f32x2v){t22, t22}; Tw[1584] = f2bf(t22); Tt[22] = f2bf(t22);
        r2[11] -= (f32x2v){a121[2], a121[3]} * T22;
        const f32x4 a126 = *(const LAS f32x4*)(Ab + 1656);
        r2[12] -= (f32x2v){a122[0], a122[1]} * T22; r2[13] -= (f32x2v){a122[2], a122[3]} * T22;
        const f32x4 a127 = *(const LAS f32x4*)(Ab + 1660);
        r2[14] -= (f32x2v){a123[0], a123[1]} * T22; r2[15] -= (f32x2v){a123[2], a123[3]} * T22;
        const f32x4 a128 = *(const LAS f32x4*)(Ab + 1724);
        const float t23 = r2[11][1]; const f32x2v T23 = (f32x2v){t23, t23}; Tw[1656] = f2bf(t23); Tt[23] = f2bf(t23);
        r2[12] -= (f32x2v){a124[0], a124[1]} * T23; r2[13] -= (f32x2v){a124[2], a124[3]} * T23;
        const f32x4 a129 = *(const LAS f32x4*)(Ab + 1728);
        r2[14] -= (f32x2v){a125[0], a125[1]} * T23; r2[15] -= (f32x2v){a125[2], a125[3]} * T23;
        const f32x4 a130 = *(const LAS f32x4*)(Ab + 1792);
        const float t24 = r2[12][0]; const f32x2v T24 = (f32x2v){t24, t24}; Tw[1728] = f2bf(t24); Tt[24] = f2bf(t24);
        r2[12] -= (f32x2v){a126[0], a126[1]} * T24; r2[13] -= (f32x2v){a126[2], a126[3]} * T24;
        const f32x4 a131 = *(const LAS f32x4*)(Ab + 1796);
        r2[14] -= (f32x2v){a127[0], a127[1]} * T24; r2[15] -= (f32x2v){a127[2], a127[3]} * T24;
        const f32x4 a132 = *(const LAS f32x4*)(Ab + 1864);
        const float t25 = r2[12][1]; const f32x2v T25 = (f32x2v){t25, t25}; Tw[1800] = f2bf(t25); Tt[25] = f2bf(t25);
        r2[13] -= (f32x2v){a128[2], a128[3]} * T25;
        const f32x4 a133 = *(const LAS f32x4*)(Ab + 1932);
        r2[14] -= (f32x2v){a129[0], a129[1]} * T25; r2[15] -= (f32x2v){a129[2], a129[3]} * T25;
        const f32x4 a134 = *(const LAS f32x4*)(Ab + 2000);
        const float t26 = r2[13][0]; const f32x2v T26 = (f32x2v){t26, t26}; Tw[1872] = f2bf(t26); Tt[26] = f2bf(t26);
        r2[13] -= (f32x2v){a130[2], a130[3]} * T26;
        const f32x4 a135 = *(const LAS f32x4*)(Ab + 2068);
        r2[14] -= (f32x2v){a131[0], a131[1]} * T26; r2[15] -= (f32x2v){a131[2], a131[3]} * T26;
        const float t27 = r2[13][1]; const f32x2v T27 = (f32x2v){t27, t27}; Tw[1944] = f2bf(t27); Tt[27] = f2bf(t27);
        r2[14] -= (f32x2v){a132[0], a132[1]} * T27; r2[15] -= (f32x2v){a132[2], a132[3]} * T27;
        const float t28 = r2[14][0]; const f32x2v T28 = (f32x2v){t28, t28}; Tw[2016] = f2bf(t28); Tt[28] = f2bf(t28);
        r2[14] -= (f32x2v){a133[0], a133[1]} * T28; r2[15] -= (f32x2v){a133[2], a133[3]} * T28;
        const float t29 = r2[14][1]; const f32x2v T29 = (f32x2v){t29, t29}; Tw[2088] = f2bf(t29); Tt[29] = f2bf(t29);
        r2[15] -= (f32x2v){a134[2], a134[3]} * T29;
        const float t30 = r2[15][0]; const f32x2v T30 = (f32x2v){t30, t30}; Tw[2160] = f2bf(t30); Tt[30] = f2bf(t30);
        r2[15] -= (f32x2v){a135[2], a135[3]} * T30;
        Tw[2232] = f2bf(r2[15][1]); Tt[31] = f2bf(r2[15][1]);
    } else if (wid == 2) {
        *(LAS u32x4*)(Tb + (lane >> 1) * 72 + 32 + (lane & 1) * 16) = (u32x4){0u, 0u, 0u, 0u}; *(LAS u32x4*)(Tb + (lane >> 1) * 72 + 32 + (lane & 1) * 16 + 8) = (u32x4){0u, 0u, 0u, 0u};
    }
    __syncthreads();
    if (wid < 4) {
        const int mt = wid >> 1, nt = wid & 1; const f32x4 acc = tile_mm(A10b, 40, mt, TT, 40, nt, 1, fr, fq);
        u32x2 w; w.x = cvt_pk(acc[0], acc[1]); w.y = cvt_pk(acc[2], acc[3]); *(LAS u32x2*)(PT + (16 * nt + fr) * 40 + 16 * mt + 4 * fq) = w;
    }
    __syncthreads();
    if (wid < 4) {
        const int mt = wid >> 1, nt = wid & 1; const f32x4 acc = tile_mm(Tb + 32 * 72 + 32, 72, mt, PT, 40, nt, 1, fr, fq);
#pragma unroll
        for (int e = 0; e < 4; ++e) Tb[(32 + 16 * mt + 4 * fq + e) * 72 + 16 * nt + fr] = f2bf(-acc[e]);
    }
    __syncthreads();
#pragma unroll 2
    for (int r = 0; r < 8; ++r) {
        const int job = wid + 8 * r, kind = job >> 5, tile = job & 31, mt = tile >> 3, nt = tile & 7;
        const f32x4 acc = tile_mm<false, true>(Tb, 72, mt, kind ? KbT : VbT, 72, nt, 2, fr, fq);
        u32x2 w; w.x = cvt_pk(acc[0], acc[1]); w.y = cvt_pk(acc[2], acc[3]);
        { const int ch = 16 * nt + fr; *(LAS u32x2*)((kind ? WT : UT) + ch * 72 + 8 * ((2 * mt + (fq >> 1)) ^ ((ch >> 3) & 7)) + 4 * (fq & 1)) = w; }
    }
    __syncthreads();
    bf16_t* GM = (bf16_t*)(p.ws + WS_GM) + (size_t)unit * 16384; bf16_t* GN = (bf16_t*)(p.ws + WS_GN) + (size_t)unit * 16384;
    bf16_t* GQ = (bf16_t*)(p.ws + WS_GQ) + (size_t)unit * 8192; bf16_t* GO = (bf16_t*)(p.ws + WS_GO) + (size_t)unit * 8192;
#pragma unroll 2
    for (int r = 0; r < 24; ++r) {
        const int job = wid + 8 * r;
        if (job < 64) { const int a = job >> 3, mt = job & 7;
            const f32x4 acc = tile_mm<true, true>(WT, 72, a, KdT, 72, mt, 2, fr, fq);
            u32x2 w; w.x = cvt_pk(-acc[0], -acc[1]); w.y = cvt_pk(-acc[2], -acc[3]);
            *(u32x2*)(GM + ((mt * 4 + (a >> 1)) * 64 + lane) * 8 + (a & 1) * 4) = w;
        } else if (job < 128) { const int j = job - 64, mt = j >> 3, nt = j & 7;
            const f32x4 acc = tile_mm<true, true>(KdT, 72, mt, UT, 72, nt, 2, fr, fq);
            u32x2 w; w.x = cvt_pk(acc[0], acc[1]); w.y = cvt_pk(acc[2], acc[3]);
            *(u32x2*)(GN + ((nt * 64 + lane) * 8 + mt) * 4) = w;
        } else if (job < 160) { const int j = job - 128, a = j >> 2, it = j & 3;
            const f32x4 acc = tile_mm<true, false>(WT, 72, a, QK, 72, it, 2, fr, fq);
            const int i = 16 * it + fr; const float eg = __expf(gcs[i]);
            const u32x2 qv = *(const LAS u32x2*)(Qs + i * 136 + 16 * a + 4 * fq);
            u32x2 w; w.x = cvt_pk(bflo(qv.x) * eg - acc[0], bfhi(qv.x) * eg - acc[1]); w.y = cvt_pk(bflo(qv.y) * eg - acc[2], bfhi(qv.y) * eg - acc[3]);
            *(u32x2*)(GQ + ((it * 4 + (a >> 1)) * 64 + lane) * 8 + (a & 1) * 4) = w;
        } else { const int j = job - 160, mt = j >> 3, nt = j & 7;
            const f32x4 acc = tile_mm<false, true>(QK, 72, mt, UT, 72, nt, 2, fr, fq);
            u32x2 w; w.x = cvt_pk(acc[0], acc[1]); w.y = cvt_pk(acc[2], acc[3]);
            *(u32x2*)(GO + ((nt * 64 + lane) * 4 + mt) * 4) = w;
        }
    }
    if (tid == 0) ((float*)(p.ws + WS_CTL + CTL_GLAST))[unit] = __expf(gclast);
    __syncthreads();
}

__device__ __forceinline__ void gdn_scan(const Params& p, LAS unsigned char* lds, int sb) {
    const int tid = threadIdx.x, lane = tid & 63, wid = tid >> 6, fr = lane & 15, fq = lane >> 4;
    const int bh = sb / (8 / CW), sp = sb % (8 / CW), unit0 = bh * 128, sl = sp * CW + wid;
    const u32x4* GMb = (const u32x4*)((const bf16_t*)(p.ws + WS_GM) + (size_t)unit0 * 16384);
    const u32x4* GQb = (const u32x4*)((const bf16_t*)(p.ws + WS_GQ) + (size_t)unit0 * 8192);
    const bf16_t* GNb = (const bf16_t*)(p.ws + WS_GN) + (size_t)unit0 * 16384;
    bf16_t* GOb = (bf16_t*)(p.ws + WS_GO) + (size_t)unit0 * 8192;
    const float* glast = (const float*)(p.ws + WS_CTL + CTL_GLAST) + unit0;
    const bool loader = (wid >= CW && wid < CW + 4);
#define SCAN_DMA(cc) do { _Pragma("unroll") for (int k = 0; k < 8; ++k) { const int inst = (wid - CW) * 8 + k; \
        __builtin_amdgcn_global_load_lds((const unsigned*)((const char*)(GMb + (size_t)(cc) * 2048) + inst * 1024 + lane * 16), (LAS unsigned*)(lds + ((cc) & 3) * 32768 + inst * 1024), 16, 0, 0); } } while (0)
#define SCAN_LOADN(dn, cc) do { const bf16_t* np_ = GNb + (size_t)((cc) < 128 ? (cc) : 127) * 16384 + (size_t)(sl * 64 + lane) * 32; \
        asm volatile("global_load_dwordx4 %0, %4, off\n\tglobal_load_dwordx4 %1, %4, off offset:16\n\tglobal_load_dwordx4 %2, %4, off offset:32\n\tglobal_load_dwordx4 %3, %4, off offset:48" \
            : "=&v"(dn[0]), "=&v"(dn[1]), "=&v"(dn[2]), "=&v"(dn[3]) : "v"(np_) : "memory"); } while (0)
#define SCAN_WAITN(dn, N) asm volatile("s_waitcnt vmcnt(" #N ")" : "+v"(dn[0]), "+v"(dn[1]), "+v"(dn[2]), "+v"(dn[3]) :: "memory")
#define SCAN_STEP(c, nn, RELOAD) do { \
        SCAN_WAITN(nn, 8); \
        const float gl = __shfl(((c) < 64) ? glr0 : glr1, (c) & 63); bf16x8 Sb[4]; \
        bf16_t* scp = (bf16_t*)GNb + (size_t)(c) * 16384 + (size_t)sl * 2048 + lane * 8; \
        _Pragma("unroll") for (int ks = 0; ks < 4; ++ks) { u32x4 w; w.x = cvt_pk(S[2 * ks][0], S[2 * ks][1]); w.y = cvt_pk(S[2 * ks][2], S[2 * ks][3]); \
            w.z = cvt_pk(S[2 * ks + 1][0], S[2 * ks + 1][1]); w.w = cvt_pk(S[2 * ks + 1][2], S[2 * ks + 1][3]); Sb[ks] = __builtin_bit_cast(bf16x8, w); } \
        const LAS unsigned char* slot = lds + ((c) & 3) * 32768 + lane * 16; \
        bf16x8 fa[2][2][4]; \
        _Pragma("unroll") for (int ks = 0; ks < 4; ++ks) { fa[0][0][ks] = *(const LAS bf16x8*)(slot + (0 * 4 + ks) * 1024); fa[0][1][ks] = *(const LAS bf16x8*)(slot + (1 * 4 + ks) * 1024); } \
        _Pragma("unroll") for (int mt = 0; mt < 8; ++mt) { const unsigned w0 = nn[mt >> 1][(mt & 1) * 2], w1 = nn[mt >> 1][(mt & 1) * 2 + 1]; \
            S[mt] = S[mt] * gl + (f32x4){bflo(w0), bfhi(w0), bflo(w1), bfhi(w1)}; } \
        _Pragma("unroll") for (int ks = 0; ks < 4; ++ks) *(u32x4*)(scp + ks * 512) = __builtin_bit_cast(u32x4, Sb[ks]);     \
        RELOAD; \
        _Pragma("unroll") for (int pr = 0; pr < 4; ++pr) { \
            if (pr < 3) { _Pragma("unroll") for (int ks = 0; ks < 4; ++ks) { fa[(pr + 1) & 1][0][ks] = *(const LAS bf16x8*)(slot + ((2 * pr + 2) * 4 + ks) * 1024); fa[(pr + 1) & 1][1][ks] = *(const LAS bf16x8*)(slot + ((2 * pr + 3) * 4 + ks) * 1024); } } \
            _Pragma("unroll") for (int ks = 0; ks < 4; ++ks) { S[2 * pr] = mfma16(fa[pr & 1][0][ks], Sb[ks], S[2 * pr]); S[2 * pr + 1] = mfma16(fa[pr & 1][1][ks], Sb[ks], S[2 * pr + 1]); } } \
        } while (0)
    if (loader) { SCAN_DMA(0); SCAN_DMA(1); SCAN_DMA(2); asm volatile("s_waitcnt vmcnt(0)" ::: "memory"); }
    f32x4 S[8];
#pragma unroll
    for (int mt = 0; mt < 8; ++mt) S[mt] = (f32x4){0.f, 0.f, 0.f, 0.f};
    float glr0 = glast[lane], glr1 = glast[64 + lane];
    asm volatile("" : "+v"(glr0), "+v"(glr1));
    u32x4 nnA[4], nnB[4];
    if (wid < CW) { SCAN_LOADN(nnA, 0); SCAN_LOADN(nnB, 1); SCAN_WAITN(nnA, 0); SCAN_WAITN(nnB, 0); }
    asm volatile("s_waitcnt lgkmcnt(0)" ::: "memory"); __builtin_amdgcn_s_barrier(); asm volatile("" ::: "memory");
#pragma unroll 1
    for (int c = 0; c < 128; c += 2) {
        if (loader) { if (c + 3 < 128) { SCAN_DMA(c + 3); asm volatile("s_waitcnt vmcnt(16)" ::: "memory"); } else asm volatile("s_waitcnt vmcnt(0)" ::: "memory"); }
        else if (wid < CW) { SCAN_STEP(c, nnA, SCAN_LOADN(nnA, c + 2)); }
        asm volatile("s_waitcnt lgkmcnt(0)" ::: "memory"); __builtin_amdgcn_s_barrier(); asm volatile("" ::: "memory");
        if (loader) { if (c + 4 < 128) { SCAN_DMA(c + 4); asm volatile("s_waitcnt vmcnt(16)" ::: "memory"); } else asm volatile("s_waitcnt vmcnt(0)" ::: "memory"); }
        else if (wid < CW) { SCAN_STEP(c + 1, nnB, SCAN_LOADN(nnB, c + 3)); }
        asm volatile("s_waitcnt lgkmcnt(0)" ::: "memory"); __builtin_amdgcn_s_barrier(); asm volatile("" ::: "memory");
    }
#undef SCAN_DMA
#undef SCAN_LOADN
#undef SCAN_WAITN
#undef SCAN_STEP
    __syncthreads();
    if (wid < CW) {
        float* go = p.out + O_GP + (size_t)bh * 16384;
#pragma unroll
        for (int mt = 0; mt < 8; ++mt)
#pragma unroll
            for (int e = 0; e < 4; ++e) go[(16 * mt + 4 * fq + e) * 128 + sl * 16 + fr] = S[mt][e];
    }
}

__device__ __forceinline__ void gdn_gate_unit(const Params& p, int unit, int lane) {
    const int fr = lane & 15, fq = lane >> 4, bh = unit >> 7, n = unit & 127, b = bh >> 2, h = bh & 3, tok0 = b * SEQ + n * 64;
    const bf16_t* GO = (const bf16_t*)(p.ws + WS_GO) + (size_t)unit * 8192;
    bf16_t* PB = (bf16_t*)(p.ws + WS_H);
    float ssq[16];
#pragma unroll
    for (int k = 0; k < 16; ++k) ssq[k] = 0.f;
    {
        bf16_t* GOw = (bf16_t*)(p.ws + WS_GO) + (size_t)unit * 8192;
        const bf16_t* GQ = (const bf16_t*)(p.ws + WS_GQ) + (size_t)unit * 8192; const bf16_t* SC = (const bf16_t*)(p.ws + WS_GN) + (size_t)unit * 16384;
        bf16x8 qa[4][4];
#pragma unroll
        for (int mt = 0; mt < 4; ++mt)
#pragma unroll
            for (int ks = 0; ks < 4; ++ks) qa[mt][ks] = *(const bf16x8*)(GQ + ((mt * 4 + ks) * 64 + lane) * 8);
#pragma unroll 2
        for (int nt = 0; nt < 8; ++nt) {
            bf16x8 sb[4];
#pragma unroll
            for (int ks = 0; ks < 4; ++ks) sb[ks] = *(const bf16x8*)(SC + nt * 2048 + (ks * 64 + lane) * 8);
            const u32x4 o0 = *(const u32x4*)(GOw + (nt * 64 + lane) * 16), o1 = *(const u32x4*)(GOw + (nt * 64 + lane) * 16 + 8);
            f32x4 acc[4];
            acc[0] = (f32x4){bflo(o0.x), bfhi(o0.x), bflo(o0.y), bfhi(o0.y)}; acc[1] = (f32x4){bflo(o0.z), bfhi(o0.z), bflo(o0.w), bfhi(o0.w)};
            acc[2] = (f32x4){bflo(o1.x), bfhi(o1.x), bflo(o1.y), bfhi(o1.y)}; acc[3] = (f32x4){bflo(o1.z), bfhi(o1.z), bflo(o1.w), bfhi(o1.w)};
#pragma unroll
            for (int ks = 0; ks < 4; ++ks)
#pragma unroll
                for (int mt = 0; mt < 4; ++mt) acc[mt] = mfma16(qa[mt][ks], sb[ks], acc[mt]);
#pragma unroll
            for (int mt = 0; mt < 4; ++mt)
#pragma unroll
                for (int e = 0; e < 4; ++e) ssq[4 * mt + e] += acc[mt][e] * acc[mt][e];
            u32x4 w0, w1;
            w0.x = cvt_pk(acc[0][0], acc[0][1]); w0.y = cvt_pk(acc[0][2], acc[0][3]); w0.z = cvt_pk(acc[1][0], acc[1][1]); w0.w = cvt_pk(acc[1][2], acc[1][3]);
            w1.x = cvt_pk(acc[2][0], acc[2][1]); w1.y = cvt_pk(acc[2][2], acc[2][3]); w1.z = cvt_pk(acc[3][0], acc[3][1]); w1.w = cvt_pk(acc[3][2], acc[3][3]);
            *(u32x4*)(GOw + (nt * 64 + lane) * 16) = w0; *(u32x4*)(GOw + (nt * 64 + lane) * 16 + 8) = w1;
        }
        asm volatile("s_waitcnt vmcnt(0)" ::: "memory");
    }
#pragma unroll
    for (int k = 0; k < 16; ++k) { float s = row16_sum(ssq[k]); ssq[k] = rsqrtf(s * (1.0f / 128.0f) + EPS); }
    const float* gn = p.in[15];
#pragma unroll 2
    for (int nt = 0; nt < 8; ++nt) {
        const int dv = 16 * nt + fr; const float g = gn[dv];
        const u32x4 a0 = *(const u32x4*)(GO + (nt * 64 + lane) * 16), a1 = *(const u32x4*)(GO + (nt * 64 + lane) * 16 + 8);
        const bf16_t* gzp = PB + (size_t)(tok0 + 4 * fq) * PW + 2304 + h * 128 + dv; bf16_t* mp = PB + (size_t)(tok0 + 4 * fq) * PW + 512 + h * 128 + dv;
#pragma unroll
        for (int k = 0; k < 16; ++k) {
            const unsigned w = (k < 8) ? a0[(k >> 1) & 3] : a1[(k >> 1) & 3]; const float o = (k & 1) ? bfhi(w) : bflo(w);
            const int to = 16 * (k >> 2) + (k & 3);
            const float gz = bf2f(gzp[(size_t)to * PW]);
            mp[(size_t)to * PW] = f2bf(o * ssq[k] * g * silu(gz));
        }
    }
}

__device__ __forceinline__ void attn_unit(const Params& p, LAS unsigned char* lds, int unit) {
    const int tid = threadIdx.x, lane = tid & 63, wid = tid >> 6, fr = lane & 15, fq = lane >> 4;
    const int b = unit >> 7, blk = (unit >> 1) & 63, kvh = unit & 1;
    LAS bf16_t* Ks = (LAS bf16_t*)lds; LAS bf16_t* Vt = (LAS bf16_t*)(lds + 36864);
    bf16_t* PB = (bf16_t*)(p.ws + WS_H);
    __syncthreads();
#pragma unroll
    for (int i = 0; i < 4; ++i) {
        const int q = tid + 512 * i, row = q >> 3, ch = q & 7, tp = blk * 128 - 128 + row;
        u32x4 kv = (u32x4){0u, 0u, 0u, 0u}, vv = (u32x4){0u, 0u, 0u, 0u};
        if (tp >= 0) { const bf16_t* base = PB + (size_t)(b * SEQ + tp) * PW; kv = *(const u32x4*)(base + 512 + kvh * 64 + ch * 8); vv = *(const u32x4*)(base + 640 + kvh * 64 + ch * 8); }
        *(LAS u32x4*)(Ks + row * 72 + ch * 8) = kv;
#pragma unroll
        for (int e = 0; e < 4; ++e) { const unsigned w = vv[e]; Vt[(ch * 8 + 2 * e) * 264 + row] = (bf16_t)(w & 0xffffu); Vt[(ch * 8 + 2 * e + 1) * 264 + row] = (bf16_t)(w >> 16); }
    }
    __syncthreads();
    const int qtok = b * SEQ + blk * 128 + 16 * wid + fr;
#pragma unroll 1
    for (int g = 0; g < 4; ++g) {
        const int h = kvh * 4 + g; const float slope = exp2f(-(float)(h + 1)), sink = p.in[11][h];
        bf16x8 qf[2];
#pragma unroll
        for (int ks = 0; ks < 2; ++ks) qf[ks] = *(const bf16x8*)(PB + (size_t)qtok * PW + h * 64 + ks * 32 + 8 * fq);
        f32x4 s[10]; float mx = sink;
#pragma unroll
        for (int j = 0; j < 10; ++j) {
            const int ct = (wid + j) < 15 ? (wid + j) : 15;
            f32x4 acc = (f32x4){0.f, 0.f, 0.f, 0.f};
#pragma unroll
            for (int ks = 0; ks < 2; ++ks) acc = mfma16(*(const LAS bf16x8*)(Ks + (16 * ct + fr) * 72 + ks * 32 + 8 * fq), qf[ks], acc);
#pragma unroll
            for (int e = 0; e < 4; ++e) {
                const int c = 16 * (wid + j) + 4 * fq + e, dist = 16 * wid + fr - c + 128;
                const bool ok = (wid + j <= 15) && dist >= 0 && dist <= 128 && (blk * 128 + c - 128 >= 0);
                const float v = ok ? acc[e] * 0.125f - slope * (float)dist : -INFINITY;
                acc[e] = v; mx = fmaxf(mx, v);
            }
            s[j] = acc;
            asm volatile("" ::: "memory");
        }
        mx = fmaxf(mx, __shfl_xor(mx, 16)); mx = fmaxf(mx, __shfl_xor(mx, 32));
        float sum = 0.f;
#pragma unroll
        for (int j = 0; j < 10; ++j)
#pragma unroll
            for (int e = 0; e < 4; ++e) { const float pv = __expf(s[j][e] - mx); s[j][e] = pv; sum += pv; }
        sum += __shfl_xor(sum, 16); sum += __shfl_xor(sum, 32);
        sum += __expf(sink - mx);
        const float inv = 1.0f / sum;
        bf16x8 pb[5];
#pragma unroll
        for (int kk = 0; kk < 5; ++kk) { u32x4 w; w.x = cvt_pk(s[2 * kk][0] * inv, s[2 * kk][1] * inv); w.y = cvt_pk(s[2 * kk][2] * inv, s[2 * kk][3] * inv);
            w.z = cvt_pk(s[2 * kk + 1][0] * inv, s[2 * kk + 1][1] * inv); w.w = cvt_pk(s[2 * kk + 1][2] * inv, s[2 * kk + 1][3] * inv); pb[kk] = __builtin_bit_cast(bf16x8, w); }
#pragma unroll
        for (int dt = 0; dt < 4; ++dt) {
            f32x4 acc = (f32x4){0.f, 0.f, 0.f, 0.f};
#pragma unroll
            for (int kk = 0; kk < 5; ++kk) {
                const int c0 = (wid + 2 * kk) < 15 ? (wid + 2 * kk) : 15, c1 = (wid + 2 * kk + 1) < 15 ? (wid + 2 * kk + 1) : 15;
                const u32x2 lo = *(const LAS u32x2*)(Vt + (16 * dt + fr) * 264 + 16 * c0 + 4 * fq), hi = *(const LAS u32x2*)(Vt + (16 * dt + fr) * 264 + 16 * c1 + 4 * fq);
                const u32x4 a = (u32x4){lo.x, lo.y, hi.x, hi.y};
                acc = mfma16(__builtin_bit_cast(bf16x8, a), pb[kk], acc);
            }
            u32x2 w; w.x = cvt_pk(acc[0], acc[1]); w.y = cvt_pk(acc[2], acc[3]);
            *(u32x2*)(PB + (size_t)qtok * PW + h * 64 + 16 * dt + 4 * fq) = w;
            asm volatile("" ::: "memory");
        }
    }
}

__device__ __forceinline__ void sattn_unit(const Params& p, int s, int h, int lane) {
    const int kvh = h >> 2; const bool wr = (h & 3) == 0;
    bf16_t* PB = (bf16_t*)(p.ws + WS_H) + (size_t)(MPR + s) * PW;
    const float* ck = p.in[2] + (size_t)s * 128 * 128 + kvh * 64 + lane; const float* cv = p.in[3] + (size_t)s * 128 * 128 + kvh * 64 + lane;
    float* nk = p.out + O_KS + (size_t)s * 128 * 128 + kvh * 64 + lane; float* nv = p.out + O_VS + (size_t)s * 128 * 128 + kvh * 64 + lane;
    const float q = bf2f(PB[h * 64 + lane]) * 0.125f, slope = exp2f(-(float)(h + 1)), sink = p.in[11][h];
    const float knew = bf2f(PB[512 + kvh * 64 + lane]), vnew = bf2f(PB[640 + kvh * 64 + lane]);
    float sc[3];
#pragma unroll
    for (int t = 0; t < 2; ++t) {
#pragma unroll 8
        for (int jj = 0; jj < 64; ++jj) {
            const int j = t * 64 + jj; const float kval = ck[(size_t)j * 128];
            if (wr && j >= 1) nk[(size_t)(j - 1) * 128] = kval;
            const float d = wave_sum(q * kval) - slope * (float)(128 - j); if (lane == jj) sc[t] = d;
        }
    }
    if (wr) nk[(size_t)127 * 128] = knew;
    sc[2] = wave_sum(q * knew);
    const float mx = fmaxf(fmaxf(wave_max(fmaxf(sc[0], sc[1])), sc[2]), sink);
    const float p0 = __expf(sc[0] - mx), p1 = __expf(sc[1] - mx), p2 = __expf(sc[2] - mx);
    const float inv = 1.0f / (wave_sum(p0 + p1) + p2 + __expf(sink - mx));
    float o = p2 * vnew;
#pragma unroll 8
    for (int jj = 0; jj < 64; ++jj) { const float vval = cv[(size_t)jj * 128]; if (wr && jj >= 1) nv[(size_t)(jj - 1) * 128] = vval; o += __shfl(p0, jj) * vval; }
#pragma unroll 8
    for (int jj = 0; jj < 64; ++jj) { const float vval = cv[(size_t)(64 + jj) * 128]; if (wr) nv[(size_t)(63 + jj) * 128] = vval; o += __shfl(p1, jj) * vval; }
    if (wr) nv[(size_t)127 * 128] = vnew;
    asm volatile("" ::: "memory");
    PB[h * 64 + lane] = f2bf(o * inv);
}

__device__ __forceinline__ void sgdn_unit(const Params& p, LAS unsigned char* lds, int s) {
    const int tid = threadIdx.x, wid = tid >> 6, h = tid >> 7, dv = tid & 127;
    LAS float* qs = (LAS float*)lds; LAS float* ks = qs + 512; LAS float* red = ks + 512;
    bf16_t* PB = (bf16_t*)(p.ws + WS_H) + (size_t)(MPR + s) * PW; const float* GBA = (const float*)(p.ws + WS_GBA) + (size_t)(MPR + s) * 8;
    const float* cw = p.in[12]; const float* hc = p.in[4] + (size_t)s * 3 * CONVC; float* nc = p.out + O_CS + (size_t)s * 3 * CONVC;
    __syncthreads();
    float val[3];
#pragma unroll
    for (int i = 0; i < 3; ++i) {
        const int c = i * 512 + tid; const float x3 = bf2f(PB[768 + c]), h0 = hc[c], h1 = hc[CONVC + c], h2 = hc[2 * CONVC + c];
        val[i] = silu(cw[c] * h0 + cw[CONVC + c] * h1 + cw[2 * CONVC + c] * h2 + cw[3 * CONVC + c] * x3);
        nc[c] = h1; nc[CONVC + c] = h2; nc[2 * CONVC + c] = x3;
    }
    const float sq = wave_sum(val[0] * val[0]), sk = wave_sum(val[1] * val[1]);
    if ((tid & 63) == 0) { red[wid] = sq; red[8 + wid] = sk; }
    __syncthreads();
    const float ssq = red[2 * h] + red[2 * h + 1], ssk = red[8 + 2 * h] + red[8 + 2 * h + 1];
    qs[tid] = val[0] * rsqrtf(ssq + EPS) * 0.08838834764831845f; ks[tid] = val[1] * rsqrtf(ssk + EPS);
    __syncthreads();
    const float beta = 1.0f / (1.0f + __expf(-GBA[h]));
    const float x = GBA[4 + h] + p.in[14][h]; const float sp = x > 20.f ? x : log1pf(__expf(x));
    const float eg = __expf(-__expf(p.in[13][h]) * sp);
    const float* S0 = p.in[5] + ((size_t)(s * 4 + h) * 128) * 128 + dv; float* S1 = p.out + O_GS + ((size_t)(s * 4 + h) * 128) * 128 + dv;
    float kS = 0.f;
#pragma unroll 1
    for (int hf = 0; hf < 4; ++hf) { float sv[32];
#pragma unroll
        for (int dk = 0; dk < 32; ++dk) sv[dk] = S0[(size_t)(hf * 32 + dk) * 128];
#pragma unroll
        for (int dk = 0; dk < 32; ++dk) kS += ks[h * 128 + hf * 32 + dk] * sv[dk]; }
    const float delta = beta * (val[2] - eg * kS);
    float o = 0.f;
#pragma unroll 1
    for (int hf = 0; hf < 4; ++hf) { float sv[32];
#pragma unroll
        for (int dk = 0; dk < 32; ++dk) sv[dk] = S0[(size_t)(hf * 32 + dk) * 128];
#pragma unroll
        for (int dk = 0; dk < 32; ++dk) { const float nvv = eg * sv[dk] + ks[h * 128 + hf * 32 + dk] * delta; S1[(size_t)(hf * 32 + dk) * 128] = nvv; o += qs[h * 128 + hf * 32 + dk] * nvv; } }
    const float so = wave_sum(o * o);
    if ((tid & 63) == 0) red[16 + wid] = so;
    __syncthreads();
    const float tot = red[16 + 2 * h] + red[16 + 2 * h + 1];
    const float gz = bf2f(PB[2304 + tid]);
    PB[512 + tid] = f2bf(o * rsqrtf(tot * (1.0f / 128.0f) + EPS) * p.in[15][dv] * silu(gz));
}

__device__ __forceinline__ void late_weight_items(const Params& p, LAS unsigned char* lds, int gw, int NGW) {
    const int lane = threadIdx.x & 63, wid = threadIdx.x >> 6;
    LAS float* scr = (LAS float*)(lds + wid * 16384);
    bf16_t* WOUTMIX = (bf16_t*)(p.ws + WS_WOUTMIX); bf16_t* W2IN = (bf16_t*)(p.ws + WS_W2IN); bf16_t* W2OUT = (bf16_t*)(p.ws + WS_W2OUT);
    constexpr int I_FIN = 16 * 176, I_FOUT = 44 * 32, I_OUTMIX = 16 * 32;
    for (int it = gw; it < I_FIN + I_FOUT + I_OUTMIX; it += NGW) {
        int r = it;
        if (r < I_OUTMIX) { const int kb = r / 32, nb = r % 32; transpose_item(p.in[16], DM, DM, WOUTMIX, kb * 64, nb * 32, nb * 32, nullptr, scr, lane); continue; } r -= I_OUTMIX;
        if (r < I_FIN) { const int kb = r / 176, nb = r % 176; transpose_item(p.in[18], DM, 2 * DFF, W2IN, kb * 64, nb * 32, map_ffin_row(nb * 32), p.in[17], scr, lane); continue; } r -= I_FIN;
        { const int kb = r / 32, nb = r % 32; transpose_item(p.in[19], DFF, DM, W2OUT, kb * 64, nb * 32, nb * 32, nullptr, scr, lane); }
    }
}
#define XB_TMO      128
#define XB_XCNT(j)  (256  + 64 * (j))
#define XB_XSUB(j)  (1280 + 64 * (j))
#define XB_XGEN(j)  (2304 + 64 * (j))
#define XB_TOP      3328
#define XB_TOPGEN   3392
#define XCD_BAR_WORDS 3456
#define XB_SPIN_CAP (1u << 18)

__device__ __forceinline__ unsigned xb_ld(unsigned* p)              { return __hip_atomic_load(p, __ATOMIC_RELAXED, __HIP_MEMORY_SCOPE_AGENT); }
__device__ __forceinline__ unsigned xb_add(unsigned* p, unsigned v) { return __hip_atomic_fetch_add(p, v, __ATOMIC_RELAXED, __HIP_MEMORY_SCOPE_AGENT); }
__device__ __forceinline__ unsigned xb_xcc_id() { return (unsigned)__builtin_amdgcn_s_getreg((3 << 11) | 20) & 0xFu; }
#define XB_SPIN(cond, bar) do { unsigned _sp = 0; while (cond) { __builtin_amdgcn_s_sleep(1); \
    if ((++_sp & 255u) == 0u) { if (xb_ld(&(bar)[XB_TMO])) break; if (_sp > XB_SPIN_CAP) { atomicAdd(&(bar)[XB_TMO], 1u); break; } } } } while (0)

struct XcdBarrier {
    unsigned* bar; unsigned x;
    volatile LAS unsigned* st;
};

__device__ __forceinline__ XcdBarrier xcd_barrier_post(unsigned* bar, volatile LAS unsigned* st) {
    XcdBarrier b; b.bar = bar; b.x = xb_xcc_id(); b.st = st;
    if (threadIdx.x == 0) (void)xb_add(&bar[XB_XCNT(b.x)], 1u);
    return b;
}
__device__ __forceinline__ void xcd_barrier_complete(unsigned* bar, unsigned x, unsigned& nloc, unsigned& nx) {
    const unsigned G = gridDim.x * gridDim.y * gridDim.z;
    unsigned sum, cnt, mine, sp = 0u;
    for (;;) {
        sum = 0u; cnt = 0u; mine = 0u;
#pragma unroll
        for (unsigned j = 0; j < 16; ++j) { const unsigned c = xb_ld(&bar[XB_XCNT(j)]); sum += c; cnt += (c > 0u) ? 1u : 0u; mine = (j == x) ? c : mine; }
        if (sum == G) break;
        __builtin_amdgcn_s_sleep(1);
        if ((++sp & 255u) == 0u) { if (xb_ld(&bar[XB_TMO])) break; if (sp > XB_SPIN_CAP) { atomicAdd(&bar[XB_TMO], 1u); break; } }
    }
    nloc = mine > 0u ? mine : 1u; nx = cnt > 0u ? cnt : 1u;
}

__device__ __forceinline__ void xcd_barrier(const XcdBarrier& b) {
    asm volatile("s_waitcnt vmcnt(0)" ::: "memory");
    __syncthreads();
    if (threadIdx.x == 0) {
        unsigned* bar = b.bar;
        __builtin_amdgcn_s_waitcnt(0);
        unsigned nloc = b.st[0], nx = b.st[1];
        if (nloc == 0u) { xcd_barrier_complete(bar, b.x, nloc, nx); b.st[0] = nloc; b.st[1] = nx; }
        const unsigned old = xb_add(&bar[XB_XSUB(b.x)], 1u);
        const unsigned gen = old / nloc;
        if (old + 1u == (gen + 1u) * nloc) {
            __builtin_amdgcn_fence(__ATOMIC_RELEASE, "agent");
            asm volatile("s_waitcnt vmcnt(0)" ::: "memory");
            const unsigned og = xb_add(&bar[XB_TOP], 1u);
            const unsigned tg = og / nx;
            if (og + 1u == (tg + 1u) * nx) xb_add(&bar[XB_TOPGEN], 1u);
            else XB_SPIN(xb_ld(&bar[XB_TOPGEN]) == tg, bar);
            __builtin_amdgcn_fence(__ATOMIC_ACQUIRE, "agent");
            xb_add(&bar[XB_XGEN(b.x)], 1u);
            asm volatile("s_waitcnt vmcnt(0)" ::: "memory");
        } else {
            XB_SPIN(xb_ld(&bar[XB_XGEN(b.x)]) == gen, bar);
            __builtin_amdgcn_fence(__ATOMIC_ACQUIRE, "agent");
            asm volatile("s_waitcnt vmcnt(0)" ::: "memory");
        }
    }
    __syncthreads();
}

__global__ void __launch_bounds__(512, 2) fwd_kernel(Params p, int ph_lo, int ph_hi) {
    extern __shared__ __attribute__((aligned(16))) unsigned char lds_raw[];
    LAS unsigned char* lds = (LAS unsigned char*)lds_raw;
    cg::grid_group grid = cg::this_grid();
    if (ph_lo < 0) grid.sync();
    volatile LAS unsigned* bst = (volatile LAS unsigned*)(lds + LDS_PHASE_BYTES);
    if (threadIdx.x < 2) bst[threadIdx.x] = 0u;
    __syncthreads();
    XcdBarrier xbar; xbar.bar = (unsigned*)(p.ws + WS_CTL + CTL_BAR); xbar.x = 0; xbar.st = bst;
    if (ph_hi - ph_lo > 1) xbar = xcd_barrier_post((unsigned*)(p.ws + WS_CTL + CTL_BAR), bst);
    const int tid = threadIdx.x, lane = tid & 63, wid = tid >> 6, G = gridDim.x, bx = blockIdx.x;
    unsigned char* ws = p.ws;
    bf16_t* XN = (bf16_t*)(ws + WS_XN); bf16_t* XN2 = (bf16_t*)(ws + WS_XN2); bf16_t* HB = (bf16_t*)(ws + WS_H);
    float* SS1 = (float*)(ws + WS_SSP1); float* SS2 = (float*)(ws + WS_SSP2);
    float* Y = p.out; bf16_t* X3b = (bf16_t*)(ws + WS_GM);
#ifndef PHMASK
#define PHMASK 0x7ff
#endif
#define IN(k) (((PHMASK >> (k)) & 1) && ph_lo <= (k) && (k) < ph_hi)
#define SEAM(k) do { if (IN(k) && IN((k) + 1)) { xcd_barrier(xbar); }     } while (0)

    if (IN(0)) p0_prologue(p, lds, bx, G);
    SEAM(0);
    if (IN(1)) {
        if (bx < 176) sk_ffn_in<false>(XN, (const bf16_t*)(ws + WS_W1IN), HB, bx, wid, lane & 15, lane >> 4, lds);
        pg8::Gemm g{XN, (const bf16_t*)(ws + WS_W1IN), MPR, 2 * DFF, DM, DM}; pg8::StaticOrder S; S.init(MPR, 2 * DFF, G, bx);
        EpiSwiglu E{HB, nullptr}; pg8::gemm_phase<EpiSwiglu, pg8::StaticOrder, GEMM_ALIGN, GEMM_SP2>(lds, g, S, E);
    }
    SEAM(1);
    if (IN(2)) {
        if (bx < 64) sk_ffn_out<false>(HB, (const bf16_t*)(ws + WS_W1OUT), p.in[1], nullptr, XN + (size_t)MPR * DM, bx, wid, lane & 15, lane >> 4, lds);
        pg8::Gemm g{HB, (const bf16_t*)(ws + WS_W1OUT), MPR, DM, DFF, DFF}; pg8::StaticOrder S; S.init(MPR, DM, G, bx);
        EpiResid<false, false, true, true, true> E{p.in[0], p.in[1], nullptr, XN, SS1}; pg8::gemm_phase<EpiResid<false, false, true, true, true>, pg8::StaticOrder, GEMM_ALIGN, GEMM_SP2>(lds, g, S, E);
    }
    SEAM(2);
    if (IN(3)) {
        if (bx < 89) sk_inproj(XN, (const bf16_t*)(ws + WS_WINMIX), HB, (float*)(ws + WS_GBA), bx, wid, lane & 15, lane >> 4, lds);
        pg8::Gemm g{XN, (const bf16_t*)(ws + WS_WINMIX), MPR, NINP, DM, DM}; pg8::StaticOrder S; S.init(MPR, NINP, G, bx);
        EpiInproj E{HB, (float*)(ws + WS_GBA), SS1}; pg8::gemm_phase<EpiInproj, pg8::StaticOrder, GEMM_ALIGN, GEMM_SP2>(lds, g, S, E);
    }
    SEAM(3);
    if (IN(4)) {
        for (int u = bx; u < 2048; u += G) gdn_prep_unit(p, lds, u);
    }
    SEAM(4);
    if (IN(5)) {
        if (bx < NSCAN) gdn_scan(p, lds, bx);
        else {
            const int ab = bx - NSCAN, NAB = G - NSCAN;
            if (NAB == 192) {
                if (ab < 128) { sattn_unit(p, ab, wid, lane); sgdn_unit(p, lds, ab); attn_unit(p, lds, 2 * ab); attn_unit(p, lds, 2 * ab + 1); }
                else { for (int k = 0; k < 4; ++k) attn_unit(p, lds, 256 + (ab - 128) * 4 + k); }
            } else {
                int it = ab;
#pragma unroll 1
                for (; it < 512; it += NAB) attn_unit(p, lds, it);
#pragma unroll 1
                for (; it < 640; it += NAB) { sattn_unit(p, it - 512, wid, lane); sgdn_unit(p, lds, it - 512); }
            }
            const bf16_t* PB = HB;
            for (int idx = ab * 512 + tid; idx < 149504; idx += NAB * 512) {
                if (idx < 131072) { const int w = idx >> 16, r = idx & 65535, b = r >> 14, j = (r >> 7) & 127, c = r & 127;
                    p.out[(w ? O_VP : O_KP) + r] = bf2f(PB[(size_t)(b * SEQ + SEQ - 128 + j) * PW + 512 + w * 128 + c]);
                } else { const int r = idx - 131072, b = r / (3 * CONVC), q = r % (3 * CONVC), rr = q / CONVC, c = q % CONVC;
                    p.out[O_CP + r] = bf2f(PB[(size_t)(b * SEQ + SEQ - 3 + rr) * PW + 768 + c]); }
            }
            __syncthreads();
            late_weight_items(p, lds, ab * 8 + wid, NAB * 8);
        }
    }
    SEAM(5);
    if (IN(6)) {
        for (int u = bx * 8 + wid; u < 2048; u += G * 8) gdn_gate_unit(p, u, lane);
    }
    SEAM(6);
#ifdef DBG_DUMP
    if (ph_lo == 11) {
        const float* src = (const float*)(ws + DBG_SRC);
        for (size_t i = (size_t)bx * 512 + tid; i < (size_t)MREAL * DM; i += (size_t)G * 512) Y[i] = (i < (size_t)MREAL * 8) ? ((const float*)(ws + WS_GBA))[i] : 0.f;
    }
#endif
    if (IN(7)) {
        if (bx < 32) sk_outproj(HB, (const bf16_t*)(ws + WS_WOUTMIX), XN, nullptr, XN2, bx, wid, lane & 15, lane >> 4, lds);
        pg8::Gemm g{HB, (const bf16_t*)(ws + WS_WOUTMIX), MPR, DM, DM, PW}; pg8::StaticOrder S; S.init(MPR, DM, G, bx);
        EpiResid<true, false, true, true, false> E{XN, XN + (size_t)MPR * DM, nullptr, XN2, SS2}; pg8::gemm_phase<EpiResid<true, false, true, true, false>, pg8::StaticOrder, GEMM_ALIGN, GEMM_SP2>(lds, g, S, E);
    }
    SEAM(7);
    if (IN(8)) {
        if (bx < 176) sk_ffn_in<true>(XN2, (const bf16_t*)(ws + WS_W2IN), HB, bx, wid, lane & 15, lane >> 4, lds);
        pg8::Gemm g{XN2, (const bf16_t*)(ws + WS_W2IN), MPR, 2 * DFF, DM, DM}; pg8::StaticOrder S; S.init(MPR, 2 * DFF, G, bx);
        EpiSwiglu E{HB, SS2}; pg8::gemm_phase<EpiSwiglu, pg8::StaticOrder, GEMM_ALIGN, GEMM_SP2>(lds, g, S, E);
    }
    SEAM(8);
    if (IN(9)) {
        if (bx < 64) sk_ffn_out<true>(HB, (const bf16_t*)(ws + WS_W2OUT), (const float*)(XN2 + (size_t)MPR * DM), nullptr, X3b + (size_t)MPR * DM, bx, wid, lane & 15, lane >> 4, lds);
        pg8::Gemm g{HB, (const bf16_t*)(ws + WS_W2OUT), MPR, DM, DFF, DFF}; pg8::StaticOrder S; S.init(MPR, DM, G, bx);
        EpiResid<true, false, true, false, true> E{XN2, XN2 + (size_t)MPR * DM, nullptr, X3b, nullptr}; pg8::gemm_phase<EpiResid<true, false, true, false, true>, pg8::StaticOrder, GEMM_ALIGN, GEMM_SP2>(lds, g, S, E);
    }
    SEAM(9);
    if (IN(10)) {
        const float* gf = p.in[20]; f32x4 gv[4];
#pragma unroll
        for (int j = 0; j < 4; ++j) gv[j] = *((const f32x4*)gf + lane + 64 * j);
        {
            f32x4 v[4], vn[4]; int m = bx * 8 + wid;
            if (m < MREAL) { const u32x2* xr = (const u32x2*)(X3b + (size_t)m * DM) + lane;
#pragma unroll
                for (int j = 0; j < 4; ++j) { const u32x2 w = xr[64 * j]; v[j] = (f32x4){bflo(w.x), bfhi(w.x), bflo(w.y), bfhi(w.y)}; } }
            for (; m < MREAL; m += G * 8) {
                const int mn = m + G * 8;
                if (mn < MREAL) { const u32x2* xr = (const u32x2*)(X3b + (size_t)mn * DM) + lane;
#pragma unroll
                    for (int j = 0; j < 4; ++j) { const u32x2 w = xr[64 * j]; vn[j] = (f32x4){bflo(w.x), bfhi(w.x), bflo(w.y), bfhi(w.y)}; } }
                float s = 0.f;
#pragma unroll
                for (int j = 0; j < 4; ++j) s += (v[j][0] * v[j][0] + v[j][1] * v[j][1]) + (v[j][2] * v[j][2] + v[j][3] * v[j][3]);
                const float rstd = rsqrtf(wave_sum(s) * (1.0f / DM) + EPS);
                f32x4* yr = (f32x4*)(Y + (size_t)m * DM) + lane;
#pragma unroll
                for (int j = 0; j < 4; ++j) yr[64 * j] = v[j] * rstd * gv[j];
#pragma unroll
                for (int j = 0; j < 4; ++j) v[j] = vn[j];
            }
        }
    }
#undef IN
#undef SEAM
}
}

#ifndef MK_N_LAUNCHES
#define MK_N_LAUNCHES 1
#endif
extern "C" void kernel_launch(void* const* d_in, const int* in_sizes, int n_in, void* d_out, int out_size, void* d_ws, size_t ws_size, hipStream_t stream) {
    static int grid = 0;
    if (grid == 0) {
        if (n_in != 21 || ws_size < mk::WS_END || out_size != 47269888) { fprintf(stderr, "kernel_launch: unexpected shapes (n_in %d, ws %zu, out %d)\n", n_in, ws_size, out_size); grid = -1; return; }
        int dev = 0, cus = 0, per_cu = 0;
        (void)hipGetDevice(&dev); (void)hipDeviceGetAttribute(&cus, hipDeviceAttributeMultiprocessorCount, dev);
        if (hipFuncSetAttribute((const void*)mk::fwd_kernel, hipFuncAttributeMaxDynamicSharedMemorySize, mk::LDS_BYTES) != hipSuccess) { fprintf(stderr, "kernel_launch: hipFuncSetAttribute failed\n"); grid = -1; return; }
        if (hipOccupancyMaxActiveBlocksPerMultiprocessor(&per_cu, (const void*)mk::fwd_kernel, 512, mk::LDS_BYTES) != hipSuccess || per_cu < 1) { fprintf(stderr, "kernel_launch: occupancy query failed (%d)\n", per_cu); per_cu = 1; }
        (void)hipGetLastError();
        grid = cus * per_cu;
        if (grid <= mk::NSCAN) { fprintf(stderr, "kernel_launch: grid %d too small\n", grid); grid = -1; return; }
    }
    if (grid < 0) return;
    (void)hipMemsetAsync((char*)d_ws + mk::WS_CTL + mk::CTL_BAR, 0, mk::CTL_BAR_BYTES, stream);
    mk::Params p{};
    for (int i = 0; i < 21; ++i) p.in[i] = (const float*)d_in[i];
    p.out = (float*)d_out; p.ws = (unsigned char*)d_ws;
#if MK_N_LAUNCHES == 1
    int lo = 0, hi = 11; void* args[] = {&p, &lo, &hi};
    hipError_t e = hipLaunchCooperativeKernel((const void*)mk::fwd_kernel, dim3(grid), dim3(512), args, mk::LDS_BYTES, stream);
    if (e != hipSuccess) fprintf(stderr, "kernel_launch: cooperative launch failed: %s (grid %d)\n", hipGetErrorString(e), grid);
#else
#ifndef MK_LAST
#define MK_LAST 11
#ifndef MK_DOUBLE
#define MK_DOUBLE 0x0
#endif
#define DBG_C0 512
#define DBG_C1 1024
#endif
    for (int ph = 0; ph < MK_LAST; ++ph) { const int reps = ((MK_DOUBLE >> ph) & 1) ? 2 : 1; for (int r = 0; r < reps; ++r) hipLaunchKernelGGL(mk::fwd_kernel, dim3(grid), dim3(512), mk::LDS_BYTES, stream, p, ph, ph + 1); }
#ifdef DBG_DUMP
    hipLaunchKernelGGL(mk::fwd_kernel, dim3(grid), dim3(512), mk::LDS_BYTES, stream, p, 11, 12);
#endif
#endif
}
```

```cpp
#include <hip/hip_runtime.h>
#include <hip/hip_cooperative_groups.h>
#include <cstdio>
namespace cg = cooperative_groups;
namespace pg8 {
#define PG8_LAS __attribute__((address_space(3)))
typedef unsigned short bf16_t;
typedef short bf16x8 __attribute__((ext_vector_type(8)));
typedef float f32x4 __attribute__((ext_vector_type(4)));
typedef unsigned u32x4 __attribute__((ext_vector_type(4)));
constexpr int BM = 256, BK = 64, HALF = 128, HTB = HALF * BK * 2  , STAGE_BYTES = 8 * HTB, NXCD = 8, WGM = 4;

__host__ __device__ __forceinline__ int lds_byte(int r, int c) { const int st = (r >> 4) * 2 + (c >> 5), rr = r & 15, cc = c & 31, ob = rr * 64 + cc * 2; return st * 1024 + (ob ^ (((ob >> 9) & 1) << 5)); }
__host__ __device__ __forceinline__ void stage_rc(int b, int& R, int& C) { const int st = b / 1024, sb = b % 1024, swz = sb ^ (((sb >> 9) & 1) << 5); R = (st >> 1) * 16 + swz / 64; C = (st & 1) * 32 + (swz % 64) / 2; }
__host__ __device__ __forceinline__ int perm32(int rho) { const int n = rho >> 4, i = rho & 15; return 8 * (i >> 2) + 4 * n + (i & 3); }

struct Unit { int pm, pn; };
struct Gemm { const bf16_t* A; const bf16_t* Bt; int M, N, K, lda; };

struct StaticOrder {
    int nM, nN, nwg, G, c, wgm;
    __host__ __device__ void init(int M, int N, int G_, int c_, int wgm_ = WGM) { nM = M / BM; nN = N / BM; nwg = nM * nN; G = G_; c = c_; wgm = wgm_; }
    __host__ __device__ bool next(int i, Unit& u) const {
        const long L = (long)i * G + c; if (L >= nwg) return false;
        int wgid = (int)L; { const int q = nwg / NXCD, r = nwg % NXCD, xcd = wgid % NXCD, off = wgid / NXCD; wgid = (xcd < r ? xcd * (q + 1) : r * (q + 1) + (xcd - r) * q) + off; }
        const int nig = wgm * nN, gid = wgid / nig, fm = gid * wgm, gsz = (nM - fm) < wgm ? (nM - fm) : wgm;
        u.pm = fm + ((wgid % nig) % gsz); u.pn = (wgid % nig) / gsz; return true;
    }
    __device__ __forceinline__ void a_ready(const Unit&) const {}
    __device__ __forceinline__ void done(const Unit&) const {}
};

__device__ __forceinline__ unsigned cvt_pk_bf16(float lo, float hi) { unsigned r; asm volatile("v_cvt_pk_bf16_f32 %0, %1, %2" : "=v"(r) : "v"(lo), "v"(hi)); return r; }
typedef float f32x2 __attribute__((ext_vector_type(2)));
__device__ __forceinline__ f32x2 gelu_pk(f32x2 v) {
    const f32x2 av = __builtin_elementwise_abs(v), d = av * 0.2316418882f + 1.0f;
    f32x2 t; t.x = __builtin_amdgcn_rcpf(d.x); t.y = __builtin_amdgcn_rcpf(d.y);
    f32x2 q = t * 0.5307027145f + (-0.7265760135f); q = q * t + 0.7107068705f; q = q * t + (-0.142248368f); q = q * t + 0.127414796f; q = q * t;
    const f32x2 s = (v * v) * (-0.72134752044f);
    f32x2 e; e.x = __builtin_amdgcn_exp2f(s.x); e.y = __builtin_amdgcn_exp2f(s.y);
    const f32x2 m = v * (q * e), r = v - m;
    f32x2 o; o.x = v.x < 0.f ? m.x : r.x; o.y = v.y < 0.f ? m.y : r.y; return o;
}

template <int ACT  > struct EpiBf16 {
    static constexpr bool PERM = true, AFTER_DRAIN = false; static_assert(ACT == 0 || ACT == 1, "EpiBf16: ACT is 0 (none) or 1 (gelu_pk)");
    bf16_t* O; int ldc; const float* bias; int split_cols; size_t split_stride; float scale0;
    __device__ __forceinline__ void operator()(const f32x4 (&acc)[2][2][4][2], const Unit& u, int wr, int wc, int fr, int fq) const {
        const int row0 = u.pm * BM + wr * 64 + fr; int colt = u.pn * BM; bf16_t* base = O;
        float sc = 1.f; if (split_cols) { const int t = colt / split_cols; base += (size_t)t * split_stride; colt -= t * split_cols; if (t == 0) sc = scale0; }
        const int col0 = colt + wc * 32 + 8 * fq, bcol0 = u.pn * BM + wc * 32 + 8 * fq;
        f32x4 bv[2][2];
#pragma unroll
        for (int bj = 0; bj < 2; ++bj)
#pragma unroll
            for (int n = 0; n < 2; ++n) bv[bj][n] = bias ? *(const f32x4*)(bias + bcol0 + bj * HALF + 4 * n) : (f32x4){0.f, 0.f, 0.f, 0.f};
#pragma unroll
        for (int ai = 0; ai < 2; ++ai)
#pragma unroll
            for (int m = 0; m < 4; ++m) { bf16_t* rowp = base + (size_t)(row0 + ai * HALF + m * 16) * ldc + col0;
#pragma unroll
                for (int bj = 0; bj < 2; ++bj) { f32x4 v0 = acc[ai][bj][m][0] + bv[bj][0], v1 = acc[ai][bj][m][1] + bv[bj][1];
                    if (ACT == 1) { f32x2 a = gelu_pk((f32x2){v0[0], v0[1]}), b = gelu_pk((f32x2){v0[2], v0[3]}), c = gelu_pk((f32x2){v1[0], v1[1]}), d = gelu_pk((f32x2){v1[2], v1[3]});
                        v0 = (f32x4){a.x, a.y, b.x, b.y}; v1 = (f32x4){c.x, c.y, d.x, d.y}; }
                    v0 = v0 * sc; v1 = v1 * sc; u32x4 w; w.x = cvt_pk_bf16(v0[0], v0[1]); w.y = cvt_pk_bf16(v0[2], v0[3]); w.z = cvt_pk_bf16(v1[0], v1[1]); w.w = cvt_pk_bf16(v1[2], v1[3]);
                    *(u32x4*)(rowp + bj * HALF) = w; } }
    }
};

struct PanelStats {
    unsigned* xbuf;
    unsigned* cnt;
    unsigned* tmo;
    int ntn; float eps;
    unsigned code;
    __device__ __forceinline__ bool run(const f32x4 (&v)[2][2][4][2], const Unit& u, int wr, int wc, int fr, int fq, PG8_LAS unsigned char* lds, int wid, int lane) const {
        typedef float f32x2v __attribute__((ext_vector_type(2)));
        PG8_LAS f32x2v* P = (PG8_LAS f32x2v*)lds;
        PG8_LAS f32x2v* S = (PG8_LAS f32x2v*)(lds + 8192);
        PG8_LAS unsigned* flag = (PG8_LAS unsigned*)(lds + 8192 + 2048);
#pragma unroll
        for (int ai = 0; ai < 2; ++ai)
#pragma unroll
            for (int m = 0; m < 4; ++m) {
                float s = 0.f;
#pragma unroll
                for (int bj = 0; bj < 2; ++bj)
#pragma unroll
                    for (int n = 0; n < 2; ++n) { const f32x4 x = v[ai][bj][m][n]; s += (x[0] + x[1]) + (x[2] + x[3]); }
                s += __shfl_xor(s, 16); s += __shfl_xor(s, 32);
                const float mw = s * (1.0f / 64.0f); float q = 0.f;
#pragma unroll
                for (int bj = 0; bj < 2; ++bj)
#pragma unroll
                    for (int n = 0; n < 2; ++n) { const f32x4 d = v[ai][bj][m][n] - mw; q += (d[0] * d[0] + d[1] * d[1]) + (d[2] * d[2] + d[3] * d[3]); }
                q += __shfl_xor(q, 16); q += __shfl_xor(q, 32);
                if (fq == 0) P[(ai * HALF + wr * 64 + m * 16 + fr) * 4 + wc] = (f32x2v){mw, q};
            }
        asm volatile("s_waitcnt lgkmcnt(0)" ::: "memory"); __builtin_amdgcn_s_barrier(); asm volatile("" ::: "memory");
#if defined(BROKEN_EXCHANGE_NO_WAIT)
#warning BROKEN CONTROL BUILD: the row-statistics exchange does not wait; results are wrong by design
        if (blockIdx.x >= 64) { const long long t0_ = clock64(); while (clock64() - t0_ < 60000) __builtin_amdgcn_s_sleep(8); }
#endif
        const int row = wid * 32 + (lane & 31);
        if (lane < 32) {
            const f32x2v a = P[row * 4 + 0], b = P[row * 4 + 1], c = P[row * 4 + 2], d = P[row * 4 + 3];
            const float mt = (a.x + b.x + c.x + d.x) * 0.25f;
            const float da = a.x - mt, db = b.x - mt, dc = c.x - mt, dd = d.x - mt;
            const float m2 = (a.y + b.y) + (c.y + d.y) + 64.0f * ((da * da + db * db) + (dc * dc + dd * dd));
            unsigned long long* slot = (unsigned long long*)xbuf + ((size_t)(u.pm * BM + row) * 4 + u.pn);
            __hip_atomic_store(slot, ((unsigned long long)__float_as_uint(m2) << 32) | __float_as_uint(mt), __ATOMIC_RELAXED, __HIP_MEMORY_SCOPE_AGENT);
        }
        asm volatile("s_waitcnt vmcnt(0)" ::: "memory");
        if (lane == 0) __hip_atomic_fetch_add(cnt + 64 * u.pm, 1u, __ATOMIC_RELAXED, __HIP_MEMORY_SCOPE_AGENT);
        if (wid == 0) {
            bool dead = false; const unsigned long long t0 = __builtin_amdgcn_s_memrealtime(); const unsigned want = 8u * (unsigned)ntn;
            for (;;) {
#if defined(BROKEN_EXCHANGE_NO_WAIT)
                break;
#endif
                if ((unsigned)__builtin_amdgcn_readfirstlane(__hip_atomic_load(cnt + 64 * u.pm, __ATOMIC_RELAXED, __HIP_MEMORY_SCOPE_AGENT)) >= want) break;
                if (__builtin_amdgcn_s_memrealtime() - t0 > 2000000ull) {
                    if (lane == 0) { unsigned expect = 0u; __hip_atomic_compare_exchange_strong(tmo + 1, &expect, code | (unsigned)(u.pm & 0xff), __ATOMIC_RELAXED, __ATOMIC_RELAXED, __HIP_MEMORY_SCOPE_AGENT);
                                     __hip_atomic_store(tmo, 1u, __ATOMIC_RELAXED, __HIP_MEMORY_SCOPE_AGENT); }
                    dead = true; break; }
                __builtin_amdgcn_s_sleep(2);
            }
            __builtin_amdgcn_fence(__ATOMIC_ACQUIRE, "agent");
            if (lane == 0) flag[0] = dead ? 1u : 0u;
        }
        asm volatile("s_waitcnt vmcnt(0) lgkmcnt(0)" ::: "memory"); __builtin_amdgcn_s_barrier(); asm volatile("" ::: "memory");
        const bool bad = flag[0] != 0u;
        if (lane < 32) {
            const unsigned long long* slot = (const unsigned long long*)xbuf + (size_t)(u.pm * BM + row) * 4; float mt[4], m2[4]; float ms = 0.f;
#pragma unroll
            for (int t = 0; t < 4; ++t) { if (t < ntn) { const unsigned long long w = __hip_atomic_load(slot + t, __ATOMIC_RELAXED, __HIP_MEMORY_SCOPE_AGENT); mt[t] = __uint_as_float((unsigned)w); m2[t] = __uint_as_float((unsigned)(w >> 32)); } else { mt[t] = 0.f; m2[t] = 0.f; } ms += mt[t]; }
            const float mean = ms / (float)ntn; float q = 0.f;
#pragma unroll
            for (int t = 0; t < 4; ++t) if (t < ntn) { const float dm = mt[t] - mean; q += m2[t] + 256.0f * dm * dm; }
            S[row] = (f32x2v){mean, 1.0f / sqrtf(q / (256.0f * (float)ntn) + eps)};
        }
        asm volatile("s_waitcnt lgkmcnt(0)" ::: "memory"); __builtin_amdgcn_s_barrier(); asm volatile("" ::: "memory");
        return bad;
    }
};
struct EpiLnRes {
    static constexpr bool PERM = false, AFTER_DRAIN = true;
    const float* base; float* out; int ldc; const float* bias; PanelStats st; unsigned poison;
    __device__ __forceinline__ void fused(f32x4 (&acc)[2][2][4][2], const Unit& u, int wr, int wc, int fr, int fq, PG8_LAS unsigned char* lds, int wid, int lane) const {
        typedef float f32x2v __attribute__((ext_vector_type(2)));
        const PG8_LAS f32x2v* S = (const PG8_LAS f32x2v*)(lds + 8192);
        const int col0 = u.pn * BM + wc * 32 + 4 * fq;
#pragma unroll
        for (int bj = 0; bj < 2; ++bj)
#pragma unroll
            for (int n = 0; n < 2; ++n) { const f32x4 bv = bias ? *(const f32x4*)(bias + col0 + bj * HALF + n * 16) : (f32x4){0.f, 0.f, 0.f, 0.f};
#pragma unroll
                for (int ai = 0; ai < 2; ++ai)
#pragma unroll
                    for (int m = 0; m < 4; ++m) acc[ai][bj][m][n] += bv; }
        f32x4 pre[4][2][2];
#pragma unroll
        for (int m = 0; m < 4; ++m) { const size_t off = (size_t)(u.pm * BM + wr * 64 + m * 16 + fr) * ldc + col0;
#pragma unroll
            for (int bj = 0; bj < 2; ++bj)
#pragma unroll
                for (int n = 0; n < 2; ++n) pre[m][bj][n] = *(const f32x4*)(base + off + bj * HALF + n * 16); }
        const bool bad = st.run(acc, u, wr, wc, fr, fq, lds, wid, lane) || poison != 0u;
        const float qnan = __builtin_nanf("");
#pragma unroll
        for (int ai = 0; ai < 2; ++ai)
#pragma unroll
            for (int m = 0; m < 4; ++m) { const int r = ai * HALF + wr * 64 + m * 16 + fr; const f32x2v sr = S[r]; const size_t off = (size_t)(u.pm * BM + r) * ldc + col0;
#pragma unroll
                for (int bj = 0; bj < 2; ++bj)
#pragma unroll
                    for (int n = 0; n < 2; ++n) { const f32x4 bs = ai == 0 ? pre[m][bj][n] : *(const f32x4*)(base + off + bj * HALF + n * 16); f32x4 o = bs + (acc[ai][bj][m][n] - sr.x) * sr.y;
                        if (bad) o = (f32x4){qnan, qnan, qnan, qnan}; *(f32x4*)(out + off + bj * HALF + n * 16) = o; }
                if (m & 1) asm volatile("" ::: "memory"); }
    }
};
struct EpiLnResLn {
    static constexpr bool PERM = false, AFTER_DRAIN = true;
    const float* base; float* out; bf16_t* xn; int ldc; const float* bias; PanelStats st1, st2; unsigned poison;
    __device__ __forceinline__ void fused(f32x4 (&acc)[2][2][4][2], const Unit& u, int wr, int wc, int fr, int fq, PG8_LAS unsigned char* lds, int wid, int lane) const {
        typedef float f32x2v __attribute__((ext_vector_type(2))); typedef unsigned u32x2v __attribute__((ext_vector_type(2)));
        const PG8_LAS f32x2v* S = (const PG8_LAS f32x2v*)(lds + 8192);
        const int col0 = u.pn * BM + wc * 32 + 4 * fq;
#pragma unroll
        for (int bj = 0; bj < 2; ++bj)
#pragma unroll
            for (int n = 0; n < 2; ++n) { const f32x4 bv = bias ? *(const f32x4*)(bias + col0 + bj * HALF + n * 16) : (f32x4){0.f, 0.f, 0.f, 0.f};
#pragma unroll
                for (int ai = 0; ai < 2; ++ai)
#pragma unroll
                    for (int m = 0; m < 4; ++m) acc[ai][bj][m][n] += bv; }
        bool bad = st1.run(acc, u, wr, wc, fr, fq, lds, wid, lane) || poison != 0u;
        const float qnan = __builtin_nanf("");
#pragma unroll
        for (int ai = 0; ai < 2; ++ai)
#pragma unroll
            for (int m = 0; m < 4; ++m) { const int r = ai * HALF + wr * 64 + m * 16 + fr; const f32x2v sr = S[r]; const size_t off = (size_t)(u.pm * BM + r) * ldc + col0;
#pragma unroll
                for (int bj = 0; bj < 2; ++bj)
#pragma unroll
                    for (int n = 0; n < 2; ++n) { const f32x4 bs = *(const f32x4*)(base + off + bj * HALF + n * 16); acc[ai][bj][m][n] = bs + (acc[ai][bj][m][n] - sr.x) * sr.y; }
                asm volatile("" : "+v"(acc[ai][0][m][0]), "+v"(acc[ai][0][m][1]), "+v"(acc[ai][1][m][0]), "+v"(acc[ai][1][m][1]));
                if (m & 1) asm volatile("" ::: "memory"); }
        const bool bad1 = bad;
        bad = st2.run(acc, u, wr, wc, fr, fq, lds, wid, lane) || bad;
#pragma unroll
        for (int ai = 0; ai < 2; ++ai)
#pragma unroll
            for (int m = 0; m < 4; ++m) { const int r = ai * HALF + wr * 64 + m * 16 + fr; const f32x2v sr = S[r]; const size_t off = (size_t)(u.pm * BM + r) * ldc + col0;
#pragma unroll
                for (int bj = 0; bj < 2; ++bj)
#pragma unroll
                    for (int n = 0; n < 2; ++n) { const f32x4 x1 = acc[ai][bj][m][n]; *(f32x4*)(out + off + bj * HALF + n * 16) = bad1 ? (f32x4){qnan, qnan, qnan, qnan} : x1;
                        const f32x4 o = (x1 - sr.x) * sr.y; u32x2v w; w.x = cvt_pk_bf16(o[0], o[1]); w.y = cvt_pk_bf16(o[2], o[3]);
                        if (bad) { w.x = 0x7fc07fc0u; w.y = 0x7fc07fc0u; } *(u32x2v*)(xn + off + bj * HALF + n * 16) = w; }
                asm volatile("" ::: "memory"); }
    }
};

template <class Epi, class Sched, bool ALIGN_EPI = false, bool SP2 = false>
__device__ __forceinline__ void gemm_phase(PG8_LAS unsigned char* lds, const Gemm g, const Sched S, const Epi E) {
    const int tid = threadIdx.x, wid = __builtin_amdgcn_readfirstlane(tid >> 6), lane = tid & 63, wr = wid >> 2, wc = wid & 3, fr = lane & 15, fq = lane >> 4;
    const int K = g.K, nt = K / BK;
    unsigned voffA[2], voffB[2];
#pragma unroll
    for (int i = 0; i < 2; ++i) { int R, C; stage_rc(tid * 16 + i * 8192, R, C); const int Rb = Epi::PERM ? ((R & ~31) + perm32(R & 31)) : R;
        voffA[i] = (unsigned)(R * g.lda + C) * 2u; voffB[i] = (unsigned)(Rb * K + C) * 2u; }
    const size_t kstep = (size_t)(BK * 2);
    const size_t hstep = (size_t)HALF * K * 2;
    const size_t tstep = 2 * hstep;
    const size_t hstepA = (size_t)HALF * g.lda * 2, tstepA = 2 * hstepA;
    const unsigned ldsw = (unsigned)wid * 1024u;
    const int aoff = lds_byte(wr * 64 + fr, fq * 8), boff = lds_byte(wc * 32 + fr, fq * 8);
#define PG8_SA(b, h) (((b) * 2 + (h)) * HTB)
#define PG8_SB(b, h) ((4 + (b) * 2 + (h)) * HTB)
#define PG8_STAGE(bufoff, gbase, voff) do { _Pragma("unroll") for (int _i = 0; _i < 2; ++_i) \
        __builtin_amdgcn_global_load_lds((const unsigned*)((const char*)(gbase) + (voff)[_i]), (PG8_LAS unsigned*)(lds + (bufoff) + ldsw + _i * 8192), 16, 0, 0); } while (0)
#define PG8_LDA(dst, b, h) do { _Pragma("unroll") for (int m = 0; m < 4; ++m) _Pragma("unroll") for (int k = 0; k < 2; ++k) dst[m][k] = *(const PG8_LAS bf16x8*)(lds + PG8_SA(b, h) + aoff + m * 2048 + k * 1024); } while (0)
#define PG8_LDB(dst, b, h) do { _Pragma("unroll") for (int n = 0; n < 2; ++n) _Pragma("unroll") for (int k = 0; k < 2; ++k) dst[n][k] = *(const PG8_LAS bf16x8*)(lds + PG8_SB(b, h) + boff + n * 2048 + k * 1024); } while (0)
#define PG8_MMA(ai, bj, At, Bt) do { __builtin_amdgcn_s_setprio(1); _Pragma("unroll") for (int m = 0; m < 4; ++m) _Pragma("unroll") for (int n = 0; n < 2; ++n) _Pragma("unroll") for (int k = 0; k < 2; ++k) \
        acc[ai][bj][m][n] = __builtin_amdgcn_mfma_f32_16x16x32_bf16(Bt[n][k], At[m][k], acc[ai][bj][m][n], 0, 0, 0); __builtin_amdgcn_s_setprio(0); } while (0)
#define PG8_WAIT_V(n) asm volatile("s_waitcnt vmcnt(" #n ")" ::: "memory")
#define PG8_WAIT_L(n) asm volatile("s_waitcnt lgkmcnt(" #n ")" ::: "memory")
#define PG8_BAR __builtin_amdgcn_s_barrier()
#define PG8_SCHED __builtin_amdgcn_sched_barrier(0)
    Unit cur, nxt; int ui = 0;
    if (!S.next(0, cur)) return;
    f32x4 acc[2][2][4][2];
#pragma unroll
    for (int a = 0; a < 2; ++a)
#pragma unroll
        for (int b = 0; b < 2; ++b)
#pragma unroll
            for (int m = 0; m < 4; ++m)
#pragma unroll
                for (int n = 0; n < 2; ++n) acc[a][b][m][n] = (f32x4){0.f, 0.f, 0.f, 0.f};
    bf16x8 At[4][2], B0[2][2], B1[2][2];
    const char* cA = (const char*)g.A + (size_t)cur.pm * tstepA; const char* cB = (const char*)g.Bt + (size_t)cur.pn * tstep;
    S.a_ready(cur);
    if constexpr (SP2) {
        PG8_STAGE(PG8_SB(0, 0), cB, voffB); PG8_STAGE(PG8_SB(0, 1), cB + hstep, voffB); PG8_STAGE(PG8_SA(0, 0), cA, voffA); PG8_STAGE(PG8_SA(0, 1), cA + hstepA, voffA);
        if (wr == 1) PG8_BAR;
        PG8_WAIT_V(2); PG8_BAR;
        PG8_STAGE(PG8_SB(1, 0), cB + kstep, voffB); PG8_STAGE(PG8_SA(1, 0), cA + kstep, voffA); PG8_STAGE(PG8_SB(1, 1), cB + hstep + kstep, voffB);
        PG8_WAIT_V(6); PG8_BAR;
    } else {
        PG8_STAGE(PG8_SB(0, 0), cB, voffB); PG8_STAGE(PG8_SA(0, 0), cA, voffA); PG8_STAGE(PG8_SB(0, 1), cB + hstep, voffB); PG8_STAGE(PG8_SA(0, 1), cA + hstepA, voffA);
        if (wr == 1) PG8_BAR;
        PG8_WAIT_V(4); PG8_BAR;
        PG8_STAGE(PG8_SB(1, 0), cB + kstep, voffB); PG8_STAGE(PG8_SA(1, 0), cA + kstep, voffA); PG8_STAGE(PG8_SB(1, 1), cB + hstep + kstep, voffB);
        PG8_WAIT_V(6); PG8_BAR;
    }
    for (;;) {
        const bool has_next = S.next(ui + 1, nxt);
        const char* nA = has_next ? (const char*)g.A + (size_t)nxt.pm * tstepA : cA; const char* nB = has_next ? (const char*)g.Bt + (size_t)nxt.pn * tstep : cB;
        for (int t = 0; t < nt; t += 2) {
            const bool last = (t == nt - 2);
            const char* a1 = cA + (size_t)(t + 1) * kstep;
            const char* a2 = last ? nA : cA + (size_t)(t + 2) * kstep; const char* b2 = last ? nB : cB + (size_t)(t + 2) * kstep;
            const char* a3 = a2 + kstep; const char* b3 = b2 + kstep;
            if (last && has_next) S.a_ready(nxt);
            if constexpr (SP2) {
            PG8_LDB(B0, 0, 0); PG8_LDB(B1, 0, 1); PG8_SCHED; PG8_LDA(At, 0, 0); PG8_STAGE(PG8_SA(1, 1), a1 + hstepA, voffA);
            PG8_WAIT_V(8); PG8_WAIT_L(0); PG8_BAR; PG8_MMA(0, 0, At, B0); PG8_MMA(0, 1, At, B1); PG8_BAR; PG8_SCHED;
            PG8_LDA(At, 0, 1); PG8_STAGE(PG8_SB(0, 0), b2, voffB); PG8_STAGE(PG8_SB(0, 1), b2 + hstep, voffB); PG8_STAGE(PG8_SA(0, 0), a2, voffA);
            PG8_WAIT_V(8); PG8_WAIT_L(0); PG8_BAR; PG8_MMA(1, 0, At, B0); PG8_MMA(1, 1, At, B1); PG8_BAR; PG8_SCHED;
            PG8_LDB(B0, 1, 0); PG8_LDB(B1, 1, 1); PG8_SCHED; PG8_LDA(At, 1, 0); PG8_STAGE(PG8_SA(0, 1), a2 + hstepA, voffA);
            PG8_WAIT_V(8); PG8_WAIT_L(0); PG8_BAR; PG8_MMA(0, 0, At, B0); PG8_MMA(0, 1, At, B1); PG8_BAR; PG8_SCHED;
            PG8_LDA(At, 1, 1); PG8_STAGE(PG8_SB(1, 0), b3, voffB); PG8_STAGE(PG8_SB(1, 1), b3 + hstep, voffB); PG8_STAGE(PG8_SA(1, 0), a3, voffA);
            PG8_WAIT_V(8); PG8_WAIT_L(0); PG8_BAR; PG8_MMA(1, 0, At, B0); PG8_MMA(1, 1, At, B1); PG8_BAR; PG8_SCHED;
            } else {
            PG8_LDB(B0, 0, 0); PG8_SCHED; PG8_LDA(At, 0, 0); PG8_STAGE(PG8_SA(1, 1), a1 + hstepA, voffA);
            PG8_WAIT_L(8); PG8_BAR; PG8_WAIT_L(0); PG8_MMA(0, 0, At, B0); PG8_BAR; PG8_SCHED;
            PG8_LDB(B1, 0, 1); PG8_STAGE(PG8_SB(0, 0), b2, voffB);
            PG8_BAR; PG8_WAIT_L(0); PG8_MMA(0, 1, At, B1); PG8_BAR;
            PG8_LDA(At, 0, 1); PG8_STAGE(PG8_SA(0, 0), a2, voffA);
            PG8_BAR; PG8_WAIT_L(0); PG8_MMA(1, 0, At, B0); PG8_BAR; PG8_SCHED;
            PG8_STAGE(PG8_SB(0, 1), b2 + hstep, voffB);
            PG8_WAIT_V(6); PG8_BAR; PG8_MMA(1, 1, At, B1); PG8_BAR;
            PG8_LDB(B0, 1, 0); PG8_SCHED; PG8_LDA(At, 1, 0); PG8_STAGE(PG8_SA(0, 1), a2 + hstepA, voffA);
            PG8_WAIT_L(8); PG8_BAR; PG8_WAIT_L(0); PG8_MMA(0, 0, At, B0); PG8_BAR; PG8_SCHED;
            PG8_LDB(B1, 1, 1); PG8_STAGE(PG8_SB(1, 0), b3, voffB);
            PG8_BAR; PG8_WAIT_L(0); PG8_MMA(0, 1, At, B1); PG8_BAR;
            PG8_LDA(At, 1, 1); PG8_STAGE(PG8_SA(1, 0), a3, voffA);
            PG8_BAR; PG8_WAIT_L(0); PG8_MMA(1, 0, At, B0); PG8_BAR; PG8_SCHED;
            PG8_STAGE(PG8_SB(1, 1), b3 + hstep, voffB);
            PG8_WAIT_V(6); PG8_BAR; PG8_MMA(1, 1, At, B1); PG8_BAR;
            }
        }
        if constexpr (ALIGN_EPI) { if (wr == 0) PG8_BAR; }
        if constexpr (!Epi::AFTER_DRAIN) { E(acc, cur, wr, wc, fr, fq); S.done(cur); }
        if (!has_next) break;
#pragma unroll
        for (int a = 0; a < 2; ++a)
#pragma unroll
            for (int b = 0; b < 2; ++b)
#pragma unroll
                for (int m = 0; m < 4; ++m)
#pragma unroll
                    for (int n = 0; n < 2; ++n) acc[a][b][m][n] = (f32x4){0.f, 0.f, 0.f, 0.f};
        cur = nxt; cA = nA; cB = nB; ++ui;
        if constexpr (ALIGN_EPI) { if (wr == 1) PG8_BAR; }
    }
    PG8_WAIT_V(0);
    if constexpr (!ALIGN_EPI) { if (wr == 0) PG8_BAR; }
    PG8_BAR;
    if constexpr (Epi::AFTER_DRAIN) { E.fused(acc, cur, wr, wc, fr, fq, lds, wid, lane); S.done(cur); }
#undef PG8_SA
#undef PG8_SB
#undef PG8_STAGE
#undef PG8_LDA
#undef PG8_LDB
#undef PG8_MMA
#undef PG8_WAIT_V
#undef PG8_WAIT_L
#undef PG8_BAR
#undef PG8_SCHED
}
}

#ifndef GEMM_SP2
#define GEMM_SP2 true
#endif
#ifndef GEMM_ALIGN
#define GEMM_ALIGN true
#endif
namespace mk {
#define LAS __attribute__((address_space(3)))
using pg8::bf16_t; using pg8::bf16x8; using pg8::f32x4; using pg8::u32x4;
typedef unsigned u32x2 __attribute__((ext_vector_type(2)));

constexpr int DM = 1024, SEQ = 8192, NBATCH = 4, MPR = NBATCH * SEQ, MSAMP = 128, MREAL = MPR + MSAMP, MPAD = 33024;
constexpr int DFF = 2816, PW = 2816, NINP = 3072, CONVC = 1536;
constexpr float EPS = 1e-6f;
#ifndef SCAN_CW
#define SCAN_CW 2
#endif
constexpr int CW = SCAN_CW, NSCAN = 128 / CW;
constexpr int LDS_PHASE_BYTES = 155648, LDS_BYTES = LDS_PHASE_BYTES + 256;

constexpr size_t O_YP = 0, O_YS = 33554432, O_KP = 33685504, O_VP = 33751040, O_CP = 33816576, O_GP = 33835008,
                 O_KS = 34097152, O_VS = 36194304, O_CS = 38291456, O_GS = 38881280;
constexpr size_t MiB = 1u << 20;
constexpr size_t WS_CTL = 0, CTL_ZERO_BYTES = 1 * MiB;
constexpr size_t WS_W1IN = 1 * MiB, WS_W1OUT = 12 * MiB, WS_WINMIX = 18 * MiB, WS_WOUTMIX = 24 * MiB, WS_W2IN = 26 * MiB, WS_W2OUT = 37 * MiB;
constexpr size_t WS_GBA = 43 * MiB, WS_XN = 45 * MiB, WS_XN2 = 110 * MiB, WS_H = 175 * MiB, WS_GM = 353 * MiB, WS_GN = 417 * MiB;
constexpr size_t WS_GQ = 110 * MiB, WS_GO = 142 * MiB;
constexpr size_t WS_SSP1 = 481 * MiB, WS_SSP2 = 484 * MiB;
constexpr size_t WS_END = 487 * MiB;
constexpr size_t CTL_BAR = 0, CTL_BAR_BYTES = 16384, CTL_GLAST = 768 * 1024;

struct Params { const float* in[21]; float* out; unsigned char* ws; };

typedef float f32x2v __attribute__((ext_vector_type(2)));
typedef __bf16 bf16x2v __attribute__((ext_vector_type(2)));
__device__ __forceinline__ unsigned cvt_pk(float lo, float hi) { const f32x2v v = {lo, hi}; const bf16x2v b = __builtin_convertvector(v, bf16x2v); return __builtin_bit_cast(unsigned, b); }
__device__ __forceinline__ bf16_t f2bf(float f) { return (bf16_t)(cvt_pk(f, 0.f) & 0xffffu); }
__device__ __forceinline__ float bf2f(bf16_t h) { return __uint_as_float(((unsigned)h) << 16); }
__device__ __forceinline__ float bflo(unsigned w) { return __uint_as_float(w << 16); }
__device__ __forceinline__ float bfhi(unsigned w) { return __uint_as_float(w & 0xffff0000u); }
__device__ __forceinline__ float silu(float x) { return x * __builtin_amdgcn_rcpf(1.0f + __expf(-x)); }
__device__ __forceinline__ float wave_sum(float v) {
#pragma unroll
    for (int o = 1; o < 64; o <<= 1) v += __shfl_xor(v, o);
    return v;
}
__device__ __forceinline__ float wave_max(float v) {
#pragma unroll
    for (int o = 1; o < 64; o <<= 1) v = fmaxf(v, __shfl_xor(v, o));
    return v;
}
__device__ __forceinline__ float row16_sum(float v) {
    v += __builtin_bit_cast(float, __builtin_amdgcn_update_dpp(0, __builtin_bit_cast(int, v), 0xB1, 0xF, 0xF, true));
    v += __builtin_bit_cast(float, __builtin_amdgcn_update_dpp(0, __builtin_bit_cast(int, v), 0x4E, 0xF, 0xF, true));
    v += __builtin_bit_cast(float, __builtin_amdgcn_update_dpp(0, __builtin_bit_cast(int, v), 0x141, 0xF, 0xF, true));
    v += __builtin_bit_cast(float, __builtin_amdgcn_update_dpp(0, __builtin_bit_cast(int, v), 0x140, 0xF, 0xF, true));
    return v;
}
__device__ __forceinline__ f32x4 mfma16(bf16x8 a, bf16x8 b, f32x4 c) { return __builtin_amdgcn_mfma_f32_16x16x32_bf16(a, b, c, 0, 0, 0); }

__device__ __forceinline__ float row_rstd(const float* ssp, int r) {
    if (r >= MREAL) return 0.f;
    const f32x4 a = *(const f32x4*)(ssp + (size_t)r * 16), b = *(const f32x4*)(ssp + (size_t)r * 16 + 4), c = *(const f32x4*)(ssp + (size_t)r * 16 + 8), d = *(const f32x4*)(ssp + (size_t)r * 16 + 12);
    const float s = (((a[0] + a[1]) + (a[2] + a[3])) + ((b[0] + b[1]) + (b[2] + b[3]))) + (((c[0] + c[1]) + (c[2] + c[3])) + ((d[0] + d[1]) + (d[2] + d[3])));
    return rsqrtf(s * (1.0f / DM) + EPS);
}
__device__ __forceinline__ float row_rstd4(const float* ssp, int r, int fq) {
    const f32x4 a = *(const f32x4*)(ssp + (size_t)r * 16 + 4 * fq);
    float s = (a[0] + a[1]) + (a[2] + a[3]);
    s += __shfl_xor(s, 16); s += __shfl_xor(s, 32);
    return rsqrtf(s * (1.0f / DM) + EPS);
}
__device__ __forceinline__ void swiglu2(float g0, float u0, float g1, float u1, float& h0, float& h1) {
    const float c0 = fmaxf(g0, -40.f), c1 = fmaxf(g1, -40.f);
    const float a = 1.0f + __expf(-c0), b = 1.0f + __expf(-c1), r = __builtin_amdgcn_rcpf(a * b);
    h0 = c0 * (r * b) * u0; h1 = c1 * (r * a) * u1;
}
struct EpiSwiglu {
    static constexpr bool PERM = true, AFTER_DRAIN = false;
    bf16_t* H; const float* ss;
    __device__ __forceinline__ void operator()(const f32x4 (&acc)[2][2][4][2], const pg8::Unit& u, int wr, int wc, int fr, int fq) const {
        const int row0 = u.pm * 256 + wr * 64 + fr, col0 = u.pn * 128 + wc * 32 + 8 * fq;
#pragma unroll
        for (int ai = 0; ai < 2; ++ai)
#pragma unroll
            for (int m = 0; m < 4; ++m) {
                const int r = row0 + ai * 128 + m * 16;
                const float rs = ss ? row_rstd4(ss, r, fq) : 1.0f;
                float h[8];
#pragma unroll
                for (int n = 0; n < 2; ++n)
#pragma unroll
                    for (int j = 0; j < 4; j += 2) swiglu2(acc[ai][0][m][n][j] * rs, acc[ai][1][m][n][j] * rs, acc[ai][0][m][n][j + 1] * rs, acc[ai][1][m][n][j + 1] * rs, h[n * 4 + j], h[n * 4 + j + 1]);
                u32x4 w; w.x = cvt_pk(h[0], h[1]); w.y = cvt_pk(h[2], h[3]); w.z = cvt_pk(h[4], h[5]); w.w = cvt_pk(h[6], h[7]);
                *(u32x4*)(H + (size_t)r * DFF + col0) = w;
            }
    }
};
template <bool RESB16, bool WF32, bool WB16, bool SUMSQ, bool HALF> struct EpiResid {
    static constexpr bool PERM = true, AFTER_DRAIN = false;
    const void* resP; const void* resS; float* Yo; bf16_t* XBo; float* sso;
    __device__ __forceinline__ void operator()(const f32x4 (&acc)[2][2][4][2], const pg8::Unit& u, int wr, int wc, int fr, int fq) const {
        const int row0 = u.pm * 256 + wr * 64 + fr, col0 = u.pn * 256 + wc * 32 + 8 * fq;
        const char* const rP = (const char*)resP; const char* const rS = (const char*)resS - (size_t)MPR * DM * (RESB16 ? 2 : 4);
        float* const Y = Yo; const float scale = HALF ? 0.5f : 1.0f; bf16_t* const XB = XBo; float* const ss = sso;
#pragma unroll
        for (int ai = 0; ai < 2; ++ai)
#pragma unroll
            for (int m = 0; m < 4; ++m) {
                const int r = row0 + ai * 128 + m * 16; float s = 0.f;
                if (r < MREAL) {
                    const char* rp = ((r < MPR) ? rP : rS) + (size_t)r * DM * (RESB16 ? 2 : 4);
#pragma unroll
                    for (int bj = 0; bj < 2; ++bj) {
                        const int c = col0 + bj * 128;
                        f32x4 r0, r1;
                        if (RESB16) { const u32x4 w = *(const u32x4*)(rp + (size_t)c * 2); r0 = (f32x4){bflo(w.x), bfhi(w.x), bflo(w.y), bfhi(w.y)}; r1 = (f32x4){bflo(w.z), bfhi(w.z), bflo(w.w), bfhi(w.w)}; }
                        else { r0 = *(const f32x4*)(rp + (size_t)c * 4); r1 = *(const f32x4*)(rp + (size_t)c * 4 + 16); }
                        const f32x4 v0 = r0 + acc[ai][bj][m][0] * scale, v1 = r1 + acc[ai][bj][m][1] * scale;
                        if (WF32) { *(f32x4*)(Y + (size_t)r * DM + c) = v0; *(f32x4*)(Y + (size_t)r * DM + c + 4) = v1; }
                        if (WB16) { u32x4 w; w.x = cvt_pk(v0[0], v0[1]); w.y = cvt_pk(v0[2], v0[3]); w.z = cvt_pk(v1[0], v1[1]); w.w = cvt_pk(v1[2], v1[3]);
                            *(u32x4*)(XB + (size_t)r * DM + c) = w; }
                        if (SUMSQ) s += (v0[0] * v0[0] + v0[1] * v0[1]) + (v0[2] * v0[2] + v0[3] * v0[3]) + (v1[0] * v1[0] + v1[1] * v1[1]) + (v1[2] * v1[2] + v1[3] * v1[3]);
                    }
                }
                if (SUMSQ) { s += __shfl_xor(s, 16); s += __shfl_xor(s, 32); if (fq == 0 && r < MREAL) ss[(size_t)r * 16 + u.pn * 4 + wc] = s; }
            }
    }
};
struct EpiInproj {
    static constexpr bool PERM = true, AFTER_DRAIN = false;
    bf16_t* P; float* gba; const float* ss;
    __device__ __forceinline__ void operator()(const f32x4 (&acc)[2][2][4][2], const pg8::Unit& u, int wr, int wc, int fr, int fq) const {
        const int row0 = u.pm * 256 + wr * 64 + fr, col0 = u.pn * 256 + wc * 32 + 8 * fq;
#pragma unroll
        for (int ai = 0; ai < 2; ++ai)
#pragma unroll
            for (int m = 0; m < 4; ++m) {
                const int r = row0 + ai * 128 + m * 16;
                const float rs = row_rstd4(ss, r, fq);
                if (u.pn < 11) {
#pragma unroll
                    for (int bj = 0; bj < 2; ++bj) { const f32x4 v0 = acc[ai][bj][m][0] * rs, v1 = acc[ai][bj][m][1] * rs;
                        u32x4 w; w.x = cvt_pk(v0[0], v0[1]); w.y = cvt_pk(v0[2], v0[3]); w.z = cvt_pk(v1[0], v1[1]); w.w = cvt_pk(v1[2], v1[3]);
                        *(u32x4*)(P + (size_t)r * PW + col0 + bj * 128) = w; }
                } else if (wc == 0 && fq == 0) {
                    *(f32x4*)(gba + (size_t)r * 8) = acc[ai][0][m][0] * rs; *(f32x4*)(gba + (size_t)r * 8 + 4) = acc[ai][0][m][1] * rs;
                }
            }
    }
};


template <int NT, bool SS>
__device__ __forceinline__ void skinny_mm(const bf16_t* A, int lda, const bf16_t* W, int K, int wrow0, int wrow1, int wid, int fr, int fq, f32x4 (&acc)[NT], float& ss, LAS unsigned char* lds) {
    const int lane = fq * 16 + fr, kper = K >> 3, nks = kper >> 5;
    const bf16_t* ap = A + (size_t)fr * lda + wid * kper + 8 * fq;
    const bf16_t* w0 = W + (size_t)(wrow0 + fr) * K + wid * kper + 8 * fq; const bf16_t* w1 = W + (size_t)(wrow1 + fr) * K + wid * kper + 8 * fq;
    f32x4 pa[NT][8]; float sp[8];
#pragma unroll
    for (int mt = 0; mt < 8; ++mt) { sp[mt] = 0.f;
#pragma unroll
        for (int nt = 0; nt < NT; ++nt) pa[nt][mt] = (f32x4){0.f, 0.f, 0.f, 0.f}; }
#pragma unroll 2
    for (int ks = 0; ks < nks; ++ks) {
        const bf16x8 b0 = *(const bf16x8*)(w0 + 32 * ks); bf16x8 b1 = b0; if (NT == 2) b1 = *(const bf16x8*)(w1 + 32 * ks);
        bf16x8 av[8];
#pragma unroll
        for (int mt = 0; mt < 8; ++mt) av[mt] = *(const bf16x8*)(ap + (size_t)(16 * mt) * lda + 32 * ks);
#pragma unroll
        for (int mt = 0; mt < 8; ++mt) {
            pa[0][mt] = mfma16(b0, av[mt], pa[0][mt]);
            if (NT == 2) pa[NT - 1][mt] = mfma16(b1, av[mt], pa[NT - 1][mt]);
            if (SS) { const u32x4 u = __builtin_bit_cast(u32x4, av[mt]);
#pragma unroll
                for (int k = 0; k < 4; ++k) { const float lo = bflo(u[k]), hi = bfhi(u[k]); sp[mt] += lo * lo + hi * hi; } }
        }
    }
    LAS f32x4* red = (LAS f32x4*)lds;
    LAS float* sred = (LAS float*)(lds + 8 * NT * 8 * 64 * 16);
#pragma unroll
    for (int mt = 0; mt < 8; ++mt) {
#pragma unroll
        for (int nt = 0; nt < NT; ++nt) red[((wid * NT + nt) * 8 + mt) * 64 + lane] = pa[nt][mt];
        if (SS) sred[(wid * 8 + mt) * 64 + lane] = sp[mt];
    }
    __syncthreads();
    float s = 0.f;
#pragma unroll
    for (int nt = 0; nt < NT; ++nt) acc[nt] = (f32x4){0.f, 0.f, 0.f, 0.f};
#pragma unroll
    for (int v = 0; v < 8; ++v) {
#pragma unroll
        for (int nt = 0; nt < NT; ++nt) acc[nt] += red[((v * NT + nt) * 8 + wid) * 64 + lane];
        if (SS) s += sred[(v * 8 + wid) * 64 + lane];
    }
    if (SS) { s += __shfl_xor(s, 16); s += __shfl_xor(s, 32); }
    ss = s;
    __syncthreads();
}
template <bool SS> __device__ __forceinline__ void sk_ffn_in(const bf16_t* X, const bf16_t* Wt, bf16_t* H, int slab, int wid, int fr, int fq, LAS unsigned char* lds) {
    const int j0 = 16 * slab, wr0 = (j0 >> 7) * 256 + (j0 & 127);
    f32x4 acc[2]; float ss;
    skinny_mm<2, SS>(X + (size_t)MPR * DM, DM, Wt, DM, wr0, wr0 + 128, wid, fr, fq, acc, ss, lds);
    const float rs = SS ? rsqrtf(ss * (1.0f / DM) + EPS) : 1.0f;
    float h[4];
#pragma unroll
    for (int e = 0; e < 4; ++e) h[e] = silu(acc[0][e] * rs) * (acc[1][e] * rs);
    u32x2 w; w.x = cvt_pk(h[0], h[1]); w.y = cvt_pk(h[2], h[3]);
    *(u32x2*)(H + (size_t)(MPR + 16 * wid + fr) * DFF + j0 + 4 * fq) = w;
}
template <bool OUTF32> __device__ __forceinline__ void sk_ffn_out(const bf16_t* Hb, const bf16_t* Wt, const float* resf, float* outf, bf16_t* outb, int slab, int wid, int fr, int fq, LAS unsigned char* lds) {
    f32x4 acc[1]; float ss;
    skinny_mm<1, false>(Hb + (size_t)MPR * DFF, DFF, Wt, DFF, 16 * slab, 0, wid, fr, fq, acc, ss, lds);
    const int rl = 16 * wid + fr, c = 16 * slab + 4 * fq;
    f32x4 rv;
    if (OUTF32) { const u32x2 xr = *(const u32x2*)((const bf16_t*)resf + (size_t)rl * DM + c); rv = (f32x4){bflo(xr.x), bfhi(xr.x), bflo(xr.y), bfhi(xr.y)}; }
    else rv = *(const f32x4*)(resf + (size_t)rl * DM + c);
    const f32x4 v = rv + acc[0] * 0.5f;
    { u32x2 w; w.x = cvt_pk(v[0], v[1]); w.y = cvt_pk(v[2], v[3]); *(u32x2*)(outb + (size_t)rl * DM + c) = w; }
}
__device__ __forceinline__ void sk_inproj(const bf16_t* X, const bf16_t* Wt, bf16_t* P, float* gba, int slab, int wid, int fr, int fq, LAS unsigned char* lds) {
    const int n0 = 32 * slab; f32x4 acc[2]; float ss;
    skinny_mm<2, true>(X + (size_t)MPR * DM, DM, Wt, DM, n0, n0 + 16, wid, fr, fq, acc, ss, lds);
    const float rs = rsqrtf(ss * (1.0f / DM) + EPS); const int r = MPR + 16 * wid + fr;
    if (n0 < PW) {
#pragma unroll
        for (int nt = 0; nt < 2; ++nt) { const f32x4 v = acc[nt] * rs; u32x2 w; w.x = cvt_pk(v[0], v[1]); w.y = cvt_pk(v[2], v[3]); *(u32x2*)(P + (size_t)r * PW + n0 + 16 * nt + 4 * fq) = w; }
    } else if (fq < 2) *(f32x4*)(gba + (size_t)r * 8 + 4 * fq) = acc[0] * rs;
}
__device__ __forceinline__ void sk_outproj(const bf16_t* Pm, const bf16_t* Wt, const bf16_t* X1b, float* X2f, bf16_t* X2b, int slab, int wid, int fr, int fq, LAS unsigned char* lds) {
    const int n0 = 32 * slab; f32x4 acc[2]; float ss;
    skinny_mm<2, false>(Pm + (size_t)MPR * PW, PW, Wt, DM, n0, n0 + 16, wid, fr, fq, acc, ss, lds);
    const int r = MPR + 16 * wid + fr;
#pragma unroll
    for (int nt = 0; nt < 2; ++nt) { const int c = n0 + 16 * nt + 4 * fq; const u32x2 xr = *(const u32x2*)(X1b + (size_t)r * DM + c);
        const f32x4 v = (f32x4){bflo(xr.x), bfhi(xr.x), bflo(xr.y), bfhi(xr.y)} + acc[nt];
        u32x2 w; w.x = cvt_pk(v[0], v[1]); w.y = cvt_pk(v[2], v[3]); *(u32x2*)(X2b + (size_t)r * DM + c) = w; }
}

__device__ __forceinline__ void transpose_item(const float* W, int K, int N, bf16_t* WT, int k0, int n0, int drow0, const float* gs, LAS float* scr, int lane) {
    float wv[32];
#pragma unroll
    for (int i = 0; i < 32; ++i) { const int kk = 2 * i + (lane >> 5), n = n0 + (lane & 31); wv[i] = (n < N) ? W[(size_t)(k0 + kk) * N + n] : 0.f; }
#pragma unroll
    for (int i = 0; i < 32; ++i) { const int kk = 2 * i + (lane >> 5); float v = wv[i]; if (gs) v *= gs[k0 + kk]; scr[kk * 33 + (lane & 31)] = v; }
    asm volatile("s_waitcnt lgkmcnt(0)" ::: "memory");
    const int c = lane & 7;
#pragma unroll
    for (int j = 0; j < 4; ++j) { const int nn = (lane >> 3) + 8 * j; const LAS float* s = scr + (8 * c) * 33 + nn;
        u32x4 o; o.x = cvt_pk(s[0 * 33], s[1 * 33]); o.y = cvt_pk(s[2 * 33], s[3 * 33]); o.z = cvt_pk(s[4 * 33], s[5 * 33]); o.w = cvt_pk(s[6 * 33], s[7 * 33]);
        *(u32x4*)(WT + (size_t)(drow0 + nn) * K + k0 + 8 * c) = o; }
    asm volatile("s_waitcnt lgkmcnt(0)" ::: "memory");
}
__device__ __forceinline__ int map_ffin_row(int n0) { return n0 < DFF ? (n0 >> 7) * 256 + (n0 & 127) : ((n0 - DFF) >> 7) * 256 + 128 + ((n0 - DFF) & 127); }

__device__ __forceinline__ void p0_prologue(const Params& p, LAS unsigned char* lds, int vb, int G) {
    const int tid = threadIdx.x, lane = tid & 63, wid = tid >> 6;
    LAS float* scr = (LAS float*)(lds + wid * 16384);
    const int gw = vb * 8 + wid, NGW = G * 8;
    bf16_t* W1IN = (bf16_t*)(p.ws + WS_W1IN); bf16_t* W1OUT = (bf16_t*)(p.ws + WS_W1OUT); bf16_t* WINMIX = (bf16_t*)(p.ws + WS_WINMIX);
    bf16_t* WOUTMIX = (bf16_t*)(p.ws + WS_WOUTMIX); bf16_t* W2IN = (bf16_t*)(p.ws + WS_W2IN); bf16_t* W2OUT = (bf16_t*)(p.ws + WS_W2OUT);
    constexpr int I_FIN = 16 * 176, I_FOUT = 44 * 32, I_INMIX = 16 * 89;
    constexpr int NITEMS = I_FIN + I_FOUT + I_INMIX;
    for (int it = gw; it < NITEMS; it += NGW) {
        int r = it;
        if (r < I_FIN) { const int kb = r / 176, nb = r % 176; transpose_item(p.in[7], DM, 2 * DFF, W1IN, kb * 64, nb * 32, map_ffin_row(nb * 32), nullptr, scr, lane); continue; } r -= I_FIN;
        if (r < I_FOUT) { const int kb = r / 32, nb = r % 32; transpose_item(p.in[8], DFF, DM, W1OUT, kb * 64, nb * 32, nb * 32, nullptr, scr, lane); continue; } r -= I_FOUT;
        { const int kb = r / 89, nb = r % 89; transpose_item(p.in[10], DM, 2824, WINMIX, kb * 64, nb * 32, nb * 32, p.in[9], scr, lane); }
    }
    bf16_t* XN = (bf16_t*)(p.ws + WS_XN); const float* g1 = p.in[6];
    f32x4 gv[4];
#pragma unroll
    for (int j = 0; j < 4; ++j) gv[j] = *((const f32x4*)g1 + lane + 64 * j);
    {
        f32x4 v[4], vn[4];
        int m = gw;
        if (m < MREAL) { const f32x4* xr = (const f32x4*)((m < MPR) ? p.in[0] + (size_t)m * DM : p.in[1] + (size_t)(m - MPR) * DM) + lane;
#pragma unroll
            for (int j = 0; j < 4; ++j) v[j] = xr[64 * j]; }
        for (; m < MREAL; m += NGW) {
            const int mn = m + NGW;
            if (mn < MREAL) { const f32x4* xr = (const f32x4*)((mn < MPR) ? p.in[0] + (size_t)mn * DM : p.in[1] + (size_t)(mn - MPR) * DM) + lane;
#pragma unroll
                for (int j = 0; j < 4; ++j) vn[j] = xr[64 * j]; }
            float s = 0.f;
#pragma unroll
            for (int j = 0; j < 4; ++j) s += (v[j][0] * v[j][0] + v[j][1] * v[j][1]) + (v[j][2] * v[j][2] + v[j][3] * v[j][3]);
            const float rstd = rsqrtf(wave_sum(s) * (1.0f / DM) + EPS);
            unsigned long long* o8 = (unsigned long long*)(XN + (size_t)m * DM) + lane;
#pragma unroll
            for (int j = 0; j < 4; ++j) { const f32x4 y = v[j] * rstd * gv[j];
                o8[64 * j] = (unsigned long long)cvt_pk(y[0], y[1]) | ((unsigned long long)cvt_pk(y[2], y[3]) << 32); }
#pragma unroll
            for (int j = 0; j < 4; ++j) v[j] = vn[j];
        }
    }
}

template <bool SWX = false, bool SWY = false>
__device__ __forceinline__ f32x4 tile_mm(const LAS bf16_t* X, int ldx, int mt, const LAS bf16_t* Y, int ldy, int nt, int nks, int fr, int fq) {
    f32x4 acc = (f32x4){0.f, 0.f, 0.f, 0.f};
    const int rx = 16 * mt + fr, ry = 16 * nt + fr, sx = SWX ? ((rx >> 3) & 7) : 0, sy = SWY ? ((ry >> 3) & 7) : 0;
    const LAS bf16_t* xp = X + rx * ldx; const LAS bf16_t* yp = Y + ry * ldy;
    for (int ks = 0; ks < nks; ++ks) acc = mfma16(*(const LAS bf16x8*)(xp + 8 * ((4 * ks + fq) ^ sx)), *(const LAS bf16x8*)(yp + 8 * ((4 * ks + fq) ^ sy)), acc);
    return acc;
}
constexpr int G1_QS = 0, G1_KS = 17408, G1_VBT = 34816, G1_KBT = 53248, G1_KDT = 71680, G1_UT = 90112, G1_WT = 108544, G1_QK = 126976, G1_TB = 136192, G1_GC = 145408, G1_BETA = 145664, G1_TT = 146176, G1_A10 = 148736, G1_PT = 151296;

__device__ __forceinline__ void gdn_prep_unit(const Params& p, LAS unsigned char* lds, int unit) {
    const int tid = threadIdx.x, lane = tid & 63, wid = tid >> 6, fr = lane & 15, fq = lane >> 4;
    const int bh = unit >> 7, n = unit & 127, b = bh >> 2, h = bh & 3;
    const int tok0 = b * SEQ + n * 64;
    LAS bf16_t* Qs = (LAS bf16_t*)(lds + G1_QS); LAS bf16_t* Ks = (LAS bf16_t*)(lds + G1_KS); LAS bf16_t* VbT = (LAS bf16_t*)(lds + G1_VBT);
    LAS bf16_t* KbT = (LAS bf16_t*)(lds + G1_KBT); LAS bf16_t* KdT = (LAS bf16_t*)(lds + G1_KDT); LAS bf16_t* UT = (LAS bf16_t*)(lds + G1_UT);
    LAS bf16_t* WT = (LAS bf16_t*)(lds + G1_WT); LAS float* Af = (LAS float*)(lds + G1_WT); LAS bf16_t* QK = (LAS bf16_t*)(lds + G1_QK);
    LAS bf16_t* Tb = (LAS bf16_t*)(lds + G1_TB); LAS bf16_t* TT = (LAS bf16_t*)(lds + G1_TT); LAS bf16_t* A10b = (LAS bf16_t*)(lds + G1_A10); LAS bf16_t* PT = (LAS bf16_t*)(lds + G1_PT); LAS float* gcs = (LAS float*)(lds + G1_GC); LAS float* betas = (LAS float*)(lds + G1_BETA);
    const bf16_t* PB = (const bf16_t*)(p.ws + WS_H); const float* GBA = (const float*)(p.ws + WS_GBA);
    LAS unsigned char* raw = lds + G1_UT;
    for (int pc4 = wid; pc4 < 51; pc4 += 8) {
        int pc = pc4 * 4 + (lane >> 4); pc = pc < 200 ? pc : 200;
        const int r = pc / 3, seg = pc - 3 * r; int tt = n * 64 - 3 + r; tt = tt < 0 ? 0 : tt;
        __builtin_amdgcn_global_load_lds((const unsigned*)(PB + (size_t)(b * SEQ + tt) * PW + 768 + seg * 512 + h * 128 + (lane & 15) * 8), (LAS unsigned*)(raw + pc4 * 1024), 16, 0, 0);
    }
    if (tid < 64) {
        const float* gb = GBA + (size_t)(tok0 + tid) * 8;
        const float bt = 1.0f / (1.0f + __expf(-gb[h]));
        const float x = gb[4 + h] + p.in[14][h]; const float sp = x > 20.f ? x : log1pf(__expf(x));
        float c = -__expf(p.in[13][h]) * sp;
#pragma unroll
        for (int o = 1; o < 64; o <<= 1) { const float t = __shfl_up(c, o); if (lane >= o) c += t; }
        gcs[tid] = c; betas[tid] = bt;
    }
    asm volatile("s_waitcnt vmcnt(0)" ::: "memory");
    __syncthreads();
    const float gclast = gcs[63];
    const float* cw = p.in[12];
    f32x4 cwv[4][2];
#pragma unroll 1
    for (int it = 0; it < 6; ++it) {
        const int item = tid + 512 * it, l16 = item & 15, row = item >> 4, which = row >> 6, t = row & 63;
        const int cch = which * 512 + h * 128 + l16 * 8;
        if ((it & 1) == 0) {
#pragma unroll
            for (int j = 0; j < 4; ++j) { cwv[j][0] = *(const f32x4*)(cw + j * CONVC + cch); cwv[j][1] = *(const f32x4*)(cw + j * CONVC + cch + 4); }
        }
        float a[8];
#pragma unroll
        for (int e = 0; e < 8; ++e) a[e] = 0.f;
#pragma unroll
        for (int j = 0; j < 4; ++j) {
            const int tt = n * 64 + t - 3 + j;
            u32x4 xv = *(const LAS u32x4*)(raw + ((t + j) * 3 + which) * 256 + l16 * 16);
            if (tt < 0) xv = (u32x4){0u, 0u, 0u, 0u};
            const f32x4 w0 = cwv[j][0], w1 = cwv[j][1];
            a[0] += w0[0] * bflo(xv.x); a[1] += w0[1] * bfhi(xv.x); a[2] += w0[2] * bflo(xv.y); a[3] += w0[3] * bfhi(xv.y);
            a[4] += w1[0] * bflo(xv.z); a[5] += w1[1] * bfhi(xv.z); a[6] += w1[2] * bflo(xv.w); a[7] += w1[3] * bfhi(xv.w);
        }
        float ss = 0.f;
#pragma unroll
        for (int e = 0; e < 8; ++e) { a[e] = silu(a[e]); ss += a[e] * a[e]; }
        ss = row16_sum(ss);
        const float gct = gcs[t], bt = betas[t];
        const int tsw = (((t >> 3) ^ (l16 & 7)) << 3) | (t & 7);
        if (which == 0) {
            const float sc = rsqrtf(ss + EPS) * 0.08838834764831845f;
            u32x4 w; w.x = cvt_pk(a[0] * sc, a[1] * sc); w.y = cvt_pk(a[2] * sc, a[3] * sc); w.z = cvt_pk(a[4] * sc, a[5] * sc); w.w = cvt_pk(a[6] * sc, a[7] * sc);
            *(LAS u32x4*)(Qs + t * 136 + l16 * 8) = w;
        } else if (which == 1) {
            const float sc = rsqrtf(ss + EPS);
            u32x4 w; w.x = cvt_pk(a[0] * sc, a[1] * sc); w.y = cvt_pk(a[2] * sc, a[3] * sc); w.z = cvt_pk(a[4] * sc, a[5] * sc); w.w = cvt_pk(a[6] * sc, a[7] * sc);
            *(LAS u32x4*)(Ks + t * 136 + l16 * 8) = w;
            const float sb = sc * bt * __expf(gct), sd = sc * __expf(gclast - gct);
#pragma unroll
            for (int e = 0; e < 8; ++e) { KbT[(l16 * 8 + e) * 72 + tsw] = f2bf(a[e] * sb); KdT[(l16 * 8 + e) * 72 + tsw] = f2bf(a[e] * sd); }
        } else {
#pragma unroll
            for (int e = 0; e < 8; ++e) VbT[(l16 * 8 + e) * 72 + tsw] = f2bf(a[e] * bt);
        }
    }
    __syncthreads();
#pragma unroll 2
    for (int r = 0; r < 4; ++r) {
        const int job = wid + 8 * r, kind = job >> 4, tile = job & 15, it = tile >> 2, jt = tile & 3;
        if (kind == 0) {
            if (jt > it) continue;
            const f32x4 acc = tile_mm(Ks, 136, it, Ks, 136, jt, 4, fr, fq);
            const int j = 16 * jt + fr; const float gcj = gcs[j];
            float v[4];
#pragma unroll
            for (int e = 0; e < 4; ++e) { const int i = 16 * it + 4 * fq + e; const bool ok = i > j; v[e] = ok ? acc[e] * __expf(gcs[i] - gcj) * betas[i] : 0.f; }
            *(LAS f32x4*)(Af + j * 68 + 16 * it + 4 * fq) = (f32x4){v[0], v[1], v[2], v[3]};
            if (it >= 2 && jt < 2) {
#pragma unroll
                for (int e = 0; e < 4; ++e) A10b[(16 * (it - 2) + 4 * fq + e) * 40 + j] = f2bf(v[e]); }
        } else {
            const f32x4 acc = tile_mm(Ks, 136, jt, Qs, 136, it, 4, fr, fq);
            const int i = 16 * it + fr; const float gci = gcs[i];
            float v[4];
#pragma unroll
            for (int e = 0; e < 4; ++e) { const int j = 16 * jt + 4 * fq + e; const bool ok = i >= j; v[e] = ok ? acc[e] * __expf(gci - gcs[j]) : 0.f; }
            u32x2 w; w.x = cvt_pk(v[0], v[1]); w.y = cvt_pk(v[2], v[3]); *(LAS u32x2*)(QK + i * 72 + 16 * jt + 4 * fq) = w;
        }
    }
    __syncthreads();
    if (wid < 2) {
        const int ofs = wid * 32, cl = lane & 31; const LAS float* Ab = Af + ofs * 69; LAS bf16_t* Tw = Tb + ofs * 73 + cl; LAS bf16_t* Tt = (wid == 0) ? TT + cl * 40 : PT + cl * 40;
        f32x2v r2[16];
#pragma unroll
        for (int k = 0; k < 16; ++k) r2[k] = (f32x2v){(cl == 2 * k) ? 1.0f : 0.0f, (cl == 2 * k + 1) ? 1.0f : 0.0f};
        const f32x4 a0 = *(const LAS f32x4*)(Ab + 0);
        const f32x4 a1 = *(const LAS f32x4*)(Ab + 4);
        const f32x4 a2 = *(const LAS f32x4*)(Ab + 8);
        const f32x4 a3 = *(const LAS f32x4*)(Ab + 12);
        const f32x4 a4 = *(const LAS f32x4*)(Ab + 16);
        const float t0 = r2[0][0]; const f32x2v T0 = (f32x2v){t0, t0}; Tw[0] = f2bf(t0); Tt[0] = f2bf(t0);
        r2[0] -= (f32x2v){a0[0], a0[1]} * T0; r2[1] -= (f32x2v){a0[2], a0[3]} * T0;
        const f32x4 a5 = *(const LAS f32x4*)(Ab + 20);
        r2[2] -= (f32x2v){a1[0], a1[1]} * T0; r2[3] -= (f32x2v){a1[2], a1[3]} * T0;
        const f32x4 a6 = *(const LAS f32x4*)(Ab + 24);
        r2[4] -= (f32x2v){a2[0], a2[1]} * T0; r2[5] -= (f32x2v){a2[2], a2[3]} * T0;
        const f32x4 a7 = *(const LAS f32x4*)(Ab + 28);
        r2[6] -= (f32x2v){a3[0], a3[1]} * T0; r2[7] -= (f32x2v){a3[2], a3[3]} * T0;
        const f32x4 a8 = *(const LAS f32x4*)(Ab + 68);
        r2[8] -= (f32x2v){a4[0], a4[1]} * T0; r2[9] -= (f32x2v){a4[2], a4[3]} * T0;
        const f32x4 a9 = *(const LAS f32x4*)(Ab + 72);
        r2[10] -= (f32x2v){a5[0], a5[1]} * T0; r2[11] -= (f32x2v){a5[2], a5[3]} * T0;
        const f32x4 a10 = *(const LAS f32x4*)(Ab + 76);
        r2[12] -= (f32x2v){a6[0], a6[1]} * T0; r2[13] -= (f32x2v){a6[2], a6[3]} * T0;
        const f32x4 a11 = *(const LAS f32x4*)(Ab + 80);
        r2[14] -= (f32x2v){a7[0], a7[1]} * T0; r2[15] -= (f32x2v){a7[2], a7[3]} * T0;
        const f32x4 a12 = *(const LAS f32x4*)(Ab + 84);
        const float t1 = r2[0][1]; const f32x2v T1 = (f32x2v){t1, t1}; Tw[72] = f2bf(t1); Tt[1] = f2bf(t1);
        r2[1] -= (f32x2v){a8[2], a8[3]} * T1;
        const f32x4 a13 = *(const LAS f32x4*)(Ab + 88);
        r2[2] -= (f32x2v){a9[0], a9[1]} * T1; r2[3] -= (f32x2v){a9[2], a9[3]} * T1;
        const f32x4 a14 = *(const LAS f32x4*)(Ab + 92);
        r2[4] -= (f32x2v){a10[0], a10[1]} * T1; r2[5] -= (f32x2v){a10[2], a10[3]} * T1;
        const f32x4 a15 = *(const LAS f32x4*)(Ab + 96);
        r2[6] -= (f32x2v){a11[0], a11[1]} * T1; r2[7] -= (f32x2v){a11[2], a11[3]} * T1;
        const f32x4 a16 = *(const LAS f32x4*)(Ab + 136);
        r2[8] -= (f32x2v){a12[0], a12[1]} * T1; r2[9] -= (f32x2v){a12[2], a12[3]} * T1;
        const f32x4 a17 = *(const LAS f32x4*)(Ab + 140);
        r2[10] -= (f32x2v){a13[0], a13[1]} * T1; r2[11] -= (f32x2v){a13[2], a13[3]} * T1;
        const f32x4 a18 = *(const LAS f32x4*)(Ab + 144);
        r2[12] -= (f32x2v){a14[0], a14[1]} * T1; r2[13] -= (f32x2v){a14[2], a14[3]} * T1;
        const f32x4 a19 = *(const LAS f32x4*)(Ab + 148);
        r2[14] -= (f32x2v){a15[0], a15[1]} * T1; r2[15] -= (f32x2v){a15[2], a15[3]} * T1;
        const f32x4 a20 = *(const LAS f32x4*)(Ab + 152);
        const float t2 = r2[1][0]; const f32x2v T2 = (f32x2v){t2, t2}; Tw[144] = f2bf(t2); Tt[2] = f2bf(t2);
        r2[1] -= (f32x2v){a16[2], a16[3]} * T2;
        const f32x4 a21 = *(const LAS f32x4*)(Ab + 156);
        r2[2] -= (f32x2v){a17[0], a17[1]} * T2; r2[3] -= (f32x2v){a17[2], a17[3]} * T2;
        const f32x4 a22 = *(const LAS f32x4*)(Ab + 160);
        r2[4] -= (f32x2v){a18[0], a18[1]} * T2; r2[5] -= (f32x2v){a18[2], a18[3]} * T2;
        const f32x4 a23 = *(const LAS f32x4*)(Ab + 164);
        r2[6] -= (f32x2v){a19[0], a19[1]} * T2; r2[7] -= (f32x2v){a19[2], a19[3]} * T2;
        const f32x4 a24 = *(const LAS f32x4*)(Ab + 208);
        r2[8] -= (f32x2v){a20[0], a20[1]} * T2; r2[9] -= (f32x2v){a20[2], a20[3]} * T2;
        const f32x4 a25 = *(const LAS f32x4*)(Ab + 212);
        r2[10] -= (f32x2v){a21[0], a21[1]} * T2; r2[11] -= (f32x2v){a21[2], a21[3]} * T2;
        const f32x4 a26 = *(const LAS f32x4*)(Ab + 216);
        r2[12] -= (f32x2v){a22[0], a22[1]} * T2; r2[13] -= (f32x2v){a22[2], a22[3]} * T2;
        const f32x4 a27 = *(const LAS f32x4*)(Ab + 220);
        r2[14] -= (f32x2v){a23[0], a23[1]} * T2; r2[15] -= (f32x2v){a23[2], a23[3]} * T2;
        const f32x4 a28 = *(const LAS f32x4*)(Ab + 224);
        const float t3 = r2[1][1]; const f32x2v T3 = (f32x2v){t3, t3}; Tw[216] = f2bf(t3); Tt[3] = f2bf(t3);
        r2[2] -= (f32x2v){a24[0], a24[1]} * T3; r2[3] -= (f32x2v){a24[2], a24[3]} * T3;
        const f32x4 a29 = *(const LAS f32x4*)(Ab + 228);
        r2[4] -= (f32x2v){a25[0], a25[1]} * T3; r2[5] -= (f32x2v){a25[2], a25[3]} * T3;
        const f32x4 a30 = *(const LAS f32x4*)(Ab + 232);
        r2[6] -= (f32x2v){a26[0], a26[1]} * T3; r2[7] -= (f32x2v){a26[2], a26[3]} * T3;
        const f32x4 a31 = *(const LAS f32x4*)(Ab + 276);
        r2[8] -= (f32x2v){a27[0], a27[1]} * T3; r2[9] -= (f32x2v){a27[2], a27[3]} * T3;
        const f32x4 a32 = *(const LAS f32x4*)(Ab + 280);
        r2[10] -= (f32x2v){a28[0], a28[1]} * T3; r2[11] -= (f32x2v){a28[2], a28[3]} * T3;
        const f32x4 a33 = *(const LAS f32x4*)(Ab + 284);
        r2[12] -= (f32x2v){a29[0], a29[1]} * T3; r2[13] -= (f32x2v){a29[2], a29[3]} * T3;
        const f32x4 a34 = *(const LAS f32x4*)(Ab + 288);
        r2[14] -= (f32x2v){a30[0], a30[1]} * T3; r2[15] -= (f32x2v){a30[2], a30[3]} * T3;
        const f32x4 a35 = *(const LAS f32x4*)(Ab + 292);
        const float t4 = r2[2][0]; const f32x2v T4 = (f32x2v){t4, t4}; Tw[288] = f2bf(t4); Tt[4] = f2bf(t4);
        r2[2] -= (f32x2v){a31[0], a31[1]} * T4; r2[3] -= (f32x2v){a31[2], a31[3]} * T4;
        const f32x4 a36 = *(const LAS f32x4*)(Ab + 296);
        r2[4] -= (f32x2v){a32[0], a32[1]} * T4; r2[5] -= (f32x2v){a32[2], a32[3]} * T4;
        const f32x4 a37 = *(const LAS f32x4*)(Ab + 300);
        r2[6] -= (f32x2v){a33[0], a33[1]} * T4; r2[7] -= (f32x2v){a33[2], a33[3]} * T4;
        const f32x4 a38 = *(const LAS f32x4*)(Ab + 344);
        r2[8] -= (f32x2v){a34[0], a34[1]} * T4; r2[9] -= (f32x2v){a34[2], a34[3]} * T4;
        const f32x4 a39 = *(const LAS f32x4*)(Ab + 348);
        r2[10] -= (f32x2v){a35[0], a35[1]} * T4; r2[11] -= (f32x2v){a35[2], a35[3]} * T4;
        const f32x4 a40 = *(const LAS f32x4*)(Ab + 352);
        r2[12] -= (f32x2v){a36[0], a36[1]} * T4; r2[13] -= (f32x2v){a36[2], a36[3]} * T4;
        const f32x4 a41 = *(const LAS f32x4*)(Ab + 356);
        r2[14] -= (f32x2v){a37[0], a37[1]} * T4; r2[15] -= (f32x2v){a37[2], a37[3]} * T4;
        const f32x4 a42 = *(const LAS f32x4*)(Ab + 360);
        const float t5 = r2[2][1]; const f32x2v T5 = (f32x2v){t5, t5}; Tw[360] = f2bf(t5); Tt[5] = f2bf(t5);
        r2[3] -= (f32x2v){a38[2], a38[3]} * T5;
        const f32x4 a43 = *(const LAS f32x4*)(Ab + 364);
        r2[4] -= (f32x2v){a39[0], a39[1]} * T5; r2[5] -= (f32x2v){a39[2], a39[3]} * T5;
        const f32x4 a44 = *(const LAS f32x4*)(Ab + 368);
        r2[6] -= (f32x2v){a40[0], a40[1]} * T5; r2[7] -= (f32x2v){a40[2], a40[3]} * T5;
        const f32x4 a45 = *(const LAS f32x4*)(Ab + 412);
        r2[8] -= (f32x2v){a41[0], a41[1]} * T5; r2[9] -= (f32x2v){a41[2], a41[3]} * T5;
        const f32x4 a46 = *(const LAS f32x4*)(Ab + 416);
        r2[10] -= (f32x2v){a42[0], a42[1]} * T5; r2[11] -= (f32x2v){a42[2], a42[3]} * T5;
        const f32x4 a47 = *(const LAS f32x4*)(Ab + 420);
        r2[12] -= (f32x2v){a43[0], a43[1]} * T5; r2[13] -= (f32x2v){a43[2], a43[3]} * T5;
        const f32x4 a48 = *(const LAS f32x4*)(Ab + 424);
        r2[14] -= (f32x2v){a44[0], a44[1]} * T5; r2[15] -= (f32x2v){a44[2], a44[3]} * T5;
        const f32x4 a49 = *(const LAS f32x4*)(Ab + 428);
        const float t6 = r2[3][0]; const f32x2v T6 = (f32x2v){t6, t6}; Tw[432] = f2bf(t6); Tt[6] = f2bf(t6);
        r2[3] -= (f32x2v){a45[2], a45[3]} * T6;
        const f32x4 a50 = *(const LAS f32x4*)(Ab + 432);
        r2[4] -= (f32x2v){a46[0], a46[1]} * T6; r2[5] -= (f32x2v){a46[2], a46[3]} * T6;
        const f32x4 a51 = *(const LAS f32x4*)(Ab + 436);
        r2[6] -= (f32x2v){a47[0], a47[1]} * T6; r2[7] -= (f32x2v){a47[2], a47[3]} * T6;
        const f32x4 a52 = *(const LAS f32x4*)(Ab + 484);
        r2[8] -= (f32x2v){a48[0], a48[1]} * T6; r2[9] -= (f32x2v){a48[2], a48[3]} * T6;
        const f32x4 a53 = *(const LAS f32x4*)(Ab + 488);
        r2[10] -= (f32x2v){a49[0], a49[1]} * T6; r2[11] -= (f32x2v){a49[2], a49[3]} * T6;
        const f32x4 a54 = *(const LAS f32x4*)(Ab + 492);
        r2[12] -= (f32x2v){a50[0], a50[1]} * T6; r2[13] -= (f32x2v){a50[2], a50[3]} * T6;
        const f32x4 a55 = *(const LAS f32x4*)(Ab + 496);
        r2[14] -= (f32x2v){a51[0], a51[1]} * T6; r2[15] -= (f32x2v){a51[2], a51[3]} * T6;
        const f32x4 a56 = *(const LAS f32x4*)(Ab + 500);
        const float t7 = r2[3][1]; const f32x2v T7 = (f32x2v){t7, t7}; Tw[504] = f2bf(t7); Tt[7] = f2bf(t7);
        r2[4] -= (f32x2v){a52[0], a52[1]} * T7; r2[5] -= (f32x2v){a52[2], a52[3]} * T7;
        const f32x4 a57 = *(const LAS f32x4*)(Ab + 504);
        r2[6] -= (f32x2v){a53[0], a53[1]} * T7; r2[7] -= (f32x2v){a53[2], a53[3]} * T7;
        const f32x4 a58 = *(const LAS f32x4*)(Ab + 552);
        r2[8] -= (f32x2v){a54[0], a54[1]} * T7; r2[9] -= (f32x2v){a54[2], a54[3]} * T7;
        const f32x4 a59 = *(const LAS f32x4*)(Ab + 556);
        r2[10] -= (f32x2v){a55[0], a55[1]} * T7; r2[11] -= (f32x2v){a55[2], a55[3]} * T7;
        const f32x4 a60 = *(const LAS f32x4*)(Ab + 560);
        r2[12] -= (f32x2v){a56[0], a56[1]} * T7; r2[13] -= (f32x2v){a56[2], a56[3]} * T7;
        const f32x4 a61 = *(const LAS f32x4*)(Ab + 564);
        r2[14] -= (f32x2v){a57[0], a57[1]} * T7; r2[15] -= (f32x2v){a57[2], a57[3]} * T7;
        const f32x4 a62 = *(const LAS f32x4*)(Ab + 568);
        const float t8 = r2[4][0]; const f32x2v T8 = (f32x2v){t8, t8}; Tw[576] = f2bf(t8); Tt[8] = f2bf(t8);
        r2[4] -= (f32x2v){a58[0], a58[1]} * T8; r2[5] -= (f32x2v){a58[2], a58[3]} * T8;
        const f32x4 a63 = *(const LAS f32x4*)(Ab + 572);
        r2[6] -= (f32x2v){a59[0], a59[1]} * T8; r2[7] -= (f32x2v){a59[2], a59[3]} * T8;
        const f32x4 a64 = *(const LAS f32x4*)(Ab + 620);
        r2[8] -= (f32x2v){a60[0], a60[1]} * T8; r2[9] -= (f32x2v){a60[2], a60[3]} * T8;
        const f32x4 a65 = *(const LAS f32x4*)(Ab + 624);
        r2[10] -= (f32x2v){a61[0], a61[1]} * T8; r2[11] -= (f32x2v){a61[2], a61[3]} * T8;
        const f32x4 a66 = *(const LAS f32x4*)(Ab + 628);
        r2[12] -= (f32x2v){a62[0], a62[1]} * T8; r2[13] -= (f32x2v){a62[2], a62[3]} * T8;
        const f32x4 a67 = *(const LAS f32x4*)(Ab + 632);
        r2[14] -= (f32x2v){a63[0], a63[1]} * T8; r2[15] -= (f32x2v){a63[2], a63[3]} * T8;
        const f32x4 a68 = *(const LAS f32x4*)(Ab + 636);
        const float t9 = r2[4][1]; const f32x2v T9 = (f32x2v){t9, t9}; Tw[648] = f2bf(t9); Tt[9] = f2bf(t9);
        r2[5] -= (f32x2v){a64[2], a64[3]} * T9;
        const f32x4 a69 = *(const LAS f32x4*)(Ab + 640);
        r2[6] -= (f32x2v){a65[0], a65[1]} * T9; r2[7] -= (f32x2v){a65[2], a65[3]} * T9;
        const f32x4 a70 = *(const LAS f32x4*)(Ab + 688);
        r2[8] -= (f32x2v){a66[0], a66[1]} * T9; r2[9] -= (f32x2v){a66[2], a66[3]} * T9;
        const f32x4 a71 = *(const LAS f32x4*)(Ab + 692);
        r2[10] -= (f32x2v){a67[0], a67[1]} * T9; r2[11] -= (f32x2v){a67[2], a67[3]} * T9;
        const f32x4 a72 = *(const LAS f32x4*)(Ab + 696);
        r2[12] -= (f32x2v){a68[0], a68[1]} * T9; r2[13] -= (f32x2v){a68[2], a68[3]} * T9;
        const f32x4 a73 = *(const LAS f32x4*)(Ab + 700);
        r2[14] -= (f32x2v){a69[0], a69[1]} * T9; r2[15] -= (f32x2v){a69[2], a69[3]} * T9;
        const f32x4 a74 = *(const LAS f32x4*)(Ab + 704);
        const float t10 = r2[5][0]; const f32x2v T10 = (f32x2v){t10, t10}; Tw[720] = f2bf(t10); Tt[10] = f2bf(t10);
        r2[5] -= (f32x2v){a70[2], a70[3]} * T10;
        const f32x4 a75 = *(const LAS f32x4*)(Ab + 708);
        r2[6] -= (f32x2v){a71[0], a71[1]} * T10; r2[7] -= (f32x2v){a71[2], a71[3]} * T10;
        const f32x4 a76 = *(const LAS f32x4*)(Ab + 760);
        r2[8] -= (f32x2v){a72[0], a72[1]} * T10; r2[9] -= (f32x2v){a72[2], a72[3]} * T10;
        const f32x4 a77 = *(const LAS f32x4*)(Ab + 764);
        r2[10] -= (f32x2v){a73[0], a73[1]} * T10; r2[11] -= (f32x2v){a73[2], a73[3]} * T10;
        const f32x4 a78 = *(const LAS f32x4*)(Ab + 768);
        r2[12] -= (f32x2v){a74[0], a74[1]} * T10; r2[13] -= (f32x2v){a74[2], a74[3]} * T10;
        const f32x4 a79 = *(const LAS f32x4*)(Ab + 772);
        r2[14] -= (f32x2v){a75[0], a75[1]} * T10; r2[15] -= (f32x2v){a75[2], a75[3]} * T10;
        const f32x4 a80 = *(const LAS f32x4*)(Ab + 776);
        const float t11 = r2[5][1]; const f32x2v T11 = (f32x2v){t11, t11}; Tw[792] = f2bf(t11); Tt[11] = f2bf(t11);
        r2[6] -= (f32x2v){a76[0], a76[1]} * T11; r2[7] -= (f32x2v){a76[2], a76[3]} * T11;
        const f32x4 a81 = *(const LAS f32x4*)(Ab + 828);
        r2[8] -= (f32x2v){a77[0], a77[1]} * T11; r2[9] -= (f32x2v){a77[2], a77[3]} * T11;
        const f32x4 a82 = *(const LAS f32x4*)(Ab + 832);
        r2[10] -= (f32x2v){a78[0], a78[1]} * T11; r2[11] -= (f32x2v){a78[2], a78[3]} * T11;
        const f32x4 a83 = *(const LAS f32x4*)(Ab + 836);
        r2[12] -= (f32x2v){a79[0], a79[1]} * T11; r2[13] -= (f32x2v){a79[2], a79[3]} * T11;
        const f32x4 a84 = *(const LAS f32x4*)(Ab + 840);
        r2[14] -= (f32x2v){a80[0], a80[1]} * T11; r2[15] -= (f32x2v){a80[2], a80[3]} * T11;
        const f32x4 a85 = *(const LAS f32x4*)(Ab + 844);
        const float t12 = r2[6][0]; const f32x2v T12 = (f32x2v){t12, t12}; Tw[864] = f2bf(t12); Tt[12] = f2bf(t12);
        r2[6] -= (f32x2v){a81[0], a81[1]} * T12; r2[7] -= (f32x2v){a81[2], a81[3]} * T12;
        const f32x4 a86 = *(const LAS f32x4*)(Ab + 896);
        r2[8] -= (f32x2v){a82[0], a82[1]} * T12; r2[9] -= (f32x2v){a82[2], a82[3]} * T12;
        const f32x4 a87 = *(const LAS f32x4*)(Ab + 900);
        r2[10] -= (f32x2v){a83[0], a83[1]} * T12; r2[11] -= (f32x2v){a83[2], a83[3]} * T12;
        const f32x4 a88 = *(const LAS f32x4*)(Ab + 904);
        r2[12] -= (f32x2v){a84[0], a84[1]} * T12; r2[13] -= (f32x2v){a84[2], a84[3]} * T12;
        const f32x4 a89 = *(const LAS f32x4*)(Ab + 908);
        r2[14] -= (f32x2v){a85[0], a85[1]} * T12; r2[15] -= (f32x2v){a85[2], a85[3]} * T12;
        const f32x4 a90 = *(const LAS f32x4*)(Ab + 912);
        const float t13 = r2[6][1]; const f32x2v T13 = (f32x2v){t13, t13}; Tw[936] = f2bf(t13); Tt[13] = f2bf(t13);
        r2[7] -= (f32x2v){a86[2], a86[3]} * T13;
        const f32x4 a91 = *(const LAS f32x4*)(Ab + 964);
        r2[8] -= (f32x2v){a87[0], a87[1]} * T13; r2[9] -= (f32x2v){a87[2], a87[3]} * T13;
        const f32x4 a92 = *(const LAS f32x4*)(Ab + 968);
        r2[10] -= (f32x2v){a88[0], a88[1]} * T13; r2[11] -= (f32x2v){a88[2], a88[3]} * T13;
        const f32x4 a93 = *(const LAS f32x4*)(Ab + 972);
        r2[12] -= (f32x2v){a89[0], a89[1]} * T13; r2[13] -= (f32x2v){a89[2], a89[3]} * T13;
        const f32x4 a94 = *(const LAS f32x4*)(Ab + 976);
        r2[14] -= (f32x2v){a90[0], a90[1]} * T13; r2[15] -= (f32x2v){a90[2], a90[3]} * T13;
        const f32x4 a95 = *(const LAS f32x4*)(Ab + 980);
        const float t14 = r2[7][0]; const f32x2v T14 = (f32x2v){t14, t14}; Tw[1008] = f2bf(t14); Tt[14] = f2bf(t14);
        r2[7] -= (f32x2v){a91[2], a91[3]} * T14;
        const f32x4 a96 = *(const LAS f32x4*)(Ab + 1036);
        r2[8] -= (f32x2v){a92[0], a92[1]} * T14; r2[9] -= (f32x2v){a92[2], a92[3]} * T14;
        const f32x4 a97 = *(const LAS f32x4*)(Ab + 1040);
        r2[10] -= (f32x2v){a93[0], a93[1]} * T14; r2[11] -= (f32x2v){a93[2], a93[3]} * T14;
        const f32x4 a98 = *(const LAS f32x4*)(Ab + 1044);
        r2[12] -= (f32x2v){a94[0], a94[1]} * T14; r2[13] -= (f32x2v){a94[2], a94[3]} * T14;
        const f32x4 a99 = *(const LAS f32x4*)(Ab + 1048);
        r2[14] -= (f32x2v){a95[0], a95[1]} * T14; r2[15] -= (f32x2v){a95[2], a95[3]} * T14;
        const f32x4 a100 = *(const LAS f32x4*)(Ab + 1104);
        const float t15 = r2[7][1]; const f32x2v T15 = (f32x2v){t15, t15}; Tw[1080] = f2bf(t15); Tt[15] = f2bf(t15);
        r2[8] -= (f32x2v){a96[0], a96[1]} * T15; r2[9] -= (f32x2v){a96[2], a96[3]} * T15;
        const f32x4 a101 = *(const LAS f32x4*)(Ab + 1108);
        r2[10] -= (f32x2v){a97[0], a97[1]} * T15; r2[11] -= (f32x2v){a97[2], a97[3]} * T15;
        const f32x4 a102 = *(const LAS f32x4*)(Ab + 1112);
        r2[12] -= (f32x2v){a98[0], a98[1]} * T15; r2[13] -= (f32x2v){a98[2], a98[3]} * T15;
        const f32x4 a103 = *(const LAS f32x4*)(Ab + 1116);
        r2[14] -= (f32x2v){a99[0], a99[1]} * T15; r2[15] -= (f32x2v){a99[2], a99[3]} * T15;
        const f32x4 a104 = *(const LAS f32x4*)(Ab + 1172);
        const float t16 = r2[8][0]; const f32x2v T16 = (f32x2v){t16, t16}; Tw[1152] = f2bf(t16); Tt[16] = f2bf(t16);
        r2[8] -= (f32x2v){a100[0], a100[1]} * T16; r2[9] -= (f32x2v){a100[2], a100[3]} * T16;
        const f32x4 a105 = *(const LAS f32x4*)(Ab + 1176);
        r2[10] -= (f32x2v){a101[0], a101[1]} * T16; r2[11] -= (f32x2v){a101[2], a101[3]} * T16;
        const f32x4 a106 = *(const LAS f32x4*)(Ab + 1180);
        r2[12] -= (f32x2v){a102[0], a102[1]} * T16; r2[13] -= (f32x2v){a102[2], a102[3]} * T16;
        const f32x4 a107 = *(const LAS f32x4*)(Ab + 1184);
        r2[14] -= (f32x2v){a103[0], a103[1]} * T16; r2[15] -= (f32x2v){a103[2], a103[3]} * T16;
        const f32x4 a108 = *(const LAS f32x4*)(Ab + 1240);
        const float t17 = r2[8][1]; const f32x2v T17 = (f32x2v){t17, t17}; Tw[1224] = f2bf(t17); Tt[17] = f2bf(t17);
        r2[9] -= (f32x2v){a104[2], a104[3]} * T17;
        const f32x4 a109 = *(const LAS f32x4*)(Ab + 1244);
        r2[10] -= (f32x2v){a105[0], a105[1]} * T17; r2[11] -= (f32x2v){a105[2], a105[3]} * T17;
        const f32x4 a110 = *(const LAS f32x4*)(Ab + 1248);
        r2[12] -= (f32x2v){a106[0], a106[1]} * T17; r2[13] -= (f32x2v){a106[2], a106[3]} * T17;
        const f32x4 a111 = *(const LAS f32x4*)(Ab + 1252);
        r2[14] -= (f32x2v){a107[0], a107[1]} * T17; r2[15] -= (f32x2v){a107[2], a107[3]} * T17;
        const f32x4 a112 = *(const LAS f32x4*)(Ab + 1312);
        const float t18 = r2[9][0]; const f32x2v T18 = (f32x2v){t18, t18}; Tw[1296] = f2bf(t18); Tt[18] = f2bf(t18);
        r2[9] -= (f32x2v){a108[2], a108[3]} * T18;
        const f32x4 a113 = *(const LAS f32x4*)(Ab + 1316);
        r2[10] -= (f32x2v){a109[0], a109[1]} * T18; r2[11] -= (f32x2v){a109[2], a109[3]} * T18;
        const f32x4 a114 = *(const LAS f32x4*)(Ab + 1320);
        r2[12] -= (f32x2v){a110[0], a110[1]} * T18; r2[13] -= (f32x2v){a110[2], a110[3]} * T18;
        const f32x4 a115 = *(const LAS f32x4*)(Ab + 1380);
        r2[14] -= (f32x2v){a111[0], a111[1]} * T18; r2[15] -= (f32x2v){a111[2], a111[3]} * T18;
        const f32x4 a116 = *(const LAS f32x4*)(Ab + 1384);
        const float t19 = r2[9][1]; const f32x2v T19 = (f32x2v){t19, t19}; Tw[1368] = f2bf(t19); Tt[19] = f2bf(t19);
        r2[10] -= (f32x2v){a112[0], a112[1]} * T19; r2[11] -= (f32x2v){a112[2], a112[3]} * T19;
        const f32x4 a117 = *(const LAS f32x4*)(Ab + 1388);
        r2[12] -= (f32x2v){a113[0], a113[1]} * T19; r2[13] -= (f32x2v){a113[2], a113[3]} * T19;
        const f32x4 a118 = *(const LAS f32x4*)(Ab + 1448);
        r2[14] -= (f32x2v){a114[0], a114[1]} * T19; r2[15] -= (f32x2v){a114[2], a114[3]} * T19;
        const f32x4 a119 = *(const LAS f32x4*)(Ab + 1452);
        const float t20 = r2[10][0]; const f32x2v T20 = (f32x2v){t20, t20}; Tw[1440] = f2bf(t20); Tt[20] = f2bf(t20);
        r2[10] -= (f32x2v){a115[0], a115[1]} * T20; r2[11] -= (f32x2v){a115[2], a115[3]} * T20;
        const f32x4 a120 = *(const LAS f32x4*)(Ab + 1456);
        r2[12] -= (f32x2v){a116[0], a116[1]} * T20; r2[13] -= (f32x2v){a116[2], a116[3]} * T20;
        const f32x4 a121 = *(const LAS f32x4*)(Ab + 1516);
        r2[14] -= (f32x2v){a117[0], a117[1]} * T20; r2[15] -= (f32x2v){a117[2], a117[3]} * T20;
        const f32x4 a122 = *(const LAS f32x4*)(Ab + 1520);
        const float t21 = r2[10][1]; const f32x2v T21 = (f32x2v){t21, t21}; Tw[1512] = f2bf(t21); Tt[21] = f2bf(t21);
        r2[11] -= (f32x2v){a118[2], a118[3]} * T21;
        const f32x4 a123 = *(const LAS f32x4*)(Ab + 1524);
        r2[12] -= (f32x2v){a119[0], a119[1]} * T21; r2[13] -= (f32x2v){a119[2], a119[3]} * T21;
        const f32x4 a124 = *(const LAS f32x4*)(Ab + 1588);
        r2[14] -= (f32x2v){a120[0], a120[1]} * T21; r2[15] -= (f32x2v){a120[2], a120[3]} * T21;
        const f32x4 a125 = *(const LAS f32x4*)(Ab + 1592);
        const float t22 = r2[11][0]; const f32x2v T22 = (f32x2v){t22, t22}; Tw[1584] = f2bf(t22); Tt[22] = f2bf(t22);
        r2[11] -= (f32x2v){a121[2], a121[3]} * T22;
        const f32x4 a126 = *(const LAS f32x4*)(Ab + 1656);
        r2[12] -= (f32x2v){a122[0], a122[1]} * T22; r2[13] -= (f32x2v){a122[2], a122[3]} * T22;
        const f32x4 a127 = *(const LAS f32x4*)(Ab + 1660);
        r2[14] -= (f32x2v){a123[0], a123[1]} * T22; r2[15] -= (f32x2v){a123[2], a123[3]} * T22;
        const f32x4 a128 = *(const LAS f32x4*)(Ab + 1724);
        const float t23 = r2[11][1]; const f32x2v T23 = (f32x2v){t23, t23}; Tw[1656] = f2bf(t23); Tt[23] = f2bf(t23);
        r2[12] -= (f32x2v){a124[0], a124[1]} * T23; r2[13] -= (f32x2v){a124[2], a124[3]} * T23;
        const f32x4 a129 = *(const LAS f32x4*)(Ab + 1728);
        r2[14] -= (f32x2v){a125[0], a125[1]} * T23; r2[15] -= (f32x2v){a125[2], a125[3]} * T23;
        const f32x4 a130 = *(const LAS f32x4*)(Ab + 1792);
        const float t24 = r2[12][0]; const f32x2v T24 = (f32x2v){t24, t24}; Tw[1728] = f2bf(t24); Tt[24] = f2bf(t24);
        r2[12] -= (f32x2v){a126[0], a126[1]} * T24; r2[13] -= (f32x2v){a126[2], a126[3]} * T24;
        const f32x4 a131 = *(const LAS f32x4*)(Ab + 1796);
        r2[14] -= (f32x2v){a127[0], a127[1]} * T24; r2[15] -= (f32x2v){a127[2], a127[3]} * T24;
        const f32x4 a132 = *(const LAS f32x4*)(Ab + 1864);
        const float t25 = r2[12][1]; const f32x2v T25 = (f32x2v){t25, t25}; Tw[1800] = f2bf(t25); Tt[25] = f2bf(t25);
        r2[13] -= (f32x2v){a128[2], a128[3]} * T25;
        const f32x4 a133 = *(const LAS f32x4*)(Ab + 1932);
        r2[14] -= (f32x2v){a129[0], a129[1]} * T25; r2[15] -= (f32x2v){a129[2], a129[3]} * T25;
        const f32x4 a134 = *(const LAS f32x4*)(Ab + 2000);
        const float t26 = r2[13][0]; const f32x2v T26 = (f32x2v){t26, t26}; Tw[1872] = f2bf(t26); Tt[26] = f2bf(t26);
        r2[13] -= (f32x2v){a130[2], a130[3]} * T26;
        const f32x4 a135 = *(const LAS f32x4*)(Ab + 2068);
        r2[14] -= (f32x2v){a131[0], a131[1]} * T26; r2[15] -= (f32x2v){a131[2], a131[3]} * T26;
        const float t27 = r2[13][1]; const f32x2v T27 = (f32x2v){t27, t27}; Tw[1944] = f2bf(t27); Tt[27] = f2bf(t27);
        r2[14] -= (f32x2v){a132[0], a132[1]} * T27; r2[15] -= (f32x2v){a132[2], a132[3]} * T27;
        const float t28 = r2[14][0]; const f32x2v T28 = (f32x2v){t28, t28}; Tw[2016] = f2bf(t28); Tt[28] = f2bf(t28);
        r2[14] -= (f32x2v){a133[0], a133[1]} * T28; r2[15] -= (f32x2v){a133[2], a133[3]} * T28;
        const float t29 = r2[14][1]; const f32x2v T29 = (f32x2v){t29, t29}; Tw[2088] = f2bf(t29); Tt[29] = f2bf(t29);
        r2[15] -= (f32x2v){a134[2], a134[3]} * T29;
        const float t30 = r2[15][0]; const f32x2v T30 = (f32x2v){t30, t30}; Tw[2160] = f2bf(t30); Tt[30] = f2bf(t30);
        r2[15] -= (f32x2v){a135[2], a135[3]} * T30;
        Tw[2232] = f2bf(r2[15][1]); Tt[31] = f2bf(r2[15][1]);
    } else if (wid == 2) {
        *(LAS u32x4*)(Tb + (lane >> 1) * 72 + 32 + (lane & 1) * 16) = (u32x4){0u, 0u, 0u, 0u}; *(LAS u32x4*)(Tb + (lane >> 1) * 72 + 32 + (lane & 1) * 16 + 8) = (u32x4){0u, 0u, 0u, 0u};
    }
    __syncthreads();
    if (wid < 4) {
        const int mt = wid >> 1, nt = wid & 1; const f32x4 acc = tile_mm(A10b, 40, mt, TT, 40, nt, 1, fr, fq);
        u32x2 w; w.x = cvt_pk(acc[0], acc[1]); w.y = cvt_pk(acc[2], acc[3]); *(LAS u32x2*)(PT + (16 * nt + fr) * 40 + 16 * mt + 4 * fq) = w;
    }
    __syncthreads();
    if (wid < 4) {
        const int mt = wid >> 1, nt = wid & 1; const f32x4 acc = tile_mm(Tb + 32 * 72 + 32, 72, mt, PT, 40, nt, 1, fr, fq);
#pragma unroll
        for (int e = 0; e < 4; ++e) Tb[(32 + 16 * mt + 4 * fq + e) * 72 + 16 * nt + fr] = f2bf(-acc[e]);
    }
    __syncthreads();
#pragma unroll 2
    for (int r = 0; r < 8; ++r) {
        const int job = wid + 8 * r, kind = job >> 5, tile = job & 31, mt = tile >> 3, nt = tile & 7;
        const f32x4 acc = tile_mm<false, true>(Tb, 72, mt, kind ? KbT : VbT, 72, nt, 2, fr, fq);
        u32x2 w; w.x = cvt_pk(acc[0], acc[1]); w.y = cvt_pk(acc[2], acc[3]);
        { const int ch = 16 * nt + fr; *(LAS u32x2*)((kind ? WT : UT) + ch * 72 + 8 * ((2 * mt + (fq >> 1)) ^ ((ch >> 3) & 7)) + 4 * (fq & 1)) = w; }
    }
    __syncthreads();
    bf16_t* GM = (bf16_t*)(p.ws + WS_GM) + (size_t)unit * 16384; bf16_t* GN = (bf16_t*)(p.ws + WS_GN) + (size_t)unit * 16384;
    bf16_t* GQ = (bf16_t*)(p.ws + WS_GQ) + (size_t)unit * 8192; bf16_t* GO = (bf16_t*)(p.ws + WS_GO) + (size_t)unit * 8192;
#pragma unroll 1
    for (int r = 0; r < 12; ++r) {
        const int job = wid + 8 * r;
        if (job < 32) { const int a2 = job >> 3, mt = job & 7;
            const f32x4 c0 = tile_mm<true, true>(WT, 72, 2 * a2, KdT, 72, mt, 2, fr, fq), c1 = tile_mm<true, true>(WT, 72, 2 * a2 + 1, KdT, 72, mt, 2, fr, fq);
            u32x4 w; w.x = cvt_pk(-c0[0], -c0[1]); w.y = cvt_pk(-c0[2], -c0[3]); w.z = cvt_pk(-c1[0], -c1[1]); w.w = cvt_pk(-c1[2], -c1[3]);
            *(u32x4*)(GM + ((mt * 4 + a2) * 64 + lane) * 8) = w;
        } else if (job < 64) { const int j = job - 32, mt2 = j >> 3, nt = j & 7;
            const f32x4 c0 = tile_mm<true, true>(KdT, 72, 2 * mt2, UT, 72, nt, 2, fr, fq), c1 = tile_mm<true, true>(KdT, 72, 2 * mt2 + 1, UT, 72, nt, 2, fr, fq);
            u32x4 w; w.x = cvt_pk(c0[0], c0[1]); w.y = cvt_pk(c0[2], c0[3]); w.z = cvt_pk(c1[0], c1[1]); w.w = cvt_pk(c1[2], c1[3]);
            *(u32x4*)(GN + ((nt * 64 + lane) * 8 + 2 * mt2) * 4) = w;
        } else if (job < 80) { const int j = job - 64, a2 = j >> 2, it = j & 3;
            const f32x4 c0 = tile_mm<true, false>(WT, 72, 2 * a2, QK, 72, it, 2, fr, fq), c1 = tile_mm<true, false>(WT, 72, 2 * a2 + 1, QK, 72, it, 2, fr, fq);
            const int i = 16 * it + fr; const float eg = __expf(gcs[i]);
            const u32x2 q0 = *(const LAS u32x2*)(Qs + i * 136 + 32 * a2 + 4 * fq), q1 = *(const LAS u32x2*)(Qs + i * 136 + 32 * a2 + 16 + 4 * fq);
            u32x4 w; w.x = cvt_pk(bflo(q0.x) * eg - c0[0], bfhi(q0.x) * eg - c0[1]); w.y = cvt_pk(bflo(q0.y) * eg - c0[2], bfhi(q0.y) * eg - c0[3]);
            w.z = cvt_pk(bflo(q1.x) * eg - c1[0], bfhi(q1.x) * eg - c1[1]); w.w = cvt_pk(bflo(q1.y) * eg - c1[2], bfhi(q1.y) * eg - c1[3]);
            *(u32x4*)(GQ + ((it * 4 + a2) * 64 + lane) * 8) = w;
        } else { const int j = job - 80, mt2 = j >> 3, nt = j & 7;
            const f32x4 c0 = tile_mm<false, true>(QK, 72, 2 * mt2, UT, 72, nt, 2, fr, fq), c1 = tile_mm<false, true>(QK, 72, 2 * mt2 + 1, UT, 72, nt, 2, fr, fq);
            u32x4 w; w.x = cvt_pk(c0[0], c0[1]); w.y = cvt_pk(c0[2], c0[3]); w.z = cvt_pk(c1[0], c1[1]); w.w = cvt_pk(c1[2], c1[3]);
            *(u32x4*)(GO + ((nt * 64 + lane) * 4 + 2 * mt2) * 4) = w;
        }
    }
    if (tid == 0) ((float*)(p.ws + WS_CTL + CTL_GLAST))[unit] = __expf(gclast);
    __syncthreads();
}

__device__ __forceinline__ void gdn_scan(const Params& p, LAS unsigned char* lds, int sb) {
    const int tid = threadIdx.x, lane = tid & 63, wid = tid >> 6, fr = lane & 15, fq = lane >> 4;
    const int bh = sb / (8 / CW), sp = sb % (8 / CW), unit0 = bh * 128, sl = sp * CW + wid;
    const u32x4* GMb = (const u32x4*)((const bf16_t*)(p.ws + WS_GM) + (size_t)unit0 * 16384);
    const u32x4* GQb = (const u32x4*)((const bf16_t*)(p.ws + WS_GQ) + (size_t)unit0 * 8192);
    const bf16_t* GNb = (const bf16_t*)(p.ws + WS_GN) + (size_t)unit0 * 16384;
    bf16_t* GOb = (bf16_t*)(p.ws + WS_GO) + (size_t)unit0 * 8192;
    const float* glast = (const float*)(p.ws + WS_CTL + CTL_GLAST) + unit0;
    const bool loader = (wid >= CW && wid < CW + 4);
#define SCAN_DMA(cc) do { _Pragma("unroll") for (int k = 0; k < 8; ++k) { const int inst = (wid - CW) * 8 + k; \
        __builtin_amdgcn_global_load_lds((const unsigned*)((const char*)(GMb + (size_t)(cc) * 2048) + inst * 1024 + lane * 16), (LAS unsigned*)(lds + ((cc) & 3) * 32768 + inst * 1024), 16, 0, 0); } } while (0)
#define SCAN_LOADN(dn, cc) do { const bf16_t* np_ = GNb + (size_t)((cc) < 128 ? (cc) : 127) * 16384 + (size_t)(sl * 64 + lane) * 32; \
        asm volatile("global_load_dwordx4 %0, %4, off\n\tglobal_load_dwordx4 %1, %4, off offset:16\n\tglobal_load_dwordx4 %2, %4, off offset:32\n\tglobal_load_dwordx4 %3, %4, off offset:48" \
            : "=&v"(dn[0]), "=&v"(dn[1]), "=&v"(dn[2]), "=&v"(dn[3]) : "v"(np_) : "memory"); } while (0)
#define SCAN_WAITN(dn, N) asm volatile("s_waitcnt vmcnt(" #N ")" : "+v"(dn[0]), "+v"(dn[1]), "+v"(dn[2]), "+v"(dn[3]) :: "memory")
#define SCAN_STEP(c, nn, RELOAD) do { \
        SCAN_WAITN(nn, 8); \
        const float gl = __shfl(((c) < 64) ? glr0 : glr1, (c) & 63); bf16x8 Sb[4]; \
        bf16_t* scp = (bf16_t*)GNb + (size_t)(c) * 16384 + (size_t)sl * 2048 + lane * 8; \
        _Pragma("unroll") for (int ks = 0; ks < 4; ++ks) { u32x4 w; w.x = cvt_pk(S[2 * ks][0], S[2 * ks][1]); w.y = cvt_pk(S[2 * ks][2], S[2 * ks][3]); \
            w.z = cvt_pk(S[2 * ks + 1][0], S[2 * ks + 1][1]); w.w = cvt_pk(S[2 * ks + 1][2], S[2 * ks + 1][3]); Sb[ks] = __builtin_bit_cast(bf16x8, w); } \
        const LAS unsigned char* slot = lds + ((c) & 3) * 32768 + lane * 16; \
        bf16x8 fa[2][2][4]; \
        _Pragma("unroll") for (int ks = 0; ks < 4; ++ks) { fa[0][0][ks] = *(const LAS bf16x8*)(slot + (0 * 4 + ks) * 1024); fa[0][1][ks] = *(const LAS bf16x8*)(slot + (1 * 4 + ks) * 1024); } \
        _Pragma("unroll") for (int mt = 0; mt < 8; ++mt) { const unsigned w0 = nn[mt >> 1][(mt & 1) * 2], w1 = nn[mt >> 1][(mt & 1) * 2 + 1]; \
            S[mt] = S[mt] * gl + (f32x4){bflo(w0), bfhi(w0), bflo(w1), bfhi(w1)}; } \
        _Pragma("unroll") for (int ks = 0; ks < 4; ++ks) *(u32x4*)(scp + ks * 512) = __builtin_bit_cast(u32x4, Sb[ks]);     \
        RELOAD; \
        _Pragma("unroll") for (int pr = 0; pr < 4; ++pr) { \
            if (pr < 3) { _Pragma("unroll") for (int ks = 0; ks < 4; ++ks) { fa[(pr + 1) & 1][0][ks] = *(const LAS bf16x8*)(slot + ((2 * pr + 2) * 4 + ks) * 1024); fa[(pr + 1) & 1][1][ks] = *(const LAS bf16x8*)(slot + ((2 * pr + 3) * 4 + ks) * 1024); } } \
            _Pragma("unroll") for (int ks = 0; ks < 4; ++ks) { S[2 * pr] = mfma16(fa[pr & 1][0][ks], Sb[ks], S[2 * pr]); S[2 * pr + 1] = mfma16(fa[pr & 1][1][ks], Sb[ks], S[2 * pr + 1]); } } \
        } while (0)
    if (loader) { SCAN_DMA(0); SCAN_DMA(1); SCAN_DMA(2); asm volatile("s_waitcnt vmcnt(0)" ::: "memory"); }
    f32x4 S[8];
#pragma unroll
    for (int mt = 0; mt < 8; ++mt) S[mt] = (f32x4){0.f, 0.f, 0.f, 0.f};
    float glr0 = glast[lane], glr1 = glast[64 + lane];
    asm volatile("" : "+v"(glr0), "+v"(glr1));
    u32x4 nnA[4], nnB[4];
    if (wid < CW) { SCAN_LOADN(nnA, 0); SCAN_LOADN(nnB, 1); SCAN_WAITN(nnA, 0); SCAN_WAITN(nnB, 0); }
    asm volatile("s_waitcnt lgkmcnt(0)" ::: "memory"); __builtin_amdgcn_s_barrier(); asm volatile("" ::: "memory");
#pragma unroll 1
    for (int c = 0; c < 128; c += 2) {
        if (loader) { if (c + 3 < 128) { SCAN_DMA(c + 3); asm volatile("s_waitcnt vmcnt(16)" ::: "memory"); } else asm volatile("s_waitcnt vmcnt(0)" ::: "memory"); }
        else if (wid < CW) { SCAN_STEP(c, nnA, SCAN_LOADN(nnA, c + 2)); }
        asm volatile("s_waitcnt lgkmcnt(0)" ::: "memory"); __builtin_amdgcn_s_barrier(); asm volatile("" ::: "memory");
        if (loader) { if (c + 4 < 128) { SCAN_DMA(c + 4); asm volatile("s_waitcnt vmcnt(16)" ::: "memory"); } else asm volatile("s_waitcnt vmcnt(0)" ::: "memory"); }
        else if (wid < CW) { SCAN_STEP(c + 1, nnB, SCAN_LOADN(nnB, c + 3)); }
        asm volatile("s_waitcnt lgkmcnt(0)" ::: "memory"); __builtin_amdgcn_s_barrier(); asm volatile("" ::: "memory");
    }
#undef SCAN_DMA
#undef SCAN_LOADN
#undef SCAN_WAITN
#undef SCAN_STEP
    __syncthreads();
    if (wid < CW) {
        float* go = p.out + O_GP + (size_t)bh * 16384;
#pragma unroll
        for (int mt = 0; mt < 8; ++mt)
#pragma unroll
            for (int e = 0; e < 4; ++e) go[(16 * mt + 4 * fq + e) * 128 + sl * 16 + fr] = S[mt][e];
    }
}

__device__ __forceinline__ void gdn_gate_unit(const Params& p, int unit, int lane) {
    const int fr = lane & 15, fq = lane >> 4, bh = unit >> 7, n = unit & 127, b = bh >> 2, h = bh & 3, tok0 = b * SEQ + n * 64;
    const bf16_t* GO = (const bf16_t*)(p.ws + WS_GO) + (size_t)unit * 8192;
    bf16_t* PB = (bf16_t*)(p.ws + WS_H);
    float ssq[16];
#pragma unroll
    for (int k = 0; k < 16; ++k) ssq[k] = 0.f;
    {
        bf16_t* GOw = (bf16_t*)(p.ws + WS_GO) + (size_t)unit * 8192;
        const bf16_t* GQ = (const bf16_t*)(p.ws + WS_GQ) + (size_t)unit * 8192; const bf16_t* SC = (const bf16_t*)(p.ws + WS_GN) + (size_t)unit * 16384;
        bf16x8 qa[4][4];
#pragma unroll
        for (int mt = 0; mt < 4; ++mt)
#pragma unroll
            for (int ks = 0; ks < 4; ++ks) qa[mt][ks] = *(const bf16x8*)(GQ + ((mt * 4 + ks) * 64 + lane) * 8);
#pragma unroll 2
        for (int nt = 0; nt < 8; ++nt) {
            bf16x8 sb[4];
#pragma unroll
            for (int ks = 0; ks < 4; ++ks) sb[ks] = *(const bf16x8*)(SC + nt * 2048 + (ks * 64 + lane) * 8);
            const u32x4 o0 = *(const u32x4*)(GOw + (nt * 64 + lane) * 16), o1 = *(const u32x4*)(GOw + (nt * 64 + lane) * 16 + 8);
            f32x4 acc[4];
            acc[0] = (f32x4){bflo(o0.x), bfhi(o0.x), bflo(o0.y), bfhi(o0.y)}; acc[1] = (f32x4){bflo(o0.z), bfhi(o0.z), bflo(o0.w), bfhi(o0.w)};
            acc[2] = (f32x4){bflo(o1.x), bfhi(o1.x), bflo(o1.y), bfhi(o1.y)}; acc[3] = (f32x4){bflo(o1.z), bfhi(o1.z), bflo(o1.w), bfhi(o1.w)};
#pragma unroll
            for (int ks = 0; ks < 4; ++ks)
#pragma unroll
                for (int mt = 0; mt < 4; ++mt) acc[mt] = mfma16(qa[mt][ks], sb[ks], acc[mt]);
#pragma unroll
            for (int mt = 0; mt < 4; ++mt)
#pragma unroll
                for (int e = 0; e < 4; ++e) ssq[4 * mt + e] += acc[mt][e] * acc[mt][e];
            u32x4 w0, w1;
            w0.x = cvt_pk(acc[0][0], acc[0][1]); w0.y = cvt_pk(acc[0][2], acc[0][3]); w0.z = cvt_pk(acc[1][0], acc[1][1]); w0.w = cvt_pk(acc[1][2], acc[1][3]);
            w1.x = cvt_pk(acc[2][0], acc[2][1]); w1.y = cvt_pk(acc[2][2], acc[2][3]); w1.z = cvt_pk(acc[3][0], acc[3][1]); w1.w = cvt_pk(acc[3][2], acc[3][3]);
            *(u32x4*)(GOw + (nt * 64 + lane) * 16) = w0; *(u32x4*)(GOw + (nt * 64 + lane) * 16 + 8) = w1;
        }
        asm volatile("s_waitcnt vmcnt(0)" ::: "memory");
    }
#pragma unroll
    for (int k = 0; k < 16; ++k) { float s = row16_sum(ssq[k]); ssq[k] = rsqrtf(s * (1.0f / 128.0f) + EPS); }
    const float* gn = p.in[15];
#pragma unroll 2
    for (int nt = 0; nt < 8; ++nt) {
        const int dv = 16 * nt + fr; const float g = gn[dv];
        const u32x4 a0 = *(const u32x4*)(GO + (nt * 64 + lane) * 16), a1 = *(const u32x4*)(GO + (nt * 64 + lane) * 16 + 8);
        const bf16_t* gzp = PB + (size_t)(tok0 + 4 * fq) * PW + 2304 + h * 128 + dv; bf16_t* mp = PB + (size_t)(tok0 + 4 * fq) * PW + 512 + h * 128 + dv;
#pragma unroll
        for (int k = 0; k < 16; ++k) {
            const unsigned w = (k < 8) ? a0[(k >> 1) & 3] : a1[(k >> 1) & 3]; const float o = (k & 1) ? bfhi(w) : bflo(w);
            const int to = 16 * (k >> 2) + (k & 3);
            const float gz = bf2f(gzp[(size_t)to * PW]);
            mp[(size_t)to * PW] = f2bf(o * ssq[k] * g * silu(gz));
        }
    }
}

__device__ __forceinline__ void attn_unit(const Params& p, LAS unsigned char* lds, int unit) {
    const int tid = threadIdx.x, lane = tid & 63, wid = tid >> 6, fr = lane & 15, fq = lane >> 4;
    const int b = unit >> 7, blk = (unit >> 1) & 63, kvh = unit & 1;
    LAS bf16_t* Ks = (LAS bf16_t*)lds; LAS bf16_t* Vt = (LAS bf16_t*)(lds + 36864);
    bf16_t* PB = (bf16_t*)(p.ws + WS_H);
    __syncthreads();
#pragma unroll
    for (int i = 0; i < 4; ++i) {
        const int q = tid + 512 * i, row = q >> 3, ch = q & 7, tp = blk * 128 - 128 + row;
        u32x4 kv = (u32x4){0u, 0u, 0u, 0u}, vv = (u32x4){0u, 0u, 0u, 0u};
        if (tp >= 0) { const bf16_t* base = PB + (size_t)(b * SEQ + tp) * PW; kv = *(const u32x4*)(base + 512 + kvh * 64 + ch * 8); vv = *(const u32x4*)(base + 640 + kvh * 64 + ch * 8); }
        *(LAS u32x4*)(Ks + row * 72 + ch * 8) = kv;
#pragma unroll
        for (int e = 0; e < 4; ++e) { const unsigned w = vv[e]; Vt[(ch * 8 + 2 * e) * 264 + row] = (bf16_t)(w & 0xffffu); Vt[(ch * 8 + 2 * e + 1) * 264 + row] = (bf16_t)(w >> 16); }
    }
    __syncthreads();
    const int qtok = b * SEQ + blk * 128 + 16 * wid + fr;
#pragma unroll 1
    for (int g = 0; g < 4; ++g) {
        const int h = kvh * 4 + g; const float slope = exp2f(-(float)(h + 1)), sink = p.in[11][h];
        bf16x8 qf[2];
#pragma unroll
        for (int ks = 0; ks < 2; ++ks) qf[ks] = *(const bf16x8*)(PB + (size_t)qtok * PW + h * 64 + ks * 32 + 8 * fq);
        f32x4 s[10]; float mx = sink;
#pragma unroll
        for (int j = 0; j < 10; ++j) {
            const int ct = (wid + j) < 15 ? (wid + j) : 15;
            f32x4 acc = (f32x4){0.f, 0.f, 0.f, 0.f};
#pragma unroll
            for (int ks = 0; ks < 2; ++ks) acc = mfma16(*(const LAS bf16x8*)(Ks + (16 * ct + fr) * 72 + ks * 32 + 8 * fq), qf[ks], acc);
#pragma unroll
            for (int e = 0; e < 4; ++e) {
                const int c = 16 * (wid + j) + 4 * fq + e, dist = 16 * wid + fr - c + 128;
                const bool ok = (wid + j <= 15) && dist >= 0 && dist <= 128 && (blk * 128 + c - 128 >= 0);
                const float v = ok ? acc[e] * 0.125f - slope * (float)dist : -INFINITY;
                acc[e] = v; mx = fmaxf(mx, v);
            }
            s[j] = acc;
            asm volatile("" ::: "memory");
        }
        mx = fmaxf(mx, __shfl_xor(mx, 16)); mx = fmaxf(mx, __shfl_xor(mx, 32));
        float sum = 0.f;
#pragma unroll
        for (int j = 0; j < 10; ++j)
#pragma unroll
            for (int e = 0; e < 4; ++e) { const float pv = __expf(s[j][e] - mx); s[j][e] = pv; sum += pv; }
        sum += __shfl_xor(sum, 16); sum += __shfl_xor(sum, 32);
        sum += __expf(sink - mx);
        const float inv = 1.0f / sum;
        bf16x8 pb[5];
#pragma unroll
        for (int kk = 0; kk < 5; ++kk) { u32x4 w; w.x = cvt_pk(s[2 * kk][0] * inv, s[2 * kk][1] * inv); w.y = cvt_pk(s[2 * kk][2] * inv, s[2 * kk][3] * inv);
            w.z = cvt_pk(s[2 * kk + 1][0] * inv, s[2 * kk + 1][1] * inv); w.w = cvt_pk(s[2 * kk + 1][2] * inv, s[2 * kk + 1][3] * inv); pb[kk] = __builtin_bit_cast(bf16x8, w); }
#pragma unroll
        for (int dt = 0; dt < 4; ++dt) {
            f32x4 acc = (f32x4){0.f, 0.f, 0.f, 0.f};
#pragma unroll
            for (int kk = 0; kk < 5; ++kk) {
                const int c0 = (wid + 2 * kk) < 15 ? (wid + 2 * kk) : 15, c1 = (wid + 2 * kk + 1) < 15 ? (wid + 2 * kk + 1) : 15;
                const u32x2 lo = *(const LAS u32x2*)(Vt + (16 * dt + fr) * 264 + 16 * c0 + 4 * fq), hi = *(const LAS u32x2*)(Vt + (16 * dt + fr) * 264 + 16 * c1 + 4 * fq);
                const u32x4 a = (u32x4){lo.x, lo.y, hi.x, hi.y};
                acc = mfma16(__builtin_bit_cast(bf16x8, a), pb[kk], acc);
            }
            u32x2 w; w.x = cvt_pk(acc[0], acc[1]); w.y = cvt_pk(acc[2], acc[3]);
            *(u32x2*)(PB + (size_t)qtok * PW + h * 64 + 16 * dt + 4 * fq) = w;
            asm volatile("" ::: "memory");
        }
    }
}

__device__ __forceinline__ void sattn_unit(const Params& p, int s, int h, int lane) {
    const int kvh = h >> 2; const bool wr = (h & 3) == 0;
    bf16_t* PB = (bf16_t*)(p.ws + WS_H) + (size_t)(MPR + s) * PW;
    const float* ck = p.in[2] + (size_t)s * 128 * 128 + kvh * 64 + lane; const float* cv = p.in[3] + (size_t)s * 128 * 128 + kvh * 64 + lane;
    float* nk = p.out + O_KS + (size_t)s * 128 * 128 + kvh * 64 + lane; float* nv = p.out + O_VS + (size_t)s * 128 * 128 + kvh * 64 + lane;
    const float q = bf2f(PB[h * 64 + lane]) * 0.125f, slope = exp2f(-(float)(h + 1)), sink = p.in[11][h];
    const float knew = bf2f(PB[512 + kvh * 64 + lane]), vnew = bf2f(PB[640 + kvh * 64 + lane]);
    float sc[3];
#pragma unroll
    for (int t = 0; t < 2; ++t) {
#pragma unroll 8
        for (int jj = 0; jj < 64; ++jj) {
            const int j = t * 64 + jj; const float kval = ck[(size_t)j * 128];
            if (wr && j >= 1) nk[(size_t)(j - 1) * 128] = kval;
            const float d = wave_sum(q * kval) - slope * (float)(128 - j); if (lane == jj) sc[t] = d;
        }
    }
    if (wr) nk[(size_t)127 * 128] = knew;
    sc[2] = wave_sum(q * knew);
    const float mx = fmaxf(fmaxf(wave_max(fmaxf(sc[0], sc[1])), sc[2]), sink);
    const float p0 = __expf(sc[0] - mx), p1 = __expf(sc[1] - mx), p2 = __expf(sc[2] - mx);
    const float inv = 1.0f / (wave_sum(p0 + p1) + p2 + __expf(sink - mx));
    float o = p2 * vnew;
#pragma unroll 8
    for (int jj = 0; jj < 64; ++jj) { const float vval = cv[(size_t)jj * 128]; if (wr && jj >= 1) nv[(size_t)(jj - 1) * 128] = vval; o += __shfl(p0, jj) * vval; }
#pragma unroll 8
    for (int jj = 0; jj < 64; ++jj) { const float vval = cv[(size_t)(64 + jj) * 128]; if (wr) nv[(size_t)(63 + jj) * 128] = vval; o += __shfl(p1, jj) * vval; }
    if (wr) nv[(size_t)127 * 128] = vnew;
    asm volatile("" ::: "memory");
    PB[h * 64 + lane] = f2bf(o * inv);
}

__device__ __forceinline__ void sgdn_unit(const Params& p, LAS unsigned char* lds, int s) {
    const int tid = threadIdx.x, wid = tid >> 6, h = tid >> 7, dv = tid & 127;
    LAS float* qs = (LAS float*)lds; LAS float* ks = qs + 512; LAS float* red = ks + 512;
    bf16_t* PB = (bf16_t*)(p.ws + WS_H) + (size_t)(MPR + s) * PW; const float* GBA = (const float*)(p.ws + WS_GBA) + (size_t)(MPR + s) * 8;
    const float* cw = p.in[12]; const float* hc = p.in[4] + (size_t)s * 3 * CONVC; float* nc = p.out + O_CS + (size_t)s * 3 * CONVC;
    __syncthreads();
    float val[3];
#pragma unroll
    for (int i = 0; i < 3; ++i) {
        const int c = i * 512 + tid; const float x3 = bf2f(PB[768 + c]), h0 = hc[c], h1 = hc[CONVC + c], h2 = hc[2 * CONVC + c];
        val[i] = silu(cw[c] * h0 + cw[CONVC + c] * h1 + cw[2 * CONVC + c] * h2 + cw[3 * CONVC + c] * x3);
        nc[c] = h1; nc[CONVC + c] = h2; nc[2 * CONVC + c] = x3;
    }
    const float sq = wave_sum(val[0] * val[0]), sk = wave_sum(val[1] * val[1]);
    if ((tid & 63) == 0) { red[wid] = sq; red[8 + wid] = sk; }
    __syncthreads();
    const float ssq = red[2 * h] + red[2 * h + 1], ssk = red[8 + 2 * h] + red[8 + 2 * h + 1];
    qs[tid] = val[0] * rsqrtf(ssq + EPS) * 0.08838834764831845f; ks[tid] = val[1] * rsqrtf(ssk + EPS);
    __syncthreads();
    const float beta = 1.0f / (1.0f + __expf(-GBA[h]));
    const float x = GBA[4 + h] + p.in[14][h]; const float sp = x > 20.f ? x : log1pf(__expf(x));
    const float eg = __expf(-__expf(p.in[13][h]) * sp);
    const float* S0 = p.in[5] + ((size_t)(s * 4 + h) * 128) * 128 + dv; float* S1 = p.out + O_GS + ((size_t)(s * 4 + h) * 128) * 128 + dv;
    float kS = 0.f;
#pragma unroll 1
    for (int hf = 0; hf < 4; ++hf) { float sv[32];
#pragma unroll
        for (int dk = 0; dk < 32; ++dk) sv[dk] = S0[(size_t)(hf * 32 + dk) * 128];
#pragma unroll
        for (int dk = 0; dk < 32; ++dk) kS += ks[h * 128 + hf * 32 + dk] * sv[dk]; }
    const float delta = beta * (val[2] - eg * kS);
    float o = 0.f;
#pragma unroll 1
    for (int hf = 0; hf < 4; ++hf) { float sv[32];
#pragma unroll
        for (int dk = 0; dk < 32; ++dk) sv[dk] = S0[(size_t)(hf * 32 + dk) * 128];
#pragma unroll
        for (int dk = 0; dk < 32; ++dk) { const float nvv = eg * sv[dk] + ks[h * 128 + hf * 32 + dk] * delta; S1[(size_t)(hf * 32 + dk) * 128] = nvv; o += qs[h * 128 + hf * 32 + dk] * nvv; } }
    const float so = wave_sum(o * o);
    if ((tid & 63) == 0) red[16 + wid] = so;
    __syncthreads();
    const float tot = red[16 + 2 * h] + red[16 + 2 * h + 1];
    const float gz = bf2f(PB[2304 + tid]);
    PB[512 + tid] = f2bf(o * rsqrtf(tot * (1.0f / 128.0f) + EPS) * p.in[15][dv] * silu(gz));
}

__device__ __forceinline__ void late_weight_items(const Params& p, LAS unsigned char* lds, int gw, int NGW) {
    const int lane = threadIdx.x & 63, wid = threadIdx.x >> 6;
    LAS float* scr = (LAS float*)(lds + wid * 16384);
    bf16_t* WOUTMIX = (bf16_t*)(p.ws + WS_WOUTMIX); bf16_t* W2IN = (bf16_t*)(p.ws + WS_W2IN); bf16_t* W2OUT = (bf16_t*)(p.ws + WS_W2OUT);
    constexpr int I_FIN = 16 * 176, I_FOUT = 44 * 32, I_OUTMIX = 16 * 32;
    for (int it = gw; it < I_FIN + I_FOUT + I_OUTMIX; it += NGW) {
        int r = it;
        if (r < I_OUTMIX) { const int kb = r / 32, nb = r % 32; transpose_item(p.in[16], DM, DM, WOUTMIX, kb * 64, nb * 32, nb * 32, nullptr, scr, lane); continue; } r -= I_OUTMIX;
        if (r < I_FIN) { const int kb = r / 176, nb = r % 176; transpose_item(p.in[18], DM, 2 * DFF, W2IN, kb * 64, nb * 32, map_ffin_row(nb * 32), p.in[17], scr, lane); continue; } r -= I_FIN;
        { const int kb = r / 32, nb = r % 32; transpose_item(p.in[19], DFF, DM, W2OUT, kb * 64, nb * 32, nb * 32, nullptr, scr, lane); }
    }
}
#define XB_TMO      128
#define XB_XCNT(j)  (256  + 64 * (j))
#define XB_XSUB(j)  (1280 + 64 * (j))
#define XB_XGEN(j)  (2304 + 64 * (j))
#define XB_TOP      3328
#define XB_TOPGEN   3392
#define XCD_BAR_WORDS 3456
#define XB_SPIN_CAP (1u << 18)

__device__ __forceinline__ unsigned xb_ld(unsigned* p)              { return __hip_atomic_load(p, __ATOMIC_RELAXED, __HIP_MEMORY_SCOPE_AGENT); }
__device__ __forceinline__ unsigned xb_add(unsigned* p, unsigned v) { return __hip_atomic_fetch_add(p, v, __ATOMIC_RELAXED, __HIP_MEMORY_SCOPE_AGENT); }
__device__ __forceinline__ unsigned xb_xcc_id() { return (unsigned)__builtin_amdgcn_s_getreg((3 << 11) | 20) & 0xFu; }
#define XB_SPIN(cond, bar) do { unsigned _sp = 0; while (cond) { __builtin_amdgcn_s_sleep(1); \
    if ((++_sp & 255u) == 0u) { if (xb_ld(&(bar)[XB_TMO])) break; if (_sp > XB_SPIN_CAP) { atomicAdd(&(bar)[XB_TMO], 1u); break; } } } } while (0)

struct XcdBarrier {
    unsigned* bar; unsigned x;
    volatile LAS unsigned* st;
};

__device__ __forceinline__ XcdBarrier xcd_barrier_post(unsigned* bar, volatile LAS unsigned* st) {
    XcdBarrier b; b.bar = bar; b.x = xb_xcc_id(); b.st = st;
    if (threadIdx.x == 0) (void)xb_add(&bar[XB_XCNT(b.x)], 1u);
    return b;
}
__device__ __forceinline__ void xcd_barrier_complete(unsigned* bar, unsigned x, unsigned& nloc, unsigned& nx) {
    const unsigned G = gridDim.x * gridDim.y * gridDim.z;
    unsigned sum, cnt, mine, sp = 0u;
    for (;;) {
        sum = 0u; cnt = 0u; mine = 0u;
#pragma unroll
        for (unsigned j = 0; j < 16; ++j) { const unsigned c = xb_ld(&bar[XB_XCNT(j)]); sum += c; cnt += (c > 0u) ? 1u : 0u; mine = (j == x) ? c : mine; }
        if (sum == G) break;
        __builtin_amdgcn_s_sleep(1);
        if ((++sp & 255u) == 0u) { if (xb_ld(&bar[XB_TMO])) break; if (sp > XB_SPIN_CAP) { atomicAdd(&bar[XB_TMO], 1u); break; } }
    }
    nloc = mine > 0u ? mine : 1u; nx = cnt > 0u ? cnt : 1u;
}

__device__ __forceinline__ void xcd_barrier(const XcdBarrier& b) {
    asm volatile("s_waitcnt vmcnt(0)" ::: "memory");
    __syncthreads();
    if (threadIdx.x == 0) {
        unsigned* bar = b.bar;
        __builtin_amdgcn_s_waitcnt(0);
        unsigned nloc = b.st[0], nx = b.st[1];
        if (nloc == 0u) { xcd_barrier_complete(bar, b.x, nloc, nx); b.st[0] = nloc; b.st[1] = nx; }
        const unsigned old = xb_add(&bar[XB_XSUB(b.x)], 1u);
        const unsigned gen = old / nloc;
        if (old + 1u == (gen + 1u) * nloc) {
            __builtin_amdgcn_fence(__ATOMIC_RELEASE, "agent");
            asm volatile("s_waitcnt vmcnt(0)" ::: "memory");
            const unsigned og = xb_add(&bar[XB_TOP], 1u);
            const unsigned tg = og / nx;
            if (og + 1u == (tg + 1u) * nx) xb_add(&bar[XB_TOPGEN], 1u);
            else XB_SPIN(xb_ld(&bar[XB_TOPGEN]) == tg, bar);
            __builtin_amdgcn_fence(__ATOMIC_ACQUIRE, "agent");
            xb_add(&bar[XB_XGEN(b.x)], 1u);
            asm volatile("s_waitcnt vmcnt(0)" ::: "memory");
        } else {
            XB_SPIN(xb_ld(&bar[XB_XGEN(b.x)]) == gen, bar);
            __builtin_amdgcn_fence(__ATOMIC_ACQUIRE, "agent");
            asm volatile("s_waitcnt vmcnt(0)" ::: "memory");
        }
    }
    __syncthreads();
}

__global__ void __launch_bounds__(512, 2) fwd_kernel(Params p, int ph_lo, int ph_hi) {
    extern __shared__ __attribute__((aligned(16))) unsigned char lds_raw[];
    LAS unsigned char* lds = (LAS unsigned char*)lds_raw;
    cg::grid_group grid = cg::this_grid();
    if (ph_lo < 0) grid.sync();
    volatile LAS unsigned* bst = (volatile LAS unsigned*)(lds + LDS_PHASE_BYTES);
    if (threadIdx.x < 2) bst[threadIdx.x] = 0u;
    __syncthreads();
    XcdBarrier xbar; xbar.bar = (unsigned*)(p.ws + WS_CTL + CTL_BAR); xbar.x = 0; xbar.st = bst;
    if (ph_hi - ph_lo > 1) xbar = xcd_barrier_post((unsigned*)(p.ws + WS_CTL + CTL_BAR), bst);
    const int tid = threadIdx.x, lane = tid & 63, wid = tid >> 6, G = gridDim.x, bx = blockIdx.x;
    unsigned char* ws = p.ws;
    bf16_t* XN = (bf16_t*)(ws + WS_XN); bf16_t* XN2 = (bf16_t*)(ws + WS_XN2); bf16_t* HB = (bf16_t*)(ws + WS_H);
    float* SS1 = (float*)(ws + WS_SSP1); float* SS2 = (float*)(ws + WS_SSP2);
    float* Y = p.out; bf16_t* X3b = (bf16_t*)(ws + WS_GM);
#ifndef PHMASK
#define PHMASK 0x7ff
#endif
#define IN(k) (((PHMASK >> (k)) & 1) && ph_lo <= (k) && (k) < ph_hi)
#define SEAM(k) do { if (IN(k) && IN((k) + 1)) { xcd_barrier(xbar); }     } while (0)

    if (IN(0)) p0_prologue(p, lds, bx, G);
    SEAM(0);
    if (IN(1)) {
        if (bx < 176) sk_ffn_in<false>(XN, (const bf16_t*)(ws + WS_W1IN), HB, bx, wid, lane & 15, lane >> 4, lds);
        pg8::Gemm g{XN, (const bf16_t*)(ws + WS_W1IN), MPR, 2 * DFF, DM, DM}; pg8::StaticOrder S; S.init(MPR, 2 * DFF, G, bx);
        EpiSwiglu E{HB, nullptr}; pg8::gemm_phase<EpiSwiglu, pg8::StaticOrder, GEMM_ALIGN, GEMM_SP2>(lds, g, S, E);
    }
    SEAM(1);
    if (IN(2)) {
        if (bx < 64) sk_ffn_out<false>(HB, (const bf16_t*)(ws + WS_W1OUT), p.in[1], nullptr, XN + (size_t)MPR * DM, bx, wid, lane & 15, lane >> 4, lds);
        pg8::Gemm g{HB, (const bf16_t*)(ws + WS_W1OUT), MPR, DM, DFF, DFF}; pg8::StaticOrder S; S.init(MPR, DM, G, bx);
        EpiResid<false, false, true, true, true> E{p.in[0], p.in[1], nullptr, XN, SS1}; pg8::gemm_phase<EpiResid<false, false, true, true, true>, pg8::StaticOrder, GEMM_ALIGN, GEMM_SP2>(lds, g, S, E);
    }
    SEAM(2);
    if (IN(3)) {
        if (bx < 89) sk_inproj(XN, (const bf16_t*)(ws + WS_WINMIX), HB, (float*)(ws + WS_GBA), bx, wid, lane & 15, lane >> 4, lds);
        pg8::Gemm g{XN, (const bf16_t*)(ws + WS_WINMIX), MPR, NINP, DM, DM}; pg8::StaticOrder S; S.init(MPR, NINP, G, bx);
        EpiInproj E{HB, (float*)(ws + WS_GBA), SS1}; pg8::gemm_phase<EpiInproj, pg8::StaticOrder, GEMM_ALIGN, GEMM_SP2>(lds, g, S, E);
    }
    SEAM(3);
    if (IN(4)) {
        for (int u = bx; u < 2048; u += G) gdn_prep_unit(p, lds, u);
    }
    SEAM(4);
    if (IN(5)) {
        if (bx < NSCAN) gdn_scan(p, lds, bx);
        else {
            const int ab = bx - NSCAN, NAB = G - NSCAN;
            if (NAB == 192) {
                if (ab < 128) { sattn_unit(p, ab, wid, lane); sgdn_unit(p, lds, ab); attn_unit(p, lds, 2 * ab); attn_unit(p, lds, 2 * ab + 1); }
                else { for (int k = 0; k < 4; ++k) attn_unit(p, lds, 256 + (ab - 128) * 4 + k); }
            } else {
                int it = ab;
#pragma unroll 1
                for (; it < 512; it += NAB) attn_unit(p, lds, it);
#pragma unroll 1
                for (; it < 640; it += NAB) { sattn_unit(p, it - 512, wid, lane); sgdn_unit(p, lds, it - 512); }
            }
            const bf16_t* PB = HB;
            for (int idx = ab * 512 + tid; idx < 149504; idx += NAB * 512) {
                if (idx < 131072) { const int w = idx >> 16, r = idx & 65535, b = r >> 14, j = (r >> 7) & 127, c = r & 127;
                    p.out[(w ? O_VP : O_KP) + r] = bf2f(PB[(size_t)(b * SEQ + SEQ - 128 + j) * PW + 512 + w * 128 + c]);
                } else { const int r = idx - 131072, b = r / (3 * CONVC), q = r % (3 * CONVC), rr = q / CONVC, c = q % CONVC;
                    p.out[O_CP + r] = bf2f(PB[(size_t)(b * SEQ + SEQ - 3 + rr) * PW + 768 + c]); }
            }
            __syncthreads();
            late_weight_items(p, lds, ab * 8 + wid, NAB * 8);
        }
    }
    SEAM(5);
    if (IN(6)) {
        for (int u = bx * 8 + wid; u < 2048; u += G * 8) gdn_gate_unit(p, u, lane);
    }
    SEAM(6);
#ifdef DBG_DUMP
    if (ph_lo == 11) {
        const float* src = (const float*)(ws + DBG_SRC);
        for (size_t i = (size_t)bx * 512 + tid; i < (size_t)MREAL * DM; i += (size_t)G * 512) Y[i] = (i < (size_t)MREAL * 8) ? ((const float*)(ws + WS_GBA))[i] : 0.f;
    }
#endif
    if (IN(7)) {
        if (bx < 32) sk_outproj(HB, (const bf16_t*)(ws + WS_WOUTMIX), XN, nullptr, XN2, bx, wid, lane & 15, lane >> 4, lds);
        pg8::Gemm g{HB, (const bf16_t*)(ws + WS_WOUTMIX), MPR, DM, DM, PW}; pg8::StaticOrder S; S.init(MPR, DM, G, bx);
        EpiResid<true, false, true, true, false> E{XN, XN + (size_t)MPR * DM, nullptr, XN2, SS2}; pg8::gemm_phase<EpiResid<true, false, true, true, false>, pg8::StaticOrder, GEMM_ALIGN, GEMM_SP2>(lds, g, S, E);
    }
    SEAM(7);
    if (IN(8)) {
        if (bx < 176) sk_ffn_in<true>(XN2, (const bf16_t*)(ws + WS_W2IN), HB, bx, wid, lane & 15, lane >> 4, lds);
        pg8::Gemm g{XN2, (const bf16_t*)(ws + WS_W2IN), MPR, 2 * DFF, DM, DM}; pg8::StaticOrder S; S.init(MPR, 2 * DFF, G, bx);
        EpiSwiglu E{HB, SS2}; pg8::gemm_phase<EpiSwiglu, pg8::StaticOrder, GEMM_ALIGN, GEMM_SP2>(lds, g, S, E);
    }
    SEAM(8);
    if (IN(9)) {
        if (bx < 64) sk_ffn_out<true>(HB, (const bf16_t*)(ws + WS_W2OUT), (const float*)(XN2 + (size_t)MPR * DM), nullptr, X3b + (size_t)MPR * DM, bx, wid, lane & 15, lane >> 4, lds);
        pg8::Gemm g{HB, (const bf16_t*)(ws + WS_W2OUT), MPR, DM, DFF, DFF}; pg8::StaticOrder S; S.init(MPR, DM, G, bx);
        EpiResid<true, false, true, false, true> E{XN2, XN2 + (size_t)MPR * DM, nullptr, X3b, nullptr}; pg8::gemm_phase<EpiResid<true, false, true, false, true>, pg8::StaticOrder, GEMM_ALIGN, GEMM_SP2>(lds, g, S, E);
    }
    SEAM(9);
    if (IN(10)) {
        const float* gf = p.in[20]; f32x4 gv[4];
#pragma unroll
        for (int j = 0; j < 4; ++j) gv[j] = *((const f32x4*)gf + lane + 64 * j);
        {
            f32x4 v[4], vn[4]; int m = bx * 8 + wid;
            if (m < MREAL) { const u32x2* xr = (const u32x2*)(X3b + (size_t)m * DM) + lane;
#pragma unroll
                for (int j = 0; j < 4; ++j) { const u32x2 w = xr[64 * j]; v[j] = (f32x4){bflo(w.x), bfhi(w.x), bflo(w.y), bfhi(w.y)}; } }
            for (; m < MREAL; m += G * 8) {
                const int mn = m + G * 8;
                if (mn < MREAL) { const u32x2* xr = (const u32x2*)(X3b + (size_t)mn * DM) + lane;
#pragma unroll
                    for (int j = 0; j < 4; ++j) { const u32x2 w = xr[64 * j]; vn[j] = (f32x4){bflo(w.x), bfhi(w.x), bflo(w.y), bfhi(w.y)}; } }
                float s = 0.f;
#pragma unroll
                for (int j = 0; j < 4; ++j) s += (v[j][0] * v[j][0] + v[j][1] * v[j][1]) + (v[j][2] * v[j][2] + v[j][3] * v[j][3]);
                const float rstd = rsqrtf(wave_sum(s) * (1.0f / DM) + EPS);
                f32x4* yr = (f32x4*)(Y + (size_t)m * DM) + lane;
#pragma unroll
                for (int j = 0; j < 4; ++j) yr[64 * j] = v[j] * rstd * gv[j];
#pragma unroll
                for (int j = 0; j < 4; ++j) v[j] = vn[j];
            }
        }
    }
#undef IN
#undef SEAM
}
}

#ifndef MK_N_LAUNCHES
#define MK_N_LAUNCHES 1
#endif
extern "C" void kernel_launch(void* const* d_in, const int* in_sizes, int n_in, void* d_out, int out_size, void* d_ws, size_t ws_size, hipStream_t stream) {
    static int grid = 0;
    if (grid == 0) {
        if (n_in != 21 || ws_size < mk::WS_END || out_size != 47269888) { fprintf(stderr, "kernel_launch: unexpected shapes (n_in %d, ws %zu, out %d)\n", n_in, ws_size, out_size); grid = -1; return; }
        int dev = 0, cus = 0, per_cu = 0;
        (void)hipGetDevice(&dev); (void)hipDeviceGetAttribute(&cus, hipDeviceAttributeMultiprocessorCount, dev);
        if (hipFuncSetAttribute((const void*)mk::fwd_kernel, hipFuncAttributeMaxDynamicSharedMemorySize, mk::LDS_BYTES) != hipSuccess) { fprintf(stderr, "kernel_launch: hipFuncSetAttribute failed\n"); grid = -1; return; }
        if (hipOccupancyMaxActiveBlocksPerMultiprocessor(&per_cu, (const void*)mk::fwd_kernel, 512, mk::LDS_BYTES) != hipSuccess || per_cu < 1) { fprintf(stderr, "kernel_launch: occupancy query failed (%d)\n", per_cu); per_cu = 1; }
        (void)hipGetLastError();
        grid = cus * per_cu;
        if (grid <= mk::NSCAN) { fprintf(stderr, "kernel_launch: grid %d too small\n", grid); grid = -1; return; }
    }
    if (grid < 0) return;
    (void)hipMemsetAsync((char*)d_ws + mk::WS_CTL + mk::CTL_BAR, 0, mk::CTL_BAR_BYTES, stream);
    mk::Params p{};
    for (int i = 0; i < 21; ++i) p.in[i] = (const float*)d_in[i];
    p.out = (float*)d_out; p.ws = (unsigned char*)d_ws;
#if MK_N_LAUNCHES == 1
    int lo = 0, hi = 11; void* args[] = {&p, &lo, &hi};
    hipError_t e = hipLaunchCooperativeKernel((const void*)mk::fwd_kernel, dim3(grid), dim3(512), args, mk::LDS_BYTES, stream);
    if (e != hipSuccess) fprintf(stderr, "kernel_launch: cooperative launch failed: %s (grid %d)\n", hipGetErrorString(e), grid);
#else
#ifndef MK_LAST
#define MK_LAST 11
#ifndef MK_DOUBLE
#define MK_DOUBLE 0x0
#endif
#define DBG_C0 512
#define DBG_C1 1024
#endif
    for (int ph = 0; ph < MK_LAST; ++ph) { const int reps = ((MK_DOUBLE >> ph) & 1) ? 2 : 1; for (int r = 0; r < reps; ++r) hipLaunchKernelGGL(mk::fwd_kernel, dim3(grid), dim3(512), mk::LDS_BYTES, stream, p, ph, ph + 1); }
#ifdef DBG_DUMP
    hipLaunchKernelGGL(mk::fwd_kernel, dim3(grid), dim3(512), mk::LDS_BYTES, stream, p, 11, 12);
#endif
#endif
}
```

```cpp
#include <hip/hip_runtime.h>
#include <hip/hip_cooperative_groups.h>
#include <cstdio>
namespace cg = cooperative_groups;
namespace pg8 {
#define PG8_LAS __attribute__((address_space(3)))
typedef unsigned short bf16_t;
typedef short bf16x8 __attribute__((ext_vector_type(8)));
typedef float f32x4 __attribute__((ext_vector_type(4)));
typedef unsigned u32x4 __attribute__((ext_vector_type(4)));
constexpr int BM = 256, BK = 64, HALF = 128, HTB = HALF * BK * 2  , STAGE_BYTES = 8 * HTB, NXCD = 8, WGM = 4;

__host__ __device__ __forceinline__ int lds_byte(int r, int c) { const int st = (r >> 4) * 2 + (c >> 5), rr = r & 15, cc = c & 31, ob = rr * 64 + cc * 2; return st * 1024 + (ob ^ (((ob >> 9) & 1) << 5)); }
__host__ __device__ __forceinline__ void stage_rc(int b, int& R, int& C) { const int st = b / 1024, sb = b % 1024, swz = sb ^ (((sb >> 9) & 1) << 5); R = (st >> 1) * 16 + swz / 64; C = (st & 1) * 32 + (swz % 64) / 2; }
__host__ __device__ __forceinline__ int perm32(int rho) { const int n = rho >> 4, i = rho & 15; return 8 * (i >> 2) + 4 * n + (i & 3); }

struct Unit { int pm, pn; };
struct Gemm { const bf16_t* A; const bf16_t* Bt; int M, N, K, lda; };

struct StaticOrder {
    int nM, nN, nwg, G, c, wgm;
    __host__ __device__ void init(int M, int N, int G_, int c_, int wgm_ = WGM) { nM = M / BM; nN = N / BM; nwg = nM * nN; G = G_; c = c_; wgm = wgm_; }
    __host__ __device__ bool next(int i, Unit& u) const {
        const long L = (long)i * G + c; if (L >= nwg) return false;
        int wgid = (int)L; { const int q = nwg / NXCD, r = nwg % NXCD, xcd = wgid % NXCD, off = wgid / NXCD; wgid = (xcd < r ? xcd * (q + 1) : r * (q + 1) + (xcd - r) * q) + off; }
        const int nig = wgm * nN, gid = wgid / nig, fm = gid * wgm, gsz = (nM - fm) < wgm ? (nM - fm) : wgm;
        u.pm = fm + ((wgid % nig) % gsz); u.pn = (wgid % nig) / gsz; return true;
    }
    __device__ __forceinline__ void a_ready(const Unit&) const {}
    __device__ __forceinline__ void done(const Unit&) const {}
};

__device__ __forceinline__ unsigned cvt_pk_bf16(float lo, float hi) { unsigned r; asm volatile("v_cvt_pk_bf16_f32 %0, %1, %2" : "=v"(r) : "v"(lo), "v"(hi)); return r; }
typedef float f32x2 __attribute__((ext_vector_type(2)));
__device__ __forceinline__ f32x2 gelu_pk(f32x2 v) {
    const f32x2 av = __builtin_elementwise_abs(v), d = av * 0.2316418882f + 1.0f;
    f32x2 t; t.x = __builtin_amdgcn_rcpf(d.x); t.y = __builtin_amdgcn_rcpf(d.y);
    f32x2 q = t * 0.5307027145f + (-0.7265760135f); q = q * t + 0.7107068705f; q = q * t + (-0.142248368f); q = q * t + 0.127414796f; q = q * t;
    const f32x2 s = (v * v) * (-0.72134752044f);
    f32x2 e; e.x = __builtin_amdgcn_exp2f(s.x); e.y = __builtin_amdgcn_exp2f(s.y);
    const f32x2 m = v * (q * e), r = v - m;
    f32x2 o; o.x = v.x < 0.f ? m.x : r.x; o.y = v.y < 0.f ? m.y : r.y; return o;
}

template <int ACT  > struct EpiBf16 {
    static constexpr bool PERM = true, AFTER_DRAIN = false; static_assert(ACT == 0 || ACT == 1, "EpiBf16: ACT is 0 (none) or 1 (gelu_pk)");
    bf16_t* O; int ldc; const float* bias; int split_cols; size_t split_stride; float scale0;
    __device__ __forceinline__ void operator()(const f32x4 (&acc)[2][2][4][2], const Unit& u, int wr, int wc, int fr, int fq) const {
        const int row0 = u.pm * BM + wr * 64 + fr; int colt = u.pn * BM; bf16_t* base = O;
        float sc = 1.f; if (split_cols) { const int t = colt / split_cols; base += (size_t)t * split_stride; colt -= t * split_cols; if (t == 0) sc = scale0; }
        const int col0 = colt + wc * 32 + 8 * fq, bcol0 = u.pn * BM + wc * 32 + 8 * fq;
        f32x4 bv[2][2];
#pragma unroll
        for (int bj = 0; bj < 2; ++bj)
#pragma unroll
            for (int n = 0; n < 2; ++n) bv[bj][n] = bias ? *(const f32x4*)(bias + bcol0 + bj * HALF + 4 * n) : (f32x4){0.f, 0.f, 0.f, 0.f};
#pragma unroll
        for (int ai = 0; ai < 2; ++ai)
#pragma unroll
            for (int m = 0; m < 4; ++m) { bf16_t* rowp = base + (size_t)(row0 + ai * HALF + m * 16) * ldc + col0;
#pragma unroll
                for (int bj = 0; bj < 2; ++bj) { f32x4 v0 = acc[ai][bj][m][0] + bv[bj][0], v1 = acc[ai][bj][m][1] + bv[bj][1];
                    if (ACT == 1) { f32x2 a = gelu_pk((f32x2){v0[0], v0[1]}), b = gelu_pk((f32x2){v0[2], v0[3]}), c = gelu_pk((f32x2){v1[0], v1[1]}), d = gelu_pk((f32x2){v1[2], v1[3]});
                        v0 = (f32x4){a.x, a.y, b.x, b.y}; v1 = (f32x4){c.x, c.y, d.x, d.y}; }
                    v0 = v0 * sc; v1 = v1 * sc; u32x4 w; w.x = cvt_pk_bf16(v0[0], v0[1]); w.y = cvt_pk_bf16(v0[2], v0[3]); w.z = cvt_pk_bf16(v1[0], v1[1]); w.w = cvt_pk_bf16(v1[2], v1[3]);
                    *(u32x4*)(rowp + bj * HALF) = w; } }
    }
};

struct PanelStats {
    unsigned* xbuf;
    unsigned* cnt;
    unsigned* tmo;
    int ntn; float eps;
    unsigned code;
    __device__ __forceinline__ bool run(const f32x4 (&v)[2][2][4][2], const Unit& u, int wr, int wc, int fr, int fq, PG8_LAS unsigned char* lds, int wid, int lane) const {
        typedef float f32x2v __attribute__((ext_vector_type(2)));
        PG8_LAS f32x2v* P = (PG8_LAS f32x2v*)lds;
        PG8_LAS f32x2v* S = (PG8_LAS f32x2v*)(lds + 8192);
        PG8_LAS unsigned* flag = (PG8_LAS unsigned*)(lds + 8192 + 2048);
#pragma unroll
        for (int ai = 0; ai < 2; ++ai)
#pragma unroll
            for (int m = 0; m < 4; ++m) {
                float s = 0.f;
#pragma unroll
                for (int bj = 0; bj < 2; ++bj)
#pragma unroll
                    for (int n = 0; n < 2; ++n) { const f32x4 x = v[ai][bj][m][n]; s += (x[0] + x[1]) + (x[2] + x[3]); }
                s += __shfl_xor(s, 16); s += __shfl_xor(s, 32);
                const float mw = s * (1.0f / 64.0f); float q = 0.f;
#pragma unroll
                for (int bj = 0; bj < 2; ++bj)
#pragma unroll
                    for (int n = 0; n < 2; ++n) { const f32x4 d = v[ai][bj][m][n] - mw; q += (d[0] * d[0] + d[1] * d[1]) + (d[2] * d[2] + d[3] * d[3]); }
                q += __shfl_xor(q, 16); q += __shfl_xor(q, 32);
                if (fq == 0) P[(ai * HALF + wr * 64 + m * 16 + fr) * 4 + wc] = (f32x2v){mw, q};
            }
        asm volatile("s_waitcnt lgkmcnt(0)" ::: "memory"); __builtin_amdgcn_s_barrier(); asm volatile("" ::: "memory");
#if defined(BROKEN_EXCHANGE_NO_WAIT)
#warning BROKEN CONTROL BUILD: the row-statistics exchange does not wait; results are wrong by design
        if (blockIdx.x >= 64) { const long long t0_ = clock64(); while (clock64() - t0_ < 60000) __builtin_amdgcn_s_sleep(8); }
#endif
        const int row = wid * 32 + (lane & 31);
        if (lane < 32) {
            const f32x2v a = P[row * 4 + 0], b = P[row * 4 + 1], c = P[row * 4 + 2], d = P[row * 4 + 3];
            const float mt = (a.x + b.x + c.x + d.x) * 0.25f;
            const float da = a.x - mt, db = b.x - mt, dc = c.x - mt, dd = d.x - mt;
            const float m2 = (a.y + b.y) + (c.y + d.y) + 64.0f * ((da * da + db * db) + (dc * dc + dd * dd));
            unsigned long long* slot = (unsigned long long*)xbuf + ((size_t)(u.pm * BM + row) * 4 + u.pn);
            __hip_atomic_store(slot, ((unsigned long long)__float_as_uint(m2) << 32) | __float_as_uint(mt), __ATOMIC_RELAXED, __HIP_MEMORY_SCOPE_AGENT);
        }
        asm volatile("s_waitcnt vmcnt(0)" ::: "memory");
        if (lane == 0) __hip_atomic_fetch_add(cnt + 64 * u.pm, 1u, __ATOMIC_RELAXED, __HIP_MEMORY_SCOPE_AGENT);
        if (wid == 0) {
            bool dead = false; const unsigned long long t0 = __builtin_amdgcn_s_memrealtime(); const unsigned want = 8u * (unsigned)ntn;
            for (;;) {
#if defined(BROKEN_EXCHANGE_NO_WAIT)
                break;
#endif
                if ((unsigned)__builtin_amdgcn_readfirstlane(__hip_atomic_load(cnt + 64 * u.pm, __ATOMIC_RELAXED, __HIP_MEMORY_SCOPE_AGENT)) >= want) break;
                if (__builtin_amdgcn_s_memrealtime() - t0 > 2000000ull) {
                    if (lane == 0) { unsigned expect = 0u; __hip_atomic_compare_exchange_strong(tmo + 1, &expect, code | (unsigned)(u.pm & 0xff), __ATOMIC_RELAXED, __ATOMIC_RELAXED, __HIP_MEMORY_SCOPE_AGENT);
                                     __hip_atomic_store(tmo, 1u, __ATOMIC_RELAXED, __HIP_MEMORY_SCOPE_AGENT); }
                    dead = true; break; }
                __builtin_amdgcn_s_sleep(2);
            }
            __builtin_amdgcn_fence(__ATOMIC_ACQUIRE, "agent");
            if (lane == 0) flag[0] = dead ? 1u : 0u;
        }
        asm volatile("s_waitcnt vmcnt(0) lgkmcnt(0)" ::: "memory"); __builtin_amdgcn_s_barrier(); asm volatile("" ::: "memory");
        const bool bad = flag[0] != 0u;
        if (lane < 32) {
            const unsigned long long* slot = (const unsigned long long*)xbuf + (size_t)(u.pm * BM + row) * 4; float mt[4], m2[4]; float ms = 0.f;
#pragma unroll
            for (int t = 0; t < 4; ++t) { if (t < ntn) { const unsigned long long w = __hip_atomic_load(slot + t, __ATOMIC_RELAXED, __HIP_MEMORY_SCOPE_AGENT); mt[t] = __uint_as_float((unsigned)w); m2[t] = __uint_as_float((unsigned)(w >> 32)); } else { mt[t] = 0.f; m2[t] = 0.f; } ms += mt[t]; }
            const float mean = ms / (float)ntn; float q = 0.f;
#pragma unroll
            for (int t = 0; t < 4; ++t) if (t < ntn) { const float dm = mt[t] - mean; q += m2[t] + 256.0f * dm * dm; }
            S[row] = (f32x2v){mean, 1.0f / sqrtf(q / (256.0f * (float)ntn) + eps)};
        }
        asm volatile("s_waitcnt lgkmcnt(0)" ::: "memory"); __builtin_amdgcn_s_barrier(); asm volatile("" ::: "memory");
        return bad;
    }
};
struct EpiLnRes {
    static constexpr bool PERM = false, AFTER_DRAIN = true;
    const float* base; float* out; int ldc; const float* bias; PanelStats st; unsigned poison;
    __device__ __forceinline__ void fused(f32x4 (&acc)[2][2][4][2], const Unit& u, int wr, int wc, int fr, int fq, PG8_LAS unsigned char* lds, int wid, int lane) const {
        typedef float f32x2v __attribute__((ext_vector_type(2)));
        const PG8_LAS f32x2v* S = (const PG8_LAS f32x2v*)(lds + 8192);
        const int col0 = u.pn * BM + wc * 32 + 4 * fq;
#pragma unroll
        for (int bj = 0; bj < 2; ++bj)
#pragma unroll
            for (int n = 0; n < 2; ++n) { const f32x4 bv = bias ? *(const f32x4*)(bias + col0 + bj * HALF + n * 16) : (f32x4){0.f, 0.f, 0.f, 0.f};
#pragma unroll
                for (int ai = 0; ai < 2; ++ai)
#pragma unroll
                    for (int m = 0; m < 4; ++m) acc[ai][bj][m][n] += bv; }
        f32x4 pre[4][2][2];
#pragma unroll
        for (int m = 0; m < 4; ++m) { const size_t off = (size_t)(u.pm * BM + wr * 64 + m * 16 + fr) * ldc + col0;
#pragma unroll
            for (int bj = 0; bj < 2; ++bj)
#pragma unroll
                for (int n = 0; n < 2; ++n) pre[m][bj][n] = *(const f32x4*)(base + off + bj * HALF + n * 16); }
        const bool bad = st.run(acc, u, wr, wc, fr, fq, lds, wid, lane) || poison != 0u;
        const float qnan = __builtin_nanf("");
#pragma unroll
        for (int ai = 0; ai < 2; ++ai)
#pragma unroll
            for (int m = 0; m < 4; ++m) { const int r = ai * HALF + wr * 64 + m * 16 + fr; const f32x2v sr = S[r]; const size_t off = (size_t)(u.pm * BM + r) * ldc + col0;
#pragma unroll
                for (int bj = 0; bj < 2; ++bj)
#pragma unroll
                    for (int n = 0; n < 2; ++n) { const f32x4 bs = ai == 0 ? pre[m][bj][n] : *(const f32x4*)(base + off + bj * HALF + n * 16); f32x4 o = bs + (acc[ai][bj][m][n] - sr.x) * sr.y;
                        if (bad) o = (f32x4){qnan, qnan, qnan, qnan}; *(f32x4*)(out + off + bj * HALF + n * 16) = o; }
                if (m & 1) asm volatile("" ::: "memory"); }
    }
};
struct EpiLnResLn {
    static constexpr bool PERM = false, AFTER_DRAIN = true;
    const float* base; float* out; bf16_t* xn; int ldc; const float* bias; PanelStats st1, st2; unsigned poison;
    __device__ __forceinline__ void fused(f32x4 (&acc)[2][2][4][2], const Unit& u, int wr, int wc, int fr, int fq, PG8_LAS unsigned char* lds, int wid, int lane) const {
        typedef float f32x2v __attribute__((ext_vector_type(2))); typedef unsigned u32x2v __attribute__((ext_vector_type(2)));
        const PG8_LAS f32x2v* S = (const PG8_LAS f32x2v*)(lds + 8192);
        const int col0 = u.pn * BM + wc * 32 + 4 * fq;
#pragma unroll
        for (int bj = 0; bj < 2; ++bj)
#pragma unroll
            for (int n = 0; n < 2; ++n) { const f32x4 bv = bias ? *(const f32x4*)(bias + col0 + bj * HALF + n * 16) : (f32x4){0.f, 0.f, 0.f, 0.f};
#pragma unroll
                for (int ai = 0; ai < 2; ++ai)
#pragma unroll
                    for (int m = 0; m < 4; ++m) acc[ai][bj][m][n] += bv; }
        bool bad = st1.run(acc, u, wr, wc, fr, fq, lds, wid, lane) || poison != 0u;
        const float qnan = __builtin_nanf("");
#pragma unroll
        for (int ai = 0; ai < 2; ++ai)
#pragma unroll
            for (int m = 0; m < 4; ++m) { const int r = ai * HALF + wr * 64 + m * 16 + fr; const f32x2v sr = S[r]; const size_t off = (size_t)(u.pm * BM + r) * ldc + col0;
#pragma unroll
                for (int bj = 0; bj < 2; ++bj)
#pragma unroll
                    for (int n = 0; n < 2; ++n) { const f32x4 bs = *(const f32x4*)(base + off + bj * HALF + n * 16); acc[ai][bj][m][n] = bs + (acc[ai][bj][m][n] - sr.x) * sr.y; }
                asm volatile("" : "+v"(acc[ai][0][m][0]), "+v"(acc[ai][0][m][1]), "+v"(acc[ai][1][m][0]), "+v"(acc[ai][1][m][1]));
                if (m & 1) asm volatile("" ::: "memory"); }
        const bool bad1 = bad;
        bad = st2.run(acc, u, wr, wc, fr, fq, lds, wid, lane) || bad;
#pragma unroll
        for (int ai = 0; ai < 2; ++ai)
#pragma unroll
            for (int m = 0; m < 4; ++m) { const int r = ai * HALF + wr * 64 + m * 16 + fr; const f32x2v sr = S[r]; const size_t off = (size_t)(u.pm * BM + r) * ldc + col0;
#pragma unroll
                for (int bj = 0; bj < 2; ++bj)
#pragma unroll
                    for (int n = 0; n < 2; ++n) { const f32x4 x1 = acc[ai][bj][m][n]; *(f32x4*)(out + off + bj * HALF + n * 16) = bad1 ? (f32x4){qnan, qnan, qnan, qnan} : x1;
                        const f32x4 o = (x1 - sr.x) * sr.y; u32x2v w; w.x = cvt_pk_bf16(o[0], o[1]); w.y = cvt_pk_bf16(o[2], o[3]);
                        if (bad) { w.x = 0x7fc07fc0u; w.y = 0x7fc07fc0u; } *(u32x2v*)(xn + off + bj * HALF + n * 16) = w; }
                asm volatile("" ::: "memory"); }
    }
};

template <class Epi, class Sched, bool ALIGN_EPI = false, bool SP2 = false>
__device__ __forceinline__ void gemm_phase(PG8_LAS unsigned char* lds, const Gemm g, const Sched S, const Epi E) {
    const int tid = threadIdx.x, wid = __builtin_amdgcn_readfirstlane(tid >> 6), lane = tid & 63, wr = wid >> 2, wc = wid & 3, fr = lane & 15, fq = lane >> 4;
    const int K = g.K, nt = K / BK;
    unsigned voffA[2], voffB[2];
#pragma unroll
    for (int i = 0; i < 2; ++i) { int R, C; stage_rc(tid * 16 + i * 8192, R, C); const int Rb = Epi::PERM ? ((R & ~31) + perm32(R & 31)) : R;
        voffA[i] = (unsigned)(R * g.lda + C) * 2u; voffB[i] = (unsigned)(Rb * K + C) * 2u; }
    const size_t kstep = (size_t)(BK * 2);
    const size_t hstep = (size_t)HALF * K * 2;
    const size_t tstep = 2 * hstep;
    const size_t hstepA = (size_t)HALF * g.lda * 2, tstepA = 2 * hstepA;
    const unsigned ldsw = (unsigned)wid * 1024u;
    const int aoff = lds_byte(wr * 64 + fr, fq * 8), boff = lds_byte(wc * 32 + fr, fq * 8);
#define PG8_SA(b, h) (((b) * 2 + (h)) * HTB)
#define PG8_SB(b, h) ((4 + (b) * 2 + (h)) * HTB)
#define PG8_STAGE(bufoff, gbase, voff) do { _Pragma("unroll") for (int _i = 0; _i < 2; ++_i) \
        __builtin_amdgcn_global_load_lds((const unsigned*)((const char*)(gbase) + (voff)[_i]), (PG8_LAS unsigned*)(lds + (bufoff) + ldsw + _i * 8192), 16, 0, 0); } while (0)
#define PG8_LDA(dst, b, h) do { _Pragma("unroll") for (int m = 0; m < 4; ++m) _Pragma("unroll") for (int k = 0; k < 2; ++k) dst[m][k] = *(const PG8_LAS bf16x8*)(lds + PG8_SA(b, h) + aoff + m * 2048 + k * 1024); } while (0)
#define PG8_LDB(dst, b, h) do { _Pragma("unroll") for (int n = 0; n < 2; ++n) _Pragma("unroll") for (int k = 0; k < 2; ++k) dst[n][k] = *(const PG8_LAS bf16x8*)(lds + PG8_SB(b, h) + boff + n * 2048 + k * 1024); } while (0)
#define PG8_MMA(ai, bj, At, Bt) do { __builtin_amdgcn_s_setprio(1); _Pragma("unroll") for (int m = 0; m < 4; ++m) _Pragma("unroll") for (int n = 0; n < 2; ++n) _Pragma("unroll") for (int k = 0; k < 2; ++k) \
        acc[ai][bj][m][n] = __builtin_amdgcn_mfma_f32_16x16x32_bf16(Bt[n][k], At[m][k], acc[ai][bj][m][n], 0, 0, 0); __builtin_amdgcn_s_setprio(0); } while (0)
#define PG8_WAIT_V(n) asm volatile("s_waitcnt vmcnt(" #n ")" ::: "memory")
#define PG8_WAIT_L(n) asm volatile("s_waitcnt lgkmcnt(" #n ")" ::: "memory")
#define PG8_BAR __builtin_amdgcn_s_barrier()
#define PG8_SCHED __builtin_amdgcn_sched_barrier(0)
    Unit cur, nxt; int ui = 0;
    if (!S.next(0, cur)) return;
    f32x4 acc[2][2][4][2];
#pragma unroll
    for (int a = 0; a < 2; ++a)
#pragma unroll
        for (int b = 0; b < 2; ++b)
#pragma unroll
            for (int m = 0; m < 4; ++m)
#pragma unroll
                for (int n = 0; n < 2; ++n) acc[a][b][m][n] = (f32x4){0.f, 0.f, 0.f, 0.f};
    bf16x8 At[4][2], B0[2][2], B1[2][2];
    const char* cA = (const char*)g.A + (size_t)cur.pm * tstepA; const char* cB = (const char*)g.Bt + (size_t)cur.pn * tstep;
    S.a_ready(cur);
    if constexpr (SP2) {
        PG8_STAGE(PG8_SB(0, 0), cB, voffB); PG8_STAGE(PG8_SB(0, 1), cB + hstep, voffB); PG8_STAGE(PG8_SA(0, 0), cA, voffA); PG8_STAGE(PG8_SA(0, 1), cA + hstepA, voffA);
        if (wr == 1) PG8_BAR;
        PG8_WAIT_V(2); PG8_BAR;
        PG8_STAGE(PG8_SB(1, 0), cB + kstep, voffB); PG8_STAGE(PG8_SA(1, 0), cA + kstep, voffA); PG8_STAGE(PG8_SB(1, 1), cB + hstep + kstep, voffB);
        PG8_WAIT_V(6); PG8_BAR;
    } else {
        PG8_STAGE(PG8_SB(0, 0), cB, voffB); PG8_STAGE(PG8_SA(0, 0), cA, voffA); PG8_STAGE(PG8_SB(0, 1), cB + hstep, voffB); PG8_STAGE(PG8_SA(0, 1), cA + hstepA, voffA);
        if (wr == 1) PG8_BAR;
        PG8_WAIT_V(4); PG8_BAR;
        PG8_STAGE(PG8_SB(1, 0), cB + kstep, voffB); PG8_STAGE(PG8_SA(1, 0), cA + kstep, voffA); PG8_STAGE(PG8_SB(1, 1), cB + hstep + kstep, voffB);
        PG8_WAIT_V(6); PG8_BAR;
    }
    for (;;) {
        const bool has_next = S.next(ui + 1, nxt);
        const char* nA = has_next ? (const char*)g.A + (size_t)nxt.pm * tstepA : cA; const char* nB = has_next ? (const char*)g.Bt + (size_t)nxt.pn * tstep : cB;
        for (int t = 0; t < nt; t += 2) {
            const bool last = (t == nt - 2);
            const char* a1 = cA + (size_t)(t + 1) * kstep;
            const char* a2 = last ? nA : cA + (size_t)(t + 2) * kstep; const char* b2 = last ? nB : cB + (size_t)(t + 2) * kstep;
            const char* a3 = a2 + kstep; const char* b3 = b2 + kstep;
            if (last && has_next) S.a_ready(nxt);
            if constexpr (SP2) {
            PG8_LDB(B0, 0, 0); PG8_LDB(B1, 0, 1); PG8_SCHED; PG8_LDA(At, 0, 0); PG8_STAGE(PG8_SA(1, 1), a1 + hstepA, voffA);
            PG8_WAIT_V(8); PG8_WAIT_L(0); PG8_BAR; PG8_MMA(0, 0, At, B0); PG8_MMA(0, 1, At, B1); PG8_BAR; PG8_SCHED;
            PG8_LDA(At, 0, 1); PG8_STAGE(PG8_SB(0, 0), b2, voffB); PG8_STAGE(PG8_SB(0, 1), b2 + hstep, voffB); PG8_STAGE(PG8_SA(0, 0), a2, voffA);
            PG8_WAIT_V(8); PG8_WAIT_L(0); PG8_BAR; PG8_MMA(1, 0, At, B0); PG8_MMA(1, 1, At, B1); PG8_BAR; PG8_SCHED;
            PG8_LDB(B0, 1, 0); PG8_LDB(B1, 1, 1); PG8_SCHED; PG8_LDA(At, 1, 0); PG8_STAGE(PG8_SA(0, 1), a2 + hstepA, voffA);
            PG8_WAIT_V(8); PG8_WAIT_L(0); PG8_BAR; PG8_MMA(0, 0, At, B0); PG8_MMA(0, 1, At, B1); PG8_BAR; PG8_SCHED;
            PG8_LDA(At, 1, 1); PG8_STAGE(PG8_SB(1, 0), b3, voffB); PG8_STAGE(PG8_SB(1, 1), b3 + hstep, voffB); PG8_STAGE(PG8_SA(1, 0), a3, voffA);
            PG8_WAIT_V(8); PG8_WAIT_L(0); PG8_BAR; PG8_MMA(1, 0, At, B0); PG8_MMA(1, 1, At, B1); PG8_BAR; PG8_SCHED;
            } else {
            PG8_LDB(B0, 0, 0); PG8_SCHED; PG8_LDA(At, 0, 0); PG8_STAGE(PG8_SA(1, 1), a1 + hstepA, voffA);
            PG8_WAIT_L(8); PG8_BAR; PG8_WAIT_L(0); PG8_MMA(0, 0, At, B0); PG8_BAR; PG8_SCHED;
            PG8_LDB(B1, 0, 1); PG8_STAGE(PG8_SB(0, 0), b2, voffB);
            PG8_BAR; PG8_WAIT_L(0); PG8_MMA(0, 1, At, B1); PG8_BAR;
            PG8_LDA(At, 0, 1); PG8_STAGE(PG8_SA(0, 0), a2, voffA);
            PG8_BAR; PG8_WAIT_L(0); PG8_MMA(1, 0, At, B0); PG8_BAR; PG8_SCHED;
            PG8_STAGE(PG8_SB(0, 1), b2 + hstep, voffB);
            PG8_WAIT_V(6); PG8_BAR; PG8_MMA(1, 1, At, B1); PG8_BAR;
            PG8_LDB(B0, 1, 0); PG8_SCHED; PG8_LDA(At, 1, 0); PG8_STAGE(PG8_SA(0, 1), a2 + hstepA, voffA);
            PG8_WAIT_L(8); PG8_BAR; PG8_WAIT_L(0); PG8_MMA(0, 0, At, B0); PG8_BAR; PG8_SCHED;
            PG8_LDB(B1, 1, 1); PG8_STAGE(PG8_SB(1, 0), b3, voffB);
            PG8_BAR; PG8_WAIT_L(0); PG8_MMA(0, 1, At, B1); PG8_BAR;
            PG8_LDA(At, 1, 1); PG8_STAGE(PG8_SA(1, 0), a3, voffA);
            PG8_BAR; PG8_WAIT_L(0); PG8_MMA(1, 0, At, B0); PG8_BAR; PG8_SCHED;
            PG8_STAGE(PG8_SB(1, 1), b3 + hstep, voffB);
            PG8_WAIT_V(6); PG8_BAR; PG8_MMA(1, 1, At, B1); PG8_BAR;
            }
        }
        if constexpr (ALIGN_EPI) { if (wr == 0) PG8_BAR; }
        if constexpr (!Epi::AFTER_DRAIN) { E(acc, cur, wr, wc, fr, fq); S.done(cur); }
        if (!has_next) break;
#pragma unroll
        for (int a = 0; a < 2; ++a)
#pragma unroll
            for (int b = 0; b < 2; ++b)
#pragma unroll
                for (int m = 0; m < 4; ++m)
#pragma unroll
                    for (int n = 0; n < 2; ++n) acc[a][b][m][n] = (f32x4){0.f, 0.f, 0.f, 0.f};
        cur = nxt; cA = nA; cB = nB; ++ui;
        if constexpr (ALIGN_EPI) { if (wr == 1) PG8_BAR; }
    }
    PG8_WAIT_V(0);
    if constexpr (!ALIGN_EPI) { if (wr == 0) PG8_BAR; }
    PG8_BAR;
    if constexpr (Epi::AFTER_DRAIN) { E.fused(acc, cur, wr, wc, fr, fq, lds, wid, lane); S.done(cur); }
#undef PG8_SA
#undef PG8_SB
#undef PG8_STAGE
#undef PG8_LDA
#undef PG8_LDB
#undef PG8_MMA
#undef PG8_WAIT_V
#undef PG8_WAIT_L
#undef PG8_BAR
#undef PG8_SCHED
}
}

#ifndef GEMM_SP2
#define GEMM_SP2 true
#endif
#ifndef GEMM_ALIGN
#define GEMM_ALIGN true
#endif
namespace mk {
#define LAS __attribute__((address_space(3)))
using pg8::bf16_t; using pg8::bf16x8; using pg8::f32x4; using pg8::u32x4;
typedef unsigned u32x2 __attribute__((ext_vector_type(2)));

constexpr int DM = 1024, SEQ = 8192, NBATCH = 4, MPR = NBATCH * SEQ, MSAMP = 128, MREAL = MPR + MSAMP, MPAD = 33024;
constexpr int DFF = 2816, PW = 2816, NINP = 3072, CONVC = 1536;
constexpr float EPS = 1e-6f;
#ifndef SCAN_CW
#define SCAN_CW 2
#endif
constexpr int CW = SCAN_CW, NSCAN = 128 / CW;
constexpr int LDS_PHASE_BYTES = 155648, LDS_BYTES = LDS_PHASE_BYTES + 256;

constexpr size_t O_YP = 0, O_YS = 33554432, O_KP = 33685504, O_VP = 33751040, O_CP = 33816576, O_GP = 33835008,
                 O_KS = 34097152, O_VS = 36194304, O_CS = 38291456, O_GS = 38881280;
constexpr size_t MiB = 1u << 20;
constexpr size_t WS_CTL = 0, CTL_ZERO_BYTES = 1 * MiB;
constexpr size_t WS_W1IN = 1 * MiB, WS_W1OUT = 12 * MiB, WS_WINMIX = 18 * MiB, WS_WOUTMIX = 24 * MiB, WS_W2IN = 26 * MiB, WS_W2OUT = 37 * MiB;
constexpr size_t WS_GBA = 43 * MiB, WS_XN = 45 * MiB, WS_XN2 = 110 * MiB, WS_H = 175 * MiB, WS_GM = 353 * MiB, WS_GN = 417 * MiB;
constexpr size_t WS_GQ = 110 * MiB, WS_GO = 142 * MiB;
constexpr size_t WS_SSP1 = 481 * MiB, WS_SSP2 = 484 * MiB;
constexpr size_t WS_END = 487 * MiB;
constexpr size_t CTL_BAR = 0, CTL_BAR_BYTES = 16384, CTL_GLAST = 768 * 1024;

struct Params { const float* in[21]; float* out; unsigned char* ws; };

typedef float f32x2v __attribute__((ext_vector_type(2)));
typedef __bf16 bf16x2v __attribute__((ext_vector_type(2)));
__device__ __forceinline__ unsigned cvt_pk(float lo, float hi) { const f32x2v v = {lo, hi}; const bf16x2v b = __builtin_convertvector(v, bf16x2v); return __builtin_bit_cast(unsigned, b); }
__device__ __forceinline__ bf16_t f2bf(float f) { return (bf16_t)(cvt_pk(f, 0.f) & 0xffffu); }
__device__ __forceinline__ float bf2f(bf16_t h) { return __uint_as_float(((unsigned)h) << 16); }
__device__ __forceinline__ float bflo(unsigned w) { return __uint_as_float(w << 16); }
__device__ __forceinline__ float bfhi(unsigned w) { return __uint_as_float(w & 0xffff0000u); }
__device__ __forceinline__ float silu(float x) { return x * __builtin_amdgcn_rcpf(1.0f + __expf(-x)); }
__device__ __forceinline__ float wave_sum(float v) {
#pragma unroll
    for (int o = 1; o < 64; o <<= 1) v += __shfl_xor(v, o);
    return v;
}
__device__ __forceinline__ float wave_max(float v) {
#pragma unroll
    for (int o = 1; o < 64; o <<= 1) v = fmaxf(v, __shfl_xor(v, o));
    return v;
}
__device__ __forceinline__ float row16_sum(float v) {
    v += __builtin_bit_cast(float, __builtin_amdgcn_update_dpp(0, __builtin_bit_cast(int, v), 0xB1, 0xF, 0xF, true));
    v += __builtin_bit_cast(float, __builtin_amdgcn_update_dpp(0, __builtin_bit_cast(int, v), 0x4E, 0xF, 0xF, true));
    v += __builtin_bit_cast(float, __builtin_amdgcn_update_dpp(0, __builtin_bit_cast(int, v), 0x141, 0xF, 0xF, true));
    v += __builtin_bit_cast(float, __builtin_amdgcn_update_dpp(0, __builtin_bit_cast(int, v), 0x140, 0xF, 0xF, true));
    return v;
}
__device__ __forceinline__ f32x4 mfma16(bf16x8 a, bf16x8 b, f32x4 c) { return __builtin_amdgcn_mfma_f32_16x16x32_bf16(a, b, c, 0, 0, 0); }

__device__ __forceinline__ float row_rstd(const float* ssp, int r) {
    if (r >= MREAL) return 0.f;
    const f32x4 a = *(const f32x4*)(ssp + (size_t)r * 16), b = *(const f32x4*)(ssp + (size_t)r * 16 + 4), c = *(const f32x4*)(ssp + (size_t)r * 16 + 8), d = *(const f32x4*)(ssp + (size_t)r * 16 + 12);
    const float s = (((a[0] + a[1]) + (a[2] + a[3])) + ((b[0] + b[1]) + (b[2] + b[3]))) + (((c[0] + c[1]) + (c[2] + c[3])) + ((d[0] + d[1]) + (d[2] + d[3])));
    return rsqrtf(s * (1.0f / DM) + EPS);
}
__device__ __forceinline__ float row_rstd4(const float* ssp, int r, int fq) {
    const f32x4 a = *(const f32x4*)(ssp + (size_t)r * 16 + 4 * fq);
    float s = (a[0] + a[1]) + (a[2] + a[3]);
    s += __shfl_xor(s, 16); s += __shfl_xor(s, 32);
    return rsqrtf(s * (1.0f / DM) + EPS);
}
__device__ __forceinline__ void swiglu2(float g0, float u0, float g1, float u1, float& h0, float& h1) {
    const float c0 = fmaxf(g0, -40.f), c1 = fmaxf(g1, -40.f);
    const float a = 1.0f + __expf(-c0), b = 1.0f + __expf(-c1), r = __builtin_amdgcn_rcpf(a * b);
    h0 = c0 * (r * b) * u0; h1 = c1 * (r * a) * u1;
}
struct EpiSwiglu {
    static constexpr bool PERM = true, AFTER_DRAIN = false;
    bf16_t* H; const float* ss;
    __device__ __forceinline__ void operator()(const f32x4 (&acc)[2][2][4][2], const pg8::Unit& u, int wr, int wc, int fr, int fq) const {
        const int row0 = u.pm * 256 + wr * 64 + fr, col0 = u.pn * 128 + wc * 32 + 8 * fq;
#pragma unroll
        for (int ai = 0; ai < 2; ++ai)
#pragma unroll
            for (int m = 0; m < 4; ++m) {
                const int r = row0 + ai * 128 + m * 16;
                const float rs = ss ? row_rstd4(ss, r, fq) : 1.0f;
                float h[8];
#pragma unroll
                for (int n = 0; n < 2; ++n)
#pragma unroll
                    for (int j = 0; j < 4; j += 2) swiglu2(acc[ai][0][m][n][j] * rs, acc[ai][1][m][n][j] * rs, acc[ai][0][m][n][j + 1] * rs, acc[ai][1][m][n][j + 1] * rs, h[n * 4 + j], h[n * 4 + j + 1]);
                u32x4 w; w.x = cvt_pk(h[0], h[1]); w.y = cvt_pk(h[2], h[3]); w.z = cvt_pk(h[4], h[5]); w.w = cvt_pk(h[6], h[7]);
                *(u32x4*)(H + (size_t)r * DFF + col0) = w;
            }
    }
};
template <bool RESB16, bool WF32, bool WB16, bool SUMSQ, bool HALF> struct EpiResid {
    static constexpr bool PERM = true, AFTER_DRAIN = false;
    const void* resP; const void* resS; float* Yo; bf16_t* XBo; float* sso;
    __device__ __forceinline__ void operator()(const f32x4 (&acc)[2][2][4][2], const pg8::Unit& u, int wr, int wc, int fr, int fq) const {
        const int row0 = u.pm * 256 + wr * 64 + fr, col0 = u.pn * 256 + wc * 32 + 8 * fq;
        const char* const rP = (const char*)resP; const char* const rS = (const char*)resS - (size_t)MPR * DM * (RESB16 ? 2 : 4);
        float* const Y = Yo; const float scale = HALF ? 0.5f : 1.0f; bf16_t* const XB = XBo; float* const ss = sso;
#pragma unroll
        for (int ai = 0; ai < 2; ++ai)
#pragma unroll
            for (int m = 0; m < 4; ++m) {
                const int r = row0 + ai * 128 + m * 16; float s = 0.f;
                if (r < MREAL) {
                    const char* rp = ((r < MPR) ? rP : rS) + (size_t)r * DM * (RESB16 ? 2 : 4);
#pragma unroll
                    for (int bj = 0; bj < 2; ++bj) {
                        const int c = col0 + bj * 128;
                        f32x4 r0, r1;
                        if (RESB16) { const u32x4 w = *(const u32x4*)(rp + (size_t)c * 2); r0 = (f32x4){bflo(w.x), bfhi(w.x), bflo(w.y), bfhi(w.y)}; r1 = (f32x4){bflo(w.z), bfhi(w.z), bflo(w.w), bfhi(w.w)}; }
                        else { r0 = *(const f32x4*)(rp + (size_t)c * 4); r1 = *(const f32x4*)(rp + (size_t)c * 4 + 16); }
                        const f32x4 v0 = r0 + acc[ai][bj][m][0] * scale, v1 = r1 + acc[ai][bj][m][1] * scale;
                        if (WF32) { *(f32x4*)(Y + (size_t)r * DM + c) = v0; *(f32x4*)(Y + (size_t)r * DM + c + 4) = v1; }
                        if (WB16) { u32x4 w; w.x = cvt_pk(v0[0], v0[1]); w.y = cvt_pk(v0[2], v0[3]); w.z = cvt_pk(v1[0], v1[1]); w.w = cvt_pk(v1[2], v1[3]);
                            *(u32x4*)(XB + (size_t)r * DM + c) = w; }
                        if (SUMSQ) s += (v0[0] * v0[0] + v0[1] * v0[1]) + (v0[2] * v0[2] + v0[3] * v0[3]) + (v1[0] * v1[0] + v1[1] * v1[1]) + (v1[2] * v1[2] + v1[3] * v1[3]);
                    }
                }
                if (SUMSQ) { s += __shfl_xor(s, 16); s += __shfl_xor(s, 32); if (fq == 0 && r < MREAL) ss[(size_t)r * 16 + u.pn * 4 + wc] = s; }
            }
    }
};
struct EpiInproj {
    static constexpr bool PERM = true, AFTER_DRAIN = false;
    bf16_t* P; float* gba; const float* ss;
    __device__ __forceinline__ void operator()(const f32x4 (&acc)[2][2][4][2], const pg8::Unit& u, int wr, int wc, int fr, int fq) const {
        const int row0 = u.pm * 256 + wr * 64 + fr, col0 = u.pn * 256 + wc * 32 + 8 * fq;
#pragma unroll
        for (int ai = 0; ai < 2; ++ai)
#pragma unroll
            for (int m = 0; m < 4; ++m) {
                const int r = row0 + ai * 128 + m * 16;
                const float rs = row_rstd4(ss, r, fq);
                if (u.pn < 11) {
#pragma unroll
                    for (int bj = 0; bj < 2; ++bj) { const f32x4 v0 = acc[ai][bj][m][0] * rs, v1 = acc[ai][bj][m][1] * rs;
                        u32x4 w; w.x = cvt_pk(v0[0], v0[1]); w.y = cvt_pk(v0[2], v0[3]); w.z = cvt_pk(v1[0], v1[1]); w.w = cvt_pk(v1[2], v1[3]);
                        *(u32x4*)(P + (size_t)r * PW + col0 + bj * 128) = w; }
                } else if (wc == 0 && fq == 0) {
                    *(f32x4*)(gba + (size_t)r * 8) = acc[ai][0][m][0] * rs; *(f32x4*)(gba + (size_t)r * 8 + 4) = acc[ai][0][m][1] * rs;
                }
            }
    }
};


template <int NT, bool SS>
__device__ __forceinline__ void skinny_mm(const bf16_t* A, int lda, const bf16_t* W, int K, int wrow0, int wrow1, int wid, int fr, int fq, f32x4 (&acc)[NT], float& ss, LAS unsigned char* lds) {
    const int lane = fq * 16 + fr, kper = K >> 3, nks = kper >> 5;
    const bf16_t* ap = A + (size_t)fr * lda + wid * kper + 8 * fq;
    const bf16_t* w0 = W + (size_t)(wrow0 + fr) * K + wid * kper + 8 * fq; const bf16_t* w1 = W + (size_t)(wrow1 + fr) * K + wid * kper + 8 * fq;
    f32x4 pa[NT][8]; float sp[8];
#pragma unroll
    for (int mt = 0; mt < 8; ++mt) { sp[mt] = 0.f;
#pragma unroll
        for (int nt = 0; nt < NT; ++nt) pa[nt][mt] = (f32x4){0.f, 0.f, 0.f, 0.f}; }
#pragma unroll 2
    for (int ks = 0; ks < nks; ++ks) {
        const bf16x8 b0 = *(const bf16x8*)(w0 + 32 * ks); bf16x8 b1 = b0; if (NT == 2) b1 = *(const bf16x8*)(w1 + 32 * ks);
        bf16x8 av[8];
#pragma unroll
        for (int mt = 0; mt < 8; ++mt) av[mt] = *(const bf16x8*)(ap + (size_t)(16 * mt) * lda + 32 * ks);
#pragma unroll
        for (int mt = 0; mt < 8; ++mt) {
            pa[0][mt] = mfma16(b0, av[mt], pa[0][mt]);
            if (NT == 2) pa[NT - 1][mt] = mfma16(b1, av[mt], pa[NT - 1][mt]);
            if (SS) { const u32x4 u = __builtin_bit_cast(u32x4, av[mt]);
#pragma unroll
                for (int k = 0; k < 4; ++k) { const float lo = bflo(u[k]), hi = bfhi(u[k]); sp[mt] += lo * lo + hi * hi; } }
        }
    }
    LAS f32x4* red = (LAS f32x4*)lds;
    LAS float* sred = (LAS float*)(lds + 8 * NT * 8 * 64 * 16);
#pragma unroll
    for (int mt = 0; mt < 8; ++mt) {
#pragma unroll
        for (int nt = 0; nt < NT; ++nt) red[((wid * NT + nt) * 8 + mt) * 64 + lane] = pa[nt][mt];
        if (SS) sred[(wid * 8 + mt) * 64 + lane] = sp[mt];
    }
    __syncthreads();
    float s = 0.f;
#pragma unroll
    for (int nt = 0; nt < NT; ++nt) acc[nt] = (f32x4){0.f, 0.f, 0.f, 0.f};
#pragma unroll
    for (int v = 0; v < 8; ++v) {
#pragma unroll
        for (int nt = 0; nt < NT; ++nt) acc[nt] += red[((v * NT + nt) * 8 + wid) * 64 + lane];
        if (SS) s += sred[(v * 8 + wid) * 64 + lane];
    }
    if (SS) { s += __shfl_xor(s, 16); s += __shfl_xor(s, 32); }
    ss = s;
    __syncthreads();
}
template <bool SS> __device__ __forceinline__ void sk_ffn_in(const bf16_t* X, const bf16_t* Wt, bf16_t* H, int slab, int wid, int fr, int fq, LAS unsigned char* lds) {
    const int j0 = 16 * slab, wr0 = (j0 >> 7) * 256 + (j0 & 127);
    f32x4 acc[2]; float ss;
    skinny_mm<2, SS>(X + (size_t)MPR * DM, DM, Wt, DM, wr0, wr0 + 128, wid, fr, fq, acc, ss, lds);
    const float rs = SS ? rsqrtf(ss * (1.0f / DM) + EPS) : 1.0f;
    float h[4];
#pragma unroll
    for (int e = 0; e < 4; ++e) h[e] = silu(acc[0][e] * rs) * (acc[1][e] * rs);
    u32x2 w; w.x = cvt_pk(h[0], h[1]); w.y = cvt_pk(h[2], h[3]);
    *(u32x2*)(H + (size_t)(MPR + 16 * wid + fr) * DFF + j0 + 4 * fq) = w;
}
template <bool OUTF32> __device__ __forceinline__ void sk_ffn_out(const bf16_t* Hb, const bf16_t* Wt, const float* resf, float* outf, bf16_t* outb, int slab, int wid, int fr, int fq, LAS unsigned char* lds) {
    f32x4 acc[1]; float ss;
    skinny_mm<1, false>(Hb + (size_t)MPR * DFF, DFF, Wt, DFF, 16 * slab, 0, wid, fr, fq, acc, ss, lds);
    const int rl = 16 * wid + fr, c = 16 * slab + 4 * fq;
    f32x4 rv;
    if (OUTF32) { const u32x2 xr = *(const u32x2*)((const bf16_t*)resf + (size_t)rl * DM + c); rv = (f32x4){bflo(xr.x), bfhi(xr.x), bflo(xr.y), bfhi(xr.y)}; }
    else rv = *(const f32x4*)(resf + (size_t)rl * DM + c);
    const f32x4 v = rv + acc[0] * 0.5f;
    { u32x2 w; w.x = cvt_pk(v[0], v[1]); w.y = cvt_pk(v[2], v[3]); *(u32x2*)(outb + (size_t)rl * DM + c) = w; }
}
__device__ __forceinline__ void sk_inproj(const bf16_t* X, const bf16_t* Wt, bf16_t* P, float* gba, int slab, int wid, int fr, int fq, LAS unsigned char* lds) {
    const int n0 = 32 * slab; f32x4 acc[2]; float ss;
    skinny_mm<2, true>(X + (size_t)MPR * DM, DM, Wt, DM, n0, n0 + 16, wid, fr, fq, acc, ss, lds);
    const float rs = rsqrtf(ss * (1.0f / DM) + EPS); const int r = MPR + 16 * wid + fr;
    if (n0 < PW) {
#pragma unroll
        for (int nt = 0; nt < 2; ++nt) { const f32x4 v = acc[nt] * rs; u32x2 w; w.x = cvt_pk(v[0], v[1]); w.y = cvt_pk(v[2], v[3]); *(u32x2*)(P + (size_t)r * PW + n0 + 16 * nt + 4 * fq) = w; }
    } else if (fq < 2) *(f32x4*)(gba + (size_t)r * 8 + 4 * fq) = acc[0] * rs;
}
__device__ __forceinline__ void sk_outproj(const bf16_t* Pm, const bf16_t* Wt, const bf16_t* X1b, float* X2f, bf16_t* X2b, int slab, int wid, int fr, int fq, LAS unsigned char* lds) {
    const int n0 = 32 * slab; f32x4 acc[2]; float ss;
    skinny_mm<2, false>(Pm + (size_t)MPR * PW, PW, Wt, DM, n0, n0 + 16, wid, fr, fq, acc, ss, lds);
    const int r = MPR + 16 * wid + fr;
#pragma unroll
    for (int nt = 0; nt < 2; ++nt) { const int c = n0 + 16 * nt + 4 * fq; const u32x2 xr = *(const u32x2*)(X1b + (size_t)r * DM + c);
        const f32x4 v = (f32x4){bflo(xr.x), bfhi(xr.x), bflo(xr.y), bfhi(xr.y)} + acc[nt];
        u32x2 w; w.x = cvt_pk(v[0], v[1]); w.y = cvt_pk(v[2], v[3]); *(u32x2*)(X2b + (size_t)r * DM + c) = w; }
}

__device__ __forceinline__ void transpose_item(const float* W, int K, int N, bf16_t* WT, int k0, int n0, int drow0, const float* gs, LAS float* scr, int lane) {
    float wv[32];
#pragma unroll
    for (int i = 0; i < 32; ++i) { const int kk = 2 * i + (lane >> 5), n = n0 + (lane & 31); wv[i] = (n < N) ? W[(size_t)(k0 + kk) * N + n] : 0.f; }
#pragma unroll
    for (int i = 0; i < 32; ++i) { const int kk = 2 * i + (lane >> 5); float v = wv[i]; if (gs) v *= gs[k0 + kk]; scr[kk * 33 + (lane & 31)] = v; }
    asm volatile("s_waitcnt lgkmcnt(0)" ::: "memory");
    const int c = lane & 7;
#pragma unroll
    for (int j = 0; j < 4; ++j) { const int nn = (lane >> 3) + 8 * j; const LAS float* s = scr + (8 * c) * 33 + nn;
        u32x4 o; o.x = cvt_pk(s[0 * 33], s[1 * 33]); o.y = cvt_pk(s[2 * 33], s[3 * 33]); o.z = cvt_pk(s[4 * 33], s[5 * 33]); o.w = cvt_pk(s[6 * 33], s[7 * 33]);
        *(u32x4*)(WT + (size_t)(drow0 + nn) * K + k0 + 8 * c) = o; }
    asm volatile("s_waitcnt lgkmcnt(0)" ::: "memory");
}
__device__ __forceinline__ int map_ffin_row(int n0) { return n0 < DFF ? (n0 >> 7) * 256 + (n0 & 127) : ((n0 - DFF) >> 7) * 256 + 128 + ((n0 - DFF) & 127); }

__device__ __forceinline__ void p0_prologue(const Params& p, LAS unsigned char* lds, int vb, int G) {
    const int tid = threadIdx.x, lane = tid & 63, wid = tid >> 6;
    LAS float* scr = (LAS float*)(lds + wid * 16384);
    const int gw = vb * 8 + wid, NGW = G * 8;
    bf16_t* W1IN = (bf16_t*)(p.ws + WS_W1IN); bf16_t* W1OUT = (bf16_t*)(p.ws + WS_W1OUT); bf16_t* WINMIX = (bf16_t*)(p.ws + WS_WINMIX);
    bf16_t* WOUTMIX = (bf16_t*)(p.ws + WS_WOUTMIX); bf16_t* W2IN = (bf16_t*)(p.ws + WS_W2IN); bf16_t* W2OUT = (bf16_t*)(p.ws + WS_W2OUT);
    constexpr int I_FIN = 16 * 176, I_FOUT = 44 * 32, I_INMIX = 16 * 89;
    constexpr int NITEMS = I_FIN + I_FOUT + I_INMIX;
    for (int it = gw; it < NITEMS; it += NGW) {
        int r = it;
        if (r < I_FIN) { const int kb = r / 176, nb = r % 176; transpose_item(p.in[7], DM, 2 * DFF, W1IN, kb * 64, nb * 32, map_ffin_row(nb * 32), nullptr, scr, lane); continue; } r -= I_FIN;
        if (r < I_FOUT) { const int kb = r / 32, nb = r % 32; transpose_item(p.in[8], DFF, DM, W1OUT, kb * 64, nb * 32, nb * 32, nullptr, scr, lane); continue; } r -= I_FOUT;
        { const int kb = r / 89, nb = r % 89; transpose_item(p.in[10], DM, 2824, WINMIX, kb * 64, nb * 32, nb * 32, p.in[9], scr, lane); }
    }
    bf16_t* XN = (bf16_t*)(p.ws + WS_XN); const float* g1 = p.in[6];
    f32x4 gv[4];
#pragma unroll
    for (int j = 0; j < 4; ++j) gv[j] = *((const f32x4*)g1 + lane + 64 * j);
    {
        f32x4 v[4], vn[4];
        int m = gw;
        if (m < MREAL) { const f32x4* xr = (const f32x4*)((m < MPR) ? p.in[0] + (size_t)m * DM : p.in[1] + (size_t)(m - MPR) * DM) + lane;
#pragma unroll
            for (int j = 0; j < 4; ++j) v[j] = xr[64 * j]; }
        for (; m < MREAL; m += NGW) {
            const int mn = m + NGW;
            if (mn < MREAL) { const f32x4* xr = (const f32x4*)((mn < MPR) ? p.in[0] + (size_t)mn * DM : p.in[1] + (size_t)(mn - MPR) * DM) + lane;
#pragma unroll
                for (int j = 0; j < 4; ++j) vn[j] = xr[64 * j]; }
            float s = 0.f;
#pragma unroll
            for (int j = 0; j < 4; ++j) s += (v[j][0] * v[j][0] + v[j][1] * v[j][1]) + (v[j][2] * v[j][2] + v[j][3] * v[j][3]);
            const float rstd = rsqrtf(wave_sum(s) * (1.0f / DM) + EPS);
            unsigned long long* o8 = (unsigned long long*)(XN + (size_t)m * DM) + lane;
#pragma unroll
            for (int j = 0; j < 4; ++j) { const f32x4 y = v[j] * rstd * gv[j];
                o8[64 * j] = (unsigned long long)cvt_pk(y[0], y[1]) | ((unsigned long long)cvt_pk(y[2], y[3]) << 32); }
#pragma unroll
            for (int j = 0; j < 4; ++j) v[j] = vn[j];
        }
    }
}

template <bool SWX = false, bool SWY = false>
__device__ __forceinline__ f32x4 tile_mm(const LAS bf16_t* X, int ldx, int mt, const LAS bf16_t* Y, int ldy, int nt, int nks, int fr, int fq) {
    f32x4 acc = (f32x4){0.f, 0.f, 0.f, 0.f};
    const int rx = 16 * mt + fr, ry = 16 * nt + fr, sx = SWX ? ((rx >> 3) & 7) : 0, sy = SWY ? ((ry >> 3) & 7) : 0;
    const LAS bf16_t* xp = X + rx * ldx; const LAS bf16_t* yp = Y + ry * ldy;
    for (int ks = 0; ks < nks; ++ks) acc = mfma16(*(const LAS bf16x8*)(xp + 8 * ((4 * ks + fq) ^ sx)), *(const LAS bf16x8*)(yp + 8 * ((4 * ks + fq) ^ sy)), acc);
    return acc;
}
constexpr int G1_QS = 0, G1_KS = 17408, G1_VBT = 34816, G1_KBT = 53248, G1_KDT = 71680, G1_UT = 90112, G1_WT = 108544, G1_QK = 126976, G1_TB = 136192, G1_GC = 145408, G1_BETA = 145664, G1_TT = 146176, G1_A10 = 148736, G1_PT = 151296;

__device__ __forceinline__ void gdn_prep_unit(const Params& p, LAS unsigned char* lds, int unit) {
    const int tid = threadIdx.x, lane = tid & 63, wid = tid >> 6, fr = lane & 15, fq = lane >> 4;
    const int bh = unit >> 7, n = unit & 127, b = bh >> 2, h = bh & 3;
    const int tok0 = b * SEQ + n * 64;
    LAS bf16_t* Qs = (LAS bf16_t*)(lds + G1_QS); LAS bf16_t* Ks = (LAS bf16_t*)(lds + G1_KS); LAS bf16_t* VbT = (LAS bf16_t*)(lds + G1_VBT);
    LAS bf16_t* KbT = (LAS bf16_t*)(lds + G1_KBT); LAS bf16_t* KdT = (LAS bf16_t*)(lds + G1_KDT); LAS bf16_t* UT = (LAS bf16_t*)(lds + G1_UT);
    LAS bf16_t* WT = (LAS bf16_t*)(lds + G1_WT); LAS float* Af = (LAS float*)(lds + G1_WT); LAS bf16_t* QK = (LAS bf16_t*)(lds + G1_QK);
    LAS bf16_t* Tb = (LAS bf16_t*)(lds + G1_TB); LAS bf16_t* TT = (LAS bf16_t*)(lds + G1_TT); LAS bf16_t* A10b = (LAS bf16_t*)(lds + G1_A10); LAS bf16_t* PT = (LAS bf16_t*)(lds + G1_PT); LAS float* gcs = (LAS float*)(lds + G1_GC); LAS float* betas = (LAS float*)(lds + G1_BETA);
    const bf16_t* PB = (const bf16_t*)(p.ws + WS_H); const float* GBA = (const float*)(p.ws + WS_GBA);
    LAS unsigned char* raw = lds + G1_UT;
    for (int pc4 = wid; pc4 < 51; pc4 += 8) {
        int pc = pc4 * 4 + (lane >> 4); pc = pc < 200 ? pc : 200;
        const int r = pc / 3, seg = pc - 3 * r; int tt = n * 64 - 3 + r; tt = tt < 0 ? 0 : tt;
        __builtin_amdgcn_global_load_lds((const unsigned*)(PB + (size_t)(b * SEQ + tt) * PW + 768 + seg * 512 + h * 128 + (lane & 15) * 8), (LAS unsigned*)(raw + pc4 * 1024), 16, 0, 0);
    }
    if (tid < 64) {
        const float* gb = GBA + (size_t)(tok0 + tid) * 8;
        const float bt = 1.0f / (1.0f + __expf(-gb[h]));
        const float x = gb[4 + h] + p.in[14][h]; const float sp = x > 20.f ? x : log1pf(__expf(x));
        float c = -__expf(p.in[13][h]) * sp;
#pragma unroll
        for (int o = 1; o < 64; o <<= 1) { const float t = __shfl_up(c, o); if (lane >= o) c += t; }
        gcs[tid] = c; betas[tid] = bt;
    }
    asm volatile("s_waitcnt vmcnt(0)" ::: "memory");
    __syncthreads();
    const float gclast = gcs[63];
    const float* cw = p.in[12];
    f32x4 cwv[4][2];
#pragma unroll 1
    for (int it = 0; it < 6; ++it) {
        const int item = tid + 512 * it, l16 = item & 15, row = item >> 4, which = row >> 6, t = row & 63;
        const int cch = which * 512 + h * 128 + l16 * 8;
        if ((it & 1) == 0) {
#pragma unroll
            for (int j = 0; j < 4; ++j) { cwv[j][0] = *(const f32x4*)(cw + j * CONVC + cch); cwv[j][1] = *(const f32x4*)(cw + j * CONVC + cch + 4); }
        }
        float a[8];
#pragma unroll
        for (int e = 0; e < 8; ++e) a[e] = 0.f;
#pragma unroll
        for (int j = 0; j < 4; ++j) {
            const int tt = n * 64 + t - 3 + j;
            u32x4 xv = *(const LAS u32x4*)(raw + ((t + j) * 3 + which) * 256 + l16 * 16);
            if (tt < 0) xv = (u32x4){0u, 0u, 0u, 0u};
            const f32x4 w0 = cwv[j][0], w1 = cwv[j][1];
            a[0] += w0[0] * bflo(xv.x); a[1] += w0[1] * bfhi(xv.x); a[2] += w0[2] * bflo(xv.y); a[3] += w0[3] * bfhi(xv.y);
            a[4] += w1[0] * bflo(xv.z); a[5] += w1[1] * bfhi(xv.z); a[6] += w1[2] * bflo(xv.w); a[7] += w1[3] * bfhi(xv.w);
        }
        float ss = 0.f;
#pragma unroll
        for (int e = 0; e < 8; ++e) { a[e] = silu(a[e]); ss += a[e] * a[e]; }
        ss = row16_sum(ss);
        const float gct = gcs[t], bt = betas[t];
        const int tsw = (((t >> 3) ^ (l16 & 7)) << 3) | (t & 7);
        if (which == 0) {
            const float sc = rsqrtf(ss + EPS) * 0.08838834764831845f;
            u32x4 w; w.x = cvt_pk(a[0] * sc, a[1] * sc); w.y = cvt_pk(a[2] * sc, a[3] * sc); w.z = cvt_pk(a[4] * sc, a[5] * sc); w.w = cvt_pk(a[6] * sc, a[7] * sc);
            *(LAS u32x4*)(Qs + t * 136 + l16 * 8) = w;
        } else if (which == 1) {
            const float sc = rsqrtf(ss + EPS);
            u32x4 w; w.x = cvt_pk(a[0] * sc, a[1] * sc); w.y = cvt_pk(a[2] * sc, a[3] * sc); w.z = cvt_pk(a[4] * sc, a[5] * sc); w.w = cvt_pk(a[6] * sc, a[7] * sc);
            *(LAS u32x4*)(Ks + t * 136 + l16 * 8) = w;
            const float sb = sc * bt * __expf(gct), sd = sc * __expf(gclast - gct);
#pragma unroll
            for (int e = 0; e < 8; ++e) { KbT[(l16 * 8 + e) * 72 + tsw] = f2bf(a[e] * sb); KdT[(l16 * 8 + e) * 72 + tsw] = f2bf(a[e] * sd); }
        } else {
#pragma unroll
            for (int e = 0; e < 8; ++e) VbT[(l16 * 8 + e) * 72 + tsw] = f2bf(a[e] * bt);
        }
    }
    __syncthreads();
#pragma unroll 2
    for (int r = 0; r < 4; ++r) {
        const int job = wid + 8 * r, kind = job >> 4, tile = job & 15, it = tile >> 2, jt = tile & 3;
        if (kind == 0) {
            if (jt > it) continue;
            const f32x4 acc = tile_mm(Ks, 136, it, Ks, 136, jt, 4, fr, fq);
            const int j = 16 * jt + fr; const float gcj = gcs[j];
            float v[4];
#pragma unroll
            for (int e = 0; e < 4; ++e) { const int i = 16 * it + 4 * fq + e; const bool ok = i > j; v[e] = ok ? acc[e] * __expf(gcs[i] - gcj) * betas[i] : 0.f; }
            *(LAS f32x4*)(Af + j * 68 + 16 * it + 4 * fq) = (f32x4){v[0], v[1], v[2], v[3]};
            if (it >= 2 && jt < 2) {
#pragma unroll
                for (int e = 0; e < 4; ++e) A10b[(16 * (it - 2) + 4 * fq + e) * 40 + j] = f2bf(v[e]); }
        } else {
            const f32x4 acc = tile_mm(Ks, 136, jt, Qs, 136, it, 4, fr, fq);
            const int i = 16 * it + fr; const float gci = gcs[i];
            float v[4];
#pragma unroll
            for (int e = 0; e < 4; ++e) { const int j = 16 * jt + 4 * fq + e; const bool ok = i >= j; v[e] = ok ? acc[e] * __expf(gci - gcs[j]) : 0.f; }
            u32x2 w; w.x = cvt_pk(v[0], v[1]); w.y = cvt_pk(v[2], v[3]); *(LAS u32x2*)(QK + i * 72 + 16 * jt + 4 * fq) = w;
        }
    }
    __syncthreads();
    if (wid < 2) {
        const int ofs = wid * 32, cl = lane & 31; const LAS float* Ab = Af + ofs * 69; LAS bf16_t* Tw = Tb + ofs * 73 + cl; LAS bf16_t* Tt = (wid == 0) ? TT + cl * 40 : PT + cl * 40;
        f32x2v r2[16];
#pragma unroll
        for (int k = 0; k < 16; ++k) r2[k] = (f32x2v){(cl == 2 * k) ? 1.0f : 0.0f, (cl == 2 * k + 1) ? 1.0f : 0.0f};
        const f32x4 a0 = *(const LAS f32x4*)(Ab + 0);
        const f32x4 a1 = *(const LAS f32x4*)(Ab + 4);
        const f32x4 a2 = *(const LAS f32x4*)(Ab + 8);
        const f32x4 a3 = *(const LAS f32x4*)(Ab + 12);
        const f32x4 a4 = *(const LAS f32x4*)(Ab + 16);
        const float t0 = r2[0][0]; const f32x2v T0 = (f32x2v){t0, t0}; Tw[0] = f2bf(t0); Tt[0] = f2bf(t0);
        r2[0] -= (f32x2v){a0[0], a0[1]} * T0; r2[1] -= (f32x2v){a0[2], a0[3]} * T0;
        const f32x4 a5 = *(const LAS f32x4*)(Ab + 20);
        r2[2] -= (f32x2v){a1[0], a1[1]} * T0; r2[3] -= (f32x2v){a1[2], a1[3]} * T0;
        const f32x4 a6 = *(const LAS f32x4*)(Ab + 24);
        r2[4] -= (f32x2v){a2[0], a2[1]} * T0; r2[5] -= (f32x2v){a2[2], a2[3]} * T0;
        const f32x4 a7 = *(const LAS f32x4*)(Ab + 28);
        r2[6] -= (f32x2v){a3[0], a3[1]} * T0; r2[7] -= (f32x2v){a3[2], a3[3]} * T0;
        const f32x4 a8 = *(const LAS f32x4*)(Ab + 68);
        r2[8] -= (f32x2v){a4[0], a4[1]} * T0; r2[9] -= (f32x2v){a4[2], a4[3]} * T0;
        const f32x4 a9 = *(const LAS f32x4*)(Ab + 72);
        r2[10] -= (f32x2v){a5[0], a5[1]} * T0; r2[11] -= (f32x2v){a5[2], a5[3]} * T0;
        const f32x4 a10 = *(const LAS f32x4*)(Ab + 76);
        r2[12] -= (f32x2v){a6[0], a6[1]} * T0; r2[13] -= (f32x2v){a6[2], a6[3]} * T0;
        const f32x4 a11 = *(const LAS f32x4*)(Ab + 80);
        r2[14] -= (f32x2v){a7[0], a7[1]} * T0; r2[15] -= (f32x2v){a7[2], a7[3]} * T0;
        const f32x4 a12 = *(const LAS f32x4*)(Ab + 84);
        const float t1 = r2[0][1]; const f32x2v T1 = (f32x2v){t1, t1}; Tw[72] = f2bf(t1); Tt[1] = f2bf(t1);
        r2[1] -= (f32x2v){a8[2], a8[3]} * T1;
        const f32x4 a13 = *(const LAS f32x4*)(Ab + 88);
        r2[2] -= (f32x2v){a9[0], a9[1]} * T1; r2[3] -= (f32x2v){a9[2], a9[3]} * T1;
        const f32x4 a14 = *(const LAS f32x4*)(Ab + 92);
        r2[4] -= (f32x2v){a10[0], a10[1]} * T1; r2[5] -= (f32x2v){a10[2], a10[3]} * T1;
        const f32x4 a15 = *(const LAS f32x4*)(Ab + 96);
        r2[6] -= (f32x2v){a11[0], a11[1]} * T1; r2[7] -= (f32x2v){a11[2], a11[3]} * T1;
        const f32x4 a16 = *(const LAS f32x4*)(Ab + 136);
        r2[8] -= (f32x2v){a12[0], a12[1]} * T1; r2[9] -= (f32x2v){a12[2], a12[3]} * T1;
        const f32x4 a17 = *(const LAS f32x4*)(Ab + 140);
        r2[10] -= (f32x2v){a13[0], a13[1]} * T1; r2[11] -= (f32x2v){a13[2], a13[3]} * T1;
        const f32x4 a18 = *(const LAS f32x4*)(Ab + 144);
        r2[12] -= (f32x2v){a14[0], a14[1]} * T1; r2[13] -= (f32x2v){a14[2], a14[3]} * T1;
        const f32x4 a19 = *(const LAS f32x4*)(Ab + 148);
        r2[14] -= (f32x2v){a15[0], a15[1]} * T1; r2[15] -= (f32x2v){a15[2], a15[3]} * T1;
        const f32x4 a20 = *(const LAS f32x4*)(Ab + 152);
        const float t2 = r2[1][0]; const f32x2v T2 = (f32x2v){t2, t2}; Tw[144] = f2bf(t2); Tt[2] = f2bf(t2);
        r2[1] -= (f32x2v){a16[2], a16[3]} * T2;
        const f32x4 a21 = *(const LAS f32x4*)(Ab + 156);
        r2[2] -= (f32x2v){a17[0], a17[1]} * T2; r2[3] -= (f32x2v){a17[2], a17[3]} * T2;
        const f32x4 a22 = *(const LAS f32x4*)(Ab + 160);
        r2[4] -= (f32x2v){a18[0], a18[1]} * T2; r2[5] -= (f32x2v){a18[2], a18[3]} * T2;
        const f32x4 a23 = *(const LAS f32x4*)(Ab + 164);
        r2[6] -= (f32x2v){a19[0], a19[1]} * T2; r2[7] -= (f32x2v){a19[2], a19[3]} * T2;
        const f32x4 a24 = *(const LAS f32x4*)(Ab + 208);
        r2[8] -= (f32x2v){a20[0], a20[1]} * T2; r2[9] -= (f32x2v){a20[2], a20[3]} * T2;
        const f32x4 a25 = *(const LAS f32x4*)(Ab + 212);
        r2[10] -= (f32x2v){a21[0], a21[1]} * T2; r2[11] -= (f32x2v){a21[2], a21[3]} * T2;
        const f32x4 a26 = *(const LAS f32x4*)(Ab + 216);
        r2[12] -= (f32x2v){a22[0], a22[1]} * T2; r2[13] -= (f32x2v){a22[2], a22[3]} * T2;
        const f32x4 a27 = *(const LAS f32x4*)(Ab + 220);
        r2[14] -= (f32x2v){a23[0], a23[1]} * T2; r2[15] -= (f32x2v){a23[2], a23[3]} * T2;
        const f32x4 a28 = *(const LAS f32x4*)(Ab + 224);
        const float t3 = r2[1][1]; const f32x2v T3 = (f32x2v){t3, t3}; Tw[216] = f2bf(t3); Tt[3] = f2bf(t3);
        r2[2] -= (f32x2v){a24[0], a24[1]} * T3; r2[3] -= (f32x2v){a24[2], a24[3]} * T3;
        const f32x4 a29 = *(const LAS f32x4*)(Ab + 228);
        r2[4] -= (f32x2v){a25[0], a25[1]} * T3; r2[5] -= (f32x2v){a25[2], a25[3]} * T3;
        const f32x4 a30 = *(const LAS f32x4*)(Ab + 232);
        r2[6] -= (f32x2v){a26[0], a26[1]} * T3; r2[7] -= (f32x2v){a26[2], a26[3]} * T3;
        const f32x4 a31 = *(const LAS f32x4*)(Ab + 276);
        r2[8] -= (f32x2v){a27[0], a27[1]} * T3; r2[9] -= (f32x2v){a27[2], a27[3]} * T3;
        const f32x4 a32 = *(const LAS f32x4*)(Ab + 280);
        r2[10] -= (f32x2v){a28[0], a28[1]} * T3; r2[11] -= (f32x2v){a28[2], a28[3]} * T3;
        const f32x4 a33 = *(const LAS f32x4*)(Ab + 284);
        r2[12] -= (f32x2v){a29[0], a29[1]} * T3; r2[13] -= (f32x2v){a29[2], a29[3]} * T3;
        const f32x4 a34 = *(const LAS f32x4*)(Ab + 288);
        r2[14] -= (f32x2v){a30[0], a30[1]} * T3; r2[15] -= (f32x2v){a30[2], a30[3]} * T3;
        const f32x4 a35 = *(const LAS f32x4*)(Ab + 292);
        const float t4 = r2[2][0]; const f32x2v T4 = (f32x2v){t4, t4}; Tw[288] = f2bf(t4); Tt[4] = f2bf(t4);
        r2[2] -= (f32x2v){a31[0], a31[1]} * T4; r2[3] -= (f32x2v){a31[2], a31[3]} * T4;
        const f32x4 a36 = *(const LAS f32x4*)(Ab + 296);
        r2[4] -= (f32x2v){a32[0], a32[1]} * T4; r2[5] -= (f32x2v){a32[2], a32[3]} * T4;
        const f32x4 a37 = *(const LAS f32x4*)(Ab + 300);
        r2[6] -= (f32x2v){a33[0], a33[1]} * T4; r2[7] -= (f32x2v){a33[2], a33[3]} * T4;
        const f32x4 a38 = *(const LAS f32x4*)(Ab + 344);
        r2[8] -= (f32x2v){a34[0], a34[1]} * T4; r2[9] -= (f32x2v){a34[2], a34[3]} * T4;
        const f32x4 a39 = *(const LAS f32x4*)(Ab + 348);
        r2[10] -= (f32x2v){a35[0], a35[1]} * T4; r2[11] -= (f32x2v){a35[2], a35[3]} * T4;
        const f32x4 a40 = *(const LAS f32x4*)(Ab + 352);
        r2[12] -= (f32x2v){a36[0], a36[1]} * T4; r2[13] -= (f32x2v){a36[2], a36[3]} * T4;
        const f32x4 a41 = *(const LAS f32x4*)(Ab + 356);
        r2[14] -= (f32x2v){a37[0], a37[1]} * T4; r2[15] -= (f32x2v){a37[2], a37[3]} * T4;
        const f32x4 a42 = *(const LAS f32x4*)(Ab + 360);
        const float t5 = r2[2][1]; const f32x2v T5 = (f32x2v){t5, t5}; Tw[360] = f2bf(t5); Tt[5] = f2bf(t5);
        r2[3] -= (f32x2v){a38[2], a38[3]} * T5;
        const f32x4 a43 = *(const LAS f32x4*)(Ab + 364);
        r2[4] -= (f32x2v){a39[0], a39[1]} * T5; r2[5] -= (f32x2v){a39[2], a39[3]} * T5;
        const f32x4 a44 = *(const LAS f32x4*)(Ab + 368);
        r2[6] -= (f32x2v){a40[0], a40[1]} * T5; r2[7] -= (f32x2v){a40[2], a40[3]} * T5;
        const f32x4 a45 = *(const LAS f32x4*)(Ab + 412);
        r2[8] -= (f32x2v){a41[0], a41[1]} * T5; r2[9] -= (f32x2v){a41[2], a41[3]} * T5;
        const f32x4 a46 = *(const LAS f32x4*)(Ab + 416);
        r2[10] -= (f32x2v){a42[0], a42[1]} * T5; r2[11] -= (f32x2v){a42[2], a42[3]} * T5;
        const f32x4 a47 = *(const LAS f32x4*)(Ab + 420);
        r2[12] -= (f32x2v){a43[0], a43[1]} * T5; r2[13] -= (f32x2v){a43[2], a43[3]} * T5;
        const f32x4 a48 = *(const LAS f32x4*)(Ab + 424);
        r2[14] -= (f32x2v){a44[0], a44[1]} * T5; r2[15] -= (f32x2v){a44[2], a44[3]} * T5;
        const f32x4 a49 = *(const LAS f32x4*)(Ab + 428);
        const float t6 = r2[3][0]; const f32x2v T6 = (f32x2v){t6, t6}; Tw[432] = f2bf(t6); Tt[6] = f2bf(t6);
        r2[3] -= (f32x2v){a45[2], a45[3]} * T6;
        const f32x4 a50 = *(const LAS f32x4*)(Ab + 432);
        r2[4] -= (f32x2v){a46[0], a46[1]} * T6; r2[5] -= (f32x2v){a46[2], a46[3]} * T6;
        const f32x4 a51 = *(const LAS f32x4*)(Ab + 436);
        r2[6] -= (f32x2v){a47[0], a47[1]} * T6; r2[7] -= (f32x2v){a47[2], a47[3]} * T6;
        const f32x4 a52 = *(const LAS f32x4*)(Ab + 484);
        r2[8] -= (f32x2v){a48[0], a48[1]} * T6; r2[9] -= (f32x2v){a48[2], a48[3]} * T6;
        const f32x4 a53 = *(const LAS f32x4*)(Ab + 488);
        r2[10] -= (f32x2v){a49[0], a49[1]} * T6; r2[11] -= (f32x2v){a49[2], a49[3]} * T6;
        const f32x4 a54 = *(const LAS f32x4*)(Ab + 492);
        r2[12] -= (f32x2v){a50[0], a50[1]} * T6; r2[13] -= (f32x2v){a50[2], a50[3]} * T6;
        const f32x4 a55 = *(const LAS f32x4*)(Ab + 496);
        r2[14] -= (f32x2v){a51[0], a51[1]} * T6; r2[15] -= (f32x2v){a51[2], a51[3]} * T6;
        const f32x4 a56 = *(const LAS f32x4*)(Ab + 500);
        const float t7 = r2[3][1]; const f32x2v T7 = (f32x2v){t7, t7}; Tw[504] = f2bf(t7); Tt[7] = f2bf(t7);
        r2[4] -= (f32x2v){a52[0], a52[1]} * T7; r2[5] -= (f32x2v){a52[2], a52[3]} * T7;
        const f32x4 a57 = *(const LAS f32x4*)(Ab + 504);
        r2[6] -= (f32x2v){a53[0], a53[1]} * T7; r2[7] -= (f32x2v){a53[2], a53[3]} * T7;
        const f32x4 a58 = *(const LAS f32x4*)(Ab + 552);
        r2[8] -= (f32x2v){a54[0], a54[1]} * T7; r2[9] -= (f32x2v){a54[2], a54[3]} * T7;
        const f32x4 a59 = *(const LAS f32x4*)(Ab + 556);
        r2[10] -= (f32x2v){a55[0], a55[1]} * T7; r2[11] -= (f32x2v){a55[2], a55[3]} * T7;
        const f32x4 a60 = *(const LAS f32x4*)(Ab + 560);
        r2[12] -= (f32x2v){a56[0], a56[1]} * T7; r2[13] -= (f32x2v){a56[2], a56[3]} * T7;
        const f32x4 a61 = *(const LAS f32x4*)(Ab + 564);
        r2[14] -= (f32x2v){a57[0], a57[1]} * T7; r2[15] -= (f32x2v){a57[2], a57[3]} * T7;
        const f32x4 a62 = *(const LAS f32x4*)(Ab + 568);
        const float t8 = r2[4][0]; const f32x2v T8 = (f32x2v){t8, t8}; Tw[576] = f2bf(t8); Tt[8] = f2bf(t8);
        r2[4] -= (f32x2v){a58[0], a58[1]} * T8; r2[5] -= (f32x2v){a58[2], a58[3]} * T8;
        const f32x4 a63 = *(const LAS f32x4*)(Ab + 572);
        r2[6] -= (f32x2v){a59[0], a59[1]} * T8; r2[7] -= (f32x2v){a59[2], a59[3]} * T8;
        const f32x4 a64 = *(const LAS f32x4*)(Ab + 620);
        r2[8] -= (f32x2v){a60[0], a60[1]} * T8; r2[9] -= (f32x2v){a60[2], a60[3]} * T8;
        const f32x4 a65 = *(const LAS f32x4*)(Ab + 624);
        r2[10] -= (f32x2v){a61[0], a61[1]} * T8; r2[11] -= (f32x2v){a61[2], a61[3]} * T8;
        const f32x4 a66 = *(const LAS f32x4*)(Ab + 628);
        r2[12] -= (f32x2v){a62[0], a62[1]} * T8; r2[13] -= (f32x2v){a62[2], a62[3]} * T8;
        const f32x4 a67 = *(const LAS f32x4*)(Ab + 632);
        r2[14] -= (f32x2v){a63[0], a63[1]} * T8; r2[15] -= (f32x2v){a63[2], a63[3]} * T8;
        const f32x4 a68 = *(const LAS f32x4*)(Ab + 636);
        const float t9 = r2[4][1]; const f32x2v T9 = (f32x2v){t9, t9}; Tw[648] = f2bf(t9); Tt[9] = f2bf(t9);
        r2[5] -= (f32x2v){a64[2], a64[3]} * T9;
        const f32x4 a69 = *(const LAS f32x4*)(Ab + 640);
        r2[6] -= (f32x2v){a65[0], a65[1]} * T9; r2[7] -= (f32x2v){a65[2], a65[3]} * T9;
        const f32x4 a70 = *(const LAS f32x4*)(Ab + 688);
        r2[8] -= (f32x2v){a66[0], a66[1]} * T9; r2[9] -= (f32x2v){a66[2], a66[3]} * T9;
        const f32x4 a71 = *(const LAS f32x4*)(Ab + 692);
        r2[10] -= (f32x2v){a67[0], a67[1]} * T9; r2[11] -= (f32x2v){a67[2], a67[3]} * T9;
        const f32x4 a72 = *(const LAS f32x4*)(Ab + 696);
        r2[12] -= (f32x2v){a68[0], a68[1]} * T9; r2[13] -= (f32x2v){a68[2], a68[3]} * T9;
        const f32x4 a73 = *(const LAS f32x4*)(Ab + 700);
        r2[14] -= (f32x2v){a69[0], a69[1]} * T9; r2[15] -= (f32x2v){a69[2], a69[3]} * T9;
        const f32x4 a74 = *(const LAS f32x4*)(Ab + 704);
        const float t10 = r2[5][0]; const f32x2v T10 = (f32x2v){t10, t10}; Tw[720] = f2bf(t10); Tt[10] = f2bf(t10);
        r2[5] -= (f32x2v){a70[2], a70[3]} * T10;
        const f32x4 a75 = *(const LAS f32x4*)(Ab + 708);
        r2[6] -= (f32x2v){a71[0], a71[1]} * T10; r2[7] -= (f32x2v){a71[2], a71[3]} * T10;
        const f32x4 a76 = *(const LAS f32x4*)(Ab + 760);
        r2[8] -= (f32x2v){a72[0], a72[1]} * T10; r2[9] -= (f32x2v){a72[2], a72[3]} * T10;
        const f32x4 a77 = *(const LAS f32x4*)(Ab + 764);
        r2[10] -= (f32x2v){a73[0], a73[1]} * T10; r2[11] -= (f32x2v){a73[2], a73[3]} * T10;
        const f32x4 a78 = *(const LAS f32x4*)(Ab + 768);
        r2[12] -= (f32x2v){a74[0], a74[1]} * T10; r2[13] -= (f32x2v){a74[2], a74[3]} * T10;
        const f32x4 a79 = *(const LAS f32x4*)(Ab + 772);
        r2[14] -= (f32x2v){a75[0], a75[1]} * T10; r2[15] -= (f32x2v){a75[2], a75[3]} * T10;
        const f32x4 a80 = *(const LAS f32x4*)(Ab + 776);
        const float t11 = r2[5][1]; const f32x2v T11 = (f32x2v){t11, t11}; Tw[792] = f2bf(t11); Tt[11] = f2bf(t11);
        r2[6] -= (f32x2v){a76[0], a76[1]} * T11; r2[7] -= (f32x2v){a76[2], a76[3]} * T11;
        const f32x4 a81 = *(const LAS f32x4*)(Ab + 828);
        r2[8] -= (f32x2v){a77[0], a77[1]} * T11; r2[9] -= (f32x2v){a77[2], a77[3]} * T11;
        const f32x4 a82 = *(const LAS f32x4*)(Ab + 832);
        r2[10] -= (f32x2v){a78[0], a78[1]} * T11; r2[11] -= (f32x2v){a78[2], a78[3]} * T11;
        const f32x4 a83 = *(const LAS f32x4*)(Ab + 836);
        r2[12] -= (f32x2v){a79[0], a79[1]} * T11; r2[13] -= (f32x2v){a79[2], a79[3]} * T11;
        const f32x4 a84 = *(const LAS f32x4*)(Ab + 840);
        r2[14] -= (f32x2v){a80[0], a80[1]} * T11; r2[15] -= (f32x2v){a80[2], a80[3]} * T11;
        const f32x4 a85 = *(const LAS f32x4*)(Ab + 844);
        const float t12 = r2[6][0]; const f32x2v T12 = (f32x2v){t12, t12}; Tw[864] = f2bf(t12); Tt[12] = f2bf(t12);
        r2[6] -= (f32x2v){a81[0], a81[1]} * T12; r2[7] -= (f32x2v){a81[2], a81[3]} * T12;
        const f32x4 a86 = *(const LAS f32x4*)(Ab + 896);
        r2[8] -= (f32x2v){a82[0], a82[1]} * T12; r2[9] -= (f32x2v){a82[2], a82[3]} * T12;
        const f32x4 a87 = *(const LAS f32x4*)(Ab + 900);
        r2[10] -= (f32x2v){a83[0], a83[1]} * T12; r2[11] -= (f32x2v){a83[2], a83[3]} * T12;
        const f32x4 a88 = *(const LAS f32x4*)(Ab + 904);
        r2[12] -= (f32x2v){a84[0], a84[1]} * T12; r2[13] -= (f32x2v){a84[2], a84[3]} * T12;
        const f32x4 a89 = *(const LAS f32x4*)(Ab + 908);
        r2[14] -= (f32x2v){a85[0], a85[1]} * T12; r2[15] -= (f32x2v){a85[2], a85[3]} * T12;
        const f32x4 a90 = *(const LAS f32x4*)(Ab + 912);
        const float t13 = r2[6][1]; const f32x2v T13 = (f32x2v){t13, t13}; Tw[936] = f2bf(t13); Tt[13] = f2bf(t13);
        r2[7] -= (f32x2v){a86[2], a86[3]} * T13;
        const f32x4 a91 = *(const LAS f32x4*)(Ab + 964);
        r2[8] -= (f32x2v){a87[0], a87[1]} * T13; r2[9] -= (f32x2v){a87[2], a87[3]} * T13;
        const f32x4 a92 = *(const LAS f32x4*)(Ab + 968);
        r2[10] -= (f32x2v){a88[0], a88[1]} * T13; r2[11] -= (f32x2v){a88[2], a88[3]} * T13;
        const f32x4 a93 = *(const LAS f32x4*)(Ab + 972);
        r2[12] -= (f32x2v){a89[0], a89[1]} * T13; r2[13] -= (f32x2v){a89[2], a89[3]} * T13;
        const f32x4 a94 = *(const LAS f32x4*)(Ab + 976);
        r2[14] -= (f32x2v){a90[0], a90[1]} * T13; r2[15] -= (f32x2v){a90[2], a90[3]} * T13;
        const f32x4 a95 = *(const LAS f32x4*)(Ab + 980);
        const float t14 = r2[7][0]; const f32x2v T14 = (f32x2v){t14, t14}; Tw[1008] = f2bf(t14); Tt[14] = f2bf(t14);
        r2[7] -= (f32x2v){a91[2], a91[3]} * T14;
        const f32x4 a96 = *(const LAS f32x4*)(Ab + 1036);
        r2[8] -= (f32x2v){a92[0], a92[1]} * T14; r2[9] -= (f32x2v){a92[2], a92[3]} * T14;
        const f32x4 a97 = *(const LAS f32x4*)(Ab + 1040);
        r2[10] -= (f32x2v){a93[0], a93[1]} * T14; r2[11] -= (f32x2v){a93[2], a93[3]} * T14;
        const f32x4 a98 = *(const LAS f32x4*)(Ab + 1044);
        r2[12] -= (f32x2v){a94[0], a94[1]} * T14; r2[13] -= (f32x2v){a94[2], a94[3]} * T14;
        const f32x4 a99 = *(const LAS f32x4*)(Ab + 1048);
        r2[14] -= (f32x2v){a95[0], a95[1]} * T14; r2[15] -= (f32x2v){a95[2], a95[3]} * T14;
        const f32x4 a100 = *(const LAS f32x4*)(Ab + 1104);
        const float t15 = r2[7][1]; const f32x2v T15 = (f32x2v){t15, t15}; Tw[1080] = f2bf(t15); Tt[15] = f2bf(t15);
        r2[8] -= (f32x2v){a96[0], a96[1]} * T15; r2[9] -= (f32x2v){a96[2], a96[3]} * T15;
        const f32x4 a101 = *(const LAS f32x4*)(Ab + 1108);
        r2[10] -= (f32x2v){a97[0], a97[1]} * T15; r2[11] -= (f32x2v){a97[2], a97[3]} * T15;
        const f32x4 a102 = *(const LAS f32x4*)(Ab + 1112);
        r2[12] -= (f32x2v){a98[0], a98[1]} * T15; r2[13] -= (f32x2v){a98[2], a98[3]} * T15;
        const f32x4 a103 = *(const LAS f32x4*)(Ab + 1116);
        r2[14] -= (f32x2v){a99[0], a99[1]} * T15; r2[15] -= (f32x2v){a99[2], a99[3]} * T15;
        const f32x4 a104 = *(const LAS f32x4*)(Ab + 1172);
        const float t16 = r2[8][0]; const f32x2v T16 = (f32x2v){t16, t16}; Tw[1152] = f2bf(t16); Tt[16] = f2bf(t16);
        r2[8] -= (f32x2v){a100[0], a100[1]} * T16; r2[9] -= (f32x2v){a100[2], a100[3]} * T16;
        const f32x4 a105 = *(const LAS f32x4*)(Ab + 1176);
        r2[10] -= (f32x2v){a101[0], a101[1]} * T16; r2[11] -= (f32x2v){a101[2], a101[3]} * T16;
        const f32x4 a106 = *(const LAS f32x4*)(Ab + 1180);
        r2[12] -= (f32x2v){a102[0], a102[1]} * T16; r2[13] -= (f32x2v){a102[2], a102[3]} * T16;
        const f32x4 a107 = *(const LAS f32x4*)(Ab + 1184);
        r2[14] -= (f32x2v){a103[0], a103[1]} * T16; r2[15] -= (f32x2v){a103[2], a103[3]} * T16;
        const f32x4 a108 = *(const LAS f32x4*)(Ab + 1240);
        const float t17 = r2[8][1]; const f32x2v T17 = (f32x2v){t17, t17}; Tw[1224] = f2bf(t17); Tt[17] = f2bf(t17);
        r2[9] -= (f32x2v){a104[2], a104[3]} * T17;
        const f32x4 a109 = *(const LAS f32x4*)(Ab + 1244);
        r2[10] -= (f32x2v){a105[0], a105[1]} * T17; r2[11] -= (f32x2v){a105[2], a105[3]} * T17;
        const f32x4 a110 = *(const LAS f32x4*)(Ab + 1248);
        r2[12] -= (f32x2v){a106[0], a106[1]} * T17; r2[13] -= (f32x2v){a106[2], a106[3]} * T17;
        const f32x4 a111 = *(const LAS f32x4*)(Ab + 1252);
        r2[14] -= (f32x2v){a107[0], a107[1]} * T17; r2[15] -= (f32x2v){a107[2], a107[3]} * T17;
        const f32x4 a112 = *(const LAS f32x4*)(Ab + 1312);
        const float t18 = r2[9][0]; const f32x2v T18 = (f32x2v){t18, t18}; Tw[1296] = f2bf(t18); Tt[18] = f2bf(t18);
        r2[9] -= (f32x2v){a108[2], a108[3]} * T18;
        const f32x4 a113 = *(const LAS f32x4*)(Ab + 1316);
        r2[10] -= (f32x2v){a109[0], a109[1]} * T18; r2[11] -= (f32x2v){a109[2], a109[3]} * T18;
        const f32x4 a114 = *(const LAS f32x4*)(Ab + 1320);
        r2[12] -= (f32x2v){a110[0], a110[1]} * T18; r2[13] -= (f32x2v){a110[2], a110[3]} * T18;
        const f32x4 a115 = *(const LAS f32x4*)(Ab + 1380);
        r2[14] -= (f32x2v){a111[0], a111[1]} * T18; r2[15] -= (f32x2v){a111[2], a111[3]} * T18;
        const f32x4 a116 = *(const LAS f32x4*)(Ab + 1384);
        const float t19 = r2[9][1]; const f32x2v T19 = (f32x2v){t19, t19}; Tw[1368] = f2bf(t19); Tt[19] = f2bf(t19);
        r2[10] -= (f32x2v){a112[0], a112[1]} * T19; r2[11] -= (f32x2v){a112[2], a112[3]} * T19;
        const f32x4 a117 = *(const LAS f32x4*)(Ab + 1388);
        r2[12] -= (f32x2v){a113[0], a113[1]} * T19; r2[13] -= (f32x2v){a113[2], a113[3]} * T19;
        const f32x4 a118 = *(const LAS f32x4*)(Ab + 1448);
        r2[14] -= (f32x2v){a114[0], a114[1]} * T19; r2[15] -= (f32x2v){a114[2], a114[3]} * T19;
        const f32x4 a119 = *(const LAS f32x4*)(Ab + 1452);
        const float t20 = r2[10][0]; const f32x2v T20 = (f32x2v){t20, t20}; Tw[1440] = f2bf(t20); Tt[20] = f2bf(t20);
        r2[10] -= (f32x2v){a115[0], a115[1]} * T20; r2[11] -= (f32x2v){a115[2], a115[3]} * T20;
        const f32x4 a120 = *(const LAS f32x4*)(Ab + 1456);
        r2[12] -= (f32x2v){a116[0], a116[1]} * T20; r2[13] -= (f32x2v){a116[2], a116[3]} * T20;
        const f32x4 a121 = *(const LAS f32x4*)(Ab + 1516);
        r2[14] -= (f32x2v){a117[0], a117[1]} * T20; r2[15] -= (f32x2v){a117[2], a117[3]} * T20;
        const f32x4 a122 = *(const LAS f32x4*)(Ab + 1520);
        const float t21 = r2[10][1]; const f32x2v T21 = (f32x2v){t21, t21}; Tw[1512] = f2bf(t21); Tt[21] = f2bf(t21);
        r2[11] -= (f32x2v){a118[2], a118[3]} * T21;
        const f32x4 a123 = *(const LAS f32x4*)(Ab + 1524);
        r2[12] -= (f32x2v){a119[0], a119[1]} * T21; r2[13] -= (f32x2v){a119[2], a119[3]} * T21;
        const f32x4 a124 = *(const LAS f32x4*)(Ab + 1588);
        r2[14] -= (f32x2v){a120[0], a120[1]} * T21; r2[15] -= (f32x2v){a120[2], a120[3]} * T21;
        const f32x4 a125 = *(const LAS f32x4*)(Ab + 1592);
        const float t22 = r2[11][0]; const f32x2v T22 = (f32x2v){t22, t22}; Tw[1584] = f2bf(t22); Tt[22] = f2bf(t22);
        r2[11] -= (f32x2v){a121[2], a121[3]} * T22;
        const f32x4 a126 = *(const LAS f32x4*)(Ab + 1656);
        r2[12] -= (f32x2v){a122[0], a122[1]} * T22; r2[13] -= (f32x2v){a122[2], a122[3]} * T22;
        const f32x4 a127 = *(const LAS f32x4*)(Ab + 1660);
        r2[14] -= (f32x2v){a123[0], a123[1]} * T22; r2[15] -= (f32x2v){a123[2], a123[3]} * T22;
        const f32x4 a128 = *(const LAS f32x4*)(Ab + 1724);
        const float t23 = r2[11][1]; const f32x2v T23 = (f32x2v){t23, t23}; Tw[1656] = f2bf(t23); Tt[23] = f2bf(t23);
        r2[12] -= (f32x2v){a124[0], a124[1]} * T23; r2[13] -= (f32x2v){a124[2], a124[3]} * T23;
        const f32x4 a129 = *(const LAS f32x4*)(Ab + 1728);
        r2[14] -= (f32x2v){a125[0], a125[1]} * T23; r2[15] -= (f32x2v){a125[2], a125[3]} * T23;
        const f32x4 a130 = *(const LAS f32x4*)(Ab + 1792);
        const float t24 = r2[12][0]; const f32x2v T24 = (f32x2v){t24, t24}; Tw[1728] = f2bf(t24); Tt[24] = f2bf(t24);
        r2[12] -= (f32x2v){a126[0], a126[1]} * T24; r2[13] -= (f32x2v){a126[2], a126[3]} * T24;
        const f32x4 a131 = *(const LAS f32x4*)(Ab + 1796);
        r2[14] -= (f32x2v){a127[0], a127[1]} * T24; r2[15] -= (f32x2v){a127[2], a127[3]} * T24;
        const f32x4 a132 = *(const LAS f32x4*)(Ab + 1864);
        const float t25 = r2[12][1]; const f32x2v T25 = (f32x2v){t25, t25}; Tw[1800] = f2bf(t25); Tt[25] = f2bf(t25);
        r2[13] -= (f32x2v){a128[2], a128[3]} * T25;
        const f32x4 a133 = *(const LAS f32x4*)(Ab + 1932);
        r2[14] -= (f32x2v){a129[0], a129[1]} * T25; r2[15] -= (f32x2v){a129[2], a129[3]} * T25;
        const f32x4 a134 = *(const LAS f32x4*)(Ab + 2000);
        const float t26 = r2[13][0]; const f32x2v T26 = (f32x2v){t26, t26}; Tw[1872] = f2bf(t26); Tt[26] = f2bf(t26);
        r2[13] -= (f32x2v){a130[2], a130[3]} * T26;
        const f32x4 a135 = *(const LAS f32x4*)(Ab + 2068);
        r2[14] -= (f32x2v){a131[0], a131[1]} * T26; r2[15] -= (f32x2v){a131[2], a131[3]} * T26;
        const float t27 = r2[13][1]; const f32x2v T27 = (f32x2v){t27, t27}; Tw[1944] = f2bf(t27); Tt[27] = f2bf(t27);
        r2[14] -= (f32x2v){a132[0], a132[1]} * T27; r2[15] -= (f32x2v){a132[2], a132[3]} * T27;
        const float t28 = r2[14][0]; const f32x2v T28 = (f32x2v){t28, t28}; Tw[2016] = f2bf(t28); Tt[28] = f2bf(t28);
        r2[14] -= (f32x2v){a133[0], a133[1]} * T28; r2[15] -= (f32x2v){a133[2], a133[3]} * T28;
        const float t29 = r2[14][1]; const f32x2v T29 = (f32x2v){t29, t29}; Tw[2088] = f2bf(t29); Tt[29] = f2bf(t29);
        r2[15] -= (f32x2v){a134[2], a134[3]} * T29;
        const float t30 = r2[15][0]; const f32x2v T30 = (f32x2v){t30, t30}; Tw[2160] = f2bf(t30); Tt[30] = f2bf(t30);
        r2[15] -= (f32x2v){a135[2], a135[3]} * T30;
        Tw[2232] = f2bf(r2[15][1]); Tt[31] = f2bf(r2[15][1]);
    } else if (wid == 2) {
        *(LAS u32x4*)(Tb + (lane >> 1) * 72 + 32 + (lane & 1) * 16) = (u32x4){0u, 0u, 0u, 0u}; *(LAS u32x4*)(Tb + (lane >> 1) * 72 + 32 + (lane & 1) * 16 + 8) = (u32x4){0u, 0u, 0u, 0u};
    }
    __syncthreads();
    if (wid < 4) {
        const int mt = wid >> 1, nt = wid & 1; const f32x4 acc = tile_mm(A10b, 40, mt, TT, 40, nt, 1, fr, fq);
        u32x2 w; w.x = cvt_pk(acc[0], acc[1]); w.y = cvt_pk(acc[2], acc[3]); *(LAS u32x2*)(PT + (16 * nt + fr) * 40 + 16 * mt + 4 * fq) = w;
    }
    __syncthreads();
    if (wid < 4) {
        const int mt = wid >> 1, nt = wid & 1; const f32x4 acc = tile_mm(Tb + 32 * 72 + 32, 72, mt, PT, 40, nt, 1, fr, fq);
#pragma unroll
        for (int e = 0; e < 4; ++e) Tb[(32 + 16 * mt + 4 * fq + e) * 72 + 16 * nt + fr] = f2bf(-acc[e]);
    }
    __syncthreads();
#pragma unroll 2
    for (int r = 0; r < 8; ++r) {
        const int job = wid + 8 * r, kind = job >> 5, tile = job & 31, mt = tile >> 3, nt = tile & 7;
        const f32x4 acc = tile_mm<false, true>(Tb, 72, mt, kind ? KbT : VbT, 72, nt, 2, fr, fq);
        u32x2 w; w.x = cvt_pk(acc[0], acc[1]); w.y = cvt_pk(acc[2], acc[3]);
        { const int ch = 16 * nt + fr; *(LAS u32x2*)((kind ? WT : UT) + ch * 72 + 8 * ((2 * mt + (fq >> 1)) ^ ((ch >> 3) & 7)) + 4 * (fq & 1)) = w; }
    }
    __syncthreads();
    bf16_t* GM = (bf16_t*)(p.ws + WS_GM) + (size_t)unit * 16384; bf16_t* GN = (bf16_t*)(p.ws + WS_GN) + (size_t)unit * 16384;
    bf16_t* GQ = (bf16_t*)(p.ws + WS_GQ) + (size_t)unit * 8192; bf16_t* GO = (bf16_t*)(p.ws + WS_GO) + (size_t)unit * 8192;
#pragma unroll 1
    for (int r = 0; r < 12; ++r) {
        const int job = wid + 8 * r;
        if (job < 32) { const int a2 = job >> 3, mt = job & 7;
            const f32x4 c0 = tile_mm<true, true>(WT, 72, 2 * a2, KdT, 72, mt, 2, fr, fq), c1 = tile_mm<true, true>(WT, 72, 2 * a2 + 1, KdT, 72, mt, 2, fr, fq);
            u32x4 w; w.x = cvt_pk(-c0[0], -c0[1]); w.y = cvt_pk(-c0[2], -c0[3]); w.z = cvt_pk(-c1[0], -c1[1]); w.w = cvt_pk(-c1[2], -c1[3]);
            *(u32x4*)(GM + ((mt * 4 + a2) * 64 + lane) * 8) = w;
        } else if (job < 64) { const int j = job - 32, mt2 = j >> 3, nt = j & 7;
            const f32x4 c0 = tile_mm<true, true>(KdT, 72, 2 * mt2, UT, 72, nt, 2, fr, fq), c1 = tile_mm<true, true>(KdT, 72, 2 * mt2 + 1, UT, 72, nt, 2, fr, fq);
            u32x4 w; w.x = cvt_pk(c0[0], c0[1]); w.y = cvt_pk(c0[2], c0[3]); w.z = cvt_pk(c1[0], c1[1]); w.w = cvt_pk(c1[2], c1[3]);
            *(u32x4*)(GN + ((nt * 64 + lane) * 8 + 2 * mt2) * 4) = w;
        } else if (job < 80) { const int j = job - 64, a2 = j >> 2, it = j & 3;
            const f32x4 c0 = tile_mm<true, false>(WT, 72, 2 * a2, QK, 72, it, 2, fr, fq), c1 = tile_mm<true, false>(WT, 72, 2 * a2 + 1, QK, 72, it, 2, fr, fq);
            const int i = 16 * it + fr; const float eg = __expf(gcs[i]);
            const u32x2 q0 = *(const LAS u32x2*)(Qs + i * 136 + 32 * a2 + 4 * fq), q1 = *(const LAS u32x2*)(Qs + i * 136 + 32 * a2 + 16 + 4 * fq);
            u32x4 w; w.x = cvt_pk(bflo(q0.x) * eg - c0[0], bfhi(q0.x) * eg - c0[1]); w.y = cvt_pk(bflo(q0.y) * eg - c0[2], bfhi(q0.y) * eg - c0[3]);
            w.z = cvt_pk(bflo(q1.x) * eg - c1[0], bfhi(q1.x) * eg - c1[1]); w.w = cvt_pk(bflo(q1.y) * eg - c1[2], bfhi(q1.y) * eg - c1[3]);
            *(u32x4*)(GQ + ((it * 4 + a2) * 64 + lane) * 8) = w;
        } else { const int j = job - 80, mt2 = j >> 3, nt = j & 7;
            const f32x4 c0 = tile_mm<false, true>(QK, 72, 2 * mt2, UT, 72, nt, 2, fr, fq), c1 = tile_mm<false, true>(QK, 72, 2 * mt2 + 1, UT, 72, nt, 2, fr, fq);
            u32x4 w; w.x = cvt_pk(c0[0], c0[1]); w.y = cvt_pk(c0[2], c0[3]); w.z = cvt_pk(c1[0], c1[1]); w.w = cvt_pk(c1[2], c1[3]);
            *(u32x4*)(GO + ((nt * 64 + lane) * 4 + 2 * mt2) * 4) = w;
        }
    }
    if (tid == 0) ((float*)(p.ws + WS_CTL + CTL_GLAST))[unit] = __expf(gclast);
    __syncthreads();
}

__device__ __forceinline__ void gdn_scan(const Params& p, LAS unsigned char* lds, int sb) {
    const int tid = threadIdx.x, lane = tid & 63, wid = tid >> 6, fr = lane & 15, fq = lane >> 4;
    const int bh = sb / (8 / CW), sp = sb % (8 / CW), unit0 = bh * 128, sl = sp * CW + wid;
    const u32x4* GMb = (const u32x4*)((const bf16_t*)(p.ws + WS_GM) + (size_t)unit0 * 16384);
    const u32x4* GQb = (const u32x4*)((const bf16_t*)(p.ws + WS_GQ) + (size_t)unit0 * 8192);
    const bf16_t* GNb = (const bf16_t*)(p.ws + WS_GN) + (size_t)unit0 * 16384;
    bf16_t* GOb = (bf16_t*)(p.ws + WS_GO) + (size_t)unit0 * 8192;
    const float* glast = (const float*)(p.ws + WS_CTL + CTL_GLAST) + unit0;
    const bool loader = (wid >= CW && wid < CW + 4);
#define SCAN_DMA(cc) do { _Pragma("unroll") for (int k = 0; k < 8; ++k) { const int inst = (wid - CW) * 8 + k; \
        __builtin_amdgcn_global_load_lds((const unsigned*)((const char*)(GMb + (size_t)(cc) * 2048) + inst * 1024 + lane * 16), (LAS unsigned*)(lds + ((cc) & 3) * 32768 + inst * 1024), 16, 0, 0); } } while (0)
#define SCAN_LOADN(dn, cc) do { const bf16_t* np_ = GNb + (size_t)((cc) < 128 ? (cc) : 127) * 16384 + (size_t)(sl * 64 + lane) * 32; \
        asm volatile("global_load_dwordx4 %0, %4, off\n\tglobal_load_dwordx4 %1, %4, off offset:16\n\tglobal_load_dwordx4 %2, %4, off offset:32\n\tglobal_load_dwordx4 %3, %4, off offset:48" \
            : "=&v"(dn[0]), "=&v"(dn[1]), "=&v"(dn[2]), "=&v"(dn[3]) : "v"(np_) : "memory"); } while (0)
#define SCAN_WAITN(dn, N) asm volatile("s_waitcnt vmcnt(" #N ")" : "+v"(dn[0]), "+v"(dn[1]), "+v"(dn[2]), "+v"(dn[3]) :: "memory")
#define SCAN_STEP(c, nn, RELOAD) do { \
        SCAN_WAITN(nn, 8); \
        const float gl = __shfl(((c) < 64) ? glr0 : glr1, (c) & 63); bf16x8 Sb[4]; \
        bf16_t* scp = (bf16_t*)GNb + (size_t)(c) * 16384 + (size_t)sl * 2048 + lane * 8; \
        _Pragma("unroll") for (int ks = 0; ks < 4; ++ks) { u32x4 w; w.x = cvt_pk(S[2 * ks][0], S[2 * ks][1]); w.y = cvt_pk(S[2 * ks][2], S[2 * ks][3]); \
            w.z = cvt_pk(S[2 * ks + 1][0], S[2 * ks + 1][1]); w.w = cvt_pk(S[2 * ks + 1][2], S[2 * ks + 1][3]); Sb[ks] = __builtin_bit_cast(bf16x8, w); } \
        const LAS unsigned char* slot = lds + ((c) & 3) * 32768 + lane * 16; \
        bf16x8 fa[2][2][4]; \
        _Pragma("unroll") for (int ks = 0; ks < 4; ++ks) { fa[0][0][ks] = *(const LAS bf16x8*)(slot + (0 * 4 + ks) * 1024); fa[0][1][ks] = *(const LAS bf16x8*)(slot + (1 * 4 + ks) * 1024); } \
        _Pragma("unroll") for (int mt = 0; mt < 8; ++mt) { const unsigned w0 = nn[mt >> 1][(mt & 1) * 2], w1 = nn[mt >> 1][(mt & 1) * 2 + 1]; \
            S[mt] = S[mt] * gl + (f32x4){bflo(w0), bfhi(w0), bflo(w1), bfhi(w1)}; } \
        _Pragma("unroll") for (int ks = 0; ks < 4; ++ks) *(u32x4*)(scp + ks * 512) = __builtin_bit_cast(u32x4, Sb[ks]);     \
        RELOAD; \
        _Pragma("unroll") for (int pr = 0; pr < 4; ++pr) { \
            if (pr < 3) { _Pragma("unroll") for (int ks = 0; ks < 4; ++ks) { fa[(pr + 1) & 1][0][ks] = *(const LAS bf16x8*)(slot + ((2 * pr + 2) * 4 + ks) * 1024); fa[(pr + 1) & 1][1][ks] = *(const LAS bf16x8*)(slot + ((2 * pr + 3) * 4 + ks) * 1024); } } \
            _Pragma("unroll") for (int ks = 0; ks < 4; ++ks) { S[2 * pr] = mfma16(fa[pr & 1][0][ks], Sb[ks], S[2 * pr]); S[2 * pr + 1] = mfma16(fa[pr & 1][1][ks], Sb[ks], S[2 * pr + 1]); } } \
        } while (0)
    if (loader) { SCAN_DMA(0); SCAN_DMA(1); SCAN_DMA(2); asm volatile("s_waitcnt vmcnt(0)" ::: "memory"); }
    f32x4 S[8];
#pragma unroll
    for (int mt = 0; mt < 8; ++mt) S[mt] = (f32x4){0.f, 0.f, 0.f, 0.f};
    float glr0 = glast[lane], glr1 = glast[64 + lane];
    asm volatile("" : "+v"(glr0), "+v"(glr1));
    u32x4 nnA[4], nnB[4];
    if (wid < CW) { SCAN_LOADN(nnA, 0); SCAN_LOADN(nnB, 1); SCAN_WAITN(nnA, 0); SCAN_WAITN(nnB, 0); }
    asm volatile("s_waitcnt lgkmcnt(0)" ::: "memory"); __builtin_amdgcn_s_barrier(); asm volatile("" ::: "memory");
#pragma unroll 1
    for (int c = 0; c < 128; c += 2) {
        if (loader) { if (c + 3 < 128) { SCAN_DMA(c + 3); asm volatile("s_waitcnt vmcnt(16)" ::: "memory"); } else asm volatile("s_waitcnt vmcnt(0)" ::: "memory"); }
        else if (wid < CW) { SCAN_STEP(c, nnA, SCAN_LOADN(nnA, c + 2)); }
        asm volatile("s_waitcnt lgkmcnt(0)" ::: "memory"); __builtin_amdgcn_s_barrier(); asm volatile("" ::: "memory");
        if (loader) { if (c + 4 < 128) { SCAN_DMA(c + 4); asm volatile("s_waitcnt vmcnt(16)" ::: "memory"); } else asm volatile("s_waitcnt vmcnt(0)" ::: "memory"); }
        else if (wid < CW) { SCAN_STEP(c + 1, nnB, SCAN_LOADN(nnB, c + 3)); }
        asm volatile("s_waitcnt lgkmcnt(0)" ::: "memory"); __builtin_amdgcn_s_barrier(); asm volatile("" ::: "memory");
    }
#undef SCAN_DMA
#undef SCAN_LOADN
#undef SCAN_WAITN
#undef SCAN_STEP
    __syncthreads();
    if (wid < CW) {
        float* go = p.out + O_GP + (size_t)bh * 16384;
#pragma unroll
        for (int mt = 0; mt < 8; ++mt)
#pragma unroll
            for (int e = 0; e < 4; ++e) go[(16 * mt + 4 * fq + e) * 128 + sl * 16 + fr] = S[mt][e];
    }
}

__device__ __forceinline__ void gdn_gate_unit(const Params& p, LAS unsigned char* lds, int wid, int unit, int lane) {
    const int fr = lane & 15, fq = lane >> 4, bh = unit >> 7, n = unit & 127, b = bh >> 2, h = bh & 3, tok0 = b * SEQ + n * 64;
    bf16_t* PB = (bf16_t*)(p.ws + WS_H);
    LAS bf16_t* ot = (LAS bf16_t*)(lds + wid * 16384);
    LAS float* rl = (LAS float*)(lds + 131072 + wid * 256);
    float ssq[16];
#pragma unroll
    for (int k = 0; k < 16; ++k) ssq[k] = 0.f;
    {
        const bf16_t* GOw = (const bf16_t*)(p.ws + WS_GO) + (size_t)unit * 8192;
        const bf16_t* GQ = (const bf16_t*)(p.ws + WS_GQ) + (size_t)unit * 8192; const bf16_t* SC = (const bf16_t*)(p.ws + WS_GN) + (size_t)unit * 16384;
        bf16x8 qa[4][4];
#pragma unroll
        for (int mt = 0; mt < 4; ++mt)
#pragma unroll
            for (int ks = 0; ks < 4; ++ks) qa[mt][ks] = *(const bf16x8*)(GQ + ((mt * 4 + ks) * 64 + lane) * 8);
#pragma unroll 2
        for (int nt = 0; nt < 8; ++nt) {
            bf16x8 sb[4];
#pragma unroll
            for (int ks = 0; ks < 4; ++ks) sb[ks] = *(const bf16x8*)(SC + nt * 2048 + (ks * 64 + lane) * 8);
            const u32x4 o0 = *(const u32x4*)(GOw + (nt * 64 + lane) * 16), o1 = *(const u32x4*)(GOw + (nt * 64 + lane) * 16 + 8);
            f32x4 acc[4];
            acc[0] = (f32x4){bflo(o0.x), bfhi(o0.x), bflo(o0.y), bfhi(o0.y)}; acc[1] = (f32x4){bflo(o0.z), bfhi(o0.z), bflo(o0.w), bfhi(o0.w)};
            acc[2] = (f32x4){bflo(o1.x), bfhi(o1.x), bflo(o1.y), bfhi(o1.y)}; acc[3] = (f32x4){bflo(o1.z), bfhi(o1.z), bflo(o1.w), bfhi(o1.w)};
#pragma unroll
            for (int ks = 0; ks < 4; ++ks)
#pragma unroll
                for (int mt = 0; mt < 4; ++mt) acc[mt] = mfma16(qa[mt][ks], sb[ks], acc[mt]);
#pragma unroll
            for (int mt = 0; mt < 4; ++mt)
#pragma unroll
                for (int e = 0; e < 4; ++e) { ssq[4 * mt + e] += acc[mt][e] * acc[mt][e];
                    ot[(16 * mt + 4 * fq + e) * 128 + 16 * nt + fr] = f2bf(acc[mt][e]); }
        }
    }
#pragma unroll
    for (int k = 0; k < 16; ++k) { const float s = row16_sum(ssq[k]); if (fr == 0) rl[16 * (k >> 2) + 4 * fq + (k & 3)] = rsqrtf(s * (1.0f / 128.0f) + EPS); }
    asm volatile("s_waitcnt lgkmcnt(0)" ::: "memory");
    const float* gn = p.in[15];
#pragma unroll 4
    for (int k = 0; k < 16; ++k) {
        const int item = lane + 64 * k, t = item >> 4, ch = item & 15;
        const u32x4 ov = *(const LAS u32x4*)(ot + t * 128 + ch * 8);
        const u32x4 gz = *(const u32x4*)(PB + (size_t)(tok0 + t) * PW + 2304 + h * 128 + ch * 8);
        const f32x4 g0 = *(const f32x4*)(gn + ch * 8), g1 = *(const f32x4*)(gn + ch * 8 + 4);
        const float r = rl[t];
        u32x4 w;
        w.x = cvt_pk(bflo(ov.x) * r * g0[0] * silu(bflo(gz.x)), bfhi(ov.x) * r * g0[1] * silu(bfhi(gz.x)));
        w.y = cvt_pk(bflo(ov.y) * r * g0[2] * silu(bflo(gz.y)), bfhi(ov.y) * r * g0[3] * silu(bfhi(gz.y)));
        w.z = cvt_pk(bflo(ov.z) * r * g1[0] * silu(bflo(gz.z)), bfhi(ov.z) * r * g1[1] * silu(bfhi(gz.z)));
        w.w = cvt_pk(bflo(ov.w) * r * g1[2] * silu(bflo(gz.w)), bfhi(ov.w) * r * g1[3] * silu(bfhi(gz.w)));
        *(u32x4*)(PB + (size_t)(tok0 + t) * PW + 512 + h * 128 + ch * 8) = w;
    }
    asm volatile("s_waitcnt lgkmcnt(0)" ::: "memory");
}

__device__ __forceinline__ void attn_unit(const Params& p, LAS unsigned char* lds, int unit) {
    const int tid = threadIdx.x, lane = tid & 63, wid = tid >> 6, fr = lane & 15, fq = lane >> 4;
    const int b = unit >> 7, blk = (unit >> 1) & 63, kvh = unit & 1;
    LAS bf16_t* Ks = (LAS bf16_t*)lds; LAS bf16_t* Vt = (LAS bf16_t*)(lds + 36864);
    bf16_t* PB = (bf16_t*)(p.ws + WS_H);
    __syncthreads();
#pragma unroll
    for (int i = 0; i < 4; ++i) {
        const int q = tid + 512 * i, row = q >> 3, ch = q & 7, tp = blk * 128 - 128 + row;
        u32x4 kv = (u32x4){0u, 0u, 0u, 0u}, vv = (u32x4){0u, 0u, 0u, 0u};
        if (tp >= 0) { const bf16_t* base = PB + (size_t)(b * SEQ + tp) * PW; kv = *(const u32x4*)(base + 512 + kvh * 64 + ch * 8); vv = *(const u32x4*)(base + 640 + kvh * 64 + ch * 8); }
        *(LAS u32x4*)(Ks + row * 72 + ch * 8) = kv;
#pragma unroll
        for (int e = 0; e < 4; ++e) { const unsigned w = vv[e]; Vt[(ch * 8 + 2 * e) * 264 + row] = (bf16_t)(w & 0xffffu); Vt[(ch * 8 + 2 * e + 1) * 264 + row] = (bf16_t)(w >> 16); }
    }
    __syncthreads();
    const int qtok = b * SEQ + blk * 128 + 16 * wid + fr;
#pragma unroll 1
    for (int g = 0; g < 4; ++g) {
        const int h = kvh * 4 + g; const float slope = exp2f(-(float)(h + 1)), sink = p.in[11][h];
        bf16x8 qf[2];
#pragma unroll
        for (int ks = 0; ks < 2; ++ks) qf[ks] = *(const bf16x8*)(PB + (size_t)qtok * PW + h * 64 + ks * 32 + 8 * fq);
        f32x4 s[10]; float mx = sink;
#pragma unroll
        for (int j = 0; j < 10; ++j) {
            const int ct = (wid + j) < 15 ? (wid + j) : 15;
            f32x4 acc = (f32x4){0.f, 0.f, 0.f, 0.f};
#pragma unroll
            for (int ks = 0; ks < 2; ++ks) acc = mfma16(*(const LAS bf16x8*)(Ks + (16 * ct + fr) * 72 + ks * 32 + 8 * fq), qf[ks], acc);
#pragma unroll
            for (int e = 0; e < 4; ++e) {
                const int c = 16 * (wid + j) + 4 * fq + e, dist = 16 * wid + fr - c + 128;
                const bool ok = (wid + j <= 15) && dist >= 0 && dist <= 128 && (blk * 128 + c - 128 >= 0);
                const float v = ok ? acc[e] * 0.125f - slope * (float)dist : -INFINITY;
                acc[e] = v; mx = fmaxf(mx, v);
            }
            s[j] = acc;
            asm volatile("" ::: "memory");
        }
        mx = fmaxf(mx, __shfl_xor(mx, 16)); mx = fmaxf(mx, __shfl_xor(mx, 32));
        float sum = 0.f;
#pragma unroll
        for (int j = 0; j < 10; ++j)
#pragma unroll
            for (int e = 0; e < 4; ++e) { const float pv = __expf(s[j][e] - mx); s[j][e] = pv; sum += pv; }
        sum += __shfl_xor(sum, 16); sum += __shfl_xor(sum, 32);
        sum += __expf(sink - mx);
        const float inv = 1.0f / sum;
        bf16x8 pb[5];
#pragma unroll
        for (int kk = 0; kk < 5; ++kk) { u32x4 w; w.x = cvt_pk(s[2 * kk][0] * inv, s[2 * kk][1] * inv); w.y = cvt_pk(s[2 * kk][2] * inv, s[2 * kk][3] * inv);
            w.z = cvt_pk(s[2 * kk + 1][0] * inv, s[2 * kk + 1][1] * inv); w.w = cvt_pk(s[2 * kk + 1][2] * inv, s[2 * kk + 1][3] * inv); pb[kk] = __builtin_bit_cast(bf16x8, w); }
#pragma unroll
        for (int dt = 0; dt < 4; ++dt) {
            f32x4 acc = (f32x4){0.f, 0.f, 0.f, 0.f};
#pragma unroll
            for (int kk = 0; kk < 5; ++kk) {
                const int c0 = (wid + 2 * kk) < 15 ? (wid + 2 * kk) : 15, c1 = (wid + 2 * kk + 1) < 15 ? (wid + 2 * kk + 1) : 15;
                const u32x2 lo = *(const LAS u32x2*)(Vt + (16 * dt + fr) * 264 + 16 * c0 + 4 * fq), hi = *(const LAS u32x2*)(Vt + (16 * dt + fr) * 264 + 16 * c1 + 4 * fq);
                const u32x4 a = (u32x4){lo.x, lo.y, hi.x, hi.y};
                acc = mfma16(__builtin_bit_cast(bf16x8, a), pb[kk], acc);
            }
            u32x2 w; w.x = cvt_pk(acc[0], acc[1]); w.y = cvt_pk(acc[2], acc[3]);
            *(u32x2*)(PB + (size_t)qtok * PW + h * 64 + 16 * dt + 4 * fq) = w;
            asm volatile("" ::: "memory");
        }
    }
}

__device__ __forceinline__ void sattn_unit(const Params& p, int s, int h, int lane) {
    const int kvh = h >> 2; const bool wr = (h & 3) == 0;
    bf16_t* PB = (bf16_t*)(p.ws + WS_H) + (size_t)(MPR + s) * PW;
    const float* ck = p.in[2] + (size_t)s * 128 * 128 + kvh * 64 + lane; const float* cv = p.in[3] + (size_t)s * 128 * 128 + kvh * 64 + lane;
    float* nk = p.out + O_KS + (size_t)s * 128 * 128 + kvh * 64 + lane; float* nv = p.out + O_VS + (size_t)s * 128 * 128 + kvh * 64 + lane;
    const float q = bf2f(PB[h * 64 + lane]) * 0.125f, slope = exp2f(-(float)(h + 1)), sink = p.in[11][h];
    const float knew = bf2f(PB[512 + kvh * 64 + lane]), vnew = bf2f(PB[640 + kvh * 64 + lane]);
    float sc[3];
#pragma unroll
    for (int t = 0; t < 2; ++t) {
#pragma unroll 8
        for (int jj = 0; jj < 64; ++jj) {
            const int j = t * 64 + jj; const float kval = ck[(size_t)j * 128];
            if (wr && j >= 1) nk[(size_t)(j - 1) * 128] = kval;
            const float d = wave_sum(q * kval) - slope * (float)(128 - j); if (lane == jj) sc[t] = d;
        }
    }
    if (wr) nk[(size_t)127 * 128] = knew;
    sc[2] = wave_sum(q * knew);
    const float mx = fmaxf(fmaxf(wave_max(fmaxf(sc[0], sc[1])), sc[2]), sink);
    const float p0 = __expf(sc[0] - mx), p1 = __expf(sc[1] - mx), p2 = __expf(sc[2] - mx);
    const float inv = 1.0f / (wave_sum(p0 + p1) + p2 + __expf(sink - mx));
    float o = p2 * vnew;
#pragma unroll 8
    for (int jj = 0; jj < 64; ++jj) { const float vval = cv[(size_t)jj * 128]; if (wr && jj >= 1) nv[(size_t)(jj - 1) * 128] = vval; o += __shfl(p0, jj) * vval; }
#pragma unroll 8
    for (int jj = 0; jj < 64; ++jj) { const float vval = cv[(size_t)(64 + jj) * 128]; if (wr) nv[(size_t)(63 + jj) * 128] = vval; o += __shfl(p1, jj) * vval; }
    if (wr) nv[(size_t)127 * 128] = vnew;
    asm volatile("" ::: "memory");
    PB[h * 64 + lane] = f2bf(o * inv);
}

__device__ __forceinline__ void sgdn_unit(const Params& p, LAS unsigned char* lds, int s) {
    const int tid = threadIdx.x, wid = tid >> 6, h = tid >> 7, dv = tid & 127;
    LAS float* qs = (LAS float*)lds; LAS float* ks = qs + 512; LAS float* red = ks + 512;
    bf16_t* PB = (bf16_t*)(p.ws + WS_H) + (size_t)(MPR + s) * PW; const float* GBA = (const float*)(p.ws + WS_GBA) + (size_t)(MPR + s) * 8;
    const float* cw = p.in[12]; const float* hc = p.in[4] + (size_t)s * 3 * CONVC; float* nc = p.out + O_CS + (size_t)s * 3 * CONVC;
    __syncthreads();
    float val[3];
#pragma unroll
    for (int i = 0; i < 3; ++i) {
        const int c = i * 512 + tid; const float x3 = bf2f(PB[768 + c]), h0 = hc[c], h1 = hc[CONVC + c], h2 = hc[2 * CONVC + c];
        val[i] = silu(cw[c] * h0 + cw[CONVC + c] * h1 + cw[2 * CONVC + c] * h2 + cw[3 * CONVC + c] * x3);
        nc[c] = h1; nc[CONVC + c] = h2; nc[2 * CONVC + c] = x3;
    }
    const float sq = wave_sum(val[0] * val[0]), sk = wave_sum(val[1] * val[1]);
    if ((tid & 63) == 0) { red[wid] = sq; red[8 + wid] = sk; }
    __syncthreads();
    const float ssq = red[2 * h] + red[2 * h + 1], ssk = red[8 + 2 * h] + red[8 + 2 * h + 1];
    qs[tid] = val[0] * rsqrtf(ssq + EPS) * 0.08838834764831845f; ks[tid] = val[1] * rsqrtf(ssk + EPS);
    __syncthreads();
    const float beta = 1.0f / (1.0f + __expf(-GBA[h]));
    const float x = GBA[4 + h] + p.in[14][h]; const float sp = x > 20.f ? x : log1pf(__expf(x));
    const float eg = __expf(-__expf(p.in[13][h]) * sp);
    const float* S0 = p.in[5] + ((size_t)(s * 4 + h) * 128) * 128 + dv; float* S1 = p.out + O_GS + ((size_t)(s * 4 + h) * 128) * 128 + dv;
    float kS = 0.f;
#pragma unroll 1
    for (int hf = 0; hf < 4; ++hf) { float sv[32];
#pragma unroll
        for (int dk = 0; dk < 32; ++dk) sv[dk] = S0[(size_t)(hf * 32 + dk) * 128];
#pragma unroll
        for (int dk = 0; dk < 32; ++dk) kS += ks[h * 128 + hf * 32 + dk] * sv[dk]; }
    const float delta = beta * (val[2] - eg * kS);
    float o = 0.f;
#pragma unroll 1
    for (int hf = 0; hf < 4; ++hf) { float sv[32];
#pragma unroll
        for (int dk = 0; dk < 32; ++dk) sv[dk] = S0[(size_t)(hf * 32 + dk) * 128];
#pragma unroll
        for (int dk = 0; dk < 32; ++dk) { const float nvv = eg * sv[dk] + ks[h * 128 + hf * 32 + dk] * delta; S1[(size_t)(hf * 32 + dk) * 128] = nvv; o += qs[h * 128 + hf * 32 + dk] * nvv; } }
    const float so = wave_sum(o * o);
    if ((tid & 63) == 0) red[16 + wid] = so;
    __syncthreads();
    const float tot = red[16 + 2 * h] + red[16 + 2 * h + 1];
    const float gz = bf2f(PB[2304 + tid]);
    PB[512 + tid] = f2bf(o * rsqrtf(tot * (1.0f / 128.0f) + EPS) * p.in[15][dv] * silu(gz));
}

__device__ __forceinline__ void late_weight_items(const Params& p, LAS unsigned char* lds, int gw, int NGW) {
    const int lane = threadIdx.x & 63, wid = threadIdx.x >> 6;
    LAS float* scr = (LAS float*)(lds + wid * 16384);
    bf16_t* WOUTMIX = (bf16_t*)(p.ws + WS_WOUTMIX); bf16_t* W2IN = (bf16_t*)(p.ws + WS_W2IN); bf16_t* W2OUT = (bf16_t*)(p.ws + WS_W2OUT);
    constexpr int I_FIN = 16 * 176, I_FOUT = 44 * 32, I_OUTMIX = 16 * 32;
    for (int it = gw; it < I_FIN + I_FOUT + I_OUTMIX; it += NGW) {
        int r = it;
        if (r < I_OUTMIX) { const int kb = r / 32, nb = r % 32; transpose_item(p.in[16], DM, DM, WOUTMIX, kb * 64, nb * 32, nb * 32, nullptr, scr, lane); continue; } r -= I_OUTMIX;
        if (r < I_FIN) { const int kb = r / 176, nb = r % 176; transpose_item(p.in[18], DM, 2 * DFF, W2IN, kb * 64, nb * 32, map_ffin_row(nb * 32), p.in[17], scr, lane); continue; } r -= I_FIN;
        { const int kb = r / 32, nb = r % 32; transpose_item(p.in[19], DFF, DM, W2OUT, kb * 64, nb * 32, nb * 32, nullptr, scr, lane); }
    }
}
#define XB_TMO      128
#define XB_XCNT(j)  (256  + 64 * (j))
#define XB_XSUB(j)  (1280 + 64 * (j))
#define XB_XGEN(j)  (2304 + 64 * (j))
#define XB_TOP      3328
#define XB_TOPGEN   3392
#define XCD_BAR_WORDS 3456
#define XB_SPIN_CAP (1u << 18)

__device__ __forceinline__ unsigned xb_ld(unsigned* p)              { return __hip_atomic_load(p, __ATOMIC_RELAXED, __HIP_MEMORY_SCOPE_AGENT); }
__device__ __forceinline__ unsigned xb_add(unsigned* p, unsigned v) { return __hip_atomic_fetch_add(p, v, __ATOMIC_RELAXED, __HIP_MEMORY_SCOPE_AGENT); }
__device__ __forceinline__ unsigned xb_xcc_id() { return (unsigned)__builtin_amdgcn_s_getreg((3 << 11) | 20) & 0xFu; }
#define XB_SPIN(cond, bar) do { unsigned _sp = 0; while (cond) { __builtin_amdgcn_s_sleep(1); \
    if ((++_sp & 255u) == 0u) { if (xb_ld(&(bar)[XB_TMO])) break; if (_sp > XB_SPIN_CAP) { atomicAdd(&(bar)[XB_TMO], 1u); break; } } } } while (0)

struct XcdBarrier {
    unsigned* bar; unsigned x;
    volatile LAS unsigned* st;
};

__device__ __forceinline__ XcdBarrier xcd_barrier_post(unsigned* bar, volatile LAS unsigned* st) {
    XcdBarrier b; b.bar = bar; b.x = xb_xcc_id(); b.st = st;
    if (threadIdx.x == 0) (void)xb_add(&bar[XB_XCNT(b.x)], 1u);
    return b;
}
__device__ __forceinline__ void xcd_barrier_complete(unsigned* bar, unsigned x, unsigned& nloc, unsigned& nx) {
    const unsigned G = gridDim.x * gridDim.y * gridDim.z;
    unsigned sum, cnt, mine, sp = 0u;
    for (;;) {
        sum = 0u; cnt = 0u; mine = 0u;
#pragma unroll
        for (unsigned j = 0; j < 16; ++j) { const unsigned c = xb_ld(&bar[XB_XCNT(j)]); sum += c; cnt += (c > 0u) ? 1u : 0u; mine = (j == x) ? c : mine; }
        if (sum == G) break;
        __builtin_amdgcn_s_sleep(1);
        if ((++sp & 255u) == 0u) { if (xb_ld(&bar[XB_TMO])) break; if (sp > XB_SPIN_CAP) { atomicAdd(&bar[XB_TMO], 1u); break; } }
    }
    nloc = mine > 0u ? mine : 1u; nx = cnt > 0u ? cnt : 1u;
}

__device__ __forceinline__ void xcd_barrier(const XcdBarrier& b) {
    asm volatile("s_waitcnt vmcnt(0)" ::: "memory");
    __syncthreads();
    if (threadIdx.x == 0) {
        unsigned* bar = b.bar;
        __builtin_amdgcn_s_waitcnt(0);
        unsigned nloc = b.st[0], nx = b.st[1];
        if (nloc == 0u) { xcd_barrier_complete(bar, b.x, nloc, nx); b.st[0] = nloc; b.st[1] = nx; }
        const unsigned old = xb_add(&bar[XB_XSUB(b.x)], 1u);
        const unsigned gen = old / nloc;
        if (old + 1u == (gen + 1u) * nloc) {
            __builtin_amdgcn_fence(__ATOMIC_RELEASE, "agent");
            asm volatile("s_waitcnt vmcnt(0)" ::: "memory");
            const unsigned og = xb_add(&bar[XB_TOP], 1u);
            const unsigned tg = og / nx;
            if (og + 1u == (tg + 1u) * nx) xb_add(&bar[XB_TOPGEN], 1u);
            else XB_SPIN(xb_ld(&bar[XB_TOPGEN]) == tg, bar);
            __builtin_amdgcn_fence(__ATOMIC_ACQUIRE, "agent");
            xb_add(&bar[XB_XGEN(b.x)], 1u);
            asm volatile("s_waitcnt vmcnt(0)" ::: "memory");
        } else {
            XB_SPIN(xb_ld(&bar[XB_XGEN(b.x)]) == gen, bar);
            __builtin_amdgcn_fence(__ATOMIC_ACQUIRE, "agent");
            asm volatile("s_waitcnt vmcnt(0)" ::: "memory");
        }
    }
    __syncthreads();
}

__global__ void __launch_bounds__(512, 2) fwd_kernel(Params p, int ph_lo, int ph_hi) {
    extern __shared__ __attribute__((aligned(16))) unsigned char lds_raw[];
    LAS unsigned char* lds = (LAS unsigned char*)lds_raw;
    cg::grid_group grid = cg::this_grid();
    if (ph_lo < 0) grid.sync();
    volatile LAS unsigned* bst = (volatile LAS unsigned*)(lds + LDS_PHASE_BYTES);
    if (threadIdx.x < 2) bst[threadIdx.x] = 0u;
    __syncthreads();
    XcdBarrier xbar; xbar.bar = (unsigned*)(p.ws + WS_CTL + CTL_BAR); xbar.x = 0; xbar.st = bst;
    if (ph_hi - ph_lo > 1) xbar = xcd_barrier_post((unsigned*)(p.ws + WS_CTL + CTL_BAR), bst);
    const int tid = threadIdx.x, lane = tid & 63, wid = tid >> 6, G = gridDim.x, bx = blockIdx.x;
    unsigned char* ws = p.ws;
    bf16_t* XN = (bf16_t*)(ws + WS_XN); bf16_t* XN2 = (bf16_t*)(ws + WS_XN2); bf16_t* HB = (bf16_t*)(ws + WS_H);
    float* SS1 = (float*)(ws + WS_SSP1); float* SS2 = (float*)(ws + WS_SSP2);
    float* Y = p.out; bf16_t* X3b = (bf16_t*)(ws + WS_GM);
#ifndef PHMASK
#define PHMASK 0x7ff
#endif
#define IN(k) (((PHMASK >> (k)) & 1) && ph_lo <= (k) && (k) < ph_hi)
#define SEAM(k) do { if (IN(k) && IN((k) + 1)) { xcd_barrier(xbar); }     } while (0)

    if (IN(0)) p0_prologue(p, lds, bx, G);
    SEAM(0);
    if (IN(1)) {
        if (bx < 176) sk_ffn_in<false>(XN, (const bf16_t*)(ws + WS_W1IN), HB, bx, wid, lane & 15, lane >> 4, lds);
        pg8::Gemm g{XN, (const bf16_t*)(ws + WS_W1IN), MPR, 2 * DFF, DM, DM}; pg8::StaticOrder S; S.init(MPR, 2 * DFF, G, bx);
        EpiSwiglu E{HB, nullptr}; pg8::gemm_phase<EpiSwiglu, pg8::StaticOrder, GEMM_ALIGN, GEMM_SP2>(lds, g, S, E);
    }
    SEAM(1);
    if (IN(2)) {
        if (bx < 64) sk_ffn_out<false>(HB, (const bf16_t*)(ws + WS_W1OUT), p.in[1], nullptr, XN + (size_t)MPR * DM, bx, wid, lane & 15, lane >> 4, lds);
        pg8::Gemm g{HB, (const bf16_t*)(ws + WS_W1OUT), MPR, DM, DFF, DFF}; pg8::StaticOrder S; S.init(MPR, DM, G, bx);
        EpiResid<false, false, true, true, true> E{p.in[0], p.in[1], nullptr, XN, SS1}; pg8::gemm_phase<EpiResid<false, false, true, true, true>, pg8::StaticOrder, GEMM_ALIGN, GEMM_SP2>(lds, g, S, E);
    }
    SEAM(2);
    if (IN(3)) {
        if (bx < 89) sk_inproj(XN, (const bf16_t*)(ws + WS_WINMIX), HB, (float*)(ws + WS_GBA), bx, wid, lane & 15, lane >> 4, lds);
        pg8::Gemm g{XN, (const bf16_t*)(ws + WS_WINMIX), MPR, NINP, DM, DM}; pg8::StaticOrder S; S.init(MPR, NINP, G, bx);
        EpiInproj E{HB, (float*)(ws + WS_GBA), SS1}; pg8::gemm_phase<EpiInproj, pg8::StaticOrder, GEMM_ALIGN, GEMM_SP2>(lds, g, S, E);
    }
    SEAM(3);
    if (IN(4)) {
        for (int u = bx; u < 2048; u += G) gdn_prep_unit(p, lds, u);
    }
    SEAM(4);
    if (IN(5)) {
        if (bx < NSCAN) gdn_scan(p, lds, bx);
        else {
            const int ab = bx - NSCAN, NAB = G - NSCAN;
            if (NAB == 192) {
                if (ab < 128) { sattn_unit(p, ab, wid, lane); sgdn_unit(p, lds, ab); attn_unit(p, lds, 2 * ab); attn_unit(p, lds, 2 * ab + 1); }
                else { for (int k = 0; k < 4; ++k) attn_unit(p, lds, 256 + (ab - 128) * 4 + k); }
            } else {
                int it = ab;
#pragma unroll 1
                for (; it < 512; it += NAB) attn_unit(p, lds, it);
#pragma unroll 1
                for (; it < 640; it += NAB) { sattn_unit(p, it - 512, wid, lane); sgdn_unit(p, lds, it - 512); }
            }
            const bf16_t* PB = HB;
            for (int idx = ab * 512 + tid; idx < 149504; idx += NAB * 512) {
                if (idx < 131072) { const int w = idx >> 16, r = idx & 65535, b = r >> 14, j = (r >> 7) & 127, c = r & 127;
                    p.out[(w ? O_VP : O_KP) + r] = bf2f(PB[(size_t)(b * SEQ + SEQ - 128 + j) * PW + 512 + w * 128 + c]);
                } else { const int r = idx - 131072, b = r / (3 * CONVC), q = r % (3 * CONVC), rr = q / CONVC, c = q % CONVC;
                    p.out[O_CP + r] = bf2f(PB[(size_t)(b * SEQ + SEQ - 3 + rr) * PW + 768 + c]); }
            }
            __syncthreads();
            late_weight_items(p, lds, ab * 8 + wid, NAB * 8);
        }
    }
    SEAM(5);
    if (IN(6)) {
        for (int u = bx * 8 + wid; u < 2048; u += G * 8) gdn_gate_unit(p, lds, wid, u, lane);
    }
    SEAM(6);
#ifdef DBG_DUMP
    if (ph_lo == 11) {
        const float* src = (const float*)(ws + DBG_SRC);
        for (size_t i = (size_t)bx * 512 + tid; i < (size_t)MREAL * DM; i += (size_t)G * 512) Y[i] = (i < (size_t)MREAL * 8) ? ((const float*)(ws + WS_GBA))[i] : 0.f;
    }
#endif
    if (IN(7)) {
        if (bx < 32) sk_outproj(HB, (const bf16_t*)(ws + WS_WOUTMIX), XN, nullptr, XN2, bx, wid, lane & 15, lane >> 4, lds);
        pg8::Gemm g{HB, (const bf16_t*)(ws + WS_WOUTMIX), MPR, DM, DM, PW}; pg8::StaticOrder S; S.init(MPR, DM, G, bx);
        EpiResid<true, false, true, true, false> E{XN, XN + (size_t)MPR * DM, nullptr, XN2, SS2}; pg8::gemm_phase<EpiResid<true, false, true, true, false>, pg8::StaticOrder, GEMM_ALIGN, GEMM_SP2>(lds, g, S, E);
    }
    SEAM(7);
    if (IN(8)) {
        if (bx < 176) sk_ffn_in<true>(XN2, (const bf16_t*)(ws + WS_W2IN), HB, bx, wid, lane & 15, lane >> 4, lds);
        pg8::Gemm g{XN2, (const bf16_t*)(ws + WS_W2IN), MPR, 2 * DFF, DM, DM}; pg8::StaticOrder S; S.init(MPR, 2 * DFF, G, bx);
        EpiSwiglu E{HB, SS2}; pg8::gemm_phase<EpiSwiglu, pg8::StaticOrder, GEMM_ALIGN, GEMM_SP2>(lds, g, S, E);
    }
    SEAM(8);
    if (IN(9)) {
        if (bx < 64) sk_ffn_out<true>(HB, (const bf16_t*)(ws + WS_W2OUT), (const float*)(XN2 + (size_t)MPR * DM), nullptr, X3b + (size_t)MPR * DM, bx, wid, lane & 15, lane >> 4, lds);
        pg8::Gemm g{HB, (const bf16_t*)(ws + WS_W2OUT), MPR, DM, DFF, DFF}; pg8::StaticOrder S; S.init(MPR, DM, G, bx);
        EpiResid<true, false, true, false, true> E{XN2, XN2 + (size_t)MPR * DM, nullptr, X3b, nullptr}; pg8::gemm_phase<EpiResid<true, false, true, false, true>, pg8::StaticOrder, GEMM_ALIGN, GEMM_SP2>(lds, g, S, E);
    }
    SEAM(9);
    if (IN(10)) {
        const float* gf = p.in[20]; f32x4 gv[4];
#pragma unroll
        for (int j = 0; j < 4; ++j) gv[j] = *((const f32x4*)gf + lane + 64 * j);
        {
            f32x4 v[4], vn[4]; int m = bx * 8 + wid;
            if (m < MREAL) { const u32x2* xr = (const u32x2*)(X3b + (size_t)m * DM) + lane;
#pragma unroll
                for (int j = 0; j < 4; ++j) { const u32x2 w = xr[64 * j]; v[j] = (f32x4){bflo(w.x), bfhi(w.x), bflo(w.y), bfhi(w.y)}; } }
            for (; m < MREAL; m += G * 8) {
                const int mn = m + G * 8;
                if (mn < MREAL) { const u32x2* xr = (const u32x2*)(X3b + (size_t)mn * DM) + lane;
#pragma unroll
                    for (int j = 0; j < 4; ++j) { const u32x2 w = xr[64 * j]; vn[j] = (f32x4){bflo(w.x), bfhi(w.x), bflo(w.y), bfhi(w.y)}; } }
                float s = 0.f;
#pragma unroll
                for (int j = 0; j < 4; ++j) s += (v[j][0] * v[j][0] + v[j][1] * v[j][1]) + (v[j][2] * v[j][2] + v[j][3] * v[j][3]);
                const float rstd = rsqrtf(wave_sum(s) * (1.0f / DM) + EPS);
                f32x4* yr = (f32x4*)(Y + (size_t)m * DM) + lane;
#pragma unroll
                for (int j = 0; j < 4; ++j) yr[64 * j] = v[j] * rstd * gv[j];
#pragma unroll
                for (int j = 0; j < 4; ++j) v[j] = vn[j];
            }
        }
    }
#undef IN
#undef SEAM
}
}

#ifndef MK_N_LAUNCHES
#define MK_N_LAUNCHES 1
#endif
extern "C" void kernel_launch(void* const* d_in, const int* in_sizes, int n_in, void* d_out, int out_size, void* d_ws, size_t ws_size, hipStream_t stream) {
    static int grid = 0;
    if (grid == 0) {
        if (n_in != 21 || ws_size < mk::WS_END || out_size != 47269888) { fprintf(stderr, "kernel_launch: unexpected shapes (n_in %d, ws %zu, out %d)\n", n_in, ws_size, out_size); grid = -1; return; }
        int dev = 0, cus = 0, per_cu = 0;
        (void)hipGetDevice(&dev); (void)hipDeviceGetAttribute(&cus, hipDeviceAttributeMultiprocessorCount, dev);
        if (hipFuncSetAttribute((const void*)mk::fwd_kernel, hipFuncAttributeMaxDynamicSharedMemorySize, mk::LDS_BYTES) != hipSuccess) { fprintf(stderr, "kernel_launch: hipFuncSetAttribute failed\n"); grid = -1; return; }
        if (hipOccupancyMaxActiveBlocksPerMultiprocessor(&per_cu, (const void*)mk::fwd_kernel, 512, mk::LDS_BYTES) != hipSuccess || per_cu < 1) { fprintf(stderr, "kernel_launch: occupancy query failed (%d)\n", per_cu); per_cu = 1; }
        (void)hipGetLastError();
        grid = cus * per_cu;
        if (grid <= mk::NSCAN) { fprintf(stderr, "kernel_launch: grid %d too small\n", grid); grid = -1; return; }
    }
    if (grid < 0) return;
    (void)hipMemsetAsync((char*)d_ws + mk::WS_CTL + mk::CTL_BAR, 0, mk::CTL_BAR_BYTES, stream);
    mk::Params p{};
    for (int i = 0; i < 21; ++i) p.in[i] = (const float*)d_in[i];
    p.out = (float*)d_out; p.ws = (unsigned char*)d_ws;
#if MK_N_LAUNCHES == 1
    int lo = 0, hi = 11; void* args[] = {&p, &lo, &hi};
    hipError_t e = hipLaunchCooperativeKernel((const void*)mk::fwd_kernel, dim3(grid), dim3(512), args, mk::LDS_BYTES, stream);
    if (e != hipSuccess) fprintf(stderr, "kernel_launch: cooperative launch failed: %s (grid %d)\n", hipGetErrorString(e), grid);
#else
#ifndef MK_LAST
#define MK_LAST 11
#ifndef MK_DOUBLE
#define MK_DOUBLE 0x0
#endif
#define DBG_C0 512
#define DBG_C1 1024
#endif
    for (int ph = 0; ph < MK_LAST; ++ph) { const int reps = ((MK_DOUBLE >> ph) & 1) ? 2 : 1; for (int r = 0; r < reps; ++r) hipLaunchKernelGGL(mk::fwd_kernel, dim3(grid), dim3(512), mk::LDS_BYTES, stream, p, ph, ph + 1); }
#ifdef DBG_DUMP
    hipLaunchKernelGGL(mk::fwd_kernel, dim3(grid), dim3(512), mk::LDS_BYTES, stream, p, 11, 12);
#endif
#endif
}
```

```cpp
#include <hip/hip_runtime.h>
#include <hip/hip_cooperative_groups.h>
#include <cstdio>
namespace cg = cooperative_groups;
namespace pg8 {
#define PG8_LAS __attribute__((address_space(3)))
typedef unsigned short bf16_t;
typedef short bf16x8 __attribute__((ext_vector_type(8)));
typedef float f32x4 __attribute__((ext_vector_type(4)));
typedef unsigned u32x4 __attribute__((ext_vector_type(4)));
constexpr int BM = 256, BK = 64, HALF = 128, HTB = HALF * BK * 2  , STAGE_BYTES = 8 * HTB, NXCD = 8, WGM = 4;

__host__ __device__ __forceinline__ int lds_byte(int r, int c) { const int st = (r >> 4) * 2 + (c >> 5), rr = r & 15, cc = c & 31, ob = rr * 64 + cc * 2; return st * 1024 + (ob ^ (((ob >> 9) & 1) << 5)); }
__host__ __device__ __forceinline__ void stage_rc(int b, int& R, int& C) { const int st = b / 1024, sb = b % 1024, swz = sb ^ (((sb >> 9) & 1) << 5); R = (st >> 1) * 16 + swz / 64; C = (st & 1) * 32 + (swz % 64) / 2; }
__host__ __device__ __forceinline__ int perm32(int rho) { const int n = rho >> 4, i = rho & 15; return 8 * (i >> 2) + 4 * n + (i & 3); }

struct Unit { int pm, pn; };
struct Gemm { const bf16_t* A; const bf16_t* Bt; int M, N, K, lda; };

struct StaticOrder {
    int nM, nN, nwg, G, c, wgm;
    __host__ __device__ void init(int M, int N, int G_, int c_, int wgm_ = WGM) { nM = M / BM; nN = N / BM; nwg = nM * nN; G = G_; c = c_; wgm = wgm_; }
    __host__ __device__ bool next(int i, Unit& u) const {
        const long L = (long)i * G + c; if (L >= nwg) return false;
        int wgid = (int)L; { const int q = nwg / NXCD, r = nwg % NXCD, xcd = wgid % NXCD, off = wgid / NXCD; wgid = (xcd < r ? xcd * (q + 1) : r * (q + 1) + (xcd - r) * q) + off; }
        const int nig = wgm * nN, gid = wgid / nig, fm = gid * wgm, gsz = (nM - fm) < wgm ? (nM - fm) : wgm;
        u.pm = fm + ((wgid % nig) % gsz); u.pn = (wgid % nig) / gsz; return true;
    }
    __device__ __forceinline__ void a_ready(const Unit&) const {}
    __device__ __forceinline__ void done(const Unit&) const {}
};

__device__ __forceinline__ unsigned cvt_pk_bf16(float lo, float hi) { unsigned r; asm volatile("v_cvt_pk_bf16_f32 %0, %1, %2" : "=v"(r) : "v"(lo), "v"(hi)); return r; }
typedef float f32x2 __attribute__((ext_vector_type(2)));
__device__ __forceinline__ f32x2 gelu_pk(f32x2 v) {
    const f32x2 av = __builtin_elementwise_abs(v), d = av * 0.2316418882f + 1.0f;
    f32x2 t; t.x = __builtin_amdgcn_rcpf(d.x); t.y = __builtin_amdgcn_rcpf(d.y);
    f32x2 q = t * 0.5307027145f + (-0.7265760135f); q = q * t + 0.7107068705f; q = q * t + (-0.142248368f); q = q * t + 0.127414796f; q = q * t;
    const f32x2 s = (v * v) * (-0.72134752044f);
    f32x2 e; e.x = __builtin_amdgcn_exp2f(s.x); e.y = __builtin_amdgcn_exp2f(s.y);
    const f32x2 m = v * (q * e), r = v - m;
    f32x2 o; o.x = v.x < 0.f ? m.x : r.x; o.y = v.y < 0.f ? m.y : r.y; return o;
}

template <int ACT  > struct EpiBf16 {
    static constexpr bool PERM = true, AFTER_DRAIN = false; static_assert(ACT == 0 || ACT == 1, "EpiBf16: ACT is 0 (none) or 1 (gelu_pk)");
    bf16_t* O; int ldc; const float* bias; int split_cols; size_t split_stride; float scale0;
    __device__ __forceinline__ void operator()(const f32x4 (&acc)[2][2][4][2], const Unit& u, int wr, int wc, int fr, int fq) const {
        const int row0 = u.pm * BM + wr * 64 + fr; int colt = u.pn * BM; bf16_t* base = O;
        float sc = 1.f; if (split_cols) { const int t = colt / split_cols; base += (size_t)t * split_stride; colt -= t * split_cols; if (t == 0) sc = scale0; }
        const int col0 = colt + wc * 32 + 8 * fq, bcol0 = u.pn * BM + wc * 32 + 8 * fq;
        f32x4 bv[2][2];
#pragma unroll
        for (int bj = 0; bj < 2; ++bj)
#pragma unroll
            for (int n = 0; n < 2; ++n) bv[bj][n] = bias ? *(const f32x4*)(bias + bcol0 + bj * HALF + 4 * n) : (f32x4){0.f, 0.f, 0.f, 0.f};
#pragma unroll
        for (int ai = 0; ai < 2; ++ai)
#pragma unroll
            for (int m = 0; m < 4; ++m) { bf16_t* rowp = base + (size_t)(row0 + ai * HALF + m * 16) * ldc + col0;
#pragma unroll
                for (int bj = 0; bj < 2; ++bj) { f32x4 v0 = acc[ai][bj][m][0] + bv[bj][0], v1 = acc[ai][bj][m][1] + bv[bj][1];
                    if (ACT == 1) { f32x2 a = gelu_pk((f32x2){v0[0], v0[1]}), b = gelu_pk((f32x2){v0[2], v0[3]}), c = gelu_pk((f32x2){v1[0], v1[1]}), d = gelu_pk((f32x2){v1[2], v1[3]});
                        v0 = (f32x4){a.x, a.y, b.x, b.y}; v1 = (f32x4){c.x, c.y, d.x, d.y}; }
                    v0 = v0 * sc; v1 = v1 * sc; u32x4 w; w.x = cvt_pk_bf16(v0[0], v0[1]); w.y = cvt_pk_bf16(v0[2], v0[3]); w.z = cvt_pk_bf16(v1[0], v1[1]); w.w = cvt_pk_bf16(v1[2], v1[3]);
                    *(u32x4*)(rowp + bj * HALF) = w; } }
    }
};

struct PanelStats {
    unsigned* xbuf;
    unsigned* cnt;
    unsigned* tmo;
    int ntn; float eps;
    unsigned code;
    __device__ __forceinline__ bool run(const f32x4 (&v)[2][2][4][2], const Unit& u, int wr, int wc, int fr, int fq, PG8_LAS unsigned char* lds, int wid, int lane) const {
        typedef float f32x2v __attribute__((ext_vector_type(2)));
        PG8_LAS f32x2v* P = (PG8_LAS f32x2v*)lds;
        PG8_LAS f32x2v* S = (PG8_LAS f32x2v*)(lds + 8192);
        PG8_LAS unsigned* flag = (PG8_LAS unsigned*)(lds + 8192 + 2048);
#pragma unroll
        for (int ai = 0; ai < 2; ++ai)
#pragma unroll
            for (int m = 0; m < 4; ++m) {
                float s = 0.f;
#pragma unroll
                for (int bj = 0; bj < 2; ++bj)
#pragma unroll
                    for (int n = 0; n < 2; ++n) { const f32x4 x = v[ai][bj][m][n]; s += (x[0] + x[1]) + (x[2] + x[3]); }
                s += __shfl_xor(s, 16); s += __shfl_xor(s, 32);
                const float mw = s * (1.0f / 64.0f); float q = 0.f;
#pragma unroll
                for (int bj = 0; bj < 2; ++bj)
#pragma unroll
                    for (int n = 0; n < 2; ++n) { const f32x4 d = v[ai][bj][m][n] - mw; q += (d[0] * d[0] + d[1] * d[1]) + (d[2] * d[2] + d[3] * d[3]); }
                q += __shfl_xor(q, 16); q += __shfl_xor(q, 32);
                if (fq == 0) P[(ai * HALF + wr * 64 + m * 16 + fr) * 4 + wc] = (f32x2v){mw, q};
            }
        asm volatile("s_waitcnt lgkmcnt(0)" ::: "memory"); __builtin_amdgcn_s_barrier(); asm volatile("" ::: "memory");
#if defined(BROKEN_EXCHANGE_NO_WAIT)
#warning BROKEN CONTROL BUILD: the row-statistics exchange does not wait; results are wrong by design
        if (blockIdx.x >= 64) { const long long t0_ = clock64(); while (clock64() - t0_ < 60000) __builtin_amdgcn_s_sleep(8); }
#endif
        const int row = wid * 32 + (lane & 31);
        if (lane < 32) {
            const f32x2v a = P[row * 4 + 0], b = P[row * 4 + 1], c = P[row * 4 + 2], d = P[row * 4 + 3];
            const float mt = (a.x + b.x + c.x + d.x) * 0.25f;
            const float da = a.x - mt, db = b.x - mt, dc = c.x - mt, dd = d.x - mt;
            const float m2 = (a.y + b.y) + (c.y + d.y) + 64.0f * ((da * da + db * db) + (dc * dc + dd * dd));
            unsigned long long* slot = (unsigned long long*)xbuf + ((size_t)(u.pm * BM + row) * 4 + u.pn);
            __hip_atomic_store(slot, ((unsigned long long)__float_as_uint(m2) << 32) | __float_as_uint(mt), __ATOMIC_RELAXED, __HIP_MEMORY_SCOPE_AGENT);
        }
        asm volatile("s_waitcnt vmcnt(0)" ::: "memory");
        if (lane == 0) __hip_atomic_fetch_add(cnt + 64 * u.pm, 1u, __ATOMIC_RELAXED, __HIP_MEMORY_SCOPE_AGENT);
        if (wid == 0) {
            bool dead = false; const unsigned long long t0 = __builtin_amdgcn_s_memrealtime(); const unsigned want = 8u * (unsigned)ntn;
            for (;;) {
#if defined(BROKEN_EXCHANGE_NO_WAIT)
                break;
#endif
                if ((unsigned)__builtin_amdgcn_readfirstlane(__hip_atomic_load(cnt + 64 * u.pm, __ATOMIC_RELAXED, __HIP_MEMORY_SCOPE_AGENT)) >= want) break;
                if (__builtin_amdgcn_s_memrealtime() - t0 > 2000000ull) {
                    if (lane == 0) { unsigned expect = 0u; __hip_atomic_compare_exchange_strong(tmo + 1, &expect, code | (unsigned)(u.pm & 0xff), __ATOMIC_RELAXED, __ATOMIC_RELAXED, __HIP_MEMORY_SCOPE_AGENT);
                                     __hip_atomic_store(tmo, 1u, __ATOMIC_RELAXED, __HIP_MEMORY_SCOPE_AGENT); }
                    dead = true; break; }
                __builtin_amdgcn_s_sleep(2);
            }
            __builtin_amdgcn_fence(__ATOMIC_ACQUIRE, "agent");
            if (lane == 0) flag[0] = dead ? 1u : 0u;
        }
        asm volatile("s_waitcnt vmcnt(0) lgkmcnt(0)" ::: "memory"); __builtin_amdgcn_s_barrier(); asm volatile("" ::: "memory");
        const bool bad = flag[0] != 0u;
        if (lane < 32) {
            const unsigned long long* slot = (const unsigned long long*)xbuf + (size_t)(u.pm * BM + row) * 4; float mt[4], m2[4]; float ms = 0.f;
#pragma unroll
            for (int t = 0; t < 4; ++t) { if (t < ntn) { const unsigned long long w = __hip_atomic_load(slot + t, __ATOMIC_RELAXED, __HIP_MEMORY_SCOPE_AGENT); mt[t] = __uint_as_float((unsigned)w); m2[t] = __uint_as_float((unsigned)(w >> 32)); } else { mt[t] = 0.f; m2[t] = 0.f; } ms += mt[t]; }
            const float mean = ms / (float)ntn; float q = 0.f;
#pragma unroll
            for (int t = 0; t < 4; ++t) if (t < ntn) { const float dm = mt[t] - mean; q += m2[t] + 256.0f * dm * dm; }
            S[row] = (f32x2v){mean, 1.0f / sqrtf(q / (256.0f * (float)ntn) + eps)};
        }
        asm volatile("s_waitcnt lgkmcnt(0)" ::: "memory"); __builtin_amdgcn_s_barrier(); asm volatile("" ::: "memory");
        return bad;
    }
};
struct EpiLnRes {
    static constexpr bool PERM = false, AFTER_DRAIN = true;
    const float* base; float* out; int ldc; const float* bias; PanelStats st; unsigned poison;
    __device__ __forceinline__ void fused(f32x4 (&acc)[2][2][4][2], const Unit& u, int wr, int wc, int fr, int fq, PG8_LAS unsigned char* lds, int wid, int lane) const {
        typedef float f32x2v __attribute__((ext_vector_type(2)));
        const PG8_LAS f32x2v* S = (const PG8_LAS f32x2v*)(lds + 8192);
        const int col0 = u.pn * BM + wc * 32 + 4 * fq;
#pragma unroll
        for (int bj = 0; bj < 2; ++bj)
#pragma unroll
            for (int n = 0; n < 2; ++n) { const f32x4 bv = bias ? *(const f32x4*)(bias + col0 + bj * HALF + n * 16) : (f32x4){0.f, 0.f, 0.f, 0.f};
#pragma unroll
                for (int ai = 0; ai < 2; ++ai)
#pragma unroll
                    for (int m = 0; m < 4; ++m) acc[ai][bj][m][n] += bv; }
        f32x4 pre[4][2][2];
#pragma unroll
        for (int m = 0; m < 4; ++m) { const size_t off = (size_t)(u.pm * BM + wr * 64 + m * 16 + fr) * ldc + col0;
#pragma unroll
            for (int bj = 0; bj < 2; ++bj)
#pragma unroll
                for (int n = 0; n < 2; ++n) pre[m][bj][n] = *(const f32x4*)(base + off + bj * HALF + n * 16); }
        const bool bad = st.run(acc, u, wr, wc, fr, fq, lds, wid, lane) || poison != 0u;
        const float qnan = __builtin_nanf("");
#pragma unroll
        for (int ai = 0; ai < 2; ++ai)
#pragma unroll
            for (int m = 0; m < 4; ++m) { const int r = ai * HALF + wr * 64 + m * 16 + fr; const f32x2v sr = S[r]; const size_t off = (size_t)(u.pm * BM + r) * ldc + col0;
#pragma unroll
                for (int bj = 0; bj < 2; ++bj)
#pragma unroll
                    for (int n = 0; n < 2; ++n) { const f32x4 bs = ai == 0 ? pre[m][bj][n] : *(const f32x4*)(base + off + bj * HALF + n * 16); f32x4 o = bs + (acc[ai][bj][m][n] - sr.x) * sr.y;
                        if (bad) o = (f32x4){qnan, qnan, qnan, qnan}; *(f32x4*)(out + off + bj * HALF + n * 16) = o; }
                if (m & 1) asm volatile("" ::: "memory"); }
    }
};
struct EpiLnResLn {
    static constexpr bool PERM = false, AFTER_DRAIN = true;
    const float* base; float* out; bf16_t* xn; int ldc; const float* bias; PanelStats st1, st2; unsigned poison;
    __device__ __forceinline__ void fused(f32x4 (&acc)[2][2][4][2], const Unit& u, int wr, int wc, int fr, int fq, PG8_LAS unsigned char* lds, int wid, int lane) const {
        typedef float f32x2v __attribute__((ext_vector_type(2))); typedef unsigned u32x2v __attribute__((ext_vector_type(2)));
        const PG8_LAS f32x2v* S = (const PG8_LAS f32x2v*)(lds + 8192);
        const int col0 = u.pn * BM + wc * 32 + 4 * fq;
#pragma unroll
        for (int bj = 0; bj < 2; ++bj)
#pragma unroll
            for (int n = 0; n < 2; ++n) { const f32x4 bv = bias ? *(const f32x4*)(bias + col0 + bj * HALF + n * 16) : (f32x4){0.f, 0.f, 0.f, 0.f};
#pragma unroll
                for (int ai = 0; ai < 2; ++ai)
#pragma unroll
                    for (int m = 0; m < 4; ++m) acc[ai][bj][m][n] += bv; }
        bool bad = st1.run(acc, u, wr, wc, fr, fq, lds, wid, lane) || poison != 0u;
        const float qnan = __builtin_nanf("");
#pragma unroll
        for (int ai = 0; ai < 2; ++ai)
#pragma unroll
            for (int m = 0; m < 4; ++m) { const int r = ai * HALF + wr * 64 + m * 16 + fr; const f32x2v sr = S[r]; const size_t off = (size_t)(u.pm * BM + r) * ldc + col0;
#pragma unroll
                for (int bj = 0; bj < 2; ++bj)
#pragma unroll
                    for (int n = 0; n < 2; ++n) { const f32x4 bs = *(const f32x4*)(base + off + bj * HALF + n * 16); acc[ai][bj][m][n] = bs + (acc[ai][bj][m][n] - sr.x) * sr.y; }
                asm volatile("" : "+v"(acc[ai][0][m][0]), "+v"(acc[ai][0][m][1]), "+v"(acc[ai][1][m][0]), "+v"(acc[ai][1][m][1]));
                if (m & 1) asm volatile("" ::: "memory"); }
        const bool bad1 = bad;
        bad = st2.run(acc, u, wr, wc, fr, fq, lds, wid, lane) || bad;
#pragma unroll
        for (int ai = 0; ai < 2; ++ai)
#pragma unroll
            for (int m = 0; m < 4; ++m) { const int r = ai * HALF + wr * 64 + m * 16 + fr; const f32x2v sr = S[r]; const size_t off = (size_t)(u.pm * BM + r) * ldc + col0;
#pragma unroll
                for (int bj = 0; bj < 2; ++bj)
#pragma unroll
                    for (int n = 0; n < 2; ++n) { const f32x4 x1 = acc[ai][bj][m][n]; *(f32x4*)(out + off + bj * HALF + n * 16) = bad1 ? (f32x4){qnan, qnan, qnan, qnan} : x1;
                        const f32x4 o = (x1 - sr.x) * sr.y; u32x2v w; w.x = cvt_pk_bf16(o[0], o[1]); w.y = cvt_pk_bf16(o[2], o[3]);
                        if (bad) { w.x = 0x7fc07fc0u; w.y = 0x7fc07fc0u; } *(u32x2v*)(xn + off + bj * HALF + n * 16) = w; }
                asm volatile("" ::: "memory"); }
    }
};

template <class Epi, class Sched, bool ALIGN_EPI = false, bool SP2 = false>
__device__ __forceinline__ void gemm_phase(PG8_LAS unsigned char* lds, const Gemm g, const Sched S, const Epi E) {
    const int tid = threadIdx.x, wid = __builtin_amdgcn_readfirstlane(tid >> 6), lane = tid & 63, wr = wid >> 2, wc = wid & 3, fr = lane & 15, fq = lane >> 4;
    const int K = g.K, nt = K / BK;
    unsigned voffA[2], voffB[2];
#pragma unroll
    for (int i = 0; i < 2; ++i) { int R, C; stage_rc(tid * 16 + i * 8192, R, C); const int Rb = Epi::PERM ? ((R & ~31) + perm32(R & 31)) : R;
        voffA[i] = (unsigned)(R * g.lda + C) * 2u; voffB[i] = (unsigned)(Rb * K + C) * 2u; }
    const size_t kstep = (size_t)(BK * 2);
    const size_t hstep = (size_t)HALF * K * 2;
    const size_t tstep = 2 * hstep;
    const size_t hstepA = (size_t)HALF * g.lda * 2, tstepA = 2 * hstepA;
    const unsigned ldsw = (unsigned)wid * 1024u;
    const int aoff = lds_byte(wr * 64 + fr, fq * 8), boff = lds_byte(wc * 32 + fr, fq * 8);
#define PG8_SA(b, h) (((b) * 2 + (h)) * HTB)
#define PG8_SB(b, h) ((4 + (b) * 2 + (h)) * HTB)
#define PG8_STAGE(bufoff, gbase, voff) do { _Pragma("unroll") for (int _i = 0; _i < 2; ++_i) \
        __builtin_amdgcn_global_load_lds((const unsigned*)((const char*)(gbase) + (voff)[_i]), (PG8_LAS unsigned*)(lds + (bufoff) + ldsw + _i * 8192), 16, 0, 0); } while (0)
#define PG8_LDA(dst, b, h) do { _Pragma("unroll") for (int m = 0; m < 4; ++m) _Pragma("unroll") for (int k = 0; k < 2; ++k) dst[m][k] = *(const PG8_LAS bf16x8*)(lds + PG8_SA(b, h) + aoff + m * 2048 + k * 1024); } while (0)
#define PG8_LDB(dst, b, h) do { _Pragma("unroll") for (int n = 0; n < 2; ++n) _Pragma("unroll") for (int k = 0; k < 2; ++k) dst[n][k] = *(const PG8_LAS bf16x8*)(lds + PG8_SB(b, h) + boff + n * 2048 + k * 1024); } while (0)
#define PG8_MMA(ai, bj, At, Bt) do { __builtin_amdgcn_s_setprio(1); _Pragma("unroll") for (int m = 0; m < 4; ++m) _Pragma("unroll") for (int n = 0; n < 2; ++n) _Pragma("unroll") for (int k = 0; k < 2; ++k) \
        acc[ai][bj][m][n] = __builtin_amdgcn_mfma_f32_16x16x32_bf16(Bt[n][k], At[m][k], acc[ai][bj][m][n], 0, 0, 0); __builtin_amdgcn_s_setprio(0); } while (0)
#define PG8_WAIT_V(n) asm volatile("s_waitcnt vmcnt(" #n ")" ::: "memory")
#define PG8_WAIT_L(n) asm volatile("s_waitcnt lgkmcnt(" #n ")" ::: "memory")
#define PG8_BAR __builtin_amdgcn_s_barrier()
#define PG8_SCHED __builtin_amdgcn_sched_barrier(0)
    Unit cur, nxt; int ui = 0;
    if (!S.next(0, cur)) return;
    f32x4 acc[2][2][4][2];
#pragma unroll
    for (int a = 0; a < 2; ++a)
#pragma unroll
        for (int b = 0; b < 2; ++b)
#pragma unroll
            for (int m = 0; m < 4; ++m)
#pragma unroll
                for (int n = 0; n < 2; ++n) acc[a][b][m][n] = (f32x4){0.f, 0.f, 0.f, 0.f};
    bf16x8 At[4][2], B0[2][2], B1[2][2];
    const char* cA = (const char*)g.A + (size_t)cur.pm * tstepA; const char* cB = (const char*)g.Bt + (size_t)cur.pn * tstep;
    S.a_ready(cur);
    if constexpr (SP2) {
        PG8_STAGE(PG8_SB(0, 0), cB, voffB); PG8_STAGE(PG8_SB(0, 1), cB + hstep, voffB); PG8_STAGE(PG8_SA(0, 0), cA, voffA); PG8_STAGE(PG8_SA(0, 1), cA + hstepA, voffA);
        if (wr == 1) PG8_BAR;
        PG8_WAIT_V(2); PG8_BAR;
        PG8_STAGE(PG8_SB(1, 0), cB + kstep, voffB); PG8_STAGE(PG8_SA(1, 0), cA + kstep, voffA); PG8_STAGE(PG8_SB(1, 1), cB + hstep + kstep, voffB);
        PG8_WAIT_V(6); PG8_BAR;
    } else {
        PG8_STAGE(PG8_SB(0, 0), cB, voffB); PG8_STAGE(PG8_SA(0, 0), cA, voffA); PG8_STAGE(PG8_SB(0, 1), cB + hstep, voffB); PG8_STAGE(PG8_SA(0, 1), cA + hstepA, voffA);
        if (wr == 1) PG8_BAR;
        PG8_WAIT_V(4); PG8_BAR;
        PG8_STAGE(PG8_SB(1, 0), cB + kstep, voffB); PG8_STAGE(PG8_SA(1, 0), cA + kstep, voffA); PG8_STAGE(PG8_SB(1, 1), cB + hstep + kstep, voffB);
        PG8_WAIT_V(6); PG8_BAR;
    }
    for (;;) {
        const bool has_next = S.next(ui + 1, nxt);
        const char* nA = has_next ? (const char*)g.A + (size_t)nxt.pm * tstepA : cA; const char* nB = has_next ? (const char*)g.Bt + (size_t)nxt.pn * tstep : cB;
        for (int t = 0; t < nt; t += 2) {
            const bool last = (t == nt - 2);
            const char* a1 = cA + (size_t)(t + 1) * kstep;
            const char* a2 = last ? nA : cA + (size_t)(t + 2) * kstep; const char* b2 = last ? nB : cB + (size_t)(t + 2) * kstep;
            const char* a3 = a2 + kstep; const char* b3 = b2 + kstep;
            if (last && has_next) S.a_ready(nxt);
            if constexpr (SP2) {
            PG8_LDB(B0, 0, 0); PG8_LDB(B1, 0, 1); PG8_SCHED; PG8_LDA(At, 0, 0); PG8_STAGE(PG8_SA(1, 1), a1 + hstepA, voffA);
            PG8_WAIT_V(8); PG8_WAIT_L(0); PG8_BAR; PG8_MMA(0, 0, At, B0); PG8_MMA(0, 1, At, B1); PG8_BAR; PG8_SCHED;
            PG8_LDA(At, 0, 1); PG8_STAGE(PG8_SB(0, 0), b2, voffB); PG8_STAGE(PG8_SB(0, 1), b2 + hstep, voffB); PG8_STAGE(PG8_SA(0, 0), a2, voffA);
            PG8_WAIT_V(8); PG8_WAIT_L(0); PG8_BAR; PG8_MMA(1, 0, At, B0); PG8_MMA(1, 1, At, B1); PG8_BAR; PG8_SCHED;
            PG8_LDB(B0, 1, 0); PG8_LDB(B1, 1, 1); PG8_SCHED; PG8_LDA(At, 1, 0); PG8_STAGE(PG8_SA(0, 1), a2 + hstepA, voffA);
            PG8_WAIT_V(8); PG8_WAIT_L(0); PG8_BAR; PG8_MMA(0, 0, At, B0); PG8_MMA(0, 1, At, B1); PG8_BAR; PG8_SCHED;
            PG8_LDA(At, 1, 1); PG8_STAGE(PG8_SB(1, 0), b3, voffB); PG8_STAGE(PG8_SB(1, 1), b3 + hstep, voffB); PG8_STAGE(PG8_SA(1, 0), a3, voffA);
            PG8_WAIT_V(8); PG8_WAIT_L(0); PG8_BAR; PG8_MMA(1, 0, At, B0); PG8_MMA(1, 1, At, B1); PG8_BAR; PG8_SCHED;
            } else {
            PG8_LDB(B0, 0, 0); PG8_SCHED; PG8_LDA(At, 0, 0); PG8_STAGE(PG8_SA(1, 1), a1 + hstepA, voffA);
            PG8_WAIT_L(8); PG8_BAR; PG8_WAIT_L(0); PG8_MMA(0, 0, At, B0); PG8_BAR; PG8_SCHED;
            PG8_LDB(B1, 0, 1); PG8_STAGE(PG8_SB(0, 0), b2, voffB);
            PG8_BAR; PG8_WAIT_L(0); PG8_MMA(0, 1, At, B1); PG8_BAR;
            PG8_LDA(At, 0, 1); PG8_STAGE(PG8_SA(0, 0), a2, voffA);
            PG8_BAR; PG8_WAIT_L(0); PG8_MMA(1, 0, At, B0); PG8_BAR; PG8_SCHED;
            PG8_STAGE(PG8_SB(0, 1), b2 + hstep, voffB);
            PG8_WAIT_V(6); PG8_BAR; PG8_MMA(1, 1, At, B1); PG8_BAR;
            PG8_LDB(B0, 1, 0); PG8_SCHED; PG8_LDA(At, 1, 0); PG8_STAGE(PG8_SA(0, 1), a2 + hstepA, voffA);
            PG8_WAIT_L(8); PG8_BAR; PG8_WAIT_L(0); PG8_MMA(0, 0, At, B0); PG8_BAR; PG8_SCHED;
            PG8_LDB(B1, 1, 1); PG8_STAGE(PG8_SB(1, 0), b3, voffB);
            PG8_BAR; PG8_WAIT_L(0); PG8_MMA(0, 1, At, B1); PG8_BAR;
            PG8_LDA(At, 1, 1); PG8_STAGE(PG8_SA(1, 0), a3, voffA);
            PG8_BAR; PG8_WAIT_L(0); PG8_MMA(1, 0, At, B0); PG8_BAR; PG8_SCHED;
            PG8_STAGE(PG8_SB(1, 1), b3 + hstep, voffB);
            PG8_WAIT_V(6); PG8_BAR; PG8_MMA(1, 1, At, B1); PG8_BAR;
            }
        }
        if constexpr (ALIGN_EPI) { if (wr == 0) PG8_BAR; }
        if constexpr (!Epi::AFTER_DRAIN) { E(acc, cur, wr, wc, fr, fq); S.done(cur); }
        if (!has_next) break;
#pragma unroll
        for (int a = 0; a < 2; ++a)
#pragma unroll
            for (int b = 0; b < 2; ++b)
#pragma unroll
                for (int m = 0; m < 4; ++m)
#pragma unroll
                    for (int n = 0; n < 2; ++n) acc[a][b][m][n] = (f32x4){0.f, 0.f, 0.f, 0.f};
        cur = nxt; cA = nA; cB = nB; ++ui;
        if constexpr (ALIGN_EPI) { if (wr == 1) PG8_BAR; }
    }
    PG8_WAIT_V(0);
    if constexpr (!ALIGN_EPI) { if (wr == 0) PG8_BAR; }
    PG8_BAR;
    if constexpr (Epi::AFTER_DRAIN) { E.fused(acc, cur, wr, wc, fr, fq, lds, wid, lane); S.done(cur); }
#undef PG8_SA
#undef PG8_SB
#undef PG8_STAGE
#undef PG8_LDA
#undef PG8_LDB
#undef PG8_MMA
#undef PG8_WAIT_V
#undef PG8_WAIT_L
#undef PG8_BAR
#undef PG8_SCHED
}
}

#ifndef GEMM_SP2
#define GEMM_SP2 true
#endif
#ifndef GEMM_ALIGN
#define GEMM_ALIGN true
#endif
#ifndef WGM_FIN
#define WGM_FIN 8
#endif
namespace mk {
#define LAS __attribute__((address_space(3)))
using pg8::bf16_t; using pg8::bf16x8; using pg8::f32x4; using pg8::u32x4;
typedef unsigned u32x2 __attribute__((ext_vector_type(2)));

constexpr int DM = 1024, SEQ = 8192, NBATCH = 4, MPR = NBATCH * SEQ, MSAMP = 128, MREAL = MPR + MSAMP, MPAD = 33024;
constexpr int DFF = 2816, PW = 2816, NINP = 3072, CONVC = 1536;
constexpr float EPS = 1e-6f;
#ifndef SCAN_CW
#define SCAN_CW 2
#endif
constexpr int CW = SCAN_CW, NSCAN = 128 / CW;
constexpr int LDS_PHASE_BYTES = 155648, LDS_BYTES = LDS_PHASE_BYTES + 256;

constexpr size_t O_YP = 0, O_YS = 33554432, O_KP = 33685504, O_VP = 33751040, O_CP = 33816576, O_GP = 33835008,
                 O_KS = 34097152, O_VS = 36194304, O_CS = 38291456, O_GS = 38881280;
constexpr size_t MiB = 1u << 20;
constexpr size_t WS_CTL = 0, CTL_ZERO_BYTES = 1 * MiB;
constexpr size_t WS_W1IN = 1 * MiB, WS_W1OUT = 12 * MiB, WS_WINMIX = 18 * MiB, WS_WOUTMIX = 24 * MiB, WS_W2IN = 26 * MiB, WS_W2OUT = 37 * MiB;
constexpr size_t WS_GBA = 43 * MiB, WS_XN = 45 * MiB, WS_XN2 = 110 * MiB, WS_H = 175 * MiB, WS_GM = 353 * MiB, WS_GN = 417 * MiB;
constexpr size_t WS_GQ = 110 * MiB, WS_GO = 142 * MiB;
constexpr size_t WS_SSP1 = 481 * MiB, WS_SSP2 = 484 * MiB;
constexpr size_t WS_END = 487 * MiB;
constexpr size_t CTL_BAR = 0, CTL_BAR_BYTES = 16384, CTL_GLAST = 768 * 1024;

struct Params { const float* in[21]; float* out; unsigned char* ws; };

typedef float f32x2v __attribute__((ext_vector_type(2)));
typedef __bf16 bf16x2v __attribute__((ext_vector_type(2)));
__device__ __forceinline__ unsigned cvt_pk(float lo, float hi) { const f32x2v v = {lo, hi}; const bf16x2v b = __builtin_convertvector(v, bf16x2v); return __builtin_bit_cast(unsigned, b); }
__device__ __forceinline__ bf16_t f2bf(float f) { return (bf16_t)(cvt_pk(f, 0.f) & 0xffffu); }
__device__ __forceinline__ float bf2f(bf16_t h) { return __uint_as_float(((unsigned)h) << 16); }
__device__ __forceinline__ float bflo(unsigned w) { return __uint_as_float(w << 16); }
__device__ __forceinline__ float bfhi(unsigned w) { return __uint_as_float(w & 0xffff0000u); }
__device__ __forceinline__ float silu(float x) { return x * __builtin_amdgcn_rcpf(1.0f + __expf(-x)); }
__device__ __forceinline__ float wave_sum(float v) {
#pragma unroll
    for (int o = 1; o < 64; o <<= 1) v += __shfl_xor(v, o);
    return v;
}
__device__ __forceinline__ float wave_max(float v) {
#pragma unroll
    for (int o = 1; o < 64; o <<= 1) v = fmaxf(v, __shfl_xor(v, o));
    return v;
}
__device__ __forceinline__ float row16_sum(float v) {
    v += __builtin_bit_cast(float, __builtin_amdgcn_update_dpp(0, __builtin_bit_cast(int, v), 0xB1, 0xF, 0xF, true));
    v += __builtin_bit_cast(float, __builtin_amdgcn_update_dpp(0, __builtin_bit_cast(int, v), 0x4E, 0xF, 0xF, true));
    v += __builtin_bit_cast(float, __builtin_amdgcn_update_dpp(0, __builtin_bit_cast(int, v), 0x141, 0xF, 0xF, true));
    v += __builtin_bit_cast(float, __builtin_amdgcn_update_dpp(0, __builtin_bit_cast(int, v), 0x140, 0xF, 0xF, true));
    return v;
}
__device__ __forceinline__ f32x4 mfma16(bf16x8 a, bf16x8 b, f32x4 c) { return __builtin_amdgcn_mfma_f32_16x16x32_bf16(a, b, c, 0, 0, 0); }

__device__ __forceinline__ float row_rstd(const float* ssp, int r) {
    if (r >= MREAL) return 0.f;
    const f32x4 a = *(const f32x4*)(ssp + (size_t)r * 16), b = *(const f32x4*)(ssp + (size_t)r * 16 + 4), c = *(const f32x4*)(ssp + (size_t)r * 16 + 8), d = *(const f32x4*)(ssp + (size_t)r * 16 + 12);
    const float s = (((a[0] + a[1]) + (a[2] + a[3])) + ((b[0] + b[1]) + (b[2] + b[3]))) + (((c[0] + c[1]) + (c[2] + c[3])) + ((d[0] + d[1]) + (d[2] + d[3])));
    return rsqrtf(s * (1.0f / DM) + EPS);
}
__device__ __forceinline__ float row_rstd4(const float* ssp, int r, int fq) {
    const f32x4 a = *(const f32x4*)(ssp + (size_t)r * 16 + 4 * fq);
    float s = (a[0] + a[1]) + (a[2] + a[3]);
    s += __shfl_xor(s, 16); s += __shfl_xor(s, 32);
    return rsqrtf(s * (1.0f / DM) + EPS);
}
__device__ __forceinline__ void swiglu2(float g0, float u0, float g1, float u1, float& h0, float& h1) {
    const float c0 = fmaxf(g0, -40.f), c1 = fmaxf(g1, -40.f);
    const float a = 1.0f + __expf(-c0), b = 1.0f + __expf(-c1), r = __builtin_amdgcn_rcpf(a * b);
    h0 = c0 * (r * b) * u0; h1 = c1 * (r * a) * u1;
}
struct EpiSwiglu {
    static constexpr bool PERM = true, AFTER_DRAIN = false;
    bf16_t* H; const float* ss;
    __device__ __forceinline__ void operator()(const f32x4 (&acc)[2][2][4][2], const pg8::Unit& u, int wr, int wc, int fr, int fq) const {
        const int row0 = u.pm * 256 + wr * 64 + fr, col0 = u.pn * 128 + wc * 32 + 8 * fq;
#pragma unroll
        for (int ai = 0; ai < 2; ++ai)
#pragma unroll
            for (int m = 0; m < 4; ++m) {
                const int r = row0 + ai * 128 + m * 16;
                const float rs = ss ? row_rstd4(ss, r, fq) : 1.0f;
                float h[8];
#pragma unroll
                for (int n = 0; n < 2; ++n)
#pragma unroll
                    for (int j = 0; j < 4; j += 2) swiglu2(acc[ai][0][m][n][j] * rs, acc[ai][1][m][n][j] * rs, acc[ai][0][m][n][j + 1] * rs, acc[ai][1][m][n][j + 1] * rs, h[n * 4 + j], h[n * 4 + j + 1]);
                u32x4 w; w.x = cvt_pk(h[0], h[1]); w.y = cvt_pk(h[2], h[3]); w.z = cvt_pk(h[4], h[5]); w.w = cvt_pk(h[6], h[7]);
                *(u32x4*)(H + (size_t)r * DFF + col0) = w;
            }
    }
};
template <bool RESB16, bool WF32, bool WB16, bool SUMSQ, bool HALF> struct EpiResid {
    static constexpr bool PERM = true, AFTER_DRAIN = false;
    const void* resP; const void* resS; float* Yo; bf16_t* XBo; float* sso;
    __device__ __forceinline__ void operator()(const f32x4 (&acc)[2][2][4][2], const pg8::Unit& u, int wr, int wc, int fr, int fq) const {
        const int row0 = u.pm * 256 + wr * 64 + fr, col0 = u.pn * 256 + wc * 32 + 8 * fq;
        const char* const rP = (const char*)resP; const char* const rS = (const char*)resS - (size_t)MPR * DM * (RESB16 ? 2 : 4);
        float* const Y = Yo; const float scale = HALF ? 0.5f : 1.0f; bf16_t* const XB = XBo; float* const ss = sso;
#pragma unroll
        for (int ai = 0; ai < 2; ++ai)
#pragma unroll
            for (int m = 0; m < 4; ++m) {
                const int r = row0 + ai * 128 + m * 16; float s = 0.f;
                if (r < MREAL) {
                    const char* rp = ((r < MPR) ? rP : rS) + (size_t)r * DM * (RESB16 ? 2 : 4);
#pragma unroll
                    for (int bj = 0; bj < 2; ++bj) {
                        const int c = col0 + bj * 128;
                        f32x4 r0, r1;
                        if (RESB16) { const u32x4 w = *(const u32x4*)(rp + (size_t)c * 2); r0 = (f32x4){bflo(w.x), bfhi(w.x), bflo(w.y), bfhi(w.y)}; r1 = (f32x4){bflo(w.z), bfhi(w.z), bflo(w.w), bfhi(w.w)}; }
                        else { r0 = *(const f32x4*)(rp + (size_t)c * 4); r1 = *(const f32x4*)(rp + (size_t)c * 4 + 16); }
                        const f32x4 v0 = r0 + acc[ai][bj][m][0] * scale, v1 = r1 + acc[ai][bj][m][1] * scale;
                        if (WF32) { *(f32x4*)(Y + (size_t)r * DM + c) = v0; *(f32x4*)(Y + (size_t)r * DM + c + 4) = v1; }
                        if (WB16) { u32x4 w; w.x = cvt_pk(v0[0], v0[1]); w.y = cvt_pk(v0[2], v0[3]); w.z = cvt_pk(v1[0], v1[1]); w.w = cvt_pk(v1[2], v1[3]);
                            *(u32x4*)(XB + (size_t)r * DM + c) = w; }
                        if (SUMSQ) s += (v0[0] * v0[0] + v0[1] * v0[1]) + (v0[2] * v0[2] + v0[3] * v0[3]) + (v1[0] * v1[0] + v1[1] * v1[1]) + (v1[2] * v1[2] + v1[3] * v1[3]);
                    }
                }
                if (SUMSQ) { s += __shfl_xor(s, 16); s += __shfl_xor(s, 32); if (fq == 0 && r < MREAL) ss[(size_t)r * 16 + u.pn * 4 + wc] = s; }
            }
    }
};
struct EpiInproj {
    static constexpr bool PERM = true, AFTER_DRAIN = false;
    bf16_t* P; float* gba; const float* ss;
    __device__ __forceinline__ void operator()(const f32x4 (&acc)[2][2][4][2], const pg8::Unit& u, int wr, int wc, int fr, int fq) const {
        const int row0 = u.pm * 256 + wr * 64 + fr, col0 = u.pn * 256 + wc * 32 + 8 * fq;
#pragma unroll
        for (int ai = 0; ai < 2; ++ai)
#pragma unroll
            for (int m = 0; m < 4; ++m) {
                const int r = row0 + ai * 128 + m * 16;
                const float rs = row_rstd4(ss, r, fq);
                if (u.pn < 11) {
#pragma unroll
                    for (int bj = 0; bj < 2; ++bj) { const f32x4 v0 = acc[ai][bj][m][0] * rs, v1 = acc[ai][bj][m][1] * rs;
                        u32x4 w; w.x = cvt_pk(v0[0], v0[1]); w.y = cvt_pk(v0[2], v0[3]); w.z = cvt_pk(v1[0], v1[1]); w.w = cvt_pk(v1[2], v1[3]);
                        *(u32x4*)(P + (size_t)r * PW + col0 + bj * 128) = w; }
                } else if (wc == 0 && fq == 0) {
                    *(f32x4*)(gba + (size_t)r * 8) = acc[ai][0][m][0] * rs; *(f32x4*)(gba + (size_t)r * 8 + 4) = acc[ai][0][m][1] * rs;
                }
            }
    }
};


template <int NT, bool SS>
__device__ __forceinline__ void skinny_mm(const bf16_t* A, int lda, const bf16_t* W, int K, int wrow0, int wrow1, int wid, int fr, int fq, f32x4 (&acc)[NT], float& ss, LAS unsigned char* lds) {
    const int lane = fq * 16 + fr, kper = K >> 3, nks = kper >> 5;
    const bf16_t* ap = A + (size_t)fr * lda + wid * kper + 8 * fq;
    const bf16_t* w0 = W + (size_t)(wrow0 + fr) * K + wid * kper + 8 * fq; const bf16_t* w1 = W + (size_t)(wrow1 + fr) * K + wid * kper + 8 * fq;
    f32x4 pa[NT][8]; float sp[8];
#pragma unroll
    for (int mt = 0; mt < 8; ++mt) { sp[mt] = 0.f;
#pragma unroll
        for (int nt = 0; nt < NT; ++nt) pa[nt][mt] = (f32x4){0.f, 0.f, 0.f, 0.f}; }
#pragma unroll 2
    for (int ks = 0; ks < nks; ++ks) {
        const bf16x8 b0 = *(const bf16x8*)(w0 + 32 * ks); bf16x8 b1 = b0; if (NT == 2) b1 = *(const bf16x8*)(w1 + 32 * ks);
        bf16x8 av[8];
#pragma unroll
        for (int mt = 0; mt < 8; ++mt) av[mt] = *(const bf16x8*)(ap + (size_t)(16 * mt) * lda + 32 * ks);
#pragma unroll
        for (int mt = 0; mt < 8; ++mt) {
            pa[0][mt] = mfma16(b0, av[mt], pa[0][mt]);
            if (NT == 2) pa[NT - 1][mt] = mfma16(b1, av[mt], pa[NT - 1][mt]);
            if (SS) { const u32x4 u = __builtin_bit_cast(u32x4, av[mt]);
#pragma unroll
                for (int k = 0; k < 4; ++k) { const float lo = bflo(u[k]), hi = bfhi(u[k]); sp[mt] += lo * lo + hi * hi; } }
        }
    }
    LAS f32x4* red = (LAS f32x4*)lds;
    LAS float* sred = (LAS float*)(lds + 8 * NT * 8 * 64 * 16);
#pragma unroll
    for (int mt = 0; mt < 8; ++mt) {
#pragma unroll
        for (int nt = 0; nt < NT; ++nt) red[((wid * NT + nt) * 8 + mt) * 64 + lane] = pa[nt][mt];
        if (SS) sred[(wid * 8 + mt) * 64 + lane] = sp[mt];
    }
    __syncthreads();
    float s = 0.f;
#pragma unroll
    for (int nt = 0; nt < NT; ++nt) acc[nt] = (f32x4){0.f, 0.f, 0.f, 0.f};
#pragma unroll
    for (int v = 0; v < 8; ++v) {
#pragma unroll
        for (int nt = 0; nt < NT; ++nt) acc[nt] += red[((v * NT + nt) * 8 + wid) * 64 + lane];
        if (SS) s += sred[(v * 8 + wid) * 64 + lane];
    }
    if (SS) { s += __shfl_xor(s, 16); s += __shfl_xor(s, 32); }
    ss = s;
    __syncthreads();
}
template <bool SS> __device__ __forceinline__ void sk_ffn_in(const bf16_t* X, const bf16_t* Wt, bf16_t* H, int slab, int wid, int fr, int fq, LAS unsigned char* lds) {
    const int j0 = 16 * slab, wr0 = (j0 >> 7) * 256 + (j0 & 127);
    f32x4 acc[2]; float ss;
    skinny_mm<2, SS>(X + (size_t)MPR * DM, DM, Wt, DM, wr0, wr0 + 128, wid, fr, fq, acc, ss, lds);
    const float rs = SS ? rsqrtf(ss * (1.0f / DM) + EPS) : 1.0f;
    float h[4];
#pragma unroll
    for (int e = 0; e < 4; ++e) h[e] = silu(acc[0][e] * rs) * (acc[1][e] * rs);
    u32x2 w; w.x = cvt_pk(h[0], h[1]); w.y = cvt_pk(h[2], h[3]);
    *(u32x2*)(H + (size_t)(MPR + 16 * wid + fr) * DFF + j0 + 4 * fq) = w;
}
template <bool OUTF32> __device__ __forceinline__ void sk_ffn_out(const bf16_t* Hb, const bf16_t* Wt, const float* resf, float* outf, bf16_t* outb, int slab, int wid, int fr, int fq, LAS unsigned char* lds) {
    f32x4 acc[1]; float ss;
    skinny_mm<1, false>(Hb + (size_t)MPR * DFF, DFF, Wt, DFF, 16 * slab, 0, wid, fr, fq, acc, ss, lds);
    const int rl = 16 * wid + fr, c = 16 * slab + 4 * fq;
    f32x4 rv;
    if (OUTF32) { const u32x2 xr = *(const u32x2*)((const bf16_t*)resf + (size_t)rl * DM + c); rv = (f32x4){bflo(xr.x), bfhi(xr.x), bflo(xr.y), bfhi(xr.y)}; }
    else rv = *(const f32x4*)(resf + (size_t)rl * DM + c);
    const f32x4 v = rv + acc[0] * 0.5f;
    { u32x2 w; w.x = cvt_pk(v[0], v[1]); w.y = cvt_pk(v[2], v[3]); *(u32x2*)(outb + (size_t)rl * DM + c) = w; }
}
__device__ __forceinline__ void sk_inproj(const bf16_t* X, const bf16_t* Wt, bf16_t* P, float* gba, int slab, int wid, int fr, int fq, LAS unsigned char* lds) {
    const int n0 = 32 * slab; f32x4 acc[2]; float ss;
    skinny_mm<2, true>(X + (size_t)MPR * DM, DM, Wt, DM, n0, n0 + 16, wid, fr, fq, acc, ss, lds);
    const float rs = rsqrtf(ss * (1.0f / DM) + EPS); const int r = MPR + 16 * wid + fr;
    if (n0 < PW) {
#pragma unroll
        for (int nt = 0; nt < 2; ++nt) { const f32x4 v = acc[nt] * rs; u32x2 w; w.x = cvt_pk(v[0], v[1]); w.y = cvt_pk(v[2], v[3]); *(u32x2*)(P + (size_t)r * PW + n0 + 16 * nt + 4 * fq) = w; }
    } else if (fq < 2) *(f32x4*)(gba + (size_t)r * 8 + 4 * fq) = acc[0] * rs;
}
__device__ __forceinline__ void sk_outproj(const bf16_t* Pm, const bf16_t* Wt, const bf16_t* X1b, float* X2f, bf16_t* X2b, int slab, int wid, int fr, int fq, LAS unsigned char* lds) {
    const int n0 = 32 * slab; f32x4 acc[2]; float ss;
    skinny_mm<2, false>(Pm + (size_t)MPR * PW, PW, Wt, DM, n0, n0 + 16, wid, fr, fq, acc, ss, lds);
    const int r = MPR + 16 * wid + fr;
#pragma unroll
    for (int nt = 0; nt < 2; ++nt) { const int c = n0 + 16 * nt + 4 * fq; const u32x2 xr = *(const u32x2*)(X1b + (size_t)r * DM + c);
        const f32x4 v = (f32x4){bflo(xr.x), bfhi(xr.x), bflo(xr.y), bfhi(xr.y)} + acc[nt];
        u32x2 w; w.x = cvt_pk(v[0], v[1]); w.y = cvt_pk(v[2], v[3]); *(u32x2*)(X2b + (size_t)r * DM + c) = w; }
}

__device__ __forceinline__ void transpose_item(const float* W, int K, int N, bf16_t* WT, int k0, int n0, int drow0, const float* gs, LAS float* scr, int lane) {
    float wv[32];
#pragma unroll
    for (int i = 0; i < 32; ++i) { const int kk = 2 * i + (lane >> 5), n = n0 + (lane & 31); wv[i] = (n < N) ? W[(size_t)(k0 + kk) * N + n] : 0.f; }
#pragma unroll
    for (int i = 0; i < 32; ++i) { const int kk = 2 * i + (lane >> 5); float v = wv[i]; if (gs) v *= gs[k0 + kk]; scr[kk * 33 + (lane & 31)] = v; }
    asm volatile("s_waitcnt lgkmcnt(0)" ::: "memory");
    const int c = lane & 7;
#pragma unroll
    for (int j = 0; j < 4; ++j) { const int nn = (lane >> 3) + 8 * j; const LAS float* s = scr + (8 * c) * 33 + nn;
        u32x4 o; o.x = cvt_pk(s[0 * 33], s[1 * 33]); o.y = cvt_pk(s[2 * 33], s[3 * 33]); o.z = cvt_pk(s[4 * 33], s[5 * 33]); o.w = cvt_pk(s[6 * 33], s[7 * 33]);
        *(u32x4*)(WT + (size_t)(drow0 + nn) * K + k0 + 8 * c) = o; }
    asm volatile("s_waitcnt lgkmcnt(0)" ::: "memory");
}
__device__ __forceinline__ int map_ffin_row(int n0) { return n0 < DFF ? (n0 >> 7) * 256 + (n0 & 127) : ((n0 - DFF) >> 7) * 256 + 128 + ((n0 - DFF) & 127); }

__device__ __forceinline__ void p0_prologue(const Params& p, LAS unsigned char* lds, int vb, int G) {
    const int tid = threadIdx.x, lane = tid & 63, wid = tid >> 6;
    LAS float* scr = (LAS float*)(lds + wid * 16384);
    const int gw = vb * 8 + wid, NGW = G * 8;
    bf16_t* W1IN = (bf16_t*)(p.ws + WS_W1IN); bf16_t* W1OUT = (bf16_t*)(p.ws + WS_W1OUT); bf16_t* WINMIX = (bf16_t*)(p.ws + WS_WINMIX);
    bf16_t* WOUTMIX = (bf16_t*)(p.ws + WS_WOUTMIX); bf16_t* W2IN = (bf16_t*)(p.ws + WS_W2IN); bf16_t* W2OUT = (bf16_t*)(p.ws + WS_W2OUT);
    constexpr int I_FIN = 16 * 176, I_FOUT = 44 * 32, I_INMIX = 16 * 89;
    constexpr int NITEMS = I_FIN + I_FOUT + I_INMIX;
    for (int it = gw; it < NITEMS; it += NGW) {
        int r = it;
        if (r < I_FIN) { const int kb = r / 176, nb = r % 176; transpose_item(p.in[7], DM, 2 * DFF, W1IN, kb * 64, nb * 32, map_ffin_row(nb * 32), nullptr, scr, lane); continue; } r -= I_FIN;
        if (r < I_FOUT) { const int kb = r / 32, nb = r % 32; transpose_item(p.in[8], DFF, DM, W1OUT, kb * 64, nb * 32, nb * 32, nullptr, scr, lane); continue; } r -= I_FOUT;
        { const int kb = r / 89, nb = r % 89; transpose_item(p.in[10], DM, 2824, WINMIX, kb * 64, nb * 32, nb * 32, p.in[9], scr, lane); }
    }
    bf16_t* XN = (bf16_t*)(p.ws + WS_XN); const float* g1 = p.in[6];
    f32x4 gv[4];
#pragma unroll
    for (int j = 0; j < 4; ++j) gv[j] = *((const f32x4*)g1 + lane + 64 * j);
    {
        f32x4 v[4], vn[4];
        int m = gw;
        if (m < MREAL) { const f32x4* xr = (const f32x4*)((m < MPR) ? p.in[0] + (size_t)m * DM : p.in[1] + (size_t)(m - MPR) * DM) + lane;
#pragma unroll
            for (int j = 0; j < 4; ++j) v[j] = xr[64 * j]; }
        for (; m < MREAL; m += NGW) {
            const int mn = m + NGW;
            if (mn < MREAL) { const f32x4* xr = (const f32x4*)((mn < MPR) ? p.in[0] + (size_t)mn * DM : p.in[1] + (size_t)(mn - MPR) * DM) + lane;
#pragma unroll
                for (int j = 0; j < 4; ++j) vn[j] = xr[64 * j]; }
            float s = 0.f;
#pragma unroll
            for (int j = 0; j < 4; ++j) s += (v[j][0] * v[j][0] + v[j][1] * v[j][1]) + (v[j][2] * v[j][2] + v[j][3] * v[j][3]);
            const float rstd = rsqrtf(wave_sum(s) * (1.0f / DM) + EPS);
            unsigned long long* o8 = (unsigned long long*)(XN + (size_t)m * DM) + lane;
#pragma unroll
            for (int j = 0; j < 4; ++j) { const f32x4 y = v[j] * rstd * gv[j];
                o8[64 * j] = (unsigned long long)cvt_pk(y[0], y[1]) | ((unsigned long long)cvt_pk(y[2], y[3]) << 32); }
#pragma unroll
            for (int j = 0; j < 4; ++j) v[j] = vn[j];
        }
    }
}

template <bool SWX = false, bool SWY = false>
__device__ __forceinline__ f32x4 tile_mm(const LAS bf16_t* X, int ldx, int mt, const LAS bf16_t* Y, int ldy, int nt, int nks, int fr, int fq) {
    f32x4 acc = (f32x4){0.f, 0.f, 0.f, 0.f};
    const int rx = 16 * mt + fr, ry = 16 * nt + fr, sx = SWX ? ((rx >> 3) & 7) : 0, sy = SWY ? ((ry >> 3) & 7) : 0;
    const LAS bf16_t* xp = X + rx * ldx; const LAS bf16_t* yp = Y + ry * ldy;
    for (int ks = 0; ks < nks; ++ks) acc = mfma16(*(const LAS bf16x8*)(xp + 8 * ((4 * ks + fq) ^ sx)), *(const LAS bf16x8*)(yp + 8 * ((4 * ks + fq) ^ sy)), acc);
    return acc;
}
constexpr int G1_QS = 0, G1_KS = 17408, G1_VBT = 34816, G1_KBT = 53248, G1_KDT = 71680, G1_UT = 90112, G1_WT = 108544, G1_QK = 126976, G1_TB = 136192, G1_GC = 145408, G1_BETA = 145664, G1_TT = 146176, G1_A10 = 148736, G1_PT = 151296;

__device__ __forceinline__ void gdn_prep_unit(const Params& p, LAS unsigned char* lds, int unit) {
    const int tid = threadIdx.x, lane = tid & 63, wid = tid >> 6, fr = lane & 15, fq = lane >> 4;
    const int bh = unit >> 7, n = unit & 127, b = bh >> 2, h = bh & 3;
    const int tok0 = b * SEQ + n * 64;
    LAS bf16_t* Qs = (LAS bf16_t*)(lds + G1_QS); LAS bf16_t* Ks = (LAS bf16_t*)(lds + G1_KS); LAS bf16_t* VbT = (LAS bf16_t*)(lds + G1_VBT);
    LAS bf16_t* KbT = (LAS bf16_t*)(lds + G1_KBT); LAS bf16_t* KdT = (LAS bf16_t*)(lds + G1_KDT); LAS bf16_t* UT = (LAS bf16_t*)(lds + G1_UT);
    LAS bf16_t* WT = (LAS bf16_t*)(lds + G1_WT); LAS float* Af = (LAS float*)(lds + G1_WT); LAS bf16_t* QK = (LAS bf16_t*)(lds + G1_QK);
    LAS bf16_t* Tb = (LAS bf16_t*)(lds + G1_TB); LAS bf16_t* TT = (LAS bf16_t*)(lds + G1_TT); LAS bf16_t* A10b = (LAS bf16_t*)(lds + G1_A10); LAS bf16_t* PT = (LAS bf16_t*)(lds + G1_PT); LAS float* gcs = (LAS float*)(lds + G1_GC); LAS float* betas = (LAS float*)(lds + G1_BETA);
    const bf16_t* PB = (const bf16_t*)(p.ws + WS_H); const float* GBA = (const float*)(p.ws + WS_GBA);
    LAS unsigned char* raw = lds + G1_UT;
    for (int pc4 = wid; pc4 < 51; pc4 += 8) {
        int pc = pc4 * 4 + (lane >> 4); pc = pc < 200 ? pc : 200;
        const int r = pc / 3, seg = pc - 3 * r; int tt = n * 64 - 3 + r; tt = tt < 0 ? 0 : tt;
        __builtin_amdgcn_global_load_lds((const unsigned*)(PB + (size_t)(b * SEQ + tt) * PW + 768 + seg * 512 + h * 128 + (lane & 15) * 8), (LAS unsigned*)(raw + pc4 * 1024), 16, 0, 0);
    }
    if (tid < 64) {
        const float* gb = GBA + (size_t)(tok0 + tid) * 8;
        const float bt = 1.0f / (1.0f + __expf(-gb[h]));
        const float x = gb[4 + h] + p.in[14][h]; const float sp = x > 20.f ? x : log1pf(__expf(x));
        float c = -__expf(p.in[13][h]) * sp;
#pragma unroll
        for (int o = 1; o < 64; o <<= 1) { const float t = __shfl_up(c, o); if (lane >= o) c += t; }
        gcs[tid] = c; betas[tid] = bt;
    }
    asm volatile("s_waitcnt vmcnt(0)" ::: "memory");
    __syncthreads();
    const float gclast = gcs[63];
    const float* cw = p.in[12];
    f32x4 cwv[4][2];
#pragma unroll 1
    for (int it = 0; it < 6; ++it) {
        const int item = tid + 512 * it, l16 = item & 15, row = item >> 4, which = row >> 6, t = row & 63;
        const int cch = which * 512 + h * 128 + l16 * 8;
        if ((it & 1) == 0) {
#pragma unroll
            for (int j = 0; j < 4; ++j) { cwv[j][0] = *(const f32x4*)(cw + j * CONVC + cch); cwv[j][1] = *(const f32x4*)(cw + j * CONVC + cch + 4); }
        }
        float a[8];
#pragma unroll
        for (int e = 0; e < 8; ++e) a[e] = 0.f;
#pragma unroll
        for (int j = 0; j < 4; ++j) {
            const int tt = n * 64 + t - 3 + j;
            u32x4 xv = *(const LAS u32x4*)(raw + ((t + j) * 3 + which) * 256 + l16 * 16);
            if (tt < 0) xv = (u32x4){0u, 0u, 0u, 0u};
            const f32x4 w0 = cwv[j][0], w1 = cwv[j][1];
            a[0] += w0[0] * bflo(xv.x); a[1] += w0[1] * bfhi(xv.x); a[2] += w0[2] * bflo(xv.y); a[3] += w0[3] * bfhi(xv.y);
            a[4] += w1[0] * bflo(xv.z); a[5] += w1[1] * bfhi(xv.z); a[6] += w1[2] * bflo(xv.w); a[7] += w1[3] * bfhi(xv.w);
        }
        float ss = 0.f;
#pragma unroll
        for (int e = 0; e < 8; ++e) { a[e] = silu(a[e]); ss += a[e] * a[e]; }
        ss = row16_sum(ss);
        const float gct = gcs[t], bt = betas[t];
        const int tsw = (((t >> 3) ^ (l16 & 7)) << 3) | (t & 7);
        if (which == 0) {
            const float sc = rsqrtf(ss + EPS) * 0.08838834764831845f;
            u32x4 w; w.x = cvt_pk(a[0] * sc, a[1] * sc); w.y = cvt_pk(a[2] * sc, a[3] * sc); w.z = cvt_pk(a[4] * sc, a[5] * sc); w.w = cvt_pk(a[6] * sc, a[7] * sc);
            *(LAS u32x4*)(Qs + t * 136 + l16 * 8) = w;
        } else if (which == 1) {
            const float sc = rsqrtf(ss + EPS);
            u32x4 w; w.x = cvt_pk(a[0] * sc, a[1] * sc); w.y = cvt_pk(a[2] * sc, a[3] * sc); w.z = cvt_pk(a[4] * sc, a[5] * sc); w.w = cvt_pk(a[6] * sc, a[7] * sc);
            *(LAS u32x4*)(Ks + t * 136 + l16 * 8) = w;
            const float sb = sc * bt * __expf(gct), sd = sc * __expf(gclast - gct);
#pragma unroll
            for (int e = 0; e < 8; ++e) { KbT[(l16 * 8 + e) * 72 + tsw] = f2bf(a[e] * sb); KdT[(l16 * 8 + e) * 72 + tsw] = f2bf(a[e] * sd); }
        } else {
#pragma unroll
            for (int e = 0; e < 8; ++e) VbT[(l16 * 8 + e) * 72 + tsw] = f2bf(a[e] * bt);
        }
    }
    __syncthreads();
#pragma unroll 2
    for (int r = 0; r < 4; ++r) {
        const int job = wid + 8 * r, kind = job >> 4, tile = job & 15, it = tile >> 2, jt = tile & 3;
        if (kind == 0) {
            if (jt > it) continue;
            const f32x4 acc = tile_mm(Ks, 136, it, Ks, 136, jt, 4, fr, fq);
            const int j = 16 * jt + fr; const float gcj = gcs[j];
            float v[4];
#pragma unroll
            for (int e = 0; e < 4; ++e) { const int i = 16 * it + 4 * fq + e; const bool ok = i > j; v[e] = ok ? acc[e] * __expf(gcs[i] - gcj) * betas[i] : 0.f; }
            *(LAS f32x4*)(Af + j * 68 + 16 * it + 4 * fq) = (f32x4){v[0], v[1], v[2], v[3]};
            if (it >= 2 && jt < 2) {
#pragma unroll
                for (int e = 0; e < 4; ++e) A10b[(16 * (it - 2) + 4 * fq + e) * 40 + j] = f2bf(v[e]); }
        } else {
            const f32x4 acc = tile_mm(Ks, 136, jt, Qs, 136, it, 4, fr, fq);
            const int i = 16 * it + fr; const float gci = gcs[i];
            float v[4];
#pragma unroll
            for (int e = 0; e < 4; ++e) { const int j = 16 * jt + 4 * fq + e; const bool ok = i >= j; v[e] = ok ? acc[e] * __expf(gci - gcs[j]) : 0.f; }
            u32x2 w; w.x = cvt_pk(v[0], v[1]); w.y = cvt_pk(v[2], v[3]); *(LAS u32x2*)(QK + i * 72 + 16 * jt + 4 * fq) = w;
        }
    }
    __syncthreads();
    if (wid < 2) {
        const int ofs = wid * 32, cl = lane & 31; const LAS float* Ab = Af + ofs * 69; LAS bf16_t* Tw = Tb + ofs * 73 + cl; LAS bf16_t* Tt = (wid == 0) ? TT + cl * 40 : PT + cl * 40;
        f32x2v r2[16];
#pragma unroll
        for (int k = 0; k < 16; ++k) r2[k] = (f32x2v){(cl == 2 * k) ? 1.0f : 0.0f, (cl == 2 * k + 1) ? 1.0f : 0.0f};
        const f32x4 a0 = *(const LAS f32x4*)(Ab + 0);
        const f32x4 a1 = *(const LAS f32x4*)(Ab + 4);
        const f32x4 a2 = *(const LAS f32x4*)(Ab + 8);
        const f32x4 a3 = *(const LAS f32x4*)(Ab + 12);
        const f32x4 a4 = *(const LAS f32x4*)(Ab + 16);
        const float t0 = r2[0][0]; const f32x2v T0 = (f32x2v){t0, t0}; Tw[0] = f2bf(t0); Tt[0] = f2bf(t0);
        r2[0] -= (f32x2v){a0[0], a0[1]} * T0; r2[1] -= (f32x2v){a0[2], a0[3]} * T0;
        const f32x4 a5 = *(const LAS f32x4*)(Ab + 20);
        r2[2] -= (f32x2v){a1[0], a1[1]} * T0; r2[3] -= (f32x2v){a1[2], a1[3]} * T0;
        const f32x4 a6 = *(const LAS f32x4*)(Ab + 24);
        r2[4] -= (f32x2v){a2[0], a2[1]} * T0; r2[5] -= (f32x2v){a2[2], a2[3]} * T0;
        const f32x4 a7 = *(const LAS f32x4*)(Ab + 28);
        r2[6] -= (f32x2v){a3[0], a3[1]} * T0; r2[7] -= (f32x2v){a3[2], a3[3]} * T0;
        const f32x4 a8 = *(const LAS f32x4*)(Ab + 68);
        r2[8] -= (f32x2v){a4[0], a4[1]} * T0; r2[9] -= (f32x2v){a4[2], a4[3]} * T0;
        const f32x4 a9 = *(const LAS f32x4*)(Ab + 72);
        r2[10] -= (f32x2v){a5[0], a5[1]} * T0; r2[11] -= (f32x2v){a5[2], a5[3]} * T0;
        const f32x4 a10 = *(const LAS f32x4*)(Ab + 76);
        r2[12] -= (f32x2v){a6[0], a6[1]} * T0; r2[13] -= (f32x2v){a6[2], a6[3]} * T0;
        const f32x4 a11 = *(const LAS f32x4*)(Ab + 80);
        r2[14] -= (f32x2v){a7[0], a7[1]} * T0; r2[15] -= (f32x2v){a7[2], a7[3]} * T0;
        const f32x4 a12 = *(const LAS f32x4*)(Ab + 84);
        const float t1 = r2[0][1]; const f32x2v T1 = (f32x2v){t1, t1}; Tw[72] = f2bf(t1); Tt[1] = f2bf(t1);
        r2[1] -= (f32x2v){a8[2], a8[3]} * T1;
        const f32x4 a13 = *(const LAS f32x4*)(Ab + 88);
        r2[2] -= (f32x2v){a9[0], a9[1]} * T1; r2[3] -= (f32x2v){a9[2], a9[3]} * T1;
        const f32x4 a14 = *(const LAS f32x4*)(Ab + 92);
        r2[4] -= (f32x2v){a10[0], a10[1]} * T1; r2[5] -= (f32x2v){a10[2], a10[3]} * T1;
        const f32x4 a15 = *(const LAS f32x4*)(Ab + 96);
        r2[6] -= (f32x2v){a11[0], a11[1]} * T1; r2[7] -= (f32x2v){a11[2], a11[3]} * T1;
        const f32x4 a16 = *(const LAS f32x4*)(Ab + 136);
        r2[8] -= (f32x2v){a12[0], a12[1]} * T1; r2[9] -= (f32x2v){a12[2], a12[3]} * T1;
        const f32x4 a17 = *(const LAS f32x4*)(Ab + 140);
        r2[10] -= (f32x2v){a13[0], a13[1]} * T1; r2[11] -= (f32x2v){a13[2], a13[3]} * T1;
        const f32x4 a18 = *(const LAS f32x4*)(Ab + 144);
        r2[12] -= (f32x2v){a14[0], a14[1]} * T1; r2[13] -= (f32x2v){a14[2], a14[3]} * T1;
        const f32x4 a19 = *(const LAS f32x4*)(Ab + 148);
        r2[14] -= (f32x2v){a15[0], a15[1]} * T1; r2[15] -= (f32x2v){a15[2], a15[3]} * T1;
        const f32x4 a20 = *(const LAS f32x4*)(Ab + 152);
        const float t2 = r2[1][0]; const f32x2v T2 = (f32x2v){t2, t2}; Tw[144] = f2bf(t2); Tt[2] = f2bf(t2);
        r2[1] -= (f32x2v){a16[2], a16[3]} * T2;
        const f32x4 a21 = *(const LAS f32x4*)(Ab + 156);
        r2[2] -= (f32x2v){a17[0], a17[1]} * T2; r2[3] -= (f32x2v){a17[2], a17[3]} * T2;
        const f32x4 a22 = *(const LAS f32x4*)(Ab + 160);
        r2[4] -= (f32x2v){a18[0], a18[1]} * T2; r2[5] -= (f32x2v){a18[2], a18[3]} * T2;
        const f32x4 a23 = *(const LAS f32x4*)(Ab + 164);
        r2[6] -= (f32x2v){a19[0], a19[1]} * T2; r2[7] -= (f32x2v){a19[2], a19[3]} * T2;
        const f32x4 a24 = *(const LAS f32x4*)(Ab + 208);
        r2[8] -= (f32x2v){a20[0], a20[1]} * T2; r2[9] -= (f32x2v){a20[2], a20[3]} * T2;
        const f32x4 a25 = *(const LAS f32x4*)(Ab + 212);
        r2[10] -= (f32x2v){a21[0], a21[1]} * T2; r2[11] -= (f32x2v){a21[2], a21[3]} * T2;
        const f32x4 a26 = *(const LAS f32x4*)(Ab + 216);
        r2[12] -= (f32x2v){a22[0], a22[1]} * T2; r2[13] -= (f32x2v){a22[2], a22[3]} * T2;
        const f32x4 a27 = *(const LAS f32x4*)(Ab + 220);
        r2[14] -= (f32x2v){a23[0], a23[1]} * T2; r2[15] -= (f32x2v){a23[2], a23[3]} * T2;
        const f32x4 a28 = *(const LAS f32x4*)(Ab + 224);
        const float t3 = r2[1][1]; const f32x2v T3 = (f32x2v){t3, t3}; Tw[216] = f2bf(t3); Tt[3] = f2bf(t3);
        r2[2] -= (f32x2v){a24[0], a24[1]} * T3; r2[3] -= (f32x2v){a24[2], a24[3]} * T3;
        const f32x4 a29 = *(const LAS f32x4*)(Ab + 228);
        r2[4] -= (f32x2v){a25[0], a25[1]} * T3; r2[5] -= (f32x2v){a25[2], a25[3]} * T3;
        const f32x4 a30 = *(const LAS f32x4*)(Ab + 232);
        r2[6] -= (f32x2v){a26[0], a26[1]} * T3; r2[7] -= (f32x2v){a26[2], a26[3]} * T3;
        const f32x4 a31 = *(const LAS f32x4*)(Ab + 276);
        r2[8] -= (f32x2v){a27[0], a27[1]} * T3; r2[9] -= (f32x2v){a27[2], a27[3]} * T3;
        const f32x4 a32 = *(const LAS f32x4*)(Ab + 280);
        r2[10] -= (f32x2v){a28[0], a28[1]} * T3; r2[11] -= (f32x2v){a28[2], a28[3]} * T3;
        const f32x4 a33 = *(const LAS f32x4*)(Ab + 284);
        r2[12] -= (f32x2v){a29[0], a29[1]} * T3; r2[13] -= (f32x2v){a29[2], a29[3]} * T3;
        const f32x4 a34 = *(const LAS f32x4*)(Ab + 288);
        r2[14] -= (f32x2v){a30[0], a30[1]} * T3; r2[15] -= (f32x2v){a30[2], a30[3]} * T3;
        const f32x4 a35 = *(const LAS f32x4*)(Ab + 292);
        const float t4 = r2[2][0]; const f32x2v T4 = (f32x2v){t4, t4}; Tw[288] = f2bf(t4); Tt[4] = f2bf(t4);
        r2[2] -= (f32x2v){a31[0], a31[1]} * T4; r2[3] -= (f32x2v){a31[2], a31[3]} * T4;
        const f32x4 a36 = *(const LAS f32x4*)(Ab + 296);
        r2[4] -= (f32x2v){a32[0], a32[1]} * T4; r2[5] -= (f32x2v){a32[2], a32[3]} * T4;
        const f32x4 a37 = *(const LAS f32x4*)(Ab + 300);
        r2[6] -= (f32x2v){a33[0], a33[1]} * T4; r2[7] -= (f32x2v){a33[2], a33[3]} * T4;
        const f32x4 a38 = *(const LAS f32x4*)(Ab + 344);
        r2[8] -= (f32x2v){a34[0], a34[1]} * T4; r2[9] -= (f32x2v){a34[2], a34[3]} * T4;
        const f32x4 a39 = *(const LAS f32x4*)(Ab + 348);
        r2[10] -= (f32x2v){a35[0], a35[1]} * T4; r2[11] -= (f32x2v){a35[2], a35[3]} * T4;
        const f32x4 a40 = *(const LAS f32x4*)(Ab + 352);
        r2[12] -= (f32x2v){a36[0], a36[1]} * T4; r2[13] -= (f32x2v){a36[2], a36[3]} * T4;
        const f32x4 a41 = *(const LAS f32x4*)(Ab + 356);
        r2[14] -= (f32x2v){a37[0], a37[1]} * T4; r2[15] -= (f32x2v){a37[2], a37[3]} * T4;
        const f32x4 a42 = *(const LAS f32x4*)(Ab + 360);
        const float t5 = r2[2][1]; const f32x2v T5 = (f32x2v){t5, t5}; Tw[360] = f2bf(t5); Tt[5] = f2bf(t5);
        r2[3] -= (f32x2v){a38[2], a38[3]} * T5;
        const f32x4 a43 = *(const LAS f32x4*)(Ab + 364);
        r2[4] -= (f32x2v){a39[0], a39[1]} * T5; r2[5] -= (f32x2v){a39[2], a39[3]} * T5;
        const f32x4 a44 = *(const LAS f32x4*)(Ab + 368);
        r2[6] -= (f32x2v){a40[0], a40[1]} * T5; r2[7] -= (f32x2v){a40[2], a40[3]} * T5;
        const f32x4 a45 = *(const LAS f32x4*)(Ab + 412);
        r2[8] -= (f32x2v){a41[0], a41[1]} * T5; r2[9] -= (f32x2v){a41[2], a41[3]} * T5;
        const f32x4 a46 = *(const LAS f32x4*)(Ab + 416);
        r2[10] -= (f32x2v){a42[0], a42[1]} * T5; r2[11] -= (f32x2v){a42[2], a42[3]} * T5;
        const f32x4 a47 = *(const LAS f32x4*)(Ab + 420);
        r2[12] -= (f32x2v){a43[0], a43[1]} * T5; r2[13] -= (f32x2v){a43[2], a43[3]} * T5;
        const f32x4 a48 = *(const LAS f32x4*)(Ab + 424);
        r2[14] -= (f32x2v){a44[0], a44[1]} * T5; r2[15] -= (f32x2v){a44[2], a44[3]} * T5;
        const f32x4 a49 = *(const LAS f32x4*)(Ab + 428);
        const float t6 = r2[3][0]; const f32x2v T6 = (f32x2v){t6, t6}; Tw[432] = f2bf(t6); Tt[6] = f2bf(t6);
        r2[3] -= (f32x2v){a45[2], a45[3]} * T6;
        const f32x4 a50 = *(const LAS f32x4*)(Ab + 432);
        r2[4] -= (f32x2v){a46[0], a46[1]} * T6; r2[5] -= (f32x2v){a46[2], a46[3]} * T6;
        const f32x4 a51 = *(const LAS f32x4*)(Ab + 436);
        r2[6] -= (f32x2v){a47[0], a47[1]} * T6; r2[7] -= (f32x2v){a47[2], a47[3]} * T6;
        const f32x4 a52 = *(const LAS f32x4*)(Ab + 484);
        r2[8] -= (f32x2v){a48[0], a48[1]} * T6; r2[9] -= (f32x2v){a48[2], a48[3]} * T6;
        const f32x4 a53 = *(const LAS f32x4*)(Ab + 488);
        r2[10] -= (f32x2v){a49[0], a49[1]} * T6; r2[11] -= (f32x2v){a49[2], a49[3]} * T6;
        const f32x4 a54 = *(const LAS f32x4*)(Ab + 492);
        r2[12] -= (f32x2v){a50[0], a50[1]} * T6; r2[13] -= (f32x2v){a50[2], a50[3]} * T6;
        const f32x4 a55 = *(const LAS f32x4*)(Ab + 496);
        r2[14] -= (f32x2v){a51[0], a51[1]} * T6; r2[15] -= (f32x2v){a51[2], a51[3]} * T6;
        const f32x4 a56 = *(const LAS f32x4*)(Ab + 500);
        const float t7 = r2[3][1]; const f32x2v T7 = (f32x2v){t7, t7}; Tw[504] = f2bf(t7); Tt[7] = f2bf(t7);
        r2[4] -= (f32x2v){a52[0], a52[1]} * T7; r2[5] -= (f32x2v){a52[2], a52[3]} * T7;
        const f32x4 a57 = *(const LAS f32x4*)(Ab + 504);
        r2[6] -= (f32x2v){a53[0], a53[1]} * T7; r2[7] -= (f32x2v){a53[2], a53[3]} * T7;
        const f32x4 a58 = *(const LAS f32x4*)(Ab + 552);
        r2[8] -= (f32x2v){a54[0], a54[1]} * T7; r2[9] -= (f32x2v){a54[2], a54[3]} * T7;
        const f32x4 a59 = *(const LAS f32x4*)(Ab + 556);
        r2[10] -= (f32x2v){a55[0], a55[1]} * T7; r2[11] -= (f32x2v){a55[2], a55[3]} * T7;
        const f32x4 a60 = *(const LAS f32x4*)(Ab + 560);
        r2[12] -= (f32x2v){a56[0], a56[1]} * T7; r2[13] -= (f32x2v){a56[2], a56[3]} * T7;
        const f32x4 a61 = *(const LAS f32x4*)(Ab + 564);
        r2[14] -= (f32x2v){a57[0], a57[1]} * T7; r2[15] -= (f32x2v){a57[2], a57[3]} * T7;
        const f32x4 a62 = *(const LAS f32x4*)(Ab + 568);
        const float t8 = r2[4][0]; const f32x2v T8 = (f32x2v){t8, t8}; Tw[576] = f2bf(t8); Tt[8] = f2bf(t8);
        r2[4] -= (f32x2v){a58[0], a58[1]} * T8; r2[5] -= (f32x2v){a58[2], a58[3]} * T8;
        const f32x4 a63 = *(const LAS f32x4*)(Ab + 572);
        r2[6] -= (f32x2v){a59[0], a59[1]} * T8; r2[7] -= (f32x2v){a59[2], a59[3]} * T8;
        const f32x4 a64 = *(const LAS f32x4*)(Ab + 620);
        r2[8] -= (f32x2v){a60[0], a60[1]} * T8; r2[9] -= (f32x2v){a60[2], a60[3]} * T8;
        const f32x4 a65 = *(const LAS f32x4*)(Ab + 624);
        r2[10] -= (f32x2v){a61[0], a61[1]} * T8; r2[11] -= (f32x2v){a61[2], a61[3]} * T8;
        const f32x4 a66 = *(const LAS f32x4*)(Ab + 628);
        r2[12] -= (f32x2v){a62[0], a62[1]} * T8; r2[13] -= (f32x2v){a62[2], a62[3]} * T8;
        const f32x4 a67 = *(const LAS f32x4*)(Ab + 632);
        r2[14] -= (f32x2v){a63[0], a63[1]} * T8; r2[15] -= (f32x2v){a63[2], a63[3]} * T8;
        const f32x4 a68 = *(const LAS f32x4*)(Ab + 636);
        const float t9 = r2[4][1]; const f32x2v T9 = (f32x2v){t9, t9}; Tw[648] = f2bf(t9); Tt[9] = f2bf(t9);
        r2[5] -= (f32x2v){a64[2], a64[3]} * T9;
        const f32x4 a69 = *(const LAS f32x4*)(Ab + 640);
        r2[6] -= (f32x2v){a65[0], a65[1]} * T9; r2[7] -= (f32x2v){a65[2], a65[3]} * T9;
        const f32x4 a70 = *(const LAS f32x4*)(Ab + 688);
        r2[8] -= (f32x2v){a66[0], a66[1]} * T9; r2[9] -= (f32x2v){a66[2], a66[3]} * T9;
        const f32x4 a71 = *(const LAS f32x4*)(Ab + 692);
        r2[10] -= (f32x2v){a67[0], a67[1]} * T9; r2[11] -= (f32x2v){a67[2], a67[3]} * T9;
        const f32x4 a72 = *(const LAS f32x4*)(Ab + 696);
        r2[12] -= (f32x2v){a68[0], a68[1]} * T9; r2[13] -= (f32x2v){a68[2], a68[3]} * T9;
        const f32x4 a73 = *(const LAS f32x4*)(Ab + 700);
        r2[14] -= (f32x2v){a69[0], a69[1]} * T9; r2[15] -= (f32x2v){a69[2], a69[3]} * T9;
        const f32x4 a74 = *(const LAS f32x4*)(Ab + 704);
        const float t10 = r2[5][0]; const f32x2v T10 = (f32x2v){t10, t10}; Tw[720] = f2bf(t10); Tt[10] = f2bf(t10);
        r2[5] -= (f32x2v){a70[2], a70[3]} * T10;
        const f32x4 a75 = *(const LAS f32x4*)(Ab + 708);
        r2[6] -= (f32x2v){a71[0], a71[1]} * T10; r2[7] -= (f32x2v){a71[2], a71[3]} * T10;
        const f32x4 a76 = *(const LAS f32x4*)(Ab + 760);
        r2[8] -= (f32x2v){a72[0], a72[1]} * T10; r2[9] -= (f32x2v){a72[2], a72[3]} * T10;
        const f32x4 a77 = *(const LAS f32x4*)(Ab + 764);
        r2[10] -= (f32x2v){a73[0], a73[1]} * T10; r2[11] -= (f32x2v){a73[2], a73[3]} * T10;
        const f32x4 a78 = *(const LAS f32x4*)(Ab + 768);
        r2[12] -= (f32x2v){a74[0], a74[1]} * T10; r2[13] -= (f32x2v){a74[2], a74[3]} * T10;
        const f32x4 a79 = *(const LAS f32x4*)(Ab + 772);
        r2[14] -= (f32x2v){a75[0], a75[1]} * T10; r2[15] -= (f32x2v){a75[2], a75[3]} * T10;
        const f32x4 a80 = *(const LAS f32x4*)(Ab + 776);
        const float t11 = r2[5][1]; const f32x2v T11 = (f32x2v){t11, t11}; Tw[792] = f2bf(t11); Tt[11] = f2bf(t11);
        r2[6] -= (f32x2v){a76[0], a76[1]} * T11; r2[7] -= (f32x2v){a76[2], a76[3]} * T11;
        const f32x4 a81 = *(const LAS f32x4*)(Ab + 828);
        r2[8] -= (f32x2v){a77[0], a77[1]} * T11; r2[9] -= (f32x2v){a77[2], a77[3]} * T11;
        const f32x4 a82 = *(const LAS f32x4*)(Ab + 832);
        r2[10] -= (f32x2v){a78[0], a78[1]} * T11; r2[11] -= (f32x2v){a78[2], a78[3]} * T11;
        const f32x4 a83 = *(const LAS f32x4*)(Ab + 836);
        r2[12] -= (f32x2v){a79[0], a79[1]} * T11; r2[13] -= (f32x2v){a79[2], a79[3]} * T11;
        const f32x4 a84 = *(const LAS f32x4*)(Ab + 840);
        r2[14] -= (f32x2v){a80[0], a80[1]} * T11; r2[15] -= (f32x2v){a80[2], a80[3]} * T11;
        const f32x4 a85 = *(const LAS f32x4*)(Ab + 844);
        const float t12 = r2[6][0]; const f32x2v T12 = (f32x2v){t12, t12}; Tw[864] = f2bf(t12); Tt[12] = f2bf(t12);
        r2[6] -= (f32x2v){a81[0], a81[1]} * T12; r2[7] -= (f32x2v){a81[2], a81[3]} * T12;
        const f32x4 a86 = *(const LAS f32x4*)(Ab + 896);
        r2[8] -= (f32x2v){a82[0], a82[1]} * T12; r2[9] -= (f32x2v){a82[2], a82[3]} * T12;
        const f32x4 a87 = *(const LAS f32x4*)(Ab + 900);
        r2[10] -= (f32x2v){a83[0], a83[1]} * T12; r2[11] -= (f32x2v){a83[2], a83[3]} * T12;
        const f32x4 a88 = *(const LAS f32x4*)(Ab + 904);
        r2[12] -= (f32x2v){a84[0], a84[1]} * T12; r2[13] -= (f32x2v){a84[2], a84[3]} * T12;
        const f32x4 a89 = *(const LAS f32x4*)(Ab + 908);
        r2[14] -= (f32x2v){a85[0], a85[1]} * T12; r2[15] -= (f32x2v){a85[2], a85[3]} * T12;
        const f32x4 a90 = *(const LAS f32x4*)(Ab + 912);
        const float t13 = r2[6][1]; const f32x2v T13 = (f32x2v){t13, t13}; Tw[936] = f2bf(t13); Tt[13] = f2bf(t13);
        r2[7] -= (f32x2v){a86[2], a86[3]} * T13;
        const f32x4 a91 = *(const LAS f32x4*)(Ab + 964);
        r2[8] -= (f32x2v){a87[0], a87[1]} * T13; r2[9] -= (f32x2v){a87[2], a87[3]} * T13;
        const f32x4 a92 = *(const LAS f32x4*)(Ab + 968);
        r2[10] -= (f32x2v){a88[0], a88[1]} * T13; r2[11] -= (f32x2v){a88[2], a88[3]} * T13;
        const f32x4 a93 = *(const LAS f32x4*)(Ab + 972);
        r2[12] -= (f32x2v){a89[0], a89[1]} * T13; r2[13] -= (f32x2v){a89[2], a89[3]} * T13;
        const f32x4 a94 = *(const LAS f32x4*)(Ab + 976);
        r2[14] -= (f32x2v){a90[0], a90[1]} * T13; r2[15] -= (f32x2v){a90[2], a90[3]} * T13;
        const f32x4 a95 = *(const LAS f32x4*)(Ab + 980);
        const float t14 = r2[7][0]; const f32x2v T14 = (f32x2v){t14, t14}; Tw[1008] = f2bf(t14); Tt[14] = f2bf(t14);
        r2[7] -= (f32x2v){a91[2], a91[3]} * T14;
        const f32x4 a96 = *(const LAS f32x4*)(Ab + 1036);
        r2[8] -= (f32x2v){a92[0], a92[1]} * T14; r2[9] -= (f32x2v){a92[2], a92[3]} * T14;
        const f32x4 a97 = *(const LAS f32x4*)(Ab + 1040);
        r2[10] -= (f32x2v){a93[0], a93[1]} * T14; r2[11] -= (f32x2v){a93[2], a93[3]} * T14;
        const f32x4 a98 = *(const LAS f32x4*)(Ab + 1044);
        r2[12] -= (f32x2v){a94[0], a94[1]} * T14; r2[13] -= (f32x2v){a94[2], a94[3]} * T14;
        const f32x4 a99 = *(const LAS f32x4*)(Ab + 1048);
        r2[14] -= (f32x2v){a95[0], a95[1]} * T14; r2[15] -= (f32x2v){a95[2], a95[3]} * T14;
        const f32x4 a100 = *(const LAS f32x4*)(Ab + 1104);
        const float t15 = r2[7][1]; const f32x2v T15 = (f32x2v){t15, t15}; Tw[1080] = f2bf(t15); Tt[15] = f2bf(t15);
        r2[8] -= (f32x2v){a96[0], a96[1]} * T15; r2[9] -= (f32x2v){a96[2], a96[3]} * T15;
        const f32x4 a101 = *(const LAS f32x4*)(Ab + 1108);
        r2[10] -= (f32x2v){a97[0], a97[1]} * T15; r2[11] -= (f32x2v){a97[2], a97[3]} * T15;
        const f32x4 a102 = *(const LAS f32x4*)(Ab + 1112);
        r2[12] -= (f32x2v){a98[0], a98[1]} * T15; r2[13] -= (f32x2v){a98[2], a98[3]} * T15;
        const f32x4 a103 = *(const LAS f32x4*)(Ab + 1116);
        r2[14] -= (f32x2v){a99[0], a99[1]} * T15; r2[15] -= (f32x2v){a99[2], a99[3]} * T15;
        const f32x4 a104 = *(const LAS f32x4*)(Ab + 1172);
        const float t16 = r2[8][0]; const f32x2v T16 = (f32x2v){t16, t16}; Tw[1152] = f2bf(t16); Tt[16] = f2bf(t16);
        r2[8] -= (f32x2v){a100[0], a100[1]} * T16; r2[9] -= (f32x2v){a100[2], a100[3]} * T16;
        const f32x4 a105 = *(const LAS f32x4*)(Ab + 1176);
        r2[10] -= (f32x2v){a101[0], a101[1]} * T16; r2[11] -= (f32x2v){a101[2], a101[3]} * T16;
        const f32x4 a106 = *(const LAS f32x4*)(Ab + 1180);
        r2[12] -= (f32x2v){a102[0], a102[1]} * T16; r2[13] -= (f32x2v){a102[2], a102[3]} * T16;
        const f32x4 a107 = *(const LAS f32x4*)(Ab + 1184);
        r2[14] -= (f32x2v){a103[0], a103[1]} * T16; r2[15] -= (f32x2v){a103[2], a103[3]} * T16;
        const f32x4 a108 = *(const LAS f32x4*)(Ab + 1240);
        const float t17 = r2[8][1]; const f32x2v T17 = (f32x2v){t17, t17}; Tw[1224] = f2bf(t17); Tt[17] = f2bf(t17);
        r2[9] -= (f32x2v){a104[2], a104[3]} * T17;
        const f32x4 a109 = *(const LAS f32x4*)(Ab + 1244);
        r2[10] -= (f32x2v){a105[0], a105[1]} * T17; r2[11] -= (f32x2v){a105[2], a105[3]} * T17;
        const f32x4 a110 = *(const LAS f32x4*)(Ab + 1248);
        r2[12] -= (f32x2v){a106[0], a106[1]} * T17; r2[13] -= (f32x2v){a106[2], a106[3]} * T17;
        const f32x4 a111 = *(const LAS f32x4*)(Ab + 1252);
        r2[14] -= (f32x2v){a107[0], a107[1]} * T17; r2[15] -= (f32x2v){a107[2], a107[3]} * T17;
        const f32x4 a112 = *(const LAS f32x4*)(Ab + 1312);
        const float t18 = r2[9][0]; const f32x2v T18 = (f32x2v){t18, t18}; Tw[1296] = f2bf(t18); Tt[18] = f2bf(t18);
        r2[9] -= (f32x2v){a108[2], a108[3]} * T18;
        const f32x4 a113 = *(const LAS f32x4*)(Ab + 1316);
        r2[10] -= (f32x2v){a109[0], a109[1]} * T18; r2[11] -= (f32x2v){a109[2], a109[3]} * T18;
        const f32x4 a114 = *(const LAS f32x4*)(Ab + 1320);
        r2[12] -= (f32x2v){a110[0], a110[1]} * T18; r2[13] -= (f32x2v){a110[2], a110[3]} * T18;
        const f32x4 a115 = *(const LAS f32x4*)(Ab + 1380);
        r2[14] -= (f32x2v){a111[0], a111[1]} * T18; r2[15] -= (f32x2v){a111[2], a111[3]} * T18;
        const f32x4 a116 = *(const LAS f32x4*)(Ab + 1384);
        const float t19 = r2[9][1]; const f32x2v T19 = (f32x2v){t19, t19}; Tw[1368] = f2bf(t19); Tt[19] = f2bf(t19);
        r2[10] -= (f32x2v){a112[0], a112[1]} * T19; r2[11] -= (f32x2v){a112[2], a112[3]} * T19;
        const f32x4 a117 = *(const LAS f32x4*)(Ab + 1388);
        r2[12] -= (f32x2v){a113[0], a113[1]} * T19; r2[13] -= (f32x2v){a113[2], a113[3]} * T19;
        const f32x4 a118 = *(const LAS f32x4*)(Ab + 1448);
        r2[14] -= (f32x2v){a114[0], a114[1]} * T19; r2[15] -= (f32x2v){a114[2], a114[3]} * T19;
        const f32x4 a119 = *(const LAS f32x4*)(Ab + 1452);
        const float t20 = r2[10][0]; const f32x2v T20 = (f32x2v){t20, t20}; Tw[1440] = f2bf(t20); Tt[20] = f2bf(t20);
        r2[10] -= (f32x2v){a115[0], a115[1]} * T20; r2[11] -= (f32x2v){a115[2], a115[3]} * T20;
        const f32x4 a120 = *(const LAS f32x4*)(Ab + 1456);
        r2[12] -= (f32x2v){a116[0], a116[1]} * T20; r2[13] -= (f32x2v){a116[2], a116[3]} * T20;
        const f32x4 a121 = *(const LAS f32x4*)(Ab + 1516);
        r2[14] -= (f32x2v){a117[0], a117[1]} * T20; r2[15] -= (f32x2v){a117[2], a117[3]} * T20;
        const f32x4 a122 = *(const LAS f32x4*)(Ab + 1520);
        const float t21 = r2[10][1]; const f32x2v T21 = (f32x2v){t21, t21}; Tw[1512] = f2bf(t21); Tt[21] = f2bf(t21);
        r2[11] -= (f32x2v){a118[2], a118[3]} * T21;
        const f32x4 a123 = *(const LAS f32x4*)(Ab + 1524);
        r2[12] -= (f32x2v){a119[0], a119[1]} * T21; r2[13] -= (f32x2v){a119[2], a119[3]} * T21;
        const f32x4 a124 = *(const LAS f32x4*)(Ab + 1588);
        r2[14] -= (f32x2v){a120[0], a120[1]} * T21; r2[15] -= (f32x2v){a120[2], a120[3]} * T21;
        const f32x4 a125 = *(const LAS f32x4*)(Ab + 1592);
        const float t22 = r2[11][0]; const f32x2v T22 = (f32x2v){t22, t22}; Tw[1584] = f2bf(t22); Tt[22] = f2bf(t22);
        r2[11] -= (f32x2v){a121[2], a121[3]} * T22;
        const f32x4 a126 = *(const LAS f32x4*)(Ab + 1656);
        r2[12] -= (f32x2v){a122[0], a122[1]} * T22; r2[13] -= (f32x2v){a122[2], a122[3]} * T22;
        const f32x4 a127 = *(const LAS f32x4*)(Ab + 1660);
        r2[14] -= (f32x2v){a123[0], a123[1]} * T22; r2[15] -= (f32x2v){a123[2], a123[3]} * T22;
        const f32x4 a128 = *(const LAS f32x4*)(Ab + 1724);
        const float t23 = r2[11][1]; const f32x2v T23 = (f32x2v){t23, t23}; Tw[1656] = f2bf(t23); Tt[23] = f2bf(t23);
        r2[12] -= (f32x2v){a124[0], a124[1]} * T23; r2[13] -= (f32x2v){a124[2], a124[3]} * T23;
        const f32x4 a129 = *(const LAS f32x4*)(Ab + 1728);
        r2[14] -= (f32x2v){a125[0], a125[1]} * T23; r2[15] -= (f32x2v){a125[2], a125[3]} * T23;
        const f32x4 a130 = *(const LAS f32x4*)(Ab + 1792);
        const float t24 = r2[12][0]; const f32x2v T24 = (f32x2v){t24, t24}; Tw[1728] = f2bf(t24); Tt[24] = f2bf(t24);
        r2[12] -= (f32x2v){a126[0], a126[1]} * T24; r2[13] -= (f32x2v){a126[2], a126[3]} * T24;
        const f32x4 a131 = *(const LAS f32x4*)(Ab + 1796);
        r2[14] -= (f32x2v){a127[0], a127[1]} * T24; r2[15] -= (f32x2v){a127[2], a127[3]} * T24;
        const f32x4 a132 = *(const LAS f32x4*)(Ab + 1864);
        const float t25 = r2[12][1]; const f32x2v T25 = (f32x2v){t25, t25}; Tw[1800] = f2bf(t25); Tt[25] = f2bf(t25);
        r2[13] -= (f32x2v){a128[2], a128[3]} * T25;
        const f32x4 a133 = *(const LAS f32x4*)(Ab + 1932);
        r2[14] -= (f32x2v){a129[0], a129[1]} * T25; r2[15] -= (f32x2v){a129[2], a129[3]} * T25;
        const f32x4 a134 = *(const LAS f32x4*)(Ab + 2000);
        const float t26 = r2[13][0]; const f32x2v T26 = (f32x2v){t26, t26}; Tw[1872] = f2bf(t26); Tt[26] = f2bf(t26);
        r2[13] -= (f32x2v){a130[2], a130[3]} * T26;
        const f32x4 a135 = *(const LAS f32x4*)(Ab + 2068);
        r2[14] -= (f32x2v){a131[0], a131[1]} * T26; r2[15] -= (f32x2v){a131[2], a131[3]} * T26;
        const float t27 = r2[13][1]; const f32x2v T27 = (f32x2v){t27, t27}; Tw[1944] = f2bf(t27); Tt[27] = f2bf(t27);
        r2[14] -= (f32x2v){a132[0], a132[1]} * T27; r2[15] -= (f32x2v){a132[2], a132[3]} * T27;
        const float t28 = r2[14][0]; const f32x2v T28 = (f32x2v){t28, t28}; Tw[2016] = f2bf(t28); Tt[28] = f2bf(t28);
        r2[14] -= (f32x2v){a133[0], a133[1]} * T28; r2[15] -= (f32x2v){a133[2], a133[3]} * T28;
        const float t29 = r2[14][1]; const f32x2v T29 = (f32x2v){t29, t29}; Tw[2088] = f2bf(t29); Tt[29] = f2bf(t29);
        r2[15] -= (f32x2v){a134[2], a134[3]} * T29;
        const float t30 = r2[15][0]; const f32x2v T30 = (f32x2v){t30, t30}; Tw[2160] = f2bf(t30); Tt[30] = f2bf(t30);
        r2[15] -= (f32x2v){a135[2], a135[3]} * T30;
        Tw[2232] = f2bf(r2[15][1]); Tt[31] = f2bf(r2[15][1]);
    } else if (wid == 2) {
        *(LAS u32x4*)(Tb + (lane >> 1) * 72 + 32 + (lane & 1) * 16) = (u32x4){0u, 0u, 0u, 0u}; *(LAS u32x4*)(Tb + (lane >> 1) * 72 + 32 + (lane & 1) * 16 + 8) = (u32x4){0u, 0u, 0u, 0u};
    }
    __syncthreads();
    if (wid < 4) {
        const int mt = wid >> 1, nt = wid & 1; const f32x4 acc = tile_mm(A10b, 40, mt, TT, 40, nt, 1, fr, fq);
        u32x2 w; w.x = cvt_pk(acc[0], acc[1]); w.y = cvt_pk(acc[2], acc[3]); *(LAS u32x2*)(PT + (16 * nt + fr) * 40 + 16 * mt + 4 * fq) = w;
    }
    __syncthreads();
    if (wid < 4) {
        const int mt = wid >> 1, nt = wid & 1; const f32x4 acc = tile_mm(Tb + 32 * 72 + 32, 72, mt, PT, 40, nt, 1, fr, fq);
#pragma unroll
        for (int e = 0; e < 4; ++e) Tb[(32 + 16 * mt + 4 * fq + e) * 72 + 16 * nt + fr] = f2bf(-acc[e]);
    }
    __syncthreads();
#pragma unroll 2
    for (int r = 0; r < 8; ++r) {
        const int job = wid + 8 * r, kind = job >> 5, tile = job & 31, mt = tile >> 3, nt = tile & 7;
        const f32x4 acc = tile_mm<false, true>(Tb, 72, mt, kind ? KbT : VbT, 72, nt, 2, fr, fq);
        u32x2 w; w.x = cvt_pk(acc[0], acc[1]); w.y = cvt_pk(acc[2], acc[3]);
        { const int ch = 16 * nt + fr; *(LAS u32x2*)((kind ? WT : UT) + ch * 72 + 8 * ((2 * mt + (fq >> 1)) ^ ((ch >> 3) & 7)) + 4 * (fq & 1)) = w; }
    }
    __syncthreads();
    bf16_t* GM = (bf16_t*)(p.ws + WS_GM) + (size_t)unit * 16384; bf16_t* GN = (bf16_t*)(p.ws + WS_GN) + (size_t)unit * 16384;
    bf16_t* GQ = (bf16_t*)(p.ws + WS_GQ) + (size_t)unit * 8192; bf16_t* GO = (bf16_t*)(p.ws + WS_GO) + (size_t)unit * 8192;
#pragma unroll 1
    for (int r = 0; r < 12; ++r) {
        const int job = wid + 8 * r;
        if (job < 32) { const int a2 = job >> 3, mt = job & 7;
            const f32x4 c0 = tile_mm<true, true>(WT, 72, 2 * a2, KdT, 72, mt, 2, fr, fq), c1 = tile_mm<true, true>(WT, 72, 2 * a2 + 1, KdT, 72, mt, 2, fr, fq);
            u32x4 w; w.x = cvt_pk(-c0[0], -c0[1]); w.y = cvt_pk(-c0[2], -c0[3]); w.z = cvt_pk(-c1[0], -c1[1]); w.w = cvt_pk(-c1[2], -c1[3]);
            *(u32x4*)(GM + ((mt * 4 + a2) * 64 + lane) * 8) = w;
        } else if (job < 64) { const int j = job - 32, mt2 = j >> 3, nt = j & 7;
            const f32x4 c0 = tile_mm<true, true>(KdT, 72, 2 * mt2, UT, 72, nt, 2, fr, fq), c1 = tile_mm<true, true>(KdT, 72, 2 * mt2 + 1, UT, 72, nt, 2, fr, fq);
            u32x4 w; w.x = cvt_pk(c0[0], c0[1]); w.y = cvt_pk(c0[2], c0[3]); w.z = cvt_pk(c1[0], c1[1]); w.w = cvt_pk(c1[2], c1[3]);
            *(u32x4*)(GN + ((nt * 64 + lane) * 8 + 2 * mt2) * 4) = w;
        } else if (job < 80) { const int j = job - 64, a2 = j >> 2, it = j & 3;
            const f32x4 c0 = tile_mm<true, false>(WT, 72, 2 * a2, QK, 72, it, 2, fr, fq), c1 = tile_mm<true, false>(WT, 72, 2 * a2 + 1, QK, 72, it, 2, fr, fq);
            const int i = 16 * it + fr; const float eg = __expf(gcs[i]);
            const u32x2 q0 = *(const LAS u32x2*)(Qs + i * 136 + 32 * a2 + 4 * fq), q1 = *(const LAS u32x2*)(Qs + i * 136 + 32 * a2 + 16 + 4 * fq);
            u32x4 w; w.x = cvt_pk(bflo(q0.x) * eg - c0[0], bfhi(q0.x) * eg - c0[1]); w.y = cvt_pk(bflo(q0.y) * eg - c0[2], bfhi(q0.y) * eg - c0[3]);
            w.z = cvt_pk(bflo(q1.x) * eg - c1[0], bfhi(q1.x) * eg - c1[1]); w.w = cvt_pk(bflo(q1.y) * eg - c1[2], bfhi(q1.y) * eg - c1[3]);
            *(u32x4*)(GQ + ((it * 4 + a2) * 64 + lane) * 8) = w;
        } else { const int j = job - 80, mt2 = j >> 3, nt = j & 7;
            const f32x4 c0 = tile_mm<false, true>(QK, 72, 2 * mt2, UT, 72, nt, 2, fr, fq), c1 = tile_mm<false, true>(QK, 72, 2 * mt2 + 1, UT, 72, nt, 2, fr, fq);
            u32x4 w; w.x = cvt_pk(c0[0], c0[1]); w.y = cvt_pk(c0[2], c0[3]); w.z = cvt_pk(c1[0], c1[1]); w.w = cvt_pk(c1[2], c1[3]);
            *(u32x4*)(GO + ((nt * 64 + lane) * 4 + 2 * mt2) * 4) = w;
        }
    }
    if (tid == 0) ((float*)(p.ws + WS_CTL + CTL_GLAST))[unit] = __expf(gclast);
    __syncthreads();
}

__device__ __forceinline__ void gdn_scan(const Params& p, LAS unsigned char* lds, int sb) {
    const int tid = threadIdx.x, lane = tid & 63, wid = tid >> 6, fr = lane & 15, fq = lane >> 4;
    const int bh = sb / (8 / CW), sp = sb % (8 / CW), unit0 = bh * 128, sl = sp * CW + wid;
    const u32x4* GMb = (const u32x4*)((const bf16_t*)(p.ws + WS_GM) + (size_t)unit0 * 16384);
    const u32x4* GQb = (const u32x4*)((const bf16_t*)(p.ws + WS_GQ) + (size_t)unit0 * 8192);
    const bf16_t* GNb = (const bf16_t*)(p.ws + WS_GN) + (size_t)unit0 * 16384;
    bf16_t* GOb = (bf16_t*)(p.ws + WS_GO) + (size_t)unit0 * 8192;
    const float* glast = (const float*)(p.ws + WS_CTL + CTL_GLAST) + unit0;
    const bool loader = (wid >= CW && wid < CW + 4);
#define SCAN_DMA(cc) do { _Pragma("unroll") for (int k = 0; k < 8; ++k) { const int inst = (wid - CW) * 8 + k; \
        __builtin_amdgcn_global_load_lds((const unsigned*)((const char*)(GMb + (size_t)(cc) * 2048) + inst * 1024 + lane * 16), (LAS unsigned*)(lds + ((cc) & 3) * 32768 + inst * 1024), 16, 0, 0); } } while (0)
#define SCAN_LOADN(dn, cc) do { const bf16_t* np_ = GNb + (size_t)((cc) < 128 ? (cc) : 127) * 16384 + (size_t)(sl * 64 + lane) * 32; \
        asm volatile("global_load_dwordx4 %0, %4, off\n\tglobal_load_dwordx4 %1, %4, off offset:16\n\tglobal_load_dwordx4 %2, %4, off offset:32\n\tglobal_load_dwordx4 %3, %4, off offset:48" \
            : "=&v"(dn[0]), "=&v"(dn[1]), "=&v"(dn[2]), "=&v"(dn[3]) : "v"(np_) : "memory"); } while (0)
#define SCAN_WAITN(dn, N) asm volatile("s_waitcnt vmcnt(" #N ")" : "+v"(dn[0]), "+v"(dn[1]), "+v"(dn[2]), "+v"(dn[3]) :: "memory")
#define SCAN_STEP(c, nn, RELOAD) do { \
        SCAN_WAITN(nn, 8); \
        const float gl = __shfl(((c) < 64) ? glr0 : glr1, (c) & 63); bf16x8 Sb[4]; \
        bf16_t* scp = (bf16_t*)GNb + (size_t)(c) * 16384 + (size_t)sl * 2048 + lane * 8; \
        _Pragma("unroll") for (int ks = 0; ks < 4; ++ks) { u32x4 w; w.x = cvt_pk(S[2 * ks][0], S[2 * ks][1]); w.y = cvt_pk(S[2 * ks][2], S[2 * ks][3]); \
            w.z = cvt_pk(S[2 * ks + 1][0], S[2 * ks + 1][1]); w.w = cvt_pk(S[2 * ks + 1][2], S[2 * ks + 1][3]); Sb[ks] = __builtin_bit_cast(bf16x8, w); } \
        const LAS unsigned char* slot = lds + ((c) & 3) * 32768 + lane * 16; \
        bf16x8 fa[2][2][4]; \
        _Pragma("unroll") for (int ks = 0; ks < 4; ++ks) { fa[0][0][ks] = *(const LAS bf16x8*)(slot + (0 * 4 + ks) * 1024); fa[0][1][ks] = *(const LAS bf16x8*)(slot + (1 * 4 + ks) * 1024); } \
        _Pragma("unroll") for (int mt = 0; mt < 8; ++mt) { const unsigned w0 = nn[mt >> 1][(mt & 1) * 2], w1 = nn[mt >> 1][(mt & 1) * 2 + 1]; \
            S[mt] = S[mt] * gl + (f32x4){bflo(w0), bfhi(w0), bflo(w1), bfhi(w1)}; } \
        _Pragma("unroll") for (int ks = 0; ks < 4; ++ks) *(u32x4*)(scp + ks * 512) = __builtin_bit_cast(u32x4, Sb[ks]);     \
        RELOAD; \
        _Pragma("unroll") for (int pr = 0; pr < 4; ++pr) { \
            if (pr < 3) { _Pragma("unroll") for (int ks = 0; ks < 4; ++ks) { fa[(pr + 1) & 1][0][ks] = *(const LAS bf16x8*)(slot + ((2 * pr + 2) * 4 + ks) * 1024); fa[(pr + 1) & 1][1][ks] = *(const LAS bf16x8*)(slot + ((2 * pr + 3) * 4 + ks) * 1024); } } \
            _Pragma("unroll") for (int ks = 0; ks < 4; ++ks) { S[2 * pr] = mfma16(fa[pr & 1][0][ks], Sb[ks], S[2 * pr]); S[2 * pr + 1] = mfma16(fa[pr & 1][1][ks], Sb[ks], S[2 * pr + 1]); } } \
        } while (0)
    if (loader) { SCAN_DMA(0); SCAN_DMA(1); SCAN_DMA(2); asm volatile("s_waitcnt vmcnt(0)" ::: "memory"); }
    f32x4 S[8];
#pragma unroll
    for (int mt = 0; mt < 8; ++mt) S[mt] = (f32x4){0.f, 0.f, 0.f, 0.f};
    float glr0 = glast[lane], glr1 = glast[64 + lane];
    asm volatile("" : "+v"(glr0), "+v"(glr1));
    u32x4 nnA[4], nnB[4];
    if (wid < CW) { SCAN_LOADN(nnA, 0); SCAN_LOADN(nnB, 1); SCAN_WAITN(nnA, 0); SCAN_WAITN(nnB, 0); }
    asm volatile("s_waitcnt lgkmcnt(0)" ::: "memory"); __builtin_amdgcn_s_barrier(); asm volatile("" ::: "memory");
#pragma unroll 1
    for (int c = 0; c < 128; c += 2) {
        if (loader) { if (c + 3 < 128) { SCAN_DMA(c + 3); asm volatile("s_waitcnt vmcnt(16)" ::: "memory"); } else asm volatile("s_waitcnt vmcnt(0)" ::: "memory"); }
        else if (wid < CW) { SCAN_STEP(c, nnA, SCAN_LOADN(nnA, c + 2)); }
        asm volatile("s_waitcnt lgkmcnt(0)" ::: "memory"); __builtin_amdgcn_s_barrier(); asm volatile("" ::: "memory");
        if (loader) { if (c + 4 < 128) { SCAN_DMA(c + 4); asm volatile("s_waitcnt vmcnt(16)" ::: "memory"); } else asm volatile("s_waitcnt vmcnt(0)" ::: "memory"); }
        else if (wid < CW) { SCAN_STEP(c + 1, nnB, SCAN_LOADN(nnB, c + 3)); }
        asm volatile("s_waitcnt lgkmcnt(0)" ::: "memory"); __builtin_amdgcn_s_barrier(); asm volatile("" ::: "memory");
    }
#undef SCAN_DMA
#undef SCAN_LOADN
#undef SCAN_WAITN
#undef SCAN_STEP
    __syncthreads();
    if (wid < CW) {
        float* go = p.out + O_GP + (size_t)bh * 16384;
#pragma unroll
        for (int mt = 0; mt < 8; ++mt)
#pragma unroll
            for (int e = 0; e < 4; ++e) go[(16 * mt + 4 * fq + e) * 128 + sl * 16 + fr] = S[mt][e];
    }
}

__device__ __forceinline__ void gdn_gate_unit(const Params& p, LAS unsigned char* lds, int wid, int unit, int lane) {
    const int fr = lane & 15, fq = lane >> 4, bh = unit >> 7, n = unit & 127, b = bh >> 2, h = bh & 3, tok0 = b * SEQ + n * 64;
    bf16_t* PB = (bf16_t*)(p.ws + WS_H);
    LAS bf16_t* ot = (LAS bf16_t*)(lds + wid * 16384);
    LAS float* rl = (LAS float*)(lds + 131072 + wid * 256);
    float ssq[16];
#pragma unroll
    for (int k = 0; k < 16; ++k) ssq[k] = 0.f;
    {
        const bf16_t* GOw = (const bf16_t*)(p.ws + WS_GO) + (size_t)unit * 8192;
        const bf16_t* GQ = (const bf16_t*)(p.ws + WS_GQ) + (size_t)unit * 8192; const bf16_t* SC = (const bf16_t*)(p.ws + WS_GN) + (size_t)unit * 16384;
        bf16x8 qa[4][4];
#pragma unroll
        for (int mt = 0; mt < 4; ++mt)
#pragma unroll
            for (int ks = 0; ks < 4; ++ks) qa[mt][ks] = *(const bf16x8*)(GQ + ((mt * 4 + ks) * 64 + lane) * 8);
#pragma unroll 2
        for (int nt = 0; nt < 8; ++nt) {
            bf16x8 sb[4];
#pragma unroll
            for (int ks = 0; ks < 4; ++ks) sb[ks] = *(const bf16x8*)(SC + nt * 2048 + (ks * 64 + lane) * 8);
            const u32x4 o0 = *(const u32x4*)(GOw + (nt * 64 + lane) * 16), o1 = *(const u32x4*)(GOw + (nt * 64 + lane) * 16 + 8);
            f32x4 acc[4];
            acc[0] = (f32x4){bflo(o0.x), bfhi(o0.x), bflo(o0.y), bfhi(o0.y)}; acc[1] = (f32x4){bflo(o0.z), bfhi(o0.z), bflo(o0.w), bfhi(o0.w)};
            acc[2] = (f32x4){bflo(o1.x), bfhi(o1.x), bflo(o1.y), bfhi(o1.y)}; acc[3] = (f32x4){bflo(o1.z), bfhi(o1.z), bflo(o1.w), bfhi(o1.w)};
#pragma unroll
            for (int ks = 0; ks < 4; ++ks)
#pragma unroll
                for (int mt = 0; mt < 4; ++mt) acc[mt] = mfma16(qa[mt][ks], sb[ks], acc[mt]);
#pragma unroll
            for (int mt = 0; mt < 4; ++mt)
#pragma unroll
                for (int e = 0; e < 4; ++e) { ssq[4 * mt + e] += acc[mt][e] * acc[mt][e];
                    ot[(16 * mt + 4 * fq + e) * 128 + 16 * nt + fr] = f2bf(acc[mt][e]); }
        }
    }
#pragma unroll
    for (int k = 0; k < 16; ++k) { const float s = row16_sum(ssq[k]); if (fr == 0) rl[16 * (k >> 2) + 4 * fq + (k & 3)] = rsqrtf(s * (1.0f / 128.0f) + EPS); }
    asm volatile("s_waitcnt lgkmcnt(0)" ::: "memory");
    const float* gn = p.in[15];
#pragma unroll 4
    for (int k = 0; k < 16; ++k) {
        const int item = lane + 64 * k, t = item >> 4, ch = item & 15;
        const u32x4 ov = *(const LAS u32x4*)(ot + t * 128 + ch * 8);
        const u32x4 gz = *(const u32x4*)(PB + (size_t)(tok0 + t) * PW + 2304 + h * 128 + ch * 8);
        const f32x4 g0 = *(const f32x4*)(gn + ch * 8), g1 = *(const f32x4*)(gn + ch * 8 + 4);
        const float r = rl[t];
        u32x4 w;
        w.x = cvt_pk(bflo(ov.x) * r * g0[0] * silu(bflo(gz.x)), bfhi(ov.x) * r * g0[1] * silu(bfhi(gz.x)));
        w.y = cvt_pk(bflo(ov.y) * r * g0[2] * silu(bflo(gz.y)), bfhi(ov.y) * r * g0[3] * silu(bfhi(gz.y)));
        w.z = cvt_pk(bflo(ov.z) * r * g1[0] * silu(bflo(gz.z)), bfhi(ov.z) * r * g1[1] * silu(bfhi(gz.z)));
        w.w = cvt_pk(bflo(ov.w) * r * g1[2] * silu(bflo(gz.w)), bfhi(ov.w) * r * g1[3] * silu(bfhi(gz.w)));
        *(u32x4*)(PB + (size_t)(tok0 + t) * PW + 512 + h * 128 + ch * 8) = w;
    }
    asm volatile("s_waitcnt lgkmcnt(0)" ::: "memory");
}

__device__ __forceinline__ void attn_unit(const Params& p, LAS unsigned char* lds, int unit) {
    const int tid = threadIdx.x, lane = tid & 63, wid = tid >> 6, fr = lane & 15, fq = lane >> 4;
    const int b = unit >> 7, blk = (unit >> 1) & 63, kvh = unit & 1;
    LAS bf16_t* Ks = (LAS bf16_t*)lds; LAS bf16_t* Vt = (LAS bf16_t*)(lds + 36864);
    bf16_t* PB = (bf16_t*)(p.ws + WS_H);
    __syncthreads();
#pragma unroll
    for (int i = 0; i < 4; ++i) {
        const int q = tid + 512 * i, row = q >> 3, ch = q & 7, tp = blk * 128 - 128 + row;
        u32x4 kv = (u32x4){0u, 0u, 0u, 0u}, vv = (u32x4){0u, 0u, 0u, 0u};
        if (tp >= 0) { const bf16_t* base = PB + (size_t)(b * SEQ + tp) * PW; kv = *(const u32x4*)(base + 512 + kvh * 64 + ch * 8); vv = *(const u32x4*)(base + 640 + kvh * 64 + ch * 8); }
        *(LAS u32x4*)(Ks + row * 72 + ch * 8) = kv;
#pragma unroll
        for (int e = 0; e < 4; ++e) { const unsigned w = vv[e]; Vt[(ch * 8 + 2 * e) * 264 + row] = (bf16_t)(w & 0xffffu); Vt[(ch * 8 + 2 * e + 1) * 264 + row] = (bf16_t)(w >> 16); }
    }
    __syncthreads();
    const int qtok = b * SEQ + blk * 128 + 16 * wid + fr;
#pragma unroll 1
    for (int g = 0; g < 4; ++g) {
        const int h = kvh * 4 + g; const float slope = exp2f(-(float)(h + 1)), sink = p.in[11][h];
        bf16x8 qf[2];
#pragma unroll
        for (int ks = 0; ks < 2; ++ks) qf[ks] = *(const bf16x8*)(PB + (size_t)qtok * PW + h * 64 + ks * 32 + 8 * fq);
        f32x4 s[10]; float mx = sink;
#pragma unroll
        for (int j = 0; j < 10; ++j) {
            const int ct = (wid + j) < 15 ? (wid + j) : 15;
            f32x4 acc = (f32x4){0.f, 0.f, 0.f, 0.f};
#pragma unroll
            for (int ks = 0; ks < 2; ++ks) acc = mfma16(*(const LAS bf16x8*)(Ks + (16 * ct + fr) * 72 + ks * 32 + 8 * fq), qf[ks], acc);
#pragma unroll
            for (int e = 0; e < 4; ++e) {
                const int c = 16 * (wid + j) + 4 * fq + e, dist = 16 * wid + fr - c + 128;
                const bool ok = (wid + j <= 15) && dist >= 0 && dist <= 128 && (blk * 128 + c - 128 >= 0);
                const float v = ok ? acc[e] * 0.125f - slope * (float)dist : -INFINITY;
                acc[e] = v; mx = fmaxf(mx, v);
            }
            s[j] = acc;
            asm volatile("" ::: "memory");
        }
        mx = fmaxf(mx, __shfl_xor(mx, 16)); mx = fmaxf(mx, __shfl_xor(mx, 32));
        float sum = 0.f;
#pragma unroll
        for (int j = 0; j < 10; ++j)
#pragma unroll
            for (int e = 0; e < 4; ++e) { const float pv = __expf(s[j][e] - mx); s[j][e] = pv; sum += pv; }
        sum += __shfl_xor(sum, 16); sum += __shfl_xor(sum, 32);
        sum += __expf(sink - mx);
        const float inv = 1.0f / sum;
        bf16x8 pb[5];
#pragma unroll
        for (int kk = 0; kk < 5; ++kk) { u32x4 w; w.x = cvt_pk(s[2 * kk][0] * inv, s[2 * kk][1] * inv); w.y = cvt_pk(s[2 * kk][2] * inv, s[2 * kk][3] * inv);
            w.z = cvt_pk(s[2 * kk + 1][0] * inv, s[2 * kk + 1][1] * inv); w.w = cvt_pk(s[2 * kk + 1][2] * inv, s[2 * kk + 1][3] * inv); pb[kk] = __builtin_bit_cast(bf16x8, w); }
#pragma unroll
        for (int dt = 0; dt < 4; ++dt) {
            f32x4 acc = (f32x4){0.f, 0.f, 0.f, 0.f};
#pragma unroll
            for (int kk = 0; kk < 5; ++kk) {
                const int c0 = (wid + 2 * kk) < 15 ? (wid + 2 * kk) : 15, c1 = (wid + 2 * kk + 1) < 15 ? (wid + 2 * kk + 1) : 15;
                const u32x2 lo = *(const LAS u32x2*)(Vt + (16 * dt + fr) * 264 + 16 * c0 + 4 * fq), hi = *(const LAS u32x2*)(Vt + (16 * dt + fr) * 264 + 16 * c1 + 4 * fq);
                const u32x4 a = (u32x4){lo.x, lo.y, hi.x, hi.y};
                acc = mfma16(__builtin_bit_cast(bf16x8, a), pb[kk], acc);
            }
            u32x2 w; w.x = cvt_pk(acc[0], acc[1]); w.y = cvt_pk(acc[2], acc[3]);
            *(u32x2*)(PB + (size_t)qtok * PW + h * 64 + 16 * dt + 4 * fq) = w;
            asm volatile("" ::: "memory");
        }
    }
}

__device__ __forceinline__ void sattn_unit(const Params& p, int s, int h, int lane) {
    const int kvh = h >> 2; const bool wr = (h & 3) == 0;
    bf16_t* PB = (bf16_t*)(p.ws + WS_H) + (size_t)(MPR + s) * PW;
    const float* ck = p.in[2] + (size_t)s * 128 * 128 + kvh * 64 + lane; const float* cv = p.in[3] + (size_t)s * 128 * 128 + kvh * 64 + lane;
    float* nk = p.out + O_KS + (size_t)s * 128 * 128 + kvh * 64 + lane; float* nv = p.out + O_VS + (size_t)s * 128 * 128 + kvh * 64 + lane;
    const float q = bf2f(PB[h * 64 + lane]) * 0.125f, slope = exp2f(-(float)(h + 1)), sink = p.in[11][h];
    const float knew = bf2f(PB[512 + kvh * 64 + lane]), vnew = bf2f(PB[640 + kvh * 64 + lane]);
    float sc[3];
#pragma unroll
    for (int t = 0; t < 2; ++t) {
#pragma unroll 8
        for (int jj = 0; jj < 64; ++jj) {
            const int j = t * 64 + jj; const float kval = ck[(size_t)j * 128];
            if (wr && j >= 1) nk[(size_t)(j - 1) * 128] = kval;
            const float d = wave_sum(q * kval) - slope * (float)(128 - j); if (lane == jj) sc[t] = d;
        }
    }
    if (wr) nk[(size_t)127 * 128] = knew;
    sc[2] = wave_sum(q * knew);
    const float mx = fmaxf(fmaxf(wave_max(fmaxf(sc[0], sc[1])), sc[2]), sink);
    const float p0 = __expf(sc[0] - mx), p1 = __expf(sc[1] - mx), p2 = __expf(sc[2] - mx);
    const float inv = 1.0f / (wave_sum(p0 + p1) + p2 + __expf(sink - mx));
    float o = p2 * vnew;
#pragma unroll 8
    for (int jj = 0; jj < 64; ++jj) { const float vval = cv[(size_t)jj * 128]; if (wr && jj >= 1) nv[(size_t)(jj - 1) * 128] = vval; o += __shfl(p0, jj) * vval; }
#pragma unroll 8
    for (int jj = 0; jj < 64; ++jj) { const float vval = cv[(size_t)(64 + jj) * 128]; if (wr) nv[(size_t)(63 + jj) * 128] = vval; o += __shfl(p1, jj) * vval; }
    if (wr) nv[(size_t)127 * 128] = vnew;
    asm volatile("" ::: "memory");
    PB[h * 64 + lane] = f2bf(o * inv);
}

__device__ __forceinline__ void sgdn_unit(const Params& p, LAS unsigned char* lds, int s) {
    const int tid = threadIdx.x, wid = tid >> 6, h = tid >> 7, dv = tid & 127;
    LAS float* qs = (LAS float*)lds; LAS float* ks = qs + 512; LAS float* red = ks + 512;
    bf16_t* PB = (bf16_t*)(p.ws + WS_H) + (size_t)(MPR + s) * PW; const float* GBA = (const float*)(p.ws + WS_GBA) + (size_t)(MPR + s) * 8;
    const float* cw = p.in[12]; const float* hc = p.in[4] + (size_t)s * 3 * CONVC; float* nc = p.out + O_CS + (size_t)s * 3 * CONVC;
    __syncthreads();
    float val[3];
#pragma unroll
    for (int i = 0; i < 3; ++i) {
        const int c = i * 512 + tid; const float x3 = bf2f(PB[768 + c]), h0 = hc[c], h1 = hc[CONVC + c], h2 = hc[2 * CONVC + c];
        val[i] = silu(cw[c] * h0 + cw[CONVC + c] * h1 + cw[2 * CONVC + c] * h2 + cw[3 * CONVC + c] * x3);
        nc[c] = h1; nc[CONVC + c] = h2; nc[2 * CONVC + c] = x3;
    }
    const float sq = wave_sum(val[0] * val[0]), sk = wave_sum(val[1] * val[1]);
    if ((tid & 63) == 0) { red[wid] = sq; red[8 + wid] = sk; }
    __syncthreads();
    const float ssq = red[2 * h] + red[2 * h + 1], ssk = red[8 + 2 * h] + red[8 + 2 * h + 1];
    qs[tid] = val[0] * rsqrtf(ssq + EPS) * 0.08838834764831845f; ks[tid] = val[1] * rsqrtf(ssk + EPS);
    __syncthreads();
    const float beta = 1.0f / (1.0f + __expf(-GBA[h]));
    const float x = GBA[4 + h] + p.in[14][h]; const float sp = x > 20.f ? x : log1pf(__expf(x));
    const float eg = __expf(-__expf(p.in[13][h]) * sp);
    const float* S0 = p.in[5] + ((size_t)(s * 4 + h) * 128) * 128 + dv; float* S1 = p.out + O_GS + ((size_t)(s * 4 + h) * 128) * 128 + dv;
    float kS = 0.f;
#pragma unroll 1
    for (int hf = 0; hf < 4; ++hf) { float sv[32];
#pragma unroll
        for (int dk = 0; dk < 32; ++dk) sv[dk] = S0[(size_t)(hf * 32 + dk) * 128];
#pragma unroll
        for (int dk = 0; dk < 32; ++dk) kS += ks[h * 128 + hf * 32 + dk] * sv[dk]; }
    const float delta = beta * (val[2] - eg * kS);
    float o = 0.f;
#pragma unroll 1
    for (int hf = 0; hf < 4; ++hf) { float sv[32];
#pragma unroll
        for (int dk = 0; dk < 32; ++dk) sv[dk] = S0[(size_t)(hf * 32 + dk) * 128];
#pragma unroll
        for (int dk = 0; dk < 32; ++dk) { const float nvv = eg * sv[dk] + ks[h * 128 + hf * 32 + dk] * delta; S1[(size_t)(hf * 32 + dk) * 128] = nvv; o += qs[h * 128 + hf * 32 + dk] * nvv; } }
    const float so = wave_sum(o * o);
    if ((tid & 63) == 0) red[16 + wid] = so;
    __syncthreads();
    const float tot = red[16 + 2 * h] + red[16 + 2 * h + 1];
    const float gz = bf2f(PB[2304 + tid]);
    PB[512 + tid] = f2bf(o * rsqrtf(tot * (1.0f / 128.0f) + EPS) * p.in[15][dv] * silu(gz));
}

__device__ __forceinline__ void late_weight_items(const Params& p, LAS unsigned char* lds, int gw, int NGW) {
    const int lane = threadIdx.x & 63, wid = threadIdx.x >> 6;
    LAS float* scr = (LAS float*)(lds + wid * 16384);
    bf16_t* WOUTMIX = (bf16_t*)(p.ws + WS_WOUTMIX); bf16_t* W2IN = (bf16_t*)(p.ws + WS_W2IN); bf16_t* W2OUT = (bf16_t*)(p.ws + WS_W2OUT);
    constexpr int I_FIN = 16 * 176, I_FOUT = 44 * 32, I_OUTMIX = 16 * 32;
    for (int it = gw; it < I_FIN + I_FOUT + I_OUTMIX; it += NGW) {
        int r = it;
        if (r < I_OUTMIX) { const int kb = r / 32, nb = r % 32; transpose_item(p.in[16], DM, DM, WOUTMIX, kb * 64, nb * 32, nb * 32, nullptr, scr, lane); continue; } r -= I_OUTMIX;
        if (r < I_FIN) { const int kb = r / 176, nb = r % 176; transpose_item(p.in[18], DM, 2 * DFF, W2IN, kb * 64, nb * 32, map_ffin_row(nb * 32), p.in[17], scr, lane); continue; } r -= I_FIN;
        { const int kb = r / 32, nb = r % 32; transpose_item(p.in[19], DFF, DM, W2OUT, kb * 64, nb * 32, nb * 32, nullptr, scr, lane); }
    }
}
#define XB_TMO      128
#define XB_XCNT(j)  (256  + 64 * (j))
#define XB_XSUB(j)  (1280 + 64 * (j))
#define XB_XGEN(j)  (2304 + 64 * (j))
#define XB_TOP      3328
#define XB_TOPGEN   3392
#define XCD_BAR_WORDS 3456
#define XB_SPIN_CAP (1u << 18)

__device__ __forceinline__ unsigned xb_ld(unsigned* p)              { return __hip_atomic_load(p, __ATOMIC_RELAXED, __HIP_MEMORY_SCOPE_AGENT); }
__device__ __forceinline__ unsigned xb_add(unsigned* p, unsigned v) { return __hip_atomic_fetch_add(p, v, __ATOMIC_RELAXED, __HIP_MEMORY_SCOPE_AGENT); }
__device__ __forceinline__ unsigned xb_xcc_id() { return (unsigned)__builtin_amdgcn_s_getreg((3 << 11) | 20) & 0xFu; }
#define XB_SPIN(cond, bar) do { unsigned _sp = 0; while (cond) { __builtin_amdgcn_s_sleep(1); \
    if ((++_sp & 255u) == 0u) { if (xb_ld(&(bar)[XB_TMO])) break; if (_sp > XB_SPIN_CAP) { atomicAdd(&(bar)[XB_TMO], 1u); break; } } } } while (0)

struct XcdBarrier {
    unsigned* bar; unsigned x;
    volatile LAS unsigned* st;
};

__device__ __forceinline__ XcdBarrier xcd_barrier_post(unsigned* bar, volatile LAS unsigned* st) {
    XcdBarrier b; b.bar = bar; b.x = xb_xcc_id(); b.st = st;
    if (threadIdx.x == 0) (void)xb_add(&bar[XB_XCNT(b.x)], 1u);
    return b;
}
__device__ __forceinline__ void xcd_barrier_complete(unsigned* bar, unsigned x, unsigned& nloc, unsigned& nx) {
    const unsigned G = gridDim.x * gridDim.y * gridDim.z;
    unsigned sum, cnt, mine, sp = 0u;
    for (;;) {
        sum = 0u; cnt = 0u; mine = 0u;
#pragma unroll
        for (unsigned j = 0; j < 16; ++j) { const unsigned c = xb_ld(&bar[XB_XCNT(j)]); sum += c; cnt += (c > 0u) ? 1u : 0u; mine = (j == x) ? c : mine; }
        if (sum == G) break;
        __builtin_amdgcn_s_sleep(1);
        if ((++sp & 255u) == 0u) { if (xb_ld(&bar[XB_TMO])) break; if (sp > XB_SPIN_CAP) { atomicAdd(&bar[XB_TMO], 1u); break; } }
    }
    nloc = mine > 0u ? mine : 1u; nx = cnt > 0u ? cnt : 1u;
}

__device__ __forceinline__ void xcd_barrier(const XcdBarrier& b) {
    asm volatile("s_waitcnt vmcnt(0)" ::: "memory");
    __syncthreads();
    if (threadIdx.x == 0) {
        unsigned* bar = b.bar;
        __builtin_amdgcn_s_waitcnt(0);
        unsigned nloc = b.st[0], nx = b.st[1];
        if (nloc == 0u) { xcd_barrier_complete(bar, b.x, nloc, nx); b.st[0] = nloc; b.st[1] = nx; }
        const unsigned old = xb_add(&bar[XB_XSUB(b.x)], 1u);
        const unsigned gen = old / nloc;
        if (old + 1u == (gen + 1u) * nloc) {
            __builtin_amdgcn_fence(__ATOMIC_RELEASE, "agent");
            asm volatile("s_waitcnt vmcnt(0)" ::: "memory");
            const unsigned og = xb_add(&bar[XB_TOP], 1u);
            const unsigned tg = og / nx;
            if (og + 1u == (tg + 1u) * nx) xb_add(&bar[XB_TOPGEN], 1u);
            else XB_SPIN(xb_ld(&bar[XB_TOPGEN]) == tg, bar);
            __builtin_amdgcn_fence(__ATOMIC_ACQUIRE, "agent");
            xb_add(&bar[XB_XGEN(b.x)], 1u);
            asm volatile("s_waitcnt vmcnt(0)" ::: "memory");
        } else {
            XB_SPIN(xb_ld(&bar[XB_XGEN(b.x)]) == gen, bar);
            __builtin_amdgcn_fence(__ATOMIC_ACQUIRE, "agent");
            asm volatile("s_waitcnt vmcnt(0)" ::: "memory");
        }
    }
    __syncthreads();
}

__global__ void __launch_bounds__(512, 2) fwd_kernel(Params p, int ph_lo, int ph_hi) {
    extern __shared__ __attribute__((aligned(16))) unsigned char lds_raw[];
    LAS unsigned char* lds = (LAS unsigned char*)lds_raw;
    cg::grid_group grid = cg::this_grid();
    if (ph_lo < 0) grid.sync();
    volatile LAS unsigned* bst = (volatile LAS unsigned*)(lds + LDS_PHASE_BYTES);
    if (threadIdx.x < 2) bst[threadIdx.x] = 0u;
    __syncthreads();
    XcdBarrier xbar; xbar.bar = (unsigned*)(p.ws + WS_CTL + CTL_BAR); xbar.x = 0; xbar.st = bst;
    if (ph_hi - ph_lo > 1) xbar = xcd_barrier_post((unsigned*)(p.ws + WS_CTL + CTL_BAR), bst);
    const int tid = threadIdx.x, lane = tid & 63, wid = tid >> 6, G = gridDim.x, bx = blockIdx.x;
    unsigned char* ws = p.ws;
    bf16_t* XN = (bf16_t*)(ws + WS_XN); bf16_t* XN2 = (bf16_t*)(ws + WS_XN2); bf16_t* HB = (bf16_t*)(ws + WS_H);
    float* SS1 = (float*)(ws + WS_SSP1); float* SS2 = (float*)(ws + WS_SSP2);
    float* Y = p.out; bf16_t* X3b = (bf16_t*)(ws + WS_GM);
#ifndef PHMASK
#define PHMASK 0x7ff
#endif
#define IN(k) (((PHMASK >> (k)) & 1) && ph_lo <= (k) && (k) < ph_hi)
#define SEAM(k) do { if (IN(k) && IN((k) + 1)) { xcd_barrier(xbar); }     } while (0)

    if (IN(0)) p0_prologue(p, lds, bx, G);
    SEAM(0);
    if (IN(1)) {
        if (bx < 176) sk_ffn_in<false>(XN, (const bf16_t*)(ws + WS_W1IN), HB, bx, wid, lane & 15, lane >> 4, lds);
        pg8::Gemm g{XN, (const bf16_t*)(ws + WS_W1IN), MPR, 2 * DFF, DM, DM}; pg8::StaticOrder S; S.init(MPR, 2 * DFF, G, bx, WGM_FIN);
        EpiSwiglu E{HB, nullptr}; pg8::gemm_phase<EpiSwiglu, pg8::StaticOrder, GEMM_ALIGN, GEMM_SP2>(lds, g, S, E);
    }
    SEAM(1);
    if (IN(2)) {
        if (bx < 64) sk_ffn_out<false>(HB, (const bf16_t*)(ws + WS_W1OUT), p.in[1], nullptr, XN + (size_t)MPR * DM, bx, wid, lane & 15, lane >> 4, lds);
        pg8::Gemm g{HB, (const bf16_t*)(ws + WS_W1OUT), MPR, DM, DFF, DFF}; pg8::StaticOrder S; S.init(MPR, DM, G, bx);
        EpiResid<false, false, true, true, true> E{p.in[0], p.in[1], nullptr, XN, SS1}; pg8::gemm_phase<EpiResid<false, false, true, true, true>, pg8::StaticOrder, GEMM_ALIGN, GEMM_SP2>(lds, g, S, E);
    }
    SEAM(2);
    if (IN(3)) {
        if (bx < 89) sk_inproj(XN, (const bf16_t*)(ws + WS_WINMIX), HB, (float*)(ws + WS_GBA), bx, wid, lane & 15, lane >> 4, lds);
        pg8::Gemm g{XN, (const bf16_t*)(ws + WS_WINMIX), MPR, NINP, DM, DM}; pg8::StaticOrder S; S.init(MPR, NINP, G, bx);
        EpiInproj E{HB, (float*)(ws + WS_GBA), SS1}; pg8::gemm_phase<EpiInproj, pg8::StaticOrder, GEMM_ALIGN, GEMM_SP2>(lds, g, S, E);
    }
    SEAM(3);
    if (IN(4)) {
        for (int u = bx; u < 2048; u += G) gdn_prep_unit(p, lds, u);
    }
    SEAM(4);
    if (IN(5)) {
        if (bx < NSCAN) gdn_scan(p, lds, bx);
        else {
            const int ab = bx - NSCAN, NAB = G - NSCAN;
            if (NAB == 192) {
                if (ab < 128) { sattn_unit(p, ab, wid, lane); sgdn_unit(p, lds, ab); attn_unit(p, lds, 2 * ab); attn_unit(p, lds, 2 * ab + 1); }
                else { for (int k = 0; k < 4; ++k) attn_unit(p, lds, 256 + (ab - 128) * 4 + k); }
            } else {
                int it = ab;
#pragma unroll 1
                for (; it < 512; it += NAB) attn_unit(p, lds, it);
#pragma unroll 1
                for (; it < 640; it += NAB) { sattn_unit(p, it - 512, wid, lane); sgdn_unit(p, lds, it - 512); }
            }
            const bf16_t* PB = HB;
            for (int idx = ab * 512 + tid; idx < 149504; idx += NAB * 512) {
                if (idx < 131072) { const int w = idx >> 16, r = idx & 65535, b = r >> 14, j = (r >> 7) & 127, c = r & 127;
                    p.out[(w ? O_VP : O_KP) + r] = bf2f(PB[(size_t)(b * SEQ + SEQ - 128 + j) * PW + 512 + w * 128 + c]);
                } else { const int r = idx - 131072, b = r / (3 * CONVC), q = r % (3 * CONVC), rr = q / CONVC, c = q % CONVC;
                    p.out[O_CP + r] = bf2f(PB[(size_t)(b * SEQ + SEQ - 3 + rr) * PW + 768 + c]); }
            }
            __syncthreads();
            late_weight_items(p, lds, ab * 8 + wid, NAB * 8);
        }
    }
    SEAM(5);
    if (IN(6)) {
        for (int u = bx * 8 + wid; u < 2048; u += G * 8) gdn_gate_unit(p, lds, wid, u, lane);
    }
    SEAM(6);
#ifdef DBG_DUMP
    if (ph_lo == 11) {
        const float* src = (const float*)(ws + DBG_SRC);
        for (size_t i = (size_t)bx * 512 + tid; i < (size_t)MREAL * DM; i += (size_t)G * 512) Y[i] = (i < (size_t)MREAL * 8) ? ((const float*)(ws + WS_GBA))[i] : 0.f;
    }
#endif
    if (IN(7)) {
        if (bx < 32) sk_outproj(HB, (const bf16_t*)(ws + WS_WOUTMIX), XN, nullptr, XN2, bx, wid, lane & 15, lane >> 4, lds);
        pg8::Gemm g{HB, (const bf16_t*)(ws + WS_WOUTMIX), MPR, DM, DM, PW}; pg8::StaticOrder S; S.init(MPR, DM, G, bx);
        EpiResid<true, false, true, true, false> E{XN, XN + (size_t)MPR * DM, nullptr, XN2, SS2}; pg8::gemm_phase<EpiResid<true, false, true, true, false>, pg8::StaticOrder, GEMM_ALIGN, GEMM_SP2>(lds, g, S, E);
    }
    SEAM(7);
    if (IN(8)) {
        if (bx < 176) sk_ffn_in<true>(XN2, (const bf16_t*)(ws + WS_W2IN), HB, bx, wid, lane & 15, lane >> 4, lds);
        pg8::Gemm g{XN2, (const bf16_t*)(ws + WS_W2IN), MPR, 2 * DFF, DM, DM}; pg8::StaticOrder S; S.init(MPR, 2 * DFF, G, bx, WGM_FIN);
        EpiSwiglu E{HB, SS2}; pg8::gemm_phase<EpiSwiglu, pg8::StaticOrder, GEMM_ALIGN, GEMM_SP2>(lds, g, S, E);
    }
    SEAM(8);
    if (IN(9)) {
        if (bx < 64) sk_ffn_out<true>(HB, (const bf16_t*)(ws + WS_W2OUT), (const float*)(XN2 + (size_t)MPR * DM), nullptr, X3b + (size_t)MPR * DM, bx, wid, lane & 15, lane >> 4, lds);
        pg8::Gemm g{HB, (const bf16_t*)(ws + WS_W2OUT), MPR, DM, DFF, DFF}; pg8::StaticOrder S; S.init(MPR, DM, G, bx);
        EpiResid<true, false, true, false, true> E{XN2, XN2 + (size_t)MPR * DM, nullptr, X3b, nullptr}; pg8::gemm_phase<EpiResid<true, false, true, false, true>, pg8::StaticOrder, GEMM_ALIGN, GEMM_SP2>(lds, g, S, E);
    }
    SEAM(9);
    if (IN(10)) {
        const float* gf = p.in[20]; f32x4 gv[4];
#pragma unroll
        for (int j = 0; j < 4; ++j) gv[j] = *((const f32x4*)gf + lane + 64 * j);
        {
            f32x4 v[4], vn[4]; int m = bx * 8 + wid;
            if (m < MREAL) { const u32x2* xr = (const u32x2*)(X3b + (size_t)m * DM) + lane;
#pragma unroll
                for (int j = 0; j < 4; ++j) { const u32x2 w = xr[64 * j]; v[j] = (f32x4){bflo(w.x), bfhi(w.x), bflo(w.y), bfhi(w.y)}; } }
            for (; m < MREAL; m += G * 8) {
                const int mn = m + G * 8;
                if (mn < MREAL) { const u32x2* xr = (const u32x2*)(X3b + (size_t)mn * DM) + lane;
#pragma unroll
                    for (int j = 0; j < 4; ++j) { const u32x2 w = xr[64 * j]; vn[j] = (f32x4){bflo(w.x), bfhi(w.x), bflo(w.y), bfhi(w.y)}; } }
                float s = 0.f;
#pragma unroll
                for (int j = 0; j < 4; ++j) s += (v[j][0] * v[j][0] + v[j][1] * v[j][1]) + (v[j][2] * v[j][2] + v[j][3] * v[j][3]);
                const float rstd = rsqrtf(wave_sum(s) * (1.0f / DM) + EPS);
                f32x4* yr = (f32x4*)(Y + (size_t)m * DM) + lane;
#pragma unroll
                for (int j = 0; j < 4; ++j) yr[64 * j] = v[j] * rstd * gv[j];
#pragma unroll
                for (int j = 0; j < 4; ++j) v[j] = vn[j];
            }
        }
    }
#undef IN
#undef SEAM
}
}

#ifndef MK_N_LAUNCHES
#define MK_N_LAUNCHES 1
#endif
extern "C" void kernel_launch(void* const* d_in, const int* in_sizes, int n_in, void* d_out, int out_size, void* d_ws, size_t ws_size, hipStream_t stream) {
    static int grid = 0;
    if (grid == 0) {
        if (n_in != 21 || ws_size < mk::WS_END || out_size != 47269888) { fprintf(stderr, "kernel_launch: unexpected shapes (n_in %d, ws %zu, out %d)\n", n_in, ws_size, out_size); grid = -1; return; }
        int dev = 0, cus = 0, per_cu = 0;
        (void)hipGetDevice(&dev); (void)hipDeviceGetAttribute(&cus, hipDeviceAttributeMultiprocessorCount, dev);
        if (hipFuncSetAttribute((const void*)mk::fwd_kernel, hipFuncAttributeMaxDynamicSharedMemorySize, mk::LDS_BYTES) != hipSuccess) { fprintf(stderr, "kernel_launch: hipFuncSetAttribute failed\n"); grid = -1; return; }
        if (hipOccupancyMaxActiveBlocksPerMultiprocessor(&per_cu, (const void*)mk::fwd_kernel, 512, mk::LDS_BYTES) != hipSuccess || per_cu < 1) { fprintf(stderr, "kernel_launch: occupancy query failed (%d)\n", per_cu); per_cu = 1; }
        (void)hipGetLastError();
        grid = cus * per_cu;
        if (grid <= mk::NSCAN) { fprintf(stderr, "kernel_launch: grid %d too small\n", grid); grid = -1; return; }
    }
    if (grid < 0) return;
    (void)hipMemsetAsync((char*)d_ws + mk::WS_CTL + mk::CTL_BAR, 0, mk::CTL_BAR_BYTES, stream);
    mk::Params p{};
    for (int i = 0; i < 21; ++i) p.in[i] = (const float*)d_in[i];
    p.out = (float*)d_out; p.ws = (unsigned char*)d_ws;
#if MK_N_LAUNCHES == 1
    int lo = 0, hi = 11; void* args[] = {&p, &lo, &hi};
    hipError_t e = hipLaunchCooperativeKernel((const void*)mk::fwd_kernel, dim3(grid), dim3(512), args, mk::LDS_BYTES, stream);
    if (e != hipSuccess) fprintf(stderr, "kernel_launch: cooperative launch failed: %s (grid %d)\n", hipGetErrorString(e), grid);
#else
#ifndef MK_LAST
#define MK_LAST 11
#ifndef MK_DOUBLE
#define MK_DOUBLE 0x0
#endif
#define DBG_C0 512
#define DBG_C1 1024
#endif
    for (int ph = 0; ph < MK_LAST; ++ph) { const int reps = ((MK_DOUBLE >> ph) & 1) ? 2 : 1; for (int r = 0; r < reps; ++r) hipLaunchKernelGGL(mk::fwd_kernel, dim3(grid), dim3(512), mk::LDS_BYTES, stream, p, ph, ph + 1); }
#ifdef DBG_DUMP
    hipLaunchKernelGGL(mk::fwd_kernel, dim3(grid), dim3(512), mk::LDS_BYTES, stream, p, 11, 12);
#endif
#endif
}
```
